# Optimizing an MI355X kernel written in HIP

```python
import math
import jax
import jax.numpy as jnp
from jax import lax
import numpy as np

D_MODEL = 1024
BATCH = 8
SEQ = 4096
DEPTH = 2

N_EVEN = (DEPTH + 1) // 2
N_ODD = DEPTH // 2
NORM_EPS = 1e-6

MLSTM_HEADS = 4
MLSTM_HD = D_MODEL // 8
MLSTM_W = MLSTM_HEADS * MLSTM_HD
MLSTM_CHUNK = 128
CONV_W = 5
POOL_WINDOWS = (2, 4, 8, 16)
POOL_GROUPS = len(POOL_WINDOWS)
POOL_GC = D_MODEL // 8
POOL_W = POOL_GROUPS * POOL_GC
MIX_W = MLSTM_W + POOL_W
N_GATE = 2 * 2 * MLSTM_HEADS
EVEN_IN = 4 * MLSTM_W + POOL_W + N_GATE
ATT_HD = 128
ATT_HEADS = D_MODEL // ATT_HD
ATT_KV_HEADS = ATT_HEADS // 4
ATT_GROUP = ATT_HEADS // ATT_KV_HEADS
ATT_W = ATT_HEADS * ATT_HD
ODD_IN = (ATT_HEADS + 2 * ATT_KV_HEADS) * ATT_HD
Q_BLOCK = 128
ROPE_THETA = 10000.0
GRID_W = 64
PEER_HEADS = 8
PEER_NKEYS = 128
PEER_EXPERTS = PEER_NKEYS * PEER_NKEYS
PEER_QDIM = 256
PEER_TOPK = 16
PEER_CHUNK = 128

kernel_name = 'hybrid_mlstm_pool_axialgqa_peer_encoder'

f32 = jnp.float32


def _unit_rms(x):
    xf = x.astype(f32)
    return xf * lax.rsqrt(jnp.mean(xf * xf, axis=-1, keepdims=True) + NORM_EPS)


def _rms_norm(x, g):
    return (_unit_rms(x) * g.astype(f32)).astype(x.dtype)


def _dwconv_centred(a, w, b):
    y = lax.conv_general_dilated(a, w.astype(a.dtype), window_strides=(1,), padding='SAME',
                                 dimension_numbers=('NWC', 'WIO', 'NWC'),
                                 feature_group_count=a.shape[-1])
    return y + b


def _mlstm_bidir_scan(q, k, v, log_i, log_f):
    lead = q.shape[:3]
    S = q.shape[3]
    L = MLSTM_CHUNK
    nc = S // L

    def to_chunks(a):
        a = a.reshape(lead + (nc, L) + a.shape[4:])
        return jnp.moveaxis(a, 3, 0)

    in_chunk_mask = jnp.tril(jnp.ones((L, L), dtype=bool))

    def step(carry, inp):
        C, n, m = carry
        qc, kc, vc, li, lf = inp
        b = jnp.cumsum(lf, axis=-1)
        b_end = b[..., -1]
        log_w = jnp.where(in_chunk_mask, b[..., :, None] - b[..., None, :] + li[..., None, :], -jnp.inf)
        log_carry = b + m[..., None]
        m_t = jnp.maximum(log_carry, jnp.max(log_w, axis=-1))
        w_intra = jnp.exp(log_w - m_t[..., None])
        w_carry = jnp.exp(log_carry - m_t)
        sc = jnp.einsum('...jd,...sd->...js', qc, kc) * w_intra
        num = jnp.einsum('...js,...sv->...jv', sc, vc) + w_carry[..., None] * jnp.einsum('...jd,...dv->...jv', qc, C)
        den = jnp.sum(sc, axis=-1) + w_carry * jnp.einsum('...jd,...d->...j', qc, n)
        h = num / jnp.maximum(jnp.abs(den), jnp.exp(-m_t))[..., None]
        log_end = b_end[..., None] - b + li
        m_new = jnp.maximum(b_end + m, jnp.max(log_end, axis=-1))
        w_end = jnp.exp(log_end - m_new[..., None])
        decay = jnp.exp(b_end + m - m_new)
        kw = kc * w_end[..., None]
        C_new = decay[..., None, None] * C + jnp.einsum('...sd,...sv->...dv', kw, vc)
        n_new = decay[..., None] * n + jnp.sum(kw, axis=-2)
        return (C_new, n_new, m_new), h

    d = q.shape[-1]
    dv = v.shape[-1]
    init = (jnp.zeros(lead + (d, dv), f32), jnp.zeros(lead + (d,), f32), jnp.zeros(lead, f32))
    _, hs = lax.scan(step, init, (to_chunks(q), to_chunks(k), to_chunks(v), to_chunks(log_i), to_chunks(log_f)))
    return jnp.moveaxis(hs, 0, 3).reshape(lead + (S, dv))


def _multiscale_pool(p, pool_w, pool_scale):
    B, S, _ = p.shape
    pf = p.astype(f32)
    csum = jnp.concatenate([jnp.zeros((B, 1, POOL_W), f32), jnp.cumsum(pf, axis=1)], axis=1)
    t = jnp.arange(S)
    outs = []
    for gi, win in enumerate(POOL_WINDOWS):
        lo = jnp.clip(t - win // 2, 0, S)
        hi = jnp.clip(t + win // 2, 0, S)
        sl = slice(gi * POOL_GC, (gi + 1) * POOL_GC)
        cg = csum[..., sl]
        mean = (cg[:, hi] - cg[:, lo]) / (hi - lo).astype(f32)[None, :, None]
        y = (mean - pf[..., sl]).astype(p.dtype)
        outs.append(jnp.einsum('bsc,ce->bse', y, pool_w[gi]))
    return jnp.concatenate(outs, axis=-1) * pool_scale


def _mlstm_pool_mixer(h, w_in, b_in, conv_w, conv_b, mnorm_g, pool_w, pool_scale, w_out):
    B, S, _ = h.shape
    z = jnp.einsum('bsd,de->bse', h, w_in) + b_in
    qk, v, o, p, g = jnp.split(z, [2 * MLSTM_W, 3 * MLSTM_W, 4 * MLSTM_W, 4 * MLSTM_W + POOL_W], axis=-1)
    qk = jax.nn.silu(_dwconv_centred(qk, conv_w, conv_b))
    q, k = jnp.split(qk, 2, axis=-1)

    def heads(a):
        return a.reshape(B, S, MLSTM_HEADS, MLSTM_HD).transpose(0, 2, 1, 3).astype(f32)

    q, k, v = heads(q), heads(k) * (MLSTM_HD ** -0.5), heads(v)

    def both(a):
        return jnp.stack([a, jnp.flip(a, axis=2)])

    g = g.astype(f32).reshape(B, S, 2, 2, MLSTM_HEADS).transpose(2, 3, 0, 4, 1)
    log_i = jnp.stack([g[0, 0], jnp.flip(g[0, 1], axis=-1)])
    log_f = jax.nn.log_sigmoid(jnp.stack([g[1, 0], jnp.flip(g[1, 1], axis=-1)]))
    hs = _mlstm_bidir_scan(both(q), both(k), both(v), log_i, log_f)
    hm = (hs[0] + jnp.flip(hs[1], axis=2)).transpose(0, 2, 1, 3)
    hm = _rms_norm(hm, mnorm_g.reshape(MLSTM_HEADS, MLSTM_HD)).astype(h.dtype)
    hm = hm.reshape(B, S, MLSTM_W) * jax.nn.sigmoid(o)
    yp = _multiscale_pool(p, pool_w, pool_scale)
    return jnp.einsum('bse,ed->bsd', jnp.concatenate([hm, yp], axis=-1), w_out)


def _axial_rope_tables(S):
    rows = S // GRID_W
    r, cidx = jnp.meshgrid(jnp.arange(rows), jnp.arange(GRID_W), indexing='ij')
    axis_dim = ATT_HD // 2
    freqs = ROPE_THETA ** (-jnp.arange(0, axis_dim, 2, dtype=f32) / axis_dim)
    ang = jnp.concatenate([r.reshape(-1, 1).astype(f32) * freqs,
                           cidx.reshape(-1, 1).astype(f32) * freqs], axis=-1)
    return jnp.cos(ang), jnp.sin(ang)


def _apply_rope(x, cos, sin):
    xr = x.astype(f32).reshape(x.shape[:-1] + (ATT_HD // 2, 2))
    x0, x1 = xr[..., 0], xr[..., 1]
    c = cos[None, :, None, :]
    s = sin[None, :, None, :]
    out = jnp.stack([x0 * c - x1 * s, x0 * s + x1 * c], axis=-1).reshape(x.shape)
    return out.astype(x.dtype)


def _gqa_axial_mixer(h, w_in, qn_g, kn_g, w_out):
    B, S, _ = h.shape
    z = jnp.einsum('bsd,de->bse', h, w_in)
    q, k, v = jnp.split(z, [ATT_W, ATT_W + ATT_KV_HEADS * ATT_HD], axis=-1)
    q = _rms_norm(q.reshape(B, S, ATT_HEADS, ATT_HD), qn_g)
    k = _rms_norm(k.reshape(B, S, ATT_KV_HEADS, ATT_HD), kn_g)
    v = v.reshape(B, S, ATT_KV_HEADS, ATT_HD)
    cos, sin = _axial_rope_tables(S)
    q = _apply_rope(q, cos, sin)
    k = _apply_rope(k, cos, sin)
    qb = jnp.moveaxis(q.reshape(B, S // Q_BLOCK, Q_BLOCK, ATT_KV_HEADS, ATT_GROUP, ATT_HD), 1, 0)
    scale = ATT_HD ** -0.5

    def attend(q_blk):
        s = jnp.einsum('bqkgd,bskd->bkgqs', q_blk, k).astype(f32) * scale
        pr = jax.nn.softmax(s, axis=-1).astype(v.dtype)
        return jnp.einsum('bkgqs,bskd->bqkgd', pr, v)

    out = lax.map(attend, qb)
    out = jnp.moveaxis(out, 0, 1).reshape(B, S, ATT_W)
    return jnp.einsum('bse,ed->bsd', out, w_out)


def _peer(h, w_q, sub_keys, u, v):
    B, S, D = h.shape
    xt = h.reshape(B * S // PEER_CHUNK, PEER_CHUNK, D)
    half = PEER_QDIM // 2
    nk2 = PEER_TOPK * PEER_TOPK

    def chunk(xc):
        q = jnp.einsum('td,de->te', xc, w_q).reshape(PEER_CHUNK, PEER_HEADS, 2, half)
        q = _unit_rms(q)
        s = jnp.einsum('thpc,pnc->thpn', q, sub_keys.astype(f32))
        s1, i1 = lax.top_k(s[:, :, 0], PEER_TOPK)
        s2, i2 = lax.top_k(s[:, :, 1], PEER_TOPK)
        cand_s = (s1[..., :, None] + s2[..., None, :]).reshape(PEER_CHUNK, PEER_HEADS, nk2)
        cand_i = (i1[..., :, None] * PEER_NKEYS + i2[..., None, :]).reshape(PEER_CHUNK, PEER_HEADS, nk2)
        top_s, pos = lax.top_k(cand_s, PEER_TOPK)
        idx = jnp.take_along_axis(cand_i, pos, axis=-1)
        gate = jax.nn.softmax(top_s, axis=-1)
        act = jax.nn.gelu(jnp.einsum('thkd,td->thk', u[idx], xc).astype(f32), approximate=False)
        coef = (gate * act).astype(xc.dtype)
        return jnp.einsum('thk,thkd->td', coef, v[idx])

    return lax.map(chunk, xt).reshape(B, S, D)


def setup_inputs(seed: int = 0) -> dict:
    key = jax.random.key(seed)
    ks = jax.random.split(key, 28)
    D = D_MODEL

    def nrm(k, shape, s):
        return jax.random.normal(k, shape, f32) * s

    ev_b_in = nrm(ks[7], (N_EVEN, EVEN_IN), 0.02)
    f0 = 4 * MLSTM_W + POOL_W + 2 * MLSTM_HEADS
    ev_b_in = ev_b_in.at[:, f0:f0 + 2 * MLSTM_HEADS].add(
        jax.random.uniform(ks[8], (N_EVEN, 2 * MLSTM_HEADS), f32, 3.0, 6.0))
    return {
        'x': nrm(ks[0], (BATCH, SEQ, D), 1.0),
        'c': nrm(ks[1], (BATCH, D), 1.0),
        'ada_w': nrm(ks[2], (DEPTH, D, 6 * D), 0.5 * D ** -0.5),
        'ada_b': nrm(ks[3], (DEPTH, 6 * D), 0.02),
        'norm_mix_g': 1.0 + nrm(ks[4], (DEPTH, D), 0.05),
        'norm_ffn_g': 1.0 + nrm(ks[5], (DEPTH, D), 0.05),
        'ev_w_in': nrm(ks[6], (N_EVEN, D, EVEN_IN), D ** -0.5),
        'ev_b_in': ev_b_in,
        'ev_conv_w': nrm(ks[9], (N_EVEN, CONV_W, 1, 2 * MLSTM_W), CONV_W ** -0.5),
        'ev_conv_b': nrm(ks[10], (N_EVEN, 2 * MLSTM_W), 0.02),
        'ev_mnorm_g': 1.0 + nrm(ks[11], (N_EVEN, MLSTM_W), 0.05),
        'ev_pool_w': nrm(ks[12], (N_EVEN, POOL_GROUPS, POOL_GC, POOL_GC), POOL_GC ** -0.5),
        'ev_pool_scale': 1.0 + nrm(ks[13], (N_EVEN, POOL_W), 0.1),
        'ev_w_out': nrm(ks[14], (N_EVEN, MIX_W, D), MIX_W ** -0.5),
        'od_w_in': nrm(ks[15], (N_ODD, D, ODD_IN), D ** -0.5),
        'od_qnorm_g': 1.0 + nrm(ks[16], (N_ODD, ATT_HD), 0.05),
        'od_knorm_g': 1.0 + nrm(ks[17], (N_ODD, ATT_HD), 0.05),
        'od_w_out': nrm(ks[18], (N_ODD, ATT_W, D), ATT_W ** -0.5),
        'peer_w_q': nrm(ks[19], (DEPTH, D, PEER_HEADS * PEER_QDIM), D ** -0.5),
        'peer_keys': nrm(ks[20], (DEPTH, 2, PEER_NKEYS, PEER_QDIM // 2), (PEER_QDIM // 2) ** -0.5),
        'peer_u': nrm(ks[21], (DEPTH, PEER_EXPERTS, D), D ** -0.5),
        'peer_v': nrm(ks[22], (DEPTH, PEER_EXPERTS, D), 0.5),
        'final_g': 1.0 + nrm(ks[23], (D,), 0.05),
    }


def reference(x, c, ada_w, ada_b, norm_mix_g, norm_ffn_g, ev_w_in, ev_b_in, ev_conv_w, ev_conv_b,
              ev_mnorm_g, ev_pool_w, ev_pool_scale, ev_w_out, od_w_in, od_qnorm_g, od_knorm_g, od_w_out,
              peer_w_q, peer_keys, peer_u, peer_v, final_g):
    cond = jax.nn.silu(c)
    for i in range(DEPTH):
        mod = jnp.einsum('bd,de->be', cond, ada_w[i]) + ada_b[i]
        sh1, sc1, g1, sh2, sc2, g2 = [m[:, None, :] for m in jnp.split(mod, 6, axis=-1)]
        hmix = _rms_norm(x, norm_mix_g[i]) * (1 + sc1) + sh1
        if i % 2 == 0:
            j = i // 2
            y = _mlstm_pool_mixer(hmix, ev_w_in[j], ev_b_in[j], ev_conv_w[j], ev_conv_b[j], ev_mnorm_g[j],
                                  ev_pool_w[j], ev_pool_scale[j], ev_w_out[j])
        else:
            j = i // 2
            y = _gqa_axial_mixer(hmix, od_w_in[j], od_qnorm_g[j], od_knorm_g[j], od_w_out[j])
        x = x + g1 * y
        hffn = _rms_norm(x, norm_ffn_g[i]) * (1 + sc2) + sh2
        x = x + g2 * _peer(hffn, peer_w_q[i], peer_keys[i], peer_u[i], peer_v[i])
    return _rms_norm(x, final_g)
```

```cpp
#include <hip/hip_runtime.h>
#include <math.h>
#include <stdint.h>

namespace {
constexpr int D = 1024, NB = 8, S = 4096, T = NB * S;
constexpr int EVEN_IN = 2576;
constexpr float EPS = 1e-6f;

__device__ __forceinline__ float siluf(float x) { return x / (1.f + expf(-x)); }
__device__ __forceinline__ float sigmf(float x) { return 1.f / (1.f + expf(-x)); }
__device__ __forceinline__ float wave_sum(float v) { for (int o = 32; o >= 1; o >>= 1) v += __shfl_xor(v, o); return v; }
__device__ __forceinline__ float wave_max(float v) { for (int o = 32; o >= 1; o >>= 1) v = fmaxf(v, __shfl_xor(v, o)); return v; }

__global__ void k_mod(const float* __restrict__ c, const float* __restrict__ w, const float* __restrict__ bias, float* __restrict__ mod) {
  int i = blockIdx.x * blockDim.x + threadIdx.x; if (i >= 2 * NB * 6144) return;
  int e = i % 6144, b = (i / 6144) % NB, l = i / (6144 * NB);
  float acc = 0.f; const float* wl = w + (size_t)l * D * 6144 + e; const float* cb = c + b * D;
  for (int d = 0; d < D; ++d) acc += siluf(cb[d]) * wl[(size_t)d * 6144];
  mod[i] = acc + bias[l * 6144 + e];
}
__global__ void k_norm(const float* __restrict__ x, const float* __restrict__ g, const float* __restrict__ sh, const float* __restrict__ sc, float* __restrict__ h) {
  int t = blockIdx.x, b = t / S, tid = threadIdx.x; __shared__ float red[4];
  float v[4], ss = 0.f;
  for (int i = 0; i < 4; ++i) { v[i] = x[(size_t)t * D + tid + i * 256]; ss += v[i] * v[i]; }
  ss = wave_sum(ss); if ((tid & 63) == 0) red[tid >> 6] = ss; __syncthreads();
  ss = red[0] + red[1] + red[2] + red[3]; float r = rsqrtf(ss / D + EPS);
  for (int i = 0; i < 4; ++i) { int d = tid + i * 256; float y = v[i] * r * g[d]; if (sc) y = y * (1.f + sc[b * 6144 + d]) + sh[b * 6144 + d]; h[(size_t)t * D + d] = y; }
}
__global__ void k_gemm(const float* __restrict__ A, int lda, const float* __restrict__ W, int ldw, const float* __restrict__ bias, float* __restrict__ C, int ldc, int M, int N, int K) {
  __shared__ float As[16][64 + 1], Ws[16][64];
  int tx = threadIdx.x & 15, ty = threadIdx.x >> 4, m0 = blockIdx.y * 64, n0 = blockIdx.x * 64;
  float acc[4][4] = {};
  for (int k0 = 0; k0 < K; k0 += 16) {
    for (int i = threadIdx.x; i < 64 * 16; i += 256) { int r = i / 16, kk = i % 16; As[kk][r] = (m0 + r < M) ? A[(size_t)(m0 + r) * lda + k0 + kk] : 0.f; }
    for (int i = threadIdx.x; i < 16 * 64; i += 256) { int kk = i / 64, cc = i % 64; Ws[kk][cc] = (n0 + cc < N) ? W[(size_t)(k0 + kk) * ldw + n0 + cc] : 0.f; }
    __syncthreads();
    for (int kk = 0; kk < 16; ++kk) { float a[4], w[4];
      for (int i = 0; i < 4; ++i) a[i] = As[kk][ty * 4 + i]; for (int j = 0; j < 4; ++j) w[j] = Ws[kk][tx * 4 + j];
      for (int i = 0; i < 4; ++i) for (int j = 0; j < 4; ++j) acc[i][j] += a[i] * w[j]; }
    __syncthreads();
  }
  for (int i = 0; i < 4; ++i) for (int j = 0; j < 4; ++j) { int m = m0 + ty * 4 + i, n = n0 + tx * 4 + j; if (m < M && n < N) C[(size_t)m * ldc + n] = acc[i][j] + (bias ? bias[n] : 0.f); }
}
__global__ void k_conv(const float* __restrict__ z, const float* __restrict__ w, const float* __restrict__ bias, float* __restrict__ qk) {
  int i = blockIdx.x * blockDim.x + threadIdx.x; if (i >= S * 1024) return; int c = i % 1024, t = i / 1024; float a = bias[c];
  for (int j = 0; j < 5; ++j) { int tt = t + j - 2; if (tt >= 0 && tt < S) a += w[j * 1024 + c] * z[(size_t)tt * EVEN_IN + c]; }
  qk[i] = siluf(a);
}
__global__ __launch_bounds__(256) void k_mlstm(const float* __restrict__ qk, const float* __restrict__ z, float* __restrict__ hs) {
  int dir = blockIdx.x >> 2, h = blockIdx.x & 3, j = threadIdx.x & 127, hf = threadIdx.x >> 7; __shared__ float qs[128], ks[128], red[4], nump[128];
  float C[64];
#pragma unroll
  for (int d = 0; d < 64; ++d) C[d] = 0.f;
  float n = 0.f, m = 0.f;
  for (int step = 0; step < S; ++step) { int t = dir ? S - 1 - step : step;
    const float* zr = z + (size_t)t * EVEN_IN;
    float li = zr[2560 + 0 * 8 + dir * 4 + h], gf = zr[2560 + 1 * 8 + dir * 4 + h];
    float lf = fminf(gf, 0.f) - log1pf(expf(-fabsf(gf)));
    __syncthreads();
    if (hf == 0) { qs[j] = qk[(size_t)t * 1024 + h * 128 + j]; ks[j] = qk[(size_t)t * 1024 + 512 + h * 128 + j] * 0.08838834764831845f; }
    float v = zr[1024 + h * 128 + j];
    __syncthreads();
    float mn = fmaxf(lf + m, li), ip = expf(li - mn), fp = expf(lf + m - mn); m = mn;
    float num = 0.f;
#pragma unroll
    for (int d = 0; d < 64; ++d) { C[d] = fp * C[d] + ip * ks[hf * 64 + d] * v; num += qs[hf * 64 + d] * C[d]; }
    float dp = 0.f; if (hf == 0) { n = fp * n + ip * ks[j]; dp = qs[j] * n; } else nump[j] = num;
    dp = wave_sum(dp); if ((threadIdx.x & 63) == 0) red[threadIdx.x >> 6] = dp; __syncthreads();
    if (hf == 0) { float den = red[0] + red[1]; num += nump[j]; hs[((size_t)dir * S + t) * 512 + h * 128 + j] = num / fmaxf(fabsf(den), expf(-mn)); }
  }
}
__global__ void k_hm(const float* __restrict__ hs, const float* __restrict__ z, const float* __restrict__ g, float* __restrict__ cat) {
  int w = (blockIdx.x * blockDim.x + threadIdx.x) >> 6, lane = threadIdx.x & 63; if (w >= S * 4) return; int t = w >> 2, h = w & 3;
  float a0 = hs[(size_t)t * 512 + h * 128 + lane] + hs[((size_t)S + t) * 512 + h * 128 + lane], a1 = hs[(size_t)t * 512 + h * 128 + 64 + lane] + hs[((size_t)S + t) * 512 + h * 128 + 64 + lane];
  float r = rsqrtf(wave_sum(a0 * a0 + a1 * a1) / 128.f + EPS);
  cat[(size_t)t * 1024 + h * 128 + lane] = a0 * r * g[h * 128 + lane] * sigmf(z[(size_t)t * EVEN_IN + 1536 + h * 128 + lane]);
  cat[(size_t)t * 1024 + h * 128 + 64 + lane] = a1 * r * g[h * 128 + 64 + lane] * sigmf(z[(size_t)t * EVEN_IN + 1536 + h * 128 + 64 + lane]);
}
__global__ void k_pooly(const float* __restrict__ z, float* __restrict__ y) {
  int i = blockIdx.x * blockDim.x + threadIdx.x; if (i >= S * 512) return; int c = i % 512, t = i / 512, gi = c >> 7, win = 2 << gi;
  int lo = max(t - win / 2, 0), hi = min(t + win / 2, S); float s = 0.f; for (int tt = lo; tt < hi; ++tt) s += z[(size_t)tt * EVEN_IN + 2048 + c];
  y[i] = s / (float)(hi - lo) - z[(size_t)t * EVEN_IN + 2048 + c];
}
__global__ void k_scale_cols(float* __restrict__ cat, const float* __restrict__ sc) { int i = blockIdx.x * blockDim.x + threadIdx.x; if (i >= S * 512) return; int c = i % 512, t = i / 512; cat[(size_t)t * 1024 + 512 + c] *= sc[c]; }
__global__ void k_resid(const float* __restrict__ xi, const float* __restrict__ y, const float* __restrict__ gate, float* __restrict__ xo, int b, int n) {
  int i = blockIdx.x * blockDim.x + threadIdx.x; if (i >= n) return; int d = i % D; xo[i] = xi[i] + gate[b * 6144 + d] * y[i];
}
__global__ void k_peer_sel(const float* __restrict__ qp, const float* __restrict__ keys, int* __restrict__ idx, float* __restrict__ gate, int ntok) {
  int w = (blockIdx.x * blockDim.x + threadIdx.x) >> 6, lane = threadIdx.x & 63; if (w >= ntok * 8) return; int t = w >> 3, h = w & 7;
  __shared__ float qsh[4][128]; float* qs = qsh[threadIdx.x >> 6];
  float ts[2][16]; int ti[2][16];
  _Pragma("unroll") for (int p = 0; p < 2; ++p) {
    const float* q = qp + (size_t)t * 2048 + h * 256 + p * 128; float q0 = q[lane], q1 = q[lane + 64];
    float r = rsqrtf(wave_sum(q0 * q0 + q1 * q1) / 128.f + EPS); qs[lane] = q0 * r; qs[lane + 64] = q1 * r;
    __builtin_amdgcn_wave_barrier();
    float s0 = 0.f, s1 = 0.f; const float* k0 = keys + ((size_t)p * 128 + lane) * 128; const float* k1 = k0 + 64 * 128;
    for (int c = 0; c < 128; ++c) { s0 += qs[c] * k0[c]; s1 += qs[c] * k1[c]; }
    __builtin_amdgcn_wave_barrier();
    _Pragma("unroll") for (int k = 0; k < 16; ++k) { float mx = wave_max(fmaxf(s0, s1)); int cand = (s0 == mx) ? lane : ((s1 == mx) ? lane + 64 : 9999);
      for (int o = 32; o >= 1; o >>= 1) cand = min(cand, __shfl_xor(cand, o));
      ts[p][k] = mx; ti[p][k] = cand; if (cand == lane) s0 = -INFINITY; if (cand == lane + 64) s1 = -INFINITY; }
  }
  float cs[4]; _Pragma("unroll") for (int r = 0; r < 4; ++r) { int c = lane * 4 + r; float va = 0.f, vb = 0.f; _Pragma("unroll") for (int k = 0; k < 16; ++k) { if (k == (c >> 4)) va = ts[0][k]; if (k == (c & 15)) vb = ts[1][k]; } cs[r] = va + vb; }
  float top[16]; int tix[16];
  _Pragma("unroll") for (int k = 0; k < 16; ++k) { float mx = wave_max(fmaxf(fmaxf(cs[0], cs[1]), fmaxf(cs[2], cs[3]))); int cand = 9999;
    _Pragma("unroll") for (int r = 3; r >= 0; --r) if (cs[r] == mx) cand = lane * 4 + r;
    for (int o = 32; o >= 1; o >>= 1) cand = min(cand, __shfl_xor(cand, o));
    top[k] = mx; tix[k] = cand; _Pragma("unroll") for (int r = 0; r < 4; ++r) if (cand == lane * 4 + r) cs[r] = -INFINITY; }
  float sum = 0.f; _Pragma("unroll") for (int k = 0; k < 16; ++k) sum += expf(top[k] - top[0]);
  if (lane < 16) { float tv = 0.f; int tc = 0; _Pragma("unroll") for (int k = 0; k < 16; ++k) if (k == lane) { tv = top[k]; tc = tix[k]; }
    int ia = 0, ib = 0; _Pragma("unroll") for (int k = 0; k < 16; ++k) { if (k == (tc >> 4)) ia = ti[0][k]; if (k == (tc & 15)) ib = ti[1][k]; }
    idx[((size_t)t * 8 + h) * 16 + lane] = ia * 128 + ib; gate[((size_t)t * 8 + h) * 16 + lane] = expf(tv - top[0]) / sum; }
}
__global__ void k_peer_gather(const float* __restrict__ hf, const int* __restrict__ idx, const float* __restrict__ gate, const float* __restrict__ u, const float* __restrict__ v,
                              const float* __restrict__ g2, float* __restrict__ x, int t0) {
  int tl = blockIdx.x, t = t0 + tl, b = t / S, tid = threadIdx.x; __shared__ float red[4]; float hv[4], acc[4] = {};
  for (int i = 0; i < 4; ++i) hv[i] = hf[(size_t)t * D + tid + i * 256];
  for (int k = 0; k < 128; ++k) { int e = idx[(size_t)tl * 128 + k]; float gt = gate[(size_t)tl * 128 + k]; const float* ur = u + (size_t)e * D; const float* vr = v + (size_t)e * D;
    float dp = 0.f; for (int i = 0; i < 4; ++i) dp += ur[tid + i * 256] * hv[i]; dp = wave_sum(dp);
    __syncthreads(); if ((tid & 63) == 0) red[tid >> 6] = dp; __syncthreads(); dp = red[0] + red[1] + red[2] + red[3];
    float cf = gt * 0.5f * dp * (1.f + erff(dp * 0.70710678118654752f));
    for (int i = 0; i < 4; ++i) acc[i] += cf * vr[tid + i * 256]; }
  for (int i = 0; i < 4; ++i) { int d = tid + i * 256; x[(size_t)t * D + d] += g2[b * 6144 + d] * acc[i]; }
}
__global__ void k_qknorm_rope(float* __restrict__ zq, const float* __restrict__ qg, const float* __restrict__ kg) {
  int w = (blockIdx.x * blockDim.x + threadIdx.x) >> 6, lane = threadIdx.x & 63; if (w >= S * 10) return; int t = w / 10, hh = w % 10;
  float* p = zq + (size_t)t * 1536 + hh * 128; const float* g = hh < 8 ? qg : kg;
  float x0 = p[2 * lane], x1 = p[2 * lane + 1]; float r = rsqrtf(wave_sum(x0 * x0 + x1 * x1) / 128.f + EPS); x0 *= r * g[2 * lane]; x1 *= r * g[2 * lane + 1];
  int pos = lane < 32 ? t / 64 : t % 64; int fi = lane & 31; float fr = powf(10000.f, -(float)(2 * fi) / 64.f); float ang = (float)pos * fr; float cs = cosf(ang), sn = sinf(ang);
  p[2 * lane] = x0 * cs - x1 * sn; p[2 * lane + 1] = x0 * sn + x1 * cs;
}
__global__ void k_attn(const float* __restrict__ zq, float* __restrict__ out) {
  int w = (blockIdx.x * blockDim.x + threadIdx.x) >> 6, lane = threadIdx.x & 63; if (w >= S * 2) return; int t = w >> 1, kv = w & 1;
  float q0[4], q1[4], m[4], l[4], o0[4], o1[4];
#pragma unroll
  for (int g = 0; g < 4; ++g) { q0[g] = zq[(size_t)t * 1536 + (kv * 4 + g) * 128 + lane]; q1[g] = zq[(size_t)t * 1536 + (kv * 4 + g) * 128 + 64 + lane]; m[g] = -1e30f; l[g] = 0.f; o0[g] = 0.f; o1[g] = 0.f; }
  for (int s = 0; s < S; ++s) { const float* kr = zq + (size_t)s * 1536 + 1024 + kv * 128; const float* vr = zq + (size_t)s * 1536 + 1280 + kv * 128;
    float k0 = kr[lane], k1 = kr[64 + lane], v0 = vr[lane], v1 = vr[64 + lane];
#pragma unroll
    for (int g = 0; g < 4; ++g) { float sc = wave_sum(q0[g] * k0 + q1[g] * k1) * 0.08838834764831845f;
      float mn = fmaxf(m[g], sc), al = expf(m[g] - mn), pw = expf(sc - mn); l[g] = l[g] * al + pw; o0[g] = o0[g] * al + pw * v0; o1[g] = o1[g] * al + pw * v1; m[g] = mn; } }
#pragma unroll
  for (int g = 0; g < 4; ++g) { out[(size_t)t * 1024 + (kv * 4 + g) * 128 + lane] = o0[g] / l[g]; out[(size_t)t * 1024 + (kv * 4 + g) * 128 + 64 + lane] = o1[g] / l[g]; }
}
}

extern "C" void kernel_launch(void* const* d_in, const int* in_sizes, int n_in, void* d_out, int out_size, void* d_ws, size_t ws_size, hipStream_t stream) {
  const float* x = (const float*)d_in[0]; const float* c = (const float*)d_in[1]; const float* ada_w = (const float*)d_in[2]; const float* ada_b = (const float*)d_in[3];
  const float* nmg = (const float*)d_in[4]; const float* nfg = (const float*)d_in[5]; const float* ev_w_in = (const float*)d_in[6]; const float* ev_b_in = (const float*)d_in[7];
  const float* conv_w = (const float*)d_in[8]; const float* conv_b = (const float*)d_in[9]; const float* mnorm_g = (const float*)d_in[10]; const float* pool_w = (const float*)d_in[11];
  const float* pool_sc = (const float*)d_in[12]; const float* ev_w_out = (const float*)d_in[13]; const float* od_w_in = (const float*)d_in[14]; const float* qn_g = (const float*)d_in[15];
  const float* kn_g = (const float*)d_in[16]; const float* od_w_out = (const float*)d_in[17]; const float* peer_wq = (const float*)d_in[18]; const float* peer_keys = (const float*)d_in[19];
  const float* peer_u = (const float*)d_in[20]; const float* peer_v = (const float*)d_in[21]; const float* final_g = (const float*)d_in[22];
  float* out = (float*)d_out; char* ws = (char*)d_ws; size_t off = 0;
  auto alloc = [&](size_t bytes) { char* p = ws + off; off += (bytes + 255) / 256 * 256; return p; };
  float* X = (float*)alloc((size_t)T * D * 4);
  float* H = (float*)alloc((size_t)T * D * 4);
  float* mod = (float*)alloc(2 * NB * 6144 * 4);
  float* zb = (float*)alloc((size_t)S * EVEN_IN * 4);
  float* qkb = (float*)alloc((size_t)S * 1024 * 4);
  float* hsb = (float*)alloc((size_t)2 * S * 512 * 4);
  float* catb = (float*)alloc((size_t)S * 1024 * 4);
  float* yb = (float*)alloc((size_t)S * 1024 * 4);
  int* idxb = (int*)alloc((size_t)S * 128 * 4);
  float* gateb = (float*)alloc((size_t)S * 128 * 4);
  float* qpb = (float*)alloc((size_t)S * 2048 * 4);
  (void)ws_size; (void)in_sizes; (void)n_in; (void)out_size;

  k_mod<<<(2 * NB * 6144 + 255) / 256, 256, 0, stream>>>(c, ada_w, ada_b, mod);
  const float* xin = x;
  for (int l = 0; l < 2; ++l) {
    const float* ml = mod + (size_t)l * NB * 6144;
    k_norm<<<T, 256, 0, stream>>>(xin, nmg + l * D, ml + 0, ml + 1024, H);
    for (int b = 0; b < NB; ++b) {
      const float* Hb = H + (size_t)b * S * D; const float* xb = xin + (size_t)b * S * D; float* Xb = X + (size_t)b * S * D;
      if (l == 0) {
        k_gemm<<<dim3((EVEN_IN + 63) / 64, S / 64), 256, 0, stream>>>(Hb, D, ev_w_in, EVEN_IN, ev_b_in, zb, EVEN_IN, S, EVEN_IN, D);
        k_conv<<<S * 1024 / 256, 256, 0, stream>>>(zb, conv_w, conv_b, qkb);
        k_mlstm<<<8, 256, 0, stream>>>(qkb, zb, hsb);
        k_hm<<<S * 4 / 4, 256, 0, stream>>>(hsb, zb, mnorm_g, catb);
        k_pooly<<<S * 512 / 256, 256, 0, stream>>>(zb, yb);
        for (int g = 0; g < 4; ++g) k_gemm<<<dim3(2, S / 64), 256, 0, stream>>>(yb + g * 128, 512, pool_w + g * 128 * 128, 128, nullptr, catb + 512 + g * 128, 1024, S, 128, 128);
        k_scale_cols<<<S * 512 / 256, 256, 0, stream>>>(catb, pool_sc);
        k_gemm<<<dim3(D / 64, S / 64), 256, 0, stream>>>(catb, 1024, ev_w_out, D, nullptr, yb, D, S, D, 1024);
      } else {
        k_gemm<<<dim3(1536 / 64, S / 64), 256, 0, stream>>>(Hb, D, od_w_in, 1536, nullptr, zb, 1536, S, 1536, D);
        k_qknorm_rope<<<S * 10 / 4, 256, 0, stream>>>(zb, qn_g, kn_g);
        k_attn<<<S * 2 / 4, 256, 0, stream>>>(zb, catb);
        k_gemm<<<dim3(D / 64, S / 64), 256, 0, stream>>>(catb, 1024, od_w_out, D, nullptr, yb, D, S, D, 1024);
      }
      k_resid<<<S * D / 256, 256, 0, stream>>>(xb, yb, ml + 2048, Xb, b, S * D);
    }
    xin = X;
    k_norm<<<T, 256, 0, stream>>>(X, nfg + l * D, ml + 3072, ml + 4096, H);
    for (int b = 0; b < NB; ++b) {
      const float* Hb = H + (size_t)b * S * D;
      k_gemm<<<dim3(2048 / 64, S / 64), 256, 0, stream>>>(Hb, D, peer_wq + (size_t)l * D * 2048, 2048, nullptr, qpb, 2048, S, 2048, D);
      k_peer_sel<<<S * 8 / 4, 256, 0, stream>>>(qpb, peer_keys + (size_t)l * 2 * 128 * 128, idxb, gateb, S);
      k_peer_gather<<<S, 256, 0, stream>>>(H, idxb, gateb, peer_u + (size_t)l * 16384 * D, peer_v + (size_t)l * 16384 * D, ml + 5120, X, b * S);
    }
  }
  k_norm<<<T, 256, 0, stream>>>(X, final_g, nullptr, nullptr, out);
}
```

```cpp
#include <hip/hip_runtime.h>
#include <hip/hip_cooperative_groups.h>
#include <math.h>
#include <stdint.h>
#include <stdio.h>
namespace cg = cooperative_groups;

#ifndef MULTI_LAUNCH
#define MULTI_LAUNCH 0
#endif

namespace {
typedef unsigned short bf16_t;
typedef unsigned int u32;
typedef float f32x4 __attribute__((ext_vector_type(4)));
typedef u32 u32x4 __attribute__((ext_vector_type(4)));
typedef u32 u32x2 __attribute__((ext_vector_type(2)));
typedef __bf16 bf16x2_t __attribute__((ext_vector_type(2)));

constexpr int D = 1024, NB = 8, S = 4096, T = NB * S;
constexpr int EVEN_IN = 2576;
constexpr float EPS = 1e-6f;
constexpr int NTHREADS = 512;
constexpr int SMEM_BYTES = 144 * 1024;
constexpr float KSCALE = 0.08838834764831845f;

struct Params {
  const float *x, *c, *ada_w, *ada_b, *nmg, *nfg, *ev_w_in, *ev_b_in, *conv_w, *conv_b, *mnorm_g, *pool_w, *pool_sc, *ev_w_out, *od_w_in, *qn_g, *kn_g, *od_w_out,
      *peer_wq, *peer_keys, *peer_u, *peer_v, *final_g;
  float* X;
  bf16_t *Wt_evin, *Wt_evout, *Wt_odin, *Wt_odout, *Wt_q, *keysb, *U, *V;
  float *Wg, *mod, *gates, *pgate;
  bf16_t *H, *ZQK, *ZV, *ZO, *ZP, *QK, *HS, *CAT, *QP, *QKV, *Qh, *Kh, *Vh;
  bf16_t* pidx;
};

__device__ __forceinline__ float siluf(float x) { return x / (1.f + __expf(-x)); }
__device__ __forceinline__ float sigmf(float x) { return 1.f / (1.f + __expf(-x)); }
__device__ __forceinline__ float wave_sum(float v) { for (int o = 32; o >= 1; o >>= 1) v += __shfl_xor(v, o); return v; }
__device__ __forceinline__ float wave_max(float v) { for (int o = 32; o >= 1; o >>= 1) v = fmaxf(v, __shfl_xor(v, o)); return v; }
__device__ __forceinline__ bf16_t f2bf(float f) { u32 u = __float_as_uint(f); u += 0x7FFFu + ((u >> 16) & 1u); return (bf16_t)(u >> 16); }
__device__ __forceinline__ float bf2f(bf16_t b) { return __uint_as_float(((u32)b) << 16); }
__device__ __forceinline__ u32 pack2(float lo, float hi) { return (u32)f2bf(lo) | ((u32)f2bf(hi) << 16); }
__device__ __forceinline__ float bflo(u32 w) { return __uint_as_float(w << 16); }
__device__ __forceinline__ float bfhi(u32 w) { return __uint_as_float(w & 0xFFFF0000u); }
__device__ __forceinline__ float dot2bf(u32 a, u32 b, float c) { return __builtin_amdgcn_fdot2_f32_bf16(__builtin_bit_cast(bf16x2_t, a), __builtin_bit_cast(bf16x2_t, b), c, false); }

constexpr int PJ_MOD = 192, PJ_TR = 2576, PJ_WG = 1, PJ_KEYS = 16, PJ_UV = 16384;
constexpr int PJ_TOTAL = PJ_MOD + PJ_TR + PJ_WG + PJ_KEYS + PJ_UV;

__device__ void prep_transpose_tile(const float* __restrict__ src, int ld, int k0, int n0, bf16_t* __restrict__ dst, int dstK, char* smem) {
  float* tile = (float*)smem;
  const int tid = threadIdx.x;
  __syncthreads();
  for (int pass = 0; pass < 8; ++pass) { int kk = pass * 8 + (tid >> 6), n = tid & 63; tile[kk * 65 + n] = src[(size_t)(k0 + kk) * ld + n0 + n]; }
  __syncthreads();
  int n = tid >> 3, kc = (tid & 7) * 8; u32x4 w;
  w.x = pack2(tile[(kc + 0) * 65 + n], tile[(kc + 1) * 65 + n]); w.y = pack2(tile[(kc + 2) * 65 + n], tile[(kc + 3) * 65 + n]);
  w.z = pack2(tile[(kc + 4) * 65 + n], tile[(kc + 5) * 65 + n]); w.w = pack2(tile[(kc + 6) * 65 + n], tile[(kc + 7) * 65 + n]);
  *(u32x4*)(dst + (size_t)(n0 + n) * dstK + k0 + kc) = w;
}

__device__ void phase_prep(const Params& p, char* smem) {
  const int tid = threadIdx.x;
  for (int job = blockIdx.x; job < PJ_TOTAL; job += gridDim.x) {
    if (job < PJ_MOD) {
      float* cs = (float*)smem; float* red = cs + 8192;
      __syncthreads();
      for (int i = tid; i < 8192; i += NTHREADS) cs[i] = siluf(p.c[i]);
      __syncthreads();
      const int l = job / 96, e0 = (job % 96) * 64, col = tid & 63, dg = tid >> 6;
      float acc[8];
#pragma unroll
      for (int b = 0; b < 8; ++b) acc[b] = 0.f;
      const float* w = p.ada_w + (size_t)l * D * 6144 + e0 + col;
      for (int d = dg * 128; d < dg * 128 + 128; ++d) { float wv = w[(size_t)d * 6144];
#pragma unroll
        for (int b = 0; b < 8; ++b) acc[b] += cs[b * 1024 + d] * wv; }
#pragma unroll
      for (int b = 0; b < 8; ++b) red[(dg * 8 + b) * 64 + col] = acc[b];
      __syncthreads();
      { const int b = tid >> 6; float s = 0.f;
#pragma unroll
        for (int g = 0; g < 8; ++g) s += red[(g * 8 + b) * 64 + col];
        p.mod[(size_t)(l * 8 + b) * 6144 + e0 + col] = s + p.ada_b[l * 6144 + e0 + col]; }
    } else if (job < PJ_MOD + PJ_TR) {
      int tt = job - PJ_MOD;
      if (tt < 640) prep_transpose_tile(p.ev_w_in, EVEN_IN, (tt / 40) * 64, (tt % 40) * 64, p.Wt_evin, 1024, smem);
      else if (tt < 896) { tt -= 640; prep_transpose_tile(p.ev_w_out, 1024, (tt / 16) * 64, (tt % 16) * 64, p.Wt_evout, 1024, smem); }
      else if (tt < 1280) { tt -= 896; prep_transpose_tile(p.od_w_in, 1536, (tt / 24) * 64, (tt % 24) * 64, p.Wt_odin, 1024, smem); }
      else if (tt < 1536) { tt -= 1280; prep_transpose_tile(p.od_w_out, 1024, (tt / 16) * 64, (tt % 16) * 64, p.Wt_odout, 1024, smem); }
      else if (tt < 2560) { tt -= 1536; int l = tt / 512; tt %= 512; prep_transpose_tile(p.peer_wq + (size_t)l * D * 2048, 2048, (tt / 32) * 64, (tt % 32) * 64, p.Wt_q + (size_t)l * 2048 * 1024, 1024, smem); }
      else {   }
    } else if (job < PJ_MOD + PJ_TR + PJ_WG) {
      for (int i = tid; i < 16 * 1024; i += NTHREADS) { int g = i >> 10, d = i & 1023; p.Wg[i] = p.ev_w_in[(size_t)d * EVEN_IN + 2560 + g]; }
    } else if (job < PJ_MOD + PJ_TR + PJ_WG + PJ_KEYS) {
      int j = job - (PJ_MOD + PJ_TR + PJ_WG);
      for (int i = tid; i < 4096; i += NTHREADS) p.keysb[j * 4096 + i] = f2bf(p.peer_keys[j * 4096 + i]);
    } else {
      int j = job - (PJ_MOD + PJ_TR + PJ_WG + PJ_KEYS); const float* src = j < 8192 ? p.peer_u : p.peer_v; bf16_t* dst = j < 8192 ? p.U : p.V; j &= 8191;
      size_t o = (size_t)j * 4096 + tid * 8; f32x4 a = *(const f32x4*)(src + o), b = *(const f32x4*)(src + o + 4);
      u32x4 w; w.x = pack2(a.x, a.y); w.y = pack2(a.z, a.w); w.z = pack2(b.x, b.y); w.w = pack2(b.z, b.w); *(u32x4*)(dst + o) = w;
    }
  }
}

template <bool WITH_GATES>
__device__ void phase_norm(const Params& p, const float* __restrict__ xin, const float* __restrict__ g, const float* __restrict__ modl, int sh_off, int sc_off, char* smem) {
  const int tid = threadIdx.x, wid = tid >> 6, lane = tid & 63;
  float* wg = (float*)smem;
  if (WITH_GATES) { __syncthreads(); for (int i = tid; i < 16 * 1024; i += NTHREADS) wg[i] = p.Wg[i]; __syncthreads(); }
  for (int job = blockIdx.x; job < T / 8; job += gridDim.x) {
    const int t = job * 8 + wid, b = t / S;
    f32x4 v[4]; float ss = 0.f;
#pragma unroll
    for (int i = 0; i < 4; ++i) { v[i] = *(const f32x4*)(xin + (size_t)t * D + i * 256 + lane * 4); ss += v[i].x * v[i].x + v[i].y * v[i].y + v[i].z * v[i].z + v[i].w * v[i].w; }
    ss = wave_sum(ss); const float r = rsqrtf(ss * (1.f / D) + EPS);
    const float* shp = modl + (size_t)b * 6144 + sh_off; const float* scp = modl + (size_t)b * 6144 + sc_off;
#pragma unroll
    for (int i = 0; i < 4; ++i) { const int d = i * 256 + lane * 4; f32x4 gg = *(const f32x4*)(g + d), s1 = *(const f32x4*)(scp + d), s0 = *(const f32x4*)(shp + d);
      v[i].x = v[i].x * r * gg.x * (1.f + s1.x) + s0.x; v[i].y = v[i].y * r * gg.y * (1.f + s1.y) + s0.y; v[i].z = v[i].z * r * gg.z * (1.f + s1.z) + s0.z; v[i].w = v[i].w * r * gg.w * (1.f + s1.w) + s0.w;
      u32x2 w; w.x = pack2(v[i].x, v[i].y); w.y = pack2(v[i].z, v[i].w); *(u32x2*)(p.H + (size_t)t * D + d) = w; }
    if (WITH_GATES) {
      float myg = 0.f;
#pragma unroll 2
      for (int gi = 0; gi < 16; ++gi) { float a = 0.f;
#pragma unroll
        for (int i = 0; i < 4; ++i) { f32x4 w4 = *(const f32x4*)(wg + gi * 1024 + i * 256 + lane * 4); a += v[i].x * w4.x + v[i].y * w4.y + v[i].z * w4.z + v[i].w * w4.w; }
        a = wave_sum(a); if (lane == gi) myg = a; }
      if (lane < 16) p.gates[(size_t)t * 16 + lane] = myg + p.ev_b_in[2560 + lane];
    }
  }
}

enum { EPI_EVIN = 0, EPI_EVOUT = 1, EPI_PEERQ = 2, EPI_ODIN = 3, EPI_ODOUT = 4 };
template <int EPI> __device__ __forceinline__ void epi_store(const Params& p, int layer, int m, int n, float acc) {
  if (EPI == EPI_EVIN) { float v = acc + p.ev_b_in[n];
    if (n < 1024) p.ZQK[(size_t)m * 1024 + n] = f2bf(v); else if (n < 1536) p.ZV[(size_t)m * 512 + n - 1024] = f2bf(v);
    else if (n < 2048) p.ZO[(size_t)m * 512 + n - 1536] = f2bf(sigmf(v)); else p.ZP[(size_t)m * 512 + n - 2048] = f2bf(v); }
  else if (EPI == EPI_EVOUT) { int b = m / S; p.X[(size_t)m * D + n] = p.x[(size_t)m * D + n] + p.mod[(size_t)(0 * 8 + b) * 6144 + 2048 + n] * acc; }
  else if (EPI == EPI_PEERQ) p.QP[(size_t)m * 2048 + n] = f2bf(acc);
  else if (EPI == EPI_ODIN) p.QKV[(size_t)m * 1536 + n] = f2bf(acc);
  else if (EPI == EPI_ODOUT) { int b = m / S; p.X[(size_t)m * D + n] += p.mod[(size_t)(1 * 8 + b) * 6144 + 2048 + n] * acc; }
}
template <int EPI> __device__ void phase_gemm_naive(const Params& p, int layer, const bf16_t* __restrict__ A, const bf16_t* __restrict__ Bt, int M, int N, int K, char* smem) {
  float* As = (float*)smem; float* Bs = As + 32 * 132;
  const int tid = threadIdx.x, tx = tid & 15, ty = tid >> 4; const int nN = N / 64, njobs = (M / 128) * nN;
  for (int job = blockIdx.x; job < njobs; job += gridDim.x) {
    const int m0 = (job / nN) * 128, n0 = (job % nN) * 64; float acc[4][4];
#pragma unroll
    for (int i = 0; i < 4; ++i)
#pragma unroll
      for (int j = 0; j < 4; ++j) acc[i][j] = 0.f;
    for (int k0 = 0; k0 < K; k0 += 32) {
      __syncthreads();
      { int row = tid >> 2, kc = (tid & 3) * 8; u32x4 w = *(const u32x4*)(A + (size_t)(m0 + row) * K + k0 + kc);
        As[(kc + 0) * 132 + row] = bflo(w.x); As[(kc + 1) * 132 + row] = bfhi(w.x); As[(kc + 2) * 132 + row] = bflo(w.y); As[(kc + 3) * 132 + row] = bfhi(w.y);
        As[(kc + 4) * 132 + row] = bflo(w.z); As[(kc + 5) * 132 + row] = bfhi(w.z); As[(kc + 6) * 132 + row] = bflo(w.w); As[(kc + 7) * 132 + row] = bfhi(w.w); }
      if (tid < 256) { int row = tid >> 2, kc = (tid & 3) * 8; u32x4 w = *(const u32x4*)(Bt + (size_t)(n0 + row) * K + k0 + kc);
        Bs[(kc + 0) * 68 + row] = bflo(w.x); Bs[(kc + 1) * 68 + row] = bfhi(w.x); Bs[(kc + 2) * 68 + row] = bflo(w.y); Bs[(kc + 3) * 68 + row] = bfhi(w.y);
        Bs[(kc + 4) * 68 + row] = bflo(w.z); Bs[(kc + 5) * 68 + row] = bfhi(w.z); Bs[(kc + 6) * 68 + row] = bflo(w.w); Bs[(kc + 7) * 68 + row] = bfhi(w.w); }
      __syncthreads();
#pragma unroll 8
      for (int kk = 0; kk < 32; ++kk) { f32x4 a = *(const f32x4*)(As + kk * 132 + ty * 4), b = *(const f32x4*)(Bs + kk * 68 + tx * 4);
        acc[0][0] += a.x * b.x; acc[0][1] += a.x * b.y; acc[0][2] += a.x * b.z; acc[0][3] += a.x * b.w;
        acc[1][0] += a.y * b.x; acc[1][1] += a.y * b.y; acc[1][2] += a.y * b.z; acc[1][3] += a.y * b.w;
        acc[2][0] += a.z * b.x; acc[2][1] += a.z * b.y; acc[2][2] += a.z * b.z; acc[2][3] += a.z * b.w;
        acc[3][0] += a.w * b.x; acc[3][1] += a.w * b.y; acc[3][2] += a.w * b.z; acc[3][3] += a.w * b.w; }
    }
#pragma unroll
    for (int i = 0; i < 4; ++i)
#pragma unroll
      for (int j = 0; j < 4; ++j) epi_store<EPI>(p, layer, m0 + ty * 4 + i, n0 + tx * 4 + j, acc[i][j]);
  }
}

__device__ void phase_convpool(const Params& p, char* smem) {
  const int tid = threadIdx.x;
  for (int job = blockIdx.x; job < T * 128 / NTHREADS; job += gridDim.x) {
    const int it = job * NTHREADS + tid, t = it >> 7, c0 = (it & 127) * 8, s = t & (S - 1);
    float a[8];
#pragma unroll
    for (int i = 0; i < 8; ++i) a[i] = p.conv_b[c0 + i];
#pragma unroll
    for (int j = 0; j < 5; ++j) { const int ss = s + j - 2; if (ss >= 0 && ss < S) { u32x4 w = *(const u32x4*)(p.ZQK + (size_t)(t + j - 2) * 1024 + c0); const float* cw = p.conv_w + j * 1024 + c0;
        a[0] += cw[0] * bflo(w.x); a[1] += cw[1] * bfhi(w.x); a[2] += cw[2] * bflo(w.y); a[3] += cw[3] * bfhi(w.y); a[4] += cw[4] * bflo(w.z); a[5] += cw[5] * bfhi(w.z); a[6] += cw[6] * bflo(w.w); a[7] += cw[7] * bfhi(w.w); } }
    const float sc = c0 >= 512 ? KSCALE : 1.f;
#pragma unroll
    for (int i = 0; i < 8; ++i) a[i] = siluf(a[i]) * sc;
    u32x4 o; o.x = pack2(a[0], a[1]); o.y = pack2(a[2], a[3]); o.z = pack2(a[4], a[5]); o.w = pack2(a[6], a[7]); *(u32x4*)(p.QK + (size_t)t * 1024 + c0) = o;
  }
  float* ys = (float*)smem;
  float* ws = ys + 64 * 128;
  for (int job = blockIdx.x; job < (T / 64) * 4; job += gridDim.x) {
    const int g = job & 3, t0 = (job >> 2) * 64, win = 2 << g;
    __syncthreads();
    for (int i = tid; i < 128 * 128; i += NTHREADS) ws[i] = p.pool_w[(size_t)g * 16384 + i];
    for (int i = tid; i < 64 * 128; i += NTHREADS) { const int tl = i >> 7, c = i & 127, t = t0 + tl, s = t & (S - 1); const int lo = max(s - win / 2, 0), hi = min(s + win / 2, S);
      float sum = 0.f; for (int q = lo; q < hi; ++q) sum += bf2f(p.ZP[(size_t)(t - s + q) * 512 + g * 128 + c]);
      ys[i] = sum / (float)(hi - lo) - bf2f(p.ZP[(size_t)t * 512 + g * 128 + c]); }
    __syncthreads();
    const int e = tid & 127, tq = tid >> 7; float acc[16];
#pragma unroll
    for (int i = 0; i < 16; ++i) acc[i] = 0.f;
    for (int c = 0; c < 128; ++c) { const float w = ws[c * 128 + e];
#pragma unroll
      for (int i = 0; i < 16; ++i) acc[i] += ys[(tq * 16 + i) * 128 + c] * w; }
    const float psc = p.pool_sc[g * 128 + e];
#pragma unroll
    for (int i = 0; i < 16; ++i) p.CAT[(size_t)(t0 + tq * 16 + i) * 1024 + 512 + g * 128 + e] = f2bf(acc[i] * psc);
  }
}

__device__ void phase_mlstm_naive(const Params& p, char* smem) {
  float* qs = (float*)smem; float* ks = qs + 128; float* nump = ks + 128; float* red = nump + 512;
  const int tid = threadIdx.x, j = tid & 127, qd = tid >> 7;
  for (int job = blockIdx.x; job < 64; job += gridDim.x) {
    const int dir = job >> 5, b = (job >> 2) & 7, h = job & 3;
    float C[32];
#pragma unroll
    for (int d = 0; d < 32; ++d) C[d] = 0.f;
    float n = 0.f, m = 0.f;
    for (int step = 0; step < S; ++step) { const int s = dir ? S - 1 - step : step; const size_t t = (size_t)b * S + s;
      const float li = p.gates[t * 16 + dir * 4 + h], gf = p.gates[t * 16 + 8 + dir * 4 + h];
      const float lf = fminf(gf, 0.f) - log1pf(__expf(-fabsf(gf)));
      __syncthreads();
      if (qd == 0) { qs[j] = bf2f(p.QK[t * 1024 + h * 128 + j]); ks[j] = bf2f(p.QK[t * 1024 + 512 + h * 128 + j]); }
      const float v = bf2f(p.ZV[t * 512 + h * 128 + j]);
      __syncthreads();
      const float mn = fmaxf(lf + m, li), ip = __expf(li - mn), fp = __expf(lf + m - mn); m = mn;
      float num = 0.f;
#pragma unroll
      for (int d = 0; d < 32; ++d) { C[d] = fp * C[d] + ip * ks[qd * 32 + d] * v; num += qs[qd * 32 + d] * C[d]; }
      float dp = 0.f; if (qd == 0) { n = fp * n + ip * ks[j]; dp = qs[j] * n; }
      nump[qd * 128 + j] = num;
      dp = wave_sum(dp); if ((tid & 63) == 0) red[tid >> 6] = dp;
      __syncthreads();
      if (qd == 0) { const float den = red[0] + red[1]; num = nump[j] + nump[128 + j] + nump[256 + j] + nump[384 + j];
        p.HS[((size_t)dir * T + t) * 512 + h * 128 + j] = f2bf(num / fmaxf(fabsf(den), __expf(-mn))); }
    }
    __syncthreads();
  }
}

__device__ void phase_cat(const Params& p) {
  const int tid = threadIdx.x, wid = tid >> 6, lane = tid & 63;
  for (int job = blockIdx.x; job < T * 4 / 8; job += gridDim.x) {
    const int w = job * 8 + wid, t = w >> 2, h = w & 3; const size_t o = (size_t)t * 512 + h * 128 + lane * 2;
    const u32 a = *(const u32*)(p.HS + o), b = *(const u32*)(p.HS + (size_t)T * 512 + o), so = *(const u32*)(p.ZO + o);
    const float a0 = bflo(a) + bflo(b), a1 = bfhi(a) + bfhi(b); const float r = rsqrtf(wave_sum(a0 * a0 + a1 * a1) * (1.f / 128.f) + EPS);
    *(u32*)(p.CAT + (size_t)t * 1024 + h * 128 + lane * 2) = pack2(a0 * r * p.mnorm_g[h * 128 + lane * 2] * bflo(so), a1 * r * p.mnorm_g[h * 128 + lane * 2 + 1] * bfhi(so));
  }
}

__device__ void phase_peer_select_naive(const Params& p, int layer, char* smem) {
  float* kl = (float*)smem;
  float* qsh = kl + 2 * 128 * 129;
  const int tid = threadIdx.x, wid = tid >> 6, lane = tid & 63; float* qs = qsh + wid * 128;
  __syncthreads();
  for (int i = tid; i < 2 * 128 * 128; i += NTHREADS) kl[(i >> 7) * 129 + (i & 127)] = p.peer_keys[(size_t)layer * 32768 + i];
  __syncthreads();
  for (int job = blockIdx.x; job < T; job += gridDim.x) {
    const int t = job, h = wid;
    float ts[2][16]; int ti[2][16];
#pragma unroll
    for (int pp = 0; pp < 2; ++pp) {
      const bf16_t* q = p.QP + (size_t)t * 2048 + h * 256 + pp * 128; const float q0 = bf2f(q[lane]), q1 = bf2f(q[lane + 64]);
      const float r = rsqrtf(wave_sum(q0 * q0 + q1 * q1) * (1.f / 128.f) + EPS); qs[lane] = q0 * r; qs[lane + 64] = q1 * r;
      float s0 = 0.f, s1 = 0.f; const float* k0 = kl + (pp * 128 + lane) * 129; const float* k1 = k0 + 64 * 129;
      for (int c = 0; c < 128; ++c) { const float qc = qs[c]; s0 += qc * k0[c]; s1 += qc * k1[c]; }
#pragma unroll
      for (int k = 0; k < 16; ++k) { const float mx = wave_max(fmaxf(s0, s1)); int cand = (s0 == mx) ? lane : ((s1 == mx) ? lane + 64 : 9999);
        for (int o = 32; o >= 1; o >>= 1) cand = min(cand, __shfl_xor(cand, o));
        ts[pp][k] = mx; ti[pp][k] = cand; if (cand == lane) s0 = -INFINITY; if (cand == lane + 64) s1 = -INFINITY; }
    }
    float cs[4];
#pragma unroll
    for (int r = 0; r < 4; ++r) { const int c = lane * 4 + r; float va = 0.f, vb = 0.f;
#pragma unroll
      for (int k = 0; k < 16; ++k) { if (k == (c >> 4)) va = ts[0][k]; if (k == (c & 15)) vb = ts[1][k]; }
      cs[r] = va + vb; }
    float top[16]; int tix[16];
#pragma unroll
    for (int k = 0; k < 16; ++k) { const float mx = wave_max(fmaxf(fmaxf(cs[0], cs[1]), fmaxf(cs[2], cs[3]))); int cand = 9999;
#pragma unroll
      for (int r = 3; r >= 0; --r) if (cs[r] == mx) cand = lane * 4 + r;
      for (int o = 32; o >= 1; o >>= 1) cand = min(cand, __shfl_xor(cand, o));
      top[k] = mx; tix[k] = cand;
#pragma unroll
      for (int r = 0; r < 4; ++r) if (cand == lane * 4 + r) cs[r] = -INFINITY; }
    float sum = 0.f;
#pragma unroll
    for (int k = 0; k < 16; ++k) sum += __expf(top[k] - top[0]);
    if (lane < 16) { float tv = 0.f; int tc = 0;
#pragma unroll
      for (int k = 0; k < 16; ++k) if (k == lane) { tv = top[k]; tc = tix[k]; }
      int ia = 0, ib = 0;
#pragma unroll
      for (int k = 0; k < 16; ++k) { if (k == (tc >> 4)) ia = ti[0][k]; if (k == (tc & 15)) ib = ti[1][k]; }
      p.pidx[((size_t)t * 8 + h) * 16 + lane] = (bf16_t)(ia * 128 + ib); p.pgate[((size_t)t * 8 + h) * 16 + lane] = __expf(tv - top[0]) / sum; }
  }
}

template <int NEXT>
__device__ void phase_peer_gather(const Params& p, int layer) {
  const int tid = threadIdx.x, wid = tid >> 6, lane = tid & 63;
  const bf16_t* U = p.U + (size_t)layer * 16384 * 1024; const bf16_t* V = p.V + (size_t)layer * 16384 * 1024;
  for (int job = blockIdx.x; job < T / 8; job += gridDim.x) {
    const int t = job * 8 + wid, b = t / S;
    u32x4 h0 = *(const u32x4*)(p.H + (size_t)t * D + lane * 8), h1 = *(const u32x4*)(p.H + (size_t)t * D + 512 + lane * 8);
    float acc[16];
#pragma unroll
    for (int i = 0; i < 16; ++i) acc[i] = 0.f;
    for (int hh = 0; hh < 8; ++hh) {
      int myidx = 0; float mygate = 0.f;
      if (lane < 16) { myidx = p.pidx[((size_t)t * 8 + hh) * 16 + lane]; mygate = p.pgate[((size_t)t * 8 + hh) * 16 + lane]; }
#pragma unroll 1
      for (int half = 0; half < 4; ++half) {
        u32x4 ua[4], ub[4], va[4], vb[4];
#pragma unroll
        for (int k = 0; k < 4; ++k) { const int e = __builtin_amdgcn_readlane(myidx, half * 4 + k); const bf16_t* ur = U + (size_t)e * 1024 + lane * 8; const bf16_t* vr = V + (size_t)e * 1024 + lane * 8;
          ua[k] = *(const u32x4*)ur; ub[k] = *(const u32x4*)(ur + 512); va[k] = *(const u32x4*)vr; vb[k] = *(const u32x4*)(vr + 512); }
        float dp[4];
#pragma unroll
        for (int k = 0; k < 4; ++k) { float a = 0.f;
          a = dot2bf(ua[k].x, h0.x, a);
          a = dot2bf(ua[k].y, h0.y, a);
          a = dot2bf(ua[k].z, h0.z, a);
          a = dot2bf(ua[k].w, h0.w, a);
          a = dot2bf(ub[k].x, h1.x, a);
          a = dot2bf(ub[k].y, h1.y, a);
          a = dot2bf(ub[k].z, h1.z, a);
          a = dot2bf(ub[k].w, h1.w, a);
          dp[k] = wave_sum(a); }
#pragma unroll
        for (int k = 0; k < 4; ++k) { const float z = dp[k]; const float gt = __uint_as_float(__builtin_amdgcn_readlane(__float_as_uint(mygate), half * 4 + k));
          const float cf = gt * 0.5f * z * (1.f + erff(z * 0.70710678118654752f));
          acc[0] += cf * bflo(va[k].x); acc[1] += cf * bfhi(va[k].x); acc[2] += cf * bflo(va[k].y); acc[3] += cf * bfhi(va[k].y);
          acc[4] += cf * bflo(va[k].z); acc[5] += cf * bfhi(va[k].z); acc[6] += cf * bflo(va[k].w); acc[7] += cf * bfhi(va[k].w);
          acc[8] += cf * bflo(vb[k].x); acc[9] += cf * bfhi(vb[k].x); acc[10] += cf * bflo(vb[k].y); acc[11] += cf * bfhi(vb[k].y);
          acc[12] += cf * bflo(vb[k].z); acc[13] += cf * bfhi(vb[k].z); acc[14] += cf * bflo(vb[k].w); acc[15] += cf * bfhi(vb[k].w); }
      }
    }
    const float* g2 = p.mod + (size_t)(layer * 8 + b) * 6144 + 5120;
    float xv[16]; float ss = 0.f;
#pragma unroll
    for (int hf = 0; hf < 2; ++hf) { const int d = hf * 512 + lane * 8; float* xp = p.X + (size_t)t * D + d;
      f32x4 x0 = *(const f32x4*)xp, x1 = *(const f32x4*)(xp + 4), g0 = *(const f32x4*)(g2 + d), g1 = *(const f32x4*)(g2 + d + 4);
      xv[hf * 8 + 0] = x0.x + g0.x * acc[hf * 8 + 0]; xv[hf * 8 + 1] = x0.y + g0.y * acc[hf * 8 + 1]; xv[hf * 8 + 2] = x0.z + g0.z * acc[hf * 8 + 2]; xv[hf * 8 + 3] = x0.w + g0.w * acc[hf * 8 + 3];
      xv[hf * 8 + 4] = x1.x + g1.x * acc[hf * 8 + 4]; xv[hf * 8 + 5] = x1.y + g1.y * acc[hf * 8 + 5]; xv[hf * 8 + 6] = x1.z + g1.z * acc[hf * 8 + 6]; xv[hf * 8 + 7] = x1.w + g1.w * acc[hf * 8 + 7]; }
#pragma unroll
    for (int i = 0; i < 16; ++i) ss += xv[i] * xv[i];
    ss = wave_sum(ss); const float r = rsqrtf(ss * (1.f / D) + EPS);
    if (NEXT == 0) {
      const float* ml = p.mod + (size_t)((layer + 1) * 8 + b) * 6144; const float* gn = p.nmg + (layer + 1) * D;
#pragma unroll
      for (int hf = 0; hf < 2; ++hf) { const int d = hf * 512 + lane * 8; float* xp = p.X + (size_t)t * D + d; float y[8];
#pragma unroll
        for (int i = 0; i < 8; ++i) y[i] = xv[hf * 8 + i] * r * gn[d + i] * (1.f + ml[1024 + d + i]) + ml[d + i];
        *(f32x4*)xp = (f32x4){xv[hf * 8 + 0], xv[hf * 8 + 1], xv[hf * 8 + 2], xv[hf * 8 + 3]}; *(f32x4*)(xp + 4) = (f32x4){xv[hf * 8 + 4], xv[hf * 8 + 5], xv[hf * 8 + 6], xv[hf * 8 + 7]};
        u32x4 w; w.x = pack2(y[0], y[1]); w.y = pack2(y[2], y[3]); w.z = pack2(y[4], y[5]); w.w = pack2(y[6], y[7]); *(u32x4*)(p.H + (size_t)t * D + d) = w; }
    } else {
#pragma unroll
      for (int hf = 0; hf < 2; ++hf) { const int d = hf * 512 + lane * 8; float* xp = p.X + (size_t)t * D + d; float y[8];
#pragma unroll
        for (int i = 0; i < 8; ++i) y[i] = xv[hf * 8 + i] * r * p.final_g[d + i];
        *(f32x4*)xp = (f32x4){y[0], y[1], y[2], y[3]}; *(f32x4*)(xp + 4) = (f32x4){y[4], y[5], y[6], y[7]}; }
    }
  }
}

__device__ void phase_qkrope(const Params& p) {
  const int tid = threadIdx.x, wid = tid >> 6, lane = tid & 63;
  for (int job = blockIdx.x; job < T * 12 / 8; job += gridDim.x) {
    const int w = job * 8 + wid, t = w / 12, hh = w % 12, b = t / S, s = t & (S - 1);
    const u32 raw = *(const u32*)(p.QKV + (size_t)t * 1536 + hh * 128 + lane * 2); float x0 = bflo(raw), x1 = bfhi(raw);
    if (hh < 10) { const float* g = hh < 8 ? p.qn_g : p.kn_g; const float r = rsqrtf(wave_sum(x0 * x0 + x1 * x1) * (1.f / 128.f) + EPS); x0 *= r * g[2 * lane]; x1 *= r * g[2 * lane + 1];
      const int pos = lane < 32 ? (s >> 6) : (s & 63); const int fi = lane & 31; const float fr = exp2f(-(float)(2 * fi) * (13.287712379549449f / 64.f)); const float ang = (float)pos * fr;
      float sn, cs; sincosf(ang, &sn, &cs); const float y0 = x0 * cs - x1 * sn, y1 = x0 * sn + x1 * cs; x0 = y0; x1 = y1; }
    bf16_t* dst = hh < 8 ? p.Qh + (((size_t)b * 8 + hh) * S + s) * 128 : (hh < 10 ? p.Kh + (((size_t)b * 2 + hh - 8) * S + s) * 128 : p.Vh + (((size_t)b * 2 + hh - 10) * S + s) * 128);
    *(u32*)(dst + lane * 2) = pack2(x0, x1);
  }
}

__device__ void phase_attn_naive(const Params& p) {
  const int tid = threadIdx.x, wid = tid >> 6, lane = tid & 63;
  for (int job = blockIdx.x; job < T * 2 / 8; job += gridDim.x) {
    const int w = job * 8 + wid, kv = w & 1, t = w >> 1, b = t / S, s = t & (S - 1);
    float q0[4], q1[4], m[4], l[4], o0[4], o1[4];
#pragma unroll
    for (int g = 0; g < 4; ++g) { const u32 qq = *(const u32*)(p.Qh + (((size_t)b * 8 + kv * 4 + g) * S + s) * 128 + lane * 2); q0[g] = bflo(qq); q1[g] = bfhi(qq); m[g] = -1e30f; l[g] = 0.f; o0[g] = 0.f; o1[g] = 0.f; }
    const bf16_t* Kb = p.Kh + ((size_t)b * 2 + kv) * S * 128; const bf16_t* Vb = p.Vh + ((size_t)b * 2 + kv) * S * 128;
    for (int k = 0; k < S; ++k) { const u32 kk = *(const u32*)(Kb + (size_t)k * 128 + lane * 2), vv = *(const u32*)(Vb + (size_t)k * 128 + lane * 2);
      const float k0 = bflo(kk), k1 = bfhi(kk), v0 = bflo(vv), v1 = bfhi(vv);
#pragma unroll
      for (int g = 0; g < 4; ++g) { const float sc = wave_sum(q0[g] * k0 + q1[g] * k1) * KSCALE; const float mn = fmaxf(m[g], sc), al = __expf(m[g] - mn), pw = __expf(sc - mn);
        l[g] = l[g] * al + pw; o0[g] = o0[g] * al + pw * v0; o1[g] = o1[g] * al + pw * v1; m[g] = mn; } }
#pragma unroll
    for (int g = 0; g < 4; ++g) *(u32*)(p.CAT + (size_t)t * 1024 + (kv * 4 + g) * 128 + lane * 2) = pack2(o0[g] / l[g], o1[g] / l[g]);
  }
}

constexpr int NPH = 19;
__global__ __launch_bounds__(NTHREADS, 2) void mega(Params p, int ph0, int ph1) {
  extern __shared__ __attribute__((aligned(16))) char smem[];
  cg::grid_group grid = cg::this_grid();
#define PHASE(k, call) if (ph0 <= (k) && (k) < ph1) { if ((k) > ph0) grid.sync(); call; }
#if !defined(ONLY_PHASE) || ONLY_PHASE == 0
  PHASE(0, phase_prep(p, smem))
#endif
#if !defined(ONLY_PHASE) || ONLY_PHASE == 1
  PHASE(1, phase_norm<true>(p, p.x, p.nmg, p.mod, 0, 1024, smem))
#endif
#if !defined(ONLY_PHASE) || ONLY_PHASE == 2
  PHASE(2, phase_gemm_naive<EPI_EVIN>(p, 0, p.H, p.Wt_evin, T, 2560, 1024, smem))
#endif
#if !defined(ONLY_PHASE) || ONLY_PHASE == 3
  PHASE(3, phase_convpool(p, smem))
#endif
#if !defined(ONLY_PHASE) || ONLY_PHASE == 4
  PHASE(4, phase_mlstm_naive(p, smem))
#endif
#if !defined(ONLY_PHASE) || ONLY_PHASE == 5
  PHASE(5, phase_cat(p))
#endif
#if !defined(ONLY_PHASE) || ONLY_PHASE == 6
  PHASE(6, phase_gemm_naive<EPI_EVOUT>(p, 0, p.CAT, p.Wt_evout, T, 1024, 1024, smem))
#endif
#if !defined(ONLY_PHASE) || ONLY_PHASE == 7
  PHASE(7, phase_norm<false>(p, p.X, p.nfg, p.mod, 3072, 4096, smem))
#endif
#if !defined(ONLY_PHASE) || ONLY_PHASE == 8
  PHASE(8, phase_gemm_naive<EPI_PEERQ>(p, 0, p.H, p.Wt_q, T, 2048, 1024, smem))
#endif
#if !defined(ONLY_PHASE) || ONLY_PHASE == 9
  PHASE(9, phase_peer_select_naive(p, 0, smem))
#endif
#if !defined(ONLY_PHASE) || ONLY_PHASE == 10
  PHASE(10, phase_peer_gather<0>(p, 0))
#endif
#if !defined(ONLY_PHASE) || ONLY_PHASE == 11
  PHASE(11, phase_gemm_naive<EPI_ODIN>(p, 1, p.H, p.Wt_odin, T, 1536, 1024, smem))
#endif
#if !defined(ONLY_PHASE) || ONLY_PHASE == 12
  PHASE(12, phase_qkrope(p))
#endif
#if !defined(ONLY_PHASE) || ONLY_PHASE == 13
  PHASE(13, phase_attn_naive(p))
#endif
#if !defined(ONLY_PHASE) || ONLY_PHASE == 14
  PHASE(14, phase_gemm_naive<EPI_ODOUT>(p, 1, p.CAT, p.Wt_odout, T, 1024, 1024, smem))
#endif
#if !defined(ONLY_PHASE) || ONLY_PHASE == 15
  PHASE(15, phase_norm<false>(p, p.X, p.nfg + D, p.mod + (size_t)8 * 6144, 3072, 4096, smem))
#endif
#if !defined(ONLY_PHASE) || ONLY_PHASE == 16
  PHASE(16, phase_gemm_naive<EPI_PEERQ>(p, 1, p.H, p.Wt_q + (size_t)2048 * 1024, T, 2048, 1024, smem))
#endif
#if !defined(ONLY_PHASE) || ONLY_PHASE == 17
  PHASE(17, phase_peer_select_naive(p, 1, smem))
#endif
#if !defined(ONLY_PHASE) || ONLY_PHASE == 18
  PHASE(18, phase_peer_gather<1>(p, 1))
#endif
#undef PHASE
}
}

extern "C" void kernel_launch(void* const* d_in, const int* in_sizes, int n_in, void* d_out, int out_size, void* d_ws, size_t ws_size, hipStream_t stream) {
  (void)in_sizes; (void)n_in; (void)out_size;
  Params p{};
  const float** fin = (const float**)&p;
  for (int i = 0; i < 23; ++i) fin[i] = (const float*)d_in[i];
  p.X = (float*)d_out;
  char* ws = (char*)d_ws; size_t off = 0;
  auto alloc = [&](size_t bytes) { char* q = ws + off; off += (bytes + 255) / 256 * 256; return q; };
  p.U = (bf16_t*)alloc((size_t)2 * 16384 * 1024 * 2); p.V = (bf16_t*)alloc((size_t)2 * 16384 * 1024 * 2);
  p.Wt_evin = (bf16_t*)alloc((size_t)2560 * 1024 * 2); p.Wt_evout = (bf16_t*)alloc((size_t)1024 * 1024 * 2); p.Wt_odin = (bf16_t*)alloc((size_t)1536 * 1024 * 2);
  p.Wt_odout = (bf16_t*)alloc((size_t)1024 * 1024 * 2); p.Wt_q = (bf16_t*)alloc((size_t)2 * 2048 * 1024 * 2); p.keysb = (bf16_t*)alloc((size_t)2 * 2 * 128 * 128 * 2);
  p.Wg = (float*)alloc(16 * 1024 * 4); p.mod = (float*)alloc(2 * 8 * 6144 * 4); p.gates = (float*)alloc((size_t)T * 16 * 4);
  p.pgate = (float*)alloc((size_t)T * 128 * 4); p.pidx = (bf16_t*)alloc((size_t)T * 128 * 2);
  p.H = (bf16_t*)alloc((size_t)T * 1024 * 2); p.CAT = p.H;
  char* big = alloc((size_t)T * 2048 * 2);
  p.ZQK = (bf16_t*)big; p.ZV = (bf16_t*)(big + (size_t)T * 1024 * 2); p.ZO = (bf16_t*)(big + (size_t)T * 1536 * 2); p.HS = (bf16_t*)big; p.QP = (bf16_t*)big; p.QKV = (bf16_t*)big;
  char* big2 = alloc((size_t)T * 1536 * 2);
  p.QK = (bf16_t*)big2; p.ZP = (bf16_t*)(big2 + (size_t)T * 1024 * 2); p.Qh = (bf16_t*)big2; p.Kh = (bf16_t*)(big2 + (size_t)T * 1024 * 2); p.Vh = (bf16_t*)(big2 + (size_t)T * 1280 * 2);
  if (off > ws_size) { fprintf(stderr, "kernel_launch: workspace too small: need %zu have %zu\n", off, ws_size); return; }

  static int grid_blocks = 0;
  if (!grid_blocks) {
    int dev = 0, cus = 0, per_cu = 0; hipGetDevice(&dev); hipDeviceGetAttribute(&cus, hipDeviceAttributeMultiprocessorCount, dev);
    hipFuncSetAttribute((const void*)mega, hipFuncAttributeMaxDynamicSharedMemorySize, SMEM_BYTES);
    hipOccupancyMaxActiveBlocksPerMultiprocessor(&per_cu, mega, NTHREADS, SMEM_BYTES);
    if (per_cu > 1) per_cu = 1;
    grid_blocks = cus * per_cu;
    if (grid_blocks <= 0) { fprintf(stderr, "kernel_launch: occupancy query returned 0\n"); grid_blocks = 0; return; }
  }
#if MULTI_LAUNCH
  for (int ph = 0; ph < NPH; ++ph) hipLaunchKernelGGL(mega, dim3(grid_blocks), dim3(NTHREADS), SMEM_BYTES, stream, p, ph, ph + 1);
#else
  int ph0 = 0, ph1 = NPH; void* args[] = {&p, &ph0, &ph1};
  hipError_t e = hipLaunchCooperativeKernel((const void*)mega, dim3(grid_blocks), dim3(NTHREADS), args, SMEM_BYTES, stream);
  if (e != hipSuccess) fprintf(stderr, "cooperative launch failed: %s (grid %d)\n", hipGetErrorString(e), grid_blocks);
#endif
}
```

```cpp
#include <hip/hip_runtime.h>
#include <hip/hip_cooperative_groups.h>
#include <math.h>
#include <stdint.h>
#include <stdio.h>
namespace cg = cooperative_groups;

#ifndef MULTI_LAUNCH
#define MULTI_LAUNCH 0
#endif

namespace {
typedef unsigned short bf16_t;
typedef unsigned int u32;
typedef float f32x4 __attribute__((ext_vector_type(4)));
typedef u32 u32x4 __attribute__((ext_vector_type(4)));
typedef u32 u32x2 __attribute__((ext_vector_type(2)));
typedef __bf16 bf16x2_t __attribute__((ext_vector_type(2)));

constexpr int D = 1024, NB = 8, S = 4096, T = NB * S;
constexpr int EVEN_IN = 2576;
constexpr float EPS = 1e-6f;
constexpr int NTHREADS = 512;
constexpr int SMEM_BYTES = 144 * 1024;
constexpr float KSCALE = 0.08838834764831845f;

struct Params {
  const float *x, *c, *ada_w, *ada_b, *nmg, *nfg, *ev_w_in, *ev_b_in, *conv_w, *conv_b, *mnorm_g, *pool_w, *pool_sc, *ev_w_out, *od_w_in, *qn_g, *kn_g, *od_w_out,
      *peer_wq, *peer_keys, *peer_u, *peer_v, *final_g;
  float* X;
  bf16_t *Wt_evin, *Wt_evout, *Wt_odin, *Wt_odout, *Wt_q, *keysb, *U, *V;
  float *Wg, *mod, *gates, *pgate;
  bf16_t *H, *ZQK, *ZV, *ZO, *ZP, *QK, *HS, *CAT, *QP, *QKV, *Qh, *Kh, *Vh;
  bf16_t* pidx;
};

__device__ __forceinline__ float siluf(float x) { return x / (1.f + __expf(-x)); }
__device__ __forceinline__ float sigmf(float x) { return 1.f / (1.f + __expf(-x)); }
__device__ __forceinline__ float wave_sum(float v) { for (int o = 32; o >= 1; o >>= 1) v += __shfl_xor(v, o); return v; }
__device__ __forceinline__ float wave_max(float v) { for (int o = 32; o >= 1; o >>= 1) v = fmaxf(v, __shfl_xor(v, o)); return v; }
__device__ __forceinline__ bf16_t f2bf(float f) { u32 u = __float_as_uint(f); u += 0x7FFFu + ((u >> 16) & 1u); return (bf16_t)(u >> 16); }
__device__ __forceinline__ float bf2f(bf16_t b) { return __uint_as_float(((u32)b) << 16); }
__device__ __forceinline__ u32 pack2(float lo, float hi) { return (u32)f2bf(lo) | ((u32)f2bf(hi) << 16); }
__device__ __forceinline__ float bflo(u32 w) { return __uint_as_float(w << 16); }
__device__ __forceinline__ float bfhi(u32 w) { return __uint_as_float(w & 0xFFFF0000u); }
__device__ __forceinline__ float dot2bf(u32 a, u32 b, float c) { return __builtin_amdgcn_fdot2_f32_bf16(__builtin_bit_cast(bf16x2_t, a), __builtin_bit_cast(bf16x2_t, b), c, false); }

constexpr int PJ_MOD = 192, PJ_TR = 2576, PJ_WG = 1, PJ_KEYS = 16, PJ_UV = 16384;
constexpr int PJ_TOTAL = PJ_MOD + PJ_TR + PJ_WG + PJ_KEYS + PJ_UV;

__device__ void prep_transpose_tile(const float* __restrict__ src, int ld, int k0, int n0, bf16_t* __restrict__ dst, int dstK, char* smem) {
  float* tile = (float*)smem;
  const int tid = threadIdx.x;
  __syncthreads();
  for (int pass = 0; pass < 8; ++pass) { int kk = pass * 8 + (tid >> 6), n = tid & 63; tile[kk * 65 + n] = src[(size_t)(k0 + kk) * ld + n0 + n]; }
  __syncthreads();
  int n = tid >> 3, kc = (tid & 7) * 8; u32x4 w;
  w.x = pack2(tile[(kc + 0) * 65 + n], tile[(kc + 1) * 65 + n]); w.y = pack2(tile[(kc + 2) * 65 + n], tile[(kc + 3) * 65 + n]);
  w.z = pack2(tile[(kc + 4) * 65 + n], tile[(kc + 5) * 65 + n]); w.w = pack2(tile[(kc + 6) * 65 + n], tile[(kc + 7) * 65 + n]);
  *(u32x4*)(dst + (size_t)(n0 + n) * dstK + k0 + kc) = w;
}

__device__ void phase_prep(const Params& p, char* smem) {
  const int tid = threadIdx.x;
  for (int job = blockIdx.x; job < PJ_TOTAL; job += gridDim.x) {
    if (job < PJ_MOD) {
      float* cs = (float*)smem; float* red = cs + 8192;
      __syncthreads();
      for (int i = tid; i < 8192; i += NTHREADS) cs[i] = siluf(p.c[i]);
      __syncthreads();
      const int l = job / 96, e0 = (job % 96) * 64, col = tid & 63, dg = tid >> 6;
      float acc[8];
#pragma unroll
      for (int b = 0; b < 8; ++b) acc[b] = 0.f;
      const float* w = p.ada_w + (size_t)l * D * 6144 + e0 + col;
      for (int d = dg * 128; d < dg * 128 + 128; ++d) { float wv = w[(size_t)d * 6144];
#pragma unroll
        for (int b = 0; b < 8; ++b) acc[b] += cs[b * 1024 + d] * wv; }
#pragma unroll
      for (int b = 0; b < 8; ++b) red[(dg * 8 + b) * 64 + col] = acc[b];
      __syncthreads();
      { const int b = tid >> 6; float s = 0.f;
#pragma unroll
        for (int g = 0; g < 8; ++g) s += red[(g * 8 + b) * 64 + col];
        p.mod[(size_t)(l * 8 + b) * 6144 + e0 + col] = s + p.ada_b[l * 6144 + e0 + col]; }
    } else if (job < PJ_MOD + PJ_TR) {
      int tt = job - PJ_MOD;
      if (tt < 640) prep_transpose_tile(p.ev_w_in, EVEN_IN, (tt / 40) * 64, (tt % 40) * 64, p.Wt_evin, 1024, smem);
      else if (tt < 896) { tt -= 640; prep_transpose_tile(p.ev_w_out, 1024, (tt / 16) * 64, (tt % 16) * 64, p.Wt_evout, 1024, smem); }
      else if (tt < 1280) { tt -= 896; prep_transpose_tile(p.od_w_in, 1536, (tt / 24) * 64, (tt % 24) * 64, p.Wt_odin, 1024, smem); }
      else if (tt < 1536) { tt -= 1280; prep_transpose_tile(p.od_w_out, 1024, (tt / 16) * 64, (tt % 16) * 64, p.Wt_odout, 1024, smem); }
      else if (tt < 2560) { tt -= 1536; int l = tt / 512; tt %= 512; prep_transpose_tile(p.peer_wq + (size_t)l * D * 2048, 2048, (tt / 32) * 64, (tt % 32) * 64, p.Wt_q + (size_t)l * 2048 * 1024, 1024, smem); }
      else {   }
    } else if (job < PJ_MOD + PJ_TR + PJ_WG) {
      for (int i = tid; i < 16 * 1024; i += NTHREADS) { int g = i >> 10, d = i & 1023; p.Wg[i] = p.ev_w_in[(size_t)d * EVEN_IN + 2560 + g]; }
    } else if (job < PJ_MOD + PJ_TR + PJ_WG + PJ_KEYS) {
      int j = job - (PJ_MOD + PJ_TR + PJ_WG);
      for (int i = tid; i < 4096; i += NTHREADS) p.keysb[j * 4096 + i] = f2bf(p.peer_keys[j * 4096 + i]);
    } else {
      int j = job - (PJ_MOD + PJ_TR + PJ_WG + PJ_KEYS); const float* src = j < 8192 ? p.peer_u : p.peer_v; bf16_t* dst = j < 8192 ? p.U : p.V; j &= 8191;
      size_t o = (size_t)j * 4096 + tid * 8; f32x4 a = *(const f32x4*)(src + o), b = *(const f32x4*)(src + o + 4);
      u32x4 w; w.x = pack2(a.x, a.y); w.y = pack2(a.z, a.w); w.z = pack2(b.x, b.y); w.w = pack2(b.z, b.w); *(u32x4*)(dst + o) = w;
    }
  }
}

template <bool WITH_GATES>
__device__ void phase_norm(const Params& p, const float* __restrict__ xin, const float* __restrict__ g, const float* __restrict__ modl, int sh_off, int sc_off, char* smem) {
  const int tid = threadIdx.x, wid = tid >> 6, lane = tid & 63;
  float* wg = (float*)smem;
  if (WITH_GATES) { __syncthreads(); for (int i = tid; i < 16 * 1024; i += NTHREADS) wg[i] = p.Wg[i]; __syncthreads(); }
  for (int job = blockIdx.x; job < T / 8; job += gridDim.x) {
    const int t = job * 8 + wid, b = t / S;
    f32x4 v[4]; float ss = 0.f;
#pragma unroll
    for (int i = 0; i < 4; ++i) { v[i] = *(const f32x4*)(xin + (size_t)t * D + i * 256 + lane * 4); ss += v[i].x * v[i].x + v[i].y * v[i].y + v[i].z * v[i].z + v[i].w * v[i].w; }
    ss = wave_sum(ss); const float r = rsqrtf(ss * (1.f / D) + EPS);
    const float* shp = modl + (size_t)b * 6144 + sh_off; const float* scp = modl + (size_t)b * 6144 + sc_off;
#pragma unroll
    for (int i = 0; i < 4; ++i) { const int d = i * 256 + lane * 4; f32x4 gg = *(const f32x4*)(g + d), s1 = *(const f32x4*)(scp + d), s0 = *(const f32x4*)(shp + d);
      v[i].x = v[i].x * r * gg.x * (1.f + s1.x) + s0.x; v[i].y = v[i].y * r * gg.y * (1.f + s1.y) + s0.y; v[i].z = v[i].z * r * gg.z * (1.f + s1.z) + s0.z; v[i].w = v[i].w * r * gg.w * (1.f + s1.w) + s0.w;
      u32x2 w; w.x = pack2(v[i].x, v[i].y); w.y = pack2(v[i].z, v[i].w); *(u32x2*)(p.H + (size_t)t * D + d) = w; }
    if (WITH_GATES) {
      float myg = 0.f;
#pragma unroll 2
      for (int gi = 0; gi < 16; ++gi) { float a = 0.f;
#pragma unroll
        for (int i = 0; i < 4; ++i) { f32x4 w4 = *(const f32x4*)(wg + gi * 1024 + i * 256 + lane * 4); a += v[i].x * w4.x + v[i].y * w4.y + v[i].z * w4.z + v[i].w * w4.w; }
        a = wave_sum(a); if (lane == gi) myg = a; }
      if (lane < 16) p.gates[(size_t)t * 16 + lane] = myg + p.ev_b_in[2560 + lane];
    }
  }
}

enum { EPI_EVIN = 0, EPI_EVOUT = 1, EPI_PEERQ = 2, EPI_ODIN = 3, EPI_ODOUT = 4 };
template <int EPI> __device__ __forceinline__ void epi_store(const Params& p, int layer, int m, int n, float acc) {
  if (EPI == EPI_EVIN) { float v = acc + p.ev_b_in[n];
    if (n < 1024) p.ZQK[(size_t)m * 1024 + n] = f2bf(v); else if (n < 1536) p.ZV[(size_t)m * 512 + n - 1024] = f2bf(v);
    else if (n < 2048) p.ZO[(size_t)m * 512 + n - 1536] = f2bf(sigmf(v)); else p.ZP[(size_t)m * 512 + n - 2048] = f2bf(v); }
  else if (EPI == EPI_EVOUT) { int b = m / S; p.X[(size_t)m * D + n] = p.x[(size_t)m * D + n] + p.mod[(size_t)(0 * 8 + b) * 6144 + 2048 + n] * acc; }
  else if (EPI == EPI_PEERQ) p.QP[(size_t)m * 2048 + n] = f2bf(acc);
  else if (EPI == EPI_ODIN) p.QKV[(size_t)m * 1536 + n] = f2bf(acc);
  else if (EPI == EPI_ODOUT) { int b = m / S; p.X[(size_t)m * D + n] += p.mod[(size_t)(1 * 8 + b) * 6144 + 2048 + n] * acc; }
}
template <int EPI> __device__ void phase_gemm_naive(const Params& p, int layer, const bf16_t* __restrict__ A, const bf16_t* __restrict__ Bt, int M, int N, int K, char* smem) {
  float* As = (float*)smem; float* Bs = As + 32 * 132;
  const int tid = threadIdx.x, tx = tid & 15, ty = tid >> 4; const int nN = N / 64, njobs = (M / 128) * nN;
  for (int job = blockIdx.x; job < njobs; job += gridDim.x) {
    const int m0 = (job / nN) * 128, n0 = (job % nN) * 64; float acc[4][4];
#pragma unroll
    for (int i = 0; i < 4; ++i)
#pragma unroll
      for (int j = 0; j < 4; ++j) acc[i][j] = 0.f;
    for (int k0 = 0; k0 < K; k0 += 32) {
      __syncthreads();
      { int row = tid >> 2, kc = (tid & 3) * 8; u32x4 w = *(const u32x4*)(A + (size_t)(m0 + row) * K + k0 + kc);
        As[(kc + 0) * 132 + row] = bflo(w.x); As[(kc + 1) * 132 + row] = bfhi(w.x); As[(kc + 2) * 132 + row] = bflo(w.y); As[(kc + 3) * 132 + row] = bfhi(w.y);
        As[(kc + 4) * 132 + row] = bflo(w.z); As[(kc + 5) * 132 + row] = bfhi(w.z); As[(kc + 6) * 132 + row] = bflo(w.w); As[(kc + 7) * 132 + row] = bfhi(w.w); }
      if (tid < 256) { int row = tid >> 2, kc = (tid & 3) * 8; u32x4 w = *(const u32x4*)(Bt + (size_t)(n0 + row) * K + k0 + kc);
        Bs[(kc + 0) * 68 + row] = bflo(w.x); Bs[(kc + 1) * 68 + row] = bfhi(w.x); Bs[(kc + 2) * 68 + row] = bflo(w.y); Bs[(kc + 3) * 68 + row] = bfhi(w.y);
        Bs[(kc + 4) * 68 + row] = bflo(w.z); Bs[(kc + 5) * 68 + row] = bfhi(w.z); Bs[(kc + 6) * 68 + row] = bflo(w.w); Bs[(kc + 7) * 68 + row] = bfhi(w.w); }
      __syncthreads();
#pragma unroll 8
      for (int kk = 0; kk < 32; ++kk) { f32x4 a = *(const f32x4*)(As + kk * 132 + ty * 4), b = *(const f32x4*)(Bs + kk * 68 + tx * 4);
        acc[0][0] += a.x * b.x; acc[0][1] += a.x * b.y; acc[0][2] += a.x * b.z; acc[0][3] += a.x * b.w;
        acc[1][0] += a.y * b.x; acc[1][1] += a.y * b.y; acc[1][2] += a.y * b.z; acc[1][3] += a.y * b.w;
        acc[2][0] += a.z * b.x; acc[2][1] += a.z * b.y; acc[2][2] += a.z * b.z; acc[2][3] += a.z * b.w;
        acc[3][0] += a.w * b.x; acc[3][1] += a.w * b.y; acc[3][2] += a.w * b.z; acc[3][3] += a.w * b.w; }
    }
#pragma unroll
    for (int i = 0; i < 4; ++i)
#pragma unroll
      for (int j = 0; j < 4; ++j) epi_store<EPI>(p, layer, m0 + ty * 4 + i, n0 + tx * 4 + j, acc[i][j]);
  }
}

namespace pg8 {
#define PG8_LAS __attribute__((address_space(3)))
typedef unsigned short bf16_t;
typedef short bf16x8 __attribute__((ext_vector_type(8)));
typedef float f32x4 __attribute__((ext_vector_type(4)));
typedef unsigned u32x4 __attribute__((ext_vector_type(4)));
constexpr int BM = 256, BK = 64, HALF = 128, HTB = HALF * BK * 2  , STAGE_BYTES = 8 * HTB, NXCD = 8, WGM = 8;

__host__ __device__ __forceinline__ int lds_byte(int r, int c) { const int st = (r >> 4) * 2 + (c >> 5), rr = r & 15, cc = c & 31, ob = rr * 64 + cc * 2; return st * 1024 + (ob ^ (((ob >> 9) & 1) << 5)); }
__host__ __device__ __forceinline__ void stage_rc(int b, int& R, int& C) { const int st = b / 1024, sb = b % 1024, swz = sb ^ (((sb >> 9) & 1) << 5); R = (st >> 1) * 16 + swz / 64; C = (st & 1) * 32 + (swz % 64) / 2; }
__host__ __device__ __forceinline__ int perm32(int rho) { const int n = rho >> 4, i = rho & 15; return 8 * (i >> 2) + 4 * n + (i & 3); }

struct Unit { int pm, pn; };
struct Gemm { const bf16_t* A; const bf16_t* Bt; int M, N, K; };

struct StaticOrder {
    int nM, nN, nwg, G, c;
    __host__ __device__ void init(int M, int N, int G_, int c_) { nM = M / BM; nN = N / BM; nwg = nM * nN; G = G_; c = c_; }
    __host__ __device__ bool next(int i, Unit& u) const {
        const long L = (long)i * G + c; if (L >= nwg) return false;
        int wgid = (int)L; { const int q = nwg / NXCD, r = nwg % NXCD, xcd = wgid % NXCD, off = wgid / NXCD; wgid = (xcd < r ? xcd * (q + 1) : r * (q + 1) + (xcd - r) * q) + off; }
        const int nig = WGM * nN, gid = wgid / nig, fm = gid * WGM, gsz = (nM - fm) < WGM ? (nM - fm) : WGM;
        u.pm = fm + ((wgid % nig) % gsz); u.pn = (wgid % nig) / gsz; return true;
    }
    __device__ __forceinline__ void a_ready(const Unit&) const {}
    __device__ __forceinline__ void done(const Unit&) const {}
};
__device__ __forceinline__ unsigned cvt_pk_bf16(float lo, float hi) { unsigned r; asm volatile("v_cvt_pk_bf16_f32 %0, %1, %2" : "=v"(r) : "v"(lo), "v"(hi)); return r; }
template <class Epi, class Sched, bool STAMP = false>
__device__ __forceinline__ void gemm_phase(PG8_LAS unsigned char* lds, const Gemm g, const Sched& S, const Epi& E, unsigned long long* stamps) {
    const int tid = threadIdx.x, wid = __builtin_amdgcn_readfirstlane(tid >> 6), lane = tid & 63, wr = wid >> 2, wc = wid & 3, fr = lane & 15, fq = lane >> 4;
    const int K = g.K, nt = K / BK;
    int ts_lo = 0, ts_hi = 0, nts = 0; const unsigned long long rt_entry = STAMP ? (unsigned long long)wall_clock64() : 0ull;
#define PG8_STAMP() do { if (STAMP && wid == 0 && nts < 64) { const unsigned long long _c = (unsigned long long)clock64(); \
        ts_lo = (lane == nts) ? (int)(unsigned)_c : ts_lo; ts_hi = (lane == nts) ? (int)(unsigned)(_c >> 32) : ts_hi; ++nts; } } while (0)
    PG8_STAMP();
    unsigned voffA[2], voffB[2];
#pragma unroll
    for (int i = 0; i < 2; ++i) { int R, C; stage_rc(tid * 16 + i * 8192, R, C); const int Rb = Epi::PERM ? ((R & ~31) + perm32(R & 31)) : R;
        voffA[i] = (unsigned)(R * K + C) * 2u; voffB[i] = (unsigned)(Rb * K + C) * 2u; }
    const size_t kstep = (size_t)(BK * 2);
    const size_t hstep = (size_t)HALF * K * 2;
    const size_t tstep = 2 * hstep;
    const unsigned ldsw = (unsigned)wid * 1024u;
    const int aoff = lds_byte(wr * 64 + fr, fq * 8), boff = lds_byte(wc * 32 + fr, fq * 8);
#define PG8_SA(b, h) (((b) * 2 + (h)) * HTB)
#define PG8_SB(b, h) ((4 + (b) * 2 + (h)) * HTB)
#define PG8_STAGE(bufoff, gbase, voff) do { _Pragma("unroll") for (int _i = 0; _i < 2; ++_i) \
        __builtin_amdgcn_global_load_lds((const unsigned*)((const char*)(gbase) + (voff)[_i]), (PG8_LAS unsigned*)(lds + (bufoff) + ldsw + _i * 8192), 16, 0, 0); } while (0)
#define PG8_LDA(dst, b, h) do { _Pragma("unroll") for (int m = 0; m < 4; ++m) _Pragma("unroll") for (int k = 0; k < 2; ++k) dst[m][k] = *(const PG8_LAS bf16x8*)(lds + PG8_SA(b, h) + aoff + m * 2048 + k * 1024); } while (0)
#define PG8_LDB(dst, b, h) do { _Pragma("unroll") for (int n = 0; n < 2; ++n) _Pragma("unroll") for (int k = 0; k < 2; ++k) dst[n][k] = *(const PG8_LAS bf16x8*)(lds + PG8_SB(b, h) + boff + n * 2048 + k * 1024); } while (0)
#define PG8_MMA(ai, bj, At, Bt) do { __builtin_amdgcn_s_setprio(1); _Pragma("unroll") for (int m = 0; m < 4; ++m) _Pragma("unroll") for (int n = 0; n < 2; ++n) _Pragma("unroll") for (int k = 0; k < 2; ++k) \
        acc[ai][bj][m][n] = __builtin_amdgcn_mfma_f32_16x16x32_bf16(Bt[n][k], At[m][k], acc[ai][bj][m][n], 0, 0, 0); __builtin_amdgcn_s_setprio(0); } while (0)
#define PG8_WAIT_V(n) asm volatile("s_waitcnt vmcnt(" #n ")" ::: "memory")
#define PG8_WAIT_L(n) asm volatile("s_waitcnt lgkmcnt(" #n ")" ::: "memory")
#define PG8_BAR __builtin_amdgcn_s_barrier()
#define PG8_SCHED __builtin_amdgcn_sched_barrier(0)
    Unit cur, nxt; int ui = 0;
    if (!S.next(0, cur)) return;
    f32x4 acc[2][2][4][2];
#pragma unroll
    for (int a = 0; a < 2; ++a)
#pragma unroll
        for (int b = 0; b < 2; ++b)
#pragma unroll
            for (int m = 0; m < 4; ++m)
#pragma unroll
                for (int n = 0; n < 2; ++n) acc[a][b][m][n] = (f32x4){0.f, 0.f, 0.f, 0.f};
    bf16x8 At[4][2], B0[2][2], B1[2][2];
    const char* cA = (const char*)g.A + (size_t)cur.pm * tstep; const char* cB = (const char*)g.Bt + (size_t)cur.pn * tstep;
    S.a_ready(cur);
    PG8_STAGE(PG8_SB(0, 0), cB, voffB); PG8_STAGE(PG8_SA(0, 0), cA, voffA); PG8_STAGE(PG8_SB(0, 1), cB + hstep, voffB); PG8_STAGE(PG8_SA(0, 1), cA + hstep, voffA);
    if (wr == 1) PG8_BAR;
    PG8_WAIT_V(4); PG8_BAR;
    PG8_STAGE(PG8_SB(1, 0), cB + kstep, voffB); PG8_STAGE(PG8_SA(1, 0), cA + kstep, voffA); PG8_STAGE(PG8_SB(1, 1), cB + hstep + kstep, voffB);
    PG8_WAIT_V(6); PG8_BAR;
    PG8_STAMP();
    for (;;) {
        const bool has_next = S.next(ui + 1, nxt);
        const char* nA = has_next ? (const char*)g.A + (size_t)nxt.pm * tstep : cA; const char* nB = has_next ? (const char*)g.Bt + (size_t)nxt.pn * tstep : cB;
        for (int t = 0; t < nt; t += 2) {
            const bool last = (t == nt - 2);
            const char* a1 = cA + (size_t)(t + 1) * kstep;
            const char* a2 = last ? nA : cA + (size_t)(t + 2) * kstep; const char* b2 = last ? nB : cB + (size_t)(t + 2) * kstep;
            const char* a3 = a2 + kstep; const char* b3 = b2 + kstep;
            if (last && has_next) S.a_ready(nxt);
            PG8_LDB(B0, 0, 0); PG8_SCHED; PG8_LDA(At, 0, 0); PG8_STAGE(PG8_SA(1, 1), a1 + hstep, voffA);
            PG8_WAIT_L(8); PG8_BAR; PG8_WAIT_L(0); PG8_MMA(0, 0, At, B0); PG8_BAR; PG8_SCHED;
            PG8_LDB(B1, 0, 1); PG8_STAGE(PG8_SB(0, 0), b2, voffB);
            PG8_BAR; PG8_WAIT_L(0); PG8_MMA(0, 1, At, B1); PG8_BAR;
            PG8_LDA(At, 0, 1); PG8_STAGE(PG8_SA(0, 0), a2, voffA);
            PG8_BAR; PG8_WAIT_L(0); PG8_MMA(1, 0, At, B0); PG8_BAR; PG8_SCHED;
            PG8_STAGE(PG8_SB(0, 1), b2 + hstep, voffB);
            PG8_WAIT_V(6); PG8_BAR; PG8_MMA(1, 1, At, B1); PG8_BAR;
            PG8_LDB(B0, 1, 0); PG8_SCHED; PG8_LDA(At, 1, 0); PG8_STAGE(PG8_SA(0, 1), a2 + hstep, voffA);
            PG8_WAIT_L(8); PG8_BAR; PG8_WAIT_L(0); PG8_MMA(0, 0, At, B0); PG8_BAR; PG8_SCHED;
            PG8_LDB(B1, 1, 1); PG8_STAGE(PG8_SB(1, 0), b3, voffB);
            PG8_BAR; PG8_WAIT_L(0); PG8_MMA(0, 1, At, B1); PG8_BAR;
            PG8_LDA(At, 1, 1); PG8_STAGE(PG8_SA(1, 0), a3, voffA);
            PG8_BAR; PG8_WAIT_L(0); PG8_MMA(1, 0, At, B0); PG8_BAR; PG8_SCHED;
            PG8_STAGE(PG8_SB(1, 1), b3 + hstep, voffB);
            PG8_WAIT_V(6); PG8_BAR; PG8_MMA(1, 1, At, B1); PG8_BAR;
        }
        PG8_STAMP();
        if constexpr (!Epi::AFTER_DRAIN) { E(acc, cur, wr, wc, fr, fq); S.done(cur); }
        PG8_STAMP();
        if (!has_next) break;
#pragma unroll
        for (int a = 0; a < 2; ++a)
#pragma unroll
            for (int b = 0; b < 2; ++b)
#pragma unroll
                for (int m = 0; m < 4; ++m)
#pragma unroll
                    for (int n = 0; n < 2; ++n) acc[a][b][m][n] = (f32x4){0.f, 0.f, 0.f, 0.f};
        cur = nxt; cA = nA; cB = nB; ++ui;
    }
    PG8_WAIT_V(0);
    if (wr == 0) PG8_BAR;
    PG8_BAR;
    if constexpr (Epi::AFTER_DRAIN) { E.fused(acc, cur, wr, wc, fr, fq, lds, wid, lane); S.done(cur); }
    PG8_STAMP();
    if (STAMP && wid == 0) { stamps[lane] = lane < nts ? (((unsigned long long)(unsigned)ts_hi << 32) | (unsigned)ts_lo) : 0ull;
        if (lane == 62) stamps[62] = rt_entry; if (lane == 63) stamps[63] = (unsigned long long)wall_clock64(); }
#undef PG8_STAMP
#undef PG8_SA
#undef PG8_SB
#undef PG8_STAGE
#undef PG8_LDA
#undef PG8_LDB
#undef PG8_MMA
#undef PG8_WAIT_V
#undef PG8_WAIT_L
#undef PG8_BAR
#undef PG8_SCHED
}
}

struct EpiEvin {
  static constexpr bool PERM = true, AFTER_DRAIN = false;
  bf16_t *ZQK, *ZV, *ZO, *ZP; const float* bias;
  __device__ __forceinline__ void operator()(const pg8::f32x4 (&acc)[2][2][4][2], const pg8::Unit& u, int wr, int wc, int fr, int fq) const {
    const int row0 = u.pm * 256 + wr * 64 + fr, ct = u.pn * 256;
    bf16_t* base; int ldc, cl; bool sig = false;
    if (ct < 1024) { base = ZQK; ldc = 1024; cl = ct; } else if (ct < 1536) { base = ZV; ldc = 512; cl = ct - 1024; } else if (ct < 2048) { base = ZO; ldc = 512; cl = ct - 1536; sig = true; } else { base = ZP; ldc = 512; cl = ct - 2048; }
    const int cofs = wc * 32 + 8 * fq;
    pg8::f32x4 bv[2][2];
#pragma unroll
    for (int bj = 0; bj < 2; ++bj)
#pragma unroll
      for (int n = 0; n < 2; ++n) bv[bj][n] = *(const pg8::f32x4*)(bias + ct + cofs + bj * 128 + 4 * n);
#pragma unroll
    for (int ai = 0; ai < 2; ++ai)
#pragma unroll
      for (int m = 0; m < 4; ++m) { bf16_t* rowp = base + (size_t)(row0 + ai * 128 + m * 16) * ldc + cl + cofs;
#pragma unroll
        for (int bj = 0; bj < 2; ++bj) { pg8::f32x4 v0 = acc[ai][bj][m][0] + bv[bj][0], v1 = acc[ai][bj][m][1] + bv[bj][1];
          if (sig) {
#pragma unroll
            for (int j = 0; j < 4; ++j) { v0[j] = sigmf(v0[j]); v1[j] = sigmf(v1[j]); } }
          pg8::u32x4 w; w.x = pg8::cvt_pk_bf16(v0[0], v0[1]); w.y = pg8::cvt_pk_bf16(v0[2], v0[3]); w.z = pg8::cvt_pk_bf16(v1[0], v1[1]); w.w = pg8::cvt_pk_bf16(v1[2], v1[3]);
          *(pg8::u32x4*)(rowp + bj * 128) = w; } }
  }
};
struct EpiPlain {
  static constexpr bool PERM = true, AFTER_DRAIN = false;
  bf16_t* out; int ldc;
  __device__ __forceinline__ void operator()(const pg8::f32x4 (&acc)[2][2][4][2], const pg8::Unit& u, int wr, int wc, int fr, int fq) const {
    const int row0 = u.pm * 256 + wr * 64 + fr, col0 = u.pn * 256 + wc * 32 + 8 * fq;
#pragma unroll
    for (int ai = 0; ai < 2; ++ai)
#pragma unroll
      for (int m = 0; m < 4; ++m) { bf16_t* rowp = out + (size_t)(row0 + ai * 128 + m * 16) * ldc + col0;
#pragma unroll
        for (int bj = 0; bj < 2; ++bj) { const pg8::f32x4 v0 = acc[ai][bj][m][0], v1 = acc[ai][bj][m][1];
          pg8::u32x4 w; w.x = pg8::cvt_pk_bf16(v0[0], v0[1]); w.y = pg8::cvt_pk_bf16(v0[2], v0[3]); w.z = pg8::cvt_pk_bf16(v1[0], v1[1]); w.w = pg8::cvt_pk_bf16(v1[2], v1[3]);
          *(pg8::u32x4*)(rowp + bj * 128) = w; } }
  }
};
struct EpiRes {
  static constexpr bool PERM = false, AFTER_DRAIN = false;
  const float* xin; float* X; const float* gate;
  __device__ __forceinline__ void operator()(const pg8::f32x4 (&acc)[2][2][4][2], const pg8::Unit& u, int wr, int wc, int fr, int fq) const {
    const int row0 = u.pm * 256 + wr * 64 + fr, col0 = u.pn * 256 + wc * 32 + 4 * fq; const float* gb = gate + (size_t)((u.pm * 256) / S) * 6144;
    pg8::f32x4 gv[2][2];
#pragma unroll
    for (int bj = 0; bj < 2; ++bj)
#pragma unroll
      for (int n = 0; n < 2; ++n) gv[bj][n] = *(const pg8::f32x4*)(gb + col0 + bj * 128 + n * 16);
#pragma unroll
    for (int ai = 0; ai < 2; ++ai)
#pragma unroll
      for (int m = 0; m < 4; ++m) { const size_t off = (size_t)(row0 + ai * 128 + m * 16) * 1024 + col0;
#pragma unroll
        for (int bj = 0; bj < 2; ++bj)
#pragma unroll
          for (int n = 0; n < 2; ++n) { const pg8::f32x4 xi = *(const pg8::f32x4*)(xin + off + bj * 128 + n * 16); *(pg8::f32x4*)(X + off + bj * 128 + n * 16) = xi + gv[bj][n] * acc[ai][bj][m][n]; }
        asm volatile("" ::: "memory"); }
  }
};
template <class Epi> __device__ __forceinline__ void phase_gemm_fast(const bf16_t* A, const bf16_t* Bt, int M, int N, int K, const Epi& E, char* smem) {
  pg8::Gemm g; g.A = A; g.Bt = Bt; g.M = M; g.N = N; g.K = K;
  pg8::StaticOrder So; So.init(M, N, (int)gridDim.x, (int)blockIdx.x);
  pg8::gemm_phase<Epi, pg8::StaticOrder, false>((PG8_LAS unsigned char*)smem, g, So, E, nullptr);
}

__device__ void phase_convpool(const Params& p, char* smem) {
  const int tid = threadIdx.x;
  for (int job = blockIdx.x; job < T * 128 / NTHREADS; job += gridDim.x) {
    const int it = job * NTHREADS + tid, t = it >> 7, c0 = (it & 127) * 8, s = t & (S - 1);
    float a[8];
#pragma unroll
    for (int i = 0; i < 8; ++i) a[i] = p.conv_b[c0 + i];
#pragma unroll
    for (int j = 0; j < 5; ++j) { const int ss = s + j - 2; if (ss >= 0 && ss < S) { u32x4 w = *(const u32x4*)(p.ZQK + (size_t)(t + j - 2) * 1024 + c0); const float* cw = p.conv_w + j * 1024 + c0;
        a[0] += cw[0] * bflo(w.x); a[1] += cw[1] * bfhi(w.x); a[2] += cw[2] * bflo(w.y); a[3] += cw[3] * bfhi(w.y); a[4] += cw[4] * bflo(w.z); a[5] += cw[5] * bfhi(w.z); a[6] += cw[6] * bflo(w.w); a[7] += cw[7] * bfhi(w.w); } }
    const float sc = c0 >= 512 ? KSCALE : 1.f;
#pragma unroll
    for (int i = 0; i < 8; ++i) a[i] = siluf(a[i]) * sc;
    u32x4 o; o.x = pack2(a[0], a[1]); o.y = pack2(a[2], a[3]); o.z = pack2(a[4], a[5]); o.w = pack2(a[6], a[7]); *(u32x4*)(p.QK + (size_t)t * 1024 + c0) = o;
  }
  float* ys = (float*)smem;
  float* ws = ys + 64 * 128;
  for (int job = blockIdx.x; job < (T / 64) * 4; job += gridDim.x) {
    const int g = job & 3, t0 = (job >> 2) * 64, win = 2 << g;
    __syncthreads();
    for (int i = tid; i < 128 * 128; i += NTHREADS) ws[i] = p.pool_w[(size_t)g * 16384 + i];
    for (int i = tid; i < 64 * 128; i += NTHREADS) { const int tl = i >> 7, c = i & 127, t = t0 + tl, s = t & (S - 1); const int lo = max(s - win / 2, 0), hi = min(s + win / 2, S);
      float sum = 0.f; for (int q = lo; q < hi; ++q) sum += bf2f(p.ZP[(size_t)(t - s + q) * 512 + g * 128 + c]);
      ys[i] = sum / (float)(hi - lo) - bf2f(p.ZP[(size_t)t * 512 + g * 128 + c]); }
    __syncthreads();
    const int e = tid & 127, tq = tid >> 7; float acc[16];
#pragma unroll
    for (int i = 0; i < 16; ++i) acc[i] = 0.f;
    for (int c = 0; c < 128; ++c) { const float w = ws[c * 128 + e];
#pragma unroll
      for (int i = 0; i < 16; ++i) acc[i] += ys[(tq * 16 + i) * 128 + c] * w; }
    const float psc = p.pool_sc[g * 128 + e];
#pragma unroll
    for (int i = 0; i < 16; ++i) p.CAT[(size_t)(t0 + tq * 16 + i) * 1024 + 512 + g * 128 + e] = f2bf(acc[i] * psc);
  }
}

__device__ void phase_mlstm_naive(const Params& p, char* smem) {
  float* qs = (float*)smem; float* ks = qs + 128; float* nump = ks + 128; float* red = nump + 512;
  const int tid = threadIdx.x, j = tid & 127, qd = tid >> 7;
  for (int job = blockIdx.x; job < 64; job += gridDim.x) {
    const int dir = job >> 5, b = (job >> 2) & 7, h = job & 3;
    float C[32];
#pragma unroll
    for (int d = 0; d < 32; ++d) C[d] = 0.f;
    float n = 0.f, m = 0.f;
    for (int step = 0; step < S; ++step) { const int s = dir ? S - 1 - step : step; const size_t t = (size_t)b * S + s;
      const float li = p.gates[t * 16 + dir * 4 + h], gf = p.gates[t * 16 + 8 + dir * 4 + h];
      const float lf = fminf(gf, 0.f) - log1pf(__expf(-fabsf(gf)));
      __syncthreads();
      if (qd == 0) { qs[j] = bf2f(p.QK[t * 1024 + h * 128 + j]); ks[j] = bf2f(p.QK[t * 1024 + 512 + h * 128 + j]); }
      const float v = bf2f(p.ZV[t * 512 + h * 128 + j]);
      __syncthreads();
      const float mn = fmaxf(lf + m, li), ip = __expf(li - mn), fp = __expf(lf + m - mn); m = mn;
      float num = 0.f;
#pragma unroll
      for (int d = 0; d < 32; ++d) { C[d] = fp * C[d] + ip * ks[qd * 32 + d] * v; num += qs[qd * 32 + d] * C[d]; }
      float dp = 0.f; if (qd == 0) { n = fp * n + ip * ks[j]; dp = qs[j] * n; }
      nump[qd * 128 + j] = num;
      dp = wave_sum(dp); if ((tid & 63) == 0) red[tid >> 6] = dp;
      __syncthreads();
      if (qd == 0) { const float den = red[0] + red[1]; num = nump[j] + nump[128 + j] + nump[256 + j] + nump[384 + j];
        p.HS[((size_t)dir * T + t) * 512 + h * 128 + j] = f2bf(num / fmaxf(fabsf(den), __expf(-mn))); }
    }
    __syncthreads();
  }
}

__device__ void phase_cat(const Params& p) {
  const int tid = threadIdx.x, wid = tid >> 6, lane = tid & 63;
  for (int job = blockIdx.x; job < T * 4 / 8; job += gridDim.x) {
    const int w = job * 8 + wid, t = w >> 2, h = w & 3; const size_t o = (size_t)t * 512 + h * 128 + lane * 2;
    const u32 a = *(const u32*)(p.HS + o), b = *(const u32*)(p.HS + (size_t)T * 512 + o), so = *(const u32*)(p.ZO + o);
    const float a0 = bflo(a) + bflo(b), a1 = bfhi(a) + bfhi(b); const float r = rsqrtf(wave_sum(a0 * a0 + a1 * a1) * (1.f / 128.f) + EPS);
    *(u32*)(p.CAT + (size_t)t * 1024 + h * 128 + lane * 2) = pack2(a0 * r * p.mnorm_g[h * 128 + lane * 2] * bflo(so), a1 * r * p.mnorm_g[h * 128 + lane * 2 + 1] * bfhi(so));
  }
}

__device__ void phase_peer_select_naive(const Params& p, int layer, char* smem) {
  float* kl = (float*)smem;
  float* qsh = kl + 2 * 128 * 129;
  const int tid = threadIdx.x, wid = tid >> 6, lane = tid & 63; float* qs = qsh + wid * 128;
  __syncthreads();
  for (int i = tid; i < 2 * 128 * 128; i += NTHREADS) kl[(i >> 7) * 129 + (i & 127)] = p.peer_keys[(size_t)layer * 32768 + i];
  __syncthreads();
  for (int job = blockIdx.x; job < T; job += gridDim.x) {
    const int t = job, h = wid;
    float ts[2][16]; int ti[2][16];
#pragma unroll
    for (int pp = 0; pp < 2; ++pp) {
      const bf16_t* q = p.QP + (size_t)t * 2048 + h * 256 + pp * 128; const float q0 = bf2f(q[lane]), q1 = bf2f(q[lane + 64]);
      const float r = rsqrtf(wave_sum(q0 * q0 + q1 * q1) * (1.f / 128.f) + EPS); qs[lane] = q0 * r; qs[lane + 64] = q1 * r;
      float s0 = 0.f, s1 = 0.f; const float* k0 = kl + (pp * 128 + lane) * 129; const float* k1 = k0 + 64 * 129;
      for (int c = 0; c < 128; ++c) { const float qc = qs[c]; s0 += qc * k0[c]; s1 += qc * k1[c]; }
#pragma unroll
      for (int k = 0; k < 16; ++k) { const float mx = wave_max(fmaxf(s0, s1)); int cand = (s0 == mx) ? lane : ((s1 == mx) ? lane + 64 : 9999);
        for (int o = 32; o >= 1; o >>= 1) cand = min(cand, __shfl_xor(cand, o));
        ts[pp][k] = mx; ti[pp][k] = cand; if (cand == lane) s0 = -INFINITY; if (cand == lane + 64) s1 = -INFINITY; }
    }
    float cs[4];
#pragma unroll
    for (int r = 0; r < 4; ++r) { const int c = lane * 4 + r; float va = 0.f, vb = 0.f;
#pragma unroll
      for (int k = 0; k < 16; ++k) { if (k == (c >> 4)) va = ts[0][k]; if (k == (c & 15)) vb = ts[1][k]; }
      cs[r] = va + vb; }
    float top[16]; int tix[16];
#pragma unroll
    for (int k = 0; k < 16; ++k) { const float mx = wave_max(fmaxf(fmaxf(cs[0], cs[1]), fmaxf(cs[2], cs[3]))); int cand = 9999;
#pragma unroll
      for (int r = 3; r >= 0; --r) if (cs[r] == mx) cand = lane * 4 + r;
      for (int o = 32; o >= 1; o >>= 1) cand = min(cand, __shfl_xor(cand, o));
      top[k] = mx; tix[k] = cand;
#pragma unroll
      for (int r = 0; r < 4; ++r) if (cand == lane * 4 + r) cs[r] = -INFINITY; }
    float sum = 0.f;
#pragma unroll
    for (int k = 0; k < 16; ++k) sum += __expf(top[k] - top[0]);
    if (lane < 16) { float tv = 0.f; int tc = 0;
#pragma unroll
      for (int k = 0; k < 16; ++k) if (k == lane) { tv = top[k]; tc = tix[k]; }
      int ia = 0, ib = 0;
#pragma unroll
      for (int k = 0; k < 16; ++k) { if (k == (tc >> 4)) ia = ti[0][k]; if (k == (tc & 15)) ib = ti[1][k]; }
      p.pidx[((size_t)t * 8 + h) * 16 + lane] = (bf16_t)(ia * 128 + ib); p.pgate[((size_t)t * 8 + h) * 16 + lane] = __expf(tv - top[0]) / sum; }
  }
}

template <int NEXT>
__device__ void phase_peer_gather(const Params& p, int layer) {
  const int tid = threadIdx.x, wid = tid >> 6, lane = tid & 63;
  const bf16_t* U = p.U + (size_t)layer * 16384 * 1024; const bf16_t* V = p.V + (size_t)layer * 16384 * 1024;
  for (int job = blockIdx.x; job < T / 8; job += gridDim.x) {
    const int t = job * 8 + wid, b = t / S;
    u32x4 h0 = *(const u32x4*)(p.H + (size_t)t * D + lane * 8), h1 = *(const u32x4*)(p.H + (size_t)t * D + 512 + lane * 8);
    float acc[16];
#pragma unroll
    for (int i = 0; i < 16; ++i) acc[i] = 0.f;
    for (int hh = 0; hh < 8; ++hh) {
      int myidx = 0; float mygate = 0.f;
      if (lane < 16) { myidx = p.pidx[((size_t)t * 8 + hh) * 16 + lane]; mygate = p.pgate[((size_t)t * 8 + hh) * 16 + lane]; }
#pragma unroll 1
      for (int half = 0; half < 4; ++half) {
        u32x4 ua[4], ub[4], va[4], vb[4];
#pragma unroll
        for (int k = 0; k < 4; ++k) { const int e = __builtin_amdgcn_readlane(myidx, half * 4 + k); const bf16_t* ur = U + (size_t)e * 1024 + lane * 8; const bf16_t* vr = V + (size_t)e * 1024 + lane * 8;
          ua[k] = *(const u32x4*)ur; ub[k] = *(const u32x4*)(ur + 512); va[k] = *(const u32x4*)vr; vb[k] = *(const u32x4*)(vr + 512); }
        float dp[4];
#pragma unroll
        for (int k = 0; k < 4; ++k) { float a = 0.f;
          a = dot2bf(ua[k].x, h0.x, a);
          a = dot2bf(ua[k].y, h0.y, a);
          a = dot2bf(ua[k].z, h0.z, a);
          a = dot2bf(ua[k].w, h0.w, a);
          a = dot2bf(ub[k].x, h1.x, a);
          a = dot2bf(ub[k].y, h1.y, a);
          a = dot2bf(ub[k].z, h1.z, a);
          a = dot2bf(ub[k].w, h1.w, a);
          dp[k] = wave_sum(a); }
#pragma unroll
        for (int k = 0; k < 4; ++k) { const float z = dp[k]; const float gt = __uint_as_float(__builtin_amdgcn_readlane(__float_as_uint(mygate), half * 4 + k));
          const float cf = gt * 0.5f * z * (1.f + erff(z * 0.70710678118654752f));
          acc[0] += cf * bflo(va[k].x); acc[1] += cf * bfhi(va[k].x); acc[2] += cf * bflo(va[k].y); acc[3] += cf * bfhi(va[k].y);
          acc[4] += cf * bflo(va[k].z); acc[5] += cf * bfhi(va[k].z); acc[6] += cf * bflo(va[k].w); acc[7] += cf * bfhi(va[k].w);
          acc[8] += cf * bflo(vb[k].x); acc[9] += cf * bfhi(vb[k].x); acc[10] += cf * bflo(vb[k].y); acc[11] += cf * bfhi(vb[k].y);
          acc[12] += cf * bflo(vb[k].z); acc[13] += cf * bfhi(vb[k].z); acc[14] += cf * bflo(vb[k].w); acc[15] += cf * bfhi(vb[k].w); }
      }
    }
    const float* g2 = p.mod + (size_t)(layer * 8 + b) * 6144 + 5120;
    float xv[16]; float ss = 0.f;
#pragma unroll
    for (int hf = 0; hf < 2; ++hf) { const int d = hf * 512 + lane * 8; float* xp = p.X + (size_t)t * D + d;
      f32x4 x0 = *(const f32x4*)xp, x1 = *(const f32x4*)(xp + 4), g0 = *(const f32x4*)(g2 + d), g1 = *(const f32x4*)(g2 + d + 4);
      xv[hf * 8 + 0] = x0.x + g0.x * acc[hf * 8 + 0]; xv[hf * 8 + 1] = x0.y + g0.y * acc[hf * 8 + 1]; xv[hf * 8 + 2] = x0.z + g0.z * acc[hf * 8 + 2]; xv[hf * 8 + 3] = x0.w + g0.w * acc[hf * 8 + 3];
      xv[hf * 8 + 4] = x1.x + g1.x * acc[hf * 8 + 4]; xv[hf * 8 + 5] = x1.y + g1.y * acc[hf * 8 + 5]; xv[hf * 8 + 6] = x1.z + g1.z * acc[hf * 8 + 6]; xv[hf * 8 + 7] = x1.w + g1.w * acc[hf * 8 + 7]; }
#pragma unroll
    for (int i = 0; i < 16; ++i) ss += xv[i] * xv[i];
    ss = wave_sum(ss); const float r = rsqrtf(ss * (1.f / D) + EPS);
    if (NEXT == 0) {
      const float* ml = p.mod + (size_t)((layer + 1) * 8 + b) * 6144; const float* gn = p.nmg + (layer + 1) * D;
#pragma unroll
      for (int hf = 0; hf < 2; ++hf) { const int d = hf * 512 + lane * 8; float* xp = p.X + (size_t)t * D + d; float y[8];
#pragma unroll
        for (int i = 0; i < 8; ++i) y[i] = xv[hf * 8 + i] * r * gn[d + i] * (1.f + ml[1024 + d + i]) + ml[d + i];
        *(f32x4*)xp = (f32x4){xv[hf * 8 + 0], xv[hf * 8 + 1], xv[hf * 8 + 2], xv[hf * 8 + 3]}; *(f32x4*)(xp + 4) = (f32x4){xv[hf * 8 + 4], xv[hf * 8 + 5], xv[hf * 8 + 6], xv[hf * 8 + 7]};
        u32x4 w; w.x = pack2(y[0], y[1]); w.y = pack2(y[2], y[3]); w.z = pack2(y[4], y[5]); w.w = pack2(y[6], y[7]); *(u32x4*)(p.H + (size_t)t * D + d) = w; }
    } else {
#pragma unroll
      for (int hf = 0; hf < 2; ++hf) { const int d = hf * 512 + lane * 8; float* xp = p.X + (size_t)t * D + d; float y[8];
#pragma unroll
        for (int i = 0; i < 8; ++i) y[i] = xv[hf * 8 + i] * r * p.final_g[d + i];
        *(f32x4*)xp = (f32x4){y[0], y[1], y[2], y[3]}; *(f32x4*)(xp + 4) = (f32x4){y[4], y[5], y[6], y[7]}; }
    }
  }
}

__device__ void phase_qkrope(const Params& p) {
  const int tid = threadIdx.x, wid = tid >> 6, lane = tid & 63;
  for (int job = blockIdx.x; job < T * 12 / 8; job += gridDim.x) {
    const int w = job * 8 + wid, t = w / 12, hh = w % 12, b = t / S, s = t & (S - 1);
    const u32 raw = *(const u32*)(p.QKV + (size_t)t * 1536 + hh * 128 + lane * 2); float x0 = bflo(raw), x1 = bfhi(raw);
    if (hh < 10) { const float* g = hh < 8 ? p.qn_g : p.kn_g; const float r = rsqrtf(wave_sum(x0 * x0 + x1 * x1) * (1.f / 128.f) + EPS); x0 *= r * g[2 * lane]; x1 *= r * g[2 * lane + 1];
      const int pos = lane < 32 ? (s >> 6) : (s & 63); const int fi = lane & 31; const float fr = exp2f(-(float)(2 * fi) * (13.287712379549449f / 64.f)); const float ang = (float)pos * fr;
      float sn, cs; sincosf(ang, &sn, &cs); const float y0 = x0 * cs - x1 * sn, y1 = x0 * sn + x1 * cs; x0 = y0; x1 = y1; }
    bf16_t* dst = hh < 8 ? p.Qh + (((size_t)b * 8 + hh) * S + s) * 128 : (hh < 10 ? p.Kh + (((size_t)b * 2 + hh - 8) * S + s) * 128 : p.Vh + (((size_t)b * 2 + hh - 10) * S + s) * 128);
    *(u32*)(dst + lane * 2) = pack2(x0, x1);
  }
}

__device__ void phase_attn_naive(const Params& p) {
  const int tid = threadIdx.x, wid = tid >> 6, lane = tid & 63;
  for (int job = blockIdx.x; job < T * 2 / 8; job += gridDim.x) {
    const int w = job * 8 + wid, kv = w & 1, t = w >> 1, b = t / S, s = t & (S - 1);
    float q0[4], q1[4], m[4], l[4], o0[4], o1[4];
#pragma unroll
    for (int g = 0; g < 4; ++g) { const u32 qq = *(const u32*)(p.Qh + (((size_t)b * 8 + kv * 4 + g) * S + s) * 128 + lane * 2); q0[g] = bflo(qq); q1[g] = bfhi(qq); m[g] = -1e30f; l[g] = 0.f; o0[g] = 0.f; o1[g] = 0.f; }
    const bf16_t* Kb = p.Kh + ((size_t)b * 2 + kv) * S * 128; const bf16_t* Vb = p.Vh + ((size_t)b * 2 + kv) * S * 128;
    for (int k = 0; k < S; ++k) { const u32 kk = *(const u32*)(Kb + (size_t)k * 128 + lane * 2), vv = *(const u32*)(Vb + (size_t)k * 128 + lane * 2);
      const float k0 = bflo(kk), k1 = bfhi(kk), v0 = bflo(vv), v1 = bfhi(vv);
#pragma unroll
      for (int g = 0; g < 4; ++g) { const float sc = wave_sum(q0[g] * k0 + q1[g] * k1) * KSCALE; const float mn = fmaxf(m[g], sc), al = __expf(m[g] - mn), pw = __expf(sc - mn);
        l[g] = l[g] * al + pw; o0[g] = o0[g] * al + pw * v0; o1[g] = o1[g] * al + pw * v1; m[g] = mn; } }
#pragma unroll
    for (int g = 0; g < 4; ++g) *(u32*)(p.CAT + (size_t)t * 1024 + (kv * 4 + g) * 128 + lane * 2) = pack2(o0[g] / l[g], o1[g] / l[g]);
  }
}

constexpr int NPH = 19;
__global__ __launch_bounds__(NTHREADS, 2) void mega(Params p, int ph0, int ph1) {
  extern __shared__ __attribute__((aligned(16))) char smem[];
  cg::grid_group grid = cg::this_grid();
#define PHASE(k, call) if (ph0 <= (k) && (k) < ph1) { if ((k) > ph0) grid.sync(); call; }
#if !defined(ONLY_PHASE) || ONLY_PHASE == 0
  PHASE(0, phase_prep(p, smem))
#endif
#if !defined(ONLY_PHASE) || ONLY_PHASE == 1
  PHASE(1, phase_norm<true>(p, p.x, p.nmg, p.mod, 0, 1024, smem))
#endif
#if !defined(ONLY_PHASE) || ONLY_PHASE == 2
  PHASE(2, phase_gemm_fast(p.H, p.Wt_evin, T, 2560, 1024, (EpiEvin{p.ZQK, p.ZV, p.ZO, p.ZP, p.ev_b_in}), smem))
#endif
#if !defined(ONLY_PHASE) || ONLY_PHASE == 3
  PHASE(3, phase_convpool(p, smem))
#endif
#if !defined(ONLY_PHASE) || ONLY_PHASE == 4
  PHASE(4, phase_mlstm_naive(p, smem))
#endif
#if !defined(ONLY_PHASE) || ONLY_PHASE == 5
  PHASE(5, phase_cat(p))
#endif
#if !defined(ONLY_PHASE) || ONLY_PHASE == 6
  PHASE(6, phase_gemm_fast(p.CAT, p.Wt_evout, T, 1024, 1024, (EpiRes{p.x, p.X, p.mod + 2048}), smem))
#endif
#if !defined(ONLY_PHASE) || ONLY_PHASE == 7
  PHASE(7, phase_norm<false>(p, p.X, p.nfg, p.mod, 3072, 4096, smem))
#endif
#if !defined(ONLY_PHASE) || ONLY_PHASE == 8
  PHASE(8, phase_gemm_fast(p.H, p.Wt_q, T, 2048, 1024, (EpiPlain{p.QP, 2048}), smem))
#endif
#if !defined(ONLY_PHASE) || ONLY_PHASE == 9
  PHASE(9, phase_peer_select_naive(p, 0, smem))
#endif
#if !defined(ONLY_PHASE) || ONLY_PHASE == 10
  PHASE(10, phase_peer_gather<0>(p, 0))
#endif
#if !defined(ONLY_PHASE) || ONLY_PHASE == 11
  PHASE(11, phase_gemm_fast(p.H, p.Wt_odin, T, 1536, 1024, (EpiPlain{p.QKV, 1536}), smem))
#endif
#if !defined(ONLY_PHASE) || ONLY_PHASE == 12
  PHASE(12, phase_qkrope(p))
#endif
#if !defined(ONLY_PHASE) || ONLY_PHASE == 13
  PHASE(13, phase_attn_naive(p))
#endif
#if !defined(ONLY_PHASE) || ONLY_PHASE == 14
  PHASE(14, phase_gemm_fast(p.CAT, p.Wt_odout, T, 1024, 1024, (EpiRes{p.X, p.X, p.mod + (size_t)8 * 6144 + 2048}), smem))
#endif
#if !defined(ONLY_PHASE) || ONLY_PHASE == 15
  PHASE(15, phase_norm<false>(p, p.X, p.nfg + D, p.mod + (size_t)8 * 6144, 3072, 4096, smem))
#endif
#if !defined(ONLY_PHASE) || ONLY_PHASE == 16
  PHASE(16, phase_gemm_fast(p.H, p.Wt_q + (size_t)2048 * 1024, T, 2048, 1024, (EpiPlain{p.QP, 2048}), smem))
#endif
#if !defined(ONLY_PHASE) || ONLY_PHASE == 17
  PHASE(17, phase_peer_select_naive(p, 1, smem))
#endif
#if !defined(ONLY_PHASE) || ONLY_PHASE == 18
  PHASE(18, phase_peer_gather<1>(p, 1))
#endif
#undef PHASE
}
}

extern "C" void kernel_launch(void* const* d_in, const int* in_sizes, int n_in, void* d_out, int out_size, void* d_ws, size_t ws_size, hipStream_t stream) {
  (void)in_sizes; (void)n_in; (void)out_size;
  Params p{};
  const float** fin = (const float**)&p;
  for (int i = 0; i < 23; ++i) fin[i] = (const float*)d_in[i];
  p.X = (float*)d_out;
  char* ws = (char*)d_ws; size_t off = 0;
  auto alloc = [&](size_t bytes) { char* q = ws + off; off += (bytes + 255) / 256 * 256; return q; };
  p.U = (bf16_t*)alloc((size_t)2 * 16384 * 1024 * 2); p.V = (bf16_t*)alloc((size_t)2 * 16384 * 1024 * 2);
  p.Wt_evin = (bf16_t*)alloc((size_t)2560 * 1024 * 2); p.Wt_evout = (bf16_t*)alloc((size_t)1024 * 1024 * 2); p.Wt_odin = (bf16_t*)alloc((size_t)1536 * 1024 * 2);
  p.Wt_odout = (bf16_t*)alloc((size_t)1024 * 1024 * 2); p.Wt_q = (bf16_t*)alloc((size_t)2 * 2048 * 1024 * 2); p.keysb = (bf16_t*)alloc((size_t)2 * 2 * 128 * 128 * 2);
  p.Wg = (float*)alloc(16 * 1024 * 4); p.mod = (float*)alloc(2 * 8 * 6144 * 4); p.gates = (float*)alloc((size_t)T * 16 * 4);
  p.pgate = (float*)alloc((size_t)T * 128 * 4); p.pidx = (bf16_t*)alloc((size_t)T * 128 * 2);
  p.H = (bf16_t*)alloc((size_t)T * 1024 * 2); p.CAT = p.H;
  char* big = alloc((size_t)T * 2048 * 2);
  p.ZQK = (bf16_t*)big; p.ZV = (bf16_t*)(big + (size_t)T * 1024 * 2); p.ZO = (bf16_t*)(big + (size_t)T * 1536 * 2); p.HS = (bf16_t*)big; p.QP = (bf16_t*)big; p.QKV = (bf16_t*)big;
  char* big2 = alloc((size_t)T * 1536 * 2);
  p.QK = (bf16_t*)big2; p.ZP = (bf16_t*)(big2 + (size_t)T * 1024 * 2); p.Qh = (bf16_t*)big2; p.Kh = (bf16_t*)(big2 + (size_t)T * 1024 * 2); p.Vh = (bf16_t*)(big2 + (size_t)T * 1280 * 2);
  if (off > ws_size) { fprintf(stderr, "kernel_launch: workspace too small: need %zu have %zu\n", off, ws_size); return; }

  static int grid_blocks = 0;
  if (!grid_blocks) {
    int dev = 0, cus = 0, per_cu = 0; hipGetDevice(&dev); hipDeviceGetAttribute(&cus, hipDeviceAttributeMultiprocessorCount, dev);
    hipFuncSetAttribute((const void*)mega, hipFuncAttributeMaxDynamicSharedMemorySize, SMEM_BYTES);
    hipOccupancyMaxActiveBlocksPerMultiprocessor(&per_cu, mega, NTHREADS, SMEM_BYTES);
    if (per_cu > 1) per_cu = 1;
    grid_blocks = cus * per_cu;
    if (grid_blocks <= 0) { fprintf(stderr, "kernel_launch: occupancy query returned 0\n"); grid_blocks = 0; return; }
  }
#if MULTI_LAUNCH
  for (int ph = 0; ph < NPH; ++ph) hipLaunchKernelGGL(mega, dim3(grid_blocks), dim3(NTHREADS), SMEM_BYTES, stream, p, ph, ph + 1);
#else
  int ph0 = 0, ph1 = NPH; void* args[] = {&p, &ph0, &ph1};
  hipError_t e = hipLaunchCooperativeKernel((const void*)mega, dim3(grid_blocks), dim3(NTHREADS), args, SMEM_BYTES, stream);
  if (e != hipSuccess) fprintf(stderr, "cooperative launch failed: %s (grid %d)\n", hipGetErrorString(e), grid_blocks);
#endif
}
```

```cpp
#include <hip/hip_runtime.h>
#include <hip/hip_cooperative_groups.h>
#include <math.h>
#include <stdint.h>
#include <stdio.h>
namespace cg = cooperative_groups;

#ifndef MULTI_LAUNCH
#define MULTI_LAUNCH 0
#endif

namespace {
typedef unsigned short bf16_t;
typedef unsigned int u32;
typedef float f32x4 __attribute__((ext_vector_type(4)));
typedef u32 u32x4 __attribute__((ext_vector_type(4)));
typedef u32 u32x2 __attribute__((ext_vector_type(2)));
typedef __bf16 bf16x2_t __attribute__((ext_vector_type(2)));

constexpr int D = 1024, NB = 8, S = 4096, T = NB * S;
constexpr int EVEN_IN = 2576;
constexpr float EPS = 1e-6f;
constexpr int NTHREADS = 512;
constexpr int SMEM_BYTES = 144 * 1024;
constexpr float KSCALE = 0.08838834764831845f;

struct Params {
  const float *x, *c, *ada_w, *ada_b, *nmg, *nfg, *ev_w_in, *ev_b_in, *conv_w, *conv_b, *mnorm_g, *pool_w, *pool_sc, *ev_w_out, *od_w_in, *qn_g, *kn_g, *od_w_out,
      *peer_wq, *peer_keys, *peer_u, *peer_v, *final_g;
  float* X;
  bf16_t *Wt_evin, *Wt_evout, *Wt_odin, *Wt_odout, *Wt_q, *keysb, *U, *V;
  float *Wg, *mod, *gates, *pgate;
  bf16_t *H, *ZQK, *ZV, *ZO, *ZP, *QK, *HS, *CAT, *QP, *QKV, *Qh, *Kh, *Vh;
  bf16_t* pidx;
};

__device__ __forceinline__ float siluf(float x) { return x / (1.f + __expf(-x)); }
__device__ __forceinline__ float sigmf(float x) { return 1.f / (1.f + __expf(-x)); }
__device__ __forceinline__ float wave_sum(float v) { for (int o = 32; o >= 1; o >>= 1) v += __shfl_xor(v, o); return v; }
__device__ __forceinline__ float wave_max(float v) { for (int o = 32; o >= 1; o >>= 1) v = fmaxf(v, __shfl_xor(v, o)); return v; }
__device__ __forceinline__ bf16_t f2bf(float f) { u32 u = __float_as_uint(f); u += 0x7FFFu + ((u >> 16) & 1u); return (bf16_t)(u >> 16); }
__device__ __forceinline__ float bf2f(bf16_t b) { return __uint_as_float(((u32)b) << 16); }
__device__ __forceinline__ u32 pack2(float lo, float hi) { return (u32)f2bf(lo) | ((u32)f2bf(hi) << 16); }
__device__ __forceinline__ float bflo(u32 w) { return __uint_as_float(w << 16); }
__device__ __forceinline__ float bfhi(u32 w) { return __uint_as_float(w & 0xFFFF0000u); }
__device__ __forceinline__ float dot2bf(u32 a, u32 b, float c) { return __builtin_amdgcn_fdot2_f32_bf16(__builtin_bit_cast(bf16x2_t, a), __builtin_bit_cast(bf16x2_t, b), c, false); }

constexpr int PJ_MOD = 192, PJ_TR = 2576, PJ_WG = 1, PJ_KEYS = 16, PJ_UV = 16384;
constexpr int PJ_TOTAL = PJ_MOD + PJ_TR + PJ_WG + PJ_KEYS + PJ_UV;

__device__ void prep_transpose_tile(const float* __restrict__ src, int ld, int k0, int n0, bf16_t* __restrict__ dst, int dstK, char* smem) {
  float* tile = (float*)smem;
  const int tid = threadIdx.x;
  __syncthreads();
  for (int pass = 0; pass < 8; ++pass) { int kk = pass * 8 + (tid >> 6), n = tid & 63; tile[kk * 65 + n] = src[(size_t)(k0 + kk) * ld + n0 + n]; }
  __syncthreads();
  int n = tid >> 3, kc = (tid & 7) * 8; u32x4 w;
  w.x = pack2(tile[(kc + 0) * 65 + n], tile[(kc + 1) * 65 + n]); w.y = pack2(tile[(kc + 2) * 65 + n], tile[(kc + 3) * 65 + n]);
  w.z = pack2(tile[(kc + 4) * 65 + n], tile[(kc + 5) * 65 + n]); w.w = pack2(tile[(kc + 6) * 65 + n], tile[(kc + 7) * 65 + n]);
  *(u32x4*)(dst + (size_t)(n0 + n) * dstK + k0 + kc) = w;
}

__device__ void phase_prep(const Params& p, char* smem) {
  const int tid = threadIdx.x;
  for (int job = blockIdx.x; job < PJ_TOTAL; job += gridDim.x) {
    if (job < PJ_MOD) {
      float* cs = (float*)smem; float* red = cs + 8192;
      __syncthreads();
      for (int i = tid; i < 8192; i += NTHREADS) cs[i] = siluf(p.c[i]);
      __syncthreads();
      const int l = job / 96, e0 = (job % 96) * 64, col = tid & 63, dg = tid >> 6;
      float acc[8];
#pragma unroll
      for (int b = 0; b < 8; ++b) acc[b] = 0.f;
      const float* w = p.ada_w + (size_t)l * D * 6144 + e0 + col;
      for (int d = dg * 128; d < dg * 128 + 128; ++d) { float wv = w[(size_t)d * 6144];
#pragma unroll
        for (int b = 0; b < 8; ++b) acc[b] += cs[b * 1024 + d] * wv; }
#pragma unroll
      for (int b = 0; b < 8; ++b) red[(dg * 8 + b) * 64 + col] = acc[b];
      __syncthreads();
      { const int b = tid >> 6; float s = 0.f;
#pragma unroll
        for (int g = 0; g < 8; ++g) s += red[(g * 8 + b) * 64 + col];
        p.mod[(size_t)(l * 8 + b) * 6144 + e0 + col] = s + p.ada_b[l * 6144 + e0 + col]; }
    } else if (job < PJ_MOD + PJ_TR) {
      int tt = job - PJ_MOD;
      if (tt < 640) prep_transpose_tile(p.ev_w_in, EVEN_IN, (tt / 40) * 64, (tt % 40) * 64, p.Wt_evin, 1024, smem);
      else if (tt < 896) { tt -= 640; prep_transpose_tile(p.ev_w_out, 1024, (tt / 16) * 64, (tt % 16) * 64, p.Wt_evout, 1024, smem); }
      else if (tt < 1280) { tt -= 896; prep_transpose_tile(p.od_w_in, 1536, (tt / 24) * 64, (tt % 24) * 64, p.Wt_odin, 1024, smem); }
      else if (tt < 1536) { tt -= 1280; prep_transpose_tile(p.od_w_out, 1024, (tt / 16) * 64, (tt % 16) * 64, p.Wt_odout, 1024, smem); }
      else if (tt < 2560) { tt -= 1536; int l = tt / 512; tt %= 512; prep_transpose_tile(p.peer_wq + (size_t)l * D * 2048, 2048, (tt / 32) * 64, (tt % 32) * 64, p.Wt_q + (size_t)l * 2048 * 1024, 1024, smem); }
      else {   }
    } else if (job < PJ_MOD + PJ_TR + PJ_WG) {
      for (int i = tid; i < 16 * 1024; i += NTHREADS) { int g = i >> 10, d = i & 1023; p.Wg[i] = p.ev_w_in[(size_t)d * EVEN_IN + 2560 + g]; }
    } else if (job < PJ_MOD + PJ_TR + PJ_WG + PJ_KEYS) {
      int j = job - (PJ_MOD + PJ_TR + PJ_WG);
      for (int i = tid; i < 4096; i += NTHREADS) p.keysb[j * 4096 + i] = f2bf(p.peer_keys[j * 4096 + i]);
    } else {
      int j = job - (PJ_MOD + PJ_TR + PJ_WG + PJ_KEYS); const float* src = j < 8192 ? p.peer_u : p.peer_v; bf16_t* dst = j < 8192 ? p.U : p.V; j &= 8191;
      size_t o = (size_t)j * 4096 + tid * 8; f32x4 a = *(const f32x4*)(src + o), b = *(const f32x4*)(src + o + 4);
      u32x4 w; w.x = pack2(a.x, a.y); w.y = pack2(a.z, a.w); w.z = pack2(b.x, b.y); w.w = pack2(b.z, b.w); *(u32x4*)(dst + o) = w;
    }
  }
}

template <bool WITH_GATES>
__device__ void phase_norm(const Params& p, const float* __restrict__ xin, const float* __restrict__ g, const float* __restrict__ modl, int sh_off, int sc_off, char* smem) {
  const int tid = threadIdx.x, wid = tid >> 6, lane = tid & 63;
  float* wg = (float*)smem;
  if (WITH_GATES) { __syncthreads(); for (int i = tid; i < 16 * 1024; i += NTHREADS) wg[i] = p.Wg[i]; __syncthreads(); }
  for (int job = blockIdx.x; job < T / 8; job += gridDim.x) {
    const int t = job * 8 + wid, b = t / S;
    f32x4 v[4]; float ss = 0.f;
#pragma unroll
    for (int i = 0; i < 4; ++i) { v[i] = *(const f32x4*)(xin + (size_t)t * D + i * 256 + lane * 4); ss += v[i].x * v[i].x + v[i].y * v[i].y + v[i].z * v[i].z + v[i].w * v[i].w; }
    ss = wave_sum(ss); const float r = rsqrtf(ss * (1.f / D) + EPS);
    const float* shp = modl + (size_t)b * 6144 + sh_off; const float* scp = modl + (size_t)b * 6144 + sc_off;
#pragma unroll
    for (int i = 0; i < 4; ++i) { const int d = i * 256 + lane * 4; f32x4 gg = *(const f32x4*)(g + d), s1 = *(const f32x4*)(scp + d), s0 = *(const f32x4*)(shp + d);
      v[i].x = v[i].x * r * gg.x * (1.f + s1.x) + s0.x; v[i].y = v[i].y * r * gg.y * (1.f + s1.y) + s0.y; v[i].z = v[i].z * r * gg.z * (1.f + s1.z) + s0.z; v[i].w = v[i].w * r * gg.w * (1.f + s1.w) + s0.w;
      u32x2 w; w.x = pack2(v[i].x, v[i].y); w.y = pack2(v[i].z, v[i].w); *(u32x2*)(p.H + (size_t)t * D + d) = w; }
    if (WITH_GATES) {
      float myg = 0.f;
#pragma unroll 2
      for (int gi = 0; gi < 16; ++gi) { float a = 0.f;
#pragma unroll
        for (int i = 0; i < 4; ++i) { f32x4 w4 = *(const f32x4*)(wg + gi * 1024 + i * 256 + lane * 4); a += v[i].x * w4.x + v[i].y * w4.y + v[i].z * w4.z + v[i].w * w4.w; }
        a = wave_sum(a); if (lane == gi) myg = a; }
      if (lane < 16) p.gates[(size_t)t * 16 + lane] = myg + p.ev_b_in[2560 + lane];
    }
  }
}

enum { EPI_EVIN = 0, EPI_EVOUT = 1, EPI_PEERQ = 2, EPI_ODIN = 3, EPI_ODOUT = 4 };
template <int EPI> __device__ __forceinline__ void epi_store(const Params& p, int layer, int m, int n, float acc) {
  if (EPI == EPI_EVIN) { float v = acc + p.ev_b_in[n];
    if (n < 1024) p.ZQK[(size_t)m * 1024 + n] = f2bf(v); else if (n < 1536) p.ZV[(size_t)m * 512 + n - 1024] = f2bf(v);
    else if (n < 2048) p.ZO[(size_t)m * 512 + n - 1536] = f2bf(sigmf(v)); else p.ZP[(size_t)m * 512 + n - 2048] = f2bf(v); }
  else if (EPI == EPI_EVOUT) { int b = m / S; p.X[(size_t)m * D + n] = p.x[(size_t)m * D + n] + p.mod[(size_t)(0 * 8 + b) * 6144 + 2048 + n] * acc; }
  else if (EPI == EPI_PEERQ) p.QP[(size_t)m * 2048 + n] = f2bf(acc);
  else if (EPI == EPI_ODIN) p.QKV[(size_t)m * 1536 + n] = f2bf(acc);
  else if (EPI == EPI_ODOUT) { int b = m / S; p.X[(size_t)m * D + n] += p.mod[(size_t)(1 * 8 + b) * 6144 + 2048 + n] * acc; }
}
template <int EPI> __device__ void phase_gemm_naive(const Params& p, int layer, const bf16_t* __restrict__ A, const bf16_t* __restrict__ Bt, int M, int N, int K, char* smem) {
  float* As = (float*)smem; float* Bs = As + 32 * 132;
  const int tid = threadIdx.x, tx = tid & 15, ty = tid >> 4; const int nN = N / 64, njobs = (M / 128) * nN;
  for (int job = blockIdx.x; job < njobs; job += gridDim.x) {
    const int m0 = (job / nN) * 128, n0 = (job % nN) * 64; float acc[4][4];
#pragma unroll
    for (int i = 0; i < 4; ++i)
#pragma unroll
      for (int j = 0; j < 4; ++j) acc[i][j] = 0.f;
    for (int k0 = 0; k0 < K; k0 += 32) {
      __syncthreads();
      { int row = tid >> 2, kc = (tid & 3) * 8; u32x4 w = *(const u32x4*)(A + (size_t)(m0 + row) * K + k0 + kc);
        As[(kc + 0) * 132 + row] = bflo(w.x); As[(kc + 1) * 132 + row] = bfhi(w.x); As[(kc + 2) * 132 + row] = bflo(w.y); As[(kc + 3) * 132 + row] = bfhi(w.y);
        As[(kc + 4) * 132 + row] = bflo(w.z); As[(kc + 5) * 132 + row] = bfhi(w.z); As[(kc + 6) * 132 + row] = bflo(w.w); As[(kc + 7) * 132 + row] = bfhi(w.w); }
      if (tid < 256) { int row = tid >> 2, kc = (tid & 3) * 8; u32x4 w = *(const u32x4*)(Bt + (size_t)(n0 + row) * K + k0 + kc);
        Bs[(kc + 0) * 68 + row] = bflo(w.x); Bs[(kc + 1) * 68 + row] = bfhi(w.x); Bs[(kc + 2) * 68 + row] = bflo(w.y); Bs[(kc + 3) * 68 + row] = bfhi(w.y);
        Bs[(kc + 4) * 68 + row] = bflo(w.z); Bs[(kc + 5) * 68 + row] = bfhi(w.z); Bs[(kc + 6) * 68 + row] = bflo(w.w); Bs[(kc + 7) * 68 + row] = bfhi(w.w); }
      __syncthreads();
#pragma unroll 8
      for (int kk = 0; kk < 32; ++kk) { f32x4 a = *(const f32x4*)(As + kk * 132 + ty * 4), b = *(const f32x4*)(Bs + kk * 68 + tx * 4);
        acc[0][0] += a.x * b.x; acc[0][1] += a.x * b.y; acc[0][2] += a.x * b.z; acc[0][3] += a.x * b.w;
        acc[1][0] += a.y * b.x; acc[1][1] += a.y * b.y; acc[1][2] += a.y * b.z; acc[1][3] += a.y * b.w;
        acc[2][0] += a.z * b.x; acc[2][1] += a.z * b.y; acc[2][2] += a.z * b.z; acc[2][3] += a.z * b.w;
        acc[3][0] += a.w * b.x; acc[3][1] += a.w * b.y; acc[3][2] += a.w * b.z; acc[3][3] += a.w * b.w; }
    }
#pragma unroll
    for (int i = 0; i < 4; ++i)
#pragma unroll
      for (int j = 0; j < 4; ++j) epi_store<EPI>(p, layer, m0 + ty * 4 + i, n0 + tx * 4 + j, acc[i][j]);
  }
}

namespace pg8 {
#define PG8_LAS __attribute__((address_space(3)))
typedef unsigned short bf16_t;
typedef short bf16x8 __attribute__((ext_vector_type(8)));
typedef float f32x4 __attribute__((ext_vector_type(4)));
typedef unsigned u32x4 __attribute__((ext_vector_type(4)));
constexpr int BM = 256, BK = 64, HALF = 128, HTB = HALF * BK * 2  , STAGE_BYTES = 8 * HTB, NXCD = 8, WGM = 8;

__host__ __device__ __forceinline__ int lds_byte(int r, int c) { const int st = (r >> 4) * 2 + (c >> 5), rr = r & 15, cc = c & 31, ob = rr * 64 + cc * 2; return st * 1024 + (ob ^ (((ob >> 9) & 1) << 5)); }
__host__ __device__ __forceinline__ void stage_rc(int b, int& R, int& C) { const int st = b / 1024, sb = b % 1024, swz = sb ^ (((sb >> 9) & 1) << 5); R = (st >> 1) * 16 + swz / 64; C = (st & 1) * 32 + (swz % 64) / 2; }
__host__ __device__ __forceinline__ int perm32(int rho) { const int n = rho >> 4, i = rho & 15; return 8 * (i >> 2) + 4 * n + (i & 3); }

struct Unit { int pm, pn; };
struct Gemm { const bf16_t* A; const bf16_t* Bt; int M, N, K; };

struct StaticOrder {
    int nM, nN, nwg, G, c;
    __host__ __device__ void init(int M, int N, int G_, int c_) { nM = M / BM; nN = N / BM; nwg = nM * nN; G = G_; c = c_; }
    __host__ __device__ bool next(int i, Unit& u) const {
        const long L = (long)i * G + c; if (L >= nwg) return false;
        int wgid = (int)L; { const int q = nwg / NXCD, r = nwg % NXCD, xcd = wgid % NXCD, off = wgid / NXCD; wgid = (xcd < r ? xcd * (q + 1) : r * (q + 1) + (xcd - r) * q) + off; }
        const int nig = WGM * nN, gid = wgid / nig, fm = gid * WGM, gsz = (nM - fm) < WGM ? (nM - fm) : WGM;
        u.pm = fm + ((wgid % nig) % gsz); u.pn = (wgid % nig) / gsz; return true;
    }
    __device__ __forceinline__ void a_ready(const Unit&) const {}
    __device__ __forceinline__ void done(const Unit&) const {}
};
__device__ __forceinline__ unsigned cvt_pk_bf16(float lo, float hi) { unsigned r; asm volatile("v_cvt_pk_bf16_f32 %0, %1, %2" : "=v"(r) : "v"(lo), "v"(hi)); return r; }
template <class Epi, class Sched, bool STAMP = false>
__device__ __forceinline__ void gemm_phase(PG8_LAS unsigned char* lds, const Gemm g, const Sched& S, const Epi& E, unsigned long long* stamps) {
    const int tid = threadIdx.x, wid = __builtin_amdgcn_readfirstlane(tid >> 6), lane = tid & 63, wr = wid >> 2, wc = wid & 3, fr = lane & 15, fq = lane >> 4;
    const int K = g.K, nt = K / BK;
    int ts_lo = 0, ts_hi = 0, nts = 0; const unsigned long long rt_entry = STAMP ? (unsigned long long)wall_clock64() : 0ull;
#define PG8_STAMP() do { if (STAMP && wid == 0 && nts < 64) { const unsigned long long _c = (unsigned long long)clock64(); \
        ts_lo = (lane == nts) ? (int)(unsigned)_c : ts_lo; ts_hi = (lane == nts) ? (int)(unsigned)(_c >> 32) : ts_hi; ++nts; } } while (0)
    PG8_STAMP();
    unsigned voffA[2], voffB[2];
#pragma unroll
    for (int i = 0; i < 2; ++i) { int R, C; stage_rc(tid * 16 + i * 8192, R, C); const int Rb = Epi::PERM ? ((R & ~31) + perm32(R & 31)) : R;
        voffA[i] = (unsigned)(R * K + C) * 2u; voffB[i] = (unsigned)(Rb * K + C) * 2u; }
    const size_t kstep = (size_t)(BK * 2);
    const size_t hstep = (size_t)HALF * K * 2;
    const size_t tstep = 2 * hstep;
    const unsigned ldsw = (unsigned)wid * 1024u;
    const int aoff = lds_byte(wr * 64 + fr, fq * 8), boff = lds_byte(wc * 32 + fr, fq * 8);
#define PG8_SA(b, h) (((b) * 2 + (h)) * HTB)
#define PG8_SB(b, h) ((4 + (b) * 2 + (h)) * HTB)
#define PG8_STAGE(bufoff, gbase, voff) do { _Pragma("unroll") for (int _i = 0; _i < 2; ++_i) \
        __builtin_amdgcn_global_load_lds((const unsigned*)((const char*)(gbase) + (voff)[_i]), (PG8_LAS unsigned*)(lds + (bufoff) + ldsw + _i * 8192), 16, 0, 0); } while (0)
#define PG8_LDA(dst, b, h) do { _Pragma("unroll") for (int m = 0; m < 4; ++m) _Pragma("unroll") for (int k = 0; k < 2; ++k) dst[m][k] = *(const PG8_LAS bf16x8*)(lds + PG8_SA(b, h) + aoff + m * 2048 + k * 1024); } while (0)
#define PG8_LDB(dst, b, h) do { _Pragma("unroll") for (int n = 0; n < 2; ++n) _Pragma("unroll") for (int k = 0; k < 2; ++k) dst[n][k] = *(const PG8_LAS bf16x8*)(lds + PG8_SB(b, h) + boff + n * 2048 + k * 1024); } while (0)
#define PG8_MMA(ai, bj, At, Bt) do { __builtin_amdgcn_s_setprio(1); _Pragma("unroll") for (int m = 0; m < 4; ++m) _Pragma("unroll") for (int n = 0; n < 2; ++n) _Pragma("unroll") for (int k = 0; k < 2; ++k) \
        acc[ai][bj][m][n] = __builtin_amdgcn_mfma_f32_16x16x32_bf16(Bt[n][k], At[m][k], acc[ai][bj][m][n], 0, 0, 0); __builtin_amdgcn_s_setprio(0); } while (0)
#define PG8_WAIT_V(n) asm volatile("s_waitcnt vmcnt(" #n ")" ::: "memory")
#define PG8_WAIT_L(n) asm volatile("s_waitcnt lgkmcnt(" #n ")" ::: "memory")
#define PG8_BAR __builtin_amdgcn_s_barrier()
#define PG8_SCHED __builtin_amdgcn_sched_barrier(0)
    Unit cur, nxt; int ui = 0;
    if (!S.next(0, cur)) return;
    f32x4 acc[2][2][4][2];
#pragma unroll
    for (int a = 0; a < 2; ++a)
#pragma unroll
        for (int b = 0; b < 2; ++b)
#pragma unroll
            for (int m = 0; m < 4; ++m)
#pragma unroll
                for (int n = 0; n < 2; ++n) acc[a][b][m][n] = (f32x4){0.f, 0.f, 0.f, 0.f};
    bf16x8 At[4][2], B0[2][2], B1[2][2];
    const char* cA = (const char*)g.A + (size_t)cur.pm * tstep; const char* cB = (const char*)g.Bt + (size_t)cur.pn * tstep;
    S.a_ready(cur);
    PG8_STAGE(PG8_SB(0, 0), cB, voffB); PG8_STAGE(PG8_SA(0, 0), cA, voffA); PG8_STAGE(PG8_SB(0, 1), cB + hstep, voffB); PG8_STAGE(PG8_SA(0, 1), cA + hstep, voffA);
    if (wr == 1) PG8_BAR;
    PG8_WAIT_V(4); PG8_BAR;
    PG8_STAGE(PG8_SB(1, 0), cB + kstep, voffB); PG8_STAGE(PG8_SA(1, 0), cA + kstep, voffA); PG8_STAGE(PG8_SB(1, 1), cB + hstep + kstep, voffB);
    PG8_WAIT_V(6); PG8_BAR;
    PG8_STAMP();
    for (;;) {
        const bool has_next = S.next(ui + 1, nxt);
        const char* nA = has_next ? (const char*)g.A + (size_t)nxt.pm * tstep : cA; const char* nB = has_next ? (const char*)g.Bt + (size_t)nxt.pn * tstep : cB;
        for (int t = 0; t < nt; t += 2) {
            const bool last = (t == nt - 2);
            const char* a1 = cA + (size_t)(t + 1) * kstep;
            const char* a2 = last ? nA : cA + (size_t)(t + 2) * kstep; const char* b2 = last ? nB : cB + (size_t)(t + 2) * kstep;
            const char* a3 = a2 + kstep; const char* b3 = b2 + kstep;
            if (last && has_next) S.a_ready(nxt);
            PG8_LDB(B0, 0, 0); PG8_SCHED; PG8_LDA(At, 0, 0); PG8_STAGE(PG8_SA(1, 1), a1 + hstep, voffA);
            PG8_WAIT_L(8); PG8_BAR; PG8_WAIT_L(0); PG8_MMA(0, 0, At, B0); PG8_BAR; PG8_SCHED;
            PG8_LDB(B1, 0, 1); PG8_STAGE(PG8_SB(0, 0), b2, voffB);
            PG8_BAR; PG8_WAIT_L(0); PG8_MMA(0, 1, At, B1); PG8_BAR;
            PG8_LDA(At, 0, 1); PG8_STAGE(PG8_SA(0, 0), a2, voffA);
            PG8_BAR; PG8_WAIT_L(0); PG8_MMA(1, 0, At, B0); PG8_BAR; PG8_SCHED;
            PG8_STAGE(PG8_SB(0, 1), b2 + hstep, voffB);
            PG8_WAIT_V(6); PG8_BAR; PG8_MMA(1, 1, At, B1); PG8_BAR;
            PG8_LDB(B0, 1, 0); PG8_SCHED; PG8_LDA(At, 1, 0); PG8_STAGE(PG8_SA(0, 1), a2 + hstep, voffA);
            PG8_WAIT_L(8); PG8_BAR; PG8_WAIT_L(0); PG8_MMA(0, 0, At, B0); PG8_BAR; PG8_SCHED;
            PG8_LDB(B1, 1, 1); PG8_STAGE(PG8_SB(1, 0), b3, voffB);
            PG8_BAR; PG8_WAIT_L(0); PG8_MMA(0, 1, At, B1); PG8_BAR;
            PG8_LDA(At, 1, 1); PG8_STAGE(PG8_SA(1, 0), a3, voffA);
            PG8_BAR; PG8_WAIT_L(0); PG8_MMA(1, 0, At, B0); PG8_BAR; PG8_SCHED;
            PG8_STAGE(PG8_SB(1, 1), b3 + hstep, voffB);
            PG8_WAIT_V(6); PG8_BAR; PG8_MMA(1, 1, At, B1); PG8_BAR;
        }
        PG8_STAMP();
        if constexpr (!Epi::AFTER_DRAIN) { E(acc, cur, wr, wc, fr, fq); S.done(cur); }
        PG8_STAMP();
        if (!has_next) break;
#pragma unroll
        for (int a = 0; a < 2; ++a)
#pragma unroll
            for (int b = 0; b < 2; ++b)
#pragma unroll
                for (int m = 0; m < 4; ++m)
#pragma unroll
                    for (int n = 0; n < 2; ++n) acc[a][b][m][n] = (f32x4){0.f, 0.f, 0.f, 0.f};
        cur = nxt; cA = nA; cB = nB; ++ui;
    }
    PG8_WAIT_V(0);
    if (wr == 0) PG8_BAR;
    PG8_BAR;
    if constexpr (Epi::AFTER_DRAIN) { E.fused(acc, cur, wr, wc, fr, fq, lds, wid, lane); S.done(cur); }
    PG8_STAMP();
    if (STAMP && wid == 0) { stamps[lane] = lane < nts ? (((unsigned long long)(unsigned)ts_hi << 32) | (unsigned)ts_lo) : 0ull;
        if (lane == 62) stamps[62] = rt_entry; if (lane == 63) stamps[63] = (unsigned long long)wall_clock64(); }
#undef PG8_STAMP
#undef PG8_SA
#undef PG8_SB
#undef PG8_STAGE
#undef PG8_LDA
#undef PG8_LDB
#undef PG8_MMA
#undef PG8_WAIT_V
#undef PG8_WAIT_L
#undef PG8_BAR
#undef PG8_SCHED
}
}

struct EpiEvin {
  static constexpr bool PERM = true, AFTER_DRAIN = false;
  bf16_t *ZQK, *ZV, *ZO, *ZP; const float* bias;
  __device__ __forceinline__ void operator()(const pg8::f32x4 (&acc)[2][2][4][2], const pg8::Unit& u, int wr, int wc, int fr, int fq) const {
    const int row0 = u.pm * 256 + wr * 64 + fr, ct = u.pn * 256;
    bf16_t* base; int ldc, cl; bool sig = false;
    if (ct < 1024) { base = ZQK; ldc = 1024; cl = ct; } else if (ct < 1536) { base = ZV; ldc = 512; cl = ct - 1024; } else if (ct < 2048) { base = ZO; ldc = 512; cl = ct - 1536; sig = true; } else { base = ZP; ldc = 512; cl = ct - 2048; }
    const int cofs = wc * 32 + 8 * fq;
    pg8::f32x4 bv[2][2];
#pragma unroll
    for (int bj = 0; bj < 2; ++bj)
#pragma unroll
      for (int n = 0; n < 2; ++n) bv[bj][n] = *(const pg8::f32x4*)(bias + ct + cofs + bj * 128 + 4 * n);
#pragma unroll
    for (int ai = 0; ai < 2; ++ai)
#pragma unroll
      for (int m = 0; m < 4; ++m) { bf16_t* rowp = base + (size_t)(row0 + ai * 128 + m * 16) * ldc + cl + cofs;
#pragma unroll
        for (int bj = 0; bj < 2; ++bj) { pg8::f32x4 v0 = acc[ai][bj][m][0] + bv[bj][0], v1 = acc[ai][bj][m][1] + bv[bj][1];
          if (sig) {
#pragma unroll
            for (int j = 0; j < 4; ++j) { v0[j] = sigmf(v0[j]); v1[j] = sigmf(v1[j]); } }
          pg8::u32x4 w; w.x = pg8::cvt_pk_bf16(v0[0], v0[1]); w.y = pg8::cvt_pk_bf16(v0[2], v0[3]); w.z = pg8::cvt_pk_bf16(v1[0], v1[1]); w.w = pg8::cvt_pk_bf16(v1[2], v1[3]);
          *(pg8::u32x4*)(rowp + bj * 128) = w; } }
  }
};
struct EpiPlain {
  static constexpr bool PERM = true, AFTER_DRAIN = false;
  bf16_t* out; int ldc;
  __device__ __forceinline__ void operator()(const pg8::f32x4 (&acc)[2][2][4][2], const pg8::Unit& u, int wr, int wc, int fr, int fq) const {
    const int row0 = u.pm * 256 + wr * 64 + fr, col0 = u.pn * 256 + wc * 32 + 8 * fq;
#pragma unroll
    for (int ai = 0; ai < 2; ++ai)
#pragma unroll
      for (int m = 0; m < 4; ++m) { bf16_t* rowp = out + (size_t)(row0 + ai * 128 + m * 16) * ldc + col0;
#pragma unroll
        for (int bj = 0; bj < 2; ++bj) { const pg8::f32x4 v0 = acc[ai][bj][m][0], v1 = acc[ai][bj][m][1];
          pg8::u32x4 w; w.x = pg8::cvt_pk_bf16(v0[0], v0[1]); w.y = pg8::cvt_pk_bf16(v0[2], v0[3]); w.z = pg8::cvt_pk_bf16(v1[0], v1[1]); w.w = pg8::cvt_pk_bf16(v1[2], v1[3]);
          *(pg8::u32x4*)(rowp + bj * 128) = w; } }
  }
};
struct EpiRes {
  static constexpr bool PERM = false, AFTER_DRAIN = false;
  const float* xin; float* X; const float* gate;
  __device__ __forceinline__ void operator()(const pg8::f32x4 (&acc)[2][2][4][2], const pg8::Unit& u, int wr, int wc, int fr, int fq) const {
    const int row0 = u.pm * 256 + wr * 64 + fr, col0 = u.pn * 256 + wc * 32 + 4 * fq; const float* gb = gate + (size_t)((u.pm * 256) / S) * 6144;
    pg8::f32x4 gv[2][2];
#pragma unroll
    for (int bj = 0; bj < 2; ++bj)
#pragma unroll
      for (int n = 0; n < 2; ++n) gv[bj][n] = *(const pg8::f32x4*)(gb + col0 + bj * 128 + n * 16);
#pragma unroll
    for (int ai = 0; ai < 2; ++ai)
#pragma unroll
      for (int m = 0; m < 4; ++m) { const size_t off = (size_t)(row0 + ai * 128 + m * 16) * 1024 + col0;
#pragma unroll
        for (int bj = 0; bj < 2; ++bj)
#pragma unroll
          for (int n = 0; n < 2; ++n) { const pg8::f32x4 xi = *(const pg8::f32x4*)(xin + off + bj * 128 + n * 16); *(pg8::f32x4*)(X + off + bj * 128 + n * 16) = xi + gv[bj][n] * acc[ai][bj][m][n]; }
        asm volatile("" ::: "memory"); }
  }
};
template <class Epi> __device__ __forceinline__ void phase_gemm_fast(const bf16_t* A, const bf16_t* Bt, int M, int N, int K, const Epi& E, char* smem) {
  pg8::Gemm g; g.A = A; g.Bt = Bt; g.M = M; g.N = N; g.K = K;
  pg8::StaticOrder So; So.init(M, N, (int)gridDim.x, (int)blockIdx.x);
  pg8::gemm_phase<Epi, pg8::StaticOrder, false>((PG8_LAS unsigned char*)smem, g, So, E, nullptr);
}

__device__ void phase_convpool(const Params& p, char* smem) {
  const int tid = threadIdx.x;
  for (int job = blockIdx.x; job < T * 128 / NTHREADS; job += gridDim.x) {
    const int it = job * NTHREADS + tid, t = it >> 7, c0 = (it & 127) * 8, s = t & (S - 1);
    float a[8];
#pragma unroll
    for (int i = 0; i < 8; ++i) a[i] = p.conv_b[c0 + i];
#pragma unroll
    for (int j = 0; j < 5; ++j) { const int ss = s + j - 2; if (ss >= 0 && ss < S) { u32x4 w = *(const u32x4*)(p.ZQK + (size_t)(t + j - 2) * 1024 + c0); const float* cw = p.conv_w + j * 1024 + c0;
        a[0] += cw[0] * bflo(w.x); a[1] += cw[1] * bfhi(w.x); a[2] += cw[2] * bflo(w.y); a[3] += cw[3] * bfhi(w.y); a[4] += cw[4] * bflo(w.z); a[5] += cw[5] * bfhi(w.z); a[6] += cw[6] * bflo(w.w); a[7] += cw[7] * bfhi(w.w); } }
    const float sc = c0 >= 512 ? KSCALE : 1.f;
#pragma unroll
    for (int i = 0; i < 8; ++i) a[i] = siluf(a[i]) * sc;
    u32x4 o; o.x = pack2(a[0], a[1]); o.y = pack2(a[2], a[3]); o.z = pack2(a[4], a[5]); o.w = pack2(a[6], a[7]); *(u32x4*)(p.QK + (size_t)t * 1024 + c0) = o;
  }
  float* ys = (float*)smem;
  float* ws = ys + 64 * 128;
  for (int job = blockIdx.x; job < (T / 64) * 4; job += gridDim.x) {
    const int g = job & 3, t0 = (job >> 2) * 64, win = 2 << g;
    __syncthreads();
    for (int i = tid; i < 128 * 128; i += NTHREADS) ws[i] = p.pool_w[(size_t)g * 16384 + i];
    for (int i = tid; i < 64 * 128; i += NTHREADS) { const int tl = i >> 7, c = i & 127, t = t0 + tl, s = t & (S - 1); const int lo = max(s - win / 2, 0), hi = min(s + win / 2, S);
      float sum = 0.f; for (int q = lo; q < hi; ++q) sum += bf2f(p.ZP[(size_t)(t - s + q) * 512 + g * 128 + c]);
      ys[i] = sum / (float)(hi - lo) - bf2f(p.ZP[(size_t)t * 512 + g * 128 + c]); }
    __syncthreads();
    const int e = tid & 127, tq = tid >> 7; float acc[16];
#pragma unroll
    for (int i = 0; i < 16; ++i) acc[i] = 0.f;
    for (int c = 0; c < 128; ++c) { const float w = ws[c * 128 + e];
#pragma unroll
      for (int i = 0; i < 16; ++i) acc[i] += ys[(tq * 16 + i) * 128 + c] * w; }
    const float psc = p.pool_sc[g * 128 + e];
#pragma unroll
    for (int i = 0; i < 16; ++i) p.CAT[(size_t)(t0 + tq * 16 + i) * 1024 + 512 + g * 128 + e] = f2bf(acc[i] * psc);
  }
}

__device__ void phase_mlstm_naive(const Params& p, char* smem) {
  float* qs = (float*)smem; float* ks = qs + 128; float* nump = ks + 128; float* red = nump + 512;
  const int tid = threadIdx.x, j = tid & 127, qd = tid >> 7;
  for (int job = blockIdx.x; job < 64; job += gridDim.x) {
    const int dir = job >> 5, b = (job >> 2) & 7, h = job & 3;
    float C[32];
#pragma unroll
    for (int d = 0; d < 32; ++d) C[d] = 0.f;
    float n = 0.f, m = 0.f;
    for (int step = 0; step < S; ++step) { const int s = dir ? S - 1 - step : step; const size_t t = (size_t)b * S + s;
      const float li = p.gates[t * 16 + dir * 4 + h], gf = p.gates[t * 16 + 8 + dir * 4 + h];
      const float lf = fminf(gf, 0.f) - log1pf(__expf(-fabsf(gf)));
      __syncthreads();
      if (qd == 0) { qs[j] = bf2f(p.QK[t * 1024 + h * 128 + j]); ks[j] = bf2f(p.QK[t * 1024 + 512 + h * 128 + j]); }
      const float v = bf2f(p.ZV[t * 512 + h * 128 + j]);
      __syncthreads();
      const float mn = fmaxf(lf + m, li), ip = __expf(li - mn), fp = __expf(lf + m - mn); m = mn;
      float num = 0.f;
#pragma unroll
      for (int d = 0; d < 32; ++d) { C[d] = fp * C[d] + ip * ks[qd * 32 + d] * v; num += qs[qd * 32 + d] * C[d]; }
      float dp = 0.f; if (qd == 0) { n = fp * n + ip * ks[j]; dp = qs[j] * n; }
      nump[qd * 128 + j] = num;
      dp = wave_sum(dp); if ((tid & 63) == 0) red[tid >> 6] = dp;
      __syncthreads();
      if (qd == 0) { const float den = red[0] + red[1]; num = nump[j] + nump[128 + j] + nump[256 + j] + nump[384 + j];
        p.HS[((size_t)dir * T + t) * 512 + h * 128 + j] = f2bf(num / fmaxf(fabsf(den), __expf(-mn))); }
    }
    __syncthreads();
  }
}

__device__ void phase_cat(const Params& p) {
  const int tid = threadIdx.x, wid = tid >> 6, lane = tid & 63;
  for (int job = blockIdx.x; job < T * 4 / 8; job += gridDim.x) {
    const int w = job * 8 + wid, t = w >> 2, h = w & 3; const size_t o = (size_t)t * 512 + h * 128 + lane * 2;
    const u32 a = *(const u32*)(p.HS + o), b = *(const u32*)(p.HS + (size_t)T * 512 + o), so = *(const u32*)(p.ZO + o);
    const float a0 = bflo(a) + bflo(b), a1 = bfhi(a) + bfhi(b); const float r = rsqrtf(wave_sum(a0 * a0 + a1 * a1) * (1.f / 128.f) + EPS);
    *(u32*)(p.CAT + (size_t)t * 1024 + h * 128 + lane * 2) = pack2(a0 * r * p.mnorm_g[h * 128 + lane * 2] * bflo(so), a1 * r * p.mnorm_g[h * 128 + lane * 2 + 1] * bfhi(so));
  }
}

__device__ void phase_peer_select_naive(const Params& p, int layer, char* smem) {
  float* kl = (float*)smem;
  float* qsh = kl + 2 * 128 * 129;
  const int tid = threadIdx.x, wid = tid >> 6, lane = tid & 63; float* qs = qsh + wid * 128;
  __syncthreads();
  for (int i = tid; i < 2 * 128 * 128; i += NTHREADS) kl[(i >> 7) * 129 + (i & 127)] = p.peer_keys[(size_t)layer * 32768 + i];
  __syncthreads();
  for (int job = blockIdx.x; job < T; job += gridDim.x) {
    const int t = job, h = wid;
    float ts[2][16]; int ti[2][16];
#pragma unroll
    for (int pp = 0; pp < 2; ++pp) {
      const bf16_t* q = p.QP + (size_t)t * 2048 + h * 256 + pp * 128; const float q0 = bf2f(q[lane]), q1 = bf2f(q[lane + 64]);
      const float r = rsqrtf(wave_sum(q0 * q0 + q1 * q1) * (1.f / 128.f) + EPS); qs[lane] = q0 * r; qs[lane + 64] = q1 * r;
      float s0 = 0.f, s1 = 0.f; const float* k0 = kl + (pp * 128 + lane) * 129; const float* k1 = k0 + 64 * 129;
      for (int c = 0; c < 128; ++c) { const float qc = qs[c]; s0 += qc * k0[c]; s1 += qc * k1[c]; }
#pragma unroll
      for (int k = 0; k < 16; ++k) { const float mx = wave_max(fmaxf(s0, s1)); int cand = (s0 == mx) ? lane : ((s1 == mx) ? lane + 64 : 9999);
        for (int o = 32; o >= 1; o >>= 1) cand = min(cand, __shfl_xor(cand, o));
        ts[pp][k] = mx; ti[pp][k] = cand; if (cand == lane) s0 = -INFINITY; if (cand == lane + 64) s1 = -INFINITY; }
    }
    float cs[4];
#pragma unroll
    for (int r = 0; r < 4; ++r) { const int c = lane * 4 + r; float va = 0.f, vb = 0.f;
#pragma unroll
      for (int k = 0; k < 16; ++k) { if (k == (c >> 4)) va = ts[0][k]; if (k == (c & 15)) vb = ts[1][k]; }
      cs[r] = va + vb; }
    float top[16]; int tix[16];
#pragma unroll
    for (int k = 0; k < 16; ++k) { const float mx = wave_max(fmaxf(fmaxf(cs[0], cs[1]), fmaxf(cs[2], cs[3]))); int cand = 9999;
#pragma unroll
      for (int r = 3; r >= 0; --r) if (cs[r] == mx) cand = lane * 4 + r;
      for (int o = 32; o >= 1; o >>= 1) cand = min(cand, __shfl_xor(cand, o));
      top[k] = mx; tix[k] = cand;
#pragma unroll
      for (int r = 0; r < 4; ++r) if (cand == lane * 4 + r) cs[r] = -INFINITY; }
    float sum = 0.f;
#pragma unroll
    for (int k = 0; k < 16; ++k) sum += __expf(top[k] - top[0]);
    if (lane < 16) { float tv = 0.f; int tc = 0;
#pragma unroll
      for (int k = 0; k < 16; ++k) if (k == lane) { tv = top[k]; tc = tix[k]; }
      int ia = 0, ib = 0;
#pragma unroll
      for (int k = 0; k < 16; ++k) { if (k == (tc >> 4)) ia = ti[0][k]; if (k == (tc & 15)) ib = ti[1][k]; }
      p.pidx[((size_t)t * 8 + h) * 16 + lane] = (bf16_t)(ia * 128 + ib); p.pgate[((size_t)t * 8 + h) * 16 + lane] = __expf(tv - top[0]) / sum; }
  }
}

template <int NEXT>
__device__ void phase_peer_gather(const Params& p, int layer) {
  const int tid = threadIdx.x, wid = tid >> 6, lane = tid & 63;
  const bf16_t* U = p.U + (size_t)layer * 16384 * 1024; const bf16_t* V = p.V + (size_t)layer * 16384 * 1024;
  for (int job = blockIdx.x; job < T / 8; job += gridDim.x) {
    const int t = job * 8 + wid, b = t / S;
    u32x4 h0 = *(const u32x4*)(p.H + (size_t)t * D + lane * 8), h1 = *(const u32x4*)(p.H + (size_t)t * D + 512 + lane * 8);
    float acc[16];
#pragma unroll
    for (int i = 0; i < 16; ++i) acc[i] = 0.f;
    for (int hh = 0; hh < 8; ++hh) {
      int myidx = 0; float mygate = 0.f;
      if (lane < 16) { myidx = p.pidx[((size_t)t * 8 + hh) * 16 + lane]; mygate = p.pgate[((size_t)t * 8 + hh) * 16 + lane]; }
#pragma unroll 1
      for (int half = 0; half < 4; ++half) {
        u32x4 ua[4], ub[4], va[4], vb[4];
#pragma unroll
        for (int k = 0; k < 4; ++k) { const int e = __builtin_amdgcn_readlane(myidx, half * 4 + k); const bf16_t* ur = U + (size_t)e * 1024 + lane * 8; const bf16_t* vr = V + (size_t)e * 1024 + lane * 8;
          ua[k] = *(const u32x4*)ur; ub[k] = *(const u32x4*)(ur + 512); va[k] = *(const u32x4*)vr; vb[k] = *(const u32x4*)(vr + 512); }
        float dp[4];
#pragma unroll
        for (int k = 0; k < 4; ++k) { float a = 0.f;
          a = dot2bf(ua[k].x, h0.x, a);
          a = dot2bf(ua[k].y, h0.y, a);
          a = dot2bf(ua[k].z, h0.z, a);
          a = dot2bf(ua[k].w, h0.w, a);
          a = dot2bf(ub[k].x, h1.x, a);
          a = dot2bf(ub[k].y, h1.y, a);
          a = dot2bf(ub[k].z, h1.z, a);
          a = dot2bf(ub[k].w, h1.w, a);
          dp[k] = wave_sum(a); }
#pragma unroll
        for (int k = 0; k < 4; ++k) { const float z = dp[k]; const float gt = __uint_as_float(__builtin_amdgcn_readlane(__float_as_uint(mygate), half * 4 + k));
          const float cf = gt * 0.5f * z * (1.f + erff(z * 0.70710678118654752f));
          acc[0] += cf * bflo(va[k].x); acc[1] += cf * bfhi(va[k].x); acc[2] += cf * bflo(va[k].y); acc[3] += cf * bfhi(va[k].y);
          acc[4] += cf * bflo(va[k].z); acc[5] += cf * bfhi(va[k].z); acc[6] += cf * bflo(va[k].w); acc[7] += cf * bfhi(va[k].w);
          acc[8] += cf * bflo(vb[k].x); acc[9] += cf * bfhi(vb[k].x); acc[10] += cf * bflo(vb[k].y); acc[11] += cf * bfhi(vb[k].y);
          acc[12] += cf * bflo(vb[k].z); acc[13] += cf * bfhi(vb[k].z); acc[14] += cf * bflo(vb[k].w); acc[15] += cf * bfhi(vb[k].w); }
      }
    }
    const float* g2 = p.mod + (size_t)(layer * 8 + b) * 6144 + 5120;
    float xv[16]; float ss = 0.f;
#pragma unroll
    for (int hf = 0; hf < 2; ++hf) { const int d = hf * 512 + lane * 8; float* xp = p.X + (size_t)t * D + d;
      f32x4 x0 = *(const f32x4*)xp, x1 = *(const f32x4*)(xp + 4), g0 = *(const f32x4*)(g2 + d), g1 = *(const f32x4*)(g2 + d + 4);
      xv[hf * 8 + 0] = x0.x + g0.x * acc[hf * 8 + 0]; xv[hf * 8 + 1] = x0.y + g0.y * acc[hf * 8 + 1]; xv[hf * 8 + 2] = x0.z + g0.z * acc[hf * 8 + 2]; xv[hf * 8 + 3] = x0.w + g0.w * acc[hf * 8 + 3];
      xv[hf * 8 + 4] = x1.x + g1.x * acc[hf * 8 + 4]; xv[hf * 8 + 5] = x1.y + g1.y * acc[hf * 8 + 5]; xv[hf * 8 + 6] = x1.z + g1.z * acc[hf * 8 + 6]; xv[hf * 8 + 7] = x1.w + g1.w * acc[hf * 8 + 7]; }
#pragma unroll
    for (int i = 0; i < 16; ++i) ss += xv[i] * xv[i];
    ss = wave_sum(ss); const float r = rsqrtf(ss * (1.f / D) + EPS);
    if (NEXT == 0) {
      const float* ml = p.mod + (size_t)((layer + 1) * 8 + b) * 6144; const float* gn = p.nmg + (layer + 1) * D;
#pragma unroll
      for (int hf = 0; hf < 2; ++hf) { const int d = hf * 512 + lane * 8; float* xp = p.X + (size_t)t * D + d; float y[8];
#pragma unroll
        for (int i = 0; i < 8; ++i) y[i] = xv[hf * 8 + i] * r * gn[d + i] * (1.f + ml[1024 + d + i]) + ml[d + i];
        *(f32x4*)xp = (f32x4){xv[hf * 8 + 0], xv[hf * 8 + 1], xv[hf * 8 + 2], xv[hf * 8 + 3]}; *(f32x4*)(xp + 4) = (f32x4){xv[hf * 8 + 4], xv[hf * 8 + 5], xv[hf * 8 + 6], xv[hf * 8 + 7]};
        u32x4 w; w.x = pack2(y[0], y[1]); w.y = pack2(y[2], y[3]); w.z = pack2(y[4], y[5]); w.w = pack2(y[6], y[7]); *(u32x4*)(p.H + (size_t)t * D + d) = w; }
    } else {
#pragma unroll
      for (int hf = 0; hf < 2; ++hf) { const int d = hf * 512 + lane * 8; float* xp = p.X + (size_t)t * D + d; float y[8];
#pragma unroll
        for (int i = 0; i < 8; ++i) y[i] = xv[hf * 8 + i] * r * p.final_g[d + i];
        *(f32x4*)xp = (f32x4){y[0], y[1], y[2], y[3]}; *(f32x4*)(xp + 4) = (f32x4){y[4], y[5], y[6], y[7]}; }
    }
  }
}

__device__ void phase_qkrope(const Params& p) {
  const int tid = threadIdx.x, wid = tid >> 6, lane = tid & 63;
  for (int job = blockIdx.x; job < T * 12 / 8; job += gridDim.x) {
    const int w = job * 8 + wid, t = w / 12, hh = w % 12, b = t / S, s = t & (S - 1);
    const u32 raw = *(const u32*)(p.QKV + (size_t)t * 1536 + hh * 128 + lane * 2); float x0 = bflo(raw), x1 = bfhi(raw);
    if (hh < 10) { const float* g = hh < 8 ? p.qn_g : p.kn_g; const float r = rsqrtf(wave_sum(x0 * x0 + x1 * x1) * (1.f / 128.f) + EPS); x0 *= r * g[2 * lane]; x1 *= r * g[2 * lane + 1];
      const int pos = lane < 32 ? (s >> 6) : (s & 63); const int fi = lane & 31; const float fr = exp2f(-(float)(2 * fi) * (13.287712379549449f / 64.f)); const float ang = (float)pos * fr;
      float sn, cs; sincosf(ang, &sn, &cs); const float y0 = x0 * cs - x1 * sn, y1 = x0 * sn + x1 * cs; x0 = y0; x1 = y1; }
    bf16_t* dst = hh < 8 ? p.Qh + (((size_t)b * 8 + hh) * S + s) * 128 : (hh < 10 ? p.Kh + (((size_t)b * 2 + hh - 8) * S + s) * 128 : p.Vh + (((size_t)b * 2 + hh - 10) * S + s) * 128);
    *(u32*)(dst + lane * 2) = pack2(x0, x1);
  }
}

__device__ void phase_attn_naive(const Params& p) {
  const int tid = threadIdx.x, wid = tid >> 6, lane = tid & 63;
  for (int job = blockIdx.x; job < T * 2 / 8; job += gridDim.x) {
    const int w = job * 8 + wid, kv = w & 1, t = w >> 1, b = t / S, s = t & (S - 1);
    float q0[4], q1[4], m[4], l[4], o0[4], o1[4];
#pragma unroll
    for (int g = 0; g < 4; ++g) { const u32 qq = *(const u32*)(p.Qh + (((size_t)b * 8 + kv * 4 + g) * S + s) * 128 + lane * 2); q0[g] = bflo(qq); q1[g] = bfhi(qq); m[g] = -1e30f; l[g] = 0.f; o0[g] = 0.f; o1[g] = 0.f; }
    const bf16_t* Kb = p.Kh + ((size_t)b * 2 + kv) * S * 128; const bf16_t* Vb = p.Vh + ((size_t)b * 2 + kv) * S * 128;
    for (int k = 0; k < S; ++k) { const u32 kk = *(const u32*)(Kb + (size_t)k * 128 + lane * 2), vv = *(const u32*)(Vb + (size_t)k * 128 + lane * 2);
      const float k0 = bflo(kk), k1 = bfhi(kk), v0 = bflo(vv), v1 = bfhi(vv);
#pragma unroll
      for (int g = 0; g < 4; ++g) { const float sc = wave_sum(q0[g] * k0 + q1[g] * k1) * KSCALE; const float mn = fmaxf(m[g], sc), al = __expf(m[g] - mn), pw = __expf(sc - mn);
        l[g] = l[g] * al + pw; o0[g] = o0[g] * al + pw * v0; o1[g] = o1[g] * al + pw * v1; m[g] = mn; } }
#pragma unroll
    for (int g = 0; g < 4; ++g) *(u32*)(p.CAT + (size_t)t * 1024 + (kv * 4 + g) * 128 + lane * 2) = pack2(o0[g] / l[g], o1[g] / l[g]);
  }
}

namespace att {
using bf16 = unsigned short;
constexpr int   D = 128, NW = 8, QBLK = 32, KVBLK = 64;
constexpr float SCALE = 0.088388347648318440f;
constexpr float THR = 8.f;
constexpr int SDEPTH = 2;
constexpr int LDQ = 128, LDK = 128, LDO = 1024;
constexpr size_t SHM_V = KVBLK * D * 2, SHM_K = KVBLK * D * 2, SHM_ATTN = 2 * SHM_V + 2 * SHM_K + NW * 64 * 4;
using bf16x8 = __attribute__((ext_vector_type(8))) short;
using s16x4  = __attribute__((ext_vector_type(4))) short;
using f32x16 = __attribute__((ext_vector_type(16))) float;
using f32x8  = __attribute__((ext_vector_type(8))) float;
using u32x4  = __attribute__((ext_vector_type(4))) unsigned;
#define KSWZ(row, colB) ((row) * 256 + ((colB) ^ (((row) & 7) << 4)))
#define SBAR() __builtin_amdgcn_sched_barrier(0)
__device__ __forceinline__ int crow(int r, int hi) { return (r & 3) + 8 * (r >> 2) + 4 * hi; }
__device__ __forceinline__ unsigned cvtpk(float lo, float hi) {
  unsigned r; asm volatile("v_cvt_pk_bf16_f32 %0, %1, %2" : "=v"(r) : "v"(lo), "v"(hi)); return r;
}
template <typename TIn> struct Stage;
template <> struct Stage<bf16>  { using T = bf16x8;
  __device__ static __forceinline__ T ld8(const bf16* p) { return *reinterpret_cast<const bf16x8*>(p); }
  __device__ static __forceinline__ bf16x8 tobf(T x) { return x; } };
template <> struct Stage<float> { using T = f32x8;
  __device__ static __forceinline__ T ld8(const float* p) { return *reinterpret_cast<const f32x8*>(p); }
  __device__ static __forceinline__ bf16x8 tobf(T x) {
    u32x4 w = {cvtpk(x[0], x[1]), cvtpk(x[2], x[3]), cvtpk(x[4], x[5]), cvtpk(x[6], x[7])}; return *reinterpret_cast<bf16x8*>(&w); } };

__device__ __forceinline__ void partialSM(f32x16& p0, f32x16& p1, float& m_reg, float& mn, float& alpha) {
  constexpr float C = SCALE * 1.4426950408889634f;
  float pmax = p0[0]; for (int r = 1; r < 16; ++r) pmax = fmaxf(pmax, p0[r]); for (int r = 0; r < 16; ++r) pmax = fmaxf(pmax, p1[r]);
  { auto rr = __builtin_amdgcn_permlane32_swap(__float_as_uint(pmax), __float_as_uint(pmax), false, false);
    pmax = fmaxf(__uint_as_float(rr[0]), __uint_as_float(rr[1])); }
  if (__builtin_expect(__all(pmax - m_reg <= THR / SCALE), 1)) { mn = m_reg; alpha = 1.f; }
  else { mn = fmaxf(m_reg, pmax); alpha = __builtin_amdgcn_exp2f((m_reg - mn) * C); m_reg = mn; }
  float mnC = -mn * C;
  for (int r = 0; r < 16; ++r) p0[r] = fmaf(p0[r], C, mnC); for (int r = 0; r < 16; ++r) p1[r] = fmaf(p1[r], C, mnC);
  for (int r = 0; r < 16; ++r) p0[r] = __builtin_amdgcn_exp2f(p0[r]);
}
__device__ __forceinline__ void finishSM(f32x16& p0, f32x16& p1, float alpha, float& l_reg, bf16x8& pa0, bf16x8& pa1, bf16x8& pa2, bf16x8& pa3) {
  for (int r = 0; r < 16; ++r) p1[r] = __builtin_amdgcn_exp2f(p1[r]);
  float ps = 0; for (int r = 0; r < 16; ++r) ps += p0[r]; for (int r = 0; r < 16; ++r) ps += p1[r];
  { auto rr = __builtin_amdgcn_permlane32_swap(__float_as_uint(ps), __float_as_uint(ps), false, false);
    ps = __uint_as_float(rr[0]) + __uint_as_float(rr[1]); }
  l_reg = l_reg * alpha + ps;
#define PK4(P, BASE, OUT) do { unsigned a0 = cvtpk(P[BASE + 0], P[BASE + 1]), a1 = cvtpk(P[BASE + 2], P[BASE + 3]);   \
    unsigned b0 = cvtpk(P[BASE + 4], P[BASE + 5]), b1 = cvtpk(P[BASE + 6], P[BASE + 7]);                              \
    auto r0 = __builtin_amdgcn_permlane32_swap(a0, b0, false, false); auto r1 = __builtin_amdgcn_permlane32_swap(a1, b1, false, false); \
    u32x4 w = {r0[0], r1[0], r0[1], r1[1]}; OUT = *reinterpret_cast<bf16x8*>(&w); } while (0)
  PK4(p0, 0, pa0); PK4(p0, 8, pa1); PK4(p1, 0, pa2); PK4(p1, 8, pa3);
#undef PK4
}
__device__ __forceinline__ void qkt(f32x16& p0, f32x16& p1, const bf16* Ks, const bf16x8* qr, int r32, int hi) {
  p0 = f32x16{}; p1 = f32x16{};
  for (int d0 = 0; d0 < 8; ++d0) { int cb = (d0 * 16 + hi * 8) * 2;
    bf16x8 b0 = *reinterpret_cast<const bf16x8*>((const char*)Ks + KSWZ(r32, cb));
    bf16x8 b1 = *reinterpret_cast<const bf16x8*>((const char*)Ks + KSWZ(32 + r32, cb));
    p0 = __builtin_amdgcn_mfma_f32_32x32x16_bf16(b0, qr[d0], p0, 0, 0, 0);
    p1 = __builtin_amdgcn_mfma_f32_32x32x16_bf16(b1, qr[d0], p1, 0, 0, 0); }
}
__device__ __forceinline__ int v_st(int k, int c) { const int kk = (k & ~0xC) | ((k & 4) << 1) | ((k & 8) >> 1); return ((kk >> 3) * 4 + (c >> 5)) * 512 + ((kk & 7) * 32 + (c & 31)) * 2; }
__device__ __forceinline__ int v_rd_base(int lane) { return ((lane & 3) << 3) | (((lane >> 2) & 3) << 6) | (((lane >> 4) & 1) << 5) | (((lane >> 5) & 1) << 8); }
constexpr int v_rd_off(int d0, int ks, int half) { return d0 * 512 + ks * 4096 + half * 2048; }
template <int OFF> __device__ __forceinline__ s16x4 tr_read(int vb) {
  s16x4 r; asm volatile("ds_read_b64_tr_b16 %0, %1 offset:%2" : "=&v"(r) : "v"(vb), "i"(OFF) : "memory"); return r;
}
template <int D0> __device__ __forceinline__ void pv_one(f32x16& od, int vb, bf16x8 pa0, bf16x8 pa1, bf16x8 pa2, bf16x8 pa3) {
  const s16x4 l0 = tr_read<v_rd_off(D0, 0, 0)>(vb), h0 = tr_read<v_rd_off(D0, 0, 1)>(vb), l1 = tr_read<v_rd_off(D0, 1, 0)>(vb), h1 = tr_read<v_rd_off(D0, 1, 1)>(vb);
  const s16x4 l2 = tr_read<v_rd_off(D0, 2, 0)>(vb), h2 = tr_read<v_rd_off(D0, 2, 1)>(vb), l3 = tr_read<v_rd_off(D0, 3, 0)>(vb), h3 = tr_read<v_rd_off(D0, 3, 1)>(vb);
  asm volatile("s_waitcnt lgkmcnt(0)" ::: "memory"); SBAR();
#define PK(L, H) (bf16x8){L[0], L[1], L[2], L[3], H[0], H[1], H[2], H[3]}
  od = __builtin_amdgcn_mfma_f32_32x32x16_bf16(pa0, PK(l0, h0), od, 0, 0, 0);
  od = __builtin_amdgcn_mfma_f32_32x32x16_bf16(pa1, PK(l1, h1), od, 0, 0, 0);
  od = __builtin_amdgcn_mfma_f32_32x32x16_bf16(pa2, PK(l2, h2), od, 0, 0, 0);
  od = __builtin_amdgcn_mfma_f32_32x32x16_bf16(pa3, PK(l3, h3), od, 0, 0, 0);
#undef PK
}
__device__ __forceinline__ void pv_d0(f32x16* o, int vb, bf16x8 pa0, bf16x8 pa1, bf16x8 pa2, bf16x8 pa3) {
  pv_one<0>(o[0], vb, pa0, pa1, pa2, pa3); pv_one<1>(o[1], vb, pa0, pa1, pa2, pa3); pv_one<2>(o[2], vb, pa0, pa1, pa2, pa3); pv_one<3>(o[3], vb, pa0, pa1, pa2, pa3);
}

template <typename TQ>
__device__ __forceinline__ void attn_dense_body(const TQ* __restrict__ Qb, const bf16* __restrict__ Kh, const bf16* __restrict__ Vh,
                                                bf16* __restrict__ Ob, int seq, char* lds) {
  using St = Stage<bf16>; using SQ = Stage<TQ>;
  int tid_ = threadIdx.x; asm volatile("" : "+v"(tid_)); const int tid = tid_, wid = tid >> 6, lane = tid & 63, r32 = lane & 31, hi = lane >> 5;
  bf16* V_lds = (bf16*)lds; bf16* K_lds = (bf16*)(lds + 2 * SHM_V);
  float* ws = (float*)(lds + 2 * SHM_V + 2 * SHM_K) + wid * 64; float* li_l = ws; float* al_l = ws + 32;
  float m_reg = -1e30f, l_reg = 0; f32x16 o[4] = {}; bf16x8 qr[8];
  const TQ* Qw = Qb + (long)(wid * QBLK + r32) * LDQ + hi * 8;
#pragma unroll
  for (int d0 = 0; d0 < 8; ++d0) qr[d0] = SQ::tobf(SQ::ld8(Qw + d0 * 16));
  const int sr = tid >> 4, sc = (tid & 15) * 8, vst0 = v_st(sr, sc), vst1 = v_st(32 + sr, sc);
  const int vb0 = (int)(uintptr_t)V_lds + v_rd_base(lane);
  struct { typename St::T vs0, vs1, ks0, ks1; } sr_[SDEPTH];
#define SLOAD(i, k0) do { sr_[i].vs0 = St::ld8(&Vh[(long)((k0) + sr) * LDK + sc]); sr_[i].vs1 = St::ld8(&Vh[(long)((k0) + 32 + sr) * LDK + sc]); \
    sr_[i].ks0 = St::ld8(&Kh[(long)((k0) + sr) * LDK + sc]); sr_[i].ks1 = St::ld8(&Kh[(long)((k0) + 32 + sr) * LDK + sc]); } while (0)
#define SWRITE(b, i) do { *(bf16x8*)((char*)V_lds + (b) * SHM_V + vst0) = St::tobf(sr_[i].vs0);          \
    *(bf16x8*)((char*)V_lds + (b) * SHM_V + vst1) = St::tobf(sr_[i].vs1); int kc = sc * 2;               \
    *(bf16x8*)((char*)K_lds + (b) * SHM_K + KSWZ(sr, kc)) = St::tobf(sr_[i].ks0);                       \
    *(bf16x8*)((char*)K_lds + (b) * SHM_K + KSWZ(32 + sr, kc)) = St::tobf(sr_[i].ks1); } while (0)
#define SWAIT() do { if constexpr (SDEPTH == 2) asm volatile("s_waitcnt vmcnt(4)" ::: "memory"); else asm volatile("s_waitcnt vmcnt(0)" ::: "memory"); } while (0)
#define RESC(a) do { if (__any((a) < 1.f)) { if (hi == 0) al_l[r32] = (a); asm volatile("s_waitcnt lgkmcnt(0)" ::: "memory"); \
    for (int d = 0; d < 4; ++d) for (int r = 0; r < 16; ++r) o[d][r] *= al_l[crow(r, hi)]; } } while (0)
  f32x16 pA0, pA1, pB0, pB1; float mnA, mnB, alA, alB; bf16x8 pa0, pa1, pa2, pa3; const int NT = seq / KVBLK;
  constexpr int SE = 0, SO = SDEPTH - 1;
  SLOAD(SE, 0); asm volatile("s_waitcnt vmcnt(0)" ::: "memory"); SWRITE(0, SE); __syncthreads();
  qkt(pA0, pA1, K_lds, qr, r32, hi); partialSM(pA0, pA1, m_reg, mnA, alA);
  SLOAD(SO, KVBLK); if constexpr (SDEPTH == 2) { if (2 < NT) SLOAD(SE, 2 * KVBLK); }
  SWAIT(); SWRITE(1, SO); __syncthreads();
  for (int j = 1; j + 1 < NT; j += 2) {
    SBAR(); qkt(pB0, pB1, (bf16*)((char*)K_lds + SHM_K), qr, r32, hi);
    finishSM(pA0, pA1, alA, l_reg, pa0, pa1, pa2, pa3); SBAR();
    SLOAD(SO, (j + SDEPTH) * KVBLK); SBAR();
    pv_d0(o, vb0, pa0, pa1, pa2, pa3); partialSM(pB0, pB1, m_reg, mnB, alB);
    __syncthreads(); SWAIT(); SWRITE(0, SE);
    RESC(alB); __syncthreads();
    SBAR(); qkt(pA0, pA1, K_lds, qr, r32, hi);
    finishSM(pB0, pB1, alB, l_reg, pa0, pa1, pa2, pa3); SBAR();
    if (SDEPTH == 1 || j + 3 < NT) SLOAD(SE, (j + 1 + SDEPTH) * KVBLK); SBAR();
    pv_d0(o, vb0 + (int)SHM_V, pa0, pa1, pa2, pa3); partialSM(pA0, pA1, m_reg, mnA, alA);
    __syncthreads(); SWAIT(); SWRITE(1, SO);
    RESC(alA); __syncthreads();
  }
  SBAR(); qkt(pB0, pB1, (bf16*)((char*)K_lds + SHM_K), qr, r32, hi);
  finishSM(pA0, pA1, alA, l_reg, pa0, pa1, pa2, pa3); SBAR();
  pv_d0(o, vb0, pa0, pa1, pa2, pa3); partialSM(pB0, pB1, m_reg, mnB, alB);
  __syncthreads(); RESC(alB);
  finishSM(pB0, pB1, alB, l_reg, pa0, pa1, pa2, pa3); SBAR();
  pv_d0(o, vb0 + (int)SHM_V, pa0, pa1, pa2, pa3);
  if (hi == 0) li_l[r32] = l_reg; asm volatile("s_waitcnt lgkmcnt(0)" ::: "memory");
  float rli[16];
#pragma unroll
  for (int r = 0; r < 16; ++r) rli[r] = __builtin_amdgcn_rcpf(li_l[crow(r, hi)]);
  __syncthreads();
  bf16* Ol = (bf16*)lds + wid * (QBLK * D);
#pragma unroll
  for (int r = 0; r < 16; ++r) { const int orow = crow(r, hi);
#pragma unroll
    for (int d0 = 0; d0 < 4; ++d0) { const float v = o[d0][r] * rli[r]; unsigned u = __float_as_uint(v); u += 0x7FFFu + ((u >> 16) & 1u); Ol[orow * D + d0 * 32 + r32] = (bf16)(u >> 16); } }
  asm volatile("s_waitcnt lgkmcnt(0)" ::: "memory");
#pragma unroll
  for (int i = 0; i < 8; ++i) { const int row = i * 4 + (lane >> 4), ch = (lane & 15) * 8;
    const u32x4 v = *reinterpret_cast<const u32x4*>(Ol + row * D + ch);
    *reinterpret_cast<u32x4*>(Ob + (long)(wid * QBLK + row) * LDO + ch) = v; }
  __syncthreads();
#undef SLOAD
#undef SWRITE
#undef SWAIT
#undef RESC
}

}

__device__ void phase_attn(const Params& p, char* smem) {
  const int G = (int)gridDim.x, c = (int)blockIdx.x;
  for (int i = 0; i * G + c < 1024; ++i) {
    int pair, j;
    if (G == 256) { pair = 2 * (c & 7) + (i >> 1); j = (i & 1) * 32 + (c >> 3); } else { const int L = i * G + c; pair = L >> 6; j = L & 63; }
    const int b = pair >> 1, kv = pair & 1, qb = j >> 2, g = j & 3, h = kv * 4 + g;
    const bf16_t* Qb = p.Qh + (((size_t)b * 8 + h) * S + qb * 256) * 128; const bf16_t* Kp = p.Kh + ((size_t)b * 2 + kv) * S * 128; const bf16_t* Vp = p.Vh + ((size_t)b * 2 + kv) * S * 128;
    bf16_t* Ob = p.CAT + ((size_t)b * S + qb * 256) * 1024 + h * 128;
    att::attn_dense_body<att::bf16>(Qb, Kp, Vp, Ob, S, smem);
  }
}

constexpr int NPH = 19;
__global__ __launch_bounds__(NTHREADS, 2) void mega(Params p, int ph0, int ph1) {
  extern __shared__ __attribute__((aligned(16))) char smem[];
  cg::grid_group grid = cg::this_grid();
#define PHASE(k, call) if (ph0 <= (k) && (k) < ph1) { if ((k) > ph0) grid.sync(); call; }
#if !defined(ONLY_PHASE) || ONLY_PHASE == 0
  PHASE(0, phase_prep(p, smem))
#endif
#if !defined(ONLY_PHASE) || ONLY_PHASE == 1
  PHASE(1, phase_norm<true>(p, p.x, p.nmg, p.mod, 0, 1024, smem))
#endif
#if !defined(ONLY_PHASE) || ONLY_PHASE == 2
  PHASE(2, phase_gemm_fast(p.H, p.Wt_evin, T, 2560, 1024, (EpiEvin{p.ZQK, p.ZV, p.ZO, p.ZP, p.ev_b_in}), smem))
#endif
#if !defined(ONLY_PHASE) || ONLY_PHASE == 3
  PHASE(3, phase_convpool(p, smem))
#endif
#if !defined(ONLY_PHASE) || ONLY_PHASE == 4
  PHASE(4, phase_mlstm_naive(p, smem))
#endif
#if !defined(ONLY_PHASE) || ONLY_PHASE == 5
  PHASE(5, phase_cat(p))
#endif
#if !defined(ONLY_PHASE) || ONLY_PHASE == 6
  PHASE(6, phase_gemm_fast(p.CAT, p.Wt_evout, T, 1024, 1024, (EpiRes{p.x, p.X, p.mod + 2048}), smem))
#endif
#if !defined(ONLY_PHASE) || ONLY_PHASE == 7
  PHASE(7, phase_norm<false>(p, p.X, p.nfg, p.mod, 3072, 4096, smem))
#endif
#if !defined(ONLY_PHASE) || ONLY_PHASE == 8
  PHASE(8, phase_gemm_fast(p.H, p.Wt_q, T, 2048, 1024, (EpiPlain{p.QP, 2048}), smem))
#endif
#if !defined(ONLY_PHASE) || ONLY_PHASE == 9
  PHASE(9, phase_peer_select_naive(p, 0, smem))
#endif
#if !defined(ONLY_PHASE) || ONLY_PHASE == 10
  PHASE(10, phase_peer_gather<0>(p, 0))
#endif
#if !defined(ONLY_PHASE) || ONLY_PHASE == 11
  PHASE(11, phase_gemm_fast(p.H, p.Wt_odin, T, 1536, 1024, (EpiPlain{p.QKV, 1536}), smem))
#endif
#if !defined(ONLY_PHASE) || ONLY_PHASE == 12
  PHASE(12, phase_qkrope(p))
#endif
#if !defined(ONLY_PHASE) || ONLY_PHASE == 13
  PHASE(13, phase_attn(p, smem))
#endif
#if !defined(ONLY_PHASE) || ONLY_PHASE == 14
  PHASE(14, phase_gemm_fast(p.CAT, p.Wt_odout, T, 1024, 1024, (EpiRes{p.X, p.X, p.mod + (size_t)8 * 6144 + 2048}), smem))
#endif
#if !defined(ONLY_PHASE) || ONLY_PHASE == 15
  PHASE(15, phase_norm<false>(p, p.X, p.nfg + D, p.mod + (size_t)8 * 6144, 3072, 4096, smem))
#endif
#if !defined(ONLY_PHASE) || ONLY_PHASE == 16
  PHASE(16, phase_gemm_fast(p.H, p.Wt_q + (size_t)2048 * 1024, T, 2048, 1024, (EpiPlain{p.QP, 2048}), smem))
#endif
#if !defined(ONLY_PHASE) || ONLY_PHASE == 17
  PHASE(17, phase_peer_select_naive(p, 1, smem))
#endif
#if !defined(ONLY_PHASE) || ONLY_PHASE == 18
  PHASE(18, phase_peer_gather<1>(p, 1))
#endif
#undef PHASE
}
}

extern "C" void kernel_launch(void* const* d_in, const int* in_sizes, int n_in, void* d_out, int out_size, void* d_ws, size_t ws_size, hipStream_t stream) {
  (void)in_sizes; (void)n_in; (void)out_size;
  Params p{};
  const float** fin = (const float**)&p;
  for (int i = 0; i < 23; ++i) fin[i] = (const float*)d_in[i];
  p.X = (float*)d_out;
  char* ws = (char*)d_ws; size_t off = 0;
  auto alloc = [&](size_t bytes) { char* q = ws + off; off += (bytes + 255) / 256 * 256; return q; };
  p.U = (bf16_t*)alloc((size_t)2 * 16384 * 1024 * 2); p.V = (bf16_t*)alloc((size_t)2 * 16384 * 1024 * 2);
  p.Wt_evin = (bf16_t*)alloc((size_t)2560 * 1024 * 2); p.Wt_evout = (bf16_t*)alloc((size_t)1024 * 1024 * 2); p.Wt_odin = (bf16_t*)alloc((size_t)1536 * 1024 * 2);
  p.Wt_odout = (bf16_t*)alloc((size_t)1024 * 1024 * 2); p.Wt_q = (bf16_t*)alloc((size_t)2 * 2048 * 1024 * 2); p.keysb = (bf16_t*)alloc((size_t)2 * 2 * 128 * 128 * 2);
  p.Wg = (float*)alloc(16 * 1024 * 4); p.mod = (float*)alloc(2 * 8 * 6144 * 4); p.gates = (float*)alloc((size_t)T * 16 * 4);
  p.pgate = (float*)alloc((size_t)T * 128 * 4); p.pidx = (bf16_t*)alloc((size_t)T * 128 * 2);
  p.H = (bf16_t*)alloc((size_t)T * 1024 * 2); p.CAT = p.H;
  char* big = alloc((size_t)T * 2048 * 2);
  p.ZQK = (bf16_t*)big; p.ZV = (bf16_t*)(big + (size_t)T * 1024 * 2); p.ZO = (bf16_t*)(big + (size_t)T * 1536 * 2); p.HS = (bf16_t*)big; p.QP = (bf16_t*)big; p.QKV = (bf16_t*)big;
  char* big2 = alloc((size_t)T * 1536 * 2);
  p.QK = (bf16_t*)big2; p.ZP = (bf16_t*)(big2 + (size_t)T * 1024 * 2); p.Qh = (bf16_t*)big2; p.Kh = (bf16_t*)(big2 + (size_t)T * 1024 * 2); p.Vh = (bf16_t*)(big2 + (size_t)T * 1280 * 2);
  if (off > ws_size) { fprintf(stderr, "kernel_launch: workspace too small: need %zu have %zu\n", off, ws_size); return; }

  static int grid_blocks = 0;
  if (!grid_blocks) {
    int dev = 0, cus = 0, per_cu = 0; hipGetDevice(&dev); hipDeviceGetAttribute(&cus, hipDeviceAttributeMultiprocessorCount, dev);
    hipFuncSetAttribute((const void*)mega, hipFuncAttributeMaxDynamicSharedMemorySize, SMEM_BYTES);
    hipOccupancyMaxActiveBlocksPerMultiprocessor(&per_cu, mega, NTHREADS, SMEM_BYTES);
    if (per_cu > 1) per_cu = 1;
    grid_blocks = cus * per_cu;
    if (grid_blocks <= 0) { fprintf(stderr, "kernel_launch: occupancy query returned 0\n"); grid_blocks = 0; return; }
  }
#if MULTI_LAUNCH
  for (int ph = 0; ph < NPH; ++ph) hipLaunchKernelGGL(mega, dim3(grid_blocks), dim3(NTHREADS), SMEM_BYTES, stream, p, ph, ph + 1);
#else
  int ph0 = 0, ph1 = NPH; void* args[] = {&p, &ph0, &ph1};
  hipError_t e = hipLaunchCooperativeKernel((const void*)mega, dim3(grid_blocks), dim3(NTHREADS), args, SMEM_BYTES, stream);
  if (e != hipSuccess) fprintf(stderr, "cooperative launch failed: %s (grid %d)\n", hipGetErrorString(e), grid_blocks);
#endif
}
```

```cpp
#include <hip/hip_runtime.h>
#include <hip/hip_cooperative_groups.h>
#include <math.h>
#include <stdint.h>
#include <stdio.h>
namespace cg = cooperative_groups;

#ifndef MULTI_LAUNCH
#define MULTI_LAUNCH 0
#endif

namespace {
typedef unsigned short bf16_t;
typedef unsigned int u32;
typedef float f32x4 __attribute__((ext_vector_type(4)));
typedef u32 u32x4 __attribute__((ext_vector_type(4)));
typedef u32 u32x2 __attribute__((ext_vector_type(2)));
typedef __bf16 bf16x2_t __attribute__((ext_vector_type(2)));

constexpr int D = 1024, NB = 8, S = 4096, T = NB * S;
constexpr int EVEN_IN = 2576;
constexpr float EPS = 1e-6f;
constexpr int NTHREADS = 512;
constexpr int SMEM_BYTES = 144 * 1024;
constexpr float KSCALE = 0.08838834764831845f;

struct Params {
  const float *x, *c, *ada_w, *ada_b, *nmg, *nfg, *ev_w_in, *ev_b_in, *conv_w, *conv_b, *mnorm_g, *pool_w, *pool_sc, *ev_w_out, *od_w_in, *qn_g, *kn_g, *od_w_out,
      *peer_wq, *peer_keys, *peer_u, *peer_v, *final_g;
  float* X;
  bf16_t *Wt_evin, *Wt_evout, *Wt_odin, *Wt_odout, *Wt_q, *keysb, *U, *V;
  float *Wg, *mod, *gates, *pgate;
  bf16_t *H, *ZQK, *ZV, *ZO, *ZP, *QK, *HS, *CAT, *QP, *QKV, *Qh, *Kh, *Vh;
  bf16_t* pidx;
};

__device__ __forceinline__ float siluf(float x) { return x / (1.f + __expf(-x)); }
__device__ __forceinline__ float sigmf(float x) { return 1.f / (1.f + __expf(-x)); }
__device__ __forceinline__ float wave_sum(float v) { for (int o = 32; o >= 1; o >>= 1) v += __shfl_xor(v, o); return v; }
__device__ __forceinline__ float wave_max(float v) { for (int o = 32; o >= 1; o >>= 1) v = fmaxf(v, __shfl_xor(v, o)); return v; }
__device__ __forceinline__ bf16_t f2bf(float f) { u32 u = __float_as_uint(f); u += 0x7FFFu + ((u >> 16) & 1u); return (bf16_t)(u >> 16); }
__device__ __forceinline__ float bf2f(bf16_t b) { return __uint_as_float(((u32)b) << 16); }
__device__ __forceinline__ u32 pack2(float lo, float hi) { return (u32)f2bf(lo) | ((u32)f2bf(hi) << 16); }
__device__ __forceinline__ float bflo(u32 w) { return __uint_as_float(w << 16); }
__device__ __forceinline__ float bfhi(u32 w) { return __uint_as_float(w & 0xFFFF0000u); }
__device__ __forceinline__ float dot2bf(u32 a, u32 b, float c) { return __builtin_amdgcn_fdot2_f32_bf16(__builtin_bit_cast(bf16x2_t, a), __builtin_bit_cast(bf16x2_t, b), c, false); }

constexpr int PJ_MOD = 192, PJ_TR = 2576, PJ_WG = 1, PJ_KEYS = 16, PJ_UV = 16384;
constexpr int PJ_TOTAL = PJ_MOD + PJ_TR + PJ_WG + PJ_KEYS + PJ_UV;

__device__ void prep_transpose_tile(const float* __restrict__ src, int ld, int k0, int n0, bf16_t* __restrict__ dst, int dstK, char* smem) {
  float* tile = (float*)smem;
  const int tid = threadIdx.x;
  __syncthreads();
  for (int pass = 0; pass < 8; ++pass) { int kk = pass * 8 + (tid >> 6), n = tid & 63; tile[kk * 65 + n] = src[(size_t)(k0 + kk) * ld + n0 + n]; }
  __syncthreads();
  int n = tid >> 3, kc = (tid & 7) * 8; u32x4 w;
  w.x = pack2(tile[(kc + 0) * 65 + n], tile[(kc + 1) * 65 + n]); w.y = pack2(tile[(kc + 2) * 65 + n], tile[(kc + 3) * 65 + n]);
  w.z = pack2(tile[(kc + 4) * 65 + n], tile[(kc + 5) * 65 + n]); w.w = pack2(tile[(kc + 6) * 65 + n], tile[(kc + 7) * 65 + n]);
  *(u32x4*)(dst + (size_t)(n0 + n) * dstK + k0 + kc) = w;
}

__device__ void phase_prep(const Params& p, char* smem) {
  const int tid = threadIdx.x;
  for (int job = blockIdx.x; job < PJ_TOTAL; job += gridDim.x) {
    if (job < PJ_MOD) {
      float* cs = (float*)smem; float* red = cs + 8192;
      __syncthreads();
      for (int i = tid; i < 8192; i += NTHREADS) cs[i] = siluf(p.c[i]);
      __syncthreads();
      const int l = job / 96, e0 = (job % 96) * 64, col = tid & 63, dg = tid >> 6;
      float acc[8];
#pragma unroll
      for (int b = 0; b < 8; ++b) acc[b] = 0.f;
      const float* w = p.ada_w + (size_t)l * D * 6144 + e0 + col;
      for (int d = dg * 128; d < dg * 128 + 128; ++d) { float wv = w[(size_t)d * 6144];
#pragma unroll
        for (int b = 0; b < 8; ++b) acc[b] += cs[b * 1024 + d] * wv; }
#pragma unroll
      for (int b = 0; b < 8; ++b) red[(dg * 8 + b) * 64 + col] = acc[b];
      __syncthreads();
      { const int b = tid >> 6; float s = 0.f;
#pragma unroll
        for (int g = 0; g < 8; ++g) s += red[(g * 8 + b) * 64 + col];
        p.mod[(size_t)(l * 8 + b) * 6144 + e0 + col] = s + p.ada_b[l * 6144 + e0 + col]; }
    } else if (job < PJ_MOD + PJ_TR) {
      int tt = job - PJ_MOD;
      if (tt < 640) prep_transpose_tile(p.ev_w_in, EVEN_IN, (tt / 40) * 64, (tt % 40) * 64, p.Wt_evin, 1024, smem);
      else if (tt < 896) { tt -= 640; prep_transpose_tile(p.ev_w_out, 1024, (tt / 16) * 64, (tt % 16) * 64, p.Wt_evout, 1024, smem); }
      else if (tt < 1280) { tt -= 896; prep_transpose_tile(p.od_w_in, 1536, (tt / 24) * 64, (tt % 24) * 64, p.Wt_odin, 1024, smem); }
      else if (tt < 1536) { tt -= 1280; prep_transpose_tile(p.od_w_out, 1024, (tt / 16) * 64, (tt % 16) * 64, p.Wt_odout, 1024, smem); }
      else if (tt < 2560) { tt -= 1536; int l = tt / 512; tt %= 512; prep_transpose_tile(p.peer_wq + (size_t)l * D * 2048, 2048, (tt / 32) * 64, (tt % 32) * 64, p.Wt_q + (size_t)l * 2048 * 1024, 1024, smem); }
      else {   }
    } else if (job < PJ_MOD + PJ_TR + PJ_WG) {
      for (int i = tid; i < 16 * 1024; i += NTHREADS) { int g = i >> 10, d = i & 1023; p.Wg[i] = p.ev_w_in[(size_t)d * EVEN_IN + 2560 + g]; }
    } else if (job < PJ_MOD + PJ_TR + PJ_WG + PJ_KEYS) {
      int j = job - (PJ_MOD + PJ_TR + PJ_WG);
      for (int i = tid; i < 4096; i += NTHREADS) p.keysb[j * 4096 + i] = f2bf(p.peer_keys[j * 4096 + i]);
    } else {
      int j = job - (PJ_MOD + PJ_TR + PJ_WG + PJ_KEYS); const float* src = j < 8192 ? p.peer_u : p.peer_v; bf16_t* dst = j < 8192 ? p.U : p.V; j &= 8191;
      size_t o = (size_t)j * 4096 + tid * 8; f32x4 a = *(const f32x4*)(src + o), b = *(const f32x4*)(src + o + 4);
      u32x4 w; w.x = pack2(a.x, a.y); w.y = pack2(a.z, a.w); w.z = pack2(b.x, b.y); w.w = pack2(b.z, b.w); *(u32x4*)(dst + o) = w;
    }
  }
}

template <bool WITH_GATES>
__device__ void phase_norm(const Params& p, const float* __restrict__ xin, const float* __restrict__ g, const float* __restrict__ modl, int sh_off, int sc_off, char* smem) {
  const int tid = threadIdx.x, wid = tid >> 6, lane = tid & 63;
  float* wg = (float*)smem;
  if (WITH_GATES) { __syncthreads(); for (int i = tid; i < 16 * 1024; i += NTHREADS) wg[i] = p.Wg[i]; __syncthreads(); }
  for (int job = blockIdx.x; job < T / 8; job += gridDim.x) {
    const int t = job * 8 + wid, b = t / S;
    f32x4 v[4]; float ss = 0.f;
#pragma unroll
    for (int i = 0; i < 4; ++i) { v[i] = *(const f32x4*)(xin + (size_t)t * D + i * 256 + lane * 4); ss += v[i].x * v[i].x + v[i].y * v[i].y + v[i].z * v[i].z + v[i].w * v[i].w; }
    ss = wave_sum(ss); const float r = rsqrtf(ss * (1.f / D) + EPS);
    const float* shp = modl + (size_t)b * 6144 + sh_off; const float* scp = modl + (size_t)b * 6144 + sc_off;
#pragma unroll
    for (int i = 0; i < 4; ++i) { const int d = i * 256 + lane * 4; f32x4 gg = *(const f32x4*)(g + d), s1 = *(const f32x4*)(scp + d), s0 = *(const f32x4*)(shp + d);
      v[i].x = v[i].x * r * gg.x * (1.f + s1.x) + s0.x; v[i].y = v[i].y * r * gg.y * (1.f + s1.y) + s0.y; v[i].z = v[i].z * r * gg.z * (1.f + s1.z) + s0.z; v[i].w = v[i].w * r * gg.w * (1.f + s1.w) + s0.w;
      u32x2 w; w.x = pack2(v[i].x, v[i].y); w.y = pack2(v[i].z, v[i].w); *(u32x2*)(p.H + (size_t)t * D + d) = w; }
    if (WITH_GATES) {
      float myg = 0.f;
#pragma unroll 2
      for (int gi = 0; gi < 16; ++gi) { float a = 0.f;
#pragma unroll
        for (int i = 0; i < 4; ++i) { f32x4 w4 = *(const f32x4*)(wg + gi * 1024 + i * 256 + lane * 4); a += v[i].x * w4.x + v[i].y * w4.y + v[i].z * w4.z + v[i].w * w4.w; }
        a = wave_sum(a); if (lane == gi) myg = a; }
      if (lane < 16) p.gates[(size_t)t * 16 + lane] = myg + p.ev_b_in[2560 + lane];
    }
  }
}

enum { EPI_EVIN = 0, EPI_EVOUT = 1, EPI_PEERQ = 2, EPI_ODIN = 3, EPI_ODOUT = 4 };
template <int EPI> __device__ __forceinline__ void epi_store(const Params& p, int layer, int m, int n, float acc) {
  if (EPI == EPI_EVIN) { float v = acc + p.ev_b_in[n];
    if (n < 1024) p.ZQK[(size_t)m * 1024 + n] = f2bf(v); else if (n < 1536) p.ZV[(size_t)m * 512 + n - 1024] = f2bf(v);
    else if (n < 2048) p.ZO[(size_t)m * 512 + n - 1536] = f2bf(sigmf(v)); else p.ZP[(size_t)m * 512 + n - 2048] = f2bf(v); }
  else if (EPI == EPI_EVOUT) { int b = m / S; p.X[(size_t)m * D + n] = p.x[(size_t)m * D + n] + p.mod[(size_t)(0 * 8 + b) * 6144 + 2048 + n] * acc; }
  else if (EPI == EPI_PEERQ) p.QP[(size_t)m * 2048 + n] = f2bf(acc);
  else if (EPI == EPI_ODIN) p.QKV[(size_t)m * 1536 + n] = f2bf(acc);
  else if (EPI == EPI_ODOUT) { int b = m / S; p.X[(size_t)m * D + n] += p.mod[(size_t)(1 * 8 + b) * 6144 + 2048 + n] * acc; }
}
template <int EPI> __device__ void phase_gemm_naive(const Params& p, int layer, const bf16_t* __restrict__ A, const bf16_t* __restrict__ Bt, int M, int N, int K, char* smem) {
  float* As = (float*)smem; float* Bs = As + 32 * 132;
  const int tid = threadIdx.x, tx = tid & 15, ty = tid >> 4; const int nN = N / 64, njobs = (M / 128) * nN;
  for (int job = blockIdx.x; job < njobs; job += gridDim.x) {
    const int m0 = (job / nN) * 128, n0 = (job % nN) * 64; float acc[4][4];
#pragma unroll
    for (int i = 0; i < 4; ++i)
#pragma unroll
      for (int j = 0; j < 4; ++j) acc[i][j] = 0.f;
    for (int k0 = 0; k0 < K; k0 += 32) {
      __syncthreads();
      { int row = tid >> 2, kc = (tid & 3) * 8; u32x4 w = *(const u32x4*)(A + (size_t)(m0 + row) * K + k0 + kc);
        As[(kc + 0) * 132 + row] = bflo(w.x); As[(kc + 1) * 132 + row] = bfhi(w.x); As[(kc + 2) * 132 + row] = bflo(w.y); As[(kc + 3) * 132 + row] = bfhi(w.y);
        As[(kc + 4) * 132 + row] = bflo(w.z); As[(kc + 5) * 132 + row] = bfhi(w.z); As[(kc + 6) * 132 + row] = bflo(w.w); As[(kc + 7) * 132 + row] = bfhi(w.w); }
      if (tid < 256) { int row = tid >> 2, kc = (tid & 3) * 8; u32x4 w = *(const u32x4*)(Bt + (size_t)(n0 + row) * K + k0 + kc);
        Bs[(kc + 0) * 68 + row] = bflo(w.x); Bs[(kc + 1) * 68 + row] = bfhi(w.x); Bs[(kc + 2) * 68 + row] = bflo(w.y); Bs[(kc + 3) * 68 + row] = bfhi(w.y);
        Bs[(kc + 4) * 68 + row] = bflo(w.z); Bs[(kc + 5) * 68 + row] = bfhi(w.z); Bs[(kc + 6) * 68 + row] = bflo(w.w); Bs[(kc + 7) * 68 + row] = bfhi(w.w); }
      __syncthreads();
#pragma unroll 8
      for (int kk = 0; kk < 32; ++kk) { f32x4 a = *(const f32x4*)(As + kk * 132 + ty * 4), b = *(const f32x4*)(Bs + kk * 68 + tx * 4);
        acc[0][0] += a.x * b.x; acc[0][1] += a.x * b.y; acc[0][2] += a.x * b.z; acc[0][3] += a.x * b.w;
        acc[1][0] += a.y * b.x; acc[1][1] += a.y * b.y; acc[1][2] += a.y * b.z; acc[1][3] += a.y * b.w;
        acc[2][0] += a.z * b.x; acc[2][1] += a.z * b.y; acc[2][2] += a.z * b.z; acc[2][3] += a.z * b.w;
        acc[3][0] += a.w * b.x; acc[3][1] += a.w * b.y; acc[3][2] += a.w * b.z; acc[3][3] += a.w * b.w; }
    }
#pragma unroll
    for (int i = 0; i < 4; ++i)
#pragma unroll
      for (int j = 0; j < 4; ++j) epi_store<EPI>(p, layer, m0 + ty * 4 + i, n0 + tx * 4 + j, acc[i][j]);
  }
}

namespace pg8 {
#define PG8_LAS __attribute__((address_space(3)))
typedef unsigned short bf16_t;
typedef short bf16x8 __attribute__((ext_vector_type(8)));
typedef float f32x4 __attribute__((ext_vector_type(4)));
typedef unsigned u32x4 __attribute__((ext_vector_type(4)));
constexpr int BM = 256, BK = 64, HALF = 128, HTB = HALF * BK * 2  , STAGE_BYTES = 8 * HTB, NXCD = 8, WGM = 8;

__host__ __device__ __forceinline__ int lds_byte(int r, int c) { const int st = (r >> 4) * 2 + (c >> 5), rr = r & 15, cc = c & 31, ob = rr * 64 + cc * 2; return st * 1024 + (ob ^ (((ob >> 9) & 1) << 5)); }
__host__ __device__ __forceinline__ void stage_rc(int b, int& R, int& C) { const int st = b / 1024, sb = b % 1024, swz = sb ^ (((sb >> 9) & 1) << 5); R = (st >> 1) * 16 + swz / 64; C = (st & 1) * 32 + (swz % 64) / 2; }
__host__ __device__ __forceinline__ int perm32(int rho) { const int n = rho >> 4, i = rho & 15; return 8 * (i >> 2) + 4 * n + (i & 3); }

struct Unit { int pm, pn; };
struct Gemm { const bf16_t* A; const bf16_t* Bt; int M, N, K; };

struct StaticOrder {
    int nM, nN, nwg, G, c;
    __host__ __device__ void init(int M, int N, int G_, int c_) { nM = M / BM; nN = N / BM; nwg = nM * nN; G = G_; c = c_; }
    __host__ __device__ bool next(int i, Unit& u) const {
        const long L = (long)i * G + c; if (L >= nwg) return false;
        int wgid = (int)L; { const int q = nwg / NXCD, r = nwg % NXCD, xcd = wgid % NXCD, off = wgid / NXCD; wgid = (xcd < r ? xcd * (q + 1) : r * (q + 1) + (xcd - r) * q) + off; }
        const int nig = WGM * nN, gid = wgid / nig, fm = gid * WGM, gsz = (nM - fm) < WGM ? (nM - fm) : WGM;
        u.pm = fm + ((wgid % nig) % gsz); u.pn = (wgid % nig) / gsz; return true;
    }
    __device__ __forceinline__ void a_ready(const Unit&) const {}
    __device__ __forceinline__ void done(const Unit&) const {}
};
__device__ __forceinline__ unsigned cvt_pk_bf16(float lo, float hi) { unsigned r; asm volatile("v_cvt_pk_bf16_f32 %0, %1, %2" : "=v"(r) : "v"(lo), "v"(hi)); return r; }
template <class Epi, class Sched, bool STAMP = false>
__device__ __forceinline__ void gemm_phase(PG8_LAS unsigned char* lds, const Gemm g, const Sched& S, const Epi& E, unsigned long long* stamps) {
    const int tid = threadIdx.x, wid = __builtin_amdgcn_readfirstlane(tid >> 6), lane = tid & 63, wr = wid >> 2, wc = wid & 3, fr = lane & 15, fq = lane >> 4;
    const int K = g.K, nt = K / BK;
    int ts_lo = 0, ts_hi = 0, nts = 0; const unsigned long long rt_entry = STAMP ? (unsigned long long)wall_clock64() : 0ull;
#define PG8_STAMP() do { if (STAMP && wid == 0 && nts < 64) { const unsigned long long _c = (unsigned long long)clock64(); \
        ts_lo = (lane == nts) ? (int)(unsigned)_c : ts_lo; ts_hi = (lane == nts) ? (int)(unsigned)(_c >> 32) : ts_hi; ++nts; } } while (0)
    PG8_STAMP();
    unsigned voffA[2], voffB[2];
#pragma unroll
    for (int i = 0; i < 2; ++i) { int R, C; stage_rc(tid * 16 + i * 8192, R, C); const int Rb = Epi::PERM ? ((R & ~31) + perm32(R & 31)) : R;
        voffA[i] = (unsigned)(R * K + C) * 2u; voffB[i] = (unsigned)(Rb * K + C) * 2u; }
    const size_t kstep = (size_t)(BK * 2);
    const size_t hstep = (size_t)HALF * K * 2;
    const size_t tstep = 2 * hstep;
    const unsigned ldsw = (unsigned)wid * 1024u;
    const int aoff = lds_byte(wr * 64 + fr, fq * 8), boff = lds_byte(wc * 32 + fr, fq * 8);
#define PG8_SA(b, h) (((b) * 2 + (h)) * HTB)
#define PG8_SB(b, h) ((4 + (b) * 2 + (h)) * HTB)
#define PG8_STAGE(bufoff, gbase, voff) do { _Pragma("unroll") for (int _i = 0; _i < 2; ++_i) \
        __builtin_amdgcn_global_load_lds((const unsigned*)((const char*)(gbase) + (voff)[_i]), (PG8_LAS unsigned*)(lds + (bufoff) + ldsw + _i * 8192), 16, 0, 0); } while (0)
#define PG8_LDA(dst, b, h) do { _Pragma("unroll") for (int m = 0; m < 4; ++m) _Pragma("unroll") for (int k = 0; k < 2; ++k) dst[m][k] = *(const PG8_LAS bf16x8*)(lds + PG8_SA(b, h) + aoff + m * 2048 + k * 1024); } while (0)
#define PG8_LDB(dst, b, h) do { _Pragma("unroll") for (int n = 0; n < 2; ++n) _Pragma("unroll") for (int k = 0; k < 2; ++k) dst[n][k] = *(const PG8_LAS bf16x8*)(lds + PG8_SB(b, h) + boff + n * 2048 + k * 1024); } while (0)
#define PG8_MMA(ai, bj, At, Bt) do { __builtin_amdgcn_s_setprio(1); _Pragma("unroll") for (int m = 0; m < 4; ++m) _Pragma("unroll") for (int n = 0; n < 2; ++n) _Pragma("unroll") for (int k = 0; k < 2; ++k) \
        acc[ai][bj][m][n] = __builtin_amdgcn_mfma_f32_16x16x32_bf16(Bt[n][k], At[m][k], acc[ai][bj][m][n], 0, 0, 0); __builtin_amdgcn_s_setprio(0); } while (0)
#define PG8_WAIT_V(n) asm volatile("s_waitcnt vmcnt(" #n ")" ::: "memory")
#define PG8_WAIT_L(n) asm volatile("s_waitcnt lgkmcnt(" #n ")" ::: "memory")
#define PG8_BAR __builtin_amdgcn_s_barrier()
#define PG8_SCHED __builtin_amdgcn_sched_barrier(0)
    Unit cur, nxt; int ui = 0;
    if (!S.next(0, cur)) return;
    f32x4 acc[2][2][4][2];
#pragma unroll
    for (int a = 0; a < 2; ++a)
#pragma unroll
        for (int b = 0; b < 2; ++b)
#pragma unroll
            for (int m = 0; m < 4; ++m)
#pragma unroll
                for (int n = 0; n < 2; ++n) acc[a][b][m][n] = (f32x4){0.f, 0.f, 0.f, 0.f};
    bf16x8 At[4][2], B0[2][2], B1[2][2];
    const char* cA = (const char*)g.A + (size_t)cur.pm * tstep; const char* cB = (const char*)g.Bt + (size_t)cur.pn * tstep;
    S.a_ready(cur);
    PG8_STAGE(PG8_SB(0, 0), cB, voffB); PG8_STAGE(PG8_SA(0, 0), cA, voffA); PG8_STAGE(PG8_SB(0, 1), cB + hstep, voffB); PG8_STAGE(PG8_SA(0, 1), cA + hstep, voffA);
    if (wr == 1) PG8_BAR;
    PG8_WAIT_V(4); PG8_BAR;
    PG8_STAGE(PG8_SB(1, 0), cB + kstep, voffB); PG8_STAGE(PG8_SA(1, 0), cA + kstep, voffA); PG8_STAGE(PG8_SB(1, 1), cB + hstep + kstep, voffB);
    PG8_WAIT_V(6); PG8_BAR;
    PG8_STAMP();
    for (;;) {
        const bool has_next = S.next(ui + 1, nxt);
        const char* nA = has_next ? (const char*)g.A + (size_t)nxt.pm * tstep : cA; const char* nB = has_next ? (const char*)g.Bt + (size_t)nxt.pn * tstep : cB;
        for (int t = 0; t < nt; t += 2) {
            const bool last = (t == nt - 2);
            const char* a1 = cA + (size_t)(t + 1) * kstep;
            const char* a2 = last ? nA : cA + (size_t)(t + 2) * kstep; const char* b2 = last ? nB : cB + (size_t)(t + 2) * kstep;
            const char* a3 = a2 + kstep; const char* b3 = b2 + kstep;
            if (last && has_next) S.a_ready(nxt);
            PG8_LDB(B0, 0, 0); PG8_SCHED; PG8_LDA(At, 0, 0); PG8_STAGE(PG8_SA(1, 1), a1 + hstep, voffA);
            PG8_WAIT_L(8); PG8_BAR; PG8_WAIT_L(0); PG8_MMA(0, 0, At, B0); PG8_BAR; PG8_SCHED;
            PG8_LDB(B1, 0, 1); PG8_STAGE(PG8_SB(0, 0), b2, voffB);
            PG8_BAR; PG8_WAIT_L(0); PG8_MMA(0, 1, At, B1); PG8_BAR;
            PG8_LDA(At, 0, 1); PG8_STAGE(PG8_SA(0, 0), a2, voffA);
            PG8_BAR; PG8_WAIT_L(0); PG8_MMA(1, 0, At, B0); PG8_BAR; PG8_SCHED;
            PG8_STAGE(PG8_SB(0, 1), b2 + hstep, voffB);
            PG8_WAIT_V(6); PG8_BAR; PG8_MMA(1, 1, At, B1); PG8_BAR;
            PG8_LDB(B0, 1, 0); PG8_SCHED; PG8_LDA(At, 1, 0); PG8_STAGE(PG8_SA(0, 1), a2 + hstep, voffA);
            PG8_WAIT_L(8); PG8_BAR; PG8_WAIT_L(0); PG8_MMA(0, 0, At, B0); PG8_BAR; PG8_SCHED;
            PG8_LDB(B1, 1, 1); PG8_STAGE(PG8_SB(1, 0), b3, voffB);
            PG8_BAR; PG8_WAIT_L(0); PG8_MMA(0, 1, At, B1); PG8_BAR;
            PG8_LDA(At, 1, 1); PG8_STAGE(PG8_SA(1, 0), a3, voffA);
            PG8_BAR; PG8_WAIT_L(0); PG8_MMA(1, 0, At, B0); PG8_BAR; PG8_SCHED;
            PG8_STAGE(PG8_SB(1, 1), b3 + hstep, voffB);
            PG8_WAIT_V(6); PG8_BAR; PG8_MMA(1, 1, At, B1); PG8_BAR;
        }
        PG8_STAMP();
        if constexpr (!Epi::AFTER_DRAIN) { E(acc, cur, wr, wc, fr, fq); S.done(cur); }
        PG8_STAMP();
        if (!has_next) break;
#pragma unroll
        for (int a = 0; a < 2; ++a)
#pragma unroll
            for (int b = 0; b < 2; ++b)
#pragma unroll
                for (int m = 0; m < 4; ++m)
#pragma unroll
                    for (int n = 0; n < 2; ++n) acc[a][b][m][n] = (f32x4){0.f, 0.f, 0.f, 0.f};
        cur = nxt; cA = nA; cB = nB; ++ui;
    }
    PG8_WAIT_V(0);
    if (wr == 0) PG8_BAR;
    PG8_BAR;
    if constexpr (Epi::AFTER_DRAIN) { E.fused(acc, cur, wr, wc, fr, fq, lds, wid, lane); S.done(cur); }
    PG8_STAMP();
    if (STAMP && wid == 0) { stamps[lane] = lane < nts ? (((unsigned long long)(unsigned)ts_hi << 32) | (unsigned)ts_lo) : 0ull;
        if (lane == 62) stamps[62] = rt_entry; if (lane == 63) stamps[63] = (unsigned long long)wall_clock64(); }
#undef PG8_STAMP
#undef PG8_SA
#undef PG8_SB
#undef PG8_STAGE
#undef PG8_LDA
#undef PG8_LDB
#undef PG8_MMA
#undef PG8_WAIT_V
#undef PG8_WAIT_L
#undef PG8_BAR
#undef PG8_SCHED
}
}

struct EpiEvin {
  static constexpr bool PERM = true, AFTER_DRAIN = false;
  bf16_t *ZQK, *ZV, *ZO, *ZP; const float* bias;
  __device__ __forceinline__ void operator()(const pg8::f32x4 (&acc)[2][2][4][2], const pg8::Unit& u, int wr, int wc, int fr, int fq) const {
    const int row0 = u.pm * 256 + wr * 64 + fr, ct = u.pn * 256;
    bf16_t* base; int ldc, cl; bool sig = false;
    if (ct < 1024) { base = ZQK; ldc = 1024; cl = ct; } else if (ct < 1536) { base = ZV; ldc = 512; cl = ct - 1024; } else if (ct < 2048) { base = ZO; ldc = 512; cl = ct - 1536; sig = true; } else { base = ZP; ldc = 512; cl = ct - 2048; }
    const int cofs = wc * 32 + 8 * fq;
    pg8::f32x4 bv[2][2];
#pragma unroll
    for (int bj = 0; bj < 2; ++bj)
#pragma unroll
      for (int n = 0; n < 2; ++n) bv[bj][n] = *(const pg8::f32x4*)(bias + ct + cofs + bj * 128 + 4 * n);
#pragma unroll
    for (int ai = 0; ai < 2; ++ai)
#pragma unroll
      for (int m = 0; m < 4; ++m) { bf16_t* rowp = base + (size_t)(row0 + ai * 128 + m * 16) * ldc + cl + cofs;
#pragma unroll
        for (int bj = 0; bj < 2; ++bj) { pg8::f32x4 v0 = acc[ai][bj][m][0] + bv[bj][0], v1 = acc[ai][bj][m][1] + bv[bj][1];
          if (sig) {
#pragma unroll
            for (int j = 0; j < 4; ++j) { v0[j] = sigmf(v0[j]); v1[j] = sigmf(v1[j]); } }
          pg8::u32x4 w; w.x = pg8::cvt_pk_bf16(v0[0], v0[1]); w.y = pg8::cvt_pk_bf16(v0[2], v0[3]); w.z = pg8::cvt_pk_bf16(v1[0], v1[1]); w.w = pg8::cvt_pk_bf16(v1[2], v1[3]);
          *(pg8::u32x4*)(rowp + bj * 128) = w; } }
  }
};
struct EpiPlain {
  static constexpr bool PERM = true, AFTER_DRAIN = false;
  bf16_t* out; int ldc;
  __device__ __forceinline__ void operator()(const pg8::f32x4 (&acc)[2][2][4][2], const pg8::Unit& u, int wr, int wc, int fr, int fq) const {
    const int row0 = u.pm * 256 + wr * 64 + fr, col0 = u.pn * 256 + wc * 32 + 8 * fq;
#pragma unroll
    for (int ai = 0; ai < 2; ++ai)
#pragma unroll
      for (int m = 0; m < 4; ++m) { bf16_t* rowp = out + (size_t)(row0 + ai * 128 + m * 16) * ldc + col0;
#pragma unroll
        for (int bj = 0; bj < 2; ++bj) { const pg8::f32x4 v0 = acc[ai][bj][m][0], v1 = acc[ai][bj][m][1];
          pg8::u32x4 w; w.x = pg8::cvt_pk_bf16(v0[0], v0[1]); w.y = pg8::cvt_pk_bf16(v0[2], v0[3]); w.z = pg8::cvt_pk_bf16(v1[0], v1[1]); w.w = pg8::cvt_pk_bf16(v1[2], v1[3]);
          *(pg8::u32x4*)(rowp + bj * 128) = w; } }
  }
};
struct EpiRes {
  static constexpr bool PERM = false, AFTER_DRAIN = false;
  const float* xin; float* X; const float* gate;
  __device__ __forceinline__ void operator()(const pg8::f32x4 (&acc)[2][2][4][2], const pg8::Unit& u, int wr, int wc, int fr, int fq) const {
    const int row0 = u.pm * 256 + wr * 64 + fr, col0 = u.pn * 256 + wc * 32 + 4 * fq; const float* gb = gate + (size_t)((u.pm * 256) / S) * 6144;
    pg8::f32x4 gv[2][2];
#pragma unroll
    for (int bj = 0; bj < 2; ++bj)
#pragma unroll
      for (int n = 0; n < 2; ++n) gv[bj][n] = *(const pg8::f32x4*)(gb + col0 + bj * 128 + n * 16);
#pragma unroll
    for (int ai = 0; ai < 2; ++ai)
#pragma unroll
      for (int m = 0; m < 4; ++m) { const size_t off = (size_t)(row0 + ai * 128 + m * 16) * 1024 + col0;
#pragma unroll
        for (int bj = 0; bj < 2; ++bj)
#pragma unroll
          for (int n = 0; n < 2; ++n) { const pg8::f32x4 xi = *(const pg8::f32x4*)(xin + off + bj * 128 + n * 16); *(pg8::f32x4*)(X + off + bj * 128 + n * 16) = xi + gv[bj][n] * acc[ai][bj][m][n]; }
        asm volatile("" ::: "memory"); }
  }
};
template <class Epi> __device__ __forceinline__ void phase_gemm_fast(const bf16_t* A, const bf16_t* Bt, int M, int N, int K, const Epi& E, char* smem) {
  pg8::Gemm g; g.A = A; g.Bt = Bt; g.M = M; g.N = N; g.K = K;
  pg8::StaticOrder So; So.init(M, N, (int)gridDim.x, (int)blockIdx.x);
  pg8::gemm_phase<Epi, pg8::StaticOrder, false>((PG8_LAS unsigned char*)smem, g, So, E, nullptr);
}

__device__ void phase_convpool(const Params& p, char* smem) {
  const int tid = threadIdx.x;
  for (int job = blockIdx.x; job < T * 128 / NTHREADS; job += gridDim.x) {
    const int it = job * NTHREADS + tid, t = it >> 7, c0 = (it & 127) * 8, s = t & (S - 1);
    float a[8];
#pragma unroll
    for (int i = 0; i < 8; ++i) a[i] = p.conv_b[c0 + i];
#pragma unroll
    for (int j = 0; j < 5; ++j) { const int ss = s + j - 2; if (ss >= 0 && ss < S) { u32x4 w = *(const u32x4*)(p.ZQK + (size_t)(t + j - 2) * 1024 + c0); const float* cw = p.conv_w + j * 1024 + c0;
        a[0] += cw[0] * bflo(w.x); a[1] += cw[1] * bfhi(w.x); a[2] += cw[2] * bflo(w.y); a[3] += cw[3] * bfhi(w.y); a[4] += cw[4] * bflo(w.z); a[5] += cw[5] * bfhi(w.z); a[6] += cw[6] * bflo(w.w); a[7] += cw[7] * bfhi(w.w); } }
    const float sc = c0 >= 512 ? KSCALE : 1.f;
#pragma unroll
    for (int i = 0; i < 8; ++i) a[i] = siluf(a[i]) * sc;
    u32x4 o; o.x = pack2(a[0], a[1]); o.y = pack2(a[2], a[3]); o.z = pack2(a[4], a[5]); o.w = pack2(a[6], a[7]); *(u32x4*)(p.QK + (size_t)t * 1024 + c0) = o;
  }
  float* ys = (float*)smem;
  float* ws = ys + 64 * 128;
  for (int job = blockIdx.x; job < (T / 64) * 4; job += gridDim.x) {
    const int g = job & 3, t0 = (job >> 2) * 64, win = 2 << g;
    __syncthreads();
    for (int i = tid; i < 128 * 128; i += NTHREADS) ws[i] = p.pool_w[(size_t)g * 16384 + i];
    for (int i = tid; i < 64 * 128; i += NTHREADS) { const int tl = i >> 7, c = i & 127, t = t0 + tl, s = t & (S - 1); const int lo = max(s - win / 2, 0), hi = min(s + win / 2, S);
      float sum = 0.f; for (int q = lo; q < hi; ++q) sum += bf2f(p.ZP[(size_t)(t - s + q) * 512 + g * 128 + c]);
      ys[i] = sum / (float)(hi - lo) - bf2f(p.ZP[(size_t)t * 512 + g * 128 + c]); }
    __syncthreads();
    const int e = tid & 127, tq = tid >> 7; float acc[16];
#pragma unroll
    for (int i = 0; i < 16; ++i) acc[i] = 0.f;
    for (int c = 0; c < 128; ++c) { const float w = ws[c * 128 + e];
#pragma unroll
      for (int i = 0; i < 16; ++i) acc[i] += ys[(tq * 16 + i) * 128 + c] * w; }
    const float psc = p.pool_sc[g * 128 + e];
#pragma unroll
    for (int i = 0; i < 16; ++i) p.CAT[(size_t)(t0 + tq * 16 + i) * 1024 + 512 + g * 128 + e] = f2bf(acc[i] * psc);
  }
}

__device__ void phase_mlstm_naive(const Params& p, char* smem) {
  float* qs = (float*)smem; float* ks = qs + 128; float* nump = ks + 128; float* red = nump + 512;
  const int tid = threadIdx.x, j = tid & 127, qd = tid >> 7;
  for (int job = blockIdx.x; job < 64; job += gridDim.x) {
    const int dir = job >> 5, b = (job >> 2) & 7, h = job & 3;
    float C[32];
#pragma unroll
    for (int d = 0; d < 32; ++d) C[d] = 0.f;
    float n = 0.f, m = 0.f;
    for (int step = 0; step < S; ++step) { const int s = dir ? S - 1 - step : step; const size_t t = (size_t)b * S + s;
      const float li = p.gates[t * 16 + dir * 4 + h], gf = p.gates[t * 16 + 8 + dir * 4 + h];
      const float lf = fminf(gf, 0.f) - log1pf(__expf(-fabsf(gf)));
      __syncthreads();
      if (qd == 0) { qs[j] = bf2f(p.QK[t * 1024 + h * 128 + j]); ks[j] = bf2f(p.QK[t * 1024 + 512 + h * 128 + j]); }
      const float v = bf2f(p.ZV[t * 512 + h * 128 + j]);
      __syncthreads();
      const float mn = fmaxf(lf + m, li), ip = __expf(li - mn), fp = __expf(lf + m - mn); m = mn;
      float num = 0.f;
#pragma unroll
      for (int d = 0; d < 32; ++d) { C[d] = fp * C[d] + ip * ks[qd * 32 + d] * v; num += qs[qd * 32 + d] * C[d]; }
      float dp = 0.f; if (qd == 0) { n = fp * n + ip * ks[j]; dp = qs[j] * n; }
      nump[qd * 128 + j] = num;
      dp = wave_sum(dp); if ((tid & 63) == 0) red[tid >> 6] = dp;
      __syncthreads();
      if (qd == 0) { const float den = red[0] + red[1]; num = nump[j] + nump[128 + j] + nump[256 + j] + nump[384 + j];
        p.HS[((size_t)dir * T + t) * 512 + h * 128 + j] = f2bf(num / fmaxf(fabsf(den), __expf(-mn))); }
    }
    __syncthreads();
  }
}

namespace ml {
typedef short bf16x8 __attribute__((ext_vector_type(8)));
typedef short s16x4 __attribute__((ext_vector_type(4)));
typedef float f32x16 __attribute__((ext_vector_type(16)));
constexpr int RS = 272;
constexpr int OFF_Q = 0, OFF_K = 128 * RS, OFF_VT = 2 * 128 * RS, OFF_VW = OFF_VT + 34 * RS, OFF_CT = OFF_VW + 34 * RS, OFF_A = OFF_CT + 34 * RS;
constexpr int OFF_PA = OFF_A + 16384, OFF_MCH = OFF_PA + 16384, OFF_TAB = OFF_MCH + 512, OFF_DEN = OFF_TAB + 4096, OFF_END = OFF_DEN + 512;
static_assert(OFF_A % 16 == 0 && OFF_END <= SMEM_BYTES, "mlstm LDS layout");
__device__ __forceinline__ int crow(int r, int h) { return (r & 3) + 8 * (r >> 2) + 4 * h; }
__device__ __forceinline__ int spos(int s) { return (s & ~12) | ((s & 4) << 1) | ((s & 8) >> 1); }
#define ML_MFMA(a, b, c) __builtin_amdgcn_mfma_f32_32x32x16_bf16((a), (b), (c), 0, 0, 0)
__device__ __forceinline__ bf16x8 pack8(float x0, float x1, float x2, float x3, float x4, float x5, float x6, float x7) {
  u32x4 w; w.x = pack2(x0, x1); w.y = pack2(x2, x3); w.z = pack2(x4, x5); w.w = pack2(x6, x7); return __builtin_bit_cast(bf16x8, w);
}
__device__ __forceinline__ void tr_read2(unsigned a0, unsigned a1, s16x4& lo, s16x4& hi) {
  asm volatile("ds_read_b64_tr_b16 %0, %2\n\tds_read_b64_tr_b16 %1, %3\n\ts_waitcnt lgkmcnt(0)" : "=&v"(lo), "=&v"(hi) : "v"(a0), "v"(a1) : "memory");
}

__device__ void phase_mlstm(const Params& p, char* smem) {
  int tid_ = threadIdx.x; asm volatile("" : "+v"(tid_));
  const int tid = tid_, wid = tid >> 6, lane = tid & 63, l31 = lane & 31, hh = lane >> 5;
  float* const LA = (float*)(smem + OFF_A); float* const LPA = (float*)(smem + OFF_PA); float* const LM = (float*)(smem + OFF_MCH);
  float* const LTAB = (float*)(smem + OFF_TAB); float* const LDEN = (float*)(smem + OFF_DEN);
  const unsigned lds0 = (unsigned)(uintptr_t)smem;
  for (int job = blockIdx.x; job < 256; job += gridDim.x) {
    const int dvq = job & 3, h = (job >> 2) & 3, b = (job >> 4) & 7, dir = job >> 7;
    const float* gts = p.gates + (size_t)b * S * 16;
    const bf16_t* QKb = p.QK + (size_t)b * S * 1024 + h * 128; const bf16_t* ZVb = p.ZV + (size_t)b * S * 512 + h * 128 + dvq * 32;
    bf16_t* HSb = p.HS + ((size_t)dir * T + (size_t)b * S) * 512 + h * 128 + dvq * 32;
    __syncthreads();
    for (int i = tid; i < 3 * 34 * RS / 4; i += NTHREADS) ((u32*)(smem + OFF_VT))[i] = 0u;
    for (int cc = 0; cc < 4; ++cc) { const int c = wid * 4 + cc, tau0 = c * 128 + 2 * lane; const int tok0 = dir ? S - 1 - tau0 : tau0, tok1 = dir ? tok0 - 1 : tok0 + 1;
      const float li0 = gts[(size_t)tok0 * 16 + dir * 4 + h], gf0 = gts[(size_t)tok0 * 16 + 8 + dir * 4 + h], li1 = gts[(size_t)tok1 * 16 + dir * 4 + h], gf1 = gts[(size_t)tok1 * 16 + 8 + dir * 4 + h];
      const float lf0 = fminf(gf0, 0.f) - log1pf(__expf(-fabsf(gf0))), lf1 = fminf(gf1, 0.f) - log1pf(__expf(-fabsf(gf1)));
      const float pr = lf0 + lf1; float incl = pr;
#pragma unroll
      for (int o = 1; o < 64; o <<= 1) { const float v = __shfl_up(incl, o); if (lane >= o) incl += v; }
      const float b0 = incl - pr + lf0, b1 = b0 + lf1, a0 = li0 - b0, a1 = li1 - b1;
      float im = fmaxf(a0, a1);
#pragma unroll
      for (int o = 1; o < 64; o <<= 1) { const float v = __shfl_up(im, o); if (lane >= o) im = fmaxf(im, v); }
      float ex = __shfl_up(im, 1); if (lane == 0) ex = -INFINITY;
      const float pa0 = fmaxf(ex, a0), pa1 = fmaxf(pa0, a1);
      LA[tau0] = a0; LA[tau0 + 1] = a1; LPA[tau0] = pa0; LPA[tau0 + 1] = pa1; if (lane == 63) LM[64 + c] = b1; }
    __syncthreads();
    if (tid == 0) { float m = 0.f; for (int c = 0; c < 32; ++c) { LM[c] = m; m = LM[64 + c] + fmaxf(m, LPA[c * 128 + 127]); } LM[32] = m; }
    __syncthreads();
    u32x4 qreg[4], kreg[4], vreg;
#define ML_TOK(tau) (dir ? S - 1 - (tau) : (tau))
#define ML_LOAD(c) do { _Pragma("unroll") for (int i_ = 0; i_ < 4; ++i_) { const int tk_ = ML_TOK((c) * 128 + (tid >> 4) + 32 * i_); \
        qreg[i_] = *(const u32x4*)(QKb + (size_t)tk_ * 1024 + (tid & 15) * 8); kreg[i_] = *(const u32x4*)(QKb + (size_t)tk_ * 1024 + 512 + (tid & 15) * 8); } \
      { const int tk_ = ML_TOK((c) * 128 + (tid >> 2)); vreg = *(const u32x4*)(ZVb + (size_t)tk_ * 512 + (tid & 3) * 8); } } while (0)
#define ML_TABLES(c) do { if (tid < 128) { const int tau_ = (c) * 128 + tid, tk_ = ML_TOK(tau_); const float li_ = gts[(size_t)tk_ * 16 + dir * 4 + h], a_ = LA[tau_], mc_ = LM[(c)]; \
        const float Mj_ = fmaxf(mc_, LPA[tau_]), Me_ = fmaxf(mc_, LPA[(c) * 128 + 127]); float* tb_ = LTAB + ((c) & 1) * 512; \
        tb_[tid] = Mj_; tb_[128 + tid] = __expf(mc_ - Mj_); tb_[256 + tid] = __expf(-((li_ - a_) + Mj_)); tb_[384 + tid] = __expf(a_ - Me_); } } while (0)
#define ML_STORE(c) do { _Pragma("unroll") for (int i_ = 0; i_ < 4; ++i_) { const int row_ = (tid >> 4) + 32 * i_; \
        *(u32x4*)(smem + OFF_Q + row_ * RS + (tid & 15) * 16) = qreg[i_]; *(u32x4*)(smem + OFF_K + row_ * RS + (tid & 15) * 16) = kreg[i_]; } \
      { const int s_ = tid >> 2, ps_ = spos(s_) * 2; const float we_ = LTAB[((c) & 1) * 512 + 384 + s_]; const u32 vw_[4] = {vreg.x, vreg.y, vreg.z, vreg.w}; \
        _Pragma("unroll") for (int i_ = 0; i_ < 4; ++i_) { const int r0_ = ((tid & 3) * 8 + 2 * i_) * RS + ps_; \
          *(bf16_t*)(smem + OFF_VT + r0_) = (bf16_t)(vw_[i_] & 0xFFFFu); *(bf16_t*)(smem + OFF_VT + r0_ + RS) = (bf16_t)(vw_[i_] >> 16); \
          *(bf16_t*)(smem + OFF_VW + r0_) = f2bf(bflo(vw_[i_]) * we_); *(bf16_t*)(smem + OFF_VW + r0_ + RS) = f2bf(bfhi(vw_[i_]) * we_); } } \
      if (tid < 128) { const int ps_ = spos(tid) * 2; *(bf16_t*)(smem + OFF_VT + 32 * RS + ps_) = (bf16_t)0x3F80u; *(bf16_t*)(smem + OFF_VW + 32 * RS + ps_) = f2bf(LTAB[((c) & 1) * 512 + 384 + tid]); } } while (0)
    ML_LOAD(0); ML_TABLES(0);
    __syncthreads();
    ML_STORE(0);
    __syncthreads();
    f32x16 Cacc;
#pragma unroll
    for (int r = 0; r < 16; ++r) Cacc[r] = 0.f;
    for (int c = 0; c < 32; ++c) {
      int tidc_ = threadIdx.x; asm volatile("" : "+v"(tidc_));
      const int tid = tidc_, wid = tid >> 6, lane = tid & 63, l31 = lane & 31, hh = lane >> 5;
      const int t2 = wid >> 1, nt = wid & 1, brow = min(nt * 32 + l31, 33);
      if (c + 1 < 32) { ML_LOAD(c + 1); ML_TABLES(c + 1); }
      const float* tab = LTAB + (c & 1) * 512;
      f32x16 acc;
#pragma unroll
      for (int r = 0; r < 16; ++r) acc[r] = 0.f;
      const char* qa = smem + OFF_Q + (t2 * 32 + l31) * RS + hh * 16;
      { const char* cb = smem + OFF_CT + brow * RS + hh * 16;
#pragma unroll
        for (int ks = 0; ks < 8; ++ks) acc = ML_MFMA(*(const bf16x8*)(qa + ks * 32), *(const bf16x8*)(cb + ks * 32), acc); }
#pragma unroll
      for (int r = 0; r < 16; ++r) acc[r] *= tab[128 + t2 * 32 + crow(r, hh)];
      const float Mj = tab[t2 * 32 + l31];
      for (int si = 0; si <= t2; ++si) {
        f32x16 X;
#pragma unroll
        for (int r = 0; r < 16; ++r) X[r] = 0.f;
        const char* ka = smem + OFF_K + (si * 32 + l31) * RS + hh * 16;
#pragma unroll
        for (int ks = 0; ks < 8; ++ks) X = ML_MFMA(*(const bf16x8*)(ka + ks * 32), *(const bf16x8*)(qa + ks * 32), X);
        const float* Ac = LA + c * 128 + si * 32;
#pragma unroll
        for (int r = 0; r < 16; ++r) { const int sl = crow(r, hh); float w = __expf(Ac[sl] - Mj); if (si == t2 && sl > l31) w = 0.f; X[r] *= w; }
        const bf16x8 f0 = pack8(X[0], X[1], X[2], X[3], X[4], X[5], X[6], X[7]), f1 = pack8(X[8], X[9], X[10], X[11], X[12], X[13], X[14], X[15]);
        const char* vb = smem + OFF_VT + brow * RS + si * 64 + hh * 16;
        acc = ML_MFMA(f0, *(const bf16x8*)(vb), acc); acc = ML_MFMA(f1, *(const bf16x8*)(vb + 32), acc);
      }
      if (nt == 1 && l31 == 0) {
#pragma unroll
        for (int r = 0; r < 16; ++r) LDEN[t2 * 32 + crow(r, hh)] = acc[r]; }
      { const float mc = LM[c], decay = __expf(mc - fmaxf(mc, LPA[c * 128 + 127]));
#pragma unroll
        for (int r = 0; r < 16; ++r) Cacc[r] *= decay;
        const unsigned ta = lds0 + OFF_K + ((lane & 15) >> 2) * RS + (t2 * 32 + 16 * ((lane >> 4) & 1) + 4 * (lane & 3)) * 2 + 4 * hh * RS;
        const char* wb = smem + OFF_VW + brow * RS + hh * 16;
#pragma unroll
        for (int ks = 0; ks < 8; ++ks) { s16x4 lo, hi; tr_read2(ta + 16 * ks * RS, ta + (16 * ks + 8) * RS, lo, hi); __builtin_amdgcn_sched_barrier(0);
          const bf16x8 a = (bf16x8){lo[0], lo[1], lo[2], lo[3], hi[0], hi[1], hi[2], hi[3]};
          Cacc = ML_MFMA(a, *(const bf16x8*)(wb + ks * 32), Cacc); } }
      __syncthreads();
      if (nt == 0) {
#pragma unroll
        for (int r = 0; r < 16; ++r) { const int j = t2 * 32 + crow(r, hh); const float dn = LDEN[j], nr = tab[256 + j]; const int tk = ML_TOK(c * 128 + j);
          HSb[(size_t)tk * 512 + l31] = f2bf(acc[r] / fmaxf(fabsf(dn), nr)); } }
      if (nt * 32 + l31 <= 32) { char* cw = smem + OFF_CT + (nt * 32 + l31) * RS + (t2 * 32 + 4 * hh) * 2;
#pragma unroll
        for (int g = 0; g < 4; ++g) { u32x2 w; w.x = pack2(Cacc[4 * g], Cacc[4 * g + 1]); w.y = pack2(Cacc[4 * g + 2], Cacc[4 * g + 3]); *(u32x2*)(cw + 16 * g) = w; } }
      if (c + 1 < 32) ML_STORE(c + 1);
      __syncthreads();
    }
#undef ML_TOK
#undef ML_LOAD
#undef ML_TABLES
#undef ML_STORE
  }
}
}

__device__ void phase_cat(const Params& p) {
  const int tid = threadIdx.x, wid = tid >> 6, lane = tid & 63;
  for (int job = blockIdx.x; job < T * 4 / 8; job += gridDim.x) {
    const int w = job * 8 + wid, t = w >> 2, h = w & 3; const size_t o = (size_t)t * 512 + h * 128 + lane * 2;
    const u32 a = *(const u32*)(p.HS + o), b = *(const u32*)(p.HS + (size_t)T * 512 + o), so = *(const u32*)(p.ZO + o);
    const float a0 = bflo(a) + bflo(b), a1 = bfhi(a) + bfhi(b); const float r = rsqrtf(wave_sum(a0 * a0 + a1 * a1) * (1.f / 128.f) + EPS);
    *(u32*)(p.CAT + (size_t)t * 1024 + h * 128 + lane * 2) = pack2(a0 * r * p.mnorm_g[h * 128 + lane * 2] * bflo(so), a1 * r * p.mnorm_g[h * 128 + lane * 2 + 1] * bfhi(so));
  }
}

__device__ void phase_peer_select_naive(const Params& p, int layer, char* smem) {
  float* kl = (float*)smem;
  float* qsh = kl + 2 * 128 * 129;
  const int tid = threadIdx.x, wid = tid >> 6, lane = tid & 63; float* qs = qsh + wid * 128;
  __syncthreads();
  for (int i = tid; i < 2 * 128 * 128; i += NTHREADS) kl[(i >> 7) * 129 + (i & 127)] = p.peer_keys[(size_t)layer * 32768 + i];
  __syncthreads();
  for (int job = blockIdx.x; job < T; job += gridDim.x) {
    const int t = job, h = wid;
    float ts[2][16]; int ti[2][16];
#pragma unroll
    for (int pp = 0; pp < 2; ++pp) {
      const bf16_t* q = p.QP + (size_t)t * 2048 + h * 256 + pp * 128; const float q0 = bf2f(q[lane]), q1 = bf2f(q[lane + 64]);
      const float r = rsqrtf(wave_sum(q0 * q0 + q1 * q1) * (1.f / 128.f) + EPS); qs[lane] = q0 * r; qs[lane + 64] = q1 * r;
      float s0 = 0.f, s1 = 0.f; const float* k0 = kl + (pp * 128 + lane) * 129; const float* k1 = k0 + 64 * 129;
      for (int c = 0; c < 128; ++c) { const float qc = qs[c]; s0 += qc * k0[c]; s1 += qc * k1[c]; }
#pragma unroll
      for (int k = 0; k < 16; ++k) { const float mx = wave_max(fmaxf(s0, s1)); int cand = (s0 == mx) ? lane : ((s1 == mx) ? lane + 64 : 9999);
        for (int o = 32; o >= 1; o >>= 1) cand = min(cand, __shfl_xor(cand, o));
        ts[pp][k] = mx; ti[pp][k] = cand; if (cand == lane) s0 = -INFINITY; if (cand == lane + 64) s1 = -INFINITY; }
    }
    float cs[4];
#pragma unroll
    for (int r = 0; r < 4; ++r) { const int c = lane * 4 + r; float va = 0.f, vb = 0.f;
#pragma unroll
      for (int k = 0; k < 16; ++k) { if (k == (c >> 4)) va = ts[0][k]; if (k == (c & 15)) vb = ts[1][k]; }
      cs[r] = va + vb; }
    float top[16]; int tix[16];
#pragma unroll
    for (int k = 0; k < 16; ++k) { const float mx = wave_max(fmaxf(fmaxf(cs[0], cs[1]), fmaxf(cs[2], cs[3]))); int cand = 9999;
#pragma unroll
      for (int r = 3; r >= 0; --r) if (cs[r] == mx) cand = lane * 4 + r;
      for (int o = 32; o >= 1; o >>= 1) cand = min(cand, __shfl_xor(cand, o));
      top[k] = mx; tix[k] = cand;
#pragma unroll
      for (int r = 0; r < 4; ++r) if (cand == lane * 4 + r) cs[r] = -INFINITY; }
    float sum = 0.f;
#pragma unroll
    for (int k = 0; k < 16; ++k) sum += __expf(top[k] - top[0]);
    if (lane < 16) { float tv = 0.f; int tc = 0;
#pragma unroll
      for (int k = 0; k < 16; ++k) if (k == lane) { tv = top[k]; tc = tix[k]; }
      int ia = 0, ib = 0;
#pragma unroll
      for (int k = 0; k < 16; ++k) { if (k == (tc >> 4)) ia = ti[0][k]; if (k == (tc & 15)) ib = ti[1][k]; }
      p.pidx[((size_t)t * 8 + h) * 16 + lane] = (bf16_t)(ia * 128 + ib); p.pgate[((size_t)t * 8 + h) * 16 + lane] = __expf(tv - top[0]) / sum; }
  }
}

template <int NEXT>
__device__ void phase_peer_gather(const Params& p, int layer) {
  const int tid = threadIdx.x, wid = tid >> 6, lane = tid & 63;
  const bf16_t* U = p.U + (size_t)layer * 16384 * 1024; const bf16_t* V = p.V + (size_t)layer * 16384 * 1024;
  for (int job = blockIdx.x; job < T / 8; job += gridDim.x) {
    const int t = job * 8 + wid, b = t / S;
    u32x4 h0 = *(const u32x4*)(p.H + (size_t)t * D + lane * 8), h1 = *(const u32x4*)(p.H + (size_t)t * D + 512 + lane * 8);
    float acc[16];
#pragma unroll
    for (int i = 0; i < 16; ++i) acc[i] = 0.f;
    for (int hh = 0; hh < 8; ++hh) {
      int myidx = 0; float mygate = 0.f;
      if (lane < 16) { myidx = p.pidx[((size_t)t * 8 + hh) * 16 + lane]; mygate = p.pgate[((size_t)t * 8 + hh) * 16 + lane]; }
#pragma unroll 1
      for (int half = 0; half < 4; ++half) {
        u32x4 ua[4], ub[4], va[4], vb[4];
#pragma unroll
        for (int k = 0; k < 4; ++k) { const int e = __builtin_amdgcn_readlane(myidx, half * 4 + k); const bf16_t* ur = U + (size_t)e * 1024 + lane * 8; const bf16_t* vr = V + (size_t)e * 1024 + lane * 8;
          ua[k] = *(const u32x4*)ur; ub[k] = *(const u32x4*)(ur + 512); va[k] = *(const u32x4*)vr; vb[k] = *(const u32x4*)(vr + 512); }
        float dp[4];
#pragma unroll
        for (int k = 0; k < 4; ++k) { float a = 0.f;
          a = dot2bf(ua[k].x, h0.x, a);
          a = dot2bf(ua[k].y, h0.y, a);
          a = dot2bf(ua[k].z, h0.z, a);
          a = dot2bf(ua[k].w, h0.w, a);
          a = dot2bf(ub[k].x, h1.x, a);
          a = dot2bf(ub[k].y, h1.y, a);
          a = dot2bf(ub[k].z, h1.z, a);
          a = dot2bf(ub[k].w, h1.w, a);
          dp[k] = wave_sum(a); }
#pragma unroll
        for (int k = 0; k < 4; ++k) { const float z = dp[k]; const float gt = __uint_as_float(__builtin_amdgcn_readlane(__float_as_uint(mygate), half * 4 + k));
          const float cf = gt * 0.5f * z * (1.f + erff(z * 0.70710678118654752f));
          acc[0] += cf * bflo(va[k].x); acc[1] += cf * bfhi(va[k].x); acc[2] += cf * bflo(va[k].y); acc[3] += cf * bfhi(va[k].y);
          acc[4] += cf * bflo(va[k].z); acc[5] += cf * bfhi(va[k].z); acc[6] += cf * bflo(va[k].w); acc[7] += cf * bfhi(va[k].w);
          acc[8] += cf * bflo(vb[k].x); acc[9] += cf * bfhi(vb[k].x); acc[10] += cf * bflo(vb[k].y); acc[11] += cf * bfhi(vb[k].y);
          acc[12] += cf * bflo(vb[k].z); acc[13] += cf * bfhi(vb[k].z); acc[14] += cf * bflo(vb[k].w); acc[15] += cf * bfhi(vb[k].w); }
      }
    }
    const float* g2 = p.mod + (size_t)(layer * 8 + b) * 6144 + 5120;
    float xv[16]; float ss = 0.f;
#pragma unroll
    for (int hf = 0; hf < 2; ++hf) { const int d = hf * 512 + lane * 8; float* xp = p.X + (size_t)t * D + d;
      f32x4 x0 = *(const f32x4*)xp, x1 = *(const f32x4*)(xp + 4), g0 = *(const f32x4*)(g2 + d), g1 = *(const f32x4*)(g2 + d + 4);
      xv[hf * 8 + 0] = x0.x + g0.x * acc[hf * 8 + 0]; xv[hf * 8 + 1] = x0.y + g0.y * acc[hf * 8 + 1]; xv[hf * 8 + 2] = x0.z + g0.z * acc[hf * 8 + 2]; xv[hf * 8 + 3] = x0.w + g0.w * acc[hf * 8 + 3];
      xv[hf * 8 + 4] = x1.x + g1.x * acc[hf * 8 + 4]; xv[hf * 8 + 5] = x1.y + g1.y * acc[hf * 8 + 5]; xv[hf * 8 + 6] = x1.z + g1.z * acc[hf * 8 + 6]; xv[hf * 8 + 7] = x1.w + g1.w * acc[hf * 8 + 7]; }
#pragma unroll
    for (int i = 0; i < 16; ++i) ss += xv[i] * xv[i];
    ss = wave_sum(ss); const float r = rsqrtf(ss * (1.f / D) + EPS);
    if (NEXT == 0) {
      const float* ml = p.mod + (size_t)((layer + 1) * 8 + b) * 6144; const float* gn = p.nmg + (layer + 1) * D;
#pragma unroll
      for (int hf = 0; hf < 2; ++hf) { const int d = hf * 512 + lane * 8; float* xp = p.X + (size_t)t * D + d; float y[8];
#pragma unroll
        for (int i = 0; i < 8; ++i) y[i] = xv[hf * 8 + i] * r * gn[d + i] * (1.f + ml[1024 + d + i]) + ml[d + i];
        *(f32x4*)xp = (f32x4){xv[hf * 8 + 0], xv[hf * 8 + 1], xv[hf * 8 + 2], xv[hf * 8 + 3]}; *(f32x4*)(xp + 4) = (f32x4){xv[hf * 8 + 4], xv[hf * 8 + 5], xv[hf * 8 + 6], xv[hf * 8 + 7]};
        u32x4 w; w.x = pack2(y[0], y[1]); w.y = pack2(y[2], y[3]); w.z = pack2(y[4], y[5]); w.w = pack2(y[6], y[7]); *(u32x4*)(p.H + (size_t)t * D + d) = w; }
    } else {
#pragma unroll
      for (int hf = 0; hf < 2; ++hf) { const int d = hf * 512 + lane * 8; float* xp = p.X + (size_t)t * D + d; float y[8];
#pragma unroll
        for (int i = 0; i < 8; ++i) y[i] = xv[hf * 8 + i] * r * p.final_g[d + i];
        *(f32x4*)xp = (f32x4){y[0], y[1], y[2], y[3]}; *(f32x4*)(xp + 4) = (f32x4){y[4], y[5], y[6], y[7]}; }
    }
  }
}

__device__ void phase_qkrope(const Params& p) {
  const int tid = threadIdx.x, wid = tid >> 6, lane = tid & 63;
  for (int job = blockIdx.x; job < T * 12 / 8; job += gridDim.x) {
    const int w = job * 8 + wid, t = w / 12, hh = w % 12, b = t / S, s = t & (S - 1);
    const u32 raw = *(const u32*)(p.QKV + (size_t)t * 1536 + hh * 128 + lane * 2); float x0 = bflo(raw), x1 = bfhi(raw);
    if (hh < 10) { const float* g = hh < 8 ? p.qn_g : p.kn_g; const float r = rsqrtf(wave_sum(x0 * x0 + x1 * x1) * (1.f / 128.f) + EPS); x0 *= r * g[2 * lane]; x1 *= r * g[2 * lane + 1];
      const int pos = lane < 32 ? (s >> 6) : (s & 63); const int fi = lane & 31; const float fr = exp2f(-(float)(2 * fi) * (13.287712379549449f / 64.f)); const float ang = (float)pos * fr;
      float sn, cs; sincosf(ang, &sn, &cs); const float y0 = x0 * cs - x1 * sn, y1 = x0 * sn + x1 * cs; x0 = y0; x1 = y1; }
    bf16_t* dst = hh < 8 ? p.Qh + (((size_t)b * 8 + hh) * S + s) * 128 : (hh < 10 ? p.Kh + (((size_t)b * 2 + hh - 8) * S + s) * 128 : p.Vh + (((size_t)b * 2 + hh - 10) * S + s) * 128);
    *(u32*)(dst + lane * 2) = pack2(x0, x1);
  }
}

__device__ void phase_attn_naive(const Params& p) {
  const int tid = threadIdx.x, wid = tid >> 6, lane = tid & 63;
  for (int job = blockIdx.x; job < T * 2 / 8; job += gridDim.x) {
    const int w = job * 8 + wid, kv = w & 1, t = w >> 1, b = t / S, s = t & (S - 1);
    float q0[4], q1[4], m[4], l[4], o0[4], o1[4];
#pragma unroll
    for (int g = 0; g < 4; ++g) { const u32 qq = *(const u32*)(p.Qh + (((size_t)b * 8 + kv * 4 + g) * S + s) * 128 + lane * 2); q0[g] = bflo(qq); q1[g] = bfhi(qq); m[g] = -1e30f; l[g] = 0.f; o0[g] = 0.f; o1[g] = 0.f; }
    const bf16_t* Kb = p.Kh + ((size_t)b * 2 + kv) * S * 128; const bf16_t* Vb = p.Vh + ((size_t)b * 2 + kv) * S * 128;
    for (int k = 0; k < S; ++k) { const u32 kk = *(const u32*)(Kb + (size_t)k * 128 + lane * 2), vv = *(const u32*)(Vb + (size_t)k * 128 + lane * 2);
      const float k0 = bflo(kk), k1 = bfhi(kk), v0 = bflo(vv), v1 = bfhi(vv);
#pragma unroll
      for (int g = 0; g < 4; ++g) { const float sc = wave_sum(q0[g] * k0 + q1[g] * k1) * KSCALE; const float mn = fmaxf(m[g], sc), al = __expf(m[g] - mn), pw = __expf(sc - mn);
        l[g] = l[g] * al + pw; o0[g] = o0[g] * al + pw * v0; o1[g] = o1[g] * al + pw * v1; m[g] = mn; } }
#pragma unroll
    for (int g = 0; g < 4; ++g) *(u32*)(p.CAT + (size_t)t * 1024 + (kv * 4 + g) * 128 + lane * 2) = pack2(o0[g] / l[g], o1[g] / l[g]);
  }
}

namespace att {
using bf16 = unsigned short;
constexpr int   D = 128, NW = 8, QBLK = 32, KVBLK = 64;
constexpr float SCALE = 0.088388347648318440f;
constexpr float THR = 8.f;
constexpr int SDEPTH = 2;
constexpr int LDQ = 128, LDK = 128, LDO = 1024;
constexpr size_t SHM_V = KVBLK * D * 2, SHM_K = KVBLK * D * 2, SHM_ATTN = 2 * SHM_V + 2 * SHM_K + NW * 64 * 4;
using bf16x8 = __attribute__((ext_vector_type(8))) short;
using s16x4  = __attribute__((ext_vector_type(4))) short;
using f32x16 = __attribute__((ext_vector_type(16))) float;
using f32x8  = __attribute__((ext_vector_type(8))) float;
using u32x4  = __attribute__((ext_vector_type(4))) unsigned;
#define KSWZ(row, colB) ((row) * 256 + ((colB) ^ (((row) & 7) << 4)))
#define SBAR() __builtin_amdgcn_sched_barrier(0)
__device__ __forceinline__ int crow(int r, int hi) { return (r & 3) + 8 * (r >> 2) + 4 * hi; }
__device__ __forceinline__ unsigned cvtpk(float lo, float hi) {
  unsigned r; asm volatile("v_cvt_pk_bf16_f32 %0, %1, %2" : "=v"(r) : "v"(lo), "v"(hi)); return r;
}
template <typename TIn> struct Stage;
template <> struct Stage<bf16>  { using T = bf16x8;
  __device__ static __forceinline__ T ld8(const bf16* p) { return *reinterpret_cast<const bf16x8*>(p); }
  __device__ static __forceinline__ bf16x8 tobf(T x) { return x; } };
template <> struct Stage<float> { using T = f32x8;
  __device__ static __forceinline__ T ld8(const float* p) { return *reinterpret_cast<const f32x8*>(p); }
  __device__ static __forceinline__ bf16x8 tobf(T x) {
    u32x4 w = {cvtpk(x[0], x[1]), cvtpk(x[2], x[3]), cvtpk(x[4], x[5]), cvtpk(x[6], x[7])}; return *reinterpret_cast<bf16x8*>(&w); } };

__device__ __forceinline__ void partialSM(f32x16& p0, f32x16& p1, float& m_reg, float& mn, float& alpha) {
  constexpr float C = SCALE * 1.4426950408889634f;
  float pmax = p0[0]; for (int r = 1; r < 16; ++r) pmax = fmaxf(pmax, p0[r]); for (int r = 0; r < 16; ++r) pmax = fmaxf(pmax, p1[r]);
  { auto rr = __builtin_amdgcn_permlane32_swap(__float_as_uint(pmax), __float_as_uint(pmax), false, false);
    pmax = fmaxf(__uint_as_float(rr[0]), __uint_as_float(rr[1])); }
  if (__builtin_expect(__all(pmax - m_reg <= THR / SCALE), 1)) { mn = m_reg; alpha = 1.f; }
  else { mn = fmaxf(m_reg, pmax); alpha = __builtin_amdgcn_exp2f((m_reg - mn) * C); m_reg = mn; }
  float mnC = -mn * C;
  for (int r = 0; r < 16; ++r) p0[r] = fmaf(p0[r], C, mnC); for (int r = 0; r < 16; ++r) p1[r] = fmaf(p1[r], C, mnC);
  for (int r = 0; r < 16; ++r) p0[r] = __builtin_amdgcn_exp2f(p0[r]);
}
__device__ __forceinline__ void finishSM(f32x16& p0, f32x16& p1, float alpha, float& l_reg, bf16x8& pa0, bf16x8& pa1, bf16x8& pa2, bf16x8& pa3) {
  for (int r = 0; r < 16; ++r) p1[r] = __builtin_amdgcn_exp2f(p1[r]);
  float ps = 0; for (int r = 0; r < 16; ++r) ps += p0[r]; for (int r = 0; r < 16; ++r) ps += p1[r];
  { auto rr = __builtin_amdgcn_permlane32_swap(__float_as_uint(ps), __float_as_uint(ps), false, false);
    ps = __uint_as_float(rr[0]) + __uint_as_float(rr[1]); }
  l_reg = l_reg * alpha + ps;
#define PK4(P, BASE, OUT) do { unsigned a0 = cvtpk(P[BASE + 0], P[BASE + 1]), a1 = cvtpk(P[BASE + 2], P[BASE + 3]);   \
    unsigned b0 = cvtpk(P[BASE + 4], P[BASE + 5]), b1 = cvtpk(P[BASE + 6], P[BASE + 7]);                              \
    auto r0 = __builtin_amdgcn_permlane32_swap(a0, b0, false, false); auto r1 = __builtin_amdgcn_permlane32_swap(a1, b1, false, false); \
    u32x4 w = {r0[0], r1[0], r0[1], r1[1]}; OUT = *reinterpret_cast<bf16x8*>(&w); } while (0)
  PK4(p0, 0, pa0); PK4(p0, 8, pa1); PK4(p1, 0, pa2); PK4(p1, 8, pa3);
#undef PK4
}
__device__ __forceinline__ void qkt(f32x16& p0, f32x16& p1, const bf16* Ks, const bf16x8* qr, int r32, int hi) {
  p0 = f32x16{}; p1 = f32x16{};
  for (int d0 = 0; d0 < 8; ++d0) { int cb = (d0 * 16 + hi * 8) * 2;
    bf16x8 b0 = *reinterpret_cast<const bf16x8*>((const char*)Ks + KSWZ(r32, cb));
    bf16x8 b1 = *reinterpret_cast<const bf16x8*>((const char*)Ks + KSWZ(32 + r32, cb));
    p0 = __builtin_amdgcn_mfma_f32_32x32x16_bf16(b0, qr[d0], p0, 0, 0, 0);
    p1 = __builtin_amdgcn_mfma_f32_32x32x16_bf16(b1, qr[d0], p1, 0, 0, 0); }
}
__device__ __forceinline__ int v_st(int k, int c) { const int kk = (k & ~0xC) | ((k & 4) << 1) | ((k & 8) >> 1); return ((kk >> 3) * 4 + (c >> 5)) * 512 + ((kk & 7) * 32 + (c & 31)) * 2; }
__device__ __forceinline__ int v_rd_base(int lane) { return ((lane & 3) << 3) | (((lane >> 2) & 3) << 6) | (((lane >> 4) & 1) << 5) | (((lane >> 5) & 1) << 8); }
constexpr int v_rd_off(int d0, int ks, int half) { return d0 * 512 + ks * 4096 + half * 2048; }
template <int OFF> __device__ __forceinline__ s16x4 tr_read(int vb) {
  s16x4 r; asm volatile("ds_read_b64_tr_b16 %0, %1 offset:%2" : "=&v"(r) : "v"(vb), "i"(OFF) : "memory"); return r;
}
template <int D0> __device__ __forceinline__ void pv_one(f32x16& od, int vb, bf16x8 pa0, bf16x8 pa1, bf16x8 pa2, bf16x8 pa3) {
  const s16x4 l0 = tr_read<v_rd_off(D0, 0, 0)>(vb), h0 = tr_read<v_rd_off(D0, 0, 1)>(vb), l1 = tr_read<v_rd_off(D0, 1, 0)>(vb), h1 = tr_read<v_rd_off(D0, 1, 1)>(vb);
  const s16x4 l2 = tr_read<v_rd_off(D0, 2, 0)>(vb), h2 = tr_read<v_rd_off(D0, 2, 1)>(vb), l3 = tr_read<v_rd_off(D0, 3, 0)>(vb), h3 = tr_read<v_rd_off(D0, 3, 1)>(vb);
  asm volatile("s_waitcnt lgkmcnt(0)" ::: "memory"); SBAR();
#define PK(L, H) (bf16x8){L[0], L[1], L[2], L[3], H[0], H[1], H[2], H[3]}
  od = __builtin_amdgcn_mfma_f32_32x32x16_bf16(pa0, PK(l0, h0), od, 0, 0, 0);
  od = __builtin_amdgcn_mfma_f32_32x32x16_bf16(pa1, PK(l1, h1), od, 0, 0, 0);
  od = __builtin_amdgcn_mfma_f32_32x32x16_bf16(pa2, PK(l2, h2), od, 0, 0, 0);
  od = __builtin_amdgcn_mfma_f32_32x32x16_bf16(pa3, PK(l3, h3), od, 0, 0, 0);
#undef PK
}
__device__ __forceinline__ void pv_d0(f32x16* o, int vb, bf16x8 pa0, bf16x8 pa1, bf16x8 pa2, bf16x8 pa3) {
  pv_one<0>(o[0], vb, pa0, pa1, pa2, pa3); pv_one<1>(o[1], vb, pa0, pa1, pa2, pa3); pv_one<2>(o[2], vb, pa0, pa1, pa2, pa3); pv_one<3>(o[3], vb, pa0, pa1, pa2, pa3);
}

template <typename TQ>
__device__ __forceinline__ void attn_dense_body(const TQ* __restrict__ Qb, const bf16* __restrict__ Kh, const bf16* __restrict__ Vh,
                                                bf16* __restrict__ Ob, int seq, char* lds) {
  using St = Stage<bf16>; using SQ = Stage<TQ>;
  int tid_ = threadIdx.x; asm volatile("" : "+v"(tid_)); const int tid = tid_, wid = tid >> 6, lane = tid & 63, r32 = lane & 31, hi = lane >> 5;
  bf16* V_lds = (bf16*)lds; bf16* K_lds = (bf16*)(lds + 2 * SHM_V);
  float* ws = (float*)(lds + 2 * SHM_V + 2 * SHM_K) + wid * 64; float* li_l = ws; float* al_l = ws + 32;
  float m_reg = -1e30f, l_reg = 0; f32x16 o[4] = {}; bf16x8 qr[8];
  const TQ* Qw = Qb + (long)(wid * QBLK + r32) * LDQ + hi * 8;
#pragma unroll
  for (int d0 = 0; d0 < 8; ++d0) qr[d0] = SQ::tobf(SQ::ld8(Qw + d0 * 16));
  const int sr = tid >> 4, sc = (tid & 15) * 8, vst0 = v_st(sr, sc), vst1 = v_st(32 + sr, sc);
  const int vb0 = (int)(uintptr_t)V_lds + v_rd_base(lane);
  struct { typename St::T vs0, vs1, ks0, ks1; } sr_[SDEPTH];
#define SLOAD(i, k0) do { sr_[i].vs0 = St::ld8(&Vh[(long)((k0) + sr) * LDK + sc]); sr_[i].vs1 = St::ld8(&Vh[(long)((k0) + 32 + sr) * LDK + sc]); \
    sr_[i].ks0 = St::ld8(&Kh[(long)((k0) + sr) * LDK + sc]); sr_[i].ks1 = St::ld8(&Kh[(long)((k0) + 32 + sr) * LDK + sc]); } while (0)
#define SWRITE(b, i) do { *(bf16x8*)((char*)V_lds + (b) * SHM_V + vst0) = St::tobf(sr_[i].vs0);          \
    *(bf16x8*)((char*)V_lds + (b) * SHM_V + vst1) = St::tobf(sr_[i].vs1); int kc = sc * 2;               \
    *(bf16x8*)((char*)K_lds + (b) * SHM_K + KSWZ(sr, kc)) = St::tobf(sr_[i].ks0);                       \
    *(bf16x8*)((char*)K_lds + (b) * SHM_K + KSWZ(32 + sr, kc)) = St::tobf(sr_[i].ks1); } while (0)
#define SWAIT() do { if constexpr (SDEPTH == 2) asm volatile("s_waitcnt vmcnt(4)" ::: "memory"); else asm volatile("s_waitcnt vmcnt(0)" ::: "memory"); } while (0)
#define RESC(a) do { if (__any((a) < 1.f)) { if (hi == 0) al_l[r32] = (a); asm volatile("s_waitcnt lgkmcnt(0)" ::: "memory"); \
    for (int d = 0; d < 4; ++d) for (int r = 0; r < 16; ++r) o[d][r] *= al_l[crow(r, hi)]; } } while (0)
  f32x16 pA0, pA1, pB0, pB1; float mnA, mnB, alA, alB; bf16x8 pa0, pa1, pa2, pa3; const int NT = seq / KVBLK;
  constexpr int SE = 0, SO = SDEPTH - 1;
  SLOAD(SE, 0); asm volatile("s_waitcnt vmcnt(0)" ::: "memory"); SWRITE(0, SE); __syncthreads();
  qkt(pA0, pA1, K_lds, qr, r32, hi); partialSM(pA0, pA1, m_reg, mnA, alA);
  SLOAD(SO, KVBLK); if constexpr (SDEPTH == 2) { if (2 < NT) SLOAD(SE, 2 * KVBLK); }
  SWAIT(); SWRITE(1, SO); __syncthreads();
  for (int j = 1; j + 1 < NT; j += 2) {
    SBAR(); qkt(pB0, pB1, (bf16*)((char*)K_lds + SHM_K), qr, r32, hi);
    finishSM(pA0, pA1, alA, l_reg, pa0, pa1, pa2, pa3); SBAR();
    SLOAD(SO, (j + SDEPTH) * KVBLK); SBAR();
    pv_d0(o, vb0, pa0, pa1, pa2, pa3); partialSM(pB0, pB1, m_reg, mnB, alB);
    __syncthreads(); SWAIT(); SWRITE(0, SE);
    RESC(alB); __syncthreads();
    SBAR(); qkt(pA0, pA1, K_lds, qr, r32, hi);
    finishSM(pB0, pB1, alB, l_reg, pa0, pa1, pa2, pa3); SBAR();
    if (SDEPTH == 1 || j + 3 < NT) SLOAD(SE, (j + 1 + SDEPTH) * KVBLK); SBAR();
    pv_d0(o, vb0 + (int)SHM_V, pa0, pa1, pa2, pa3); partialSM(pA0, pA1, m_reg, mnA, alA);
    __syncthreads(); SWAIT(); SWRITE(1, SO);
    RESC(alA); __syncthreads();
  }
  SBAR(); qkt(pB0, pB1, (bf16*)((char*)K_lds + SHM_K), qr, r32, hi);
  finishSM(pA0, pA1, alA, l_reg, pa0, pa1, pa2, pa3); SBAR();
  pv_d0(o, vb0, pa0, pa1, pa2, pa3); partialSM(pB0, pB1, m_reg, mnB, alB);
  __syncthreads(); RESC(alB);
  finishSM(pB0, pB1, alB, l_reg, pa0, pa1, pa2, pa3); SBAR();
  pv_d0(o, vb0 + (int)SHM_V, pa0, pa1, pa2, pa3);
  if (hi == 0) li_l[r32] = l_reg; asm volatile("s_waitcnt lgkmcnt(0)" ::: "memory");
  float rli[16];
#pragma unroll
  for (int r = 0; r < 16; ++r) rli[r] = __builtin_amdgcn_rcpf(li_l[crow(r, hi)]);
  __syncthreads();
  bf16* Ol = (bf16*)lds + wid * (QBLK * D);
#pragma unroll
  for (int r = 0; r < 16; ++r) { const int orow = crow(r, hi);
#pragma unroll
    for (int d0 = 0; d0 < 4; ++d0) { const float v = o[d0][r] * rli[r]; unsigned u = __float_as_uint(v); u += 0x7FFFu + ((u >> 16) & 1u); Ol[orow * D + d0 * 32 + r32] = (bf16)(u >> 16); } }
  asm volatile("s_waitcnt lgkmcnt(0)" ::: "memory");
#pragma unroll
  for (int i = 0; i < 8; ++i) { const int row = i * 4 + (lane >> 4), ch = (lane & 15) * 8;
    const u32x4 v = *reinterpret_cast<const u32x4*>(Ol + row * D + ch);
    *reinterpret_cast<u32x4*>(Ob + (long)(wid * QBLK + row) * LDO + ch) = v; }
  __syncthreads();
#undef SLOAD
#undef SWRITE
#undef SWAIT
#undef RESC
}

}

__device__ void phase_attn(const Params& p, char* smem) {
  const int G = (int)gridDim.x, c = (int)blockIdx.x;
  for (int i = 0; i * G + c < 1024; ++i) {
    int pair, j;
    if (G == 256) { pair = 2 * (c & 7) + (i >> 1); j = (i & 1) * 32 + (c >> 3); } else { const int L = i * G + c; pair = L >> 6; j = L & 63; }
    const int b = pair >> 1, kv = pair & 1, qb = j >> 2, g = j & 3, h = kv * 4 + g;
    const bf16_t* Qb = p.Qh + (((size_t)b * 8 + h) * S + qb * 256) * 128; const bf16_t* Kp = p.Kh + ((size_t)b * 2 + kv) * S * 128; const bf16_t* Vp = p.Vh + ((size_t)b * 2 + kv) * S * 128;
    bf16_t* Ob = p.CAT + ((size_t)b * S + qb * 256) * 1024 + h * 128;
    att::attn_dense_body<att::bf16>(Qb, Kp, Vp, Ob, S, smem);
  }
}

constexpr int NPH = 19;
__global__ __launch_bounds__(NTHREADS, 2) void mega(Params p, int ph0, int ph1) {
  extern __shared__ __attribute__((aligned(16))) char smem[];
  cg::grid_group grid = cg::this_grid();
#define PHASE(k, call) if (ph0 <= (k) && (k) < ph1) { if ((k) > ph0) grid.sync(); call; }
#if !defined(ONLY_PHASE) || ONLY_PHASE == 0
  PHASE(0, phase_prep(p, smem))
#endif
#if !defined(ONLY_PHASE) || ONLY_PHASE == 1
  PHASE(1, phase_norm<true>(p, p.x, p.nmg, p.mod, 0, 1024, smem))
#endif
#if !defined(ONLY_PHASE) || ONLY_PHASE == 2
  PHASE(2, phase_gemm_fast(p.H, p.Wt_evin, T, 2560, 1024, (EpiEvin{p.ZQK, p.ZV, p.ZO, p.ZP, p.ev_b_in}), smem))
#endif
#if !defined(ONLY_PHASE) || ONLY_PHASE == 3
  PHASE(3, phase_convpool(p, smem))
#endif
#if !defined(ONLY_PHASE) || ONLY_PHASE == 4
  PHASE(4, ml::phase_mlstm(p, smem))
#endif
#if !defined(ONLY_PHASE) || ONLY_PHASE == 5
  PHASE(5, phase_cat(p))
#endif
#if !defined(ONLY_PHASE) || ONLY_PHASE == 6
  PHASE(6, phase_gemm_fast(p.CAT, p.Wt_evout, T, 1024, 1024, (EpiRes{p.x, p.X, p.mod + 2048}), smem))
#endif
#if !defined(ONLY_PHASE) || ONLY_PHASE == 7
  PHASE(7, phase_norm<false>(p, p.X, p.nfg, p.mod, 3072, 4096, smem))
#endif
#if !defined(ONLY_PHASE) || ONLY_PHASE == 8
  PHASE(8, phase_gemm_fast(p.H, p.Wt_q, T, 2048, 1024, (EpiPlain{p.QP, 2048}), smem))
#endif
#if !defined(ONLY_PHASE) || ONLY_PHASE == 9
  PHASE(9, phase_peer_select_naive(p, 0, smem))
#endif
#if !defined(ONLY_PHASE) || ONLY_PHASE == 10
  PHASE(10, phase_peer_gather<0>(p, 0))
#endif
#if !defined(ONLY_PHASE) || ONLY_PHASE == 11
  PHASE(11, phase_gemm_fast(p.H, p.Wt_odin, T, 1536, 1024, (EpiPlain{p.QKV, 1536}), smem))
#endif
#if !defined(ONLY_PHASE) || ONLY_PHASE == 12
  PHASE(12, phase_qkrope(p))
#endif
#if !defined(ONLY_PHASE) || ONLY_PHASE == 13
  PHASE(13, phase_attn(p, smem))
#endif
#if !defined(ONLY_PHASE) || ONLY_PHASE == 14
  PHASE(14, phase_gemm_fast(p.CAT, p.Wt_odout, T, 1024, 1024, (EpiRes{p.X, p.X, p.mod + (size_t)8 * 6144 + 2048}), smem))
#endif
#if !defined(ONLY_PHASE) || ONLY_PHASE == 15
  PHASE(15, phase_norm<false>(p, p.X, p.nfg + D, p.mod + (size_t)8 * 6144, 3072, 4096, smem))
#endif
#if !defined(ONLY_PHASE) || ONLY_PHASE == 16
  PHASE(16, phase_gemm_fast(p.H, p.Wt_q + (size_t)2048 * 1024, T, 2048, 1024, (EpiPlain{p.QP, 2048}), smem))
#endif
#if !defined(ONLY_PHASE) || ONLY_PHASE == 17
  PHASE(17, phase_peer_select_naive(p, 1, smem))
#endif
#if !defined(ONLY_PHASE) || ONLY_PHASE == 18
  PHASE(18, phase_peer_gather<1>(p, 1))
#endif
#undef PHASE
}
}

extern "C" void kernel_launch(void* const* d_in, const int* in_sizes, int n_in, void* d_out, int out_size, void* d_ws, size_t ws_size, hipStream_t stream) {
  (void)in_sizes; (void)n_in; (void)out_size;
  Params p{};
  const float** fin = (const float**)&p;
  for (int i = 0; i < 23; ++i) fin[i] = (const float*)d_in[i];
  p.X = (float*)d_out;
  char* ws = (char*)d_ws; size_t off = 0;
  auto alloc = [&](size_t bytes) { char* q = ws + off; off += (bytes + 255) / 256 * 256; return q; };
  p.U = (bf16_t*)alloc((size_t)2 * 16384 * 1024 * 2); p.V = (bf16_t*)alloc((size_t)2 * 16384 * 1024 * 2);
  p.Wt_evin = (bf16_t*)alloc((size_t)2560 * 1024 * 2); p.Wt_evout = (bf16_t*)alloc((size_t)1024 * 1024 * 2); p.Wt_odin = (bf16_t*)alloc((size_t)1536 * 1024 * 2);
  p.Wt_odout = (bf16_t*)alloc((size_t)1024 * 1024 * 2); p.Wt_q = (bf16_t*)alloc((size_t)2 * 2048 * 1024 * 2); p.keysb = (bf16_t*)alloc((size_t)2 * 2 * 128 * 128 * 2);
  p.Wg = (float*)alloc(16 * 1024 * 4); p.mod = (float*)alloc(2 * 8 * 6144 * 4); p.gates = (float*)alloc((size_t)T * 16 * 4);
  p.pgate = (float*)alloc((size_t)T * 128 * 4); p.pidx = (bf16_t*)alloc((size_t)T * 128 * 2);
  p.H = (bf16_t*)alloc((size_t)T * 1024 * 2); p.CAT = p.H;
  char* big = alloc((size_t)T * 2048 * 2);
  p.ZQK = (bf16_t*)big; p.ZV = (bf16_t*)(big + (size_t)T * 1024 * 2); p.ZO = (bf16_t*)(big + (size_t)T * 1536 * 2); p.HS = (bf16_t*)big; p.QP = (bf16_t*)big; p.QKV = (bf16_t*)big;
  char* big2 = alloc((size_t)T * 1536 * 2);
  p.QK = (bf16_t*)big2; p.ZP = (bf16_t*)(big2 + (size_t)T * 1024 * 2); p.Qh = (bf16_t*)big2; p.Kh = (bf16_t*)(big2 + (size_t)T * 1024 * 2); p.Vh = (bf16_t*)(big2 + (size_t)T * 1280 * 2);
  if (off > ws_size) { fprintf(stderr, "kernel_launch: workspace too small: need %zu have %zu\n", off, ws_size); return; }

  static int grid_blocks = 0;
  if (!grid_blocks) {
    int dev = 0, cus = 0, per_cu = 0; hipGetDevice(&dev); hipDeviceGetAttribute(&cus, hipDeviceAttributeMultiprocessorCount, dev);
    hipFuncSetAttribute((const void*)mega, hipFuncAttributeMaxDynamicSharedMemorySize, SMEM_BYTES);
    hipOccupancyMaxActiveBlocksPerMultiprocessor(&per_cu, mega, NTHREADS, SMEM_BYTES);
    if (per_cu > 1) per_cu = 1;
    grid_blocks = cus * per_cu;
    if (grid_blocks <= 0) { fprintf(stderr, "kernel_launch: occupancy query returned 0\n"); grid_blocks = 0; return; }
  }
#if MULTI_LAUNCH
  for (int ph = 0; ph < NPH; ++ph) hipLaunchKernelGGL(mega, dim3(grid_blocks), dim3(NTHREADS), SMEM_BYTES, stream, p, ph, ph + 1);
#else
  int ph0 = 0, ph1 = NPH; void* args[] = {&p, &ph0, &ph1};
  hipError_t e = hipLaunchCooperativeKernel((const void*)mega, dim3(grid_blocks), dim3(NTHREADS), args, SMEM_BYTES, stream);
  if (e != hipSuccess) fprintf(stderr, "cooperative launch failed: %s (grid %d)\n", hipGetErrorString(e), grid_blocks);
#endif
}
```

```cpp
#include <hip/hip_runtime.h>
#include <hip/hip_cooperative_groups.h>
#include <math.h>
#include <stdint.h>
#include <stdio.h>
namespace cg = cooperative_groups;

#ifndef MULTI_LAUNCH
#define MULTI_LAUNCH 0
#endif

namespace {
typedef unsigned short bf16_t;
typedef unsigned int u32;
typedef float f32x4 __attribute__((ext_vector_type(4)));
typedef u32 u32x4 __attribute__((ext_vector_type(4)));
typedef u32 u32x2 __attribute__((ext_vector_type(2)));
typedef __bf16 bf16x2_t __attribute__((ext_vector_type(2)));

constexpr int D = 1024, NB = 8, S = 4096, T = NB * S;
constexpr int EVEN_IN = 2576;
constexpr float EPS = 1e-6f;
constexpr int NTHREADS = 512;
constexpr int SMEM_BYTES = 144 * 1024;
constexpr float KSCALE = 0.08838834764831845f;

struct Params {
  const float *x, *c, *ada_w, *ada_b, *nmg, *nfg, *ev_w_in, *ev_b_in, *conv_w, *conv_b, *mnorm_g, *pool_w, *pool_sc, *ev_w_out, *od_w_in, *qn_g, *kn_g, *od_w_out,
      *peer_wq, *peer_keys, *peer_u, *peer_v, *final_g;
  float* X;
  bf16_t *Wt_evin, *Wt_evout, *Wt_odin, *Wt_odout, *Wt_q, *keysb, *U, *V;
  float *Wg, *mod, *gates, *pgate;
  bf16_t *H, *ZQK, *ZV, *ZO, *ZP, *QK, *HS, *CAT, *QP, *QKV, *Qh, *Kh, *Vh;
  bf16_t* pidx;
};

__device__ __forceinline__ float siluf(float x) { return x / (1.f + __expf(-x)); }
__device__ __forceinline__ float sigmf(float x) { return 1.f / (1.f + __expf(-x)); }
__device__ __forceinline__ float wave_sum(float v) { for (int o = 32; o >= 1; o >>= 1) v += __shfl_xor(v, o); return v; }
__device__ __forceinline__ float wave_max(float v) { for (int o = 32; o >= 1; o >>= 1) v = fmaxf(v, __shfl_xor(v, o)); return v; }
__device__ __forceinline__ bf16_t f2bf(float f) { u32 u = __float_as_uint(f); u += 0x7FFFu + ((u >> 16) & 1u); return (bf16_t)(u >> 16); }
__device__ __forceinline__ float bf2f(bf16_t b) { return __uint_as_float(((u32)b) << 16); }
__device__ __forceinline__ u32 pack2(float lo, float hi) { return (u32)f2bf(lo) | ((u32)f2bf(hi) << 16); }
__device__ __forceinline__ float bflo(u32 w) { return __uint_as_float(w << 16); }
__device__ __forceinline__ float bfhi(u32 w) { return __uint_as_float(w & 0xFFFF0000u); }
__device__ __forceinline__ float dot2bf(u32 a, u32 b, float c) { return __builtin_amdgcn_fdot2_f32_bf16(__builtin_bit_cast(bf16x2_t, a), __builtin_bit_cast(bf16x2_t, b), c, false); }

constexpr int PJ_MOD = 192, PJ_TR = 2576, PJ_WG = 1, PJ_KEYS = 16, PJ_UV = 16384;
constexpr int PJ_TOTAL = PJ_MOD + PJ_TR + PJ_WG + PJ_KEYS + PJ_UV;

__device__ void prep_transpose_tile(const float* __restrict__ src, int ld, int k0, int n0, bf16_t* __restrict__ dst, int dstK, char* smem) {
  float* tile = (float*)smem;
  const int tid = threadIdx.x;
  __syncthreads();
  for (int pass = 0; pass < 8; ++pass) { int kk = pass * 8 + (tid >> 6), n = tid & 63; tile[kk * 65 + n] = src[(size_t)(k0 + kk) * ld + n0 + n]; }
  __syncthreads();
  int n = tid >> 3, kc = (tid & 7) * 8; u32x4 w;
  w.x = pack2(tile[(kc + 0) * 65 + n], tile[(kc + 1) * 65 + n]); w.y = pack2(tile[(kc + 2) * 65 + n], tile[(kc + 3) * 65 + n]);
  w.z = pack2(tile[(kc + 4) * 65 + n], tile[(kc + 5) * 65 + n]); w.w = pack2(tile[(kc + 6) * 65 + n], tile[(kc + 7) * 65 + n]);
  *(u32x4*)(dst + (size_t)(n0 + n) * dstK + k0 + kc) = w;
}

__device__ void phase_prep(const Params& p, char* smem) {
  const int tid = threadIdx.x;
  for (int job = blockIdx.x; job < PJ_TOTAL; job += gridDim.x) {
    if (job < PJ_MOD) {
      float* cs = (float*)smem; float* red = cs + 8192;
      __syncthreads();
      for (int i = tid; i < 8192; i += NTHREADS) cs[i] = siluf(p.c[i]);
      __syncthreads();
      const int l = job / 96, e0 = (job % 96) * 64, col = tid & 63, dg = tid >> 6;
      float acc[8];
#pragma unroll
      for (int b = 0; b < 8; ++b) acc[b] = 0.f;
      const float* w = p.ada_w + (size_t)l * D * 6144 + e0 + col;
      for (int d = dg * 128; d < dg * 128 + 128; ++d) { float wv = w[(size_t)d * 6144];
#pragma unroll
        for (int b = 0; b < 8; ++b) acc[b] += cs[b * 1024 + d] * wv; }
#pragma unroll
      for (int b = 0; b < 8; ++b) red[(dg * 8 + b) * 64 + col] = acc[b];
      __syncthreads();
      { const int b = tid >> 6; float s = 0.f;
#pragma unroll
        for (int g = 0; g < 8; ++g) s += red[(g * 8 + b) * 64 + col];
        p.mod[(size_t)(l * 8 + b) * 6144 + e0 + col] = s + p.ada_b[l * 6144 + e0 + col]; }
    } else if (job < PJ_MOD + PJ_TR) {
      int tt = job - PJ_MOD;
      if (tt < 640) prep_transpose_tile(p.ev_w_in, EVEN_IN, (tt / 40) * 64, (tt % 40) * 64, p.Wt_evin, 1024, smem);
      else if (tt < 896) { tt -= 640; prep_transpose_tile(p.ev_w_out, 1024, (tt / 16) * 64, (tt % 16) * 64, p.Wt_evout, 1024, smem); }
      else if (tt < 1280) { tt -= 896; prep_transpose_tile(p.od_w_in, 1536, (tt / 24) * 64, (tt % 24) * 64, p.Wt_odin, 1024, smem); }
      else if (tt < 1536) { tt -= 1280; prep_transpose_tile(p.od_w_out, 1024, (tt / 16) * 64, (tt % 16) * 64, p.Wt_odout, 1024, smem); }
      else if (tt < 2560) { tt -= 1536; int l = tt / 512; tt %= 512; prep_transpose_tile(p.peer_wq + (size_t)l * D * 2048, 2048, (tt / 32) * 64, (tt % 32) * 64, p.Wt_q + (size_t)l * 2048 * 1024, 1024, smem); }
      else {   }
    } else if (job < PJ_MOD + PJ_TR + PJ_WG) {
      for (int i = tid; i < 16 * 1024; i += NTHREADS) { int g = i >> 10, d = i & 1023; p.Wg[i] = p.ev_w_in[(size_t)d * EVEN_IN + 2560 + g]; }
    } else if (job < PJ_MOD + PJ_TR + PJ_WG + PJ_KEYS) {
      int j = job - (PJ_MOD + PJ_TR + PJ_WG);
      for (int i = tid; i < 4096; i += NTHREADS) p.keysb[j * 4096 + i] = f2bf(p.peer_keys[j * 4096 + i]);
    } else {
      int j = job - (PJ_MOD + PJ_TR + PJ_WG + PJ_KEYS); const float* src = j < 8192 ? p.peer_u : p.peer_v; bf16_t* dst = j < 8192 ? p.U : p.V; j &= 8191;
      size_t o = (size_t)j * 4096 + tid * 8; f32x4 a = *(const f32x4*)(src + o), b = *(const f32x4*)(src + o + 4);
      u32x4 w; w.x = pack2(a.x, a.y); w.y = pack2(a.z, a.w); w.z = pack2(b.x, b.y); w.w = pack2(b.z, b.w); *(u32x4*)(dst + o) = w;
    }
  }
}

template <bool WITH_GATES>
__device__ void phase_norm(const Params& p, const float* __restrict__ xin, const float* __restrict__ g, const float* __restrict__ modl, int sh_off, int sc_off, char* smem) {
  const int tid = threadIdx.x, wid = tid >> 6, lane = tid & 63;
  float* wg = (float*)smem;
  if (WITH_GATES) { __syncthreads(); for (int i = tid; i < 16 * 1024; i += NTHREADS) wg[i] = p.Wg[i]; __syncthreads(); }
  for (int job = blockIdx.x; job < T / 8; job += gridDim.x) {
    const int t = job * 8 + wid, b = t / S;
    f32x4 v[4]; float ss = 0.f;
#pragma unroll
    for (int i = 0; i < 4; ++i) { v[i] = *(const f32x4*)(xin + (size_t)t * D + i * 256 + lane * 4); ss += v[i].x * v[i].x + v[i].y * v[i].y + v[i].z * v[i].z + v[i].w * v[i].w; }
    ss = wave_sum(ss); const float r = rsqrtf(ss * (1.f / D) + EPS);
    const float* shp = modl + (size_t)b * 6144 + sh_off; const float* scp = modl + (size_t)b * 6144 + sc_off;
#pragma unroll
    for (int i = 0; i < 4; ++i) { const int d = i * 256 + lane * 4; f32x4 gg = *(const f32x4*)(g + d), s1 = *(const f32x4*)(scp + d), s0 = *(const f32x4*)(shp + d);
      v[i].x = v[i].x * r * gg.x * (1.f + s1.x) + s0.x; v[i].y = v[i].y * r * gg.y * (1.f + s1.y) + s0.y; v[i].z = v[i].z * r * gg.z * (1.f + s1.z) + s0.z; v[i].w = v[i].w * r * gg.w * (1.f + s1.w) + s0.w;
      u32x2 w; w.x = pack2(v[i].x, v[i].y); w.y = pack2(v[i].z, v[i].w); *(u32x2*)(p.H + (size_t)t * D + d) = w; }
    if (WITH_GATES) {
      float myg = 0.f;
#pragma unroll 2
      for (int gi = 0; gi < 16; ++gi) { float a = 0.f;
#pragma unroll
        for (int i = 0; i < 4; ++i) { f32x4 w4 = *(const f32x4*)(wg + gi * 1024 + i * 256 + lane * 4); a += v[i].x * w4.x + v[i].y * w4.y + v[i].z * w4.z + v[i].w * w4.w; }
        a = wave_sum(a); if (lane == gi) myg = a; }
      if (lane < 16) p.gates[(size_t)t * 16 + lane] = myg + p.ev_b_in[2560 + lane];
    }
  }
}

enum { EPI_EVIN = 0, EPI_EVOUT = 1, EPI_PEERQ = 2, EPI_ODIN = 3, EPI_ODOUT = 4 };
template <int EPI> __device__ __forceinline__ void epi_store(const Params& p, int layer, int m, int n, float acc) {
  if (EPI == EPI_EVIN) { float v = acc + p.ev_b_in[n];
    if (n < 1024) p.ZQK[(size_t)m * 1024 + n] = f2bf(v); else if (n < 1536) p.ZV[(size_t)m * 512 + n - 1024] = f2bf(v);
    else if (n < 2048) p.ZO[(size_t)m * 512 + n - 1536] = f2bf(sigmf(v)); else p.ZP[(size_t)m * 512 + n - 2048] = f2bf(v); }
  else if (EPI == EPI_EVOUT) { int b = m / S; p.X[(size_t)m * D + n] = p.x[(size_t)m * D + n] + p.mod[(size_t)(0 * 8 + b) * 6144 + 2048 + n] * acc; }
  else if (EPI == EPI_PEERQ) p.QP[(size_t)m * 2048 + n] = f2bf(acc);
  else if (EPI == EPI_ODIN) p.QKV[(size_t)m * 1536 + n] = f2bf(acc);
  else if (EPI == EPI_ODOUT) { int b = m / S; p.X[(size_t)m * D + n] += p.mod[(size_t)(1 * 8 + b) * 6144 + 2048 + n] * acc; }
}
template <int EPI> __device__ void phase_gemm_naive(const Params& p, int layer, const bf16_t* __restrict__ A, const bf16_t* __restrict__ Bt, int M, int N, int K, char* smem) {
  float* As = (float*)smem; float* Bs = As + 32 * 132;
  const int tid = threadIdx.x, tx = tid & 15, ty = tid >> 4; const int nN = N / 64, njobs = (M / 128) * nN;
  for (int job = blockIdx.x; job < njobs; job += gridDim.x) {
    const int m0 = (job / nN) * 128, n0 = (job % nN) * 64; float acc[4][4];
#pragma unroll
    for (int i = 0; i < 4; ++i)
#pragma unroll
      for (int j = 0; j < 4; ++j) acc[i][j] = 0.f;
    for (int k0 = 0; k0 < K; k0 += 32) {
      __syncthreads();
      { int row = tid >> 2, kc = (tid & 3) * 8; u32x4 w = *(const u32x4*)(A + (size_t)(m0 + row) * K + k0 + kc);
        As[(kc + 0) * 132 + row] = bflo(w.x); As[(kc + 1) * 132 + row] = bfhi(w.x); As[(kc + 2) * 132 + row] = bflo(w.y); As[(kc + 3) * 132 + row] = bfhi(w.y);
        As[(kc + 4) * 132 + row] = bflo(w.z); As[(kc + 5) * 132 + row] = bfhi(w.z); As[(kc + 6) * 132 + row] = bflo(w.w); As[(kc + 7) * 132 + row] = bfhi(w.w); }
      if (tid < 256) { int row = tid >> 2, kc = (tid & 3) * 8; u32x4 w = *(const u32x4*)(Bt + (size_t)(n0 + row) * K + k0 + kc);
        Bs[(kc + 0) * 68 + row] = bflo(w.x); Bs[(kc + 1) * 68 + row] = bfhi(w.x); Bs[(kc + 2) * 68 + row] = bflo(w.y); Bs[(kc + 3) * 68 + row] = bfhi(w.y);
        Bs[(kc + 4) * 68 + row] = bflo(w.z); Bs[(kc + 5) * 68 + row] = bfhi(w.z); Bs[(kc + 6) * 68 + row] = bflo(w.w); Bs[(kc + 7) * 68 + row] = bfhi(w.w); }
      __syncthreads();
#pragma unroll 8
      for (int kk = 0; kk < 32; ++kk) { f32x4 a = *(const f32x4*)(As + kk * 132 + ty * 4), b = *(const f32x4*)(Bs + kk * 68 + tx * 4);
        acc[0][0] += a.x * b.x; acc[0][1] += a.x * b.y; acc[0][2] += a.x * b.z; acc[0][3] += a.x * b.w;
        acc[1][0] += a.y * b.x; acc[1][1] += a.y * b.y; acc[1][2] += a.y * b.z; acc[1][3] += a.y * b.w;
        acc[2][0] += a.z * b.x; acc[2][1] += a.z * b.y; acc[2][2] += a.z * b.z; acc[2][3] += a.z * b.w;
        acc[3][0] += a.w * b.x; acc[3][1] += a.w * b.y; acc[3][2] += a.w * b.z; acc[3][3] += a.w * b.w; }
    }
#pragma unroll
    for (int i = 0; i < 4; ++i)
#pragma unroll
      for (int j = 0; j < 4; ++j) epi_store<EPI>(p, layer, m0 + ty * 4 + i, n0 + tx * 4 + j, acc[i][j]);
  }
}

namespace pg8 {
#define PG8_LAS __attribute__((address_space(3)))
typedef unsigned short bf16_t;
typedef short bf16x8 __attribute__((ext_vector_type(8)));
typedef float f32x4 __attribute__((ext_vector_type(4)));
typedef unsigned u32x4 __attribute__((ext_vector_type(4)));
constexpr int BM = 256, BK = 64, HALF = 128, HTB = HALF * BK * 2  , STAGE_BYTES = 8 * HTB, NXCD = 8, WGM = 8;

__host__ __device__ __forceinline__ int lds_byte(int r, int c) { const int st = (r >> 4) * 2 + (c >> 5), rr = r & 15, cc = c & 31, ob = rr * 64 + cc * 2; return st * 1024 + (ob ^ (((ob >> 9) & 1) << 5)); }
__host__ __device__ __forceinline__ void stage_rc(int b, int& R, int& C) { const int st = b / 1024, sb = b % 1024, swz = sb ^ (((sb >> 9) & 1) << 5); R = (st >> 1) * 16 + swz / 64; C = (st & 1) * 32 + (swz % 64) / 2; }
__host__ __device__ __forceinline__ int perm32(int rho) { const int n = rho >> 4, i = rho & 15; return 8 * (i >> 2) + 4 * n + (i & 3); }

struct Unit { int pm, pn; };
struct Gemm { const bf16_t* A; const bf16_t* Bt; int M, N, K; };

struct StaticOrder {
    int nM, nN, nwg, G, c;
    __host__ __device__ void init(int M, int N, int G_, int c_) { nM = M / BM; nN = N / BM; nwg = nM * nN; G = G_; c = c_; }
    __host__ __device__ bool next(int i, Unit& u) const {
        const long L = (long)i * G + c; if (L >= nwg) return false;
        int wgid = (int)L; { const int q = nwg / NXCD, r = nwg % NXCD, xcd = wgid % NXCD, off = wgid / NXCD; wgid = (xcd < r ? xcd * (q + 1) : r * (q + 1) + (xcd - r) * q) + off; }
        const int nig = WGM * nN, gid = wgid / nig, fm = gid * WGM, gsz = (nM - fm) < WGM ? (nM - fm) : WGM;
        u.pm = fm + ((wgid % nig) % gsz); u.pn = (wgid % nig) / gsz; return true;
    }
    __device__ __forceinline__ void a_ready(const Unit&) const {}
    __device__ __forceinline__ void done(const Unit&) const {}
};
__device__ __forceinline__ unsigned cvt_pk_bf16(float lo, float hi) { unsigned r; asm volatile("v_cvt_pk_bf16_f32 %0, %1, %2" : "=v"(r) : "v"(lo), "v"(hi)); return r; }
template <class Epi, class Sched, bool STAMP = false>
__device__ __forceinline__ void gemm_phase(PG8_LAS unsigned char* lds, const Gemm g, const Sched& S, const Epi& E, unsigned long long* stamps) {
    const int tid = threadIdx.x, wid = __builtin_amdgcn_readfirstlane(tid >> 6), lane = tid & 63, wr = wid >> 2, wc = wid & 3, fr = lane & 15, fq = lane >> 4;
    const int K = g.K, nt = K / BK;
    int ts_lo = 0, ts_hi = 0, nts = 0; const unsigned long long rt_entry = STAMP ? (unsigned long long)wall_clock64() : 0ull;
#define PG8_STAMP() do { if (STAMP && wid == 0 && nts < 64) { const unsigned long long _c = (unsigned long long)clock64(); \
        ts_lo = (lane == nts) ? (int)(unsigned)_c : ts_lo; ts_hi = (lane == nts) ? (int)(unsigned)(_c >> 32) : ts_hi; ++nts; } } while (0)
    PG8_STAMP();
    unsigned voffA[2], voffB[2];
#pragma unroll
    for (int i = 0; i < 2; ++i) { int R, C; stage_rc(tid * 16 + i * 8192, R, C); const int Rb = Epi::PERM ? ((R & ~31) + perm32(R & 31)) : R;
        voffA[i] = (unsigned)(R * K + C) * 2u; voffB[i] = (unsigned)(Rb * K + C) * 2u; }
    const size_t kstep = (size_t)(BK * 2);
    const size_t hstep = (size_t)HALF * K * 2;
    const size_t tstep = 2 * hstep;
    const unsigned ldsw = (unsigned)wid * 1024u;
    const int aoff = lds_byte(wr * 64 + fr, fq * 8), boff = lds_byte(wc * 32 + fr, fq * 8);
#define PG8_SA(b, h) (((b) * 2 + (h)) * HTB)
#define PG8_SB(b, h) ((4 + (b) * 2 + (h)) * HTB)
#define PG8_STAGE(bufoff, gbase, voff) do { _Pragma("unroll") for (int _i = 0; _i < 2; ++_i) \
        __builtin_amdgcn_global_load_lds((const unsigned*)((const char*)(gbase) + (voff)[_i]), (PG8_LAS unsigned*)(lds + (bufoff) + ldsw + _i * 8192), 16, 0, 0); } while (0)
#define PG8_LDA(dst, b, h) do { _Pragma("unroll") for (int m = 0; m < 4; ++m) _Pragma("unroll") for (int k = 0; k < 2; ++k) dst[m][k] = *(const PG8_LAS bf16x8*)(lds + PG8_SA(b, h) + aoff + m * 2048 + k * 1024); } while (0)
#define PG8_LDB(dst, b, h) do { _Pragma("unroll") for (int n = 0; n < 2; ++n) _Pragma("unroll") for (int k = 0; k < 2; ++k) dst[n][k] = *(const PG8_LAS bf16x8*)(lds + PG8_SB(b, h) + boff + n * 2048 + k * 1024); } while (0)
#define PG8_MMA(ai, bj, At, Bt) do { __builtin_amdgcn_s_setprio(1); _Pragma("unroll") for (int m = 0; m < 4; ++m) _Pragma("unroll") for (int n = 0; n < 2; ++n) _Pragma("unroll") for (int k = 0; k < 2; ++k) \
        acc[ai][bj][m][n] = __builtin_amdgcn_mfma_f32_16x16x32_bf16(Bt[n][k], At[m][k], acc[ai][bj][m][n], 0, 0, 0); __builtin_amdgcn_s_setprio(0); } while (0)
#define PG8_WAIT_V(n) asm volatile("s_waitcnt vmcnt(" #n ")" ::: "memory")
#define PG8_WAIT_L(n) asm volatile("s_waitcnt lgkmcnt(" #n ")" ::: "memory")
#define PG8_BAR __builtin_amdgcn_s_barrier()
#define PG8_SCHED __builtin_amdgcn_sched_barrier(0)
    Unit cur, nxt; int ui = 0;
    if (!S.next(0, cur)) return;
    f32x4 acc[2][2][4][2];
#pragma unroll
    for (int a = 0; a < 2; ++a)
#pragma unroll
        for (int b = 0; b < 2; ++b)
#pragma unroll
            for (int m = 0; m < 4; ++m)
#pragma unroll
                for (int n = 0; n < 2; ++n) acc[a][b][m][n] = (f32x4){0.f, 0.f, 0.f, 0.f};
    bf16x8 At[4][2], B0[2][2], B1[2][2];
    const char* cA = (const char*)g.A + (size_t)cur.pm * tstep; const char* cB = (const char*)g.Bt + (size_t)cur.pn * tstep;
    S.a_ready(cur);
    PG8_STAGE(PG8_SB(0, 0), cB, voffB); PG8_STAGE(PG8_SA(0, 0), cA, voffA); PG8_STAGE(PG8_SB(0, 1), cB + hstep, voffB); PG8_STAGE(PG8_SA(0, 1), cA + hstep, voffA);
    if (wr == 1) PG8_BAR;
    PG8_WAIT_V(4); PG8_BAR;
    PG8_STAGE(PG8_SB(1, 0), cB + kstep, voffB); PG8_STAGE(PG8_SA(1, 0), cA + kstep, voffA); PG8_STAGE(PG8_SB(1, 1), cB + hstep + kstep, voffB);
    PG8_WAIT_V(6); PG8_BAR;
    PG8_STAMP();
    for (;;) {
        const bool has_next = S.next(ui + 1, nxt);
        const char* nA = has_next ? (const char*)g.A + (size_t)nxt.pm * tstep : cA; const char* nB = has_next ? (const char*)g.Bt + (size_t)nxt.pn * tstep : cB;
        for (int t = 0; t < nt; t += 2) {
            const bool last = (t == nt - 2);
            const char* a1 = cA + (size_t)(t + 1) * kstep;
            const char* a2 = last ? nA : cA + (size_t)(t + 2) * kstep; const char* b2 = last ? nB : cB + (size_t)(t + 2) * kstep;
            const char* a3 = a2 + kstep; const char* b3 = b2 + kstep;
            if (last && has_next) S.a_ready(nxt);
            PG8_LDB(B0, 0, 0); PG8_SCHED; PG8_LDA(At, 0, 0); PG8_STAGE(PG8_SA(1, 1), a1 + hstep, voffA);
            PG8_WAIT_L(8); PG8_BAR; PG8_WAIT_L(0); PG8_MMA(0, 0, At, B0); PG8_BAR; PG8_SCHED;
            PG8_LDB(B1, 0, 1); PG8_STAGE(PG8_SB(0, 0), b2, voffB);
            PG8_BAR; PG8_WAIT_L(0); PG8_MMA(0, 1, At, B1); PG8_BAR;
            PG8_LDA(At, 0, 1); PG8_STAGE(PG8_SA(0, 0), a2, voffA);
            PG8_BAR; PG8_WAIT_L(0); PG8_MMA(1, 0, At, B0); PG8_BAR; PG8_SCHED;
            PG8_STAGE(PG8_SB(0, 1), b2 + hstep, voffB);
            PG8_WAIT_V(6); PG8_BAR; PG8_MMA(1, 1, At, B1); PG8_BAR;
            PG8_LDB(B0, 1, 0); PG8_SCHED; PG8_LDA(At, 1, 0); PG8_STAGE(PG8_SA(0, 1), a2 + hstep, voffA);
            PG8_WAIT_L(8); PG8_BAR; PG8_WAIT_L(0); PG8_MMA(0, 0, At, B0); PG8_BAR; PG8_SCHED;
            PG8_LDB(B1, 1, 1); PG8_STAGE(PG8_SB(1, 0), b3, voffB);
            PG8_BAR; PG8_WAIT_L(0); PG8_MMA(0, 1, At, B1); PG8_BAR;
            PG8_LDA(At, 1, 1); PG8_STAGE(PG8_SA(1, 0), a3, voffA);
            PG8_BAR; PG8_WAIT_L(0); PG8_MMA(1, 0, At, B0); PG8_BAR; PG8_SCHED;
            PG8_STAGE(PG8_SB(1, 1), b3 + hstep, voffB);
            PG8_WAIT_V(6); PG8_BAR; PG8_MMA(1, 1, At, B1); PG8_BAR;
        }
        PG8_STAMP();
        if constexpr (!Epi::AFTER_DRAIN) { E(acc, cur, wr, wc, fr, fq); S.done(cur); }
        PG8_STAMP();
        if (!has_next) break;
#pragma unroll
        for (int a = 0; a < 2; ++a)
#pragma unroll
            for (int b = 0; b < 2; ++b)
#pragma unroll
                for (int m = 0; m < 4; ++m)
#pragma unroll
                    for (int n = 0; n < 2; ++n) acc[a][b][m][n] = (f32x4){0.f, 0.f, 0.f, 0.f};
        cur = nxt; cA = nA; cB = nB; ++ui;
    }
    PG8_WAIT_V(0);
    if (wr == 0) PG8_BAR;
    PG8_BAR;
    if constexpr (Epi::AFTER_DRAIN) { E.fused(acc, cur, wr, wc, fr, fq, lds, wid, lane); S.done(cur); }
    PG8_STAMP();
    if (STAMP && wid == 0) { stamps[lane] = lane < nts ? (((unsigned long long)(unsigned)ts_hi << 32) | (unsigned)ts_lo) : 0ull;
        if (lane == 62) stamps[62] = rt_entry; if (lane == 63) stamps[63] = (unsigned long long)wall_clock64(); }
#undef PG8_STAMP
#undef PG8_SA
#undef PG8_SB
#undef PG8_STAGE
#undef PG8_LDA
#undef PG8_LDB
#undef PG8_MMA
#undef PG8_WAIT_V
#undef PG8_WAIT_L
#undef PG8_BAR
#undef PG8_SCHED
}
}

struct EpiEvin {
  static constexpr bool PERM = true, AFTER_DRAIN = false;
  bf16_t *ZQK, *ZV, *ZO, *ZP; const float* bias;
  __device__ __forceinline__ void operator()(const pg8::f32x4 (&acc)[2][2][4][2], const pg8::Unit& u, int wr, int wc, int fr, int fq) const {
    const int row0 = u.pm * 256 + wr * 64 + fr, ct = u.pn * 256;
    bf16_t* base; int ldc, cl; bool sig = false;
    if (ct < 1024) { base = ZQK; ldc = 1024; cl = ct; } else if (ct < 1536) { base = ZV; ldc = 512; cl = ct - 1024; } else if (ct < 2048) { base = ZO; ldc = 512; cl = ct - 1536; sig = true; } else { base = ZP; ldc = 512; cl = ct - 2048; }
    const int cofs = wc * 32 + 8 * fq;
    pg8::f32x4 bv[2][2];
#pragma unroll
    for (int bj = 0; bj < 2; ++bj)
#pragma unroll
      for (int n = 0; n < 2; ++n) bv[bj][n] = *(const pg8::f32x4*)(bias + ct + cofs + bj * 128 + 4 * n);
#pragma unroll
    for (int ai = 0; ai < 2; ++ai)
#pragma unroll
      for (int m = 0; m < 4; ++m) { bf16_t* rowp = base + (size_t)(row0 + ai * 128 + m * 16) * ldc + cl + cofs;
#pragma unroll
        for (int bj = 0; bj < 2; ++bj) { pg8::f32x4 v0 = acc[ai][bj][m][0] + bv[bj][0], v1 = acc[ai][bj][m][1] + bv[bj][1];
          if (sig) {
#pragma unroll
            for (int j = 0; j < 4; ++j) { v0[j] = sigmf(v0[j]); v1[j] = sigmf(v1[j]); } }
          pg8::u32x4 w; w.x = pg8::cvt_pk_bf16(v0[0], v0[1]); w.y = pg8::cvt_pk_bf16(v0[2], v0[3]); w.z = pg8::cvt_pk_bf16(v1[0], v1[1]); w.w = pg8::cvt_pk_bf16(v1[2], v1[3]);
          *(pg8::u32x4*)(rowp + bj * 128) = w; } }
  }
};
struct EpiPlain {
  static constexpr bool PERM = true, AFTER_DRAIN = false;
  bf16_t* out; int ldc;
  __device__ __forceinline__ void operator()(const pg8::f32x4 (&acc)[2][2][4][2], const pg8::Unit& u, int wr, int wc, int fr, int fq) const {
    const int row0 = u.pm * 256 + wr * 64 + fr, col0 = u.pn * 256 + wc * 32 + 8 * fq;
#pragma unroll
    for (int ai = 0; ai < 2; ++ai)
#pragma unroll
      for (int m = 0; m < 4; ++m) { bf16_t* rowp = out + (size_t)(row0 + ai * 128 + m * 16) * ldc + col0;
#pragma unroll
        for (int bj = 0; bj < 2; ++bj) { const pg8::f32x4 v0 = acc[ai][bj][m][0], v1 = acc[ai][bj][m][1];
          pg8::u32x4 w; w.x = pg8::cvt_pk_bf16(v0[0], v0[1]); w.y = pg8::cvt_pk_bf16(v0[2], v0[3]); w.z = pg8::cvt_pk_bf16(v1[0], v1[1]); w.w = pg8::cvt_pk_bf16(v1[2], v1[3]);
          *(pg8::u32x4*)(rowp + bj * 128) = w; } }
  }
};
struct EpiRes {
  static constexpr bool PERM = false, AFTER_DRAIN = false;
  const float* xin; float* X; const float* gate;
  __device__ __forceinline__ void operator()(const pg8::f32x4 (&acc)[2][2][4][2], const pg8::Unit& u, int wr, int wc, int fr, int fq) const {
    const int row0 = u.pm * 256 + wr * 64 + fr, col0 = u.pn * 256 + wc * 32 + 4 * fq; const float* gb = gate + (size_t)((u.pm * 256) / S) * 6144;
    pg8::f32x4 gv[2][2];
#pragma unroll
    for (int bj = 0; bj < 2; ++bj)
#pragma unroll
      for (int n = 0; n < 2; ++n) gv[bj][n] = *(const pg8::f32x4*)(gb + col0 + bj * 128 + n * 16);
#pragma unroll
    for (int ai = 0; ai < 2; ++ai)
#pragma unroll
      for (int m = 0; m < 4; ++m) { const size_t off = (size_t)(row0 + ai * 128 + m * 16) * 1024 + col0;
#pragma unroll
        for (int bj = 0; bj < 2; ++bj)
#pragma unroll
          for (int n = 0; n < 2; ++n) { const pg8::f32x4 xi = *(const pg8::f32x4*)(xin + off + bj * 128 + n * 16); *(pg8::f32x4*)(X + off + bj * 128 + n * 16) = xi + gv[bj][n] * acc[ai][bj][m][n]; }
        asm volatile("" ::: "memory"); }
  }
};
template <class Epi> __device__ __forceinline__ void phase_gemm_fast(const bf16_t* A, const bf16_t* Bt, int M, int N, int K, const Epi& E, char* smem) {
  pg8::Gemm g; g.A = A; g.Bt = Bt; g.M = M; g.N = N; g.K = K;
  pg8::StaticOrder So; So.init(M, N, (int)gridDim.x, (int)blockIdx.x);
  pg8::gemm_phase<Epi, pg8::StaticOrder, false>((PG8_LAS unsigned char*)smem, g, So, E, nullptr);
}

__device__ void phase_convpool(const Params& p, char* smem) {
  const int tid = threadIdx.x;
  for (int job = blockIdx.x; job < T * 128 / NTHREADS; job += gridDim.x) {
    const int it = job * NTHREADS + tid, t = it >> 7, c0 = (it & 127) * 8, s = t & (S - 1);
    float a[8];
#pragma unroll
    for (int i = 0; i < 8; ++i) a[i] = p.conv_b[c0 + i];
#pragma unroll
    for (int j = 0; j < 5; ++j) { const int ss = s + j - 2; if (ss >= 0 && ss < S) { u32x4 w = *(const u32x4*)(p.ZQK + (size_t)(t + j - 2) * 1024 + c0); const float* cw = p.conv_w + j * 1024 + c0;
        a[0] += cw[0] * bflo(w.x); a[1] += cw[1] * bfhi(w.x); a[2] += cw[2] * bflo(w.y); a[3] += cw[3] * bfhi(w.y); a[4] += cw[4] * bflo(w.z); a[5] += cw[5] * bfhi(w.z); a[6] += cw[6] * bflo(w.w); a[7] += cw[7] * bfhi(w.w); } }
    const float sc = c0 >= 512 ? KSCALE : 1.f;
#pragma unroll
    for (int i = 0; i < 8; ++i) a[i] = siluf(a[i]) * sc;
    u32x4 o; o.x = pack2(a[0], a[1]); o.y = pack2(a[2], a[3]); o.z = pack2(a[4], a[5]); o.w = pack2(a[6], a[7]); *(u32x4*)(p.QK + (size_t)t * 1024 + c0) = o;
  }
  float* ys = (float*)smem;
  float* ws = ys + 64 * 128;
  for (int job = blockIdx.x; job < (T / 64) * 4; job += gridDim.x) {
    const int g = job & 3, t0 = (job >> 2) * 64, win = 2 << g;
    __syncthreads();
    for (int i = tid; i < 128 * 128; i += NTHREADS) ws[i] = p.pool_w[(size_t)g * 16384 + i];
    for (int i = tid; i < 64 * 128; i += NTHREADS) { const int tl = i >> 7, c = i & 127, t = t0 + tl, s = t & (S - 1); const int lo = max(s - win / 2, 0), hi = min(s + win / 2, S);
      float sum = 0.f; for (int q = lo; q < hi; ++q) sum += bf2f(p.ZP[(size_t)(t - s + q) * 512 + g * 128 + c]);
      ys[i] = sum / (float)(hi - lo) - bf2f(p.ZP[(size_t)t * 512 + g * 128 + c]); }
    __syncthreads();
    const int e = tid & 127, tq = tid >> 7; float acc[16];
#pragma unroll
    for (int i = 0; i < 16; ++i) acc[i] = 0.f;
    for (int c = 0; c < 128; ++c) { const float w = ws[c * 128 + e];
#pragma unroll
      for (int i = 0; i < 16; ++i) acc[i] += ys[(tq * 16 + i) * 128 + c] * w; }
    const float psc = p.pool_sc[g * 128 + e];
#pragma unroll
    for (int i = 0; i < 16; ++i) p.CAT[(size_t)(t0 + tq * 16 + i) * 1024 + 512 + g * 128 + e] = f2bf(acc[i] * psc);
  }
}

__device__ void phase_mlstm_naive(const Params& p, char* smem) {
  float* qs = (float*)smem; float* ks = qs + 128; float* nump = ks + 128; float* red = nump + 512;
  const int tid = threadIdx.x, j = tid & 127, qd = tid >> 7;
  for (int job = blockIdx.x; job < 64; job += gridDim.x) {
    const int dir = job >> 5, b = (job >> 2) & 7, h = job & 3;
    float C[32];
#pragma unroll
    for (int d = 0; d < 32; ++d) C[d] = 0.f;
    float n = 0.f, m = 0.f;
    for (int step = 0; step < S; ++step) { const int s = dir ? S - 1 - step : step; const size_t t = (size_t)b * S + s;
      const float li = p.gates[t * 16 + dir * 4 + h], gf = p.gates[t * 16 + 8 + dir * 4 + h];
      const float lf = fminf(gf, 0.f) - log1pf(__expf(-fabsf(gf)));
      __syncthreads();
      if (qd == 0) { qs[j] = bf2f(p.QK[t * 1024 + h * 128 + j]); ks[j] = bf2f(p.QK[t * 1024 + 512 + h * 128 + j]); }
      const float v = bf2f(p.ZV[t * 512 + h * 128 + j]);
      __syncthreads();
      const float mn = fmaxf(lf + m, li), ip = __expf(li - mn), fp = __expf(lf + m - mn); m = mn;
      float num = 0.f;
#pragma unroll
      for (int d = 0; d < 32; ++d) { C[d] = fp * C[d] + ip * ks[qd * 32 + d] * v; num += qs[qd * 32 + d] * C[d]; }
      float dp = 0.f; if (qd == 0) { n = fp * n + ip * ks[j]; dp = qs[j] * n; }
      nump[qd * 128 + j] = num;
      dp = wave_sum(dp); if ((tid & 63) == 0) red[tid >> 6] = dp;
      __syncthreads();
      if (qd == 0) { const float den = red[0] + red[1]; num = nump[j] + nump[128 + j] + nump[256 + j] + nump[384 + j];
        p.HS[((size_t)dir * T + t) * 512 + h * 128 + j] = f2bf(num / fmaxf(fabsf(den), __expf(-mn))); }
    }
    __syncthreads();
  }
}

namespace ml {
typedef short bf16x8 __attribute__((ext_vector_type(8)));
typedef short s16x4 __attribute__((ext_vector_type(4)));
typedef float f32x16 __attribute__((ext_vector_type(16)));
constexpr int RS = 272;
constexpr int OFF_Q = 0, OFF_K = 128 * RS, OFF_VT = 2 * 128 * RS, OFF_VW = OFF_VT + 34 * RS, OFF_CT = OFF_VW + 34 * RS, OFF_A = OFF_CT + 34 * RS;
constexpr int OFF_PA = OFF_A + 16384, OFF_MCH = OFF_PA + 16384, OFF_TAB = OFF_MCH + 512, OFF_DEN = OFF_TAB + 4096, OFF_END = OFF_DEN + 512;
static_assert(OFF_A % 16 == 0 && OFF_END <= SMEM_BYTES, "mlstm LDS layout");
__device__ __forceinline__ int crow(int r, int h) { return (r & 3) + 8 * (r >> 2) + 4 * h; }
__device__ __forceinline__ int spos(int s) { return (s & ~12) | ((s & 4) << 1) | ((s & 8) >> 1); }
#define ML_MFMA(a, b, c) __builtin_amdgcn_mfma_f32_32x32x16_bf16((a), (b), (c), 0, 0, 0)
__device__ __forceinline__ bf16x8 pack8(float x0, float x1, float x2, float x3, float x4, float x5, float x6, float x7) {
  u32x4 w; w.x = pack2(x0, x1); w.y = pack2(x2, x3); w.z = pack2(x4, x5); w.w = pack2(x6, x7); return __builtin_bit_cast(bf16x8, w);
}
__device__ __forceinline__ void tr_read2(unsigned a0, unsigned a1, s16x4& lo, s16x4& hi) {
  asm volatile("ds_read_b64_tr_b16 %0, %2\n\tds_read_b64_tr_b16 %1, %3\n\ts_waitcnt lgkmcnt(0)" : "=&v"(lo), "=&v"(hi) : "v"(a0), "v"(a1) : "memory");
}

__device__ void phase_mlstm(const Params& p, char* smem) {
  int tid_ = threadIdx.x; asm volatile("" : "+v"(tid_));
  const int tid = tid_, wid = tid >> 6, lane = tid & 63, l31 = lane & 31, hh = lane >> 5;
  float* const LA = (float*)(smem + OFF_A); float* const LPA = (float*)(smem + OFF_PA); float* const LM = (float*)(smem + OFF_MCH);
  float* const LTAB = (float*)(smem + OFF_TAB); float* const LDEN = (float*)(smem + OFF_DEN);
  const unsigned lds0 = (unsigned)(uintptr_t)smem;
  for (int job = blockIdx.x; job < 256; job += gridDim.x) {
    const int dvq = job & 3, h = (job >> 2) & 3, b = (job >> 4) & 7, dir = job >> 7;
    const float* gts = p.gates + (size_t)b * S * 16;
    const bf16_t* QKb = p.QK + (size_t)b * S * 1024 + h * 128; const bf16_t* ZVb = p.ZV + (size_t)b * S * 512 + h * 128 + dvq * 32;
    bf16_t* HSb = p.HS + ((size_t)dir * T + (size_t)b * S) * 512 + h * 128 + dvq * 32;
    __syncthreads();
    for (int i = tid; i < 3 * 34 * RS / 4; i += NTHREADS) ((u32*)(smem + OFF_VT))[i] = 0u;
    for (int cc = 0; cc < 4; ++cc) { const int c = wid * 4 + cc, tau0 = c * 128 + 2 * lane; const int tok0 = dir ? S - 1 - tau0 : tau0, tok1 = dir ? tok0 - 1 : tok0 + 1;
      const float li0 = gts[(size_t)tok0 * 16 + dir * 4 + h], gf0 = gts[(size_t)tok0 * 16 + 8 + dir * 4 + h], li1 = gts[(size_t)tok1 * 16 + dir * 4 + h], gf1 = gts[(size_t)tok1 * 16 + 8 + dir * 4 + h];
      const float lf0 = fminf(gf0, 0.f) - log1pf(__expf(-fabsf(gf0))), lf1 = fminf(gf1, 0.f) - log1pf(__expf(-fabsf(gf1)));
      const float pr = lf0 + lf1; float incl = pr;
#pragma unroll
      for (int o = 1; o < 64; o <<= 1) { const float v = __shfl_up(incl, o); if (lane >= o) incl += v; }
      const float b0 = incl - pr + lf0, b1 = b0 + lf1, a0 = li0 - b0, a1 = li1 - b1;
      float im = fmaxf(a0, a1);
#pragma unroll
      for (int o = 1; o < 64; o <<= 1) { const float v = __shfl_up(im, o); if (lane >= o) im = fmaxf(im, v); }
      float ex = __shfl_up(im, 1); if (lane == 0) ex = -INFINITY;
      const float pa0 = fmaxf(ex, a0), pa1 = fmaxf(pa0, a1);
      LA[tau0] = a0; LA[tau0 + 1] = a1; LPA[tau0] = pa0; LPA[tau0 + 1] = pa1; if (lane == 63) LM[64 + c] = b1; }
    __syncthreads();
    if (tid == 0) { float m = 0.f; for (int c = 0; c < 32; ++c) { LM[c] = m; m = LM[64 + c] + fmaxf(m, LPA[c * 128 + 127]); } LM[32] = m; }
    __syncthreads();
    u32x4 qreg[4], kreg[4], vreg;
#define ML_TOK(tau) (dir ? S - 1 - (tau) : (tau))
#define ML_LOAD(c) do { _Pragma("unroll") for (int i_ = 0; i_ < 4; ++i_) { const int tk_ = ML_TOK((c) * 128 + (tid >> 4) + 32 * i_); \
        qreg[i_] = *(const u32x4*)(QKb + (size_t)tk_ * 1024 + (tid & 15) * 8); kreg[i_] = *(const u32x4*)(QKb + (size_t)tk_ * 1024 + 512 + (tid & 15) * 8); } \
      { const int tk_ = ML_TOK((c) * 128 + (tid >> 2)); vreg = *(const u32x4*)(ZVb + (size_t)tk_ * 512 + (tid & 3) * 8); } } while (0)
#define ML_TABLES(c) do { if (tid < 128) { const int tau_ = (c) * 128 + tid, tk_ = ML_TOK(tau_); const float li_ = gts[(size_t)tk_ * 16 + dir * 4 + h], a_ = LA[tau_], mc_ = LM[(c)]; \
        const float Mj_ = fmaxf(mc_, LPA[tau_]), Me_ = fmaxf(mc_, LPA[(c) * 128 + 127]); float* tb_ = LTAB + ((c) & 1) * 512; \
        tb_[tid] = Mj_; tb_[128 + tid] = __expf(mc_ - Mj_); tb_[256 + tid] = __expf(-((li_ - a_) + Mj_)); tb_[384 + tid] = __expf(a_ - Me_); } } while (0)
#define ML_STORE(c) do { _Pragma("unroll") for (int i_ = 0; i_ < 4; ++i_) { const int row_ = (tid >> 4) + 32 * i_; \
        *(u32x4*)(smem + OFF_Q + row_ * RS + (tid & 15) * 16) = qreg[i_]; *(u32x4*)(smem + OFF_K + row_ * RS + (tid & 15) * 16) = kreg[i_]; } \
      { const int s_ = tid >> 2, ps_ = spos(s_) * 2; const float we_ = LTAB[((c) & 1) * 512 + 384 + s_]; const u32 vw_[4] = {vreg.x, vreg.y, vreg.z, vreg.w}; \
        _Pragma("unroll") for (int i_ = 0; i_ < 4; ++i_) { const int r0_ = ((tid & 3) * 8 + 2 * i_) * RS + ps_; \
          *(bf16_t*)(smem + OFF_VT + r0_) = (bf16_t)(vw_[i_] & 0xFFFFu); *(bf16_t*)(smem + OFF_VT + r0_ + RS) = (bf16_t)(vw_[i_] >> 16); \
          *(bf16_t*)(smem + OFF_VW + r0_) = f2bf(bflo(vw_[i_]) * we_); *(bf16_t*)(smem + OFF_VW + r0_ + RS) = f2bf(bfhi(vw_[i_]) * we_); } } \
      if (tid < 128) { const int ps_ = spos(tid) * 2; *(bf16_t*)(smem + OFF_VT + 32 * RS + ps_) = (bf16_t)0x3F80u; *(bf16_t*)(smem + OFF_VW + 32 * RS + ps_) = f2bf(LTAB[((c) & 1) * 512 + 384 + tid]); } } while (0)
    ML_LOAD(0); ML_TABLES(0);
    __syncthreads();
    ML_STORE(0);
    __syncthreads();
    f32x16 Cacc;
#pragma unroll
    for (int r = 0; r < 16; ++r) Cacc[r] = 0.f;
    for (int c = 0; c < 32; ++c) {
      int tidc_ = threadIdx.x; asm volatile("" : "+v"(tidc_));
      const int tid = tidc_, wid = tid >> 6, lane = tid & 63, l31 = lane & 31, hh = lane >> 5;
      const int t2 = wid >> 1, nt = wid & 1, brow = min(nt * 32 + l31, 33);
      if (c + 1 < 32) { ML_LOAD(c + 1); ML_TABLES(c + 1); }
      const float* tab = LTAB + (c & 1) * 512;
      f32x16 acc;
#pragma unroll
      for (int r = 0; r < 16; ++r) acc[r] = 0.f;
      const char* qa = smem + OFF_Q + (t2 * 32 + l31) * RS + hh * 16;
      { const char* cb = smem + OFF_CT + brow * RS + hh * 16;
#pragma unroll
        for (int ks = 0; ks < 8; ++ks) acc = ML_MFMA(*(const bf16x8*)(qa + ks * 32), *(const bf16x8*)(cb + ks * 32), acc); }
#pragma unroll
      for (int r = 0; r < 16; ++r) acc[r] *= tab[128 + t2 * 32 + crow(r, hh)];
      const float Mj = tab[t2 * 32 + l31];
      for (int si = 0; si <= t2; ++si) {
        f32x16 X;
#pragma unroll
        for (int r = 0; r < 16; ++r) X[r] = 0.f;
        const char* ka = smem + OFF_K + (si * 32 + l31) * RS + hh * 16;
#pragma unroll
        for (int ks = 0; ks < 8; ++ks) X = ML_MFMA(*(const bf16x8*)(ka + ks * 32), *(const bf16x8*)(qa + ks * 32), X);
        const float* Ac = LA + c * 128 + si * 32;
#pragma unroll
        for (int r = 0; r < 16; ++r) { const int sl = crow(r, hh); float w = __expf(Ac[sl] - Mj); if (si == t2 && sl > l31) w = 0.f; X[r] *= w; }
        const bf16x8 f0 = pack8(X[0], X[1], X[2], X[3], X[4], X[5], X[6], X[7]), f1 = pack8(X[8], X[9], X[10], X[11], X[12], X[13], X[14], X[15]);
        const char* vb = smem + OFF_VT + brow * RS + si * 64 + hh * 16;
        acc = ML_MFMA(f0, *(const bf16x8*)(vb), acc); acc = ML_MFMA(f1, *(const bf16x8*)(vb + 32), acc);
      }
      if (nt == 1 && l31 == 0) {
#pragma unroll
        for (int r = 0; r < 16; ++r) LDEN[t2 * 32 + crow(r, hh)] = acc[r]; }
      { const float mc = LM[c], decay = __expf(mc - fmaxf(mc, LPA[c * 128 + 127]));
#pragma unroll
        for (int r = 0; r < 16; ++r) Cacc[r] *= decay;
        const unsigned ta = lds0 + OFF_K + ((lane & 15) >> 2) * RS + (t2 * 32 + 16 * ((lane >> 4) & 1) + 4 * (lane & 3)) * 2 + 4 * hh * RS;
        const char* wb = smem + OFF_VW + brow * RS + hh * 16;
#pragma unroll
        for (int ks = 0; ks < 8; ++ks) { s16x4 lo, hi; tr_read2(ta + 16 * ks * RS, ta + (16 * ks + 8) * RS, lo, hi); __builtin_amdgcn_sched_barrier(0);
          const bf16x8 a = (bf16x8){lo[0], lo[1], lo[2], lo[3], hi[0], hi[1], hi[2], hi[3]};
          Cacc = ML_MFMA(a, *(const bf16x8*)(wb + ks * 32), Cacc); } }
      __syncthreads();
      if (nt == 0) {
#pragma unroll
        for (int r = 0; r < 16; ++r) { const int j = t2 * 32 + crow(r, hh); const float dn = LDEN[j], nr = tab[256 + j]; const int tk = ML_TOK(c * 128 + j);
          HSb[(size_t)tk * 512 + l31] = f2bf(acc[r] / fmaxf(fabsf(dn), nr)); } }
      if (nt * 32 + l31 <= 32) { char* cw = smem + OFF_CT + (nt * 32 + l31) * RS + (t2 * 32 + 4 * hh) * 2;
#pragma unroll
        for (int g = 0; g < 4; ++g) { u32x2 w; w.x = pack2(Cacc[4 * g], Cacc[4 * g + 1]); w.y = pack2(Cacc[4 * g + 2], Cacc[4 * g + 3]); *(u32x2*)(cw + 16 * g) = w; } }
      if (c + 1 < 32) ML_STORE(c + 1);
      __syncthreads();
    }
#undef ML_TOK
#undef ML_LOAD
#undef ML_TABLES
#undef ML_STORE
  }
}
}

__device__ void phase_cat(const Params& p) {
  const int tid = threadIdx.x, wid = tid >> 6, lane = tid & 63;
  for (int job = blockIdx.x; job < T * 4 / 8; job += gridDim.x) {
    const int w = job * 8 + wid, t = w >> 2, h = w & 3; const size_t o = (size_t)t * 512 + h * 128 + lane * 2;
    const u32 a = *(const u32*)(p.HS + o), b = *(const u32*)(p.HS + (size_t)T * 512 + o), so = *(const u32*)(p.ZO + o);
    const float a0 = bflo(a) + bflo(b), a1 = bfhi(a) + bfhi(b); const float r = rsqrtf(wave_sum(a0 * a0 + a1 * a1) * (1.f / 128.f) + EPS);
    *(u32*)(p.CAT + (size_t)t * 1024 + h * 128 + lane * 2) = pack2(a0 * r * p.mnorm_g[h * 128 + lane * 2] * bflo(so), a1 * r * p.mnorm_g[h * 128 + lane * 2 + 1] * bfhi(so));
  }
}

__device__ void phase_peer_select_naive(const Params& p, int layer, char* smem) {
  float* kl = (float*)smem;
  float* qsh = kl + 2 * 128 * 129;
  const int tid = threadIdx.x, wid = tid >> 6, lane = tid & 63; float* qs = qsh + wid * 128;
  __syncthreads();
  for (int i = tid; i < 2 * 128 * 128; i += NTHREADS) kl[(i >> 7) * 129 + (i & 127)] = p.peer_keys[(size_t)layer * 32768 + i];
  __syncthreads();
  for (int job = blockIdx.x; job < T; job += gridDim.x) {
    const int t = job, h = wid;
    float ts[2][16]; int ti[2][16];
#pragma unroll
    for (int pp = 0; pp < 2; ++pp) {
      const bf16_t* q = p.QP + (size_t)t * 2048 + h * 256 + pp * 128; const float q0 = bf2f(q[lane]), q1 = bf2f(q[lane + 64]);
      const float r = rsqrtf(wave_sum(q0 * q0 + q1 * q1) * (1.f / 128.f) + EPS); qs[lane] = q0 * r; qs[lane + 64] = q1 * r;
      float s0 = 0.f, s1 = 0.f; const float* k0 = kl + (pp * 128 + lane) * 129; const float* k1 = k0 + 64 * 129;
      for (int c = 0; c < 128; ++c) { const float qc = qs[c]; s0 += qc * k0[c]; s1 += qc * k1[c]; }
#pragma unroll
      for (int k = 0; k < 16; ++k) { const float mx = wave_max(fmaxf(s0, s1)); int cand = (s0 == mx) ? lane : ((s1 == mx) ? lane + 64 : 9999);
        for (int o = 32; o >= 1; o >>= 1) cand = min(cand, __shfl_xor(cand, o));
        ts[pp][k] = mx; ti[pp][k] = cand; if (cand == lane) s0 = -INFINITY; if (cand == lane + 64) s1 = -INFINITY; }
    }
    float cs[4];
#pragma unroll
    for (int r = 0; r < 4; ++r) { const int c = lane * 4 + r; float va = 0.f, vb = 0.f;
#pragma unroll
      for (int k = 0; k < 16; ++k) { if (k == (c >> 4)) va = ts[0][k]; if (k == (c & 15)) vb = ts[1][k]; }
      cs[r] = va + vb; }
    float top[16]; int tix[16];
#pragma unroll
    for (int k = 0; k < 16; ++k) { const float mx = wave_max(fmaxf(fmaxf(cs[0], cs[1]), fmaxf(cs[2], cs[3]))); int cand = 9999;
#pragma unroll
      for (int r = 3; r >= 0; --r) if (cs[r] == mx) cand = lane * 4 + r;
      for (int o = 32; o >= 1; o >>= 1) cand = min(cand, __shfl_xor(cand, o));
      top[k] = mx; tix[k] = cand;
#pragma unroll
      for (int r = 0; r < 4; ++r) if (cand == lane * 4 + r) cs[r] = -INFINITY; }
    float sum = 0.f;
#pragma unroll
    for (int k = 0; k < 16; ++k) sum += __expf(top[k] - top[0]);
    if (lane < 16) { float tv = 0.f; int tc = 0;
#pragma unroll
      for (int k = 0; k < 16; ++k) if (k == lane) { tv = top[k]; tc = tix[k]; }
      int ia = 0, ib = 0;
#pragma unroll
      for (int k = 0; k < 16; ++k) { if (k == (tc >> 4)) ia = ti[0][k]; if (k == (tc & 15)) ib = ti[1][k]; }
      p.pidx[((size_t)t * 8 + h) * 16 + lane] = (bf16_t)(ia * 128 + ib); p.pgate[((size_t)t * 8 + h) * 16 + lane] = __expf(tv - top[0]) / sum; }
  }
}

namespace sel {
typedef short bf16x8 __attribute__((ext_vector_type(8)));
typedef float f32x16 __attribute__((ext_vector_type(16)));
constexpr int RS = 272, OFF_W = 2 * 128 * RS, WB = 3 * 16 * 32 * 4;
static_assert(OFF_W + 8 * WB <= SMEM_BYTES, "select LDS layout");
constexpr float NEG = -3.0e38f;
__device__ __forceinline__ float max3(float a, float b, float c) { return fmaxf(fmaxf(a, b), c); }
__device__ __forceinline__ float xhalf(float v) { return __shfl_xor(v, 32); }

__device__ void phase_peer_select(const Params& p, int layer, char* smem) {
  const int tid0 = threadIdx.x;
  __syncthreads();
  { const bf16_t* kb = p.keysb + (size_t)layer * 32768;
    for (int i = tid0; i < 2 * 128 * 16; i += NTHREADS) { const int row = i >> 4, ch = i & 15; *(u32x4*)(smem + row * RS + ch * 16) = *(const u32x4*)(kb + (size_t)row * 128 + ch * 8); } }
  __syncthreads();
  for (int job = blockIdx.x; job < T / 32; job += gridDim.x) {
    int tid_ = threadIdx.x; asm volatile("" : "+v"(tid_));
    const int tid = tid_, wid = tid >> 6, lane = tid & 63, l31 = lane & 31, hh = lane >> 5, h = wid;
    const int t = job * 32 + l31;
    float* const wl = (float*)(smem + OFF_W + wid * WB);
    float rs[2];
#pragma unroll
    for (int pp = 0; pp < 2; ++pp) {
      const bf16_t* qrow = p.QP + (size_t)t * 2048 + h * 256 + pp * 128 + hh * 8;
      bf16x8 bq[8]; float ssq = 0.f;
#pragma unroll
      for (int ks = 0; ks < 8; ++ks) { const u32x4 w = *(const u32x4*)(qrow + ks * 16); bq[ks] = __builtin_bit_cast(bf16x8, w);
        const u32 w0 = w.x, w1 = w.y, w2 = w.z, w3 = w.w; ssq = dot2bf(w0, w0, ssq); ssq = dot2bf(w1, w1, ssq); ssq = dot2bf(w2, w2, ssq); ssq = dot2bf(w3, w3, ssq); }
      ssq += xhalf(ssq); rs[pp] = rsqrtf(ssq * (1.f / 128.f) + EPS);
      f32x16 X[4];
#pragma unroll
      for (int nt = 0; nt < 4; ++nt) {
#pragma unroll
        for (int r = 0; r < 16; ++r) X[nt][r] = 0.f;
        const char* ka = smem + (pp * 128 + nt * 32 + l31) * RS + hh * 16;
#pragma unroll
        for (int ks = 0; ks < 8; ++ks) X[nt] = __builtin_amdgcn_mfma_f32_32x32x16_bf16(*(const bf16x8*)(ka + ks * 32), bq[ks], X[nt], 0, 0, 0); }
#pragma unroll
      for (int nt = 0; nt < 4; ++nt)
#pragma unroll
        for (int r = 0; r < 16; ++r) X[nt][r] = __uint_as_float((__float_as_uint(X[nt][r]) & ~0x7Fu) | (u32)(nt * 32 + (r & 3) + 8 * (r >> 2)) | ((u32)hh << 2));
#pragma unroll 1
      for (int k = 0; k < 16; ++k) {
        float m = NEG;
#pragma unroll
        for (int nt = 0; nt < 4; ++nt)
#pragma unroll
          for (int r = 0; r < 16; r += 2) m = max3(m, X[nt][r], X[nt][r + 1]);
        const float M = fmaxf(m, xhalf(m));
        wl[(pp * 16 + k) * 32 + l31] = M;
#pragma unroll
        for (int nt = 0; nt < 4; ++nt)
#pragma unroll
          for (int r = 0; r < 16; ++r) X[nt][r] = (X[nt][r] == M) ? NEG : X[nt][r];
      }
    }
    float s1[16], s2[16];
#pragma unroll
    for (int k = 0; k < 16; ++k) { s1[k] = wl[k * 32 + l31] * rs[0]; s2[k] = wl[(16 + k) * 32 + l31] * rs[1]; }
    constexpr int A0[25] = {0, 0, 0, 0, 0, 0, 0, 0, 0, 0, 0, 0, 0, 0, 0, 0, 2, 2, 2, 2, 2, 3, 3, 3, 3}, B0[25] = {0, 1, 2, 3, 4, 5, 6, 7, 8, 9, 10, 11, 12, 13, 14, 15, 0, 1, 2, 3, 4, 0, 1, 2, 3};
    constexpr int A1[25] = {1, 1, 1, 1, 1, 1, 1, 1, 4, 4, 4, 5, 5, 6, 6, 7, 7, 8, 9, 10, 11, 12, 13, 14, 15}, B1[25] = {0, 1, 2, 3, 4, 5, 6, 7, 0, 1, 2, 0, 1, 0, 1, 0, 1, 0, 0, 0, 0, 0, 0, 0, 0};
    float cd[25];
#pragma unroll
    for (int i = 0; i < 25; ++i) { const float v0 = s1[A0[i]] + s2[B0[i]], v1 = s1[A1[i]] + s2[B1[i]]; const float v = hh ? v1 : v0; const u32 cid = hh ? (u32)(A1[i] * 16 + B1[i]) : (u32)(A0[i] * 16 + B0[i]);
      cd[i] = __uint_as_float((__float_as_uint(v) & ~0xFFu) | cid); }
#pragma unroll 1
    for (int k = 0; k < 16; ++k) {
      float m = cd[24];
#pragma unroll
      for (int i = 0; i < 24; i += 2) m = max3(m, cd[i], cd[i + 1]);
      const float M = fmaxf(m, xhalf(m));
      wl[(32 + k) * 32 + l31] = M;
#pragma unroll
      for (int i = 0; i < 25; ++i) cd[i] = (cd[i] == M) ? NEG : cd[i];
    }
    float tv[16];
#pragma unroll
    for (int k = 0; k < 16; ++k) tv[k] = wl[(32 + k) * 32 + l31];
    float sum = 0.f;
#pragma unroll
    for (int k = 0; k < 16; ++k) sum += __expf(tv[k] - tv[0]);
    const float inv = 1.f / sum;
    u32 ev[8]; float go[8];
#pragma unroll
    for (int q = 0; q < 8; ++q) { const float v = wl[(32 + hh * 8 + q) * 32 + l31]; const u32 cid = __float_as_uint(v) & 0xFFu;
      const u32 i1 = __float_as_uint(wl[(cid >> 4) * 32 + l31]) & 0x7Fu, i2 = __float_as_uint(wl[(16 + (cid & 15)) * 32 + l31]) & 0x7Fu; ev[q] = i1 * 128 + i2;
      go[q] = __expf(v - tv[0]) * inv; }
    const u32 io0 = ev[0] | (ev[1] << 16), io1 = ev[2] | (ev[3] << 16), io2 = ev[4] | (ev[5] << 16), io3 = ev[6] | (ev[7] << 16);
    const size_t ob = ((size_t)t * 8 + h) * 16 + hh * 8;
    *(u32x4*)(p.pidx + ob) = (u32x4){io0, io1, io2, io3};
    *(f32x4*)(p.pgate + ob) = (f32x4){go[0], go[1], go[2], go[3]}; *(f32x4*)(p.pgate + ob + 4) = (f32x4){go[4], go[5], go[6], go[7]};
  }
}
}

template <int NEXT, bool DRY = false>
__device__ void phase_peer_gather(const Params& p, int layer) {
  const int tid = threadIdx.x, wid = tid >> 6, lane = tid & 63;
  const bf16_t* U = p.U + (size_t)layer * 16384 * 1024; const bf16_t* V = p.V + (size_t)layer * 16384 * 1024;
  for (int job = blockIdx.x; job < T / 8; job += gridDim.x) {
    const int t = job * 8 + wid, b = t / S;
    u32x4 h0 = *(const u32x4*)(p.H + (size_t)t * D + lane * 8), h1 = *(const u32x4*)(p.H + (size_t)t * D + 512 + lane * 8);
    float acc[16];
#pragma unroll
    for (int i = 0; i < 16; ++i) acc[i] = 0.f;
    for (int hh = 0; hh < 8; ++hh) {
      int myidx = 0; float mygate = 0.f;
      if (lane < 16) { myidx = p.pidx[((size_t)t * 8 + hh) * 16 + lane]; mygate = p.pgate[((size_t)t * 8 + hh) * 16 + lane]; }
#pragma unroll 1
      for (int half = 0; half < 4; ++half) {
        u32x4 ua[4], ub[4], va[4], vb[4];
#pragma unroll
        for (int k = 0; k < 4; ++k) { const int e = __builtin_amdgcn_readlane(myidx, half * 4 + k); const bf16_t* ur = U + (size_t)e * 1024 + lane * 8; const bf16_t* vr = V + (size_t)e * 1024 + lane * 8;
          ua[k] = *(const u32x4*)ur; ub[k] = *(const u32x4*)(ur + 512); va[k] = *(const u32x4*)vr; vb[k] = *(const u32x4*)(vr + 512); }
        float dp[4];
#pragma unroll
        for (int k = 0; k < 4; ++k) { float a = 0.f;
          a = dot2bf(ua[k].x, h0.x, a);
          a = dot2bf(ua[k].y, h0.y, a);
          a = dot2bf(ua[k].z, h0.z, a);
          a = dot2bf(ua[k].w, h0.w, a);
          a = dot2bf(ub[k].x, h1.x, a);
          a = dot2bf(ub[k].y, h1.y, a);
          a = dot2bf(ub[k].z, h1.z, a);
          a = dot2bf(ub[k].w, h1.w, a);
          dp[k] = wave_sum(a); }
#pragma unroll
        for (int k = 0; k < 4; ++k) { const float z = dp[k]; const float gt = __uint_as_float(__builtin_amdgcn_readlane(__float_as_uint(mygate), half * 4 + k));
          const float cf = gt * 0.5f * z * (1.f + erff(z * 0.70710678118654752f));
          acc[0] += cf * bflo(va[k].x); acc[1] += cf * bfhi(va[k].x); acc[2] += cf * bflo(va[k].y); acc[3] += cf * bfhi(va[k].y);
          acc[4] += cf * bflo(va[k].z); acc[5] += cf * bfhi(va[k].z); acc[6] += cf * bflo(va[k].w); acc[7] += cf * bfhi(va[k].w);
          acc[8] += cf * bflo(vb[k].x); acc[9] += cf * bfhi(vb[k].x); acc[10] += cf * bflo(vb[k].y); acc[11] += cf * bfhi(vb[k].y);
          acc[12] += cf * bflo(vb[k].z); acc[13] += cf * bfhi(vb[k].z); acc[14] += cf * bflo(vb[k].w); acc[15] += cf * bfhi(vb[k].w); }
      }
    }
    const float* g2 = p.mod + (size_t)(layer * 8 + b) * 6144 + 5120;
    float xv[16]; float ss = 0.f;
#pragma unroll
    for (int hf = 0; hf < 2; ++hf) { const int d = hf * 512 + lane * 8; float* xp = p.X + (size_t)t * D + d;
      f32x4 x0 = *(const f32x4*)xp, x1 = *(const f32x4*)(xp + 4), g0 = *(const f32x4*)(g2 + d), g1 = *(const f32x4*)(g2 + d + 4);
      xv[hf * 8 + 0] = x0.x + g0.x * acc[hf * 8 + 0]; xv[hf * 8 + 1] = x0.y + g0.y * acc[hf * 8 + 1]; xv[hf * 8 + 2] = x0.z + g0.z * acc[hf * 8 + 2]; xv[hf * 8 + 3] = x0.w + g0.w * acc[hf * 8 + 3];
      xv[hf * 8 + 4] = x1.x + g1.x * acc[hf * 8 + 4]; xv[hf * 8 + 5] = x1.y + g1.y * acc[hf * 8 + 5]; xv[hf * 8 + 6] = x1.z + g1.z * acc[hf * 8 + 6]; xv[hf * 8 + 7] = x1.w + g1.w * acc[hf * 8 + 7]; }
#pragma unroll
    for (int i = 0; i < 16; ++i) ss += xv[i] * xv[i];
    ss = wave_sum(ss); const float r = rsqrtf(ss * (1.f / D) + EPS);
    if (DRY && ss != -1.2345f) continue;
    if (NEXT == 0) {
      const float* ml = p.mod + (size_t)((layer + 1) * 8 + b) * 6144; const float* gn = p.nmg + (layer + 1) * D;
#pragma unroll
      for (int hf = 0; hf < 2; ++hf) { const int d = hf * 512 + lane * 8; float* xp = p.X + (size_t)t * D + d; float y[8];
#pragma unroll
        for (int i = 0; i < 8; ++i) y[i] = xv[hf * 8 + i] * r * gn[d + i] * (1.f + ml[1024 + d + i]) + ml[d + i];
        *(f32x4*)xp = (f32x4){xv[hf * 8 + 0], xv[hf * 8 + 1], xv[hf * 8 + 2], xv[hf * 8 + 3]}; *(f32x4*)(xp + 4) = (f32x4){xv[hf * 8 + 4], xv[hf * 8 + 5], xv[hf * 8 + 6], xv[hf * 8 + 7]};
        u32x4 w; w.x = pack2(y[0], y[1]); w.y = pack2(y[2], y[3]); w.z = pack2(y[4], y[5]); w.w = pack2(y[6], y[7]); *(u32x4*)(p.H + (size_t)t * D + d) = w; }
    } else {
#pragma unroll
      for (int hf = 0; hf < 2; ++hf) { const int d = hf * 512 + lane * 8; float* xp = p.X + (size_t)t * D + d; float y[8];
#pragma unroll
        for (int i = 0; i < 8; ++i) y[i] = xv[hf * 8 + i] * r * p.final_g[d + i];
        *(f32x4*)xp = (f32x4){y[0], y[1], y[2], y[3]}; *(f32x4*)(xp + 4) = (f32x4){y[4], y[5], y[6], y[7]}; }
    }
  }
}

__device__ void phase_qkrope(const Params& p) {
  const int tid = threadIdx.x, wid = tid >> 6, lane = tid & 63;
  for (int job = blockIdx.x; job < T * 12 / 8; job += gridDim.x) {
    const int w = job * 8 + wid, t = w / 12, hh = w % 12, b = t / S, s = t & (S - 1);
    const u32 raw = *(const u32*)(p.QKV + (size_t)t * 1536 + hh * 128 + lane * 2); float x0 = bflo(raw), x1 = bfhi(raw);
    if (hh < 10) { const float* g = hh < 8 ? p.qn_g : p.kn_g; const float r = rsqrtf(wave_sum(x0 * x0 + x1 * x1) * (1.f / 128.f) + EPS); x0 *= r * g[2 * lane]; x1 *= r * g[2 * lane + 1];
      const int pos = lane < 32 ? (s >> 6) : (s & 63); const int fi = lane & 31; const float fr = exp2f(-(float)(2 * fi) * (13.287712379549449f / 64.f)); const float ang = (float)pos * fr;
      float sn, cs; sincosf(ang, &sn, &cs); const float y0 = x0 * cs - x1 * sn, y1 = x0 * sn + x1 * cs; x0 = y0; x1 = y1; }
    bf16_t* dst = hh < 8 ? p.Qh + (((size_t)b * 8 + hh) * S + s) * 128 : (hh < 10 ? p.Kh + (((size_t)b * 2 + hh - 8) * S + s) * 128 : p.Vh + (((size_t)b * 2 + hh - 10) * S + s) * 128);
    *(u32*)(dst + lane * 2) = pack2(x0, x1);
  }
}

__device__ void phase_attn_naive(const Params& p) {
  const int tid = threadIdx.x, wid = tid >> 6, lane = tid & 63;
  for (int job = blockIdx.x; job < T * 2 / 8; job += gridDim.x) {
    const int w = job * 8 + wid, kv = w & 1, t = w >> 1, b = t / S, s = t & (S - 1);
    float q0[4], q1[4], m[4], l[4], o0[4], o1[4];
#pragma unroll
    for (int g = 0; g < 4; ++g) { const u32 qq = *(const u32*)(p.Qh + (((size_t)b * 8 + kv * 4 + g) * S + s) * 128 + lane * 2); q0[g] = bflo(qq); q1[g] = bfhi(qq); m[g] = -1e30f; l[g] = 0.f; o0[g] = 0.f; o1[g] = 0.f; }
    const bf16_t* Kb = p.Kh + ((size_t)b * 2 + kv) * S * 128; const bf16_t* Vb = p.Vh + ((size_t)b * 2 + kv) * S * 128;
    for (int k = 0; k < S; ++k) { const u32 kk = *(const u32*)(Kb + (size_t)k * 128 + lane * 2), vv = *(const u32*)(Vb + (size_t)k * 128 + lane * 2);
      const float k0 = bflo(kk), k1 = bfhi(kk), v0 = bflo(vv), v1 = bfhi(vv);
#pragma unroll
      for (int g = 0; g < 4; ++g) { const float sc = wave_sum(q0[g] * k0 + q1[g] * k1) * KSCALE; const float mn = fmaxf(m[g], sc), al = __expf(m[g] - mn), pw = __expf(sc - mn);
        l[g] = l[g] * al + pw; o0[g] = o0[g] * al + pw * v0; o1[g] = o1[g] * al + pw * v1; m[g] = mn; } }
#pragma unroll
    for (int g = 0; g < 4; ++g) *(u32*)(p.CAT + (size_t)t * 1024 + (kv * 4 + g) * 128 + lane * 2) = pack2(o0[g] / l[g], o1[g] / l[g]);
  }
}

namespace att {
using bf16 = unsigned short;
constexpr int   D = 128, NW = 8, QBLK = 32, KVBLK = 64;
constexpr float SCALE = 0.088388347648318440f;
constexpr float THR = 8.f;
constexpr int SDEPTH = 2;
constexpr int LDQ = 128, LDK = 128, LDO = 1024;
constexpr size_t SHM_V = KVBLK * D * 2, SHM_K = KVBLK * D * 2, SHM_ATTN = 2 * SHM_V + 2 * SHM_K + NW * 64 * 4;
using bf16x8 = __attribute__((ext_vector_type(8))) short;
using s16x4  = __attribute__((ext_vector_type(4))) short;
using f32x16 = __attribute__((ext_vector_type(16))) float;
using f32x8  = __attribute__((ext_vector_type(8))) float;
using u32x4  = __attribute__((ext_vector_type(4))) unsigned;
#define KSWZ(row, colB) ((row) * 256 + ((colB) ^ (((row) & 7) << 4)))
#define SBAR() __builtin_amdgcn_sched_barrier(0)
__device__ __forceinline__ int crow(int r, int hi) { return (r & 3) + 8 * (r >> 2) + 4 * hi; }
__device__ __forceinline__ unsigned cvtpk(float lo, float hi) {
  unsigned r; asm volatile("v_cvt_pk_bf16_f32 %0, %1, %2" : "=v"(r) : "v"(lo), "v"(hi)); return r;
}
template <typename TIn> struct Stage;
template <> struct Stage<bf16>  { using T = bf16x8;
  __device__ static __forceinline__ T ld8(const bf16* p) { return *reinterpret_cast<const bf16x8*>(p); }
  __device__ static __forceinline__ bf16x8 tobf(T x) { return x; } };
template <> struct Stage<float> { using T = f32x8;
  __device__ static __forceinline__ T ld8(const float* p) { return *reinterpret_cast<const f32x8*>(p); }
  __device__ static __forceinline__ bf16x8 tobf(T x) {
    u32x4 w = {cvtpk(x[0], x[1]), cvtpk(x[2], x[3]), cvtpk(x[4], x[5]), cvtpk(x[6], x[7])}; return *reinterpret_cast<bf16x8*>(&w); } };

__device__ __forceinline__ void partialSM(f32x16& p0, f32x16& p1, float& m_reg, float& mn, float& alpha) {
  constexpr float C = SCALE * 1.4426950408889634f;
  float pmax = p0[0]; for (int r = 1; r < 16; ++r) pmax = fmaxf(pmax, p0[r]); for (int r = 0; r < 16; ++r) pmax = fmaxf(pmax, p1[r]);
  { auto rr = __builtin_amdgcn_permlane32_swap(__float_as_uint(pmax), __float_as_uint(pmax), false, false);
    pmax = fmaxf(__uint_as_float(rr[0]), __uint_as_float(rr[1])); }
  if (__builtin_expect(__all(pmax - m_reg <= THR / SCALE), 1)) { mn = m_reg; alpha = 1.f; }
  else { mn = fmaxf(m_reg, pmax); alpha = __builtin_amdgcn_exp2f((m_reg - mn) * C); m_reg = mn; }
  float mnC = -mn * C;
  for (int r = 0; r < 16; ++r) p0[r] = fmaf(p0[r], C, mnC); for (int r = 0; r < 16; ++r) p1[r] = fmaf(p1[r], C, mnC);
  for (int r = 0; r < 16; ++r) p0[r] = __builtin_amdgcn_exp2f(p0[r]);
}
__device__ __forceinline__ void finishSM(f32x16& p0, f32x16& p1, float alpha, float& l_reg, bf16x8& pa0, bf16x8& pa1, bf16x8& pa2, bf16x8& pa3) {
  for (int r = 0; r < 16; ++r) p1[r] = __builtin_amdgcn_exp2f(p1[r]);
  float ps = 0; for (int r = 0; r < 16; ++r) ps += p0[r]; for (int r = 0; r < 16; ++r) ps += p1[r];
  { auto rr = __builtin_amdgcn_permlane32_swap(__float_as_uint(ps), __float_as_uint(ps), false, false);
    ps = __uint_as_float(rr[0]) + __uint_as_float(rr[1]); }
  l_reg = l_reg * alpha + ps;
#define PK4(P, BASE, OUT) do { unsigned a0 = cvtpk(P[BASE + 0], P[BASE + 1]), a1 = cvtpk(P[BASE + 2], P[BASE + 3]);   \
    unsigned b0 = cvtpk(P[BASE + 4], P[BASE + 5]), b1 = cvtpk(P[BASE + 6], P[BASE + 7]);                              \
    auto r0 = __builtin_amdgcn_permlane32_swap(a0, b0, false, false); auto r1 = __builtin_amdgcn_permlane32_swap(a1, b1, false, false); \
    u32x4 w = {r0[0], r1[0], r0[1], r1[1]}; OUT = *reinterpret_cast<bf16x8*>(&w); } while (0)
  PK4(p0, 0, pa0); PK4(p0, 8, pa1); PK4(p1, 0, pa2); PK4(p1, 8, pa3);
#undef PK4
}
__device__ __forceinline__ void qkt(f32x16& p0, f32x16& p1, const bf16* Ks, const bf16x8* qr, int r32, int hi) {
  p0 = f32x16{}; p1 = f32x16{};
  for (int d0 = 0; d0 < 8; ++d0) { int cb = (d0 * 16 + hi * 8) * 2;
    bf16x8 b0 = *reinterpret_cast<const bf16x8*>((const char*)Ks + KSWZ(r32, cb));
    bf16x8 b1 = *reinterpret_cast<const bf16x8*>((const char*)Ks + KSWZ(32 + r32, cb));
    p0 = __builtin_amdgcn_mfma_f32_32x32x16_bf16(b0, qr[d0], p0, 0, 0, 0);
    p1 = __builtin_amdgcn_mfma_f32_32x32x16_bf16(b1, qr[d0], p1, 0, 0, 0); }
}
__device__ __forceinline__ int v_st(int k, int c) { const int kk = (k & ~0xC) | ((k & 4) << 1) | ((k & 8) >> 1); return ((kk >> 3) * 4 + (c >> 5)) * 512 + ((kk & 7) * 32 + (c & 31)) * 2; }
__device__ __forceinline__ int v_rd_base(int lane) { return ((lane & 3) << 3) | (((lane >> 2) & 3) << 6) | (((lane >> 4) & 1) << 5) | (((lane >> 5) & 1) << 8); }
constexpr int v_rd_off(int d0, int ks, int half) { return d0 * 512 + ks * 4096 + half * 2048; }
template <int OFF> __device__ __forceinline__ s16x4 tr_read(int vb) {
  s16x4 r; asm volatile("ds_read_b64_tr_b16 %0, %1 offset:%2" : "=&v"(r) : "v"(vb), "i"(OFF) : "memory"); return r;
}
template <int D0> __device__ __forceinline__ void pv_one(f32x16& od, int vb, bf16x8 pa0, bf16x8 pa1, bf16x8 pa2, bf16x8 pa3) {
  const s16x4 l0 = tr_read<v_rd_off(D0, 0, 0)>(vb), h0 = tr_read<v_rd_off(D0, 0, 1)>(vb), l1 = tr_read<v_rd_off(D0, 1, 0)>(vb), h1 = tr_read<v_rd_off(D0, 1, 1)>(vb);
  const s16x4 l2 = tr_read<v_rd_off(D0, 2, 0)>(vb), h2 = tr_read<v_rd_off(D0, 2, 1)>(vb), l3 = tr_read<v_rd_off(D0, 3, 0)>(vb), h3 = tr_read<v_rd_off(D0, 3, 1)>(vb);
  asm volatile("s_waitcnt lgkmcnt(0)" ::: "memory"); SBAR();
#define PK(L, H) (bf16x8){L[0], L[1], L[2], L[3], H[0], H[1], H[2], H[3]}
  od = __builtin_amdgcn_mfma_f32_32x32x16_bf16(pa0, PK(l0, h0), od, 0, 0, 0);
  od = __builtin_amdgcn_mfma_f32_32x32x16_bf16(pa1, PK(l1, h1), od, 0, 0, 0);
  od = __builtin_amdgcn_mfma_f32_32x32x16_bf16(pa2, PK(l2, h2), od, 0, 0, 0);
  od = __builtin_amdgcn_mfma_f32_32x32x16_bf16(pa3, PK(l3, h3), od, 0, 0, 0);
#undef PK
}
__device__ __forceinline__ void pv_d0(f32x16* o, int vb, bf16x8 pa0, bf16x8 pa1, bf16x8 pa2, bf16x8 pa3) {
  pv_one<0>(o[0], vb, pa0, pa1, pa2, pa3); pv_one<1>(o[1], vb, pa0, pa1, pa2, pa3); pv_one<2>(o[2], vb, pa0, pa1, pa2, pa3); pv_one<3>(o[3], vb, pa0, pa1, pa2, pa3);
}

template <typename TQ>
__device__ __forceinline__ void attn_dense_body(const TQ* __restrict__ Qb, const bf16* __restrict__ Kh, const bf16* __restrict__ Vh,
                                                bf16* __restrict__ Ob, int seq, char* lds) {
  using St = Stage<bf16>; using SQ = Stage<TQ>;
  int tid_ = threadIdx.x; asm volatile("" : "+v"(tid_)); const int tid = tid_, wid = tid >> 6, lane = tid & 63, r32 = lane & 31, hi = lane >> 5;
  bf16* V_lds = (bf16*)lds; bf16* K_lds = (bf16*)(lds + 2 * SHM_V);
  float* ws = (float*)(lds + 2 * SHM_V + 2 * SHM_K) + wid * 64; float* li_l = ws; float* al_l = ws + 32;
  float m_reg = -1e30f, l_reg = 0; f32x16 o[4] = {}; bf16x8 qr[8];
  const TQ* Qw = Qb + (long)(wid * QBLK + r32) * LDQ + hi * 8;
#pragma unroll
  for (int d0 = 0; d0 < 8; ++d0) qr[d0] = SQ::tobf(SQ::ld8(Qw + d0 * 16));
  const int sr = tid >> 4, sc = (tid & 15) * 8, vst0 = v_st(sr, sc), vst1 = v_st(32 + sr, sc);
  const int vb0 = (int)(uintptr_t)V_lds + v_rd_base(lane);
  struct { typename St::T vs0, vs1, ks0, ks1; } sr_[SDEPTH];
#define SLOAD(i, k0) do { sr_[i].vs0 = St::ld8(&Vh[(long)((k0) + sr) * LDK + sc]); sr_[i].vs1 = St::ld8(&Vh[(long)((k0) + 32 + sr) * LDK + sc]); \
    sr_[i].ks0 = St::ld8(&Kh[(long)((k0) + sr) * LDK + sc]); sr_[i].ks1 = St::ld8(&Kh[(long)((k0) + 32 + sr) * LDK + sc]); } while (0)
#define SWRITE(b, i) do { *(bf16x8*)((char*)V_lds + (b) * SHM_V + vst0) = St::tobf(sr_[i].vs0);          \
    *(bf16x8*)((char*)V_lds + (b) * SHM_V + vst1) = St::tobf(sr_[i].vs1); int kc = sc * 2;               \
    *(bf16x8*)((char*)K_lds + (b) * SHM_K + KSWZ(sr, kc)) = St::tobf(sr_[i].ks0);                       \
    *(bf16x8*)((char*)K_lds + (b) * SHM_K + KSWZ(32 + sr, kc)) = St::tobf(sr_[i].ks1); } while (0)
#define SWAIT() do { if constexpr (SDEPTH == 2) asm volatile("s_waitcnt vmcnt(4)" ::: "memory"); else asm volatile("s_waitcnt vmcnt(0)" ::: "memory"); } while (0)
#define RESC(a) do { if (__any((a) < 1.f)) { if (hi == 0) al_l[r32] = (a); asm volatile("s_waitcnt lgkmcnt(0)" ::: "memory"); \
    for (int d = 0; d < 4; ++d) for (int r = 0; r < 16; ++r) o[d][r] *= al_l[crow(r, hi)]; } } while (0)
  f32x16 pA0, pA1, pB0, pB1; float mnA, mnB, alA, alB; bf16x8 pa0, pa1, pa2, pa3; const int NT = seq / KVBLK;
  constexpr int SE = 0, SO = SDEPTH - 1;
  SLOAD(SE, 0); asm volatile("s_waitcnt vmcnt(0)" ::: "memory"); SWRITE(0, SE); __syncthreads();
  qkt(pA0, pA1, K_lds, qr, r32, hi); partialSM(pA0, pA1, m_reg, mnA, alA);
  SLOAD(SO, KVBLK); if constexpr (SDEPTH == 2) { if (2 < NT) SLOAD(SE, 2 * KVBLK); }
  SWAIT(); SWRITE(1, SO); __syncthreads();
  for (int j = 1; j + 1 < NT; j += 2) {
    SBAR(); qkt(pB0, pB1, (bf16*)((char*)K_lds + SHM_K), qr, r32, hi);
    finishSM(pA0, pA1, alA, l_reg, pa0, pa1, pa2, pa3); SBAR();
    SLOAD(SO, (j + SDEPTH) * KVBLK); SBAR();
    pv_d0(o, vb0, pa0, pa1, pa2, pa3); partialSM(pB0, pB1, m_reg, mnB, alB);
    __syncthreads(); SWAIT(); SWRITE(0, SE);
    RESC(alB); __syncthreads();
    SBAR(); qkt(pA0, pA1, K_lds, qr, r32, hi);
    finishSM(pB0, pB1, alB, l_reg, pa0, pa1, pa2, pa3); SBAR();
    if (SDEPTH == 1 || j + 3 < NT) SLOAD(SE, (j + 1 + SDEPTH) * KVBLK); SBAR();
    pv_d0(o, vb0 + (int)SHM_V, pa0, pa1, pa2, pa3); partialSM(pA0, pA1, m_reg, mnA, alA);
    __syncthreads(); SWAIT(); SWRITE(1, SO);
    RESC(alA); __syncthreads();
  }
  SBAR(); qkt(pB0, pB1, (bf16*)((char*)K_lds + SHM_K), qr, r32, hi);
  finishSM(pA0, pA1, alA, l_reg, pa0, pa1, pa2, pa3); SBAR();
  pv_d0(o, vb0, pa0, pa1, pa2, pa3); partialSM(pB0, pB1, m_reg, mnB, alB);
  __syncthreads(); RESC(alB);
  finishSM(pB0, pB1, alB, l_reg, pa0, pa1, pa2, pa3); SBAR();
  pv_d0(o, vb0 + (int)SHM_V, pa0, pa1, pa2, pa3);
  if (hi == 0) li_l[r32] = l_reg; asm volatile("s_waitcnt lgkmcnt(0)" ::: "memory");
  float rli[16];
#pragma unroll
  for (int r = 0; r < 16; ++r) rli[r] = __builtin_amdgcn_rcpf(li_l[crow(r, hi)]);
  __syncthreads();
  bf16* Ol = (bf16*)lds + wid * (QBLK * D);
#pragma unroll
  for (int r = 0; r < 16; ++r) { const int orow = crow(r, hi);
#pragma unroll
    for (int d0 = 0; d0 < 4; ++d0) { const float v = o[d0][r] * rli[r]; unsigned u = __float_as_uint(v); u += 0x7FFFu + ((u >> 16) & 1u); Ol[orow * D + d0 * 32 + r32] = (bf16)(u >> 16); } }
  asm volatile("s_waitcnt lgkmcnt(0)" ::: "memory");
#pragma unroll
  for (int i = 0; i < 8; ++i) { const int row = i * 4 + (lane >> 4), ch = (lane & 15) * 8;
    const u32x4 v = *reinterpret_cast<const u32x4*>(Ol + row * D + ch);
    *reinterpret_cast<u32x4*>(Ob + (long)(wid * QBLK + row) * LDO + ch) = v; }
  __syncthreads();
#undef SLOAD
#undef SWRITE
#undef SWAIT
#undef RESC
}

}

__device__ void phase_attn(const Params& p, char* smem) {
  const int G = (int)gridDim.x, c = (int)blockIdx.x;
  for (int i = 0; i * G + c < 1024; ++i) {
    int pair, j;
    if (G == 256) { pair = 2 * (c & 7) + (i >> 1); j = (i & 1) * 32 + (c >> 3); } else { const int L = i * G + c; pair = L >> 6; j = L & 63; }
    const int b = pair >> 1, kv = pair & 1, qb = j >> 2, g = j & 3, h = kv * 4 + g;
    const bf16_t* Qb = p.Qh + (((size_t)b * 8 + h) * S + qb * 256) * 128; const bf16_t* Kp = p.Kh + ((size_t)b * 2 + kv) * S * 128; const bf16_t* Vp = p.Vh + ((size_t)b * 2 + kv) * S * 128;
    bf16_t* Ob = p.CAT + ((size_t)b * S + qb * 256) * 1024 + h * 128;
    att::attn_dense_body<att::bf16>(Qb, Kp, Vp, Ob, S, smem);
  }
}

constexpr int NPH = 19;
__global__ __launch_bounds__(NTHREADS, 2) void mega(Params p, int ph0, int ph1) {
  extern __shared__ __attribute__((aligned(16))) char smem[];
  cg::grid_group grid = cg::this_grid();
#ifndef REP_MASK
#define REP_MASK 0
#endif
#define PHASE(k, call) if (ph0 <= (k) && (k) < ph1) { if ((k) > ph0) grid.sync(); if ((REP_MASK >> (k)) & 1) { if ((k) == 10) phase_peer_gather<0, true>(p, 0); else if ((k) == 18) phase_peer_gather<1, true>(p, 1); else { call; } grid.sync(); } call; }
#if !defined(ONLY_PHASE) || ONLY_PHASE == 0
  PHASE(0, phase_prep(p, smem))
#endif
#if !defined(ONLY_PHASE) || ONLY_PHASE == 1
  PHASE(1, phase_norm<true>(p, p.x, p.nmg, p.mod, 0, 1024, smem))
#endif
#if !defined(ONLY_PHASE) || ONLY_PHASE == 2
  PHASE(2, phase_gemm_fast(p.H, p.Wt_evin, T, 2560, 1024, (EpiEvin{p.ZQK, p.ZV, p.ZO, p.ZP, p.ev_b_in}), smem))
#endif
#if !defined(ONLY_PHASE) || ONLY_PHASE == 3
  PHASE(3, phase_convpool(p, smem))
#endif
#if !defined(ONLY_PHASE) || ONLY_PHASE == 4
  PHASE(4, ml::phase_mlstm(p, smem))
#endif
#if !defined(ONLY_PHASE) || ONLY_PHASE == 5
  PHASE(5, phase_cat(p))
#endif
#if !defined(ONLY_PHASE) || ONLY_PHASE == 6
  PHASE(6, phase_gemm_fast(p.CAT, p.Wt_evout, T, 1024, 1024, (EpiRes{p.x, p.X, p.mod + 2048}), smem))
#endif
#if !defined(ONLY_PHASE) || ONLY_PHASE == 7
  PHASE(7, phase_norm<false>(p, p.X, p.nfg, p.mod, 3072, 4096, smem))
#endif
#if !defined(ONLY_PHASE) || ONLY_PHASE == 8
  PHASE(8, phase_gemm_fast(p.H, p.Wt_q, T, 2048, 1024, (EpiPlain{p.QP, 2048}), smem))
#endif
#if !defined(ONLY_PHASE) || ONLY_PHASE == 9
  PHASE(9, sel::phase_peer_select(p, 0, smem))
#endif
#if !defined(ONLY_PHASE) || ONLY_PHASE == 10
  PHASE(10, phase_peer_gather<0>(p, 0))
#endif
#if !defined(ONLY_PHASE) || ONLY_PHASE == 11
  PHASE(11, phase_gemm_fast(p.H, p.Wt_odin, T, 1536, 1024, (EpiPlain{p.QKV, 1536}), smem))
#endif
#if !defined(ONLY_PHASE) || ONLY_PHASE == 12
  PHASE(12, phase_qkrope(p))
#endif
#if !defined(ONLY_PHASE) || ONLY_PHASE == 13
  PHASE(13, phase_attn(p, smem))
#endif
#if !defined(ONLY_PHASE) || ONLY_PHASE == 14
  PHASE(14, phase_gemm_fast(p.CAT, p.Wt_odout, T, 1024, 1024, (EpiRes{p.X, p.X, p.mod + (size_t)8 * 6144 + 2048}), smem))
#endif
#if !defined(ONLY_PHASE) || ONLY_PHASE == 15
  PHASE(15, phase_norm<false>(p, p.X, p.nfg + D, p.mod + (size_t)8 * 6144, 3072, 4096, smem))
#endif
#if !defined(ONLY_PHASE) || ONLY_PHASE == 16
  PHASE(16, phase_gemm_fast(p.H, p.Wt_q + (size_t)2048 * 1024, T, 2048, 1024, (EpiPlain{p.QP, 2048}), smem))
#endif
#if !defined(ONLY_PHASE) || ONLY_PHASE == 17
  PHASE(17, sel::phase_peer_select(p, 1, smem))
#endif
#if !defined(ONLY_PHASE) || ONLY_PHASE == 18
  PHASE(18, phase_peer_gather<1>(p, 1))
#endif
#undef PHASE
}
}

extern "C" void kernel_launch(void* const* d_in, const int* in_sizes, int n_in, void* d_out, int out_size, void* d_ws, size_t ws_size, hipStream_t stream) {
  (void)in_sizes; (void)n_in; (void)out_size;
  Params p{};
  const float** fin = (const float**)&p;
  for (int i = 0; i < 23; ++i) fin[i] = (const float*)d_in[i];
  p.X = (float*)d_out;
  char* ws = (char*)d_ws; size_t off = 0;
  auto alloc = [&](size_t bytes) { char* q = ws + off; off += (bytes + 255) / 256 * 256; return q; };
  p.U = (bf16_t*)alloc((size_t)2 * 16384 * 1024 * 2); p.V = (bf16_t*)alloc((size_t)2 * 16384 * 1024 * 2);
  p.Wt_evin = (bf16_t*)alloc((size_t)2560 * 1024 * 2); p.Wt_evout = (bf16_t*)alloc((size_t)1024 * 1024 * 2); p.Wt_odin = (bf16_t*)alloc((size_t)1536 * 1024 * 2);
  p.Wt_odout = (bf16_t*)alloc((size_t)1024 * 1024 * 2); p.Wt_q = (bf16_t*)alloc((size_t)2 * 2048 * 1024 * 2); p.keysb = (bf16_t*)alloc((size_t)2 * 2 * 128 * 128 * 2);
  p.Wg = (float*)alloc(16 * 1024 * 4); p.mod = (float*)alloc(2 * 8 * 6144 * 4); p.gates = (float*)alloc((size_t)T * 16 * 4);
  p.pgate = (float*)alloc((size_t)T * 128 * 4); p.pidx = (bf16_t*)alloc((size_t)T * 128 * 2);
  p.H = (bf16_t*)alloc((size_t)T * 1024 * 2); p.CAT = p.H;
  char* big = alloc((size_t)T * 2048 * 2);
  p.ZQK = (bf16_t*)big; p.ZV = (bf16_t*)(big + (size_t)T * 1024 * 2); p.ZO = (bf16_t*)(big + (size_t)T * 1536 * 2); p.HS = (bf16_t*)big; p.QP = (bf16_t*)big; p.QKV = (bf16_t*)big;
  char* big2 = alloc((size_t)T * 1536 * 2);
  p.QK = (bf16_t*)big2; p.ZP = (bf16_t*)(big2 + (size_t)T * 1024 * 2); p.Qh = (bf16_t*)big2; p.Kh = (bf16_t*)(big2 + (size_t)T * 1024 * 2); p.Vh = (bf16_t*)(big2 + (size_t)T * 1280 * 2);
  if (off > ws_size) { fprintf(stderr, "kernel_launch: workspace too small: need %zu have %zu\n", off, ws_size); return; }

  static int grid_blocks = 0;
  if (!grid_blocks) {
    int dev = 0, cus = 0, per_cu = 0; hipGetDevice(&dev); hipDeviceGetAttribute(&cus, hipDeviceAttributeMultiprocessorCount, dev);
    hipFuncSetAttribute((const void*)mega, hipFuncAttributeMaxDynamicSharedMemorySize, SMEM_BYTES);
    hipOccupancyMaxActiveBlocksPerMultiprocessor(&per_cu, mega, NTHREADS, SMEM_BYTES);
    if (per_cu > 1) per_cu = 1;
    grid_blocks = cus * per_cu;
    if (grid_blocks <= 0) { fprintf(stderr, "kernel_launch: occupancy query returned 0\n"); grid_blocks = 0; return; }
  }
#if MULTI_LAUNCH
  for (int ph = 0; ph < NPH; ++ph) hipLaunchKernelGGL(mega, dim3(grid_blocks), dim3(NTHREADS), SMEM_BYTES, stream, p, ph, ph + 1);
#else
  int ph0 = 0, ph1 = NPH; void* args[] = {&p, &ph0, &ph1};
  hipError_t e = hipLaunchCooperativeKernel((const void*)mega, dim3(grid_blocks), dim3(NTHREADS), args, SMEM_BYTES, stream);
  if (e != hipSuccess) fprintf(stderr, "cooperative launch failed: %s (grid %d)\n", hipGetErrorString(e), grid_blocks);
#endif
}
```

```cpp
#include <hip/hip_runtime.h>
#include <hip/hip_cooperative_groups.h>
#include <math.h>
#include <stdint.h>
#include <stdio.h>
namespace cg = cooperative_groups;

#ifndef MULTI_LAUNCH
#define MULTI_LAUNCH 0
#endif

namespace {
typedef unsigned short bf16_t;
typedef unsigned int u32;
typedef float f32x4 __attribute__((ext_vector_type(4)));
typedef u32 u32x4 __attribute__((ext_vector_type(4)));
typedef u32 u32x2 __attribute__((ext_vector_type(2)));
typedef __bf16 bf16x2_t __attribute__((ext_vector_type(2)));

constexpr int D = 1024, NB = 8, S = 4096, T = NB * S;
constexpr int EVEN_IN = 2576;
constexpr float EPS = 1e-6f;
constexpr int NTHREADS = 512;
constexpr int SMEM_BYTES = 144 * 1024;
constexpr float KSCALE = 0.08838834764831845f;

struct Params {
  const float *x, *c, *ada_w, *ada_b, *nmg, *nfg, *ev_w_in, *ev_b_in, *conv_w, *conv_b, *mnorm_g, *pool_w, *pool_sc, *ev_w_out, *od_w_in, *qn_g, *kn_g, *od_w_out,
      *peer_wq, *peer_keys, *peer_u, *peer_v, *final_g;
  float* X;
  bf16_t *Wt_evin, *Wt_evout, *Wt_odin, *Wt_odout, *Wt_q, *keysb; unsigned char *U8, *V8;
  float *Wg, *mod, *gates, *pgate;
  bf16_t *H, *ZQK, *ZV, *ZO, *ZP, *QK, *HS, *CAT, *QP, *QKV, *Qh, *Kh, *Vh;
  bf16_t* pidx;
};

__device__ __forceinline__ float siluf(float x) { return x / (1.f + __expf(-x)); }
__device__ __forceinline__ float sigmf(float x) { return 1.f / (1.f + __expf(-x)); }
__device__ __forceinline__ float wave_sum(float v) { for (int o = 32; o >= 1; o >>= 1) v += __shfl_xor(v, o); return v; }
__device__ __forceinline__ float wave_max(float v) { for (int o = 32; o >= 1; o >>= 1) v = fmaxf(v, __shfl_xor(v, o)); return v; }
__device__ __forceinline__ bf16_t f2bf(float f) { u32 u = __float_as_uint(f); u += 0x7FFFu + ((u >> 16) & 1u); return (bf16_t)(u >> 16); }
__device__ __forceinline__ float bf2f(bf16_t b) { return __uint_as_float(((u32)b) << 16); }
__device__ __forceinline__ u32 pack2(float lo, float hi) { return (u32)f2bf(lo) | ((u32)f2bf(hi) << 16); }
__device__ __forceinline__ float bflo(u32 w) { return __uint_as_float(w << 16); }
__device__ __forceinline__ float bfhi(u32 w) { return __uint_as_float(w & 0xFFFF0000u); }
__device__ __forceinline__ float dot2bf(u32 a, u32 b, float c) { return __builtin_amdgcn_fdot2_f32_bf16(__builtin_bit_cast(bf16x2_t, a), __builtin_bit_cast(bf16x2_t, b), c, false); }

constexpr int PJ_MOD = 192, PJ_TR = 2576, PJ_WG = 1, PJ_KEYS = 16, PJ_UV = 8192;
constexpr int PJ_TOTAL = PJ_MOD + PJ_TR + PJ_WG + PJ_KEYS + PJ_UV;

__device__ void prep_transpose_tile(const float* __restrict__ src, int ld, int k0, int n0, bf16_t* __restrict__ dst, int dstK, char* smem) {
  float* tile = (float*)smem;
  const int tid = threadIdx.x;
  __syncthreads();
  for (int pass = 0; pass < 8; ++pass) { int kk = pass * 8 + (tid >> 6), n = tid & 63; tile[kk * 65 + n] = src[(size_t)(k0 + kk) * ld + n0 + n]; }
  __syncthreads();
  int n = tid >> 3, kc = (tid & 7) * 8; u32x4 w;
  w.x = pack2(tile[(kc + 0) * 65 + n], tile[(kc + 1) * 65 + n]); w.y = pack2(tile[(kc + 2) * 65 + n], tile[(kc + 3) * 65 + n]);
  w.z = pack2(tile[(kc + 4) * 65 + n], tile[(kc + 5) * 65 + n]); w.w = pack2(tile[(kc + 6) * 65 + n], tile[(kc + 7) * 65 + n]);
  *(u32x4*)(dst + (size_t)(n0 + n) * dstK + k0 + kc) = w;
}

__device__ void phase_prep(const Params& p, char* smem) {
  const int tid = threadIdx.x;
  for (int job = blockIdx.x; job < PJ_TOTAL; job += gridDim.x) {
    if (job < PJ_MOD) {
      float* cs = (float*)smem; float* red = cs + 8192;
      __syncthreads();
      for (int i = tid; i < 8192; i += NTHREADS) cs[i] = siluf(p.c[i]);
      __syncthreads();
      const int l = job / 96, e0 = (job % 96) * 64, col = tid & 63, dg = tid >> 6;
      float acc[8];
#pragma unroll
      for (int b = 0; b < 8; ++b) acc[b] = 0.f;
      const float* w = p.ada_w + (size_t)l * D * 6144 + e0 + col;
      for (int d = dg * 128; d < dg * 128 + 128; ++d) { float wv = w[(size_t)d * 6144];
#pragma unroll
        for (int b = 0; b < 8; ++b) acc[b] += cs[b * 1024 + d] * wv; }
#pragma unroll
      for (int b = 0; b < 8; ++b) red[(dg * 8 + b) * 64 + col] = acc[b];
      __syncthreads();
      { const int b = tid >> 6; float s = 0.f;
#pragma unroll
        for (int g = 0; g < 8; ++g) s += red[(g * 8 + b) * 64 + col];
        p.mod[(size_t)(l * 8 + b) * 6144 + e0 + col] = s + p.ada_b[l * 6144 + e0 + col]; }
    } else if (job < PJ_MOD + PJ_TR) {
      int tt = job - PJ_MOD;
      if (tt < 640) prep_transpose_tile(p.ev_w_in, EVEN_IN, (tt / 40) * 64, (tt % 40) * 64, p.Wt_evin, 1024, smem);
      else if (tt < 896) { tt -= 640; prep_transpose_tile(p.ev_w_out, 1024, (tt / 16) * 64, (tt % 16) * 64, p.Wt_evout, 1024, smem); }
      else if (tt < 1280) { tt -= 896; prep_transpose_tile(p.od_w_in, 1536, (tt / 24) * 64, (tt % 24) * 64, p.Wt_odin, 1024, smem); }
      else if (tt < 1536) { tt -= 1280; prep_transpose_tile(p.od_w_out, 1024, (tt / 16) * 64, (tt % 16) * 64, p.Wt_odout, 1024, smem); }
      else if (tt < 2560) { tt -= 1536; int l = tt / 512; tt %= 512; prep_transpose_tile(p.peer_wq + (size_t)l * D * 2048, 2048, (tt / 32) * 64, (tt % 32) * 64, p.Wt_q + (size_t)l * 2048 * 1024, 1024, smem); }
      else {   }
    } else if (job < PJ_MOD + PJ_TR + PJ_WG) {
      for (int i = tid; i < 16 * 1024; i += NTHREADS) { int g = i >> 10, d = i & 1023; p.Wg[i] = p.ev_w_in[(size_t)d * EVEN_IN + 2560 + g]; }
    } else if (job < PJ_MOD + PJ_TR + PJ_WG + PJ_KEYS) {
      int j = job - (PJ_MOD + PJ_TR + PJ_WG);
      for (int i = tid; i < 4096; i += NTHREADS) p.keysb[j * 4096 + i] = f2bf(p.peer_keys[j * 4096 + i]);
    } else {
      int j = job - (PJ_MOD + PJ_TR + PJ_WG + PJ_KEYS); const bool isu = j < 4096; const float* src = isu ? p.peer_u : p.peer_v; unsigned char* dst = isu ? p.U8 : p.V8; j &= 4095; const float sc = isu ? 32.f : 2.f;
      const size_t o = (size_t)j * 8192 + tid * 16; u32x4 w; u32 ww[4];
#pragma unroll
      for (int q = 0; q < 4; ++q) { const f32x4 a = *(const f32x4*)(src + o + 4 * q); int pk = __builtin_amdgcn_cvt_pk_fp8_f32(a.x * sc, a.y * sc, 0, false); pk = __builtin_amdgcn_cvt_pk_fp8_f32(a.z * sc, a.w * sc, pk, true); ww[q] = (u32)pk; }
      w.x = ww[0]; w.y = ww[1]; w.z = ww[2]; w.w = ww[3]; *(u32x4*)(dst + o) = w;
    }
  }
}

template <bool WITH_GATES>
__device__ void phase_norm(const Params& p, const float* __restrict__ xin, const float* __restrict__ g, const float* __restrict__ modl, int sh_off, int sc_off, char* smem) {
  const int tid = threadIdx.x, wid = tid >> 6, lane = tid & 63;
  float* wg = (float*)smem;
  if (WITH_GATES) { __syncthreads(); for (int i = tid; i < 16 * 1024; i += NTHREADS) wg[i] = p.Wg[i]; __syncthreads(); }
  for (int job = blockIdx.x; job < T / 8; job += gridDim.x) {
    const int t = job * 8 + wid, b = t / S;
    f32x4 v[4]; float ss = 0.f;
#pragma unroll
    for (int i = 0; i < 4; ++i) { v[i] = *(const f32x4*)(xin + (size_t)t * D + i * 256 + lane * 4); ss += v[i].x * v[i].x + v[i].y * v[i].y + v[i].z * v[i].z + v[i].w * v[i].w; }
    ss = wave_sum(ss); const float r = rsqrtf(ss * (1.f / D) + EPS);
    const float* shp = modl + (size_t)b * 6144 + sh_off; const float* scp = modl + (size_t)b * 6144 + sc_off;
#pragma unroll
    for (int i = 0; i < 4; ++i) { const int d = i * 256 + lane * 4; f32x4 gg = *(const f32x4*)(g + d), s1 = *(const f32x4*)(scp + d), s0 = *(const f32x4*)(shp + d);
      v[i].x = v[i].x * r * gg.x * (1.f + s1.x) + s0.x; v[i].y = v[i].y * r * gg.y * (1.f + s1.y) + s0.y; v[i].z = v[i].z * r * gg.z * (1.f + s1.z) + s0.z; v[i].w = v[i].w * r * gg.w * (1.f + s1.w) + s0.w;
      u32x2 w; w.x = pack2(v[i].x, v[i].y); w.y = pack2(v[i].z, v[i].w); *(u32x2*)(p.H + (size_t)t * D + d) = w; }
    if (WITH_GATES) {
      float myg = 0.f;
#pragma unroll 2
      for (int gi = 0; gi < 16; ++gi) { float a = 0.f;
#pragma unroll
        for (int i = 0; i < 4; ++i) { f32x4 w4 = *(const f32x4*)(wg + gi * 1024 + i * 256 + lane * 4); a += v[i].x * w4.x + v[i].y * w4.y + v[i].z * w4.z + v[i].w * w4.w; }
        a = wave_sum(a); if (lane == gi) myg = a; }
      if (lane < 16) p.gates[(size_t)t * 16 + lane] = myg + p.ev_b_in[2560 + lane];
    }
  }
}

enum { EPI_EVIN = 0, EPI_EVOUT = 1, EPI_PEERQ = 2, EPI_ODIN = 3, EPI_ODOUT = 4 };
template <int EPI> __device__ __forceinline__ void epi_store(const Params& p, int layer, int m, int n, float acc) {
  if (EPI == EPI_EVIN) { float v = acc + p.ev_b_in[n];
    if (n < 1024) p.ZQK[(size_t)m * 1024 + n] = f2bf(v); else if (n < 1536) p.ZV[(size_t)m * 512 + n - 1024] = f2bf(v);
    else if (n < 2048) p.ZO[(size_t)m * 512 + n - 1536] = f2bf(sigmf(v)); else p.ZP[(size_t)m * 512 + n - 2048] = f2bf(v); }
  else if (EPI == EPI_EVOUT) { int b = m / S; p.X[(size_t)m * D + n] = p.x[(size_t)m * D + n] + p.mod[(size_t)(0 * 8 + b) * 6144 + 2048 + n] * acc; }
  else if (EPI == EPI_PEERQ) p.QP[(size_t)m * 2048 + n] = f2bf(acc);
  else if (EPI == EPI_ODIN) p.QKV[(size_t)m * 1536 + n] = f2bf(acc);
  else if (EPI == EPI_ODOUT) { int b = m / S; p.X[(size_t)m * D + n] += p.mod[(size_t)(1 * 8 + b) * 6144 + 2048 + n] * acc; }
}
template <int EPI> __device__ void phase_gemm_naive(const Params& p, int layer, const bf16_t* __restrict__ A, const bf16_t* __restrict__ Bt, int M, int N, int K, char* smem) {
  float* As = (float*)smem; float* Bs = As + 32 * 132;
  const int tid = threadIdx.x, tx = tid & 15, ty = tid >> 4; const int nN = N / 64, njobs = (M / 128) * nN;
  for (int job = blockIdx.x; job < njobs; job += gridDim.x) {
    const int m0 = (job / nN) * 128, n0 = (job % nN) * 64; float acc[4][4];
#pragma unroll
    for (int i = 0; i < 4; ++i)
#pragma unroll
      for (int j = 0; j < 4; ++j) acc[i][j] = 0.f;
    for (int k0 = 0; k0 < K; k0 += 32) {
      __syncthreads();
      { int row = tid >> 2, kc = (tid & 3) * 8; u32x4 w = *(const u32x4*)(A + (size_t)(m0 + row) * K + k0 + kc);
        As[(kc + 0) * 132 + row] = bflo(w.x); As[(kc + 1) * 132 + row] = bfhi(w.x); As[(kc + 2) * 132 + row] = bflo(w.y); As[(kc + 3) * 132 + row] = bfhi(w.y);
        As[(kc + 4) * 132 + row] = bflo(w.z); As[(kc + 5) * 132 + row] = bfhi(w.z); As[(kc + 6) * 132 + row] = bflo(w.w); As[(kc + 7) * 132 + row] = bfhi(w.w); }
      if (tid < 256) { int row = tid >> 2, kc = (tid & 3) * 8; u32x4 w = *(const u32x4*)(Bt + (size_t)(n0 + row) * K + k0 + kc);
        Bs[(kc + 0) * 68 + row] = bflo(w.x); Bs[(kc + 1) * 68 + row] = bfhi(w.x); Bs[(kc + 2) * 68 + row] = bflo(w.y); Bs[(kc + 3) * 68 + row] = bfhi(w.y);
        Bs[(kc + 4) * 68 + row] = bflo(w.z); Bs[(kc + 5) * 68 + row] = bfhi(w.z); Bs[(kc + 6) * 68 + row] = bflo(w.w); Bs[(kc + 7) * 68 + row] = bfhi(w.w); }
      __syncthreads();
#pragma unroll 8
      for (int kk = 0; kk < 32; ++kk) { f32x4 a = *(const f32x4*)(As + kk * 132 + ty * 4), b = *(const f32x4*)(Bs + kk * 68 + tx * 4);
        acc[0][0] += a.x * b.x; acc[0][1] += a.x * b.y; acc[0][2] += a.x * b.z; acc[0][3] += a.x * b.w;
        acc[1][0] += a.y * b.x; acc[1][1] += a.y * b.y; acc[1][2] += a.y * b.z; acc[1][3] += a.y * b.w;
        acc[2][0] += a.z * b.x; acc[2][1] += a.z * b.y; acc[2][2] += a.z * b.z; acc[2][3] += a.z * b.w;
        acc[3][0] += a.w * b.x; acc[3][1] += a.w * b.y; acc[3][2] += a.w * b.z; acc[3][3] += a.w * b.w; }
    }
#pragma unroll
    for (int i = 0; i < 4; ++i)
#pragma unroll
      for (int j = 0; j < 4; ++j) epi_store<EPI>(p, layer, m0 + ty * 4 + i, n0 + tx * 4 + j, acc[i][j]);
  }
}

namespace pg8 {
#define PG8_LAS __attribute__((address_space(3)))
typedef unsigned short bf16_t;
typedef short bf16x8 __attribute__((ext_vector_type(8)));
typedef float f32x4 __attribute__((ext_vector_type(4)));
typedef unsigned u32x4 __attribute__((ext_vector_type(4)));
constexpr int BM = 256, BK = 64, HALF = 128, HTB = HALF * BK * 2  , STAGE_BYTES = 8 * HTB, NXCD = 8, WGM = 8;

__host__ __device__ __forceinline__ int lds_byte(int r, int c) { const int st = (r >> 4) * 2 + (c >> 5), rr = r & 15, cc = c & 31, ob = rr * 64 + cc * 2; return st * 1024 + (ob ^ (((ob >> 9) & 1) << 5)); }
__host__ __device__ __forceinline__ void stage_rc(int b, int& R, int& C) { const int st = b / 1024, sb = b % 1024, swz = sb ^ (((sb >> 9) & 1) << 5); R = (st >> 1) * 16 + swz / 64; C = (st & 1) * 32 + (swz % 64) / 2; }
__host__ __device__ __forceinline__ int perm32(int rho) { const int n = rho >> 4, i = rho & 15; return 8 * (i >> 2) + 4 * n + (i & 3); }

struct Unit { int pm, pn; };
struct Gemm { const bf16_t* A; const bf16_t* Bt; int M, N, K; };

struct StaticOrder {
    int nM, nN, nwg, G, c;
    __host__ __device__ void init(int M, int N, int G_, int c_) { nM = M / BM; nN = N / BM; nwg = nM * nN; G = G_; c = c_; }
    __host__ __device__ bool next(int i, Unit& u) const {
        const long L = (long)i * G + c; if (L >= nwg) return false;
        int wgid = (int)L; { const int q = nwg / NXCD, r = nwg % NXCD, xcd = wgid % NXCD, off = wgid / NXCD; wgid = (xcd < r ? xcd * (q + 1) : r * (q + 1) + (xcd - r) * q) + off; }
        const int nig = WGM * nN, gid = wgid / nig, fm = gid * WGM, gsz = (nM - fm) < WGM ? (nM - fm) : WGM;
        u.pm = fm + ((wgid % nig) % gsz); u.pn = (wgid % nig) / gsz; return true;
    }
    __device__ __forceinline__ void a_ready(const Unit&) const {}
    __device__ __forceinline__ void done(const Unit&) const {}
};
__device__ __forceinline__ unsigned cvt_pk_bf16(float lo, float hi) { unsigned r; asm volatile("v_cvt_pk_bf16_f32 %0, %1, %2" : "=v"(r) : "v"(lo), "v"(hi)); return r; }
template <class Epi, class Sched, bool STAMP = false>
__device__ __forceinline__ void gemm_phase(PG8_LAS unsigned char* lds, const Gemm g, const Sched& S, const Epi& E, unsigned long long* stamps) {
    const int tid = threadIdx.x, wid = __builtin_amdgcn_readfirstlane(tid >> 6), lane = tid & 63, wr = wid >> 2, wc = wid & 3, fr = lane & 15, fq = lane >> 4;
    const int K = g.K, nt = K / BK;
    int ts_lo = 0, ts_hi = 0, nts = 0; const unsigned long long rt_entry = STAMP ? (unsigned long long)wall_clock64() : 0ull;
#define PG8_STAMP() do { if (STAMP && wid == 0 && nts < 64) { const unsigned long long _c = (unsigned long long)clock64(); \
        ts_lo = (lane == nts) ? (int)(unsigned)_c : ts_lo; ts_hi = (lane == nts) ? (int)(unsigned)(_c >> 32) : ts_hi; ++nts; } } while (0)
    PG8_STAMP();
    unsigned voffA[2], voffB[2];
#pragma unroll
    for (int i = 0; i < 2; ++i) { int R, C; stage_rc(tid * 16 + i * 8192, R, C); const int Rb = Epi::PERM ? ((R & ~31) + perm32(R & 31)) : R;
        voffA[i] = (unsigned)(R * K + C) * 2u; voffB[i] = (unsigned)(Rb * K + C) * 2u; }
    const size_t kstep = (size_t)(BK * 2);
    const size_t hstep = (size_t)HALF * K * 2;
    const size_t tstep = 2 * hstep;
    const unsigned ldsw = (unsigned)wid * 1024u;
    const int aoff = lds_byte(wr * 64 + fr, fq * 8), boff = lds_byte(wc * 32 + fr, fq * 8);
#define PG8_SA(b, h) (((b) * 2 + (h)) * HTB)
#define PG8_SB(b, h) ((4 + (b) * 2 + (h)) * HTB)
#define PG8_STAGE(bufoff, gbase, voff) do { _Pragma("unroll") for (int _i = 0; _i < 2; ++_i) \
        __builtin_amdgcn_global_load_lds((const unsigned*)((const char*)(gbase) + (voff)[_i]), (PG8_LAS unsigned*)(lds + (bufoff) + ldsw + _i * 8192), 16, 0, 0); } while (0)
#define PG8_LDA(dst, b, h) do { _Pragma("unroll") for (int m = 0; m < 4; ++m) _Pragma("unroll") for (int k = 0; k < 2; ++k) dst[m][k] = *(const PG8_LAS bf16x8*)(lds + PG8_SA(b, h) + aoff + m * 2048 + k * 1024); } while (0)
#define PG8_LDB(dst, b, h) do { _Pragma("unroll") for (int n = 0; n < 2; ++n) _Pragma("unroll") for (int k = 0; k < 2; ++k) dst[n][k] = *(const PG8_LAS bf16x8*)(lds + PG8_SB(b, h) + boff + n * 2048 + k * 1024); } while (0)
#define PG8_MMA(ai, bj, At, Bt) do { __builtin_amdgcn_s_setprio(1); _Pragma("unroll") for (int m = 0; m < 4; ++m) _Pragma("unroll") for (int n = 0; n < 2; ++n) _Pragma("unroll") for (int k = 0; k < 2; ++k) \
        acc[ai][bj][m][n] = __builtin_amdgcn_mfma_f32_16x16x32_bf16(Bt[n][k], At[m][k], acc[ai][bj][m][n], 0, 0, 0); __builtin_amdgcn_s_setprio(0); } while (0)
#define PG8_WAIT_V(n) asm volatile("s_waitcnt vmcnt(" #n ")" ::: "memory")
#define PG8_WAIT_L(n) asm volatile("s_waitcnt lgkmcnt(" #n ")" ::: "memory")
#define PG8_BAR __builtin_amdgcn_s_barrier()
#define PG8_SCHED __builtin_amdgcn_sched_barrier(0)
    Unit cur, nxt; int ui = 0;
    if (!S.next(0, cur)) return;
    f32x4 acc[2][2][4][2];
#pragma unroll
    for (int a = 0; a < 2; ++a)
#pragma unroll
        for (int b = 0; b < 2; ++b)
#pragma unroll
            for (int m = 0; m < 4; ++m)
#pragma unroll
                for (int n = 0; n < 2; ++n) acc[a][b][m][n] = (f32x4){0.f, 0.f, 0.f, 0.f};
    bf16x8 At[4][2], B0[2][2], B1[2][2];
    const char* cA = (const char*)g.A + (size_t)cur.pm * tstep; const char* cB = (const char*)g.Bt + (size_t)cur.pn * tstep;
    S.a_ready(cur);
    PG8_STAGE(PG8_SB(0, 0), cB, voffB); PG8_STAGE(PG8_SA(0, 0), cA, voffA); PG8_STAGE(PG8_SB(0, 1), cB + hstep, voffB); PG8_STAGE(PG8_SA(0, 1), cA + hstep, voffA);
    if (wr == 1) PG8_BAR;
    PG8_WAIT_V(4); PG8_BAR;
    PG8_STAGE(PG8_SB(1, 0), cB + kstep, voffB); PG8_STAGE(PG8_SA(1, 0), cA + kstep, voffA); PG8_STAGE(PG8_SB(1, 1), cB + hstep + kstep, voffB);
    PG8_WAIT_V(6); PG8_BAR;
    PG8_STAMP();
    for (;;) {
        const bool has_next = S.next(ui + 1, nxt);
        const char* nA = has_next ? (const char*)g.A + (size_t)nxt.pm * tstep : cA; const char* nB = has_next ? (const char*)g.Bt + (size_t)nxt.pn * tstep : cB;
        for (int t = 0; t < nt; t += 2) {
            const bool last = (t == nt - 2);
            const char* a1 = cA + (size_t)(t + 1) * kstep;
            const char* a2 = last ? nA : cA + (size_t)(t + 2) * kstep; const char* b2 = last ? nB : cB + (size_t)(t + 2) * kstep;
            const char* a3 = a2 + kstep; const char* b3 = b2 + kstep;
            if (last && has_next) S.a_ready(nxt);
            PG8_LDB(B0, 0, 0); PG8_SCHED; PG8_LDA(At, 0, 0); PG8_STAGE(PG8_SA(1, 1), a1 + hstep, voffA);
            PG8_WAIT_L(8); PG8_BAR; PG8_WAIT_L(0); PG8_MMA(0, 0, At, B0); PG8_BAR; PG8_SCHED;
            PG8_LDB(B1, 0, 1); PG8_STAGE(PG8_SB(0, 0), b2, voffB);
            PG8_BAR; PG8_WAIT_L(0); PG8_MMA(0, 1, At, B1); PG8_BAR;
            PG8_LDA(At, 0, 1); PG8_STAGE(PG8_SA(0, 0), a2, voffA);
            PG8_BAR; PG8_WAIT_L(0); PG8_MMA(1, 0, At, B0); PG8_BAR; PG8_SCHED;
            PG8_STAGE(PG8_SB(0, 1), b2 + hstep, voffB);
            PG8_WAIT_V(6); PG8_BAR; PG8_MMA(1, 1, At, B1); PG8_BAR;
            PG8_LDB(B0, 1, 0); PG8_SCHED; PG8_LDA(At, 1, 0); PG8_STAGE(PG8_SA(0, 1), a2 + hstep, voffA);
            PG8_WAIT_L(8); PG8_BAR; PG8_WAIT_L(0); PG8_MMA(0, 0, At, B0); PG8_BAR; PG8_SCHED;
            PG8_LDB(B1, 1, 1); PG8_STAGE(PG8_SB(1, 0), b3, voffB);
            PG8_BAR; PG8_WAIT_L(0); PG8_MMA(0, 1, At, B1); PG8_BAR;
            PG8_LDA(At, 1, 1); PG8_STAGE(PG8_SA(1, 0), a3, voffA);
            PG8_BAR; PG8_WAIT_L(0); PG8_MMA(1, 0, At, B0); PG8_BAR; PG8_SCHED;
            PG8_STAGE(PG8_SB(1, 1), b3 + hstep, voffB);
            PG8_WAIT_V(6); PG8_BAR; PG8_MMA(1, 1, At, B1); PG8_BAR;
        }
        PG8_STAMP();
        if constexpr (!Epi::AFTER_DRAIN) { E(acc, cur, wr, wc, fr, fq); S.done(cur); }
        PG8_STAMP();
        if (!has_next) break;
#pragma unroll
        for (int a = 0; a < 2; ++a)
#pragma unroll
            for (int b = 0; b < 2; ++b)
#pragma unroll
                for (int m = 0; m < 4; ++m)
#pragma unroll
                    for (int n = 0; n < 2; ++n) acc[a][b][m][n] = (f32x4){0.f, 0.f, 0.f, 0.f};
        cur = nxt; cA = nA; cB = nB; ++ui;
    }
    PG8_WAIT_V(0);
    if (wr == 0) PG8_BAR;
    PG8_BAR;
    if constexpr (Epi::AFTER_DRAIN) { E.fused(acc, cur, wr, wc, fr, fq, lds, wid, lane); S.done(cur); }
    PG8_STAMP();
    if (STAMP && wid == 0) { stamps[lane] = lane < nts ? (((unsigned long long)(unsigned)ts_hi << 32) | (unsigned)ts_lo) : 0ull;
        if (lane == 62) stamps[62] = rt_entry; if (lane == 63) stamps[63] = (unsigned long long)wall_clock64(); }
#undef PG8_STAMP
#undef PG8_SA
#undef PG8_SB
#undef PG8_STAGE
#undef PG8_LDA
#undef PG8_LDB
#undef PG8_MMA
#undef PG8_WAIT_V
#undef PG8_WAIT_L
#undef PG8_BAR
#undef PG8_SCHED
}
}

struct EpiEvin {
  static constexpr bool PERM = true, AFTER_DRAIN = false;
  bf16_t *ZQK, *ZV, *ZO, *ZP; const float* bias;
  __device__ __forceinline__ void operator()(const pg8::f32x4 (&acc)[2][2][4][2], const pg8::Unit& u, int wr, int wc, int fr, int fq) const {
    const int row0 = u.pm * 256 + wr * 64 + fr, ct = u.pn * 256;
    bf16_t* base; int ldc, cl; bool sig = false;
    if (ct < 1024) { base = ZQK; ldc = 1024; cl = ct; } else if (ct < 1536) { base = ZV; ldc = 512; cl = ct - 1024; } else if (ct < 2048) { base = ZO; ldc = 512; cl = ct - 1536; sig = true; } else { base = ZP; ldc = 512; cl = ct - 2048; }
    const int cofs = wc * 32 + 8 * fq;
    pg8::f32x4 bv[2][2];
#pragma unroll
    for (int bj = 0; bj < 2; ++bj)
#pragma unroll
      for (int n = 0; n < 2; ++n) bv[bj][n] = *(const pg8::f32x4*)(bias + ct + cofs + bj * 128 + 4 * n);
#pragma unroll
    for (int ai = 0; ai < 2; ++ai)
#pragma unroll
      for (int m = 0; m < 4; ++m) { bf16_t* rowp = base + (size_t)(row0 + ai * 128 + m * 16) * ldc + cl + cofs;
#pragma unroll
        for (int bj = 0; bj < 2; ++bj) { pg8::f32x4 v0 = acc[ai][bj][m][0] + bv[bj][0], v1 = acc[ai][bj][m][1] + bv[bj][1];
          if (sig) {
#pragma unroll
            for (int j = 0; j < 4; ++j) { v0[j] = sigmf(v0[j]); v1[j] = sigmf(v1[j]); } }
          pg8::u32x4 w; w.x = pg8::cvt_pk_bf16(v0[0], v0[1]); w.y = pg8::cvt_pk_bf16(v0[2], v0[3]); w.z = pg8::cvt_pk_bf16(v1[0], v1[1]); w.w = pg8::cvt_pk_bf16(v1[2], v1[3]);
          *(pg8::u32x4*)(rowp + bj * 128) = w; } }
  }
};
struct EpiPlain {
  static constexpr bool PERM = true, AFTER_DRAIN = false;
  bf16_t* out; int ldc;
  __device__ __forceinline__ void operator()(const pg8::f32x4 (&acc)[2][2][4][2], const pg8::Unit& u, int wr, int wc, int fr, int fq) const {
    const int row0 = u.pm * 256 + wr * 64 + fr, col0 = u.pn * 256 + wc * 32 + 8 * fq;
#pragma unroll
    for (int ai = 0; ai < 2; ++ai)
#pragma unroll
      for (int m = 0; m < 4; ++m) { bf16_t* rowp = out + (size_t)(row0 + ai * 128 + m * 16) * ldc + col0;
#pragma unroll
        for (int bj = 0; bj < 2; ++bj) { const pg8::f32x4 v0 = acc[ai][bj][m][0], v1 = acc[ai][bj][m][1];
          pg8::u32x4 w; w.x = pg8::cvt_pk_bf16(v0[0], v0[1]); w.y = pg8::cvt_pk_bf16(v0[2], v0[3]); w.z = pg8::cvt_pk_bf16(v1[0], v1[1]); w.w = pg8::cvt_pk_bf16(v1[2], v1[3]);
          *(pg8::u32x4*)(rowp + bj * 128) = w; } }
  }
};
struct EpiRes {
  static constexpr bool PERM = false, AFTER_DRAIN = false;
  const float* xin; float* X; const float* gate;
  __device__ __forceinline__ void operator()(const pg8::f32x4 (&acc)[2][2][4][2], const pg8::Unit& u, int wr, int wc, int fr, int fq) const {
    const int row0 = u.pm * 256 + wr * 64 + fr, col0 = u.pn * 256 + wc * 32 + 4 * fq; const float* gb = gate + (size_t)((u.pm * 256) / S) * 6144;
    pg8::f32x4 gv[2][2];
#pragma unroll
    for (int bj = 0; bj < 2; ++bj)
#pragma unroll
      for (int n = 0; n < 2; ++n) gv[bj][n] = *(const pg8::f32x4*)(gb + col0 + bj * 128 + n * 16);
#pragma unroll
    for (int ai = 0; ai < 2; ++ai)
#pragma unroll
      for (int m = 0; m < 4; ++m) { const size_t off = (size_t)(row0 + ai * 128 + m * 16) * 1024 + col0;
#pragma unroll
        for (int bj = 0; bj < 2; ++bj)
#pragma unroll
          for (int n = 0; n < 2; ++n) { const pg8::f32x4 xi = *(const pg8::f32x4*)(xin + off + bj * 128 + n * 16); *(pg8::f32x4*)(X + off + bj * 128 + n * 16) = xi + gv[bj][n] * acc[ai][bj][m][n]; }
        asm volatile("" ::: "memory"); }
  }
};
template <class Epi> __device__ __forceinline__ void phase_gemm_fast(const bf16_t* A, const bf16_t* Bt, int M, int N, int K, const Epi& E, char* smem) {
  pg8::Gemm g; g.A = A; g.Bt = Bt; g.M = M; g.N = N; g.K = K;
  pg8::StaticOrder So; So.init(M, N, (int)gridDim.x, (int)blockIdx.x);
  pg8::gemm_phase<Epi, pg8::StaticOrder, false>((PG8_LAS unsigned char*)smem, g, So, E, nullptr);
}

__device__ void phase_convpool(const Params& p, char* smem) {
  const int tid = threadIdx.x;
  for (int job = blockIdx.x; job < T * 128 / NTHREADS; job += gridDim.x) {
    const int it = job * NTHREADS + tid, t = it >> 7, c0 = (it & 127) * 8, s = t & (S - 1);
    float a[8];
#pragma unroll
    for (int i = 0; i < 8; ++i) a[i] = p.conv_b[c0 + i];
#pragma unroll
    for (int j = 0; j < 5; ++j) { const int ss = s + j - 2; if (ss >= 0 && ss < S) { u32x4 w = *(const u32x4*)(p.ZQK + (size_t)(t + j - 2) * 1024 + c0); const float* cw = p.conv_w + j * 1024 + c0;
        a[0] += cw[0] * bflo(w.x); a[1] += cw[1] * bfhi(w.x); a[2] += cw[2] * bflo(w.y); a[3] += cw[3] * bfhi(w.y); a[4] += cw[4] * bflo(w.z); a[5] += cw[5] * bfhi(w.z); a[6] += cw[6] * bflo(w.w); a[7] += cw[7] * bfhi(w.w); } }
    const float sc = c0 >= 512 ? KSCALE : 1.f;
#pragma unroll
    for (int i = 0; i < 8; ++i) a[i] = siluf(a[i]) * sc;
    u32x4 o; o.x = pack2(a[0], a[1]); o.y = pack2(a[2], a[3]); o.z = pack2(a[4], a[5]); o.w = pack2(a[6], a[7]); *(u32x4*)(p.QK + (size_t)t * 1024 + c0) = o;
  }
  float* ys = (float*)smem;
  float* ws = ys + 64 * 128;
  for (int job = blockIdx.x; job < (T / 64) * 4; job += gridDim.x) {
    const int g = job & 3, t0 = (job >> 2) * 64, win = 2 << g;
    __syncthreads();
    for (int i = tid; i < 128 * 128; i += NTHREADS) ws[i] = p.pool_w[(size_t)g * 16384 + i];
    for (int i = tid; i < 64 * 128; i += NTHREADS) { const int tl = i >> 7, c = i & 127, t = t0 + tl, s = t & (S - 1); const int lo = max(s - win / 2, 0), hi = min(s + win / 2, S);
      float sum = 0.f; for (int q = lo; q < hi; ++q) sum += bf2f(p.ZP[(size_t)(t - s + q) * 512 + g * 128 + c]);
      ys[i] = sum / (float)(hi - lo) - bf2f(p.ZP[(size_t)t * 512 + g * 128 + c]); }
    __syncthreads();
    const int e = tid & 127, tq = tid >> 7; float acc[16];
#pragma unroll
    for (int i = 0; i < 16; ++i) acc[i] = 0.f;
    for (int c = 0; c < 128; ++c) { const float w = ws[c * 128 + e];
#pragma unroll
      for (int i = 0; i < 16; ++i) acc[i] += ys[(tq * 16 + i) * 128 + c] * w; }
    const float psc = p.pool_sc[g * 128 + e];
#pragma unroll
    for (int i = 0; i < 16; ++i) p.CAT[(size_t)(t0 + tq * 16 + i) * 1024 + 512 + g * 128 + e] = f2bf(acc[i] * psc);
  }
}

__device__ void phase_mlstm_naive(const Params& p, char* smem) {
  float* qs = (float*)smem; float* ks = qs + 128; float* nump = ks + 128; float* red = nump + 512;
  const int tid = threadIdx.x, j = tid & 127, qd = tid >> 7;
  for (int job = blockIdx.x; job < 64; job += gridDim.x) {
    const int dir = job >> 5, b = (job >> 2) & 7, h = job & 3;
    float C[32];
#pragma unroll
    for (int d = 0; d < 32; ++d) C[d] = 0.f;
    float n = 0.f, m = 0.f;
    for (int step = 0; step < S; ++step) { const int s = dir ? S - 1 - step : step; const size_t t = (size_t)b * S + s;
      const float li = p.gates[t * 16 + dir * 4 + h], gf = p.gates[t * 16 + 8 + dir * 4 + h];
      const float lf = fminf(gf, 0.f) - log1pf(__expf(-fabsf(gf)));
      __syncthreads();
      if (qd == 0) { qs[j] = bf2f(p.QK[t * 1024 + h * 128 + j]); ks[j] = bf2f(p.QK[t * 1024 + 512 + h * 128 + j]); }
      const float v = bf2f(p.ZV[t * 512 + h * 128 + j]);
      __syncthreads();
      const float mn = fmaxf(lf + m, li), ip = __expf(li - mn), fp = __expf(lf + m - mn); m = mn;
      float num = 0.f;
#pragma unroll
      for (int d = 0; d < 32; ++d) { C[d] = fp * C[d] + ip * ks[qd * 32 + d] * v; num += qs[qd * 32 + d] * C[d]; }
      float dp = 0.f; if (qd == 0) { n = fp * n + ip * ks[j]; dp = qs[j] * n; }
      nump[qd * 128 + j] = num;
      dp = wave_sum(dp); if ((tid & 63) == 0) red[tid >> 6] = dp;
      __syncthreads();
      if (qd == 0) { const float den = red[0] + red[1]; num = nump[j] + nump[128 + j] + nump[256 + j] + nump[384 + j];
        p.HS[((size_t)dir * T + t) * 512 + h * 128 + j] = f2bf(num / fmaxf(fabsf(den), __expf(-mn))); }
    }
    __syncthreads();
  }
}

namespace ml {
typedef short bf16x8 __attribute__((ext_vector_type(8)));
typedef short s16x4 __attribute__((ext_vector_type(4)));
typedef float f32x16 __attribute__((ext_vector_type(16)));
constexpr int RS = 272;
constexpr int OFF_Q = 0, OFF_K = 128 * RS, OFF_VT = 2 * 128 * RS, OFF_VW = OFF_VT + 34 * RS, OFF_CT = OFF_VW + 34 * RS, OFF_A = OFF_CT + 34 * RS;
constexpr int OFF_PA = OFF_A + 16384, OFF_MCH = OFF_PA + 16384, OFF_TAB = OFF_MCH + 512, OFF_DEN = OFF_TAB + 4096, OFF_END = OFF_DEN + 512;
static_assert(OFF_A % 16 == 0 && OFF_END <= SMEM_BYTES, "mlstm LDS layout");
__device__ __forceinline__ int crow(int r, int h) { return (r & 3) + 8 * (r >> 2) + 4 * h; }
__device__ __forceinline__ int spos(int s) { return (s & ~12) | ((s & 4) << 1) | ((s & 8) >> 1); }
#define ML_MFMA(a, b, c) __builtin_amdgcn_mfma_f32_32x32x16_bf16((a), (b), (c), 0, 0, 0)
__device__ __forceinline__ bf16x8 pack8(float x0, float x1, float x2, float x3, float x4, float x5, float x6, float x7) {
  u32x4 w; w.x = pack2(x0, x1); w.y = pack2(x2, x3); w.z = pack2(x4, x5); w.w = pack2(x6, x7); return __builtin_bit_cast(bf16x8, w);
}
__device__ __forceinline__ void tr_read2(unsigned a0, unsigned a1, s16x4& lo, s16x4& hi) {
  asm volatile("ds_read_b64_tr_b16 %0, %2\n\tds_read_b64_tr_b16 %1, %3\n\ts_waitcnt lgkmcnt(0)" : "=&v"(lo), "=&v"(hi) : "v"(a0), "v"(a1) : "memory");
}

__device__ void phase_mlstm(const Params& p, char* smem) {
  int tid_ = threadIdx.x; asm volatile("" : "+v"(tid_));
  const int tid = tid_, wid = tid >> 6, lane = tid & 63, l31 = lane & 31, hh = lane >> 5;
  float* const LA = (float*)(smem + OFF_A); float* const LPA = (float*)(smem + OFF_PA); float* const LM = (float*)(smem + OFF_MCH);
  float* const LTAB = (float*)(smem + OFF_TAB); float* const LDEN = (float*)(smem + OFF_DEN);
  const unsigned lds0 = (unsigned)(uintptr_t)smem;
  for (int job = blockIdx.x; job < 256; job += gridDim.x) {
    const int dvq = job & 3, h = (job >> 2) & 3, b = (job >> 4) & 7, dir = job >> 7;
    const float* gts = p.gates + (size_t)b * S * 16;
    const bf16_t* QKb = p.QK + (size_t)b * S * 1024 + h * 128; const bf16_t* ZVb = p.ZV + (size_t)b * S * 512 + h * 128 + dvq * 32;
    bf16_t* HSb = p.HS + ((size_t)dir * T + (size_t)b * S) * 512 + h * 128 + dvq * 32;
    __syncthreads();
    for (int i = tid; i < 3 * 34 * RS / 4; i += NTHREADS) ((u32*)(smem + OFF_VT))[i] = 0u;
    for (int cc = 0; cc < 4; ++cc) { const int c = wid * 4 + cc, tau0 = c * 128 + 2 * lane; const int tok0 = dir ? S - 1 - tau0 : tau0, tok1 = dir ? tok0 - 1 : tok0 + 1;
      const float li0 = gts[(size_t)tok0 * 16 + dir * 4 + h], gf0 = gts[(size_t)tok0 * 16 + 8 + dir * 4 + h], li1 = gts[(size_t)tok1 * 16 + dir * 4 + h], gf1 = gts[(size_t)tok1 * 16 + 8 + dir * 4 + h];
      const float lf0 = fminf(gf0, 0.f) - log1pf(__expf(-fabsf(gf0))), lf1 = fminf(gf1, 0.f) - log1pf(__expf(-fabsf(gf1)));
      const float pr = lf0 + lf1; float incl = pr;
#pragma unroll
      for (int o = 1; o < 64; o <<= 1) { const float v = __shfl_up(incl, o); if (lane >= o) incl += v; }
      const float b0 = incl - pr + lf0, b1 = b0 + lf1, a0 = li0 - b0, a1 = li1 - b1;
      float im = fmaxf(a0, a1);
#pragma unroll
      for (int o = 1; o < 64; o <<= 1) { const float v = __shfl_up(im, o); if (lane >= o) im = fmaxf(im, v); }
      float ex = __shfl_up(im, 1); if (lane == 0) ex = -INFINITY;
      const float pa0 = fmaxf(ex, a0), pa1 = fmaxf(pa0, a1);
      LA[tau0] = a0; LA[tau0 + 1] = a1; LPA[tau0] = pa0; LPA[tau0 + 1] = pa1; if (lane == 63) LM[64 + c] = b1; }
    __syncthreads();
    if (tid == 0) { float m = 0.f; for (int c = 0; c < 32; ++c) { LM[c] = m; m = LM[64 + c] + fmaxf(m, LPA[c * 128 + 127]); } LM[32] = m; }
    __syncthreads();
    u32x4 qreg[4], kreg[4], vreg;
#define ML_TOK(tau) (dir ? S - 1 - (tau) : (tau))
#define ML_LOAD(c) do { _Pragma("unroll") for (int i_ = 0; i_ < 4; ++i_) { const int tk_ = ML_TOK((c) * 128 + (tid >> 4) + 32 * i_); \
        qreg[i_] = *(const u32x4*)(QKb + (size_t)tk_ * 1024 + (tid & 15) * 8); kreg[i_] = *(const u32x4*)(QKb + (size_t)tk_ * 1024 + 512 + (tid & 15) * 8); } \
      { const int tk_ = ML_TOK((c) * 128 + (tid >> 2)); vreg = *(const u32x4*)(ZVb + (size_t)tk_ * 512 + (tid & 3) * 8); } } while (0)
#define ML_TABLES(c) do { if (tid < 128) { const int tau_ = (c) * 128 + tid, tk_ = ML_TOK(tau_); const float li_ = gts[(size_t)tk_ * 16 + dir * 4 + h], a_ = LA[tau_], mc_ = LM[(c)]; \
        const float Mj_ = fmaxf(mc_, LPA[tau_]), Me_ = fmaxf(mc_, LPA[(c) * 128 + 127]); float* tb_ = LTAB + ((c) & 1) * 512; \
        tb_[tid] = Mj_; tb_[128 + tid] = __expf(mc_ - Mj_); tb_[256 + tid] = __expf(-((li_ - a_) + Mj_)); tb_[384 + tid] = __expf(a_ - Me_); } } while (0)
#define ML_STORE(c) do { _Pragma("unroll") for (int i_ = 0; i_ < 4; ++i_) { const int row_ = (tid >> 4) + 32 * i_; \
        *(u32x4*)(smem + OFF_Q + row_ * RS + (tid & 15) * 16) = qreg[i_]; *(u32x4*)(smem + OFF_K + row_ * RS + (tid & 15) * 16) = kreg[i_]; } \
      { const int s_ = tid >> 2, ps_ = spos(s_) * 2; const float we_ = LTAB[((c) & 1) * 512 + 384 + s_]; const u32 vw_[4] = {vreg.x, vreg.y, vreg.z, vreg.w}; \
        _Pragma("unroll") for (int i_ = 0; i_ < 4; ++i_) { const int r0_ = ((tid & 3) * 8 + 2 * i_) * RS + ps_; \
          *(bf16_t*)(smem + OFF_VT + r0_) = (bf16_t)(vw_[i_] & 0xFFFFu); *(bf16_t*)(smem + OFF_VT + r0_ + RS) = (bf16_t)(vw_[i_] >> 16); \
          *(bf16_t*)(smem + OFF_VW + r0_) = f2bf(bflo(vw_[i_]) * we_); *(bf16_t*)(smem + OFF_VW + r0_ + RS) = f2bf(bfhi(vw_[i_]) * we_); } } \
      if (tid < 128) { const int ps_ = spos(tid) * 2; *(bf16_t*)(smem + OFF_VT + 32 * RS + ps_) = (bf16_t)0x3F80u; *(bf16_t*)(smem + OFF_VW + 32 * RS + ps_) = f2bf(LTAB[((c) & 1) * 512 + 384 + tid]); } } while (0)
    ML_LOAD(0); ML_TABLES(0);
    __syncthreads();
    ML_STORE(0);
    __syncthreads();
    f32x16 Cacc;
#pragma unroll
    for (int r = 0; r < 16; ++r) Cacc[r] = 0.f;
    for (int c = 0; c < 32; ++c) {
      int tidc_ = threadIdx.x; asm volatile("" : "+v"(tidc_));
      const int tid = tidc_, wid = tid >> 6, lane = tid & 63, l31 = lane & 31, hh = lane >> 5;
      const int t2 = wid >> 1, nt = wid & 1, brow = min(nt * 32 + l31, 33);
      if (c + 1 < 32) { ML_LOAD(c + 1); ML_TABLES(c + 1); }
      const float* tab = LTAB + (c & 1) * 512;
      f32x16 acc;
#pragma unroll
      for (int r = 0; r < 16; ++r) acc[r] = 0.f;
      const char* qa = smem + OFF_Q + (t2 * 32 + l31) * RS + hh * 16;
      { const char* cb = smem + OFF_CT + brow * RS + hh * 16;
#pragma unroll
        for (int ks = 0; ks < 8; ++ks) acc = ML_MFMA(*(const bf16x8*)(qa + ks * 32), *(const bf16x8*)(cb + ks * 32), acc); }
#pragma unroll
      for (int r = 0; r < 16; ++r) acc[r] *= tab[128 + t2 * 32 + crow(r, hh)];
      const float Mj = tab[t2 * 32 + l31];
      for (int si = 0; si <= t2; ++si) {
        f32x16 X;
#pragma unroll
        for (int r = 0; r < 16; ++r) X[r] = 0.f;
        const char* ka = smem + OFF_K + (si * 32 + l31) * RS + hh * 16;
#pragma unroll
        for (int ks = 0; ks < 8; ++ks) X = ML_MFMA(*(const bf16x8*)(ka + ks * 32), *(const bf16x8*)(qa + ks * 32), X);
        const float* Ac = LA + c * 128 + si * 32;
#pragma unroll
        for (int r = 0; r < 16; ++r) { const int sl = crow(r, hh); float w = __expf(Ac[sl] - Mj); if (si == t2 && sl > l31) w = 0.f; X[r] *= w; }
        const bf16x8 f0 = pack8(X[0], X[1], X[2], X[3], X[4], X[5], X[6], X[7]), f1 = pack8(X[8], X[9], X[10], X[11], X[12], X[13], X[14], X[15]);
        const char* vb = smem + OFF_VT + brow * RS + si * 64 + hh * 16;
        acc = ML_MFMA(f0, *(const bf16x8*)(vb), acc); acc = ML_MFMA(f1, *(const bf16x8*)(vb + 32), acc);
      }
      if (nt == 1 && l31 == 0) {
#pragma unroll
        for (int r = 0; r < 16; ++r) LDEN[t2 * 32 + crow(r, hh)] = acc[r]; }
      { const float mc = LM[c], decay = __expf(mc - fmaxf(mc, LPA[c * 128 + 127]));
#pragma unroll
        for (int r = 0; r < 16; ++r) Cacc[r] *= decay;
        const unsigned ta = lds0 + OFF_K + ((lane & 15) >> 2) * RS + (t2 * 32 + 16 * ((lane >> 4) & 1) + 4 * (lane & 3)) * 2 + 4 * hh * RS;
        const char* wb = smem + OFF_VW + brow * RS + hh * 16;
#pragma unroll
        for (int ks = 0; ks < 8; ++ks) { s16x4 lo, hi; tr_read2(ta + 16 * ks * RS, ta + (16 * ks + 8) * RS, lo, hi); __builtin_amdgcn_sched_barrier(0);
          const bf16x8 a = (bf16x8){lo[0], lo[1], lo[2], lo[3], hi[0], hi[1], hi[2], hi[3]};
          Cacc = ML_MFMA(a, *(const bf16x8*)(wb + ks * 32), Cacc); } }
      __syncthreads();
      if (nt == 0) {
#pragma unroll
        for (int r = 0; r < 16; ++r) { const int j = t2 * 32 + crow(r, hh); const float dn = LDEN[j], nr = tab[256 + j]; const int tk = ML_TOK(c * 128 + j);
          HSb[(size_t)tk * 512 + l31] = f2bf(acc[r] / fmaxf(fabsf(dn), nr)); } }
      if (nt * 32 + l31 <= 32) { char* cw = smem + OFF_CT + (nt * 32 + l31) * RS + (t2 * 32 + 4 * hh) * 2;
#pragma unroll
        for (int g = 0; g < 4; ++g) { u32x2 w; w.x = pack2(Cacc[4 * g], Cacc[4 * g + 1]); w.y = pack2(Cacc[4 * g + 2], Cacc[4 * g + 3]); *(u32x2*)(cw + 16 * g) = w; } }
      if (c + 1 < 32) ML_STORE(c + 1);
      __syncthreads();
    }
#undef ML_TOK
#undef ML_LOAD
#undef ML_TABLES
#undef ML_STORE
  }
}
}

__device__ void phase_cat(const Params& p) {
  const int tid = threadIdx.x, wid = tid >> 6, lane = tid & 63;
  for (int job = blockIdx.x; job < T * 4 / 8; job += gridDim.x) {
    const int w = job * 8 + wid, t = w >> 2, h = w & 3; const size_t o = (size_t)t * 512 + h * 128 + lane * 2;
    const u32 a = *(const u32*)(p.HS + o), b = *(const u32*)(p.HS + (size_t)T * 512 + o), so = *(const u32*)(p.ZO + o);
    const float a0 = bflo(a) + bflo(b), a1 = bfhi(a) + bfhi(b); const float r = rsqrtf(wave_sum(a0 * a0 + a1 * a1) * (1.f / 128.f) + EPS);
    *(u32*)(p.CAT + (size_t)t * 1024 + h * 128 + lane * 2) = pack2(a0 * r * p.mnorm_g[h * 128 + lane * 2] * bflo(so), a1 * r * p.mnorm_g[h * 128 + lane * 2 + 1] * bfhi(so));
  }
}

__device__ void phase_peer_select_naive(const Params& p, int layer, char* smem) {
  float* kl = (float*)smem;
  float* qsh = kl + 2 * 128 * 129;
  const int tid = threadIdx.x, wid = tid >> 6, lane = tid & 63; float* qs = qsh + wid * 128;
  __syncthreads();
  for (int i = tid; i < 2 * 128 * 128; i += NTHREADS) kl[(i >> 7) * 129 + (i & 127)] = p.peer_keys[(size_t)layer * 32768 + i];
  __syncthreads();
  for (int job = blockIdx.x; job < T; job += gridDim.x) {
    const int t = job, h = wid;
    float ts[2][16]; int ti[2][16];
#pragma unroll
    for (int pp = 0; pp < 2; ++pp) {
      const bf16_t* q = p.QP + (size_t)t * 2048 + h * 256 + pp * 128; const float q0 = bf2f(q[lane]), q1 = bf2f(q[lane + 64]);
      const float r = rsqrtf(wave_sum(q0 * q0 + q1 * q1) * (1.f / 128.f) + EPS); qs[lane] = q0 * r; qs[lane + 64] = q1 * r;
      float s0 = 0.f, s1 = 0.f; const float* k0 = kl + (pp * 128 + lane) * 129; const float* k1 = k0 + 64 * 129;
      for (int c = 0; c < 128; ++c) { const float qc = qs[c]; s0 += qc * k0[c]; s1 += qc * k1[c]; }
#pragma unroll
      for (int k = 0; k < 16; ++k) { const float mx = wave_max(fmaxf(s0, s1)); int cand = (s0 == mx) ? lane : ((s1 == mx) ? lane + 64 : 9999);
        for (int o = 32; o >= 1; o >>= 1) cand = min(cand, __shfl_xor(cand, o));
        ts[pp][k] = mx; ti[pp][k] = cand; if (cand == lane) s0 = -INFINITY; if (cand == lane + 64) s1 = -INFINITY; }
    }
    float cs[4];
#pragma unroll
    for (int r = 0; r < 4; ++r) { const int c = lane * 4 + r; float va = 0.f, vb = 0.f;
#pragma unroll
      for (int k = 0; k < 16; ++k) { if (k == (c >> 4)) va = ts[0][k]; if (k == (c & 15)) vb = ts[1][k]; }
      cs[r] = va + vb; }
    float top[16]; int tix[16];
#pragma unroll
    for (int k = 0; k < 16; ++k) { const float mx = wave_max(fmaxf(fmaxf(cs[0], cs[1]), fmaxf(cs[2], cs[3]))); int cand = 9999;
#pragma unroll
      for (int r = 3; r >= 0; --r) if (cs[r] == mx) cand = lane * 4 + r;
      for (int o = 32; o >= 1; o >>= 1) cand = min(cand, __shfl_xor(cand, o));
      top[k] = mx; tix[k] = cand;
#pragma unroll
      for (int r = 0; r < 4; ++r) if (cand == lane * 4 + r) cs[r] = -INFINITY; }
    float sum = 0.f;
#pragma unroll
    for (int k = 0; k < 16; ++k) sum += __expf(top[k] - top[0]);
    if (lane < 16) { float tv = 0.f; int tc = 0;
#pragma unroll
      for (int k = 0; k < 16; ++k) if (k == lane) { tv = top[k]; tc = tix[k]; }
      int ia = 0, ib = 0;
#pragma unroll
      for (int k = 0; k < 16; ++k) { if (k == (tc >> 4)) ia = ti[0][k]; if (k == (tc & 15)) ib = ti[1][k]; }
      p.pidx[((size_t)t * 8 + h) * 16 + lane] = (bf16_t)(ia * 128 + ib); p.pgate[((size_t)t * 8 + h) * 16 + lane] = __expf(tv - top[0]) / sum; }
  }
}

namespace sel {
typedef short bf16x8 __attribute__((ext_vector_type(8)));
typedef float f32x16 __attribute__((ext_vector_type(16)));
constexpr int RS = 272, OFF_W = 2 * 128 * RS, WB = 3 * 16 * 32 * 4;
static_assert(OFF_W + 8 * WB <= SMEM_BYTES, "select LDS layout");
constexpr float NEG = -3.0e38f;
__device__ __forceinline__ float max3(float a, float b, float c) { return fmaxf(fmaxf(a, b), c); }
__device__ __forceinline__ float xhalf(float v) { return __shfl_xor(v, 32); }

__device__ void phase_peer_select(const Params& p, int layer, char* smem) {
  const int tid0 = threadIdx.x;
  __syncthreads();
  { const bf16_t* kb = p.keysb + (size_t)layer * 32768;
    for (int i = tid0; i < 2 * 128 * 16; i += NTHREADS) { const int row = i >> 4, ch = i & 15; *(u32x4*)(smem + row * RS + ch * 16) = *(const u32x4*)(kb + (size_t)row * 128 + ch * 8); } }
  __syncthreads();
  for (int job = blockIdx.x; job < T / 32; job += gridDim.x) {
    int tid_ = threadIdx.x; asm volatile("" : "+v"(tid_));
    const int tid = tid_, wid = tid >> 6, lane = tid & 63, l31 = lane & 31, hh = lane >> 5, h = wid;
    const int t = job * 32 + l31;
    float* const wl = (float*)(smem + OFF_W + wid * WB);
    float rs[2];
#pragma unroll
    for (int pp = 0; pp < 2; ++pp) {
      const bf16_t* qrow = p.QP + (size_t)t * 2048 + h * 256 + pp * 128 + hh * 8;
      bf16x8 bq[8]; float ssq = 0.f;
#pragma unroll
      for (int ks = 0; ks < 8; ++ks) { const u32x4 w = *(const u32x4*)(qrow + ks * 16); bq[ks] = __builtin_bit_cast(bf16x8, w);
        const u32 w0 = w.x, w1 = w.y, w2 = w.z, w3 = w.w; ssq = dot2bf(w0, w0, ssq); ssq = dot2bf(w1, w1, ssq); ssq = dot2bf(w2, w2, ssq); ssq = dot2bf(w3, w3, ssq); }
      ssq += xhalf(ssq); rs[pp] = rsqrtf(ssq * (1.f / 128.f) + EPS);
      f32x16 X[4];
#pragma unroll
      for (int nt = 0; nt < 4; ++nt) {
#pragma unroll
        for (int r = 0; r < 16; ++r) X[nt][r] = 0.f;
        const char* ka = smem + (pp * 128 + nt * 32 + l31) * RS + hh * 16;
#pragma unroll
        for (int ks = 0; ks < 8; ++ks) X[nt] = __builtin_amdgcn_mfma_f32_32x32x16_bf16(*(const bf16x8*)(ka + ks * 32), bq[ks], X[nt], 0, 0, 0); }
#pragma unroll
      for (int nt = 0; nt < 4; ++nt)
#pragma unroll
        for (int r = 0; r < 16; ++r) X[nt][r] = __uint_as_float((__float_as_uint(X[nt][r]) & ~0x7Fu) | (u32)(nt * 32 + (r & 3) + 8 * (r >> 2)) | ((u32)hh << 2));
#pragma unroll 1
      for (int k = 0; k < 16; ++k) {
        float m = NEG;
#pragma unroll
        for (int nt = 0; nt < 4; ++nt)
#pragma unroll
          for (int r = 0; r < 16; r += 2) m = max3(m, X[nt][r], X[nt][r + 1]);
        const float M = fmaxf(m, xhalf(m));
        wl[(pp * 16 + k) * 32 + l31] = M;
#pragma unroll
        for (int nt = 0; nt < 4; ++nt)
#pragma unroll
          for (int r = 0; r < 16; ++r) X[nt][r] = (X[nt][r] == M) ? NEG : X[nt][r];
      }
    }
    float s1[16], s2[16];
#pragma unroll
    for (int k = 0; k < 16; ++k) { s1[k] = wl[k * 32 + l31] * rs[0]; s2[k] = wl[(16 + k) * 32 + l31] * rs[1]; }
    constexpr int A0[25] = {0, 0, 0, 0, 0, 0, 0, 0, 0, 0, 0, 0, 0, 0, 0, 0, 2, 2, 2, 2, 2, 3, 3, 3, 3}, B0[25] = {0, 1, 2, 3, 4, 5, 6, 7, 8, 9, 10, 11, 12, 13, 14, 15, 0, 1, 2, 3, 4, 0, 1, 2, 3};
    constexpr int A1[25] = {1, 1, 1, 1, 1, 1, 1, 1, 4, 4, 4, 5, 5, 6, 6, 7, 7, 8, 9, 10, 11, 12, 13, 14, 15}, B1[25] = {0, 1, 2, 3, 4, 5, 6, 7, 0, 1, 2, 0, 1, 0, 1, 0, 1, 0, 0, 0, 0, 0, 0, 0, 0};
    float cd[25];
#pragma unroll
    for (int i = 0; i < 25; ++i) { const float v0 = s1[A0[i]] + s2[B0[i]], v1 = s1[A1[i]] + s2[B1[i]]; const float v = hh ? v1 : v0; const u32 cid = hh ? (u32)(A1[i] * 16 + B1[i]) : (u32)(A0[i] * 16 + B0[i]);
      cd[i] = __uint_as_float((__float_as_uint(v) & ~0xFFu) | cid); }
#pragma unroll 1
    for (int k = 0; k < 16; ++k) {
      float m = cd[24];
#pragma unroll
      for (int i = 0; i < 24; i += 2) m = max3(m, cd[i], cd[i + 1]);
      const float M = fmaxf(m, xhalf(m));
      wl[(32 + k) * 32 + l31] = M;
#pragma unroll
      for (int i = 0; i < 25; ++i) cd[i] = (cd[i] == M) ? NEG : cd[i];
    }
    float tv[16];
#pragma unroll
    for (int k = 0; k < 16; ++k) tv[k] = wl[(32 + k) * 32 + l31];
    float sum = 0.f;
#pragma unroll
    for (int k = 0; k < 16; ++k) sum += __expf(tv[k] - tv[0]);
    const float inv = 1.f / sum;
    u32 ev[8]; float go[8];
#pragma unroll
    for (int q = 0; q < 8; ++q) { const float v = wl[(32 + hh * 8 + q) * 32 + l31]; const u32 cid = __float_as_uint(v) & 0xFFu;
      const u32 i1 = __float_as_uint(wl[(cid >> 4) * 32 + l31]) & 0x7Fu, i2 = __float_as_uint(wl[(16 + (cid & 15)) * 32 + l31]) & 0x7Fu; ev[q] = i1 * 128 + i2;
      go[q] = __expf(v - tv[0]) * inv; }
    const u32 io0 = ev[0] | (ev[1] << 16), io1 = ev[2] | (ev[3] << 16), io2 = ev[4] | (ev[5] << 16), io3 = ev[6] | (ev[7] << 16);
    const size_t ob = ((size_t)t * 8 + h) * 16 + hh * 8;
    *(u32x4*)(p.pidx + ob) = (u32x4){io0, io1, io2, io3};
    *(f32x4*)(p.pgate + ob) = (f32x4){go[0], go[1], go[2], go[3]}; *(f32x4*)(p.pgate + ob + 4) = (f32x4){go[4], go[5], go[6], go[7]};
  }
}
}

typedef float f32x2 __attribute__((ext_vector_type(2)));
constexpr float U8_SCALE = 32.f, V8_SCALE = 2.f;
__device__ __forceinline__ float gelu_erf(float z) { return 0.5f * z * (1.f + erff(z * 0.70710678118654752f)); }
__device__ __forceinline__ float reduce8(float d0, float d1, float d2, float d3, float d4, float d5, float d6, float d7, int lane) {
  float e[4];
  { auto r0 = __builtin_amdgcn_permlane32_swap(__float_as_uint(d0), __float_as_uint(d4), false, false); e[0] = __uint_as_float(r0[0]) + __uint_as_float(r0[1]);
    auto r1 = __builtin_amdgcn_permlane32_swap(__float_as_uint(d1), __float_as_uint(d5), false, false); e[1] = __uint_as_float(r1[0]) + __uint_as_float(r1[1]);
    auto r2 = __builtin_amdgcn_permlane32_swap(__float_as_uint(d2), __float_as_uint(d6), false, false); e[2] = __uint_as_float(r2[0]) + __uint_as_float(r2[1]);
    auto r3 = __builtin_amdgcn_permlane32_swap(__float_as_uint(d3), __float_as_uint(d7), false, false); e[3] = __uint_as_float(r3[0]) + __uint_as_float(r3[1]); }
  float f0, f1;
  { auto r0 = __builtin_amdgcn_permlane16_swap(__float_as_uint(e[0]), __float_as_uint(e[2]), false, false); f0 = __uint_as_float(r0[0]) + __uint_as_float(r0[1]);
    auto r1 = __builtin_amdgcn_permlane16_swap(__float_as_uint(e[1]), __float_as_uint(e[3]), false, false); f1 = __uint_as_float(r1[0]) + __uint_as_float(r1[1]); }
  const bool up = (lane & 8) != 0; const float keep = up ? f1 : f0, send = up ? f0 : f1;
  float g = keep + __shfl_xor(send, 8);
  g += __shfl_xor(g, 4); g += __shfl_xor(g, 2); g += __shfl_xor(g, 1);
  return g;
}
template <int NEXT, bool DRY = false>
__device__ void phase_peer_gather(const Params& p, int layer) {
  const unsigned char* U8 = p.U8 + (size_t)layer * 16384 * 1024; const unsigned char* V8 = p.V8 + (size_t)layer * 16384 * 1024;
  for (int job = blockIdx.x; job < T / 8; job += gridDim.x) {
    int tid_ = threadIdx.x; asm volatile("" : "+v"(tid_));
    const int tid = tid_, wid = tid >> 6, lane = tid & 63;
    const int t = job * 8 + wid, b = t / S;
    const int vidx = 4 * (lane >> 5) + 2 * ((lane >> 4) & 1) + ((lane >> 3) & 1);
    const u32x4 h0 = *(const u32x4*)(p.H + (size_t)t * D + lane * 16), h1 = *(const u32x4*)(p.H + (size_t)t * D + lane * 16 + 8);
    const u32 hx[8] = {h0.x, h0.y, h0.z, h0.w, h1.x, h1.y, h1.z, h1.w};
    f32x2 acc[8];
#pragma unroll
    for (int i = 0; i < 8; ++i) acc[i] = (f32x2){0.f, 0.f};
#pragma unroll 1
    for (int hb = 0; hb < 16; ++hb) {
      const int myidx = (int)p.pidx[(size_t)t * 128 + hb * 8 + (lane & 7)];
      const float mygate = p.pgate[(size_t)t * 128 + hb * 8 + vidx];
      u32x4 ur[8], vr[8];
#pragma unroll
      for (int k = 0; k < 8; ++k) { const int e = __builtin_amdgcn_readlane(myidx, k); ur[k] = *(const u32x4*)(U8 + (size_t)e * 1024 + lane * 16); vr[k] = *(const u32x4*)(V8 + (size_t)e * 1024 + lane * 16); }
      float d[8];
#pragma unroll
      for (int k = 0; k < 8; ++k) { const u32 w[4] = {ur[k].x, ur[k].y, ur[k].z, ur[k].w}; float a = 0.f;
#pragma unroll
        for (int j = 0; j < 4; ++j) { const u32 lo = __builtin_bit_cast(u32, __builtin_amdgcn_cvt_scalef32_pk_bf16_fp8(w[j], 1.0f, false)), hi = __builtin_bit_cast(u32, __builtin_amdgcn_cvt_scalef32_pk_bf16_fp8(w[j], 1.0f, true));
          a = dot2bf(lo, hx[2 * j], a); a = dot2bf(hi, hx[2 * j + 1], a); }
        d[k] = a; }
      const float z = reduce8(d[0], d[1], d[2], d[3], d[4], d[5], d[6], d[7], lane) * (1.f / U8_SCALE);
      const float cf = mygate * gelu_erf(z) * (1.f / V8_SCALE);
#pragma unroll
      for (int k = 0; k < 8; ++k) { const float ck = __uint_as_float(__builtin_amdgcn_readlane(__float_as_uint(cf), 32 * (k >> 2) + 16 * ((k >> 1) & 1) + 8 * (k & 1)));
        const u32 w[4] = {vr[k].x, vr[k].y, vr[k].z, vr[k].w}; const f32x2 c2 = (f32x2){ck, ck};
#pragma unroll
        for (int j = 0; j < 4; ++j) { const f32x2 lo = __builtin_amdgcn_cvt_pk_f32_fp8((int)w[j], false), hi = __builtin_amdgcn_cvt_pk_f32_fp8((int)w[j], true);
          acc[2 * j] = lo * c2 + acc[2 * j]; acc[2 * j + 1] = hi * c2 + acc[2 * j + 1]; } }
    }
    const float* g2 = p.mod + (size_t)(layer * 8 + b) * 6144 + 5120 + lane * 16; float* xp = p.X + (size_t)t * D + lane * 16;
    float xv[16]; float ss = 0.f;
#pragma unroll
    for (int q = 0; q < 4; ++q) { const f32x4 x0 = *(const f32x4*)(xp + 4 * q), g0 = *(const f32x4*)(g2 + 4 * q);
      xv[4 * q + 0] = x0.x + g0.x * acc[2 * q].x; xv[4 * q + 1] = x0.y + g0.y * acc[2 * q].y; xv[4 * q + 2] = x0.z + g0.z * acc[2 * q + 1].x; xv[4 * q + 3] = x0.w + g0.w * acc[2 * q + 1].y; }
#pragma unroll
    for (int i = 0; i < 16; ++i) ss += xv[i] * xv[i];
    ss = wave_sum(ss); const float r = rsqrtf(ss * (1.f / D) + EPS);
    if (DRY && ss != -1.2345f) continue;
    if (NEXT == 0) {
      const float* ml = p.mod + (size_t)((layer + 1) * 8 + b) * 6144 + lane * 16; const float* gn = p.nmg + (layer + 1) * D + lane * 16; float y[16];
#pragma unroll
      for (int i = 0; i < 16; ++i) y[i] = xv[i] * r * gn[i] * (1.f + ml[1024 + i]) + ml[i];
#pragma unroll
      for (int q = 0; q < 4; ++q) *(f32x4*)(xp + 4 * q) = (f32x4){xv[4 * q], xv[4 * q + 1], xv[4 * q + 2], xv[4 * q + 3]};
      u32x4 w0, w1; w0.x = pack2(y[0], y[1]); w0.y = pack2(y[2], y[3]); w0.z = pack2(y[4], y[5]); w0.w = pack2(y[6], y[7]); w1.x = pack2(y[8], y[9]); w1.y = pack2(y[10], y[11]); w1.z = pack2(y[12], y[13]); w1.w = pack2(y[14], y[15]);
      *(u32x4*)(p.H + (size_t)t * D + lane * 16) = w0; *(u32x4*)(p.H + (size_t)t * D + lane * 16 + 8) = w1;
    } else {
      const float* fg = p.final_g + lane * 16;
#pragma unroll
      for (int q = 0; q < 4; ++q) *(f32x4*)(xp + 4 * q) = (f32x4){xv[4 * q] * r * fg[4 * q], xv[4 * q + 1] * r * fg[4 * q + 1], xv[4 * q + 2] * r * fg[4 * q + 2], xv[4 * q + 3] * r * fg[4 * q + 3]};
    }
  }
}

__device__ void phase_qkrope(const Params& p) {
  const int tid = threadIdx.x, wid = tid >> 6, lane = tid & 63;
  for (int job = blockIdx.x; job < T * 12 / 8; job += gridDim.x) {
    const int w = job * 8 + wid, t = w / 12, hh = w % 12, b = t / S, s = t & (S - 1);
    const u32 raw = *(const u32*)(p.QKV + (size_t)t * 1536 + hh * 128 + lane * 2); float x0 = bflo(raw), x1 = bfhi(raw);
    if (hh < 10) { const float* g = hh < 8 ? p.qn_g : p.kn_g; const float r = rsqrtf(wave_sum(x0 * x0 + x1 * x1) * (1.f / 128.f) + EPS); x0 *= r * g[2 * lane]; x1 *= r * g[2 * lane + 1];
      const int pos = lane < 32 ? (s >> 6) : (s & 63); const int fi = lane & 31; const float fr = exp2f(-(float)(2 * fi) * (13.287712379549449f / 64.f)); const float ang = (float)pos * fr;
      float sn, cs; sincosf(ang, &sn, &cs); const float y0 = x0 * cs - x1 * sn, y1 = x0 * sn + x1 * cs; x0 = y0; x1 = y1; }
    bf16_t* dst = hh < 8 ? p.Qh + (((size_t)b * 8 + hh) * S + s) * 128 : (hh < 10 ? p.Kh + (((size_t)b * 2 + hh - 8) * S + s) * 128 : p.Vh + (((size_t)b * 2 + hh - 10) * S + s) * 128);
    *(u32*)(dst + lane * 2) = pack2(x0, x1);
  }
}

__device__ void phase_attn_naive(const Params& p) {
  const int tid = threadIdx.x, wid = tid >> 6, lane = tid & 63;
  for (int job = blockIdx.x; job < T * 2 / 8; job += gridDim.x) {
    const int w = job * 8 + wid, kv = w & 1, t = w >> 1, b = t / S, s = t & (S - 1);
    float q0[4], q1[4], m[4], l[4], o0[4], o1[4];
#pragma unroll
    for (int g = 0; g < 4; ++g) { const u32 qq = *(const u32*)(p.Qh + (((size_t)b * 8 + kv * 4 + g) * S + s) * 128 + lane * 2); q0[g] = bflo(qq); q1[g] = bfhi(qq); m[g] = -1e30f; l[g] = 0.f; o0[g] = 0.f; o1[g] = 0.f; }
    const bf16_t* Kb = p.Kh + ((size_t)b * 2 + kv) * S * 128; const bf16_t* Vb = p.Vh + ((size_t)b * 2 + kv) * S * 128;
    for (int k = 0; k < S; ++k) { const u32 kk = *(const u32*)(Kb + (size_t)k * 128 + lane * 2), vv = *(const u32*)(Vb + (size_t)k * 128 + lane * 2);
      const float k0 = bflo(kk), k1 = bfhi(kk), v0 = bflo(vv), v1 = bfhi(vv);
#pragma unroll
      for (int g = 0; g < 4; ++g) { const float sc = wave_sum(q0[g] * k0 + q1[g] * k1) * KSCALE; const float mn = fmaxf(m[g], sc), al = __expf(m[g] - mn), pw = __expf(sc - mn);
        l[g] = l[g] * al + pw; o0[g] = o0[g] * al + pw * v0; o1[g] = o1[g] * al + pw * v1; m[g] = mn; } }
#pragma unroll
    for (int g = 0; g < 4; ++g) *(u32*)(p.CAT + (size_t)t * 1024 + (kv * 4 + g) * 128 + lane * 2) = pack2(o0[g] / l[g], o1[g] / l[g]);
  }
}

namespace att {
using bf16 = unsigned short;
constexpr int   D = 128, NW = 8, QBLK = 32, KVBLK = 64;
constexpr float SCALE = 0.088388347648318440f;
constexpr float THR = 8.f;
constexpr int SDEPTH = 2;
constexpr int LDQ = 128, LDK = 128, LDO = 1024;
constexpr size_t SHM_V = KVBLK * D * 2, SHM_K = KVBLK * D * 2, SHM_ATTN = 2 * SHM_V + 2 * SHM_K + NW * 64 * 4;
using bf16x8 = __attribute__((ext_vector_type(8))) short;
using s16x4  = __attribute__((ext_vector_type(4))) short;
using f32x16 = __attribute__((ext_vector_type(16))) float;
using f32x8  = __attribute__((ext_vector_type(8))) float;
using u32x4  = __attribute__((ext_vector_type(4))) unsigned;
#define KSWZ(row, colB) ((row) * 256 + ((colB) ^ (((row) & 7) << 4)))
#define SBAR() __builtin_amdgcn_sched_barrier(0)
__device__ __forceinline__ int crow(int r, int hi) { return (r & 3) + 8 * (r >> 2) + 4 * hi; }
__device__ __forceinline__ unsigned cvtpk(float lo, float hi) {
  unsigned r; asm volatile("v_cvt_pk_bf16_f32 %0, %1, %2" : "=v"(r) : "v"(lo), "v"(hi)); return r;
}
template <typename TIn> struct Stage;
template <> struct Stage<bf16>  { using T = bf16x8;
  __device__ static __forceinline__ T ld8(const bf16* p) { return *reinterpret_cast<const bf16x8*>(p); }
  __device__ static __forceinline__ bf16x8 tobf(T x) { return x; } };
template <> struct Stage<float> { using T = f32x8;
  __device__ static __forceinline__ T ld8(const float* p) { return *reinterpret_cast<const f32x8*>(p); }
  __device__ static __forceinline__ bf16x8 tobf(T x) {
    u32x4 w = {cvtpk(x[0], x[1]), cvtpk(x[2], x[3]), cvtpk(x[4], x[5]), cvtpk(x[6], x[7])}; return *reinterpret_cast<bf16x8*>(&w); } };

__device__ __forceinline__ void partialSM(f32x16& p0, f32x16& p1, float& m_reg, float& mn, float& alpha) {
  constexpr float C = SCALE * 1.4426950408889634f;
  float pmax = p0[0]; for (int r = 1; r < 16; ++r) pmax = fmaxf(pmax, p0[r]); for (int r = 0; r < 16; ++r) pmax = fmaxf(pmax, p1[r]);
  { auto rr = __builtin_amdgcn_permlane32_swap(__float_as_uint(pmax), __float_as_uint(pmax), false, false);
    pmax = fmaxf(__uint_as_float(rr[0]), __uint_as_float(rr[1])); }
  if (__builtin_expect(__all(pmax - m_reg <= THR / SCALE), 1)) { mn = m_reg; alpha = 1.f; }
  else { mn = fmaxf(m_reg, pmax); alpha = __builtin_amdgcn_exp2f((m_reg - mn) * C); m_reg = mn; }
  float mnC = -mn * C;
  for (int r = 0; r < 16; ++r) p0[r] = fmaf(p0[r], C, mnC); for (int r = 0; r < 16; ++r) p1[r] = fmaf(p1[r], C, mnC);
  for (int r = 0; r < 16; ++r) p0[r] = __builtin_amdgcn_exp2f(p0[r]);
}
__device__ __forceinline__ void finishSM(f32x16& p0, f32x16& p1, float alpha, float& l_reg, bf16x8& pa0, bf16x8& pa1, bf16x8& pa2, bf16x8& pa3) {
  for (int r = 0; r < 16; ++r) p1[r] = __builtin_amdgcn_exp2f(p1[r]);
  float ps = 0; for (int r = 0; r < 16; ++r) ps += p0[r]; for (int r = 0; r < 16; ++r) ps += p1[r];
  { auto rr = __builtin_amdgcn_permlane32_swap(__float_as_uint(ps), __float_as_uint(ps), false, false);
    ps = __uint_as_float(rr[0]) + __uint_as_float(rr[1]); }
  l_reg = l_reg * alpha + ps;
#define PK4(P, BASE, OUT) do { unsigned a0 = cvtpk(P[BASE + 0], P[BASE + 1]), a1 = cvtpk(P[BASE + 2], P[BASE + 3]);   \
    unsigned b0 = cvtpk(P[BASE + 4], P[BASE + 5]), b1 = cvtpk(P[BASE + 6], P[BASE + 7]);                              \
    auto r0 = __builtin_amdgcn_permlane32_swap(a0, b0, false, false); auto r1 = __builtin_amdgcn_permlane32_swap(a1, b1, false, false); \
    u32x4 w = {r0[0], r1[0], r0[1], r1[1]}; OUT = *reinterpret_cast<bf16x8*>(&w); } while (0)
  PK4(p0, 0, pa0); PK4(p0, 8, pa1); PK4(p1, 0, pa2); PK4(p1, 8, pa3);
#undef PK4
}
__device__ __forceinline__ void qkt(f32x16& p0, f32x16& p1, const bf16* Ks, const bf16x8* qr, int r32, int hi) {
  p0 = f32x16{}; p1 = f32x16{};
  for (int d0 = 0; d0 < 8; ++d0) { int cb = (d0 * 16 + hi * 8) * 2;
    bf16x8 b0 = *reinterpret_cast<const bf16x8*>((const char*)Ks + KSWZ(r32, cb));
    bf16x8 b1 = *reinterpret_cast<const bf16x8*>((const char*)Ks + KSWZ(32 + r32, cb));
    p0 = __builtin_amdgcn_mfma_f32_32x32x16_bf16(b0, qr[d0], p0, 0, 0, 0);
    p1 = __builtin_amdgcn_mfma_f32_32x32x16_bf16(b1, qr[d0], p1, 0, 0, 0); }
}
__device__ __forceinline__ int v_st(int k, int c) { const int kk = (k & ~0xC) | ((k & 4) << 1) | ((k & 8) >> 1); return ((kk >> 3) * 4 + (c >> 5)) * 512 + ((kk & 7) * 32 + (c & 31)) * 2; }
__device__ __forceinline__ int v_rd_base(int lane) { return ((lane & 3) << 3) | (((lane >> 2) & 3) << 6) | (((lane >> 4) & 1) << 5) | (((lane >> 5) & 1) << 8); }
constexpr int v_rd_off(int d0, int ks, int half) { return d0 * 512 + ks * 4096 + half * 2048; }
template <int OFF> __device__ __forceinline__ s16x4 tr_read(int vb) {
  s16x4 r; asm volatile("ds_read_b64_tr_b16 %0, %1 offset:%2" : "=&v"(r) : "v"(vb), "i"(OFF) : "memory"); return r;
}
template <int D0> __device__ __forceinline__ void pv_one(f32x16& od, int vb, bf16x8 pa0, bf16x8 pa1, bf16x8 pa2, bf16x8 pa3) {
  const s16x4 l0 = tr_read<v_rd_off(D0, 0, 0)>(vb), h0 = tr_read<v_rd_off(D0, 0, 1)>(vb), l1 = tr_read<v_rd_off(D0, 1, 0)>(vb), h1 = tr_read<v_rd_off(D0, 1, 1)>(vb);
  const s16x4 l2 = tr_read<v_rd_off(D0, 2, 0)>(vb), h2 = tr_read<v_rd_off(D0, 2, 1)>(vb), l3 = tr_read<v_rd_off(D0, 3, 0)>(vb), h3 = tr_read<v_rd_off(D0, 3, 1)>(vb);
  asm volatile("s_waitcnt lgkmcnt(0)" ::: "memory"); SBAR();
#define PK(L, H) (bf16x8){L[0], L[1], L[2], L[3], H[0], H[1], H[2], H[3]}
  od = __builtin_amdgcn_mfma_f32_32x32x16_bf16(pa0, PK(l0, h0), od, 0, 0, 0);
  od = __builtin_amdgcn_mfma_f32_32x32x16_bf16(pa1, PK(l1, h1), od, 0, 0, 0);
  od = __builtin_amdgcn_mfma_f32_32x32x16_bf16(pa2, PK(l2, h2), od, 0, 0, 0);
  od = __builtin_amdgcn_mfma_f32_32x32x16_bf16(pa3, PK(l3, h3), od, 0, 0, 0);
#undef PK
}
__device__ __forceinline__ void pv_d0(f32x16* o, int vb, bf16x8 pa0, bf16x8 pa1, bf16x8 pa2, bf16x8 pa3) {
  pv_one<0>(o[0], vb, pa0, pa1, pa2, pa3); pv_one<1>(o[1], vb, pa0, pa1, pa2, pa3); pv_one<2>(o[2], vb, pa0, pa1, pa2, pa3); pv_one<3>(o[3], vb, pa0, pa1, pa2, pa3);
}

template <typename TQ>
__device__ __forceinline__ void attn_dense_body(const TQ* __restrict__ Qb, const bf16* __restrict__ Kh, const bf16* __restrict__ Vh,
                                                bf16* __restrict__ Ob, int seq, char* lds) {
  using St = Stage<bf16>; using SQ = Stage<TQ>;
  int tid_ = threadIdx.x; asm volatile("" : "+v"(tid_)); const int tid = tid_, wid = tid >> 6, lane = tid & 63, r32 = lane & 31, hi = lane >> 5;
  bf16* V_lds = (bf16*)lds; bf16* K_lds = (bf16*)(lds + 2 * SHM_V);
  float* ws = (float*)(lds + 2 * SHM_V + 2 * SHM_K) + wid * 64; float* li_l = ws; float* al_l = ws + 32;
  float m_reg = -1e30f, l_reg = 0; f32x16 o[4] = {}; bf16x8 qr[8];
  const TQ* Qw = Qb + (long)(wid * QBLK + r32) * LDQ + hi * 8;
#pragma unroll
  for (int d0 = 0; d0 < 8; ++d0) qr[d0] = SQ::tobf(SQ::ld8(Qw + d0 * 16));
  const int sr = tid >> 4, sc = (tid & 15) * 8, vst0 = v_st(sr, sc), vst1 = v_st(32 + sr, sc);
  const int vb0 = (int)(uintptr_t)V_lds + v_rd_base(lane);
  struct { typename St::T vs0, vs1, ks0, ks1; } sr_[SDEPTH];
#define SLOAD(i, k0) do { sr_[i].vs0 = St::ld8(&Vh[(long)((k0) + sr) * LDK + sc]); sr_[i].vs1 = St::ld8(&Vh[(long)((k0) + 32 + sr) * LDK + sc]); \
    sr_[i].ks0 = St::ld8(&Kh[(long)((k0) + sr) * LDK + sc]); sr_[i].ks1 = St::ld8(&Kh[(long)((k0) + 32 + sr) * LDK + sc]); } while (0)
#define SWRITE(b, i) do { *(bf16x8*)((char*)V_lds + (b) * SHM_V + vst0) = St::tobf(sr_[i].vs0);          \
    *(bf16x8*)((char*)V_lds + (b) * SHM_V + vst1) = St::tobf(sr_[i].vs1); int kc = sc * 2;               \
    *(bf16x8*)((char*)K_lds + (b) * SHM_K + KSWZ(sr, kc)) = St::tobf(sr_[i].ks0);                       \
    *(bf16x8*)((char*)K_lds + (b) * SHM_K + KSWZ(32 + sr, kc)) = St::tobf(sr_[i].ks1); } while (0)
#define SWAIT() do { if constexpr (SDEPTH == 2) asm volatile("s_waitcnt vmcnt(4)" ::: "memory"); else asm volatile("s_waitcnt vmcnt(0)" ::: "memory"); } while (0)
#define RESC(a) do { if (__any((a) < 1.f)) { if (hi == 0) al_l[r32] = (a); asm volatile("s_waitcnt lgkmcnt(0)" ::: "memory"); \
    for (int d = 0; d < 4; ++d) for (int r = 0; r < 16; ++r) o[d][r] *= al_l[crow(r, hi)]; } } while (0)
  f32x16 pA0, pA1, pB0, pB1; float mnA, mnB, alA, alB; bf16x8 pa0, pa1, pa2, pa3; const int NT = seq / KVBLK;
  constexpr int SE = 0, SO = SDEPTH - 1;
  SLOAD(SE, 0); asm volatile("s_waitcnt vmcnt(0)" ::: "memory"); SWRITE(0, SE); __syncthreads();
  qkt(pA0, pA1, K_lds, qr, r32, hi); partialSM(pA0, pA1, m_reg, mnA, alA);
  SLOAD(SO, KVBLK); if constexpr (SDEPTH == 2) { if (2 < NT) SLOAD(SE, 2 * KVBLK); }
  SWAIT(); SWRITE(1, SO); __syncthreads();
  for (int j = 1; j + 1 < NT; j += 2) {
    SBAR(); qkt(pB0, pB1, (bf16*)((char*)K_lds + SHM_K), qr, r32, hi);
    finishSM(pA0, pA1, alA, l_reg, pa0, pa1, pa2, pa3); SBAR();
    SLOAD(SO, (j + SDEPTH) * KVBLK); SBAR();
    pv_d0(o, vb0, pa0, pa1, pa2, pa3); partialSM(pB0, pB1, m_reg, mnB, alB);
    __syncthreads(); SWAIT(); SWRITE(0, SE);
    RESC(alB); __syncthreads();
    SBAR(); qkt(pA0, pA1, K_lds, qr, r32, hi);
    finishSM(pB0, pB1, alB, l_reg, pa0, pa1, pa2, pa3); SBAR();
    if (SDEPTH == 1 || j + 3 < NT) SLOAD(SE, (j + 1 + SDEPTH) * KVBLK); SBAR();
    pv_d0(o, vb0 + (int)SHM_V, pa0, pa1, pa2, pa3); partialSM(pA0, pA1, m_reg, mnA, alA);
    __syncthreads(); SWAIT(); SWRITE(1, SO);
    RESC(alA); __syncthreads();
  }
  SBAR(); qkt(pB0, pB1, (bf16*)((char*)K_lds + SHM_K), qr, r32, hi);
  finishSM(pA0, pA1, alA, l_reg, pa0, pa1, pa2, pa3); SBAR();
  pv_d0(o, vb0, pa0, pa1, pa2, pa3); partialSM(pB0, pB1, m_reg, mnB, alB);
  __syncthreads(); RESC(alB);
  finishSM(pB0, pB1, alB, l_reg, pa0, pa1, pa2, pa3); SBAR();
  pv_d0(o, vb0 + (int)SHM_V, pa0, pa1, pa2, pa3);
  if (hi == 0) li_l[r32] = l_reg; asm volatile("s_waitcnt lgkmcnt(0)" ::: "memory");
  float rli[16];
#pragma unroll
  for (int r = 0; r < 16; ++r) rli[r] = __builtin_amdgcn_rcpf(li_l[crow(r, hi)]);
  __syncthreads();
  bf16* Ol = (bf16*)lds + wid * (QBLK * D);
#pragma unroll
  for (int r = 0; r < 16; ++r) { const int orow = crow(r, hi);
#pragma unroll
    for (int d0 = 0; d0 < 4; ++d0) { const float v = o[d0][r] * rli[r]; unsigned u = __float_as_uint(v); u += 0x7FFFu + ((u >> 16) & 1u); Ol[orow * D + d0 * 32 + r32] = (bf16)(u >> 16); } }
  asm volatile("s_waitcnt lgkmcnt(0)" ::: "memory");
#pragma unroll
  for (int i = 0; i < 8; ++i) { const int row = i * 4 + (lane >> 4), ch = (lane & 15) * 8;
    const u32x4 v = *reinterpret_cast<const u32x4*>(Ol + row * D + ch);
    *reinterpret_cast<u32x4*>(Ob + (long)(wid * QBLK + row) * LDO + ch) = v; }
  __syncthreads();
#undef SLOAD
#undef SWRITE
#undef SWAIT
#undef RESC
}

}

__device__ void phase_attn(const Params& p, char* smem) {
  const int G = (int)gridDim.x, c = (int)blockIdx.x;
  for (int i = 0; i * G + c < 1024; ++i) {
    int pair, j;
    if (G == 256) { pair = 2 * (c & 7) + (i >> 1); j = (i & 1) * 32 + (c >> 3); } else { const int L = i * G + c; pair = L >> 6; j = L & 63; }
    const int b = pair >> 1, kv = pair & 1, qb = j >> 2, g = j & 3, h = kv * 4 + g;
    const bf16_t* Qb = p.Qh + (((size_t)b * 8 + h) * S + qb * 256) * 128; const bf16_t* Kp = p.Kh + ((size_t)b * 2 + kv) * S * 128; const bf16_t* Vp = p.Vh + ((size_t)b * 2 + kv) * S * 128;
    bf16_t* Ob = p.CAT + ((size_t)b * S + qb * 256) * 1024 + h * 128;
    att::attn_dense_body<att::bf16>(Qb, Kp, Vp, Ob, S, smem);
  }
}

constexpr int NPH = 19;
__global__ __launch_bounds__(NTHREADS, 2) void mega(Params p, int ph0, int ph1) {
  extern __shared__ __attribute__((aligned(16))) char smem[];
  cg::grid_group grid = cg::this_grid();
#ifndef REP_MASK
#define REP_MASK 0
#endif
#define PHASE(k, call) if (ph0 <= (k) && (k) < ph1) { if ((k) > ph0) grid.sync(); if ((REP_MASK >> (k)) & 1) { if ((k) == 10) phase_peer_gather<0, true>(p, 0); else if ((k) == 18) phase_peer_gather<1, true>(p, 1); else { call; } grid.sync(); } call; }
#if !defined(ONLY_PHASE) || ONLY_PHASE == 0
  PHASE(0, phase_prep(p, smem))
#endif
#if !defined(ONLY_PHASE) || ONLY_PHASE == 1
  PHASE(1, phase_norm<true>(p, p.x, p.nmg, p.mod, 0, 1024, smem))
#endif
#if !defined(ONLY_PHASE) || ONLY_PHASE == 2
  PHASE(2, phase_gemm_fast(p.H, p.Wt_evin, T, 2560, 1024, (EpiEvin{p.ZQK, p.ZV, p.ZO, p.ZP, p.ev_b_in}), smem))
#endif
#if !defined(ONLY_PHASE) || ONLY_PHASE == 3
  PHASE(3, phase_convpool(p, smem))
#endif
#if !defined(ONLY_PHASE) || ONLY_PHASE == 4
  PHASE(4, ml::phase_mlstm(p, smem))
#endif
#if !defined(ONLY_PHASE) || ONLY_PHASE == 5
  PHASE(5, phase_cat(p))
#endif
#if !defined(ONLY_PHASE) || ONLY_PHASE == 6
  PHASE(6, phase_gemm_fast(p.CAT, p.Wt_evout, T, 1024, 1024, (EpiRes{p.x, p.X, p.mod + 2048}), smem))
#endif
#if !defined(ONLY_PHASE) || ONLY_PHASE == 7
  PHASE(7, phase_norm<false>(p, p.X, p.nfg, p.mod, 3072, 4096, smem))
#endif
#if !defined(ONLY_PHASE) || ONLY_PHASE == 8
  PHASE(8, phase_gemm_fast(p.H, p.Wt_q, T, 2048, 1024, (EpiPlain{p.QP, 2048}), smem))
#endif
#if !defined(ONLY_PHASE) || ONLY_PHASE == 9
  PHASE(9, sel::phase_peer_select(p, 0, smem))
#endif
#if !defined(ONLY_PHASE) || ONLY_PHASE == 10
  PHASE(10, phase_peer_gather<0>(p, 0))
#endif
#if !defined(ONLY_PHASE) || ONLY_PHASE == 11
  PHASE(11, phase_gemm_fast(p.H, p.Wt_odin, T, 1536, 1024, (EpiPlain{p.QKV, 1536}), smem))
#endif
#if !defined(ONLY_PHASE) || ONLY_PHASE == 12
  PHASE(12, phase_qkrope(p))
#endif
#if !defined(ONLY_PHASE) || ONLY_PHASE == 13
  PHASE(13, phase_attn(p, smem))
#endif
#if !defined(ONLY_PHASE) || ONLY_PHASE == 14
  PHASE(14, phase_gemm_fast(p.CAT, p.Wt_odout, T, 1024, 1024, (EpiRes{p.X, p.X, p.mod + (size_t)8 * 6144 + 2048}), smem))
#endif
#if !defined(ONLY_PHASE) || ONLY_PHASE == 15
  PHASE(15, phase_norm<false>(p, p.X, p.nfg + D, p.mod + (size_t)8 * 6144, 3072, 4096, smem))
#endif
#if !defined(ONLY_PHASE) || ONLY_PHASE == 16
  PHASE(16, phase_gemm_fast(p.H, p.Wt_q + (size_t)2048 * 1024, T, 2048, 1024, (EpiPlain{p.QP, 2048}), smem))
#endif
#if !defined(ONLY_PHASE) || ONLY_PHASE == 17
  PHASE(17, sel::phase_peer_select(p, 1, smem))
#endif
#if !defined(ONLY_PHASE) || ONLY_PHASE == 18
  PHASE(18, phase_peer_gather<1>(p, 1))
#endif
#undef PHASE
}
}

extern "C" void kernel_launch(void* const* d_in, const int* in_sizes, int n_in, void* d_out, int out_size, void* d_ws, size_t ws_size, hipStream_t stream) {
  (void)in_sizes; (void)n_in; (void)out_size;
  Params p{};
  const float** fin = (const float**)&p;
  for (int i = 0; i < 23; ++i) fin[i] = (const float*)d_in[i];
  p.X = (float*)d_out;
  char* ws = (char*)d_ws; size_t off = 0;
  auto alloc = [&](size_t bytes) { char* q = ws + off; off += (bytes + 255) / 256 * 256; return q; };
  p.U8 = (unsigned char*)alloc((size_t)2 * 16384 * 1024); p.V8 = (unsigned char*)alloc((size_t)2 * 16384 * 1024);
  p.Wt_evin = (bf16_t*)alloc((size_t)2560 * 1024 * 2); p.Wt_evout = (bf16_t*)alloc((size_t)1024 * 1024 * 2); p.Wt_odin = (bf16_t*)alloc((size_t)1536 * 1024 * 2);
  p.Wt_odout = (bf16_t*)alloc((size_t)1024 * 1024 * 2); p.Wt_q = (bf16_t*)alloc((size_t)2 * 2048 * 1024 * 2); p.keysb = (bf16_t*)alloc((size_t)2 * 2 * 128 * 128 * 2);
  p.Wg = (float*)alloc(16 * 1024 * 4); p.mod = (float*)alloc(2 * 8 * 6144 * 4); p.gates = (float*)alloc((size_t)T * 16 * 4);
  p.pgate = (float*)alloc((size_t)T * 128 * 4); p.pidx = (bf16_t*)alloc((size_t)T * 128 * 2);
  p.H = (bf16_t*)alloc((size_t)T * 1024 * 2); p.CAT = p.H;
  char* big = alloc((size_t)T * 2048 * 2);
  p.ZQK = (bf16_t*)big; p.ZV = (bf16_t*)(big + (size_t)T * 1024 * 2); p.ZO = (bf16_t*)(big + (size_t)T * 1536 * 2); p.HS = (bf16_t*)big; p.QP = (bf16_t*)big; p.QKV = (bf16_t*)big;
  char* big2 = alloc((size_t)T * 1536 * 2);
  p.QK = (bf16_t*)big2; p.ZP = (bf16_t*)(big2 + (size_t)T * 1024 * 2); p.Qh = (bf16_t*)big2; p.Kh = (bf16_t*)(big2 + (size_t)T * 1024 * 2); p.Vh = (bf16_t*)(big2 + (size_t)T * 1280 * 2);
  if (off > ws_size) { fprintf(stderr, "kernel_launch: workspace too small: need %zu have %zu\n", off, ws_size); return; }

  static int grid_blocks = 0;
  if (!grid_blocks) {
    int dev = 0, cus = 0, per_cu = 0; hipGetDevice(&dev); hipDeviceGetAttribute(&cus, hipDeviceAttributeMultiprocessorCount, dev);
    hipFuncSetAttribute((const void*)mega, hipFuncAttributeMaxDynamicSharedMemorySize, SMEM_BYTES);
    hipOccupancyMaxActiveBlocksPerMultiprocessor(&per_cu, mega, NTHREADS, SMEM_BYTES);
    if (per_cu > 1) per_cu = 1;
    grid_blocks = cus * per_cu;
    if (grid_blocks <= 0) { fprintf(stderr, "kernel_launch: occupancy query returned 0\n"); grid_blocks = 0; return; }
  }
#if MULTI_LAUNCH
  for (int ph = 0; ph < NPH; ++ph) hipLaunchKernelGGL(mega, dim3(grid_blocks), dim3(NTHREADS), SMEM_BYTES, stream, p, ph, ph + 1);
#else
  int ph0 = 0, ph1 = NPH; void* args[] = {&p, &ph0, &ph1};
  hipError_t e = hipLaunchCooperativeKernel((const void*)mega, dim3(grid_blocks), dim3(NTHREADS), args, SMEM_BYTES, stream);
  if (e != hipSuccess) fprintf(stderr, "cooperative launch failed: %s (grid %d)\n", hipGetErrorString(e), grid_blocks);
#endif
}
```

```cpp
#include <hip/hip_runtime.h>
#include <hip/hip_cooperative_groups.h>
#include <math.h>
#include <stdint.h>
#include <stdio.h>
namespace cg = cooperative_groups;

#ifndef MULTI_LAUNCH
#define MULTI_LAUNCH 0
#endif

namespace {
typedef unsigned short bf16_t;
typedef unsigned int u32;
typedef float f32x4 __attribute__((ext_vector_type(4)));
typedef u32 u32x4 __attribute__((ext_vector_type(4)));
typedef u32 u32x2 __attribute__((ext_vector_type(2)));
typedef __bf16 bf16x2_t __attribute__((ext_vector_type(2)));

constexpr int D = 1024, NB = 8, S = 4096, T = NB * S;
constexpr int EVEN_IN = 2576;
constexpr float EPS = 1e-6f;
constexpr int NTHREADS = 512;
constexpr int SMEM_BYTES = 144 * 1024;
constexpr float KSCALE = 0.08838834764831845f;

struct Params {
  const float *x, *c, *ada_w, *ada_b, *nmg, *nfg, *ev_w_in, *ev_b_in, *conv_w, *conv_b, *mnorm_g, *pool_w, *pool_sc, *ev_w_out, *od_w_in, *qn_g, *kn_g, *od_w_out,
      *peer_wq, *peer_keys, *peer_u, *peer_v, *final_g;
  float* X;
  bf16_t *Wt_evin, *Wt_evout, *Wt_odin, *Wt_odout, *Wt_q, *keysb; unsigned char *U8, *V8;
  float *Wg, *mod, *gates, *pgate;
  bf16_t *H, *ZQK, *ZV, *ZO, *ZP, *QK, *HS, *CAT, *QP, *QKV, *Qh, *Kh, *Vh;
  bf16_t* pidx;
  unsigned* bar;
};

__device__ __forceinline__ float siluf(float x) { return x / (1.f + __expf(-x)); }
__device__ __forceinline__ float sigmf(float x) { return 1.f / (1.f + __expf(-x)); }
__device__ __forceinline__ float wave_sum(float v) { for (int o = 32; o >= 1; o >>= 1) v += __shfl_xor(v, o); return v; }
__device__ __forceinline__ float wave_max(float v) { for (int o = 32; o >= 1; o >>= 1) v = fmaxf(v, __shfl_xor(v, o)); return v; }
__device__ __forceinline__ bf16_t f2bf(float f) { u32 u = __float_as_uint(f); u += 0x7FFFu + ((u >> 16) & 1u); return (bf16_t)(u >> 16); }
__device__ __forceinline__ float bf2f(bf16_t b) { return __uint_as_float(((u32)b) << 16); }
__device__ __forceinline__ u32 pack2(float lo, float hi) { return (u32)f2bf(lo) | ((u32)f2bf(hi) << 16); }
__device__ __forceinline__ float bflo(u32 w) { return __uint_as_float(w << 16); }
__device__ __forceinline__ float bfhi(u32 w) { return __uint_as_float(w & 0xFFFF0000u); }
__device__ __forceinline__ float dot2bf(u32 a, u32 b, float c) { return __builtin_amdgcn_fdot2_f32_bf16(__builtin_bit_cast(bf16x2_t, a), __builtin_bit_cast(bf16x2_t, b), c, false); }

constexpr int PJ_MOD = 192, PJ_TR = 2576, PJ_WG = 1, PJ_KEYS = 16, PJ_UV = 8192;
constexpr int PJ_TOTAL = PJ_MOD + PJ_TR + PJ_WG + PJ_KEYS + PJ_UV;

__device__ void prep_transpose_tile(const float* __restrict__ src, int ld, int k0, int n0, bf16_t* __restrict__ dst, int dstK, char* smem) {
  float* tile = (float*)smem;
  const int tid = threadIdx.x;
  __syncthreads();
  for (int pass = 0; pass < 8; ++pass) { int kk = pass * 8 + (tid >> 6), n = tid & 63; tile[kk * 65 + n] = src[(size_t)(k0 + kk) * ld + n0 + n]; }
  __syncthreads();
  int n = tid >> 3, kc = (tid & 7) * 8; u32x4 w;
  w.x = pack2(tile[(kc + 0) * 65 + n], tile[(kc + 1) * 65 + n]); w.y = pack2(tile[(kc + 2) * 65 + n], tile[(kc + 3) * 65 + n]);
  w.z = pack2(tile[(kc + 4) * 65 + n], tile[(kc + 5) * 65 + n]); w.w = pack2(tile[(kc + 6) * 65 + n], tile[(kc + 7) * 65 + n]);
  *(u32x4*)(dst + (size_t)(n0 + n) * dstK + k0 + kc) = w;
}

__device__ void phase_prep(const Params& p, char* smem) {
  const int tid = threadIdx.x;
  for (int job = blockIdx.x; job < PJ_TOTAL; job += gridDim.x) {
    if (job < PJ_MOD) {
      float* cs = (float*)smem; float* red = cs + 8192;
      __syncthreads();
      for (int i = tid; i < 8192; i += NTHREADS) cs[i] = siluf(p.c[i]);
      __syncthreads();
      const int l = job / 96, e0 = (job % 96) * 64, col = tid & 63, dg = tid >> 6;
      float acc[8];
#pragma unroll
      for (int b = 0; b < 8; ++b) acc[b] = 0.f;
      const float* w = p.ada_w + (size_t)l * D * 6144 + e0 + col;
      for (int d = dg * 128; d < dg * 128 + 128; ++d) { float wv = w[(size_t)d * 6144];
#pragma unroll
        for (int b = 0; b < 8; ++b) acc[b] += cs[b * 1024 + d] * wv; }
#pragma unroll
      for (int b = 0; b < 8; ++b) red[(dg * 8 + b) * 64 + col] = acc[b];
      __syncthreads();
      { const int b = tid >> 6; float s = 0.f;
#pragma unroll
        for (int g = 0; g < 8; ++g) s += red[(g * 8 + b) * 64 + col];
        p.mod[(size_t)(l * 8 + b) * 6144 + e0 + col] = s + p.ada_b[l * 6144 + e0 + col]; }
    } else if (job < PJ_MOD + PJ_TR) {
      int tt = job - PJ_MOD;
      if (tt < 640) prep_transpose_tile(p.ev_w_in, EVEN_IN, (tt / 40) * 64, (tt % 40) * 64, p.Wt_evin, 1024, smem);
      else if (tt < 896) { tt -= 640; prep_transpose_tile(p.ev_w_out, 1024, (tt / 16) * 64, (tt % 16) * 64, p.Wt_evout, 1024, smem); }
      else if (tt < 1280) { tt -= 896; prep_transpose_tile(p.od_w_in, 1536, (tt / 24) * 64, (tt % 24) * 64, p.Wt_odin, 1024, smem); }
      else if (tt < 1536) { tt -= 1280; prep_transpose_tile(p.od_w_out, 1024, (tt / 16) * 64, (tt % 16) * 64, p.Wt_odout, 1024, smem); }
      else if (tt < 2560) { tt -= 1536; int l = tt / 512; tt %= 512; prep_transpose_tile(p.peer_wq + (size_t)l * D * 2048, 2048, (tt / 32) * 64, (tt % 32) * 64, p.Wt_q + (size_t)l * 2048 * 1024, 1024, smem); }
      else {   }
    } else if (job < PJ_MOD + PJ_TR + PJ_WG) {
      for (int i = tid; i < 16 * 1024; i += NTHREADS) { int g = i >> 10, d = i & 1023; p.Wg[i] = p.ev_w_in[(size_t)d * EVEN_IN + 2560 + g]; }
    } else if (job < PJ_MOD + PJ_TR + PJ_WG + PJ_KEYS) {
      int j = job - (PJ_MOD + PJ_TR + PJ_WG);
      for (int i = tid; i < 4096; i += NTHREADS) p.keysb[j * 4096 + i] = f2bf(p.peer_keys[j * 4096 + i]);
    } else {
      int j = job - (PJ_MOD + PJ_TR + PJ_WG + PJ_KEYS); const bool isu = j < 4096; const float* src = isu ? p.peer_u : p.peer_v; unsigned char* dst = isu ? p.U8 : p.V8; j &= 4095; const float sc = isu ? 32.f : 2.f;
      const size_t o = (size_t)j * 8192 + tid * 16; u32x4 w; u32 ww[4];
#pragma unroll
      for (int q = 0; q < 4; ++q) { const f32x4 a = *(const f32x4*)(src + o + 4 * q); int pk = __builtin_amdgcn_cvt_pk_fp8_f32(a.x * sc, a.y * sc, 0, false); pk = __builtin_amdgcn_cvt_pk_fp8_f32(a.z * sc, a.w * sc, pk, true); ww[q] = (u32)pk; }
      w.x = ww[0]; w.y = ww[1]; w.z = ww[2]; w.w = ww[3]; *(u32x4*)(dst + o) = w;
    }
  }
}

template <bool WITH_GATES>
__device__ void phase_norm(const Params& p, const float* __restrict__ xin, const float* __restrict__ g, const float* __restrict__ modl, int sh_off, int sc_off, char* smem) {
  const int tid = threadIdx.x, wid = tid >> 6, lane = tid & 63;
  float* wg = (float*)smem;
  if (WITH_GATES) { __syncthreads(); for (int i = tid; i < 16 * 1024; i += NTHREADS) wg[i] = p.Wg[i]; __syncthreads(); }
  for (int job = blockIdx.x; job < T / 8; job += gridDim.x) {
    const int t = job * 8 + wid, b = t / S;
    f32x4 v[4]; float ss = 0.f;
#pragma unroll
    for (int i = 0; i < 4; ++i) { v[i] = *(const f32x4*)(xin + (size_t)t * D + i * 256 + lane * 4); ss += v[i].x * v[i].x + v[i].y * v[i].y + v[i].z * v[i].z + v[i].w * v[i].w; }
    ss = wave_sum(ss); const float r = rsqrtf(ss * (1.f / D) + EPS);
    const float* shp = modl + (size_t)b * 6144 + sh_off; const float* scp = modl + (size_t)b * 6144 + sc_off;
#pragma unroll
    for (int i = 0; i < 4; ++i) { const int d = i * 256 + lane * 4; f32x4 gg = *(const f32x4*)(g + d), s1 = *(const f32x4*)(scp + d), s0 = *(const f32x4*)(shp + d);
      v[i].x = v[i].x * r * gg.x * (1.f + s1.x) + s0.x; v[i].y = v[i].y * r * gg.y * (1.f + s1.y) + s0.y; v[i].z = v[i].z * r * gg.z * (1.f + s1.z) + s0.z; v[i].w = v[i].w * r * gg.w * (1.f + s1.w) + s0.w;
      u32x2 w; w.x = pack2(v[i].x, v[i].y); w.y = pack2(v[i].z, v[i].w); *(u32x2*)(p.H + (size_t)t * D + d) = w; }
    if (WITH_GATES) {
      float myg = 0.f;
#pragma unroll 2
      for (int gi = 0; gi < 16; ++gi) { float a = 0.f;
#pragma unroll
        for (int i = 0; i < 4; ++i) { f32x4 w4 = *(const f32x4*)(wg + gi * 1024 + i * 256 + lane * 4); a += v[i].x * w4.x + v[i].y * w4.y + v[i].z * w4.z + v[i].w * w4.w; }
        a = wave_sum(a); if (lane == gi) myg = a; }
      if (lane < 16) p.gates[(size_t)t * 16 + lane] = myg + p.ev_b_in[2560 + lane];
    }
  }
}

enum { EPI_EVIN = 0, EPI_EVOUT = 1, EPI_PEERQ = 2, EPI_ODIN = 3, EPI_ODOUT = 4 };
template <int EPI> __device__ __forceinline__ void epi_store(const Params& p, int layer, int m, int n, float acc) {
  if (EPI == EPI_EVIN) { float v = acc + p.ev_b_in[n];
    if (n < 1024) p.ZQK[(size_t)m * 1024 + n] = f2bf(v); else if (n < 1536) p.ZV[(size_t)m * 512 + n - 1024] = f2bf(v);
    else if (n < 2048) p.ZO[(size_t)m * 512 + n - 1536] = f2bf(sigmf(v)); else p.ZP[(size_t)m * 512 + n - 2048] = f2bf(v); }
  else if (EPI == EPI_EVOUT) { int b = m / S; p.X[(size_t)m * D + n] = p.x[(size_t)m * D + n] + p.mod[(size_t)(0 * 8 + b) * 6144 + 2048 + n] * acc; }
  else if (EPI == EPI_PEERQ) p.QP[(size_t)m * 2048 + n] = f2bf(acc);
  else if (EPI == EPI_ODIN) p.QKV[(size_t)m * 1536 + n] = f2bf(acc);
  else if (EPI == EPI_ODOUT) { int b = m / S; p.X[(size_t)m * D + n] += p.mod[(size_t)(1 * 8 + b) * 6144 + 2048 + n] * acc; }
}
template <int EPI> __device__ void phase_gemm_naive(const Params& p, int layer, const bf16_t* __restrict__ A, const bf16_t* __restrict__ Bt, int M, int N, int K, char* smem) {
  float* As = (float*)smem; float* Bs = As + 32 * 132;
  const int tid = threadIdx.x, tx = tid & 15, ty = tid >> 4; const int nN = N / 64, njobs = (M / 128) * nN;
  for (int job = blockIdx.x; job < njobs; job += gridDim.x) {
    const int m0 = (job / nN) * 128, n0 = (job % nN) * 64; float acc[4][4];
#pragma unroll
    for (int i = 0; i < 4; ++i)
#pragma unroll
      for (int j = 0; j < 4; ++j) acc[i][j] = 0.f;
    for (int k0 = 0; k0 < K; k0 += 32) {
      __syncthreads();
      { int row = tid >> 2, kc = (tid & 3) * 8; u32x4 w = *(const u32x4*)(A + (size_t)(m0 + row) * K + k0 + kc);
        As[(kc + 0) * 132 + row] = bflo(w.x); As[(kc + 1) * 132 + row] = bfhi(w.x); As[(kc + 2) * 132 + row] = bflo(w.y); As[(kc + 3) * 132 + row] = bfhi(w.y);
        As[(kc + 4) * 132 + row] = bflo(w.z); As[(kc + 5) * 132 + row] = bfhi(w.z); As[(kc + 6) * 132 + row] = bflo(w.w); As[(kc + 7) * 132 + row] = bfhi(w.w); }
      if (tid < 256) { int row = tid >> 2, kc = (tid & 3) * 8; u32x4 w = *(const u32x4*)(Bt + (size_t)(n0 + row) * K + k0 + kc);
        Bs[(kc + 0) * 68 + row] = bflo(w.x); Bs[(kc + 1) * 68 + row] = bfhi(w.x); Bs[(kc + 2) * 68 + row] = bflo(w.y); Bs[(kc + 3) * 68 + row] = bfhi(w.y);
        Bs[(kc + 4) * 68 + row] = bflo(w.z); Bs[(kc + 5) * 68 + row] = bfhi(w.z); Bs[(kc + 6) * 68 + row] = bflo(w.w); Bs[(kc + 7) * 68 + row] = bfhi(w.w); }
      __syncthreads();
#pragma unroll 8
      for (int kk = 0; kk < 32; ++kk) { f32x4 a = *(const f32x4*)(As + kk * 132 + ty * 4), b = *(const f32x4*)(Bs + kk * 68 + tx * 4);
        acc[0][0] += a.x * b.x; acc[0][1] += a.x * b.y; acc[0][2] += a.x * b.z; acc[0][3] += a.x * b.w;
        acc[1][0] += a.y * b.x; acc[1][1] += a.y * b.y; acc[1][2] += a.y * b.z; acc[1][3] += a.y * b.w;
        acc[2][0] += a.z * b.x; acc[2][1] += a.z * b.y; acc[2][2] += a.z * b.z; acc[2][3] += a.z * b.w;
        acc[3][0] += a.w * b.x; acc[3][1] += a.w * b.y; acc[3][2] += a.w * b.z; acc[3][3] += a.w * b.w; }
    }
#pragma unroll
    for (int i = 0; i < 4; ++i)
#pragma unroll
      for (int j = 0; j < 4; ++j) epi_store<EPI>(p, layer, m0 + ty * 4 + i, n0 + tx * 4 + j, acc[i][j]);
  }
}

namespace pg8 {
#define PG8_LAS __attribute__((address_space(3)))
typedef unsigned short bf16_t;
typedef short bf16x8 __attribute__((ext_vector_type(8)));
typedef float f32x4 __attribute__((ext_vector_type(4)));
typedef unsigned u32x4 __attribute__((ext_vector_type(4)));
constexpr int BM = 256, BK = 64, HALF = 128, HTB = HALF * BK * 2  , STAGE_BYTES = 8 * HTB, NXCD = 8, WGM = 8;

__host__ __device__ __forceinline__ int lds_byte(int r, int c) { const int st = (r >> 4) * 2 + (c >> 5), rr = r & 15, cc = c & 31, ob = rr * 64 + cc * 2; return st * 1024 + (ob ^ (((ob >> 9) & 1) << 5)); }
__host__ __device__ __forceinline__ void stage_rc(int b, int& R, int& C) { const int st = b / 1024, sb = b % 1024, swz = sb ^ (((sb >> 9) & 1) << 5); R = (st >> 1) * 16 + swz / 64; C = (st & 1) * 32 + (swz % 64) / 2; }
__host__ __device__ __forceinline__ int perm32(int rho) { const int n = rho >> 4, i = rho & 15; return 8 * (i >> 2) + 4 * n + (i & 3); }

struct Unit { int pm, pn; };
struct Gemm { const bf16_t* A; const bf16_t* Bt; int M, N, K; };

struct StaticOrder {
    int nM, nN, nwg, G, c;
    __host__ __device__ void init(int M, int N, int G_, int c_) { nM = M / BM; nN = N / BM; nwg = nM * nN; G = G_; c = c_; }
    __host__ __device__ bool next(int i, Unit& u) const {
        const long L = (long)i * G + c; if (L >= nwg) return false;
        int wgid = (int)L; { const int q = nwg / NXCD, r = nwg % NXCD, xcd = wgid % NXCD, off = wgid / NXCD; wgid = (xcd < r ? xcd * (q + 1) : r * (q + 1) + (xcd - r) * q) + off; }
        const int nig = WGM * nN, gid = wgid / nig, fm = gid * WGM, gsz = (nM - fm) < WGM ? (nM - fm) : WGM;
        u.pm = fm + ((wgid % nig) % gsz); u.pn = (wgid % nig) / gsz; return true;
    }
    __device__ __forceinline__ void a_ready(const Unit&) const {}
    __device__ __forceinline__ void done(const Unit&) const {}
};
__device__ __forceinline__ unsigned cvt_pk_bf16(float lo, float hi) { unsigned r; asm volatile("v_cvt_pk_bf16_f32 %0, %1, %2" : "=v"(r) : "v"(lo), "v"(hi)); return r; }
template <class Epi, class Sched, bool STAMP = false>
__device__ __forceinline__ void gemm_phase(PG8_LAS unsigned char* lds, const Gemm g, const Sched& S, const Epi& E, unsigned long long* stamps) {
    const int tid = threadIdx.x, wid = __builtin_amdgcn_readfirstlane(tid >> 6), lane = tid & 63, wr = wid >> 2, wc = wid & 3, fr = lane & 15, fq = lane >> 4;
    const int K = g.K, nt = K / BK;
    int ts_lo = 0, ts_hi = 0, nts = 0; const unsigned long long rt_entry = STAMP ? (unsigned long long)wall_clock64() : 0ull;
#define PG8_STAMP() do { if (STAMP && wid == 0 && nts < 64) { const unsigned long long _c = (unsigned long long)clock64(); \
        ts_lo = (lane == nts) ? (int)(unsigned)_c : ts_lo; ts_hi = (lane == nts) ? (int)(unsigned)(_c >> 32) : ts_hi; ++nts; } } while (0)
    PG8_STAMP();
    unsigned voffA[2], voffB[2];
#pragma unroll
    for (int i = 0; i < 2; ++i) { int R, C; stage_rc(tid * 16 + i * 8192, R, C); const int Rb = Epi::PERM ? ((R & ~31) + perm32(R & 31)) : R;
        voffA[i] = (unsigned)(R * K + C) * 2u; voffB[i] = (unsigned)(Rb * K + C) * 2u; }
    const size_t kstep = (size_t)(BK * 2);
    const size_t hstep = (size_t)HALF * K * 2;
    const size_t tstep = 2 * hstep;
    const unsigned ldsw = (unsigned)wid * 1024u;
    const int aoff = lds_byte(wr * 64 + fr, fq * 8), boff = lds_byte(wc * 32 + fr, fq * 8);
#define PG8_SA(b, h) (((b) * 2 + (h)) * HTB)
#define PG8_SB(b, h) ((4 + (b) * 2 + (h)) * HTB)
#define PG8_STAGE(bufoff, gbase, voff) do { _Pragma("unroll") for (int _i = 0; _i < 2; ++_i) \
        __builtin_amdgcn_global_load_lds((const unsigned*)((const char*)(gbase) + (voff)[_i]), (PG8_LAS unsigned*)(lds + (bufoff) + ldsw + _i * 8192), 16, 0, 0); } while (0)
#define PG8_LDA(dst, b, h) do { _Pragma("unroll") for (int m = 0; m < 4; ++m) _Pragma("unroll") for (int k = 0; k < 2; ++k) dst[m][k] = *(const PG8_LAS bf16x8*)(lds + PG8_SA(b, h) + aoff + m * 2048 + k * 1024); } while (0)
#define PG8_LDB(dst, b, h) do { _Pragma("unroll") for (int n = 0; n < 2; ++n) _Pragma("unroll") for (int k = 0; k < 2; ++k) dst[n][k] = *(const PG8_LAS bf16x8*)(lds + PG8_SB(b, h) + boff + n * 2048 + k * 1024); } while (0)
#define PG8_MMA(ai, bj, At, Bt) do { __builtin_amdgcn_s_setprio(1); _Pragma("unroll") for (int m = 0; m < 4; ++m) _Pragma("unroll") for (int n = 0; n < 2; ++n) _Pragma("unroll") for (int k = 0; k < 2; ++k) \
        acc[ai][bj][m][n] = __builtin_amdgcn_mfma_f32_16x16x32_bf16(Bt[n][k], At[m][k], acc[ai][bj][m][n], 0, 0, 0); __builtin_amdgcn_s_setprio(0); } while (0)
#define PG8_WAIT_V(n) asm volatile("s_waitcnt vmcnt(" #n ")" ::: "memory")
#define PG8_WAIT_L(n) asm volatile("s_waitcnt lgkmcnt(" #n ")" ::: "memory")
#define PG8_BAR __builtin_amdgcn_s_barrier()
#define PG8_SCHED __builtin_amdgcn_sched_barrier(0)
    Unit cur, nxt; int ui = 0;
    if (!S.next(0, cur)) return;
    f32x4 acc[2][2][4][2];
#pragma unroll
    for (int a = 0; a < 2; ++a)
#pragma unroll
        for (int b = 0; b < 2; ++b)
#pragma unroll
            for (int m = 0; m < 4; ++m)
#pragma unroll
                for (int n = 0; n < 2; ++n) acc[a][b][m][n] = (f32x4){0.f, 0.f, 0.f, 0.f};
    bf16x8 At[4][2], B0[2][2], B1[2][2];
    const char* cA = (const char*)g.A + (size_t)cur.pm * tstep; const char* cB = (const char*)g.Bt + (size_t)cur.pn * tstep;
    S.a_ready(cur);
    PG8_STAGE(PG8_SB(0, 0), cB, voffB); PG8_STAGE(PG8_SA(0, 0), cA, voffA); PG8_STAGE(PG8_SB(0, 1), cB + hstep, voffB); PG8_STAGE(PG8_SA(0, 1), cA + hstep, voffA);
    if (wr == 1) PG8_BAR;
    PG8_WAIT_V(4); PG8_BAR;
    PG8_STAGE(PG8_SB(1, 0), cB + kstep, voffB); PG8_STAGE(PG8_SA(1, 0), cA + kstep, voffA); PG8_STAGE(PG8_SB(1, 1), cB + hstep + kstep, voffB);
    PG8_WAIT_V(6); PG8_BAR;
    PG8_STAMP();
    for (;;) {
        const bool has_next = S.next(ui + 1, nxt);
        const char* nA = has_next ? (const char*)g.A + (size_t)nxt.pm * tstep : cA; const char* nB = has_next ? (const char*)g.Bt + (size_t)nxt.pn * tstep : cB;
        for (int t = 0; t < nt; t += 2) {
            const bool last = (t == nt - 2);
            const char* a1 = cA + (size_t)(t + 1) * kstep;
            const char* a2 = last ? nA : cA + (size_t)(t + 2) * kstep; const char* b2 = last ? nB : cB + (size_t)(t + 2) * kstep;
            const char* a3 = a2 + kstep; const char* b3 = b2 + kstep;
            if (last && has_next) S.a_ready(nxt);
            PG8_LDB(B0, 0, 0); PG8_SCHED; PG8_LDA(At, 0, 0); PG8_STAGE(PG8_SA(1, 1), a1 + hstep, voffA);
            PG8_WAIT_L(8); PG8_BAR; PG8_WAIT_L(0); PG8_MMA(0, 0, At, B0); PG8_BAR; PG8_SCHED;
            PG8_LDB(B1, 0, 1); PG8_STAGE(PG8_SB(0, 0), b2, voffB);
            PG8_BAR; PG8_WAIT_L(0); PG8_MMA(0, 1, At, B1); PG8_BAR;
            PG8_LDA(At, 0, 1); PG8_STAGE(PG8_SA(0, 0), a2, voffA);
            PG8_BAR; PG8_WAIT_L(0); PG8_MMA(1, 0, At, B0); PG8_BAR; PG8_SCHED;
            PG8_STAGE(PG8_SB(0, 1), b2 + hstep, voffB);
            PG8_WAIT_V(6); PG8_BAR; PG8_MMA(1, 1, At, B1); PG8_BAR;
            PG8_LDB(B0, 1, 0); PG8_SCHED; PG8_LDA(At, 1, 0); PG8_STAGE(PG8_SA(0, 1), a2 + hstep, voffA);
            PG8_WAIT_L(8); PG8_BAR; PG8_WAIT_L(0); PG8_MMA(0, 0, At, B0); PG8_BAR; PG8_SCHED;
            PG8_LDB(B1, 1, 1); PG8_STAGE(PG8_SB(1, 0), b3, voffB);
            PG8_BAR; PG8_WAIT_L(0); PG8_MMA(0, 1, At, B1); PG8_BAR;
            PG8_LDA(At, 1, 1); PG8_STAGE(PG8_SA(1, 0), a3, voffA);
            PG8_BAR; PG8_WAIT_L(0); PG8_MMA(1, 0, At, B0); PG8_BAR; PG8_SCHED;
            PG8_STAGE(PG8_SB(1, 1), b3 + hstep, voffB);
            PG8_WAIT_V(6); PG8_BAR; PG8_MMA(1, 1, At, B1); PG8_BAR;
        }
        PG8_STAMP();
        if constexpr (!Epi::AFTER_DRAIN) { E(acc, cur, wr, wc, fr, fq); S.done(cur); }
        PG8_STAMP();
        if (!has_next) break;
#pragma unroll
        for (int a = 0; a < 2; ++a)
#pragma unroll
            for (int b = 0; b < 2; ++b)
#pragma unroll
                for (int m = 0; m < 4; ++m)
#pragma unroll
                    for (int n = 0; n < 2; ++n) acc[a][b][m][n] = (f32x4){0.f, 0.f, 0.f, 0.f};
        cur = nxt; cA = nA; cB = nB; ++ui;
    }
    PG8_WAIT_V(0);
    if (wr == 0) PG8_BAR;
    PG8_BAR;
    if constexpr (Epi::AFTER_DRAIN) { E.fused(acc, cur, wr, wc, fr, fq, lds, wid, lane); S.done(cur); }
    PG8_STAMP();
    if (STAMP && wid == 0) { stamps[lane] = lane < nts ? (((unsigned long long)(unsigned)ts_hi << 32) | (unsigned)ts_lo) : 0ull;
        if (lane == 62) stamps[62] = rt_entry; if (lane == 63) stamps[63] = (unsigned long long)wall_clock64(); }
#undef PG8_STAMP
#undef PG8_SA
#undef PG8_SB
#undef PG8_STAGE
#undef PG8_LDA
#undef PG8_LDB
#undef PG8_MMA
#undef PG8_WAIT_V
#undef PG8_WAIT_L
#undef PG8_BAR
#undef PG8_SCHED
}
}

struct EpiEvin {
  static constexpr bool PERM = true, AFTER_DRAIN = false;
  bf16_t *ZQK, *ZV, *ZO, *ZP; const float* bias;
  __device__ __forceinline__ void operator()(const pg8::f32x4 (&acc)[2][2][4][2], const pg8::Unit& u, int wr, int wc, int fr, int fq) const {
    const int row0 = u.pm * 256 + wr * 64 + fr, ct = u.pn * 256;
    bf16_t* base; int ldc, cl; bool sig = false;
    if (ct < 1024) { base = ZQK; ldc = 1024; cl = ct; } else if (ct < 1536) { base = ZV; ldc = 512; cl = ct - 1024; } else if (ct < 2048) { base = ZO; ldc = 512; cl = ct - 1536; sig = true; } else { base = ZP; ldc = 512; cl = ct - 2048; }
    const int cofs = wc * 32 + 8 * fq;
    pg8::f32x4 bv[2][2];
#pragma unroll
    for (int bj = 0; bj < 2; ++bj)
#pragma unroll
      for (int n = 0; n < 2; ++n) bv[bj][n] = *(const pg8::f32x4*)(bias + ct + cofs + bj * 128 + 4 * n);
#pragma unroll
    for (int ai = 0; ai < 2; ++ai)
#pragma unroll
      for (int m = 0; m < 4; ++m) { bf16_t* rowp = base + (size_t)(row0 + ai * 128 + m * 16) * ldc + cl + cofs;
#pragma unroll
        for (int bj = 0; bj < 2; ++bj) { pg8::f32x4 v0 = acc[ai][bj][m][0] + bv[bj][0], v1 = acc[ai][bj][m][1] + bv[bj][1];
          if (sig) {
#pragma unroll
            for (int j = 0; j < 4; ++j) { v0[j] = sigmf(v0[j]); v1[j] = sigmf(v1[j]); } }
          pg8::u32x4 w; w.x = pg8::cvt_pk_bf16(v0[0], v0[1]); w.y = pg8::cvt_pk_bf16(v0[2], v0[3]); w.z = pg8::cvt_pk_bf16(v1[0], v1[1]); w.w = pg8::cvt_pk_bf16(v1[2], v1[3]);
          *(pg8::u32x4*)(rowp + bj * 128) = w; } }
  }
};
struct EpiPlain {
  static constexpr bool PERM = true, AFTER_DRAIN = false;
  bf16_t* out; int ldc;
  __device__ __forceinline__ void operator()(const pg8::f32x4 (&acc)[2][2][4][2], const pg8::Unit& u, int wr, int wc, int fr, int fq) const {
    const int row0 = u.pm * 256 + wr * 64 + fr, col0 = u.pn * 256 + wc * 32 + 8 * fq;
#pragma unroll
    for (int ai = 0; ai < 2; ++ai)
#pragma unroll
      for (int m = 0; m < 4; ++m) { bf16_t* rowp = out + (size_t)(row0 + ai * 128 + m * 16) * ldc + col0;
#pragma unroll
        for (int bj = 0; bj < 2; ++bj) { const pg8::f32x4 v0 = acc[ai][bj][m][0], v1 = acc[ai][bj][m][1];
          pg8::u32x4 w; w.x = pg8::cvt_pk_bf16(v0[0], v0[1]); w.y = pg8::cvt_pk_bf16(v0[2], v0[3]); w.z = pg8::cvt_pk_bf16(v1[0], v1[1]); w.w = pg8::cvt_pk_bf16(v1[2], v1[3]);
          *(pg8::u32x4*)(rowp + bj * 128) = w; } }
  }
};
struct EpiRes {
  static constexpr bool PERM = false, AFTER_DRAIN = false;
  const float* xin; float* X; const float* gate;
  __device__ __forceinline__ void operator()(const pg8::f32x4 (&acc)[2][2][4][2], const pg8::Unit& u, int wr, int wc, int fr, int fq) const {
    const int row0 = u.pm * 256 + wr * 64 + fr, col0 = u.pn * 256 + wc * 32 + 4 * fq; const float* gb = gate + (size_t)((u.pm * 256) / S) * 6144;
    pg8::f32x4 gv[2][2];
#pragma unroll
    for (int bj = 0; bj < 2; ++bj)
#pragma unroll
      for (int n = 0; n < 2; ++n) gv[bj][n] = *(const pg8::f32x4*)(gb + col0 + bj * 128 + n * 16);
#pragma unroll
    for (int ai = 0; ai < 2; ++ai)
#pragma unroll
      for (int m = 0; m < 4; ++m) { const size_t off = (size_t)(row0 + ai * 128 + m * 16) * 1024 + col0;
#pragma unroll
        for (int bj = 0; bj < 2; ++bj)
#pragma unroll
          for (int n = 0; n < 2; ++n) { const pg8::f32x4 xi = *(const pg8::f32x4*)(xin + off + bj * 128 + n * 16); *(pg8::f32x4*)(X + off + bj * 128 + n * 16) = xi + gv[bj][n] * acc[ai][bj][m][n]; }
        asm volatile("" ::: "memory"); }
  }
};
template <class Epi> __device__ __forceinline__ void phase_gemm_fast(const bf16_t* A, const bf16_t* Bt, int M, int N, int K, const Epi& E, char* smem) {
  pg8::Gemm g; g.A = A; g.Bt = Bt; g.M = M; g.N = N; g.K = K;
  pg8::StaticOrder So; So.init(M, N, (int)gridDim.x, (int)blockIdx.x);
  pg8::gemm_phase<Epi, pg8::StaticOrder, false>((PG8_LAS unsigned char*)smem, g, So, E, nullptr);
}

__device__ void phase_convpool(const Params& p, char* smem) {
  const int tid = threadIdx.x;
  for (int job = blockIdx.x; job < T * 128 / NTHREADS; job += gridDim.x) {
    const int it = job * NTHREADS + tid, t = it >> 7, c0 = (it & 127) * 8, s = t & (S - 1);
    float a[8];
#pragma unroll
    for (int i = 0; i < 8; ++i) a[i] = p.conv_b[c0 + i];
#pragma unroll
    for (int j = 0; j < 5; ++j) { const int ss = s + j - 2; if (ss >= 0 && ss < S) { u32x4 w = *(const u32x4*)(p.ZQK + (size_t)(t + j - 2) * 1024 + c0); const float* cw = p.conv_w + j * 1024 + c0;
        a[0] += cw[0] * bflo(w.x); a[1] += cw[1] * bfhi(w.x); a[2] += cw[2] * bflo(w.y); a[3] += cw[3] * bfhi(w.y); a[4] += cw[4] * bflo(w.z); a[5] += cw[5] * bfhi(w.z); a[6] += cw[6] * bflo(w.w); a[7] += cw[7] * bfhi(w.w); } }
    const float sc = c0 >= 512 ? KSCALE : 1.f;
#pragma unroll
    for (int i = 0; i < 8; ++i) a[i] = siluf(a[i]) * sc;
    u32x4 o; o.x = pack2(a[0], a[1]); o.y = pack2(a[2], a[3]); o.z = pack2(a[4], a[5]); o.w = pack2(a[6], a[7]); *(u32x4*)(p.QK + (size_t)t * 1024 + c0) = o;
  }
  float* ys = (float*)smem;
  float* ws = ys + 64 * 128;
  for (int job = blockIdx.x; job < (T / 64) * 4; job += gridDim.x) {
    const int g = job & 3, t0 = (job >> 2) * 64, win = 2 << g;
    __syncthreads();
    for (int i = tid; i < 128 * 128; i += NTHREADS) ws[i] = p.pool_w[(size_t)g * 16384 + i];
    for (int i = tid; i < 64 * 128; i += NTHREADS) { const int tl = i >> 7, c = i & 127, t = t0 + tl, s = t & (S - 1); const int lo = max(s - win / 2, 0), hi = min(s + win / 2, S);
      float sum = 0.f; for (int q = lo; q < hi; ++q) sum += bf2f(p.ZP[(size_t)(t - s + q) * 512 + g * 128 + c]);
      ys[i] = sum / (float)(hi - lo) - bf2f(p.ZP[(size_t)t * 512 + g * 128 + c]); }
    __syncthreads();
    const int e = tid & 127, tq = tid >> 7; float acc[16];
#pragma unroll
    for (int i = 0; i < 16; ++i) acc[i] = 0.f;
    for (int c = 0; c < 128; ++c) { const float w = ws[c * 128 + e];
#pragma unroll
      for (int i = 0; i < 16; ++i) acc[i] += ys[(tq * 16 + i) * 128 + c] * w; }
    const float psc = p.pool_sc[g * 128 + e];
#pragma unroll
    for (int i = 0; i < 16; ++i) p.CAT[(size_t)(t0 + tq * 16 + i) * 1024 + 512 + g * 128 + e] = f2bf(acc[i] * psc);
  }
}

__device__ void phase_mlstm_naive(const Params& p, char* smem) {
  float* qs = (float*)smem; float* ks = qs + 128; float* nump = ks + 128; float* red = nump + 512;
  const int tid = threadIdx.x, j = tid & 127, qd = tid >> 7;
  for (int job = blockIdx.x; job < 64; job += gridDim.x) {
    const int dir = job >> 5, b = (job >> 2) & 7, h = job & 3;
    float C[32];
#pragma unroll
    for (int d = 0; d < 32; ++d) C[d] = 0.f;
    float n = 0.f, m = 0.f;
    for (int step = 0; step < S; ++step) { const int s = dir ? S - 1 - step : step; const size_t t = (size_t)b * S + s;
      const float li = p.gates[t * 16 + dir * 4 + h], gf = p.gates[t * 16 + 8 + dir * 4 + h];
      const float lf = fminf(gf, 0.f) - log1pf(__expf(-fabsf(gf)));
      __syncthreads();
      if (qd == 0) { qs[j] = bf2f(p.QK[t * 1024 + h * 128 + j]); ks[j] = bf2f(p.QK[t * 1024 + 512 + h * 128 + j]); }
      const float v = bf2f(p.ZV[t * 512 + h * 128 + j]);
      __syncthreads();
      const float mn = fmaxf(lf + m, li), ip = __expf(li - mn), fp = __expf(lf + m - mn); m = mn;
      float num = 0.f;
#pragma unroll
      for (int d = 0; d < 32; ++d) { C[d] = fp * C[d] + ip * ks[qd * 32 + d] * v; num += qs[qd * 32 + d] * C[d]; }
      float dp = 0.f; if (qd == 0) { n = fp * n + ip * ks[j]; dp = qs[j] * n; }
      nump[qd * 128 + j] = num;
      dp = wave_sum(dp); if ((tid & 63) == 0) red[tid >> 6] = dp;
      __syncthreads();
      if (qd == 0) { const float den = red[0] + red[1]; num = nump[j] + nump[128 + j] + nump[256 + j] + nump[384 + j];
        p.HS[((size_t)dir * T + t) * 512 + h * 128 + j] = f2bf(num / fmaxf(fabsf(den), __expf(-mn))); }
    }
    __syncthreads();
  }
}

namespace ml {
typedef short bf16x8 __attribute__((ext_vector_type(8)));
typedef short s16x4 __attribute__((ext_vector_type(4)));
typedef float f32x16 __attribute__((ext_vector_type(16)));
constexpr int RS = 272;
constexpr int OFF_Q = 0, OFF_K = 128 * RS, OFF_VT = 2 * 128 * RS, OFF_VW = OFF_VT + 34 * RS, OFF_CT = OFF_VW + 34 * RS, OFF_A = OFF_CT + 34 * RS;
constexpr int OFF_PA = OFF_A + 16384, OFF_MCH = OFF_PA + 16384, OFF_TAB = OFF_MCH + 512, OFF_DEN = OFF_TAB + 4096, OFF_END = OFF_DEN + 512;
static_assert(OFF_A % 16 == 0 && OFF_END <= SMEM_BYTES, "mlstm LDS layout");
__device__ __forceinline__ int crow(int r, int h) { return (r & 3) + 8 * (r >> 2) + 4 * h; }
__device__ __forceinline__ int spos(int s) { return (s & ~12) | ((s & 4) << 1) | ((s & 8) >> 1); }
#define ML_MFMA(a, b, c) __builtin_amdgcn_mfma_f32_32x32x16_bf16((a), (b), (c), 0, 0, 0)
__device__ __forceinline__ bf16x8 pack8(float x0, float x1, float x2, float x3, float x4, float x5, float x6, float x7) {
  u32x4 w; w.x = pack2(x0, x1); w.y = pack2(x2, x3); w.z = pack2(x4, x5); w.w = pack2(x6, x7); return __builtin_bit_cast(bf16x8, w);
}
__device__ __forceinline__ void tr_read2(unsigned a0, unsigned a1, s16x4& lo, s16x4& hi) {
  asm volatile("ds_read_b64_tr_b16 %0, %2\n\tds_read_b64_tr_b16 %1, %3\n\ts_waitcnt lgkmcnt(0)" : "=&v"(lo), "=&v"(hi) : "v"(a0), "v"(a1) : "memory");
}

__device__ void phase_mlstm(const Params& p, char* smem) {
  int tid_ = threadIdx.x; asm volatile("" : "+v"(tid_));
  const int tid = tid_, wid = tid >> 6, lane = tid & 63, l31 = lane & 31, hh = lane >> 5;
  float* const LA = (float*)(smem + OFF_A); float* const LPA = (float*)(smem + OFF_PA); float* const LM = (float*)(smem + OFF_MCH);
  float* const LTAB = (float*)(smem + OFF_TAB); float* const LDEN = (float*)(smem + OFF_DEN);
  const unsigned lds0 = (unsigned)(uintptr_t)smem;
  for (int job = blockIdx.x; job < 256; job += gridDim.x) {
    const int dvq = job & 3, h = (job >> 2) & 3, b = (job >> 4) & 7, dir = job >> 7;
    const float* gts = p.gates + (size_t)b * S * 16;
    const bf16_t* QKb = p.QK + (size_t)b * S * 1024 + h * 128; const bf16_t* ZVb = p.ZV + (size_t)b * S * 512 + h * 128 + dvq * 32;
    bf16_t* HSb = p.HS + ((size_t)dir * T + (size_t)b * S) * 512 + h * 128 + dvq * 32;
    __syncthreads();
    for (int i = tid; i < 3 * 34 * RS / 4; i += NTHREADS) ((u32*)(smem + OFF_VT))[i] = 0u;
    for (int cc = 0; cc < 4; ++cc) { const int c = wid * 4 + cc, tau0 = c * 128 + 2 * lane; const int tok0 = dir ? S - 1 - tau0 : tau0, tok1 = dir ? tok0 - 1 : tok0 + 1;
      const float li0 = gts[(size_t)tok0 * 16 + dir * 4 + h], gf0 = gts[(size_t)tok0 * 16 + 8 + dir * 4 + h], li1 = gts[(size_t)tok1 * 16 + dir * 4 + h], gf1 = gts[(size_t)tok1 * 16 + 8 + dir * 4 + h];
      const float lf0 = fminf(gf0, 0.f) - log1pf(__expf(-fabsf(gf0))), lf1 = fminf(gf1, 0.f) - log1pf(__expf(-fabsf(gf1)));
      const float pr = lf0 + lf1; float incl = pr;
#pragma unroll
      for (int o = 1; o < 64; o <<= 1) { const float v = __shfl_up(incl, o); if (lane >= o) incl += v; }
      const float b0 = incl - pr + lf0, b1 = b0 + lf1, a0 = li0 - b0, a1 = li1 - b1;
      float im = fmaxf(a0, a1);
#pragma unroll
      for (int o = 1; o < 64; o <<= 1) { const float v = __shfl_up(im, o); if (lane >= o) im = fmaxf(im, v); }
      float ex = __shfl_up(im, 1); if (lane == 0) ex = -INFINITY;
      const float pa0 = fmaxf(ex, a0), pa1 = fmaxf(pa0, a1);
      LA[tau0] = a0; LA[tau0 + 1] = a1; LPA[tau0] = pa0; LPA[tau0 + 1] = pa1; if (lane == 63) LM[64 + c] = b1; }
    __syncthreads();
    if (tid == 0) { float m = 0.f; for (int c = 0; c < 32; ++c) { LM[c] = m; m = LM[64 + c] + fmaxf(m, LPA[c * 128 + 127]); } LM[32] = m; }
    __syncthreads();
    u32x4 qreg[4], kreg[4], vreg;
#define ML_TOK(tau) (dir ? S - 1 - (tau) : (tau))
#define ML_LOAD(c) do { _Pragma("unroll") for (int i_ = 0; i_ < 4; ++i_) { const int tk_ = ML_TOK((c) * 128 + (tid >> 4) + 32 * i_); \
        qreg[i_] = *(const u32x4*)(QKb + (size_t)tk_ * 1024 + (tid & 15) * 8); kreg[i_] = *(const u32x4*)(QKb + (size_t)tk_ * 1024 + 512 + (tid & 15) * 8); } \
      { const int tk_ = ML_TOK((c) * 128 + (tid >> 2)); vreg = *(const u32x4*)(ZVb + (size_t)tk_ * 512 + (tid & 3) * 8); } } while (0)
#define ML_TABLES(c) do { if (tid < 128) { const int tau_ = (c) * 128 + tid, tk_ = ML_TOK(tau_); const float li_ = gts[(size_t)tk_ * 16 + dir * 4 + h], a_ = LA[tau_], mc_ = LM[(c)]; \
        const float Mj_ = fmaxf(mc_, LPA[tau_]), Me_ = fmaxf(mc_, LPA[(c) * 128 + 127]); float* tb_ = LTAB + ((c) & 1) * 512; \
        tb_[tid] = Mj_; tb_[128 + tid] = __expf(mc_ - Mj_); tb_[256 + tid] = __expf(-((li_ - a_) + Mj_)); tb_[384 + tid] = __expf(a_ - Me_); } } while (0)
#define ML_STORE(c) do { _Pragma("unroll") for (int i_ = 0; i_ < 4; ++i_) { const int row_ = (tid >> 4) + 32 * i_; \
        *(u32x4*)(smem + OFF_Q + row_ * RS + (tid & 15) * 16) = qreg[i_]; *(u32x4*)(smem + OFF_K + row_ * RS + (tid & 15) * 16) = kreg[i_]; } \
      { const int s_ = tid >> 2, ps_ = spos(s_) * 2; const float we_ = LTAB[((c) & 1) * 512 + 384 + s_]; const u32 vw_[4] = {vreg.x, vreg.y, vreg.z, vreg.w}; \
        _Pragma("unroll") for (int i_ = 0; i_ < 4; ++i_) { const int r0_ = ((tid & 3) * 8 + 2 * i_) * RS + ps_; \
          *(bf16_t*)(smem + OFF_VT + r0_) = (bf16_t)(vw_[i_] & 0xFFFFu); *(bf16_t*)(smem + OFF_VT + r0_ + RS) = (bf16_t)(vw_[i_] >> 16); \
          *(bf16_t*)(smem + OFF_VW + r0_) = f2bf(bflo(vw_[i_]) * we_); *(bf16_t*)(smem + OFF_VW + r0_ + RS) = f2bf(bfhi(vw_[i_]) * we_); } } \
      if (tid < 128) { const int ps_ = spos(tid) * 2; *(bf16_t*)(smem + OFF_VT + 32 * RS + ps_) = (bf16_t)0x3F80u; *(bf16_t*)(smem + OFF_VW + 32 * RS + ps_) = f2bf(LTAB[((c) & 1) * 512 + 384 + tid]); } } while (0)
    ML_LOAD(0); ML_TABLES(0);
    __syncthreads();
    ML_STORE(0);
    __syncthreads();
    f32x16 Cacc;
#pragma unroll
    for (int r = 0; r < 16; ++r) Cacc[r] = 0.f;
    for (int c = 0; c < 32; ++c) {
      int tidc_ = threadIdx.x; asm volatile("" : "+v"(tidc_));
      const int tid = tidc_, wid = tid >> 6, lane = tid & 63, l31 = lane & 31, hh = lane >> 5;
      const int t2 = wid >> 1, nt = wid & 1, brow = min(nt * 32 + l31, 33);
      if (c + 1 < 32) { ML_LOAD(c + 1); ML_TABLES(c + 1); }
      const float* tab = LTAB + (c & 1) * 512;
      f32x16 acc;
#pragma unroll
      for (int r = 0; r < 16; ++r) acc[r] = 0.f;
      const char* qa = smem + OFF_Q + (t2 * 32 + l31) * RS + hh * 16;
      { const char* cb = smem + OFF_CT + brow * RS + hh * 16;
#pragma unroll
        for (int ks = 0; ks < 8; ++ks) acc = ML_MFMA(*(const bf16x8*)(qa + ks * 32), *(const bf16x8*)(cb + ks * 32), acc); }
#pragma unroll
      for (int r = 0; r < 16; ++r) acc[r] *= tab[128 + t2 * 32 + crow(r, hh)];
      const float Mj = tab[t2 * 32 + l31];
      for (int si = 0; si <= t2; ++si) {
        f32x16 X;
#pragma unroll
        for (int r = 0; r < 16; ++r) X[r] = 0.f;
        const char* ka = smem + OFF_K + (si * 32 + l31) * RS + hh * 16;
#pragma unroll
        for (int ks = 0; ks < 8; ++ks) X = ML_MFMA(*(const bf16x8*)(ka + ks * 32), *(const bf16x8*)(qa + ks * 32), X);
        const float* Ac = LA + c * 128 + si * 32;
#pragma unroll
        for (int r = 0; r < 16; ++r) { const int sl = crow(r, hh); float w = __expf(Ac[sl] - Mj); if (si == t2 && sl > l31) w = 0.f; X[r] *= w; }
        const bf16x8 f0 = pack8(X[0], X[1], X[2], X[3], X[4], X[5], X[6], X[7]), f1 = pack8(X[8], X[9], X[10], X[11], X[12], X[13], X[14], X[15]);
        const char* vb = smem + OFF_VT + brow * RS + si * 64 + hh * 16;
        acc = ML_MFMA(f0, *(const bf16x8*)(vb), acc); acc = ML_MFMA(f1, *(const bf16x8*)(vb + 32), acc);
      }
      if (nt == 1 && l31 == 0) {
#pragma unroll
        for (int r = 0; r < 16; ++r) LDEN[t2 * 32 + crow(r, hh)] = acc[r]; }
      { const float mc = LM[c], decay = __expf(mc - fmaxf(mc, LPA[c * 128 + 127]));
#pragma unroll
        for (int r = 0; r < 16; ++r) Cacc[r] *= decay;
        const unsigned ta = lds0 + OFF_K + ((lane & 15) >> 2) * RS + (t2 * 32 + 16 * ((lane >> 4) & 1) + 4 * (lane & 3)) * 2 + 4 * hh * RS;
        const char* wb = smem + OFF_VW + brow * RS + hh * 16;
#pragma unroll
        for (int ks = 0; ks < 8; ++ks) { s16x4 lo, hi; tr_read2(ta + 16 * ks * RS, ta + (16 * ks + 8) * RS, lo, hi); __builtin_amdgcn_sched_barrier(0);
          const bf16x8 a = (bf16x8){lo[0], lo[1], lo[2], lo[3], hi[0], hi[1], hi[2], hi[3]};
          Cacc = ML_MFMA(a, *(const bf16x8*)(wb + ks * 32), Cacc); } }
      __syncthreads();
      if (nt == 0) {
#pragma unroll
        for (int r = 0; r < 16; ++r) { const int j = t2 * 32 + crow(r, hh); const float dn = LDEN[j], nr = tab[256 + j]; const int tk = ML_TOK(c * 128 + j);
          HSb[(size_t)tk * 512 + l31] = f2bf(acc[r] / fmaxf(fabsf(dn), nr)); } }
      if (nt * 32 + l31 <= 32) { char* cw = smem + OFF_CT + (nt * 32 + l31) * RS + (t2 * 32 + 4 * hh) * 2;
#pragma unroll
        for (int g = 0; g < 4; ++g) { u32x2 w; w.x = pack2(Cacc[4 * g], Cacc[4 * g + 1]); w.y = pack2(Cacc[4 * g + 2], Cacc[4 * g + 3]); *(u32x2*)(cw + 16 * g) = w; } }
      if (c + 1 < 32) ML_STORE(c + 1);
      __syncthreads();
    }
#undef ML_TOK
#undef ML_LOAD
#undef ML_TABLES
#undef ML_STORE
  }
}
}

__device__ void phase_cat(const Params& p) {
  const int tid = threadIdx.x, wid = tid >> 6, lane = tid & 63;
  for (int job = blockIdx.x; job < T * 4 / 8; job += gridDim.x) {
    const int w = job * 8 + wid, t = w >> 2, h = w & 3; const size_t o = (size_t)t * 512 + h * 128 + lane * 2;
    const u32 a = *(const u32*)(p.HS + o), b = *(const u32*)(p.HS + (size_t)T * 512 + o), so = *(const u32*)(p.ZO + o);
    const float a0 = bflo(a) + bflo(b), a1 = bfhi(a) + bfhi(b); const float r = rsqrtf(wave_sum(a0 * a0 + a1 * a1) * (1.f / 128.f) + EPS);
    *(u32*)(p.CAT + (size_t)t * 1024 + h * 128 + lane * 2) = pack2(a0 * r * p.mnorm_g[h * 128 + lane * 2] * bflo(so), a1 * r * p.mnorm_g[h * 128 + lane * 2 + 1] * bfhi(so));
  }
}

__device__ void phase_peer_select_naive(const Params& p, int layer, char* smem) {
  float* kl = (float*)smem;
  float* qsh = kl + 2 * 128 * 129;
  const int tid = threadIdx.x, wid = tid >> 6, lane = tid & 63; float* qs = qsh + wid * 128;
  __syncthreads();
  for (int i = tid; i < 2 * 128 * 128; i += NTHREADS) kl[(i >> 7) * 129 + (i & 127)] = p.peer_keys[(size_t)layer * 32768 + i];
  __syncthreads();
  for (int job = blockIdx.x; job < T; job += gridDim.x) {
    const int t = job, h = wid;
    float ts[2][16]; int ti[2][16];
#pragma unroll
    for (int pp = 0; pp < 2; ++pp) {
      const bf16_t* q = p.QP + (size_t)t * 2048 + h * 256 + pp * 128; const float q0 = bf2f(q[lane]), q1 = bf2f(q[lane + 64]);
      const float r = rsqrtf(wave_sum(q0 * q0 + q1 * q1) * (1.f / 128.f) + EPS); qs[lane] = q0 * r; qs[lane + 64] = q1 * r;
      float s0 = 0.f, s1 = 0.f; const float* k0 = kl + (pp * 128 + lane) * 129; const float* k1 = k0 + 64 * 129;
      for (int c = 0; c < 128; ++c) { const float qc = qs[c]; s0 += qc * k0[c]; s1 += qc * k1[c]; }
#pragma unroll
      for (int k = 0; k < 16; ++k) { const float mx = wave_max(fmaxf(s0, s1)); int cand = (s0 == mx) ? lane : ((s1 == mx) ? lane + 64 : 9999);
        for (int o = 32; o >= 1; o >>= 1) cand = min(cand, __shfl_xor(cand, o));
        ts[pp][k] = mx; ti[pp][k] = cand; if (cand == lane) s0 = -INFINITY; if (cand == lane + 64) s1 = -INFINITY; }
    }
    float cs[4];
#pragma unroll
    for (int r = 0; r < 4; ++r) { const int c = lane * 4 + r; float va = 0.f, vb = 0.f;
#pragma unroll
      for (int k = 0; k < 16; ++k) { if (k == (c >> 4)) va = ts[0][k]; if (k == (c & 15)) vb = ts[1][k]; }
      cs[r] = va + vb; }
    float top[16]; int tix[16];
#pragma unroll
    for (int k = 0; k < 16; ++k) { const float mx = wave_max(fmaxf(fmaxf(cs[0], cs[1]), fmaxf(cs[2], cs[3]))); int cand = 9999;
#pragma unroll
      for (int r = 3; r >= 0; --r) if (cs[r] == mx) cand = lane * 4 + r;
      for (int o = 32; o >= 1; o >>= 1) cand = min(cand, __shfl_xor(cand, o));
      top[k] = mx; tix[k] = cand;
#pragma unroll
      for (int r = 0; r < 4; ++r) if (cand == lane * 4 + r) cs[r] = -INFINITY; }
    float sum = 0.f;
#pragma unroll
    for (int k = 0; k < 16; ++k) sum += __expf(top[k] - top[0]);
    if (lane < 16) { float tv = 0.f; int tc = 0;
#pragma unroll
      for (int k = 0; k < 16; ++k) if (k == lane) { tv = top[k]; tc = tix[k]; }
      int ia = 0, ib = 0;
#pragma unroll
      for (int k = 0; k < 16; ++k) { if (k == (tc >> 4)) ia = ti[0][k]; if (k == (tc & 15)) ib = ti[1][k]; }
      p.pidx[((size_t)t * 8 + h) * 16 + lane] = (bf16_t)(ia * 128 + ib); p.pgate[((size_t)t * 8 + h) * 16 + lane] = __expf(tv - top[0]) / sum; }
  }
}

namespace sel {
typedef short bf16x8 __attribute__((ext_vector_type(8)));
typedef float f32x16 __attribute__((ext_vector_type(16)));
constexpr int RS = 272, OFF_W = 2 * 128 * RS, WB = 3 * 16 * 32 * 4;
static_assert(OFF_W + 8 * WB <= SMEM_BYTES, "select LDS layout");
constexpr float NEG = -3.0e38f;
__device__ __forceinline__ float max3(float a, float b, float c) { return fmaxf(fmaxf(a, b), c); }
__device__ __forceinline__ float xhalf(float v) { return __shfl_xor(v, 32); }

__device__ void phase_peer_select(const Params& p, int layer, char* smem) {
  const int tid0 = threadIdx.x;
  __syncthreads();
  { const bf16_t* kb = p.keysb + (size_t)layer * 32768;
    for (int i = tid0; i < 2 * 128 * 16; i += NTHREADS) { const int row = i >> 4, ch = i & 15; *(u32x4*)(smem + row * RS + ch * 16) = *(const u32x4*)(kb + (size_t)row * 128 + ch * 8); } }
  __syncthreads();
  for (int job = blockIdx.x; job < T / 32; job += gridDim.x) {
    int tid_ = threadIdx.x; asm volatile("" : "+v"(tid_));
    const int tid = tid_, wid = tid >> 6, lane = tid & 63, l31 = lane & 31, hh = lane >> 5, h = wid;
    const int t = job * 32 + l31;
    float* const wl = (float*)(smem + OFF_W + wid * WB);
    float rs[2];
#pragma unroll
    for (int pp = 0; pp < 2; ++pp) {
      const bf16_t* qrow = p.QP + (size_t)t * 2048 + h * 256 + pp * 128 + hh * 8;
      bf16x8 bq[8]; float ssq = 0.f;
#pragma unroll
      for (int ks = 0; ks < 8; ++ks) { const u32x4 w = *(const u32x4*)(qrow + ks * 16); bq[ks] = __builtin_bit_cast(bf16x8, w);
        const u32 w0 = w.x, w1 = w.y, w2 = w.z, w3 = w.w; ssq = dot2bf(w0, w0, ssq); ssq = dot2bf(w1, w1, ssq); ssq = dot2bf(w2, w2, ssq); ssq = dot2bf(w3, w3, ssq); }
      ssq += xhalf(ssq); rs[pp] = rsqrtf(ssq * (1.f / 128.f) + EPS);
      f32x16 X[4];
#pragma unroll
      for (int nt = 0; nt < 4; ++nt) {
#pragma unroll
        for (int r = 0; r < 16; ++r) X[nt][r] = 0.f;
        const char* ka = smem + (pp * 128 + nt * 32 + l31) * RS + hh * 16;
#pragma unroll
        for (int ks = 0; ks < 8; ++ks) X[nt] = __builtin_amdgcn_mfma_f32_32x32x16_bf16(*(const bf16x8*)(ka + ks * 32), bq[ks], X[nt], 0, 0, 0); }
#pragma unroll
      for (int nt = 0; nt < 4; ++nt)
#pragma unroll
        for (int r = 0; r < 16; ++r) X[nt][r] = __uint_as_float((__float_as_uint(X[nt][r]) & ~0x7Fu) | (u32)(nt * 32 + (r & 3) + 8 * (r >> 2)) | ((u32)hh << 2));
#pragma unroll 1
      for (int k = 0; k < 16; ++k) {
        float m = NEG;
#pragma unroll
        for (int nt = 0; nt < 4; ++nt)
#pragma unroll
          for (int r = 0; r < 16; r += 2) m = max3(m, X[nt][r], X[nt][r + 1]);
        const float M = fmaxf(m, xhalf(m));
        wl[(pp * 16 + k) * 32 + l31] = M;
#pragma unroll
        for (int nt = 0; nt < 4; ++nt)
#pragma unroll
          for (int r = 0; r < 16; ++r) X[nt][r] = (X[nt][r] == M) ? NEG : X[nt][r];
      }
    }
    float s1[16], s2[16];
#pragma unroll
    for (int k = 0; k < 16; ++k) { s1[k] = wl[k * 32 + l31] * rs[0]; s2[k] = wl[(16 + k) * 32 + l31] * rs[1]; }
    constexpr int A0[25] = {0, 0, 0, 0, 0, 0, 0, 0, 0, 0, 0, 0, 0, 0, 0, 0, 2, 2, 2, 2, 2, 3, 3, 3, 3}, B0[25] = {0, 1, 2, 3, 4, 5, 6, 7, 8, 9, 10, 11, 12, 13, 14, 15, 0, 1, 2, 3, 4, 0, 1, 2, 3};
    constexpr int A1[25] = {1, 1, 1, 1, 1, 1, 1, 1, 4, 4, 4, 5, 5, 6, 6, 7, 7, 8, 9, 10, 11, 12, 13, 14, 15}, B1[25] = {0, 1, 2, 3, 4, 5, 6, 7, 0, 1, 2, 0, 1, 0, 1, 0, 1, 0, 0, 0, 0, 0, 0, 0, 0};
    float cd[25];
#pragma unroll
    for (int i = 0; i < 25; ++i) { const float v0 = s1[A0[i]] + s2[B0[i]], v1 = s1[A1[i]] + s2[B1[i]]; const float v = hh ? v1 : v0; const u32 cid = hh ? (u32)(A1[i] * 16 + B1[i]) : (u32)(A0[i] * 16 + B0[i]);
      cd[i] = __uint_as_float((__float_as_uint(v) & ~0xFFu) | cid); }
#pragma unroll 1
    for (int k = 0; k < 16; ++k) {
      float m = cd[24];
#pragma unroll
      for (int i = 0; i < 24; i += 2) m = max3(m, cd[i], cd[i + 1]);
      const float M = fmaxf(m, xhalf(m));
      wl[(32 + k) * 32 + l31] = M;
#pragma unroll
      for (int i = 0; i < 25; ++i) cd[i] = (cd[i] == M) ? NEG : cd[i];
    }
    float tv[16];
#pragma unroll
    for (int k = 0; k < 16; ++k) tv[k] = wl[(32 + k) * 32 + l31];
    float sum = 0.f;
#pragma unroll
    for (int k = 0; k < 16; ++k) sum += __expf(tv[k] - tv[0]);
    const float inv = 1.f / sum;
    u32 ev[8]; float go[8];
#pragma unroll
    for (int q = 0; q < 8; ++q) { const float v = wl[(32 + hh * 8 + q) * 32 + l31]; const u32 cid = __float_as_uint(v) & 0xFFu;
      const u32 i1 = __float_as_uint(wl[(cid >> 4) * 32 + l31]) & 0x7Fu, i2 = __float_as_uint(wl[(16 + (cid & 15)) * 32 + l31]) & 0x7Fu; ev[q] = i1 * 128 + i2;
      go[q] = __expf(v - tv[0]) * inv; }
    const u32 io0 = ev[0] | (ev[1] << 16), io1 = ev[2] | (ev[3] << 16), io2 = ev[4] | (ev[5] << 16), io3 = ev[6] | (ev[7] << 16);
    const size_t ob = ((size_t)t * 8 + h) * 16 + hh * 8;
    *(u32x4*)(p.pidx + ob) = (u32x4){io0, io1, io2, io3};
    *(f32x4*)(p.pgate + ob) = (f32x4){go[0], go[1], go[2], go[3]}; *(f32x4*)(p.pgate + ob + 4) = (f32x4){go[4], go[5], go[6], go[7]};
  }
}
}

typedef float f32x2 __attribute__((ext_vector_type(2)));
constexpr float U8_SCALE = 32.f, V8_SCALE = 2.f;
__device__ __forceinline__ float gelu_erf(float z) { return 0.5f * z * (1.f + erff(z * 0.70710678118654752f)); }
__device__ __forceinline__ float reduce8(float d0, float d1, float d2, float d3, float d4, float d5, float d6, float d7, int lane) {
  float e[4];
  { auto r0 = __builtin_amdgcn_permlane32_swap(__float_as_uint(d0), __float_as_uint(d4), false, false); e[0] = __uint_as_float(r0[0]) + __uint_as_float(r0[1]);
    auto r1 = __builtin_amdgcn_permlane32_swap(__float_as_uint(d1), __float_as_uint(d5), false, false); e[1] = __uint_as_float(r1[0]) + __uint_as_float(r1[1]);
    auto r2 = __builtin_amdgcn_permlane32_swap(__float_as_uint(d2), __float_as_uint(d6), false, false); e[2] = __uint_as_float(r2[0]) + __uint_as_float(r2[1]);
    auto r3 = __builtin_amdgcn_permlane32_swap(__float_as_uint(d3), __float_as_uint(d7), false, false); e[3] = __uint_as_float(r3[0]) + __uint_as_float(r3[1]); }
  float f0, f1;
  { auto r0 = __builtin_amdgcn_permlane16_swap(__float_as_uint(e[0]), __float_as_uint(e[2]), false, false); f0 = __uint_as_float(r0[0]) + __uint_as_float(r0[1]);
    auto r1 = __builtin_amdgcn_permlane16_swap(__float_as_uint(e[1]), __float_as_uint(e[3]), false, false); f1 = __uint_as_float(r1[0]) + __uint_as_float(r1[1]); }
  const bool up = (lane & 8) != 0; const float keep = up ? f1 : f0, send = up ? f0 : f1;
  float g = keep + __shfl_xor(send, 8);
  g += __shfl_xor(g, 4); g += __shfl_xor(g, 2); g += __shfl_xor(g, 1);
  return g;
}
template <int NEXT, bool DRY = false>
__device__ void phase_peer_gather(const Params& p, int layer) {
  const unsigned char* U8 = p.U8 + (size_t)layer * 16384 * 1024; const unsigned char* V8 = p.V8 + (size_t)layer * 16384 * 1024;
  for (int job = blockIdx.x; job < T / 8; job += gridDim.x) {
    int tid_ = threadIdx.x; asm volatile("" : "+v"(tid_));
    const int tid = tid_, wid = tid >> 6, lane = tid & 63;
    const int t = job * 8 + wid, b = t / S;
    const int vidx = 4 * (lane >> 5) + 2 * ((lane >> 4) & 1) + ((lane >> 3) & 1);
    const u32x4 h0 = *(const u32x4*)(p.H + (size_t)t * D + lane * 16), h1 = *(const u32x4*)(p.H + (size_t)t * D + lane * 16 + 8);
    const u32 hx[8] = {h0.x, h0.y, h0.z, h0.w, h1.x, h1.y, h1.z, h1.w};
    f32x2 acc[8];
#pragma unroll
    for (int i = 0; i < 8; ++i) acc[i] = (f32x2){0.f, 0.f};
#pragma unroll 1
    for (int hb = 0; hb < 16; ++hb) {
      const int myidx = (int)p.pidx[(size_t)t * 128 + hb * 8 + (lane & 7)];
      const float mygate = p.pgate[(size_t)t * 128 + hb * 8 + vidx];
      u32x4 ur[8], vr[8];
#pragma unroll
      for (int k = 0; k < 8; ++k) { const int e = __builtin_amdgcn_readlane(myidx, k); ur[k] = *(const u32x4*)(U8 + (size_t)e * 1024 + lane * 16); vr[k] = *(const u32x4*)(V8 + (size_t)e * 1024 + lane * 16); }
      float d[8];
#pragma unroll
      for (int k = 0; k < 8; ++k) { const u32 w[4] = {ur[k].x, ur[k].y, ur[k].z, ur[k].w}; float a = 0.f;
#pragma unroll
        for (int j = 0; j < 4; ++j) { const u32 lo = __builtin_bit_cast(u32, __builtin_amdgcn_cvt_scalef32_pk_bf16_fp8(w[j], 1.0f, false)), hi = __builtin_bit_cast(u32, __builtin_amdgcn_cvt_scalef32_pk_bf16_fp8(w[j], 1.0f, true));
          a = dot2bf(lo, hx[2 * j], a); a = dot2bf(hi, hx[2 * j + 1], a); }
        d[k] = a; }
      const float z = reduce8(d[0], d[1], d[2], d[3], d[4], d[5], d[6], d[7], lane) * (1.f / U8_SCALE);
      const float cf = mygate * gelu_erf(z) * (1.f / V8_SCALE);
#pragma unroll
      for (int k = 0; k < 8; ++k) { const float ck = __uint_as_float(__builtin_amdgcn_readlane(__float_as_uint(cf), 32 * (k >> 2) + 16 * ((k >> 1) & 1) + 8 * (k & 1)));
        const u32 w[4] = {vr[k].x, vr[k].y, vr[k].z, vr[k].w}; const f32x2 c2 = (f32x2){ck, ck};
#pragma unroll
        for (int j = 0; j < 4; ++j) { const f32x2 lo = __builtin_amdgcn_cvt_pk_f32_fp8((int)w[j], false), hi = __builtin_amdgcn_cvt_pk_f32_fp8((int)w[j], true);
          acc[2 * j] = lo * c2 + acc[2 * j]; acc[2 * j + 1] = hi * c2 + acc[2 * j + 1]; } }
    }
    const float* g2 = p.mod + (size_t)(layer * 8 + b) * 6144 + 5120 + lane * 16; float* xp = p.X + (size_t)t * D + lane * 16;
    float xv[16]; float ss = 0.f;
#pragma unroll
    for (int q = 0; q < 4; ++q) { const f32x4 x0 = *(const f32x4*)(xp + 4 * q), g0 = *(const f32x4*)(g2 + 4 * q);
      xv[4 * q + 0] = x0.x + g0.x * acc[2 * q].x; xv[4 * q + 1] = x0.y + g0.y * acc[2 * q].y; xv[4 * q + 2] = x0.z + g0.z * acc[2 * q + 1].x; xv[4 * q + 3] = x0.w + g0.w * acc[2 * q + 1].y; }
#pragma unroll
    for (int i = 0; i < 16; ++i) ss += xv[i] * xv[i];
    ss = wave_sum(ss); const float r = rsqrtf(ss * (1.f / D) + EPS);
    if (DRY && ss != -1.2345f) continue;
    if (NEXT == 0) {
      const float* ml = p.mod + (size_t)((layer + 1) * 8 + b) * 6144 + lane * 16; const float* gn = p.nmg + (layer + 1) * D + lane * 16; float y[16];
#pragma unroll
      for (int i = 0; i < 16; ++i) y[i] = xv[i] * r * gn[i] * (1.f + ml[1024 + i]) + ml[i];
#pragma unroll
      for (int q = 0; q < 4; ++q) *(f32x4*)(xp + 4 * q) = (f32x4){xv[4 * q], xv[4 * q + 1], xv[4 * q + 2], xv[4 * q + 3]};
      u32x4 w0, w1; w0.x = pack2(y[0], y[1]); w0.y = pack2(y[2], y[3]); w0.z = pack2(y[4], y[5]); w0.w = pack2(y[6], y[7]); w1.x = pack2(y[8], y[9]); w1.y = pack2(y[10], y[11]); w1.z = pack2(y[12], y[13]); w1.w = pack2(y[14], y[15]);
      *(u32x4*)(p.H + (size_t)t * D + lane * 16) = w0; *(u32x4*)(p.H + (size_t)t * D + lane * 16 + 8) = w1;
    } else {
      const float* fg = p.final_g + lane * 16;
#pragma unroll
      for (int q = 0; q < 4; ++q) *(f32x4*)(xp + 4 * q) = (f32x4){xv[4 * q] * r * fg[4 * q], xv[4 * q + 1] * r * fg[4 * q + 1], xv[4 * q + 2] * r * fg[4 * q + 2], xv[4 * q + 3] * r * fg[4 * q + 3]};
    }
  }
}

__device__ void phase_qkrope(const Params& p) {
  const int tid = threadIdx.x, wid = tid >> 6, lane = tid & 63;
  for (int job = blockIdx.x; job < T * 12 / 8; job += gridDim.x) {
    const int w = job * 8 + wid, t = w / 12, hh = w % 12, b = t / S, s = t & (S - 1);
    const u32 raw = *(const u32*)(p.QKV + (size_t)t * 1536 + hh * 128 + lane * 2); float x0 = bflo(raw), x1 = bfhi(raw);
    if (hh < 10) { const float* g = hh < 8 ? p.qn_g : p.kn_g; const float r = rsqrtf(wave_sum(x0 * x0 + x1 * x1) * (1.f / 128.f) + EPS); x0 *= r * g[2 * lane]; x1 *= r * g[2 * lane + 1];
      const int pos = lane < 32 ? (s >> 6) : (s & 63); const int fi = lane & 31; const float fr = exp2f(-(float)(2 * fi) * (13.287712379549449f / 64.f)); const float ang = (float)pos * fr;
      float sn, cs; sincosf(ang, &sn, &cs); const float y0 = x0 * cs - x1 * sn, y1 = x0 * sn + x1 * cs; x0 = y0; x1 = y1; }
    bf16_t* dst = hh < 8 ? p.Qh + (((size_t)b * 8 + hh) * S + s) * 128 : (hh < 10 ? p.Kh + (((size_t)b * 2 + hh - 8) * S + s) * 128 : p.Vh + (((size_t)b * 2 + hh - 10) * S + s) * 128);
    *(u32*)(dst + lane * 2) = pack2(x0, x1);
  }
}

__device__ void phase_attn_naive(const Params& p) {
  const int tid = threadIdx.x, wid = tid >> 6, lane = tid & 63;
  for (int job = blockIdx.x; job < T * 2 / 8; job += gridDim.x) {
    const int w = job * 8 + wid, kv = w & 1, t = w >> 1, b = t / S, s = t & (S - 1);
    float q0[4], q1[4], m[4], l[4], o0[4], o1[4];
#pragma unroll
    for (int g = 0; g < 4; ++g) { const u32 qq = *(const u32*)(p.Qh + (((size_t)b * 8 + kv * 4 + g) * S + s) * 128 + lane * 2); q0[g] = bflo(qq); q1[g] = bfhi(qq); m[g] = -1e30f; l[g] = 0.f; o0[g] = 0.f; o1[g] = 0.f; }
    const bf16_t* Kb = p.Kh + ((size_t)b * 2 + kv) * S * 128; const bf16_t* Vb = p.Vh + ((size_t)b * 2 + kv) * S * 128;
    for (int k = 0; k < S; ++k) { const u32 kk = *(const u32*)(Kb + (size_t)k * 128 + lane * 2), vv = *(const u32*)(Vb + (size_t)k * 128 + lane * 2);
      const float k0 = bflo(kk), k1 = bfhi(kk), v0 = bflo(vv), v1 = bfhi(vv);
#pragma unroll
      for (int g = 0; g < 4; ++g) { const float sc = wave_sum(q0[g] * k0 + q1[g] * k1) * KSCALE; const float mn = fmaxf(m[g], sc), al = __expf(m[g] - mn), pw = __expf(sc - mn);
        l[g] = l[g] * al + pw; o0[g] = o0[g] * al + pw * v0; o1[g] = o1[g] * al + pw * v1; m[g] = mn; } }
#pragma unroll
    for (int g = 0; g < 4; ++g) *(u32*)(p.CAT + (size_t)t * 1024 + (kv * 4 + g) * 128 + lane * 2) = pack2(o0[g] / l[g], o1[g] / l[g]);
  }
}

namespace att {
using bf16 = unsigned short;
constexpr int   D = 128, NW = 8, QBLK = 32, KVBLK = 64;
constexpr float SCALE = 0.088388347648318440f;
constexpr float THR = 8.f;
constexpr int SDEPTH = 2;
constexpr int LDQ = 128, LDK = 128, LDO = 1024;
constexpr size_t SHM_V = KVBLK * D * 2, SHM_K = KVBLK * D * 2, SHM_ATTN = 2 * SHM_V + 2 * SHM_K + NW * 64 * 4;
using bf16x8 = __attribute__((ext_vector_type(8))) short;
using s16x4  = __attribute__((ext_vector_type(4))) short;
using f32x16 = __attribute__((ext_vector_type(16))) float;
using f32x8  = __attribute__((ext_vector_type(8))) float;
using u32x4  = __attribute__((ext_vector_type(4))) unsigned;
#define KSWZ(row, colB) ((row) * 256 + ((colB) ^ (((row) & 7) << 4)))
#define SBAR() __builtin_amdgcn_sched_barrier(0)
__device__ __forceinline__ int crow(int r, int hi) { return (r & 3) + 8 * (r >> 2) + 4 * hi; }
__device__ __forceinline__ unsigned cvtpk(float lo, float hi) {
  unsigned r; asm volatile("v_cvt_pk_bf16_f32 %0, %1, %2" : "=v"(r) : "v"(lo), "v"(hi)); return r;
}
template <typename TIn> struct Stage;
template <> struct Stage<bf16>  { using T = bf16x8;
  __device__ static __forceinline__ T ld8(const bf16* p) { return *reinterpret_cast<const bf16x8*>(p); }
  __device__ static __forceinline__ bf16x8 tobf(T x) { return x; } };
template <> struct Stage<float> { using T = f32x8;
  __device__ static __forceinline__ T ld8(const float* p) { return *reinterpret_cast<const f32x8*>(p); }
  __device__ static __forceinline__ bf16x8 tobf(T x) {
    u32x4 w = {cvtpk(x[0], x[1]), cvtpk(x[2], x[3]), cvtpk(x[4], x[5]), cvtpk(x[6], x[7])}; return *reinterpret_cast<bf16x8*>(&w); } };

__device__ __forceinline__ void partialSM(f32x16& p0, f32x16& p1, float& m_reg, float& mn, float& alpha) {
  constexpr float C = SCALE * 1.4426950408889634f;
  float pmax = p0[0]; for (int r = 1; r < 16; ++r) pmax = fmaxf(pmax, p0[r]); for (int r = 0; r < 16; ++r) pmax = fmaxf(pmax, p1[r]);
  { auto rr = __builtin_amdgcn_permlane32_swap(__float_as_uint(pmax), __float_as_uint(pmax), false, false);
    pmax = fmaxf(__uint_as_float(rr[0]), __uint_as_float(rr[1])); }
  if (__builtin_expect(__all(pmax - m_reg <= THR / SCALE), 1)) { mn = m_reg; alpha = 1.f; }
  else { mn = fmaxf(m_reg, pmax); alpha = __builtin_amdgcn_exp2f((m_reg - mn) * C); m_reg = mn; }
  float mnC = -mn * C;
  for (int r = 0; r < 16; ++r) p0[r] = fmaf(p0[r], C, mnC); for (int r = 0; r < 16; ++r) p1[r] = fmaf(p1[r], C, mnC);
  for (int r = 0; r < 16; ++r) p0[r] = __builtin_amdgcn_exp2f(p0[r]);
}
__device__ __forceinline__ void finishSM(f32x16& p0, f32x16& p1, float alpha, float& l_reg, bf16x8& pa0, bf16x8& pa1, bf16x8& pa2, bf16x8& pa3) {
  for (int r = 0; r < 16; ++r) p1[r] = __builtin_amdgcn_exp2f(p1[r]);
  float ps = 0; for (int r = 0; r < 16; ++r) ps += p0[r]; for (int r = 0; r < 16; ++r) ps += p1[r];
  { auto rr = __builtin_amdgcn_permlane32_swap(__float_as_uint(ps), __float_as_uint(ps), false, false);
    ps = __uint_as_float(rr[0]) + __uint_as_float(rr[1]); }
  l_reg = l_reg * alpha + ps;
#define PK4(P, BASE, OUT) do { unsigned a0 = cvtpk(P[BASE + 0], P[BASE + 1]), a1 = cvtpk(P[BASE + 2], P[BASE + 3]);   \
    unsigned b0 = cvtpk(P[BASE + 4], P[BASE + 5]), b1 = cvtpk(P[BASE + 6], P[BASE + 7]);                              \
    auto r0 = __builtin_amdgcn_permlane32_swap(a0, b0, false, false); auto r1 = __builtin_amdgcn_permlane32_swap(a1, b1, false, false); \
    u32x4 w = {r0[0], r1[0], r0[1], r1[1]}; OUT = *reinterpret_cast<bf16x8*>(&w); } while (0)
  PK4(p0, 0, pa0); PK4(p0, 8, pa1); PK4(p1, 0, pa2); PK4(p1, 8, pa3);
#undef PK4
}
__device__ __forceinline__ void qkt(f32x16& p0, f32x16& p1, const bf16* Ks, const bf16x8* qr, int r32, int hi) {
  p0 = f32x16{}; p1 = f32x16{};
  for (int d0 = 0; d0 < 8; ++d0) { int cb = (d0 * 16 + hi * 8) * 2;
    bf16x8 b0 = *reinterpret_cast<const bf16x8*>((const char*)Ks + KSWZ(r32, cb));
    bf16x8 b1 = *reinterpret_cast<const bf16x8*>((const char*)Ks + KSWZ(32 + r32, cb));
    p0 = __builtin_amdgcn_mfma_f32_32x32x16_bf16(b0, qr[d0], p0, 0, 0, 0);
    p1 = __builtin_amdgcn_mfma_f32_32x32x16_bf16(b1, qr[d0], p1, 0, 0, 0); }
}
__device__ __forceinline__ int v_st(int k, int c) { const int kk = (k & ~0xC) | ((k & 4) << 1) | ((k & 8) >> 1); return ((kk >> 3) * 4 + (c >> 5)) * 512 + ((kk & 7) * 32 + (c & 31)) * 2; }
__device__ __forceinline__ int v_rd_base(int lane) { return ((lane & 3) << 3) | (((lane >> 2) & 3) << 6) | (((lane >> 4) & 1) << 5) | (((lane >> 5) & 1) << 8); }
constexpr int v_rd_off(int d0, int ks, int half) { return d0 * 512 + ks * 4096 + half * 2048; }
template <int OFF> __device__ __forceinline__ s16x4 tr_read(int vb) {
  s16x4 r; asm volatile("ds_read_b64_tr_b16 %0, %1 offset:%2" : "=&v"(r) : "v"(vb), "i"(OFF) : "memory"); return r;
}
template <int D0> __device__ __forceinline__ void pv_one(f32x16& od, int vb, bf16x8 pa0, bf16x8 pa1, bf16x8 pa2, bf16x8 pa3) {
  const s16x4 l0 = tr_read<v_rd_off(D0, 0, 0)>(vb), h0 = tr_read<v_rd_off(D0, 0, 1)>(vb), l1 = tr_read<v_rd_off(D0, 1, 0)>(vb), h1 = tr_read<v_rd_off(D0, 1, 1)>(vb);
  const s16x4 l2 = tr_read<v_rd_off(D0, 2, 0)>(vb), h2 = tr_read<v_rd_off(D0, 2, 1)>(vb), l3 = tr_read<v_rd_off(D0, 3, 0)>(vb), h3 = tr_read<v_rd_off(D0, 3, 1)>(vb);
  asm volatile("s_waitcnt lgkmcnt(0)" ::: "memory"); SBAR();
#define PK(L, H) (bf16x8){L[0], L[1], L[2], L[3], H[0], H[1], H[2], H[3]}
  od = __builtin_amdgcn_mfma_f32_32x32x16_bf16(pa0, PK(l0, h0), od, 0, 0, 0);
  od = __builtin_amdgcn_mfma_f32_32x32x16_bf16(pa1, PK(l1, h1), od, 0, 0, 0);
  od = __builtin_amdgcn_mfma_f32_32x32x16_bf16(pa2, PK(l2, h2), od, 0, 0, 0);
  od = __builtin_amdgcn_mfma_f32_32x32x16_bf16(pa3, PK(l3, h3), od, 0, 0, 0);
#undef PK
}
__device__ __forceinline__ void pv_d0(f32x16* o, int vb, bf16x8 pa0, bf16x8 pa1, bf16x8 pa2, bf16x8 pa3) {
  pv_one<0>(o[0], vb, pa0, pa1, pa2, pa3); pv_one<1>(o[1], vb, pa0, pa1, pa2, pa3); pv_one<2>(o[2], vb, pa0, pa1, pa2, pa3); pv_one<3>(o[3], vb, pa0, pa1, pa2, pa3);
}

template <typename TQ>
__device__ __forceinline__ void attn_dense_body(const TQ* __restrict__ Qb, const bf16* __restrict__ Kh, const bf16* __restrict__ Vh,
                                                bf16* __restrict__ Ob, int seq, char* lds) {
  using St = Stage<bf16>; using SQ = Stage<TQ>;
  int tid_ = threadIdx.x; asm volatile("" : "+v"(tid_)); const int tid = tid_, wid = tid >> 6, lane = tid & 63, r32 = lane & 31, hi = lane >> 5;
  bf16* V_lds = (bf16*)lds; bf16* K_lds = (bf16*)(lds + 2 * SHM_V);
  float* ws = (float*)(lds + 2 * SHM_V + 2 * SHM_K) + wid * 64; float* li_l = ws; float* al_l = ws + 32;
  float m_reg = -1e30f, l_reg = 0; f32x16 o[4] = {}; bf16x8 qr[8];
  const TQ* Qw = Qb + (long)(wid * QBLK + r32) * LDQ + hi * 8;
#pragma unroll
  for (int d0 = 0; d0 < 8; ++d0) qr[d0] = SQ::tobf(SQ::ld8(Qw + d0 * 16));
  const int sr = tid >> 4, sc = (tid & 15) * 8, vst0 = v_st(sr, sc), vst1 = v_st(32 + sr, sc);
  const int vb0 = (int)(uintptr_t)V_lds + v_rd_base(lane);
  struct { typename St::T vs0, vs1, ks0, ks1; } sr_[SDEPTH];
#define SLOAD(i, k0) do { sr_[i].vs0 = St::ld8(&Vh[(long)((k0) + sr) * LDK + sc]); sr_[i].vs1 = St::ld8(&Vh[(long)((k0) + 32 + sr) * LDK + sc]); \
    sr_[i].ks0 = St::ld8(&Kh[(long)((k0) + sr) * LDK + sc]); sr_[i].ks1 = St::ld8(&Kh[(long)((k0) + 32 + sr) * LDK + sc]); } while (0)
#define SWRITE(b, i) do { *(bf16x8*)((char*)V_lds + (b) * SHM_V + vst0) = St::tobf(sr_[i].vs0);          \
    *(bf16x8*)((char*)V_lds + (b) * SHM_V + vst1) = St::tobf(sr_[i].vs1); int kc = sc * 2;               \
    *(bf16x8*)((char*)K_lds + (b) * SHM_K + KSWZ(sr, kc)) = St::tobf(sr_[i].ks0);                       \
    *(bf16x8*)((char*)K_lds + (b) * SHM_K + KSWZ(32 + sr, kc)) = St::tobf(sr_[i].ks1); } while (0)
#define SWAIT() do { if constexpr (SDEPTH == 2) asm volatile("s_waitcnt vmcnt(4)" ::: "memory"); else asm volatile("s_waitcnt vmcnt(0)" ::: "memory"); } while (0)
#define RESC(a) do { if (__any((a) < 1.f)) { if (hi == 0) al_l[r32] = (a); asm volatile("s_waitcnt lgkmcnt(0)" ::: "memory"); \
    for (int d = 0; d < 4; ++d) for (int r = 0; r < 16; ++r) o[d][r] *= al_l[crow(r, hi)]; } } while (0)
  f32x16 pA0, pA1, pB0, pB1; float mnA, mnB, alA, alB; bf16x8 pa0, pa1, pa2, pa3; const int NT = seq / KVBLK;
  constexpr int SE = 0, SO = SDEPTH - 1;
  SLOAD(SE, 0); asm volatile("s_waitcnt vmcnt(0)" ::: "memory"); SWRITE(0, SE); __syncthreads();
  qkt(pA0, pA1, K_lds, qr, r32, hi); partialSM(pA0, pA1, m_reg, mnA, alA);
  SLOAD(SO, KVBLK); if constexpr (SDEPTH == 2) { if (2 < NT) SLOAD(SE, 2 * KVBLK); }
  SWAIT(); SWRITE(1, SO); __syncthreads();
  for (int j = 1; j + 1 < NT; j += 2) {
    SBAR(); qkt(pB0, pB1, (bf16*)((char*)K_lds + SHM_K), qr, r32, hi);
    finishSM(pA0, pA1, alA, l_reg, pa0, pa1, pa2, pa3); SBAR();
    SLOAD(SO, (j + SDEPTH) * KVBLK); SBAR();
    pv_d0(o, vb0, pa0, pa1, pa2, pa3); partialSM(pB0, pB1, m_reg, mnB, alB);
    __syncthreads(); SWAIT(); SWRITE(0, SE);
    RESC(alB); __syncthreads();
    SBAR(); qkt(pA0, pA1, K_lds, qr, r32, hi);
    finishSM(pB0, pB1, alB, l_reg, pa0, pa1, pa2, pa3); SBAR();
    if (SDEPTH == 1 || j + 3 < NT) SLOAD(SE, (j + 1 + SDEPTH) * KVBLK); SBAR();
    pv_d0(o, vb0 + (int)SHM_V, pa0, pa1, pa2, pa3); partialSM(pA0, pA1, m_reg, mnA, alA);
    __syncthreads(); SWAIT(); SWRITE(1, SO);
    RESC(alA); __syncthreads();
  }
  SBAR(); qkt(pB0, pB1, (bf16*)((char*)K_lds + SHM_K), qr, r32, hi);
  finishSM(pA0, pA1, alA, l_reg, pa0, pa1, pa2, pa3); SBAR();
  pv_d0(o, vb0, pa0, pa1, pa2, pa3); partialSM(pB0, pB1, m_reg, mnB, alB);
  __syncthreads(); RESC(alB);
  finishSM(pB0, pB1, alB, l_reg, pa0, pa1, pa2, pa3); SBAR();
  pv_d0(o, vb0 + (int)SHM_V, pa0, pa1, pa2, pa3);
  if (hi == 0) li_l[r32] = l_reg; asm volatile("s_waitcnt lgkmcnt(0)" ::: "memory");
  float rli[16];
#pragma unroll
  for (int r = 0; r < 16; ++r) rli[r] = __builtin_amdgcn_rcpf(li_l[crow(r, hi)]);
  __syncthreads();
  bf16* Ol = (bf16*)lds + wid * (QBLK * D);
#pragma unroll
  for (int r = 0; r < 16; ++r) { const int orow = crow(r, hi);
#pragma unroll
    for (int d0 = 0; d0 < 4; ++d0) { const float v = o[d0][r] * rli[r]; unsigned u = __float_as_uint(v); u += 0x7FFFu + ((u >> 16) & 1u); Ol[orow * D + d0 * 32 + r32] = (bf16)(u >> 16); } }
  asm volatile("s_waitcnt lgkmcnt(0)" ::: "memory");
#pragma unroll
  for (int i = 0; i < 8; ++i) { const int row = i * 4 + (lane >> 4), ch = (lane & 15) * 8;
    const u32x4 v = *reinterpret_cast<const u32x4*>(Ol + row * D + ch);
    *reinterpret_cast<u32x4*>(Ob + (long)(wid * QBLK + row) * LDO + ch) = v; }
  __syncthreads();
#undef SLOAD
#undef SWRITE
#undef SWAIT
#undef RESC
}

}

__device__ void phase_attn(const Params& p, char* smem) {
  const int G = (int)gridDim.x, c = (int)blockIdx.x;
  for (int i = 0; i * G + c < 1024; ++i) {
    int pair, j;
    if (G == 256) { pair = 2 * (c & 7) + (i >> 1); j = (i & 1) * 32 + (c >> 3); } else { const int L = i * G + c; pair = L >> 6; j = L & 63; }
    const int b = pair >> 1, kv = pair & 1, qb = j >> 2, g = j & 3, h = kv * 4 + g;
    const bf16_t* Qb = p.Qh + (((size_t)b * 8 + h) * S + qb * 256) * 128; const bf16_t* Kp = p.Kh + ((size_t)b * 2 + kv) * S * 128; const bf16_t* Vp = p.Vh + ((size_t)b * 2 + kv) * S * 128;
    bf16_t* Ob = p.CAT + ((size_t)b * S + qb * 256) * 1024 + h * 128;
    att::attn_dense_body<att::bf16>(Qb, Kp, Vp, Ob, S, smem);
  }
}

#define XB_TMO      128
#define XB_XCNT(j)  (256  + 64 * (j))
#define XB_XSUB(j)  (1280 + 64 * (j))
#define XB_XGEN(j)  (2304 + 64 * (j))
#define XB_TOP      3328
#define XB_TOPGEN   3392
#define XCD_BAR_WORDS 3456
#define XB_SPIN_CAP (1u << 18)
#define LAS __attribute__((address_space(3)))

__device__ __forceinline__ unsigned xb_ld(unsigned* p)              { return __hip_atomic_load(p, __ATOMIC_RELAXED, __HIP_MEMORY_SCOPE_AGENT); }
__device__ __forceinline__ unsigned xb_add(unsigned* p, unsigned v) { return __hip_atomic_fetch_add(p, v, __ATOMIC_RELAXED, __HIP_MEMORY_SCOPE_AGENT); }
__device__ __forceinline__ unsigned xb_xcc_id() { return (unsigned)__builtin_amdgcn_s_getreg((3 << 11) | 20) & 0xFu; }
#define XB_SPIN(cond, bar) do { unsigned _sp = 0; while (cond) { __builtin_amdgcn_s_sleep(1); \
    if ((++_sp & 255u) == 0u) { if (xb_ld(&(bar)[XB_TMO])) break; if (_sp > XB_SPIN_CAP) { atomicAdd(&(bar)[XB_TMO], 1u); break; } } } } while (0)

struct XcdBarrier {
    unsigned* bar; unsigned x;
    volatile LAS unsigned* st;
};

__device__ __forceinline__ XcdBarrier xcd_barrier_post(unsigned* bar, volatile LAS unsigned* st) {
    XcdBarrier b; b.bar = bar; b.x = xb_xcc_id(); b.st = st;
    if (threadIdx.x == 0) (void)xb_add(&bar[XB_XCNT(b.x)], 1u);
    return b;
}
__device__ __forceinline__ void xcd_barrier_complete(unsigned* bar, unsigned x, unsigned& nloc, unsigned& nx) {
    const unsigned G = gridDim.x * gridDim.y * gridDim.z;
    unsigned sum, cnt, mine, sp = 0u;
    for (;;) {
        sum = 0u; cnt = 0u; mine = 0u;
#pragma unroll
        for (unsigned j = 0; j < 16; ++j) { const unsigned c = xb_ld(&bar[XB_XCNT(j)]); sum += c; cnt += (c > 0u) ? 1u : 0u; mine = (j == x) ? c : mine; }
        if (sum == G) break;
        __builtin_amdgcn_s_sleep(1);
        if ((++sp & 255u) == 0u) { if (xb_ld(&bar[XB_TMO])) break; if (sp > XB_SPIN_CAP) { atomicAdd(&bar[XB_TMO], 1u); break; } }
    }
    nloc = mine > 0u ? mine : 1u; nx = cnt > 0u ? cnt : 1u;
}

__device__ __forceinline__ void xcd_barrier(const XcdBarrier& b) {
    asm volatile("s_waitcnt vmcnt(0)" ::: "memory");
    __syncthreads();
    if (threadIdx.x == 0) {
        unsigned* bar = b.bar;
        __builtin_amdgcn_s_waitcnt(0);
        unsigned nloc = b.st[0], nx = b.st[1];
        if (nloc == 0u) { xcd_barrier_complete(bar, b.x, nloc, nx); b.st[0] = nloc; b.st[1] = nx; }
        const unsigned old = xb_add(&bar[XB_XSUB(b.x)], 1u);
        const unsigned gen = old / nloc;
        if (old + 1u == (gen + 1u) * nloc) {
            __builtin_amdgcn_fence(__ATOMIC_RELEASE, "agent");
            asm volatile("s_waitcnt vmcnt(0)" ::: "memory");
            const unsigned og = xb_add(&bar[XB_TOP], 1u);
            const unsigned tg = og / nx;
            if (og + 1u == (tg + 1u) * nx) xb_add(&bar[XB_TOPGEN], 1u);
            else XB_SPIN(xb_ld(&bar[XB_TOPGEN]) == tg, bar);
            __builtin_amdgcn_fence(__ATOMIC_ACQUIRE, "agent");
            xb_add(&bar[XB_XGEN(b.x)], 1u);
            asm volatile("s_waitcnt vmcnt(0)" ::: "memory");
        } else {
            XB_SPIN(xb_ld(&bar[XB_XGEN(b.x)]) == gen, bar);
            __builtin_amdgcn_fence(__ATOMIC_ACQUIRE, "agent");
            asm volatile("s_waitcnt vmcnt(0)" ::: "memory");
        }
    }
    __syncthreads();
}


constexpr int NPH = 19;
__global__ __launch_bounds__(NTHREADS, 2) void mega(Params p, int ph0, int ph1) {
  extern __shared__ __attribute__((aligned(16))) char smem[];
  cg::grid_group grid = cg::this_grid();
  volatile LAS unsigned* xst = (volatile LAS unsigned*)(LAS char*)(smem + SMEM_BYTES - 16);
  if (threadIdx.x == 0) { xst[0] = 0u; xst[1] = 0u; }
  __syncthreads();
  const XcdBarrier xb = xcd_barrier_post(p.bar, xst);
#ifndef REP_MASK
#define REP_MASK 0
#endif
#define GSYNC(k) do { if ((k) == 1) grid.sync(); else xcd_barrier(xb); } while (0)
#define PHASE(k, call) if (ph0 <= (k) && (k) < ph1) { if ((k) > ph0) GSYNC(k); if ((REP_MASK >> (k)) & 1) { if ((k) == 10) phase_peer_gather<0, true>(p, 0); else if ((k) == 18) phase_peer_gather<1, true>(p, 1); else { call; } xcd_barrier(xb); } call; }
#if !defined(ONLY_PHASE) || ONLY_PHASE == 0
  PHASE(0, phase_prep(p, smem))
#endif
#if !defined(ONLY_PHASE) || ONLY_PHASE == 1
  PHASE(1, phase_norm<true>(p, p.x, p.nmg, p.mod, 0, 1024, smem))
#endif
#if !defined(ONLY_PHASE) || ONLY_PHASE == 2
  PHASE(2, phase_gemm_fast(p.H, p.Wt_evin, T, 2560, 1024, (EpiEvin{p.ZQK, p.ZV, p.ZO, p.ZP, p.ev_b_in}), smem))
#endif
#if !defined(ONLY_PHASE) || ONLY_PHASE == 3
  PHASE(3, phase_convpool(p, smem))
#endif
#if !defined(ONLY_PHASE) || ONLY_PHASE == 4
  PHASE(4, ml::phase_mlstm(p, smem))
#endif
#if !defined(ONLY_PHASE) || ONLY_PHASE == 5
  PHASE(5, phase_cat(p))
#endif
#if !defined(ONLY_PHASE) || ONLY_PHASE == 6
  PHASE(6, phase_gemm_fast(p.CAT, p.Wt_evout, T, 1024, 1024, (EpiRes{p.x, p.X, p.mod + 2048}), smem))
#endif
#if !defined(ONLY_PHASE) || ONLY_PHASE == 7
  PHASE(7, phase_norm<false>(p, p.X, p.nfg, p.mod, 3072, 4096, smem))
#endif
#if !defined(ONLY_PHASE) || ONLY_PHASE == 8
  PHASE(8, phase_gemm_fast(p.H, p.Wt_q, T, 2048, 1024, (EpiPlain{p.QP, 2048}), smem))
#endif
#if !defined(ONLY_PHASE) || ONLY_PHASE == 9
  PHASE(9, sel::phase_peer_select(p, 0, smem))
#endif
#if !defined(ONLY_PHASE) || ONLY_PHASE == 10
  PHASE(10, phase_peer_gather<0>(p, 0))
#endif
#if !defined(ONLY_PHASE) || ONLY_PHASE == 11
  PHASE(11, phase_gemm_fast(p.H, p.Wt_odin, T, 1536, 1024, (EpiPlain{p.QKV, 1536}), smem))
#endif
#if !defined(ONLY_PHASE) || ONLY_PHASE == 12
  PHASE(12, phase_qkrope(p))
#endif
#if !defined(ONLY_PHASE) || ONLY_PHASE == 13
  PHASE(13, phase_attn(p, smem))
#endif
#if !defined(ONLY_PHASE) || ONLY_PHASE == 14
  PHASE(14, phase_gemm_fast(p.CAT, p.Wt_odout, T, 1024, 1024, (EpiRes{p.X, p.X, p.mod + (size_t)8 * 6144 + 2048}), smem))
#endif
#if !defined(ONLY_PHASE) || ONLY_PHASE == 15
  PHASE(15, phase_norm<false>(p, p.X, p.nfg + D, p.mod + (size_t)8 * 6144, 3072, 4096, smem))
#endif
#if !defined(ONLY_PHASE) || ONLY_PHASE == 16
  PHASE(16, phase_gemm_fast(p.H, p.Wt_q + (size_t)2048 * 1024, T, 2048, 1024, (EpiPlain{p.QP, 2048}), smem))
#endif
#if !defined(ONLY_PHASE) || ONLY_PHASE == 17
  PHASE(17, sel::phase_peer_select(p, 1, smem))
#endif
#if !defined(ONLY_PHASE) || ONLY_PHASE == 18
  PHASE(18, phase_peer_gather<1>(p, 1))
#endif
#undef PHASE
}
}

extern "C" void kernel_launch(void* const* d_in, const int* in_sizes, int n_in, void* d_out, int out_size, void* d_ws, size_t ws_size, hipStream_t stream) {
  (void)in_sizes; (void)n_in; (void)out_size;
  Params p{};
  const float** fin = (const float**)&p;
  for (int i = 0; i < 23; ++i) fin[i] = (const float*)d_in[i];
  p.X = (float*)d_out;
  char* ws = (char*)d_ws; size_t off = 0;
  auto alloc = [&](size_t bytes) { char* q = ws + off; off += (bytes + 255) / 256 * 256; return q; };
  p.U8 = (unsigned char*)alloc((size_t)2 * 16384 * 1024); p.V8 = (unsigned char*)alloc((size_t)2 * 16384 * 1024);
  p.Wt_evin = (bf16_t*)alloc((size_t)2560 * 1024 * 2); p.Wt_evout = (bf16_t*)alloc((size_t)1024 * 1024 * 2); p.Wt_odin = (bf16_t*)alloc((size_t)1536 * 1024 * 2);
  p.Wt_odout = (bf16_t*)alloc((size_t)1024 * 1024 * 2); p.Wt_q = (bf16_t*)alloc((size_t)2 * 2048 * 1024 * 2); p.keysb = (bf16_t*)alloc((size_t)2 * 2 * 128 * 128 * 2);
  p.Wg = (float*)alloc(16 * 1024 * 4); p.mod = (float*)alloc(2 * 8 * 6144 * 4); p.gates = (float*)alloc((size_t)T * 16 * 4);
  p.pgate = (float*)alloc((size_t)T * 128 * 4); p.pidx = (bf16_t*)alloc((size_t)T * 128 * 2);
  p.H = (bf16_t*)alloc((size_t)T * 1024 * 2); p.CAT = p.H;
  char* big = alloc((size_t)T * 2048 * 2);
  p.ZQK = (bf16_t*)big; p.ZV = (bf16_t*)(big + (size_t)T * 1024 * 2); p.ZO = (bf16_t*)(big + (size_t)T * 1536 * 2); p.HS = (bf16_t*)big; p.QP = (bf16_t*)big; p.QKV = (bf16_t*)big;
  char* big2 = alloc((size_t)T * 1536 * 2);
  p.QK = (bf16_t*)big2; p.ZP = (bf16_t*)(big2 + (size_t)T * 1024 * 2); p.Qh = (bf16_t*)big2; p.Kh = (bf16_t*)(big2 + (size_t)T * 1024 * 2); p.Vh = (bf16_t*)(big2 + (size_t)T * 1280 * 2);
  p.bar = (unsigned*)alloc(XCD_BAR_WORDS * 4);
  if (off > ws_size) { fprintf(stderr, "kernel_launch: workspace too small: need %zu have %zu\n", off, ws_size); return; }

  static int grid_blocks = 0;
  if (!grid_blocks) {
    int dev = 0, cus = 0, per_cu = 0; hipGetDevice(&dev); hipDeviceGetAttribute(&cus, hipDeviceAttributeMultiprocessorCount, dev);
    hipFuncSetAttribute((const void*)mega, hipFuncAttributeMaxDynamicSharedMemorySize, SMEM_BYTES);
    hipOccupancyMaxActiveBlocksPerMultiprocessor(&per_cu, mega, NTHREADS, SMEM_BYTES);
    if (per_cu > 1) per_cu = 1;
    grid_blocks = cus * per_cu;
    if (grid_blocks <= 0) { fprintf(stderr, "kernel_launch: occupancy query returned 0\n"); grid_blocks = 0; return; }
  }
  hipMemsetAsync(p.bar, 0, XCD_BAR_WORDS * 4, stream);
#if MULTI_LAUNCH
  for (int ph = 0; ph < NPH; ++ph) hipLaunchKernelGGL(mega, dim3(grid_blocks), dim3(NTHREADS), SMEM_BYTES, stream, p, ph, ph + 1);
#else
  int ph0 = 0, ph1 = NPH; void* args[] = {&p, &ph0, &ph1};
  hipError_t e = hipLaunchCooperativeKernel((const void*)mega, dim3(grid_blocks), dim3(NTHREADS), args, SMEM_BYTES, stream);
  if (e != hipSuccess) fprintf(stderr, "cooperative launch failed: %s (grid %d)\n", hipGetErrorString(e), grid_blocks);
#endif
}
```

```cpp
#include <hip/hip_runtime.h>
#include <hip/hip_cooperative_groups.h>
#include <math.h>
#include <stdint.h>
#include <stdio.h>
namespace cg = cooperative_groups;

#ifndef MULTI_LAUNCH
#define MULTI_LAUNCH 0
#endif

namespace {
typedef unsigned short bf16_t;
typedef unsigned int u32;
typedef float f32x4 __attribute__((ext_vector_type(4)));
typedef u32 u32x4 __attribute__((ext_vector_type(4)));
typedef u32 u32x2 __attribute__((ext_vector_type(2)));
typedef __bf16 bf16x2_t __attribute__((ext_vector_type(2)));

constexpr int D = 1024, NB = 8, S = 4096, T = NB * S;
constexpr int EVEN_IN = 2576;
constexpr float EPS = 1e-6f;
constexpr int NTHREADS = 512;
constexpr int SMEM_BYTES = 144 * 1024;
constexpr float KSCALE = 0.08838834764831845f;

struct Params {
  const float *x, *c, *ada_w, *ada_b, *nmg, *nfg, *ev_w_in, *ev_b_in, *conv_w, *conv_b, *mnorm_g, *pool_w, *pool_sc, *ev_w_out, *od_w_in, *qn_g, *kn_g, *od_w_out,
      *peer_wq, *peer_keys, *peer_u, *peer_v, *final_g;
  float* X;
  bf16_t *Wt_evin, *Wt_evout, *Wt_odin, *Wt_odout, *Wt_q, *keysb, *poolWt; unsigned char *U8, *V8;
  float *Wg, *mod, *gates, *pgate;
  bf16_t *H, *ZQK, *ZV, *ZO, *ZP, *QK, *HS, *CAT, *QP, *QKV, *Qh, *Kh, *Vh;
  bf16_t* pidx;
  unsigned* bar;
};

__device__ __forceinline__ float siluf(float x) { return x / (1.f + __expf(-x)); }
__device__ __forceinline__ float sigmf(float x) { return 1.f / (1.f + __expf(-x)); }
__device__ __forceinline__ float wave_sum(float v) { for (int o = 32; o >= 1; o >>= 1) v += __shfl_xor(v, o); return v; }
__device__ __forceinline__ float wave_max(float v) { for (int o = 32; o >= 1; o >>= 1) v = fmaxf(v, __shfl_xor(v, o)); return v; }
__device__ __forceinline__ bf16_t f2bf(float f) { u32 u = __float_as_uint(f); u += 0x7FFFu + ((u >> 16) & 1u); return (bf16_t)(u >> 16); }
__device__ __forceinline__ float bf2f(bf16_t b) { return __uint_as_float(((u32)b) << 16); }
__device__ __forceinline__ u32 pack2(float lo, float hi) { return (u32)f2bf(lo) | ((u32)f2bf(hi) << 16); }
__device__ __forceinline__ float bflo(u32 w) { return __uint_as_float(w << 16); }
__device__ __forceinline__ float bfhi(u32 w) { return __uint_as_float(w & 0xFFFF0000u); }
__device__ __forceinline__ float dot2bf(u32 a, u32 b, float c) { return __builtin_amdgcn_fdot2_f32_bf16(__builtin_bit_cast(bf16x2_t, a), __builtin_bit_cast(bf16x2_t, b), c, false); }

constexpr int PJ_MOD = 192, PJ_TR = 2576, PJ_WG = 1, PJ_KEYS = 16, PJ_UV = 8192;
constexpr int PJ_TOTAL = PJ_MOD + PJ_TR + PJ_WG + PJ_KEYS + PJ_UV;

__device__ void prep_transpose_tile(const float* __restrict__ src, int ld, int k0, int n0, bf16_t* __restrict__ dst, int dstK, char* smem) {
  float* tile = (float*)smem;
  const int tid = threadIdx.x;
  __syncthreads();
  for (int pass = 0; pass < 8; ++pass) { int kk = pass * 8 + (tid >> 6), n = tid & 63; tile[kk * 65 + n] = src[(size_t)(k0 + kk) * ld + n0 + n]; }
  __syncthreads();
  int n = tid >> 3, kc = (tid & 7) * 8; u32x4 w;
  w.x = pack2(tile[(kc + 0) * 65 + n], tile[(kc + 1) * 65 + n]); w.y = pack2(tile[(kc + 2) * 65 + n], tile[(kc + 3) * 65 + n]);
  w.z = pack2(tile[(kc + 4) * 65 + n], tile[(kc + 5) * 65 + n]); w.w = pack2(tile[(kc + 6) * 65 + n], tile[(kc + 7) * 65 + n]);
  *(u32x4*)(dst + (size_t)(n0 + n) * dstK + k0 + kc) = w;
}

__device__ void phase_prep(const Params& p, char* smem) {
  const int tid = threadIdx.x;
  for (int job = blockIdx.x; job < PJ_TOTAL; job += gridDim.x) {
    if (job < PJ_MOD) {
      float* cs = (float*)smem; float* red = cs + 8192;
      __syncthreads();
      for (int i = tid; i < 8192; i += NTHREADS) cs[i] = siluf(p.c[i]);
      __syncthreads();
      const int l = job / 96, e0 = (job % 96) * 64, col = tid & 63, dg = tid >> 6;
      float acc[8];
#pragma unroll
      for (int b = 0; b < 8; ++b) acc[b] = 0.f;
      const float* w = p.ada_w + (size_t)l * D * 6144 + e0 + col;
      for (int d = dg * 128; d < dg * 128 + 128; ++d) { float wv = w[(size_t)d * 6144];
#pragma unroll
        for (int b = 0; b < 8; ++b) acc[b] += cs[b * 1024 + d] * wv; }
#pragma unroll
      for (int b = 0; b < 8; ++b) red[(dg * 8 + b) * 64 + col] = acc[b];
      __syncthreads();
      { const int b = tid >> 6; float s = 0.f;
#pragma unroll
        for (int g = 0; g < 8; ++g) s += red[(g * 8 + b) * 64 + col];
        p.mod[(size_t)(l * 8 + b) * 6144 + e0 + col] = s + p.ada_b[l * 6144 + e0 + col]; }
    } else if (job < PJ_MOD + PJ_TR) {
      int tt = job - PJ_MOD;
      if (tt < 640) prep_transpose_tile(p.ev_w_in, EVEN_IN, (tt / 40) * 64, (tt % 40) * 64, p.Wt_evin, 1024, smem);
      else if (tt < 896) { tt -= 640; prep_transpose_tile(p.ev_w_out, 1024, (tt / 16) * 64, (tt % 16) * 64, p.Wt_evout, 1024, smem); }
      else if (tt < 1280) { tt -= 896; prep_transpose_tile(p.od_w_in, 1536, (tt / 24) * 64, (tt % 24) * 64, p.Wt_odin, 1024, smem); }
      else if (tt < 1536) { tt -= 1280; prep_transpose_tile(p.od_w_out, 1024, (tt / 16) * 64, (tt % 16) * 64, p.Wt_odout, 1024, smem); }
      else if (tt < 2560) { tt -= 1536; int l = tt / 512; tt %= 512; prep_transpose_tile(p.peer_wq + (size_t)l * D * 2048, 2048, (tt / 32) * 64, (tt % 32) * 64, p.Wt_q + (size_t)l * 2048 * 1024, 1024, smem); }
      else { tt -= 2560; const int g = tt >> 2; prep_transpose_tile(p.pool_w + (size_t)g * 16384, 128, ((tt >> 1) & 1) * 64, (tt & 1) * 64, p.poolWt + (size_t)g * 16384, 128, smem); }
    } else if (job < PJ_MOD + PJ_TR + PJ_WG) {
      for (int i = tid; i < 16 * 1024; i += NTHREADS) { int g = i >> 10, d = i & 1023; p.Wg[i] = p.ev_w_in[(size_t)d * EVEN_IN + 2560 + g]; }
    } else if (job < PJ_MOD + PJ_TR + PJ_WG + PJ_KEYS) {
      int j = job - (PJ_MOD + PJ_TR + PJ_WG);
      for (int i = tid; i < 4096; i += NTHREADS) p.keysb[j * 4096 + i] = f2bf(p.peer_keys[j * 4096 + i]);
    } else {
      int j = job - (PJ_MOD + PJ_TR + PJ_WG + PJ_KEYS); const bool isu = j < 4096; const float* src = isu ? p.peer_u : p.peer_v; unsigned char* dst = isu ? p.U8 : p.V8; j &= 4095; const float sc = isu ? 32.f : 2.f;
      const size_t o = (size_t)j * 8192 + tid * 16; u32x4 w; u32 ww[4];
#pragma unroll
      for (int q = 0; q < 4; ++q) { const f32x4 a = *(const f32x4*)(src + o + 4 * q); int pk = __builtin_amdgcn_cvt_pk_fp8_f32(a.x * sc, a.y * sc, 0, false); pk = __builtin_amdgcn_cvt_pk_fp8_f32(a.z * sc, a.w * sc, pk, true); ww[q] = (u32)pk; }
      w.x = ww[0]; w.y = ww[1]; w.z = ww[2]; w.w = ww[3]; *(u32x4*)(dst + o) = w;
    }
  }
}

template <bool WITH_GATES>
__device__ void phase_norm(const Params& p, const float* __restrict__ xin, const float* __restrict__ g, const float* __restrict__ modl, int sh_off, int sc_off, char* smem) {
  const int tid = threadIdx.x, wid = tid >> 6, lane = tid & 63;
  float* wg = (float*)smem;
  if (WITH_GATES) { __syncthreads(); for (int i = tid; i < 16 * 1024; i += NTHREADS) wg[i] = p.Wg[i]; __syncthreads(); }
  for (int job = blockIdx.x; job < T / 8; job += gridDim.x) {
    const int t = job * 8 + wid, b = t / S;
    f32x4 v[4]; float ss = 0.f;
#pragma unroll
    for (int i = 0; i < 4; ++i) { v[i] = *(const f32x4*)(xin + (size_t)t * D + i * 256 + lane * 4); ss += v[i].x * v[i].x + v[i].y * v[i].y + v[i].z * v[i].z + v[i].w * v[i].w; }
    ss = wave_sum(ss); const float r = rsqrtf(ss * (1.f / D) + EPS);
    const float* shp = modl + (size_t)b * 6144 + sh_off; const float* scp = modl + (size_t)b * 6144 + sc_off;
#pragma unroll
    for (int i = 0; i < 4; ++i) { const int d = i * 256 + lane * 4; f32x4 gg = *(const f32x4*)(g + d), s1 = *(const f32x4*)(scp + d), s0 = *(const f32x4*)(shp + d);
      v[i].x = v[i].x * r * gg.x * (1.f + s1.x) + s0.x; v[i].y = v[i].y * r * gg.y * (1.f + s1.y) + s0.y; v[i].z = v[i].z * r * gg.z * (1.f + s1.z) + s0.z; v[i].w = v[i].w * r * gg.w * (1.f + s1.w) + s0.w;
      u32x2 w; w.x = pack2(v[i].x, v[i].y); w.y = pack2(v[i].z, v[i].w); *(u32x2*)(p.H + (size_t)t * D + d) = w; }
    if (WITH_GATES) {
      float myg = 0.f;
#pragma unroll 2
      for (int gi = 0; gi < 16; ++gi) { float a = 0.f;
#pragma unroll
        for (int i = 0; i < 4; ++i) { f32x4 w4 = *(const f32x4*)(wg + gi * 1024 + i * 256 + lane * 4); a += v[i].x * w4.x + v[i].y * w4.y + v[i].z * w4.z + v[i].w * w4.w; }
        a = wave_sum(a); if (lane == gi) myg = a; }
      if (lane < 16) p.gates[(size_t)t * 16 + lane] = myg + p.ev_b_in[2560 + lane];
    }
  }
}

enum { EPI_EVIN = 0, EPI_EVOUT = 1, EPI_PEERQ = 2, EPI_ODIN = 3, EPI_ODOUT = 4 };
template <int EPI> __device__ __forceinline__ void epi_store(const Params& p, int layer, int m, int n, float acc) {
  if (EPI == EPI_EVIN) { float v = acc + p.ev_b_in[n];
    if (n < 1024) p.ZQK[(size_t)m * 1024 + n] = f2bf(v); else if (n < 1536) p.ZV[(size_t)m * 512 + n - 1024] = f2bf(v);
    else if (n < 2048) p.ZO[(size_t)m * 512 + n - 1536] = f2bf(sigmf(v)); else p.ZP[(size_t)m * 512 + n - 2048] = f2bf(v); }
  else if (EPI == EPI_EVOUT) { int b = m / S; p.X[(size_t)m * D + n] = p.x[(size_t)m * D + n] + p.mod[(size_t)(0 * 8 + b) * 6144 + 2048 + n] * acc; }
  else if (EPI == EPI_PEERQ) p.QP[(size_t)m * 2048 + n] = f2bf(acc);
  else if (EPI == EPI_ODIN) p.QKV[(size_t)m * 1536 + n] = f2bf(acc);
  else if (EPI == EPI_ODOUT) { int b = m / S; p.X[(size_t)m * D + n] += p.mod[(size_t)(1 * 8 + b) * 6144 + 2048 + n] * acc; }
}
template <int EPI> __device__ void phase_gemm_naive(const Params& p, int layer, const bf16_t* __restrict__ A, const bf16_t* __restrict__ Bt, int M, int N, int K, char* smem) {
  float* As = (float*)smem; float* Bs = As + 32 * 132;
  const int tid = threadIdx.x, tx = tid & 15, ty = tid >> 4; const int nN = N / 64, njobs = (M / 128) * nN;
  for (int job = blockIdx.x; job < njobs; job += gridDim.x) {
    const int m0 = (job / nN) * 128, n0 = (job % nN) * 64; float acc[4][4];
#pragma unroll
    for (int i = 0; i < 4; ++i)
#pragma unroll
      for (int j = 0; j < 4; ++j) acc[i][j] = 0.f;
    for (int k0 = 0; k0 < K; k0 += 32) {
      __syncthreads();
      { int row = tid >> 2, kc = (tid & 3) * 8; u32x4 w = *(const u32x4*)(A + (size_t)(m0 + row) * K + k0 + kc);
        As[(kc + 0) * 132 + row] = bflo(w.x); As[(kc + 1) * 132 + row] = bfhi(w.x); As[(kc + 2) * 132 + row] = bflo(w.y); As[(kc + 3) * 132 + row] = bfhi(w.y);
        As[(kc + 4) * 132 + row] = bflo(w.z); As[(kc + 5) * 132 + row] = bfhi(w.z); As[(kc + 6) * 132 + row] = bflo(w.w); As[(kc + 7) * 132 + row] = bfhi(w.w); }
      if (tid < 256) { int row = tid >> 2, kc = (tid & 3) * 8; u32x4 w = *(const u32x4*)(Bt + (size_t)(n0 + row) * K + k0 + kc);
        Bs[(kc + 0) * 68 + row] = bflo(w.x); Bs[(kc + 1) * 68 + row] = bfhi(w.x); Bs[(kc + 2) * 68 + row] = bflo(w.y); Bs[(kc + 3) * 68 + row] = bfhi(w.y);
        Bs[(kc + 4) * 68 + row] = bflo(w.z); Bs[(kc + 5) * 68 + row] = bfhi(w.z); Bs[(kc + 6) * 68 + row] = bflo(w.w); Bs[(kc + 7) * 68 + row] = bfhi(w.w); }
      __syncthreads();
#pragma unroll 8
      for (int kk = 0; kk < 32; ++kk) { f32x4 a = *(const f32x4*)(As + kk * 132 + ty * 4), b = *(const f32x4*)(Bs + kk * 68 + tx * 4);
        acc[0][0] += a.x * b.x; acc[0][1] += a.x * b.y; acc[0][2] += a.x * b.z; acc[0][3] += a.x * b.w;
        acc[1][0] += a.y * b.x; acc[1][1] += a.y * b.y; acc[1][2] += a.y * b.z; acc[1][3] += a.y * b.w;
        acc[2][0] += a.z * b.x; acc[2][1] += a.z * b.y; acc[2][2] += a.z * b.z; acc[2][3] += a.z * b.w;
        acc[3][0] += a.w * b.x; acc[3][1] += a.w * b.y; acc[3][2] += a.w * b.z; acc[3][3] += a.w * b.w; }
    }
#pragma unroll
    for (int i = 0; i < 4; ++i)
#pragma unroll
      for (int j = 0; j < 4; ++j) epi_store<EPI>(p, layer, m0 + ty * 4 + i, n0 + tx * 4 + j, acc[i][j]);
  }
}

namespace pg8 {
#define PG8_LAS __attribute__((address_space(3)))
typedef unsigned short bf16_t;
typedef short bf16x8 __attribute__((ext_vector_type(8)));
typedef float f32x4 __attribute__((ext_vector_type(4)));
typedef unsigned u32x4 __attribute__((ext_vector_type(4)));
constexpr int BM = 256, BK = 64, HALF = 128, HTB = HALF * BK * 2  , STAGE_BYTES = 8 * HTB, NXCD = 8, WGM = 8;

__host__ __device__ __forceinline__ int lds_byte(int r, int c) { const int st = (r >> 4) * 2 + (c >> 5), rr = r & 15, cc = c & 31, ob = rr * 64 + cc * 2; return st * 1024 + (ob ^ (((ob >> 9) & 1) << 5)); }
__host__ __device__ __forceinline__ void stage_rc(int b, int& R, int& C) { const int st = b / 1024, sb = b % 1024, swz = sb ^ (((sb >> 9) & 1) << 5); R = (st >> 1) * 16 + swz / 64; C = (st & 1) * 32 + (swz % 64) / 2; }
__host__ __device__ __forceinline__ int perm32(int rho) { const int n = rho >> 4, i = rho & 15; return 8 * (i >> 2) + 4 * n + (i & 3); }

struct Unit { int pm, pn; };
struct Gemm { const bf16_t* A; const bf16_t* Bt; int M, N, K; };

struct StaticOrder {
    int nM, nN, nwg, G, c;
    __host__ __device__ void init(int M, int N, int G_, int c_) { nM = M / BM; nN = N / BM; nwg = nM * nN; G = G_; c = c_; }
    __host__ __device__ bool next(int i, Unit& u) const {
        const long L = (long)i * G + c; if (L >= nwg) return false;
        int wgid = (int)L; { const int q = nwg / NXCD, r = nwg % NXCD, xcd = wgid % NXCD, off = wgid / NXCD; wgid = (xcd < r ? xcd * (q + 1) : r * (q + 1) + (xcd - r) * q) + off; }
        const int nig = WGM * nN, gid = wgid / nig, fm = gid * WGM, gsz = (nM - fm) < WGM ? (nM - fm) : WGM;
        u.pm = fm + ((wgid % nig) % gsz); u.pn = (wgid % nig) / gsz; return true;
    }
    __device__ __forceinline__ void a_ready(const Unit&) const {}
    __device__ __forceinline__ void done(const Unit&) const {}
};
__device__ __forceinline__ unsigned cvt_pk_bf16(float lo, float hi) { unsigned r; asm volatile("v_cvt_pk_bf16_f32 %0, %1, %2" : "=v"(r) : "v"(lo), "v"(hi)); return r; }
template <class Epi, class Sched, bool STAMP = false>
__device__ __forceinline__ void gemm_phase(PG8_LAS unsigned char* lds, const Gemm g, const Sched& S, const Epi& E, unsigned long long* stamps) {
    const int tid = threadIdx.x, wid = __builtin_amdgcn_readfirstlane(tid >> 6), lane = tid & 63, wr = wid >> 2, wc = wid & 3, fr = lane & 15, fq = lane >> 4;
    const int K = g.K, nt = K / BK;
    int ts_lo = 0, ts_hi = 0, nts = 0; const unsigned long long rt_entry = STAMP ? (unsigned long long)wall_clock64() : 0ull;
#define PG8_STAMP() do { if (STAMP && wid == 0 && nts < 64) { const unsigned long long _c = (unsigned long long)clock64(); \
        ts_lo = (lane == nts) ? (int)(unsigned)_c : ts_lo; ts_hi = (lane == nts) ? (int)(unsigned)(_c >> 32) : ts_hi; ++nts; } } while (0)
    PG8_STAMP();
    unsigned voffA[2], voffB[2];
#pragma unroll
    for (int i = 0; i < 2; ++i) { int R, C; stage_rc(tid * 16 + i * 8192, R, C); const int Rb = Epi::PERM ? ((R & ~31) + perm32(R & 31)) : R;
        voffA[i] = (unsigned)(R * K + C) * 2u; voffB[i] = (unsigned)(Rb * K + C) * 2u; }
    const size_t kstep = (size_t)(BK * 2);
    const size_t hstep = (size_t)HALF * K * 2;
    const size_t tstep = 2 * hstep;
    const unsigned ldsw = (unsigned)wid * 1024u;
    const int aoff = lds_byte(wr * 64 + fr, fq * 8), boff = lds_byte(wc * 32 + fr, fq * 8);
#define PG8_SA(b, h) (((b) * 2 + (h)) * HTB)
#define PG8_SB(b, h) ((4 + (b) * 2 + (h)) * HTB)
#define PG8_STAGE(bufoff, gbase, voff) do { _Pragma("unroll") for (int _i = 0; _i < 2; ++_i) \
        __builtin_amdgcn_global_load_lds((const unsigned*)((const char*)(gbase) + (voff)[_i]), (PG8_LAS unsigned*)(lds + (bufoff) + ldsw + _i * 8192), 16, 0, 0); } while (0)
#define PG8_LDA(dst, b, h) do { _Pragma("unroll") for (int m = 0; m < 4; ++m) _Pragma("unroll") for (int k = 0; k < 2; ++k) dst[m][k] = *(const PG8_LAS bf16x8*)(lds + PG8_SA(b, h) + aoff + m * 2048 + k * 1024); } while (0)
#define PG8_LDB(dst, b, h) do { _Pragma("unroll") for (int n = 0; n < 2; ++n) _Pragma("unroll") for (int k = 0; k < 2; ++k) dst[n][k] = *(const PG8_LAS bf16x8*)(lds + PG8_SB(b, h) + boff + n * 2048 + k * 1024); } while (0)
#define PG8_MMA(ai, bj, At, Bt) do { __builtin_amdgcn_s_setprio(1); _Pragma("unroll") for (int m = 0; m < 4; ++m) _Pragma("unroll") for (int n = 0; n < 2; ++n) _Pragma("unroll") for (int k = 0; k < 2; ++k) \
        acc[ai][bj][m][n] = __builtin_amdgcn_mfma_f32_16x16x32_bf16(Bt[n][k], At[m][k], acc[ai][bj][m][n], 0, 0, 0); __builtin_amdgcn_s_setprio(0); } while (0)
#define PG8_WAIT_V(n) asm volatile("s_waitcnt vmcnt(" #n ")" ::: "memory")
#define PG8_WAIT_L(n) asm volatile("s_waitcnt lgkmcnt(" #n ")" ::: "memory")
#define PG8_BAR __builtin_amdgcn_s_barrier()
#define PG8_SCHED __builtin_amdgcn_sched_barrier(0)
    Unit cur, nxt; int ui = 0;
    if (!S.next(0, cur)) return;
    f32x4 acc[2][2][4][2];
#pragma unroll
    for (int a = 0; a < 2; ++a)
#pragma unroll
        for (int b = 0; b < 2; ++b)
#pragma unroll
            for (int m = 0; m < 4; ++m)
#pragma unroll
                for (int n = 0; n < 2; ++n) acc[a][b][m][n] = (f32x4){0.f, 0.f, 0.f, 0.f};
    bf16x8 At[4][2], B0[2][2], B1[2][2];
    const char* cA = (const char*)g.A + (size_t)cur.pm * tstep; const char* cB = (const char*)g.Bt + (size_t)cur.pn * tstep;
    S.a_ready(cur);
    PG8_STAGE(PG8_SB(0, 0), cB, voffB); PG8_STAGE(PG8_SA(0, 0), cA, voffA); PG8_STAGE(PG8_SB(0, 1), cB + hstep, voffB); PG8_STAGE(PG8_SA(0, 1), cA + hstep, voffA);
    if (wr == 1) PG8_BAR;
    PG8_WAIT_V(4); PG8_BAR;
    PG8_STAGE(PG8_SB(1, 0), cB + kstep, voffB); PG8_STAGE(PG8_SA(1, 0), cA + kstep, voffA); PG8_STAGE(PG8_SB(1, 1), cB + hstep + kstep, voffB);
    PG8_WAIT_V(6); PG8_BAR;
    PG8_STAMP();
    for (;;) {
        const bool has_next = S.next(ui + 1, nxt);
        const char* nA = has_next ? (const char*)g.A + (size_t)nxt.pm * tstep : cA; const char* nB = has_next ? (const char*)g.Bt + (size_t)nxt.pn * tstep : cB;
        for (int t = 0; t < nt; t += 2) {
            const bool last = (t == nt - 2);
            const char* a1 = cA + (size_t)(t + 1) * kstep;
            const char* a2 = last ? nA : cA + (size_t)(t + 2) * kstep; const char* b2 = last ? nB : cB + (size_t)(t + 2) * kstep;
            const char* a3 = a2 + kstep; const char* b3 = b2 + kstep;
            if (last && has_next) S.a_ready(nxt);
            PG8_LDB(B0, 0, 0); PG8_SCHED; PG8_LDA(At, 0, 0); PG8_STAGE(PG8_SA(1, 1), a1 + hstep, voffA);
            PG8_WAIT_L(8); PG8_BAR; PG8_WAIT_L(0); PG8_MMA(0, 0, At, B0); PG8_BAR; PG8_SCHED;
            PG8_LDB(B1, 0, 1); PG8_STAGE(PG8_SB(0, 0), b2, voffB);
            PG8_BAR; PG8_WAIT_L(0); PG8_MMA(0, 1, At, B1); PG8_BAR;
            PG8_LDA(At, 0, 1); PG8_STAGE(PG8_SA(0, 0), a2, voffA);
            PG8_BAR; PG8_WAIT_L(0); PG8_MMA(1, 0, At, B0); PG8_BAR; PG8_SCHED;
            PG8_STAGE(PG8_SB(0, 1), b2 + hstep, voffB);
            PG8_WAIT_V(6); PG8_BAR; PG8_MMA(1, 1, At, B1); PG8_BAR;
            PG8_LDB(B0, 1, 0); PG8_SCHED; PG8_LDA(At, 1, 0); PG8_STAGE(PG8_SA(0, 1), a2 + hstep, voffA);
            PG8_WAIT_L(8); PG8_BAR; PG8_WAIT_L(0); PG8_MMA(0, 0, At, B0); PG8_BAR; PG8_SCHED;
            PG8_LDB(B1, 1, 1); PG8_STAGE(PG8_SB(1, 0), b3, voffB);
            PG8_BAR; PG8_WAIT_L(0); PG8_MMA(0, 1, At, B1); PG8_BAR;
            PG8_LDA(At, 1, 1); PG8_STAGE(PG8_SA(1, 0), a3, voffA);
            PG8_BAR; PG8_WAIT_L(0); PG8_MMA(1, 0, At, B0); PG8_BAR; PG8_SCHED;
            PG8_STAGE(PG8_SB(1, 1), b3 + hstep, voffB);
            PG8_WAIT_V(6); PG8_BAR; PG8_MMA(1, 1, At, B1); PG8_BAR;
        }
        PG8_STAMP();
        if constexpr (!Epi::AFTER_DRAIN) { E(acc, cur, wr, wc, fr, fq); S.done(cur); }
        PG8_STAMP();
        if (!has_next) break;
#pragma unroll
        for (int a = 0; a < 2; ++a)
#pragma unroll
            for (int b = 0; b < 2; ++b)
#pragma unroll
                for (int m = 0; m < 4; ++m)
#pragma unroll
                    for (int n = 0; n < 2; ++n) acc[a][b][m][n] = (f32x4){0.f, 0.f, 0.f, 0.f};
        cur = nxt; cA = nA; cB = nB; ++ui;
    }
    PG8_WAIT_V(0);
    if (wr == 0) PG8_BAR;
    PG8_BAR;
    if constexpr (Epi::AFTER_DRAIN) { E.fused(acc, cur, wr, wc, fr, fq, lds, wid, lane); S.done(cur); }
    PG8_STAMP();
    if (STAMP && wid == 0) { stamps[lane] = lane < nts ? (((unsigned long long)(unsigned)ts_hi << 32) | (unsigned)ts_lo) : 0ull;
        if (lane == 62) stamps[62] = rt_entry; if (lane == 63) stamps[63] = (unsigned long long)wall_clock64(); }
#undef PG8_STAMP
#undef PG8_SA
#undef PG8_SB
#undef PG8_STAGE
#undef PG8_LDA
#undef PG8_LDB
#undef PG8_MMA
#undef PG8_WAIT_V
#undef PG8_WAIT_L
#undef PG8_BAR
#undef PG8_SCHED
}
}

struct EpiEvin {
  static constexpr bool PERM = true, AFTER_DRAIN = false;
  bf16_t *ZQK, *ZV, *ZO, *ZP; const float* bias;
  __device__ __forceinline__ void operator()(const pg8::f32x4 (&acc)[2][2][4][2], const pg8::Unit& u, int wr, int wc, int fr, int fq) const {
    const int row0 = u.pm * 256 + wr * 64 + fr, ct = u.pn * 256;
    bf16_t* base; int ldc, cl; bool sig = false;
    if (ct < 1024) { base = ZQK; ldc = 1024; cl = ct; } else if (ct < 1536) { base = ZV; ldc = 512; cl = ct - 1024; } else if (ct < 2048) { base = ZO; ldc = 512; cl = ct - 1536; sig = true; } else { base = ZP; ldc = 512; cl = ct - 2048; }
    const int cofs = wc * 32 + 8 * fq;
    pg8::f32x4 bv[2][2];
#pragma unroll
    for (int bj = 0; bj < 2; ++bj)
#pragma unroll
      for (int n = 0; n < 2; ++n) bv[bj][n] = *(const pg8::f32x4*)(bias + ct + cofs + bj * 128 + 4 * n);
#pragma unroll
    for (int ai = 0; ai < 2; ++ai)
#pragma unroll
      for (int m = 0; m < 4; ++m) { bf16_t* rowp = base + (size_t)(row0 + ai * 128 + m * 16) * ldc + cl + cofs;
#pragma unroll
        for (int bj = 0; bj < 2; ++bj) { pg8::f32x4 v0 = acc[ai][bj][m][0] + bv[bj][0], v1 = acc[ai][bj][m][1] + bv[bj][1];
          if (sig) {
#pragma unroll
            for (int j = 0; j < 4; ++j) { v0[j] = sigmf(v0[j]); v1[j] = sigmf(v1[j]); } }
          pg8::u32x4 w; w.x = pg8::cvt_pk_bf16(v0[0], v0[1]); w.y = pg8::cvt_pk_bf16(v0[2], v0[3]); w.z = pg8::cvt_pk_bf16(v1[0], v1[1]); w.w = pg8::cvt_pk_bf16(v1[2], v1[3]);
          *(pg8::u32x4*)(rowp + bj * 128) = w; } }
  }
};
struct EpiPlain {
  static constexpr bool PERM = true, AFTER_DRAIN = false;
  bf16_t* out; int ldc;
  __device__ __forceinline__ void operator()(const pg8::f32x4 (&acc)[2][2][4][2], const pg8::Unit& u, int wr, int wc, int fr, int fq) const {
    const int row0 = u.pm * 256 + wr * 64 + fr, col0 = u.pn * 256 + wc * 32 + 8 * fq;
#pragma unroll
    for (int ai = 0; ai < 2; ++ai)
#pragma unroll
      for (int m = 0; m < 4; ++m) { bf16_t* rowp = out + (size_t)(row0 + ai * 128 + m * 16) * ldc + col0;
#pragma unroll
        for (int bj = 0; bj < 2; ++bj) { const pg8::f32x4 v0 = acc[ai][bj][m][0], v1 = acc[ai][bj][m][1];
          pg8::u32x4 w; w.x = pg8::cvt_pk_bf16(v0[0], v0[1]); w.y = pg8::cvt_pk_bf16(v0[2], v0[3]); w.z = pg8::cvt_pk_bf16(v1[0], v1[1]); w.w = pg8::cvt_pk_bf16(v1[2], v1[3]);
          *(pg8::u32x4*)(rowp + bj * 128) = w; } }
  }
};
struct EpiRes {
  static constexpr bool PERM = false, AFTER_DRAIN = false;
  const float* xin; float* X; const float* gate;
  __device__ __forceinline__ void operator()(const pg8::f32x4 (&acc)[2][2][4][2], const pg8::Unit& u, int wr, int wc, int fr, int fq) const {
    const int row0 = u.pm * 256 + wr * 64 + fr, col0 = u.pn * 256 + wc * 32 + 4 * fq; const float* gb = gate + (size_t)((u.pm * 256) / S) * 6144;
    pg8::f32x4 gv[2][2];
#pragma unroll
    for (int bj = 0; bj < 2; ++bj)
#pragma unroll
      for (int n = 0; n < 2; ++n) gv[bj][n] = *(const pg8::f32x4*)(gb + col0 + bj * 128 + n * 16);
#pragma unroll
    for (int ai = 0; ai < 2; ++ai)
#pragma unroll
      for (int m = 0; m < 4; ++m) { const size_t off = (size_t)(row0 + ai * 128 + m * 16) * 1024 + col0;
#pragma unroll
        for (int bj = 0; bj < 2; ++bj)
#pragma unroll
          for (int n = 0; n < 2; ++n) { const pg8::f32x4 xi = *(const pg8::f32x4*)(xin + off + bj * 128 + n * 16); *(pg8::f32x4*)(X + off + bj * 128 + n * 16) = xi + gv[bj][n] * acc[ai][bj][m][n]; }
        asm volatile("" ::: "memory"); }
  }
};
template <class Epi> __device__ __forceinline__ void phase_gemm_fast(const bf16_t* A, const bf16_t* Bt, int M, int N, int K, const Epi& E, char* smem) {
  pg8::Gemm g; g.A = A; g.Bt = Bt; g.M = M; g.N = N; g.K = K;
  pg8::StaticOrder So; So.init(M, N, (int)gridDim.x, (int)blockIdx.x);
  pg8::gemm_phase<Epi, pg8::StaticOrder, false>((PG8_LAS unsigned char*)smem, g, So, E, nullptr);
}

namespace cp {
typedef short bf16x8 __attribute__((ext_vector_type(8)));
typedef float f32x16 __attribute__((ext_vector_type(16)));
constexpr int RS = 272;
__device__ __forceinline__ void unpack8(const u32x4 w, float* f) { f[0] = bflo(w.x); f[1] = bfhi(w.x); f[2] = bflo(w.y); f[3] = bfhi(w.y); f[4] = bflo(w.z); f[5] = bfhi(w.z); f[6] = bflo(w.w); f[7] = bfhi(w.w); }
__device__ void phase_convpool(const Params& p, char* smem) {
  for (int job = blockIdx.x; job < T / 64; job += gridDim.x) {
    int tid_ = threadIdx.x; asm volatile("" : "+v"(tid_));
    const int tid = tid_, c0 = (tid & 127) * 8, t0 = job * 64 + (tid >> 7) * 16, s0 = t0 & (S - 1);
    float cw[5][8], cb[8];
#pragma unroll
    for (int j = 0; j < 5; ++j) { const f32x4 a = *(const f32x4*)(p.conv_w + j * 1024 + c0), b = *(const f32x4*)(p.conv_w + j * 1024 + c0 + 4); cw[j][0] = a.x; cw[j][1] = a.y; cw[j][2] = a.z; cw[j][3] = a.w; cw[j][4] = b.x; cw[j][5] = b.y; cw[j][6] = b.z; cw[j][7] = b.w; }
    { const f32x4 a = *(const f32x4*)(p.conv_b + c0), b = *(const f32x4*)(p.conv_b + c0 + 4); cb[0] = a.x; cb[1] = a.y; cb[2] = a.z; cb[3] = a.w; cb[4] = b.x; cb[5] = b.y; cb[6] = b.z; cb[7] = b.w; }
    const float sc = c0 >= 512 ? KSCALE : 1.f;
    float win[5][8];
#pragma unroll
    for (int j = 0; j < 4; ++j) { const int ss = s0 + j - 2; u32x4 w = (u32x4){0u, 0u, 0u, 0u}; if (ss >= 0 && ss < S) w = *(const u32x4*)(p.ZQK + (size_t)(t0 + j - 2) * 1024 + c0); unpack8(w, win[j + 1]); }
#pragma unroll
    for (int i = 0; i < 16; ++i) {
#pragma unroll
      for (int j = 0; j < 4; ++j)
#pragma unroll
        for (int q = 0; q < 8; ++q) win[j][q] = win[j + 1][q];
      { const int ss = s0 + i + 2; u32x4 w = (u32x4){0u, 0u, 0u, 0u}; if (ss < S) w = *(const u32x4*)(p.ZQK + (size_t)(t0 + i + 2) * 1024 + c0); unpack8(w, win[4]); }
      float a[8];
#pragma unroll
      for (int q = 0; q < 8; ++q) { float v = cb[q];
#pragma unroll
        for (int j = 0; j < 5; ++j) v += cw[j][q] * win[j][q];
        a[q] = siluf(v) * sc; }
      u32x4 o; o.x = pack2(a[0], a[1]); o.y = pack2(a[2], a[3]); o.z = pack2(a[4], a[5]); o.w = pack2(a[6], a[7]); *(u32x4*)(p.QK + (size_t)(t0 + i) * 1024 + c0) = o;
    }
  }
  for (int job = blockIdx.x; job < (T / 128) * 4; job += gridDim.x) {
    int tid_ = threadIdx.x; asm volatile("" : "+v"(tid_));
    const int tid = tid_, wid = tid >> 6, lane = tid & 63, l31 = lane & 31, hh = lane >> 5;
    const int g = job & 3, t0 = (job >> 2) * 128, win = 2 << g, hw = win >> 1;
    __syncthreads();
#pragma unroll
    for (int i = 0; i < 4; ++i) { const int idx = tid + i * NTHREADS, row = idx >> 4, ch = idx & 15; *(u32x4*)(smem + 128 * RS + row * RS + ch * 16) = *(const u32x4*)(p.poolWt + (size_t)g * 16384 + row * 128 + ch * 8); }
#pragma unroll 1
    for (int i = 0; i < 4; ++i) { const int idx = tid + i * NTHREADS, row = idx >> 4, ch = idx & 15, t = t0 + row, s = t & (S - 1); const int lo = max(s - hw, 0), hi = min(s + hw, S);
      float sum[8], own[8];
#pragma unroll
      for (int q = 0; q < 8; ++q) sum[q] = 0.f;
      const bf16_t* base = p.ZP + (size_t)(t - s) * 512 + g * 128 + ch * 8;
      for (int r = lo; r < hi; ++r) { float f[8]; unpack8(*(const u32x4*)(base + (size_t)r * 512), f);
#pragma unroll
        for (int q = 0; q < 8; ++q) sum[q] += f[q]; }
      unpack8(*(const u32x4*)(base + (size_t)s * 512), own); const float inv = 1.f / (float)(hi - lo);
      u32x4 o; o.x = pack2(sum[0] * inv - own[0], sum[1] * inv - own[1]); o.y = pack2(sum[2] * inv - own[2], sum[3] * inv - own[3]); o.z = pack2(sum[4] * inv - own[4], sum[5] * inv - own[5]); o.w = pack2(sum[6] * inv - own[6], sum[7] * inv - own[7]);
      *(u32x4*)(smem + row * RS + ch * 16) = o; }
    __syncthreads();
    const int mt = wid >> 1;
#pragma unroll
    for (int q = 0; q < 2; ++q) { const int nt = (wid & 1) * 2 + q;
      f32x16 acc;
#pragma unroll
      for (int r = 0; r < 16; ++r) acc[r] = 0.f;
      const char* ya = smem + (mt * 32 + l31) * RS + hh * 16; const char* wb = smem + 128 * RS + (nt * 32 + l31) * RS + hh * 16;
#pragma unroll
      for (int ks = 0; ks < 8; ++ks) acc = __builtin_amdgcn_mfma_f32_32x32x16_bf16(*(const bf16x8*)(ya + ks * 32), *(const bf16x8*)(wb + ks * 32), acc, 0, 0, 0);
      const int e = nt * 32 + l31; const float psc = p.pool_sc[g * 128 + e];
#pragma unroll
      for (int r = 0; r < 16; ++r) { const int row = mt * 32 + (r & 3) + 8 * (r >> 2) + 4 * hh; p.CAT[(size_t)(t0 + row) * 1024 + 512 + g * 128 + e] = f2bf(acc[r] * psc); } }
  }
}
}

__device__ void phase_mlstm_naive(const Params& p, char* smem) {
  float* qs = (float*)smem; float* ks = qs + 128; float* nump = ks + 128; float* red = nump + 512;
  const int tid = threadIdx.x, j = tid & 127, qd = tid >> 7;
  for (int job = blockIdx.x; job < 64; job += gridDim.x) {
    const int dir = job >> 5, b = (job >> 2) & 7, h = job & 3;
    float C[32];
#pragma unroll
    for (int d = 0; d < 32; ++d) C[d] = 0.f;
    float n = 0.f, m = 0.f;
    for (int step = 0; step < S; ++step) { const int s = dir ? S - 1 - step : step; const size_t t = (size_t)b * S + s;
      const float li = p.gates[t * 16 + dir * 4 + h], gf = p.gates[t * 16 + 8 + dir * 4 + h];
      const float lf = fminf(gf, 0.f) - log1pf(__expf(-fabsf(gf)));
      __syncthreads();
      if (qd == 0) { qs[j] = bf2f(p.QK[t * 1024 + h * 128 + j]); ks[j] = bf2f(p.QK[t * 1024 + 512 + h * 128 + j]); }
      const float v = bf2f(p.ZV[t * 512 + h * 128 + j]);
      __syncthreads();
      const float mn = fmaxf(lf + m, li), ip = __expf(li - mn), fp = __expf(lf + m - mn); m = mn;
      float num = 0.f;
#pragma unroll
      for (int d = 0; d < 32; ++d) { C[d] = fp * C[d] + ip * ks[qd * 32 + d] * v; num += qs[qd * 32 + d] * C[d]; }
      float dp = 0.f; if (qd == 0) { n = fp * n + ip * ks[j]; dp = qs[j] * n; }
      nump[qd * 128 + j] = num;
      dp = wave_sum(dp); if ((tid & 63) == 0) red[tid >> 6] = dp;
      __syncthreads();
      if (qd == 0) { const float den = red[0] + red[1]; num = nump[j] + nump[128 + j] + nump[256 + j] + nump[384 + j];
        p.HS[((size_t)dir * T + t) * 512 + h * 128 + j] = f2bf(num / fmaxf(fabsf(den), __expf(-mn))); }
    }
    __syncthreads();
  }
}

namespace ml {
typedef short bf16x8 __attribute__((ext_vector_type(8)));
typedef short s16x4 __attribute__((ext_vector_type(4)));
typedef float f32x16 __attribute__((ext_vector_type(16)));
constexpr int RS = 272;
constexpr int OFF_Q = 0, OFF_K = 128 * RS, OFF_VT = 2 * 128 * RS, OFF_VW = OFF_VT + 34 * RS, OFF_CT = OFF_VW + 34 * RS, OFF_A = OFF_CT + 34 * RS;
constexpr int OFF_PA = OFF_A + 16384, OFF_MCH = OFF_PA + 16384, OFF_TAB = OFF_MCH + 512, OFF_DEN = OFF_TAB + 4096, OFF_END = OFF_DEN + 512;
static_assert(OFF_A % 16 == 0 && OFF_END <= SMEM_BYTES, "mlstm LDS layout");
__device__ __forceinline__ int crow(int r, int h) { return (r & 3) + 8 * (r >> 2) + 4 * h; }
__device__ __forceinline__ int spos(int s) { return (s & ~12) | ((s & 4) << 1) | ((s & 8) >> 1); }
#define ML_MFMA(a, b, c) __builtin_amdgcn_mfma_f32_32x32x16_bf16((a), (b), (c), 0, 0, 0)
__device__ __forceinline__ bf16x8 pack8(float x0, float x1, float x2, float x3, float x4, float x5, float x6, float x7) {
  u32x4 w; w.x = pack2(x0, x1); w.y = pack2(x2, x3); w.z = pack2(x4, x5); w.w = pack2(x6, x7); return __builtin_bit_cast(bf16x8, w);
}
__device__ __forceinline__ void tr_read2(unsigned a0, unsigned a1, s16x4& lo, s16x4& hi) {
  asm volatile("ds_read_b64_tr_b16 %0, %2\n\tds_read_b64_tr_b16 %1, %3\n\ts_waitcnt lgkmcnt(0)" : "=&v"(lo), "=&v"(hi) : "v"(a0), "v"(a1) : "memory");
}

__device__ void phase_mlstm(const Params& p, char* smem) {
  int tid_ = threadIdx.x; asm volatile("" : "+v"(tid_));
  const int tid = tid_, wid = tid >> 6, lane = tid & 63, l31 = lane & 31, hh = lane >> 5;
  float* const LA = (float*)(smem + OFF_A); float* const LPA = (float*)(smem + OFF_PA); float* const LM = (float*)(smem + OFF_MCH);
  float* const LTAB = (float*)(smem + OFF_TAB); float* const LDEN = (float*)(smem + OFF_DEN);
  const unsigned lds0 = (unsigned)(uintptr_t)smem;
  for (int job = blockIdx.x; job < 256; job += gridDim.x) {
    const int dvq = job & 3, h = (job >> 2) & 3, b = (job >> 4) & 7, dir = job >> 7;
    const float* gts = p.gates + (size_t)b * S * 16;
    const bf16_t* QKb = p.QK + (size_t)b * S * 1024 + h * 128; const bf16_t* ZVb = p.ZV + (size_t)b * S * 512 + h * 128 + dvq * 32;
    bf16_t* HSb = p.HS + ((size_t)dir * T + (size_t)b * S) * 512 + h * 128 + dvq * 32;
    __syncthreads();
    for (int i = tid; i < 3 * 34 * RS / 4; i += NTHREADS) ((u32*)(smem + OFF_VT))[i] = 0u;
    for (int cc = 0; cc < 4; ++cc) { const int c = wid * 4 + cc, tau0 = c * 128 + 2 * lane; const int tok0 = dir ? S - 1 - tau0 : tau0, tok1 = dir ? tok0 - 1 : tok0 + 1;
      const float li0 = gts[(size_t)tok0 * 16 + dir * 4 + h], gf0 = gts[(size_t)tok0 * 16 + 8 + dir * 4 + h], li1 = gts[(size_t)tok1 * 16 + dir * 4 + h], gf1 = gts[(size_t)tok1 * 16 + 8 + dir * 4 + h];
      const float lf0 = fminf(gf0, 0.f) - log1pf(__expf(-fabsf(gf0))), lf1 = fminf(gf1, 0.f) - log1pf(__expf(-fabsf(gf1)));
      const float pr = lf0 + lf1; float incl = pr;
#pragma unroll
      for (int o = 1; o < 64; o <<= 1) { const float v = __shfl_up(incl, o); if (lane >= o) incl += v; }
      const float b0 = incl - pr + lf0, b1 = b0 + lf1, a0 = li0 - b0, a1 = li1 - b1;
      float im = fmaxf(a0, a1);
#pragma unroll
      for (int o = 1; o < 64; o <<= 1) { const float v = __shfl_up(im, o); if (lane >= o) im = fmaxf(im, v); }
      float ex = __shfl_up(im, 1); if (lane == 0) ex = -INFINITY;
      const float pa0 = fmaxf(ex, a0), pa1 = fmaxf(pa0, a1);
      LA[tau0] = a0; LA[tau0 + 1] = a1; LPA[tau0] = pa0; LPA[tau0 + 1] = pa1; if (lane == 63) LM[64 + c] = b1; }
    __syncthreads();
    if (tid == 0) { float m = 0.f; for (int c = 0; c < 32; ++c) { LM[c] = m; m = LM[64 + c] + fmaxf(m, LPA[c * 128 + 127]); } LM[32] = m; }
    __syncthreads();
    u32x4 qreg[4], kreg[4], vreg;
#define ML_TOK(tau) (dir ? S - 1 - (tau) : (tau))
#define ML_LOAD(c) do { _Pragma("unroll") for (int i_ = 0; i_ < 4; ++i_) { const int tk_ = ML_TOK((c) * 128 + (tid >> 4) + 32 * i_); \
        qreg[i_] = *(const u32x4*)(QKb + (size_t)tk_ * 1024 + (tid & 15) * 8); kreg[i_] = *(const u32x4*)(QKb + (size_t)tk_ * 1024 + 512 + (tid & 15) * 8); } \
      { const int tk_ = ML_TOK((c) * 128 + (tid >> 2)); vreg = *(const u32x4*)(ZVb + (size_t)tk_ * 512 + (tid & 3) * 8); } } while (0)
#define ML_TABLES(c) do { if (tid < 128) { const int tau_ = (c) * 128 + tid, tk_ = ML_TOK(tau_); const float li_ = gts[(size_t)tk_ * 16 + dir * 4 + h], a_ = LA[tau_], mc_ = LM[(c)]; \
        const float Mj_ = fmaxf(mc_, LPA[tau_]), Me_ = fmaxf(mc_, LPA[(c) * 128 + 127]); float* tb_ = LTAB + ((c) & 1) * 512; \
        tb_[tid] = Mj_; tb_[128 + tid] = __expf(mc_ - Mj_); tb_[256 + tid] = __expf(-((li_ - a_) + Mj_)); tb_[384 + tid] = __expf(a_ - Me_); } } while (0)
#define ML_STORE(c) do { _Pragma("unroll") for (int i_ = 0; i_ < 4; ++i_) { const int row_ = (tid >> 4) + 32 * i_; \
        *(u32x4*)(smem + OFF_Q + row_ * RS + (tid & 15) * 16) = qreg[i_]; *(u32x4*)(smem + OFF_K + row_ * RS + (tid & 15) * 16) = kreg[i_]; } \
      { const int s_ = tid >> 2, ps_ = spos(s_) * 2; const float we_ = LTAB[((c) & 1) * 512 + 384 + s_]; const u32 vw_[4] = {vreg.x, vreg.y, vreg.z, vreg.w}; \
        _Pragma("unroll") for (int i_ = 0; i_ < 4; ++i_) { const int r0_ = ((tid & 3) * 8 + 2 * i_) * RS + ps_; \
          *(bf16_t*)(smem + OFF_VT + r0_) = (bf16_t)(vw_[i_] & 0xFFFFu); *(bf16_t*)(smem + OFF_VT + r0_ + RS) = (bf16_t)(vw_[i_] >> 16); \
          *(bf16_t*)(smem + OFF_VW + r0_) = f2bf(bflo(vw_[i_]) * we_); *(bf16_t*)(smem + OFF_VW + r0_ + RS) = f2bf(bfhi(vw_[i_]) * we_); } } \
      if (tid < 128) { const int ps_ = spos(tid) * 2; *(bf16_t*)(smem + OFF_VT + 32 * RS + ps_) = (bf16_t)0x3F80u; *(bf16_t*)(smem + OFF_VW + 32 * RS + ps_) = f2bf(LTAB[((c) & 1) * 512 + 384 + tid]); } } while (0)
    ML_LOAD(0); ML_TABLES(0);
    __syncthreads();
    ML_STORE(0);
    __syncthreads();
    f32x16 Cacc;
#pragma unroll
    for (int r = 0; r < 16; ++r) Cacc[r] = 0.f;
    for (int c = 0; c < 32; ++c) {
      int tidc_ = threadIdx.x; asm volatile("" : "+v"(tidc_));
      const int tid = tidc_, wid = tid >> 6, lane = tid & 63, l31 = lane & 31, hh = lane >> 5;
      const int t2 = wid >> 1, nt = wid & 1, brow = min(nt * 32 + l31, 33);
      if (c + 1 < 32) { ML_LOAD(c + 1); ML_TABLES(c + 1); }
      const float* tab = LTAB + (c & 1) * 512;
      f32x16 acc;
#pragma unroll
      for (int r = 0; r < 16; ++r) acc[r] = 0.f;
      const char* qa = smem + OFF_Q + (t2 * 32 + l31) * RS + hh * 16;
      { const char* cb = smem + OFF_CT + brow * RS + hh * 16;
#pragma unroll
        for (int ks = 0; ks < 8; ++ks) acc = ML_MFMA(*(const bf16x8*)(qa + ks * 32), *(const bf16x8*)(cb + ks * 32), acc); }
#pragma unroll
      for (int r = 0; r < 16; ++r) acc[r] *= tab[128 + t2 * 32 + crow(r, hh)];
      const float Mj = tab[t2 * 32 + l31];
      for (int si = 0; si <= t2; ++si) {
        f32x16 X;
#pragma unroll
        for (int r = 0; r < 16; ++r) X[r] = 0.f;
        const char* ka = smem + OFF_K + (si * 32 + l31) * RS + hh * 16;
#pragma unroll
        for (int ks = 0; ks < 8; ++ks) X = ML_MFMA(*(const bf16x8*)(ka + ks * 32), *(const bf16x8*)(qa + ks * 32), X);
        const float* Ac = LA + c * 128 + si * 32;
#pragma unroll
        for (int r = 0; r < 16; ++r) { const int sl = crow(r, hh); float w = __expf(Ac[sl] - Mj); if (si == t2 && sl > l31) w = 0.f; X[r] *= w; }
        const bf16x8 f0 = pack8(X[0], X[1], X[2], X[3], X[4], X[5], X[6], X[7]), f1 = pack8(X[8], X[9], X[10], X[11], X[12], X[13], X[14], X[15]);
        const char* vb = smem + OFF_VT + brow * RS + si * 64 + hh * 16;
        acc = ML_MFMA(f0, *(const bf16x8*)(vb), acc); acc = ML_MFMA(f1, *(const bf16x8*)(vb + 32), acc);
      }
      if (nt == 1 && l31 == 0) {
#pragma unroll
        for (int r = 0; r < 16; ++r) LDEN[t2 * 32 + crow(r, hh)] = acc[r]; }
      { const float mc = LM[c], decay = __expf(mc - fmaxf(mc, LPA[c * 128 + 127]));
#pragma unroll
        for (int r = 0; r < 16; ++r) Cacc[r] *= decay;
        const unsigned ta = lds0 + OFF_K + ((lane & 15) >> 2) * RS + (t2 * 32 + 16 * ((lane >> 4) & 1) + 4 * (lane & 3)) * 2 + 4 * hh * RS;
        const char* wb = smem + OFF_VW + brow * RS + hh * 16;
#pragma unroll
        for (int ks = 0; ks < 8; ++ks) { s16x4 lo, hi; tr_read2(ta + 16 * ks * RS, ta + (16 * ks + 8) * RS, lo, hi); __builtin_amdgcn_sched_barrier(0);
          const bf16x8 a = (bf16x8){lo[0], lo[1], lo[2], lo[3], hi[0], hi[1], hi[2], hi[3]};
          Cacc = ML_MFMA(a, *(const bf16x8*)(wb + ks * 32), Cacc); } }
      __syncthreads();
      if (nt == 0) {
#pragma unroll
        for (int r = 0; r < 16; ++r) { const int j = t2 * 32 + crow(r, hh); const float dn = LDEN[j], nr = tab[256 + j]; const int tk = ML_TOK(c * 128 + j);
          HSb[(size_t)tk * 512 + l31] = f2bf(acc[r] / fmaxf(fabsf(dn), nr)); } }
      if (nt * 32 + l31 <= 32) { char* cw = smem + OFF_CT + (nt * 32 + l31) * RS + (t2 * 32 + 4 * hh) * 2;
#pragma unroll
        for (int g = 0; g < 4; ++g) { u32x2 w; w.x = pack2(Cacc[4 * g], Cacc[4 * g + 1]); w.y = pack2(Cacc[4 * g + 2], Cacc[4 * g + 3]); *(u32x2*)(cw + 16 * g) = w; } }
      if (c + 1 < 32) ML_STORE(c + 1);
      __syncthreads();
    }
#undef ML_TOK
#undef ML_LOAD
#undef ML_TABLES
#undef ML_STORE
  }
}
}

__device__ void phase_cat(const Params& p) {
  const int tid = threadIdx.x, wid = tid >> 6, lane = tid & 63;
  for (int job = blockIdx.x; job < T * 4 / 8; job += gridDim.x) {
    const int w = job * 8 + wid, t = w >> 2, h = w & 3; const size_t o = (size_t)t * 512 + h * 128 + lane * 2;
    const u32 a = *(const u32*)(p.HS + o), b = *(const u32*)(p.HS + (size_t)T * 512 + o), so = *(const u32*)(p.ZO + o);
    const float a0 = bflo(a) + bflo(b), a1 = bfhi(a) + bfhi(b); const float r = rsqrtf(wave_sum(a0 * a0 + a1 * a1) * (1.f / 128.f) + EPS);
    *(u32*)(p.CAT + (size_t)t * 1024 + h * 128 + lane * 2) = pack2(a0 * r * p.mnorm_g[h * 128 + lane * 2] * bflo(so), a1 * r * p.mnorm_g[h * 128 + lane * 2 + 1] * bfhi(so));
  }
}

__device__ void phase_peer_select_naive(const Params& p, int layer, char* smem) {
  float* kl = (float*)smem;
  float* qsh = kl + 2 * 128 * 129;
  const int tid = threadIdx.x, wid = tid >> 6, lane = tid & 63; float* qs = qsh + wid * 128;
  __syncthreads();
  for (int i = tid; i < 2 * 128 * 128; i += NTHREADS) kl[(i >> 7) * 129 + (i & 127)] = p.peer_keys[(size_t)layer * 32768 + i];
  __syncthreads();
  for (int job = blockIdx.x; job < T; job += gridDim.x) {
    const int t = job, h = wid;
    float ts[2][16]; int ti[2][16];
#pragma unroll
    for (int pp = 0; pp < 2; ++pp) {
      const bf16_t* q = p.QP + (size_t)t * 2048 + h * 256 + pp * 128; const float q0 = bf2f(q[lane]), q1 = bf2f(q[lane + 64]);
      const float r = rsqrtf(wave_sum(q0 * q0 + q1 * q1) * (1.f / 128.f) + EPS); qs[lane] = q0 * r; qs[lane + 64] = q1 * r;
      float s0 = 0.f, s1 = 0.f; const float* k0 = kl + (pp * 128 + lane) * 129; const float* k1 = k0 + 64 * 129;
      for (int c = 0; c < 128; ++c) { const float qc = qs[c]; s0 += qc * k0[c]; s1 += qc * k1[c]; }
#pragma unroll
      for (int k = 0; k < 16; ++k) { const float mx = wave_max(fmaxf(s0, s1)); int cand = (s0 == mx) ? lane : ((s1 == mx) ? lane + 64 : 9999);
        for (int o = 32; o >= 1; o >>= 1) cand = min(cand, __shfl_xor(cand, o));
        ts[pp][k] = mx; ti[pp][k] = cand; if (cand == lane) s0 = -INFINITY; if (cand == lane + 64) s1 = -INFINITY; }
    }
    float cs[4];
#pragma unroll
    for (int r = 0; r < 4; ++r) { const int c = lane * 4 + r; float va = 0.f, vb = 0.f;
#pragma unroll
      for (int k = 0; k < 16; ++k) { if (k == (c >> 4)) va = ts[0][k]; if (k == (c & 15)) vb = ts[1][k]; }
      cs[r] = va + vb; }
    float top[16]; int tix[16];
#pragma unroll
    for (int k = 0; k < 16; ++k) { const float mx = wave_max(fmaxf(fmaxf(cs[0], cs[1]), fmaxf(cs[2], cs[3]))); int cand = 9999;
#pragma unroll
      for (int r = 3; r >= 0; --r) if (cs[r] == mx) cand = lane * 4 + r;
      for (int o = 32; o >= 1; o >>= 1) cand = min(cand, __shfl_xor(cand, o));
      top[k] = mx; tix[k] = cand;
#pragma unroll
      for (int r = 0; r < 4; ++r) if (cand == lane * 4 + r) cs[r] = -INFINITY; }
    float sum = 0.f;
#pragma unroll
    for (int k = 0; k < 16; ++k) sum += __expf(top[k] - top[0]);
    if (lane < 16) { float tv = 0.f; int tc = 0;
#pragma unroll
      for (int k = 0; k < 16; ++k) if (k == lane) { tv = top[k]; tc = tix[k]; }
      int ia = 0, ib = 0;
#pragma unroll
      for (int k = 0; k < 16; ++k) { if (k == (tc >> 4)) ia = ti[0][k]; if (k == (tc & 15)) ib = ti[1][k]; }
      p.pidx[((size_t)t * 8 + h) * 16 + lane] = (bf16_t)(ia * 128 + ib); p.pgate[((size_t)t * 8 + h) * 16 + lane] = __expf(tv - top[0]) / sum; }
  }
}

namespace sel {
typedef short bf16x8 __attribute__((ext_vector_type(8)));
typedef float f32x16 __attribute__((ext_vector_type(16)));
constexpr int RS = 272, OFF_W = 2 * 128 * RS, WB = 3 * 16 * 32 * 4;
static_assert(OFF_W + 8 * WB <= SMEM_BYTES, "select LDS layout");
constexpr float NEG = -3.0e38f;
__device__ __forceinline__ float max3(float a, float b, float c) { return fmaxf(fmaxf(a, b), c); }
__device__ __forceinline__ float xhalf(float v) { return __shfl_xor(v, 32); }

__device__ void phase_peer_select(const Params& p, int layer, char* smem) {
  const int tid0 = threadIdx.x;
  __syncthreads();
  { const bf16_t* kb = p.keysb + (size_t)layer * 32768;
    for (int i = tid0; i < 2 * 128 * 16; i += NTHREADS) { const int row = i >> 4, ch = i & 15; *(u32x4*)(smem + row * RS + ch * 16) = *(const u32x4*)(kb + (size_t)row * 128 + ch * 8); } }
  __syncthreads();
  for (int job = blockIdx.x; job < T / 32; job += gridDim.x) {
    int tid_ = threadIdx.x; asm volatile("" : "+v"(tid_));
    const int tid = tid_, wid = tid >> 6, lane = tid & 63, l31 = lane & 31, hh = lane >> 5, h = wid;
    const int t = job * 32 + l31;
    float* const wl = (float*)(smem + OFF_W + wid * WB);
    float rs[2];
#pragma unroll
    for (int pp = 0; pp < 2; ++pp) {
      const bf16_t* qrow = p.QP + (size_t)t * 2048 + h * 256 + pp * 128 + hh * 8;
      bf16x8 bq[8]; float ssq = 0.f;
#pragma unroll
      for (int ks = 0; ks < 8; ++ks) { const u32x4 w = *(const u32x4*)(qrow + ks * 16); bq[ks] = __builtin_bit_cast(bf16x8, w);
        const u32 w0 = w.x, w1 = w.y, w2 = w.z, w3 = w.w; ssq = dot2bf(w0, w0, ssq); ssq = dot2bf(w1, w1, ssq); ssq = dot2bf(w2, w2, ssq); ssq = dot2bf(w3, w3, ssq); }
      ssq += xhalf(ssq); rs[pp] = rsqrtf(ssq * (1.f / 128.f) + EPS);
      f32x16 X[4];
#pragma unroll
      for (int nt = 0; nt < 4; ++nt) {
#pragma unroll
        for (int r = 0; r < 16; ++r) X[nt][r] = 0.f;
        const char* ka = smem + (pp * 128 + nt * 32 + l31) * RS + hh * 16;
#pragma unroll
        for (int ks = 0; ks < 8; ++ks) X[nt] = __builtin_amdgcn_mfma_f32_32x32x16_bf16(*(const bf16x8*)(ka + ks * 32), bq[ks], X[nt], 0, 0, 0); }
#pragma unroll
      for (int nt = 0; nt < 4; ++nt)
#pragma unroll
        for (int r = 0; r < 16; ++r) X[nt][r] = __uint_as_float((__float_as_uint(X[nt][r]) & ~0x7Fu) | (u32)(nt * 32 + (r & 3) + 8 * (r >> 2)) | ((u32)hh << 2));
#pragma unroll 1
      for (int k = 0; k < 16; ++k) {
        float m = NEG;
#pragma unroll
        for (int nt = 0; nt < 4; ++nt)
#pragma unroll
          for (int r = 0; r < 16; r += 2) m = max3(m, X[nt][r], X[nt][r + 1]);
        const float M = fmaxf(m, xhalf(m));
        wl[(pp * 16 + k) * 32 + l31] = M;
#pragma unroll
        for (int nt = 0; nt < 4; ++nt)
#pragma unroll
          for (int r = 0; r < 16; ++r) X[nt][r] = (X[nt][r] == M) ? NEG : X[nt][r];
      }
    }
    float s1[16], s2[16];
#pragma unroll
    for (int k = 0; k < 16; ++k) { s1[k] = wl[k * 32 + l31] * rs[0]; s2[k] = wl[(16 + k) * 32 + l31] * rs[1]; }
    constexpr int A0[25] = {0, 0, 0, 0, 0, 0, 0, 0, 0, 0, 0, 0, 0, 0, 0, 0, 2, 2, 2, 2, 2, 3, 3, 3, 3}, B0[25] = {0, 1, 2, 3, 4, 5, 6, 7, 8, 9, 10, 11, 12, 13, 14, 15, 0, 1, 2, 3, 4, 0, 1, 2, 3};
    constexpr int A1[25] = {1, 1, 1, 1, 1, 1, 1, 1, 4, 4, 4, 5, 5, 6, 6, 7, 7, 8, 9, 10, 11, 12, 13, 14, 15}, B1[25] = {0, 1, 2, 3, 4, 5, 6, 7, 0, 1, 2, 0, 1, 0, 1, 0, 1, 0, 0, 0, 0, 0, 0, 0, 0};
    float cd[25];
#pragma unroll
    for (int i = 0; i < 25; ++i) { const float v0 = s1[A0[i]] + s2[B0[i]], v1 = s1[A1[i]] + s2[B1[i]]; const float v = hh ? v1 : v0; const u32 cid = hh ? (u32)(A1[i] * 16 + B1[i]) : (u32)(A0[i] * 16 + B0[i]);
      cd[i] = __uint_as_float((__float_as_uint(v) & ~0xFFu) | cid); }
#pragma unroll 1
    for (int k = 0; k < 16; ++k) {
      float m = cd[24];
#pragma unroll
      for (int i = 0; i < 24; i += 2) m = max3(m, cd[i], cd[i + 1]);
      const float M = fmaxf(m, xhalf(m));
      wl[(32 + k) * 32 + l31] = M;
#pragma unroll
      for (int i = 0; i < 25; ++i) cd[i] = (cd[i] == M) ? NEG : cd[i];
    }
    float tv[16];
#pragma unroll
    for (int k = 0; k < 16; ++k) tv[k] = wl[(32 + k) * 32 + l31];
    float sum = 0.f;
#pragma unroll
    for (int k = 0; k < 16; ++k) sum += __expf(tv[k] - tv[0]);
    const float inv = 1.f / sum;
    u32 ev[8]; float go[8];
#pragma unroll
    for (int q = 0; q < 8; ++q) { const float v = wl[(32 + hh * 8 + q) * 32 + l31]; const u32 cid = __float_as_uint(v) & 0xFFu;
      const u32 i1 = __float_as_uint(wl[(cid >> 4) * 32 + l31]) & 0x7Fu, i2 = __float_as_uint(wl[(16 + (cid & 15)) * 32 + l31]) & 0x7Fu; ev[q] = i1 * 128 + i2;
      go[q] = __expf(v - tv[0]) * inv; }
    const u32 io0 = ev[0] | (ev[1] << 16), io1 = ev[2] | (ev[3] << 16), io2 = ev[4] | (ev[5] << 16), io3 = ev[6] | (ev[7] << 16);
    const size_t ob = ((size_t)t * 8 + h) * 16 + hh * 8;
    *(u32x4*)(p.pidx + ob) = (u32x4){io0, io1, io2, io3};
    *(f32x4*)(p.pgate + ob) = (f32x4){go[0], go[1], go[2], go[3]}; *(f32x4*)(p.pgate + ob + 4) = (f32x4){go[4], go[5], go[6], go[7]};
  }
}
}

typedef float f32x2 __attribute__((ext_vector_type(2)));
constexpr float U8_SCALE = 32.f, V8_SCALE = 2.f;
__device__ __forceinline__ float gelu_erf(float z) { return 0.5f * z * (1.f + erff(z * 0.70710678118654752f)); }
__device__ __forceinline__ float reduce8(float d0, float d1, float d2, float d3, float d4, float d5, float d6, float d7, int lane) {
  float e[4];
  { auto r0 = __builtin_amdgcn_permlane32_swap(__float_as_uint(d0), __float_as_uint(d4), false, false); e[0] = __uint_as_float(r0[0]) + __uint_as_float(r0[1]);
    auto r1 = __builtin_amdgcn_permlane32_swap(__float_as_uint(d1), __float_as_uint(d5), false, false); e[1] = __uint_as_float(r1[0]) + __uint_as_float(r1[1]);
    auto r2 = __builtin_amdgcn_permlane32_swap(__float_as_uint(d2), __float_as_uint(d6), false, false); e[2] = __uint_as_float(r2[0]) + __uint_as_float(r2[1]);
    auto r3 = __builtin_amdgcn_permlane32_swap(__float_as_uint(d3), __float_as_uint(d7), false, false); e[3] = __uint_as_float(r3[0]) + __uint_as_float(r3[1]); }
  float f0, f1;
  { auto r0 = __builtin_amdgcn_permlane16_swap(__float_as_uint(e[0]), __float_as_uint(e[2]), false, false); f0 = __uint_as_float(r0[0]) + __uint_as_float(r0[1]);
    auto r1 = __builtin_amdgcn_permlane16_swap(__float_as_uint(e[1]), __float_as_uint(e[3]), false, false); f1 = __uint_as_float(r1[0]) + __uint_as_float(r1[1]); }
  const bool up = (lane & 8) != 0; const float keep = up ? f1 : f0, send = up ? f0 : f1;
  float g = keep + __shfl_xor(send, 8);
  g += __shfl_xor(g, 4); g += __shfl_xor(g, 2); g += __shfl_xor(g, 1);
  return g;
}
template <int NEXT, bool DRY = false>
__device__ void phase_peer_gather(const Params& p, int layer) {
  const unsigned char* U8 = p.U8 + (size_t)layer * 16384 * 1024; const unsigned char* V8 = p.V8 + (size_t)layer * 16384 * 1024;
  for (int job = blockIdx.x; job < T / 8; job += gridDim.x) {
    int tid_ = threadIdx.x; asm volatile("" : "+v"(tid_));
    const int tid = tid_, wid = tid >> 6, lane = tid & 63;
    const int t = job * 8 + wid, b = t / S;
    const int vidx = 4 * (lane >> 5) + 2 * ((lane >> 4) & 1) + ((lane >> 3) & 1);
    const u32x4 h0 = *(const u32x4*)(p.H + (size_t)t * D + lane * 16), h1 = *(const u32x4*)(p.H + (size_t)t * D + lane * 16 + 8);
    const u32 hx[8] = {h0.x, h0.y, h0.z, h0.w, h1.x, h1.y, h1.z, h1.w};
    f32x2 acc[8];
#pragma unroll
    for (int i = 0; i < 8; ++i) acc[i] = (f32x2){0.f, 0.f};
#pragma unroll 1
    for (int hb = 0; hb < 16; ++hb) {
      const int myidx = (int)p.pidx[(size_t)t * 128 + hb * 8 + (lane & 7)];
      const float mygate = p.pgate[(size_t)t * 128 + hb * 8 + vidx];
      u32x4 ur[8], vr[8];
#pragma unroll
      for (int k = 0; k < 8; ++k) { const int e = __builtin_amdgcn_readlane(myidx, k); ur[k] = *(const u32x4*)(U8 + (size_t)e * 1024 + lane * 16); vr[k] = *(const u32x4*)(V8 + (size_t)e * 1024 + lane * 16); }
      float d[8];
#pragma unroll
      for (int k = 0; k < 8; ++k) { const u32 w[4] = {ur[k].x, ur[k].y, ur[k].z, ur[k].w}; float a = 0.f;
#pragma unroll
        for (int j = 0; j < 4; ++j) { const u32 lo = __builtin_bit_cast(u32, __builtin_amdgcn_cvt_scalef32_pk_bf16_fp8(w[j], 1.0f, false)), hi = __builtin_bit_cast(u32, __builtin_amdgcn_cvt_scalef32_pk_bf16_fp8(w[j], 1.0f, true));
          a = dot2bf(lo, hx[2 * j], a); a = dot2bf(hi, hx[2 * j + 1], a); }
        d[k] = a; }
      const float z = reduce8(d[0], d[1], d[2], d[3], d[4], d[5], d[6], d[7], lane) * (1.f / U8_SCALE);
      const float cf = mygate * gelu_erf(z) * (1.f / V8_SCALE);
#pragma unroll
      for (int k = 0; k < 8; ++k) { const float ck = __uint_as_float(__builtin_amdgcn_readlane(__float_as_uint(cf), 32 * (k >> 2) + 16 * ((k >> 1) & 1) + 8 * (k & 1)));
        const u32 w[4] = {vr[k].x, vr[k].y, vr[k].z, vr[k].w}; const f32x2 c2 = (f32x2){ck, ck};
#pragma unroll
        for (int j = 0; j < 4; ++j) { const f32x2 lo = __builtin_amdgcn_cvt_pk_f32_fp8((int)w[j], false), hi = __builtin_amdgcn_cvt_pk_f32_fp8((int)w[j], true);
          acc[2 * j] = lo * c2 + acc[2 * j]; acc[2 * j + 1] = hi * c2 + acc[2 * j + 1]; } }
    }
    const float* g2 = p.mod + (size_t)(layer * 8 + b) * 6144 + 5120 + lane * 16; float* xp = p.X + (size_t)t * D + lane * 16;
    float xv[16]; float ss = 0.f;
#pragma unroll
    for (int q = 0; q < 4; ++q) { const f32x4 x0 = *(const f32x4*)(xp + 4 * q), g0 = *(const f32x4*)(g2 + 4 * q);
      xv[4 * q + 0] = x0.x + g0.x * acc[2 * q].x; xv[4 * q + 1] = x0.y + g0.y * acc[2 * q].y; xv[4 * q + 2] = x0.z + g0.z * acc[2 * q + 1].x; xv[4 * q + 3] = x0.w + g0.w * acc[2 * q + 1].y; }
#pragma unroll
    for (int i = 0; i < 16; ++i) ss += xv[i] * xv[i];
    ss = wave_sum(ss); const float r = rsqrtf(ss * (1.f / D) + EPS);
    if (DRY && ss != -1.2345f) continue;
    if (NEXT == 0) {
      const float* ml = p.mod + (size_t)((layer + 1) * 8 + b) * 6144 + lane * 16; const float* gn = p.nmg + (layer + 1) * D + lane * 16; float y[16];
#pragma unroll
      for (int i = 0; i < 16; ++i) y[i] = xv[i] * r * gn[i] * (1.f + ml[1024 + i]) + ml[i];
#pragma unroll
      for (int q = 0; q < 4; ++q) *(f32x4*)(xp + 4 * q) = (f32x4){xv[4 * q], xv[4 * q + 1], xv[4 * q + 2], xv[4 * q + 3]};
      u32x4 w0, w1; w0.x = pack2(y[0], y[1]); w0.y = pack2(y[2], y[3]); w0.z = pack2(y[4], y[5]); w0.w = pack2(y[6], y[7]); w1.x = pack2(y[8], y[9]); w1.y = pack2(y[10], y[11]); w1.z = pack2(y[12], y[13]); w1.w = pack2(y[14], y[15]);
      *(u32x4*)(p.H + (size_t)t * D + lane * 16) = w0; *(u32x4*)(p.H + (size_t)t * D + lane * 16 + 8) = w1;
    } else {
      const float* fg = p.final_g + lane * 16;
#pragma unroll
      for (int q = 0; q < 4; ++q) *(f32x4*)(xp + 4 * q) = (f32x4){xv[4 * q] * r * fg[4 * q], xv[4 * q + 1] * r * fg[4 * q + 1], xv[4 * q + 2] * r * fg[4 * q + 2], xv[4 * q + 3] * r * fg[4 * q + 3]};
    }
  }
}

__device__ void phase_qkrope(const Params& p) {
  const int tid = threadIdx.x, wid = tid >> 6, lane = tid & 63;
  for (int job = blockIdx.x; job < T * 12 / 8; job += gridDim.x) {
    const int w = job * 8 + wid, t = w / 12, hh = w % 12, b = t / S, s = t & (S - 1);
    const u32 raw = *(const u32*)(p.QKV + (size_t)t * 1536 + hh * 128 + lane * 2); float x0 = bflo(raw), x1 = bfhi(raw);
    if (hh < 10) { const float* g = hh < 8 ? p.qn_g : p.kn_g; const float r = rsqrtf(wave_sum(x0 * x0 + x1 * x1) * (1.f / 128.f) + EPS); x0 *= r * g[2 * lane]; x1 *= r * g[2 * lane + 1];
      const int pos = lane < 32 ? (s >> 6) : (s & 63); const int fi = lane & 31; const float fr = exp2f(-(float)(2 * fi) * (13.287712379549449f / 64.f)); const float ang = (float)pos * fr;
      float sn, cs; sincosf(ang, &sn, &cs); const float y0 = x0 * cs - x1 * sn, y1 = x0 * sn + x1 * cs; x0 = y0; x1 = y1; }
    bf16_t* dst = hh < 8 ? p.Qh + (((size_t)b * 8 + hh) * S + s) * 128 : (hh < 10 ? p.Kh + (((size_t)b * 2 + hh - 8) * S + s) * 128 : p.Vh + (((size_t)b * 2 + hh - 10) * S + s) * 128);
    *(u32*)(dst + lane * 2) = pack2(x0, x1);
  }
}

__device__ void phase_attn_naive(const Params& p) {
  const int tid = threadIdx.x, wid = tid >> 6, lane = tid & 63;
  for (int job = blockIdx.x; job < T * 2 / 8; job += gridDim.x) {
    const int w = job * 8 + wid, kv = w & 1, t = w >> 1, b = t / S, s = t & (S - 1);
    float q0[4], q1[4], m[4], l[4], o0[4], o1[4];
#pragma unroll
    for (int g = 0; g < 4; ++g) { const u32 qq = *(const u32*)(p.Qh + (((size_t)b * 8 + kv * 4 + g) * S + s) * 128 + lane * 2); q0[g] = bflo(qq); q1[g] = bfhi(qq); m[g] = -1e30f; l[g] = 0.f; o0[g] = 0.f; o1[g] = 0.f; }
    const bf16_t* Kb = p.Kh + ((size_t)b * 2 + kv) * S * 128; const bf16_t* Vb = p.Vh + ((size_t)b * 2 + kv) * S * 128;
    for (int k = 0; k < S; ++k) { const u32 kk = *(const u32*)(Kb + (size_t)k * 128 + lane * 2), vv = *(const u32*)(Vb + (size_t)k * 128 + lane * 2);
      const float k0 = bflo(kk), k1 = bfhi(kk), v0 = bflo(vv), v1 = bfhi(vv);
#pragma unroll
      for (int g = 0; g < 4; ++g) { const float sc = wave_sum(q0[g] * k0 + q1[g] * k1) * KSCALE; const float mn = fmaxf(m[g], sc), al = __expf(m[g] - mn), pw = __expf(sc - mn);
        l[g] = l[g] * al + pw; o0[g] = o0[g] * al + pw * v0; o1[g] = o1[g] * al + pw * v1; m[g] = mn; } }
#pragma unroll
    for (int g = 0; g < 4; ++g) *(u32*)(p.CAT + (size_t)t * 1024 + (kv * 4 + g) * 128 + lane * 2) = pack2(o0[g] / l[g], o1[g] / l[g]);
  }
}

namespace att {
using bf16 = unsigned short;
constexpr int   D = 128, NW = 8, QBLK = 32, KVBLK = 64;
constexpr float SCALE = 0.088388347648318440f;
constexpr float THR = 8.f;
constexpr int SDEPTH = 2;
constexpr int LDQ = 128, LDK = 128, LDO = 1024;
constexpr size_t SHM_V = KVBLK * D * 2, SHM_K = KVBLK * D * 2, SHM_ATTN = 2 * SHM_V + 2 * SHM_K + NW * 64 * 4;
using bf16x8 = __attribute__((ext_vector_type(8))) short;
using s16x4  = __attribute__((ext_vector_type(4))) short;
using f32x16 = __attribute__((ext_vector_type(16))) float;
using f32x8  = __attribute__((ext_vector_type(8))) float;
using u32x4  = __attribute__((ext_vector_type(4))) unsigned;
#define KSWZ(row, colB) ((row) * 256 + ((colB) ^ (((row) & 7) << 4)))
#define SBAR() __builtin_amdgcn_sched_barrier(0)
__device__ __forceinline__ int crow(int r, int hi) { return (r & 3) + 8 * (r >> 2) + 4 * hi; }
__device__ __forceinline__ unsigned cvtpk(float lo, float hi) {
  unsigned r; asm volatile("v_cvt_pk_bf16_f32 %0, %1, %2" : "=v"(r) : "v"(lo), "v"(hi)); return r;
}
template <typename TIn> struct Stage;
template <> struct Stage<bf16>  { using T = bf16x8;
  __device__ static __forceinline__ T ld8(const bf16* p) { return *reinterpret_cast<const bf16x8*>(p); }
  __device__ static __forceinline__ bf16x8 tobf(T x) { return x; } };
template <> struct Stage<float> { using T = f32x8;
  __device__ static __forceinline__ T ld8(const float* p) { return *reinterpret_cast<const f32x8*>(p); }
  __device__ static __forceinline__ bf16x8 tobf(T x) {
    u32x4 w = {cvtpk(x[0], x[1]), cvtpk(x[2], x[3]), cvtpk(x[4], x[5]), cvtpk(x[6], x[7])}; return *reinterpret_cast<bf16x8*>(&w); } };

__device__ __forceinline__ void partialSM(f32x16& p0, f32x16& p1, float& m_reg, float& mn, float& alpha) {
  constexpr float C = SCALE * 1.4426950408889634f;
  float pmax = p0[0]; for (int r = 1; r < 16; ++r) pmax = fmaxf(pmax, p0[r]); for (int r = 0; r < 16; ++r) pmax = fmaxf(pmax, p1[r]);
  { auto rr = __builtin_amdgcn_permlane32_swap(__float_as_uint(pmax), __float_as_uint(pmax), false, false);
    pmax = fmaxf(__uint_as_float(rr[0]), __uint_as_float(rr[1])); }
  if (__builtin_expect(__all(pmax - m_reg <= THR / SCALE), 1)) { mn = m_reg; alpha = 1.f; }
  else { mn = fmaxf(m_reg, pmax); alpha = __builtin_amdgcn_exp2f((m_reg - mn) * C); m_reg = mn; }
  float mnC = -mn * C;
  for (int r = 0; r < 16; ++r) p0[r] = fmaf(p0[r], C, mnC); for (int r = 0; r < 16; ++r) p1[r] = fmaf(p1[r], C, mnC);
  for (int r = 0; r < 16; ++r) p0[r] = __builtin_amdgcn_exp2f(p0[r]);
}
__device__ __forceinline__ void finishSM(f32x16& p0, f32x16& p1, float alpha, float& l_reg, bf16x8& pa0, bf16x8& pa1, bf16x8& pa2, bf16x8& pa3) {
  for (int r = 0; r < 16; ++r) p1[r] = __builtin_amdgcn_exp2f(p1[r]);
  float ps = 0; for (int r = 0; r < 16; ++r) ps += p0[r]; for (int r = 0; r < 16; ++r) ps += p1[r];
  { auto rr = __builtin_amdgcn_permlane32_swap(__float_as_uint(ps), __float_as_uint(ps), false, false);
    ps = __uint_as_float(rr[0]) + __uint_as_float(rr[1]); }
  l_reg = l_reg * alpha + ps;
#define PK4(P, BASE, OUT) do { unsigned a0 = cvtpk(P[BASE + 0], P[BASE + 1]), a1 = cvtpk(P[BASE + 2], P[BASE + 3]);   \
    unsigned b0 = cvtpk(P[BASE + 4], P[BASE + 5]), b1 = cvtpk(P[BASE + 6], P[BASE + 7]);                              \
    auto r0 = __builtin_amdgcn_permlane32_swap(a0, b0, false, false); auto r1 = __builtin_amdgcn_permlane32_swap(a1, b1, false, false); \
    u32x4 w = {r0[0], r1[0], r0[1], r1[1]}; OUT = *reinterpret_cast<bf16x8*>(&w); } while (0)
  PK4(p0, 0, pa0); PK4(p0, 8, pa1); PK4(p1, 0, pa2); PK4(p1, 8, pa3);
#undef PK4
}
__device__ __forceinline__ void qkt(f32x16& p0, f32x16& p1, const bf16* Ks, const bf16x8* qr, int r32, int hi) {
  p0 = f32x16{}; p1 = f32x16{};
  for (int d0 = 0; d0 < 8; ++d0) { int cb = (d0 * 16 + hi * 8) * 2;
    bf16x8 b0 = *reinterpret_cast<const bf16x8*>((const char*)Ks + KSWZ(r32, cb));
    bf16x8 b1 = *reinterpret_cast<const bf16x8*>((const char*)Ks + KSWZ(32 + r32, cb));
    p0 = __builtin_amdgcn_mfma_f32_32x32x16_bf16(b0, qr[d0], p0, 0, 0, 0);
    p1 = __builtin_amdgcn_mfma_f32_32x32x16_bf16(b1, qr[d0], p1, 0, 0, 0); }
}
__device__ __forceinline__ int v_st(int k, int c) { const int kk = (k & ~0xC) | ((k & 4) << 1) | ((k & 8) >> 1); return ((kk >> 3) * 4 + (c >> 5)) * 512 + ((kk & 7) * 32 + (c & 31)) * 2; }
__device__ __forceinline__ int v_rd_base(int lane) { return ((lane & 3) << 3) | (((lane >> 2) & 3) << 6) | (((lane >> 4) & 1) << 5) | (((lane >> 5) & 1) << 8); }
constexpr int v_rd_off(int d0, int ks, int half) { return d0 * 512 + ks * 4096 + half * 2048; }
template <int OFF> __device__ __forceinline__ s16x4 tr_read(int vb) {
  s16x4 r; asm volatile("ds_read_b64_tr_b16 %0, %1 offset:%2" : "=&v"(r) : "v"(vb), "i"(OFF) : "memory"); return r;
}
template <int D0> __device__ __forceinline__ void pv_one(f32x16& od, int vb, bf16x8 pa0, bf16x8 pa1, bf16x8 pa2, bf16x8 pa3) {
  const s16x4 l0 = tr_read<v_rd_off(D0, 0, 0)>(vb), h0 = tr_read<v_rd_off(D0, 0, 1)>(vb), l1 = tr_read<v_rd_off(D0, 1, 0)>(vb), h1 = tr_read<v_rd_off(D0, 1, 1)>(vb);
  const s16x4 l2 = tr_read<v_rd_off(D0, 2, 0)>(vb), h2 = tr_read<v_rd_off(D0, 2, 1)>(vb), l3 = tr_read<v_rd_off(D0, 3, 0)>(vb), h3 = tr_read<v_rd_off(D0, 3, 1)>(vb);
  asm volatile("s_waitcnt lgkmcnt(0)" ::: "memory"); SBAR();
#define PK(L, H) (bf16x8){L[0], L[1], L[2], L[3], H[0], H[1], H[2], H[3]}
  od = __builtin_amdgcn_mfma_f32_32x32x16_bf16(pa0, PK(l0, h0), od, 0, 0, 0);
  od = __builtin_amdgcn_mfma_f32_32x32x16_bf16(pa1, PK(l1, h1), od, 0, 0, 0);
  od = __builtin_amdgcn_mfma_f32_32x32x16_bf16(pa2, PK(l2, h2), od, 0, 0, 0);
  od = __builtin_amdgcn_mfma_f32_32x32x16_bf16(pa3, PK(l3, h3), od, 0, 0, 0);
#undef PK
}
__device__ __forceinline__ void pv_d0(f32x16* o, int vb, bf16x8 pa0, bf16x8 pa1, bf16x8 pa2, bf16x8 pa3) {
  pv_one<0>(o[0], vb, pa0, pa1, pa2, pa3); pv_one<1>(o[1], vb, pa0, pa1, pa2, pa3); pv_one<2>(o[2], vb, pa0, pa1, pa2, pa3); pv_one<3>(o[3], vb, pa0, pa1, pa2, pa3);
}

template <typename TQ>
__device__ __forceinline__ void attn_dense_body(const TQ* __restrict__ Qb, const bf16* __restrict__ Kh, const bf16* __restrict__ Vh,
                                                bf16* __restrict__ Ob, int seq, char* lds) {
  using St = Stage<bf16>; using SQ = Stage<TQ>;
  int tid_ = threadIdx.x; asm volatile("" : "+v"(tid_)); const int tid = tid_, wid = tid >> 6, lane = tid & 63, r32 = lane & 31, hi = lane >> 5;
  bf16* V_lds = (bf16*)lds; bf16* K_lds = (bf16*)(lds + 2 * SHM_V);
  float* ws = (float*)(lds + 2 * SHM_V + 2 * SHM_K) + wid * 64; float* li_l = ws; float* al_l = ws + 32;
  float m_reg = -1e30f, l_reg = 0; f32x16 o[4] = {}; bf16x8 qr[8];
  const TQ* Qw = Qb + (long)(wid * QBLK + r32) * LDQ + hi * 8;
#pragma unroll
  for (int d0 = 0; d0 < 8; ++d0) qr[d0] = SQ::tobf(SQ::ld8(Qw + d0 * 16));
  const int sr = tid >> 4, sc = (tid & 15) * 8, vst0 = v_st(sr, sc), vst1 = v_st(32 + sr, sc);
  const int vb0 = (int)(uintptr_t)V_lds + v_rd_base(lane);
  struct { typename St::T vs0, vs1, ks0, ks1; } sr_[SDEPTH];
#define SLOAD(i, k0) do { sr_[i].vs0 = St::ld8(&Vh[(long)((k0) + sr) * LDK + sc]); sr_[i].vs1 = St::ld8(&Vh[(long)((k0) + 32 + sr) * LDK + sc]); \
    sr_[i].ks0 = St::ld8(&Kh[(long)((k0) + sr) * LDK + sc]); sr_[i].ks1 = St::ld8(&Kh[(long)((k0) + 32 + sr) * LDK + sc]); } while (0)
#define SWRITE(b, i) do { *(bf16x8*)((char*)V_lds + (b) * SHM_V + vst0) = St::tobf(sr_[i].vs0);          \
    *(bf16x8*)((char*)V_lds + (b) * SHM_V + vst1) = St::tobf(sr_[i].vs1); int kc = sc * 2;               \
    *(bf16x8*)((char*)K_lds + (b) * SHM_K + KSWZ(sr, kc)) = St::tobf(sr_[i].ks0);                       \
    *(bf16x8*)((char*)K_lds + (b) * SHM_K + KSWZ(32 + sr, kc)) = St::tobf(sr_[i].ks1); } while (0)
#define SWAIT() do { if constexpr (SDEPTH == 2) asm volatile("s_waitcnt vmcnt(4)" ::: "memory"); else asm volatile("s_waitcnt vmcnt(0)" ::: "memory"); } while (0)
#define RESC(a) do { if (__any((a) < 1.f)) { if (hi == 0) al_l[r32] = (a); asm volatile("s_waitcnt lgkmcnt(0)" ::: "memory"); \
    for (int d = 0; d < 4; ++d) for (int r = 0; r < 16; ++r) o[d][r] *= al_l[crow(r, hi)]; } } while (0)
  f32x16 pA0, pA1, pB0, pB1; float mnA, mnB, alA, alB; bf16x8 pa0, pa1, pa2, pa3; const int NT = seq / KVBLK;
  constexpr int SE = 0, SO = SDEPTH - 1;
  SLOAD(SE, 0); asm volatile("s_waitcnt vmcnt(0)" ::: "memory"); SWRITE(0, SE); __syncthreads();
  qkt(pA0, pA1, K_lds, qr, r32, hi); partialSM(pA0, pA1, m_reg, mnA, alA);
  SLOAD(SO, KVBLK); if constexpr (SDEPTH == 2) { if (2 < NT) SLOAD(SE, 2 * KVBLK); }
  SWAIT(); SWRITE(1, SO); __syncthreads();
  for (int j = 1; j + 1 < NT; j += 2) {
    SBAR(); qkt(pB0, pB1, (bf16*)((char*)K_lds + SHM_K), qr, r32, hi);
    finishSM(pA0, pA1, alA, l_reg, pa0, pa1, pa2, pa3); SBAR();
    SLOAD(SO, (j + SDEPTH) * KVBLK); SBAR();
    pv_d0(o, vb0, pa0, pa1, pa2, pa3); partialSM(pB0, pB1, m_reg, mnB, alB);
    __syncthreads(); SWAIT(); SWRITE(0, SE);
    RESC(alB); __syncthreads();
    SBAR(); qkt(pA0, pA1, K_lds, qr, r32, hi);
    finishSM(pB0, pB1, alB, l_reg, pa0, pa1, pa2, pa3); SBAR();
    if (SDEPTH == 1 || j + 3 < NT) SLOAD(SE, (j + 1 + SDEPTH) * KVBLK); SBAR();
    pv_d0(o, vb0 + (int)SHM_V, pa0, pa1, pa2, pa3); partialSM(pA0, pA1, m_reg, mnA, alA);
    __syncthreads(); SWAIT(); SWRITE(1, SO);
    RESC(alA); __syncthreads();
  }
  SBAR(); qkt(pB0, pB1, (bf16*)((char*)K_lds + SHM_K), qr, r32, hi);
  finishSM(pA0, pA1, alA, l_reg, pa0, pa1, pa2, pa3); SBAR();
  pv_d0(o, vb0, pa0, pa1, pa2, pa3); partialSM(pB0, pB1, m_reg, mnB, alB);
  __syncthreads(); RESC(alB);
  finishSM(pB0, pB1, alB, l_reg, pa0, pa1, pa2, pa3); SBAR();
  pv_d0(o, vb0 + (int)SHM_V, pa0, pa1, pa2, pa3);
  if (hi == 0) li_l[r32] = l_reg; asm volatile("s_waitcnt lgkmcnt(0)" ::: "memory");
  float rli[16];
#pragma unroll
  for (int r = 0; r < 16; ++r) rli[r] = __builtin_amdgcn_rcpf(li_l[crow(r, hi)]);
  __syncthreads();
  bf16* Ol = (bf16*)lds + wid * (QBLK * D);
#pragma unroll
  for (int r = 0; r < 16; ++r) { const int orow = crow(r, hi);
#pragma unroll
    for (int d0 = 0; d0 < 4; ++d0) { const float v = o[d0][r] * rli[r]; unsigned u = __float_as_uint(v); u += 0x7FFFu + ((u >> 16) & 1u); Ol[orow * D + d0 * 32 + r32] = (bf16)(u >> 16); } }
  asm volatile("s_waitcnt lgkmcnt(0)" ::: "memory");
#pragma unroll
  for (int i = 0; i < 8; ++i) { const int row = i * 4 + (lane >> 4), ch = (lane & 15) * 8;
    const u32x4 v = *reinterpret_cast<const u32x4*>(Ol + row * D + ch);
    *reinterpret_cast<u32x4*>(Ob + (long)(wid * QBLK + row) * LDO + ch) = v; }
  __syncthreads();
#undef SLOAD
#undef SWRITE
#undef SWAIT
#undef RESC
}

}

__device__ void phase_attn(const Params& p, char* smem) {
  const int G = (int)gridDim.x, c = (int)blockIdx.x;
  for (int i = 0; i * G + c < 1024; ++i) {
    int pair, j;
    if (G == 256) { pair = 2 * (c & 7) + (i >> 1); j = (i & 1) * 32 + (c >> 3); } else { const int L = i * G + c; pair = L >> 6; j = L & 63; }
    const int b = pair >> 1, kv = pair & 1, qb = j >> 2, g = j & 3, h = kv * 4 + g;
    const bf16_t* Qb = p.Qh + (((size_t)b * 8 + h) * S + qb * 256) * 128; const bf16_t* Kp = p.Kh + ((size_t)b * 2 + kv) * S * 128; const bf16_t* Vp = p.Vh + ((size_t)b * 2 + kv) * S * 128;
    bf16_t* Ob = p.CAT + ((size_t)b * S + qb * 256) * 1024 + h * 128;
    att::attn_dense_body<att::bf16>(Qb, Kp, Vp, Ob, S, smem);
  }
}

#define XB_TMO      128
#define XB_XCNT(j)  (256  + 64 * (j))
#define XB_XSUB(j)  (1280 + 64 * (j))
#define XB_XGEN(j)  (2304 + 64 * (j))
#define XB_TOP      3328
#define XB_TOPGEN   3392
#define XCD_BAR_WORDS 3456
#define XB_SPIN_CAP (1u << 18)
#define LAS __attribute__((address_space(3)))

__device__ __forceinline__ unsigned xb_ld(unsigned* p)              { return __hip_atomic_load(p, __ATOMIC_RELAXED, __HIP_MEMORY_SCOPE_AGENT); }
__device__ __forceinline__ unsigned xb_add(unsigned* p, unsigned v) { return __hip_atomic_fetch_add(p, v, __ATOMIC_RELAXED, __HIP_MEMORY_SCOPE_AGENT); }
__device__ __forceinline__ unsigned xb_xcc_id() { return (unsigned)__builtin_amdgcn_s_getreg((3 << 11) | 20) & 0xFu; }
#define XB_SPIN(cond, bar) do { unsigned _sp = 0; while (cond) { __builtin_amdgcn_s_sleep(1); \
    if ((++_sp & 255u) == 0u) { if (xb_ld(&(bar)[XB_TMO])) break; if (_sp > XB_SPIN_CAP) { atomicAdd(&(bar)[XB_TMO], 1u); break; } } } } while (0)

struct XcdBarrier {
    unsigned* bar; unsigned x;
    volatile LAS unsigned* st;
};

__device__ __forceinline__ XcdBarrier xcd_barrier_post(unsigned* bar, volatile LAS unsigned* st) {
    XcdBarrier b; b.bar = bar; b.x = xb_xcc_id(); b.st = st;
    if (threadIdx.x == 0) (void)xb_add(&bar[XB_XCNT(b.x)], 1u);
    return b;
}
__device__ __forceinline__ void xcd_barrier_complete(unsigned* bar, unsigned x, unsigned& nloc, unsigned& nx) {
    const unsigned G = gridDim.x * gridDim.y * gridDim.z;
    unsigned sum, cnt, mine, sp = 0u;
    for (;;) {
        sum = 0u; cnt = 0u; mine = 0u;
#pragma unroll
        for (unsigned j = 0; j < 16; ++j) { const unsigned c = xb_ld(&bar[XB_XCNT(j)]); sum += c; cnt += (c > 0u) ? 1u : 0u; mine = (j == x) ? c : mine; }
        if (sum == G) break;
        __builtin_amdgcn_s_sleep(1);
        if ((++sp & 255u) == 0u) { if (xb_ld(&bar[XB_TMO])) break; if (sp > XB_SPIN_CAP) { atomicAdd(&bar[XB_TMO], 1u); break; } }
    }
    nloc = mine > 0u ? mine : 1u; nx = cnt > 0u ? cnt : 1u;
}

__device__ __forceinline__ void xcd_barrier(const XcdBarrier& b) {
    asm volatile("s_waitcnt vmcnt(0)" ::: "memory");
    __syncthreads();
    if (threadIdx.x == 0) {
        unsigned* bar = b.bar;
        __builtin_amdgcn_s_waitcnt(0);
        unsigned nloc = b.st[0], nx = b.st[1];
        if (nloc == 0u) { xcd_barrier_complete(bar, b.x, nloc, nx); b.st[0] = nloc; b.st[1] = nx; }
        const unsigned old = xb_add(&bar[XB_XSUB(b.x)], 1u);
        const unsigned gen = old / nloc;
        if (old + 1u == (gen + 1u) * nloc) {
            __builtin_amdgcn_fence(__ATOMIC_RELEASE, "agent");
            asm volatile("s_waitcnt vmcnt(0)" ::: "memory");
            const unsigned og = xb_add(&bar[XB_TOP], 1u);
            const unsigned tg = og / nx;
            if (og + 1u == (tg + 1u) * nx) xb_add(&bar[XB_TOPGEN], 1u);
            else XB_SPIN(xb_ld(&bar[XB_TOPGEN]) == tg, bar);
            __builtin_amdgcn_fence(__ATOMIC_ACQUIRE, "agent");
            xb_add(&bar[XB_XGEN(b.x)], 1u);
            asm volatile("s_waitcnt vmcnt(0)" ::: "memory");
        } else {
            XB_SPIN(xb_ld(&bar[XB_XGEN(b.x)]) == gen, bar);
            __builtin_amdgcn_fence(__ATOMIC_ACQUIRE, "agent");
            asm volatile("s_waitcnt vmcnt(0)" ::: "memory");
        }
    }
    __syncthreads();
}


constexpr int NPH = 19;
__global__ __launch_bounds__(NTHREADS, 2) void mega(Params p, int ph0, int ph1) {
  extern __shared__ __attribute__((aligned(16))) char smem[];
  cg::grid_group grid = cg::this_grid();
  volatile LAS unsigned* xst = (volatile LAS unsigned*)(LAS char*)(smem + SMEM_BYTES - 16);
  if (threadIdx.x == 0) { xst[0] = 0u; xst[1] = 0u; }
  __syncthreads();
  const XcdBarrier xb = xcd_barrier_post(p.bar, xst);
#ifndef REP_MASK
#define REP_MASK 0
#endif
#define GSYNC(k) do { if ((k) == 1) grid.sync(); else xcd_barrier(xb); } while (0)
#define PHASE(k, call) if (ph0 <= (k) && (k) < ph1) { if ((k) > ph0) GSYNC(k); if ((REP_MASK >> (k)) & 1) { if ((k) == 10) phase_peer_gather<0, true>(p, 0); else if ((k) == 18) phase_peer_gather<1, true>(p, 1); else { call; } xcd_barrier(xb); } call; }
#if !defined(ONLY_PHASE) || ONLY_PHASE == 0
  PHASE(0, phase_prep(p, smem))
#endif
#if !defined(ONLY_PHASE) || ONLY_PHASE == 1
  PHASE(1, phase_norm<true>(p, p.x, p.nmg, p.mod, 0, 1024, smem))
#endif
#if !defined(ONLY_PHASE) || ONLY_PHASE == 2
  PHASE(2, phase_gemm_fast(p.H, p.Wt_evin, T, 2560, 1024, (EpiEvin{p.ZQK, p.ZV, p.ZO, p.ZP, p.ev_b_in}), smem))
#endif
#if !defined(ONLY_PHASE) || ONLY_PHASE == 3
  PHASE(3, cp::phase_convpool(p, smem))
#endif
#if !defined(ONLY_PHASE) || ONLY_PHASE == 4
  PHASE(4, ml::phase_mlstm(p, smem))
#endif
#if !defined(ONLY_PHASE) || ONLY_PHASE == 5
  PHASE(5, phase_cat(p))
#endif
#if !defined(ONLY_PHASE) || ONLY_PHASE == 6
  PHASE(6, phase_gemm_fast(p.CAT, p.Wt_evout, T, 1024, 1024, (EpiRes{p.x, p.X, p.mod + 2048}), smem))
#endif
#if !defined(ONLY_PHASE) || ONLY_PHASE == 7
  PHASE(7, phase_norm<false>(p, p.X, p.nfg, p.mod, 3072, 4096, smem))
#endif
#if !defined(ONLY_PHASE) || ONLY_PHASE == 8
  PHASE(8, phase_gemm_fast(p.H, p.Wt_q, T, 2048, 1024, (EpiPlain{p.QP, 2048}), smem))
#endif
#if !defined(ONLY_PHASE) || ONLY_PHASE == 9
  PHASE(9, sel::phase_peer_select(p, 0, smem))
#endif
#if !defined(ONLY_PHASE) || ONLY_PHASE == 10
  PHASE(10, phase_peer_gather<0>(p, 0))
#endif
#if !defined(ONLY_PHASE) || ONLY_PHASE == 11
  PHASE(11, phase_gemm_fast(p.H, p.Wt_odin, T, 1536, 1024, (EpiPlain{p.QKV, 1536}), smem))
#endif
#if !defined(ONLY_PHASE) || ONLY_PHASE == 12
  PHASE(12, phase_qkrope(p))
#endif
#if !defined(ONLY_PHASE) || ONLY_PHASE == 13
  PHASE(13, phase_attn(p, smem))
#endif
#if !defined(ONLY_PHASE) || ONLY_PHASE == 14
  PHASE(14, phase_gemm_fast(p.CAT, p.Wt_odout, T, 1024, 1024, (EpiRes{p.X, p.X, p.mod + (size_t)8 * 6144 + 2048}), smem))
#endif
#if !defined(ONLY_PHASE) || ONLY_PHASE == 15
  PHASE(15, phase_norm<false>(p, p.X, p.nfg + D, p.mod + (size_t)8 * 6144, 3072, 4096, smem))
#endif
#if !defined(ONLY_PHASE) || ONLY_PHASE == 16
  PHASE(16, phase_gemm_fast(p.H, p.Wt_q + (size_t)2048 * 1024, T, 2048, 1024, (EpiPlain{p.QP, 2048}), smem))
#endif
#if !defined(ONLY_PHASE) || ONLY_PHASE == 17
  PHASE(17, sel::phase_peer_select(p, 1, smem))
#endif
#if !defined(ONLY_PHASE) || ONLY_PHASE == 18
  PHASE(18, phase_peer_gather<1>(p, 1))
#endif
#undef PHASE
}
}

extern "C" void kernel_launch(void* const* d_in, const int* in_sizes, int n_in, void* d_out, int out_size, void* d_ws, size_t ws_size, hipStream_t stream) {
  (void)in_sizes; (void)n_in; (void)out_size;
  Params p{};
  const float** fin = (const float**)&p;
  for (int i = 0; i < 23; ++i) fin[i] = (const float*)d_in[i];
  p.X = (float*)d_out;
  char* ws = (char*)d_ws; size_t off = 0;
  auto alloc = [&](size_t bytes) { char* q = ws + off; off += (bytes + 255) / 256 * 256; return q; };
  p.U8 = (unsigned char*)alloc((size_t)2 * 16384 * 1024); p.V8 = (unsigned char*)alloc((size_t)2 * 16384 * 1024);
  p.Wt_evin = (bf16_t*)alloc((size_t)2560 * 1024 * 2); p.Wt_evout = (bf16_t*)alloc((size_t)1024 * 1024 * 2); p.Wt_odin = (bf16_t*)alloc((size_t)1536 * 1024 * 2);
  p.Wt_odout = (bf16_t*)alloc((size_t)1024 * 1024 * 2); p.Wt_q = (bf16_t*)alloc((size_t)2 * 2048 * 1024 * 2); p.keysb = (bf16_t*)alloc((size_t)2 * 2 * 128 * 128 * 2); p.poolWt = (bf16_t*)alloc((size_t)4 * 128 * 128 * 2);
  p.Wg = (float*)alloc(16 * 1024 * 4); p.mod = (float*)alloc(2 * 8 * 6144 * 4); p.gates = (float*)alloc((size_t)T * 16 * 4);
  p.pgate = (float*)alloc((size_t)T * 128 * 4); p.pidx = (bf16_t*)alloc((size_t)T * 128 * 2);
  p.H = (bf16_t*)alloc((size_t)T * 1024 * 2); p.CAT = p.H;
  char* big = alloc((size_t)T * 2048 * 2);
  p.ZQK = (bf16_t*)big; p.ZV = (bf16_t*)(big + (size_t)T * 1024 * 2); p.ZO = (bf16_t*)(big + (size_t)T * 1536 * 2); p.HS = (bf16_t*)big; p.QP = (bf16_t*)big; p.QKV = (bf16_t*)big;
  char* big2 = alloc((size_t)T * 1536 * 2);
  p.QK = (bf16_t*)big2; p.ZP = (bf16_t*)(big2 + (size_t)T * 1024 * 2); p.Qh = (bf16_t*)big2; p.Kh = (bf16_t*)(big2 + (size_t)T * 1024 * 2); p.Vh = (bf16_t*)(big2 + (size_t)T * 1280 * 2);
  p.bar = (unsigned*)alloc(XCD_BAR_WORDS * 4);
  if (off > ws_size) { fprintf(stderr, "kernel_launch: workspace too small: need %zu have %zu\n", off, ws_size); return; }

  static int grid_blocks = 0;
  if (!grid_blocks) {
    int dev = 0, cus = 0, per_cu = 0; hipGetDevice(&dev); hipDeviceGetAttribute(&cus, hipDeviceAttributeMultiprocessorCount, dev);
    hipFuncSetAttribute((const void*)mega, hipFuncAttributeMaxDynamicSharedMemorySize, SMEM_BYTES);
    hipOccupancyMaxActiveBlocksPerMultiprocessor(&per_cu, mega, NTHREADS, SMEM_BYTES);
    if (per_cu > 1) per_cu = 1;
    grid_blocks = cus * per_cu;
    if (grid_blocks <= 0) { fprintf(stderr, "kernel_launch: occupancy query returned 0\n"); grid_blocks = 0; return; }
  }
  hipMemsetAsync(p.bar, 0, XCD_BAR_WORDS * 4, stream);
#if MULTI_LAUNCH
  for (int ph = 0; ph < NPH; ++ph) hipLaunchKernelGGL(mega, dim3(grid_blocks), dim3(NTHREADS), SMEM_BYTES, stream, p, ph, ph + 1);
#else
  int ph0 = 0, ph1 = NPH; void* args[] = {&p, &ph0, &ph1};
  hipError_t e = hipLaunchCooperativeKernel((const void*)mega, dim3(grid_blocks), dim3(NTHREADS), args, SMEM_BYTES, stream);
  if (e != hipSuccess) fprintf(stderr, "cooperative launch failed: %s (grid %d)\n", hipGetErrorString(e), grid_blocks);
#endif
}
```

```cpp
#include <hip/hip_runtime.h>
#include <hip/hip_cooperative_groups.h>
#include <math.h>
#include <stdint.h>
#include <stdio.h>
namespace cg = cooperative_groups;

#ifndef MULTI_LAUNCH
#define MULTI_LAUNCH 0
#endif

namespace {
typedef unsigned short bf16_t;
typedef unsigned int u32;
typedef float f32x4 __attribute__((ext_vector_type(4)));
typedef u32 u32x4 __attribute__((ext_vector_type(4)));
typedef u32 u32x2 __attribute__((ext_vector_type(2)));
typedef __bf16 bf16x2_t __attribute__((ext_vector_type(2)));

constexpr int D = 1024, NB = 8, S = 4096, T = NB * S;
constexpr int EVEN_IN = 2576;
constexpr float EPS = 1e-6f;
constexpr int NTHREADS = 512;
constexpr int SMEM_BYTES = 144 * 1024;
constexpr float KSCALE = 0.08838834764831845f;

struct Params {
  const float *x, *c, *ada_w, *ada_b, *nmg, *nfg, *ev_w_in, *ev_b_in, *conv_w, *conv_b, *mnorm_g, *pool_w, *pool_sc, *ev_w_out, *od_w_in, *qn_g, *kn_g, *od_w_out,
      *peer_wq, *peer_keys, *peer_u, *peer_v, *final_g;
  float* X;
  bf16_t *Wt_evin, *Wt_evout, *Wt_odin, *Wt_odout, *Wt_q, *keysb, *poolWt; unsigned char *U8, *V8;
  float *Wg, *mod, *gates, *pgate;
  bf16_t *H, *ZQK, *ZV, *ZO, *ZP, *QK, *HS, *CAT, *QP, *QKV, *Qh, *Kh, *Vh;
  bf16_t* pidx;
  unsigned* bar;
};

__device__ __forceinline__ float siluf(float x) { return x / (1.f + __expf(-x)); }
__device__ __forceinline__ float sigmf(float x) { return 1.f / (1.f + __expf(-x)); }
__device__ __forceinline__ float wave_sum(float v) { for (int o = 32; o >= 1; o >>= 1) v += __shfl_xor(v, o); return v; }
__device__ __forceinline__ float wave_max(float v) { for (int o = 32; o >= 1; o >>= 1) v = fmaxf(v, __shfl_xor(v, o)); return v; }
__device__ __forceinline__ bf16_t f2bf(float f) { u32 u = __float_as_uint(f); u += 0x7FFFu + ((u >> 16) & 1u); return (bf16_t)(u >> 16); }
__device__ __forceinline__ float bf2f(bf16_t b) { return __uint_as_float(((u32)b) << 16); }
__device__ __forceinline__ u32 pack2(float lo, float hi) { return (u32)f2bf(lo) | ((u32)f2bf(hi) << 16); }
__device__ __forceinline__ float bflo(u32 w) { return __uint_as_float(w << 16); }
__device__ __forceinline__ float bfhi(u32 w) { return __uint_as_float(w & 0xFFFF0000u); }
__device__ __forceinline__ float dot2bf(u32 a, u32 b, float c) { return __builtin_amdgcn_fdot2_f32_bf16(__builtin_bit_cast(bf16x2_t, a), __builtin_bit_cast(bf16x2_t, b), c, false); }

constexpr int PJ_MOD = 192, PJ_TR = 2576, PJ_WG = 1, PJ_KEYS = 16, PJ_UV = 8192;
constexpr int PJ_TOTAL = PJ_MOD + PJ_TR + PJ_WG + PJ_KEYS + PJ_UV;

__device__ void prep_transpose_tile(const float* __restrict__ src, int ld, int k0, int n0, bf16_t* __restrict__ dst, int dstK, char* smem) {
  float* tile = (float*)smem;
  const int tid = threadIdx.x;
  __syncthreads();
  for (int pass = 0; pass < 8; ++pass) { int kk = pass * 8 + (tid >> 6), n = tid & 63; tile[kk * 65 + n] = src[(size_t)(k0 + kk) * ld + n0 + n]; }
  __syncthreads();
  int n = tid >> 3, kc = (tid & 7) * 8; u32x4 w;
  w.x = pack2(tile[(kc + 0) * 65 + n], tile[(kc + 1) * 65 + n]); w.y = pack2(tile[(kc + 2) * 65 + n], tile[(kc + 3) * 65 + n]);
  w.z = pack2(tile[(kc + 4) * 65 + n], tile[(kc + 5) * 65 + n]); w.w = pack2(tile[(kc + 6) * 65 + n], tile[(kc + 7) * 65 + n]);
  *(u32x4*)(dst + (size_t)(n0 + n) * dstK + k0 + kc) = w;
}

__device__ void phase_prep(const Params& p, char* smem) {
  const int tid = threadIdx.x;
  for (int job = blockIdx.x; job < PJ_TOTAL; job += gridDim.x) {
    if (job < PJ_MOD) {
      float* cs = (float*)smem; float* red = cs + 8192;
      __syncthreads();
      for (int i = tid; i < 8192; i += NTHREADS) cs[i] = siluf(p.c[i]);
      __syncthreads();
      const int l = job / 96, e0 = (job % 96) * 64, col = tid & 63, dg = tid >> 6;
      float acc[8];
#pragma unroll
      for (int b = 0; b < 8; ++b) acc[b] = 0.f;
      const float* w = p.ada_w + (size_t)l * D * 6144 + e0 + col;
      for (int d = dg * 128; d < dg * 128 + 128; ++d) { float wv = w[(size_t)d * 6144];
#pragma unroll
        for (int b = 0; b < 8; ++b) acc[b] += cs[b * 1024 + d] * wv; }
#pragma unroll
      for (int b = 0; b < 8; ++b) red[(dg * 8 + b) * 64 + col] = acc[b];
      __syncthreads();
      { const int b = tid >> 6; float s = 0.f;
#pragma unroll
        for (int g = 0; g < 8; ++g) s += red[(g * 8 + b) * 64 + col];
        p.mod[(size_t)(l * 8 + b) * 6144 + e0 + col] = s + p.ada_b[l * 6144 + e0 + col]; }
    } else if (job < PJ_MOD + PJ_TR) {
      int tt = job - PJ_MOD;
      if (tt < 640) prep_transpose_tile(p.ev_w_in, EVEN_IN, (tt / 40) * 64, (tt % 40) * 64, p.Wt_evin, 1024, smem);
      else if (tt < 896) { tt -= 640; prep_transpose_tile(p.ev_w_out, 1024, (tt / 16) * 64, (tt % 16) * 64, p.Wt_evout, 1024, smem); }
      else if (tt < 1280) { tt -= 896; prep_transpose_tile(p.od_w_in, 1536, (tt / 24) * 64, (tt % 24) * 64, p.Wt_odin, 1024, smem); }
      else if (tt < 1536) { tt -= 1280; prep_transpose_tile(p.od_w_out, 1024, (tt / 16) * 64, (tt % 16) * 64, p.Wt_odout, 1024, smem); }
      else if (tt < 2560) { tt -= 1536; int l = tt / 512; tt %= 512; prep_transpose_tile(p.peer_wq + (size_t)l * D * 2048, 2048, (tt / 32) * 64, (tt % 32) * 64, p.Wt_q + (size_t)l * 2048 * 1024, 1024, smem); }
      else { tt -= 2560; const int g = tt >> 2; prep_transpose_tile(p.pool_w + (size_t)g * 16384, 128, ((tt >> 1) & 1) * 64, (tt & 1) * 64, p.poolWt + (size_t)g * 16384, 128, smem); }
    } else if (job < PJ_MOD + PJ_TR + PJ_WG) {
      for (int i = tid; i < 16 * 1024; i += NTHREADS) { int g = i >> 10, d = i & 1023; p.Wg[i] = p.ev_w_in[(size_t)d * EVEN_IN + 2560 + g]; }
    } else if (job < PJ_MOD + PJ_TR + PJ_WG + PJ_KEYS) {
      int j = job - (PJ_MOD + PJ_TR + PJ_WG);
      for (int i = tid; i < 4096; i += NTHREADS) p.keysb[j * 4096 + i] = f2bf(p.peer_keys[j * 4096 + i]);
    } else {
      int j = job - (PJ_MOD + PJ_TR + PJ_WG + PJ_KEYS); const bool isu = j < 4096; const float* src = isu ? p.peer_u : p.peer_v; unsigned char* dst = isu ? p.U8 : p.V8; j &= 4095; const float sc = isu ? 32.f : 2.f;
      const size_t o = (size_t)j * 8192 + tid * 16; u32x4 w; u32 ww[4];
#pragma unroll
      for (int q = 0; q < 4; ++q) { const f32x4 a = *(const f32x4*)(src + o + 4 * q); int pk = __builtin_amdgcn_cvt_pk_fp8_f32(a.x * sc, a.y * sc, 0, false); pk = __builtin_amdgcn_cvt_pk_fp8_f32(a.z * sc, a.w * sc, pk, true); ww[q] = (u32)pk; }
      w.x = ww[0]; w.y = ww[1]; w.z = ww[2]; w.w = ww[3]; *(u32x4*)(dst + o) = w;
    }
  }
}

template <bool WITH_GATES>
__device__ void phase_norm(const Params& p, const float* __restrict__ xin, const float* __restrict__ g, const float* __restrict__ modl, int sh_off, int sc_off, char* smem) {
  const int tid = threadIdx.x, wid = tid >> 6, lane = tid & 63;
  float* wg = (float*)smem;
  if (WITH_GATES) { __syncthreads(); for (int i = tid; i < 16 * 1024; i += NTHREADS) wg[i] = p.Wg[i]; __syncthreads(); }
  for (int job = blockIdx.x; job < T / 8; job += gridDim.x) {
    const int t = job * 8 + wid, b = t / S;
    f32x4 v[4]; float ss = 0.f;
#pragma unroll
    for (int i = 0; i < 4; ++i) { v[i] = *(const f32x4*)(xin + (size_t)t * D + i * 256 + lane * 4); ss += v[i].x * v[i].x + v[i].y * v[i].y + v[i].z * v[i].z + v[i].w * v[i].w; }
    ss = wave_sum(ss); const float r = rsqrtf(ss * (1.f / D) + EPS);
    const float* shp = modl + (size_t)b * 6144 + sh_off; const float* scp = modl + (size_t)b * 6144 + sc_off;
#pragma unroll
    for (int i = 0; i < 4; ++i) { const int d = i * 256 + lane * 4; f32x4 gg = *(const f32x4*)(g + d), s1 = *(const f32x4*)(scp + d), s0 = *(const f32x4*)(shp + d);
      v[i].x = v[i].x * r * gg.x * (1.f + s1.x) + s0.x; v[i].y = v[i].y * r * gg.y * (1.f + s1.y) + s0.y; v[i].z = v[i].z * r * gg.z * (1.f + s1.z) + s0.z; v[i].w = v[i].w * r * gg.w * (1.f + s1.w) + s0.w;
      u32x2 w; w.x = pack2(v[i].x, v[i].y); w.y = pack2(v[i].z, v[i].w); *(u32x2*)(p.H + (size_t)t * D + d) = w; }
    if (WITH_GATES) {
      float myg = 0.f;
#pragma unroll 2
      for (int gi = 0; gi < 16; ++gi) { float a = 0.f;
#pragma unroll
        for (int i = 0; i < 4; ++i) { f32x4 w4 = *(const f32x4*)(wg + gi * 1024 + i * 256 + lane * 4); a += v[i].x * w4.x + v[i].y * w4.y + v[i].z * w4.z + v[i].w * w4.w; }
        a = wave_sum(a); if (lane == gi) myg = a; }
      if (lane < 16) p.gates[(size_t)t * 16 + lane] = myg + p.ev_b_in[2560 + lane];
    }
  }
}

enum { EPI_EVIN = 0, EPI_EVOUT = 1, EPI_PEERQ = 2, EPI_ODIN = 3, EPI_ODOUT = 4 };
template <int EPI> __device__ __forceinline__ void epi_store(const Params& p, int layer, int m, int n, float acc) {
  if (EPI == EPI_EVIN) { float v = acc + p.ev_b_in[n];
    if (n < 1024) p.ZQK[(size_t)m * 1024 + n] = f2bf(v); else if (n < 1536) p.ZV[(size_t)m * 512 + n - 1024] = f2bf(v);
    else if (n < 2048) p.ZO[(size_t)m * 512 + n - 1536] = f2bf(sigmf(v)); else p.ZP[(size_t)m * 512 + n - 2048] = f2bf(v); }
  else if (EPI == EPI_EVOUT) { int b = m / S; p.X[(size_t)m * D + n] = p.x[(size_t)m * D + n] + p.mod[(size_t)(0 * 8 + b) * 6144 + 2048 + n] * acc; }
  else if (EPI == EPI_PEERQ) p.QP[(size_t)m * 2048 + n] = f2bf(acc);
  else if (EPI == EPI_ODIN) p.QKV[(size_t)m * 1536 + n] = f2bf(acc);
  else if (EPI == EPI_ODOUT) { int b = m / S; p.X[(size_t)m * D + n] += p.mod[(size_t)(1 * 8 + b) * 6144 + 2048 + n] * acc; }
}
template <int EPI> __device__ void phase_gemm_naive(const Params& p, int layer, const bf16_t* __restrict__ A, const bf16_t* __restrict__ Bt, int M, int N, int K, char* smem) {
  float* As = (float*)smem; float* Bs = As + 32 * 132;
  const int tid = threadIdx.x, tx = tid & 15, ty = tid >> 4; const int nN = N / 64, njobs = (M / 128) * nN;
  for (int job = blockIdx.x; job < njobs; job += gridDim.x) {
    const int m0 = (job / nN) * 128, n0 = (job % nN) * 64; float acc[4][4];
#pragma unroll
    for (int i = 0; i < 4; ++i)
#pragma unroll
      for (int j = 0; j < 4; ++j) acc[i][j] = 0.f;
    for (int k0 = 0; k0 < K; k0 += 32) {
      __syncthreads();
      { int row = tid >> 2, kc = (tid & 3) * 8; u32x4 w = *(const u32x4*)(A + (size_t)(m0 + row) * K + k0 + kc);
        As[(kc + 0) * 132 + row] = bflo(w.x); As[(kc + 1) * 132 + row] = bfhi(w.x); As[(kc + 2) * 132 + row] = bflo(w.y); As[(kc + 3) * 132 + row] = bfhi(w.y);
        As[(kc + 4) * 132 + row] = bflo(w.z); As[(kc + 5) * 132 + row] = bfhi(w.z); As[(kc + 6) * 132 + row] = bflo(w.w); As[(kc + 7) * 132 + row] = bfhi(w.w); }
      if (tid < 256) { int row = tid >> 2, kc = (tid & 3) * 8; u32x4 w = *(const u32x4*)(Bt + (size_t)(n0 + row) * K + k0 + kc);
        Bs[(kc + 0) * 68 + row] = bflo(w.x); Bs[(kc + 1) * 68 + row] = bfhi(w.x); Bs[(kc + 2) * 68 + row] = bflo(w.y); Bs[(kc + 3) * 68 + row] = bfhi(w.y);
        Bs[(kc + 4) * 68 + row] = bflo(w.z); Bs[(kc + 5) * 68 + row] = bfhi(w.z); Bs[(kc + 6) * 68 + row] = bflo(w.w); Bs[(kc + 7) * 68 + row] = bfhi(w.w); }
      __syncthreads();
#pragma unroll 8
      for (int kk = 0; kk < 32; ++kk) { f32x4 a = *(const f32x4*)(As + kk * 132 + ty * 4), b = *(const f32x4*)(Bs + kk * 68 + tx * 4);
        acc[0][0] += a.x * b.x; acc[0][1] += a.x * b.y; acc[0][2] += a.x * b.z; acc[0][3] += a.x * b.w;
        acc[1][0] += a.y * b.x; acc[1][1] += a.y * b.y; acc[1][2] += a.y * b.z; acc[1][3] += a.y * b.w;
        acc[2][0] += a.z * b.x; acc[2][1] += a.z * b.y; acc[2][2] += a.z * b.z; acc[2][3] += a.z * b.w;
        acc[3][0] += a.w * b.x; acc[3][1] += a.w * b.y; acc[3][2] += a.w * b.z; acc[3][3] += a.w * b.w; }
    }
#pragma unroll
    for (int i = 0; i < 4; ++i)
#pragma unroll
      for (int j = 0; j < 4; ++j) epi_store<EPI>(p, layer, m0 + ty * 4 + i, n0 + tx * 4 + j, acc[i][j]);
  }
}

namespace pg8 {
#define PG8_LAS __attribute__((address_space(3)))
typedef unsigned short bf16_t;
typedef short bf16x8 __attribute__((ext_vector_type(8)));
typedef float f32x4 __attribute__((ext_vector_type(4)));
typedef unsigned u32x4 __attribute__((ext_vector_type(4)));
constexpr int BM = 256, BK = 64, HALF = 128, HTB = HALF * BK * 2  , STAGE_BYTES = 8 * HTB, NXCD = 8, WGM = 8;

__host__ __device__ __forceinline__ int lds_byte(int r, int c) { const int st = (r >> 4) * 2 + (c >> 5), rr = r & 15, cc = c & 31, ob = rr * 64 + cc * 2; return st * 1024 + (ob ^ (((ob >> 9) & 1) << 5)); }
__host__ __device__ __forceinline__ void stage_rc(int b, int& R, int& C) { const int st = b / 1024, sb = b % 1024, swz = sb ^ (((sb >> 9) & 1) << 5); R = (st >> 1) * 16 + swz / 64; C = (st & 1) * 32 + (swz % 64) / 2; }
__host__ __device__ __forceinline__ int perm32(int rho) { const int n = rho >> 4, i = rho & 15; return 8 * (i >> 2) + 4 * n + (i & 3); }

struct Unit { int pm, pn; };
struct Gemm { const bf16_t* A; const bf16_t* Bt; int M, N, K; };

struct StaticOrder {
    int nM, nN, nwg, G, c;
    __host__ __device__ void init(int M, int N, int G_, int c_) { nM = M / BM; nN = N / BM; nwg = nM * nN; G = G_; c = c_; }
    __host__ __device__ bool next(int i, Unit& u) const {
        const long L = (long)i * G + c; if (L >= nwg) return false;
        int wgid = (int)L; { const int q = nwg / NXCD, r = nwg % NXCD, xcd = wgid % NXCD, off = wgid / NXCD; wgid = (xcd < r ? xcd * (q + 1) : r * (q + 1) + (xcd - r) * q) + off; }
        const int nig = WGM * nN, gid = wgid / nig, fm = gid * WGM, gsz = (nM - fm) < WGM ? (nM - fm) : WGM;
        u.pm = fm + ((wgid % nig) % gsz); u.pn = (wgid % nig) / gsz; return true;
    }
    __device__ __forceinline__ void a_ready(const Unit&) const {}
    __device__ __forceinline__ void done(const Unit&) const {}
};
__device__ __forceinline__ unsigned cvt_pk_bf16(float lo, float hi) { unsigned r; asm volatile("v_cvt_pk_bf16_f32 %0, %1, %2" : "=v"(r) : "v"(lo), "v"(hi)); return r; }
template <class Epi, class Sched, bool STAMP = false>
__device__ __forceinline__ void gemm_phase(PG8_LAS unsigned char* lds, const Gemm g, const Sched& S, const Epi& E, unsigned long long* stamps) {
    const int tid = threadIdx.x, wid = __builtin_amdgcn_readfirstlane(tid >> 6), lane = tid & 63, wr = wid >> 2, wc = wid & 3, fr = lane & 15, fq = lane >> 4;
    const int K = g.K, nt = K / BK;
    int ts_lo = 0, ts_hi = 0, nts = 0; const unsigned long long rt_entry = STAMP ? (unsigned long long)wall_clock64() : 0ull;
#define PG8_STAMP() do { if (STAMP && wid == 0 && nts < 64) { const unsigned long long _c = (unsigned long long)clock64(); \
        ts_lo = (lane == nts) ? (int)(unsigned)_c : ts_lo; ts_hi = (lane == nts) ? (int)(unsigned)(_c >> 32) : ts_hi; ++nts; } } while (0)
    PG8_STAMP();
    unsigned voffA[2], voffB[2];
#pragma unroll
    for (int i = 0; i < 2; ++i) { int R, C; stage_rc(tid * 16 + i * 8192, R, C); const int Rb = Epi::PERM ? ((R & ~31) + perm32(R & 31)) : R;
        voffA[i] = (unsigned)(R * K + C) * 2u; voffB[i] = (unsigned)(Rb * K + C) * 2u; }
    const size_t kstep = (size_t)(BK * 2);
    const size_t hstep = (size_t)HALF * K * 2;
    const size_t tstep = 2 * hstep;
    const unsigned ldsw = (unsigned)wid * 1024u;
    const int aoff = lds_byte(wr * 64 + fr, fq * 8), boff = lds_byte(wc * 32 + fr, fq * 8);
#define PG8_SA(b, h) (((b) * 2 + (h)) * HTB)
#define PG8_SB(b, h) ((4 + (b) * 2 + (h)) * HTB)
#define PG8_STAGE(bufoff, gbase, voff) do { _Pragma("unroll") for (int _i = 0; _i < 2; ++_i) \
        __builtin_amdgcn_global_load_lds((const unsigned*)((const char*)(gbase) + (voff)[_i]), (PG8_LAS unsigned*)(lds + (bufoff) + ldsw + _i * 8192), 16, 0, 0); } while (0)
#define PG8_LDA(dst, b, h) do { _Pragma("unroll") for (int m = 0; m < 4; ++m) _Pragma("unroll") for (int k = 0; k < 2; ++k) dst[m][k] = *(const PG8_LAS bf16x8*)(lds + PG8_SA(b, h) + aoff + m * 2048 + k * 1024); } while (0)
#define PG8_LDB(dst, b, h) do { _Pragma("unroll") for (int n = 0; n < 2; ++n) _Pragma("unroll") for (int k = 0; k < 2; ++k) dst[n][k] = *(const PG8_LAS bf16x8*)(lds + PG8_SB(b, h) + boff + n * 2048 + k * 1024); } while (0)
#define PG8_MMA(ai, bj, At, Bt) do { __builtin_amdgcn_s_setprio(1); _Pragma("unroll") for (int m = 0; m < 4; ++m) _Pragma("unroll") for (int n = 0; n < 2; ++n) _Pragma("unroll") for (int k = 0; k < 2; ++k) \
        acc[ai][bj][m][n] = __builtin_amdgcn_mfma_f32_16x16x32_bf16(Bt[n][k], At[m][k], acc[ai][bj][m][n], 0, 0, 0); __builtin_amdgcn_s_setprio(0); } while (0)
#define PG8_WAIT_V(n) asm volatile("s_waitcnt vmcnt(" #n ")" ::: "memory")
#define PG8_WAIT_L(n) asm volatile("s_waitcnt lgkmcnt(" #n ")" ::: "memory")
#define PG8_BAR __builtin_amdgcn_s_barrier()
#define PG8_SCHED __builtin_amdgcn_sched_barrier(0)
    Unit cur, nxt; int ui = 0;
    if (!S.next(0, cur)) return;
    f32x4 acc[2][2][4][2];
#pragma unroll
    for (int a = 0; a < 2; ++a)
#pragma unroll
        for (int b = 0; b < 2; ++b)
#pragma unroll
            for (int m = 0; m < 4; ++m)
#pragma unroll
                for (int n = 0; n < 2; ++n) acc[a][b][m][n] = (f32x4){0.f, 0.f, 0.f, 0.f};
    bf16x8 At[4][2], B0[2][2], B1[2][2];
    const char* cA = (const char*)g.A + (size_t)cur.pm * tstep; const char* cB = (const char*)g.Bt + (size_t)cur.pn * tstep;
    S.a_ready(cur);
    PG8_STAGE(PG8_SB(0, 0), cB, voffB); PG8_STAGE(PG8_SA(0, 0), cA, voffA); PG8_STAGE(PG8_SB(0, 1), cB + hstep, voffB); PG8_STAGE(PG8_SA(0, 1), cA + hstep, voffA);
    if (wr == 1) PG8_BAR;
    PG8_WAIT_V(4); PG8_BAR;
    PG8_STAGE(PG8_SB(1, 0), cB + kstep, voffB); PG8_STAGE(PG8_SA(1, 0), cA + kstep, voffA); PG8_STAGE(PG8_SB(1, 1), cB + hstep + kstep, voffB);
    PG8_WAIT_V(6); PG8_BAR;
    PG8_STAMP();
    for (;;) {
        const bool has_next = S.next(ui + 1, nxt);
        const char* nA = has_next ? (const char*)g.A + (size_t)nxt.pm * tstep : cA; const char* nB = has_next ? (const char*)g.Bt + (size_t)nxt.pn * tstep : cB;
        for (int t = 0; t < nt; t += 2) {
            const bool last = (t == nt - 2);
            const char* a1 = cA + (size_t)(t + 1) * kstep;
            const char* a2 = last ? nA : cA + (size_t)(t + 2) * kstep; const char* b2 = last ? nB : cB + (size_t)(t + 2) * kstep;
            const char* a3 = a2 + kstep; const char* b3 = b2 + kstep;
            if (last && has_next) S.a_ready(nxt);
            PG8_LDB(B0, 0, 0); PG8_SCHED; PG8_LDA(At, 0, 0); PG8_STAGE(PG8_SA(1, 1), a1 + hstep, voffA);
            PG8_WAIT_L(8); PG8_BAR; PG8_WAIT_L(0); PG8_MMA(0, 0, At, B0); PG8_BAR; PG8_SCHED;
            PG8_LDB(B1, 0, 1); PG8_STAGE(PG8_SB(0, 0), b2, voffB);
            PG8_BAR; PG8_WAIT_L(0); PG8_MMA(0, 1, At, B1); PG8_BAR;
            PG8_LDA(At, 0, 1); PG8_STAGE(PG8_SA(0, 0), a2, voffA);
            PG8_BAR; PG8_WAIT_L(0); PG8_MMA(1, 0, At, B0); PG8_BAR; PG8_SCHED;
            PG8_STAGE(PG8_SB(0, 1), b2 + hstep, voffB);
            PG8_WAIT_V(6); PG8_BAR; PG8_MMA(1, 1, At, B1); PG8_BAR;
            PG8_LDB(B0, 1, 0); PG8_SCHED; PG8_LDA(At, 1, 0); PG8_STAGE(PG8_SA(0, 1), a2 + hstep, voffA);
            PG8_WAIT_L(8); PG8_BAR; PG8_WAIT_L(0); PG8_MMA(0, 0, At, B0); PG8_BAR; PG8_SCHED;
            PG8_LDB(B1, 1, 1); PG8_STAGE(PG8_SB(1, 0), b3, voffB);
            PG8_BAR; PG8_WAIT_L(0); PG8_MMA(0, 1, At, B1); PG8_BAR;
            PG8_LDA(At, 1, 1); PG8_STAGE(PG8_SA(1, 0), a3, voffA);
            PG8_BAR; PG8_WAIT_L(0); PG8_MMA(1, 0, At, B0); PG8_BAR; PG8_SCHED;
            PG8_STAGE(PG8_SB(1, 1), b3 + hstep, voffB);
            PG8_WAIT_V(6); PG8_BAR; PG8_MMA(1, 1, At, B1); PG8_BAR;
        }
        PG8_STAMP();
        if constexpr (!Epi::AFTER_DRAIN) { E(acc, cur, wr, wc, fr, fq); S.done(cur); }
        PG8_STAMP();
        if (!has_next) break;
#pragma unroll
        for (int a = 0; a < 2; ++a)
#pragma unroll
            for (int b = 0; b < 2; ++b)
#pragma unroll
                for (int m = 0; m < 4; ++m)
#pragma unroll
                    for (int n = 0; n < 2; ++n) acc[a][b][m][n] = (f32x4){0.f, 0.f, 0.f, 0.f};
        cur = nxt; cA = nA; cB = nB; ++ui;
    }
    PG8_WAIT_V(0);
    if (wr == 0) PG8_BAR;
    PG8_BAR;
    if constexpr (Epi::AFTER_DRAIN) { E.fused(acc, cur, wr, wc, fr, fq, lds, wid, lane); S.done(cur); }
    PG8_STAMP();
    if (STAMP && wid == 0) { stamps[lane] = lane < nts ? (((unsigned long long)(unsigned)ts_hi << 32) | (unsigned)ts_lo) : 0ull;
        if (lane == 62) stamps[62] = rt_entry; if (lane == 63) stamps[63] = (unsigned long long)wall_clock64(); }
#undef PG8_STAMP
#undef PG8_SA
#undef PG8_SB
#undef PG8_STAGE
#undef PG8_LDA
#undef PG8_LDB
#undef PG8_MMA
#undef PG8_WAIT_V
#undef PG8_WAIT_L
#undef PG8_BAR
#undef PG8_SCHED
}
}

struct EpiEvin {
  static constexpr bool PERM = true, AFTER_DRAIN = false;
  bf16_t *ZQK, *ZV, *ZO, *ZP; const float* bias;
  __device__ __forceinline__ void operator()(const pg8::f32x4 (&acc)[2][2][4][2], const pg8::Unit& u, int wr, int wc, int fr, int fq) const {
    const int row0 = u.pm * 256 + wr * 64 + fr, ct = u.pn * 256;
    bf16_t* base; int ldc, cl; bool sig = false;
    if (ct < 1024) { base = ZQK; ldc = 1024; cl = ct; } else if (ct < 1536) { base = ZV; ldc = 512; cl = ct - 1024; } else if (ct < 2048) { base = ZO; ldc = 512; cl = ct - 1536; sig = true; } else { base = ZP; ldc = 512; cl = ct - 2048; }
    const int cofs = wc * 32 + 8 * fq;
    pg8::f32x4 bv[2][2];
#pragma unroll
    for (int bj = 0; bj < 2; ++bj)
#pragma unroll
      for (int n = 0; n < 2; ++n) bv[bj][n] = *(const pg8::f32x4*)(bias + ct + cofs + bj * 128 + 4 * n);
#pragma unroll
    for (int ai = 0; ai < 2; ++ai)
#pragma unroll
      for (int m = 0; m < 4; ++m) { bf16_t* rowp = base + (size_t)(row0 + ai * 128 + m * 16) * ldc + cl + cofs;
#pragma unroll
        for (int bj = 0; bj < 2; ++bj) { pg8::f32x4 v0 = acc[ai][bj][m][0] + bv[bj][0], v1 = acc[ai][bj][m][1] + bv[bj][1];
          if (sig) {
#pragma unroll
            for (int j = 0; j < 4; ++j) { v0[j] = sigmf(v0[j]); v1[j] = sigmf(v1[j]); } }
          pg8::u32x4 w; w.x = pg8::cvt_pk_bf16(v0[0], v0[1]); w.y = pg8::cvt_pk_bf16(v0[2], v0[3]); w.z = pg8::cvt_pk_bf16(v1[0], v1[1]); w.w = pg8::cvt_pk_bf16(v1[2], v1[3]);
          *(pg8::u32x4*)(rowp + bj * 128) = w; } }
  }
};
struct EpiPlain {
  static constexpr bool PERM = true, AFTER_DRAIN = false;
  bf16_t* out; int ldc;
  __device__ __forceinline__ void operator()(const pg8::f32x4 (&acc)[2][2][4][2], const pg8::Unit& u, int wr, int wc, int fr, int fq) const {
    const int row0 = u.pm * 256 + wr * 64 + fr, col0 = u.pn * 256 + wc * 32 + 8 * fq;
#pragma unroll
    for (int ai = 0; ai < 2; ++ai)
#pragma unroll
      for (int m = 0; m < 4; ++m) { bf16_t* rowp = out + (size_t)(row0 + ai * 128 + m * 16) * ldc + col0;
#pragma unroll
        for (int bj = 0; bj < 2; ++bj) { const pg8::f32x4 v0 = acc[ai][bj][m][0], v1 = acc[ai][bj][m][1];
          pg8::u32x4 w; w.x = pg8::cvt_pk_bf16(v0[0], v0[1]); w.y = pg8::cvt_pk_bf16(v0[2], v0[3]); w.z = pg8::cvt_pk_bf16(v1[0], v1[1]); w.w = pg8::cvt_pk_bf16(v1[2], v1[3]);
          *(pg8::u32x4*)(rowp + bj * 128) = w; } }
  }
};
struct EpiRes {
  static constexpr bool PERM = false, AFTER_DRAIN = false;
  const float* xin; float* X; const float* gate;
  __device__ __forceinline__ void operator()(const pg8::f32x4 (&acc)[2][2][4][2], const pg8::Unit& u, int wr, int wc, int fr, int fq) const {
    const int row0 = u.pm * 256 + wr * 64 + fr, col0 = u.pn * 256 + wc * 32 + 4 * fq; const float* gb = gate + (size_t)((u.pm * 256) / S) * 6144;
    pg8::f32x4 gv[2][2];
#pragma unroll
    for (int bj = 0; bj < 2; ++bj)
#pragma unroll
      for (int n = 0; n < 2; ++n) gv[bj][n] = *(const pg8::f32x4*)(gb + col0 + bj * 128 + n * 16);
#pragma unroll
    for (int ai = 0; ai < 2; ++ai)
#pragma unroll
      for (int m = 0; m < 4; ++m) { const size_t off = (size_t)(row0 + ai * 128 + m * 16) * 1024 + col0;
#pragma unroll
        for (int bj = 0; bj < 2; ++bj)
#pragma unroll
          for (int n = 0; n < 2; ++n) { const pg8::f32x4 xi = *(const pg8::f32x4*)(xin + off + bj * 128 + n * 16); *(pg8::f32x4*)(X + off + bj * 128 + n * 16) = xi + gv[bj][n] * acc[ai][bj][m][n]; }
        asm volatile("" ::: "memory"); }
  }
};
template <class Epi> __device__ __forceinline__ void phase_gemm_fast(const bf16_t* A, const bf16_t* Bt, int M, int N, int K, const Epi& E, char* smem) {
  pg8::Gemm g; g.A = A; g.Bt = Bt; g.M = M; g.N = N; g.K = K;
  pg8::StaticOrder So; So.init(M, N, (int)gridDim.x, (int)blockIdx.x);
  pg8::gemm_phase<Epi, pg8::StaticOrder, false>((PG8_LAS unsigned char*)smem, g, So, E, nullptr);
}

namespace cp {
typedef short bf16x8 __attribute__((ext_vector_type(8)));
typedef float f32x16 __attribute__((ext_vector_type(16)));
constexpr int RS = 272;
__device__ __forceinline__ void unpack8(const u32x4 w, float* f) { f[0] = bflo(w.x); f[1] = bfhi(w.x); f[2] = bflo(w.y); f[3] = bfhi(w.y); f[4] = bflo(w.z); f[5] = bfhi(w.z); f[6] = bflo(w.w); f[7] = bfhi(w.w); }
__device__ void phase_convpool(const Params& p, char* smem) {
  for (int job = blockIdx.x; job < T / 64; job += gridDim.x) {
    int tid_ = threadIdx.x; asm volatile("" : "+v"(tid_));
    const int tid = tid_, c0 = (tid & 127) * 8, t0 = job * 64 + (tid >> 7) * 16, s0 = t0 & (S - 1);
    float cw[5][8], cb[8];
#pragma unroll
    for (int j = 0; j < 5; ++j) { const f32x4 a = *(const f32x4*)(p.conv_w + j * 1024 + c0), b = *(const f32x4*)(p.conv_w + j * 1024 + c0 + 4); cw[j][0] = a.x; cw[j][1] = a.y; cw[j][2] = a.z; cw[j][3] = a.w; cw[j][4] = b.x; cw[j][5] = b.y; cw[j][6] = b.z; cw[j][7] = b.w; }
    { const f32x4 a = *(const f32x4*)(p.conv_b + c0), b = *(const f32x4*)(p.conv_b + c0 + 4); cb[0] = a.x; cb[1] = a.y; cb[2] = a.z; cb[3] = a.w; cb[4] = b.x; cb[5] = b.y; cb[6] = b.z; cb[7] = b.w; }
    const float sc = c0 >= 512 ? KSCALE : 1.f;
    float win[5][8];
#pragma unroll
    for (int j = 0; j < 4; ++j) { const int ss = s0 + j - 2; u32x4 w = (u32x4){0u, 0u, 0u, 0u}; if (ss >= 0 && ss < S) w = *(const u32x4*)(p.ZQK + (size_t)(t0 + j - 2) * 1024 + c0); unpack8(w, win[j + 1]); }
#pragma unroll
    for (int i = 0; i < 16; ++i) {
#pragma unroll
      for (int j = 0; j < 4; ++j)
#pragma unroll
        for (int q = 0; q < 8; ++q) win[j][q] = win[j + 1][q];
      { const int ss = s0 + i + 2; u32x4 w = (u32x4){0u, 0u, 0u, 0u}; if (ss < S) w = *(const u32x4*)(p.ZQK + (size_t)(t0 + i + 2) * 1024 + c0); unpack8(w, win[4]); }
      float a[8];
#pragma unroll
      for (int q = 0; q < 8; ++q) { float v = cb[q];
#pragma unroll
        for (int j = 0; j < 5; ++j) v += cw[j][q] * win[j][q];
        a[q] = siluf(v) * sc; }
      u32x4 o; o.x = pack2(a[0], a[1]); o.y = pack2(a[2], a[3]); o.z = pack2(a[4], a[5]); o.w = pack2(a[6], a[7]); *(u32x4*)(p.QK + (size_t)(t0 + i) * 1024 + c0) = o;
    }
  }
  for (int job = blockIdx.x; job < (T / 128) * 4; job += gridDim.x) {
    int tid_ = threadIdx.x; asm volatile("" : "+v"(tid_));
    const int tid = tid_, wid = tid >> 6, lane = tid & 63, l31 = lane & 31, hh = lane >> 5;
    const int g = job & 3, t0 = (job >> 2) * 128, win = 2 << g, hw = win >> 1;
    __syncthreads();
#pragma unroll
    for (int i = 0; i < 4; ++i) { const int idx = tid + i * NTHREADS, row = idx >> 4, ch = idx & 15; *(u32x4*)(smem + 128 * RS + row * RS + ch * 16) = *(const u32x4*)(p.poolWt + (size_t)g * 16384 + row * 128 + ch * 8); }
#pragma unroll 1
    for (int i = 0; i < 4; ++i) { const int idx = tid + i * NTHREADS, row = idx >> 4, ch = idx & 15, t = t0 + row, s = t & (S - 1); const int lo = max(s - hw, 0), hi = min(s + hw, S);
      float sum[8], own[8];
#pragma unroll
      for (int q = 0; q < 8; ++q) sum[q] = 0.f;
      const bf16_t* base = p.ZP + (size_t)(t - s) * 512 + g * 128 + ch * 8;
      for (int r = lo; r < hi; ++r) { float f[8]; unpack8(*(const u32x4*)(base + (size_t)r * 512), f);
#pragma unroll
        for (int q = 0; q < 8; ++q) sum[q] += f[q]; }
      unpack8(*(const u32x4*)(base + (size_t)s * 512), own); const float inv = 1.f / (float)(hi - lo);
      u32x4 o; o.x = pack2(sum[0] * inv - own[0], sum[1] * inv - own[1]); o.y = pack2(sum[2] * inv - own[2], sum[3] * inv - own[3]); o.z = pack2(sum[4] * inv - own[4], sum[5] * inv - own[5]); o.w = pack2(sum[6] * inv - own[6], sum[7] * inv - own[7]);
      *(u32x4*)(smem + row * RS + ch * 16) = o; }
    __syncthreads();
    const int mt = wid >> 1;
#pragma unroll
    for (int q = 0; q < 2; ++q) { const int nt = (wid & 1) * 2 + q;
      f32x16 acc;
#pragma unroll
      for (int r = 0; r < 16; ++r) acc[r] = 0.f;
      const char* ya = smem + (mt * 32 + l31) * RS + hh * 16; const char* wb = smem + 128 * RS + (nt * 32 + l31) * RS + hh * 16;
#pragma unroll
      for (int ks = 0; ks < 8; ++ks) acc = __builtin_amdgcn_mfma_f32_32x32x16_bf16(*(const bf16x8*)(ya + ks * 32), *(const bf16x8*)(wb + ks * 32), acc, 0, 0, 0);
      const int e = nt * 32 + l31; const float psc = p.pool_sc[g * 128 + e];
#pragma unroll
      for (int r = 0; r < 16; ++r) { const int row = mt * 32 + (r & 3) + 8 * (r >> 2) + 4 * hh; p.CAT[(size_t)(t0 + row) * 1024 + 512 + g * 128 + e] = f2bf(acc[r] * psc); } }
  }
}
}

__device__ void phase_mlstm_naive(const Params& p, char* smem) {
  float* qs = (float*)smem; float* ks = qs + 128; float* nump = ks + 128; float* red = nump + 512;
  const int tid = threadIdx.x, j = tid & 127, qd = tid >> 7;
  for (int job = blockIdx.x; job < 64; job += gridDim.x) {
    const int dir = job >> 5, b = (job >> 2) & 7, h = job & 3;
    float C[32];
#pragma unroll
    for (int d = 0; d < 32; ++d) C[d] = 0.f;
    float n = 0.f, m = 0.f;
    for (int step = 0; step < S; ++step) { const int s = dir ? S - 1 - step : step; const size_t t = (size_t)b * S + s;
      const float li = p.gates[t * 16 + dir * 4 + h], gf = p.gates[t * 16 + 8 + dir * 4 + h];
      const float lf = fminf(gf, 0.f) - log1pf(__expf(-fabsf(gf)));
      __syncthreads();
      if (qd == 0) { qs[j] = bf2f(p.QK[t * 1024 + h * 128 + j]); ks[j] = bf2f(p.QK[t * 1024 + 512 + h * 128 + j]); }
      const float v = bf2f(p.ZV[t * 512 + h * 128 + j]);
      __syncthreads();
      const float mn = fmaxf(lf + m, li), ip = __expf(li - mn), fp = __expf(lf + m - mn); m = mn;
      float num = 0.f;
#pragma unroll
      for (int d = 0; d < 32; ++d) { C[d] = fp * C[d] + ip * ks[qd * 32 + d] * v; num += qs[qd * 32 + d] * C[d]; }
      float dp = 0.f; if (qd == 0) { n = fp * n + ip * ks[j]; dp = qs[j] * n; }
      nump[qd * 128 + j] = num;
      dp = wave_sum(dp); if ((tid & 63) == 0) red[tid >> 6] = dp;
      __syncthreads();
      if (qd == 0) { const float den = red[0] + red[1]; num = nump[j] + nump[128 + j] + nump[256 + j] + nump[384 + j];
        p.HS[((size_t)dir * T + t) * 512 + h * 128 + j] = f2bf(num / fmaxf(fabsf(den), __expf(-mn))); }
    }
    __syncthreads();
  }
}

namespace ml {
typedef short bf16x8 __attribute__((ext_vector_type(8)));
typedef short s16x4 __attribute__((ext_vector_type(4)));
typedef float f32x16 __attribute__((ext_vector_type(16)));
constexpr int RS = 272;
constexpr int OFF_Q = 0, OFF_K = 128 * RS, OFF_VT = 2 * 128 * RS, OFF_VW = OFF_VT + 34 * RS, OFF_CT = OFF_VW + 34 * RS, OFF_A = OFF_CT + 34 * RS;
constexpr int OFF_PA = OFF_A + 16384, OFF_MCH = OFF_PA + 16384, OFF_TAB = OFF_MCH + 512, OFF_DEN = OFF_TAB + 4096, OFF_END = OFF_DEN + 512;
static_assert(OFF_A % 16 == 0 && OFF_END <= SMEM_BYTES, "mlstm LDS layout");
__device__ __forceinline__ int crow(int r, int h) { return (r & 3) + 8 * (r >> 2) + 4 * h; }
__device__ __forceinline__ int spos(int s) { return (s & ~12) | ((s & 4) << 1) | ((s & 8) >> 1); }
#define ML_MFMA(a, b, c) __builtin_amdgcn_mfma_f32_32x32x16_bf16((a), (b), (c), 0, 0, 0)
__device__ __forceinline__ bf16x8 pack8(float x0, float x1, float x2, float x3, float x4, float x5, float x6, float x7) {
  u32x4 w; w.x = pack2(x0, x1); w.y = pack2(x2, x3); w.z = pack2(x4, x5); w.w = pack2(x6, x7); return __builtin_bit_cast(bf16x8, w);
}
__device__ __forceinline__ void tr_read2(unsigned a0, unsigned a1, s16x4& lo, s16x4& hi) {
  asm volatile("ds_read_b64_tr_b16 %0, %2\n\tds_read_b64_tr_b16 %1, %3\n\ts_waitcnt lgkmcnt(0)" : "=&v"(lo), "=&v"(hi) : "v"(a0), "v"(a1) : "memory");
}

__device__ void phase_mlstm(const Params& p, char* smem) {
  int tid_ = threadIdx.x; asm volatile("" : "+v"(tid_));
  const int tid = tid_, wid = tid >> 6, lane = tid & 63, l31 = lane & 31, hh = lane >> 5;
  float* const LA = (float*)(smem + OFF_A); float* const LPA = (float*)(smem + OFF_PA); float* const LM = (float*)(smem + OFF_MCH);
  float* const LTAB = (float*)(smem + OFF_TAB); float* const LDEN = (float*)(smem + OFF_DEN);
  const unsigned lds0 = (unsigned)(uintptr_t)smem;
  for (int job = blockIdx.x; job < 256; job += gridDim.x) {
    const int dvq = job & 3, h = (job >> 2) & 3, b = (job >> 4) & 7, dir = job >> 7;
    const float* gts = p.gates + (size_t)b * S * 16;
    const bf16_t* QKb = p.QK + (size_t)b * S * 1024 + h * 128; const bf16_t* ZVb = p.ZV + (size_t)b * S * 512 + h * 128 + dvq * 32;
    bf16_t* HSb = p.HS + ((size_t)dir * T + (size_t)b * S) * 512 + h * 128 + dvq * 32;
    __syncthreads();
    for (int i = tid; i < 3 * 34 * RS / 4; i += NTHREADS) ((u32*)(smem + OFF_VT))[i] = 0u;
    for (int cc = 0; cc < 4; ++cc) { const int c = wid * 4 + cc, tau0 = c * 128 + 2 * lane; const int tok0 = dir ? S - 1 - tau0 : tau0, tok1 = dir ? tok0 - 1 : tok0 + 1;
      const float li0 = gts[(size_t)tok0 * 16 + dir * 4 + h], gf0 = gts[(size_t)tok0 * 16 + 8 + dir * 4 + h], li1 = gts[(size_t)tok1 * 16 + dir * 4 + h], gf1 = gts[(size_t)tok1 * 16 + 8 + dir * 4 + h];
      const float lf0 = fminf(gf0, 0.f) - log1pf(__expf(-fabsf(gf0))), lf1 = fminf(gf1, 0.f) - log1pf(__expf(-fabsf(gf1)));
      const float pr = lf0 + lf1; float incl = pr;
#pragma unroll
      for (int o = 1; o < 64; o <<= 1) { const float v = __shfl_up(incl, o); if (lane >= o) incl += v; }
      const float b0 = incl - pr + lf0, b1 = b0 + lf1, a0 = li0 - b0, a1 = li1 - b1;
      float im = fmaxf(a0, a1);
#pragma unroll
      for (int o = 1; o < 64; o <<= 1) { const float v = __shfl_up(im, o); if (lane >= o) im = fmaxf(im, v); }
      float ex = __shfl_up(im, 1); if (lane == 0) ex = -INFINITY;
      const float pa0 = fmaxf(ex, a0), pa1 = fmaxf(pa0, a1);
      LA[tau0] = a0; LA[tau0 + 1] = a1; LPA[tau0] = pa0; LPA[tau0 + 1] = pa1; if (lane == 63) LM[64 + c] = b1; }
    __syncthreads();
    if (tid == 0) { float m = 0.f; for (int c = 0; c < 32; ++c) { LM[c] = m; m = LM[64 + c] + fmaxf(m, LPA[c * 128 + 127]); } LM[32] = m; }
    __syncthreads();
    u32x4 qreg[4], kreg[4], vreg;
#define ML_TOK(tau) (dir ? S - 1 - (tau) : (tau))
#define ML_LOAD(c) do { _Pragma("unroll") for (int i_ = 0; i_ < 4; ++i_) { const int tk_ = ML_TOK((c) * 128 + (tid >> 4) + 32 * i_); \
        qreg[i_] = *(const u32x4*)(QKb + (size_t)tk_ * 1024 + (tid & 15) * 8); kreg[i_] = *(const u32x4*)(QKb + (size_t)tk_ * 1024 + 512 + (tid & 15) * 8); } \
      { const int tk_ = ML_TOK((c) * 128 + (tid >> 2)); vreg = *(const u32x4*)(ZVb + (size_t)tk_ * 512 + (tid & 3) * 8); } } while (0)
#define ML_TABLES(c) do { if (tid < 128) { const int tau_ = (c) * 128 + tid, tk_ = ML_TOK(tau_); const float li_ = gts[(size_t)tk_ * 16 + dir * 4 + h], a_ = LA[tau_], mc_ = LM[(c)]; \
        const float Mj_ = fmaxf(mc_, LPA[tau_]), Me_ = fmaxf(mc_, LPA[(c) * 128 + 127]); float* tb_ = LTAB + ((c) & 1) * 512; \
        tb_[tid] = Mj_; tb_[128 + tid] = __expf(mc_ - Mj_); tb_[256 + tid] = __expf(-((li_ - a_) + Mj_)); tb_[384 + tid] = __expf(a_ - Me_); } } while (0)
#define ML_STORE(c) do { _Pragma("unroll") for (int i_ = 0; i_ < 4; ++i_) { const int row_ = (tid >> 4) + 32 * i_; \
        *(u32x4*)(smem + OFF_Q + row_ * RS + (tid & 15) * 16) = qreg[i_]; *(u32x4*)(smem + OFF_K + row_ * RS + (tid & 15) * 16) = kreg[i_]; } \
      { const int s_ = tid >> 2, ps_ = spos(s_) * 2; const float we_ = LTAB[((c) & 1) * 512 + 384 + s_]; const u32 vw_[4] = {vreg.x, vreg.y, vreg.z, vreg.w}; \
        _Pragma("unroll") for (int i_ = 0; i_ < 4; ++i_) { const int r0_ = ((tid & 3) * 8 + 2 * i_) * RS + ps_; \
          *(bf16_t*)(smem + OFF_VT + r0_) = (bf16_t)(vw_[i_] & 0xFFFFu); *(bf16_t*)(smem + OFF_VT + r0_ + RS) = (bf16_t)(vw_[i_] >> 16); \
          *(bf16_t*)(smem + OFF_VW + r0_) = f2bf(bflo(vw_[i_]) * we_); *(bf16_t*)(smem + OFF_VW + r0_ + RS) = f2bf(bfhi(vw_[i_]) * we_); } } \
      if (tid < 128) { const int ps_ = spos(tid) * 2; *(bf16_t*)(smem + OFF_VT + 32 * RS + ps_) = (bf16_t)0x3F80u; *(bf16_t*)(smem + OFF_VW + 32 * RS + ps_) = f2bf(LTAB[((c) & 1) * 512 + 384 + tid]); } } while (0)
    ML_LOAD(0); ML_TABLES(0);
    __syncthreads();
    ML_STORE(0);
    __syncthreads();
    f32x16 Cacc;
#pragma unroll
    for (int r = 0; r < 16; ++r) Cacc[r] = 0.f;
    for (int c = 0; c < 32; ++c) {
      int tidc_ = threadIdx.x; asm volatile("" : "+v"(tidc_));
      const int tid = tidc_, wid = tid >> 6, lane = tid & 63, l31 = lane & 31, hh = lane >> 5;
      const int t2 = wid >> 1, nt = wid & 1, brow = min(nt * 32 + l31, 33);
      if (c + 1 < 32) { ML_LOAD(c + 1); ML_TABLES(c + 1); }
      const float* tab = LTAB + (c & 1) * 512;
      f32x16 acc;
#pragma unroll
      for (int r = 0; r < 16; ++r) acc[r] = 0.f;
      const char* qa = smem + OFF_Q + (t2 * 32 + l31) * RS + hh * 16;
      { const char* cb = smem + OFF_CT + brow * RS + hh * 16;
#pragma unroll
        for (int ks = 0; ks < 8; ++ks) acc = ML_MFMA(*(const bf16x8*)(qa + ks * 32), *(const bf16x8*)(cb + ks * 32), acc); }
#pragma unroll
      for (int r = 0; r < 16; ++r) acc[r] *= tab[128 + t2 * 32 + crow(r, hh)];
      const float Mj = tab[t2 * 32 + l31];
      for (int si = 0; si <= t2; ++si) {
        f32x16 X;
#pragma unroll
        for (int r = 0; r < 16; ++r) X[r] = 0.f;
        const char* ka = smem + OFF_K + (si * 32 + l31) * RS + hh * 16;
#pragma unroll
        for (int ks = 0; ks < 8; ++ks) X = ML_MFMA(*(const bf16x8*)(ka + ks * 32), *(const bf16x8*)(qa + ks * 32), X);
        const float* Ac = LA + c * 128 + si * 32;
#pragma unroll
        for (int r = 0; r < 16; ++r) { const int sl = crow(r, hh); float w = __expf(Ac[sl] - Mj); if (si == t2 && sl > l31) w = 0.f; X[r] *= w; }
        const bf16x8 f0 = pack8(X[0], X[1], X[2], X[3], X[4], X[5], X[6], X[7]), f1 = pack8(X[8], X[9], X[10], X[11], X[12], X[13], X[14], X[15]);
        const char* vb = smem + OFF_VT + brow * RS + si * 64 + hh * 16;
        acc = ML_MFMA(f0, *(const bf16x8*)(vb), acc); acc = ML_MFMA(f1, *(const bf16x8*)(vb + 32), acc);
      }
      if (nt == 1 && l31 == 0) {
#pragma unroll
        for (int r = 0; r < 16; ++r) LDEN[t2 * 32 + crow(r, hh)] = acc[r]; }
      { const float mc = LM[c], decay = __expf(mc - fmaxf(mc, LPA[c * 128 + 127]));
#pragma unroll
        for (int r = 0; r < 16; ++r) Cacc[r] *= decay;
        const unsigned ta = lds0 + OFF_K + ((lane & 15) >> 2) * RS + (t2 * 32 + 16 * ((lane >> 4) & 1) + 4 * (lane & 3)) * 2 + 4 * hh * RS;
        const char* wb = smem + OFF_VW + brow * RS + hh * 16;
#pragma unroll
        for (int ks = 0; ks < 8; ++ks) { s16x4 lo, hi; tr_read2(ta + 16 * ks * RS, ta + (16 * ks + 8) * RS, lo, hi); __builtin_amdgcn_sched_barrier(0);
          const bf16x8 a = (bf16x8){lo[0], lo[1], lo[2], lo[3], hi[0], hi[1], hi[2], hi[3]};
          Cacc = ML_MFMA(a, *(const bf16x8*)(wb + ks * 32), Cacc); } }
      __syncthreads();
      if (nt == 0) {
#pragma unroll
        for (int r = 0; r < 16; ++r) { const int j = t2 * 32 + crow(r, hh); const float dn = LDEN[j], nr = tab[256 + j]; const int tk = ML_TOK(c * 128 + j);
          HSb[(size_t)tk * 512 + l31] = f2bf(acc[r] / fmaxf(fabsf(dn), nr)); } }
      if (nt * 32 + l31 <= 32) { char* cw = smem + OFF_CT + (nt * 32 + l31) * RS + (t2 * 32 + 4 * hh) * 2;
#pragma unroll
        for (int g = 0; g < 4; ++g) { u32x2 w; w.x = pack2(Cacc[4 * g], Cacc[4 * g + 1]); w.y = pack2(Cacc[4 * g + 2], Cacc[4 * g + 3]); *(u32x2*)(cw + 16 * g) = w; } }
      if (c + 1 < 32) ML_STORE(c + 1);
      __syncthreads();
    }
#undef ML_TOK
#undef ML_LOAD
#undef ML_TABLES
#undef ML_STORE
  }
}
}

__device__ void phase_cat(const Params& p) {
  const int tid = threadIdx.x, wid = tid >> 6, lane = tid & 63;
  for (int job = blockIdx.x; job < T * 4 / 8; job += gridDim.x) {
    const int w = job * 8 + wid, t = w >> 2, h = w & 3; const size_t o = (size_t)t * 512 + h * 128 + lane * 2;
    const u32 a = *(const u32*)(p.HS + o), b = *(const u32*)(p.HS + (size_t)T * 512 + o), so = *(const u32*)(p.ZO + o);
    const float a0 = bflo(a) + bflo(b), a1 = bfhi(a) + bfhi(b); const float r = rsqrtf(wave_sum(a0 * a0 + a1 * a1) * (1.f / 128.f) + EPS);
    *(u32*)(p.CAT + (size_t)t * 1024 + h * 128 + lane * 2) = pack2(a0 * r * p.mnorm_g[h * 128 + lane * 2] * bflo(so), a1 * r * p.mnorm_g[h * 128 + lane * 2 + 1] * bfhi(so));
  }
}

__device__ void phase_peer_select_naive(const Params& p, int layer, char* smem) {
  float* kl = (float*)smem;
  float* qsh = kl + 2 * 128 * 129;
  const int tid = threadIdx.x, wid = tid >> 6, lane = tid & 63; float* qs = qsh + wid * 128;
  __syncthreads();
  for (int i = tid; i < 2 * 128 * 128; i += NTHREADS) kl[(i >> 7) * 129 + (i & 127)] = p.peer_keys[(size_t)layer * 32768 + i];
  __syncthreads();
  for (int job = blockIdx.x; job < T; job += gridDim.x) {
    const int t = job, h = wid;
    float ts[2][16]; int ti[2][16];
#pragma unroll
    for (int pp = 0; pp < 2; ++pp) {
      const bf16_t* q = p.QP + (size_t)t * 2048 + h * 256 + pp * 128; const float q0 = bf2f(q[lane]), q1 = bf2f(q[lane + 64]);
      const float r = rsqrtf(wave_sum(q0 * q0 + q1 * q1) * (1.f / 128.f) + EPS); qs[lane] = q0 * r; qs[lane + 64] = q1 * r;
      float s0 = 0.f, s1 = 0.f; const float* k0 = kl + (pp * 128 + lane) * 129; const float* k1 = k0 + 64 * 129;
      for (int c = 0; c < 128; ++c) { const float qc = qs[c]; s0 += qc * k0[c]; s1 += qc * k1[c]; }
#pragma unroll
      for (int k = 0; k < 16; ++k) { const float mx = wave_max(fmaxf(s0, s1)); int cand = (s0 == mx) ? lane : ((s1 == mx) ? lane + 64 : 9999);
        for (int o = 32; o >= 1; o >>= 1) cand = min(cand, __shfl_xor(cand, o));
        ts[pp][k] = mx; ti[pp][k] = cand; if (cand == lane) s0 = -INFINITY; if (cand == lane + 64) s1 = -INFINITY; }
    }
    float cs[4];
#pragma unroll
    for (int r = 0; r < 4; ++r) { const int c = lane * 4 + r; float va = 0.f, vb = 0.f;
#pragma unroll
      for (int k = 0; k < 16; ++k) { if (k == (c >> 4)) va = ts[0][k]; if (k == (c & 15)) vb = ts[1][k]; }
      cs[r] = va + vb; }
    float top[16]; int tix[16];
#pragma unroll
    for (int k = 0; k < 16; ++k) { const float mx = wave_max(fmaxf(fmaxf(cs[0], cs[1]), fmaxf(cs[2], cs[3]))); int cand = 9999;
#pragma unroll
      for (int r = 3; r >= 0; --r) if (cs[r] == mx) cand = lane * 4 + r;
      for (int o = 32; o >= 1; o >>= 1) cand = min(cand, __shfl_xor(cand, o));
      top[k] = mx; tix[k] = cand;
#pragma unroll
      for (int r = 0; r < 4; ++r) if (cand == lane * 4 + r) cs[r] = -INFINITY; }
    float sum = 0.f;
#pragma unroll
    for (int k = 0; k < 16; ++k) sum += __expf(top[k] - top[0]);
    if (lane < 16) { float tv = 0.f; int tc = 0;
#pragma unroll
      for (int k = 0; k < 16; ++k) if (k == lane) { tv = top[k]; tc = tix[k]; }
      int ia = 0, ib = 0;
#pragma unroll
      for (int k = 0; k < 16; ++k) { if (k == (tc >> 4)) ia = ti[0][k]; if (k == (tc & 15)) ib = ti[1][k]; }
      p.pidx[((size_t)t * 8 + h) * 16 + lane] = (bf16_t)(ia * 128 + ib); p.pgate[((size_t)t * 8 + h) * 16 + lane] = __expf(tv - top[0]) / sum; }
  }
}

namespace sel {
typedef short bf16x8 __attribute__((ext_vector_type(8)));
typedef float f32x16 __attribute__((ext_vector_type(16)));
constexpr int RS = 272, OFF_W = 2 * 128 * RS, WB = 3 * 16 * 32 * 4;
static_assert(OFF_W + 8 * WB <= SMEM_BYTES, "select LDS layout");
constexpr float NEG = -3.0e38f;
__device__ __forceinline__ float max3(float a, float b, float c) { return fmaxf(fmaxf(a, b), c); }
__device__ __forceinline__ float xhalf(float v) { return __shfl_xor(v, 32); }

__device__ void phase_peer_select(const Params& p, int layer, char* smem) {
  const int tid0 = threadIdx.x;
  __syncthreads();
  { const bf16_t* kb = p.keysb + (size_t)layer * 32768;
    for (int i = tid0; i < 2 * 128 * 16; i += NTHREADS) { const int row = i >> 4, ch = i & 15; *(u32x4*)(smem + row * RS + ch * 16) = *(const u32x4*)(kb + (size_t)row * 128 + ch * 8); } }
  __syncthreads();
  for (int job = blockIdx.x; job < T / 32; job += gridDim.x) {
    int tid_ = threadIdx.x; asm volatile("" : "+v"(tid_));
    const int tid = tid_, wid = tid >> 6, lane = tid & 63, l31 = lane & 31, hh = lane >> 5, h = wid;
    const int t = job * 32 + l31;
    float* const wl = (float*)(smem + OFF_W + wid * WB);
    float rs[2];
#pragma unroll
    for (int pp = 0; pp < 2; ++pp) {
      const bf16_t* qrow = p.QP + (size_t)t * 2048 + h * 256 + pp * 128 + hh * 8;
      bf16x8 bq[8]; float ssq = 0.f;
#pragma unroll
      for (int ks = 0; ks < 8; ++ks) { const u32x4 w = *(const u32x4*)(qrow + ks * 16); bq[ks] = __builtin_bit_cast(bf16x8, w);
        const u32 w0 = w.x, w1 = w.y, w2 = w.z, w3 = w.w; ssq = dot2bf(w0, w0, ssq); ssq = dot2bf(w1, w1, ssq); ssq = dot2bf(w2, w2, ssq); ssq = dot2bf(w3, w3, ssq); }
      ssq += xhalf(ssq); rs[pp] = rsqrtf(ssq * (1.f / 128.f) + EPS);
      f32x16 X[4];
#pragma unroll
      for (int nt = 0; nt < 4; ++nt) {
#pragma unroll
        for (int r = 0; r < 16; ++r) X[nt][r] = 0.f;
        const char* ka = smem + (pp * 128 + nt * 32 + l31) * RS + hh * 16;
#pragma unroll
        for (int ks = 0; ks < 8; ++ks) X[nt] = __builtin_amdgcn_mfma_f32_32x32x16_bf16(*(const bf16x8*)(ka + ks * 32), bq[ks], X[nt], 0, 0, 0); }
#pragma unroll
      for (int nt = 0; nt < 4; ++nt)
#pragma unroll
        for (int r = 0; r < 16; ++r) X[nt][r] = __uint_as_float((__float_as_uint(X[nt][r]) & ~0x7Fu) | (u32)(nt * 32 + (r & 3) + 8 * (r >> 2)) | ((u32)hh << 2));
#pragma unroll 1
      for (int k = 0; k < 16; ++k) {
        float m = NEG;
#pragma unroll
        for (int nt = 0; nt < 4; ++nt)
#pragma unroll
          for (int r = 0; r < 16; r += 2) m = max3(m, X[nt][r], X[nt][r + 1]);
        const float M = fmaxf(m, xhalf(m));
        wl[(pp * 16 + k) * 32 + l31] = M;
#pragma unroll
        for (int nt = 0; nt < 4; ++nt)
#pragma unroll
          for (int r = 0; r < 16; ++r) X[nt][r] = (X[nt][r] == M) ? NEG : X[nt][r];
      }
    }
    float s1[16], s2[16];
#pragma unroll
    for (int k = 0; k < 16; ++k) { s1[k] = wl[k * 32 + l31] * rs[0]; s2[k] = wl[(16 + k) * 32 + l31] * rs[1]; }
    constexpr int A0[25] = {0, 0, 0, 0, 0, 0, 0, 0, 0, 0, 0, 0, 0, 0, 0, 0, 2, 2, 2, 2, 2, 3, 3, 3, 3}, B0[25] = {0, 1, 2, 3, 4, 5, 6, 7, 8, 9, 10, 11, 12, 13, 14, 15, 0, 1, 2, 3, 4, 0, 1, 2, 3};
    constexpr int A1[25] = {1, 1, 1, 1, 1, 1, 1, 1, 4, 4, 4, 5, 5, 6, 6, 7, 7, 8, 9, 10, 11, 12, 13, 14, 15}, B1[25] = {0, 1, 2, 3, 4, 5, 6, 7, 0, 1, 2, 0, 1, 0, 1, 0, 1, 0, 0, 0, 0, 0, 0, 0, 0};
    float cd[25];
#pragma unroll
    for (int i = 0; i < 25; ++i) { const float v0 = s1[A0[i]] + s2[B0[i]], v1 = s1[A1[i]] + s2[B1[i]]; const float v = hh ? v1 : v0; const u32 cid = hh ? (u32)(A1[i] * 16 + B1[i]) : (u32)(A0[i] * 16 + B0[i]);
      cd[i] = __uint_as_float((__float_as_uint(v) & ~0xFFu) | cid); }
#pragma unroll 1
    for (int k = 0; k < 16; ++k) {
      float m = cd[24];
#pragma unroll
      for (int i = 0; i < 24; i += 2) m = max3(m, cd[i], cd[i + 1]);
      const float M = fmaxf(m, xhalf(m));
      wl[(32 + k) * 32 + l31] = M;
#pragma unroll
      for (int i = 0; i < 25; ++i) cd[i] = (cd[i] == M) ? NEG : cd[i];
    }
    float tv[16];
#pragma unroll
    for (int k = 0; k < 16; ++k) tv[k] = wl[(32 + k) * 32 + l31];
    float sum = 0.f;
#pragma unroll
    for (int k = 0; k < 16; ++k) sum += __expf(tv[k] - tv[0]);
    const float inv = 1.f / sum;
    u32 ev[8]; float go[8];
#pragma unroll
    for (int q = 0; q < 8; ++q) { const float v = wl[(32 + hh * 8 + q) * 32 + l31]; const u32 cid = __float_as_uint(v) & 0xFFu;
      const u32 i1 = __float_as_uint(wl[(cid >> 4) * 32 + l31]) & 0x7Fu, i2 = __float_as_uint(wl[(16 + (cid & 15)) * 32 + l31]) & 0x7Fu; ev[q] = i1 * 128 + i2;
      go[q] = __expf(v - tv[0]) * inv; }
    const u32 io0 = ev[0] | (ev[1] << 16), io1 = ev[2] | (ev[3] << 16), io2 = ev[4] | (ev[5] << 16), io3 = ev[6] | (ev[7] << 16);
    const size_t ob = ((size_t)t * 8 + h) * 16 + hh * 8;
    *(u32x4*)(p.pidx + ob) = (u32x4){io0, io1, io2, io3};
    *(f32x4*)(p.pgate + ob) = (f32x4){go[0], go[1], go[2], go[3]}; *(f32x4*)(p.pgate + ob + 4) = (f32x4){go[4], go[5], go[6], go[7]};
  }
}
}

typedef float f32x2 __attribute__((ext_vector_type(2)));
constexpr float U8_SCALE = 32.f, V8_SCALE = 2.f;
constexpr int GT = 4;
constexpr int GW_WAVE_BYTES = GT * (2048 + 128 * 2 + 128 * 4);
static_assert(8 * GW_WAVE_BYTES <= SMEM_BYTES - 16, "gather LDS layout");
__device__ __forceinline__ float gelu_erf(float z) { return 0.5f * z * (1.f + erff(z * 0.70710678118654752f)); }
__device__ __forceinline__ float reduce8(float d0, float d1, float d2, float d3, float d4, float d5, float d6, float d7, int lane) {
  float e[4];
  { auto r0 = __builtin_amdgcn_permlane32_swap(__float_as_uint(d0), __float_as_uint(d4), false, false); e[0] = __uint_as_float(r0[0]) + __uint_as_float(r0[1]);
    auto r1 = __builtin_amdgcn_permlane32_swap(__float_as_uint(d1), __float_as_uint(d5), false, false); e[1] = __uint_as_float(r1[0]) + __uint_as_float(r1[1]);
    auto r2 = __builtin_amdgcn_permlane32_swap(__float_as_uint(d2), __float_as_uint(d6), false, false); e[2] = __uint_as_float(r2[0]) + __uint_as_float(r2[1]);
    auto r3 = __builtin_amdgcn_permlane32_swap(__float_as_uint(d3), __float_as_uint(d7), false, false); e[3] = __uint_as_float(r3[0]) + __uint_as_float(r3[1]); }
  float f0, f1;
  { auto r0 = __builtin_amdgcn_permlane16_swap(__float_as_uint(e[0]), __float_as_uint(e[2]), false, false); f0 = __uint_as_float(r0[0]) + __uint_as_float(r0[1]);
    auto r1 = __builtin_amdgcn_permlane16_swap(__float_as_uint(e[1]), __float_as_uint(e[3]), false, false); f1 = __uint_as_float(r1[0]) + __uint_as_float(r1[1]); }
  const bool up = (lane & 8) != 0; const float keep = up ? f1 : f0, send = up ? f0 : f1;
  float g = keep + __shfl_xor(send, 8);
  g += __shfl_xor(g, 4); g += __shfl_xor(g, 2); g += __shfl_xor(g, 1);
  return g;
}
template <int NEXT>
__device__ void phase_peer_gather(const Params& p, int layer, char* smem) {
  const unsigned char* U8 = p.U8 + (size_t)layer * 16384 * 1024; const unsigned char* V8 = p.V8 + (size_t)layer * 16384 * 1024;
  for (int job = blockIdx.x; job < T / (8 * GT); job += gridDim.x) {
    int tid_ = threadIdx.x; asm volatile("" : "+v"(tid_));
    const int tid = tid_, wid = tid >> 6, lane = tid & 63;
    const int tb = (job * 8 + wid) * GT;
    const int vidx = 4 * (lane >> 5) + 2 * ((lane >> 4) & 1) + ((lane >> 3) & 1);
    char* wl = smem + wid * GW_WAVE_BYTES; bf16_t* sx = (bf16_t*)wl; bf16_t* sidx = (bf16_t*)(wl + GT * 2048); float* sgate = (float*)(wl + GT * 2048 + GT * 256);
#pragma unroll 1
    for (int g = 0; g < GT; ++g) { const size_t t = (size_t)(tb + g);
      *(u32x4*)(sx + g * 1024 + lane * 16) = *(const u32x4*)(p.H + t * D + lane * 16); *(u32x4*)(sx + g * 1024 + lane * 16 + 8) = *(const u32x4*)(p.H + t * D + lane * 16 + 8);
      const int ia = p.pidx[t * 128 + lane], ib = p.pidx[t * 128 + 64 + lane]; const float ga = p.pgate[t * 128 + lane], gb = p.pgate[t * 128 + 64 + lane];
      const int wa = ia >> 10, wb = ib >> 10; int off = 0, pa = 0, pb = 0;
#pragma unroll
      for (int w = 0; w < 16; ++w) { const unsigned long long m0 = __ballot(wa == w), m1 = __ballot(wb == w); const int c0 = __popcll(m0), c1 = __popcll(m1);
        const int r0 = __builtin_amdgcn_mbcnt_hi((unsigned)(m0 >> 32), __builtin_amdgcn_mbcnt_lo((unsigned)m0, 0)), r1 = __builtin_amdgcn_mbcnt_hi((unsigned)(m1 >> 32), __builtin_amdgcn_mbcnt_lo((unsigned)m1, 0));
        if (wa == w) pa = off + r0; if (wb == w) pb = off + c0 + r1; off += c0 + c1; }
      sidx[g * 128 + pa] = (bf16_t)ia; sgate[g * 128 + pa] = ga; sidx[g * 128 + pb] = (bf16_t)ib; sgate[g * 128 + pb] = gb; }
    f32x2 acc[GT][8];
#pragma unroll
    for (int g = 0; g < GT; ++g)
#pragma unroll
      for (int i = 0; i < 8; ++i) acc[g][i] = (f32x2){0.f, 0.f};
#pragma unroll 1
    for (int hb = 0; hb < 16; ++hb) {
#pragma unroll
      for (int g = 0; g < GT; ++g) {
        const int myidx = (int)sidx[g * 128 + hb * 8 + (lane & 7)]; const float mygate = sgate[g * 128 + hb * 8 + vidx];
        const u32x4 h0 = *(const u32x4*)(sx + g * 1024 + lane * 16), h1 = *(const u32x4*)(sx + g * 1024 + lane * 16 + 8);
        const u32 hx[8] = {h0.x, h0.y, h0.z, h0.w, h1.x, h1.y, h1.z, h1.w};
        u32x4 ur[8], vr[8];
#pragma unroll
        for (int k = 0; k < 8; ++k) { const int e = __builtin_amdgcn_readlane(myidx, k); ur[k] = *(const u32x4*)(U8 + (size_t)e * 1024 + lane * 16); if (k < 4) vr[k] = *(const u32x4*)(V8 + (size_t)e * 1024 + lane * 16); }
        float d[8];
#pragma unroll
        for (int k = 0; k < 8; ++k) { const u32 w[4] = {ur[k].x, ur[k].y, ur[k].z, ur[k].w}; float a = 0.f;
#pragma unroll
          for (int j = 0; j < 4; ++j) { const u32 lo = __builtin_bit_cast(u32, __builtin_amdgcn_cvt_scalef32_pk_bf16_fp8(w[j], 1.0f, false)), hi = __builtin_bit_cast(u32, __builtin_amdgcn_cvt_scalef32_pk_bf16_fp8(w[j], 1.0f, true));
            a = dot2bf(lo, hx[2 * j], a); a = dot2bf(hi, hx[2 * j + 1], a); }
          asm volatile("" : "+v"(a));
          d[k] = a; }
        asm volatile("" ::: "memory");
#pragma unroll
        for (int k = 4; k < 8; ++k) { const int e = __builtin_amdgcn_readlane(myidx, k); vr[k] = *(const u32x4*)(V8 + (size_t)e * 1024 + lane * 16); }
        const float z = reduce8(d[0], d[1], d[2], d[3], d[4], d[5], d[6], d[7], lane) * (1.f / U8_SCALE);
        const float cf = mygate * gelu_erf(z) * (1.f / V8_SCALE);
#pragma unroll
        for (int k = 0; k < 8; ++k) { const float ck = __uint_as_float(__builtin_amdgcn_readlane(__float_as_uint(cf), 32 * (k >> 2) + 16 * ((k >> 1) & 1) + 8 * (k & 1)));
          const u32 w[4] = {vr[k].x, vr[k].y, vr[k].z, vr[k].w}; const f32x2 c2 = (f32x2){ck, ck};
#pragma unroll
          for (int j = 0; j < 4; ++j) { const f32x2 lo = __builtin_amdgcn_cvt_pk_f32_fp8((int)w[j], false), hi = __builtin_amdgcn_cvt_pk_f32_fp8((int)w[j], true);
            acc[g][2 * j] = lo * c2 + acc[g][2 * j]; acc[g][2 * j + 1] = hi * c2 + acc[g][2 * j + 1]; } }
        asm volatile("" ::: "memory");
      }
      if ((hb & 3) == 3) __syncthreads();
    }
#pragma unroll
    for (int g = 0; g < GT; ++g) { const int t = tb + g, b = t / S;
      const float* g2 = p.mod + (size_t)(layer * 8 + b) * 6144 + 5120 + lane * 16; float* xp = p.X + (size_t)t * D + lane * 16;
      float xv[16]; float ss = 0.f;
#pragma unroll
      for (int q = 0; q < 4; ++q) { const f32x4 x0 = *(const f32x4*)(xp + 4 * q), g0 = *(const f32x4*)(g2 + 4 * q);
        xv[4 * q + 0] = x0.x + g0.x * acc[g][2 * q].x; xv[4 * q + 1] = x0.y + g0.y * acc[g][2 * q].y; xv[4 * q + 2] = x0.z + g0.z * acc[g][2 * q + 1].x; xv[4 * q + 3] = x0.w + g0.w * acc[g][2 * q + 1].y; }
#pragma unroll
      for (int i = 0; i < 16; ++i) ss += xv[i] * xv[i];
      ss = wave_sum(ss); const float r = rsqrtf(ss * (1.f / D) + EPS);
      if (NEXT == 0) {
        const float* ml = p.mod + (size_t)((layer + 1) * 8 + b) * 6144 + lane * 16; const float* gn = p.nmg + (layer + 1) * D + lane * 16; float y[16];
#pragma unroll
        for (int i = 0; i < 16; ++i) y[i] = xv[i] * r * gn[i] * (1.f + ml[1024 + i]) + ml[i];
#pragma unroll
        for (int q = 0; q < 4; ++q) *(f32x4*)(xp + 4 * q) = (f32x4){xv[4 * q], xv[4 * q + 1], xv[4 * q + 2], xv[4 * q + 3]};
        u32x4 w0, w1; w0.x = pack2(y[0], y[1]); w0.y = pack2(y[2], y[3]); w0.z = pack2(y[4], y[5]); w0.w = pack2(y[6], y[7]); w1.x = pack2(y[8], y[9]); w1.y = pack2(y[10], y[11]); w1.z = pack2(y[12], y[13]); w1.w = pack2(y[14], y[15]);
        *(u32x4*)(p.H + (size_t)t * D + lane * 16) = w0; *(u32x4*)(p.H + (size_t)t * D + lane * 16 + 8) = w1;
      } else {
        const float* fg = p.final_g + lane * 16;
#pragma unroll
        for (int q = 0; q < 4; ++q) *(f32x4*)(xp + 4 * q) = (f32x4){xv[4 * q] * r * fg[4 * q], xv[4 * q + 1] * r * fg[4 * q + 1], xv[4 * q + 2] * r * fg[4 * q + 2], xv[4 * q + 3] * r * fg[4 * q + 3]};
      }
      asm volatile("" ::: "memory");
    }
    __syncthreads();
  }
}

__device__ void phase_qkrope(const Params& p) {
  const int tid = threadIdx.x, wid = tid >> 6, lane = tid & 63;
  for (int job = blockIdx.x; job < T * 12 / 8; job += gridDim.x) {
    const int w = job * 8 + wid, t = w / 12, hh = w % 12, b = t / S, s = t & (S - 1);
    const u32 raw = *(const u32*)(p.QKV + (size_t)t * 1536 + hh * 128 + lane * 2); float x0 = bflo(raw), x1 = bfhi(raw);
    if (hh < 10) { const float* g = hh < 8 ? p.qn_g : p.kn_g; const float r = rsqrtf(wave_sum(x0 * x0 + x1 * x1) * (1.f / 128.f) + EPS); x0 *= r * g[2 * lane]; x1 *= r * g[2 * lane + 1];
      const int pos = lane < 32 ? (s >> 6) : (s & 63); const int fi = lane & 31; const float fr = exp2f(-(float)(2 * fi) * (13.287712379549449f / 64.f)); const float ang = (float)pos * fr;
      float sn, cs; sincosf(ang, &sn, &cs); const float y0 = x0 * cs - x1 * sn, y1 = x0 * sn + x1 * cs; x0 = y0; x1 = y1; }
    bf16_t* dst = hh < 8 ? p.Qh + (((size_t)b * 8 + hh) * S + s) * 128 : (hh < 10 ? p.Kh + (((size_t)b * 2 + hh - 8) * S + s) * 128 : p.Vh + (((size_t)b * 2 + hh - 10) * S + s) * 128);
    *(u32*)(dst + lane * 2) = pack2(x0, x1);
  }
}

__device__ void phase_attn_naive(const Params& p) {
  const int tid = threadIdx.x, wid = tid >> 6, lane = tid & 63;
  for (int job = blockIdx.x; job < T * 2 / 8; job += gridDim.x) {
    const int w = job * 8 + wid, kv = w & 1, t = w >> 1, b = t / S, s = t & (S - 1);
    float q0[4], q1[4], m[4], l[4], o0[4], o1[4];
#pragma unroll
    for (int g = 0; g < 4; ++g) { const u32 qq = *(const u32*)(p.Qh + (((size_t)b * 8 + kv * 4 + g) * S + s) * 128 + lane * 2); q0[g] = bflo(qq); q1[g] = bfhi(qq); m[g] = -1e30f; l[g] = 0.f; o0[g] = 0.f; o1[g] = 0.f; }
    const bf16_t* Kb = p.Kh + ((size_t)b * 2 + kv) * S * 128; const bf16_t* Vb = p.Vh + ((size_t)b * 2 + kv) * S * 128;
    for (int k = 0; k < S; ++k) { const u32 kk = *(const u32*)(Kb + (size_t)k * 128 + lane * 2), vv = *(const u32*)(Vb + (size_t)k * 128 + lane * 2);
      const float k0 = bflo(kk), k1 = bfhi(kk), v0 = bflo(vv), v1 = bfhi(vv);
#pragma unroll
      for (int g = 0; g < 4; ++g) { const float sc = wave_sum(q0[g] * k0 + q1[g] * k1) * KSCALE; const float mn = fmaxf(m[g], sc), al = __expf(m[g] - mn), pw = __expf(sc - mn);
        l[g] = l[g] * al + pw; o0[g] = o0[g] * al + pw * v0; o1[g] = o1[g] * al + pw * v1; m[g] = mn; } }
#pragma unroll
    for (int g = 0; g < 4; ++g) *(u32*)(p.CAT + (size_t)t * 1024 + (kv * 4 + g) * 128 + lane * 2) = pack2(o0[g] / l[g], o1[g] / l[g]);
  }
}

namespace att {
using bf16 = unsigned short;
constexpr int   D = 128, NW = 8, QBLK = 32, KVBLK = 64;
constexpr float SCALE = 0.088388347648318440f;
constexpr float THR = 8.f;
constexpr int SDEPTH = 2;
constexpr int LDQ = 128, LDK = 128, LDO = 1024;
constexpr size_t SHM_V = KVBLK * D * 2, SHM_K = KVBLK * D * 2, SHM_ATTN = 2 * SHM_V + 2 * SHM_K + NW * 64 * 4;
using bf16x8 = __attribute__((ext_vector_type(8))) short;
using s16x4  = __attribute__((ext_vector_type(4))) short;
using f32x16 = __attribute__((ext_vector_type(16))) float;
using f32x8  = __attribute__((ext_vector_type(8))) float;
using u32x4  = __attribute__((ext_vector_type(4))) unsigned;
#define KSWZ(row, colB) ((row) * 256 + ((colB) ^ (((row) & 7) << 4)))
#define SBAR() __builtin_amdgcn_sched_barrier(0)
__device__ __forceinline__ int crow(int r, int hi) { return (r & 3) + 8 * (r >> 2) + 4 * hi; }
__device__ __forceinline__ unsigned cvtpk(float lo, float hi) {
  unsigned r; asm volatile("v_cvt_pk_bf16_f32 %0, %1, %2" : "=v"(r) : "v"(lo), "v"(hi)); return r;
}
template <typename TIn> struct Stage;
template <> struct Stage<bf16>  { using T = bf16x8;
  __device__ static __forceinline__ T ld8(const bf16* p) { return *reinterpret_cast<const bf16x8*>(p); }
  __device__ static __forceinline__ bf16x8 tobf(T x) { return x; } };
template <> struct Stage<float> { using T = f32x8;
  __device__ static __forceinline__ T ld8(const float* p) { return *reinterpret_cast<const f32x8*>(p); }
  __device__ static __forceinline__ bf16x8 tobf(T x) {
    u32x4 w = {cvtpk(x[0], x[1]), cvtpk(x[2], x[3]), cvtpk(x[4], x[5]), cvtpk(x[6], x[7])}; return *reinterpret_cast<bf16x8*>(&w); } };

__device__ __forceinline__ void partialSM(f32x16& p0, f32x16& p1, float& m_reg, float& mn, float& alpha) {
  constexpr float C = SCALE * 1.4426950408889634f;
  float pmax = p0[0]; for (int r = 1; r < 16; ++r) pmax = fmaxf(pmax, p0[r]); for (int r = 0; r < 16; ++r) pmax = fmaxf(pmax, p1[r]);
  { auto rr = __builtin_amdgcn_permlane32_swap(__float_as_uint(pmax), __float_as_uint(pmax), false, false);
    pmax = fmaxf(__uint_as_float(rr[0]), __uint_as_float(rr[1])); }
  if (__builtin_expect(__all(pmax - m_reg <= THR / SCALE), 1)) { mn = m_reg; alpha = 1.f; }
  else { mn = fmaxf(m_reg, pmax); alpha = __builtin_amdgcn_exp2f((m_reg - mn) * C); m_reg = mn; }
  float mnC = -mn * C;
  for (int r = 0; r < 16; ++r) p0[r] = fmaf(p0[r], C, mnC); for (int r = 0; r < 16; ++r) p1[r] = fmaf(p1[r], C, mnC);
  for (int r = 0; r < 16; ++r) p0[r] = __builtin_amdgcn_exp2f(p0[r]);
}
__device__ __forceinline__ void finishSM(f32x16& p0, f32x16& p1, float alpha, float& l_reg, bf16x8& pa0, bf16x8& pa1, bf16x8& pa2, bf16x8& pa3) {
  for (int r = 0; r < 16; ++r) p1[r] = __builtin_amdgcn_exp2f(p1[r]);
  float ps = 0; for (int r = 0; r < 16; ++r) ps += p0[r]; for (int r = 0; r < 16; ++r) ps += p1[r];
  { auto rr = __builtin_amdgcn_permlane32_swap(__float_as_uint(ps), __float_as_uint(ps), false, false);
    ps = __uint_as_float(rr[0]) + __uint_as_float(rr[1]); }
  l_reg = l_reg * alpha + ps;
#define PK4(P, BASE, OUT) do { unsigned a0 = cvtpk(P[BASE + 0], P[BASE + 1]), a1 = cvtpk(P[BASE + 2], P[BASE + 3]);   \
    unsigned b0 = cvtpk(P[BASE + 4], P[BASE + 5]), b1 = cvtpk(P[BASE + 6], P[BASE + 7]);                              \
    auto r0 = __builtin_amdgcn_permlane32_swap(a0, b0, false, false); auto r1 = __builtin_amdgcn_permlane32_swap(a1, b1, false, false); \
    u32x4 w = {r0[0], r1[0], r0[1], r1[1]}; OUT = *reinterpret_cast<bf16x8*>(&w); } while (0)
  PK4(p0, 0, pa0); PK4(p0, 8, pa1); PK4(p1, 0, pa2); PK4(p1, 8, pa3);
#undef PK4
}
__device__ __forceinline__ void qkt(f32x16& p0, f32x16& p1, const bf16* Ks, const bf16x8* qr, int r32, int hi) {
  p0 = f32x16{}; p1 = f32x16{};
  for (int d0 = 0; d0 < 8; ++d0) { int cb = (d0 * 16 + hi * 8) * 2;
    bf16x8 b0 = *reinterpret_cast<const bf16x8*>((const char*)Ks + KSWZ(r32, cb));
    bf16x8 b1 = *reinterpret_cast<const bf16x8*>((const char*)Ks + KSWZ(32 + r32, cb));
    p0 = __builtin_amdgcn_mfma_f32_32x32x16_bf16(b0, qr[d0], p0, 0, 0, 0);
    p1 = __builtin_amdgcn_mfma_f32_32x32x16_bf16(b1, qr[d0], p1, 0, 0, 0); }
}
__device__ __forceinline__ int v_st(int k, int c) { const int kk = (k & ~0xC) | ((k & 4) << 1) | ((k & 8) >> 1); return ((kk >> 3) * 4 + (c >> 5)) * 512 + ((kk & 7) * 32 + (c & 31)) * 2; }
__device__ __forceinline__ int v_rd_base(int lane) { return ((lane & 3) << 3) | (((lane >> 2) & 3) << 6) | (((lane >> 4) & 1) << 5) | (((lane >> 5) & 1) << 8); }
constexpr int v_rd_off(int d0, int ks, int half) { return d0 * 512 + ks * 4096 + half * 2048; }
template <int OFF> __device__ __forceinline__ s16x4 tr_read(int vb) {
  s16x4 r; asm volatile("ds_read_b64_tr_b16 %0, %1 offset:%2" : "=&v"(r) : "v"(vb), "i"(OFF) : "memory"); return r;
}
template <int D0> __device__ __forceinline__ void pv_one(f32x16& od, int vb, bf16x8 pa0, bf16x8 pa1, bf16x8 pa2, bf16x8 pa3) {
  const s16x4 l0 = tr_read<v_rd_off(D0, 0, 0)>(vb), h0 = tr_read<v_rd_off(D0, 0, 1)>(vb), l1 = tr_read<v_rd_off(D0, 1, 0)>(vb), h1 = tr_read<v_rd_off(D0, 1, 1)>(vb);
  const s16x4 l2 = tr_read<v_rd_off(D0, 2, 0)>(vb), h2 = tr_read<v_rd_off(D0, 2, 1)>(vb), l3 = tr_read<v_rd_off(D0, 3, 0)>(vb), h3 = tr_read<v_rd_off(D0, 3, 1)>(vb);
  asm volatile("s_waitcnt lgkmcnt(0)" ::: "memory"); SBAR();
#define PK(L, H) (bf16x8){L[0], L[1], L[2], L[3], H[0], H[1], H[2], H[3]}
  od = __builtin_amdgcn_mfma_f32_32x32x16_bf16(pa0, PK(l0, h0), od, 0, 0, 0);
  od = __builtin_amdgcn_mfma_f32_32x32x16_bf16(pa1, PK(l1, h1), od, 0, 0, 0);
  od = __builtin_amdgcn_mfma_f32_32x32x16_bf16(pa2, PK(l2, h2), od, 0, 0, 0);
  od = __builtin_amdgcn_mfma_f32_32x32x16_bf16(pa3, PK(l3, h3), od, 0, 0, 0);
#undef PK
}
__device__ __forceinline__ void pv_d0(f32x16* o, int vb, bf16x8 pa0, bf16x8 pa1, bf16x8 pa2, bf16x8 pa3) {
  pv_one<0>(o[0], vb, pa0, pa1, pa2, pa3); pv_one<1>(o[1], vb, pa0, pa1, pa2, pa3); pv_one<2>(o[2], vb, pa0, pa1, pa2, pa3); pv_one<3>(o[3], vb, pa0, pa1, pa2, pa3);
}

template <typename TQ>
__device__ __forceinline__ void attn_dense_body(const TQ* __restrict__ Qb, const bf16* __restrict__ Kh, const bf16* __restrict__ Vh,
                                                bf16* __restrict__ Ob, int seq, char* lds) {
  using St = Stage<bf16>; using SQ = Stage<TQ>;
  int tid_ = threadIdx.x; asm volatile("" : "+v"(tid_)); const int tid = tid_, wid = tid >> 6, lane = tid & 63, r32 = lane & 31, hi = lane >> 5;
  bf16* V_lds = (bf16*)lds; bf16* K_lds = (bf16*)(lds + 2 * SHM_V);
  float* ws = (float*)(lds + 2 * SHM_V + 2 * SHM_K) + wid * 64; float* li_l = ws; float* al_l = ws + 32;
  float m_reg = -1e30f, l_reg = 0; f32x16 o[4] = {}; bf16x8 qr[8];
  const TQ* Qw = Qb + (long)(wid * QBLK + r32) * LDQ + hi * 8;
#pragma unroll
  for (int d0 = 0; d0 < 8; ++d0) qr[d0] = SQ::tobf(SQ::ld8(Qw + d0 * 16));
  const int sr = tid >> 4, sc = (tid & 15) * 8, vst0 = v_st(sr, sc), vst1 = v_st(32 + sr, sc);
  const int vb0 = (int)(uintptr_t)V_lds + v_rd_base(lane);
  struct { typename St::T vs0, vs1, ks0, ks1; } sr_[SDEPTH];
#define SLOAD(i, k0) do { sr_[i].vs0 = St::ld8(&Vh[(long)((k0) + sr) * LDK + sc]); sr_[i].vs1 = St::ld8(&Vh[(long)((k0) + 32 + sr) * LDK + sc]); \
    sr_[i].ks0 = St::ld8(&Kh[(long)((k0) + sr) * LDK + sc]); sr_[i].ks1 = St::ld8(&Kh[(long)((k0) + 32 + sr) * LDK + sc]); } while (0)
#define SWRITE(b, i) do { *(bf16x8*)((char*)V_lds + (b) * SHM_V + vst0) = St::tobf(sr_[i].vs0);          \
    *(bf16x8*)((char*)V_lds + (b) * SHM_V + vst1) = St::tobf(sr_[i].vs1); int kc = sc * 2;               \
    *(bf16x8*)((char*)K_lds + (b) * SHM_K + KSWZ(sr, kc)) = St::tobf(sr_[i].ks0);                       \
    *(bf16x8*)((char*)K_lds + (b) * SHM_K + KSWZ(32 + sr, kc)) = St::tobf(sr_[i].ks1); } while (0)
#define SWAIT() do { if constexpr (SDEPTH == 2) asm volatile("s_waitcnt vmcnt(4)" ::: "memory"); else asm volatile("s_waitcnt vmcnt(0)" ::: "memory"); } while (0)
#define RESC(a) do { if (__any((a) < 1.f)) { if (hi == 0) al_l[r32] = (a); asm volatile("s_waitcnt lgkmcnt(0)" ::: "memory"); \
    for (int d = 0; d < 4; ++d) for (int r = 0; r < 16; ++r) o[d][r] *= al_l[crow(r, hi)]; } } while (0)
  f32x16 pA0, pA1, pB0, pB1; float mnA, mnB, alA, alB; bf16x8 pa0, pa1, pa2, pa3; const int NT = seq / KVBLK;
  constexpr int SE = 0, SO = SDEPTH - 1;
  SLOAD(SE, 0); asm volatile("s_waitcnt vmcnt(0)" ::: "memory"); SWRITE(0, SE); __syncthreads();
  qkt(pA0, pA1, K_lds, qr, r32, hi); partialSM(pA0, pA1, m_reg, mnA, alA);
  SLOAD(SO, KVBLK); if constexpr (SDEPTH == 2) { if (2 < NT) SLOAD(SE, 2 * KVBLK); }
  SWAIT(); SWRITE(1, SO); __syncthreads();
  for (int j = 1; j + 1 < NT; j += 2) {
    SBAR(); qkt(pB0, pB1, (bf16*)((char*)K_lds + SHM_K), qr, r32, hi);
    finishSM(pA0, pA1, alA, l_reg, pa0, pa1, pa2, pa3); SBAR();
    SLOAD(SO, (j + SDEPTH) * KVBLK); SBAR();
    pv_d0(o, vb0, pa0, pa1, pa2, pa3); partialSM(pB0, pB1, m_reg, mnB, alB);
    __syncthreads(); SWAIT(); SWRITE(0, SE);
    RESC(alB); __syncthreads();
    SBAR(); qkt(pA0, pA1, K_lds, qr, r32, hi);
    finishSM(pB0, pB1, alB, l_reg, pa0, pa1, pa2, pa3); SBAR();
    if (SDEPTH == 1 || j + 3 < NT) SLOAD(SE, (j + 1 + SDEPTH) * KVBLK); SBAR();
    pv_d0(o, vb0 + (int)SHM_V, pa0, pa1, pa2, pa3); partialSM(pA0, pA1, m_reg, mnA, alA);
    __syncthreads(); SWAIT(); SWRITE(1, SO);
    RESC(alA); __syncthreads();
  }
  SBAR(); qkt(pB0, pB1, (bf16*)((char*)K_lds + SHM_K), qr, r32, hi);
  finishSM(pA0, pA1, alA, l_reg, pa0, pa1, pa2, pa3); SBAR();
  pv_d0(o, vb0, pa0, pa1, pa2, pa3); partialSM(pB0, pB1, m_reg, mnB, alB);
  __syncthreads(); RESC(alB);
  finishSM(pB0, pB1, alB, l_reg, pa0, pa1, pa2, pa3); SBAR();
  pv_d0(o, vb0 + (int)SHM_V, pa0, pa1, pa2, pa3);
  if (hi == 0) li_l[r32] = l_reg; asm volatile("s_waitcnt lgkmcnt(0)" ::: "memory");
  float rli[16];
#pragma unroll
  for (int r = 0; r < 16; ++r) rli[r] = __builtin_amdgcn_rcpf(li_l[crow(r, hi)]);
  __syncthreads();
  bf16* Ol = (bf16*)lds + wid * (QBLK * D);
#pragma unroll
  for (int r = 0; r < 16; ++r) { const int orow = crow(r, hi);
#pragma unroll
    for (int d0 = 0; d0 < 4; ++d0) { const float v = o[d0][r] * rli[r]; unsigned u = __float_as_uint(v); u += 0x7FFFu + ((u >> 16) & 1u); Ol[orow * D + d0 * 32 + r32] = (bf16)(u >> 16); } }
  asm volatile("s_waitcnt lgkmcnt(0)" ::: "memory");
#pragma unroll
  for (int i = 0; i < 8; ++i) { const int row = i * 4 + (lane >> 4), ch = (lane & 15) * 8;
    const u32x4 v = *reinterpret_cast<const u32x4*>(Ol + row * D + ch);
    *reinterpret_cast<u32x4*>(Ob + (long)(wid * QBLK + row) * LDO + ch) = v; }
  __syncthreads();
#undef SLOAD
#undef SWRITE
#undef SWAIT
#undef RESC
}

}

__device__ void phase_attn(const Params& p, char* smem) {
  const int G = (int)gridDim.x, c = (int)blockIdx.x;
  for (int i = 0; i * G + c < 1024; ++i) {
    int pair, j;
    if (G == 256) { pair = 2 * (c & 7) + (i >> 1); j = (i & 1) * 32 + (c >> 3); } else { const int L = i * G + c; pair = L >> 6; j = L & 63; }
    const int b = pair >> 1, kv = pair & 1, qb = j >> 2, g = j & 3, h = kv * 4 + g;
    const bf16_t* Qb = p.Qh + (((size_t)b * 8 + h) * S + qb * 256) * 128; const bf16_t* Kp = p.Kh + ((size_t)b * 2 + kv) * S * 128; const bf16_t* Vp = p.Vh + ((size_t)b * 2 + kv) * S * 128;
    bf16_t* Ob = p.CAT + ((size_t)b * S + qb * 256) * 1024 + h * 128;
    att::attn_dense_body<att::bf16>(Qb, Kp, Vp, Ob, S, smem);
  }
}

#define XB_TMO      128
#define XB_XCNT(j)  (256  + 64 * (j))
#define XB_XSUB(j)  (1280 + 64 * (j))
#define XB_XGEN(j)  (2304 + 64 * (j))
#define XB_TOP      3328
#define XB_TOPGEN   3392
#define XCD_BAR_WORDS 3456
#define XB_SPIN_CAP (1u << 18)
#define LAS __attribute__((address_space(3)))

__device__ __forceinline__ unsigned xb_ld(unsigned* p)              { return __hip_atomic_load(p, __ATOMIC_RELAXED, __HIP_MEMORY_SCOPE_AGENT); }
__device__ __forceinline__ unsigned xb_add(unsigned* p, unsigned v) { return __hip_atomic_fetch_add(p, v, __ATOMIC_RELAXED, __HIP_MEMORY_SCOPE_AGENT); }
__device__ __forceinline__ unsigned xb_xcc_id() { return (unsigned)__builtin_amdgcn_s_getreg((3 << 11) | 20) & 0xFu; }
#define XB_SPIN(cond, bar) do { unsigned _sp = 0; while (cond) { __builtin_amdgcn_s_sleep(1); \
    if ((++_sp & 255u) == 0u) { if (xb_ld(&(bar)[XB_TMO])) break; if (_sp > XB_SPIN_CAP) { atomicAdd(&(bar)[XB_TMO], 1u); break; } } } } while (0)

struct XcdBarrier {
    unsigned* bar; unsigned x;
    volatile LAS unsigned* st;
};

__device__ __forceinline__ XcdBarrier xcd_barrier_post(unsigned* bar, volatile LAS unsigned* st) {
    XcdBarrier b; b.bar = bar; b.x = xb_xcc_id(); b.st = st;
    if (threadIdx.x == 0) (void)xb_add(&bar[XB_XCNT(b.x)], 1u);
    return b;
}
__device__ __forceinline__ void xcd_barrier_complete(unsigned* bar, unsigned x, unsigned& nloc, unsigned& nx) {
    const unsigned G = gridDim.x * gridDim.y * gridDim.z;
    unsigned sum, cnt, mine, sp = 0u;
    for (;;) {
        sum = 0u; cnt = 0u; mine = 0u;
#pragma unroll
        for (unsigned j = 0; j < 16; ++j) { const unsigned c = xb_ld(&bar[XB_XCNT(j)]); sum += c; cnt += (c > 0u) ? 1u : 0u; mine = (j == x) ? c : mine; }
        if (sum == G) break;
        __builtin_amdgcn_s_sleep(1);
        if ((++sp & 255u) == 0u) { if (xb_ld(&bar[XB_TMO])) break; if (sp > XB_SPIN_CAP) { atomicAdd(&bar[XB_TMO], 1u); break; } }
    }
    nloc = mine > 0u ? mine : 1u; nx = cnt > 0u ? cnt : 1u;
}

__device__ __forceinline__ void xcd_barrier(const XcdBarrier& b) {
    asm volatile("s_waitcnt vmcnt(0)" ::: "memory");
    __syncthreads();
    if (threadIdx.x == 0) {
        unsigned* bar = b.bar;
        __builtin_amdgcn_s_waitcnt(0);
        unsigned nloc = b.st[0], nx = b.st[1];
        if (nloc == 0u) { xcd_barrier_complete(bar, b.x, nloc, nx); b.st[0] = nloc; b.st[1] = nx; }
        const unsigned old = xb_add(&bar[XB_XSUB(b.x)], 1u);
        const unsigned gen = old / nloc;
        if (old + 1u == (gen + 1u) * nloc) {
            __builtin_amdgcn_fence(__ATOMIC_RELEASE, "agent");
            asm volatile("s_waitcnt vmcnt(0)" ::: "memory");
            const unsigned og = xb_add(&bar[XB_TOP], 1u);
            const unsigned tg = og / nx;
            if (og + 1u == (tg + 1u) * nx) xb_add(&bar[XB_TOPGEN], 1u);
            else XB_SPIN(xb_ld(&bar[XB_TOPGEN]) == tg, bar);
            __builtin_amdgcn_fence(__ATOMIC_ACQUIRE, "agent");
            xb_add(&bar[XB_XGEN(b.x)], 1u);
            asm volatile("s_waitcnt vmcnt(0)" ::: "memory");
        } else {
            XB_SPIN(xb_ld(&bar[XB_XGEN(b.x)]) == gen, bar);
            __builtin_amdgcn_fence(__ATOMIC_ACQUIRE, "agent");
            asm volatile("s_waitcnt vmcnt(0)" ::: "memory");
        }
    }
    __syncthreads();
}


constexpr int NPH = 19;
__global__ __launch_bounds__(NTHREADS, 2) void mega(Params p, int ph0, int ph1) {
  extern __shared__ __attribute__((aligned(16))) char smem[];
  cg::grid_group grid = cg::this_grid();
  volatile LAS unsigned* xst = (volatile LAS unsigned*)(LAS char*)(smem + SMEM_BYTES - 16);
  if (threadIdx.x == 0) { xst[0] = 0u; xst[1] = 0u; }
  __syncthreads();
  const XcdBarrier xb = xcd_barrier_post(p.bar, xst);
#ifndef REP_MASK
#define REP_MASK 0
#endif
#define GSYNC(k) do { if ((k) == 1) grid.sync(); else xcd_barrier(xb); } while (0)
#define PHASE(k, call) if (ph0 <= (k) && (k) < ph1) { if ((k) > ph0) GSYNC(k); if ((REP_MASK >> (k)) & 1) { { call; } xcd_barrier(xb); } call; }
#if !defined(ONLY_PHASE) || ONLY_PHASE == 0
  PHASE(0, phase_prep(p, smem))
#endif
#if !defined(ONLY_PHASE) || ONLY_PHASE == 1
  PHASE(1, phase_norm<true>(p, p.x, p.nmg, p.mod, 0, 1024, smem))
#endif
#if !defined(ONLY_PHASE) || ONLY_PHASE == 2
  PHASE(2, phase_gemm_fast(p.H, p.Wt_evin, T, 2560, 1024, (EpiEvin{p.ZQK, p.ZV, p.ZO, p.ZP, p.ev_b_in}), smem))
#endif
#if !defined(ONLY_PHASE) || ONLY_PHASE == 3
  PHASE(3, cp::phase_convpool(p, smem))
#endif
#if !defined(ONLY_PHASE) || ONLY_PHASE == 4
  PHASE(4, ml::phase_mlstm(p, smem))
#endif
#if !defined(ONLY_PHASE) || ONLY_PHASE == 5
  PHASE(5, phase_cat(p))
#endif
#if !defined(ONLY_PHASE) || ONLY_PHASE == 6
  PHASE(6, phase_gemm_fast(p.CAT, p.Wt_evout, T, 1024, 1024, (EpiRes{p.x, p.X, p.mod + 2048}), smem))
#endif
#if !defined(ONLY_PHASE) || ONLY_PHASE == 7
  PHASE(7, phase_norm<false>(p, p.X, p.nfg, p.mod, 3072, 4096, smem))
#endif
#if !defined(ONLY_PHASE) || ONLY_PHASE == 8
  PHASE(8, phase_gemm_fast(p.H, p.Wt_q, T, 2048, 1024, (EpiPlain{p.QP, 2048}), smem))
#endif
#if !defined(ONLY_PHASE) || ONLY_PHASE == 9
  PHASE(9, sel::phase_peer_select(p, 0, smem))
#endif
#if !defined(ONLY_PHASE) || ONLY_PHASE == 10
  PHASE(10, phase_peer_gather<0>(p, 0, smem))
#endif
#if !defined(ONLY_PHASE) || ONLY_PHASE == 11
  PHASE(11, phase_gemm_fast(p.H, p.Wt_odin, T, 1536, 1024, (EpiPlain{p.QKV, 1536}), smem))
#endif
#if !defined(ONLY_PHASE) || ONLY_PHASE == 12
  PHASE(12, phase_qkrope(p))
#endif
#if !defined(ONLY_PHASE) || ONLY_PHASE == 13
  PHASE(13, phase_attn(p, smem))
#endif
#if !defined(ONLY_PHASE) || ONLY_PHASE == 14
  PHASE(14, phase_gemm_fast(p.CAT, p.Wt_odout, T, 1024, 1024, (EpiRes{p.X, p.X, p.mod + (size_t)8 * 6144 + 2048}), smem))
#endif
#if !defined(ONLY_PHASE) || ONLY_PHASE == 15
  PHASE(15, phase_norm<false>(p, p.X, p.nfg + D, p.mod + (size_t)8 * 6144, 3072, 4096, smem))
#endif
#if !defined(ONLY_PHASE) || ONLY_PHASE == 16
  PHASE(16, phase_gemm_fast(p.H, p.Wt_q + (size_t)2048 * 1024, T, 2048, 1024, (EpiPlain{p.QP, 2048}), smem))
#endif
#if !defined(ONLY_PHASE) || ONLY_PHASE == 17
  PHASE(17, sel::phase_peer_select(p, 1, smem))
#endif
#if !defined(ONLY_PHASE) || ONLY_PHASE == 18
  PHASE(18, phase_peer_gather<1>(p, 1, smem))
#endif
#undef PHASE
}
}

extern "C" void kernel_launch(void* const* d_in, const int* in_sizes, int n_in, void* d_out, int out_size, void* d_ws, size_t ws_size, hipStream_t stream) {
  (void)in_sizes; (void)n_in; (void)out_size;
  Params p{};
  const float** fin = (const float**)&p;
  for (int i = 0; i < 23; ++i) fin[i] = (const float*)d_in[i];
  p.X = (float*)d_out;
  char* ws = (char*)d_ws; size_t off = 0;
  auto alloc = [&](size_t bytes) { char* q = ws + off; off += (bytes + 255) / 256 * 256; return q; };
  p.U8 = (unsigned char*)alloc((size_t)2 * 16384 * 1024); p.V8 = (unsigned char*)alloc((size_t)2 * 16384 * 1024);
  p.Wt_evin = (bf16_t*)alloc((size_t)2560 * 1024 * 2); p.Wt_evout = (bf16_t*)alloc((size_t)1024 * 1024 * 2); p.Wt_odin = (bf16_t*)alloc((size_t)1536 * 1024 * 2);
  p.Wt_odout = (bf16_t*)alloc((size_t)1024 * 1024 * 2); p.Wt_q = (bf16_t*)alloc((size_t)2 * 2048 * 1024 * 2); p.keysb = (bf16_t*)alloc((size_t)2 * 2 * 128 * 128 * 2); p.poolWt = (bf16_t*)alloc((size_t)4 * 128 * 128 * 2);
  p.Wg = (float*)alloc(16 * 1024 * 4); p.mod = (float*)alloc(2 * 8 * 6144 * 4); p.gates = (float*)alloc((size_t)T * 16 * 4);
  p.pgate = (float*)alloc((size_t)T * 128 * 4); p.pidx = (bf16_t*)alloc((size_t)T * 128 * 2);
  p.H = (bf16_t*)alloc((size_t)T * 1024 * 2); p.CAT = p.H;
  char* big = alloc((size_t)T * 2048 * 2);
  p.ZQK = (bf16_t*)big; p.ZV = (bf16_t*)(big + (size_t)T * 1024 * 2); p.ZO = (bf16_t*)(big + (size_t)T * 1536 * 2); p.HS = (bf16_t*)big; p.QP = (bf16_t*)big; p.QKV = (bf16_t*)big;
  char* big2 = alloc((size_t)T * 1536 * 2);
  p.QK = (bf16_t*)big2; p.ZP = (bf16_t*)(big2 + (size_t)T * 1024 * 2); p.Qh = (bf16_t*)big2; p.Kh = (bf16_t*)(big2 + (size_t)T * 1024 * 2); p.Vh = (bf16_t*)(big2 + (size_t)T * 1280 * 2);
  p.bar = (unsigned*)alloc(XCD_BAR_WORDS * 4);
  if (off > ws_size) { fprintf(stderr, "kernel_launch: workspace too small: need %zu have %zu\n", off, ws_size); return; }

  static int grid_blocks = 0;
  if (!grid_blocks) {
    int dev = 0, cus = 0, per_cu = 0; hipGetDevice(&dev); hipDeviceGetAttribute(&cus, hipDeviceAttributeMultiprocessorCount, dev);
    hipFuncSetAttribute((const void*)mega, hipFuncAttributeMaxDynamicSharedMemorySize, SMEM_BYTES);
    hipOccupancyMaxActiveBlocksPerMultiprocessor(&per_cu, mega, NTHREADS, SMEM_BYTES);
    if (per_cu > 1) per_cu = 1;
    grid_blocks = cus * per_cu;
    if (grid_blocks <= 0) { fprintf(stderr, "kernel_launch: occupancy query returned 0\n"); grid_blocks = 0; return; }
  }
  hipMemsetAsync(p.bar, 0, XCD_BAR_WORDS * 4, stream);
#if MULTI_LAUNCH
  for (int ph = 0; ph < NPH; ++ph) hipLaunchKernelGGL(mega, dim3(grid_blocks), dim3(NTHREADS), SMEM_BYTES, stream, p, ph, ph + 1);
#else
  int ph0 = 0, ph1 = NPH; void* args[] = {&p, &ph0, &ph1};
  hipError_t e = hipLaunchCooperativeKernel((const void*)mega, dim3(grid_blocks), dim3(NTHREADS), args, SMEM_BYTES, stream);
  if (e != hipSuccess) fprintf(stderr, "cooperative launch failed: %s (grid %d)\n", hipGetErrorString(e), grid_blocks);
#endif
}
```

```cpp
#include <hip/hip_runtime.h>
#include <hip/hip_cooperative_groups.h>
#include <math.h>
#include <stdint.h>
#include <stdio.h>
namespace cg = cooperative_groups;

#ifndef MULTI_LAUNCH
#define MULTI_LAUNCH 0
#endif

namespace {
typedef unsigned short bf16_t;
typedef unsigned int u32;
typedef float f32x4 __attribute__((ext_vector_type(4)));
typedef u32 u32x4 __attribute__((ext_vector_type(4)));
typedef u32 u32x2 __attribute__((ext_vector_type(2)));
typedef __bf16 bf16x2_t __attribute__((ext_vector_type(2)));

constexpr int D = 1024, NB = 8, S = 4096, T = NB * S;
constexpr int EVEN_IN = 2576;
constexpr float EPS = 1e-6f;
constexpr int NTHREADS = 512;
constexpr int SMEM_BYTES = 144 * 1024;
constexpr float KSCALE = 0.08838834764831845f;

struct Params {
  const float *x, *c, *ada_w, *ada_b, *nmg, *nfg, *ev_w_in, *ev_b_in, *conv_w, *conv_b, *mnorm_g, *pool_w, *pool_sc, *ev_w_out, *od_w_in, *qn_g, *kn_g, *od_w_out,
      *peer_wq, *peer_keys, *peer_u, *peer_v, *final_g;
  float* X;
  bf16_t *Wt_evin, *Wt_evout, *Wt_odin, *Wt_odout, *Wt_q, *keysb, *poolWt; unsigned char *U8, *V8;
  float *Wg, *mod, *gates, *pgate;
  bf16_t *H, *ZQK, *ZV, *ZO, *ZP, *QK, *HS, *CAT, *QP, *QKV, *Qh, *Kh, *Vh;
  bf16_t* pidx;
  unsigned* bar;
};

__device__ __forceinline__ float siluf(float x) { return x / (1.f + __expf(-x)); }
__device__ __forceinline__ float sigmf(float x) { return 1.f / (1.f + __expf(-x)); }
__device__ __forceinline__ float wave_sum(float v) { for (int o = 32; o >= 1; o >>= 1) v += __shfl_xor(v, o); return v; }
__device__ __forceinline__ float wave_max(float v) { for (int o = 32; o >= 1; o >>= 1) v = fmaxf(v, __shfl_xor(v, o)); return v; }
__device__ __forceinline__ bf16_t f2bf(float f) { u32 u = __float_as_uint(f); u += 0x7FFFu + ((u >> 16) & 1u); return (bf16_t)(u >> 16); }
__device__ __forceinline__ float bf2f(bf16_t b) { return __uint_as_float(((u32)b) << 16); }
__device__ __forceinline__ u32 pack2(float lo, float hi) { return (u32)f2bf(lo) | ((u32)f2bf(hi) << 16); }
__device__ __forceinline__ float bflo(u32 w) { return __uint_as_float(w << 16); }
__device__ __forceinline__ float bfhi(u32 w) { return __uint_as_float(w & 0xFFFF0000u); }
__device__ __forceinline__ float dot2bf(u32 a, u32 b, float c) { return __builtin_amdgcn_fdot2_f32_bf16(__builtin_bit_cast(bf16x2_t, a), __builtin_bit_cast(bf16x2_t, b), c, false); }

constexpr int PJ_MOD = 192, PJ_TR = 2576, PJ_WG = 1, PJ_KEYS = 16, PJ_UV = 8192;
constexpr int PJ_TOTAL = PJ_MOD + PJ_TR + PJ_WG + PJ_KEYS + PJ_UV;

__device__ void prep_transpose_tile(const float* __restrict__ src, int ld, int k0, int n0, bf16_t* __restrict__ dst, int dstK, char* smem) {
  float* tile = (float*)smem;
  const int tid = threadIdx.x;
  __syncthreads();
  for (int pass = 0; pass < 8; ++pass) { int kk = pass * 8 + (tid >> 6), n = tid & 63; tile[kk * 65 + n] = src[(size_t)(k0 + kk) * ld + n0 + n]; }
  __syncthreads();
  int n = tid >> 3, kc = (tid & 7) * 8; u32x4 w;
  w.x = pack2(tile[(kc + 0) * 65 + n], tile[(kc + 1) * 65 + n]); w.y = pack2(tile[(kc + 2) * 65 + n], tile[(kc + 3) * 65 + n]);
  w.z = pack2(tile[(kc + 4) * 65 + n], tile[(kc + 5) * 65 + n]); w.w = pack2(tile[(kc + 6) * 65 + n], tile[(kc + 7) * 65 + n]);
  *(u32x4*)(dst + (size_t)(n0 + n) * dstK + k0 + kc) = w;
}

__device__ void phase_prep(const Params& p, char* smem) {
  const int tid = threadIdx.x;
  for (int job = blockIdx.x; job < PJ_TOTAL; job += gridDim.x) {
    if (job < PJ_MOD) {
      float* cs = (float*)smem; float* red = cs + 8192;
      __syncthreads();
      for (int i = tid; i < 8192; i += NTHREADS) cs[i] = siluf(p.c[i]);
      __syncthreads();
      const int l = job / 96, e0 = (job % 96) * 64, col = tid & 63, dg = tid >> 6;
      float acc[8];
#pragma unroll
      for (int b = 0; b < 8; ++b) acc[b] = 0.f;
      const float* w = p.ada_w + (size_t)l * D * 6144 + e0 + col;
      for (int d = dg * 128; d < dg * 128 + 128; ++d) { float wv = w[(size_t)d * 6144];
#pragma unroll
        for (int b = 0; b < 8; ++b) acc[b] += cs[b * 1024 + d] * wv; }
#pragma unroll
      for (int b = 0; b < 8; ++b) red[(dg * 8 + b) * 64 + col] = acc[b];
      __syncthreads();
      { const int b = tid >> 6; float s = 0.f;
#pragma unroll
        for (int g = 0; g < 8; ++g) s += red[(g * 8 + b) * 64 + col];
        p.mod[(size_t)(l * 8 + b) * 6144 + e0 + col] = s + p.ada_b[l * 6144 + e0 + col]; }
    } else if (job < PJ_MOD + PJ_TR) {
      int tt = job - PJ_MOD;
      if (tt < 640) prep_transpose_tile(p.ev_w_in, EVEN_IN, (tt / 40) * 64, (tt % 40) * 64, p.Wt_evin, 1024, smem);
      else if (tt < 896) { tt -= 640; prep_transpose_tile(p.ev_w_out, 1024, (tt / 16) * 64, (tt % 16) * 64, p.Wt_evout, 1024, smem); }
      else if (tt < 1280) { tt -= 896; prep_transpose_tile(p.od_w_in, 1536, (tt / 24) * 64, (tt % 24) * 64, p.Wt_odin, 1024, smem); }
      else if (tt < 1536) { tt -= 1280; prep_transpose_tile(p.od_w_out, 1024, (tt / 16) * 64, (tt % 16) * 64, p.Wt_odout, 1024, smem); }
      else if (tt < 2560) { tt -= 1536; int l = tt / 512; tt %= 512; prep_transpose_tile(p.peer_wq + (size_t)l * D * 2048, 2048, (tt / 32) * 64, (tt % 32) * 64, p.Wt_q + (size_t)l * 2048 * 1024, 1024, smem); }
      else { tt -= 2560; const int g = tt >> 2; prep_transpose_tile(p.pool_w + (size_t)g * 16384, 128, ((tt >> 1) & 1) * 64, (tt & 1) * 64, p.poolWt + (size_t)g * 16384, 128, smem); }
    } else if (job < PJ_MOD + PJ_TR + PJ_WG) {
      for (int i = tid; i < 16 * 1024; i += NTHREADS) { int g = i >> 10, d = i & 1023; p.Wg[i] = p.ev_w_in[(size_t)d * EVEN_IN + 2560 + g]; }
    } else if (job < PJ_MOD + PJ_TR + PJ_WG + PJ_KEYS) {
      int j = job - (PJ_MOD + PJ_TR + PJ_WG);
      for (int i = tid; i < 4096; i += NTHREADS) p.keysb[j * 4096 + i] = f2bf(p.peer_keys[j * 4096 + i]);
    } else {
      int j = job - (PJ_MOD + PJ_TR + PJ_WG + PJ_KEYS); const bool isu = j < 4096; const float* src = isu ? p.peer_u : p.peer_v; unsigned char* dst = isu ? p.U8 : p.V8; j &= 4095; const float sc = isu ? 32.f : 2.f;
      const size_t o = (size_t)j * 8192 + tid * 16; u32x4 w; u32 ww[4];
#pragma unroll
      for (int q = 0; q < 4; ++q) { const f32x4 a = *(const f32x4*)(src + o + 4 * q); int pk = __builtin_amdgcn_cvt_pk_fp8_f32(a.x * sc, a.y * sc, 0, false); pk = __builtin_amdgcn_cvt_pk_fp8_f32(a.z * sc, a.w * sc, pk, true); ww[q] = (u32)pk; }
      w.x = ww[0]; w.y = ww[1]; w.z = ww[2]; w.w = ww[3]; *(u32x4*)(dst + o) = w;
    }
  }
}

enum { EPI_EVIN = 0, EPI_EVOUT = 1, EPI_PEERQ = 2, EPI_ODIN = 3, EPI_ODOUT = 4 };
template <int EPI> __device__ __forceinline__ void epi_store(const Params& p, int layer, int m, int n, float acc) {
  if (EPI == EPI_EVIN) { float v = acc + p.ev_b_in[n];
    if (n < 1024) p.ZQK[(size_t)m * 1024 + n] = f2bf(v); else if (n < 1536) p.ZV[(size_t)m * 512 + n - 1024] = f2bf(v);
    else if (n < 2048) p.ZO[(size_t)m * 512 + n - 1536] = f2bf(sigmf(v)); else p.ZP[(size_t)m * 512 + n - 2048] = f2bf(v); }
  else if (EPI == EPI_EVOUT) { int b = m / S; p.X[(size_t)m * D + n] = p.x[(size_t)m * D + n] + p.mod[(size_t)(0 * 8 + b) * 6144 + 2048 + n] * acc; }
  else if (EPI == EPI_PEERQ) p.QP[(size_t)m * 2048 + n] = f2bf(acc);
  else if (EPI == EPI_ODIN) p.QKV[(size_t)m * 1536 + n] = f2bf(acc);
  else if (EPI == EPI_ODOUT) { int b = m / S; p.X[(size_t)m * D + n] += p.mod[(size_t)(1 * 8 + b) * 6144 + 2048 + n] * acc; }
}
template <int EPI> __device__ void phase_gemm_naive(const Params& p, int layer, const bf16_t* __restrict__ A, const bf16_t* __restrict__ Bt, int M, int N, int K, char* smem) {
  float* As = (float*)smem; float* Bs = As + 32 * 132;
  const int tid = threadIdx.x, tx = tid & 15, ty = tid >> 4; const int nN = N / 64, njobs = (M / 128) * nN;
  for (int job = blockIdx.x; job < njobs; job += gridDim.x) {
    const int m0 = (job / nN) * 128, n0 = (job % nN) * 64; float acc[4][4];
#pragma unroll
    for (int i = 0; i < 4; ++i)
#pragma unroll
      for (int j = 0; j < 4; ++j) acc[i][j] = 0.f;
    for (int k0 = 0; k0 < K; k0 += 32) {
      __syncthreads();
      { int row = tid >> 2, kc = (tid & 3) * 8; u32x4 w = *(const u32x4*)(A + (size_t)(m0 + row) * K + k0 + kc);
        As[(kc + 0) * 132 + row] = bflo(w.x); As[(kc + 1) * 132 + row] = bfhi(w.x); As[(kc + 2) * 132 + row] = bflo(w.y); As[(kc + 3) * 132 + row] = bfhi(w.y);
        As[(kc + 4) * 132 + row] = bflo(w.z); As[(kc + 5) * 132 + row] = bfhi(w.z); As[(kc + 6) * 132 + row] = bflo(w.w); As[(kc + 7) * 132 + row] = bfhi(w.w); }
      if (tid < 256) { int row = tid >> 2, kc = (tid & 3) * 8; u32x4 w = *(const u32x4*)(Bt + (size_t)(n0 + row) * K + k0 + kc);
        Bs[(kc + 0) * 68 + row] = bflo(w.x); Bs[(kc + 1) * 68 + row] = bfhi(w.x); Bs[(kc + 2) * 68 + row] = bflo(w.y); Bs[(kc + 3) * 68 + row] = bfhi(w.y);
        Bs[(kc + 4) * 68 + row] = bflo(w.z); Bs[(kc + 5) * 68 + row] = bfhi(w.z); Bs[(kc + 6) * 68 + row] = bflo(w.w); Bs[(kc + 7) * 68 + row] = bfhi(w.w); }
      __syncthreads();
#pragma unroll 8
      for (int kk = 0; kk < 32; ++kk) { f32x4 a = *(const f32x4*)(As + kk * 132 + ty * 4), b = *(const f32x4*)(Bs + kk * 68 + tx * 4);
        acc[0][0] += a.x * b.x; acc[0][1] += a.x * b.y; acc[0][2] += a.x * b.z; acc[0][3] += a.x * b.w;
        acc[1][0] += a.y * b.x; acc[1][1] += a.y * b.y; acc[1][2] += a.y * b.z; acc[1][3] += a.y * b.w;
        acc[2][0] += a.z * b.x; acc[2][1] += a.z * b.y; acc[2][2] += a.z * b.z; acc[2][3] += a.z * b.w;
        acc[3][0] += a.w * b.x; acc[3][1] += a.w * b.y; acc[3][2] += a.w * b.z; acc[3][3] += a.w * b.w; }
    }
#pragma unroll
    for (int i = 0; i < 4; ++i)
#pragma unroll
      for (int j = 0; j < 4; ++j) epi_store<EPI>(p, layer, m0 + ty * 4 + i, n0 + tx * 4 + j, acc[i][j]);
  }
}

namespace pg8 {
#define PG8_LAS __attribute__((address_space(3)))
typedef unsigned short bf16_t;
typedef short bf16x8 __attribute__((ext_vector_type(8)));
typedef float f32x4 __attribute__((ext_vector_type(4)));
typedef unsigned u32x4 __attribute__((ext_vector_type(4)));
constexpr int BM = 256, BK = 64, HALF = 128, HTB = HALF * BK * 2  , STAGE_BYTES = 8 * HTB, NXCD = 8, WGM = 8;

__host__ __device__ __forceinline__ int lds_byte(int r, int c) { const int st = (r >> 4) * 2 + (c >> 5), rr = r & 15, cc = c & 31, ob = rr * 64 + cc * 2; return st * 1024 + (ob ^ (((ob >> 9) & 1) << 5)); }
__host__ __device__ __forceinline__ void stage_rc(int b, int& R, int& C) { const int st = b / 1024, sb = b % 1024, swz = sb ^ (((sb >> 9) & 1) << 5); R = (st >> 1) * 16 + swz / 64; C = (st & 1) * 32 + (swz % 64) / 2; }
__host__ __device__ __forceinline__ int perm32(int rho) { const int n = rho >> 4, i = rho & 15; return 8 * (i >> 2) + 4 * n + (i & 3); }

struct Unit { int pm, pn; };
struct Gemm { const bf16_t* A; const bf16_t* Bt; int M, N, K; };

struct StaticOrder {
    int nM, nN, nwg, G, c;
    __host__ __device__ void init(int M, int N, int G_, int c_) { nM = M / BM; nN = N / BM; nwg = nM * nN; G = G_; c = c_; }
    __host__ __device__ bool next(int i, Unit& u) const {
        const long L = (long)i * G + c; if (L >= nwg) return false;
        int wgid = (int)L; { const int q = nwg / NXCD, r = nwg % NXCD, xcd = wgid % NXCD, off = wgid / NXCD; wgid = (xcd < r ? xcd * (q + 1) : r * (q + 1) + (xcd - r) * q) + off; }
        const int nig = WGM * nN, gid = wgid / nig, fm = gid * WGM, gsz = (nM - fm) < WGM ? (nM - fm) : WGM;
        u.pm = fm + ((wgid % nig) % gsz); u.pn = (wgid % nig) / gsz; return true;
    }
    __device__ __forceinline__ void a_ready(const Unit&) const {}
    __device__ __forceinline__ void done(const Unit&) const {}
};
__device__ __forceinline__ unsigned cvt_pk_bf16(float lo, float hi) { unsigned r; asm volatile("v_cvt_pk_bf16_f32 %0, %1, %2" : "=v"(r) : "v"(lo), "v"(hi)); return r; }
template <class Epi, class Sched, bool STAMP = false>
__device__ __forceinline__ void gemm_phase(PG8_LAS unsigned char* lds, const Gemm g, const Sched& S, const Epi& E, unsigned long long* stamps) {
    const int tid = threadIdx.x, wid = __builtin_amdgcn_readfirstlane(tid >> 6), lane = tid & 63, wr = wid >> 2, wc = wid & 3, fr = lane & 15, fq = lane >> 4;
    const int K = g.K, nt = K / BK;
    int ts_lo = 0, ts_hi = 0, nts = 0; const unsigned long long rt_entry = STAMP ? (unsigned long long)wall_clock64() : 0ull;
#define PG8_STAMP() do { if (STAMP && wid == 0 && nts < 64) { const unsigned long long _c = (unsigned long long)clock64(); \
        ts_lo = (lane == nts) ? (int)(unsigned)_c : ts_lo; ts_hi = (lane == nts) ? (int)(unsigned)(_c >> 32) : ts_hi; ++nts; } } while (0)
    PG8_STAMP();
    unsigned voffA[2], voffB[2];
#pragma unroll
    for (int i = 0; i < 2; ++i) { int R, C; stage_rc(tid * 16 + i * 8192, R, C); const int Rb = Epi::PERM ? ((R & ~31) + perm32(R & 31)) : R;
        voffA[i] = (unsigned)(R * K + C) * 2u; voffB[i] = (unsigned)(Rb * K + C) * 2u; }
    const size_t kstep = (size_t)(BK * 2);
    const size_t hstep = (size_t)HALF * K * 2;
    const size_t tstep = 2 * hstep;
    const unsigned ldsw = (unsigned)wid * 1024u;
    const int aoff = lds_byte(wr * 64 + fr, fq * 8), boff = lds_byte(wc * 32 + fr, fq * 8);
#define PG8_SA(b, h) (((b) * 2 + (h)) * HTB)
#define PG8_SB(b, h) ((4 + (b) * 2 + (h)) * HTB)
#define PG8_STAGE(bufoff, gbase, voff) do { _Pragma("unroll") for (int _i = 0; _i < 2; ++_i) \
        __builtin_amdgcn_global_load_lds((const unsigned*)((const char*)(gbase) + (voff)[_i]), (PG8_LAS unsigned*)(lds + (bufoff) + ldsw + _i * 8192), 16, 0, 0); } while (0)
#define PG8_LDA(dst, b, h) do { _Pragma("unroll") for (int m = 0; m < 4; ++m) _Pragma("unroll") for (int k = 0; k < 2; ++k) dst[m][k] = *(const PG8_LAS bf16x8*)(lds + PG8_SA(b, h) + aoff + m * 2048 + k * 1024); } while (0)
#define PG8_LDB(dst, b, h) do { _Pragma("unroll") for (int n = 0; n < 2; ++n) _Pragma("unroll") for (int k = 0; k < 2; ++k) dst[n][k] = *(const PG8_LAS bf16x8*)(lds + PG8_SB(b, h) + boff + n * 2048 + k * 1024); } while (0)
#define PG8_MMA(ai, bj, At, Bt) do { __builtin_amdgcn_s_setprio(1); _Pragma("unroll") for (int m = 0; m < 4; ++m) _Pragma("unroll") for (int n = 0; n < 2; ++n) _Pragma("unroll") for (int k = 0; k < 2; ++k) \
        acc[ai][bj][m][n] = __builtin_amdgcn_mfma_f32_16x16x32_bf16(Bt[n][k], At[m][k], acc[ai][bj][m][n], 0, 0, 0); __builtin_amdgcn_s_setprio(0); } while (0)
#define PG8_WAIT_V(n) asm volatile("s_waitcnt vmcnt(" #n ")" ::: "memory")
#define PG8_WAIT_L(n) asm volatile("s_waitcnt lgkmcnt(" #n ")" ::: "memory")
#define PG8_BAR __builtin_amdgcn_s_barrier()
#define PG8_SCHED __builtin_amdgcn_sched_barrier(0)
    Unit cur, nxt; int ui = 0;
    if (!S.next(0, cur)) return;
    f32x4 acc[2][2][4][2];
#pragma unroll
    for (int a = 0; a < 2; ++a)
#pragma unroll
        for (int b = 0; b < 2; ++b)
#pragma unroll
            for (int m = 0; m < 4; ++m)
#pragma unroll
                for (int n = 0; n < 2; ++n) acc[a][b][m][n] = (f32x4){0.f, 0.f, 0.f, 0.f};
    bf16x8 At[4][2], B0[2][2], B1[2][2];
    const char* cA = (const char*)g.A + (size_t)cur.pm * tstep; const char* cB = (const char*)g.Bt + (size_t)cur.pn * tstep;
    S.a_ready(cur);
    PG8_STAGE(PG8_SB(0, 0), cB, voffB); PG8_STAGE(PG8_SA(0, 0), cA, voffA); PG8_STAGE(PG8_SB(0, 1), cB + hstep, voffB); PG8_STAGE(PG8_SA(0, 1), cA + hstep, voffA);
    if (wr == 1) PG8_BAR;
    PG8_WAIT_V(4); PG8_BAR;
    PG8_STAGE(PG8_SB(1, 0), cB + kstep, voffB); PG8_STAGE(PG8_SA(1, 0), cA + kstep, voffA); PG8_STAGE(PG8_SB(1, 1), cB + hstep + kstep, voffB);
    PG8_WAIT_V(6); PG8_BAR;
    PG8_STAMP();
    for (;;) {
        const bool has_next = S.next(ui + 1, nxt);
        const char* nA = has_next ? (const char*)g.A + (size_t)nxt.pm * tstep : cA; const char* nB = has_next ? (const char*)g.Bt + (size_t)nxt.pn * tstep : cB;
        for (int t = 0; t < nt; t += 2) {
            const bool last = (t == nt - 2);
            const char* a1 = cA + (size_t)(t + 1) * kstep;
            const char* a2 = last ? nA : cA + (size_t)(t + 2) * kstep; const char* b2 = last ? nB : cB + (size_t)(t + 2) * kstep;
            const char* a3 = a2 + kstep; const char* b3 = b2 + kstep;
            if (last && has_next) S.a_ready(nxt);
            PG8_LDB(B0, 0, 0); PG8_SCHED; PG8_LDA(At, 0, 0); PG8_STAGE(PG8_SA(1, 1), a1 + hstep, voffA);
            PG8_WAIT_L(8); PG8_BAR; PG8_WAIT_L(0); PG8_MMA(0, 0, At, B0); PG8_BAR; PG8_SCHED;
            PG8_LDB(B1, 0, 1); PG8_STAGE(PG8_SB(0, 0), b2, voffB);
            PG8_BAR; PG8_WAIT_L(0); PG8_MMA(0, 1, At, B1); PG8_BAR;
            PG8_LDA(At, 0, 1); PG8_STAGE(PG8_SA(0, 0), a2, voffA);
            PG8_BAR; PG8_WAIT_L(0); PG8_MMA(1, 0, At, B0); PG8_BAR; PG8_SCHED;
            PG8_STAGE(PG8_SB(0, 1), b2 + hstep, voffB);
            PG8_WAIT_V(6); PG8_BAR; PG8_MMA(1, 1, At, B1); PG8_BAR;
            PG8_LDB(B0, 1, 0); PG8_SCHED; PG8_LDA(At, 1, 0); PG8_STAGE(PG8_SA(0, 1), a2 + hstep, voffA);
            PG8_WAIT_L(8); PG8_BAR; PG8_WAIT_L(0); PG8_MMA(0, 0, At, B0); PG8_BAR; PG8_SCHED;
            PG8_LDB(B1, 1, 1); PG8_STAGE(PG8_SB(1, 0), b3, voffB);
            PG8_BAR; PG8_WAIT_L(0); PG8_MMA(0, 1, At, B1); PG8_BAR;
            PG8_LDA(At, 1, 1); PG8_STAGE(PG8_SA(1, 0), a3, voffA);
            PG8_BAR; PG8_WAIT_L(0); PG8_MMA(1, 0, At, B0); PG8_BAR; PG8_SCHED;
            PG8_STAGE(PG8_SB(1, 1), b3 + hstep, voffB);
            PG8_WAIT_V(6); PG8_BAR; PG8_MMA(1, 1, At, B1); PG8_BAR;
        }
        PG8_STAMP();
        if constexpr (!Epi::AFTER_DRAIN) { E(acc, cur, wr, wc, fr, fq); S.done(cur); }
        PG8_STAMP();
        if (!has_next) break;
#pragma unroll
        for (int a = 0; a < 2; ++a)
#pragma unroll
            for (int b = 0; b < 2; ++b)
#pragma unroll
                for (int m = 0; m < 4; ++m)
#pragma unroll
                    for (int n = 0; n < 2; ++n) acc[a][b][m][n] = (f32x4){0.f, 0.f, 0.f, 0.f};
        cur = nxt; cA = nA; cB = nB; ++ui;
    }
    PG8_WAIT_V(0);
    if (wr == 0) PG8_BAR;
    PG8_BAR;
    if constexpr (Epi::AFTER_DRAIN) { E.fused(acc, cur, wr, wc, fr, fq, lds, wid, lane); S.done(cur); }
    PG8_STAMP();
    if (STAMP && wid == 0) { stamps[lane] = lane < nts ? (((unsigned long long)(unsigned)ts_hi << 32) | (unsigned)ts_lo) : 0ull;
        if (lane == 62) stamps[62] = rt_entry; if (lane == 63) stamps[63] = (unsigned long long)wall_clock64(); }
#undef PG8_STAMP
#undef PG8_SA
#undef PG8_SB
#undef PG8_STAGE
#undef PG8_LDA
#undef PG8_LDB
#undef PG8_MMA
#undef PG8_WAIT_V
#undef PG8_WAIT_L
#undef PG8_BAR
#undef PG8_SCHED
}
}

struct EpiEvin {
  static constexpr bool PERM = true, AFTER_DRAIN = false;
  bf16_t *ZQK, *ZV, *ZO, *ZP; const float* bias;
  __device__ __forceinline__ void operator()(const pg8::f32x4 (&acc)[2][2][4][2], const pg8::Unit& u, int wr, int wc, int fr, int fq) const {
    const int row0 = u.pm * 256 + wr * 64 + fr, ct = u.pn * 256;
    bf16_t* base; int ldc, cl; bool sig = false;
    if (ct < 1024) { base = ZQK; ldc = 1024; cl = ct; } else if (ct < 1536) { base = ZV; ldc = 512; cl = ct - 1024; } else if (ct < 2048) { base = ZO; ldc = 512; cl = ct - 1536; sig = true; } else { base = ZP; ldc = 512; cl = ct - 2048; }
    const int cofs = wc * 32 + 8 * fq;
    pg8::f32x4 bv[2][2];
#pragma unroll
    for (int bj = 0; bj < 2; ++bj)
#pragma unroll
      for (int n = 0; n < 2; ++n) bv[bj][n] = *(const pg8::f32x4*)(bias + ct + cofs + bj * 128 + 4 * n);
#pragma unroll
    for (int ai = 0; ai < 2; ++ai)
#pragma unroll
      for (int m = 0; m < 4; ++m) { bf16_t* rowp = base + (size_t)(row0 + ai * 128 + m * 16) * ldc + cl + cofs;
#pragma unroll
        for (int bj = 0; bj < 2; ++bj) { pg8::f32x4 v0 = acc[ai][bj][m][0] + bv[bj][0], v1 = acc[ai][bj][m][1] + bv[bj][1];
          if (sig) {
#pragma unroll
            for (int j = 0; j < 4; ++j) { v0[j] = sigmf(v0[j]); v1[j] = sigmf(v1[j]); } }
          pg8::u32x4 w; w.x = pg8::cvt_pk_bf16(v0[0], v0[1]); w.y = pg8::cvt_pk_bf16(v0[2], v0[3]); w.z = pg8::cvt_pk_bf16(v1[0], v1[1]); w.w = pg8::cvt_pk_bf16(v1[2], v1[3]);
          *(pg8::u32x4*)(rowp + bj * 128) = w; } }
  }
};
struct EpiPlain {
  static constexpr bool PERM = true, AFTER_DRAIN = false;
  bf16_t* out; int ldc;
  __device__ __forceinline__ void operator()(const pg8::f32x4 (&acc)[2][2][4][2], const pg8::Unit& u, int wr, int wc, int fr, int fq) const {
    const int row0 = u.pm * 256 + wr * 64 + fr, col0 = u.pn * 256 + wc * 32 + 8 * fq;
#pragma unroll
    for (int ai = 0; ai < 2; ++ai)
#pragma unroll
      for (int m = 0; m < 4; ++m) { bf16_t* rowp = out + (size_t)(row0 + ai * 128 + m * 16) * ldc + col0;
#pragma unroll
        for (int bj = 0; bj < 2; ++bj) { const pg8::f32x4 v0 = acc[ai][bj][m][0], v1 = acc[ai][bj][m][1];
          pg8::u32x4 w; w.x = pg8::cvt_pk_bf16(v0[0], v0[1]); w.y = pg8::cvt_pk_bf16(v0[2], v0[3]); w.z = pg8::cvt_pk_bf16(v1[0], v1[1]); w.w = pg8::cvt_pk_bf16(v1[2], v1[3]);
          *(pg8::u32x4*)(rowp + bj * 128) = w; } }
  }
};
struct EpiRes {
  static constexpr bool PERM = false, AFTER_DRAIN = false;
  const float* xin; float* X; const float* gate;
  __device__ __forceinline__ void operator()(const pg8::f32x4 (&acc)[2][2][4][2], const pg8::Unit& u, int wr, int wc, int fr, int fq) const {
    const int row0 = u.pm * 256 + wr * 64 + fr, col0 = u.pn * 256 + wc * 32 + 4 * fq; const float* gb = gate + (size_t)((u.pm * 256) / S) * 6144;
    pg8::f32x4 gv[2][2];
#pragma unroll
    for (int bj = 0; bj < 2; ++bj)
#pragma unroll
      for (int n = 0; n < 2; ++n) gv[bj][n] = *(const pg8::f32x4*)(gb + col0 + bj * 128 + n * 16);
#pragma unroll
    for (int ai = 0; ai < 2; ++ai)
#pragma unroll
      for (int m = 0; m < 4; ++m) { const size_t off = (size_t)(row0 + ai * 128 + m * 16) * 1024 + col0;
#pragma unroll
        for (int bj = 0; bj < 2; ++bj)
#pragma unroll
          for (int n = 0; n < 2; ++n) { const pg8::f32x4 xi = *(const pg8::f32x4*)(xin + off + bj * 128 + n * 16); *(pg8::f32x4*)(X + off + bj * 128 + n * 16) = xi + gv[bj][n] * acc[ai][bj][m][n]; }
        asm volatile("" ::: "memory"); }
  }
};
template <class Epi> __device__ __forceinline__ void phase_gemm_fast(const bf16_t* A, const bf16_t* Bt, int M, int N, int K, const Epi& E, char* smem) {
  pg8::Gemm g; g.A = A; g.Bt = Bt; g.M = M; g.N = N; g.K = K;
  pg8::StaticOrder So; So.init(M, N, (int)gridDim.x, (int)blockIdx.x);
  pg8::gemm_phase<Epi, pg8::StaticOrder, false>((PG8_LAS unsigned char*)smem, g, So, E, nullptr);
}

namespace cp {
typedef short bf16x8 __attribute__((ext_vector_type(8)));
typedef float f32x16 __attribute__((ext_vector_type(16)));
constexpr int RS = 272;
__device__ __forceinline__ void unpack8(const u32x4 w, float* f) { f[0] = bflo(w.x); f[1] = bfhi(w.x); f[2] = bflo(w.y); f[3] = bfhi(w.y); f[4] = bflo(w.z); f[5] = bfhi(w.z); f[6] = bflo(w.w); f[7] = bfhi(w.w); }
__device__ void phase_convpool(const Params& p, char* smem) {
  for (int job = blockIdx.x; job < T / 64; job += gridDim.x) {
    int tid_ = threadIdx.x; asm volatile("" : "+v"(tid_));
    const int tid = tid_, c0 = (tid & 127) * 8, t0 = job * 64 + (tid >> 7) * 16, s0 = t0 & (S - 1);
    float cw[5][8], cb[8];
#pragma unroll
    for (int j = 0; j < 5; ++j) { const f32x4 a = *(const f32x4*)(p.conv_w + j * 1024 + c0), b = *(const f32x4*)(p.conv_w + j * 1024 + c0 + 4); cw[j][0] = a.x; cw[j][1] = a.y; cw[j][2] = a.z; cw[j][3] = a.w; cw[j][4] = b.x; cw[j][5] = b.y; cw[j][6] = b.z; cw[j][7] = b.w; }
    { const f32x4 a = *(const f32x4*)(p.conv_b + c0), b = *(const f32x4*)(p.conv_b + c0 + 4); cb[0] = a.x; cb[1] = a.y; cb[2] = a.z; cb[3] = a.w; cb[4] = b.x; cb[5] = b.y; cb[6] = b.z; cb[7] = b.w; }
    const float sc = c0 >= 512 ? KSCALE : 1.f;
    float win[5][8];
#pragma unroll
    for (int j = 0; j < 4; ++j) { const int ss = s0 + j - 2; u32x4 w = (u32x4){0u, 0u, 0u, 0u}; if (ss >= 0 && ss < S) w = *(const u32x4*)(p.ZQK + (size_t)(t0 + j - 2) * 1024 + c0); unpack8(w, win[j + 1]); }
#pragma unroll
    for (int i = 0; i < 16; ++i) {
#pragma unroll
      for (int j = 0; j < 4; ++j)
#pragma unroll
        for (int q = 0; q < 8; ++q) win[j][q] = win[j + 1][q];
      { const int ss = s0 + i + 2; u32x4 w = (u32x4){0u, 0u, 0u, 0u}; if (ss < S) w = *(const u32x4*)(p.ZQK + (size_t)(t0 + i + 2) * 1024 + c0); unpack8(w, win[4]); }
      float a[8];
#pragma unroll
      for (int q = 0; q < 8; ++q) { float v = cb[q];
#pragma unroll
        for (int j = 0; j < 5; ++j) v += cw[j][q] * win[j][q];
        a[q] = siluf(v) * sc; }
      u32x4 o; o.x = pack2(a[0], a[1]); o.y = pack2(a[2], a[3]); o.z = pack2(a[4], a[5]); o.w = pack2(a[6], a[7]); *(u32x4*)(p.QK + (size_t)(t0 + i) * 1024 + c0) = o;
    }
  }
  for (int job = blockIdx.x; job < (T / 128) * 4; job += gridDim.x) {
    int tid_ = threadIdx.x; asm volatile("" : "+v"(tid_));
    const int tid = tid_, wid = tid >> 6, lane = tid & 63, l31 = lane & 31, hh = lane >> 5;
    const int g = job & 3, t0 = (job >> 2) * 128, win = 2 << g, hw = win >> 1;
    __syncthreads();
#pragma unroll
    for (int i = 0; i < 4; ++i) { const int idx = tid + i * NTHREADS, row = idx >> 4, ch = idx & 15; *(u32x4*)(smem + 128 * RS + row * RS + ch * 16) = *(const u32x4*)(p.poolWt + (size_t)g * 16384 + row * 128 + ch * 8); }
#pragma unroll 1
    for (int i = 0; i < 4; ++i) { const int idx = tid + i * NTHREADS, row = idx >> 4, ch = idx & 15, t = t0 + row, s = t & (S - 1); const int lo = max(s - hw, 0), hi = min(s + hw, S);
      float sum[8], own[8];
#pragma unroll
      for (int q = 0; q < 8; ++q) sum[q] = 0.f;
      const bf16_t* base = p.ZP + (size_t)(t - s) * 512 + g * 128 + ch * 8;
      for (int r = lo; r < hi; ++r) { float f[8]; unpack8(*(const u32x4*)(base + (size_t)r * 512), f);
#pragma unroll
        for (int q = 0; q < 8; ++q) sum[q] += f[q]; }
      unpack8(*(const u32x4*)(base + (size_t)s * 512), own); const float inv = 1.f / (float)(hi - lo);
      u32x4 o; o.x = pack2(sum[0] * inv - own[0], sum[1] * inv - own[1]); o.y = pack2(sum[2] * inv - own[2], sum[3] * inv - own[3]); o.z = pack2(sum[4] * inv - own[4], sum[5] * inv - own[5]); o.w = pack2(sum[6] * inv - own[6], sum[7] * inv - own[7]);
      *(u32x4*)(smem + row * RS + ch * 16) = o; }
    __syncthreads();
    const int mt = wid >> 1;
#pragma unroll
    for (int q = 0; q < 2; ++q) { const int nt = (wid & 1) * 2 + q;
      f32x16 acc;
#pragma unroll
      for (int r = 0; r < 16; ++r) acc[r] = 0.f;
      const char* ya = smem + (mt * 32 + l31) * RS + hh * 16; const char* wb = smem + 128 * RS + (nt * 32 + l31) * RS + hh * 16;
#pragma unroll
      for (int ks = 0; ks < 8; ++ks) acc = __builtin_amdgcn_mfma_f32_32x32x16_bf16(*(const bf16x8*)(ya + ks * 32), *(const bf16x8*)(wb + ks * 32), acc, 0, 0, 0);
      const int e = nt * 32 + l31; const float psc = p.pool_sc[g * 128 + e];
#pragma unroll
      for (int r = 0; r < 16; ++r) { const int row = mt * 32 + (r & 3) + 8 * (r >> 2) + 4 * hh; p.CAT[(size_t)(t0 + row) * 1024 + 512 + g * 128 + e] = f2bf(acc[r] * psc); } }
  }
}
}

__device__ void phase_mlstm_naive(const Params& p, char* smem) {
  float* qs = (float*)smem; float* ks = qs + 128; float* nump = ks + 128; float* red = nump + 512;
  const int tid = threadIdx.x, j = tid & 127, qd = tid >> 7;
  for (int job = blockIdx.x; job < 64; job += gridDim.x) {
    const int dir = job >> 5, b = (job >> 2) & 7, h = job & 3;
    float C[32];
#pragma unroll
    for (int d = 0; d < 32; ++d) C[d] = 0.f;
    float n = 0.f, m = 0.f;
    for (int step = 0; step < S; ++step) { const int s = dir ? S - 1 - step : step; const size_t t = (size_t)b * S + s;
      const float li = p.gates[t * 16 + dir * 4 + h], gf = p.gates[t * 16 + 8 + dir * 4 + h];
      const float lf = fminf(gf, 0.f) - log1pf(__expf(-fabsf(gf)));
      __syncthreads();
      if (qd == 0) { qs[j] = bf2f(p.QK[t * 1024 + h * 128 + j]); ks[j] = bf2f(p.QK[t * 1024 + 512 + h * 128 + j]); }
      const float v = bf2f(p.ZV[t * 512 + h * 128 + j]);
      __syncthreads();
      const float mn = fmaxf(lf + m, li), ip = __expf(li - mn), fp = __expf(lf + m - mn); m = mn;
      float num = 0.f;
#pragma unroll
      for (int d = 0; d < 32; ++d) { C[d] = fp * C[d] + ip * ks[qd * 32 + d] * v; num += qs[qd * 32 + d] * C[d]; }
      float dp = 0.f; if (qd == 0) { n = fp * n + ip * ks[j]; dp = qs[j] * n; }
      nump[qd * 128 + j] = num;
      dp = wave_sum(dp); if ((tid & 63) == 0) red[tid >> 6] = dp;
      __syncthreads();
      if (qd == 0) { const float den = red[0] + red[1]; num = nump[j] + nump[128 + j] + nump[256 + j] + nump[384 + j];
        p.HS[((size_t)dir * T + t) * 512 + h * 128 + j] = f2bf(num / fmaxf(fabsf(den), __expf(-mn))); }
    }
    __syncthreads();
  }
}

namespace ml {
typedef short bf16x8 __attribute__((ext_vector_type(8)));
typedef short s16x4 __attribute__((ext_vector_type(4)));
typedef float f32x16 __attribute__((ext_vector_type(16)));
constexpr int RS = 272;
constexpr int OFF_Q = 0, OFF_K = 128 * RS, OFF_VT = 2 * 128 * RS, OFF_VW = OFF_VT + 34 * RS, OFF_CT = OFF_VW + 34 * RS, OFF_A = OFF_CT + 34 * RS;
constexpr int OFF_PA = OFF_A + 16384, OFF_MCH = OFF_PA + 16384, OFF_TAB = OFF_MCH + 512, OFF_DEN = OFF_TAB + 4096, OFF_END = OFF_DEN + 512;
static_assert(OFF_A % 16 == 0 && OFF_END <= SMEM_BYTES, "mlstm LDS layout");
__device__ __forceinline__ int crow(int r, int h) { return (r & 3) + 8 * (r >> 2) + 4 * h; }
__device__ __forceinline__ int spos(int s) { return (s & ~12) | ((s & 4) << 1) | ((s & 8) >> 1); }
#define ML_MFMA(a, b, c) __builtin_amdgcn_mfma_f32_32x32x16_bf16((a), (b), (c), 0, 0, 0)
__device__ __forceinline__ bf16x8 pack8(float x0, float x1, float x2, float x3, float x4, float x5, float x6, float x7) {
  u32x4 w; w.x = pack2(x0, x1); w.y = pack2(x2, x3); w.z = pack2(x4, x5); w.w = pack2(x6, x7); return __builtin_bit_cast(bf16x8, w);
}
__device__ __forceinline__ void tr_read2(unsigned a0, unsigned a1, s16x4& lo, s16x4& hi) {
  asm volatile("ds_read_b64_tr_b16 %0, %2\n\tds_read_b64_tr_b16 %1, %3\n\ts_waitcnt lgkmcnt(0)" : "=&v"(lo), "=&v"(hi) : "v"(a0), "v"(a1) : "memory");
}

__device__ void phase_mlstm(const Params& p, char* smem) {
  int tid_ = threadIdx.x; asm volatile("" : "+v"(tid_));
  const int tid = tid_, wid = tid >> 6, lane = tid & 63, l31 = lane & 31, hh = lane >> 5;
  float* const LA = (float*)(smem + OFF_A); float* const LPA = (float*)(smem + OFF_PA); float* const LM = (float*)(smem + OFF_MCH);
  float* const LTAB = (float*)(smem + OFF_TAB); float* const LDEN = (float*)(smem + OFF_DEN);
  const unsigned lds0 = (unsigned)(uintptr_t)smem;
  for (int job = blockIdx.x; job < 256; job += gridDim.x) {
    const int dvq = job & 3, h = (job >> 2) & 3, b = (job >> 4) & 7, dir = job >> 7;
    const float* gts = p.gates + (size_t)b * S * 16;
    const bf16_t* QKb = p.QK + (size_t)b * S * 1024 + h * 128; const bf16_t* ZVb = p.ZV + (size_t)b * S * 512 + h * 128 + dvq * 32;
    bf16_t* HSb = p.HS + ((size_t)dir * T + (size_t)b * S) * 512 + h * 128 + dvq * 32;
    __syncthreads();
    for (int i = tid; i < 3 * 34 * RS / 4; i += NTHREADS) ((u32*)(smem + OFF_VT))[i] = 0u;
    for (int cc = 0; cc < 4; ++cc) { const int c = wid * 4 + cc, tau0 = c * 128 + 2 * lane; const int tok0 = dir ? S - 1 - tau0 : tau0, tok1 = dir ? tok0 - 1 : tok0 + 1;
      const float li0 = gts[(size_t)tok0 * 16 + dir * 4 + h], gf0 = gts[(size_t)tok0 * 16 + 8 + dir * 4 + h], li1 = gts[(size_t)tok1 * 16 + dir * 4 + h], gf1 = gts[(size_t)tok1 * 16 + 8 + dir * 4 + h];
      const float lf0 = fminf(gf0, 0.f) - log1pf(__expf(-fabsf(gf0))), lf1 = fminf(gf1, 0.f) - log1pf(__expf(-fabsf(gf1)));
      const float pr = lf0 + lf1; float incl = pr;
#pragma unroll
      for (int o = 1; o < 64; o <<= 1) { const float v = __shfl_up(incl, o); if (lane >= o) incl += v; }
      const float b0 = incl - pr + lf0, b1 = b0 + lf1, a0 = li0 - b0, a1 = li1 - b1;
      float im = fmaxf(a0, a1);
#pragma unroll
      for (int o = 1; o < 64; o <<= 1) { const float v = __shfl_up(im, o); if (lane >= o) im = fmaxf(im, v); }
      float ex = __shfl_up(im, 1); if (lane == 0) ex = -INFINITY;
      const float pa0 = fmaxf(ex, a0), pa1 = fmaxf(pa0, a1);
      LA[tau0] = a0; LA[tau0 + 1] = a1; LPA[tau0] = pa0; LPA[tau0 + 1] = pa1; if (lane == 63) LM[64 + c] = b1; }
    __syncthreads();
    if (tid == 0) { float m = 0.f; for (int c = 0; c < 32; ++c) { LM[c] = m; m = LM[64 + c] + fmaxf(m, LPA[c * 128 + 127]); } LM[32] = m; }
    __syncthreads();
    u32x4 qreg[4], kreg[4], vreg;
#define ML_TOK(tau) (dir ? S - 1 - (tau) : (tau))
#define ML_LOAD(c) do { _Pragma("unroll") for (int i_ = 0; i_ < 4; ++i_) { const int tk_ = ML_TOK((c) * 128 + (tid >> 4) + 32 * i_); \
        qreg[i_] = *(const u32x4*)(QKb + (size_t)tk_ * 1024 + (tid & 15) * 8); kreg[i_] = *(const u32x4*)(QKb + (size_t)tk_ * 1024 + 512 + (tid & 15) * 8); } \
      { const int tk_ = ML_TOK((c) * 128 + (tid >> 2)); vreg = *(const u32x4*)(ZVb + (size_t)tk_ * 512 + (tid & 3) * 8); } } while (0)
#define ML_TABLES(c) do { if (tid < 128) { const int tau_ = (c) * 128 + tid, tk_ = ML_TOK(tau_); const float li_ = gts[(size_t)tk_ * 16 + dir * 4 + h], a_ = LA[tau_], mc_ = LM[(c)]; \
        const float Mj_ = fmaxf(mc_, LPA[tau_]), Me_ = fmaxf(mc_, LPA[(c) * 128 + 127]); float* tb_ = LTAB + ((c) & 1) * 512; \
        tb_[tid] = Mj_; tb_[128 + tid] = __expf(mc_ - Mj_); tb_[256 + tid] = __expf(-((li_ - a_) + Mj_)); tb_[384 + tid] = __expf(a_ - Me_); } } while (0)
#define ML_STORE(c) do { _Pragma("unroll") for (int i_ = 0; i_ < 4; ++i_) { const int row_ = (tid >> 4) + 32 * i_; \
        *(u32x4*)(smem + OFF_Q + row_ * RS + (tid & 15) * 16) = qreg[i_]; *(u32x4*)(smem + OFF_K + row_ * RS + (tid & 15) * 16) = kreg[i_]; } \
      { const int s_ = tid >> 2, ps_ = spos(s_) * 2; const float we_ = LTAB[((c) & 1) * 512 + 384 + s_]; const u32 vw_[4] = {vreg.x, vreg.y, vreg.z, vreg.w}; \
        _Pragma("unroll") for (int i_ = 0; i_ < 4; ++i_) { const int r0_ = ((tid & 3) * 8 + 2 * i_) * RS + ps_; \
          *(bf16_t*)(smem + OFF_VT + r0_) = (bf16_t)(vw_[i_] & 0xFFFFu); *(bf16_t*)(smem + OFF_VT + r0_ + RS) = (bf16_t)(vw_[i_] >> 16); \
          *(bf16_t*)(smem + OFF_VW + r0_) = f2bf(bflo(vw_[i_]) * we_); *(bf16_t*)(smem + OFF_VW + r0_ + RS) = f2bf(bfhi(vw_[i_]) * we_); } } \
      if (tid < 128) { const int ps_ = spos(tid) * 2; *(bf16_t*)(smem + OFF_VT + 32 * RS + ps_) = (bf16_t)0x3F80u; *(bf16_t*)(smem + OFF_VW + 32 * RS + ps_) = f2bf(LTAB[((c) & 1) * 512 + 384 + tid]); } } while (0)
    ML_LOAD(0); ML_TABLES(0);
    __syncthreads();
    ML_STORE(0);
    __syncthreads();
    f32x16 Cacc;
#pragma unroll
    for (int r = 0; r < 16; ++r) Cacc[r] = 0.f;
    for (int c = 0; c < 32; ++c) {
      int tidc_ = threadIdx.x; asm volatile("" : "+v"(tidc_));
      const int tid = tidc_, wid = tid >> 6, lane = tid & 63, l31 = lane & 31, hh = lane >> 5;
      const int t2 = wid >> 1, nt = wid & 1, brow = min(nt * 32 + l31, 33);
      if (c + 1 < 32) { ML_LOAD(c + 1); ML_TABLES(c + 1); }
      const float* tab = LTAB + (c & 1) * 512;
      f32x16 acc;
#pragma unroll
      for (int r = 0; r < 16; ++r) acc[r] = 0.f;
      const char* qa = smem + OFF_Q + (t2 * 32 + l31) * RS + hh * 16;
      { const char* cb = smem + OFF_CT + brow * RS + hh * 16;
#pragma unroll
        for (int ks = 0; ks < 8; ++ks) acc = ML_MFMA(*(const bf16x8*)(qa + ks * 32), *(const bf16x8*)(cb + ks * 32), acc); }
#pragma unroll
      for (int r = 0; r < 16; ++r) acc[r] *= tab[128 + t2 * 32 + crow(r, hh)];
      const float Mj = tab[t2 * 32 + l31];
      for (int si = 0; si <= t2; ++si) {
        f32x16 X;
#pragma unroll
        for (int r = 0; r < 16; ++r) X[r] = 0.f;
        const char* ka = smem + OFF_K + (si * 32 + l31) * RS + hh * 16;
#pragma unroll
        for (int ks = 0; ks < 8; ++ks) X = ML_MFMA(*(const bf16x8*)(ka + ks * 32), *(const bf16x8*)(qa + ks * 32), X);
        const float* Ac = LA + c * 128 + si * 32;
#pragma unroll
        for (int r = 0; r < 16; ++r) { const int sl = crow(r, hh); float w = __expf(Ac[sl] - Mj); if (si == t2 && sl > l31) w = 0.f; X[r] *= w; }
        const bf16x8 f0 = pack8(X[0], X[1], X[2], X[3], X[4], X[5], X[6], X[7]), f1 = pack8(X[8], X[9], X[10], X[11], X[12], X[13], X[14], X[15]);
        const char* vb = smem + OFF_VT + brow * RS + si * 64 + hh * 16;
        acc = ML_MFMA(f0, *(const bf16x8*)(vb), acc); acc = ML_MFMA(f1, *(const bf16x8*)(vb + 32), acc);
      }
      if (nt == 1 && l31 == 0) {
#pragma unroll
        for (int r = 0; r < 16; ++r) LDEN[t2 * 32 + crow(r, hh)] = acc[r]; }
      { const float mc = LM[c], decay = __expf(mc - fmaxf(mc, LPA[c * 128 + 127]));
#pragma unroll
        for (int r = 0; r < 16; ++r) Cacc[r] *= decay;
        const unsigned ta = lds0 + OFF_K + ((lane & 15) >> 2) * RS + (t2 * 32 + 16 * ((lane >> 4) & 1) + 4 * (lane & 3)) * 2 + 4 * hh * RS;
        const char* wb = smem + OFF_VW + brow * RS + hh * 16;
#pragma unroll
        for (int ks = 0; ks < 8; ++ks) { s16x4 lo, hi; tr_read2(ta + 16 * ks * RS, ta + (16 * ks + 8) * RS, lo, hi); __builtin_amdgcn_sched_barrier(0);
          const bf16x8 a = (bf16x8){lo[0], lo[1], lo[2], lo[3], hi[0], hi[1], hi[2], hi[3]};
          Cacc = ML_MFMA(a, *(const bf16x8*)(wb + ks * 32), Cacc); } }
      __syncthreads();
      if (nt == 0) {
#pragma unroll
        for (int r = 0; r < 16; ++r) { const int j = t2 * 32 + crow(r, hh); const float dn = LDEN[j], nr = tab[256 + j]; const int tk = ML_TOK(c * 128 + j);
          HSb[(size_t)tk * 512 + l31] = f2bf(acc[r] / fmaxf(fabsf(dn), nr)); } }
      if (nt * 32 + l31 <= 32) { char* cw = smem + OFF_CT + (nt * 32 + l31) * RS + (t2 * 32 + 4 * hh) * 2;
#pragma unroll
        for (int g = 0; g < 4; ++g) { u32x2 w; w.x = pack2(Cacc[4 * g], Cacc[4 * g + 1]); w.y = pack2(Cacc[4 * g + 2], Cacc[4 * g + 3]); *(u32x2*)(cw + 16 * g) = w; } }
      if (c + 1 < 32) ML_STORE(c + 1);
      __syncthreads();
    }
#undef ML_TOK
#undef ML_LOAD
#undef ML_TABLES
#undef ML_STORE
  }
}
}

__device__ void phase_peer_select_naive(const Params& p, int layer, char* smem) {
  float* kl = (float*)smem;
  float* qsh = kl + 2 * 128 * 129;
  const int tid = threadIdx.x, wid = tid >> 6, lane = tid & 63; float* qs = qsh + wid * 128;
  __syncthreads();
  for (int i = tid; i < 2 * 128 * 128; i += NTHREADS) kl[(i >> 7) * 129 + (i & 127)] = p.peer_keys[(size_t)layer * 32768 + i];
  __syncthreads();
  for (int job = blockIdx.x; job < T; job += gridDim.x) {
    const int t = job, h = wid;
    float ts[2][16]; int ti[2][16];
#pragma unroll
    for (int pp = 0; pp < 2; ++pp) {
      const bf16_t* q = p.QP + (size_t)t * 2048 + h * 256 + pp * 128; const float q0 = bf2f(q[lane]), q1 = bf2f(q[lane + 64]);
      const float r = rsqrtf(wave_sum(q0 * q0 + q1 * q1) * (1.f / 128.f) + EPS); qs[lane] = q0 * r; qs[lane + 64] = q1 * r;
      float s0 = 0.f, s1 = 0.f; const float* k0 = kl + (pp * 128 + lane) * 129; const float* k1 = k0 + 64 * 129;
      for (int c = 0; c < 128; ++c) { const float qc = qs[c]; s0 += qc * k0[c]; s1 += qc * k1[c]; }
#pragma unroll
      for (int k = 0; k < 16; ++k) { const float mx = wave_max(fmaxf(s0, s1)); int cand = (s0 == mx) ? lane : ((s1 == mx) ? lane + 64 : 9999);
        for (int o = 32; o >= 1; o >>= 1) cand = min(cand, __shfl_xor(cand, o));
        ts[pp][k] = mx; ti[pp][k] = cand; if (cand == lane) s0 = -INFINITY; if (cand == lane + 64) s1 = -INFINITY; }
    }
    float cs[4];
#pragma unroll
    for (int r = 0; r < 4; ++r) { const int c = lane * 4 + r; float va = 0.f, vb = 0.f;
#pragma unroll
      for (int k = 0; k < 16; ++k) { if (k == (c >> 4)) va = ts[0][k]; if (k == (c & 15)) vb = ts[1][k]; }
      cs[r] = va + vb; }
    float top[16]; int tix[16];
#pragma unroll
    for (int k = 0; k < 16; ++k) { const float mx = wave_max(fmaxf(fmaxf(cs[0], cs[1]), fmaxf(cs[2], cs[3]))); int cand = 9999;
#pragma unroll
      for (int r = 3; r >= 0; --r) if (cs[r] == mx) cand = lane * 4 + r;
      for (int o = 32; o >= 1; o >>= 1) cand = min(cand, __shfl_xor(cand, o));
      top[k] = mx; tix[k] = cand;
#pragma unroll
      for (int r = 0; r < 4; ++r) if (cand == lane * 4 + r) cs[r] = -INFINITY; }
    float sum = 0.f;
#pragma unroll
    for (int k = 0; k < 16; ++k) sum += __expf(top[k] - top[0]);
    if (lane < 16) { float tv = 0.f; int tc = 0;
#pragma unroll
      for (int k = 0; k < 16; ++k) if (k == lane) { tv = top[k]; tc = tix[k]; }
      int ia = 0, ib = 0;
#pragma unroll
      for (int k = 0; k < 16; ++k) { if (k == (tc >> 4)) ia = ti[0][k]; if (k == (tc & 15)) ib = ti[1][k]; }
      p.pidx[((size_t)t * 8 + h) * 16 + lane] = (bf16_t)(ia * 128 + ib); p.pgate[((size_t)t * 8 + h) * 16 + lane] = __expf(tv - top[0]) / sum; }
  }
}

namespace sel {
typedef short bf16x8 __attribute__((ext_vector_type(8)));
typedef float f32x16 __attribute__((ext_vector_type(16)));
constexpr int RS = 272, OFF_W = 2 * 128 * RS, WB = 3 * 16 * 32 * 4;
static_assert(OFF_W + 8 * WB <= SMEM_BYTES, "select LDS layout");
constexpr float NEG = -3.0e38f;
__device__ __forceinline__ float max3(float a, float b, float c) { return fmaxf(fmaxf(a, b), c); }
__device__ __forceinline__ float xhalf(float v) { return __shfl_xor(v, 32); }

__device__ void phase_peer_select(const Params& p, int layer, char* smem) {
  const int tid0 = threadIdx.x;
  __syncthreads();
  { const bf16_t* kb = p.keysb + (size_t)layer * 32768;
    for (int i = tid0; i < 2 * 128 * 16; i += NTHREADS) { const int row = i >> 4, ch = i & 15; *(u32x4*)(smem + row * RS + ch * 16) = *(const u32x4*)(kb + (size_t)row * 128 + ch * 8); } }
  __syncthreads();
  for (int job = blockIdx.x; job < T / 32; job += gridDim.x) {
    int tid_ = threadIdx.x; asm volatile("" : "+v"(tid_));
    const int tid = tid_, wid = tid >> 6, lane = tid & 63, l31 = lane & 31, hh = lane >> 5, h = wid;
    const int t = job * 32 + l31;
    float* const wl = (float*)(smem + OFF_W + wid * WB);
    float rs[2];
#pragma unroll
    for (int pp = 0; pp < 2; ++pp) {
      const bf16_t* qrow = p.QP + (size_t)t * 2048 + h * 256 + pp * 128 + hh * 8;
      bf16x8 bq[8]; float ssq = 0.f;
#pragma unroll
      for (int ks = 0; ks < 8; ++ks) { const u32x4 w = *(const u32x4*)(qrow + ks * 16); bq[ks] = __builtin_bit_cast(bf16x8, w);
        const u32 w0 = w.x, w1 = w.y, w2 = w.z, w3 = w.w; ssq = dot2bf(w0, w0, ssq); ssq = dot2bf(w1, w1, ssq); ssq = dot2bf(w2, w2, ssq); ssq = dot2bf(w3, w3, ssq); }
      ssq += xhalf(ssq); rs[pp] = rsqrtf(ssq * (1.f / 128.f) + EPS);
      f32x16 X[4];
#pragma unroll
      for (int nt = 0; nt < 4; ++nt) {
#pragma unroll
        for (int r = 0; r < 16; ++r) X[nt][r] = 0.f;
        const char* ka = smem + (pp * 128 + nt * 32 + l31) * RS + hh * 16;
#pragma unroll
        for (int ks = 0; ks < 8; ++ks) X[nt] = __builtin_amdgcn_mfma_f32_32x32x16_bf16(*(const bf16x8*)(ka + ks * 32), bq[ks], X[nt], 0, 0, 0); }
#pragma unroll
      for (int nt = 0; nt < 4; ++nt)
#pragma unroll
        for (int r = 0; r < 16; ++r) X[nt][r] = __uint_as_float((__float_as_uint(X[nt][r]) & ~0x7Fu) | (u32)(nt * 32 + (r & 3) + 8 * (r >> 2)) | ((u32)hh << 2));
#pragma unroll 1
      for (int k = 0; k < 16; ++k) {
        float m = NEG;
#pragma unroll
        for (int nt = 0; nt < 4; ++nt)
#pragma unroll
          for (int r = 0; r < 16; r += 2) m = max3(m, X[nt][r], X[nt][r + 1]);
        const float M = fmaxf(m, xhalf(m));
        wl[(pp * 16 + k) * 32 + l31] = M;
#pragma unroll
        for (int nt = 0; nt < 4; ++nt)
#pragma unroll
          for (int r = 0; r < 16; ++r) X[nt][r] = (X[nt][r] == M) ? NEG : X[nt][r];
      }
    }
    float s1[16], s2[16];
#pragma unroll
    for (int k = 0; k < 16; ++k) { s1[k] = wl[k * 32 + l31] * rs[0]; s2[k] = wl[(16 + k) * 32 + l31] * rs[1]; }
    constexpr int A0[25] = {0, 0, 0, 0, 0, 0, 0, 0, 0, 0, 0, 0, 0, 0, 0, 0, 2, 2, 2, 2, 2, 3, 3, 3, 3}, B0[25] = {0, 1, 2, 3, 4, 5, 6, 7, 8, 9, 10, 11, 12, 13, 14, 15, 0, 1, 2, 3, 4, 0, 1, 2, 3};
    constexpr int A1[25] = {1, 1, 1, 1, 1, 1, 1, 1, 4, 4, 4, 5, 5, 6, 6, 7, 7, 8, 9, 10, 11, 12, 13, 14, 15}, B1[25] = {0, 1, 2, 3, 4, 5, 6, 7, 0, 1, 2, 0, 1, 0, 1, 0, 1, 0, 0, 0, 0, 0, 0, 0, 0};
    float cd[25];
#pragma unroll
    for (int i = 0; i < 25; ++i) { const float v0 = s1[A0[i]] + s2[B0[i]], v1 = s1[A1[i]] + s2[B1[i]]; const float v = hh ? v1 : v0; const u32 cid = hh ? (u32)(A1[i] * 16 + B1[i]) : (u32)(A0[i] * 16 + B0[i]);
      cd[i] = __uint_as_float((__float_as_uint(v) & ~0xFFu) | cid); }
#pragma unroll 1
    for (int k = 0; k < 16; ++k) {
      float m = cd[24];
#pragma unroll
      for (int i = 0; i < 24; i += 2) m = max3(m, cd[i], cd[i + 1]);
      const float M = fmaxf(m, xhalf(m));
      wl[(32 + k) * 32 + l31] = M;
#pragma unroll
      for (int i = 0; i < 25; ++i) cd[i] = (cd[i] == M) ? NEG : cd[i];
    }
    float tv[16];
#pragma unroll
    for (int k = 0; k < 16; ++k) tv[k] = wl[(32 + k) * 32 + l31];
    float sum = 0.f;
#pragma unroll
    for (int k = 0; k < 16; ++k) sum += __expf(tv[k] - tv[0]);
    const float inv = 1.f / sum;
    u32 ev[8]; float go[8];
#pragma unroll
    for (int q = 0; q < 8; ++q) { const float v = wl[(32 + hh * 8 + q) * 32 + l31]; const u32 cid = __float_as_uint(v) & 0xFFu;
      const u32 i1 = __float_as_uint(wl[(cid >> 4) * 32 + l31]) & 0x7Fu, i2 = __float_as_uint(wl[(16 + (cid & 15)) * 32 + l31]) & 0x7Fu; ev[q] = i1 * 128 + i2;
      go[q] = __expf(v - tv[0]) * inv; }
    const u32 io0 = ev[0] | (ev[1] << 16), io1 = ev[2] | (ev[3] << 16), io2 = ev[4] | (ev[5] << 16), io3 = ev[6] | (ev[7] << 16);
    const size_t ob = ((size_t)t * 8 + h) * 16 + hh * 8;
    *(u32x4*)(p.pidx + ob) = (u32x4){io0, io1, io2, io3};
    *(f32x4*)(p.pgate + ob) = (f32x4){go[0], go[1], go[2], go[3]}; *(f32x4*)(p.pgate + ob + 4) = (f32x4){go[4], go[5], go[6], go[7]};
  }
}
}

typedef float f32x2 __attribute__((ext_vector_type(2)));
constexpr float U8_SCALE = 32.f, V8_SCALE = 2.f;
constexpr int GT = 4;
constexpr int GW_WAVE_BYTES = GT * (2048 + 128 * 2 + 128 * 4);
static_assert(8 * GW_WAVE_BYTES <= SMEM_BYTES - 16, "gather LDS layout");
__device__ __forceinline__ float gelu_erf(float z) { return 0.5f * z * (1.f + erff(z * 0.70710678118654752f)); }
__device__ __forceinline__ float reduce8(float d0, float d1, float d2, float d3, float d4, float d5, float d6, float d7, int lane) {
  float e[4];
  { auto r0 = __builtin_amdgcn_permlane32_swap(__float_as_uint(d0), __float_as_uint(d4), false, false); e[0] = __uint_as_float(r0[0]) + __uint_as_float(r0[1]);
    auto r1 = __builtin_amdgcn_permlane32_swap(__float_as_uint(d1), __float_as_uint(d5), false, false); e[1] = __uint_as_float(r1[0]) + __uint_as_float(r1[1]);
    auto r2 = __builtin_amdgcn_permlane32_swap(__float_as_uint(d2), __float_as_uint(d6), false, false); e[2] = __uint_as_float(r2[0]) + __uint_as_float(r2[1]);
    auto r3 = __builtin_amdgcn_permlane32_swap(__float_as_uint(d3), __float_as_uint(d7), false, false); e[3] = __uint_as_float(r3[0]) + __uint_as_float(r3[1]); }
  float f0, f1;
  { auto r0 = __builtin_amdgcn_permlane16_swap(__float_as_uint(e[0]), __float_as_uint(e[2]), false, false); f0 = __uint_as_float(r0[0]) + __uint_as_float(r0[1]);
    auto r1 = __builtin_amdgcn_permlane16_swap(__float_as_uint(e[1]), __float_as_uint(e[3]), false, false); f1 = __uint_as_float(r1[0]) + __uint_as_float(r1[1]); }
  const bool up = (lane & 8) != 0; const float keep = up ? f1 : f0, send = up ? f0 : f1;
  float g = keep + __shfl_xor(send, 8);
  g += __shfl_xor(g, 4); g += __shfl_xor(g, 2); g += __shfl_xor(g, 1);
  return g;
}
template <int NEXT>
__device__ void phase_peer_gather(const Params& p, int layer, char* smem) {
  const unsigned char* U8 = p.U8 + (size_t)layer * 16384 * 1024; const unsigned char* V8 = p.V8 + (size_t)layer * 16384 * 1024;
  for (int job = blockIdx.x; job < T / (8 * GT); job += gridDim.x) {
    int tid_ = threadIdx.x; asm volatile("" : "+v"(tid_));
    const int tid = tid_, wid = tid >> 6, lane = tid & 63;
    const int tb = (job * 8 + wid) * GT;
    const int vidx = 4 * (lane >> 5) + 2 * ((lane >> 4) & 1) + ((lane >> 3) & 1);
    char* wl = smem + wid * GW_WAVE_BYTES; bf16_t* sx = (bf16_t*)wl; bf16_t* sidx = (bf16_t*)(wl + GT * 2048); float* sgate = (float*)(wl + GT * 2048 + GT * 256);
#pragma unroll 1
    for (int g = 0; g < GT; ++g) { const size_t t = (size_t)(tb + g);
      *(u32x4*)(sx + g * 1024 + lane * 16) = *(const u32x4*)(p.H + t * D + lane * 16); *(u32x4*)(sx + g * 1024 + lane * 16 + 8) = *(const u32x4*)(p.H + t * D + lane * 16 + 8);
      const int ia = p.pidx[t * 128 + lane], ib = p.pidx[t * 128 + 64 + lane]; const float ga = p.pgate[t * 128 + lane], gb = p.pgate[t * 128 + 64 + lane];
      const int wa = ia >> 10, wb = ib >> 10; int off = 0, pa = 0, pb = 0;
#pragma unroll
      for (int w = 0; w < 16; ++w) { const unsigned long long m0 = __ballot(wa == w), m1 = __ballot(wb == w); const int c0 = __popcll(m0), c1 = __popcll(m1);
        const int r0 = __builtin_amdgcn_mbcnt_hi((unsigned)(m0 >> 32), __builtin_amdgcn_mbcnt_lo((unsigned)m0, 0)), r1 = __builtin_amdgcn_mbcnt_hi((unsigned)(m1 >> 32), __builtin_amdgcn_mbcnt_lo((unsigned)m1, 0));
        if (wa == w) pa = off + r0; if (wb == w) pb = off + c0 + r1; off += c0 + c1; }
      sidx[g * 128 + pa] = (bf16_t)ia; sgate[g * 128 + pa] = ga; sidx[g * 128 + pb] = (bf16_t)ib; sgate[g * 128 + pb] = gb; }
    f32x2 acc[GT][8];
#pragma unroll
    for (int g = 0; g < GT; ++g)
#pragma unroll
      for (int i = 0; i < 8; ++i) acc[g][i] = (f32x2){0.f, 0.f};
#pragma unroll 1
    for (int hb = 0; hb < 16; ++hb) {
#pragma unroll
      for (int g = 0; g < GT; ++g) {
        const int myidx = (int)sidx[g * 128 + hb * 8 + (lane & 7)]; const float mygate = sgate[g * 128 + hb * 8 + vidx];
        const u32x4 h0 = *(const u32x4*)(sx + g * 1024 + lane * 16), h1 = *(const u32x4*)(sx + g * 1024 + lane * 16 + 8);
        const u32 hx[8] = {h0.x, h0.y, h0.z, h0.w, h1.x, h1.y, h1.z, h1.w};
        u32x4 ur[8], vr[8];
#pragma unroll
        for (int k = 0; k < 8; ++k) { const int e = __builtin_amdgcn_readlane(myidx, k); ur[k] = *(const u32x4*)(U8 + (size_t)e * 1024 + lane * 16); if (k < 4) vr[k] = *(const u32x4*)(V8 + (size_t)e * 1024 + lane * 16); }
        float d[8];
#pragma unroll
        for (int k = 0; k < 8; ++k) { const u32 w[4] = {ur[k].x, ur[k].y, ur[k].z, ur[k].w}; float a = 0.f;
#pragma unroll
          for (int j = 0; j < 4; ++j) { const u32 lo = __builtin_bit_cast(u32, __builtin_amdgcn_cvt_scalef32_pk_bf16_fp8(w[j], 1.0f, false)), hi = __builtin_bit_cast(u32, __builtin_amdgcn_cvt_scalef32_pk_bf16_fp8(w[j], 1.0f, true));
            a = dot2bf(lo, hx[2 * j], a); a = dot2bf(hi, hx[2 * j + 1], a); }
          asm volatile("" : "+v"(a));
          d[k] = a; }
        asm volatile("" ::: "memory");
#pragma unroll
        for (int k = 4; k < 8; ++k) { const int e = __builtin_amdgcn_readlane(myidx, k); vr[k] = *(const u32x4*)(V8 + (size_t)e * 1024 + lane * 16); }
        const float z = reduce8(d[0], d[1], d[2], d[3], d[4], d[5], d[6], d[7], lane) * (1.f / U8_SCALE);
        const float cf = mygate * gelu_erf(z) * (1.f / V8_SCALE);
#pragma unroll
        for (int k = 0; k < 8; ++k) { const float ck = __uint_as_float(__builtin_amdgcn_readlane(__float_as_uint(cf), 32 * (k >> 2) + 16 * ((k >> 1) & 1) + 8 * (k & 1)));
          const u32 w[4] = {vr[k].x, vr[k].y, vr[k].z, vr[k].w}; const f32x2 c2 = (f32x2){ck, ck};
#pragma unroll
          for (int j = 0; j < 4; ++j) { const f32x2 lo = __builtin_amdgcn_cvt_pk_f32_fp8((int)w[j], false), hi = __builtin_amdgcn_cvt_pk_f32_fp8((int)w[j], true);
            acc[g][2 * j] = lo * c2 + acc[g][2 * j]; acc[g][2 * j + 1] = hi * c2 + acc[g][2 * j + 1]; } }
        asm volatile("" ::: "memory");
      }
      if ((hb & 3) == 3) __syncthreads();
    }
#pragma unroll
    for (int g = 0; g < GT; ++g) { const int t = tb + g, b = t / S;
      const float* g2 = p.mod + (size_t)(layer * 8 + b) * 6144 + 5120 + lane * 16; float* xp = p.X + (size_t)t * D + lane * 16;
      float xv[16]; float ss = 0.f;
#pragma unroll
      for (int q = 0; q < 4; ++q) { const f32x4 x0 = *(const f32x4*)(xp + 4 * q), g0 = *(const f32x4*)(g2 + 4 * q);
        xv[4 * q + 0] = x0.x + g0.x * acc[g][2 * q].x; xv[4 * q + 1] = x0.y + g0.y * acc[g][2 * q].y; xv[4 * q + 2] = x0.z + g0.z * acc[g][2 * q + 1].x; xv[4 * q + 3] = x0.w + g0.w * acc[g][2 * q + 1].y; }
#pragma unroll
      for (int i = 0; i < 16; ++i) ss += xv[i] * xv[i];
      ss = wave_sum(ss); const float r = rsqrtf(ss * (1.f / D) + EPS);
      if (NEXT == 0) {
        const float* ml = p.mod + (size_t)((layer + 1) * 8 + b) * 6144 + lane * 16; const float* gn = p.nmg + (layer + 1) * D + lane * 16; float y[16];
#pragma unroll
        for (int i = 0; i < 16; ++i) y[i] = xv[i] * r * gn[i] * (1.f + ml[1024 + i]) + ml[i];
#pragma unroll
        for (int q = 0; q < 4; ++q) *(f32x4*)(xp + 4 * q) = (f32x4){xv[4 * q], xv[4 * q + 1], xv[4 * q + 2], xv[4 * q + 3]};
        u32x4 w0, w1; w0.x = pack2(y[0], y[1]); w0.y = pack2(y[2], y[3]); w0.z = pack2(y[4], y[5]); w0.w = pack2(y[6], y[7]); w1.x = pack2(y[8], y[9]); w1.y = pack2(y[10], y[11]); w1.z = pack2(y[12], y[13]); w1.w = pack2(y[14], y[15]);
        *(u32x4*)(p.H + (size_t)t * D + lane * 16) = w0; *(u32x4*)(p.H + (size_t)t * D + lane * 16 + 8) = w1;
      } else {
        const float* fg = p.final_g + lane * 16;
#pragma unroll
        for (int q = 0; q < 4; ++q) *(f32x4*)(xp + 4 * q) = (f32x4){xv[4 * q] * r * fg[4 * q], xv[4 * q + 1] * r * fg[4 * q + 1], xv[4 * q + 2] * r * fg[4 * q + 2], xv[4 * q + 3] * r * fg[4 * q + 3]};
      }
      asm volatile("" ::: "memory");
    }
    __syncthreads();
  }
}

template <bool WITH_GATES>
__device__ void phase_norm(const Params& p, const float* __restrict__ xin, const float* __restrict__ g, const float* __restrict__ modl, int sh_off, int sc_off, char* smem) {
  float* wg = (float*)smem;
  if (WITH_GATES) { __syncthreads(); for (int i = threadIdx.x; i < 16 * 1024; i += NTHREADS) wg[i] = p.Wg[i]; __syncthreads(); }
  for (int job = blockIdx.x; job < T / 32; job += gridDim.x) {
    int tid_ = threadIdx.x; asm volatile("" : "+v"(tid_));
    const int tid = tid_, wid = tid >> 6, lane = tid & 63; const int tb = job * 32 + wid * 4, b = tb / S;
    f32x4 v[4][4];
#pragma unroll
    for (int q = 0; q < 4; ++q)
#pragma unroll
      for (int i = 0; i < 4; ++i) v[q][i] = *(const f32x4*)(xin + (size_t)(tb + q) * D + i * 256 + lane * 4);
    const float* shp = modl + (size_t)b * 6144 + sh_off; const float* scp = modl + (size_t)b * 6144 + sc_off;
    f32x4 ga[4], gc[4];
#pragma unroll
    for (int i = 0; i < 4; ++i) { const int d = i * 256 + lane * 4; const f32x4 gg = *(const f32x4*)(g + d), s1 = *(const f32x4*)(scp + d); ga[i] = gg * (1.f + s1); gc[i] = *(const f32x4*)(shp + d); }
#pragma unroll
    for (int q = 0; q < 4; ++q) { float ss = 0.f;
#pragma unroll
      for (int i = 0; i < 4; ++i) ss += v[q][i].x * v[q][i].x + v[q][i].y * v[q][i].y + v[q][i].z * v[q][i].z + v[q][i].w * v[q][i].w;
      ss = wave_sum(ss); const float r = rsqrtf(ss * (1.f / D) + EPS);
#pragma unroll
      for (int i = 0; i < 4; ++i) { v[q][i] = v[q][i] * r * ga[i] + gc[i]; u32x2 w; w.x = pack2(v[q][i].x, v[q][i].y); w.y = pack2(v[q][i].z, v[q][i].w); *(u32x2*)(p.H + (size_t)(tb + q) * D + i * 256 + lane * 4) = w; }
      if (WITH_GATES) { float myg = 0.f;
#pragma unroll 2
        for (int gi = 0; gi < 16; ++gi) { float a = 0.f;
#pragma unroll
          for (int i = 0; i < 4; ++i) { const f32x4 w4 = *(const f32x4*)(wg + gi * 1024 + i * 256 + lane * 4); a += v[q][i].x * w4.x + v[q][i].y * w4.y + v[q][i].z * w4.z + v[q][i].w * w4.w; }
          a = wave_sum(a); if (lane == gi) myg = a; }
        if (lane < 16) p.gates[(size_t)(tb + q) * 16 + lane] = myg + p.ev_b_in[2560 + lane]; }
    }
  }
}
__device__ void phase_cat(const Params& p) {
  for (int job = blockIdx.x; job < T / 32; job += gridDim.x) {
    int tid_ = threadIdx.x; asm volatile("" : "+v"(tid_));
    const int tid = tid_, wid = tid >> 6, lane = tid & 63; const int tb = job * 32 + wid * 4;
    u32x4 a[4], bq[4], so[4];
#pragma unroll
    for (int q = 0; q < 4; ++q) { const size_t o = (size_t)(tb + q) * 512 + lane * 8; a[q] = *(const u32x4*)(p.HS + o); bq[q] = *(const u32x4*)(p.HS + (size_t)T * 512 + o); so[q] = *(const u32x4*)(p.ZO + o); }
    const f32x4 g0 = *(const f32x4*)(p.mnorm_g + lane * 8), g1 = *(const f32x4*)(p.mnorm_g + lane * 8 + 4);
#pragma unroll
    for (int q = 0; q < 4; ++q) { float x[8]; const u32 aw[4] = {a[q].x, a[q].y, a[q].z, a[q].w}, bw[4] = {bq[q].x, bq[q].y, bq[q].z, bq[q].w}, sw[4] = {so[q].x, so[q].y, so[q].z, so[q].w};
      float ss = 0.f;
#pragma unroll
      for (int j = 0; j < 4; ++j) { x[2 * j] = bflo(aw[j]) + bflo(bw[j]); x[2 * j + 1] = bfhi(aw[j]) + bfhi(bw[j]); ss += x[2 * j] * x[2 * j] + x[2 * j + 1] * x[2 * j + 1]; }
      ss += __shfl_xor(ss, 1); ss += __shfl_xor(ss, 2); ss += __shfl_xor(ss, 4); ss += __shfl_xor(ss, 8);
      const float r = rsqrtf(ss * (1.f / 128.f) + EPS);
      u32x4 w; w.x = pack2(x[0] * r * g0.x * bflo(sw[0]), x[1] * r * g0.y * bfhi(sw[0])); w.y = pack2(x[2] * r * g0.z * bflo(sw[1]), x[3] * r * g0.w * bfhi(sw[1]));
      w.z = pack2(x[4] * r * g1.x * bflo(sw[2]), x[5] * r * g1.y * bfhi(sw[2])); w.w = pack2(x[6] * r * g1.z * bflo(sw[3]), x[7] * r * g1.w * bfhi(sw[3]));
      *(u32x4*)(p.CAT + (size_t)(tb + q) * 1024 + lane * 8) = w; }
  }
}
__device__ void phase_qkrope(const Params& p, char* smem) {
  float* tab = (float*)smem;
  __syncthreads();
  for (int i = threadIdx.x; i < 64 * 32; i += NTHREADS) { const int pos = i >> 5, fi = i & 31; const float fr = exp2f(-(float)(2 * fi) * (13.287712379549449f / 64.f)); float sn, cs; sincosf((float)pos * fr, &sn, &cs); tab[2 * i] = cs; tab[2 * i + 1] = sn; }
  __syncthreads();
  for (int job = blockIdx.x; job < T / 16; job += gridDim.x) {
    int tid_ = threadIdx.x; asm volatile("" : "+v"(tid_));
    const int tid = tid_, wid = tid >> 6, lane = tid & 63; const int tb = job * 16 + wid * 2;
    u32x4 raw[2][3];
#pragma unroll
    for (int q = 0; q < 2; ++q)
#pragma unroll
      for (int i = 0; i < 3; ++i) raw[q][i] = *(const u32x4*)(p.QKV + (size_t)(tb + q) * 1536 + (lane + 64 * i) * 8);
#pragma unroll
    for (int q = 0; q < 2; ++q) { const int t = tb + q, b = t / S, s = t & (S - 1);
#pragma unroll
      for (int i = 0; i < 3; ++i) { const int c = lane + 64 * i, hh = c >> 4, cc = c & 15; float x[8]; const u32 rw[4] = {raw[q][i].x, raw[q][i].y, raw[q][i].z, raw[q][i].w};
#pragma unroll
        for (int j = 0; j < 4; ++j) { x[2 * j] = bflo(rw[j]); x[2 * j + 1] = bfhi(rw[j]); }
        u32x4 w;
        if (hh < 10) { float ss = 0.f;
#pragma unroll
          for (int j = 0; j < 8; ++j) ss += x[j] * x[j];
          ss += __shfl_xor(ss, 1); ss += __shfl_xor(ss, 2); ss += __shfl_xor(ss, 4); ss += __shfl_xor(ss, 8);
          const float r = rsqrtf(ss * (1.f / 128.f) + EPS); const float* gp = (hh < 8 ? p.qn_g : p.kn_g) + cc * 8;
          const int pos = cc < 8 ? (s >> 6) : (s & 63); const float* tp = tab + (pos * 32 + (cc & 7) * 4) * 2; float y[8];
#pragma unroll
          for (int j = 0; j < 4; ++j) { const float x0 = x[2 * j] * r * gp[2 * j], x1 = x[2 * j + 1] * r * gp[2 * j + 1], cs = tp[2 * j], sn = tp[2 * j + 1]; y[2 * j] = x0 * cs - x1 * sn; y[2 * j + 1] = x0 * sn + x1 * cs; }
          w.x = pack2(y[0], y[1]); w.y = pack2(y[2], y[3]); w.z = pack2(y[4], y[5]); w.w = pack2(y[6], y[7]);
        } else w = raw[q][i];
        bf16_t* dst = hh < 8 ? p.Qh + (((size_t)b * 8 + hh) * S + s) * 128 : (hh < 10 ? p.Kh + (((size_t)b * 2 + hh - 8) * S + s) * 128 : p.Vh + (((size_t)b * 2 + hh - 10) * S + s) * 128);
        *(u32x4*)(dst + cc * 8) = w; }
    }
  }
}

__device__ void phase_attn_naive(const Params& p) {
  const int tid = threadIdx.x, wid = tid >> 6, lane = tid & 63;
  for (int job = blockIdx.x; job < T * 2 / 8; job += gridDim.x) {
    const int w = job * 8 + wid, kv = w & 1, t = w >> 1, b = t / S, s = t & (S - 1);
    float q0[4], q1[4], m[4], l[4], o0[4], o1[4];
#pragma unroll
    for (int g = 0; g < 4; ++g) { const u32 qq = *(const u32*)(p.Qh + (((size_t)b * 8 + kv * 4 + g) * S + s) * 128 + lane * 2); q0[g] = bflo(qq); q1[g] = bfhi(qq); m[g] = -1e30f; l[g] = 0.f; o0[g] = 0.f; o1[g] = 0.f; }
    const bf16_t* Kb = p.Kh + ((size_t)b * 2 + kv) * S * 128; const bf16_t* Vb = p.Vh + ((size_t)b * 2 + kv) * S * 128;
    for (int k = 0; k < S; ++k) { const u32 kk = *(const u32*)(Kb + (size_t)k * 128 + lane * 2), vv = *(const u32*)(Vb + (size_t)k * 128 + lane * 2);
      const float k0 = bflo(kk), k1 = bfhi(kk), v0 = bflo(vv), v1 = bfhi(vv);
#pragma unroll
      for (int g = 0; g < 4; ++g) { const float sc = wave_sum(q0[g] * k0 + q1[g] * k1) * KSCALE; const float mn = fmaxf(m[g], sc), al = __expf(m[g] - mn), pw = __expf(sc - mn);
        l[g] = l[g] * al + pw; o0[g] = o0[g] * al + pw * v0; o1[g] = o1[g] * al + pw * v1; m[g] = mn; } }
#pragma unroll
    for (int g = 0; g < 4; ++g) *(u32*)(p.CAT + (size_t)t * 1024 + (kv * 4 + g) * 128 + lane * 2) = pack2(o0[g] / l[g], o1[g] / l[g]);
  }
}

namespace att {
using bf16 = unsigned short;
constexpr int   D = 128, NW = 8, QBLK = 32, KVBLK = 64;
constexpr float SCALE = 0.088388347648318440f;
constexpr float THR = 8.f;
constexpr int SDEPTH = 2;
constexpr int LDQ = 128, LDK = 128, LDO = 1024;
constexpr size_t SHM_V = KVBLK * D * 2, SHM_K = KVBLK * D * 2, SHM_ATTN = 2 * SHM_V + 2 * SHM_K + NW * 64 * 4;
using bf16x8 = __attribute__((ext_vector_type(8))) short;
using s16x4  = __attribute__((ext_vector_type(4))) short;
using f32x16 = __attribute__((ext_vector_type(16))) float;
using f32x8  = __attribute__((ext_vector_type(8))) float;
using u32x4  = __attribute__((ext_vector_type(4))) unsigned;
#define KSWZ(row, colB) ((row) * 256 + ((colB) ^ (((row) & 7) << 4)))
#define SBAR() __builtin_amdgcn_sched_barrier(0)
__device__ __forceinline__ int crow(int r, int hi) { return (r & 3) + 8 * (r >> 2) + 4 * hi; }
__device__ __forceinline__ unsigned cvtpk(float lo, float hi) {
  unsigned r; asm volatile("v_cvt_pk_bf16_f32 %0, %1, %2" : "=v"(r) : "v"(lo), "v"(hi)); return r;
}
template <typename TIn> struct Stage;
template <> struct Stage<bf16>  { using T = bf16x8;
  __device__ static __forceinline__ T ld8(const bf16* p) { return *reinterpret_cast<const bf16x8*>(p); }
  __device__ static __forceinline__ bf16x8 tobf(T x) { return x; } };
template <> struct Stage<float> { using T = f32x8;
  __device__ static __forceinline__ T ld8(const float* p) { return *reinterpret_cast<const f32x8*>(p); }
  __device__ static __forceinline__ bf16x8 tobf(T x) {
    u32x4 w = {cvtpk(x[0], x[1]), cvtpk(x[2], x[3]), cvtpk(x[4], x[5]), cvtpk(x[6], x[7])}; return *reinterpret_cast<bf16x8*>(&w); } };

__device__ __forceinline__ void partialSM(f32x16& p0, f32x16& p1, float& m_reg, float& mn, float& alpha) {
  constexpr float C = SCALE * 1.4426950408889634f;
  float pmax = p0[0]; for (int r = 1; r < 16; ++r) pmax = fmaxf(pmax, p0[r]); for (int r = 0; r < 16; ++r) pmax = fmaxf(pmax, p1[r]);
  { auto rr = __builtin_amdgcn_permlane32_swap(__float_as_uint(pmax), __float_as_uint(pmax), false, false);
    pmax = fmaxf(__uint_as_float(rr[0]), __uint_as_float(rr[1])); }
  if (__builtin_expect(__all(pmax - m_reg <= THR / SCALE), 1)) { mn = m_reg; alpha = 1.f; }
  else { mn = fmaxf(m_reg, pmax); alpha = __builtin_amdgcn_exp2f((m_reg - mn) * C); m_reg = mn; }
  float mnC = -mn * C;
  for (int r = 0; r < 16; ++r) p0[r] = fmaf(p0[r], C, mnC); for (int r = 0; r < 16; ++r) p1[r] = fmaf(p1[r], C, mnC);
  for (int r = 0; r < 16; ++r) p0[r] = __builtin_amdgcn_exp2f(p0[r]);
}
__device__ __forceinline__ void finishSM(f32x16& p0, f32x16& p1, float alpha, float& l_reg, bf16x8& pa0, bf16x8& pa1, bf16x8& pa2, bf16x8& pa3) {
  for (int r = 0; r < 16; ++r) p1[r] = __builtin_amdgcn_exp2f(p1[r]);
  float ps = 0; for (int r = 0; r < 16; ++r) ps += p0[r]; for (int r = 0; r < 16; ++r) ps += p1[r];
  { auto rr = __builtin_amdgcn_permlane32_swap(__float_as_uint(ps), __float_as_uint(ps), false, false);
    ps = __uint_as_float(rr[0]) + __uint_as_float(rr[1]); }
  l_reg = l_reg * alpha + ps;
#define PK4(P, BASE, OUT) do { unsigned a0 = cvtpk(P[BASE + 0], P[BASE + 1]), a1 = cvtpk(P[BASE + 2], P[BASE + 3]);   \
    unsigned b0 = cvtpk(P[BASE + 4], P[BASE + 5]), b1 = cvtpk(P[BASE + 6], P[BASE + 7]);                              \
    auto r0 = __builtin_amdgcn_permlane32_swap(a0, b0, false, false); auto r1 = __builtin_amdgcn_permlane32_swap(a1, b1, false, false); \
    u32x4 w = {r0[0], r1[0], r0[1], r1[1]}; OUT = *reinterpret_cast<bf16x8*>(&w); } while (0)
  PK4(p0, 0, pa0); PK4(p0, 8, pa1); PK4(p1, 0, pa2); PK4(p1, 8, pa3);
#undef PK4
}
__device__ __forceinline__ void qkt(f32x16& p0, f32x16& p1, const bf16* Ks, const bf16x8* qr, int r32, int hi) {
  p0 = f32x16{}; p1 = f32x16{};
  for (int d0 = 0; d0 < 8; ++d0) { int cb = (d0 * 16 + hi * 8) * 2;
    bf16x8 b0 = *reinterpret_cast<const bf16x8*>((const char*)Ks + KSWZ(r32, cb));
    bf16x8 b1 = *reinterpret_cast<const bf16x8*>((const char*)Ks + KSWZ(32 + r32, cb));
    p0 = __builtin_amdgcn_mfma_f32_32x32x16_bf16(b0, qr[d0], p0, 0, 0, 0);
    p1 = __builtin_amdgcn_mfma_f32_32x32x16_bf16(b1, qr[d0], p1, 0, 0, 0); }
}
__device__ __forceinline__ int v_st(int k, int c) { const int kk = (k & ~0xC) | ((k & 4) << 1) | ((k & 8) >> 1); return ((kk >> 3) * 4 + (c >> 5)) * 512 + ((kk & 7) * 32 + (c & 31)) * 2; }
__device__ __forceinline__ int v_rd_base(int lane) { return ((lane & 3) << 3) | (((lane >> 2) & 3) << 6) | (((lane >> 4) & 1) << 5) | (((lane >> 5) & 1) << 8); }
constexpr int v_rd_off(int d0, int ks, int half) { return d0 * 512 + ks * 4096 + half * 2048; }
template <int OFF> __device__ __forceinline__ s16x4 tr_read(int vb) {
  s16x4 r; asm volatile("ds_read_b64_tr_b16 %0, %1 offset:%2" : "=&v"(r) : "v"(vb), "i"(OFF) : "memory"); return r;
}
template <int D0> __device__ __forceinline__ void pv_one(f32x16& od, int vb, bf16x8 pa0, bf16x8 pa1, bf16x8 pa2, bf16x8 pa3) {
  const s16x4 l0 = tr_read<v_rd_off(D0, 0, 0)>(vb), h0 = tr_read<v_rd_off(D0, 0, 1)>(vb), l1 = tr_read<v_rd_off(D0, 1, 0)>(vb), h1 = tr_read<v_rd_off(D0, 1, 1)>(vb);
  const s16x4 l2 = tr_read<v_rd_off(D0, 2, 0)>(vb), h2 = tr_read<v_rd_off(D0, 2, 1)>(vb), l3 = tr_read<v_rd_off(D0, 3, 0)>(vb), h3 = tr_read<v_rd_off(D0, 3, 1)>(vb);
  asm volatile("s_waitcnt lgkmcnt(0)" ::: "memory"); SBAR();
#define PK(L, H) (bf16x8){L[0], L[1], L[2], L[3], H[0], H[1], H[2], H[3]}
  od = __builtin_amdgcn_mfma_f32_32x32x16_bf16(pa0, PK(l0, h0), od, 0, 0, 0);
  od = __builtin_amdgcn_mfma_f32_32x32x16_bf16(pa1, PK(l1, h1), od, 0, 0, 0);
  od = __builtin_amdgcn_mfma_f32_32x32x16_bf16(pa2, PK(l2, h2), od, 0, 0, 0);
  od = __builtin_amdgcn_mfma_f32_32x32x16_bf16(pa3, PK(l3, h3), od, 0, 0, 0);
#undef PK
}
__device__ __forceinline__ void pv_d0(f32x16* o, int vb, bf16x8 pa0, bf16x8 pa1, bf16x8 pa2, bf16x8 pa3) {
  pv_one<0>(o[0], vb, pa0, pa1, pa2, pa3); pv_one<1>(o[1], vb, pa0, pa1, pa2, pa3); pv_one<2>(o[2], vb, pa0, pa1, pa2, pa3); pv_one<3>(o[3], vb, pa0, pa1, pa2, pa3);
}

template <typename TQ>
__device__ __forceinline__ void attn_dense_body(const TQ* __restrict__ Qb, const bf16* __restrict__ Kh, const bf16* __restrict__ Vh,
                                                bf16* __restrict__ Ob, int seq, char* lds) {
  using St = Stage<bf16>; using SQ = Stage<TQ>;
  int tid_ = threadIdx.x; asm volatile("" : "+v"(tid_)); const int tid = tid_, wid = tid >> 6, lane = tid & 63, r32 = lane & 31, hi = lane >> 5;
  bf16* V_lds = (bf16*)lds; bf16* K_lds = (bf16*)(lds + 2 * SHM_V);
  float* ws = (float*)(lds + 2 * SHM_V + 2 * SHM_K) + wid * 64; float* li_l = ws; float* al_l = ws + 32;
  float m_reg = -1e30f, l_reg = 0; f32x16 o[4] = {}; bf16x8 qr[8];
  const TQ* Qw = Qb + (long)(wid * QBLK + r32) * LDQ + hi * 8;
#pragma unroll
  for (int d0 = 0; d0 < 8; ++d0) qr[d0] = SQ::tobf(SQ::ld8(Qw + d0 * 16));
  const int sr = tid >> 4, sc = (tid & 15) * 8, vst0 = v_st(sr, sc), vst1 = v_st(32 + sr, sc);
  const int vb0 = (int)(uintptr_t)V_lds + v_rd_base(lane);
  struct { typename St::T vs0, vs1, ks0, ks1; } sr_[SDEPTH];
#define SLOAD(i, k0) do { sr_[i].vs0 = St::ld8(&Vh[(long)((k0) + sr) * LDK + sc]); sr_[i].vs1 = St::ld8(&Vh[(long)((k0) + 32 + sr) * LDK + sc]); \
    sr_[i].ks0 = St::ld8(&Kh[(long)((k0) + sr) * LDK + sc]); sr_[i].ks1 = St::ld8(&Kh[(long)((k0) + 32 + sr) * LDK + sc]); } while (0)
#define SWRITE(b, i) do { *(bf16x8*)((char*)V_lds + (b) * SHM_V + vst0) = St::tobf(sr_[i].vs0);          \
    *(bf16x8*)((char*)V_lds + (b) * SHM_V + vst1) = St::tobf(sr_[i].vs1); int kc = sc * 2;               \
    *(bf16x8*)((char*)K_lds + (b) * SHM_K + KSWZ(sr, kc)) = St::tobf(sr_[i].ks0);                       \
    *(bf16x8*)((char*)K_lds + (b) * SHM_K + KSWZ(32 + sr, kc)) = St::tobf(sr_[i].ks1); } while (0)
#define SWAIT() do { if constexpr (SDEPTH == 2) asm volatile("s_waitcnt vmcnt(4)" ::: "memory"); else asm volatile("s_waitcnt vmcnt(0)" ::: "memory"); } while (0)
#define RESC(a) do { if (__any((a) < 1.f)) { if (hi == 0) al_l[r32] = (a); asm volatile("s_waitcnt lgkmcnt(0)" ::: "memory"); \
    for (int d = 0; d < 4; ++d) for (int r = 0; r < 16; ++r) o[d][r] *= al_l[crow(r, hi)]; } } while (0)
  f32x16 pA0, pA1, pB0, pB1; float mnA, mnB, alA, alB; bf16x8 pa0, pa1, pa2, pa3; const int NT = seq / KVBLK;
  constexpr int SE = 0, SO = SDEPTH - 1;
  SLOAD(SE, 0); asm volatile("s_waitcnt vmcnt(0)" ::: "memory"); SWRITE(0, SE); __syncthreads();
  qkt(pA0, pA1, K_lds, qr, r32, hi); partialSM(pA0, pA1, m_reg, mnA, alA);
  SLOAD(SO, KVBLK); if constexpr (SDEPTH == 2) { if (2 < NT) SLOAD(SE, 2 * KVBLK); }
  SWAIT(); SWRITE(1, SO); __syncthreads();
  for (int j = 1; j + 1 < NT; j += 2) {
    SBAR(); qkt(pB0, pB1, (bf16*)((char*)K_lds + SHM_K), qr, r32, hi);
    finishSM(pA0, pA1, alA, l_reg, pa0, pa1, pa2, pa3); SBAR();
    SLOAD(SO, (j + SDEPTH) * KVBLK); SBAR();
    pv_d0(o, vb0, pa0, pa1, pa2, pa3); partialSM(pB0, pB1, m_reg, mnB, alB);
    __syncthreads(); SWAIT(); SWRITE(0, SE);
    RESC(alB); __syncthreads();
    SBAR(); qkt(pA0, pA1, K_lds, qr, r32, hi);
    finishSM(pB0, pB1, alB, l_reg, pa0, pa1, pa2, pa3); SBAR();
    if (SDEPTH == 1 || j + 3 < NT) SLOAD(SE, (j + 1 + SDEPTH) * KVBLK); SBAR();
    pv_d0(o, vb0 + (int)SHM_V, pa0, pa1, pa2, pa3); partialSM(pA0, pA1, m_reg, mnA, alA);
    __syncthreads(); SWAIT(); SWRITE(1, SO);
    RESC(alA); __syncthreads();
  }
  SBAR(); qkt(pB0, pB1, (bf16*)((char*)K_lds + SHM_K), qr, r32, hi);
  finishSM(pA0, pA1, alA, l_reg, pa0, pa1, pa2, pa3); SBAR();
  pv_d0(o, vb0, pa0, pa1, pa2, pa3); partialSM(pB0, pB1, m_reg, mnB, alB);
  __syncthreads(); RESC(alB);
  finishSM(pB0, pB1, alB, l_reg, pa0, pa1, pa2, pa3); SBAR();
  pv_d0(o, vb0 + (int)SHM_V, pa0, pa1, pa2, pa3);
  if (hi == 0) li_l[r32] = l_reg; asm volatile("s_waitcnt lgkmcnt(0)" ::: "memory");
  float rli[16];
#pragma unroll
  for (int r = 0; r < 16; ++r) rli[r] = __builtin_amdgcn_rcpf(li_l[crow(r, hi)]);
  __syncthreads();
  bf16* Ol = (bf16*)lds + wid * (QBLK * D);
#pragma unroll
  for (int r = 0; r < 16; ++r) { const int orow = crow(r, hi);
#pragma unroll
    for (int d0 = 0; d0 < 4; ++d0) { const float v = o[d0][r] * rli[r]; unsigned u = __float_as_uint(v); u += 0x7FFFu + ((u >> 16) & 1u); Ol[orow * D + d0 * 32 + r32] = (bf16)(u >> 16); } }
  asm volatile("s_waitcnt lgkmcnt(0)" ::: "memory");
#pragma unroll
  for (int i = 0; i < 8; ++i) { const int row = i * 4 + (lane >> 4), ch = (lane & 15) * 8;
    const u32x4 v = *reinterpret_cast<const u32x4*>(Ol + row * D + ch);
    *reinterpret_cast<u32x4*>(Ob + (long)(wid * QBLK + row) * LDO + ch) = v; }
  __syncthreads();
#undef SLOAD
#undef SWRITE
#undef SWAIT
#undef RESC
}

}

__device__ void phase_attn(const Params& p, char* smem) {
  const int G = (int)gridDim.x, c = (int)blockIdx.x;
  for (int i = 0; i * G + c < 1024; ++i) {
    int pair, j;
    if (G == 256) { pair = 2 * (c & 7) + (i >> 1); j = (i & 1) * 32 + (c >> 3); } else { const int L = i * G + c; pair = L >> 6; j = L & 63; }
    const int b = pair >> 1, kv = pair & 1, qb = j >> 2, g = j & 3, h = kv * 4 + g;
    const bf16_t* Qb = p.Qh + (((size_t)b * 8 + h) * S + qb * 256) * 128; const bf16_t* Kp = p.Kh + ((size_t)b * 2 + kv) * S * 128; const bf16_t* Vp = p.Vh + ((size_t)b * 2 + kv) * S * 128;
    bf16_t* Ob = p.CAT + ((size_t)b * S + qb * 256) * 1024 + h * 128;
    att::attn_dense_body<att::bf16>(Qb, Kp, Vp, Ob, S, smem);
  }
}

#define XB_TMO      128
#define XB_XCNT(j)  (256  + 64 * (j))
#define XB_XSUB(j)  (1280 + 64 * (j))
#define XB_XGEN(j)  (2304 + 64 * (j))
#define XB_TOP      3328
#define XB_TOPGEN   3392
#define XCD_BAR_WORDS 3456
#define XB_SPIN_CAP (1u << 18)
#define LAS __attribute__((address_space(3)))

__device__ __forceinline__ unsigned xb_ld(unsigned* p)              { return __hip_atomic_load(p, __ATOMIC_RELAXED, __HIP_MEMORY_SCOPE_AGENT); }
__device__ __forceinline__ unsigned xb_add(unsigned* p, unsigned v) { return __hip_atomic_fetch_add(p, v, __ATOMIC_RELAXED, __HIP_MEMORY_SCOPE_AGENT); }
__device__ __forceinline__ unsigned xb_xcc_id() { return (unsigned)__builtin_amdgcn_s_getreg((3 << 11) | 20) & 0xFu; }
#define XB_SPIN(cond, bar) do { unsigned _sp = 0; while (cond) { __builtin_amdgcn_s_sleep(1); \
    if ((++_sp & 255u) == 0u) { if (xb_ld(&(bar)[XB_TMO])) break; if (_sp > XB_SPIN_CAP) { atomicAdd(&(bar)[XB_TMO], 1u); break; } } } } while (0)

struct XcdBarrier {
    unsigned* bar; unsigned x;
    volatile LAS unsigned* st;
};

__device__ __forceinline__ XcdBarrier xcd_barrier_post(unsigned* bar, volatile LAS unsigned* st) {
    XcdBarrier b; b.bar = bar; b.x = xb_xcc_id(); b.st = st;
    if (threadIdx.x == 0) (void)xb_add(&bar[XB_XCNT(b.x)], 1u);
    return b;
}
__device__ __forceinline__ void xcd_barrier_complete(unsigned* bar, unsigned x, unsigned& nloc, unsigned& nx) {
    const unsigned G = gridDim.x * gridDim.y * gridDim.z;
    unsigned sum, cnt, mine, sp = 0u;
    for (;;) {
        sum = 0u; cnt = 0u; mine = 0u;
#pragma unroll
        for (unsigned j = 0; j < 16; ++j) { const unsigned c = xb_ld(&bar[XB_XCNT(j)]); sum += c; cnt += (c > 0u) ? 1u : 0u; mine = (j == x) ? c : mine; }
        if (sum == G) break;
        __builtin_amdgcn_s_sleep(1);
        if ((++sp & 255u) == 0u) { if (xb_ld(&bar[XB_TMO])) break; if (sp > XB_SPIN_CAP) { atomicAdd(&bar[XB_TMO], 1u); break; } }
    }
    nloc = mine > 0u ? mine : 1u; nx = cnt > 0u ? cnt : 1u;
}

__device__ __forceinline__ void xcd_barrier(const XcdBarrier& b) {
    asm volatile("s_waitcnt vmcnt(0)" ::: "memory");
    __syncthreads();
    if (threadIdx.x == 0) {
        unsigned* bar = b.bar;
        __builtin_amdgcn_s_waitcnt(0);
        unsigned nloc = b.st[0], nx = b.st[1];
        if (nloc == 0u) { xcd_barrier_complete(bar, b.x, nloc, nx); b.st[0] = nloc; b.st[1] = nx; }
        const unsigned old = xb_add(&bar[XB_XSUB(b.x)], 1u);
        const unsigned gen = old / nloc;
        if (old + 1u == (gen + 1u) * nloc) {
            __builtin_amdgcn_fence(__ATOMIC_RELEASE, "agent");
            asm volatile("s_waitcnt vmcnt(0)" ::: "memory");
            const unsigned og = xb_add(&bar[XB_TOP], 1u);
            const unsigned tg = og / nx;
            if (og + 1u == (tg + 1u) * nx) xb_add(&bar[XB_TOPGEN], 1u);
            else XB_SPIN(xb_ld(&bar[XB_TOPGEN]) == tg, bar);
            __builtin_amdgcn_fence(__ATOMIC_ACQUIRE, "agent");
            xb_add(&bar[XB_XGEN(b.x)], 1u);
            asm volatile("s_waitcnt vmcnt(0)" ::: "memory");
        } else {
            XB_SPIN(xb_ld(&bar[XB_XGEN(b.x)]) == gen, bar);
            __builtin_amdgcn_fence(__ATOMIC_ACQUIRE, "agent");
            asm volatile("s_waitcnt vmcnt(0)" ::: "memory");
        }
    }
    __syncthreads();
}


constexpr int NPH = 19;
__global__ __launch_bounds__(NTHREADS, 2) void mega(Params p, int ph0, int ph1) {
  extern __shared__ __attribute__((aligned(16))) char smem[];
  cg::grid_group grid = cg::this_grid();
  volatile LAS unsigned* xst = (volatile LAS unsigned*)(LAS char*)(smem + SMEM_BYTES - 16);
  if (threadIdx.x == 0) { xst[0] = 0u; xst[1] = 0u; }
  __syncthreads();
  const XcdBarrier xb = xcd_barrier_post(p.bar, xst);
#ifndef REP_MASK
#define REP_MASK 0
#endif
#define GSYNC(k) do { if ((k) == 1) grid.sync(); else xcd_barrier(xb); } while (0)
#define PHASE(k, call) if (ph0 <= (k) && (k) < ph1) { if ((k) > ph0) GSYNC(k); if ((REP_MASK >> (k)) & 1) { { call; } xcd_barrier(xb); } call; }
#if !defined(ONLY_PHASE) || ONLY_PHASE == 0
  PHASE(0, phase_prep(p, smem))
#endif
#if !defined(ONLY_PHASE) || ONLY_PHASE == 1
  PHASE(1, phase_norm<true>(p, p.x, p.nmg, p.mod, 0, 1024, smem))
#endif
#if !defined(ONLY_PHASE) || ONLY_PHASE == 2
  PHASE(2, phase_gemm_fast(p.H, p.Wt_evin, T, 2560, 1024, (EpiEvin{p.ZQK, p.ZV, p.ZO, p.ZP, p.ev_b_in}), smem))
#endif
#if !defined(ONLY_PHASE) || ONLY_PHASE == 3
  PHASE(3, cp::phase_convpool(p, smem))
#endif
#if !defined(ONLY_PHASE) || ONLY_PHASE == 4
  PHASE(4, ml::phase_mlstm(p, smem))
#endif
#if !defined(ONLY_PHASE) || ONLY_PHASE == 5
  PHASE(5, phase_cat(p))
#endif
#if !defined(ONLY_PHASE) || ONLY_PHASE == 6
  PHASE(6, phase_gemm_fast(p.CAT, p.Wt_evout, T, 1024, 1024, (EpiRes{p.x, p.X, p.mod + 2048}), smem))
#endif
#if !defined(ONLY_PHASE) || ONLY_PHASE == 7
  PHASE(7, phase_norm<false>(p, p.X, p.nfg, p.mod, 3072, 4096, smem))
#endif
#if !defined(ONLY_PHASE) || ONLY_PHASE == 8
  PHASE(8, phase_gemm_fast(p.H, p.Wt_q, T, 2048, 1024, (EpiPlain{p.QP, 2048}), smem))
#endif
#if !defined(ONLY_PHASE) || ONLY_PHASE == 9
  PHASE(9, sel::phase_peer_select(p, 0, smem))
#endif
#if !defined(ONLY_PHASE) || ONLY_PHASE == 10
  PHASE(10, phase_peer_gather<0>(p, 0, smem))
#endif
#if !defined(ONLY_PHASE) || ONLY_PHASE == 11
  PHASE(11, phase_gemm_fast(p.H, p.Wt_odin, T, 1536, 1024, (EpiPlain{p.QKV, 1536}), smem))
#endif
#if !defined(ONLY_PHASE) || ONLY_PHASE == 12
  PHASE(12, phase_qkrope(p, smem))
#endif
#if !defined(ONLY_PHASE) || ONLY_PHASE == 13
  PHASE(13, phase_attn(p, smem))
#endif
#if !defined(ONLY_PHASE) || ONLY_PHASE == 14
  PHASE(14, phase_gemm_fast(p.CAT, p.Wt_odout, T, 1024, 1024, (EpiRes{p.X, p.X, p.mod + (size_t)8 * 6144 + 2048}), smem))
#endif
#if !defined(ONLY_PHASE) || ONLY_PHASE == 15
  PHASE(15, phase_norm<false>(p, p.X, p.nfg + D, p.mod + (size_t)8 * 6144, 3072, 4096, smem))
#endif
#if !defined(ONLY_PHASE) || ONLY_PHASE == 16
  PHASE(16, phase_gemm_fast(p.H, p.Wt_q + (size_t)2048 * 1024, T, 2048, 1024, (EpiPlain{p.QP, 2048}), smem))
#endif
#if !defined(ONLY_PHASE) || ONLY_PHASE == 17
  PHASE(17, sel::phase_peer_select(p, 1, smem))
#endif
#if !defined(ONLY_PHASE) || ONLY_PHASE == 18
  PHASE(18, phase_peer_gather<1>(p, 1, smem))
#endif
#undef PHASE
}
}

extern "C" void kernel_launch(void* const* d_in, const int* in_sizes, int n_in, void* d_out, int out_size, void* d_ws, size_t ws_size, hipStream_t stream) {
  (void)in_sizes; (void)n_in; (void)out_size;
  Params p{};
  const float** fin = (const float**)&p;
  for (int i = 0; i < 23; ++i) fin[i] = (const float*)d_in[i];
  p.X = (float*)d_out;
  char* ws = (char*)d_ws; size_t off = 0;
  auto alloc = [&](size_t bytes) { char* q = ws + off; off += (bytes + 255) / 256 * 256; return q; };
  p.U8 = (unsigned char*)alloc((size_t)2 * 16384 * 1024); p.V8 = (unsigned char*)alloc((size_t)2 * 16384 * 1024);
  p.Wt_evin = (bf16_t*)alloc((size_t)2560 * 1024 * 2); p.Wt_evout = (bf16_t*)alloc((size_t)1024 * 1024 * 2); p.Wt_odin = (bf16_t*)alloc((size_t)1536 * 1024 * 2);
  p.Wt_odout = (bf16_t*)alloc((size_t)1024 * 1024 * 2); p.Wt_q = (bf16_t*)alloc((size_t)2 * 2048 * 1024 * 2); p.keysb = (bf16_t*)alloc((size_t)2 * 2 * 128 * 128 * 2); p.poolWt = (bf16_t*)alloc((size_t)4 * 128 * 128 * 2);
  p.Wg = (float*)alloc(16 * 1024 * 4); p.mod = (float*)alloc(2 * 8 * 6144 * 4); p.gates = (float*)alloc((size_t)T * 16 * 4);
  p.pgate = (float*)alloc((size_t)T * 128 * 4); p.pidx = (bf16_t*)alloc((size_t)T * 128 * 2);
  p.H = (bf16_t*)alloc((size_t)T * 1024 * 2); p.CAT = p.H;
  char* big = alloc((size_t)T * 2048 * 2);
  p.ZQK = (bf16_t*)big; p.ZV = (bf16_t*)(big + (size_t)T * 1024 * 2); p.ZO = (bf16_t*)(big + (size_t)T * 1536 * 2); p.HS = (bf16_t*)big; p.QP = (bf16_t*)big; p.QKV = (bf16_t*)big;
  char* big2 = alloc((size_t)T * 1536 * 2);
  p.QK = (bf16_t*)big2; p.ZP = (bf16_t*)(big2 + (size_t)T * 1024 * 2); p.Qh = (bf16_t*)big2; p.Kh = (bf16_t*)(big2 + (size_t)T * 1024 * 2); p.Vh = (bf16_t*)(big2 + (size_t)T * 1280 * 2);
  p.bar = (unsigned*)alloc(XCD_BAR_WORDS * 4);
  if (off > ws_size) { fprintf(stderr, "kernel_launch: workspace too small: need %zu have %zu\n", off, ws_size); return; }

  static int grid_blocks = 0;
  if (!grid_blocks) {
    int dev = 0, cus = 0, per_cu = 0; hipGetDevice(&dev); hipDeviceGetAttribute(&cus, hipDeviceAttributeMultiprocessorCount, dev);
    hipFuncSetAttribute((const void*)mega, hipFuncAttributeMaxDynamicSharedMemorySize, SMEM_BYTES);
    hipOccupancyMaxActiveBlocksPerMultiprocessor(&per_cu, mega, NTHREADS, SMEM_BYTES);
    if (per_cu > 1) per_cu = 1;
    grid_blocks = cus * per_cu;
    if (grid_blocks <= 0) { fprintf(stderr, "kernel_launch: occupancy query returned 0\n"); grid_blocks = 0; return; }
  }
  hipMemsetAsync(p.bar, 0, XCD_BAR_WORDS * 4, stream);
#if MULTI_LAUNCH
  for (int ph = 0; ph < NPH; ++ph) hipLaunchKernelGGL(mega, dim3(grid_blocks), dim3(NTHREADS), SMEM_BYTES, stream, p, ph, ph + 1);
#else
  int ph0 = 0, ph1 = NPH; void* args[] = {&p, &ph0, &ph1};
  hipError_t e = hipLaunchCooperativeKernel((const void*)mega, dim3(grid_blocks), dim3(NTHREADS), args, SMEM_BYTES, stream);
  if (e != hipSuccess) fprintf(stderr, "cooperative launch failed: %s (grid %d)\n", hipGetErrorString(e), grid_blocks);
#endif
}
```

```cpp
#include <hip/hip_runtime.h>
#include <hip/hip_cooperative_groups.h>
#include <math.h>
#include <stdint.h>
#include <stdio.h>
namespace cg = cooperative_groups;

#ifndef MULTI_LAUNCH
#define MULTI_LAUNCH 0
#endif

namespace {
typedef unsigned short bf16_t;
typedef unsigned int u32;
typedef float f32x4 __attribute__((ext_vector_type(4)));
typedef u32 u32x4 __attribute__((ext_vector_type(4)));
typedef u32 u32x2 __attribute__((ext_vector_type(2)));
typedef __bf16 bf16x2_t __attribute__((ext_vector_type(2)));

constexpr int D = 1024, NB = 8, S = 4096, T = NB * S;
constexpr int EVEN_IN = 2576;
constexpr float EPS = 1e-6f;
constexpr int NTHREADS = 512;
constexpr int SMEM_BYTES = 144 * 1024;
constexpr float KSCALE = 0.08838834764831845f;

struct Params {
  const float *x, *c, *ada_w, *ada_b, *nmg, *nfg, *ev_w_in, *ev_b_in, *conv_w, *conv_b, *mnorm_g, *pool_w, *pool_sc, *ev_w_out, *od_w_in, *qn_g, *kn_g, *od_w_out,
      *peer_wq, *peer_keys, *peer_u, *peer_v, *final_g;
  float* X;
  bf16_t *Wt_evin, *Wt_evout, *Wt_odin, *Wt_odout, *Wt_q, *keysb, *poolWt; unsigned char *U8, *V8;
  float *Wg, *mod, *gates, *pgate;
  bf16_t *H, *ZQK, *ZV, *ZO, *ZP, *QK, *HS, *CAT, *QP, *QKV, *Qh, *Kh, *Vh;
  bf16_t* pidx;
  unsigned* bar;
};

__device__ __forceinline__ float siluf(float x) { return x / (1.f + __expf(-x)); }
__device__ __forceinline__ float sigmf(float x) { return 1.f / (1.f + __expf(-x)); }
__device__ __forceinline__ float wave_sum(float v) { for (int o = 32; o >= 1; o >>= 1) v += __shfl_xor(v, o); return v; }
__device__ __forceinline__ float wave_max(float v) { for (int o = 32; o >= 1; o >>= 1) v = fmaxf(v, __shfl_xor(v, o)); return v; }
__device__ __forceinline__ bf16_t f2bf(float f) { u32 u = __float_as_uint(f); u += 0x7FFFu + ((u >> 16) & 1u); return (bf16_t)(u >> 16); }
__device__ __forceinline__ float bf2f(bf16_t b) { return __uint_as_float(((u32)b) << 16); }
__device__ __forceinline__ u32 pack2(float lo, float hi) { return (u32)f2bf(lo) | ((u32)f2bf(hi) << 16); }
__device__ __forceinline__ float bflo(u32 w) { return __uint_as_float(w << 16); }
__device__ __forceinline__ float bfhi(u32 w) { return __uint_as_float(w & 0xFFFF0000u); }
__device__ __forceinline__ float dot2bf(u32 a, u32 b, float c) { return __builtin_amdgcn_fdot2_f32_bf16(__builtin_bit_cast(bf16x2_t, a), __builtin_bit_cast(bf16x2_t, b), c, false); }

constexpr int PJ_MOD = 192, PJ_TR = 2576, PJ_WG = 1, PJ_KEYS = 16, PJ_UV = 8192;
constexpr int PJ_TOTAL = PJ_MOD + PJ_TR + PJ_WG + PJ_KEYS + PJ_UV;

__device__ void prep_transpose_tile(const float* __restrict__ src, int ld, int k0, int n0, bf16_t* __restrict__ dst, int dstK, char* smem) {
  float* tile = (float*)smem;
  const int tid = threadIdx.x;
  __syncthreads();
  for (int pass = 0; pass < 8; ++pass) { int kk = pass * 8 + (tid >> 6), n = tid & 63; tile[kk * 65 + n] = src[(size_t)(k0 + kk) * ld + n0 + n]; }
  __syncthreads();
  int n = tid >> 3, kc = (tid & 7) * 8; u32x4 w;
  w.x = pack2(tile[(kc + 0) * 65 + n], tile[(kc + 1) * 65 + n]); w.y = pack2(tile[(kc + 2) * 65 + n], tile[(kc + 3) * 65 + n]);
  w.z = pack2(tile[(kc + 4) * 65 + n], tile[(kc + 5) * 65 + n]); w.w = pack2(tile[(kc + 6) * 65 + n], tile[(kc + 7) * 65 + n]);
  *(u32x4*)(dst + (size_t)(n0 + n) * dstK + k0 + kc) = w;
}

__device__ void phase_prep(const Params& p, char* smem) {
  const int tid = threadIdx.x;
  for (int job = blockIdx.x; job < PJ_TOTAL; job += gridDim.x) {
    if (job < PJ_MOD) {
      float* cs = (float*)smem; float* red = cs + 8192;
      __syncthreads();
      for (int i = tid; i < 8192; i += NTHREADS) cs[i] = siluf(p.c[i]);
      __syncthreads();
      const int l = job / 96, e0 = (job % 96) * 64, col = tid & 63, dg = tid >> 6;
      float acc[8];
#pragma unroll
      for (int b = 0; b < 8; ++b) acc[b] = 0.f;
      const float* w = p.ada_w + (size_t)l * D * 6144 + e0 + col;
      for (int d = dg * 128; d < dg * 128 + 128; ++d) { float wv = w[(size_t)d * 6144];
#pragma unroll
        for (int b = 0; b < 8; ++b) acc[b] += cs[b * 1024 + d] * wv; }
#pragma unroll
      for (int b = 0; b < 8; ++b) red[(dg * 8 + b) * 64 + col] = acc[b];
      __syncthreads();
      { const int b = tid >> 6; float s = 0.f;
#pragma unroll
        for (int g = 0; g < 8; ++g) s += red[(g * 8 + b) * 64 + col];
        p.mod[(size_t)(l * 8 + b) * 6144 + e0 + col] = s + p.ada_b[l * 6144 + e0 + col]; }
    } else if (job < PJ_MOD + PJ_TR) {
      int tt = job - PJ_MOD;
      if (tt < 640) prep_transpose_tile(p.ev_w_in, EVEN_IN, (tt / 40) * 64, (tt % 40) * 64, p.Wt_evin, 1024, smem);
      else if (tt < 896) { tt -= 640; prep_transpose_tile(p.ev_w_out, 1024, (tt / 16) * 64, (tt % 16) * 64, p.Wt_evout, 1024, smem); }
      else if (tt < 1280) { tt -= 896; prep_transpose_tile(p.od_w_in, 1536, (tt / 24) * 64, (tt % 24) * 64, p.Wt_odin, 1024, smem); }
      else if (tt < 1536) { tt -= 1280; prep_transpose_tile(p.od_w_out, 1024, (tt / 16) * 64, (tt % 16) * 64, p.Wt_odout, 1024, smem); }
      else if (tt < 2560) { tt -= 1536; int l = tt / 512; tt %= 512; prep_transpose_tile(p.peer_wq + (size_t)l * D * 2048, 2048, (tt / 32) * 64, (tt % 32) * 64, p.Wt_q + (size_t)l * 2048 * 1024, 1024, smem); }
      else { tt -= 2560; const int g = tt >> 2; prep_transpose_tile(p.pool_w + (size_t)g * 16384, 128, ((tt >> 1) & 1) * 64, (tt & 1) * 64, p.poolWt + (size_t)g * 16384, 128, smem); }
    } else if (job < PJ_MOD + PJ_TR + PJ_WG) {
      for (int i = tid; i < 16 * 1024; i += NTHREADS) { int g = i >> 10, d = i & 1023; p.Wg[i] = p.ev_w_in[(size_t)d * EVEN_IN + 2560 + g]; }
    } else if (job < PJ_MOD + PJ_TR + PJ_WG + PJ_KEYS) {
      int j = job - (PJ_MOD + PJ_TR + PJ_WG);
      for (int i = tid; i < 4096; i += NTHREADS) p.keysb[j * 4096 + i] = f2bf(p.peer_keys[j * 4096 + i]);
    } else {
      int j = job - (PJ_MOD + PJ_TR + PJ_WG + PJ_KEYS); const bool isu = j < 4096; const float* src = isu ? p.peer_u : p.peer_v; unsigned char* dst = isu ? p.U8 : p.V8; j &= 4095; const float sc = isu ? 32.f : 2.f;
      const size_t o = (size_t)j * 8192 + tid * 16; u32x4 w; u32 ww[4];
#pragma unroll
      for (int q = 0; q < 4; ++q) { const f32x4 a = *(const f32x4*)(src + o + 4 * q); int pk = __builtin_amdgcn_cvt_pk_fp8_f32(a.x * sc, a.y * sc, 0, false); pk = __builtin_amdgcn_cvt_pk_fp8_f32(a.z * sc, a.w * sc, pk, true); ww[q] = (u32)pk; }
      w.x = ww[0]; w.y = ww[1]; w.z = ww[2]; w.w = ww[3]; *(u32x4*)(dst + o) = w;
    }
  }
}

enum { EPI_EVIN = 0, EPI_EVOUT = 1, EPI_PEERQ = 2, EPI_ODIN = 3, EPI_ODOUT = 4 };
template <int EPI> __device__ __forceinline__ void epi_store(const Params& p, int layer, int m, int n, float acc) {
  if (EPI == EPI_EVIN) { float v = acc + p.ev_b_in[n];
    if (n < 1024) p.ZQK[(size_t)m * 1024 + n] = f2bf(v); else if (n < 1536) p.ZV[(size_t)m * 512 + n - 1024] = f2bf(v);
    else if (n < 2048) p.ZO[(size_t)m * 512 + n - 1536] = f2bf(sigmf(v)); else p.ZP[(size_t)m * 512 + n - 2048] = f2bf(v); }
  else if (EPI == EPI_EVOUT) { int b = m / S; p.X[(size_t)m * D + n] = p.x[(size_t)m * D + n] + p.mod[(size_t)(0 * 8 + b) * 6144 + 2048 + n] * acc; }
  else if (EPI == EPI_PEERQ) p.QP[(size_t)m * 2048 + n] = f2bf(acc);
  else if (EPI == EPI_ODIN) p.QKV[(size_t)m * 1536 + n] = f2bf(acc);
  else if (EPI == EPI_ODOUT) { int b = m / S; p.X[(size_t)m * D + n] += p.mod[(size_t)(1 * 8 + b) * 6144 + 2048 + n] * acc; }
}
template <int EPI> __device__ void phase_gemm_naive(const Params& p, int layer, const bf16_t* __restrict__ A, const bf16_t* __restrict__ Bt, int M, int N, int K, char* smem) {
  float* As = (float*)smem; float* Bs = As + 32 * 132;
  const int tid = threadIdx.x, tx = tid & 15, ty = tid >> 4; const int nN = N / 64, njobs = (M / 128) * nN;
  for (int job = blockIdx.x; job < njobs; job += gridDim.x) {
    const int m0 = (job / nN) * 128, n0 = (job % nN) * 64; float acc[4][4];
#pragma unroll
    for (int i = 0; i < 4; ++i)
#pragma unroll
      for (int j = 0; j < 4; ++j) acc[i][j] = 0.f;
    for (int k0 = 0; k0 < K; k0 += 32) {
      __syncthreads();
      { int row = tid >> 2, kc = (tid & 3) * 8; u32x4 w = *(const u32x4*)(A + (size_t)(m0 + row) * K + k0 + kc);
        As[(kc + 0) * 132 + row] = bflo(w.x); As[(kc + 1) * 132 + row] = bfhi(w.x); As[(kc + 2) * 132 + row] = bflo(w.y); As[(kc + 3) * 132 + row] = bfhi(w.y);
        As[(kc + 4) * 132 + row] = bflo(w.z); As[(kc + 5) * 132 + row] = bfhi(w.z); As[(kc + 6) * 132 + row] = bflo(w.w); As[(kc + 7) * 132 + row] = bfhi(w.w); }
      if (tid < 256) { int row = tid >> 2, kc = (tid & 3) * 8; u32x4 w = *(const u32x4*)(Bt + (size_t)(n0 + row) * K + k0 + kc);
        Bs[(kc + 0) * 68 + row] = bflo(w.x); Bs[(kc + 1) * 68 + row] = bfhi(w.x); Bs[(kc + 2) * 68 + row] = bflo(w.y); Bs[(kc + 3) * 68 + row] = bfhi(w.y);
        Bs[(kc + 4) * 68 + row] = bflo(w.z); Bs[(kc + 5) * 68 + row] = bfhi(w.z); Bs[(kc + 6) * 68 + row] = bflo(w.w); Bs[(kc + 7) * 68 + row] = bfhi(w.w); }
      __syncthreads();
#pragma unroll 8
      for (int kk = 0; kk < 32; ++kk) { f32x4 a = *(const f32x4*)(As + kk * 132 + ty * 4), b = *(const f32x4*)(Bs + kk * 68 + tx * 4);
        acc[0][0] += a.x * b.x; acc[0][1] += a.x * b.y; acc[0][2] += a.x * b.z; acc[0][3] += a.x * b.w;
        acc[1][0] += a.y * b.x; acc[1][1] += a.y * b.y; acc[1][2] += a.y * b.z; acc[1][3] += a.y * b.w;
        acc[2][0] += a.z * b.x; acc[2][1] += a.z * b.y; acc[2][2] += a.z * b.z; acc[2][3] += a.z * b.w;
        acc[3][0] += a.w * b.x; acc[3][1] += a.w * b.y; acc[3][2] += a.w * b.z; acc[3][3] += a.w * b.w; }
    }
#pragma unroll
    for (int i = 0; i < 4; ++i)
#pragma unroll
      for (int j = 0; j < 4; ++j) epi_store<EPI>(p, layer, m0 + ty * 4 + i, n0 + tx * 4 + j, acc[i][j]);
  }
}

namespace pg8 {
#define PG8_LAS __attribute__((address_space(3)))
typedef unsigned short bf16_t;
typedef short bf16x8 __attribute__((ext_vector_type(8)));
typedef float f32x4 __attribute__((ext_vector_type(4)));
typedef unsigned u32x4 __attribute__((ext_vector_type(4)));
constexpr int BM = 256, BK = 64, HALF = 128, HTB = HALF * BK * 2  , STAGE_BYTES = 8 * HTB, NXCD = 8, WGM = 8;

__host__ __device__ __forceinline__ int lds_byte(int r, int c) { const int st = (r >> 4) * 2 + (c >> 5), rr = r & 15, cc = c & 31, ob = rr * 64 + cc * 2; return st * 1024 + (ob ^ (((ob >> 9) & 1) << 5)); }
__host__ __device__ __forceinline__ void stage_rc(int b, int& R, int& C) { const int st = b / 1024, sb = b % 1024, swz = sb ^ (((sb >> 9) & 1) << 5); R = (st >> 1) * 16 + swz / 64; C = (st & 1) * 32 + (swz % 64) / 2; }
__host__ __device__ __forceinline__ int perm32(int rho) { const int n = rho >> 4, i = rho & 15; return 8 * (i >> 2) + 4 * n + (i & 3); }

struct Unit { int pm, pn; };
struct Gemm { const bf16_t* A; const bf16_t* Bt; int M, N, K; };

struct StaticOrder {
    int nM, nN, nwg, G, c;
    __host__ __device__ void init(int M, int N, int G_, int c_) { nM = M / BM; nN = N / BM; nwg = nM * nN; G = G_; c = c_; }
    __host__ __device__ bool next(int i, Unit& u) const {
        const long L = (long)i * G + c; if (L >= nwg) return false;
        int wgid = (int)L; { const int q = nwg / NXCD, r = nwg % NXCD, xcd = wgid % NXCD, off = wgid / NXCD; wgid = (xcd < r ? xcd * (q + 1) : r * (q + 1) + (xcd - r) * q) + off; }
        const int nig = WGM * nN, gid = wgid / nig, fm = gid * WGM, gsz = (nM - fm) < WGM ? (nM - fm) : WGM;
        u.pm = fm + ((wgid % nig) % gsz); u.pn = (wgid % nig) / gsz; return true;
    }
    __device__ __forceinline__ void a_ready(const Unit&) const {}
    __device__ __forceinline__ void done(const Unit&) const {}
};
__device__ __forceinline__ unsigned cvt_pk_bf16(float lo, float hi) { unsigned r; asm volatile("v_cvt_pk_bf16_f32 %0, %1, %2" : "=v"(r) : "v"(lo), "v"(hi)); return r; }
template <class Epi, class Sched, bool STAMP = false>
__device__ __forceinline__ void gemm_phase(PG8_LAS unsigned char* lds, const Gemm g, const Sched& S, const Epi& E, unsigned long long* stamps) {
    const int tid = threadIdx.x, wid = __builtin_amdgcn_readfirstlane(tid >> 6), lane = tid & 63, wr = wid >> 2, wc = wid & 3, fr = lane & 15, fq = lane >> 4;
    const int K = g.K, nt = K / BK;
    int ts_lo = 0, ts_hi = 0, nts = 0; const unsigned long long rt_entry = STAMP ? (unsigned long long)wall_clock64() : 0ull;
#define PG8_STAMP() do { if (STAMP && wid == 0 && nts < 64) { const unsigned long long _c = (unsigned long long)clock64(); \
        ts_lo = (lane == nts) ? (int)(unsigned)_c : ts_lo; ts_hi = (lane == nts) ? (int)(unsigned)(_c >> 32) : ts_hi; ++nts; } } while (0)
    PG8_STAMP();
    unsigned voffA[2], voffB[2];
#pragma unroll
    for (int i = 0; i < 2; ++i) { int R, C; stage_rc(tid * 16 + i * 8192, R, C); const int Rb = Epi::PERM ? ((R & ~31) + perm32(R & 31)) : R;
        voffA[i] = (unsigned)(R * K + C) * 2u; voffB[i] = (unsigned)(Rb * K + C) * 2u; }
    const size_t kstep = (size_t)(BK * 2);
    const size_t hstep = (size_t)HALF * K * 2;
    const size_t tstep = 2 * hstep;
    const unsigned ldsw = (unsigned)wid * 1024u;
    const int aoff = lds_byte(wr * 64 + fr, fq * 8), boff = lds_byte(wc * 32 + fr, fq * 8);
#define PG8_SA(b, h) (((b) * 2 + (h)) * HTB)
#define PG8_SB(b, h) ((4 + (b) * 2 + (h)) * HTB)
#define PG8_STAGE(bufoff, gbase, voff) do { _Pragma("unroll") for (int _i = 0; _i < 2; ++_i) \
        __builtin_amdgcn_global_load_lds((const unsigned*)((const char*)(gbase) + (voff)[_i]), (PG8_LAS unsigned*)(lds + (bufoff) + ldsw + _i * 8192), 16, 0, 0); } while (0)
#define PG8_LDA(dst, b, h) do { _Pragma("unroll") for (int m = 0; m < 4; ++m) _Pragma("unroll") for (int k = 0; k < 2; ++k) dst[m][k] = *(const PG8_LAS bf16x8*)(lds + PG8_SA(b, h) + aoff + m * 2048 + k * 1024); } while (0)
#define PG8_LDB(dst, b, h) do { _Pragma("unroll") for (int n = 0; n < 2; ++n) _Pragma("unroll") for (int k = 0; k < 2; ++k) dst[n][k] = *(const PG8_LAS bf16x8*)(lds + PG8_SB(b, h) + boff + n * 2048 + k * 1024); } while (0)
#define PG8_MMA(ai, bj, At, Bt) do { __builtin_amdgcn_s_setprio(1); _Pragma("unroll") for (int m = 0; m < 4; ++m) _Pragma("unroll") for (int n = 0; n < 2; ++n) _Pragma("unroll") for (int k = 0; k < 2; ++k) \
        acc[ai][bj][m][n] = __builtin_amdgcn_mfma_f32_16x16x32_bf16(Bt[n][k], At[m][k], acc[ai][bj][m][n], 0, 0, 0); __builtin_amdgcn_s_setprio(0); } while (0)
#define PG8_WAIT_V(n) asm volatile("s_waitcnt vmcnt(" #n ")" ::: "memory")
#define PG8_WAIT_L(n) asm volatile("s_waitcnt lgkmcnt(" #n ")" ::: "memory")
#define PG8_BAR __builtin_amdgcn_s_barrier()
#define PG8_SCHED __builtin_amdgcn_sched_barrier(0)
    Unit cur, nxt; int ui = 0;
    if (!S.next(0, cur)) return;
    f32x4 acc[2][2][4][2];
#pragma unroll
    for (int a = 0; a < 2; ++a)
#pragma unroll
        for (int b = 0; b < 2; ++b)
#pragma unroll
            for (int m = 0; m < 4; ++m)
#pragma unroll
                for (int n = 0; n < 2; ++n) acc[a][b][m][n] = (f32x4){0.f, 0.f, 0.f, 0.f};
    bf16x8 At[4][2], B0[2][2], B1[2][2];
    const char* cA = (const char*)g.A + (size_t)cur.pm * tstep; const char* cB = (const char*)g.Bt + (size_t)cur.pn * tstep;
    S.a_ready(cur);
    PG8_STAGE(PG8_SB(0, 0), cB, voffB); PG8_STAGE(PG8_SA(0, 0), cA, voffA); PG8_STAGE(PG8_SB(0, 1), cB + hstep, voffB); PG8_STAGE(PG8_SA(0, 1), cA + hstep, voffA);
    if (wr == 1) PG8_BAR;
    PG8_WAIT_V(4); PG8_BAR;
    PG8_STAGE(PG8_SB(1, 0), cB + kstep, voffB); PG8_STAGE(PG8_SA(1, 0), cA + kstep, voffA); PG8_STAGE(PG8_SB(1, 1), cB + hstep + kstep, voffB);
    PG8_WAIT_V(6); PG8_BAR;
    PG8_STAMP();
    for (;;) {
        const bool has_next = S.next(ui + 1, nxt);
        const char* nA = has_next ? (const char*)g.A + (size_t)nxt.pm * tstep : cA; const char* nB = has_next ? (const char*)g.Bt + (size_t)nxt.pn * tstep : cB;
        for (int t = 0; t < nt; t += 2) {
            const bool last = (t == nt - 2);
            const char* a1 = cA + (size_t)(t + 1) * kstep;
            const char* a2 = last ? nA : cA + (size_t)(t + 2) * kstep; const char* b2 = last ? nB : cB + (size_t)(t + 2) * kstep;
            const char* a3 = a2 + kstep; const char* b3 = b2 + kstep;
            if (last && has_next) S.a_ready(nxt);
            PG8_LDB(B0, 0, 0); PG8_SCHED; PG8_LDA(At, 0, 0); PG8_STAGE(PG8_SA(1, 1), a1 + hstep, voffA);
            PG8_WAIT_L(8); PG8_BAR; PG8_WAIT_L(0); PG8_MMA(0, 0, At, B0); PG8_BAR; PG8_SCHED;
            PG8_LDB(B1, 0, 1); PG8_STAGE(PG8_SB(0, 0), b2, voffB);
            PG8_BAR; PG8_WAIT_L(0); PG8_MMA(0, 1, At, B1); PG8_BAR;
            PG8_LDA(At, 0, 1); PG8_STAGE(PG8_SA(0, 0), a2, voffA);
            PG8_BAR; PG8_WAIT_L(0); PG8_MMA(1, 0, At, B0); PG8_BAR; PG8_SCHED;
            PG8_STAGE(PG8_SB(0, 1), b2 + hstep, voffB);
            PG8_WAIT_V(6); PG8_BAR; PG8_MMA(1, 1, At, B1); PG8_BAR;
            PG8_LDB(B0, 1, 0); PG8_SCHED; PG8_LDA(At, 1, 0); PG8_STAGE(PG8_SA(0, 1), a2 + hstep, voffA);
            PG8_WAIT_L(8); PG8_BAR; PG8_WAIT_L(0); PG8_MMA(0, 0, At, B0); PG8_BAR; PG8_SCHED;
            PG8_LDB(B1, 1, 1); PG8_STAGE(PG8_SB(1, 0), b3, voffB);
            PG8_BAR; PG8_WAIT_L(0); PG8_MMA(0, 1, At, B1); PG8_BAR;
            PG8_LDA(At, 1, 1); PG8_STAGE(PG8_SA(1, 0), a3, voffA);
            PG8_BAR; PG8_WAIT_L(0); PG8_MMA(1, 0, At, B0); PG8_BAR; PG8_SCHED;
            PG8_STAGE(PG8_SB(1, 1), b3 + hstep, voffB);
            PG8_WAIT_V(6); PG8_BAR; PG8_MMA(1, 1, At, B1); PG8_BAR;
        }
        PG8_STAMP();
        if constexpr (!Epi::AFTER_DRAIN) { E(acc, cur, wr, wc, fr, fq); S.done(cur); }
        PG8_STAMP();
        if (!has_next) break;
#pragma unroll
        for (int a = 0; a < 2; ++a)
#pragma unroll
            for (int b = 0; b < 2; ++b)
#pragma unroll
                for (int m = 0; m < 4; ++m)
#pragma unroll
                    for (int n = 0; n < 2; ++n) acc[a][b][m][n] = (f32x4){0.f, 0.f, 0.f, 0.f};
        cur = nxt; cA = nA; cB = nB; ++ui;
    }
    PG8_WAIT_V(0);
    if (wr == 0) PG8_BAR;
    PG8_BAR;
    if constexpr (Epi::AFTER_DRAIN) { E.fused(acc, cur, wr, wc, fr, fq, lds, wid, lane); S.done(cur); }
    PG8_STAMP();
    if (STAMP && wid == 0) { stamps[lane] = lane < nts ? (((unsigned long long)(unsigned)ts_hi << 32) | (unsigned)ts_lo) : 0ull;
        if (lane == 62) stamps[62] = rt_entry; if (lane == 63) stamps[63] = (unsigned long long)wall_clock64(); }
#undef PG8_STAMP
#undef PG8_SA
#undef PG8_SB
#undef PG8_STAGE
#undef PG8_LDA
#undef PG8_LDB
#undef PG8_MMA
#undef PG8_WAIT_V
#undef PG8_WAIT_L
#undef PG8_BAR
#undef PG8_SCHED
}
}

struct EpiEvin {
  static constexpr bool PERM = true, AFTER_DRAIN = false;
  bf16_t *ZQK, *ZV, *ZO, *ZP; const float* bias;
  __device__ __forceinline__ void operator()(const pg8::f32x4 (&acc)[2][2][4][2], const pg8::Unit& u, int wr, int wc, int fr, int fq) const {
    const int row0 = u.pm * 256 + wr * 64 + fr, ct = u.pn * 256;
    bf16_t* base; int ldc, cl; bool sig = false;
    if (ct < 1024) { base = ZQK; ldc = 1024; cl = ct; } else if (ct < 1536) { base = ZV; ldc = 512; cl = ct - 1024; } else if (ct < 2048) { base = ZO; ldc = 512; cl = ct - 1536; sig = true; } else { base = ZP; ldc = 512; cl = ct - 2048; }
    const int cofs = wc * 32 + 8 * fq;
    pg8::f32x4 bv[2][2];
#pragma unroll
    for (int bj = 0; bj < 2; ++bj)
#pragma unroll
      for (int n = 0; n < 2; ++n) bv[bj][n] = *(const pg8::f32x4*)(bias + ct + cofs + bj * 128 + 4 * n);
#pragma unroll
    for (int ai = 0; ai < 2; ++ai)
#pragma unroll
      for (int m = 0; m < 4; ++m) { bf16_t* rowp = base + (size_t)(row0 + ai * 128 + m * 16) * ldc + cl + cofs;
#pragma unroll
        for (int bj = 0; bj < 2; ++bj) { pg8::f32x4 v0 = acc[ai][bj][m][0] + bv[bj][0], v1 = acc[ai][bj][m][1] + bv[bj][1];
          if (sig) {
#pragma unroll
            for (int j = 0; j < 4; ++j) { v0[j] = sigmf(v0[j]); v1[j] = sigmf(v1[j]); } }
          pg8::u32x4 w; w.x = pg8::cvt_pk_bf16(v0[0], v0[1]); w.y = pg8::cvt_pk_bf16(v0[2], v0[3]); w.z = pg8::cvt_pk_bf16(v1[0], v1[1]); w.w = pg8::cvt_pk_bf16(v1[2], v1[3]);
          *(pg8::u32x4*)(rowp + bj * 128) = w; } }
  }
};
struct EpiPlain {
  static constexpr bool PERM = true, AFTER_DRAIN = false;
  bf16_t* out; int ldc;
  __device__ __forceinline__ void operator()(const pg8::f32x4 (&acc)[2][2][4][2], const pg8::Unit& u, int wr, int wc, int fr, int fq) const {
    const int row0 = u.pm * 256 + wr * 64 + fr, col0 = u.pn * 256 + wc * 32 + 8 * fq;
#pragma unroll
    for (int ai = 0; ai < 2; ++ai)
#pragma unroll
      for (int m = 0; m < 4; ++m) { bf16_t* rowp = out + (size_t)(row0 + ai * 128 + m * 16) * ldc + col0;
#pragma unroll
        for (int bj = 0; bj < 2; ++bj) { const pg8::f32x4 v0 = acc[ai][bj][m][0], v1 = acc[ai][bj][m][1];
          pg8::u32x4 w; w.x = pg8::cvt_pk_bf16(v0[0], v0[1]); w.y = pg8::cvt_pk_bf16(v0[2], v0[3]); w.z = pg8::cvt_pk_bf16(v1[0], v1[1]); w.w = pg8::cvt_pk_bf16(v1[2], v1[3]);
          *(pg8::u32x4*)(rowp + bj * 128) = w; } }
  }
};
struct EpiRes {
  static constexpr bool PERM = false, AFTER_DRAIN = false;
  const float* xin; float* X; const float* gate;
  __device__ __forceinline__ void operator()(const pg8::f32x4 (&acc)[2][2][4][2], const pg8::Unit& u, int wr, int wc, int fr, int fq) const {
    const int row0 = u.pm * 256 + wr * 64 + fr, col0 = u.pn * 256 + wc * 32 + 4 * fq; const float* gb = gate + (size_t)((u.pm * 256) / S) * 6144;
    pg8::f32x4 gv[2][2];
#pragma unroll
    for (int bj = 0; bj < 2; ++bj)
#pragma unroll
      for (int n = 0; n < 2; ++n) gv[bj][n] = *(const pg8::f32x4*)(gb + col0 + bj * 128 + n * 16);
#pragma unroll
    for (int ai = 0; ai < 2; ++ai)
#pragma unroll
      for (int m = 0; m < 4; ++m) { const size_t off = (size_t)(row0 + ai * 128 + m * 16) * 1024 + col0;
#pragma unroll
        for (int bj = 0; bj < 2; ++bj)
#pragma unroll
          for (int n = 0; n < 2; ++n) { const pg8::f32x4 xi = *(const pg8::f32x4*)(xin + off + bj * 128 + n * 16); *(pg8::f32x4*)(X + off + bj * 128 + n * 16) = xi + gv[bj][n] * acc[ai][bj][m][n]; }
        asm volatile("" ::: "memory"); }
  }
};
template <class Epi> __device__ __forceinline__ void phase_gemm_fast(const bf16_t* A, const bf16_t* Bt, int M, int N, int K, const Epi& E, char* smem) {
  pg8::Gemm g; g.A = A; g.Bt = Bt; g.M = M; g.N = N; g.K = K;
  pg8::StaticOrder So; So.init(M, N, (int)gridDim.x, (int)blockIdx.x);
  pg8::gemm_phase<Epi, pg8::StaticOrder, false>((PG8_LAS unsigned char*)smem, g, So, E, nullptr);
}

namespace cp {
typedef short bf16x8 __attribute__((ext_vector_type(8)));
typedef float f32x16 __attribute__((ext_vector_type(16)));
constexpr int RS = 272;
__device__ __forceinline__ void unpack8(const u32x4 w, float* f) { f[0] = bflo(w.x); f[1] = bfhi(w.x); f[2] = bflo(w.y); f[3] = bfhi(w.y); f[4] = bflo(w.z); f[5] = bfhi(w.z); f[6] = bflo(w.w); f[7] = bfhi(w.w); }
__device__ void phase_convpool(const Params& p, char* smem) {
  for (int job = blockIdx.x; job < T / 64; job += gridDim.x) {
    int tid_ = threadIdx.x; asm volatile("" : "+v"(tid_));
    const int tid = tid_, c0 = (tid & 127) * 8, t0 = job * 64 + (tid >> 7) * 16, s0 = t0 & (S - 1);
    float cw[5][8], cb[8];
#pragma unroll
    for (int j = 0; j < 5; ++j) { const f32x4 a = *(const f32x4*)(p.conv_w + j * 1024 + c0), b = *(const f32x4*)(p.conv_w + j * 1024 + c0 + 4); cw[j][0] = a.x; cw[j][1] = a.y; cw[j][2] = a.z; cw[j][3] = a.w; cw[j][4] = b.x; cw[j][5] = b.y; cw[j][6] = b.z; cw[j][7] = b.w; }
    { const f32x4 a = *(const f32x4*)(p.conv_b + c0), b = *(const f32x4*)(p.conv_b + c0 + 4); cb[0] = a.x; cb[1] = a.y; cb[2] = a.z; cb[3] = a.w; cb[4] = b.x; cb[5] = b.y; cb[6] = b.z; cb[7] = b.w; }
    const float sc = c0 >= 512 ? KSCALE : 1.f;
    float win[5][8];
#pragma unroll
    for (int j = 0; j < 4; ++j) { const int ss = s0 + j - 2; u32x4 w = (u32x4){0u, 0u, 0u, 0u}; if (ss >= 0 && ss < S) w = *(const u32x4*)(p.ZQK + (size_t)(t0 + j - 2) * 1024 + c0); unpack8(w, win[j + 1]); }
#pragma unroll
    for (int i = 0; i < 16; ++i) {
#pragma unroll
      for (int j = 0; j < 4; ++j)
#pragma unroll
        for (int q = 0; q < 8; ++q) win[j][q] = win[j + 1][q];
      { const int ss = s0 + i + 2; u32x4 w = (u32x4){0u, 0u, 0u, 0u}; if (ss < S) w = *(const u32x4*)(p.ZQK + (size_t)(t0 + i + 2) * 1024 + c0); unpack8(w, win[4]); }
      float a[8];
#pragma unroll
      for (int q = 0; q < 8; ++q) { float v = cb[q];
#pragma unroll
        for (int j = 0; j < 5; ++j) v += cw[j][q] * win[j][q];
        a[q] = siluf(v) * sc; }
      u32x4 o; o.x = pack2(a[0], a[1]); o.y = pack2(a[2], a[3]); o.z = pack2(a[4], a[5]); o.w = pack2(a[6], a[7]); *(u32x4*)(p.QK + (size_t)(t0 + i) * 1024 + c0) = o;
    }
  }
  for (int job = blockIdx.x; job < (T / 128) * 4; job += gridDim.x) {
    int tid_ = threadIdx.x; asm volatile("" : "+v"(tid_));
    const int tid = tid_, wid = tid >> 6, lane = tid & 63, l31 = lane & 31, hh = lane >> 5;
    const int g = job & 3, t0 = (job >> 2) * 128, win = 2 << g, hw = win >> 1;
    __syncthreads();
#pragma unroll
    for (int i = 0; i < 4; ++i) { const int idx = tid + i * NTHREADS, row = idx >> 4, ch = idx & 15; *(u32x4*)(smem + 128 * RS + row * RS + ch * 16) = *(const u32x4*)(p.poolWt + (size_t)g * 16384 + row * 128 + ch * 8); }
#pragma unroll 1
    for (int i = 0; i < 4; ++i) { const int idx = tid + i * NTHREADS, row = idx >> 4, ch = idx & 15, t = t0 + row, s = t & (S - 1); const int lo = max(s - hw, 0), hi = min(s + hw, S);
      float sum[8], own[8];
#pragma unroll
      for (int q = 0; q < 8; ++q) sum[q] = 0.f;
      const bf16_t* base = p.ZP + (size_t)(t - s) * 512 + g * 128 + ch * 8;
      for (int r = lo; r < hi; ++r) { float f[8]; unpack8(*(const u32x4*)(base + (size_t)r * 512), f);
#pragma unroll
        for (int q = 0; q < 8; ++q) sum[q] += f[q]; }
      unpack8(*(const u32x4*)(base + (size_t)s * 512), own); const float inv = 1.f / (float)(hi - lo);
      u32x4 o; o.x = pack2(sum[0] * inv - own[0], sum[1] * inv - own[1]); o.y = pack2(sum[2] * inv - own[2], sum[3] * inv - own[3]); o.z = pack2(sum[4] * inv - own[4], sum[5] * inv - own[5]); o.w = pack2(sum[6] * inv - own[6], sum[7] * inv - own[7]);
      *(u32x4*)(smem + row * RS + ch * 16) = o; }
    __syncthreads();
    const int mt = wid >> 1;
#pragma unroll
    for (int q = 0; q < 2; ++q) { const int nt = (wid & 1) * 2 + q;
      f32x16 acc;
#pragma unroll
      for (int r = 0; r < 16; ++r) acc[r] = 0.f;
      const char* ya = smem + (mt * 32 + l31) * RS + hh * 16; const char* wb = smem + 128 * RS + (nt * 32 + l31) * RS + hh * 16;
#pragma unroll
      for (int ks = 0; ks < 8; ++ks) acc = __builtin_amdgcn_mfma_f32_32x32x16_bf16(*(const bf16x8*)(ya + ks * 32), *(const bf16x8*)(wb + ks * 32), acc, 0, 0, 0);
      const int e = nt * 32 + l31; const float psc = p.pool_sc[g * 128 + e];
#pragma unroll
      for (int r = 0; r < 16; ++r) { const int row = mt * 32 + (r & 3) + 8 * (r >> 2) + 4 * hh; p.CAT[(size_t)(t0 + row) * 1024 + 512 + g * 128 + e] = f2bf(acc[r] * psc); } }
  }
}
}

__device__ void phase_mlstm_naive(const Params& p, char* smem) {
  float* qs = (float*)smem; float* ks = qs + 128; float* nump = ks + 128; float* red = nump + 512;
  const int tid = threadIdx.x, j = tid & 127, qd = tid >> 7;
  for (int job = blockIdx.x; job < 64; job += gridDim.x) {
    const int dir = job >> 5, b = (job >> 2) & 7, h = job & 3;
    float C[32];
#pragma unroll
    for (int d = 0; d < 32; ++d) C[d] = 0.f;
    float n = 0.f, m = 0.f;
    for (int step = 0; step < S; ++step) { const int s = dir ? S - 1 - step : step; const size_t t = (size_t)b * S + s;
      const float li = p.gates[t * 16 + dir * 4 + h], gf = p.gates[t * 16 + 8 + dir * 4 + h];
      const float lf = fminf(gf, 0.f) - log1pf(__expf(-fabsf(gf)));
      __syncthreads();
      if (qd == 0) { qs[j] = bf2f(p.QK[t * 1024 + h * 128 + j]); ks[j] = bf2f(p.QK[t * 1024 + 512 + h * 128 + j]); }
      const float v = bf2f(p.ZV[t * 512 + h * 128 + j]);
      __syncthreads();
      const float mn = fmaxf(lf + m, li), ip = __expf(li - mn), fp = __expf(lf + m - mn); m = mn;
      float num = 0.f;
#pragma unroll
      for (int d = 0; d < 32; ++d) { C[d] = fp * C[d] + ip * ks[qd * 32 + d] * v; num += qs[qd * 32 + d] * C[d]; }
      float dp = 0.f; if (qd == 0) { n = fp * n + ip * ks[j]; dp = qs[j] * n; }
      nump[qd * 128 + j] = num;
      dp = wave_sum(dp); if ((tid & 63) == 0) red[tid >> 6] = dp;
      __syncthreads();
      if (qd == 0) { const float den = red[0] + red[1]; num = nump[j] + nump[128 + j] + nump[256 + j] + nump[384 + j];
        p.HS[((size_t)dir * T + t) * 512 + h * 128 + j] = f2bf(num / fmaxf(fabsf(den), __expf(-mn))); }
    }
    __syncthreads();
  }
}

namespace ml {
typedef short bf16x8 __attribute__((ext_vector_type(8)));
typedef short s16x4 __attribute__((ext_vector_type(4)));
typedef float f32x16 __attribute__((ext_vector_type(16)));
constexpr int RS = 272;
constexpr int OFF_Q = 0, OFF_K = 128 * RS, OFF_VT = 2 * 128 * RS, OFF_VW = OFF_VT + 34 * RS, OFF_CT = OFF_VW + 34 * RS, OFF_A = OFF_CT + 34 * RS;
constexpr int OFF_PA = OFF_A + 16384, OFF_MCH = OFF_PA + 16384, OFF_TAB = OFF_MCH + 512, OFF_DEN = OFF_TAB + 4096, OFF_END = OFF_DEN + 512;
static_assert(OFF_A % 16 == 0 && OFF_END <= SMEM_BYTES, "mlstm LDS layout");
__device__ __forceinline__ int crow(int r, int h) { return (r & 3) + 8 * (r >> 2) + 4 * h; }
__device__ __forceinline__ int spos(int s) { return (s & ~12) | ((s & 4) << 1) | ((s & 8) >> 1); }
#define ML_MFMA(a, b, c) __builtin_amdgcn_mfma_f32_32x32x16_bf16((a), (b), (c), 0, 0, 0)
__device__ __forceinline__ bf16x8 pack8(float x0, float x1, float x2, float x3, float x4, float x5, float x6, float x7) {
  u32x4 w;
  asm volatile("v_cvt_pk_bf16_f32 %0, %4, %5\n\tv_cvt_pk_bf16_f32 %1, %6, %7\n\tv_cvt_pk_bf16_f32 %2, %8, %9\n\tv_cvt_pk_bf16_f32 %3, %10, %11\n\ts_nop 1"
               : "=&v"(w.x), "=&v"(w.y), "=&v"(w.z), "=&v"(w.w) : "v"(x0), "v"(x1), "v"(x2), "v"(x3), "v"(x4), "v"(x5), "v"(x6), "v"(x7));
  return __builtin_bit_cast(bf16x8, w);
}
__device__ __forceinline__ void tr_read8(unsigned a, s16x4& r0, s16x4& r1, s16x4& r2, s16x4& r3, s16x4& r4, s16x4& r5, s16x4& r6, s16x4& r7) {
  asm volatile("ds_read_b64_tr_b16 %0, %8\n\tds_read_b64_tr_b16 %1, %8 offset:2176\n\tds_read_b64_tr_b16 %2, %8 offset:4352\n\tds_read_b64_tr_b16 %3, %8 offset:6528\n\t"
               "ds_read_b64_tr_b16 %4, %8 offset:8704\n\tds_read_b64_tr_b16 %5, %8 offset:10880\n\tds_read_b64_tr_b16 %6, %8 offset:13056\n\tds_read_b64_tr_b16 %7, %8 offset:15232\n\ts_waitcnt lgkmcnt(0)"
               : "=&v"(r0), "=&v"(r1), "=&v"(r2), "=&v"(r3), "=&v"(r4), "=&v"(r5), "=&v"(r6), "=&v"(r7) : "v"(a) : "memory");
}
static_assert(8 * RS == 2176, "tr_read8 offsets assume 272-byte rows");

__device__ void phase_mlstm(const Params& p, char* smem) {
  int tid_ = threadIdx.x; asm volatile("" : "+v"(tid_));
  const int tid = tid_, wid = tid >> 6, lane = tid & 63, l31 = lane & 31, hh = lane >> 5;
  float* const LA = (float*)(smem + OFF_A); float* const LPA = (float*)(smem + OFF_PA); float* const LM = (float*)(smem + OFF_MCH);
  float* const LTAB = (float*)(smem + OFF_TAB); float* const LDEN = (float*)(smem + OFF_DEN);
  const unsigned lds0 = (unsigned)(uintptr_t)smem;
  for (int job = blockIdx.x; job < 256; job += gridDim.x) {
    const int dvq = job & 3, h = (job >> 2) & 3, b = (job >> 4) & 7, dir = job >> 7;
    const float* gts = p.gates + (size_t)b * S * 16;
    const bf16_t* QKb = p.QK + (size_t)b * S * 1024 + h * 128; const bf16_t* ZVb = p.ZV + (size_t)b * S * 512 + h * 128 + dvq * 32;
    bf16_t* HSb = p.HS + ((size_t)dir * T + (size_t)b * S) * 512 + h * 128 + dvq * 32;
    __syncthreads();
    for (int i = tid; i < 3 * 34 * RS / 4; i += NTHREADS) ((u32*)(smem + OFF_VT))[i] = 0u;
    for (int cc = 0; cc < 4; ++cc) { const int c = wid * 4 + cc, tau0 = c * 128 + 2 * lane; const int tok0 = dir ? S - 1 - tau0 : tau0, tok1 = dir ? tok0 - 1 : tok0 + 1;
      const float li0 = gts[(size_t)tok0 * 16 + dir * 4 + h], gf0 = gts[(size_t)tok0 * 16 + 8 + dir * 4 + h], li1 = gts[(size_t)tok1 * 16 + dir * 4 + h], gf1 = gts[(size_t)tok1 * 16 + 8 + dir * 4 + h];
      const float lf0 = fminf(gf0, 0.f) - log1pf(__expf(-fabsf(gf0))), lf1 = fminf(gf1, 0.f) - log1pf(__expf(-fabsf(gf1)));
      const float pr = lf0 + lf1; float incl = pr;
#pragma unroll
      for (int o = 1; o < 64; o <<= 1) { const float v = __shfl_up(incl, o); if (lane >= o) incl += v; }
      const float b0 = incl - pr + lf0, b1 = b0 + lf1, a0 = li0 - b0, a1 = li1 - b1;
      float im = fmaxf(a0, a1);
#pragma unroll
      for (int o = 1; o < 64; o <<= 1) { const float v = __shfl_up(im, o); if (lane >= o) im = fmaxf(im, v); }
      float ex = __shfl_up(im, 1); if (lane == 0) ex = -INFINITY;
      const float pa0 = fmaxf(ex, a0), pa1 = fmaxf(pa0, a1);
      LA[tau0] = a0; LA[tau0 + 1] = a1; LPA[tau0] = pa0; LPA[tau0 + 1] = pa1; if (lane == 63) LM[64 + c] = b1; }
    __syncthreads();
    if (tid == 0) { float m = 0.f; for (int c = 0; c < 32; ++c) { LM[c] = m; m = LM[64 + c] + fmaxf(m, LPA[c * 128 + 127]); } LM[32] = m; }
    __syncthreads();
    u32x4 qreg[4], kreg[4], vreg;
#define ML_TOK(tau) (dir ? S - 1 - (tau) : (tau))
#define ML_LOAD(c) do { _Pragma("unroll") for (int i_ = 0; i_ < 4; ++i_) { const int tk_ = ML_TOK((c) * 128 + (tid >> 4) + 32 * i_); \
        qreg[i_] = *(const u32x4*)(QKb + (size_t)tk_ * 1024 + (tid & 15) * 8); kreg[i_] = *(const u32x4*)(QKb + (size_t)tk_ * 1024 + 512 + (tid & 15) * 8); } \
      { const int tk_ = ML_TOK((c) * 128 + (tid >> 2)); vreg = *(const u32x4*)(ZVb + (size_t)tk_ * 512 + (tid & 3) * 8); } } while (0)
#define ML_TABLES(c) do { if (tid < 128) { const int tau_ = (c) * 128 + tid, tk_ = ML_TOK(tau_); const float li_ = gts[(size_t)tk_ * 16 + dir * 4 + h], a_ = LA[tau_], mc_ = LM[(c)]; \
        const float Mj_ = fmaxf(mc_, LPA[tau_]), Me_ = fmaxf(mc_, LPA[(c) * 128 + 127]); float* tb_ = LTAB + ((c) & 1) * 512; \
        tb_[tid] = Mj_; tb_[128 + tid] = __expf(mc_ - Mj_); tb_[256 + tid] = __expf(-((li_ - a_) + Mj_)); tb_[384 + tid] = __expf(a_ - Me_); } } while (0)
#define ML_STORE(c) do { _Pragma("unroll") for (int i_ = 0; i_ < 4; ++i_) { const int row_ = (tid >> 4) + 32 * i_; \
        *(u32x4*)(smem + OFF_Q + row_ * RS + (tid & 15) * 16) = qreg[i_]; *(u32x4*)(smem + OFF_K + row_ * RS + (tid & 15) * 16) = kreg[i_]; } \
      { const int s_ = tid >> 2, ps_ = spos(s_) * 2; const float we_ = LTAB[((c) & 1) * 512 + 384 + s_]; const u32 vw_[4] = {vreg.x, vreg.y, vreg.z, vreg.w}; \
        _Pragma("unroll") for (int i_ = 0; i_ < 4; ++i_) { const int r0_ = ((tid & 3) * 8 + 2 * i_) * RS + ps_; \
          *(bf16_t*)(smem + OFF_VT + r0_) = (bf16_t)(vw_[i_] & 0xFFFFu); *(bf16_t*)(smem + OFF_VT + r0_ + RS) = (bf16_t)(vw_[i_] >> 16); \
          *(bf16_t*)(smem + OFF_VW + r0_) = f2bf(bflo(vw_[i_]) * we_); *(bf16_t*)(smem + OFF_VW + r0_ + RS) = f2bf(bfhi(vw_[i_]) * we_); } } \
      if (tid < 128) { const int ps_ = spos(tid) * 2; *(bf16_t*)(smem + OFF_VT + 32 * RS + ps_) = (bf16_t)0x3F80u; *(bf16_t*)(smem + OFF_VW + 32 * RS + ps_) = f2bf(LTAB[((c) & 1) * 512 + 384 + tid]); } } while (0)
    ML_LOAD(0); ML_TABLES(0);
    __syncthreads();
    ML_STORE(0);
    __syncthreads();
    f32x16 Cacc;
#pragma unroll
    for (int r = 0; r < 16; ++r) Cacc[r] = 0.f;
    for (int c = 0; c < 32; ++c) {
      int tidc_ = threadIdx.x; asm volatile("" : "+v"(tidc_));
      const int tid = tidc_, wid = tid >> 6, lane = tid & 63, l31 = lane & 31, hh = lane >> 5;
      const int t2 = wid >> 1, nt = wid & 1, brow = min(nt * 32 + l31, 33);
      if (c + 1 < 32) { ML_LOAD(c + 1); ML_TABLES(c + 1); }
      const float* tab = LTAB + (c & 1) * 512;
      f32x16 acc;
#pragma unroll
      for (int r = 0; r < 16; ++r) acc[r] = 0.f;
      const char* qa = smem + OFF_Q + (t2 * 32 + l31) * RS + hh * 16;
      { const char* cb = smem + OFF_CT + brow * RS + hh * 16;
#pragma unroll
        for (int ks = 0; ks < 8; ++ks) acc = ML_MFMA(*(const bf16x8*)(qa + ks * 32), *(const bf16x8*)(cb + ks * 32), acc); }
#pragma unroll
      for (int r = 0; r < 16; ++r) acc[r] *= tab[128 + t2 * 32 + crow(r, hh)];
      const float Mj = tab[t2 * 32 + l31];
      for (int si = 0; si <= t2; ++si) {
        f32x16 X;
#pragma unroll
        for (int r = 0; r < 16; ++r) X[r] = 0.f;
        const char* ka = smem + OFF_K + (si * 32 + l31) * RS + hh * 16;
#pragma unroll
        for (int ks = 0; ks < 8; ++ks) X = ML_MFMA(*(const bf16x8*)(ka + ks * 32), *(const bf16x8*)(qa + ks * 32), X);
        const float* Ac = LA + c * 128 + si * 32;
#pragma unroll
        for (int r = 0; r < 16; ++r) { const int sl = crow(r, hh); float w = __expf(Ac[sl] - Mj); if (si == t2 && sl > l31) w = 0.f; X[r] *= w; }
        const bf16x8 f0 = pack8(X[0], X[1], X[2], X[3], X[4], X[5], X[6], X[7]), f1 = pack8(X[8], X[9], X[10], X[11], X[12], X[13], X[14], X[15]);
        const char* vb = smem + OFF_VT + brow * RS + si * 64 + hh * 16;
        acc = ML_MFMA(f0, *(const bf16x8*)(vb), acc); acc = ML_MFMA(f1, *(const bf16x8*)(vb + 32), acc);
      }
      if (nt == 1 && l31 == 0) {
#pragma unroll
        for (int r = 0; r < 16; ++r) LDEN[t2 * 32 + crow(r, hh)] = acc[r]; }
      { const float mc = LM[c], decay = __expf(mc - fmaxf(mc, LPA[c * 128 + 127]));
#pragma unroll
        for (int r = 0; r < 16; ++r) Cacc[r] *= decay;
        const unsigned ta = lds0 + OFF_K + ((lane & 15) >> 2) * RS + (t2 * 32 + 16 * ((lane >> 4) & 1) + 4 * (lane & 3)) * 2 + 4 * hh * RS;
        const char* wb = smem + OFF_VW + brow * RS + hh * 16;
#pragma unroll
        for (int kq = 0; kq < 2; ++kq) { s16x4 r0, r1, r2, r3, r4, r5, r6, r7; tr_read8(ta + 64 * kq * RS, r0, r1, r2, r3, r4, r5, r6, r7); __builtin_amdgcn_sched_barrier(0);
          Cacc = ML_MFMA(((bf16x8){r0[0], r0[1], r0[2], r0[3], r1[0], r1[1], r1[2], r1[3]}), *(const bf16x8*)(wb + (4 * kq + 0) * 32), Cacc);
          Cacc = ML_MFMA(((bf16x8){r2[0], r2[1], r2[2], r2[3], r3[0], r3[1], r3[2], r3[3]}), *(const bf16x8*)(wb + (4 * kq + 1) * 32), Cacc);
          Cacc = ML_MFMA(((bf16x8){r4[0], r4[1], r4[2], r4[3], r5[0], r5[1], r5[2], r5[3]}), *(const bf16x8*)(wb + (4 * kq + 2) * 32), Cacc);
          Cacc = ML_MFMA(((bf16x8){r6[0], r6[1], r6[2], r6[3], r7[0], r7[1], r7[2], r7[3]}), *(const bf16x8*)(wb + (4 * kq + 3) * 32), Cacc); } }
      __syncthreads();
      if (nt == 0) {
#pragma unroll
        for (int r = 0; r < 16; ++r) { const int j = t2 * 32 + crow(r, hh); const float dn = LDEN[j], nr = tab[256 + j]; const int tk = ML_TOK(c * 128 + j);
          HSb[(size_t)tk * 512 + l31] = f2bf(acc[r] / fmaxf(fabsf(dn), nr)); } }
      if (nt * 32 + l31 <= 32) { char* cw = smem + OFF_CT + (nt * 32 + l31) * RS + (t2 * 32 + 4 * hh) * 2;
#pragma unroll
        for (int g = 0; g < 4; ++g) { u32x2 w; w.x = pack2(Cacc[4 * g], Cacc[4 * g + 1]); w.y = pack2(Cacc[4 * g + 2], Cacc[4 * g + 3]); *(u32x2*)(cw + 16 * g) = w; } }
      if (c + 1 < 32) ML_STORE(c + 1);
      __syncthreads();
    }
#undef ML_TOK
#undef ML_LOAD
#undef ML_TABLES
#undef ML_STORE
  }
}
}

__device__ void phase_peer_select_naive(const Params& p, int layer, char* smem) {
  float* kl = (float*)smem;
  float* qsh = kl + 2 * 128 * 129;
  const int tid = threadIdx.x, wid = tid >> 6, lane = tid & 63; float* qs = qsh + wid * 128;
  __syncthreads();
  for (int i = tid; i < 2 * 128 * 128; i += NTHREADS) kl[(i >> 7) * 129 + (i & 127)] = p.peer_keys[(size_t)layer * 32768 + i];
  __syncthreads();
  for (int job = blockIdx.x; job < T; job += gridDim.x) {
    const int t = job, h = wid;
    float ts[2][16]; int ti[2][16];
#pragma unroll
    for (int pp = 0; pp < 2; ++pp) {
      const bf16_t* q = p.QP + (size_t)t * 2048 + h * 256 + pp * 128; const float q0 = bf2f(q[lane]), q1 = bf2f(q[lane + 64]);
      const float r = rsqrtf(wave_sum(q0 * q0 + q1 * q1) * (1.f / 128.f) + EPS); qs[lane] = q0 * r; qs[lane + 64] = q1 * r;
      float s0 = 0.f, s1 = 0.f; const float* k0 = kl + (pp * 128 + lane) * 129; const float* k1 = k0 + 64 * 129;
      for (int c = 0; c < 128; ++c) { const float qc = qs[c]; s0 += qc * k0[c]; s1 += qc * k1[c]; }
#pragma unroll
      for (int k = 0; k < 16; ++k) { const float mx = wave_max(fmaxf(s0, s1)); int cand = (s0 == mx) ? lane : ((s1 == mx) ? lane + 64 : 9999);
        for (int o = 32; o >= 1; o >>= 1) cand = min(cand, __shfl_xor(cand, o));
        ts[pp][k] = mx; ti[pp][k] = cand; if (cand == lane) s0 = -INFINITY; if (cand == lane + 64) s1 = -INFINITY; }
    }
    float cs[4];
#pragma unroll
    for (int r = 0; r < 4; ++r) { const int c = lane * 4 + r; float va = 0.f, vb = 0.f;
#pragma unroll
      for (int k = 0; k < 16; ++k) { if (k == (c >> 4)) va = ts[0][k]; if (k == (c & 15)) vb = ts[1][k]; }
      cs[r] = va + vb; }
    float top[16]; int tix[16];
#pragma unroll
    for (int k = 0; k < 16; ++k) { const float mx = wave_max(fmaxf(fmaxf(cs[0], cs[1]), fmaxf(cs[2], cs[3]))); int cand = 9999;
#pragma unroll
      for (int r = 3; r >= 0; --r) if (cs[r] == mx) cand = lane * 4 + r;
      for (int o = 32; o >= 1; o >>= 1) cand = min(cand, __shfl_xor(cand, o));
      top[k] = mx; tix[k] = cand;
#pragma unroll
      for (int r = 0; r < 4; ++r) if (cand == lane * 4 + r) cs[r] = -INFINITY; }
    float sum = 0.f;
#pragma unroll
    for (int k = 0; k < 16; ++k) sum += __expf(top[k] - top[0]);
    if (lane < 16) { float tv = 0.f; int tc = 0;
#pragma unroll
      for (int k = 0; k < 16; ++k) if (k == lane) { tv = top[k]; tc = tix[k]; }
      int ia = 0, ib = 0;
#pragma unroll
      for (int k = 0; k < 16; ++k) { if (k == (tc >> 4)) ia = ti[0][k]; if (k == (tc & 15)) ib = ti[1][k]; }
      p.pidx[((size_t)t * 8 + h) * 16 + lane] = (bf16_t)(ia * 128 + ib); p.pgate[((size_t)t * 8 + h) * 16 + lane] = __expf(tv - top[0]) / sum; }
  }
}

namespace sel {
typedef short bf16x8 __attribute__((ext_vector_type(8)));
typedef float f32x16 __attribute__((ext_vector_type(16)));
constexpr int RS = 272, OFF_W = 2 * 128 * RS, WB = 3 * 16 * 32 * 4;
static_assert(OFF_W + 8 * WB <= SMEM_BYTES, "select LDS layout");
constexpr float NEG = -3.0e38f;
__device__ __forceinline__ float max3(float a, float b, float c) { return fmaxf(fmaxf(a, b), c); }
__device__ __forceinline__ float xhalf(float v) { return __shfl_xor(v, 32); }

__device__ void phase_peer_select(const Params& p, int layer, char* smem) {
  const int tid0 = threadIdx.x;
  __syncthreads();
  { const bf16_t* kb = p.keysb + (size_t)layer * 32768;
    for (int i = tid0; i < 2 * 128 * 16; i += NTHREADS) { const int row = i >> 4, ch = i & 15; *(u32x4*)(smem + row * RS + ch * 16) = *(const u32x4*)(kb + (size_t)row * 128 + ch * 8); } }
  __syncthreads();
  for (int job = blockIdx.x; job < T / 32; job += gridDim.x) {
    int tid_ = threadIdx.x; asm volatile("" : "+v"(tid_));
    const int tid = tid_, wid = tid >> 6, lane = tid & 63, l31 = lane & 31, hh = lane >> 5, h = wid;
    const int t = job * 32 + l31;
    float* const wl = (float*)(smem + OFF_W + wid * WB);
    float rs[2];
#pragma unroll
    for (int pp = 0; pp < 2; ++pp) {
      const bf16_t* qrow = p.QP + (size_t)t * 2048 + h * 256 + pp * 128 + hh * 8;
      bf16x8 bq[8]; float ssq = 0.f;
#pragma unroll
      for (int ks = 0; ks < 8; ++ks) { const u32x4 w = *(const u32x4*)(qrow + ks * 16); bq[ks] = __builtin_bit_cast(bf16x8, w);
        const u32 w0 = w.x, w1 = w.y, w2 = w.z, w3 = w.w; ssq = dot2bf(w0, w0, ssq); ssq = dot2bf(w1, w1, ssq); ssq = dot2bf(w2, w2, ssq); ssq = dot2bf(w3, w3, ssq); }
      ssq += xhalf(ssq); rs[pp] = rsqrtf(ssq * (1.f / 128.f) + EPS);
      f32x16 X[4];
#pragma unroll
      for (int nt = 0; nt < 4; ++nt) {
#pragma unroll
        for (int r = 0; r < 16; ++r) X[nt][r] = 0.f;
        const char* ka = smem + (pp * 128 + nt * 32 + l31) * RS + hh * 16;
#pragma unroll
        for (int ks = 0; ks < 8; ++ks) X[nt] = __builtin_amdgcn_mfma_f32_32x32x16_bf16(*(const bf16x8*)(ka + ks * 32), bq[ks], X[nt], 0, 0, 0); }
#pragma unroll
      for (int nt = 0; nt < 4; ++nt)
#pragma unroll
        for (int r = 0; r < 16; ++r) X[nt][r] = __uint_as_float((__float_as_uint(X[nt][r]) & ~0x7Fu) | (u32)(nt * 32 + (r & 3) + 8 * (r >> 2)) | ((u32)hh << 2));
#pragma unroll 1
      for (int k = 0; k < 16; ++k) {
        float m = NEG;
#pragma unroll
        for (int nt = 0; nt < 4; ++nt)
#pragma unroll
          for (int r = 0; r < 16; r += 2) m = max3(m, X[nt][r], X[nt][r + 1]);
        const float M = fmaxf(m, xhalf(m));
        wl[(pp * 16 + k) * 32 + l31] = M;
#pragma unroll
        for (int nt = 0; nt < 4; ++nt)
#pragma unroll
          for (int r = 0; r < 16; ++r) X[nt][r] = (X[nt][r] == M) ? NEG : X[nt][r];
      }
    }
    float s1[16], s2[16];
#pragma unroll
    for (int k = 0; k < 16; ++k) { s1[k] = wl[k * 32 + l31] * rs[0]; s2[k] = wl[(16 + k) * 32 + l31] * rs[1]; }
    constexpr int A0[25] = {0, 0, 0, 0, 0, 0, 0, 0, 0, 0, 0, 0, 0, 0, 0, 0, 2, 2, 2, 2, 2, 3, 3, 3, 3}, B0[25] = {0, 1, 2, 3, 4, 5, 6, 7, 8, 9, 10, 11, 12, 13, 14, 15, 0, 1, 2, 3, 4, 0, 1, 2, 3};
    constexpr int A1[25] = {1, 1, 1, 1, 1, 1, 1, 1, 4, 4, 4, 5, 5, 6, 6, 7, 7, 8, 9, 10, 11, 12, 13, 14, 15}, B1[25] = {0, 1, 2, 3, 4, 5, 6, 7, 0, 1, 2, 0, 1, 0, 1, 0, 1, 0, 0, 0, 0, 0, 0, 0, 0};
    float cd[25];
#pragma unroll
    for (int i = 0; i < 25; ++i) { const float v0 = s1[A0[i]] + s2[B0[i]], v1 = s1[A1[i]] + s2[B1[i]]; const float v = hh ? v1 : v0; const u32 cid = hh ? (u32)(A1[i] * 16 + B1[i]) : (u32)(A0[i] * 16 + B0[i]);
      cd[i] = __uint_as_float((__float_as_uint(v) & ~0xFFu) | cid); }
#pragma unroll 1
    for (int k = 0; k < 16; ++k) {
      float m = cd[24];
#pragma unroll
      for (int i = 0; i < 24; i += 2) m = max3(m, cd[i], cd[i + 1]);
      const float M = fmaxf(m, xhalf(m));
      wl[(32 + k) * 32 + l31] = M;
#pragma unroll
      for (int i = 0; i < 25; ++i) cd[i] = (cd[i] == M) ? NEG : cd[i];
    }
    float tv[16];
#pragma unroll
    for (int k = 0; k < 16; ++k) tv[k] = wl[(32 + k) * 32 + l31];
    float sum = 0.f;
#pragma unroll
    for (int k = 0; k < 16; ++k) sum += __expf(tv[k] - tv[0]);
    const float inv = 1.f / sum;
    u32 ev[8]; float go[8];
#pragma unroll
    for (int q = 0; q < 8; ++q) { const float v = wl[(32 + hh * 8 + q) * 32 + l31]; const u32 cid = __float_as_uint(v) & 0xFFu;
      const u32 i1 = __float_as_uint(wl[(cid >> 4) * 32 + l31]) & 0x7Fu, i2 = __float_as_uint(wl[(16 + (cid & 15)) * 32 + l31]) & 0x7Fu; ev[q] = i1 * 128 + i2;
      go[q] = __expf(v - tv[0]) * inv; }
    const u32 io0 = ev[0] | (ev[1] << 16), io1 = ev[2] | (ev[3] << 16), io2 = ev[4] | (ev[5] << 16), io3 = ev[6] | (ev[7] << 16);
    const size_t ob = ((size_t)t * 8 + h) * 16 + hh * 8;
    *(u32x4*)(p.pidx + ob) = (u32x4){io0, io1, io2, io3};
    *(f32x4*)(p.pgate + ob) = (f32x4){go[0], go[1], go[2], go[3]}; *(f32x4*)(p.pgate + ob + 4) = (f32x4){go[4], go[5], go[6], go[7]};
  }
}
}

typedef float f32x2 __attribute__((ext_vector_type(2)));
constexpr float U8_SCALE = 32.f, V8_SCALE = 2.f;
constexpr int GT = 4;
constexpr int GW_WAVE_BYTES = GT * (2048 + 128 * 2 + 128 * 4);
static_assert(8 * GW_WAVE_BYTES <= SMEM_BYTES - 16, "gather LDS layout");
__device__ __forceinline__ float gelu_erf(float z) { return 0.5f * z * (1.f + erff(z * 0.70710678118654752f)); }
__device__ __forceinline__ float reduce8(float d0, float d1, float d2, float d3, float d4, float d5, float d6, float d7, int lane) {
  float e[4];
  { auto r0 = __builtin_amdgcn_permlane32_swap(__float_as_uint(d0), __float_as_uint(d4), false, false); e[0] = __uint_as_float(r0[0]) + __uint_as_float(r0[1]);
    auto r1 = __builtin_amdgcn_permlane32_swap(__float_as_uint(d1), __float_as_uint(d5), false, false); e[1] = __uint_as_float(r1[0]) + __uint_as_float(r1[1]);
    auto r2 = __builtin_amdgcn_permlane32_swap(__float_as_uint(d2), __float_as_uint(d6), false, false); e[2] = __uint_as_float(r2[0]) + __uint_as_float(r2[1]);
    auto r3 = __builtin_amdgcn_permlane32_swap(__float_as_uint(d3), __float_as_uint(d7), false, false); e[3] = __uint_as_float(r3[0]) + __uint_as_float(r3[1]); }
  float f0, f1;
  { auto r0 = __builtin_amdgcn_permlane16_swap(__float_as_uint(e[0]), __float_as_uint(e[2]), false, false); f0 = __uint_as_float(r0[0]) + __uint_as_float(r0[1]);
    auto r1 = __builtin_amdgcn_permlane16_swap(__float_as_uint(e[1]), __float_as_uint(e[3]), false, false); f1 = __uint_as_float(r1[0]) + __uint_as_float(r1[1]); }
  const bool up = (lane & 8) != 0; const float keep = up ? f1 : f0, send = up ? f0 : f1;
  float g = keep + __shfl_xor(send, 8);
  g += __shfl_xor(g, 4); g += __shfl_xor(g, 2); g += __shfl_xor(g, 1);
  return g;
}
template <int NEXT>
__device__ void phase_peer_gather(const Params& p, int layer, char* smem) {
  const unsigned char* U8 = p.U8 + (size_t)layer * 16384 * 1024; const unsigned char* V8 = p.V8 + (size_t)layer * 16384 * 1024;
  for (int job = blockIdx.x; job < T / (8 * GT); job += gridDim.x) {
    int tid_ = threadIdx.x; asm volatile("" : "+v"(tid_));
    const int tid = tid_, wid = tid >> 6, lane = tid & 63;
    const int tb = (job * 8 + wid) * GT;
    const int vidx = 4 * (lane >> 5) + 2 * ((lane >> 4) & 1) + ((lane >> 3) & 1);
    char* wl = smem + wid * GW_WAVE_BYTES; bf16_t* sx = (bf16_t*)wl; bf16_t* sidx = (bf16_t*)(wl + GT * 2048); float* sgate = (float*)(wl + GT * 2048 + GT * 256);
#pragma unroll 1
    for (int g = 0; g < GT; ++g) { const size_t t = (size_t)(tb + g);
      *(u32x4*)(sx + g * 1024 + lane * 16) = *(const u32x4*)(p.H + t * D + lane * 16); *(u32x4*)(sx + g * 1024 + lane * 16 + 8) = *(const u32x4*)(p.H + t * D + lane * 16 + 8);
      const int ia = p.pidx[t * 128 + lane], ib = p.pidx[t * 128 + 64 + lane]; const float ga = p.pgate[t * 128 + lane], gb = p.pgate[t * 128 + 64 + lane];
      const int wa = ia >> 10, wb = ib >> 10; int off = 0, pa = 0, pb = 0;
#pragma unroll
      for (int w = 0; w < 16; ++w) { const unsigned long long m0 = __ballot(wa == w), m1 = __ballot(wb == w); const int c0 = __popcll(m0), c1 = __popcll(m1);
        const int r0 = __builtin_amdgcn_mbcnt_hi((unsigned)(m0 >> 32), __builtin_amdgcn_mbcnt_lo((unsigned)m0, 0)), r1 = __builtin_amdgcn_mbcnt_hi((unsigned)(m1 >> 32), __builtin_amdgcn_mbcnt_lo((unsigned)m1, 0));
        if (wa == w) pa = off + r0; if (wb == w) pb = off + c0 + r1; off += c0 + c1; }
      sidx[g * 128 + pa] = (bf16_t)ia; sgate[g * 128 + pa] = ga; sidx[g * 128 + pb] = (bf16_t)ib; sgate[g * 128 + pb] = gb; }
    f32x2 acc[GT][8];
#pragma unroll
    for (int g = 0; g < GT; ++g)
#pragma unroll
      for (int i = 0; i < 8; ++i) acc[g][i] = (f32x2){0.f, 0.f};
#pragma unroll 1
    for (int hb = 0; hb < 16; ++hb) {
#pragma unroll
      for (int g = 0; g < GT; ++g) {
        const int myidx = (int)sidx[g * 128 + hb * 8 + (lane & 7)]; const float mygate = sgate[g * 128 + hb * 8 + vidx];
        const u32x4 h0 = *(const u32x4*)(sx + g * 1024 + lane * 16), h1 = *(const u32x4*)(sx + g * 1024 + lane * 16 + 8);
        const u32 hx[8] = {h0.x, h0.y, h0.z, h0.w, h1.x, h1.y, h1.z, h1.w};
        u32x4 ur[8], vr[8];
#pragma unroll
        for (int k = 0; k < 8; ++k) { const int e = __builtin_amdgcn_readlane(myidx, k); ur[k] = *(const u32x4*)(U8 + (size_t)e * 1024 + lane * 16); if (k < 4) vr[k] = *(const u32x4*)(V8 + (size_t)e * 1024 + lane * 16); }
        float d[8];
#pragma unroll
        for (int k = 0; k < 8; ++k) { const u32 w[4] = {ur[k].x, ur[k].y, ur[k].z, ur[k].w}; float a = 0.f;
#pragma unroll
          for (int j = 0; j < 4; ++j) { const u32 lo = __builtin_bit_cast(u32, __builtin_amdgcn_cvt_scalef32_pk_bf16_fp8(w[j], 1.0f, false)), hi = __builtin_bit_cast(u32, __builtin_amdgcn_cvt_scalef32_pk_bf16_fp8(w[j], 1.0f, true));
            a = dot2bf(lo, hx[2 * j], a); a = dot2bf(hi, hx[2 * j + 1], a); }
          asm volatile("" : "+v"(a));
          d[k] = a; }
        asm volatile("" ::: "memory");
#pragma unroll
        for (int k = 4; k < 8; ++k) { const int e = __builtin_amdgcn_readlane(myidx, k); vr[k] = *(const u32x4*)(V8 + (size_t)e * 1024 + lane * 16); }
        const float z = reduce8(d[0], d[1], d[2], d[3], d[4], d[5], d[6], d[7], lane) * (1.f / U8_SCALE);
        const float cf = mygate * gelu_erf(z) * (1.f / V8_SCALE);
#pragma unroll
        for (int k = 0; k < 8; ++k) { const float ck = __uint_as_float(__builtin_amdgcn_readlane(__float_as_uint(cf), 32 * (k >> 2) + 16 * ((k >> 1) & 1) + 8 * (k & 1)));
          const u32 w[4] = {vr[k].x, vr[k].y, vr[k].z, vr[k].w}; const f32x2 c2 = (f32x2){ck, ck};
#pragma unroll
          for (int j = 0; j < 4; ++j) { const f32x2 lo = __builtin_amdgcn_cvt_pk_f32_fp8((int)w[j], false), hi = __builtin_amdgcn_cvt_pk_f32_fp8((int)w[j], true);
            acc[g][2 * j] = lo * c2 + acc[g][2 * j]; acc[g][2 * j + 1] = hi * c2 + acc[g][2 * j + 1]; } }
        asm volatile("" ::: "memory");
      }
      if ((hb & 3) == 3) __syncthreads();
    }
#pragma unroll
    for (int g = 0; g < GT; ++g) { const int t = tb + g, b = t / S;
      const float* g2 = p.mod + (size_t)(layer * 8 + b) * 6144 + 5120 + lane * 16; float* xp = p.X + (size_t)t * D + lane * 16;
      float xv[16]; float ss = 0.f;
#pragma unroll
      for (int q = 0; q < 4; ++q) { const f32x4 x0 = *(const f32x4*)(xp + 4 * q), g0 = *(const f32x4*)(g2 + 4 * q);
        xv[4 * q + 0] = x0.x + g0.x * acc[g][2 * q].x; xv[4 * q + 1] = x0.y + g0.y * acc[g][2 * q].y; xv[4 * q + 2] = x0.z + g0.z * acc[g][2 * q + 1].x; xv[4 * q + 3] = x0.w + g0.w * acc[g][2 * q + 1].y; }
#pragma unroll
      for (int i = 0; i < 16; ++i) ss += xv[i] * xv[i];
      ss = wave_sum(ss); const float r = rsqrtf(ss * (1.f / D) + EPS);
      if (NEXT == 0) {
        const float* ml = p.mod + (size_t)((layer + 1) * 8 + b) * 6144 + lane * 16; const float* gn = p.nmg + (layer + 1) * D + lane * 16; float y[16];
#pragma unroll
        for (int i = 0; i < 16; ++i) y[i] = xv[i] * r * gn[i] * (1.f + ml[1024 + i]) + ml[i];
#pragma unroll
        for (int q = 0; q < 4; ++q) *(f32x4*)(xp + 4 * q) = (f32x4){xv[4 * q], xv[4 * q + 1], xv[4 * q + 2], xv[4 * q + 3]};
        u32x4 w0, w1; w0.x = pack2(y[0], y[1]); w0.y = pack2(y[2], y[3]); w0.z = pack2(y[4], y[5]); w0.w = pack2(y[6], y[7]); w1.x = pack2(y[8], y[9]); w1.y = pack2(y[10], y[11]); w1.z = pack2(y[12], y[13]); w1.w = pack2(y[14], y[15]);
        *(u32x4*)(p.H + (size_t)t * D + lane * 16) = w0; *(u32x4*)(p.H + (size_t)t * D + lane * 16 + 8) = w1;
      } else {
        const float* fg = p.final_g + lane * 16;
#pragma unroll
        for (int q = 0; q < 4; ++q) *(f32x4*)(xp + 4 * q) = (f32x4){xv[4 * q] * r * fg[4 * q], xv[4 * q + 1] * r * fg[4 * q + 1], xv[4 * q + 2] * r * fg[4 * q + 2], xv[4 * q + 3] * r * fg[4 * q + 3]};
      }
      asm volatile("" ::: "memory");
    }
    __syncthreads();
  }
}

template <bool WITH_GATES>
__device__ void phase_norm(const Params& p, const float* __restrict__ xin, const float* __restrict__ g, const float* __restrict__ modl, int sh_off, int sc_off, char* smem) {
  float* wg = (float*)smem;
  if (WITH_GATES) { __syncthreads(); for (int i = threadIdx.x; i < 16 * 1024; i += NTHREADS) wg[i] = p.Wg[i]; __syncthreads(); }
  for (int job = blockIdx.x; job < T / 32; job += gridDim.x) {
    int tid_ = threadIdx.x; asm volatile("" : "+v"(tid_));
    const int tid = tid_, wid = tid >> 6, lane = tid & 63; const int tb = job * 32 + wid * 4, b = tb / S;
    f32x4 v[4][4];
#pragma unroll
    for (int q = 0; q < 4; ++q)
#pragma unroll
      for (int i = 0; i < 4; ++i) v[q][i] = *(const f32x4*)(xin + (size_t)(tb + q) * D + i * 256 + lane * 4);
    const float* shp = modl + (size_t)b * 6144 + sh_off; const float* scp = modl + (size_t)b * 6144 + sc_off;
    f32x4 ga[4], gc[4];
#pragma unroll
    for (int i = 0; i < 4; ++i) { const int d = i * 256 + lane * 4; const f32x4 gg = *(const f32x4*)(g + d), s1 = *(const f32x4*)(scp + d); ga[i] = gg * (1.f + s1); gc[i] = *(const f32x4*)(shp + d); }
#pragma unroll
    for (int q = 0; q < 4; ++q) { float ss = 0.f;
#pragma unroll
      for (int i = 0; i < 4; ++i) ss += v[q][i].x * v[q][i].x + v[q][i].y * v[q][i].y + v[q][i].z * v[q][i].z + v[q][i].w * v[q][i].w;
      ss = wave_sum(ss); const float r = rsqrtf(ss * (1.f / D) + EPS);
#pragma unroll
      for (int i = 0; i < 4; ++i) { v[q][i] = v[q][i] * r * ga[i] + gc[i]; u32x2 w; w.x = pack2(v[q][i].x, v[q][i].y); w.y = pack2(v[q][i].z, v[q][i].w); *(u32x2*)(p.H + (size_t)(tb + q) * D + i * 256 + lane * 4) = w; }
      if (WITH_GATES) { float myg = 0.f;
#pragma unroll 2
        for (int gi = 0; gi < 16; ++gi) { float a = 0.f;
#pragma unroll
          for (int i = 0; i < 4; ++i) { const f32x4 w4 = *(const f32x4*)(wg + gi * 1024 + i * 256 + lane * 4); a += v[q][i].x * w4.x + v[q][i].y * w4.y + v[q][i].z * w4.z + v[q][i].w * w4.w; }
          a = wave_sum(a); if (lane == gi) myg = a; }
        if (lane < 16) p.gates[(size_t)(tb + q) * 16 + lane] = myg + p.ev_b_in[2560 + lane]; }
    }
  }
}
__device__ void phase_cat(const Params& p) {
  for (int job = blockIdx.x; job < T / 32; job += gridDim.x) {
    int tid_ = threadIdx.x; asm volatile("" : "+v"(tid_));
    const int tid = tid_, wid = tid >> 6, lane = tid & 63; const int tb = job * 32 + wid * 4;
    u32x4 a[4], bq[4], so[4];
#pragma unroll
    for (int q = 0; q < 4; ++q) { const size_t o = (size_t)(tb + q) * 512 + lane * 8; a[q] = *(const u32x4*)(p.HS + o); bq[q] = *(const u32x4*)(p.HS + (size_t)T * 512 + o); so[q] = *(const u32x4*)(p.ZO + o); }
    const f32x4 g0 = *(const f32x4*)(p.mnorm_g + lane * 8), g1 = *(const f32x4*)(p.mnorm_g + lane * 8 + 4);
#pragma unroll
    for (int q = 0; q < 4; ++q) { float x[8]; const u32 aw[4] = {a[q].x, a[q].y, a[q].z, a[q].w}, bw[4] = {bq[q].x, bq[q].y, bq[q].z, bq[q].w}, sw[4] = {so[q].x, so[q].y, so[q].z, so[q].w};
      float ss = 0.f;
#pragma unroll
      for (int j = 0; j < 4; ++j) { x[2 * j] = bflo(aw[j]) + bflo(bw[j]); x[2 * j + 1] = bfhi(aw[j]) + bfhi(bw[j]); ss += x[2 * j] * x[2 * j] + x[2 * j + 1] * x[2 * j + 1]; }
      ss += __shfl_xor(ss, 1); ss += __shfl_xor(ss, 2); ss += __shfl_xor(ss, 4); ss += __shfl_xor(ss, 8);
      const float r = rsqrtf(ss * (1.f / 128.f) + EPS);
      u32x4 w; w.x = pack2(x[0] * r * g0.x * bflo(sw[0]), x[1] * r * g0.y * bfhi(sw[0])); w.y = pack2(x[2] * r * g0.z * bflo(sw[1]), x[3] * r * g0.w * bfhi(sw[1]));
      w.z = pack2(x[4] * r * g1.x * bflo(sw[2]), x[5] * r * g1.y * bfhi(sw[2])); w.w = pack2(x[6] * r * g1.z * bflo(sw[3]), x[7] * r * g1.w * bfhi(sw[3]));
      *(u32x4*)(p.CAT + (size_t)(tb + q) * 1024 + lane * 8) = w; }
  }
}
__device__ void phase_qkrope(const Params& p, char* smem) {
  float* tab = (float*)smem;
  __syncthreads();
  for (int i = threadIdx.x; i < 64 * 32; i += NTHREADS) { const int pos = i >> 5, fi = i & 31; const float fr = exp2f(-(float)(2 * fi) * (13.287712379549449f / 64.f)); float sn, cs; sincosf((float)pos * fr, &sn, &cs); tab[2 * i] = cs; tab[2 * i + 1] = sn; }
  __syncthreads();
  for (int job = blockIdx.x; job < T / 16; job += gridDim.x) {
    int tid_ = threadIdx.x; asm volatile("" : "+v"(tid_));
    const int tid = tid_, wid = tid >> 6, lane = tid & 63; const int tb = job * 16 + wid * 2;
    u32x4 raw[2][3];
#pragma unroll
    for (int q = 0; q < 2; ++q)
#pragma unroll
      for (int i = 0; i < 3; ++i) raw[q][i] = *(const u32x4*)(p.QKV + (size_t)(tb + q) * 1536 + (lane + 64 * i) * 8);
#pragma unroll
    for (int q = 0; q < 2; ++q) { const int t = tb + q, b = t / S, s = t & (S - 1);
#pragma unroll
      for (int i = 0; i < 3; ++i) { const int c = lane + 64 * i, hh = c >> 4, cc = c & 15; float x[8]; const u32 rw[4] = {raw[q][i].x, raw[q][i].y, raw[q][i].z, raw[q][i].w};
#pragma unroll
        for (int j = 0; j < 4; ++j) { x[2 * j] = bflo(rw[j]); x[2 * j + 1] = bfhi(rw[j]); }
        u32x4 w;
        if (hh < 10) { float ss = 0.f;
#pragma unroll
          for (int j = 0; j < 8; ++j) ss += x[j] * x[j];
          ss += __shfl_xor(ss, 1); ss += __shfl_xor(ss, 2); ss += __shfl_xor(ss, 4); ss += __shfl_xor(ss, 8);
          const float r = rsqrtf(ss * (1.f / 128.f) + EPS); const float* gp = (hh < 8 ? p.qn_g : p.kn_g) + cc * 8;
          const int pos = cc < 8 ? (s >> 6) : (s & 63); const float* tp = tab + (pos * 32 + (cc & 7) * 4) * 2; float y[8];
#pragma unroll
          for (int j = 0; j < 4; ++j) { const float x0 = x[2 * j] * r * gp[2 * j], x1 = x[2 * j + 1] * r * gp[2 * j + 1], cs = tp[2 * j], sn = tp[2 * j + 1]; y[2 * j] = x0 * cs - x1 * sn; y[2 * j + 1] = x0 * sn + x1 * cs; }
          w.x = pack2(y[0], y[1]); w.y = pack2(y[2], y[3]); w.z = pack2(y[4], y[5]); w.w = pack2(y[6], y[7]);
        } else w = raw[q][i];
        bf16_t* dst = hh < 8 ? p.Qh + (((size_t)b * 8 + hh) * S + s) * 128 : (hh < 10 ? p.Kh + (((size_t)b * 2 + hh - 8) * S + s) * 128 : p.Vh + (((size_t)b * 2 + hh - 10) * S + s) * 128);
        *(u32x4*)(dst + cc * 8) = w; }
    }
  }
}

__device__ void phase_attn_naive(const Params& p) {
  const int tid = threadIdx.x, wid = tid >> 6, lane = tid & 63;
  for (int job = blockIdx.x; job < T * 2 / 8; job += gridDim.x) {
    const int w = job * 8 + wid, kv = w & 1, t = w >> 1, b = t / S, s = t & (S - 1);
    float q0[4], q1[4], m[4], l[4], o0[4], o1[4];
#pragma unroll
    for (int g = 0; g < 4; ++g) { const u32 qq = *(const u32*)(p.Qh + (((size_t)b * 8 + kv * 4 + g) * S + s) * 128 + lane * 2); q0[g] = bflo(qq); q1[g] = bfhi(qq); m[g] = -1e30f; l[g] = 0.f; o0[g] = 0.f; o1[g] = 0.f; }
    const bf16_t* Kb = p.Kh + ((size_t)b * 2 + kv) * S * 128; const bf16_t* Vb = p.Vh + ((size_t)b * 2 + kv) * S * 128;
    for (int k = 0; k < S; ++k) { const u32 kk = *(const u32*)(Kb + (size_t)k * 128 + lane * 2), vv = *(const u32*)(Vb + (size_t)k * 128 + lane * 2);
      const float k0 = bflo(kk), k1 = bfhi(kk), v0 = bflo(vv), v1 = bfhi(vv);
#pragma unroll
      for (int g = 0; g < 4; ++g) { const float sc = wave_sum(q0[g] * k0 + q1[g] * k1) * KSCALE; const float mn = fmaxf(m[g], sc), al = __expf(m[g] - mn), pw = __expf(sc - mn);
        l[g] = l[g] * al + pw; o0[g] = o0[g] * al + pw * v0; o1[g] = o1[g] * al + pw * v1; m[g] = mn; } }
#pragma unroll
    for (int g = 0; g < 4; ++g) *(u32*)(p.CAT + (size_t)t * 1024 + (kv * 4 + g) * 128 + lane * 2) = pack2(o0[g] / l[g], o1[g] / l[g]);
  }
}

namespace att {
using bf16 = unsigned short;
constexpr int   D = 128, NW = 8, QBLK = 32, KVBLK = 64;
constexpr float SCALE = 0.088388347648318440f;
constexpr float THR = 8.f;
constexpr int SDEPTH = 2;
constexpr int LDQ = 128, LDK = 128, LDO = 1024;
constexpr size_t SHM_V = KVBLK * D * 2, SHM_K = KVBLK * D * 2, SHM_ATTN = 2 * SHM_V + 2 * SHM_K + NW * 64 * 4;
using bf16x8 = __attribute__((ext_vector_type(8))) short;
using s16x4  = __attribute__((ext_vector_type(4))) short;
using f32x16 = __attribute__((ext_vector_type(16))) float;
using f32x8  = __attribute__((ext_vector_type(8))) float;
using u32x4  = __attribute__((ext_vector_type(4))) unsigned;
#define KSWZ(row, colB) ((row) * 256 + ((colB) ^ (((row) & 7) << 4)))
#define SBAR() __builtin_amdgcn_sched_barrier(0)
__device__ __forceinline__ int crow(int r, int hi) { return (r & 3) + 8 * (r >> 2) + 4 * hi; }
__device__ __forceinline__ unsigned cvtpk(float lo, float hi) {
  unsigned r; asm volatile("v_cvt_pk_bf16_f32 %0, %1, %2" : "=v"(r) : "v"(lo), "v"(hi)); return r;
}
template <typename TIn> struct Stage;
template <> struct Stage<bf16>  { using T = bf16x8;
  __device__ static __forceinline__ T ld8(const bf16* p) { return *reinterpret_cast<const bf16x8*>(p); }
  __device__ static __forceinline__ bf16x8 tobf(T x) { return x; } };
template <> struct Stage<float> { using T = f32x8;
  __device__ static __forceinline__ T ld8(const float* p) { return *reinterpret_cast<const f32x8*>(p); }
  __device__ static __forceinline__ bf16x8 tobf(T x) {
    u32x4 w = {cvtpk(x[0], x[1]), cvtpk(x[2], x[3]), cvtpk(x[4], x[5]), cvtpk(x[6], x[7])}; return *reinterpret_cast<bf16x8*>(&w); } };

__device__ __forceinline__ void partialSM(f32x16& p0, f32x16& p1, float& m_reg, float& mn, float& alpha) {
  constexpr float C = SCALE * 1.4426950408889634f;
  float pmax = p0[0]; for (int r = 1; r < 16; ++r) pmax = fmaxf(pmax, p0[r]); for (int r = 0; r < 16; ++r) pmax = fmaxf(pmax, p1[r]);
  { auto rr = __builtin_amdgcn_permlane32_swap(__float_as_uint(pmax), __float_as_uint(pmax), false, false);
    pmax = fmaxf(__uint_as_float(rr[0]), __uint_as_float(rr[1])); }
  if (__builtin_expect(__all(pmax - m_reg <= THR / SCALE), 1)) { mn = m_reg; alpha = 1.f; }
  else { mn = fmaxf(m_reg, pmax); alpha = __builtin_amdgcn_exp2f((m_reg - mn) * C); m_reg = mn; }
  float mnC = -mn * C;
  for (int r = 0; r < 16; ++r) p0[r] = fmaf(p0[r], C, mnC); for (int r = 0; r < 16; ++r) p1[r] = fmaf(p1[r], C, mnC);
  for (int r = 0; r < 16; ++r) p0[r] = __builtin_amdgcn_exp2f(p0[r]);
}
__device__ __forceinline__ void finishSM(f32x16& p0, f32x16& p1, float alpha, float& l_reg, bf16x8& pa0, bf16x8& pa1, bf16x8& pa2, bf16x8& pa3) {
  for (int r = 0; r < 16; ++r) p1[r] = __builtin_amdgcn_exp2f(p1[r]);
  float ps = 0; for (int r = 0; r < 16; ++r) ps += p0[r]; for (int r = 0; r < 16; ++r) ps += p1[r];
  { auto rr = __builtin_amdgcn_permlane32_swap(__float_as_uint(ps), __float_as_uint(ps), false, false);
    ps = __uint_as_float(rr[0]) + __uint_as_float(rr[1]); }
  l_reg = l_reg * alpha + ps;
#define PK4(P, BASE, OUT) do { unsigned a0 = cvtpk(P[BASE + 0], P[BASE + 1]), a1 = cvtpk(P[BASE + 2], P[BASE + 3]);   \
    unsigned b0 = cvtpk(P[BASE + 4], P[BASE + 5]), b1 = cvtpk(P[BASE + 6], P[BASE + 7]);                              \
    auto r0 = __builtin_amdgcn_permlane32_swap(a0, b0, false, false); auto r1 = __builtin_amdgcn_permlane32_swap(a1, b1, false, false); \
    u32x4 w = {r0[0], r1[0], r0[1], r1[1]}; OUT = *reinterpret_cast<bf16x8*>(&w); } while (0)
  PK4(p0, 0, pa0); PK4(p0, 8, pa1); PK4(p1, 0, pa2); PK4(p1, 8, pa3);
#undef PK4
}
__device__ __forceinline__ void qkt(f32x16& p0, f32x16& p1, const bf16* Ks, const bf16x8* qr, int r32, int hi) {
  p0 = f32x16{}; p1 = f32x16{};
  for (int d0 = 0; d0 < 8; ++d0) { int cb = (d0 * 16 + hi * 8) * 2;
    bf16x8 b0 = *reinterpret_cast<const bf16x8*>((const char*)Ks + KSWZ(r32, cb));
    bf16x8 b1 = *reinterpret_cast<const bf16x8*>((const char*)Ks + KSWZ(32 + r32, cb));
    p0 = __builtin_amdgcn_mfma_f32_32x32x16_bf16(b0, qr[d0], p0, 0, 0, 0);
    p1 = __builtin_amdgcn_mfma_f32_32x32x16_bf16(b1, qr[d0], p1, 0, 0, 0); }
}
__device__ __forceinline__ int v_st(int k, int c) { const int kk = (k & ~0xC) | ((k & 4) << 1) | ((k & 8) >> 1); return ((kk >> 3) * 4 + (c >> 5)) * 512 + ((kk & 7) * 32 + (c & 31)) * 2; }
__device__ __forceinline__ int v_rd_base(int lane) { return ((lane & 3) << 3) | (((lane >> 2) & 3) << 6) | (((lane >> 4) & 1) << 5) | (((lane >> 5) & 1) << 8); }
constexpr int v_rd_off(int d0, int ks, int half) { return d0 * 512 + ks * 4096 + half * 2048; }
template <int OFF> __device__ __forceinline__ s16x4 tr_read(int vb) {
  s16x4 r; asm volatile("ds_read_b64_tr_b16 %0, %1 offset:%2" : "=&v"(r) : "v"(vb), "i"(OFF) : "memory"); return r;
}
template <int D0> __device__ __forceinline__ void pv_one(f32x16& od, int vb, bf16x8 pa0, bf16x8 pa1, bf16x8 pa2, bf16x8 pa3) {
  const s16x4 l0 = tr_read<v_rd_off(D0, 0, 0)>(vb), h0 = tr_read<v_rd_off(D0, 0, 1)>(vb), l1 = tr_read<v_rd_off(D0, 1, 0)>(vb), h1 = tr_read<v_rd_off(D0, 1, 1)>(vb);
  const s16x4 l2 = tr_read<v_rd_off(D0, 2, 0)>(vb), h2 = tr_read<v_rd_off(D0, 2, 1)>(vb), l3 = tr_read<v_rd_off(D0, 3, 0)>(vb), h3 = tr_read<v_rd_off(D0, 3, 1)>(vb);
  asm volatile("s_waitcnt lgkmcnt(0)" ::: "memory"); SBAR();
#define PK(L, H) (bf16x8){L[0], L[1], L[2], L[3], H[0], H[1], H[2], H[3]}
  od = __builtin_amdgcn_mfma_f32_32x32x16_bf16(pa0, PK(l0, h0), od, 0, 0, 0);
  od = __builtin_amdgcn_mfma_f32_32x32x16_bf16(pa1, PK(l1, h1), od, 0, 0, 0);
  od = __builtin_amdgcn_mfma_f32_32x32x16_bf16(pa2, PK(l2, h2), od, 0, 0, 0);
  od = __builtin_amdgcn_mfma_f32_32x32x16_bf16(pa3, PK(l3, h3), od, 0, 0, 0);
#undef PK
}
__device__ __forceinline__ void pv_d0(f32x16* o, int vb, bf16x8 pa0, bf16x8 pa1, bf16x8 pa2, bf16x8 pa3) {
  pv_one<0>(o[0], vb, pa0, pa1, pa2, pa3); pv_one<1>(o[1], vb, pa0, pa1, pa2, pa3); pv_one<2>(o[2], vb, pa0, pa1, pa2, pa3); pv_one<3>(o[3], vb, pa0, pa1, pa2, pa3);
}

template <typename TQ>
__device__ __forceinline__ void attn_dense_body(const TQ* __restrict__ Qb, const bf16* __restrict__ Kh, const bf16* __restrict__ Vh,
                                                bf16* __restrict__ Ob, int seq, char* lds) {
  using St = Stage<bf16>; using SQ = Stage<TQ>;
  int tid_ = threadIdx.x; asm volatile("" : "+v"(tid_)); const int tid = tid_, wid = tid >> 6, lane = tid & 63, r32 = lane & 31, hi = lane >> 5;
  bf16* V_lds = (bf16*)lds; bf16* K_lds = (bf16*)(lds + 2 * SHM_V);
  float* ws = (float*)(lds + 2 * SHM_V + 2 * SHM_K) + wid * 64; float* li_l = ws; float* al_l = ws + 32;
  float m_reg = -1e30f, l_reg = 0; f32x16 o[4] = {}; bf16x8 qr[8];
  const TQ* Qw = Qb + (long)(wid * QBLK + r32) * LDQ + hi * 8;
#pragma unroll
  for (int d0 = 0; d0 < 8; ++d0) qr[d0] = SQ::tobf(SQ::ld8(Qw + d0 * 16));
  const int sr = tid >> 4, sc = (tid & 15) * 8, vst0 = v_st(sr, sc), vst1 = v_st(32 + sr, sc);
  const int vb0 = (int)(uintptr_t)V_lds + v_rd_base(lane);
  struct { typename St::T vs0, vs1, ks0, ks1; } sr_[SDEPTH];
#define SLOAD(i, k0) do { sr_[i].vs0 = St::ld8(&Vh[(long)((k0) + sr) * LDK + sc]); sr_[i].vs1 = St::ld8(&Vh[(long)((k0) + 32 + sr) * LDK + sc]); \
    sr_[i].ks0 = St::ld8(&Kh[(long)((k0) + sr) * LDK + sc]); sr_[i].ks1 = St::ld8(&Kh[(long)((k0) + 32 + sr) * LDK + sc]); } while (0)
#define SWRITE(b, i) do { *(bf16x8*)((char*)V_lds + (b) * SHM_V + vst0) = St::tobf(sr_[i].vs0);          \
    *(bf16x8*)((char*)V_lds + (b) * SHM_V + vst1) = St::tobf(sr_[i].vs1); int kc = sc * 2;               \
    *(bf16x8*)((char*)K_lds + (b) * SHM_K + KSWZ(sr, kc)) = St::tobf(sr_[i].ks0);                       \
    *(bf16x8*)((char*)K_lds + (b) * SHM_K + KSWZ(32 + sr, kc)) = St::tobf(sr_[i].ks1); } while (0)
#define SWAIT() do { if constexpr (SDEPTH == 2) asm volatile("s_waitcnt vmcnt(4)" ::: "memory"); else asm volatile("s_waitcnt vmcnt(0)" ::: "memory"); } while (0)
#define RESC(a) do { if (__any((a) < 1.f)) { if (hi == 0) al_l[r32] = (a); asm volatile("s_waitcnt lgkmcnt(0)" ::: "memory"); \
    for (int d = 0; d < 4; ++d) for (int r = 0; r < 16; ++r) o[d][r] *= al_l[crow(r, hi)]; } } while (0)
  f32x16 pA0, pA1, pB0, pB1; float mnA, mnB, alA, alB; bf16x8 pa0, pa1, pa2, pa3; const int NT = seq / KVBLK;
  constexpr int SE = 0, SO = SDEPTH - 1;
  SLOAD(SE, 0); asm volatile("s_waitcnt vmcnt(0)" ::: "memory"); SWRITE(0, SE); __syncthreads();
  qkt(pA0, pA1, K_lds, qr, r32, hi); partialSM(pA0, pA1, m_reg, mnA, alA);
  SLOAD(SO, KVBLK); if constexpr (SDEPTH == 2) { if (2 < NT) SLOAD(SE, 2 * KVBLK); }
  SWAIT(); SWRITE(1, SO); __syncthreads();
  for (int j = 1; j + 1 < NT; j += 2) {
    SBAR(); qkt(pB0, pB1, (bf16*)((char*)K_lds + SHM_K), qr, r32, hi);
    finishSM(pA0, pA1, alA, l_reg, pa0, pa1, pa2, pa3); SBAR();
    SLOAD(SO, (j + SDEPTH) * KVBLK); SBAR();
    pv_d0(o, vb0, pa0, pa1, pa2, pa3); partialSM(pB0, pB1, m_reg, mnB, alB);
    __syncthreads(); SWAIT(); SWRITE(0, SE);
    RESC(alB); __syncthreads();
    SBAR(); qkt(pA0, pA1, K_lds, qr, r32, hi);
    finishSM(pB0, pB1, alB, l_reg, pa0, pa1, pa2, pa3); SBAR();
    if (SDEPTH == 1 || j + 3 < NT) SLOAD(SE, (j + 1 + SDEPTH) * KVBLK); SBAR();
    pv_d0(o, vb0 + (int)SHM_V, pa0, pa1, pa2, pa3); partialSM(pA0, pA1, m_reg, mnA, alA);
    __syncthreads(); SWAIT(); SWRITE(1, SO);
    RESC(alA); __syncthreads();
  }
  SBAR(); qkt(pB0, pB1, (bf16*)((char*)K_lds + SHM_K), qr, r32, hi);
  finishSM(pA0, pA1, alA, l_reg, pa0, pa1, pa2, pa3); SBAR();
  pv_d0(o, vb0, pa0, pa1, pa2, pa3); partialSM(pB0, pB1, m_reg, mnB, alB);
  __syncthreads(); RESC(alB);
  finishSM(pB0, pB1, alB, l_reg, pa0, pa1, pa2, pa3); SBAR();
  pv_d0(o, vb0 + (int)SHM_V, pa0, pa1, pa2, pa3);
  if (hi == 0) li_l[r32] = l_reg; asm volatile("s_waitcnt lgkmcnt(0)" ::: "memory");
  float rli[16];
#pragma unroll
  for (int r = 0; r < 16; ++r) rli[r] = __builtin_amdgcn_rcpf(li_l[crow(r, hi)]);
  __syncthreads();
  bf16* Ol = (bf16*)lds + wid * (QBLK * D);
#pragma unroll
  for (int r = 0; r < 16; ++r) { const int orow = crow(r, hi);
#pragma unroll
    for (int d0 = 0; d0 < 4; ++d0) { const float v = o[d0][r] * rli[r]; unsigned u = __float_as_uint(v); u += 0x7FFFu + ((u >> 16) & 1u); Ol[orow * D + d0 * 32 + r32] = (bf16)(u >> 16); } }
  asm volatile("s_waitcnt lgkmcnt(0)" ::: "memory");
#pragma unroll
  for (int i = 0; i < 8; ++i) { const int row = i * 4 + (lane >> 4), ch = (lane & 15) * 8;
    const u32x4 v = *reinterpret_cast<const u32x4*>(Ol + row * D + ch);
    *reinterpret_cast<u32x4*>(Ob + (long)(wid * QBLK + row) * LDO + ch) = v; }
  __syncthreads();
#undef SLOAD
#undef SWRITE
#undef SWAIT
#undef RESC
}

}

__device__ void phase_attn(const Params& p, char* smem) {
  const int G = (int)gridDim.x, c = (int)blockIdx.x;
  for (int i = 0; i * G + c < 1024; ++i) {
    int pair, j;
    if (G == 256) { pair = 2 * (c & 7) + (i >> 1); j = (i & 1) * 32 + (c >> 3); } else { const int L = i * G + c; pair = L >> 6; j = L & 63; }
    const int b = pair >> 1, kv = pair & 1, qb = j >> 2, g = j & 3, h = kv * 4 + g;
    const bf16_t* Qb = p.Qh + (((size_t)b * 8 + h) * S + qb * 256) * 128; const bf16_t* Kp = p.Kh + ((size_t)b * 2 + kv) * S * 128; const bf16_t* Vp = p.Vh + ((size_t)b * 2 + kv) * S * 128;
    bf16_t* Ob = p.CAT + ((size_t)b * S + qb * 256) * 1024 + h * 128;
    att::attn_dense_body<att::bf16>(Qb, Kp, Vp, Ob, S, smem);
  }
}

#define XB_TMO      128
#define XB_XCNT(j)  (256  + 64 * (j))
#define XB_XSUB(j)  (1280 + 64 * (j))
#define XB_XGEN(j)  (2304 + 64 * (j))
#define XB_TOP      3328
#define XB_TOPGEN   3392
#define XCD_BAR_WORDS 3456
#define XB_SPIN_CAP (1u << 18)
#define LAS __attribute__((address_space(3)))

__device__ __forceinline__ unsigned xb_ld(unsigned* p)              { return __hip_atomic_load(p, __ATOMIC_RELAXED, __HIP_MEMORY_SCOPE_AGENT); }
__device__ __forceinline__ unsigned xb_add(unsigned* p, unsigned v) { return __hip_atomic_fetch_add(p, v, __ATOMIC_RELAXED, __HIP_MEMORY_SCOPE_AGENT); }
__device__ __forceinline__ unsigned xb_xcc_id() { return (unsigned)__builtin_amdgcn_s_getreg((3 << 11) | 20) & 0xFu; }
#define XB_SPIN(cond, bar) do { unsigned _sp = 0; while (cond) { __builtin_amdgcn_s_sleep(1); \
    if ((++_sp & 255u) == 0u) { if (xb_ld(&(bar)[XB_TMO])) break; if (_sp > XB_SPIN_CAP) { atomicAdd(&(bar)[XB_TMO], 1u); break; } } } } while (0)

struct XcdBarrier {
    unsigned* bar; unsigned x;
    volatile LAS unsigned* st;
};

__device__ __forceinline__ XcdBarrier xcd_barrier_post(unsigned* bar, volatile LAS unsigned* st) {
    XcdBarrier b; b.bar = bar; b.x = xb_xcc_id(); b.st = st;
    if (threadIdx.x == 0) (void)xb_add(&bar[XB_XCNT(b.x)], 1u);
    return b;
}
__device__ __forceinline__ void xcd_barrier_complete(unsigned* bar, unsigned x, unsigned& nloc, unsigned& nx) {
    const unsigned G = gridDim.x * gridDim.y * gridDim.z;
    unsigned sum, cnt, mine, sp = 0u;
    for (;;) {
        sum = 0u; cnt = 0u; mine = 0u;
#pragma unroll
        for (unsigned j = 0; j < 16; ++j) { const unsigned c = xb_ld(&bar[XB_XCNT(j)]); sum += c; cnt += (c > 0u) ? 1u : 0u; mine = (j == x) ? c : mine; }
        if (sum == G) break;
        __builtin_amdgcn_s_sleep(1);
        if ((++sp & 255u) == 0u) { if (xb_ld(&bar[XB_TMO])) break; if (sp > XB_SPIN_CAP) { atomicAdd(&bar[XB_TMO], 1u); break; } }
    }
    nloc = mine > 0u ? mine : 1u; nx = cnt > 0u ? cnt : 1u;
}

__device__ __forceinline__ void xcd_barrier(const XcdBarrier& b) {
    asm volatile("s_waitcnt vmcnt(0)" ::: "memory");
    __syncthreads();
    if (threadIdx.x == 0) {
        unsigned* bar = b.bar;
        __builtin_amdgcn_s_waitcnt(0);
        unsigned nloc = b.st[0], nx = b.st[1];
        if (nloc == 0u) { xcd_barrier_complete(bar, b.x, nloc, nx); b.st[0] = nloc; b.st[1] = nx; }
        const unsigned old = xb_add(&bar[XB_XSUB(b.x)], 1u);
        const unsigned gen = old / nloc;
        if (old + 1u == (gen + 1u) * nloc) {
            __builtin_amdgcn_fence(__ATOMIC_RELEASE, "agent");
            asm volatile("s_waitcnt vmcnt(0)" ::: "memory");
            const unsigned og = xb_add(&bar[XB_TOP], 1u);
            const unsigned tg = og / nx;
            if (og + 1u == (tg + 1u) * nx) xb_add(&bar[XB_TOPGEN], 1u);
            else XB_SPIN(xb_ld(&bar[XB_TOPGEN]) == tg, bar);
            __builtin_amdgcn_fence(__ATOMIC_ACQUIRE, "agent");
            xb_add(&bar[XB_XGEN(b.x)], 1u);
            asm volatile("s_waitcnt vmcnt(0)" ::: "memory");
        } else {
            XB_SPIN(xb_ld(&bar[XB_XGEN(b.x)]) == gen, bar);
            __builtin_amdgcn_fence(__ATOMIC_ACQUIRE, "agent");
            asm volatile("s_waitcnt vmcnt(0)" ::: "memory");
        }
    }
    __syncthreads();
}


constexpr int NPH = 19;
__global__ __launch_bounds__(NTHREADS, 2) void mega(Params p, int ph0, int ph1) {
  extern __shared__ __attribute__((aligned(16))) char smem[];
  cg::grid_group grid = cg::this_grid();
  volatile LAS unsigned* xst = (volatile LAS unsigned*)(LAS char*)(smem + SMEM_BYTES - 16);
  if (threadIdx.x == 0) { xst[0] = 0u; xst[1] = 0u; }
  __syncthreads();
  const XcdBarrier xb = xcd_barrier_post(p.bar, xst);
#ifndef REP_MASK
#define REP_MASK 0
#endif
#define GSYNC(k) do { if ((k) == 1) grid.sync(); else xcd_barrier(xb); } while (0)
#define PHASE(k, call) if (ph0 <= (k) && (k) < ph1) { if ((k) > ph0) GSYNC(k); if ((REP_MASK >> (k)) & 1) { { call; } xcd_barrier(xb); } call; }
#if !defined(ONLY_PHASE) || ONLY_PHASE == 0
  PHASE(0, phase_prep(p, smem))
#endif
#if !defined(ONLY_PHASE) || ONLY_PHASE == 1
  PHASE(1, phase_norm<true>(p, p.x, p.nmg, p.mod, 0, 1024, smem))
#endif
#if !defined(ONLY_PHASE) || ONLY_PHASE == 2
  PHASE(2, phase_gemm_fast(p.H, p.Wt_evin, T, 2560, 1024, (EpiEvin{p.ZQK, p.ZV, p.ZO, p.ZP, p.ev_b_in}), smem))
#endif
#if !defined(ONLY_PHASE) || ONLY_PHASE == 3
  PHASE(3, cp::phase_convpool(p, smem))
#endif
#if !defined(ONLY_PHASE) || ONLY_PHASE == 4
  PHASE(4, ml::phase_mlstm(p, smem))
#endif
#if !defined(ONLY_PHASE) || ONLY_PHASE == 5
  PHASE(5, phase_cat(p))
#endif
#if !defined(ONLY_PHASE) || ONLY_PHASE == 6
  PHASE(6, phase_gemm_fast(p.CAT, p.Wt_evout, T, 1024, 1024, (EpiRes{p.x, p.X, p.mod + 2048}), smem))
#endif
#if !defined(ONLY_PHASE) || ONLY_PHASE == 7
  PHASE(7, phase_norm<false>(p, p.X, p.nfg, p.mod, 3072, 4096, smem))
#endif
#if !defined(ONLY_PHASE) || ONLY_PHASE == 8
  PHASE(8, phase_gemm_fast(p.H, p.Wt_q, T, 2048, 1024, (EpiPlain{p.QP, 2048}), smem))
#endif
#if !defined(ONLY_PHASE) || ONLY_PHASE == 9
  PHASE(9, sel::phase_peer_select(p, 0, smem))
#endif
#if !defined(ONLY_PHASE) || ONLY_PHASE == 10
  PHASE(10, phase_peer_gather<0>(p, 0, smem))
#endif
#if !defined(ONLY_PHASE) || ONLY_PHASE == 11
  PHASE(11, phase_gemm_fast(p.H, p.Wt_odin, T, 1536, 1024, (EpiPlain{p.QKV, 1536}), smem))
#endif
#if !defined(ONLY_PHASE) || ONLY_PHASE == 12
  PHASE(12, phase_qkrope(p, smem))
#endif
#if !defined(ONLY_PHASE) || ONLY_PHASE == 13
  PHASE(13, phase_attn(p, smem))
#endif
#if !defined(ONLY_PHASE) || ONLY_PHASE == 14
  PHASE(14, phase_gemm_fast(p.CAT, p.Wt_odout, T, 1024, 1024, (EpiRes{p.X, p.X, p.mod + (size_t)8 * 6144 + 2048}), smem))
#endif
#if !defined(ONLY_PHASE) || ONLY_PHASE == 15
  PHASE(15, phase_norm<false>(p, p.X, p.nfg + D, p.mod + (size_t)8 * 6144, 3072, 4096, smem))
#endif
#if !defined(ONLY_PHASE) || ONLY_PHASE == 16
  PHASE(16, phase_gemm_fast(p.H, p.Wt_q + (size_t)2048 * 1024, T, 2048, 1024, (EpiPlain{p.QP, 2048}), smem))
#endif
#if !defined(ONLY_PHASE) || ONLY_PHASE == 17
  PHASE(17, sel::phase_peer_select(p, 1, smem))
#endif
#if !defined(ONLY_PHASE) || ONLY_PHASE == 18
  PHASE(18, phase_peer_gather<1>(p, 1, smem))
#endif
#undef PHASE
}
}

extern "C" void kernel_launch(void* const* d_in, const int* in_sizes, int n_in, void* d_out, int out_size, void* d_ws, size_t ws_size, hipStream_t stream) {
  (void)in_sizes; (void)n_in; (void)out_size;
  Params p{};
  const float** fin = (const float**)&p;
  for (int i = 0; i < 23; ++i) fin[i] = (const float*)d_in[i];
  p.X = (float*)d_out;
  char* ws = (char*)d_ws; size_t off = 0;
  auto alloc = [&](size_t bytes) { char* q = ws + off; off += (bytes + 255) / 256 * 256; return q; };
  p.U8 = (unsigned char*)alloc((size_t)2 * 16384 * 1024); p.V8 = (unsigned char*)alloc((size_t)2 * 16384 * 1024);
  p.Wt_evin = (bf16_t*)alloc((size_t)2560 * 1024 * 2); p.Wt_evout = (bf16_t*)alloc((size_t)1024 * 1024 * 2); p.Wt_odin = (bf16_t*)alloc((size_t)1536 * 1024 * 2);
  p.Wt_odout = (bf16_t*)alloc((size_t)1024 * 1024 * 2); p.Wt_q = (bf16_t*)alloc((size_t)2 * 2048 * 1024 * 2); p.keysb = (bf16_t*)alloc((size_t)2 * 2 * 128 * 128 * 2); p.poolWt = (bf16_t*)alloc((size_t)4 * 128 * 128 * 2);
  p.Wg = (float*)alloc(16 * 1024 * 4); p.mod = (float*)alloc(2 * 8 * 6144 * 4); p.gates = (float*)alloc((size_t)T * 16 * 4);
  p.pgate = (float*)alloc((size_t)T * 128 * 4); p.pidx = (bf16_t*)alloc((size_t)T * 128 * 2);
  p.H = (bf16_t*)alloc((size_t)T * 1024 * 2); p.CAT = p.H;
  char* big = alloc((size_t)T * 2048 * 2);
  p.ZQK = (bf16_t*)big; p.ZV = (bf16_t*)(big + (size_t)T * 1024 * 2); p.ZO = (bf16_t*)(big + (size_t)T * 1536 * 2); p.HS = (bf16_t*)big; p.QP = (bf16_t*)big; p.QKV = (bf16_t*)big;
  char* big2 = alloc((size_t)T * 1536 * 2);
  p.QK = (bf16_t*)big2; p.ZP = (bf16_t*)(big2 + (size_t)T * 1024 * 2); p.Qh = (bf16_t*)big2; p.Kh = (bf16_t*)(big2 + (size_t)T * 1024 * 2); p.Vh = (bf16_t*)(big2 + (size_t)T * 1280 * 2);
  p.bar = (unsigned*)alloc(XCD_BAR_WORDS * 4);
  if (off > ws_size) { fprintf(stderr, "kernel_launch: workspace too small: need %zu have %zu\n", off, ws_size); return; }

  static int grid_blocks = 0;
  if (!grid_blocks) {
    int dev = 0, cus = 0, per_cu = 0; hipGetDevice(&dev); hipDeviceGetAttribute(&cus, hipDeviceAttributeMultiprocessorCount, dev);
    hipFuncSetAttribute((const void*)mega, hipFuncAttributeMaxDynamicSharedMemorySize, SMEM_BYTES);
    hipOccupancyMaxActiveBlocksPerMultiprocessor(&per_cu, mega, NTHREADS, SMEM_BYTES);
    if (per_cu > 1) per_cu = 1;
    grid_blocks = cus * per_cu;
    if (grid_blocks <= 0) { fprintf(stderr, "kernel_launch: occupancy query returned 0\n"); grid_blocks = 0; return; }
  }
  hipMemsetAsync(p.bar, 0, XCD_BAR_WORDS * 4, stream);
#if MULTI_LAUNCH
  for (int ph = 0; ph < NPH; ++ph) hipLaunchKernelGGL(mega, dim3(grid_blocks), dim3(NTHREADS), SMEM_BYTES, stream, p, ph, ph + 1);
#else
  int ph0 = 0, ph1 = NPH; void* args[] = {&p, &ph0, &ph1};
  hipError_t e = hipLaunchCooperativeKernel((const void*)mega, dim3(grid_blocks), dim3(NTHREADS), args, SMEM_BYTES, stream);
  if (e != hipSuccess) fprintf(stderr, "cooperative launch failed: %s (grid %d)\n", hipGetErrorString(e), grid_blocks);
#endif
}
```

```cpp
#include <hip/hip_runtime.h>
#include <hip/hip_cooperative_groups.h>
#include <math.h>
#include <stdint.h>
#include <stdio.h>
namespace cg = cooperative_groups;

#ifndef MULTI_LAUNCH
#define MULTI_LAUNCH 0
#endif

namespace {
typedef unsigned short bf16_t;
typedef unsigned int u32;
typedef float f32x4 __attribute__((ext_vector_type(4)));
typedef u32 u32x4 __attribute__((ext_vector_type(4)));
typedef u32 u32x2 __attribute__((ext_vector_type(2)));
typedef __bf16 bf16x2_t __attribute__((ext_vector_type(2)));

constexpr int D = 1024, NB = 8, S = 4096, T = NB * S;
constexpr int EVEN_IN = 2576;
constexpr float EPS = 1e-6f;
constexpr int NTHREADS = 512;
constexpr int SMEM_BYTES = 144 * 1024;
constexpr float KSCALE = 0.08838834764831845f;

struct Params {
  const float *x, *c, *ada_w, *ada_b, *nmg, *nfg, *ev_w_in, *ev_b_in, *conv_w, *conv_b, *mnorm_g, *pool_w, *pool_sc, *ev_w_out, *od_w_in, *qn_g, *kn_g, *od_w_out,
      *peer_wq, *peer_keys, *peer_u, *peer_v, *final_g;
  float* X;
  bf16_t *Wt_evin, *Wt_evout, *Wt_odin, *Wt_odout, *Wt_q, *keysb, *poolWt; unsigned char *U8, *V8;
  float *Wg, *mod, *gates, *pgate;
  bf16_t *H, *ZQK, *ZV, *ZO, *ZP, *QK, *HS, *CAT, *QP, *QKV, *Qh, *Kh, *Vh;
  bf16_t* pidx;
  unsigned* bar;
};

__device__ __forceinline__ float siluf(float x) { return x / (1.f + __expf(-x)); }
__device__ __forceinline__ float sigmf(float x) { return 1.f / (1.f + __expf(-x)); }
__device__ __forceinline__ float wave_sum(float v) { for (int o = 32; o >= 1; o >>= 1) v += __shfl_xor(v, o); return v; }
__device__ __forceinline__ float wave_max(float v) { for (int o = 32; o >= 1; o >>= 1) v = fmaxf(v, __shfl_xor(v, o)); return v; }
__device__ __forceinline__ bf16_t f2bf(float f) { u32 u = __float_as_uint(f); u += 0x7FFFu + ((u >> 16) & 1u); return (bf16_t)(u >> 16); }
__device__ __forceinline__ float bf2f(bf16_t b) { return __uint_as_float(((u32)b) << 16); }
__device__ __forceinline__ u32 pack2(float lo, float hi) { return (u32)f2bf(lo) | ((u32)f2bf(hi) << 16); }
__device__ __forceinline__ float bflo(u32 w) { return __uint_as_float(w << 16); }
__device__ __forceinline__ float bfhi(u32 w) { return __uint_as_float(w & 0xFFFF0000u); }
__device__ __forceinline__ float dot2bf(u32 a, u32 b, float c) { return __builtin_amdgcn_fdot2_f32_bf16(__builtin_bit_cast(bf16x2_t, a), __builtin_bit_cast(bf16x2_t, b), c, false); }

constexpr int PJ_MOD = 192, PJ_TR = 2576, PJ_WG = 1, PJ_KEYS = 16, PJ_UV = 8192;
constexpr int PJ_TOTAL = PJ_MOD + PJ_TR + PJ_WG + PJ_KEYS + PJ_UV;

__device__ void prep_transpose_tile(const float* __restrict__ src, int ld, int k0, int n0, bf16_t* __restrict__ dst, int dstK, char* smem) {
  float* tile = (float*)smem;
  const int tid = threadIdx.x;
  __syncthreads();
  for (int pass = 0; pass < 8; ++pass) { int kk = pass * 8 + (tid >> 6), n = tid & 63; tile[kk * 65 + n] = src[(size_t)(k0 + kk) * ld + n0 + n]; }
  __syncthreads();
  int n = tid >> 3, kc = (tid & 7) * 8; u32x4 w;
  w.x = pack2(tile[(kc + 0) * 65 + n], tile[(kc + 1) * 65 + n]); w.y = pack2(tile[(kc + 2) * 65 + n], tile[(kc + 3) * 65 + n]);
  w.z = pack2(tile[(kc + 4) * 65 + n], tile[(kc + 5) * 65 + n]); w.w = pack2(tile[(kc + 6) * 65 + n], tile[(kc + 7) * 65 + n]);
  *(u32x4*)(dst + (size_t)(n0 + n) * dstK + k0 + kc) = w;
}

__device__ void phase_prep(const Params& p, char* smem) {
  const int tid = threadIdx.x;
  for (int job = blockIdx.x; job < PJ_TOTAL; job += gridDim.x) {
    if (job < PJ_MOD) {
      float* cs = (float*)smem; float* red = cs + 8192;
      __syncthreads();
      for (int i = tid; i < 8192; i += NTHREADS) cs[i] = siluf(p.c[i]);
      __syncthreads();
      const int l = job / 96, e0 = (job % 96) * 64, col = tid & 63, dg = tid >> 6;
      float acc[8];
#pragma unroll
      for (int b = 0; b < 8; ++b) acc[b] = 0.f;
      const float* w = p.ada_w + (size_t)l * D * 6144 + e0 + col;
      for (int d = dg * 128; d < dg * 128 + 128; ++d) { float wv = w[(size_t)d * 6144];
#pragma unroll
        for (int b = 0; b < 8; ++b) acc[b] += cs[b * 1024 + d] * wv; }
#pragma unroll
      for (int b = 0; b < 8; ++b) red[(dg * 8 + b) * 64 + col] = acc[b];
      __syncthreads();
      { const int b = tid >> 6; float s = 0.f;
#pragma unroll
        for (int g = 0; g < 8; ++g) s += red[(g * 8 + b) * 64 + col];
        p.mod[(size_t)(l * 8 + b) * 6144 + e0 + col] = s + p.ada_b[l * 6144 + e0 + col]; }
    } else if (job < PJ_MOD + PJ_TR) {
      int tt = job - PJ_MOD;
      if (tt < 640) prep_transpose_tile(p.ev_w_in, EVEN_IN, (tt / 40) * 64, (tt % 40) * 64, p.Wt_evin, 1024, smem);
      else if (tt < 896) { tt -= 640; prep_transpose_tile(p.ev_w_out, 1024, (tt / 16) * 64, (tt % 16) * 64, p.Wt_evout, 1024, smem); }
      else if (tt < 1280) { tt -= 896; prep_transpose_tile(p.od_w_in, 1536, (tt / 24) * 64, (tt % 24) * 64, p.Wt_odin, 1024, smem); }
      else if (tt < 1536) { tt -= 1280; prep_transpose_tile(p.od_w_out, 1024, (tt / 16) * 64, (tt % 16) * 64, p.Wt_odout, 1024, smem); }
      else if (tt < 2560) { tt -= 1536; int l = tt / 512; tt %= 512; prep_transpose_tile(p.peer_wq + (size_t)l * D * 2048, 2048, (tt / 32) * 64, (tt % 32) * 64, p.Wt_q + (size_t)l * 2048 * 1024, 1024, smem); }
      else { tt -= 2560; const int g = tt >> 2; prep_transpose_tile(p.pool_w + (size_t)g * 16384, 128, ((tt >> 1) & 1) * 64, (tt & 1) * 64, p.poolWt + (size_t)g * 16384, 128, smem); }
    } else if (job < PJ_MOD + PJ_TR + PJ_WG) {
      for (int i = tid; i < 16 * 1024; i += NTHREADS) { int g = i >> 10, d = i & 1023; p.Wg[i] = p.ev_w_in[(size_t)d * EVEN_IN + 2560 + g]; }
    } else if (job < PJ_MOD + PJ_TR + PJ_WG + PJ_KEYS) {
      int j = job - (PJ_MOD + PJ_TR + PJ_WG);
      for (int i = tid; i < 4096; i += NTHREADS) p.keysb[j * 4096 + i] = f2bf(p.peer_keys[j * 4096 + i]);
    } else {
      int j = job - (PJ_MOD + PJ_TR + PJ_WG + PJ_KEYS); const bool isu = j < 4096; const float* src = isu ? p.peer_u : p.peer_v; unsigned char* dst = isu ? p.U8 : p.V8; j &= 4095; const float sc = isu ? 32.f : 2.f;
      const size_t o = (size_t)j * 8192 + tid * 16; u32x4 w; u32 ww[4];
#pragma unroll
      for (int q = 0; q < 4; ++q) { const f32x4 a = *(const f32x4*)(src + o + 4 * q); int pk = __builtin_amdgcn_cvt_pk_fp8_f32(a.x * sc, a.y * sc, 0, false); pk = __builtin_amdgcn_cvt_pk_fp8_f32(a.z * sc, a.w * sc, pk, true); ww[q] = (u32)pk; }
      w.x = ww[0]; w.y = ww[1]; w.z = ww[2]; w.w = ww[3]; *(u32x4*)(dst + o) = w;
    }
  }
}

enum { EPI_EVIN = 0, EPI_EVOUT = 1, EPI_PEERQ = 2, EPI_ODIN = 3, EPI_ODOUT = 4 };
template <int EPI> __device__ __forceinline__ void epi_store(const Params& p, int layer, int m, int n, float acc) {
  if (EPI == EPI_EVIN) { float v = acc + p.ev_b_in[n];
    if (n < 1024) p.ZQK[(size_t)m * 1024 + n] = f2bf(v); else if (n < 1536) p.ZV[(size_t)m * 512 + n - 1024] = f2bf(v);
    else if (n < 2048) p.ZO[(size_t)m * 512 + n - 1536] = f2bf(sigmf(v)); else p.ZP[(size_t)m * 512 + n - 2048] = f2bf(v); }
  else if (EPI == EPI_EVOUT) { int b = m / S; p.X[(size_t)m * D + n] = p.x[(size_t)m * D + n] + p.mod[(size_t)(0 * 8 + b) * 6144 + 2048 + n] * acc; }
  else if (EPI == EPI_PEERQ) p.QP[(size_t)m * 2048 + n] = f2bf(acc);
  else if (EPI == EPI_ODIN) p.QKV[(size_t)m * 1536 + n] = f2bf(acc);
  else if (EPI == EPI_ODOUT) { int b = m / S; p.X[(size_t)m * D + n] += p.mod[(size_t)(1 * 8 + b) * 6144 + 2048 + n] * acc; }
}
template <int EPI> __device__ void phase_gemm_naive(const Params& p, int layer, const bf16_t* __restrict__ A, const bf16_t* __restrict__ Bt, int M, int N, int K, char* smem) {
  float* As = (float*)smem; float* Bs = As + 32 * 132;
  const int tid = threadIdx.x, tx = tid & 15, ty = tid >> 4; const int nN = N / 64, njobs = (M / 128) * nN;
  for (int job = blockIdx.x; job < njobs; job += gridDim.x) {
    const int m0 = (job / nN) * 128, n0 = (job % nN) * 64; float acc[4][4];
#pragma unroll
    for (int i = 0; i < 4; ++i)
#pragma unroll
      for (int j = 0; j < 4; ++j) acc[i][j] = 0.f;
    for (int k0 = 0; k0 < K; k0 += 32) {
      __syncthreads();
      { int row = tid >> 2, kc = (tid & 3) * 8; u32x4 w = *(const u32x4*)(A + (size_t)(m0 + row) * K + k0 + kc);
        As[(kc + 0) * 132 + row] = bflo(w.x); As[(kc + 1) * 132 + row] = bfhi(w.x); As[(kc + 2) * 132 + row] = bflo(w.y); As[(kc + 3) * 132 + row] = bfhi(w.y);
        As[(kc + 4) * 132 + row] = bflo(w.z); As[(kc + 5) * 132 + row] = bfhi(w.z); As[(kc + 6) * 132 + row] = bflo(w.w); As[(kc + 7) * 132 + row] = bfhi(w.w); }
      if (tid < 256) { int row = tid >> 2, kc = (tid & 3) * 8; u32x4 w = *(const u32x4*)(Bt + (size_t)(n0 + row) * K + k0 + kc);
        Bs[(kc + 0) * 68 + row] = bflo(w.x); Bs[(kc + 1) * 68 + row] = bfhi(w.x); Bs[(kc + 2) * 68 + row] = bflo(w.y); Bs[(kc + 3) * 68 + row] = bfhi(w.y);
        Bs[(kc + 4) * 68 + row] = bflo(w.z); Bs[(kc + 5) * 68 + row] = bfhi(w.z); Bs[(kc + 6) * 68 + row] = bflo(w.w); Bs[(kc + 7) * 68 + row] = bfhi(w.w); }
      __syncthreads();
#pragma unroll 8
      for (int kk = 0; kk < 32; ++kk) { f32x4 a = *(const f32x4*)(As + kk * 132 + ty * 4), b = *(const f32x4*)(Bs + kk * 68 + tx * 4);
        acc[0][0] += a.x * b.x; acc[0][1] += a.x * b.y; acc[0][2] += a.x * b.z; acc[0][3] += a.x * b.w;
        acc[1][0] += a.y * b.x; acc[1][1] += a.y * b.y; acc[1][2] += a.y * b.z; acc[1][3] += a.y * b.w;
        acc[2][0] += a.z * b.x; acc[2][1] += a.z * b.y; acc[2][2] += a.z * b.z; acc[2][3] += a.z * b.w;
        acc[3][0] += a.w * b.x; acc[3][1] += a.w * b.y; acc[3][2] += a.w * b.z; acc[3][3] += a.w * b.w; }
    }
#pragma unroll
    for (int i = 0; i < 4; ++i)
#pragma unroll
      for (int j = 0; j < 4; ++j) epi_store<EPI>(p, layer, m0 + ty * 4 + i, n0 + tx * 4 + j, acc[i][j]);
  }
}

namespace pg8 {
#define PG8_LAS __attribute__((address_space(3)))
typedef unsigned short bf16_t;
typedef short bf16x8 __attribute__((ext_vector_type(8)));
typedef float f32x4 __attribute__((ext_vector_type(4)));
typedef unsigned u32x4 __attribute__((ext_vector_type(4)));
constexpr int BM = 256, BK = 64, HALF = 128, HTB = HALF * BK * 2  , STAGE_BYTES = 8 * HTB, NXCD = 8, WGM = 8;

__host__ __device__ __forceinline__ int lds_byte(int r, int c) { const int st = (r >> 4) * 2 + (c >> 5), rr = r & 15, cc = c & 31, ob = rr * 64 + cc * 2; return st * 1024 + (ob ^ (((ob >> 9) & 1) << 5)); }
__host__ __device__ __forceinline__ void stage_rc(int b, int& R, int& C) { const int st = b / 1024, sb = b % 1024, swz = sb ^ (((sb >> 9) & 1) << 5); R = (st >> 1) * 16 + swz / 64; C = (st & 1) * 32 + (swz % 64) / 2; }
__host__ __device__ __forceinline__ int perm32(int rho) { const int n = rho >> 4, i = rho & 15; return 8 * (i >> 2) + 4 * n + (i & 3); }

struct Unit { int pm, pn; };
struct Gemm { const bf16_t* A; const bf16_t* Bt; int M, N, K; };

struct StaticOrder {
    int nM, nN, nwg, G, c;
    __host__ __device__ void init(int M, int N, int G_, int c_) { nM = M / BM; nN = N / BM; nwg = nM * nN; G = G_; c = c_; }
    __host__ __device__ bool next(int i, Unit& u) const {
        const long L = (long)i * G + c; if (L >= nwg) return false;
        int wgid = (int)L; { const int q = nwg / NXCD, r = nwg % NXCD, xcd = wgid % NXCD, off = wgid / NXCD; wgid = (xcd < r ? xcd * (q + 1) : r * (q + 1) + (xcd - r) * q) + off; }
        const int nig = WGM * nN, gid = wgid / nig, fm = gid * WGM, gsz = (nM - fm) < WGM ? (nM - fm) : WGM;
        u.pm = fm + ((wgid % nig) % gsz); u.pn = (wgid % nig) / gsz; return true;
    }
    __device__ __forceinline__ void a_ready(const Unit&) const {}
    __device__ __forceinline__ void done(const Unit&) const {}
};
__device__ __forceinline__ unsigned cvt_pk_bf16(float lo, float hi) { unsigned r; asm volatile("v_cvt_pk_bf16_f32 %0, %1, %2" : "=v"(r) : "v"(lo), "v"(hi)); return r; }
template <class Epi, class Sched, bool STAMP = false>
__device__ __forceinline__ void gemm_phase(PG8_LAS unsigned char* lds, const Gemm g, const Sched& S, const Epi& E, unsigned long long* stamps) {
    const int tid = threadIdx.x, wid = __builtin_amdgcn_readfirstlane(tid >> 6), lane = tid & 63, wr = wid >> 2, wc = wid & 3, fr = lane & 15, fq = lane >> 4;
    const int K = g.K, nt = K / BK;
    int ts_lo = 0, ts_hi = 0, nts = 0; const unsigned long long rt_entry = STAMP ? (unsigned long long)wall_clock64() : 0ull;
#define PG8_STAMP() do { if (STAMP && wid == 0 && nts < 64) { const unsigned long long _c = (unsigned long long)clock64(); \
        ts_lo = (lane == nts) ? (int)(unsigned)_c : ts_lo; ts_hi = (lane == nts) ? (int)(unsigned)(_c >> 32) : ts_hi; ++nts; } } while (0)
    PG8_STAMP();
    unsigned voffA[2], voffB[2];
#pragma unroll
    for (int i = 0; i < 2; ++i) { int R, C; stage_rc(tid * 16 + i * 8192, R, C); const int Rb = Epi::PERM ? ((R & ~31) + perm32(R & 31)) : R;
        voffA[i] = (unsigned)(R * K + C) * 2u; voffB[i] = (unsigned)(Rb * K + C) * 2u; }
    const size_t kstep = (size_t)(BK * 2);
    const size_t hstep = (size_t)HALF * K * 2;
    const size_t tstep = 2 * hstep;
    const unsigned ldsw = (unsigned)wid * 1024u;
    const int aoff = lds_byte(wr * 64 + fr, fq * 8), boff = lds_byte(wc * 32 + fr, fq * 8);
#define PG8_SA(b, h) (((b) * 2 + (h)) * HTB)
#define PG8_SB(b, h) ((4 + (b) * 2 + (h)) * HTB)
#define PG8_STAGE(bufoff, gbase, voff) do { _Pragma("unroll") for (int _i = 0; _i < 2; ++_i) \
        __builtin_amdgcn_global_load_lds((const unsigned*)((const char*)(gbase) + (voff)[_i]), (PG8_LAS unsigned*)(lds + (bufoff) + ldsw + _i * 8192), 16, 0, 0); } while (0)
#define PG8_LDA(dst, b, h) do { _Pragma("unroll") for (int m = 0; m < 4; ++m) _Pragma("unroll") for (int k = 0; k < 2; ++k) dst[m][k] = *(const PG8_LAS bf16x8*)(lds + PG8_SA(b, h) + aoff + m * 2048 + k * 1024); } while (0)
#define PG8_LDB(dst, b, h) do { _Pragma("unroll") for (int n = 0; n < 2; ++n) _Pragma("unroll") for (int k = 0; k < 2; ++k) dst[n][k] = *(const PG8_LAS bf16x8*)(lds + PG8_SB(b, h) + boff + n * 2048 + k * 1024); } while (0)
#define PG8_MMA(ai, bj, At, Bt) do { __builtin_amdgcn_s_setprio(1); _Pragma("unroll") for (int m = 0; m < 4; ++m) _Pragma("unroll") for (int n = 0; n < 2; ++n) _Pragma("unroll") for (int k = 0; k < 2; ++k) \
        acc[ai][bj][m][n] = __builtin_amdgcn_mfma_f32_16x16x32_bf16(Bt[n][k], At[m][k], acc[ai][bj][m][n], 0, 0, 0); __builtin_amdgcn_s_setprio(0); } while (0)
#define PG8_WAIT_V(n) asm volatile("s_waitcnt vmcnt(" #n ")" ::: "memory")
#define PG8_WAIT_L(n) asm volatile("s_waitcnt lgkmcnt(" #n ")" ::: "memory")
#define PG8_BAR __builtin_amdgcn_s_barrier()
#define PG8_SCHED __builtin_amdgcn_sched_barrier(0)
    Unit cur, nxt; int ui = 0;
    if (!S.next(0, cur)) return;
    f32x4 acc[2][2][4][2];
#pragma unroll
    for (int a = 0; a < 2; ++a)
#pragma unroll
        for (int b = 0; b < 2; ++b)
#pragma unroll
            for (int m = 0; m < 4; ++m)
#pragma unroll
                for (int n = 0; n < 2; ++n) acc[a][b][m][n] = (f32x4){0.f, 0.f, 0.f, 0.f};
    bf16x8 At[4][2], B0[2][2], B1[2][2];
    const char* cA = (const char*)g.A + (size_t)cur.pm * tstep; const char* cB = (const char*)g.Bt + (size_t)cur.pn * tstep;
    S.a_ready(cur);
    PG8_STAGE(PG8_SB(0, 0), cB, voffB); PG8_STAGE(PG8_SA(0, 0), cA, voffA); PG8_STAGE(PG8_SB(0, 1), cB + hstep, voffB); PG8_STAGE(PG8_SA(0, 1), cA + hstep, voffA);
    if (wr == 1) PG8_BAR;
    PG8_WAIT_V(4); PG8_BAR;
    PG8_STAGE(PG8_SB(1, 0), cB + kstep, voffB); PG8_STAGE(PG8_SA(1, 0), cA + kstep, voffA); PG8_STAGE(PG8_SB(1, 1), cB + hstep + kstep, voffB);
    PG8_WAIT_V(6); PG8_BAR;
    PG8_STAMP();
    for (;;) {
        const bool has_next = S.next(ui + 1, nxt);
        const char* nA = has_next ? (const char*)g.A + (size_t)nxt.pm * tstep : cA; const char* nB = has_next ? (const char*)g.Bt + (size_t)nxt.pn * tstep : cB;
        for (int t = 0; t < nt; t += 2) {
            const bool last = (t == nt - 2);
            const char* a1 = cA + (size_t)(t + 1) * kstep;
            const char* a2 = last ? nA : cA + (size_t)(t + 2) * kstep; const char* b2 = last ? nB : cB + (size_t)(t + 2) * kstep;
            const char* a3 = a2 + kstep; const char* b3 = b2 + kstep;
            if (last && has_next) S.a_ready(nxt);
            PG8_LDB(B0, 0, 0); PG8_SCHED; PG8_LDA(At, 0, 0); PG8_STAGE(PG8_SA(1, 1), a1 + hstep, voffA);
            PG8_WAIT_L(8); PG8_BAR; PG8_WAIT_L(0); PG8_MMA(0, 0, At, B0); PG8_BAR; PG8_SCHED;
            PG8_LDB(B1, 0, 1); PG8_STAGE(PG8_SB(0, 0), b2, voffB);
            PG8_BAR; PG8_WAIT_L(0); PG8_MMA(0, 1, At, B1); PG8_BAR;
            PG8_LDA(At, 0, 1); PG8_STAGE(PG8_SA(0, 0), a2, voffA);
            PG8_BAR; PG8_WAIT_L(0); PG8_MMA(1, 0, At, B0); PG8_BAR; PG8_SCHED;
            PG8_STAGE(PG8_SB(0, 1), b2 + hstep, voffB);
            PG8_WAIT_V(6); PG8_BAR; PG8_MMA(1, 1, At, B1); PG8_BAR;
            PG8_LDB(B0, 1, 0); PG8_SCHED; PG8_LDA(At, 1, 0); PG8_STAGE(PG8_SA(0, 1), a2 + hstep, voffA);
            PG8_WAIT_L(8); PG8_BAR; PG8_WAIT_L(0); PG8_MMA(0, 0, At, B0); PG8_BAR; PG8_SCHED;
            PG8_LDB(B1, 1, 1); PG8_STAGE(PG8_SB(1, 0), b3, voffB);
            PG8_BAR; PG8_WAIT_L(0); PG8_MMA(0, 1, At, B1); PG8_BAR;
            PG8_LDA(At, 1, 1); PG8_STAGE(PG8_SA(1, 0), a3, voffA);
            PG8_BAR; PG8_WAIT_L(0); PG8_MMA(1, 0, At, B0); PG8_BAR; PG8_SCHED;
            PG8_STAGE(PG8_SB(1, 1), b3 + hstep, voffB);
            PG8_WAIT_V(6); PG8_BAR; PG8_MMA(1, 1, At, B1); PG8_BAR;
        }
        PG8_STAMP();
        if constexpr (!Epi::AFTER_DRAIN) { E(acc, cur, wr, wc, fr, fq); S.done(cur); }
        PG8_STAMP();
        if (!has_next) break;
#pragma unroll
        for (int a = 0; a < 2; ++a)
#pragma unroll
            for (int b = 0; b < 2; ++b)
#pragma unroll
                for (int m = 0; m < 4; ++m)
#pragma unroll
                    for (int n = 0; n < 2; ++n) acc[a][b][m][n] = (f32x4){0.f, 0.f, 0.f, 0.f};
        cur = nxt; cA = nA; cB = nB; ++ui;
    }
    PG8_WAIT_V(0);
    if (wr == 0) PG8_BAR;
    PG8_BAR;
    if constexpr (Epi::AFTER_DRAIN) { E.fused(acc, cur, wr, wc, fr, fq, lds, wid, lane); S.done(cur); }
    PG8_STAMP();
    if (STAMP && wid == 0) { stamps[lane] = lane < nts ? (((unsigned long long)(unsigned)ts_hi << 32) | (unsigned)ts_lo) : 0ull;
        if (lane == 62) stamps[62] = rt_entry; if (lane == 63) stamps[63] = (unsigned long long)wall_clock64(); }
#undef PG8_STAMP
#undef PG8_SA
#undef PG8_SB
#undef PG8_STAGE
#undef PG8_LDA
#undef PG8_LDB
#undef PG8_MMA
#undef PG8_WAIT_V
#undef PG8_WAIT_L
#undef PG8_BAR
#undef PG8_SCHED
}
}

struct EpiEvin {
  static constexpr bool PERM = true, AFTER_DRAIN = false;
  bf16_t *ZQK, *ZV, *ZO, *ZP; const float* bias;
  __device__ __forceinline__ void operator()(const pg8::f32x4 (&acc)[2][2][4][2], const pg8::Unit& u, int wr, int wc, int fr, int fq) const {
    const int row0 = u.pm * 256 + wr * 64 + fr, ct = u.pn * 256;
    bf16_t* base; int ldc, cl; bool sig = false;
    if (ct < 1024) { base = ZQK; ldc = 1024; cl = ct; } else if (ct < 1536) { base = ZV; ldc = 512; cl = ct - 1024; } else if (ct < 2048) { base = ZO; ldc = 512; cl = ct - 1536; sig = true; } else { base = ZP; ldc = 512; cl = ct - 2048; }
    const int cofs = wc * 32 + 8 * fq;
    pg8::f32x4 bv[2][2];
#pragma unroll
    for (int bj = 0; bj < 2; ++bj)
#pragma unroll
      for (int n = 0; n < 2; ++n) bv[bj][n] = *(const pg8::f32x4*)(bias + ct + cofs + bj * 128 + 4 * n);
#pragma unroll
    for (int ai = 0; ai < 2; ++ai)
#pragma unroll
      for (int m = 0; m < 4; ++m) { bf16_t* rowp = base + (size_t)(row0 + ai * 128 + m * 16) * ldc + cl + cofs;
#pragma unroll
        for (int bj = 0; bj < 2; ++bj) { pg8::f32x4 v0 = acc[ai][bj][m][0] + bv[bj][0], v1 = acc[ai][bj][m][1] + bv[bj][1];
          if (sig) {
#pragma unroll
            for (int j = 0; j < 4; ++j) { v0[j] = sigmf(v0[j]); v1[j] = sigmf(v1[j]); } }
          pg8::u32x4 w; w.x = pg8::cvt_pk_bf16(v0[0], v0[1]); w.y = pg8::cvt_pk_bf16(v0[2], v0[3]); w.z = pg8::cvt_pk_bf16(v1[0], v1[1]); w.w = pg8::cvt_pk_bf16(v1[2], v1[3]);
          *(pg8::u32x4*)(rowp + bj * 128) = w; } }
  }
};
struct EpiPlain {
  static constexpr bool PERM = true, AFTER_DRAIN = false;
  bf16_t* out; int ldc;
  __device__ __forceinline__ void operator()(const pg8::f32x4 (&acc)[2][2][4][2], const pg8::Unit& u, int wr, int wc, int fr, int fq) const {
    const int row0 = u.pm * 256 + wr * 64 + fr, col0 = u.pn * 256 + wc * 32 + 8 * fq;
#pragma unroll
    for (int ai = 0; ai < 2; ++ai)
#pragma unroll
      for (int m = 0; m < 4; ++m) { bf16_t* rowp = out + (size_t)(row0 + ai * 128 + m * 16) * ldc + col0;
#pragma unroll
        for (int bj = 0; bj < 2; ++bj) { const pg8::f32x4 v0 = acc[ai][bj][m][0], v1 = acc[ai][bj][m][1];
          pg8::u32x4 w; w.x = pg8::cvt_pk_bf16(v0[0], v0[1]); w.y = pg8::cvt_pk_bf16(v0[2], v0[3]); w.z = pg8::cvt_pk_bf16(v1[0], v1[1]); w.w = pg8::cvt_pk_bf16(v1[2], v1[3]);
          *(pg8::u32x4*)(rowp + bj * 128) = w; } }
  }
};
struct EpiRes {
  static constexpr bool PERM = false, AFTER_DRAIN = false;
  const float* xin; float* X; const float* gate;
  __device__ __forceinline__ void operator()(const pg8::f32x4 (&acc)[2][2][4][2], const pg8::Unit& u, int wr, int wc, int fr, int fq) const {
    const int row0 = u.pm * 256 + wr * 64 + fr, col0 = u.pn * 256 + wc * 32 + 4 * fq; const float* gb = gate + (size_t)((u.pm * 256) / S) * 6144;
    pg8::f32x4 gv[2][2];
#pragma unroll
    for (int bj = 0; bj < 2; ++bj)
#pragma unroll
      for (int n = 0; n < 2; ++n) gv[bj][n] = *(const pg8::f32x4*)(gb + col0 + bj * 128 + n * 16);
#pragma unroll
    for (int ai = 0; ai < 2; ++ai)
#pragma unroll
      for (int m = 0; m < 4; ++m) { const size_t off = (size_t)(row0 + ai * 128 + m * 16) * 1024 + col0;
#pragma unroll
        for (int bj = 0; bj < 2; ++bj)
#pragma unroll
          for (int n = 0; n < 2; ++n) { const pg8::f32x4 xi = *(const pg8::f32x4*)(xin + off + bj * 128 + n * 16); *(pg8::f32x4*)(X + off + bj * 128 + n * 16) = xi + gv[bj][n] * acc[ai][bj][m][n]; }
        asm volatile("" ::: "memory"); }
  }
};
template <class Epi> __device__ __forceinline__ void phase_gemm_fast(const bf16_t* A, const bf16_t* Bt, int M, int N, int K, const Epi& E, char* smem) {
  pg8::Gemm g; g.A = A; g.Bt = Bt; g.M = M; g.N = N; g.K = K;
  pg8::StaticOrder So; So.init(M, N, (int)gridDim.x, (int)blockIdx.x);
  pg8::gemm_phase<Epi, pg8::StaticOrder, false>((PG8_LAS unsigned char*)smem, g, So, E, nullptr);
}

namespace cp {
typedef short bf16x8 __attribute__((ext_vector_type(8)));
typedef float f32x16 __attribute__((ext_vector_type(16)));
constexpr int RS = 272;
__device__ __forceinline__ void unpack8(const u32x4 w, float* f) { f[0] = bflo(w.x); f[1] = bfhi(w.x); f[2] = bflo(w.y); f[3] = bfhi(w.y); f[4] = bflo(w.z); f[5] = bfhi(w.z); f[6] = bflo(w.w); f[7] = bfhi(w.w); }
__device__ void phase_convpool(const Params& p, char* smem) {
  for (int job = blockIdx.x; job < T / 64; job += gridDim.x) {
    int tid_ = threadIdx.x; asm volatile("" : "+v"(tid_));
    const int tid = tid_, c0 = (tid & 127) * 8, t0 = job * 64 + (tid >> 7) * 16, s0 = t0 & (S - 1);
    float cw[5][8], cb[8];
#pragma unroll
    for (int j = 0; j < 5; ++j) { const f32x4 a = *(const f32x4*)(p.conv_w + j * 1024 + c0), b = *(const f32x4*)(p.conv_w + j * 1024 + c0 + 4); cw[j][0] = a.x; cw[j][1] = a.y; cw[j][2] = a.z; cw[j][3] = a.w; cw[j][4] = b.x; cw[j][5] = b.y; cw[j][6] = b.z; cw[j][7] = b.w; }
    { const f32x4 a = *(const f32x4*)(p.conv_b + c0), b = *(const f32x4*)(p.conv_b + c0 + 4); cb[0] = a.x; cb[1] = a.y; cb[2] = a.z; cb[3] = a.w; cb[4] = b.x; cb[5] = b.y; cb[6] = b.z; cb[7] = b.w; }
    const float sc = c0 >= 512 ? KSCALE : 1.f;
    float win[5][8];
#pragma unroll
    for (int j = 0; j < 4; ++j) { const int ss = s0 + j - 2; u32x4 w = (u32x4){0u, 0u, 0u, 0u}; if (ss >= 0 && ss < S) w = *(const u32x4*)(p.ZQK + (size_t)(t0 + j - 2) * 1024 + c0); unpack8(w, win[j + 1]); }
#pragma unroll
    for (int i = 0; i < 16; ++i) {
#pragma unroll
      for (int j = 0; j < 4; ++j)
#pragma unroll
        for (int q = 0; q < 8; ++q) win[j][q] = win[j + 1][q];
      { const int ss = s0 + i + 2; u32x4 w = (u32x4){0u, 0u, 0u, 0u}; if (ss < S) w = *(const u32x4*)(p.ZQK + (size_t)(t0 + i + 2) * 1024 + c0); unpack8(w, win[4]); }
      float a[8];
#pragma unroll
      for (int q = 0; q < 8; ++q) { float v = cb[q];
#pragma unroll
        for (int j = 0; j < 5; ++j) v += cw[j][q] * win[j][q];
        a[q] = siluf(v) * sc; }
      u32x4 o; o.x = pack2(a[0], a[1]); o.y = pack2(a[2], a[3]); o.z = pack2(a[4], a[5]); o.w = pack2(a[6], a[7]); *(u32x4*)(p.QK + (size_t)(t0 + i) * 1024 + c0) = o;
    }
  }
  for (int job = blockIdx.x; job < (T / 128) * 4; job += gridDim.x) {
    int tid_ = threadIdx.x; asm volatile("" : "+v"(tid_));
    const int tid = tid_, wid = tid >> 6, lane = tid & 63, l31 = lane & 31, hh = lane >> 5;
    const int g = job & 3, t0 = (job >> 2) * 128, win = 2 << g, hw = win >> 1;
    __syncthreads();
#pragma unroll
    for (int i = 0; i < 4; ++i) { const int idx = tid + i * NTHREADS, row = idx >> 4, ch = idx & 15; *(u32x4*)(smem + 128 * RS + row * RS + ch * 16) = *(const u32x4*)(p.poolWt + (size_t)g * 16384 + row * 128 + ch * 8); }
#pragma unroll 1
    for (int i = 0; i < 4; ++i) { const int idx = tid + i * NTHREADS, row = idx >> 4, ch = idx & 15, t = t0 + row, s = t & (S - 1); const int lo = max(s - hw, 0), hi = min(s + hw, S);
      float sum[8], own[8];
#pragma unroll
      for (int q = 0; q < 8; ++q) sum[q] = 0.f;
      const bf16_t* base = p.ZP + (size_t)(t - s) * 512 + g * 128 + ch * 8;
      for (int r = lo; r < hi; ++r) { float f[8]; unpack8(*(const u32x4*)(base + (size_t)r * 512), f);
#pragma unroll
        for (int q = 0; q < 8; ++q) sum[q] += f[q]; }
      unpack8(*(const u32x4*)(base + (size_t)s * 512), own); const float inv = 1.f / (float)(hi - lo);
      u32x4 o; o.x = pack2(sum[0] * inv - own[0], sum[1] * inv - own[1]); o.y = pack2(sum[2] * inv - own[2], sum[3] * inv - own[3]); o.z = pack2(sum[4] * inv - own[4], sum[5] * inv - own[5]); o.w = pack2(sum[6] * inv - own[6], sum[7] * inv - own[7]);
      *(u32x4*)(smem + row * RS + ch * 16) = o; }
    __syncthreads();
    const int mt = wid >> 1;
#pragma unroll
    for (int q = 0; q < 2; ++q) { const int nt = (wid & 1) * 2 + q;
      f32x16 acc;
#pragma unroll
      for (int r = 0; r < 16; ++r) acc[r] = 0.f;
      const char* ya = smem + (mt * 32 + l31) * RS + hh * 16; const char* wb = smem + 128 * RS + (nt * 32 + l31) * RS + hh * 16;
#pragma unroll
      for (int ks = 0; ks < 8; ++ks) acc = __builtin_amdgcn_mfma_f32_32x32x16_bf16(*(const bf16x8*)(ya + ks * 32), *(const bf16x8*)(wb + ks * 32), acc, 0, 0, 0);
      const int e = nt * 32 + l31; const float psc = p.pool_sc[g * 128 + e];
#pragma unroll
      for (int r = 0; r < 16; ++r) { const int row = mt * 32 + (r & 3) + 8 * (r >> 2) + 4 * hh; p.CAT[(size_t)(t0 + row) * 1024 + 512 + g * 128 + e] = f2bf(acc[r] * psc); } }
  }
}
}

__device__ void phase_mlstm_naive(const Params& p, char* smem) {
  float* qs = (float*)smem; float* ks = qs + 128; float* nump = ks + 128; float* red = nump + 512;
  const int tid = threadIdx.x, j = tid & 127, qd = tid >> 7;
  for (int job = blockIdx.x; job < 64; job += gridDim.x) {
    const int dir = job >> 5, b = (job >> 2) & 7, h = job & 3;
    float C[32];
#pragma unroll
    for (int d = 0; d < 32; ++d) C[d] = 0.f;
    float n = 0.f, m = 0.f;
    for (int step = 0; step < S; ++step) { const int s = dir ? S - 1 - step : step; const size_t t = (size_t)b * S + s;
      const float li = p.gates[t * 16 + dir * 4 + h], gf = p.gates[t * 16 + 8 + dir * 4 + h];
      const float lf = fminf(gf, 0.f) - log1pf(__expf(-fabsf(gf)));
      __syncthreads();
      if (qd == 0) { qs[j] = bf2f(p.QK[t * 1024 + h * 128 + j]); ks[j] = bf2f(p.QK[t * 1024 + 512 + h * 128 + j]); }
      const float v = bf2f(p.ZV[t * 512 + h * 128 + j]);
      __syncthreads();
      const float mn = fmaxf(lf + m, li), ip = __expf(li - mn), fp = __expf(lf + m - mn); m = mn;
      float num = 0.f;
#pragma unroll
      for (int d = 0; d < 32; ++d) { C[d] = fp * C[d] + ip * ks[qd * 32 + d] * v; num += qs[qd * 32 + d] * C[d]; }
      float dp = 0.f; if (qd == 0) { n = fp * n + ip * ks[j]; dp = qs[j] * n; }
      nump[qd * 128 + j] = num;
      dp = wave_sum(dp); if ((tid & 63) == 0) red[tid >> 6] = dp;
      __syncthreads();
      if (qd == 0) { const float den = red[0] + red[1]; num = nump[j] + nump[128 + j] + nump[256 + j] + nump[384 + j];
        p.HS[((size_t)dir * T + t) * 512 + h * 128 + j] = f2bf(num / fmaxf(fabsf(den), __expf(-mn))); }
    }
    __syncthreads();
  }
}

namespace ml {
typedef short bf16x8 __attribute__((ext_vector_type(8)));
typedef short s16x4 __attribute__((ext_vector_type(4)));
typedef float f32x16 __attribute__((ext_vector_type(16)));
constexpr int RS = 272;
constexpr int OFF_Q = 0, OFF_K = 128 * RS, OFF_VT = 2 * 128 * RS, OFF_VW = OFF_VT + 34 * RS, OFF_CT = OFF_VW + 34 * RS, OFF_A = OFF_CT + 34 * RS;
constexpr int OFF_PA = OFF_A + 16384, OFF_MCH = OFF_PA + 16384, OFF_TAB = OFF_MCH + 512, OFF_DEN = OFF_TAB + 4096, OFF_END = OFF_DEN + 512;
static_assert(OFF_A % 16 == 0 && OFF_END <= SMEM_BYTES, "mlstm LDS layout");
__device__ __forceinline__ int crow(int r, int h) { return (r & 3) + 8 * (r >> 2) + 4 * h; }
__device__ __forceinline__ int spos(int s) { return (s & ~12) | ((s & 4) << 1) | ((s & 8) >> 1); }
#define ML_MFMA(a, b, c) __builtin_amdgcn_mfma_f32_32x32x16_bf16((a), (b), (c), 0, 0, 0)
__device__ __forceinline__ bf16x8 pack8(float x0, float x1, float x2, float x3, float x4, float x5, float x6, float x7) {
  u32x4 w;
  asm volatile("v_cvt_pk_bf16_f32 %0, %4, %5\n\tv_cvt_pk_bf16_f32 %1, %6, %7\n\tv_cvt_pk_bf16_f32 %2, %8, %9\n\tv_cvt_pk_bf16_f32 %3, %10, %11\n\ts_nop 1"
               : "=&v"(w.x), "=&v"(w.y), "=&v"(w.z), "=&v"(w.w) : "v"(x0), "v"(x1), "v"(x2), "v"(x3), "v"(x4), "v"(x5), "v"(x6), "v"(x7));
  return __builtin_bit_cast(bf16x8, w);
}
__device__ __forceinline__ void tr_read8(unsigned a, s16x4& r0, s16x4& r1, s16x4& r2, s16x4& r3, s16x4& r4, s16x4& r5, s16x4& r6, s16x4& r7) {
  asm volatile("ds_read_b64_tr_b16 %0, %8\n\tds_read_b64_tr_b16 %1, %8 offset:2176\n\tds_read_b64_tr_b16 %2, %8 offset:4352\n\tds_read_b64_tr_b16 %3, %8 offset:6528\n\t"
               "ds_read_b64_tr_b16 %4, %8 offset:8704\n\tds_read_b64_tr_b16 %5, %8 offset:10880\n\tds_read_b64_tr_b16 %6, %8 offset:13056\n\tds_read_b64_tr_b16 %7, %8 offset:15232\n\ts_waitcnt lgkmcnt(0)"
               : "=&v"(r0), "=&v"(r1), "=&v"(r2), "=&v"(r3), "=&v"(r4), "=&v"(r5), "=&v"(r6), "=&v"(r7) : "v"(a) : "memory");
}
static_assert(8 * RS == 2176, "tr_read8 offsets assume 272-byte rows");

__device__ void phase_mlstm(const Params& p, char* smem) {
  int tid_ = threadIdx.x; asm volatile("" : "+v"(tid_));
  const int tid = tid_, wid = tid >> 6, lane = tid & 63, l31 = lane & 31, hh = lane >> 5;
  float* const LA = (float*)(smem + OFF_A); float* const LPA = (float*)(smem + OFF_PA); float* const LM = (float*)(smem + OFF_MCH);
  float* const LTAB = (float*)(smem + OFF_TAB); float* const LDEN = (float*)(smem + OFF_DEN);
  const unsigned lds0 = (unsigned)(uintptr_t)smem;
  for (int job = blockIdx.x; job < 256; job += gridDim.x) {
    const int dvq = job & 3, h = (job >> 2) & 3, b = (job >> 4) & 7, dir = job >> 7;
    const float* gts = p.gates + (size_t)b * S * 16;
    const bf16_t* QKb = p.QK + (size_t)b * S * 1024 + h * 128; const bf16_t* ZVb = p.ZV + (size_t)b * S * 512 + h * 128 + dvq * 32;
    bf16_t* HSb = p.HS + ((size_t)dir * T + (size_t)b * S) * 512 + h * 128 + dvq * 32;
    __syncthreads();
    for (int i = tid; i < 3 * 34 * RS / 4; i += NTHREADS) ((u32*)(smem + OFF_VT))[i] = 0u;
    for (int cc = 0; cc < 4; ++cc) { const int c = wid * 4 + cc, tau0 = c * 128 + 2 * lane; const int tok0 = dir ? S - 1 - tau0 : tau0, tok1 = dir ? tok0 - 1 : tok0 + 1;
      const float li0 = gts[(size_t)tok0 * 16 + dir * 4 + h], gf0 = gts[(size_t)tok0 * 16 + 8 + dir * 4 + h], li1 = gts[(size_t)tok1 * 16 + dir * 4 + h], gf1 = gts[(size_t)tok1 * 16 + 8 + dir * 4 + h];
      const float lf0 = fminf(gf0, 0.f) - log1pf(__expf(-fabsf(gf0))), lf1 = fminf(gf1, 0.f) - log1pf(__expf(-fabsf(gf1)));
      const float pr = lf0 + lf1; float incl = pr;
#pragma unroll
      for (int o = 1; o < 64; o <<= 1) { const float v = __shfl_up(incl, o); if (lane >= o) incl += v; }
      const float b0 = incl - pr + lf0, b1 = b0 + lf1, a0 = li0 - b0, a1 = li1 - b1;
      float im = fmaxf(a0, a1);
#pragma unroll
      for (int o = 1; o < 64; o <<= 1) { const float v = __shfl_up(im, o); if (lane >= o) im = fmaxf(im, v); }
      float ex = __shfl_up(im, 1); if (lane == 0) ex = -INFINITY;
      const float pa0 = fmaxf(ex, a0), pa1 = fmaxf(pa0, a1);
      LA[tau0] = a0; LA[tau0 + 1] = a1; LPA[tau0] = pa0; LPA[tau0 + 1] = pa1; if (lane == 63) LM[64 + c] = b1; }
    __syncthreads();
    if (tid == 0) { float m = 0.f; for (int c = 0; c < 32; ++c) { LM[c] = m; m = LM[64 + c] + fmaxf(m, LPA[c * 128 + 127]); } LM[32] = m; }
    __syncthreads();
    u32x4 qreg[4], kreg[4], vreg;
#define ML_TOK(tau) (dir ? S - 1 - (tau) : (tau))
#define ML_LOAD(c) do { _Pragma("unroll") for (int i_ = 0; i_ < 4; ++i_) { const int tk_ = ML_TOK((c) * 128 + (tid >> 4) + 32 * i_); \
        qreg[i_] = *(const u32x4*)(QKb + (size_t)tk_ * 1024 + (tid & 15) * 8); kreg[i_] = *(const u32x4*)(QKb + (size_t)tk_ * 1024 + 512 + (tid & 15) * 8); } \
      { const int tk_ = ML_TOK((c) * 128 + (tid >> 2)); vreg = *(const u32x4*)(ZVb + (size_t)tk_ * 512 + (tid & 3) * 8); } } while (0)
#define ML_TABLES(c) do { if (tid < 128) { const int tau_ = (c) * 128 + tid, tk_ = ML_TOK(tau_); const float li_ = gts[(size_t)tk_ * 16 + dir * 4 + h], a_ = LA[tau_], mc_ = LM[(c)]; \
        const float Mj_ = fmaxf(mc_, LPA[tau_]), Me_ = fmaxf(mc_, LPA[(c) * 128 + 127]); float* tb_ = LTAB + ((c) & 1) * 512; \
        tb_[tid] = Mj_; tb_[128 + tid] = __expf(mc_ - Mj_); tb_[256 + tid] = __expf(-((li_ - a_) + Mj_)); tb_[384 + tid] = __expf(a_ - Me_); } } while (0)
#define ML_STORE(c) do { _Pragma("unroll") for (int i_ = 0; i_ < 4; ++i_) { const int row_ = (tid >> 4) + 32 * i_; \
        *(u32x4*)(smem + OFF_Q + row_ * RS + (tid & 15) * 16) = qreg[i_]; *(u32x4*)(smem + OFF_K + row_ * RS + (tid & 15) * 16) = kreg[i_]; } \
      { const int s_ = tid >> 2, ps_ = spos(s_) * 2; const float we_ = LTAB[((c) & 1) * 512 + 384 + s_]; const u32 vw_[4] = {vreg.x, vreg.y, vreg.z, vreg.w}; \
        _Pragma("unroll") for (int i_ = 0; i_ < 4; ++i_) { const int r0_ = ((tid & 3) * 8 + 2 * i_) * RS + ps_; \
          *(bf16_t*)(smem + OFF_VT + r0_) = (bf16_t)(vw_[i_] & 0xFFFFu); *(bf16_t*)(smem + OFF_VT + r0_ + RS) = (bf16_t)(vw_[i_] >> 16); \
          *(bf16_t*)(smem + OFF_VW + r0_) = f2bf(bflo(vw_[i_]) * we_); *(bf16_t*)(smem + OFF_VW + r0_ + RS) = f2bf(bfhi(vw_[i_]) * we_); } } \
      if (tid < 128) { const int ps_ = spos(tid) * 2; *(bf16_t*)(smem + OFF_VT + 32 * RS + ps_) = (bf16_t)0x3F80u; *(bf16_t*)(smem + OFF_VW + 32 * RS + ps_) = f2bf(LTAB[((c) & 1) * 512 + 384 + tid]); } } while (0)
    ML_LOAD(0); ML_TABLES(0);
    __syncthreads();
    ML_STORE(0);
    __syncthreads();
    f32x16 Cacc;
#pragma unroll
    for (int r = 0; r < 16; ++r) Cacc[r] = 0.f;
    for (int c = 0; c < 32; ++c) {
      int tidc_ = threadIdx.x; asm volatile("" : "+v"(tidc_));
      const int tid = tidc_, wid = tid >> 6, lane = tid & 63, l31 = lane & 31, hh = lane >> 5;
      const int t2 = wid >> 1, nt = wid & 1, brow = min(nt * 32 + l31, 33);
      if (c + 1 < 32) { ML_LOAD(c + 1); ML_TABLES(c + 1); }
      const float* tab = LTAB + (c & 1) * 512;
      f32x16 acc;
#pragma unroll
      for (int r = 0; r < 16; ++r) acc[r] = 0.f;
      const char* qa = smem + OFF_Q + (t2 * 32 + l31) * RS + hh * 16;
      { const char* cb = smem + OFF_CT + brow * RS + hh * 16;
#pragma unroll
        for (int ks = 0; ks < 8; ++ks) acc = ML_MFMA(*(const bf16x8*)(qa + ks * 32), *(const bf16x8*)(cb + ks * 32), acc); }
#pragma unroll
      for (int r = 0; r < 16; ++r) acc[r] *= tab[128 + t2 * 32 + crow(r, hh)];
      const float Mj = tab[t2 * 32 + l31];
      for (int si = 0; si <= t2; ++si) {
        f32x16 X;
#pragma unroll
        for (int r = 0; r < 16; ++r) X[r] = 0.f;
        const char* ka = smem + OFF_K + (si * 32 + l31) * RS + hh * 16;
#pragma unroll
        for (int ks = 0; ks < 8; ++ks) X = ML_MFMA(*(const bf16x8*)(ka + ks * 32), *(const bf16x8*)(qa + ks * 32), X);
        const float* Ac = LA + c * 128 + si * 32;
#pragma unroll
        for (int r = 0; r < 16; ++r) { const int sl = crow(r, hh); float w = __expf(Ac[sl] - Mj); if (si == t2 && sl > l31) w = 0.f; X[r] *= w; }
        const bf16x8 f0 = pack8(X[0], X[1], X[2], X[3], X[4], X[5], X[6], X[7]), f1 = pack8(X[8], X[9], X[10], X[11], X[12], X[13], X[14], X[15]);
        const char* vb = smem + OFF_VT + brow * RS + si * 64 + hh * 16;
        acc = ML_MFMA(f0, *(const bf16x8*)(vb), acc); acc = ML_MFMA(f1, *(const bf16x8*)(vb + 32), acc);
      }
      if (nt == 1 && l31 == 0) {
#pragma unroll
        for (int r = 0; r < 16; ++r) LDEN[t2 * 32 + crow(r, hh)] = acc[r]; }
      { const float mc = LM[c], decay = __expf(mc - fmaxf(mc, LPA[c * 128 + 127]));
#pragma unroll
        for (int r = 0; r < 16; ++r) Cacc[r] *= decay;
        const unsigned ta = lds0 + OFF_K + ((lane & 15) >> 2) * RS + (t2 * 32 + 16 * ((lane >> 4) & 1) + 4 * (lane & 3)) * 2 + 4 * hh * RS;
        const char* wb = smem + OFF_VW + brow * RS + hh * 16;
#pragma unroll
        for (int kq = 0; kq < 2; ++kq) { s16x4 r0, r1, r2, r3, r4, r5, r6, r7; tr_read8(ta + 64 * kq * RS, r0, r1, r2, r3, r4, r5, r6, r7); __builtin_amdgcn_sched_barrier(0);
          Cacc = ML_MFMA(((bf16x8){r0[0], r0[1], r0[2], r0[3], r1[0], r1[1], r1[2], r1[3]}), *(const bf16x8*)(wb + (4 * kq + 0) * 32), Cacc);
          Cacc = ML_MFMA(((bf16x8){r2[0], r2[1], r2[2], r2[3], r3[0], r3[1], r3[2], r3[3]}), *(const bf16x8*)(wb + (4 * kq + 1) * 32), Cacc);
          Cacc = ML_MFMA(((bf16x8){r4[0], r4[1], r4[2], r4[3], r5[0], r5[1], r5[2], r5[3]}), *(const bf16x8*)(wb + (4 * kq + 2) * 32), Cacc);
          Cacc = ML_MFMA(((bf16x8){r6[0], r6[1], r6[2], r6[3], r7[0], r7[1], r7[2], r7[3]}), *(const bf16x8*)(wb + (4 * kq + 3) * 32), Cacc); } }
      __syncthreads();
      if (nt == 0) {
#pragma unroll
        for (int r = 0; r < 16; ++r) { const int j = t2 * 32 + crow(r, hh); const float dn = LDEN[j], nr = tab[256 + j]; const int tk = ML_TOK(c * 128 + j);
          HSb[(size_t)tk * 512 + l31] = f2bf(acc[r] / fmaxf(fabsf(dn), nr)); } }
      if (nt * 32 + l31 <= 32) { char* cw = smem + OFF_CT + (nt * 32 + l31) * RS + (t2 * 32 + 4 * hh) * 2;
#pragma unroll
        for (int g = 0; g < 4; ++g) { u32x2 w; w.x = pack2(Cacc[4 * g], Cacc[4 * g + 1]); w.y = pack2(Cacc[4 * g + 2], Cacc[4 * g + 3]); *(u32x2*)(cw + 16 * g) = w; } }
      if (c + 1 < 32) ML_STORE(c + 1);
      __syncthreads();
    }
#undef ML_TOK
#undef ML_LOAD
#undef ML_TABLES
#undef ML_STORE
  }
}
}

__device__ void phase_peer_select_naive(const Params& p, int layer, char* smem) {
  float* kl = (float*)smem;
  float* qsh = kl + 2 * 128 * 129;
  const int tid = threadIdx.x, wid = tid >> 6, lane = tid & 63; float* qs = qsh + wid * 128;
  __syncthreads();
  for (int i = tid; i < 2 * 128 * 128; i += NTHREADS) kl[(i >> 7) * 129 + (i & 127)] = p.peer_keys[(size_t)layer * 32768 + i];
  __syncthreads();
  for (int job = blockIdx.x; job < T; job += gridDim.x) {
    const int t = job, h = wid;
    float ts[2][16]; int ti[2][16];
#pragma unroll
    for (int pp = 0; pp < 2; ++pp) {
      const bf16_t* q = p.QP + (size_t)t * 2048 + h * 256 + pp * 128; const float q0 = bf2f(q[lane]), q1 = bf2f(q[lane + 64]);
      const float r = rsqrtf(wave_sum(q0 * q0 + q1 * q1) * (1.f / 128.f) + EPS); qs[lane] = q0 * r; qs[lane + 64] = q1 * r;
      float s0 = 0.f, s1 = 0.f; const float* k0 = kl + (pp * 128 + lane) * 129; const float* k1 = k0 + 64 * 129;
      for (int c = 0; c < 128; ++c) { const float qc = qs[c]; s0 += qc * k0[c]; s1 += qc * k1[c]; }
#pragma unroll
      for (int k = 0; k < 16; ++k) { const float mx = wave_max(fmaxf(s0, s1)); int cand = (s0 == mx) ? lane : ((s1 == mx) ? lane + 64 : 9999);
        for (int o = 32; o >= 1; o >>= 1) cand = min(cand, __shfl_xor(cand, o));
        ts[pp][k] = mx; ti[pp][k] = cand; if (cand == lane) s0 = -INFINITY; if (cand == lane + 64) s1 = -INFINITY; }
    }
    float cs[4];
#pragma unroll
    for (int r = 0; r < 4; ++r) { const int c = lane * 4 + r; float va = 0.f, vb = 0.f;
#pragma unroll
      for (int k = 0; k < 16; ++k) { if (k == (c >> 4)) va = ts[0][k]; if (k == (c & 15)) vb = ts[1][k]; }
      cs[r] = va + vb; }
    float top[16]; int tix[16];
#pragma unroll
    for (int k = 0; k < 16; ++k) { const float mx = wave_max(fmaxf(fmaxf(cs[0], cs[1]), fmaxf(cs[2], cs[3]))); int cand = 9999;
#pragma unroll
      for (int r = 3; r >= 0; --r) if (cs[r] == mx) cand = lane * 4 + r;
      for (int o = 32; o >= 1; o >>= 1) cand = min(cand, __shfl_xor(cand, o));
      top[k] = mx; tix[k] = cand;
#pragma unroll
      for (int r = 0; r < 4; ++r) if (cand == lane * 4 + r) cs[r] = -INFINITY; }
    float sum = 0.f;
#pragma unroll
    for (int k = 0; k < 16; ++k) sum += __expf(top[k] - top[0]);
    if (lane < 16) { float tv = 0.f; int tc = 0;
#pragma unroll
      for (int k = 0; k < 16; ++k) if (k == lane) { tv = top[k]; tc = tix[k]; }
      int ia = 0, ib = 0;
#pragma unroll
      for (int k = 0; k < 16; ++k) { if (k == (tc >> 4)) ia = ti[0][k]; if (k == (tc & 15)) ib = ti[1][k]; }
      p.pidx[((size_t)t * 8 + h) * 16 + lane] = (bf16_t)(ia * 128 + ib); p.pgate[((size_t)t * 8 + h) * 16 + lane] = __expf(tv - top[0]) / sum; }
  }
}

namespace sel {
typedef short bf16x8 __attribute__((ext_vector_type(8)));
typedef float f32x16 __attribute__((ext_vector_type(16)));
constexpr int RS = 272, OFF_W = 2 * 128 * RS, WB = 3 * 16 * 32 * 4;
static_assert(OFF_W + 8 * WB <= SMEM_BYTES, "select LDS layout");
constexpr float NEG = -3.0e38f;
__device__ __forceinline__ float max3(float a, float b, float c) { return fmaxf(fmaxf(a, b), c); }
__device__ __forceinline__ float xhalf(float v) { return __shfl_xor(v, 32); }

#define CE(a, b) do { const float hi_ = fmaxf(a, b), lo_ = fminf(a, b); a = hi_; b = lo_; } while (0)
#define SORT16(V) do { CE(V[0], V[1]); CE(V[2], V[3]); CE(V[0], V[2]); CE(V[1], V[3]); CE(V[1], V[2]); CE(V[4], V[5]); CE(V[6], V[7]); CE(V[4], V[6]); CE(V[5], V[7]); CE(V[5], V[6]); CE(V[0], V[4]); CE(V[2], V[6]); CE(V[2], V[4]); CE(V[1], V[5]); CE(V[3], V[7]); CE(V[3], V[5]); CE(V[1], V[2]); CE(V[3], V[4]); CE(V[5], V[6]); CE(V[8], V[9]); CE(V[10], V[11]); CE(V[8], V[10]); CE(V[9], V[11]); CE(V[9], V[10]); CE(V[12], V[13]); CE(V[14], V[15]); CE(V[12], V[14]); CE(V[13], V[15]); CE(V[13], V[14]); CE(V[8], V[12]); CE(V[10], V[14]); CE(V[10], V[12]); CE(V[9], V[13]); CE(V[11], V[15]); CE(V[11], V[13]); CE(V[9], V[10]); CE(V[11], V[12]); CE(V[13], V[14]); CE(V[0], V[8]); CE(V[4], V[12]); CE(V[4], V[8]); CE(V[2], V[10]); CE(V[6], V[14]); CE(V[6], V[10]); CE(V[2], V[4]); CE(V[6], V[8]); CE(V[10], V[12]); CE(V[1], V[9]); CE(V[5], V[13]); CE(V[5], V[9]); CE(V[3], V[11]); CE(V[7], V[15]); CE(V[7], V[11]); CE(V[3], V[5]); CE(V[7], V[9]); CE(V[11], V[13]); CE(V[1], V[2]); CE(V[3], V[4]); CE(V[5], V[6]); CE(V[7], V[8]); CE(V[9], V[10]); CE(V[11], V[12]); CE(V[13], V[14]); } while (0)
#define BMERGE16(V) do { CE(V[0], V[8]); CE(V[1], V[9]); CE(V[2], V[10]); CE(V[3], V[11]); CE(V[4], V[12]); CE(V[5], V[13]); CE(V[6], V[14]); CE(V[7], V[15]); CE(V[0], V[4]); CE(V[1], V[5]); CE(V[2], V[6]); CE(V[3], V[7]); CE(V[8], V[12]); CE(V[9], V[13]); CE(V[10], V[14]); CE(V[11], V[15]); CE(V[0], V[2]); CE(V[1], V[3]); CE(V[4], V[6]); CE(V[5], V[7]); CE(V[8], V[10]); CE(V[9], V[11]); CE(V[12], V[14]); CE(V[13], V[15]); CE(V[0], V[1]); CE(V[2], V[3]); CE(V[4], V[5]); CE(V[6], V[7]); CE(V[8], V[9]); CE(V[10], V[11]); CE(V[12], V[13]); CE(V[14], V[15]); } while (0)

__device__ void phase_peer_select(const Params& p, int layer, char* smem) {
  const int tid0 = threadIdx.x;
  __syncthreads();
  { const bf16_t* kb = p.keysb + (size_t)layer * 32768;
    for (int i = tid0; i < 2 * 128 * 16; i += NTHREADS) { const int row = i >> 4, ch = i & 15; *(u32x4*)(smem + row * RS + ch * 16) = *(const u32x4*)(kb + (size_t)row * 128 + ch * 8); } }
  __syncthreads();
  for (int job = blockIdx.x; job < T / 32; job += gridDim.x) {
    int tid_ = threadIdx.x; asm volatile("" : "+v"(tid_));
    const int tid = tid_, wid = tid >> 6, lane = tid & 63, l31 = lane & 31, hh = lane >> 5, h = wid;
    const int t = job * 32 + l31;
    float* const wl = (float*)(smem + OFF_W + wid * WB);
    float rs[2], s1[16], s2[16];
#pragma unroll
    for (int pp = 0; pp < 2; ++pp) {
      const bf16_t* qrow = p.QP + (size_t)t * 2048 + h * 256 + pp * 128 + hh * 8;
      bf16x8 bq[8]; float ssq = 0.f;
#pragma unroll
      for (int ks = 0; ks < 8; ++ks) { const u32x4 w = *(const u32x4*)(qrow + ks * 16); bq[ks] = __builtin_bit_cast(bf16x8, w);
        const u32 w0 = w.x, w1 = w.y, w2 = w.z, w3 = w.w; ssq = dot2bf(w0, w0, ssq); ssq = dot2bf(w1, w1, ssq); ssq = dot2bf(w2, w2, ssq); ssq = dot2bf(w3, w3, ssq); }
      ssq += xhalf(ssq); rs[pp] = rsqrtf(ssq * (1.f / 128.f) + EPS);
      f32x16 X[4];
#pragma unroll
      for (int nt = 0; nt < 4; ++nt) {
#pragma unroll
        for (int r = 0; r < 16; ++r) X[nt][r] = 0.f;
        const char* ka = smem + (pp * 128 + nt * 32 + l31) * RS + hh * 16;
#pragma unroll
        for (int ks = 0; ks < 8; ++ks) X[nt] = __builtin_amdgcn_mfma_f32_32x32x16_bf16(*(const bf16x8*)(ka + ks * 32), bq[ks], X[nt], 0, 0, 0); }
#pragma unroll
      for (int nt = 0; nt < 4; ++nt)
#pragma unroll
        for (int r = 0; r < 16; ++r) X[nt][r] = __uint_as_float((__float_as_uint(X[nt][r]) & ~0x7Fu) | (u32)(nt * 32 + (r & 3) + 8 * (r >> 2)) | ((u32)hh << 2));
      SORT16(X[0]); SORT16(X[1]); SORT16(X[2]); SORT16(X[3]);
#pragma unroll
      for (int i = 0; i < 16; ++i) { X[0][i] = fmaxf(X[0][i], X[1][15 - i]); X[2][i] = fmaxf(X[2][i], X[3][15 - i]); }
      BMERGE16(X[0]); BMERGE16(X[2]);
#pragma unroll
      for (int i = 0; i < 16; ++i) X[0][i] = fmaxf(X[0][i], X[2][15 - i]);
      BMERGE16(X[0]);
      f32x16 lo_, hi_;
#pragma unroll
      for (int i = 0; i < 16; ++i) { const u32 b_ = __float_as_uint(X[0][i]); auto r_ = __builtin_amdgcn_permlane32_swap(b_, b_, false, false); lo_[i] = __uint_as_float(r_[0]); hi_[i] = __uint_as_float(r_[1]); }
#pragma unroll
      for (int i = 0; i < 16; ++i) X[0][i] = fmaxf(lo_[i], hi_[15 - i]);
      BMERGE16(X[0]);
#pragma unroll
      for (int k = 0; k < 16; ++k) { wl[(pp * 16 + k) * 32 + l31] = X[0][k]; if (pp == 0) s1[k] = X[0][k] * rs[0]; else s2[k] = X[0][k] * rs[1]; }
    }
    constexpr int A0[25] = {0, 0, 0, 0, 0, 0, 0, 0, 0, 0, 0, 0, 0, 0, 0, 0, 2, 2, 2, 2, 2, 3, 3, 3, 3}, B0[25] = {0, 1, 2, 3, 4, 5, 6, 7, 8, 9, 10, 11, 12, 13, 14, 15, 0, 1, 2, 3, 4, 0, 1, 2, 3};
    constexpr int A1[25] = {1, 1, 1, 1, 1, 1, 1, 1, 4, 4, 4, 5, 5, 6, 6, 7, 7, 8, 9, 10, 11, 12, 13, 14, 15}, B1[25] = {0, 1, 2, 3, 4, 5, 6, 7, 0, 1, 2, 0, 1, 0, 1, 0, 1, 0, 0, 0, 0, 0, 0, 0, 0};
    float cd[25];
#pragma unroll
    for (int i = 0; i < 25; ++i) { const float v0 = s1[A0[i]] + s2[B0[i]], v1 = s1[A1[i]] + s2[B1[i]]; const float v = hh ? v1 : v0; const u32 cid = hh ? (u32)(A1[i] * 16 + B1[i]) : (u32)(A0[i] * 16 + B0[i]);
      cd[i] = __uint_as_float((__float_as_uint(v) & ~0xFFu) | cid); }
#pragma unroll 1
    for (int k = 0; k < 16; ++k) {
      float m = cd[24];
#pragma unroll
      for (int i = 0; i < 24; i += 2) m = max3(m, cd[i], cd[i + 1]);
      const float M = fmaxf(m, xhalf(m));
      wl[(32 + k) * 32 + l31] = M;
#pragma unroll
      for (int i = 0; i < 25; ++i) cd[i] = (cd[i] == M) ? NEG : cd[i];
    }
    float tv[16];
#pragma unroll
    for (int k = 0; k < 16; ++k) tv[k] = wl[(32 + k) * 32 + l31];
    float sum = 0.f;
#pragma unroll
    for (int k = 0; k < 16; ++k) sum += __expf(tv[k] - tv[0]);
    const float inv = 1.f / sum;
    u32 ev[8]; float go[8];
#pragma unroll
    for (int q = 0; q < 8; ++q) { const float v = wl[(32 + hh * 8 + q) * 32 + l31]; const u32 cid = __float_as_uint(v) & 0xFFu;
      const u32 i1 = __float_as_uint(wl[(cid >> 4) * 32 + l31]) & 0x7Fu, i2 = __float_as_uint(wl[(16 + (cid & 15)) * 32 + l31]) & 0x7Fu; ev[q] = i1 * 128 + i2;
      go[q] = __expf(v - tv[0]) * inv; }
    const u32 io0 = ev[0] | (ev[1] << 16), io1 = ev[2] | (ev[3] << 16), io2 = ev[4] | (ev[5] << 16), io3 = ev[6] | (ev[7] << 16);
    const size_t ob = ((size_t)t * 8 + h) * 16 + hh * 8;
    *(u32x4*)(p.pidx + ob) = (u32x4){io0, io1, io2, io3};
    *(f32x4*)(p.pgate + ob) = (f32x4){go[0], go[1], go[2], go[3]}; *(f32x4*)(p.pgate + ob + 4) = (f32x4){go[4], go[5], go[6], go[7]};
  }
}
}

typedef float f32x2 __attribute__((ext_vector_type(2)));
constexpr float U8_SCALE = 32.f, V8_SCALE = 2.f;
constexpr int GT = 4;
constexpr int GW_WAVE_BYTES = GT * (2048 + 128 * 2 + 128 * 4);
static_assert(8 * GW_WAVE_BYTES <= SMEM_BYTES - 16, "gather LDS layout");
__device__ __forceinline__ float gelu_erf(float z) { return 0.5f * z * (1.f + erff(z * 0.70710678118654752f)); }
__device__ __forceinline__ float reduce8(float d0, float d1, float d2, float d3, float d4, float d5, float d6, float d7, int lane) {
  float e[4];
  { auto r0 = __builtin_amdgcn_permlane32_swap(__float_as_uint(d0), __float_as_uint(d4), false, false); e[0] = __uint_as_float(r0[0]) + __uint_as_float(r0[1]);
    auto r1 = __builtin_amdgcn_permlane32_swap(__float_as_uint(d1), __float_as_uint(d5), false, false); e[1] = __uint_as_float(r1[0]) + __uint_as_float(r1[1]);
    auto r2 = __builtin_amdgcn_permlane32_swap(__float_as_uint(d2), __float_as_uint(d6), false, false); e[2] = __uint_as_float(r2[0]) + __uint_as_float(r2[1]);
    auto r3 = __builtin_amdgcn_permlane32_swap(__float_as_uint(d3), __float_as_uint(d7), false, false); e[3] = __uint_as_float(r3[0]) + __uint_as_float(r3[1]); }
  float f0, f1;
  { auto r0 = __builtin_amdgcn_permlane16_swap(__float_as_uint(e[0]), __float_as_uint(e[2]), false, false); f0 = __uint_as_float(r0[0]) + __uint_as_float(r0[1]);
    auto r1 = __builtin_amdgcn_permlane16_swap(__float_as_uint(e[1]), __float_as_uint(e[3]), false, false); f1 = __uint_as_float(r1[0]) + __uint_as_float(r1[1]); }
  const bool up = (lane & 8) != 0; const float keep = up ? f1 : f0, send = up ? f0 : f1;
  float g = keep + __shfl_xor(send, 8);
  g += __shfl_xor(g, 4); g += __shfl_xor(g, 2); g += __shfl_xor(g, 1);
  return g;
}
template <int NEXT>
__device__ void phase_peer_gather(const Params& p, int layer, char* smem) {
  const unsigned char* U8 = p.U8 + (size_t)layer * 16384 * 1024; const unsigned char* V8 = p.V8 + (size_t)layer * 16384 * 1024;
  for (int job = blockIdx.x; job < T / (8 * GT); job += gridDim.x) {
    int tid_ = threadIdx.x; asm volatile("" : "+v"(tid_));
    const int tid = tid_, wid = tid >> 6, lane = tid & 63;
    const int tb = (job * 8 + wid) * GT;
    const int vidx = 4 * (lane >> 5) + 2 * ((lane >> 4) & 1) + ((lane >> 3) & 1);
    char* wl = smem + wid * GW_WAVE_BYTES; bf16_t* sx = (bf16_t*)wl; bf16_t* sidx = (bf16_t*)(wl + GT * 2048); float* sgate = (float*)(wl + GT * 2048 + GT * 256);
#pragma unroll 1
    for (int g = 0; g < GT; ++g) { const size_t t = (size_t)(tb + g);
      *(u32x4*)(sx + g * 1024 + lane * 16) = *(const u32x4*)(p.H + t * D + lane * 16); *(u32x4*)(sx + g * 1024 + lane * 16 + 8) = *(const u32x4*)(p.H + t * D + lane * 16 + 8);
      const int ia = p.pidx[t * 128 + lane], ib = p.pidx[t * 128 + 64 + lane]; const float ga = p.pgate[t * 128 + lane], gb = p.pgate[t * 128 + 64 + lane];
      const int wa = ia >> 10, wb = ib >> 10; int off = 0, pa = 0, pb = 0;
#pragma unroll
      for (int w = 0; w < 16; ++w) { const unsigned long long m0 = __ballot(wa == w), m1 = __ballot(wb == w); const int c0 = __popcll(m0), c1 = __popcll(m1);
        const int r0 = __builtin_amdgcn_mbcnt_hi((unsigned)(m0 >> 32), __builtin_amdgcn_mbcnt_lo((unsigned)m0, 0)), r1 = __builtin_amdgcn_mbcnt_hi((unsigned)(m1 >> 32), __builtin_amdgcn_mbcnt_lo((unsigned)m1, 0));
        if (wa == w) pa = off + r0; if (wb == w) pb = off + c0 + r1; off += c0 + c1; }
      sidx[g * 128 + pa] = (bf16_t)ia; sgate[g * 128 + pa] = ga; sidx[g * 128 + pb] = (bf16_t)ib; sgate[g * 128 + pb] = gb; }
    f32x2 acc[GT][8];
#pragma unroll
    for (int g = 0; g < GT; ++g)
#pragma unroll
      for (int i = 0; i < 8; ++i) acc[g][i] = (f32x2){0.f, 0.f};
#pragma unroll 1
    for (int hb = 0; hb < 16; ++hb) {
#pragma unroll
      for (int g = 0; g < GT; ++g) {
        const int myidx = (int)sidx[g * 128 + hb * 8 + (lane & 7)]; const float mygate = sgate[g * 128 + hb * 8 + vidx];
        const u32x4 h0 = *(const u32x4*)(sx + g * 1024 + lane * 16), h1 = *(const u32x4*)(sx + g * 1024 + lane * 16 + 8);
        const u32 hx[8] = {h0.x, h0.y, h0.z, h0.w, h1.x, h1.y, h1.z, h1.w};
        u32x4 ur[8], vr[8];
#pragma unroll
        for (int k = 0; k < 8; ++k) { const int e = __builtin_amdgcn_readlane(myidx, k); ur[k] = *(const u32x4*)(U8 + (size_t)e * 1024 + lane * 16); if (k < 4) vr[k] = *(const u32x4*)(V8 + (size_t)e * 1024 + lane * 16); }
        float d[8];
#pragma unroll
        for (int k = 0; k < 8; ++k) { const u32 w[4] = {ur[k].x, ur[k].y, ur[k].z, ur[k].w}; float a = 0.f;
#pragma unroll
          for (int j = 0; j < 4; ++j) { const u32 lo = __builtin_bit_cast(u32, __builtin_amdgcn_cvt_scalef32_pk_bf16_fp8(w[j], 1.0f, false)), hi = __builtin_bit_cast(u32, __builtin_amdgcn_cvt_scalef32_pk_bf16_fp8(w[j], 1.0f, true));
            a = dot2bf(lo, hx[2 * j], a); a = dot2bf(hi, hx[2 * j + 1], a); }
          asm volatile("" : "+v"(a));
          d[k] = a; }
        asm volatile("" ::: "memory");
#pragma unroll
        for (int k = 4; k < 8; ++k) { const int e = __builtin_amdgcn_readlane(myidx, k); vr[k] = *(const u32x4*)(V8 + (size_t)e * 1024 + lane * 16); }
        const float z = reduce8(d[0], d[1], d[2], d[3], d[4], d[5], d[6], d[7], lane) * (1.f / U8_SCALE);
        const float cf = mygate * gelu_erf(z) * (1.f / V8_SCALE);
#pragma unroll
        for (int k = 0; k < 8; ++k) { const float ck = __uint_as_float(__builtin_amdgcn_readlane(__float_as_uint(cf), 32 * (k >> 2) + 16 * ((k >> 1) & 1) + 8 * (k & 1)));
          const u32 w[4] = {vr[k].x, vr[k].y, vr[k].z, vr[k].w}; const f32x2 c2 = (f32x2){ck, ck};
#pragma unroll
          for (int j = 0; j < 4; ++j) { const f32x2 lo = __builtin_amdgcn_cvt_pk_f32_fp8((int)w[j], false), hi = __builtin_amdgcn_cvt_pk_f32_fp8((int)w[j], true);
            acc[g][2 * j] = lo * c2 + acc[g][2 * j]; acc[g][2 * j + 1] = hi * c2 + acc[g][2 * j + 1]; } }
        asm volatile("" ::: "memory");
      }
      if ((hb & 3) == 3) __syncthreads();
    }
#pragma unroll
    for (int g = 0; g < GT; ++g) { const int t = tb + g, b = t / S;
      const float* g2 = p.mod + (size_t)(layer * 8 + b) * 6144 + 5120 + lane * 16; float* xp = p.X + (size_t)t * D + lane * 16;
      float xv[16]; float ss = 0.f;
#pragma unroll
      for (int q = 0; q < 4; ++q) { const f32x4 x0 = *(const f32x4*)(xp + 4 * q), g0 = *(const f32x4*)(g2 + 4 * q);
        xv[4 * q + 0] = x0.x + g0.x * acc[g][2 * q].x; xv[4 * q + 1] = x0.y + g0.y * acc[g][2 * q].y; xv[4 * q + 2] = x0.z + g0.z * acc[g][2 * q + 1].x; xv[4 * q + 3] = x0.w + g0.w * acc[g][2 * q + 1].y; }
#pragma unroll
      for (int i = 0; i < 16; ++i) ss += xv[i] * xv[i];
      ss = wave_sum(ss); const float r = rsqrtf(ss * (1.f / D) + EPS);
      if (NEXT == 0) {
        const float* ml = p.mod + (size_t)((layer + 1) * 8 + b) * 6144 + lane * 16; const float* gn = p.nmg + (layer + 1) * D + lane * 16; float y[16];
#pragma unroll
        for (int i = 0; i < 16; ++i) y[i] = xv[i] * r * gn[i] * (1.f + ml[1024 + i]) + ml[i];
#pragma unroll
        for (int q = 0; q < 4; ++q) *(f32x4*)(xp + 4 * q) = (f32x4){xv[4 * q], xv[4 * q + 1], xv[4 * q + 2], xv[4 * q + 3]};
        u32x4 w0, w1; w0.x = pack2(y[0], y[1]); w0.y = pack2(y[2], y[3]); w0.z = pack2(y[4], y[5]); w0.w = pack2(y[6], y[7]); w1.x = pack2(y[8], y[9]); w1.y = pack2(y[10], y[11]); w1.z = pack2(y[12], y[13]); w1.w = pack2(y[14], y[15]);
        *(u32x4*)(p.H + (size_t)t * D + lane * 16) = w0; *(u32x4*)(p.H + (size_t)t * D + lane * 16 + 8) = w1;
      } else {
        const float* fg = p.final_g + lane * 16;
#pragma unroll
        for (int q = 0; q < 4; ++q) *(f32x4*)(xp + 4 * q) = (f32x4){xv[4 * q] * r * fg[4 * q], xv[4 * q + 1] * r * fg[4 * q + 1], xv[4 * q + 2] * r * fg[4 * q + 2], xv[4 * q + 3] * r * fg[4 * q + 3]};
      }
      asm volatile("" ::: "memory");
    }
    __syncthreads();
  }
}

template <bool WITH_GATES>
__device__ void phase_norm(const Params& p, const float* __restrict__ xin, const float* __restrict__ g, const float* __restrict__ modl, int sh_off, int sc_off, char* smem) {
  float* wg = (float*)smem;
  if (WITH_GATES) { __syncthreads(); for (int i = threadIdx.x; i < 16 * 1024; i += NTHREADS) wg[i] = p.Wg[i]; __syncthreads(); }
  for (int job = blockIdx.x; job < T / 32; job += gridDim.x) {
    int tid_ = threadIdx.x; asm volatile("" : "+v"(tid_));
    const int tid = tid_, wid = tid >> 6, lane = tid & 63; const int tb = job * 32 + wid * 4, b = tb / S;
    f32x4 v[4][4];
#pragma unroll
    for (int q = 0; q < 4; ++q)
#pragma unroll
      for (int i = 0; i < 4; ++i) v[q][i] = *(const f32x4*)(xin + (size_t)(tb + q) * D + i * 256 + lane * 4);
    const float* shp = modl + (size_t)b * 6144 + sh_off; const float* scp = modl + (size_t)b * 6144 + sc_off;
    f32x4 ga[4], gc[4];
#pragma unroll
    for (int i = 0; i < 4; ++i) { const int d = i * 256 + lane * 4; const f32x4 gg = *(const f32x4*)(g + d), s1 = *(const f32x4*)(scp + d); ga[i] = gg * (1.f + s1); gc[i] = *(const f32x4*)(shp + d); }
#pragma unroll
    for (int q = 0; q < 4; ++q) { float ss = 0.f;
#pragma unroll
      for (int i = 0; i < 4; ++i) ss += v[q][i].x * v[q][i].x + v[q][i].y * v[q][i].y + v[q][i].z * v[q][i].z + v[q][i].w * v[q][i].w;
      ss = wave_sum(ss); const float r = rsqrtf(ss * (1.f / D) + EPS);
#pragma unroll
      for (int i = 0; i < 4; ++i) { v[q][i] = v[q][i] * r * ga[i] + gc[i]; u32x2 w; w.x = pack2(v[q][i].x, v[q][i].y); w.y = pack2(v[q][i].z, v[q][i].w); *(u32x2*)(p.H + (size_t)(tb + q) * D + i * 256 + lane * 4) = w; }
      if (WITH_GATES) { float myg = 0.f;
#pragma unroll 2
        for (int gi = 0; gi < 16; ++gi) { float a = 0.f;
#pragma unroll
          for (int i = 0; i < 4; ++i) { const f32x4 w4 = *(const f32x4*)(wg + gi * 1024 + i * 256 + lane * 4); a += v[q][i].x * w4.x + v[q][i].y * w4.y + v[q][i].z * w4.z + v[q][i].w * w4.w; }
          a = wave_sum(a); if (lane == gi) myg = a; }
        if (lane < 16) p.gates[(size_t)(tb + q) * 16 + lane] = myg + p.ev_b_in[2560 + lane]; }
    }
  }
}
__device__ void phase_cat(const Params& p) {
  for (int job = blockIdx.x; job < T / 32; job += gridDim.x) {
    int tid_ = threadIdx.x; asm volatile("" : "+v"(tid_));
    const int tid = tid_, wid = tid >> 6, lane = tid & 63; const int tb = job * 32 + wid * 4;
    u32x4 a[4], bq[4], so[4];
#pragma unroll
    for (int q = 0; q < 4; ++q) { const size_t o = (size_t)(tb + q) * 512 + lane * 8; a[q] = *(const u32x4*)(p.HS + o); bq[q] = *(const u32x4*)(p.HS + (size_t)T * 512 + o); so[q] = *(const u32x4*)(p.ZO + o); }
    const f32x4 g0 = *(const f32x4*)(p.mnorm_g + lane * 8), g1 = *(const f32x4*)(p.mnorm_g + lane * 8 + 4);
#pragma unroll
    for (int q = 0; q < 4; ++q) { float x[8]; const u32 aw[4] = {a[q].x, a[q].y, a[q].z, a[q].w}, bw[4] = {bq[q].x, bq[q].y, bq[q].z, bq[q].w}, sw[4] = {so[q].x, so[q].y, so[q].z, so[q].w};
      float ss = 0.f;
#pragma unroll
      for (int j = 0; j < 4; ++j) { x[2 * j] = bflo(aw[j]) + bflo(bw[j]); x[2 * j + 1] = bfhi(aw[j]) + bfhi(bw[j]); ss += x[2 * j] * x[2 * j] + x[2 * j + 1] * x[2 * j + 1]; }
      ss += __shfl_xor(ss, 1); ss += __shfl_xor(ss, 2); ss += __shfl_xor(ss, 4); ss += __shfl_xor(ss, 8);
      const float r = rsqrtf(ss * (1.f / 128.f) + EPS);
      u32x4 w; w.x = pack2(x[0] * r * g0.x * bflo(sw[0]), x[1] * r * g0.y * bfhi(sw[0])); w.y = pack2(x[2] * r * g0.z * bflo(sw[1]), x[3] * r * g0.w * bfhi(sw[1]));
      w.z = pack2(x[4] * r * g1.x * bflo(sw[2]), x[5] * r * g1.y * bfhi(sw[2])); w.w = pack2(x[6] * r * g1.z * bflo(sw[3]), x[7] * r * g1.w * bfhi(sw[3]));
      *(u32x4*)(p.CAT + (size_t)(tb + q) * 1024 + lane * 8) = w; }
  }
}
__device__ void phase_qkrope(const Params& p, char* smem) {
  float* tab = (float*)smem;
  __syncthreads();
  for (int i = threadIdx.x; i < 64 * 32; i += NTHREADS) { const int pos = i >> 5, fi = i & 31; const float fr = exp2f(-(float)(2 * fi) * (13.287712379549449f / 64.f)); float sn, cs; sincosf((float)pos * fr, &sn, &cs); tab[2 * i] = cs; tab[2 * i + 1] = sn; }
  __syncthreads();
  for (int job = blockIdx.x; job < T / 16; job += gridDim.x) {
    int tid_ = threadIdx.x; asm volatile("" : "+v"(tid_));
    const int tid = tid_, wid = tid >> 6, lane = tid & 63; const int tb = job * 16 + wid * 2;
    u32x4 raw[2][3];
#pragma unroll
    for (int q = 0; q < 2; ++q)
#pragma unroll
      for (int i = 0; i < 3; ++i) raw[q][i] = *(const u32x4*)(p.QKV + (size_t)(tb + q) * 1536 + (lane + 64 * i) * 8);
#pragma unroll
    for (int q = 0; q < 2; ++q) { const int t = tb + q, b = t / S, s = t & (S - 1);
#pragma unroll
      for (int i = 0; i < 3; ++i) { const int c = lane + 64 * i, hh = c >> 4, cc = c & 15; float x[8]; const u32 rw[4] = {raw[q][i].x, raw[q][i].y, raw[q][i].z, raw[q][i].w};
#pragma unroll
        for (int j = 0; j < 4; ++j) { x[2 * j] = bflo(rw[j]); x[2 * j + 1] = bfhi(rw[j]); }
        u32x4 w;
        if (hh < 10) { float ss = 0.f;
#pragma unroll
          for (int j = 0; j < 8; ++j) ss += x[j] * x[j];
          ss += __shfl_xor(ss, 1); ss += __shfl_xor(ss, 2); ss += __shfl_xor(ss, 4); ss += __shfl_xor(ss, 8);
          const float r = rsqrtf(ss * (1.f / 128.f) + EPS); const float* gp = (hh < 8 ? p.qn_g : p.kn_g) + cc * 8;
          const int pos = cc < 8 ? (s >> 6) : (s & 63); const float* tp = tab + (pos * 32 + (cc & 7) * 4) * 2; float y[8];
#pragma unroll
          for (int j = 0; j < 4; ++j) { const float x0 = x[2 * j] * r * gp[2 * j], x1 = x[2 * j + 1] * r * gp[2 * j + 1], cs = tp[2 * j], sn = tp[2 * j + 1]; y[2 * j] = x0 * cs - x1 * sn; y[2 * j + 1] = x0 * sn + x1 * cs; }
          w.x = pack2(y[0], y[1]); w.y = pack2(y[2], y[3]); w.z = pack2(y[4], y[5]); w.w = pack2(y[6], y[7]);
        } else w = raw[q][i];
        bf16_t* dst = hh < 8 ? p.Qh + (((size_t)b * 8 + hh) * S + s) * 128 : (hh < 10 ? p.Kh + (((size_t)b * 2 + hh - 8) * S + s) * 128 : p.Vh + (((size_t)b * 2 + hh - 10) * S + s) * 128);
        *(u32x4*)(dst + cc * 8) = w; }
    }
  }
}

__device__ void phase_attn_naive(const Params& p) {
  const int tid = threadIdx.x, wid = tid >> 6, lane = tid & 63;
  for (int job = blockIdx.x; job < T * 2 / 8; job += gridDim.x) {
    const int w = job * 8 + wid, kv = w & 1, t = w >> 1, b = t / S, s = t & (S - 1);
    float q0[4], q1[4], m[4], l[4], o0[4], o1[4];
#pragma unroll
    for (int g = 0; g < 4; ++g) { const u32 qq = *(const u32*)(p.Qh + (((size_t)b * 8 + kv * 4 + g) * S + s) * 128 + lane * 2); q0[g] = bflo(qq); q1[g] = bfhi(qq); m[g] = -1e30f; l[g] = 0.f; o0[g] = 0.f; o1[g] = 0.f; }
    const bf16_t* Kb = p.Kh + ((size_t)b * 2 + kv) * S * 128; const bf16_t* Vb = p.Vh + ((size_t)b * 2 + kv) * S * 128;
    for (int k = 0; k < S; ++k) { const u32 kk = *(const u32*)(Kb + (size_t)k * 128 + lane * 2), vv = *(const u32*)(Vb + (size_t)k * 128 + lane * 2);
      const float k0 = bflo(kk), k1 = bfhi(kk), v0 = bflo(vv), v1 = bfhi(vv);
#pragma unroll
      for (int g = 0; g < 4; ++g) { const float sc = wave_sum(q0[g] * k0 + q1[g] * k1) * KSCALE; const float mn = fmaxf(m[g], sc), al = __expf(m[g] - mn), pw = __expf(sc - mn);
        l[g] = l[g] * al + pw; o0[g] = o0[g] * al + pw * v0; o1[g] = o1[g] * al + pw * v1; m[g] = mn; } }
#pragma unroll
    for (int g = 0; g < 4; ++g) *(u32*)(p.CAT + (size_t)t * 1024 + (kv * 4 + g) * 128 + lane * 2) = pack2(o0[g] / l[g], o1[g] / l[g]);
  }
}

namespace att {
using bf16 = unsigned short;
constexpr int   D = 128, NW = 8, QBLK = 32, KVBLK = 64;
constexpr float SCALE = 0.088388347648318440f;
constexpr float THR = 8.f;
constexpr int SDEPTH = 2;
constexpr int LDQ = 128, LDK = 128, LDO = 1024;
constexpr size_t SHM_V = KVBLK * D * 2, SHM_K = KVBLK * D * 2, SHM_ATTN = 2 * SHM_V + 2 * SHM_K + NW * 64 * 4;
using bf16x8 = __attribute__((ext_vector_type(8))) short;
using s16x4  = __attribute__((ext_vector_type(4))) short;
using f32x16 = __attribute__((ext_vector_type(16))) float;
using f32x8  = __attribute__((ext_vector_type(8))) float;
using u32x4  = __attribute__((ext_vector_type(4))) unsigned;
#define KSWZ(row, colB) ((row) * 256 + ((colB) ^ (((row) & 7) << 4)))
#define SBAR() __builtin_amdgcn_sched_barrier(0)
__device__ __forceinline__ int crow(int r, int hi) { return (r & 3) + 8 * (r >> 2) + 4 * hi; }
__device__ __forceinline__ unsigned cvtpk(float lo, float hi) {
  unsigned r; asm volatile("v_cvt_pk_bf16_f32 %0, %1, %2" : "=v"(r) : "v"(lo), "v"(hi)); return r;
}
template <typename TIn> struct Stage;
template <> struct Stage<bf16>  { using T = bf16x8;
  __device__ static __forceinline__ T ld8(const bf16* p) { return *reinterpret_cast<const bf16x8*>(p); }
  __device__ static __forceinline__ bf16x8 tobf(T x) { return x; } };
template <> struct Stage<float> { using T = f32x8;
  __device__ static __forceinline__ T ld8(const float* p) { return *reinterpret_cast<const f32x8*>(p); }
  __device__ static __forceinline__ bf16x8 tobf(T x) {
    u32x4 w = {cvtpk(x[0], x[1]), cvtpk(x[2], x[3]), cvtpk(x[4], x[5]), cvtpk(x[6], x[7])}; return *reinterpret_cast<bf16x8*>(&w); } };

__device__ __forceinline__ void partialSM(f32x16& p0, f32x16& p1, float& m_reg, float& mn, float& alpha) {
  constexpr float C = SCALE * 1.4426950408889634f;
  float pmax = p0[0]; for (int r = 1; r < 16; ++r) pmax = fmaxf(pmax, p0[r]); for (int r = 0; r < 16; ++r) pmax = fmaxf(pmax, p1[r]);
  { auto rr = __builtin_amdgcn_permlane32_swap(__float_as_uint(pmax), __float_as_uint(pmax), false, false);
    pmax = fmaxf(__uint_as_float(rr[0]), __uint_as_float(rr[1])); }
  if (__builtin_expect(__all(pmax - m_reg <= THR / SCALE), 1)) { mn = m_reg; alpha = 1.f; }
  else { mn = fmaxf(m_reg, pmax); alpha = __builtin_amdgcn_exp2f((m_reg - mn) * C); m_reg = mn; }
  float mnC = -mn * C;
  for (int r = 0; r < 16; ++r) p0[r] = fmaf(p0[r], C, mnC); for (int r = 0; r < 16; ++r) p1[r] = fmaf(p1[r], C, mnC);
  for (int r = 0; r < 16; ++r) p0[r] = __builtin_amdgcn_exp2f(p0[r]);
}
__device__ __forceinline__ void finishSM(f32x16& p0, f32x16& p1, float alpha, float& l_reg, bf16x8& pa0, bf16x8& pa1, bf16x8& pa2, bf16x8& pa3) {
  for (int r = 0; r < 16; ++r) p1[r] = __builtin_amdgcn_exp2f(p1[r]);
  float ps = 0; for (int r = 0; r < 16; ++r) ps += p0[r]; for (int r = 0; r < 16; ++r) ps += p1[r];
  { auto rr = __builtin_amdgcn_permlane32_swap(__float_as_uint(ps), __float_as_uint(ps), false, false);
    ps = __uint_as_float(rr[0]) + __uint_as_float(rr[1]); }
  l_reg = l_reg * alpha + ps;
#define PK4(P, BASE, OUT) do { unsigned a0 = cvtpk(P[BASE + 0], P[BASE + 1]), a1 = cvtpk(P[BASE + 2], P[BASE + 3]);   \
    unsigned b0 = cvtpk(P[BASE + 4], P[BASE + 5]), b1 = cvtpk(P[BASE + 6], P[BASE + 7]);                              \
    auto r0 = __builtin_amdgcn_permlane32_swap(a0, b0, false, false); auto r1 = __builtin_amdgcn_permlane32_swap(a1, b1, false, false); \
    u32x4 w = {r0[0], r1[0], r0[1], r1[1]}; OUT = *reinterpret_cast<bf16x8*>(&w); } while (0)
  PK4(p0, 0, pa0); PK4(p0, 8, pa1); PK4(p1, 0, pa2); PK4(p1, 8, pa3);
#undef PK4
}
__device__ __forceinline__ void qkt(f32x16& p0, f32x16& p1, const bf16* Ks, const bf16x8* qr, int r32, int hi) {
  p0 = f32x16{}; p1 = f32x16{};
  for (int d0 = 0; d0 < 8; ++d0) { int cb = (d0 * 16 + hi * 8) * 2;
    bf16x8 b0 = *reinterpret_cast<const bf16x8*>((const char*)Ks + KSWZ(r32, cb));
    bf16x8 b1 = *reinterpret_cast<const bf16x8*>((const char*)Ks + KSWZ(32 + r32, cb));
    p0 = __builtin_amdgcn_mfma_f32_32x32x16_bf16(b0, qr[d0], p0, 0, 0, 0);
    p1 = __builtin_amdgcn_mfma_f32_32x32x16_bf16(b1, qr[d0], p1, 0, 0, 0); }
}
__device__ __forceinline__ int v_st(int k, int c) { const int kk = (k & ~0xC) | ((k & 4) << 1) | ((k & 8) >> 1); return ((kk >> 3) * 4 + (c >> 5)) * 512 + ((kk & 7) * 32 + (c & 31)) * 2; }
__device__ __forceinline__ int v_rd_base(int lane) { return ((lane & 3) << 3) | (((lane >> 2) & 3) << 6) | (((lane >> 4) & 1) << 5) | (((lane >> 5) & 1) << 8); }
constexpr int v_rd_off(int d0, int ks, int half) { return d0 * 512 + ks * 4096 + half * 2048; }
template <int OFF> __device__ __forceinline__ s16x4 tr_read(int vb) {
  s16x4 r; asm volatile("ds_read_b64_tr_b16 %0, %1 offset:%2" : "=&v"(r) : "v"(vb), "i"(OFF) : "memory"); return r;
}
template <int D0> __device__ __forceinline__ void pv_one(f32x16& od, int vb, bf16x8 pa0, bf16x8 pa1, bf16x8 pa2, bf16x8 pa3) {
  const s16x4 l0 = tr_read<v_rd_off(D0, 0, 0)>(vb), h0 = tr_read<v_rd_off(D0, 0, 1)>(vb), l1 = tr_read<v_rd_off(D0, 1, 0)>(vb), h1 = tr_read<v_rd_off(D0, 1, 1)>(vb);
  const s16x4 l2 = tr_read<v_rd_off(D0, 2, 0)>(vb), h2 = tr_read<v_rd_off(D0, 2, 1)>(vb), l3 = tr_read<v_rd_off(D0, 3, 0)>(vb), h3 = tr_read<v_rd_off(D0, 3, 1)>(vb);
  asm volatile("s_waitcnt lgkmcnt(0)" ::: "memory"); SBAR();
#define PK(L, H) (bf16x8){L[0], L[1], L[2], L[3], H[0], H[1], H[2], H[3]}
  od = __builtin_amdgcn_mfma_f32_32x32x16_bf16(pa0, PK(l0, h0), od, 0, 0, 0);
  od = __builtin_amdgcn_mfma_f32_32x32x16_bf16(pa1, PK(l1, h1), od, 0, 0, 0);
  od = __builtin_amdgcn_mfma_f32_32x32x16_bf16(pa2, PK(l2, h2), od, 0, 0, 0);
  od = __builtin_amdgcn_mfma_f32_32x32x16_bf16(pa3, PK(l3, h3), od, 0, 0, 0);
#undef PK
}
__device__ __forceinline__ void pv_d0(f32x16* o, int vb, bf16x8 pa0, bf16x8 pa1, bf16x8 pa2, bf16x8 pa3) {
  pv_one<0>(o[0], vb, pa0, pa1, pa2, pa3); pv_one<1>(o[1], vb, pa0, pa1, pa2, pa3); pv_one<2>(o[2], vb, pa0, pa1, pa2, pa3); pv_one<3>(o[3], vb, pa0, pa1, pa2, pa3);
}

template <typename TQ>
__device__ __forceinline__ void attn_dense_body(const TQ* __restrict__ Qb, const bf16* __restrict__ Kh, const bf16* __restrict__ Vh,
                                                bf16* __restrict__ Ob, int seq, char* lds) {
  using St = Stage<bf16>; using SQ = Stage<TQ>;
  int tid_ = threadIdx.x; asm volatile("" : "+v"(tid_)); const int tid = tid_, wid = tid >> 6, lane = tid & 63, r32 = lane & 31, hi = lane >> 5;
  bf16* V_lds = (bf16*)lds; bf16* K_lds = (bf16*)(lds + 2 * SHM_V);
  float* ws = (float*)(lds + 2 * SHM_V + 2 * SHM_K) + wid * 64; float* li_l = ws; float* al_l = ws + 32;
  float m_reg = -1e30f, l_reg = 0; f32x16 o[4] = {}; bf16x8 qr[8];
  const TQ* Qw = Qb + (long)(wid * QBLK + r32) * LDQ + hi * 8;
#pragma unroll
  for (int d0 = 0; d0 < 8; ++d0) qr[d0] = SQ::tobf(SQ::ld8(Qw + d0 * 16));
  const int sr = tid >> 4, sc = (tid & 15) * 8, vst0 = v_st(sr, sc), vst1 = v_st(32 + sr, sc);
  const int vb0 = (int)(uintptr_t)V_lds + v_rd_base(lane);
  struct { typename St::T vs0, vs1, ks0, ks1; } sr_[SDEPTH];
#define SLOAD(i, k0) do { sr_[i].vs0 = St::ld8(&Vh[(long)((k0) + sr) * LDK + sc]); sr_[i].vs1 = St::ld8(&Vh[(long)((k0) + 32 + sr) * LDK + sc]); \
    sr_[i].ks0 = St::ld8(&Kh[(long)((k0) + sr) * LDK + sc]); sr_[i].ks1 = St::ld8(&Kh[(long)((k0) + 32 + sr) * LDK + sc]); } while (0)
#define SWRITE(b, i) do { *(bf16x8*)((char*)V_lds + (b) * SHM_V + vst0) = St::tobf(sr_[i].vs0);          \
    *(bf16x8*)((char*)V_lds + (b) * SHM_V + vst1) = St::tobf(sr_[i].vs1); int kc = sc * 2;               \
    *(bf16x8*)((char*)K_lds + (b) * SHM_K + KSWZ(sr, kc)) = St::tobf(sr_[i].ks0);                       \
    *(bf16x8*)((char*)K_lds + (b) * SHM_K + KSWZ(32 + sr, kc)) = St::tobf(sr_[i].ks1); } while (0)
#define SWAIT() do { if constexpr (SDEPTH == 2) asm volatile("s_waitcnt vmcnt(4)" ::: "memory"); else asm volatile("s_waitcnt vmcnt(0)" ::: "memory"); } while (0)
#define RESC(a) do { if (__any((a) < 1.f)) { if (hi == 0) al_l[r32] = (a); asm volatile("s_waitcnt lgkmcnt(0)" ::: "memory"); \
    for (int d = 0; d < 4; ++d) for (int r = 0; r < 16; ++r) o[d][r] *= al_l[crow(r, hi)]; } } while (0)
  f32x16 pA0, pA1, pB0, pB1; float mnA, mnB, alA, alB; bf16x8 pa0, pa1, pa2, pa3; const int NT = seq / KVBLK;
  constexpr int SE = 0, SO = SDEPTH - 1;
  SLOAD(SE, 0); asm volatile("s_waitcnt vmcnt(0)" ::: "memory"); SWRITE(0, SE); __syncthreads();
  qkt(pA0, pA1, K_lds, qr, r32, hi); partialSM(pA0, pA1, m_reg, mnA, alA);
  SLOAD(SO, KVBLK); if constexpr (SDEPTH == 2) { if (2 < NT) SLOAD(SE, 2 * KVBLK); }
  SWAIT(); SWRITE(1, SO); __syncthreads();
  for (int j = 1; j + 1 < NT; j += 2) {
    SBAR(); qkt(pB0, pB1, (bf16*)((char*)K_lds + SHM_K), qr, r32, hi);
    finishSM(pA0, pA1, alA, l_reg, pa0, pa1, pa2, pa3); SBAR();
    SLOAD(SO, (j + SDEPTH) * KVBLK); SBAR();
    pv_d0(o, vb0, pa0, pa1, pa2, pa3); partialSM(pB0, pB1, m_reg, mnB, alB);
    __syncthreads(); SWAIT(); SWRITE(0, SE);
    RESC(alB); __syncthreads();
    SBAR(); qkt(pA0, pA1, K_lds, qr, r32, hi);
    finishSM(pB0, pB1, alB, l_reg, pa0, pa1, pa2, pa3); SBAR();
    if (SDEPTH == 1 || j + 3 < NT) SLOAD(SE, (j + 1 + SDEPTH) * KVBLK); SBAR();
    pv_d0(o, vb0 + (int)SHM_V, pa0, pa1, pa2, pa3); partialSM(pA0, pA1, m_reg, mnA, alA);
    __syncthreads(); SWAIT(); SWRITE(1, SO);
    RESC(alA); __syncthreads();
  }
  SBAR(); qkt(pB0, pB1, (bf16*)((char*)K_lds + SHM_K), qr, r32, hi);
  finishSM(pA0, pA1, alA, l_reg, pa0, pa1, pa2, pa3); SBAR();
  pv_d0(o, vb0, pa0, pa1, pa2, pa3); partialSM(pB0, pB1, m_reg, mnB, alB);
  __syncthreads(); RESC(alB);
  finishSM(pB0, pB1, alB, l_reg, pa0, pa1, pa2, pa3); SBAR();
  pv_d0(o, vb0 + (int)SHM_V, pa0, pa1, pa2, pa3);
  if (hi == 0) li_l[r32] = l_reg; asm volatile("s_waitcnt lgkmcnt(0)" ::: "memory");
  float rli[16];
#pragma unroll
  for (int r = 0; r < 16; ++r) rli[r] = __builtin_amdgcn_rcpf(li_l[crow(r, hi)]);
  __syncthreads();
  bf16* Ol = (bf16*)lds + wid * (QBLK * D);
#pragma unroll
  for (int r = 0; r < 16; ++r) { const int orow = crow(r, hi);
#pragma unroll
    for (int d0 = 0; d0 < 4; ++d0) { const float v = o[d0][r] * rli[r]; unsigned u = __float_as_uint(v); u += 0x7FFFu + ((u >> 16) & 1u); Ol[orow * D + d0 * 32 + r32] = (bf16)(u >> 16); } }
  asm volatile("s_waitcnt lgkmcnt(0)" ::: "memory");
#pragma unroll
  for (int i = 0; i < 8; ++i) { const int row = i * 4 + (lane >> 4), ch = (lane & 15) * 8;
    const u32x4 v = *reinterpret_cast<const u32x4*>(Ol + row * D + ch);
    *reinterpret_cast<u32x4*>(Ob + (long)(wid * QBLK + row) * LDO + ch) = v; }
  __syncthreads();
#undef SLOAD
#undef SWRITE
#undef SWAIT
#undef RESC
}

}

__device__ void phase_attn(const Params& p, char* smem) {
  const int G = (int)gridDim.x, c = (int)blockIdx.x;
  for (int i = 0; i * G + c < 1024; ++i) {
    int pair, j;
    if (G == 256) { pair = 2 * (c & 7) + (i >> 1); j = (i & 1) * 32 + (c >> 3); } else { const int L = i * G + c; pair = L >> 6; j = L & 63; }
    const int b = pair >> 1, kv = pair & 1, qb = j >> 2, g = j & 3, h = kv * 4 + g;
    const bf16_t* Qb = p.Qh + (((size_t)b * 8 + h) * S + qb * 256) * 128; const bf16_t* Kp = p.Kh + ((size_t)b * 2 + kv) * S * 128; const bf16_t* Vp = p.Vh + ((size_t)b * 2 + kv) * S * 128;
    bf16_t* Ob = p.CAT + ((size_t)b * S + qb * 256) * 1024 + h * 128;
    att::attn_dense_body<att::bf16>(Qb, Kp, Vp, Ob, S, smem);
  }
}

#define XB_TMO      128
#define XB_XCNT(j)  (256  + 64 * (j))
#define XB_XSUB(j)  (1280 + 64 * (j))
#define XB_XGEN(j)  (2304 + 64 * (j))
#define XB_TOP      3328
#define XB_TOPGEN   3392
#define XCD_BAR_WORDS 3456
#define XB_SPIN_CAP (1u << 18)
#define LAS __attribute__((address_space(3)))

__device__ __forceinline__ unsigned xb_ld(unsigned* p)              { return __hip_atomic_load(p, __ATOMIC_RELAXED, __HIP_MEMORY_SCOPE_AGENT); }
__device__ __forceinline__ unsigned xb_add(unsigned* p, unsigned v) { return __hip_atomic_fetch_add(p, v, __ATOMIC_RELAXED, __HIP_MEMORY_SCOPE_AGENT); }
__device__ __forceinline__ unsigned xb_xcc_id() { return (unsigned)__builtin_amdgcn_s_getreg((3 << 11) | 20) & 0xFu; }
#define XB_SPIN(cond, bar) do { unsigned _sp = 0; while (cond) { __builtin_amdgcn_s_sleep(1); \
    if ((++_sp & 255u) == 0u) { if (xb_ld(&(bar)[XB_TMO])) break; if (_sp > XB_SPIN_CAP) { atomicAdd(&(bar)[XB_TMO], 1u); break; } } } } while (0)

struct XcdBarrier {
    unsigned* bar; unsigned x;
    volatile LAS unsigned* st;
};

__device__ __forceinline__ XcdBarrier xcd_barrier_post(unsigned* bar, volatile LAS unsigned* st) {
    XcdBarrier b; b.bar = bar; b.x = xb_xcc_id(); b.st = st;
    if (threadIdx.x == 0) (void)xb_add(&bar[XB_XCNT(b.x)], 1u);
    return b;
}
__device__ __forceinline__ void xcd_barrier_complete(unsigned* bar, unsigned x, unsigned& nloc, unsigned& nx) {
    const unsigned G = gridDim.x * gridDim.y * gridDim.z;
    unsigned sum, cnt, mine, sp = 0u;
    for (;;) {
        sum = 0u; cnt = 0u; mine = 0u;
#pragma unroll
        for (unsigned j = 0; j < 16; ++j) { const unsigned c = xb_ld(&bar[XB_XCNT(j)]); sum += c; cnt += (c > 0u) ? 1u : 0u; mine = (j == x) ? c : mine; }
        if (sum == G) break;
        __builtin_amdgcn_s_sleep(1);
        if ((++sp & 255u) == 0u) { if (xb_ld(&bar[XB_TMO])) break; if (sp > XB_SPIN_CAP) { atomicAdd(&bar[XB_TMO], 1u); break; } }
    }
    nloc = mine > 0u ? mine : 1u; nx = cnt > 0u ? cnt : 1u;
}

__device__ __forceinline__ void xcd_barrier(const XcdBarrier& b) {
    asm volatile("s_waitcnt vmcnt(0)" ::: "memory");
    __syncthreads();
    if (threadIdx.x == 0) {
        unsigned* bar = b.bar;
        __builtin_amdgcn_s_waitcnt(0);
        unsigned nloc = b.st[0], nx = b.st[1];
        if (nloc == 0u) { xcd_barrier_complete(bar, b.x, nloc, nx); b.st[0] = nloc; b.st[1] = nx; }
        const unsigned old = xb_add(&bar[XB_XSUB(b.x)], 1u);
        const unsigned gen = old / nloc;
        if (old + 1u == (gen + 1u) * nloc) {
            __builtin_amdgcn_fence(__ATOMIC_RELEASE, "agent");
            asm volatile("s_waitcnt vmcnt(0)" ::: "memory");
            const unsigned og = xb_add(&bar[XB_TOP], 1u);
            const unsigned tg = og / nx;
            if (og + 1u == (tg + 1u) * nx) xb_add(&bar[XB_TOPGEN], 1u);
            else XB_SPIN(xb_ld(&bar[XB_TOPGEN]) == tg, bar);
            __builtin_amdgcn_fence(__ATOMIC_ACQUIRE, "agent");
            xb_add(&bar[XB_XGEN(b.x)], 1u);
            asm volatile("s_waitcnt vmcnt(0)" ::: "memory");
        } else {
            XB_SPIN(xb_ld(&bar[XB_XGEN(b.x)]) == gen, bar);
            __builtin_amdgcn_fence(__ATOMIC_ACQUIRE, "agent");
            asm volatile("s_waitcnt vmcnt(0)" ::: "memory");
        }
    }
    __syncthreads();
}


constexpr int NPH = 19;
__global__ __launch_bounds__(NTHREADS, 2) void mega(Params p, int ph0, int ph1) {
  extern __shared__ __attribute__((aligned(16))) char smem[];
  cg::grid_group grid = cg::this_grid();
  volatile LAS unsigned* xst = (volatile LAS unsigned*)(LAS char*)(smem + SMEM_BYTES - 16);
  if (threadIdx.x == 0) { xst[0] = 0u; xst[1] = 0u; }
  __syncthreads();
  const XcdBarrier xb = xcd_barrier_post(p.bar, xst);
#ifndef REP_MASK
#define REP_MASK 0
#endif
#define GSYNC(k) do { if ((k) == 1) grid.sync(); else xcd_barrier(xb); } while (0)
#define PHASE(k, call) if (ph0 <= (k) && (k) < ph1) { if ((k) > ph0) GSYNC(k); if ((REP_MASK >> (k)) & 1) { { call; } xcd_barrier(xb); } call; }
#if !defined(ONLY_PHASE) || ONLY_PHASE == 0
  PHASE(0, phase_prep(p, smem))
#endif
#if !defined(ONLY_PHASE) || ONLY_PHASE == 1
  PHASE(1, phase_norm<true>(p, p.x, p.nmg, p.mod, 0, 1024, smem))
#endif
#if !defined(ONLY_PHASE) || ONLY_PHASE == 2
  PHASE(2, phase_gemm_fast(p.H, p.Wt_evin, T, 2560, 1024, (EpiEvin{p.ZQK, p.ZV, p.ZO, p.ZP, p.ev_b_in}), smem))
#endif
#if !defined(ONLY_PHASE) || ONLY_PHASE == 3
  PHASE(3, cp::phase_convpool(p, smem))
#endif
#if !defined(ONLY_PHASE) || ONLY_PHASE == 4
  PHASE(4, ml::phase_mlstm(p, smem))
#endif
#if !defined(ONLY_PHASE) || ONLY_PHASE == 5
  PHASE(5, phase_cat(p))
#endif
#if !defined(ONLY_PHASE) || ONLY_PHASE == 6
  PHASE(6, phase_gemm_fast(p.CAT, p.Wt_evout, T, 1024, 1024, (EpiRes{p.x, p.X, p.mod + 2048}), smem))
#endif
#if !defined(ONLY_PHASE) || ONLY_PHASE == 7
  PHASE(7, phase_norm<false>(p, p.X, p.nfg, p.mod, 3072, 4096, smem))
#endif
#if !defined(ONLY_PHASE) || ONLY_PHASE == 8
  PHASE(8, phase_gemm_fast(p.H, p.Wt_q, T, 2048, 1024, (EpiPlain{p.QP, 2048}), smem))
#endif
#if !defined(ONLY_PHASE) || ONLY_PHASE == 9
  PHASE(9, sel::phase_peer_select(p, 0, smem))
#endif
#if !defined(ONLY_PHASE) || ONLY_PHASE == 10
  PHASE(10, phase_peer_gather<0>(p, 0, smem))
#endif
#if !defined(ONLY_PHASE) || ONLY_PHASE == 11
  PHASE(11, phase_gemm_fast(p.H, p.Wt_odin, T, 1536, 1024, (EpiPlain{p.QKV, 1536}), smem))
#endif
#if !defined(ONLY_PHASE) || ONLY_PHASE == 12
  PHASE(12, phase_qkrope(p, smem))
#endif
#if !defined(ONLY_PHASE) || ONLY_PHASE == 13
  PHASE(13, phase_attn(p, smem))
#endif
#if !defined(ONLY_PHASE) || ONLY_PHASE == 14
  PHASE(14, phase_gemm_fast(p.CAT, p.Wt_odout, T, 1024, 1024, (EpiRes{p.X, p.X, p.mod + (size_t)8 * 6144 + 2048}), smem))
#endif
#if !defined(ONLY_PHASE) || ONLY_PHASE == 15
  PHASE(15, phase_norm<false>(p, p.X, p.nfg + D, p.mod + (size_t)8 * 6144, 3072, 4096, smem))
#endif
#if !defined(ONLY_PHASE) || ONLY_PHASE == 16
  PHASE(16, phase_gemm_fast(p.H, p.Wt_q + (size_t)2048 * 1024, T, 2048, 1024, (EpiPlain{p.QP, 2048}), smem))
#endif
#if !defined(ONLY_PHASE) || ONLY_PHASE == 17
  PHASE(17, sel::phase_peer_select(p, 1, smem))
#endif
#if !defined(ONLY_PHASE) || ONLY_PHASE == 18
  PHASE(18, phase_peer_gather<1>(p, 1, smem))
#endif
#undef PHASE
}
}

extern "C" void kernel_launch(void* const* d_in, const int* in_sizes, int n_in, void* d_out, int out_size, void* d_ws, size_t ws_size, hipStream_t stream) {
  (void)in_sizes; (void)n_in; (void)out_size;
  Params p{};
  const float** fin = (const float**)&p;
  for (int i = 0; i < 23; ++i) fin[i] = (const float*)d_in[i];
  p.X = (float*)d_out;
  char* ws = (char*)d_ws; size_t off = 0;
  auto alloc = [&](size_t bytes) { char* q = ws + off; off += (bytes + 255) / 256 * 256; return q; };
  p.U8 = (unsigned char*)alloc((size_t)2 * 16384 * 1024); p.V8 = (unsigned char*)alloc((size_t)2 * 16384 * 1024);
  p.Wt_evin = (bf16_t*)alloc((size_t)2560 * 1024 * 2); p.Wt_evout = (bf16_t*)alloc((size_t)1024 * 1024 * 2); p.Wt_odin = (bf16_t*)alloc((size_t)1536 * 1024 * 2);
  p.Wt_odout = (bf16_t*)alloc((size_t)1024 * 1024 * 2); p.Wt_q = (bf16_t*)alloc((size_t)2 * 2048 * 1024 * 2); p.keysb = (bf16_t*)alloc((size_t)2 * 2 * 128 * 128 * 2); p.poolWt = (bf16_t*)alloc((size_t)4 * 128 * 128 * 2);
  p.Wg = (float*)alloc(16 * 1024 * 4); p.mod = (float*)alloc(2 * 8 * 6144 * 4); p.gates = (float*)alloc((size_t)T * 16 * 4);
  p.pgate = (float*)alloc((size_t)T * 128 * 4); p.pidx = (bf16_t*)alloc((size_t)T * 128 * 2);
  p.H = (bf16_t*)alloc((size_t)T * 1024 * 2); p.CAT = p.H;
  char* big = alloc((size_t)T * 2048 * 2);
  p.ZQK = (bf16_t*)big; p.ZV = (bf16_t*)(big + (size_t)T * 1024 * 2); p.ZO = (bf16_t*)(big + (size_t)T * 1536 * 2); p.HS = (bf16_t*)big; p.QP = (bf16_t*)big; p.QKV = (bf16_t*)big;
  char* big2 = alloc((size_t)T * 1536 * 2);
  p.QK = (bf16_t*)big2; p.ZP = (bf16_t*)(big2 + (size_t)T * 1024 * 2); p.Qh = (bf16_t*)big2; p.Kh = (bf16_t*)(big2 + (size_t)T * 1024 * 2); p.Vh = (bf16_t*)(big2 + (size_t)T * 1280 * 2);
  p.bar = (unsigned*)alloc(XCD_BAR_WORDS * 4);
  if (off > ws_size) { fprintf(stderr, "kernel_launch: workspace too small: need %zu have %zu\n", off, ws_size); return; }

  static int grid_blocks = 0;
  if (!grid_blocks) {
    int dev = 0, cus = 0, per_cu = 0; hipGetDevice(&dev); hipDeviceGetAttribute(&cus, hipDeviceAttributeMultiprocessorCount, dev);
    hipFuncSetAttribute((const void*)mega, hipFuncAttributeMaxDynamicSharedMemorySize, SMEM_BYTES);
    hipOccupancyMaxActiveBlocksPerMultiprocessor(&per_cu, mega, NTHREADS, SMEM_BYTES);
    if (per_cu > 1) per_cu = 1;
    grid_blocks = cus * per_cu;
    if (grid_blocks <= 0) { fprintf(stderr, "kernel_launch: occupancy query returned 0\n"); grid_blocks = 0; return; }
  }
  hipMemsetAsync(p.bar, 0, XCD_BAR_WORDS * 4, stream);
#if MULTI_LAUNCH
  for (int ph = 0; ph < NPH; ++ph) hipLaunchKernelGGL(mega, dim3(grid_blocks), dim3(NTHREADS), SMEM_BYTES, stream, p, ph, ph + 1);
#else
  int ph0 = 0, ph1 = NPH; void* args[] = {&p, &ph0, &ph1};
  hipError_t e = hipLaunchCooperativeKernel((const void*)mega, dim3(grid_blocks), dim3(NTHREADS), args, SMEM_BYTES, stream);
  if (e != hipSuccess) fprintf(stderr, "cooperative launch failed: %s (grid %d)\n", hipGetErrorString(e), grid_blocks);
#endif
}
```

```cpp
#include <hip/hip_runtime.h>
#include <hip/hip_cooperative_groups.h>
#include <math.h>
#include <stdint.h>
#include <stdio.h>
namespace cg = cooperative_groups;

#ifndef MULTI_LAUNCH
#define MULTI_LAUNCH 0
#endif

namespace {
typedef unsigned short bf16_t;
typedef unsigned int u32;
typedef float f32x4 __attribute__((ext_vector_type(4)));
typedef u32 u32x4 __attribute__((ext_vector_type(4)));
typedef u32 u32x2 __attribute__((ext_vector_type(2)));
typedef __bf16 bf16x2_t __attribute__((ext_vector_type(2)));

constexpr int D = 1024, NB = 8, S = 4096, T = NB * S;
constexpr int EVEN_IN = 2576;
constexpr float EPS = 1e-6f;
constexpr int NTHREADS = 512;
constexpr int SMEM_BYTES = 144 * 1024;
constexpr float KSCALE = 0.08838834764831845f;

struct Params {
  const float *x, *c, *ada_w, *ada_b, *nmg, *nfg, *ev_w_in, *ev_b_in, *conv_w, *conv_b, *mnorm_g, *pool_w, *pool_sc, *ev_w_out, *od_w_in, *qn_g, *kn_g, *od_w_out,
      *peer_wq, *peer_keys, *peer_u, *peer_v, *final_g;
  float* X;
  bf16_t *Wt_evin, *Wt_evout, *Wt_odin, *Wt_odout, *Wt_q, *keysb, *poolWt; unsigned char *U8, *V8;
  float *Wg, *mod, *gates, *pgate;
  bf16_t *H, *ZQK, *ZV, *ZO, *ZP, *QK, *HS, *CAT, *QP, *QKV, *Qh, *Kh, *Vh;
  bf16_t* pidx;
  unsigned* bar;
};

__device__ __forceinline__ float siluf(float x) { return x / (1.f + __expf(-x)); }
__device__ __forceinline__ float sigmf(float x) { return 1.f / (1.f + __expf(-x)); }
__device__ __forceinline__ float wave_sum(float v) { for (int o = 32; o >= 1; o >>= 1) v += __shfl_xor(v, o); return v; }
__device__ __forceinline__ float wave_max(float v) { for (int o = 32; o >= 1; o >>= 1) v = fmaxf(v, __shfl_xor(v, o)); return v; }
__device__ __forceinline__ bf16_t f2bf(float f) { u32 u = __float_as_uint(f); u += 0x7FFFu + ((u >> 16) & 1u); return (bf16_t)(u >> 16); }
__device__ __forceinline__ float bf2f(bf16_t b) { return __uint_as_float(((u32)b) << 16); }
__device__ __forceinline__ u32 pack2(float lo, float hi) { return (u32)f2bf(lo) | ((u32)f2bf(hi) << 16); }
__device__ __forceinline__ float bflo(u32 w) { return __uint_as_float(w << 16); }
__device__ __forceinline__ float bfhi(u32 w) { return __uint_as_float(w & 0xFFFF0000u); }
__device__ __forceinline__ float dot2bf(u32 a, u32 b, float c) { return __builtin_amdgcn_fdot2_f32_bf16(__builtin_bit_cast(bf16x2_t, a), __builtin_bit_cast(bf16x2_t, b), c, false); }

constexpr int PJ_MOD = 192, PJ_TR = 2576, PJ_WG = 1, PJ_KEYS = 16, PJ_UV = 8192;
constexpr int PJ_TOTAL = PJ_MOD + PJ_TR + PJ_WG + PJ_KEYS + PJ_UV;

__device__ void prep_transpose_tile(const float* __restrict__ src, int ld, int k0, int n0, bf16_t* __restrict__ dst, int dstK, char* smem) {
  float* tile = (float*)smem;
  const int tid = threadIdx.x;
  __syncthreads();
  for (int pass = 0; pass < 8; ++pass) { int kk = pass * 8 + (tid >> 6), n = tid & 63; tile[kk * 65 + n] = src[(size_t)(k0 + kk) * ld + n0 + n]; }
  __syncthreads();
  int n = tid >> 3, kc = (tid & 7) * 8; u32x4 w;
  w.x = pack2(tile[(kc + 0) * 65 + n], tile[(kc + 1) * 65 + n]); w.y = pack2(tile[(kc + 2) * 65 + n], tile[(kc + 3) * 65 + n]);
  w.z = pack2(tile[(kc + 4) * 65 + n], tile[(kc + 5) * 65 + n]); w.w = pack2(tile[(kc + 6) * 65 + n], tile[(kc + 7) * 65 + n]);
  *(u32x4*)(dst + (size_t)(n0 + n) * dstK + k0 + kc) = w;
}

__device__ void phase_prep(const Params& p, char* smem) {
  const int tid = threadIdx.x;
  for (int job = blockIdx.x; job < PJ_TOTAL; job += gridDim.x) {
    if (job < PJ_MOD) {
      float* cs = (float*)smem; float* red = cs + 8192;
      __syncthreads();
      for (int i = tid; i < 8192; i += NTHREADS) cs[i] = siluf(p.c[i]);
      __syncthreads();
      const int l = job / 96, e0 = (job % 96) * 64, col = tid & 63, dg = tid >> 6;
      float acc[8];
#pragma unroll
      for (int b = 0; b < 8; ++b) acc[b] = 0.f;
      const float* w = p.ada_w + (size_t)l * D * 6144 + e0 + col;
      for (int d = dg * 128; d < dg * 128 + 128; ++d) { float wv = w[(size_t)d * 6144];
#pragma unroll
        for (int b = 0; b < 8; ++b) acc[b] += cs[b * 1024 + d] * wv; }
#pragma unroll
      for (int b = 0; b < 8; ++b) red[(dg * 8 + b) * 64 + col] = acc[b];
      __syncthreads();
      { const int b = tid >> 6; float s = 0.f;
#pragma unroll
        for (int g = 0; g < 8; ++g) s += red[(g * 8 + b) * 64 + col];
        p.mod[(size_t)(l * 8 + b) * 6144 + e0 + col] = s + p.ada_b[l * 6144 + e0 + col]; }
    } else if (job < PJ_MOD + PJ_TR) {
      int tt = job - PJ_MOD;
      if (tt < 640) prep_transpose_tile(p.ev_w_in, EVEN_IN, (tt / 40) * 64, (tt % 40) * 64, p.Wt_evin, 1024, smem);
      else if (tt < 896) { tt -= 640; prep_transpose_tile(p.ev_w_out, 1024, (tt / 16) * 64, (tt % 16) * 64, p.Wt_evout, 1024, smem); }
      else if (tt < 1280) { tt -= 896; prep_transpose_tile(p.od_w_in, 1536, (tt / 24) * 64, (tt % 24) * 64, p.Wt_odin, 1024, smem); }
      else if (tt < 1536) { tt -= 1280; prep_transpose_tile(p.od_w_out, 1024, (tt / 16) * 64, (tt % 16) * 64, p.Wt_odout, 1024, smem); }
      else if (tt < 2560) { tt -= 1536; int l = tt / 512; tt %= 512; prep_transpose_tile(p.peer_wq + (size_t)l * D * 2048, 2048, (tt / 32) * 64, (tt % 32) * 64, p.Wt_q + (size_t)l * 2048 * 1024, 1024, smem); }
      else { tt -= 2560; const int g = tt >> 2; prep_transpose_tile(p.pool_w + (size_t)g * 16384, 128, ((tt >> 1) & 1) * 64, (tt & 1) * 64, p.poolWt + (size_t)g * 16384, 128, smem); }
    } else if (job < PJ_MOD + PJ_TR + PJ_WG) {
      for (int i = tid; i < 16 * 1024; i += NTHREADS) { int g = i >> 10, d = i & 1023; p.Wg[i] = p.ev_w_in[(size_t)d * EVEN_IN + 2560 + g]; }
    } else if (job < PJ_MOD + PJ_TR + PJ_WG + PJ_KEYS) {
      int j = job - (PJ_MOD + PJ_TR + PJ_WG);
      for (int i = tid; i < 4096; i += NTHREADS) p.keysb[j * 4096 + i] = f2bf(p.peer_keys[j * 4096 + i]);
    } else {
      int j = job - (PJ_MOD + PJ_TR + PJ_WG + PJ_KEYS); const bool isu = j < 4096; const float* src = isu ? p.peer_u : p.peer_v; unsigned char* dst = isu ? p.U8 : p.V8; j &= 4095; const float sc = isu ? 32.f : 2.f;
      const size_t o = (size_t)j * 8192 + tid * 16; u32x4 w; u32 ww[4];
#pragma unroll
      for (int q = 0; q < 4; ++q) { const f32x4 a = *(const f32x4*)(src + o + 4 * q); int pk = __builtin_amdgcn_cvt_pk_fp8_f32(a.x * sc, a.y * sc, 0, false); pk = __builtin_amdgcn_cvt_pk_fp8_f32(a.z * sc, a.w * sc, pk, true); ww[q] = (u32)pk; }
      w.x = ww[0]; w.y = ww[1]; w.z = ww[2]; w.w = ww[3]; *(u32x4*)(dst + o) = w;
    }
  }
}

enum { EPI_EVIN = 0, EPI_EVOUT = 1, EPI_PEERQ = 2, EPI_ODIN = 3, EPI_ODOUT = 4 };
template <int EPI> __device__ __forceinline__ void epi_store(const Params& p, int layer, int m, int n, float acc) {
  if (EPI == EPI_EVIN) { float v = acc + p.ev_b_in[n];
    if (n < 1024) p.ZQK[(size_t)m * 1024 + n] = f2bf(v); else if (n < 1536) p.ZV[(size_t)m * 512 + n - 1024] = f2bf(v);
    else if (n < 2048) p.ZO[(size_t)m * 512 + n - 1536] = f2bf(sigmf(v)); else p.ZP[(size_t)m * 512 + n - 2048] = f2bf(v); }
  else if (EPI == EPI_EVOUT) { int b = m / S; p.X[(size_t)m * D + n] = p.x[(size_t)m * D + n] + p.mod[(size_t)(0 * 8 + b) * 6144 + 2048 + n] * acc; }
  else if (EPI == EPI_PEERQ) p.QP[(size_t)m * 2048 + n] = f2bf(acc);
  else if (EPI == EPI_ODIN) p.QKV[(size_t)m * 1536 + n] = f2bf(acc);
  else if (EPI == EPI_ODOUT) { int b = m / S; p.X[(size_t)m * D + n] += p.mod[(size_t)(1 * 8 + b) * 6144 + 2048 + n] * acc; }
}
template <int EPI> __device__ void phase_gemm_naive(const Params& p, int layer, const bf16_t* __restrict__ A, const bf16_t* __restrict__ Bt, int M, int N, int K, char* smem) {
  float* As = (float*)smem; float* Bs = As + 32 * 132;
  const int tid = threadIdx.x, tx = tid & 15, ty = tid >> 4; const int nN = N / 64, njobs = (M / 128) * nN;
  for (int job = blockIdx.x; job < njobs; job += gridDim.x) {
    const int m0 = (job / nN) * 128, n0 = (job % nN) * 64; float acc[4][4];
#pragma unroll
    for (int i = 0; i < 4; ++i)
#pragma unroll
      for (int j = 0; j < 4; ++j) acc[i][j] = 0.f;
    for (int k0 = 0; k0 < K; k0 += 32) {
      __syncthreads();
      { int row = tid >> 2, kc = (tid & 3) * 8; u32x4 w = *(const u32x4*)(A + (size_t)(m0 + row) * K + k0 + kc);
        As[(kc + 0) * 132 + row] = bflo(w.x); As[(kc + 1) * 132 + row] = bfhi(w.x); As[(kc + 2) * 132 + row] = bflo(w.y); As[(kc + 3) * 132 + row] = bfhi(w.y);
        As[(kc + 4) * 132 + row] = bflo(w.z); As[(kc + 5) * 132 + row] = bfhi(w.z); As[(kc + 6) * 132 + row] = bflo(w.w); As[(kc + 7) * 132 + row] = bfhi(w.w); }
      if (tid < 256) { int row = tid >> 2, kc = (tid & 3) * 8; u32x4 w = *(const u32x4*)(Bt + (size_t)(n0 + row) * K + k0 + kc);
        Bs[(kc + 0) * 68 + row] = bflo(w.x); Bs[(kc + 1) * 68 + row] = bfhi(w.x); Bs[(kc + 2) * 68 + row] = bflo(w.y); Bs[(kc + 3) * 68 + row] = bfhi(w.y);
        Bs[(kc + 4) * 68 + row] = bflo(w.z); Bs[(kc + 5) * 68 + row] = bfhi(w.z); Bs[(kc + 6) * 68 + row] = bflo(w.w); Bs[(kc + 7) * 68 + row] = bfhi(w.w); }
      __syncthreads();
#pragma unroll 8
      for (int kk = 0; kk < 32; ++kk) { f32x4 a = *(const f32x4*)(As + kk * 132 + ty * 4), b = *(const f32x4*)(Bs + kk * 68 + tx * 4);
        acc[0][0] += a.x * b.x; acc[0][1] += a.x * b.y; acc[0][2] += a.x * b.z; acc[0][3] += a.x * b.w;
        acc[1][0] += a.y * b.x; acc[1][1] += a.y * b.y; acc[1][2] += a.y * b.z; acc[1][3] += a.y * b.w;
        acc[2][0] += a.z * b.x; acc[2][1] += a.z * b.y; acc[2][2] += a.z * b.z; acc[2][3] += a.z * b.w;
        acc[3][0] += a.w * b.x; acc[3][1] += a.w * b.y; acc[3][2] += a.w * b.z; acc[3][3] += a.w * b.w; }
    }
#pragma unroll
    for (int i = 0; i < 4; ++i)
#pragma unroll
      for (int j = 0; j < 4; ++j) epi_store<EPI>(p, layer, m0 + ty * 4 + i, n0 + tx * 4 + j, acc[i][j]);
  }
}

namespace pg8 {
#define PG8_LAS __attribute__((address_space(3)))
typedef unsigned short bf16_t;
typedef short bf16x8 __attribute__((ext_vector_type(8)));
typedef float f32x4 __attribute__((ext_vector_type(4)));
typedef unsigned u32x4 __attribute__((ext_vector_type(4)));
constexpr int BM = 256, BK = 64, HALF = 128, HTB = HALF * BK * 2  , STAGE_BYTES = 8 * HTB, NXCD = 8, WGM = 8;

__host__ __device__ __forceinline__ int lds_byte(int r, int c) { const int st = (r >> 4) * 2 + (c >> 5), rr = r & 15, cc = c & 31, ob = rr * 64 + cc * 2; return st * 1024 + (ob ^ (((ob >> 9) & 1) << 5)); }
__host__ __device__ __forceinline__ void stage_rc(int b, int& R, int& C) { const int st = b / 1024, sb = b % 1024, swz = sb ^ (((sb >> 9) & 1) << 5); R = (st >> 1) * 16 + swz / 64; C = (st & 1) * 32 + (swz % 64) / 2; }
__host__ __device__ __forceinline__ int perm32(int rho) { const int n = rho >> 4, i = rho & 15; return 8 * (i >> 2) + 4 * n + (i & 3); }

struct Unit { int pm, pn; };
struct Gemm { const bf16_t* A; const bf16_t* Bt; int M, N, K; };

struct StaticOrder {
    int nM, nN, nwg, G, c;
    __host__ __device__ void init(int M, int N, int G_, int c_) { nM = M / BM; nN = N / BM; nwg = nM * nN; G = G_; c = c_; }
    __host__ __device__ bool next(int i, Unit& u) const {
        const long L = (long)i * G + c; if (L >= nwg) return false;
        int wgid = (int)L; { const int q = nwg / NXCD, r = nwg % NXCD, xcd = wgid % NXCD, off = wgid / NXCD; wgid = (xcd < r ? xcd * (q + 1) : r * (q + 1) + (xcd - r) * q) + off; }
        const int nig = WGM * nN, gid = wgid / nig, fm = gid * WGM, gsz = (nM - fm) < WGM ? (nM - fm) : WGM;
        u.pm = fm + ((wgid % nig) % gsz); u.pn = (wgid % nig) / gsz; return true;
    }
    __device__ __forceinline__ void a_ready(const Unit&) const {}
    __device__ __forceinline__ void done(const Unit&) const {}
};
__device__ __forceinline__ unsigned cvt_pk_bf16(float lo, float hi) { unsigned r; asm volatile("v_cvt_pk_bf16_f32 %0, %1, %2" : "=v"(r) : "v"(lo), "v"(hi)); return r; }
template <class Epi, class Sched, bool STAMP = false>
__device__ __forceinline__ void gemm_phase(PG8_LAS unsigned char* lds, const Gemm g, const Sched& S, const Epi& E, unsigned long long* stamps) {
    const int tid = threadIdx.x, wid = __builtin_amdgcn_readfirstlane(tid >> 6), lane = tid & 63, wr = wid >> 2, wc = wid & 3, fr = lane & 15, fq = lane >> 4;
    const int K = g.K, nt = K / BK;
    int ts_lo = 0, ts_hi = 0, nts = 0; const unsigned long long rt_entry = STAMP ? (unsigned long long)wall_clock64() : 0ull;
#define PG8_STAMP() do { if (STAMP && wid == 0 && nts < 64) { const unsigned long long _c = (unsigned long long)clock64(); \
        ts_lo = (lane == nts) ? (int)(unsigned)_c : ts_lo; ts_hi = (lane == nts) ? (int)(unsigned)(_c >> 32) : ts_hi; ++nts; } } while (0)
    PG8_STAMP();
    unsigned voffA[2], voffB[2];
#pragma unroll
    for (int i = 0; i < 2; ++i) { int R, C; stage_rc(tid * 16 + i * 8192, R, C); const int Rb = Epi::PERM ? ((R & ~31) + perm32(R & 31)) : R;
        voffA[i] = (unsigned)(R * K + C) * 2u; voffB[i] = (unsigned)(Rb * K + C) * 2u; }
    const size_t kstep = (size_t)(BK * 2);
    const size_t hstep = (size_t)HALF * K * 2;
    const size_t tstep = 2 * hstep;
    const unsigned ldsw = (unsigned)wid * 1024u;
    const int aoff = lds_byte(wr * 64 + fr, fq * 8), boff = lds_byte(wc * 32 + fr, fq * 8);
#define PG8_SA(b, h) (((b) * 2 + (h)) * HTB)
#define PG8_SB(b, h) ((4 + (b) * 2 + (h)) * HTB)
#define PG8_STAGE(bufoff, gbase, voff) do { _Pragma("unroll") for (int _i = 0; _i < 2; ++_i) \
        __builtin_amdgcn_global_load_lds((const unsigned*)((const char*)(gbase) + (voff)[_i]), (PG8_LAS unsigned*)(lds + (bufoff) + ldsw + _i * 8192), 16, 0, 0); } while (0)
#define PG8_LDA(dst, b, h) do { _Pragma("unroll") for (int m = 0; m < 4; ++m) _Pragma("unroll") for (int k = 0; k < 2; ++k) dst[m][k] = *(const PG8_LAS bf16x8*)(lds + PG8_SA(b, h) + aoff + m * 2048 + k * 1024); } while (0)
#define PG8_LDB(dst, b, h) do { _Pragma("unroll") for (int n = 0; n < 2; ++n) _Pragma("unroll") for (int k = 0; k < 2; ++k) dst[n][k] = *(const PG8_LAS bf16x8*)(lds + PG8_SB(b, h) + boff + n * 2048 + k * 1024); } while (0)
#define PG8_MMA(ai, bj, At, Bt) do { __builtin_amdgcn_s_setprio(1); _Pragma("unroll") for (int m = 0; m < 4; ++m) _Pragma("unroll") for (int n = 0; n < 2; ++n) _Pragma("unroll") for (int k = 0; k < 2; ++k) \
        acc[ai][bj][m][n] = __builtin_amdgcn_mfma_f32_16x16x32_bf16(Bt[n][k], At[m][k], acc[ai][bj][m][n], 0, 0, 0); __builtin_amdgcn_s_setprio(0); } while (0)
#define PG8_WAIT_V(n) asm volatile("s_waitcnt vmcnt(" #n ")" ::: "memory")
#define PG8_WAIT_L(n) asm volatile("s_waitcnt lgkmcnt(" #n ")" ::: "memory")
#define PG8_BAR __builtin_amdgcn_s_barrier()
#define PG8_SCHED __builtin_amdgcn_sched_barrier(0)
    Unit cur, nxt; int ui = 0;
    if (!S.next(0, cur)) return;
    f32x4 acc[2][2][4][2];
#pragma unroll
    for (int a = 0; a < 2; ++a)
#pragma unroll
        for (int b = 0; b < 2; ++b)
#pragma unroll
            for (int m = 0; m < 4; ++m)
#pragma unroll
                for (int n = 0; n < 2; ++n) acc[a][b][m][n] = (f32x4){0.f, 0.f, 0.f, 0.f};
    bf16x8 At[4][2], B0[2][2], B1[2][2];
    const char* cA = (const char*)g.A + (size_t)cur.pm * tstep; const char* cB = (const char*)g.Bt + (size_t)cur.pn * tstep;
    S.a_ready(cur);
    PG8_STAGE(PG8_SB(0, 0), cB, voffB); PG8_STAGE(PG8_SA(0, 0), cA, voffA); PG8_STAGE(PG8_SB(0, 1), cB + hstep, voffB); PG8_STAGE(PG8_SA(0, 1), cA + hstep, voffA);
    if (wr == 1) PG8_BAR;
    PG8_WAIT_V(4); PG8_BAR;
    PG8_STAGE(PG8_SB(1, 0), cB + kstep, voffB); PG8_STAGE(PG8_SA(1, 0), cA + kstep, voffA); PG8_STAGE(PG8_SB(1, 1), cB + hstep + kstep, voffB);
    PG8_WAIT_V(6); PG8_BAR;
    PG8_STAMP();
    for (;;) {
        const bool has_next = S.next(ui + 1, nxt);
        const char* nA = has_next ? (const char*)g.A + (size_t)nxt.pm * tstep : cA; const char* nB = has_next ? (const char*)g.Bt + (size_t)nxt.pn * tstep : cB;
        for (int t = 0; t < nt; t += 2) {
            const bool last = (t == nt - 2);
            const char* a1 = cA + (size_t)(t + 1) * kstep;
            const char* a2 = last ? nA : cA + (size_t)(t + 2) * kstep; const char* b2 = last ? nB : cB + (size_t)(t + 2) * kstep;
            const char* a3 = a2 + kstep; const char* b3 = b2 + kstep;
            if (last && has_next) S.a_ready(nxt);
            PG8_LDB(B0, 0, 0); PG8_SCHED; PG8_LDA(At, 0, 0); PG8_STAGE(PG8_SA(1, 1), a1 + hstep, voffA);
            PG8_WAIT_L(8); PG8_BAR; PG8_WAIT_L(0); PG8_MMA(0, 0, At, B0); PG8_BAR; PG8_SCHED;
            PG8_LDB(B1, 0, 1); PG8_STAGE(PG8_SB(0, 0), b2, voffB);
            PG8_BAR; PG8_WAIT_L(0); PG8_MMA(0, 1, At, B1); PG8_BAR;
            PG8_LDA(At, 0, 1); PG8_STAGE(PG8_SA(0, 0), a2, voffA);
            PG8_BAR; PG8_WAIT_L(0); PG8_MMA(1, 0, At, B0); PG8_BAR; PG8_SCHED;
            PG8_STAGE(PG8_SB(0, 1), b2 + hstep, voffB);
            PG8_WAIT_V(6); PG8_BAR; PG8_MMA(1, 1, At, B1); PG8_BAR;
            PG8_LDB(B0, 1, 0); PG8_SCHED; PG8_LDA(At, 1, 0); PG8_STAGE(PG8_SA(0, 1), a2 + hstep, voffA);
            PG8_WAIT_L(8); PG8_BAR; PG8_WAIT_L(0); PG8_MMA(0, 0, At, B0); PG8_BAR; PG8_SCHED;
            PG8_LDB(B1, 1, 1); PG8_STAGE(PG8_SB(1, 0), b3, voffB);
            PG8_BAR; PG8_WAIT_L(0); PG8_MMA(0, 1, At, B1); PG8_BAR;
            PG8_LDA(At, 1, 1); PG8_STAGE(PG8_SA(1, 0), a3, voffA);
            PG8_BAR; PG8_WAIT_L(0); PG8_MMA(1, 0, At, B0); PG8_BAR; PG8_SCHED;
            PG8_STAGE(PG8_SB(1, 1), b3 + hstep, voffB);
            PG8_WAIT_V(6); PG8_BAR; PG8_MMA(1, 1, At, B1); PG8_BAR;
        }
        PG8_STAMP();
        if constexpr (!Epi::AFTER_DRAIN) { E(acc, cur, wr, wc, fr, fq); S.done(cur); }
        PG8_STAMP();
        if (!has_next) break;
#pragma unroll
        for (int a = 0; a < 2; ++a)
#pragma unroll
            for (int b = 0; b < 2; ++b)
#pragma unroll
                for (int m = 0; m < 4; ++m)
#pragma unroll
                    for (int n = 0; n < 2; ++n) acc[a][b][m][n] = (f32x4){0.f, 0.f, 0.f, 0.f};
        cur = nxt; cA = nA; cB = nB; ++ui;
    }
    PG8_WAIT_V(0);
    if (wr == 0) PG8_BAR;
    PG8_BAR;
    if constexpr (Epi::AFTER_DRAIN) { E.fused(acc, cur, wr, wc, fr, fq, lds, wid, lane); S.done(cur); }
    PG8_STAMP();
    if (STAMP && wid == 0) { stamps[lane] = lane < nts ? (((unsigned long long)(unsigned)ts_hi << 32) | (unsigned)ts_lo) : 0ull;
        if (lane == 62) stamps[62] = rt_entry; if (lane == 63) stamps[63] = (unsigned long long)wall_clock64(); }
#undef PG8_STAMP
#undef PG8_SA
#undef PG8_SB
#undef PG8_STAGE
#undef PG8_LDA
#undef PG8_LDB
#undef PG8_MMA
#undef PG8_WAIT_V
#undef PG8_WAIT_L
#undef PG8_BAR
#undef PG8_SCHED
}
}

struct EpiEvin {
  static constexpr bool PERM = true, AFTER_DRAIN = false;
  bf16_t *ZQK, *ZV, *ZO, *ZP; const float* bias;
  __device__ __forceinline__ void operator()(const pg8::f32x4 (&acc)[2][2][4][2], const pg8::Unit& u, int wr, int wc, int fr, int fq) const {
    const int row0 = u.pm * 256 + wr * 64 + fr, ct = u.pn * 256;
    bf16_t* base; int ldc, cl; bool sig = false;
    if (ct < 1024) { base = ZQK; ldc = 1024; cl = ct; } else if (ct < 1536) { base = ZV; ldc = 512; cl = ct - 1024; } else if (ct < 2048) { base = ZO; ldc = 512; cl = ct - 1536; sig = true; } else { base = ZP; ldc = 512; cl = ct - 2048; }
    const int cofs = wc * 32 + 8 * fq;
    pg8::f32x4 bv[2][2];
#pragma unroll
    for (int bj = 0; bj < 2; ++bj)
#pragma unroll
      for (int n = 0; n < 2; ++n) bv[bj][n] = *(const pg8::f32x4*)(bias + ct + cofs + bj * 128 + 4 * n);
#pragma unroll
    for (int ai = 0; ai < 2; ++ai)
#pragma unroll
      for (int m = 0; m < 4; ++m) { bf16_t* rowp = base + (size_t)(row0 + ai * 128 + m * 16) * ldc + cl + cofs;
#pragma unroll
        for (int bj = 0; bj < 2; ++bj) { pg8::f32x4 v0 = acc[ai][bj][m][0] + bv[bj][0], v1 = acc[ai][bj][m][1] + bv[bj][1];
          if (sig) {
#pragma unroll
            for (int j = 0; j < 4; ++j) { v0[j] = sigmf(v0[j]); v1[j] = sigmf(v1[j]); } }
          pg8::u32x4 w; w.x = pg8::cvt_pk_bf16(v0[0], v0[1]); w.y = pg8::cvt_pk_bf16(v0[2], v0[3]); w.z = pg8::cvt_pk_bf16(v1[0], v1[1]); w.w = pg8::cvt_pk_bf16(v1[2], v1[3]);
          *(pg8::u32x4*)(rowp + bj * 128) = w; } }
  }
};
struct EpiPlain {
  static constexpr bool PERM = true, AFTER_DRAIN = false;
  bf16_t* out; int ldc;
  __device__ __forceinline__ void operator()(const pg8::f32x4 (&acc)[2][2][4][2], const pg8::Unit& u, int wr, int wc, int fr, int fq) const {
    const int row0 = u.pm * 256 + wr * 64 + fr, col0 = u.pn * 256 + wc * 32 + 8 * fq;
#pragma unroll
    for (int ai = 0; ai < 2; ++ai)
#pragma unroll
      for (int m = 0; m < 4; ++m) { bf16_t* rowp = out + (size_t)(row0 + ai * 128 + m * 16) * ldc + col0;
#pragma unroll
        for (int bj = 0; bj < 2; ++bj) { const pg8::f32x4 v0 = acc[ai][bj][m][0], v1 = acc[ai][bj][m][1];
          pg8::u32x4 w; w.x = pg8::cvt_pk_bf16(v0[0], v0[1]); w.y = pg8::cvt_pk_bf16(v0[2], v0[3]); w.z = pg8::cvt_pk_bf16(v1[0], v1[1]); w.w = pg8::cvt_pk_bf16(v1[2], v1[3]);
          *(pg8::u32x4*)(rowp + bj * 128) = w; } }
  }
};
struct EpiRes {
  static constexpr bool PERM = false, AFTER_DRAIN = false;
  const float* xin; float* X; const float* gate;
  __device__ __forceinline__ void operator()(const pg8::f32x4 (&acc)[2][2][4][2], const pg8::Unit& u, int wr, int wc, int fr, int fq) const {
    const int row0 = u.pm * 256 + wr * 64 + fr, col0 = u.pn * 256 + wc * 32 + 4 * fq; const float* gb = gate + (size_t)((u.pm * 256) / S) * 6144;
    pg8::f32x4 gv[2][2];
#pragma unroll
    for (int bj = 0; bj < 2; ++bj)
#pragma unroll
      for (int n = 0; n < 2; ++n) gv[bj][n] = *(const pg8::f32x4*)(gb + col0 + bj * 128 + n * 16);
#pragma unroll
    for (int ai = 0; ai < 2; ++ai)
#pragma unroll
      for (int m = 0; m < 4; ++m) { const size_t off = (size_t)(row0 + ai * 128 + m * 16) * 1024 + col0;
#pragma unroll
        for (int bj = 0; bj < 2; ++bj)
#pragma unroll
          for (int n = 0; n < 2; ++n) { const pg8::f32x4 xi = *(const pg8::f32x4*)(xin + off + bj * 128 + n * 16); *(pg8::f32x4*)(X + off + bj * 128 + n * 16) = xi + gv[bj][n] * acc[ai][bj][m][n]; }
        asm volatile("" ::: "memory"); }
  }
};
template <class Epi> __device__ __forceinline__ void phase_gemm_fast(const bf16_t* A, const bf16_t* Bt, int M, int N, int K, const Epi& E, char* smem) {
  pg8::Gemm g; g.A = A; g.Bt = Bt; g.M = M; g.N = N; g.K = K;
  pg8::StaticOrder So; So.init(M, N, (int)gridDim.x, (int)blockIdx.x);
  pg8::gemm_phase<Epi, pg8::StaticOrder, false>((PG8_LAS unsigned char*)smem, g, So, E, nullptr);
}

namespace cp {
typedef short bf16x8 __attribute__((ext_vector_type(8)));
typedef float f32x16 __attribute__((ext_vector_type(16)));
constexpr int RS = 272;
__device__ __forceinline__ void unpack8(const u32x4 w, float* f) { f[0] = bflo(w.x); f[1] = bfhi(w.x); f[2] = bflo(w.y); f[3] = bfhi(w.y); f[4] = bflo(w.z); f[5] = bfhi(w.z); f[6] = bflo(w.w); f[7] = bfhi(w.w); }
__device__ void phase_convpool(const Params& p, char* smem) {
  for (int job = blockIdx.x; job < T / 64; job += gridDim.x) {
    int tid_ = threadIdx.x; asm volatile("" : "+v"(tid_));
    const int tid = tid_, c0 = (tid & 127) * 8, t0 = job * 64 + (tid >> 7) * 16, s0 = t0 & (S - 1);
    float cw[5][8], cb[8];
#pragma unroll
    for (int j = 0; j < 5; ++j) { const f32x4 a = *(const f32x4*)(p.conv_w + j * 1024 + c0), b = *(const f32x4*)(p.conv_w + j * 1024 + c0 + 4); cw[j][0] = a.x; cw[j][1] = a.y; cw[j][2] = a.z; cw[j][3] = a.w; cw[j][4] = b.x; cw[j][5] = b.y; cw[j][6] = b.z; cw[j][7] = b.w; }
    { const f32x4 a = *(const f32x4*)(p.conv_b + c0), b = *(const f32x4*)(p.conv_b + c0 + 4); cb[0] = a.x; cb[1] = a.y; cb[2] = a.z; cb[3] = a.w; cb[4] = b.x; cb[5] = b.y; cb[6] = b.z; cb[7] = b.w; }
    const float sc = c0 >= 512 ? KSCALE : 1.f;
    float win[5][8];
#pragma unroll
    for (int j = 0; j < 4; ++j) { const int ss = s0 + j - 2; u32x4 w = (u32x4){0u, 0u, 0u, 0u}; if (ss >= 0 && ss < S) w = *(const u32x4*)(p.ZQK + (size_t)(t0 + j - 2) * 1024 + c0); unpack8(w, win[j + 1]); }
#pragma unroll
    for (int i = 0; i < 16; ++i) {
#pragma unroll
      for (int j = 0; j < 4; ++j)
#pragma unroll
        for (int q = 0; q < 8; ++q) win[j][q] = win[j + 1][q];
      { const int ss = s0 + i + 2; u32x4 w = (u32x4){0u, 0u, 0u, 0u}; if (ss < S) w = *(const u32x4*)(p.ZQK + (size_t)(t0 + i + 2) * 1024 + c0); unpack8(w, win[4]); }
      float a[8];
#pragma unroll
      for (int q = 0; q < 8; ++q) { float v = cb[q];
#pragma unroll
        for (int j = 0; j < 5; ++j) v += cw[j][q] * win[j][q];
        a[q] = siluf(v) * sc; }
      u32x4 o; o.x = pack2(a[0], a[1]); o.y = pack2(a[2], a[3]); o.z = pack2(a[4], a[5]); o.w = pack2(a[6], a[7]); *(u32x4*)(p.QK + (size_t)(t0 + i) * 1024 + c0) = o;
    }
  }
  for (int job = blockIdx.x; job < (T / 128) * 4; job += gridDim.x) {
    int tid_ = threadIdx.x; asm volatile("" : "+v"(tid_));
    const int tid = tid_, wid = tid >> 6, lane = tid & 63, l31 = lane & 31, hh = lane >> 5;
    const int g = (job + (job >> 8)) & 3, t0 = (job >> 2) * 128, win = 2 << g, hw = win >> 1;
    __syncthreads();
#pragma unroll
    for (int i = 0; i < 4; ++i) { const int idx = tid + i * NTHREADS, row = idx >> 4, ch = idx & 15; *(u32x4*)(smem + 128 * RS + row * RS + ch * 16) = *(const u32x4*)(p.poolWt + (size_t)g * 16384 + row * 128 + ch * 8); }
#pragma unroll 1
    for (int i = 0; i < 4; ++i) { const int idx = tid + i * NTHREADS, row = idx >> 4, ch = idx & 15, t = t0 + row, s = t & (S - 1); const int lo = max(s - hw, 0), hi = min(s + hw, S);
      float sum[8], own[8];
#pragma unroll
      for (int q = 0; q < 8; ++q) sum[q] = 0.f;
      const bf16_t* base = p.ZP + (size_t)(t - s) * 512 + g * 128 + ch * 8;
      u32x4 rw[16];
#pragma unroll
      for (int r = 0; r < 16; ++r) { rw[r] = (u32x4){0u, 0u, 0u, 0u}; if (r < win) { const int rr = s - hw + r; if (rr >= 0 && rr < S) rw[r] = *(const u32x4*)(base + (size_t)rr * 512); } }
#pragma unroll
      for (int r = 0; r < 16; ++r) if (r < win) { float f[8]; unpack8(rw[r], f);
#pragma unroll
        for (int q = 0; q < 8; ++q) sum[q] += f[q]; }
      unpack8(*(const u32x4*)(base + (size_t)s * 512), own); const float inv = 1.f / (float)(hi - lo);
      u32x4 o; o.x = pack2(sum[0] * inv - own[0], sum[1] * inv - own[1]); o.y = pack2(sum[2] * inv - own[2], sum[3] * inv - own[3]); o.z = pack2(sum[4] * inv - own[4], sum[5] * inv - own[5]); o.w = pack2(sum[6] * inv - own[6], sum[7] * inv - own[7]);
      *(u32x4*)(smem + row * RS + ch * 16) = o; }
    __syncthreads();
    const int mt = wid >> 1;
#pragma unroll
    for (int q = 0; q < 2; ++q) { const int nt = (wid & 1) * 2 + q;
      f32x16 acc;
#pragma unroll
      for (int r = 0; r < 16; ++r) acc[r] = 0.f;
      const char* ya = smem + (mt * 32 + l31) * RS + hh * 16; const char* wb = smem + 128 * RS + (nt * 32 + l31) * RS + hh * 16;
#pragma unroll
      for (int ks = 0; ks < 8; ++ks) acc = __builtin_amdgcn_mfma_f32_32x32x16_bf16(*(const bf16x8*)(ya + ks * 32), *(const bf16x8*)(wb + ks * 32), acc, 0, 0, 0);
      const int e = nt * 32 + l31; const float psc = p.pool_sc[g * 128 + e];
#pragma unroll
      for (int r = 0; r < 16; ++r) { const int row = mt * 32 + (r & 3) + 8 * (r >> 2) + 4 * hh; p.CAT[(size_t)(t0 + row) * 1024 + 512 + g * 128 + e] = f2bf(acc[r] * psc); } }
  }
}
}

__device__ void phase_mlstm_naive(const Params& p, char* smem) {
  float* qs = (float*)smem; float* ks = qs + 128; float* nump = ks + 128; float* red = nump + 512;
  const int tid = threadIdx.x, j = tid & 127, qd = tid >> 7;
  for (int job = blockIdx.x; job < 64; job += gridDim.x) {
    const int dir = job >> 5, b = (job >> 2) & 7, h = job & 3;
    float C[32];
#pragma unroll
    for (int d = 0; d < 32; ++d) C[d] = 0.f;
    float n = 0.f, m = 0.f;
    for (int step = 0; step < S; ++step) { const int s = dir ? S - 1 - step : step; const size_t t = (size_t)b * S + s;
      const float li = p.gates[t * 16 + dir * 4 + h], gf = p.gates[t * 16 + 8 + dir * 4 + h];
      const float lf = fminf(gf, 0.f) - log1pf(__expf(-fabsf(gf)));
      __syncthreads();
      if (qd == 0) { qs[j] = bf2f(p.QK[t * 1024 + h * 128 + j]); ks[j] = bf2f(p.QK[t * 1024 + 512 + h * 128 + j]); }
      const float v = bf2f(p.ZV[t * 512 + h * 128 + j]);
      __syncthreads();
      const float mn = fmaxf(lf + m, li), ip = __expf(li - mn), fp = __expf(lf + m - mn); m = mn;
      float num = 0.f;
#pragma unroll
      for (int d = 0; d < 32; ++d) { C[d] = fp * C[d] + ip * ks[qd * 32 + d] * v; num += qs[qd * 32 + d] * C[d]; }
      float dp = 0.f; if (qd == 0) { n = fp * n + ip * ks[j]; dp = qs[j] * n; }
      nump[qd * 128 + j] = num;
      dp = wave_sum(dp); if ((tid & 63) == 0) red[tid >> 6] = dp;
      __syncthreads();
      if (qd == 0) { const float den = red[0] + red[1]; num = nump[j] + nump[128 + j] + nump[256 + j] + nump[384 + j];
        p.HS[((size_t)dir * T + t) * 512 + h * 128 + j] = f2bf(num / fmaxf(fabsf(den), __expf(-mn))); }
    }
    __syncthreads();
  }
}

namespace ml {
typedef short bf16x8 __attribute__((ext_vector_type(8)));
typedef short s16x4 __attribute__((ext_vector_type(4)));
typedef float f32x16 __attribute__((ext_vector_type(16)));
constexpr int RS = 272;
constexpr int OFF_Q = 0, OFF_K = 128 * RS, OFF_VT = 2 * 128 * RS, OFF_VW = OFF_VT + 34 * RS, OFF_CT = OFF_VW + 34 * RS, OFF_A = OFF_CT + 34 * RS;
constexpr int OFF_PA = OFF_A + 16384, OFF_MCH = OFF_PA + 16384, OFF_TAB = OFF_MCH + 512, OFF_DEN = OFF_TAB + 4096, OFF_END = OFF_DEN + 512;
static_assert(OFF_A % 16 == 0 && OFF_END <= SMEM_BYTES, "mlstm LDS layout");
__device__ __forceinline__ int crow(int r, int h) { return (r & 3) + 8 * (r >> 2) + 4 * h; }
__device__ __forceinline__ int spos(int s) { return (s & ~12) | ((s & 4) << 1) | ((s & 8) >> 1); }
#define ML_MFMA(a, b, c) __builtin_amdgcn_mfma_f32_32x32x16_bf16((a), (b), (c), 0, 0, 0)
__device__ __forceinline__ bf16x8 pack8(float x0, float x1, float x2, float x3, float x4, float x5, float x6, float x7) {
  u32x4 w;
  asm volatile("v_cvt_pk_bf16_f32 %0, %4, %5\n\tv_cvt_pk_bf16_f32 %1, %6, %7\n\tv_cvt_pk_bf16_f32 %2, %8, %9\n\tv_cvt_pk_bf16_f32 %3, %10, %11\n\ts_nop 1"
               : "=&v"(w.x), "=&v"(w.y), "=&v"(w.z), "=&v"(w.w) : "v"(x0), "v"(x1), "v"(x2), "v"(x3), "v"(x4), "v"(x5), "v"(x6), "v"(x7));
  return __builtin_bit_cast(bf16x8, w);
}
__device__ __forceinline__ void tr_read8(unsigned a, s16x4& r0, s16x4& r1, s16x4& r2, s16x4& r3, s16x4& r4, s16x4& r5, s16x4& r6, s16x4& r7) {
  asm volatile("ds_read_b64_tr_b16 %0, %8\n\tds_read_b64_tr_b16 %1, %8 offset:2176\n\tds_read_b64_tr_b16 %2, %8 offset:4352\n\tds_read_b64_tr_b16 %3, %8 offset:6528\n\t"
               "ds_read_b64_tr_b16 %4, %8 offset:8704\n\tds_read_b64_tr_b16 %5, %8 offset:10880\n\tds_read_b64_tr_b16 %6, %8 offset:13056\n\tds_read_b64_tr_b16 %7, %8 offset:15232\n\ts_waitcnt lgkmcnt(0)"
               : "=&v"(r0), "=&v"(r1), "=&v"(r2), "=&v"(r3), "=&v"(r4), "=&v"(r5), "=&v"(r6), "=&v"(r7) : "v"(a) : "memory");
}
static_assert(8 * RS == 2176, "tr_read8 offsets assume 272-byte rows");

__device__ void phase_mlstm(const Params& p, char* smem) {
  int tid_ = threadIdx.x; asm volatile("" : "+v"(tid_));
  const int tid = tid_, wid = tid >> 6, lane = tid & 63, l31 = lane & 31, hh = lane >> 5;
  float* const LA = (float*)(smem + OFF_A); float* const LPA = (float*)(smem + OFF_PA); float* const LM = (float*)(smem + OFF_MCH);
  float* const LTAB = (float*)(smem + OFF_TAB); float* const LDEN = (float*)(smem + OFF_DEN);
  const unsigned lds0 = (unsigned)(uintptr_t)smem;
  for (int job = blockIdx.x; job < 256; job += gridDim.x) {
    const int dvq = job & 3, h = (job >> 2) & 3, b = (job >> 4) & 7, dir = job >> 7;
    const float* gts = p.gates + (size_t)b * S * 16;
    const bf16_t* QKb = p.QK + (size_t)b * S * 1024 + h * 128; const bf16_t* ZVb = p.ZV + (size_t)b * S * 512 + h * 128 + dvq * 32;
    bf16_t* HSb = p.HS + ((size_t)dir * T + (size_t)b * S) * 512 + h * 128 + dvq * 32;
    __syncthreads();
    for (int i = tid; i < 3 * 34 * RS / 4; i += NTHREADS) ((u32*)(smem + OFF_VT))[i] = 0u;
    for (int cc = 0; cc < 4; ++cc) { const int c = wid * 4 + cc, tau0 = c * 128 + 2 * lane; const int tok0 = dir ? S - 1 - tau0 : tau0, tok1 = dir ? tok0 - 1 : tok0 + 1;
      const float li0 = gts[(size_t)tok0 * 16 + dir * 4 + h], gf0 = gts[(size_t)tok0 * 16 + 8 + dir * 4 + h], li1 = gts[(size_t)tok1 * 16 + dir * 4 + h], gf1 = gts[(size_t)tok1 * 16 + 8 + dir * 4 + h];
      const float lf0 = fminf(gf0, 0.f) - log1pf(__expf(-fabsf(gf0))), lf1 = fminf(gf1, 0.f) - log1pf(__expf(-fabsf(gf1)));
      const float pr = lf0 + lf1; float incl = pr;
#pragma unroll
      for (int o = 1; o < 64; o <<= 1) { const float v = __shfl_up(incl, o); if (lane >= o) incl += v; }
      const float b0 = incl - pr + lf0, b1 = b0 + lf1, a0 = li0 - b0, a1 = li1 - b1;
      float im = fmaxf(a0, a1);
#pragma unroll
      for (int o = 1; o < 64; o <<= 1) { const float v = __shfl_up(im, o); if (lane >= o) im = fmaxf(im, v); }
      float ex = __shfl_up(im, 1); if (lane == 0) ex = -INFINITY;
      const float pa0 = fmaxf(ex, a0), pa1 = fmaxf(pa0, a1);
      LA[tau0] = a0; LA[tau0 + 1] = a1; LPA[tau0] = pa0; LPA[tau0 + 1] = pa1; if (lane == 63) LM[64 + c] = b1; }
    __syncthreads();
    if (tid == 0) { float m = 0.f; for (int c = 0; c < 32; ++c) { LM[c] = m; m = LM[64 + c] + fmaxf(m, LPA[c * 128 + 127]); } LM[32] = m; }
    __syncthreads();
    u32x4 qreg[4], kreg[4], vreg;
#define ML_TOK(tau) (dir ? S - 1 - (tau) : (tau))
#define ML_LOAD(c) do { _Pragma("unroll") for (int i_ = 0; i_ < 4; ++i_) { const int tk_ = ML_TOK((c) * 128 + (tid >> 4) + 32 * i_); \
        qreg[i_] = *(const u32x4*)(QKb + (size_t)tk_ * 1024 + (tid & 15) * 8); kreg[i_] = *(const u32x4*)(QKb + (size_t)tk_ * 1024 + 512 + (tid & 15) * 8); } \
      { const int tk_ = ML_TOK((c) * 128 + (tid >> 2)); vreg = *(const u32x4*)(ZVb + (size_t)tk_ * 512 + (tid & 3) * 8); } } while (0)
#define ML_TABLES(c) do { if (tid < 128) { const int tau_ = (c) * 128 + tid, tk_ = ML_TOK(tau_); const float li_ = gts[(size_t)tk_ * 16 + dir * 4 + h], a_ = LA[tau_], mc_ = LM[(c)]; \
        const float Mj_ = fmaxf(mc_, LPA[tau_]), Me_ = fmaxf(mc_, LPA[(c) * 128 + 127]); float* tb_ = LTAB + ((c) & 1) * 512; \
        tb_[tid] = __expf(fminf(Me_ - Mj_, 60.f)); tb_[128 + tid] = __expf(mc_ - Mj_); tb_[256 + tid] = __expf(-((li_ - a_) + Mj_)); tb_[384 + tid] = __expf(a_ - Me_); } } while (0)
#define ML_STORE(c) do { _Pragma("unroll") for (int i_ = 0; i_ < 4; ++i_) { const int row_ = (tid >> 4) + 32 * i_; \
        *(u32x4*)(smem + OFF_Q + row_ * RS + (tid & 15) * 16) = qreg[i_]; *(u32x4*)(smem + OFF_K + row_ * RS + (tid & 15) * 16) = kreg[i_]; } \
      { const int s_ = tid >> 2, ps_ = spos(s_) * 2; const float we_ = LTAB[((c) & 1) * 512 + 384 + s_]; const u32 vw_[4] = {vreg.x, vreg.y, vreg.z, vreg.w}; \
        _Pragma("unroll") for (int i_ = 0; i_ < 4; ++i_) { const int r0_ = ((tid & 3) * 8 + 2 * i_) * RS + ps_; \
          *(bf16_t*)(smem + OFF_VT + r0_) = (bf16_t)(vw_[i_] & 0xFFFFu); *(bf16_t*)(smem + OFF_VT + r0_ + RS) = (bf16_t)(vw_[i_] >> 16); \
          *(bf16_t*)(smem + OFF_VW + r0_) = f2bf(bflo(vw_[i_]) * we_); *(bf16_t*)(smem + OFF_VW + r0_ + RS) = f2bf(bfhi(vw_[i_]) * we_); } } \
      if (tid < 128) { const int ps_ = spos(tid) * 2; *(bf16_t*)(smem + OFF_VT + 32 * RS + ps_) = (bf16_t)0x3F80u; *(bf16_t*)(smem + OFF_VW + 32 * RS + ps_) = f2bf(LTAB[((c) & 1) * 512 + 384 + tid]); } } while (0)
    ML_LOAD(0); ML_TABLES(0);
    __syncthreads();
    ML_STORE(0);
    __syncthreads();
    f32x16 Cacc;
#pragma unroll
    for (int r = 0; r < 16; ++r) Cacc[r] = 0.f;
    for (int c = 0; c < 32; ++c) {
      int tidc_ = threadIdx.x; asm volatile("" : "+v"(tidc_));
      const int tid = tidc_, wid = tid >> 6, lane = tid & 63, l31 = lane & 31, hh = lane >> 5;
      const int t2 = wid >> 1, nt = wid & 1, brow = min(nt * 32 + l31, 33);
      if (c + 1 < 32) { ML_LOAD(c + 1); ML_TABLES(c + 1); }
      const float* tab = LTAB + (c & 1) * 512;
      f32x16 acc;
#pragma unroll
      for (int r = 0; r < 16; ++r) acc[r] = 0.f;
      const char* qa = smem + OFF_Q + (t2 * 32 + l31) * RS + hh * 16;
      { const char* cb = smem + OFF_CT + brow * RS + hh * 16;
#pragma unroll
        for (int ks = 0; ks < 8; ++ks) acc = ML_MFMA(*(const bf16x8*)(qa + ks * 32), *(const bf16x8*)(cb + ks * 32), acc); }
#pragma unroll
      for (int r = 0; r < 16; ++r) acc[r] *= tab[128 + t2 * 32 + crow(r, hh)];
      const float fj = tab[t2 * 32 + l31];
      for (int si = 0; si <= t2; ++si) {
        f32x16 X;
#pragma unroll
        for (int r = 0; r < 16; ++r) X[r] = 0.f;
        const char* ka = smem + OFF_K + (si * 32 + l31) * RS + hh * 16;
#pragma unroll
        for (int ks = 0; ks < 8; ++ks) X = ML_MFMA(*(const bf16x8*)(ka + ks * 32), *(const bf16x8*)(qa + ks * 32), X);
        const float* We = tab + 384 + si * 32;
#pragma unroll
        for (int r = 0; r < 16; ++r) { const int sl = crow(r, hh); float w = We[sl] * fj; if (si == t2 && sl > l31) w = 0.f; X[r] *= w; }
        const bf16x8 f0 = pack8(X[0], X[1], X[2], X[3], X[4], X[5], X[6], X[7]), f1 = pack8(X[8], X[9], X[10], X[11], X[12], X[13], X[14], X[15]);
        const char* vb = smem + OFF_VT + brow * RS + si * 64 + hh * 16;
        acc = ML_MFMA(f0, *(const bf16x8*)(vb), acc); acc = ML_MFMA(f1, *(const bf16x8*)(vb + 32), acc);
      }
      if (nt == 1 && l31 == 0) {
#pragma unroll
        for (int r = 0; r < 16; ++r) LDEN[t2 * 32 + crow(r, hh)] = acc[r]; }
      { const float mc = LM[c], decay = __expf(mc - fmaxf(mc, LPA[c * 128 + 127]));
#pragma unroll
        for (int r = 0; r < 16; ++r) Cacc[r] *= decay;
        const unsigned ta = lds0 + OFF_K + ((lane & 15) >> 2) * RS + (t2 * 32 + 16 * ((lane >> 4) & 1) + 4 * (lane & 3)) * 2 + 4 * hh * RS;
        const char* wb = smem + OFF_VW + brow * RS + hh * 16;
#pragma unroll
        for (int kq = 0; kq < 2; ++kq) { s16x4 r0, r1, r2, r3, r4, r5, r6, r7; tr_read8(ta + 64 * kq * RS, r0, r1, r2, r3, r4, r5, r6, r7); __builtin_amdgcn_sched_barrier(0);
          Cacc = ML_MFMA(((bf16x8){r0[0], r0[1], r0[2], r0[3], r1[0], r1[1], r1[2], r1[3]}), *(const bf16x8*)(wb + (4 * kq + 0) * 32), Cacc);
          Cacc = ML_MFMA(((bf16x8){r2[0], r2[1], r2[2], r2[3], r3[0], r3[1], r3[2], r3[3]}), *(const bf16x8*)(wb + (4 * kq + 1) * 32), Cacc);
          Cacc = ML_MFMA(((bf16x8){r4[0], r4[1], r4[2], r4[3], r5[0], r5[1], r5[2], r5[3]}), *(const bf16x8*)(wb + (4 * kq + 2) * 32), Cacc);
          Cacc = ML_MFMA(((bf16x8){r6[0], r6[1], r6[2], r6[3], r7[0], r7[1], r7[2], r7[3]}), *(const bf16x8*)(wb + (4 * kq + 3) * 32), Cacc); } }
      __syncthreads();
      if (nt == 0) {
#pragma unroll
        for (int r = 0; r < 16; ++r) { const int j = t2 * 32 + crow(r, hh); const float dn = LDEN[j], nr = tab[256 + j]; const int tk = ML_TOK(c * 128 + j);
          HSb[(size_t)tk * 512 + l31] = f2bf(acc[r] / fmaxf(fabsf(dn), nr)); } }
      if (nt * 32 + l31 <= 32) { char* cw = smem + OFF_CT + (nt * 32 + l31) * RS + (t2 * 32 + 4 * hh) * 2;
#pragma unroll
        for (int g = 0; g < 4; ++g) { u32x2 w; w.x = pack2(Cacc[4 * g], Cacc[4 * g + 1]); w.y = pack2(Cacc[4 * g + 2], Cacc[4 * g + 3]); *(u32x2*)(cw + 16 * g) = w; } }
      if (c + 1 < 32) ML_STORE(c + 1);
      __syncthreads();
    }
#undef ML_TOK
#undef ML_LOAD
#undef ML_TABLES
#undef ML_STORE
  }
}
}

__device__ void phase_peer_select_naive(const Params& p, int layer, char* smem) {
  float* kl = (float*)smem;
  float* qsh = kl + 2 * 128 * 129;
  const int tid = threadIdx.x, wid = tid >> 6, lane = tid & 63; float* qs = qsh + wid * 128;
  __syncthreads();
  for (int i = tid; i < 2 * 128 * 128; i += NTHREADS) kl[(i >> 7) * 129 + (i & 127)] = p.peer_keys[(size_t)layer * 32768 + i];
  __syncthreads();
  for (int job = blockIdx.x; job < T; job += gridDim.x) {
    const int t = job, h = wid;
    float ts[2][16]; int ti[2][16];
#pragma unroll
    for (int pp = 0; pp < 2; ++pp) {
      const bf16_t* q = p.QP + (size_t)t * 2048 + h * 256 + pp * 128; const float q0 = bf2f(q[lane]), q1 = bf2f(q[lane + 64]);
      const float r = rsqrtf(wave_sum(q0 * q0 + q1 * q1) * (1.f / 128.f) + EPS); qs[lane] = q0 * r; qs[lane + 64] = q1 * r;
      float s0 = 0.f, s1 = 0.f; const float* k0 = kl + (pp * 128 + lane) * 129; const float* k1 = k0 + 64 * 129;
      for (int c = 0; c < 128; ++c) { const float qc = qs[c]; s0 += qc * k0[c]; s1 += qc * k1[c]; }
#pragma unroll
      for (int k = 0; k < 16; ++k) { const float mx = wave_max(fmaxf(s0, s1)); int cand = (s0 == mx) ? lane : ((s1 == mx) ? lane + 64 : 9999);
        for (int o = 32; o >= 1; o >>= 1) cand = min(cand, __shfl_xor(cand, o));
        ts[pp][k] = mx; ti[pp][k] = cand; if (cand == lane) s0 = -INFINITY; if (cand == lane + 64) s1 = -INFINITY; }
    }
    float cs[4];
#pragma unroll
    for (int r = 0; r < 4; ++r) { const int c = lane * 4 + r; float va = 0.f, vb = 0.f;
#pragma unroll
      for (int k = 0; k < 16; ++k) { if (k == (c >> 4)) va = ts[0][k]; if (k == (c & 15)) vb = ts[1][k]; }
      cs[r] = va + vb; }
    float top[16]; int tix[16];
#pragma unroll
    for (int k = 0; k < 16; ++k) { const float mx = wave_max(fmaxf(fmaxf(cs[0], cs[1]), fmaxf(cs[2], cs[3]))); int cand = 9999;
#pragma unroll
      for (int r = 3; r >= 0; --r) if (cs[r] == mx) cand = lane * 4 + r;
      for (int o = 32; o >= 1; o >>= 1) cand = min(cand, __shfl_xor(cand, o));
      top[k] = mx; tix[k] = cand;
#pragma unroll
      for (int r = 0; r < 4; ++r) if (cand == lane * 4 + r) cs[r] = -INFINITY; }
    float sum = 0.f;
#pragma unroll
    for (int k = 0; k < 16; ++k) sum += __expf(top[k] - top[0]);
    if (lane < 16) { float tv = 0.f; int tc = 0;
#pragma unroll
      for (int k = 0; k < 16; ++k) if (k == lane) { tv = top[k]; tc = tix[k]; }
      int ia = 0, ib = 0;
#pragma unroll
      for (int k = 0; k < 16; ++k) { if (k == (tc >> 4)) ia = ti[0][k]; if (k == (tc & 15)) ib = ti[1][k]; }
      p.pidx[((size_t)t * 8 + h) * 16 + lane] = (bf16_t)(ia * 128 + ib); p.pgate[((size_t)t * 8 + h) * 16 + lane] = __expf(tv - top[0]) / sum; }
  }
}

namespace sel {
typedef short bf16x8 __attribute__((ext_vector_type(8)));
typedef float f32x16 __attribute__((ext_vector_type(16)));
constexpr int RS = 272, OFF_W = 2 * 128 * RS, WB = 3 * 16 * 32 * 4;
static_assert(OFF_W + 8 * WB <= SMEM_BYTES, "select LDS layout");
constexpr float NEG = -3.0e38f;
__device__ __forceinline__ float max3(float a, float b, float c) { return fmaxf(fmaxf(a, b), c); }
__device__ __forceinline__ float xhalf(float v) { return __shfl_xor(v, 32); }

#define CE(a, b) do { const float hi_ = fmaxf(a, b), lo_ = fminf(a, b); a = hi_; b = lo_; } while (0)
#define SORT16(V) do { CE(V[0], V[1]); CE(V[2], V[3]); CE(V[0], V[2]); CE(V[1], V[3]); CE(V[1], V[2]); CE(V[4], V[5]); CE(V[6], V[7]); CE(V[4], V[6]); CE(V[5], V[7]); CE(V[5], V[6]); CE(V[0], V[4]); CE(V[2], V[6]); CE(V[2], V[4]); CE(V[1], V[5]); CE(V[3], V[7]); CE(V[3], V[5]); CE(V[1], V[2]); CE(V[3], V[4]); CE(V[5], V[6]); CE(V[8], V[9]); CE(V[10], V[11]); CE(V[8], V[10]); CE(V[9], V[11]); CE(V[9], V[10]); CE(V[12], V[13]); CE(V[14], V[15]); CE(V[12], V[14]); CE(V[13], V[15]); CE(V[13], V[14]); CE(V[8], V[12]); CE(V[10], V[14]); CE(V[10], V[12]); CE(V[9], V[13]); CE(V[11], V[15]); CE(V[11], V[13]); CE(V[9], V[10]); CE(V[11], V[12]); CE(V[13], V[14]); CE(V[0], V[8]); CE(V[4], V[12]); CE(V[4], V[8]); CE(V[2], V[10]); CE(V[6], V[14]); CE(V[6], V[10]); CE(V[2], V[4]); CE(V[6], V[8]); CE(V[10], V[12]); CE(V[1], V[9]); CE(V[5], V[13]); CE(V[5], V[9]); CE(V[3], V[11]); CE(V[7], V[15]); CE(V[7], V[11]); CE(V[3], V[5]); CE(V[7], V[9]); CE(V[11], V[13]); CE(V[1], V[2]); CE(V[3], V[4]); CE(V[5], V[6]); CE(V[7], V[8]); CE(V[9], V[10]); CE(V[11], V[12]); CE(V[13], V[14]); } while (0)
#define BMERGE16(V) do { CE(V[0], V[8]); CE(V[1], V[9]); CE(V[2], V[10]); CE(V[3], V[11]); CE(V[4], V[12]); CE(V[5], V[13]); CE(V[6], V[14]); CE(V[7], V[15]); CE(V[0], V[4]); CE(V[1], V[5]); CE(V[2], V[6]); CE(V[3], V[7]); CE(V[8], V[12]); CE(V[9], V[13]); CE(V[10], V[14]); CE(V[11], V[15]); CE(V[0], V[2]); CE(V[1], V[3]); CE(V[4], V[6]); CE(V[5], V[7]); CE(V[8], V[10]); CE(V[9], V[11]); CE(V[12], V[14]); CE(V[13], V[15]); CE(V[0], V[1]); CE(V[2], V[3]); CE(V[4], V[5]); CE(V[6], V[7]); CE(V[8], V[9]); CE(V[10], V[11]); CE(V[12], V[13]); CE(V[14], V[15]); } while (0)

__device__ void phase_peer_select(const Params& p, int layer, char* smem) {
  const int tid0 = threadIdx.x;
  __syncthreads();
  { const bf16_t* kb = p.keysb + (size_t)layer * 32768;
    for (int i = tid0; i < 2 * 128 * 16; i += NTHREADS) { const int row = i >> 4, ch = i & 15; *(u32x4*)(smem + row * RS + ch * 16) = *(const u32x4*)(kb + (size_t)row * 128 + ch * 8); } }
  __syncthreads();
  for (int job = blockIdx.x; job < T / 32; job += gridDim.x) {
    int tid_ = threadIdx.x; asm volatile("" : "+v"(tid_));
    const int tid = tid_, wid = tid >> 6, lane = tid & 63, l31 = lane & 31, hh = lane >> 5, h = wid;
    const int t = job * 32 + l31;
    float* const wl = (float*)(smem + OFF_W + wid * WB);
    float rs[2], s1[16], s2[16];
#pragma unroll
    for (int pp = 0; pp < 2; ++pp) {
      const bf16_t* qrow = p.QP + (size_t)t * 2048 + h * 256 + pp * 128 + hh * 8;
      bf16x8 bq[8]; float ssq = 0.f;
#pragma unroll
      for (int ks = 0; ks < 8; ++ks) { const u32x4 w = *(const u32x4*)(qrow + ks * 16); bq[ks] = __builtin_bit_cast(bf16x8, w);
        const u32 w0 = w.x, w1 = w.y, w2 = w.z, w3 = w.w; ssq = dot2bf(w0, w0, ssq); ssq = dot2bf(w1, w1, ssq); ssq = dot2bf(w2, w2, ssq); ssq = dot2bf(w3, w3, ssq); }
      ssq += xhalf(ssq); rs[pp] = rsqrtf(ssq * (1.f / 128.f) + EPS);
      f32x16 X[4];
#pragma unroll
      for (int nt = 0; nt < 4; ++nt) {
#pragma unroll
        for (int r = 0; r < 16; ++r) X[nt][r] = 0.f;
        const char* ka = smem + (pp * 128 + nt * 32 + l31) * RS + hh * 16;
#pragma unroll
        for (int ks = 0; ks < 8; ++ks) X[nt] = __builtin_amdgcn_mfma_f32_32x32x16_bf16(*(const bf16x8*)(ka + ks * 32), bq[ks], X[nt], 0, 0, 0); }
#pragma unroll
      for (int nt = 0; nt < 4; ++nt)
#pragma unroll
        for (int r = 0; r < 16; ++r) X[nt][r] = __uint_as_float((__float_as_uint(X[nt][r]) & ~0x7Fu) | (u32)(nt * 32 + (r & 3) + 8 * (r >> 2)) | ((u32)hh << 2));
      SORT16(X[0]); SORT16(X[1]); SORT16(X[2]); SORT16(X[3]);
#pragma unroll
      for (int i = 0; i < 16; ++i) { X[0][i] = fmaxf(X[0][i], X[1][15 - i]); X[2][i] = fmaxf(X[2][i], X[3][15 - i]); }
      BMERGE16(X[0]); BMERGE16(X[2]);
#pragma unroll
      for (int i = 0; i < 16; ++i) X[0][i] = fmaxf(X[0][i], X[2][15 - i]);
      BMERGE16(X[0]);
      f32x16 lo_, hi_;
#pragma unroll
      for (int i = 0; i < 16; ++i) { const u32 b_ = __float_as_uint(X[0][i]); auto r_ = __builtin_amdgcn_permlane32_swap(b_, b_, false, false); lo_[i] = __uint_as_float(r_[0]); hi_[i] = __uint_as_float(r_[1]); }
#pragma unroll
      for (int i = 0; i < 16; ++i) X[0][i] = fmaxf(lo_[i], hi_[15 - i]);
      BMERGE16(X[0]);
#pragma unroll
      for (int k = 0; k < 16; ++k) { wl[(pp * 16 + k) * 32 + l31] = X[0][k]; if (pp == 0) s1[k] = X[0][k] * rs[0]; else s2[k] = X[0][k] * rs[1]; }
    }
    constexpr int A0[25] = {0, 0, 0, 0, 0, 0, 0, 0, 0, 0, 0, 0, 0, 0, 0, 0, 2, 2, 2, 2, 2, 3, 3, 3, 3}, B0[25] = {0, 1, 2, 3, 4, 5, 6, 7, 8, 9, 10, 11, 12, 13, 14, 15, 0, 1, 2, 3, 4, 0, 1, 2, 3};
    constexpr int A1[25] = {1, 1, 1, 1, 1, 1, 1, 1, 4, 4, 4, 5, 5, 6, 6, 7, 7, 8, 9, 10, 11, 12, 13, 14, 15}, B1[25] = {0, 1, 2, 3, 4, 5, 6, 7, 0, 1, 2, 0, 1, 0, 1, 0, 1, 0, 0, 0, 0, 0, 0, 0, 0};
    float cd[25];
#pragma unroll
    for (int i = 0; i < 25; ++i) { const float v0 = s1[A0[i]] + s2[B0[i]], v1 = s1[A1[i]] + s2[B1[i]]; const float v = hh ? v1 : v0; const u32 cid = hh ? (u32)(A1[i] * 16 + B1[i]) : (u32)(A0[i] * 16 + B0[i]);
      cd[i] = __uint_as_float((__float_as_uint(v) & ~0xFFu) | cid); }
#pragma unroll 1
    for (int k = 0; k < 16; ++k) {
      float m = cd[24];
#pragma unroll
      for (int i = 0; i < 24; i += 2) m = max3(m, cd[i], cd[i + 1]);
      const float M = fmaxf(m, xhalf(m));
      wl[(32 + k) * 32 + l31] = M;
#pragma unroll
      for (int i = 0; i < 25; ++i) cd[i] = (cd[i] == M) ? NEG : cd[i];
    }
    float tv[16];
#pragma unroll
    for (int k = 0; k < 16; ++k) tv[k] = wl[(32 + k) * 32 + l31];
    float sum = 0.f;
#pragma unroll
    for (int k = 0; k < 16; ++k) sum += __expf(tv[k] - tv[0]);
    const float inv = 1.f / sum;
    u32 ev[8]; float go[8];
#pragma unroll
    for (int q = 0; q < 8; ++q) { const float v = wl[(32 + hh * 8 + q) * 32 + l31]; const u32 cid = __float_as_uint(v) & 0xFFu;
      const u32 i1 = __float_as_uint(wl[(cid >> 4) * 32 + l31]) & 0x7Fu, i2 = __float_as_uint(wl[(16 + (cid & 15)) * 32 + l31]) & 0x7Fu; ev[q] = i1 * 128 + i2;
      go[q] = __expf(v - tv[0]) * inv; }
    const u32 io0 = ev[0] | (ev[1] << 16), io1 = ev[2] | (ev[3] << 16), io2 = ev[4] | (ev[5] << 16), io3 = ev[6] | (ev[7] << 16);
    const size_t ob = ((size_t)t * 8 + h) * 16 + hh * 8;
    *(u32x4*)(p.pidx + ob) = (u32x4){io0, io1, io2, io3};
    *(f32x4*)(p.pgate + ob) = (f32x4){go[0], go[1], go[2], go[3]}; *(f32x4*)(p.pgate + ob + 4) = (f32x4){go[4], go[5], go[6], go[7]};
  }
}
}

typedef float f32x2 __attribute__((ext_vector_type(2)));
constexpr float U8_SCALE = 32.f, V8_SCALE = 2.f;
constexpr int GT = 4;
constexpr int GW_WAVE_BYTES = GT * (2048 + 128 * 2 + 128 * 4);
static_assert(8 * GW_WAVE_BYTES <= SMEM_BYTES - 16, "gather LDS layout");
__device__ __forceinline__ float gelu_erf(float z) { return 0.5f * z * (1.f + erff(z * 0.70710678118654752f)); }
__device__ __forceinline__ float reduce8(float d0, float d1, float d2, float d3, float d4, float d5, float d6, float d7, int lane) {
  float e[4];
  { auto r0 = __builtin_amdgcn_permlane32_swap(__float_as_uint(d0), __float_as_uint(d4), false, false); e[0] = __uint_as_float(r0[0]) + __uint_as_float(r0[1]);
    auto r1 = __builtin_amdgcn_permlane32_swap(__float_as_uint(d1), __float_as_uint(d5), false, false); e[1] = __uint_as_float(r1[0]) + __uint_as_float(r1[1]);
    auto r2 = __builtin_amdgcn_permlane32_swap(__float_as_uint(d2), __float_as_uint(d6), false, false); e[2] = __uint_as_float(r2[0]) + __uint_as_float(r2[1]);
    auto r3 = __builtin_amdgcn_permlane32_swap(__float_as_uint(d3), __float_as_uint(d7), false, false); e[3] = __uint_as_float(r3[0]) + __uint_as_float(r3[1]); }
  float f0, f1;
  { auto r0 = __builtin_amdgcn_permlane16_swap(__float_as_uint(e[0]), __float_as_uint(e[2]), false, false); f0 = __uint_as_float(r0[0]) + __uint_as_float(r0[1]);
    auto r1 = __builtin_amdgcn_permlane16_swap(__float_as_uint(e[1]), __float_as_uint(e[3]), false, false); f1 = __uint_as_float(r1[0]) + __uint_as_float(r1[1]); }
  const bool up = (lane & 8) != 0; const float keep = up ? f1 : f0, send = up ? f0 : f1;
  float g = keep + __shfl_xor(send, 8);
  g += __shfl_xor(g, 4); g += __shfl_xor(g, 2); g += __shfl_xor(g, 1);
  return g;
}
template <int NEXT>
__device__ void phase_peer_gather(const Params& p, int layer, char* smem) {
  const unsigned char* U8 = p.U8 + (size_t)layer * 16384 * 1024; const unsigned char* V8 = p.V8 + (size_t)layer * 16384 * 1024;
  for (int job = blockIdx.x; job < T / (8 * GT); job += gridDim.x) {
    int tid_ = threadIdx.x; asm volatile("" : "+v"(tid_));
    const int tid = tid_, wid = tid >> 6, lane = tid & 63;
    const int tb = (job * 8 + wid) * GT;
    const int vidx = 4 * (lane >> 5) + 2 * ((lane >> 4) & 1) + ((lane >> 3) & 1);
    char* wl = smem + wid * GW_WAVE_BYTES; bf16_t* sx = (bf16_t*)wl; bf16_t* sidx = (bf16_t*)(wl + GT * 2048); float* sgate = (float*)(wl + GT * 2048 + GT * 256);
#pragma unroll 1
    for (int g = 0; g < GT; ++g) { const size_t t = (size_t)(tb + g);
      *(u32x4*)(sx + g * 1024 + lane * 16) = *(const u32x4*)(p.H + t * D + lane * 16); *(u32x4*)(sx + g * 1024 + lane * 16 + 8) = *(const u32x4*)(p.H + t * D + lane * 16 + 8);
      const int ia = p.pidx[t * 128 + lane], ib = p.pidx[t * 128 + 64 + lane]; const float ga = p.pgate[t * 128 + lane], gb = p.pgate[t * 128 + 64 + lane];
      const int wa = ia >> 10, wb = ib >> 10; int off = 0, pa = 0, pb = 0;
#pragma unroll
      for (int w = 0; w < 16; ++w) { const unsigned long long m0 = __ballot(wa == w), m1 = __ballot(wb == w); const int c0 = __popcll(m0), c1 = __popcll(m1);
        const int r0 = __builtin_amdgcn_mbcnt_hi((unsigned)(m0 >> 32), __builtin_amdgcn_mbcnt_lo((unsigned)m0, 0)), r1 = __builtin_amdgcn_mbcnt_hi((unsigned)(m1 >> 32), __builtin_amdgcn_mbcnt_lo((unsigned)m1, 0));
        if (wa == w) pa = off + r0; if (wb == w) pb = off + c0 + r1; off += c0 + c1; }
      sidx[g * 128 + pa] = (bf16_t)ia; sgate[g * 128 + pa] = ga; sidx[g * 128 + pb] = (bf16_t)ib; sgate[g * 128 + pb] = gb; }
    f32x2 acc[GT][8];
#pragma unroll
    for (int g = 0; g < GT; ++g)
#pragma unroll
      for (int i = 0; i < 8; ++i) acc[g][i] = (f32x2){0.f, 0.f};
#pragma unroll 1
    for (int hb = 0; hb < 16; ++hb) {
#pragma unroll
      for (int g = 0; g < GT; ++g) {
        const int myidx = (int)sidx[g * 128 + hb * 8 + (lane & 7)]; const float mygate = sgate[g * 128 + hb * 8 + vidx];
        const u32x4 h0 = *(const u32x4*)(sx + g * 1024 + lane * 16), h1 = *(const u32x4*)(sx + g * 1024 + lane * 16 + 8);
        const u32 hx[8] = {h0.x, h0.y, h0.z, h0.w, h1.x, h1.y, h1.z, h1.w};
        u32x4 ur[8], vr[8];
#pragma unroll
        for (int k = 0; k < 8; ++k) { const int e = __builtin_amdgcn_readlane(myidx, k); ur[k] = *(const u32x4*)(U8 + (size_t)e * 1024 + lane * 16); if (k < 4) vr[k] = *(const u32x4*)(V8 + (size_t)e * 1024 + lane * 16); }
        float d[8];
#pragma unroll
        for (int k = 0; k < 8; ++k) { const u32 w[4] = {ur[k].x, ur[k].y, ur[k].z, ur[k].w}; float a = 0.f;
#pragma unroll
          for (int j = 0; j < 4; ++j) { const u32 lo = __builtin_bit_cast(u32, __builtin_amdgcn_cvt_scalef32_pk_bf16_fp8(w[j], 1.0f, false)), hi = __builtin_bit_cast(u32, __builtin_amdgcn_cvt_scalef32_pk_bf16_fp8(w[j], 1.0f, true));
            a = dot2bf(lo, hx[2 * j], a); a = dot2bf(hi, hx[2 * j + 1], a); }
          asm volatile("" : "+v"(a));
          d[k] = a; }
        asm volatile("" ::: "memory");
#pragma unroll
        for (int k = 4; k < 8; ++k) { const int e = __builtin_amdgcn_readlane(myidx, k); vr[k] = *(const u32x4*)(V8 + (size_t)e * 1024 + lane * 16); }
        const float z = reduce8(d[0], d[1], d[2], d[3], d[4], d[5], d[6], d[7], lane) * (1.f / U8_SCALE);
        const float cf = mygate * gelu_erf(z) * (1.f / V8_SCALE);
#pragma unroll
        for (int k = 0; k < 8; ++k) { const float ck = __uint_as_float(__builtin_amdgcn_readlane(__float_as_uint(cf), 32 * (k >> 2) + 16 * ((k >> 1) & 1) + 8 * (k & 1)));
          const u32 w[4] = {vr[k].x, vr[k].y, vr[k].z, vr[k].w}; const f32x2 c2 = (f32x2){ck, ck};
#pragma unroll
          for (int j = 0; j < 4; ++j) { const f32x2 lo = __builtin_amdgcn_cvt_pk_f32_fp8((int)w[j], false), hi = __builtin_amdgcn_cvt_pk_f32_fp8((int)w[j], true);
            acc[g][2 * j] = lo * c2 + acc[g][2 * j]; acc[g][2 * j + 1] = hi * c2 + acc[g][2 * j + 1]; } }
        asm volatile("" ::: "memory");
      }
      if ((hb & 3) == 3) __syncthreads();
    }
#pragma unroll
    for (int g = 0; g < GT; ++g) { const int t = tb + g, b = t / S;
      const float* g2 = p.mod + (size_t)(layer * 8 + b) * 6144 + 5120 + lane * 16; float* xp = p.X + (size_t)t * D + lane * 16;
      float xv[16]; float ss = 0.f;
#pragma unroll
      for (int q = 0; q < 4; ++q) { const f32x4 x0 = *(const f32x4*)(xp + 4 * q), g0 = *(const f32x4*)(g2 + 4 * q);
        xv[4 * q + 0] = x0.x + g0.x * acc[g][2 * q].x; xv[4 * q + 1] = x0.y + g0.y * acc[g][2 * q].y; xv[4 * q + 2] = x0.z + g0.z * acc[g][2 * q + 1].x; xv[4 * q + 3] = x0.w + g0.w * acc[g][2 * q + 1].y; }
#pragma unroll
      for (int i = 0; i < 16; ++i) ss += xv[i] * xv[i];
      ss = wave_sum(ss); const float r = rsqrtf(ss * (1.f / D) + EPS);
      if (NEXT == 0) {
        const float* ml = p.mod + (size_t)((layer + 1) * 8 + b) * 6144 + lane * 16; const float* gn = p.nmg + (layer + 1) * D + lane * 16; float y[16];
#pragma unroll
        for (int i = 0; i < 16; ++i) y[i] = xv[i] * r * gn[i] * (1.f + ml[1024 + i]) + ml[i];
#pragma unroll
        for (int q = 0; q < 4; ++q) *(f32x4*)(xp + 4 * q) = (f32x4){xv[4 * q], xv[4 * q + 1], xv[4 * q + 2], xv[4 * q + 3]};
        u32x4 w0, w1; w0.x = pack2(y[0], y[1]); w0.y = pack2(y[2], y[3]); w0.z = pack2(y[4], y[5]); w0.w = pack2(y[6], y[7]); w1.x = pack2(y[8], y[9]); w1.y = pack2(y[10], y[11]); w1.z = pack2(y[12], y[13]); w1.w = pack2(y[14], y[15]);
        *(u32x4*)(p.H + (size_t)t * D + lane * 16) = w0; *(u32x4*)(p.H + (size_t)t * D + lane * 16 + 8) = w1;
      } else {
        const float* fg = p.final_g + lane * 16;
#pragma unroll
        for (int q = 0; q < 4; ++q) *(f32x4*)(xp + 4 * q) = (f32x4){xv[4 * q] * r * fg[4 * q], xv[4 * q + 1] * r * fg[4 * q + 1], xv[4 * q + 2] * r * fg[4 * q + 2], xv[4 * q + 3] * r * fg[4 * q + 3]};
      }
      asm volatile("" ::: "memory");
    }
    __syncthreads();
  }
}

template <bool WITH_GATES>
__device__ void phase_norm(const Params& p, const float* __restrict__ xin, const float* __restrict__ g, const float* __restrict__ modl, int sh_off, int sc_off, char* smem) {
  float* wg = (float*)smem;
  if (WITH_GATES) { __syncthreads(); for (int i = threadIdx.x; i < 16 * 1024; i += NTHREADS) wg[i] = p.Wg[i]; __syncthreads(); }
  for (int job = blockIdx.x; job < T / 32; job += gridDim.x) {
    int tid_ = threadIdx.x; asm volatile("" : "+v"(tid_));
    const int tid = tid_, wid = tid >> 6, lane = tid & 63; const int tb = job * 32 + wid * 4, b = tb / S;
    f32x4 v[4][4];
#pragma unroll
    for (int q = 0; q < 4; ++q)
#pragma unroll
      for (int i = 0; i < 4; ++i) v[q][i] = *(const f32x4*)(xin + (size_t)(tb + q) * D + i * 256 + lane * 4);
    const float* shp = modl + (size_t)b * 6144 + sh_off; const float* scp = modl + (size_t)b * 6144 + sc_off;
    f32x4 ga[4], gc[4];
#pragma unroll
    for (int i = 0; i < 4; ++i) { const int d = i * 256 + lane * 4; const f32x4 gg = *(const f32x4*)(g + d), s1 = *(const f32x4*)(scp + d); ga[i] = gg * (1.f + s1); gc[i] = *(const f32x4*)(shp + d); }
#pragma unroll
    for (int q = 0; q < 4; ++q) { float ss = 0.f;
#pragma unroll
      for (int i = 0; i < 4; ++i) ss += v[q][i].x * v[q][i].x + v[q][i].y * v[q][i].y + v[q][i].z * v[q][i].z + v[q][i].w * v[q][i].w;
      ss = wave_sum(ss); const float r = rsqrtf(ss * (1.f / D) + EPS);
#pragma unroll
      for (int i = 0; i < 4; ++i) { v[q][i] = v[q][i] * r * ga[i] + gc[i]; u32x2 w; w.x = pack2(v[q][i].x, v[q][i].y); w.y = pack2(v[q][i].z, v[q][i].w); *(u32x2*)(p.H + (size_t)(tb + q) * D + i * 256 + lane * 4) = w; }
      if (WITH_GATES) { float myg = 0.f;
#pragma unroll 2
        for (int gi = 0; gi < 16; ++gi) { float a = 0.f;
#pragma unroll
          for (int i = 0; i < 4; ++i) { const f32x4 w4 = *(const f32x4*)(wg + gi * 1024 + i * 256 + lane * 4); a += v[q][i].x * w4.x + v[q][i].y * w4.y + v[q][i].z * w4.z + v[q][i].w * w4.w; }
          a = wave_sum(a); if (lane == gi) myg = a; }
        if (lane < 16) p.gates[(size_t)(tb + q) * 16 + lane] = myg + p.ev_b_in[2560 + lane]; }
    }
  }
}
__device__ void phase_cat(const Params& p) {
  for (int job = blockIdx.x; job < T / 32; job += gridDim.x) {
    int tid_ = threadIdx.x; asm volatile("" : "+v"(tid_));
    const int tid = tid_, wid = tid >> 6, lane = tid & 63; const int tb = job * 32 + wid * 4;
    u32x4 a[4], bq[4], so[4];
#pragma unroll
    for (int q = 0; q < 4; ++q) { const size_t o = (size_t)(tb + q) * 512 + lane * 8; a[q] = *(const u32x4*)(p.HS + o); bq[q] = *(const u32x4*)(p.HS + (size_t)T * 512 + o); so[q] = *(const u32x4*)(p.ZO + o); }
    const f32x4 g0 = *(const f32x4*)(p.mnorm_g + lane * 8), g1 = *(const f32x4*)(p.mnorm_g + lane * 8 + 4);
#pragma unroll
    for (int q = 0; q < 4; ++q) { float x[8]; const u32 aw[4] = {a[q].x, a[q].y, a[q].z, a[q].w}, bw[4] = {bq[q].x, bq[q].y, bq[q].z, bq[q].w}, sw[4] = {so[q].x, so[q].y, so[q].z, so[q].w};
      float ss = 0.f;
#pragma unroll
      for (int j = 0; j < 4; ++j) { x[2 * j] = bflo(aw[j]) + bflo(bw[j]); x[2 * j + 1] = bfhi(aw[j]) + bfhi(bw[j]); ss += x[2 * j] * x[2 * j] + x[2 * j + 1] * x[2 * j + 1]; }
      ss += __shfl_xor(ss, 1); ss += __shfl_xor(ss, 2); ss += __shfl_xor(ss, 4); ss += __shfl_xor(ss, 8);
      const float r = rsqrtf(ss * (1.f / 128.f) + EPS);
      u32x4 w; w.x = pack2(x[0] * r * g0.x * bflo(sw[0]), x[1] * r * g0.y * bfhi(sw[0])); w.y = pack2(x[2] * r * g0.z * bflo(sw[1]), x[3] * r * g0.w * bfhi(sw[1]));
      w.z = pack2(x[4] * r * g1.x * bflo(sw[2]), x[5] * r * g1.y * bfhi(sw[2])); w.w = pack2(x[6] * r * g1.z * bflo(sw[3]), x[7] * r * g1.w * bfhi(sw[3]));
      *(u32x4*)(p.CAT + (size_t)(tb + q) * 1024 + lane * 8) = w; }
  }
}
__device__ void phase_qkrope(const Params& p, char* smem) {
  float* tab = (float*)smem;
  __syncthreads();
  for (int i = threadIdx.x; i < 64 * 32; i += NTHREADS) { const int pos = i >> 5, fi = i & 31; const float fr = exp2f(-(float)(2 * fi) * (13.287712379549449f / 64.f)); float sn, cs; sincosf((float)pos * fr, &sn, &cs); tab[2 * i] = cs; tab[2 * i + 1] = sn; }
  __syncthreads();
  for (int job = blockIdx.x; job < T / 16; job += gridDim.x) {
    int tid_ = threadIdx.x; asm volatile("" : "+v"(tid_));
    const int tid = tid_, wid = tid >> 6, lane = tid & 63; const int tb = job * 16 + wid * 2;
    u32x4 raw[2][3];
#pragma unroll
    for (int q = 0; q < 2; ++q)
#pragma unroll
      for (int i = 0; i < 3; ++i) raw[q][i] = *(const u32x4*)(p.QKV + (size_t)(tb + q) * 1536 + (lane + 64 * i) * 8);
#pragma unroll
    for (int q = 0; q < 2; ++q) { const int t = tb + q, b = t / S, s = t & (S - 1);
#pragma unroll
      for (int i = 0; i < 3; ++i) { const int c = lane + 64 * i, hh = c >> 4, cc = c & 15; float x[8]; const u32 rw[4] = {raw[q][i].x, raw[q][i].y, raw[q][i].z, raw[q][i].w};
#pragma unroll
        for (int j = 0; j < 4; ++j) { x[2 * j] = bflo(rw[j]); x[2 * j + 1] = bfhi(rw[j]); }
        u32x4 w;
        if (hh < 10) { float ss = 0.f;
#pragma unroll
          for (int j = 0; j < 8; ++j) ss += x[j] * x[j];
          ss += __shfl_xor(ss, 1); ss += __shfl_xor(ss, 2); ss += __shfl_xor(ss, 4); ss += __shfl_xor(ss, 8);
          const float r = rsqrtf(ss * (1.f / 128.f) + EPS); const float* gp = (hh < 8 ? p.qn_g : p.kn_g) + cc * 8;
          const int pos = cc < 8 ? (s >> 6) : (s & 63); const float* tp = tab + (pos * 32 + (cc & 7) * 4) * 2; float y[8];
#pragma unroll
          for (int j = 0; j < 4; ++j) { const float x0 = x[2 * j] * r * gp[2 * j], x1 = x[2 * j + 1] * r * gp[2 * j + 1], cs = tp[2 * j], sn = tp[2 * j + 1]; y[2 * j] = x0 * cs - x1 * sn; y[2 * j + 1] = x0 * sn + x1 * cs; }
          w.x = pack2(y[0], y[1]); w.y = pack2(y[2], y[3]); w.z = pack2(y[4], y[5]); w.w = pack2(y[6], y[7]);
        } else w = raw[q][i];
        bf16_t* dst = hh < 8 ? p.Qh + (((size_t)b * 8 + hh) * S + s) * 128 : (hh < 10 ? p.Kh + (((size_t)b * 2 + hh - 8) * S + s) * 128 : p.Vh + (((size_t)b * 2 + hh - 10) * S + s) * 128);
        *(u32x4*)(dst + cc * 8) = w; }
    }
  }
}

__device__ void phase_attn_naive(const Params& p) {
  const int tid = threadIdx.x, wid = tid >> 6, lane = tid & 63;
  for (int job = blockIdx.x; job < T * 2 / 8; job += gridDim.x) {
    const int w = job * 8 + wid, kv = w & 1, t = w >> 1, b = t / S, s = t & (S - 1);
    float q0[4], q1[4], m[4], l[4], o0[4], o1[4];
#pragma unroll
    for (int g = 0; g < 4; ++g) { const u32 qq = *(const u32*)(p.Qh + (((size_t)b * 8 + kv * 4 + g) * S + s) * 128 + lane * 2); q0[g] = bflo(qq); q1[g] = bfhi(qq); m[g] = -1e30f; l[g] = 0.f; o0[g] = 0.f; o1[g] = 0.f; }
    const bf16_t* Kb = p.Kh + ((size_t)b * 2 + kv) * S * 128; const bf16_t* Vb = p.Vh + ((size_t)b * 2 + kv) * S * 128;
    for (int k = 0; k < S; ++k) { const u32 kk = *(const u32*)(Kb + (size_t)k * 128 + lane * 2), vv = *(const u32*)(Vb + (size_t)k * 128 + lane * 2);
      const float k0 = bflo(kk), k1 = bfhi(kk), v0 = bflo(vv), v1 = bfhi(vv);
#pragma unroll
      for (int g = 0; g < 4; ++g) { const float sc = wave_sum(q0[g] * k0 + q1[g] * k1) * KSCALE; const float mn = fmaxf(m[g], sc), al = __expf(m[g] - mn), pw = __expf(sc - mn);
        l[g] = l[g] * al + pw; o0[g] = o0[g] * al + pw * v0; o1[g] = o1[g] * al + pw * v1; m[g] = mn; } }
#pragma unroll
    for (int g = 0; g < 4; ++g) *(u32*)(p.CAT + (size_t)t * 1024 + (kv * 4 + g) * 128 + lane * 2) = pack2(o0[g] / l[g], o1[g] / l[g]);
  }
}

namespace att {
using bf16 = unsigned short;
constexpr int   D = 128, NW = 8, QBLK = 32, KVBLK = 64;
constexpr float SCALE = 0.088388347648318440f;
constexpr float THR = 8.f;
constexpr int SDEPTH = 2;
constexpr int LDQ = 128, LDK = 128, LDO = 1024;
constexpr size_t SHM_V = KVBLK * D * 2, SHM_K = KVBLK * D * 2, SHM_ATTN = 2 * SHM_V + 2 * SHM_K + NW * 64 * 4;
using bf16x8 = __attribute__((ext_vector_type(8))) short;
using s16x4  = __attribute__((ext_vector_type(4))) short;
using f32x16 = __attribute__((ext_vector_type(16))) float;
using f32x8  = __attribute__((ext_vector_type(8))) float;
using u32x4  = __attribute__((ext_vector_type(4))) unsigned;
#define KSWZ(row, colB) ((row) * 256 + ((colB) ^ (((row) & 7) << 4)))
#define SBAR() __builtin_amdgcn_sched_barrier(0)
__device__ __forceinline__ int crow(int r, int hi) { return (r & 3) + 8 * (r >> 2) + 4 * hi; }
__device__ __forceinline__ unsigned cvtpk(float lo, float hi) {
  unsigned r; asm volatile("v_cvt_pk_bf16_f32 %0, %1, %2" : "=v"(r) : "v"(lo), "v"(hi)); return r;
}
template <typename TIn> struct Stage;
template <> struct Stage<bf16>  { using T = bf16x8;
  __device__ static __forceinline__ T ld8(const bf16* p) { return *reinterpret_cast<const bf16x8*>(p); }
  __device__ static __forceinline__ bf16x8 tobf(T x) { return x; } };
template <> struct Stage<float> { using T = f32x8;
  __device__ static __forceinline__ T ld8(const float* p) { return *reinterpret_cast<const f32x8*>(p); }
  __device__ static __forceinline__ bf16x8 tobf(T x) {
    u32x4 w = {cvtpk(x[0], x[1]), cvtpk(x[2], x[3]), cvtpk(x[4], x[5]), cvtpk(x[6], x[7])}; return *reinterpret_cast<bf16x8*>(&w); } };

__device__ __forceinline__ void partialSM(f32x16& p0, f32x16& p1, float& m_reg, float& mn, float& alpha) {
  constexpr float C = SCALE * 1.4426950408889634f;
  float pmax = p0[0]; for (int r = 1; r < 16; ++r) pmax = fmaxf(pmax, p0[r]); for (int r = 0; r < 16; ++r) pmax = fmaxf(pmax, p1[r]);
  { auto rr = __builtin_amdgcn_permlane32_swap(__float_as_uint(pmax), __float_as_uint(pmax), false, false);
    pmax = fmaxf(__uint_as_float(rr[0]), __uint_as_float(rr[1])); }
  if (__builtin_expect(__all(pmax - m_reg <= THR / SCALE), 1)) { mn = m_reg; alpha = 1.f; }
  else { mn = fmaxf(m_reg, pmax); alpha = __builtin_amdgcn_exp2f((m_reg - mn) * C); m_reg = mn; }
  float mnC = -mn * C;
  for (int r = 0; r < 16; ++r) p0[r] = fmaf(p0[r], C, mnC); for (int r = 0; r < 16; ++r) p1[r] = fmaf(p1[r], C, mnC);
  for (int r = 0; r < 16; ++r) p0[r] = __builtin_amdgcn_exp2f(p0[r]);
}
__device__ __forceinline__ void finishSM(f32x16& p0, f32x16& p1, float alpha, float& l_reg, bf16x8& pa0, bf16x8& pa1, bf16x8& pa2, bf16x8& pa3) {
  for (int r = 0; r < 16; ++r) p1[r] = __builtin_amdgcn_exp2f(p1[r]);
  float ps = 0; for (int r = 0; r < 16; ++r) ps += p0[r]; for (int r = 0; r < 16; ++r) ps += p1[r];
  { auto rr = __builtin_amdgcn_permlane32_swap(__float_as_uint(ps), __float_as_uint(ps), false, false);
    ps = __uint_as_float(rr[0]) + __uint_as_float(rr[1]); }
  l_reg = l_reg * alpha + ps;
#define PK4(P, BASE, OUT) do { unsigned a0 = cvtpk(P[BASE + 0], P[BASE + 1]), a1 = cvtpk(P[BASE + 2], P[BASE + 3]);   \
    unsigned b0 = cvtpk(P[BASE + 4], P[BASE + 5]), b1 = cvtpk(P[BASE + 6], P[BASE + 7]);                              \
    auto r0 = __builtin_amdgcn_permlane32_swap(a0, b0, false, false); auto r1 = __builtin_amdgcn_permlane32_swap(a1, b1, false, false); \
    u32x4 w = {r0[0], r1[0], r0[1], r1[1]}; OUT = *reinterpret_cast<bf16x8*>(&w); } while (0)
  PK4(p0, 0, pa0); PK4(p0, 8, pa1); PK4(p1, 0, pa2); PK4(p1, 8, pa3);
#undef PK4
}
__device__ __forceinline__ void qkt(f32x16& p0, f32x16& p1, const bf16* Ks, const bf16x8* qr, int r32, int hi) {
  p0 = f32x16{}; p1 = f32x16{};
  for (int d0 = 0; d0 < 8; ++d0) { int cb = (d0 * 16 + hi * 8) * 2;
    bf16x8 b0 = *reinterpret_cast<const bf16x8*>((const char*)Ks + KSWZ(r32, cb));
    bf16x8 b1 = *reinterpret_cast<const bf16x8*>((const char*)Ks + KSWZ(32 + r32, cb));
    p0 = __builtin_amdgcn_mfma_f32_32x32x16_bf16(b0, qr[d0], p0, 0, 0, 0);
    p1 = __builtin_amdgcn_mfma_f32_32x32x16_bf16(b1, qr[d0], p1, 0, 0, 0); }
}
__device__ __forceinline__ int v_st(int k, int c) { const int kk = (k & ~0xC) | ((k & 4) << 1) | ((k & 8) >> 1); return ((kk >> 3) * 4 + (c >> 5)) * 512 + ((kk & 7) * 32 + (c & 31)) * 2; }
__device__ __forceinline__ int v_rd_base(int lane) { return ((lane & 3) << 3) | (((lane >> 2) & 3) << 6) | (((lane >> 4) & 1) << 5) | (((lane >> 5) & 1) << 8); }
constexpr int v_rd_off(int d0, int ks, int half) { return d0 * 512 + ks * 4096 + half * 2048; }
template <int OFF> __device__ __forceinline__ s16x4 tr_read(int vb) {
  s16x4 r; asm volatile("ds_read_b64_tr_b16 %0, %1 offset:%2" : "=&v"(r) : "v"(vb), "i"(OFF) : "memory"); return r;
}
template <int D0> __device__ __forceinline__ void pv_one(f32x16& od, int vb, bf16x8 pa0, bf16x8 pa1, bf16x8 pa2, bf16x8 pa3) {
  const s16x4 l0 = tr_read<v_rd_off(D0, 0, 0)>(vb), h0 = tr_read<v_rd_off(D0, 0, 1)>(vb), l1 = tr_read<v_rd_off(D0, 1, 0)>(vb), h1 = tr_read<v_rd_off(D0, 1, 1)>(vb);
  const s16x4 l2 = tr_read<v_rd_off(D0, 2, 0)>(vb), h2 = tr_read<v_rd_off(D0, 2, 1)>(vb), l3 = tr_read<v_rd_off(D0, 3, 0)>(vb), h3 = tr_read<v_rd_off(D0, 3, 1)>(vb);
  asm volatile("s_waitcnt lgkmcnt(0)" ::: "memory"); SBAR();
#define PK(L, H) (bf16x8){L[0], L[1], L[2], L[3], H[0], H[1], H[2], H[3]}
  od = __builtin_amdgcn_mfma_f32_32x32x16_bf16(pa0, PK(l0, h0), od, 0, 0, 0);
  od = __builtin_amdgcn_mfma_f32_32x32x16_bf16(pa1, PK(l1, h1), od, 0, 0, 0);
  od = __builtin_amdgcn_mfma_f32_32x32x16_bf16(pa2, PK(l2, h2), od, 0, 0, 0);
  od = __builtin_amdgcn_mfma_f32_32x32x16_bf16(pa3, PK(l3, h3), od, 0, 0, 0);
#undef PK
}
__device__ __forceinline__ void pv_d0(f32x16* o, int vb, bf16x8 pa0, bf16x8 pa1, bf16x8 pa2, bf16x8 pa3) {
  pv_one<0>(o[0], vb, pa0, pa1, pa2, pa3); pv_one<1>(o[1], vb, pa0, pa1, pa2, pa3); pv_one<2>(o[2], vb, pa0, pa1, pa2, pa3); pv_one<3>(o[3], vb, pa0, pa1, pa2, pa3);
}

template <typename TQ>
__device__ __forceinline__ void attn_dense_body(const TQ* __restrict__ Qb, const bf16* __restrict__ Kh, const bf16* __restrict__ Vh,
                                                bf16* __restrict__ Ob, int seq, char* lds) {
  using St = Stage<bf16>; using SQ = Stage<TQ>;
  int tid_ = threadIdx.x; asm volatile("" : "+v"(tid_)); const int tid = tid_, wid = tid >> 6, lane = tid & 63, r32 = lane & 31, hi = lane >> 5;
  bf16* V_lds = (bf16*)lds; bf16* K_lds = (bf16*)(lds + 2 * SHM_V);
  float* ws = (float*)(lds + 2 * SHM_V + 2 * SHM_K) + wid * 64; float* li_l = ws; float* al_l = ws + 32;
  float m_reg = -1e30f, l_reg = 0; f32x16 o[4] = {}; bf16x8 qr[8];
  const TQ* Qw = Qb + (long)(wid * QBLK + r32) * LDQ + hi * 8;
#pragma unroll
  for (int d0 = 0; d0 < 8; ++d0) qr[d0] = SQ::tobf(SQ::ld8(Qw + d0 * 16));
  const int sr = tid >> 4, sc = (tid & 15) * 8, vst0 = v_st(sr, sc), vst1 = v_st(32 + sr, sc);
  const int vb0 = (int)(uintptr_t)V_lds + v_rd_base(lane);
  struct { typename St::T vs0, vs1, ks0, ks1; } sr_[SDEPTH];
#define SLOAD(i, k0) do { sr_[i].vs0 = St::ld8(&Vh[(long)((k0) + sr) * LDK + sc]); sr_[i].vs1 = St::ld8(&Vh[(long)((k0) + 32 + sr) * LDK + sc]); \
    sr_[i].ks0 = St::ld8(&Kh[(long)((k0) + sr) * LDK + sc]); sr_[i].ks1 = St::ld8(&Kh[(long)((k0) + 32 + sr) * LDK + sc]); } while (0)
#define SWRITE(b, i) do { *(bf16x8*)((char*)V_lds + (b) * SHM_V + vst0) = St::tobf(sr_[i].vs0);          \
    *(bf16x8*)((char*)V_lds + (b) * SHM_V + vst1) = St::tobf(sr_[i].vs1); int kc = sc * 2;               \
    *(bf16x8*)((char*)K_lds + (b) * SHM_K + KSWZ(sr, kc)) = St::tobf(sr_[i].ks0);                       \
    *(bf16x8*)((char*)K_lds + (b) * SHM_K + KSWZ(32 + sr, kc)) = St::tobf(sr_[i].ks1); } while (0)
#define SWAIT() do { if constexpr (SDEPTH == 2) asm volatile("s_waitcnt vmcnt(4)" ::: "memory"); else asm volatile("s_waitcnt vmcnt(0)" ::: "memory"); } while (0)
#define RESC(a) do { if (__any((a) < 1.f)) { if (hi == 0) al_l[r32] = (a); asm volatile("s_waitcnt lgkmcnt(0)" ::: "memory"); \
    for (int d = 0; d < 4; ++d) for (int r = 0; r < 16; ++r) o[d][r] *= al_l[crow(r, hi)]; } } while (0)
  f32x16 pA0, pA1, pB0, pB1; float mnA, mnB, alA, alB; bf16x8 pa0, pa1, pa2, pa3; const int NT = seq / KVBLK;
  constexpr int SE = 0, SO = SDEPTH - 1;
  SLOAD(SE, 0); asm volatile("s_waitcnt vmcnt(0)" ::: "memory"); SWRITE(0, SE); __syncthreads();
  qkt(pA0, pA1, K_lds, qr, r32, hi); partialSM(pA0, pA1, m_reg, mnA, alA);
  SLOAD(SO, KVBLK); if constexpr (SDEPTH == 2) { if (2 < NT) SLOAD(SE, 2 * KVBLK); }
  SWAIT(); SWRITE(1, SO); __syncthreads();
  for (int j = 1; j + 1 < NT; j += 2) {
    SBAR(); qkt(pB0, pB1, (bf16*)((char*)K_lds + SHM_K), qr, r32, hi);
    finishSM(pA0, pA1, alA, l_reg, pa0, pa1, pa2, pa3); SBAR();
    SLOAD(SO, (j + SDEPTH) * KVBLK); SBAR();
    pv_d0(o, vb0, pa0, pa1, pa2, pa3); partialSM(pB0, pB1, m_reg, mnB, alB);
    __syncthreads(); SWAIT(); SWRITE(0, SE);
    RESC(alB); __syncthreads();
    SBAR(); qkt(pA0, pA1, K_lds, qr, r32, hi);
    finishSM(pB0, pB1, alB, l_reg, pa0, pa1, pa2, pa3); SBAR();
    if (SDEPTH == 1 || j + 3 < NT) SLOAD(SE, (j + 1 + SDEPTH) * KVBLK); SBAR();
    pv_d0(o, vb0 + (int)SHM_V, pa0, pa1, pa2, pa3); partialSM(pA0, pA1, m_reg, mnA, alA);
    __syncthreads(); SWAIT(); SWRITE(1, SO);
    RESC(alA); __syncthreads();
  }
  SBAR(); qkt(pB0, pB1, (bf16*)((char*)K_lds + SHM_K), qr, r32, hi);
  finishSM(pA0, pA1, alA, l_reg, pa0, pa1, pa2, pa3); SBAR();
  pv_d0(o, vb0, pa0, pa1, pa2, pa3); partialSM(pB0, pB1, m_reg, mnB, alB);
  __syncthreads(); RESC(alB);
  finishSM(pB0, pB1, alB, l_reg, pa0, pa1, pa2, pa3); SBAR();
  pv_d0(o, vb0 + (int)SHM_V, pa0, pa1, pa2, pa3);
  if (hi == 0) li_l[r32] = l_reg; asm volatile("s_waitcnt lgkmcnt(0)" ::: "memory");
  float rli[16];
#pragma unroll
  for (int r = 0; r < 16; ++r) rli[r] = __builtin_amdgcn_rcpf(li_l[crow(r, hi)]);
  __syncthreads();
  bf16* Ol = (bf16*)lds + wid * (QBLK * D);
#pragma unroll
  for (int r = 0; r < 16; ++r) { const int orow = crow(r, hi);
#pragma unroll
    for (int d0 = 0; d0 < 4; ++d0) { const float v = o[d0][r] * rli[r]; unsigned u = __float_as_uint(v); u += 0x7FFFu + ((u >> 16) & 1u); Ol[orow * D + d0 * 32 + r32] = (bf16)(u >> 16); } }
  asm volatile("s_waitcnt lgkmcnt(0)" ::: "memory");
#pragma unroll
  for (int i = 0; i < 8; ++i) { const int row = i * 4 + (lane >> 4), ch = (lane & 15) * 8;
    const u32x4 v = *reinterpret_cast<const u32x4*>(Ol + row * D + ch);
    *reinterpret_cast<u32x4*>(Ob + (long)(wid * QBLK + row) * LDO + ch) = v; }
  __syncthreads();
#undef SLOAD
#undef SWRITE
#undef SWAIT
#undef RESC
}

}

__device__ void phase_attn(const Params& p, char* smem) {
  const int G = (int)gridDim.x, c = (int)blockIdx.x;
  for (int i = 0; i * G + c < 1024; ++i) {
    int pair, j;
    if (G == 256) { pair = 2 * (c & 7) + (i >> 1); j = (i & 1) * 32 + (c >> 3); } else { const int L = i * G + c; pair = L >> 6; j = L & 63; }
    const int b = pair >> 1, kv = pair & 1, qb = j >> 2, g = j & 3, h = kv * 4 + g;
    const bf16_t* Qb = p.Qh + (((size_t)b * 8 + h) * S + qb * 256) * 128; const bf16_t* Kp = p.Kh + ((size_t)b * 2 + kv) * S * 128; const bf16_t* Vp = p.Vh + ((size_t)b * 2 + kv) * S * 128;
    bf16_t* Ob = p.CAT + ((size_t)b * S + qb * 256) * 1024 + h * 128;
    att::attn_dense_body<att::bf16>(Qb, Kp, Vp, Ob, S, smem);
  }
}

#define XB_TMO      128
#define XB_XCNT(j)  (256  + 64 * (j))
#define XB_XSUB(j)  (1280 + 64 * (j))
#define XB_XGEN(j)  (2304 + 64 * (j))
#define XB_TOP      3328
#define XB_TOPGEN   3392
#define XCD_BAR_WORDS 3456
#define XB_SPIN_CAP (1u << 18)
#define LAS __attribute__((address_space(3)))

__device__ __forceinline__ unsigned xb_ld(unsigned* p)              { return __hip_atomic_load(p, __ATOMIC_RELAXED, __HIP_MEMORY_SCOPE_AGENT); }
__device__ __forceinline__ unsigned xb_add(unsigned* p, unsigned v) { return __hip_atomic_fetch_add(p, v, __ATOMIC_RELAXED, __HIP_MEMORY_SCOPE_AGENT); }
__device__ __forceinline__ unsigned xb_xcc_id() { return (unsigned)__builtin_amdgcn_s_getreg((3 << 11) | 20) & 0xFu; }
#define XB_SPIN(cond, bar) do { unsigned _sp = 0; while (cond) { __builtin_amdgcn_s_sleep(1); \
    if ((++_sp & 255u) == 0u) { if (xb_ld(&(bar)[XB_TMO])) break; if (_sp > XB_SPIN_CAP) { atomicAdd(&(bar)[XB_TMO], 1u); break; } } } } while (0)

struct XcdBarrier {
    unsigned* bar; unsigned x;
    volatile LAS unsigned* st;
};

__device__ __forceinline__ XcdBarrier xcd_barrier_post(unsigned* bar, volatile LAS unsigned* st) {
    XcdBarrier b; b.bar = bar; b.x = xb_xcc_id(); b.st = st;
    if (threadIdx.x == 0) (void)xb_add(&bar[XB_XCNT(b.x)], 1u);
    return b;
}
__device__ __forceinline__ void xcd_barrier_complete(unsigned* bar, unsigned x, unsigned& nloc, unsigned& nx) {
    const unsigned G = gridDim.x * gridDim.y * gridDim.z;
    unsigned sum, cnt, mine, sp = 0u;
    for (;;) {
        sum = 0u; cnt = 0u; mine = 0u;
#pragma unroll
        for (unsigned j = 0; j < 16; ++j) { const unsigned c = xb_ld(&bar[XB_XCNT(j)]); sum += c; cnt += (c > 0u) ? 1u : 0u; mine = (j == x) ? c : mine; }
        if (sum == G) break;
        __builtin_amdgcn_s_sleep(1);
        if ((++sp & 255u) == 0u) { if (xb_ld(&bar[XB_TMO])) break; if (sp > XB_SPIN_CAP) { atomicAdd(&bar[XB_TMO], 1u); break; } }
    }
    nloc = mine > 0u ? mine : 1u; nx = cnt > 0u ? cnt : 1u;
}

__device__ __forceinline__ void xcd_barrier(const XcdBarrier& b) {
    asm volatile("s_waitcnt vmcnt(0)" ::: "memory");
    __syncthreads();
    if (threadIdx.x == 0) {
        unsigned* bar = b.bar;
        __builtin_amdgcn_s_waitcnt(0);
        unsigned nloc = b.st[0], nx = b.st[1];
        if (nloc == 0u) { xcd_barrier_complete(bar, b.x, nloc, nx); b.st[0] = nloc; b.st[1] = nx; }
        const unsigned old = xb_add(&bar[XB_XSUB(b.x)], 1u);
        const unsigned gen = old / nloc;
        if (old + 1u == (gen + 1u) * nloc) {
            __builtin_amdgcn_fence(__ATOMIC_RELEASE, "agent");
            asm volatile("s_waitcnt vmcnt(0)" ::: "memory");
            const unsigned og = xb_add(&bar[XB_TOP], 1u);
            const unsigned tg = og / nx;
            if (og + 1u == (tg + 1u) * nx) xb_add(&bar[XB_TOPGEN], 1u);
            else XB_SPIN(xb_ld(&bar[XB_TOPGEN]) == tg, bar);
            __builtin_amdgcn_fence(__ATOMIC_ACQUIRE, "agent");
            xb_add(&bar[XB_XGEN(b.x)], 1u);
            asm volatile("s_waitcnt vmcnt(0)" ::: "memory");
        } else {
            XB_SPIN(xb_ld(&bar[XB_XGEN(b.x)]) == gen, bar);
            __builtin_amdgcn_fence(__ATOMIC_ACQUIRE, "agent");
            asm volatile("s_waitcnt vmcnt(0)" ::: "memory");
        }
    }
    __syncthreads();
}


constexpr int NPH = 19;
__global__ __launch_bounds__(NTHREADS, 2) void mega(Params p, int ph0, int ph1) {
  extern __shared__ __attribute__((aligned(16))) char smem[];
  cg::grid_group grid = cg::this_grid();
  volatile LAS unsigned* xst = (volatile LAS unsigned*)(LAS char*)(smem + SMEM_BYTES - 16);
  if (threadIdx.x == 0) { xst[0] = 0u; xst[1] = 0u; }
  __syncthreads();
  const XcdBarrier xb = xcd_barrier_post(p.bar, xst);
#ifndef REP_MASK
#define REP_MASK 0
#endif
#define GSYNC(k) do { if ((k) == 1) grid.sync(); else xcd_barrier(xb); } while (0)
#define PHASE(k, call) if (ph0 <= (k) && (k) < ph1) { if ((k) > ph0) GSYNC(k); if ((REP_MASK >> (k)) & 1) { { call; } xcd_barrier(xb); } call; }
#if !defined(ONLY_PHASE) || ONLY_PHASE == 0
  PHASE(0, phase_prep(p, smem))
#endif
#if !defined(ONLY_PHASE) || ONLY_PHASE == 1
  PHASE(1, phase_norm<true>(p, p.x, p.nmg, p.mod, 0, 1024, smem))
#endif
#if !defined(ONLY_PHASE) || ONLY_PHASE == 2
  PHASE(2, phase_gemm_fast(p.H, p.Wt_evin, T, 2560, 1024, (EpiEvin{p.ZQK, p.ZV, p.ZO, p.ZP, p.ev_b_in}), smem))
#endif
#if !defined(ONLY_PHASE) || ONLY_PHASE == 3
  PHASE(3, cp::phase_convpool(p, smem))
#endif
#if !defined(ONLY_PHASE) || ONLY_PHASE == 4
  PHASE(4, ml::phase_mlstm(p, smem))
#endif
#if !defined(ONLY_PHASE) || ONLY_PHASE == 5
  PHASE(5, phase_cat(p))
#endif
#if !defined(ONLY_PHASE) || ONLY_PHASE == 6
  PHASE(6, phase_gemm_fast(p.CAT, p.Wt_evout, T, 1024, 1024, (EpiRes{p.x, p.X, p.mod + 2048}), smem))
#endif
#if !defined(ONLY_PHASE) || ONLY_PHASE == 7
  PHASE(7, phase_norm<false>(p, p.X, p.nfg, p.mod, 3072, 4096, smem))
#endif
#if !defined(ONLY_PHASE) || ONLY_PHASE == 8
  PHASE(8, phase_gemm_fast(p.H, p.Wt_q, T, 2048, 1024, (EpiPlain{p.QP, 2048}), smem))
#endif
#if !defined(ONLY_PHASE) || ONLY_PHASE == 9
  PHASE(9, sel::phase_peer_select(p, 0, smem))
#endif
#if !defined(ONLY_PHASE) || ONLY_PHASE == 10
  PHASE(10, phase_peer_gather<0>(p, 0, smem))
#endif
#if !defined(ONLY_PHASE) || ONLY_PHASE == 11
  PHASE(11, phase_gemm_fast(p.H, p.Wt_odin, T, 1536, 1024, (EpiPlain{p.QKV, 1536}), smem))
#endif
#if !defined(ONLY_PHASE) || ONLY_PHASE == 12
  PHASE(12, phase_qkrope(p, smem))
#endif
#if !defined(ONLY_PHASE) || ONLY_PHASE == 13
  PHASE(13, phase_attn(p, smem))
#endif
#if !defined(ONLY_PHASE) || ONLY_PHASE == 14
  PHASE(14, phase_gemm_fast(p.CAT, p.Wt_odout, T, 1024, 1024, (EpiRes{p.X, p.X, p.mod + (size_t)8 * 6144 + 2048}), smem))
#endif
#if !defined(ONLY_PHASE) || ONLY_PHASE == 15
  PHASE(15, phase_norm<false>(p, p.X, p.nfg + D, p.mod + (size_t)8 * 6144, 3072, 4096, smem))
#endif
#if !defined(ONLY_PHASE) || ONLY_PHASE == 16
  PHASE(16, phase_gemm_fast(p.H, p.Wt_q + (size_t)2048 * 1024, T, 2048, 1024, (EpiPlain{p.QP, 2048}), smem))
#endif
#if !defined(ONLY_PHASE) || ONLY_PHASE == 17
  PHASE(17, sel::phase_peer_select(p, 1, smem))
#endif
#if !defined(ONLY_PHASE) || ONLY_PHASE == 18
  PHASE(18, phase_peer_gather<1>(p, 1, smem))
#endif
#undef PHASE
}
}

extern "C" void kernel_launch(void* const* d_in, const int* in_sizes, int n_in, void* d_out, int out_size, void* d_ws, size_t ws_size, hipStream_t stream) {
  (void)in_sizes; (void)n_in; (void)out_size;
  Params p{};
  const float** fin = (const float**)&p;
  for (int i = 0; i < 23; ++i) fin[i] = (const float*)d_in[i];
  p.X = (float*)d_out;
  char* ws = (char*)d_ws; size_t off = 0;
  auto alloc = [&](size_t bytes) { char* q = ws + off; off += (bytes + 255) / 256 * 256; return q; };
  p.U8 = (unsigned char*)alloc((size_t)2 * 16384 * 1024); p.V8 = (unsigned char*)alloc((size_t)2 * 16384 * 1024);
  p.Wt_evin = (bf16_t*)alloc((size_t)2560 * 1024 * 2); p.Wt_evout = (bf16_t*)alloc((size_t)1024 * 1024 * 2); p.Wt_odin = (bf16_t*)alloc((size_t)1536 * 1024 * 2);
  p.Wt_odout = (bf16_t*)alloc((size_t)1024 * 1024 * 2); p.Wt_q = (bf16_t*)alloc((size_t)2 * 2048 * 1024 * 2); p.keysb = (bf16_t*)alloc((size_t)2 * 2 * 128 * 128 * 2); p.poolWt = (bf16_t*)alloc((size_t)4 * 128 * 128 * 2);
  p.Wg = (float*)alloc(16 * 1024 * 4); p.mod = (float*)alloc(2 * 8 * 6144 * 4); p.gates = (float*)alloc((size_t)T * 16 * 4);
  p.pgate = (float*)alloc((size_t)T * 128 * 4); p.pidx = (bf16_t*)alloc((size_t)T * 128 * 2);
  p.H = (bf16_t*)alloc((size_t)T * 1024 * 2); p.CAT = p.H;
  char* big = alloc((size_t)T * 2048 * 2);
  p.ZQK = (bf16_t*)big; p.ZV = (bf16_t*)(big + (size_t)T * 1024 * 2); p.ZO = (bf16_t*)(big + (size_t)T * 1536 * 2); p.HS = (bf16_t*)big; p.QP = (bf16_t*)big; p.QKV = (bf16_t*)big;
  char* big2 = alloc((size_t)T * 1536 * 2);
  p.QK = (bf16_t*)big2; p.ZP = (bf16_t*)(big2 + (size_t)T * 1024 * 2); p.Qh = (bf16_t*)big2; p.Kh = (bf16_t*)(big2 + (size_t)T * 1024 * 2); p.Vh = (bf16_t*)(big2 + (size_t)T * 1280 * 2);
  p.bar = (unsigned*)alloc(XCD_BAR_WORDS * 4);
  if (off > ws_size) { fprintf(stderr, "kernel_launch: workspace too small: need %zu have %zu\n", off, ws_size); return; }

  static int grid_blocks = 0;
  if (!grid_blocks) {
    int dev = 0, cus = 0, per_cu = 0; hipGetDevice(&dev); hipDeviceGetAttribute(&cus, hipDeviceAttributeMultiprocessorCount, dev);
    hipFuncSetAttribute((const void*)mega, hipFuncAttributeMaxDynamicSharedMemorySize, SMEM_BYTES);
    hipOccupancyMaxActiveBlocksPerMultiprocessor(&per_cu, mega, NTHREADS, SMEM_BYTES);
    if (per_cu > 1) per_cu = 1;
    grid_blocks = cus * per_cu;
    if (grid_blocks <= 0) { fprintf(stderr, "kernel_launch: occupancy query returned 0\n"); grid_blocks = 0; return; }
  }
  hipMemsetAsync(p.bar, 0, XCD_BAR_WORDS * 4, stream);
#if MULTI_LAUNCH
  for (int ph = 0; ph < NPH; ++ph) hipLaunchKernelGGL(mega, dim3(grid_blocks), dim3(NTHREADS), SMEM_BYTES, stream, p, ph, ph + 1);
#else
  int ph0 = 0, ph1 = NPH; void* args[] = {&p, &ph0, &ph1};
  hipError_t e = hipLaunchCooperativeKernel((const void*)mega, dim3(grid_blocks), dim3(NTHREADS), args, SMEM_BYTES, stream);
  if (e != hipSuccess) fprintf(stderr, "cooperative launch failed: %s (grid %d)\n", hipGetErrorString(e), grid_blocks);
#endif
}
```

```cpp
#include <hip/hip_runtime.h>
#include <hip/hip_cooperative_groups.h>
#include <math.h>
#include <stdint.h>
#include <stdio.h>
namespace cg = cooperative_groups;

#ifndef MULTI_LAUNCH
#define MULTI_LAUNCH 0
#endif

namespace {
typedef unsigned short bf16_t;
typedef unsigned int u32;
typedef float f32x4 __attribute__((ext_vector_type(4)));
typedef u32 u32x4 __attribute__((ext_vector_type(4)));
typedef u32 u32x2 __attribute__((ext_vector_type(2)));
typedef __bf16 bf16x2_t __attribute__((ext_vector_type(2)));

constexpr int D = 1024, NB = 8, S = 4096, T = NB * S;
constexpr int EVEN_IN = 2576;
constexpr float EPS = 1e-6f;
constexpr int NTHREADS = 512;
constexpr int SMEM_BYTES = 160 * 1024;
constexpr float KSCALE = 0.08838834764831845f;

struct Params {
  const float *x, *c, *ada_w, *ada_b, *nmg, *nfg, *ev_w_in, *ev_b_in, *conv_w, *conv_b, *mnorm_g, *pool_w, *pool_sc, *ev_w_out, *od_w_in, *qn_g, *kn_g, *od_w_out,
      *peer_wq, *peer_keys, *peer_u, *peer_v, *final_g;
  float* X;
  bf16_t *Wt_evin, *Wt_evout, *Wt_odin, *Wt_odout, *Wt_q, *keysb, *poolWt; unsigned char *U8, *V8;
  float *Wg, *mod, *gates, *pgate;
  bf16_t *H, *ZQK, *ZV, *ZO, *ZP, *QK, *HS, *CAT, *QP, *QKV, *Qh, *Kh, *Vh;
  bf16_t* pidx;
  unsigned* bar;
};

__device__ __forceinline__ float siluf(float x) { return x / (1.f + __expf(-x)); }
__device__ __forceinline__ float sigmf(float x) { return 1.f / (1.f + __expf(-x)); }
__device__ __forceinline__ float wave_sum(float v) { for (int o = 32; o >= 1; o >>= 1) v += __shfl_xor(v, o); return v; }
__device__ __forceinline__ float wave_max(float v) { for (int o = 32; o >= 1; o >>= 1) v = fmaxf(v, __shfl_xor(v, o)); return v; }
__device__ __forceinline__ bf16_t f2bf(float f) { u32 u = __float_as_uint(f); u += 0x7FFFu + ((u >> 16) & 1u); return (bf16_t)(u >> 16); }
__device__ __forceinline__ float bf2f(bf16_t b) { return __uint_as_float(((u32)b) << 16); }
__device__ __forceinline__ u32 pack2(float lo, float hi) { return (u32)f2bf(lo) | ((u32)f2bf(hi) << 16); }
__device__ __forceinline__ float bflo(u32 w) { return __uint_as_float(w << 16); }
__device__ __forceinline__ float bfhi(u32 w) { return __uint_as_float(w & 0xFFFF0000u); }
__device__ __forceinline__ float dot2bf(u32 a, u32 b, float c) { return __builtin_amdgcn_fdot2_f32_bf16(__builtin_bit_cast(bf16x2_t, a), __builtin_bit_cast(bf16x2_t, b), c, false); }

constexpr int PJ_MOD = 192, PJ_TR = 2576, PJ_WG = 1, PJ_KEYS = 16, PJ_UV = 8192;
constexpr int PJ_TOTAL = PJ_MOD + PJ_TR + PJ_WG + PJ_KEYS + PJ_UV;

__device__ void prep_transpose_tile(const float* __restrict__ src, int ld, int k0, int n0, bf16_t* __restrict__ dst, int dstK, char* smem) {
  float* tile = (float*)smem;
  const int tid = threadIdx.x;
  __syncthreads();
  for (int pass = 0; pass < 8; ++pass) { int kk = pass * 8 + (tid >> 6), n = tid & 63; tile[kk * 65 + n] = src[(size_t)(k0 + kk) * ld + n0 + n]; }
  __syncthreads();
  int n = tid >> 3, kc = (tid & 7) * 8; u32x4 w;
  w.x = pack2(tile[(kc + 0) * 65 + n], tile[(kc + 1) * 65 + n]); w.y = pack2(tile[(kc + 2) * 65 + n], tile[(kc + 3) * 65 + n]);
  w.z = pack2(tile[(kc + 4) * 65 + n], tile[(kc + 5) * 65 + n]); w.w = pack2(tile[(kc + 6) * 65 + n], tile[(kc + 7) * 65 + n]);
  *(u32x4*)(dst + (size_t)(n0 + n) * dstK + k0 + kc) = w;
}

__device__ void phase_prep(const Params& p, char* smem) {
  const int tid = threadIdx.x;
  for (int job = blockIdx.x; job < PJ_TOTAL; job += gridDim.x) {
    if (job < PJ_MOD) {
      float* cs = (float*)smem; float* red = cs + 8192;
      __syncthreads();
      for (int i = tid; i < 8192; i += NTHREADS) cs[i] = siluf(p.c[i]);
      __syncthreads();
      const int l = job / 96, e0 = (job % 96) * 64, col = tid & 63, dg = tid >> 6;
      float acc[8];
#pragma unroll
      for (int b = 0; b < 8; ++b) acc[b] = 0.f;
      const float* w = p.ada_w + (size_t)l * D * 6144 + e0 + col;
      for (int d = dg * 128; d < dg * 128 + 128; ++d) { float wv = w[(size_t)d * 6144];
#pragma unroll
        for (int b = 0; b < 8; ++b) acc[b] += cs[b * 1024 + d] * wv; }
#pragma unroll
      for (int b = 0; b < 8; ++b) red[(dg * 8 + b) * 64 + col] = acc[b];
      __syncthreads();
      { const int b = tid >> 6; float s = 0.f;
#pragma unroll
        for (int g = 0; g < 8; ++g) s += red[(g * 8 + b) * 64 + col];
        p.mod[(size_t)(l * 8 + b) * 6144 + e0 + col] = s + p.ada_b[l * 6144 + e0 + col]; }
    } else if (job < PJ_MOD + PJ_TR) {
      int tt = job - PJ_MOD;
      if (tt < 640) prep_transpose_tile(p.ev_w_in, EVEN_IN, (tt / 40) * 64, (tt % 40) * 64, p.Wt_evin, 1024, smem);
      else if (tt < 896) { tt -= 640; prep_transpose_tile(p.ev_w_out, 1024, (tt / 16) * 64, (tt % 16) * 64, p.Wt_evout, 1024, smem); }
      else if (tt < 1280) { tt -= 896; prep_transpose_tile(p.od_w_in, 1536, (tt / 24) * 64, (tt % 24) * 64, p.Wt_odin, 1024, smem); }
      else if (tt < 1536) { tt -= 1280; prep_transpose_tile(p.od_w_out, 1024, (tt / 16) * 64, (tt % 16) * 64, p.Wt_odout, 1024, smem); }
      else if (tt < 2560) { tt -= 1536; int l = tt / 512; tt %= 512; prep_transpose_tile(p.peer_wq + (size_t)l * D * 2048, 2048, (tt / 32) * 64, (tt % 32) * 64, p.Wt_q + (size_t)l * 2048 * 1024, 1024, smem); }
      else { tt -= 2560; const int g = tt >> 2; prep_transpose_tile(p.pool_w + (size_t)g * 16384, 128, ((tt >> 1) & 1) * 64, (tt & 1) * 64, p.poolWt + (size_t)g * 16384, 128, smem); }
    } else if (job < PJ_MOD + PJ_TR + PJ_WG) {
      for (int i = tid; i < 16 * 1024; i += NTHREADS) { int g = i >> 10, d = i & 1023; p.Wg[i] = p.ev_w_in[(size_t)d * EVEN_IN + 2560 + g]; }
    } else if (job < PJ_MOD + PJ_TR + PJ_WG + PJ_KEYS) {
      int j = job - (PJ_MOD + PJ_TR + PJ_WG);
      for (int i = tid; i < 4096; i += NTHREADS) p.keysb[j * 4096 + i] = f2bf(p.peer_keys[j * 4096 + i]);
    } else {
      int j = job - (PJ_MOD + PJ_TR + PJ_WG + PJ_KEYS); const bool isu = j < 4096; const float* src = isu ? p.peer_u : p.peer_v; unsigned char* dst = isu ? p.U8 : p.V8; j &= 4095; const float sc = isu ? 32.f : 2.f;
      const size_t o = (size_t)j * 8192 + tid * 16; u32x4 w; u32 ww[4];
#pragma unroll
      for (int q = 0; q < 4; ++q) { const f32x4 a = *(const f32x4*)(src + o + 4 * q); int pk = __builtin_amdgcn_cvt_pk_fp8_f32(a.x * sc, a.y * sc, 0, false); pk = __builtin_amdgcn_cvt_pk_fp8_f32(a.z * sc, a.w * sc, pk, true); ww[q] = (u32)pk; }
      w.x = ww[0]; w.y = ww[1]; w.z = ww[2]; w.w = ww[3]; *(u32x4*)(dst + o) = w;
    }
  }
}

enum { EPI_EVIN = 0, EPI_EVOUT = 1, EPI_PEERQ = 2, EPI_ODIN = 3, EPI_ODOUT = 4 };
template <int EPI> __device__ __forceinline__ void epi_store(const Params& p, int layer, int m, int n, float acc) {
  if (EPI == EPI_EVIN) { float v = acc + p.ev_b_in[n];
    if (n < 1024) p.ZQK[(size_t)m * 1024 + n] = f2bf(v); else if (n < 1536) p.ZV[(size_t)m * 512 + n - 1024] = f2bf(v);
    else if (n < 2048) p.ZO[(size_t)m * 512 + n - 1536] = f2bf(sigmf(v)); else p.ZP[(size_t)m * 512 + n - 2048] = f2bf(v); }
  else if (EPI == EPI_EVOUT) { int b = m / S; p.X[(size_t)m * D + n] = p.x[(size_t)m * D + n] + p.mod[(size_t)(0 * 8 + b) * 6144 + 2048 + n] * acc; }
  else if (EPI == EPI_PEERQ) p.QP[(size_t)m * 2048 + n] = f2bf(acc);
  else if (EPI == EPI_ODIN) p.QKV[(size_t)m * 1536 + n] = f2bf(acc);
  else if (EPI == EPI_ODOUT) { int b = m / S; p.X[(size_t)m * D + n] += p.mod[(size_t)(1 * 8 + b) * 6144 + 2048 + n] * acc; }
}
template <int EPI> __device__ void phase_gemm_naive(const Params& p, int layer, const bf16_t* __restrict__ A, const bf16_t* __restrict__ Bt, int M, int N, int K, char* smem) {
  float* As = (float*)smem; float* Bs = As + 32 * 132;
  const int tid = threadIdx.x, tx = tid & 15, ty = tid >> 4; const int nN = N / 64, njobs = (M / 128) * nN;
  for (int job = blockIdx.x; job < njobs; job += gridDim.x) {
    const int m0 = (job / nN) * 128, n0 = (job % nN) * 64; float acc[4][4];
#pragma unroll
    for (int i = 0; i < 4; ++i)
#pragma unroll
      for (int j = 0; j < 4; ++j) acc[i][j] = 0.f;
    for (int k0 = 0; k0 < K; k0 += 32) {
      __syncthreads();
      { int row = tid >> 2, kc = (tid & 3) * 8; u32x4 w = *(const u32x4*)(A + (size_t)(m0 + row) * K + k0 + kc);
        As[(kc + 0) * 132 + row] = bflo(w.x); As[(kc + 1) * 132 + row] = bfhi(w.x); As[(kc + 2) * 132 + row] = bflo(w.y); As[(kc + 3) * 132 + row] = bfhi(w.y);
        As[(kc + 4) * 132 + row] = bflo(w.z); As[(kc + 5) * 132 + row] = bfhi(w.z); As[(kc + 6) * 132 + row] = bflo(w.w); As[(kc + 7) * 132 + row] = bfhi(w.w); }
      if (tid < 256) { int row = tid >> 2, kc = (tid & 3) * 8; u32x4 w = *(const u32x4*)(Bt + (size_t)(n0 + row) * K + k0 + kc);
        Bs[(kc + 0) * 68 + row] = bflo(w.x); Bs[(kc + 1) * 68 + row] = bfhi(w.x); Bs[(kc + 2) * 68 + row] = bflo(w.y); Bs[(kc + 3) * 68 + row] = bfhi(w.y);
        Bs[(kc + 4) * 68 + row] = bflo(w.z); Bs[(kc + 5) * 68 + row] = bfhi(w.z); Bs[(kc + 6) * 68 + row] = bflo(w.w); Bs[(kc + 7) * 68 + row] = bfhi(w.w); }
      __syncthreads();
#pragma unroll 8
      for (int kk = 0; kk < 32; ++kk) { f32x4 a = *(const f32x4*)(As + kk * 132 + ty * 4), b = *(const f32x4*)(Bs + kk * 68 + tx * 4);
        acc[0][0] += a.x * b.x; acc[0][1] += a.x * b.y; acc[0][2] += a.x * b.z; acc[0][3] += a.x * b.w;
        acc[1][0] += a.y * b.x; acc[1][1] += a.y * b.y; acc[1][2] += a.y * b.z; acc[1][3] += a.y * b.w;
        acc[2][0] += a.z * b.x; acc[2][1] += a.z * b.y; acc[2][2] += a.z * b.z; acc[2][3] += a.z * b.w;
        acc[3][0] += a.w * b.x; acc[3][1] += a.w * b.y; acc[3][2] += a.w * b.z; acc[3][3] += a.w * b.w; }
    }
#pragma unroll
    for (int i = 0; i < 4; ++i)
#pragma unroll
      for (int j = 0; j < 4; ++j) epi_store<EPI>(p, layer, m0 + ty * 4 + i, n0 + tx * 4 + j, acc[i][j]);
  }
}

namespace pg8 {
#define PG8_LAS __attribute__((address_space(3)))
typedef unsigned short bf16_t;
typedef short bf16x8 __attribute__((ext_vector_type(8)));
typedef float f32x4 __attribute__((ext_vector_type(4)));
typedef unsigned u32x4 __attribute__((ext_vector_type(4)));
constexpr int BM = 256, BK = 64, HALF = 128, HTB = HALF * BK * 2  , STAGE_BYTES = 8 * HTB, NXCD = 8, WGM = 8;

__host__ __device__ __forceinline__ int lds_byte(int r, int c) { const int st = (r >> 4) * 2 + (c >> 5), rr = r & 15, cc = c & 31, ob = rr * 64 + cc * 2; return st * 1024 + (ob ^ (((ob >> 9) & 1) << 5)); }
__host__ __device__ __forceinline__ void stage_rc(int b, int& R, int& C) { const int st = b / 1024, sb = b % 1024, swz = sb ^ (((sb >> 9) & 1) << 5); R = (st >> 1) * 16 + swz / 64; C = (st & 1) * 32 + (swz % 64) / 2; }
__host__ __device__ __forceinline__ int perm32(int rho) { const int n = rho >> 4, i = rho & 15; return 8 * (i >> 2) + 4 * n + (i & 3); }

struct Unit { int pm, pn; };
struct Gemm { const bf16_t* A; const bf16_t* Bt; int M, N, K; };

struct StaticOrder {
    int nM, nN, nwg, G, c;
    __host__ __device__ void init(int M, int N, int G_, int c_) { nM = M / BM; nN = N / BM; nwg = nM * nN; G = G_; c = c_; }
    __host__ __device__ bool next(int i, Unit& u) const {
        const long L = (long)i * G + c; if (L >= nwg) return false;
        int wgid = (int)L; { const int q = nwg / NXCD, r = nwg % NXCD, xcd = wgid % NXCD, off = wgid / NXCD; wgid = (xcd < r ? xcd * (q + 1) : r * (q + 1) + (xcd - r) * q) + off; }
        const int nig = WGM * nN, gid = wgid / nig, fm = gid * WGM, gsz = (nM - fm) < WGM ? (nM - fm) : WGM;
        u.pm = fm + ((wgid % nig) % gsz); u.pn = (wgid % nig) / gsz; return true;
    }
    __device__ __forceinline__ void a_ready(const Unit&) const {}
    __device__ __forceinline__ void done(const Unit&) const {}
};
__device__ __forceinline__ unsigned cvt_pk_bf16(float lo, float hi) { unsigned r; asm volatile("v_cvt_pk_bf16_f32 %0, %1, %2" : "=v"(r) : "v"(lo), "v"(hi)); return r; }
template <class Epi, class Sched, bool STAMP = false>
__device__ __forceinline__ void gemm_phase(PG8_LAS unsigned char* lds, const Gemm g, const Sched& S, const Epi& E, unsigned long long* stamps) {
    const int tid = threadIdx.x, wid = __builtin_amdgcn_readfirstlane(tid >> 6), lane = tid & 63, wr = wid >> 2, wc = wid & 3, fr = lane & 15, fq = lane >> 4;
    const int K = g.K, nt = K / BK;
    int ts_lo = 0, ts_hi = 0, nts = 0; const unsigned long long rt_entry = STAMP ? (unsigned long long)wall_clock64() : 0ull;
#define PG8_STAMP() do { if (STAMP && wid == 0 && nts < 64) { const unsigned long long _c = (unsigned long long)clock64(); \
        ts_lo = (lane == nts) ? (int)(unsigned)_c : ts_lo; ts_hi = (lane == nts) ? (int)(unsigned)(_c >> 32) : ts_hi; ++nts; } } while (0)
    PG8_STAMP();
    unsigned voffA[2], voffB[2];
#pragma unroll
    for (int i = 0; i < 2; ++i) { int R, C; stage_rc(tid * 16 + i * 8192, R, C); const int Rb = Epi::PERM ? ((R & ~31) + perm32(R & 31)) : R;
        voffA[i] = (unsigned)(R * K + C) * 2u; voffB[i] = (unsigned)(Rb * K + C) * 2u; }
    const size_t kstep = (size_t)(BK * 2);
    const size_t hstep = (size_t)HALF * K * 2;
    const size_t tstep = 2 * hstep;
    const unsigned ldsw = (unsigned)wid * 1024u;
    const int aoff = lds_byte(wr * 64 + fr, fq * 8), boff = lds_byte(wc * 32 + fr, fq * 8);
#define PG8_SA(b, h) (((b) * 2 + (h)) * HTB)
#define PG8_SB(b, h) ((4 + (b) * 2 + (h)) * HTB)
#define PG8_STAGE(bufoff, gbase, voff) do { _Pragma("unroll") for (int _i = 0; _i < 2; ++_i) \
        __builtin_amdgcn_global_load_lds((const unsigned*)((const char*)(gbase) + (voff)[_i]), (PG8_LAS unsigned*)(lds + (bufoff) + ldsw + _i * 8192), 16, 0, 0); } while (0)
#define PG8_LDA(dst, b, h) do { _Pragma("unroll") for (int m = 0; m < 4; ++m) _Pragma("unroll") for (int k = 0; k < 2; ++k) dst[m][k] = *(const PG8_LAS bf16x8*)(lds + PG8_SA(b, h) + aoff + m * 2048 + k * 1024); } while (0)
#define PG8_LDB(dst, b, h) do { _Pragma("unroll") for (int n = 0; n < 2; ++n) _Pragma("unroll") for (int k = 0; k < 2; ++k) dst[n][k] = *(const PG8_LAS bf16x8*)(lds + PG8_SB(b, h) + boff + n * 2048 + k * 1024); } while (0)
#define PG8_MMA(ai, bj, At, Bt) do { __builtin_amdgcn_s_setprio(1); _Pragma("unroll") for (int m = 0; m < 4; ++m) _Pragma("unroll") for (int n = 0; n < 2; ++n) _Pragma("unroll") for (int k = 0; k < 2; ++k) \
        acc[ai][bj][m][n] = __builtin_amdgcn_mfma_f32_16x16x32_bf16(Bt[n][k], At[m][k], acc[ai][bj][m][n], 0, 0, 0); __builtin_amdgcn_s_setprio(0); } while (0)
#define PG8_WAIT_V(n) asm volatile("s_waitcnt vmcnt(" #n ")" ::: "memory")
#define PG8_WAIT_L(n) asm volatile("s_waitcnt lgkmcnt(" #n ")" ::: "memory")
#define PG8_BAR __builtin_amdgcn_s_barrier()
#define PG8_SCHED __builtin_amdgcn_sched_barrier(0)
    Unit cur, nxt; int ui = 0;
    if (!S.next(0, cur)) return;
    f32x4 acc[2][2][4][2];
#pragma unroll
    for (int a = 0; a < 2; ++a)
#pragma unroll
        for (int b = 0; b < 2; ++b)
#pragma unroll
            for (int m = 0; m < 4; ++m)
#pragma unroll
                for (int n = 0; n < 2; ++n) acc[a][b][m][n] = (f32x4){0.f, 0.f, 0.f, 0.f};
    bf16x8 At[4][2], B0[2][2], B1[2][2];
    const char* cA = (const char*)g.A + (size_t)cur.pm * tstep; const char* cB = (const char*)g.Bt + (size_t)cur.pn * tstep;
    S.a_ready(cur);
    PG8_STAGE(PG8_SB(0, 0), cB, voffB); PG8_STAGE(PG8_SA(0, 0), cA, voffA); PG8_STAGE(PG8_SB(0, 1), cB + hstep, voffB); PG8_STAGE(PG8_SA(0, 1), cA + hstep, voffA);
    if (wr == 1) PG8_BAR;
    PG8_WAIT_V(4); PG8_BAR;
    PG8_STAGE(PG8_SB(1, 0), cB + kstep, voffB); PG8_STAGE(PG8_SA(1, 0), cA + kstep, voffA); PG8_STAGE(PG8_SB(1, 1), cB + hstep + kstep, voffB);
    PG8_WAIT_V(6); PG8_BAR;
    PG8_STAMP();
    for (;;) {
        const bool has_next = S.next(ui + 1, nxt);
        const char* nA = has_next ? (const char*)g.A + (size_t)nxt.pm * tstep : cA; const char* nB = has_next ? (const char*)g.Bt + (size_t)nxt.pn * tstep : cB;
        for (int t = 0; t < nt; t += 2) {
            const bool last = (t == nt - 2);
            const char* a1 = cA + (size_t)(t + 1) * kstep;
            const char* a2 = last ? nA : cA + (size_t)(t + 2) * kstep; const char* b2 = last ? nB : cB + (size_t)(t + 2) * kstep;
            const char* a3 = a2 + kstep; const char* b3 = b2 + kstep;
            if (last && has_next) S.a_ready(nxt);
            PG8_LDB(B0, 0, 0); PG8_SCHED; PG8_LDA(At, 0, 0); PG8_STAGE(PG8_SA(1, 1), a1 + hstep, voffA);
            PG8_WAIT_L(8); PG8_BAR; PG8_WAIT_L(0); PG8_MMA(0, 0, At, B0); PG8_BAR; PG8_SCHED;
            PG8_LDB(B1, 0, 1); PG8_STAGE(PG8_SB(0, 0), b2, voffB);
            PG8_BAR; PG8_WAIT_L(0); PG8_MMA(0, 1, At, B1); PG8_BAR;
            PG8_LDA(At, 0, 1); PG8_STAGE(PG8_SA(0, 0), a2, voffA);
            PG8_BAR; PG8_WAIT_L(0); PG8_MMA(1, 0, At, B0); PG8_BAR; PG8_SCHED;
            PG8_STAGE(PG8_SB(0, 1), b2 + hstep, voffB);
            PG8_WAIT_V(6); PG8_BAR; PG8_MMA(1, 1, At, B1); PG8_BAR;
            PG8_LDB(B0, 1, 0); PG8_SCHED; PG8_LDA(At, 1, 0); PG8_STAGE(PG8_SA(0, 1), a2 + hstep, voffA);
            PG8_WAIT_L(8); PG8_BAR; PG8_WAIT_L(0); PG8_MMA(0, 0, At, B0); PG8_BAR; PG8_SCHED;
            PG8_LDB(B1, 1, 1); PG8_STAGE(PG8_SB(1, 0), b3, voffB);
            PG8_BAR; PG8_WAIT_L(0); PG8_MMA(0, 1, At, B1); PG8_BAR;
            PG8_LDA(At, 1, 1); PG8_STAGE(PG8_SA(1, 0), a3, voffA);
            PG8_BAR; PG8_WAIT_L(0); PG8_MMA(1, 0, At, B0); PG8_BAR; PG8_SCHED;
            PG8_STAGE(PG8_SB(1, 1), b3 + hstep, voffB);
            PG8_WAIT_V(6); PG8_BAR; PG8_MMA(1, 1, At, B1); PG8_BAR;
        }
        PG8_STAMP();
        if constexpr (!Epi::AFTER_DRAIN) { E(acc, cur, wr, wc, fr, fq); S.done(cur); }
        PG8_STAMP();
        if (!has_next) break;
#pragma unroll
        for (int a = 0; a < 2; ++a)
#pragma unroll
            for (int b = 0; b < 2; ++b)
#pragma unroll
                for (int m = 0; m < 4; ++m)
#pragma unroll
                    for (int n = 0; n < 2; ++n) acc[a][b][m][n] = (f32x4){0.f, 0.f, 0.f, 0.f};
        cur = nxt; cA = nA; cB = nB; ++ui;
    }
    PG8_WAIT_V(0);
    if (wr == 0) PG8_BAR;
    PG8_BAR;
    if constexpr (Epi::AFTER_DRAIN) { E.fused(acc, cur, wr, wc, fr, fq, lds, wid, lane); S.done(cur); }
    PG8_STAMP();
    if (STAMP && wid == 0) { stamps[lane] = lane < nts ? (((unsigned long long)(unsigned)ts_hi << 32) | (unsigned)ts_lo) : 0ull;
        if (lane == 62) stamps[62] = rt_entry; if (lane == 63) stamps[63] = (unsigned long long)wall_clock64(); }
#undef PG8_STAMP
#undef PG8_SA
#undef PG8_SB
#undef PG8_STAGE
#undef PG8_LDA
#undef PG8_LDB
#undef PG8_MMA
#undef PG8_WAIT_V
#undef PG8_WAIT_L
#undef PG8_BAR
#undef PG8_SCHED
}
}

struct EpiEvin {
  static constexpr bool PERM = true, AFTER_DRAIN = false;
  bf16_t *ZQK, *ZV, *ZO, *ZP; const float* bias;
  __device__ __forceinline__ void operator()(const pg8::f32x4 (&acc)[2][2][4][2], const pg8::Unit& u, int wr, int wc, int fr, int fq) const {
    const int row0 = u.pm * 256 + wr * 64 + fr, ct = u.pn * 256;
    bf16_t* base; int ldc, cl; bool sig = false;
    if (ct < 1024) { base = ZQK; ldc = 1024; cl = ct; } else if (ct < 1536) { base = ZV; ldc = 512; cl = ct - 1024; } else if (ct < 2048) { base = ZO; ldc = 512; cl = ct - 1536; sig = true; } else { base = ZP; ldc = 512; cl = ct - 2048; }
    const int cofs = wc * 32 + 8 * fq;
    pg8::f32x4 bv[2][2];
#pragma unroll
    for (int bj = 0; bj < 2; ++bj)
#pragma unroll
      for (int n = 0; n < 2; ++n) bv[bj][n] = *(const pg8::f32x4*)(bias + ct + cofs + bj * 128 + 4 * n);
#pragma unroll
    for (int ai = 0; ai < 2; ++ai)
#pragma unroll
      for (int m = 0; m < 4; ++m) { bf16_t* rowp = base + (size_t)(row0 + ai * 128 + m * 16) * ldc + cl + cofs;
#pragma unroll
        for (int bj = 0; bj < 2; ++bj) { pg8::f32x4 v0 = acc[ai][bj][m][0] + bv[bj][0], v1 = acc[ai][bj][m][1] + bv[bj][1];
          if (sig) {
#pragma unroll
            for (int j = 0; j < 4; ++j) { v0[j] = sigmf(v0[j]); v1[j] = sigmf(v1[j]); } }
          pg8::u32x4 w; w.x = pg8::cvt_pk_bf16(v0[0], v0[1]); w.y = pg8::cvt_pk_bf16(v0[2], v0[3]); w.z = pg8::cvt_pk_bf16(v1[0], v1[1]); w.w = pg8::cvt_pk_bf16(v1[2], v1[3]);
          *(pg8::u32x4*)(rowp + bj * 128) = w; } }
  }
};
struct EpiPlain {
  static constexpr bool PERM = true, AFTER_DRAIN = false;
  bf16_t* out; int ldc;
  __device__ __forceinline__ void operator()(const pg8::f32x4 (&acc)[2][2][4][2], const pg8::Unit& u, int wr, int wc, int fr, int fq) const {
    const int row0 = u.pm * 256 + wr * 64 + fr, col0 = u.pn * 256 + wc * 32 + 8 * fq;
#pragma unroll
    for (int ai = 0; ai < 2; ++ai)
#pragma unroll
      for (int m = 0; m < 4; ++m) { bf16_t* rowp = out + (size_t)(row0 + ai * 128 + m * 16) * ldc + col0;
#pragma unroll
        for (int bj = 0; bj < 2; ++bj) { const pg8::f32x4 v0 = acc[ai][bj][m][0], v1 = acc[ai][bj][m][1];
          pg8::u32x4 w; w.x = pg8::cvt_pk_bf16(v0[0], v0[1]); w.y = pg8::cvt_pk_bf16(v0[2], v0[3]); w.z = pg8::cvt_pk_bf16(v1[0], v1[1]); w.w = pg8::cvt_pk_bf16(v1[2], v1[3]);
          *(pg8::u32x4*)(rowp + bj * 128) = w; } }
  }
};
struct EpiRes {
  static constexpr bool PERM = false, AFTER_DRAIN = false;
  const float* xin; float* X; const float* gate;
  __device__ __forceinline__ void operator()(const pg8::f32x4 (&acc)[2][2][4][2], const pg8::Unit& u, int wr, int wc, int fr, int fq) const {
    const int row0 = u.pm * 256 + wr * 64 + fr, col0 = u.pn * 256 + wc * 32 + 4 * fq; const float* gb = gate + (size_t)((u.pm * 256) / S) * 6144;
    pg8::f32x4 gv[2][2];
#pragma unroll
    for (int bj = 0; bj < 2; ++bj)
#pragma unroll
      for (int n = 0; n < 2; ++n) gv[bj][n] = *(const pg8::f32x4*)(gb + col0 + bj * 128 + n * 16);
#pragma unroll
    for (int ai = 0; ai < 2; ++ai)
#pragma unroll
      for (int m = 0; m < 4; ++m) { const size_t off = (size_t)(row0 + ai * 128 + m * 16) * 1024 + col0;
#pragma unroll
        for (int bj = 0; bj < 2; ++bj)
#pragma unroll
          for (int n = 0; n < 2; ++n) { const pg8::f32x4 xi = *(const pg8::f32x4*)(xin + off + bj * 128 + n * 16); *(pg8::f32x4*)(X + off + bj * 128 + n * 16) = xi + gv[bj][n] * acc[ai][bj][m][n]; }
        asm volatile("" ::: "memory"); }
  }
};
template <class Epi> __device__ __forceinline__ void phase_gemm_fast(const bf16_t* A, const bf16_t* Bt, int M, int N, int K, const Epi& E, char* smem) {
  pg8::Gemm g; g.A = A; g.Bt = Bt; g.M = M; g.N = N; g.K = K;
  pg8::StaticOrder So; So.init(M, N, (int)gridDim.x, (int)blockIdx.x);
  pg8::gemm_phase<Epi, pg8::StaticOrder, false>((PG8_LAS unsigned char*)smem, g, So, E, nullptr);
}

namespace cp {
typedef short bf16x8 __attribute__((ext_vector_type(8)));
typedef float f32x16 __attribute__((ext_vector_type(16)));
constexpr int RS = 272;
__device__ __forceinline__ void unpack8(const u32x4 w, float* f) { f[0] = bflo(w.x); f[1] = bfhi(w.x); f[2] = bflo(w.y); f[3] = bfhi(w.y); f[4] = bflo(w.z); f[5] = bfhi(w.z); f[6] = bflo(w.w); f[7] = bfhi(w.w); }
__device__ void phase_convpool(const Params& p, char* smem) {
  for (int job = blockIdx.x; job < T / 64; job += gridDim.x) {
    int tid_ = threadIdx.x; asm volatile("" : "+v"(tid_));
    const int tid = tid_, c0 = (tid & 127) * 8, t0 = job * 64 + (tid >> 7) * 16, s0 = t0 & (S - 1);
    float cw[5][8], cb[8];
#pragma unroll
    for (int j = 0; j < 5; ++j) { const f32x4 a = *(const f32x4*)(p.conv_w + j * 1024 + c0), b = *(const f32x4*)(p.conv_w + j * 1024 + c0 + 4); cw[j][0] = a.x; cw[j][1] = a.y; cw[j][2] = a.z; cw[j][3] = a.w; cw[j][4] = b.x; cw[j][5] = b.y; cw[j][6] = b.z; cw[j][7] = b.w; }
    { const f32x4 a = *(const f32x4*)(p.conv_b + c0), b = *(const f32x4*)(p.conv_b + c0 + 4); cb[0] = a.x; cb[1] = a.y; cb[2] = a.z; cb[3] = a.w; cb[4] = b.x; cb[5] = b.y; cb[6] = b.z; cb[7] = b.w; }
    const float sc = c0 >= 512 ? KSCALE : 1.f;
    float win[5][8];
#pragma unroll
    for (int j = 0; j < 4; ++j) { const int ss = s0 + j - 2; u32x4 w = (u32x4){0u, 0u, 0u, 0u}; if (ss >= 0 && ss < S) w = *(const u32x4*)(p.ZQK + (size_t)(t0 + j - 2) * 1024 + c0); unpack8(w, win[j + 1]); }
#pragma unroll
    for (int i = 0; i < 16; ++i) {
#pragma unroll
      for (int j = 0; j < 4; ++j)
#pragma unroll
        for (int q = 0; q < 8; ++q) win[j][q] = win[j + 1][q];
      { const int ss = s0 + i + 2; u32x4 w = (u32x4){0u, 0u, 0u, 0u}; if (ss < S) w = *(const u32x4*)(p.ZQK + (size_t)(t0 + i + 2) * 1024 + c0); unpack8(w, win[4]); }
      float a[8];
#pragma unroll
      for (int q = 0; q < 8; ++q) { float v = cb[q];
#pragma unroll
        for (int j = 0; j < 5; ++j) v += cw[j][q] * win[j][q];
        a[q] = siluf(v) * sc; }
      u32x4 o; o.x = pack2(a[0], a[1]); o.y = pack2(a[2], a[3]); o.z = pack2(a[4], a[5]); o.w = pack2(a[6], a[7]); *(u32x4*)(p.QK + (size_t)(t0 + i) * 1024 + c0) = o;
    }
  }
  for (int job = blockIdx.x; job < (T / 128) * 4; job += gridDim.x) {
    int tid_ = threadIdx.x; asm volatile("" : "+v"(tid_));
    const int tid = tid_, wid = tid >> 6, lane = tid & 63, l31 = lane & 31, hh = lane >> 5;
    const int g = (job + (job >> 8)) & 3, t0 = (job >> 2) * 128, win = 2 << g, hw = win >> 1;
    __syncthreads();
#pragma unroll
    for (int i = 0; i < 4; ++i) { const int idx = tid + i * NTHREADS, row = idx >> 4, ch = idx & 15; *(u32x4*)(smem + 128 * RS + row * RS + ch * 16) = *(const u32x4*)(p.poolWt + (size_t)g * 16384 + row * 128 + ch * 8); }
#pragma unroll 1
    for (int i = 0; i < 4; ++i) { const int idx = tid + i * NTHREADS, row = idx >> 4, ch = idx & 15, t = t0 + row, s = t & (S - 1); const int lo = max(s - hw, 0), hi = min(s + hw, S);
      float sum[8], own[8];
#pragma unroll
      for (int q = 0; q < 8; ++q) sum[q] = 0.f;
      const bf16_t* base = p.ZP + (size_t)(t - s) * 512 + g * 128 + ch * 8;
      u32x4 rw[16];
#pragma unroll
      for (int r = 0; r < 16; ++r) { rw[r] = (u32x4){0u, 0u, 0u, 0u}; if (r < win) { const int rr = s - hw + r; if (rr >= 0 && rr < S) rw[r] = *(const u32x4*)(base + (size_t)rr * 512); } }
#pragma unroll
      for (int r = 0; r < 16; ++r) if (r < win) { float f[8]; unpack8(rw[r], f);
#pragma unroll
        for (int q = 0; q < 8; ++q) sum[q] += f[q]; }
      unpack8(*(const u32x4*)(base + (size_t)s * 512), own); const float inv = 1.f / (float)(hi - lo);
      u32x4 o; o.x = pack2(sum[0] * inv - own[0], sum[1] * inv - own[1]); o.y = pack2(sum[2] * inv - own[2], sum[3] * inv - own[3]); o.z = pack2(sum[4] * inv - own[4], sum[5] * inv - own[5]); o.w = pack2(sum[6] * inv - own[6], sum[7] * inv - own[7]);
      *(u32x4*)(smem + row * RS + ch * 16) = o; }
    __syncthreads();
    const int mt = wid >> 1;
#pragma unroll
    for (int q = 0; q < 2; ++q) { const int nt = (wid & 1) * 2 + q;
      f32x16 acc;
#pragma unroll
      for (int r = 0; r < 16; ++r) acc[r] = 0.f;
      const char* ya = smem + (mt * 32 + l31) * RS + hh * 16; const char* wb = smem + 128 * RS + (nt * 32 + l31) * RS + hh * 16;
#pragma unroll
      for (int ks = 0; ks < 8; ++ks) acc = __builtin_amdgcn_mfma_f32_32x32x16_bf16(*(const bf16x8*)(ya + ks * 32), *(const bf16x8*)(wb + ks * 32), acc, 0, 0, 0);
      const int e = nt * 32 + l31; const float psc = p.pool_sc[g * 128 + e];
#pragma unroll
      for (int r = 0; r < 16; ++r) { const int row = mt * 32 + (r & 3) + 8 * (r >> 2) + 4 * hh; p.CAT[(size_t)(t0 + row) * 1024 + 512 + g * 128 + e] = f2bf(acc[r] * psc); } }
  }
}
}

__device__ void phase_mlstm_naive(const Params& p, char* smem) {
  float* qs = (float*)smem; float* ks = qs + 128; float* nump = ks + 128; float* red = nump + 512;
  const int tid = threadIdx.x, j = tid & 127, qd = tid >> 7;
  for (int job = blockIdx.x; job < 64; job += gridDim.x) {
    const int dir = job >> 5, b = (job >> 2) & 7, h = job & 3;
    float C[32];
#pragma unroll
    for (int d = 0; d < 32; ++d) C[d] = 0.f;
    float n = 0.f, m = 0.f;
    for (int step = 0; step < S; ++step) { const int s = dir ? S - 1 - step : step; const size_t t = (size_t)b * S + s;
      const float li = p.gates[t * 16 + dir * 4 + h], gf = p.gates[t * 16 + 8 + dir * 4 + h];
      const float lf = fminf(gf, 0.f) - log1pf(__expf(-fabsf(gf)));
      __syncthreads();
      if (qd == 0) { qs[j] = bf2f(p.QK[t * 1024 + h * 128 + j]); ks[j] = bf2f(p.QK[t * 1024 + 512 + h * 128 + j]); }
      const float v = bf2f(p.ZV[t * 512 + h * 128 + j]);
      __syncthreads();
      const float mn = fmaxf(lf + m, li), ip = __expf(li - mn), fp = __expf(lf + m - mn); m = mn;
      float num = 0.f;
#pragma unroll
      for (int d = 0; d < 32; ++d) { C[d] = fp * C[d] + ip * ks[qd * 32 + d] * v; num += qs[qd * 32 + d] * C[d]; }
      float dp = 0.f; if (qd == 0) { n = fp * n + ip * ks[j]; dp = qs[j] * n; }
      nump[qd * 128 + j] = num;
      dp = wave_sum(dp); if ((tid & 63) == 0) red[tid >> 6] = dp;
      __syncthreads();
      if (qd == 0) { const float den = red[0] + red[1]; num = nump[j] + nump[128 + j] + nump[256 + j] + nump[384 + j];
        p.HS[((size_t)dir * T + t) * 512 + h * 128 + j] = f2bf(num / fmaxf(fabsf(den), __expf(-mn))); }
    }
    __syncthreads();
  }
}

namespace ml {
typedef short bf16x8 __attribute__((ext_vector_type(8)));
typedef short s16x4 __attribute__((ext_vector_type(4)));
typedef float f32x16 __attribute__((ext_vector_type(16)));
constexpr int RS = 272;
constexpr int OFF_Q = 0, OFF_K = 128 * RS, OFF_VT = 2 * 128 * RS, OFF_VW = OFF_VT + 34 * RS, OFF_CT = OFF_VW + 34 * RS, OFF_A = OFF_CT + 34 * RS;
constexpr int OFF_PA = OFF_A + 16384, OFF_MCH = OFF_PA + 16384, OFF_TAB = OFF_MCH + 512, OFF_DEN = OFF_TAB + 4096  , OFF_EX = OFF_DEN + 1536  , OFF_END = OFF_EX + 16384;
static_assert(OFF_A % 16 == 0 && OFF_END <= SMEM_BYTES, "mlstm LDS layout");
__device__ __forceinline__ int crow(int r, int h) { return (r & 3) + 8 * (r >> 2) + 4 * h; }
__device__ __forceinline__ int spos(int s) { return (s & ~12) | ((s & 4) << 1) | ((s & 8) >> 1); }
#define ML_MFMA(a, b, c) __builtin_amdgcn_mfma_f32_32x32x16_bf16((a), (b), (c), 0, 0, 0)
__device__ __forceinline__ bf16x8 pack8(float x0, float x1, float x2, float x3, float x4, float x5, float x6, float x7) {
  u32x4 w;
  asm volatile("v_cvt_pk_bf16_f32 %0, %4, %5\n\tv_cvt_pk_bf16_f32 %1, %6, %7\n\tv_cvt_pk_bf16_f32 %2, %8, %9\n\tv_cvt_pk_bf16_f32 %3, %10, %11\n\ts_nop 1"
               : "=&v"(w.x), "=&v"(w.y), "=&v"(w.z), "=&v"(w.w) : "v"(x0), "v"(x1), "v"(x2), "v"(x3), "v"(x4), "v"(x5), "v"(x6), "v"(x7));
  return __builtin_bit_cast(bf16x8, w);
}
__device__ __forceinline__ void tr_read8(unsigned a, s16x4& r0, s16x4& r1, s16x4& r2, s16x4& r3, s16x4& r4, s16x4& r5, s16x4& r6, s16x4& r7) {
  asm volatile("ds_read_b64_tr_b16 %0, %8\n\tds_read_b64_tr_b16 %1, %8 offset:2176\n\tds_read_b64_tr_b16 %2, %8 offset:4352\n\tds_read_b64_tr_b16 %3, %8 offset:6528\n\t"
               "ds_read_b64_tr_b16 %4, %8 offset:8704\n\tds_read_b64_tr_b16 %5, %8 offset:10880\n\tds_read_b64_tr_b16 %6, %8 offset:13056\n\tds_read_b64_tr_b16 %7, %8 offset:15232\n\ts_waitcnt lgkmcnt(0)"
               : "=&v"(r0), "=&v"(r1), "=&v"(r2), "=&v"(r3), "=&v"(r4), "=&v"(r5), "=&v"(r6), "=&v"(r7) : "v"(a) : "memory");
}
static_assert(8 * RS == 2176, "tr_read8 offsets assume 272-byte rows");

__device__ void phase_mlstm(const Params& p, char* smem) {
  int tid_ = threadIdx.x; asm volatile("" : "+v"(tid_));
  const int tid = tid_, wid = tid >> 6, lane = tid & 63, l31 = lane & 31, hh = lane >> 5;
  float* const LA = (float*)(smem + OFF_A); float* const LPA = (float*)(smem + OFF_PA); float* const LM = (float*)(smem + OFF_MCH);
  float* const LTAB = (float*)(smem + OFF_TAB); float* const LDEN = (float*)(smem + OFF_DEN);
  const unsigned lds0 = (unsigned)(uintptr_t)smem;
  for (int job = blockIdx.x; job < 256; job += gridDim.x) {
    const int dvq = job & 3, h = (job >> 2) & 3, b = (job >> 4) & 7, dir = job >> 7;
    const float* gts = p.gates + (size_t)b * S * 16;
    const bf16_t* QKb = p.QK + (size_t)b * S * 1024 + h * 128; const bf16_t* ZVb = p.ZV + (size_t)b * S * 512 + h * 128 + dvq * 32;
    bf16_t* HSb = p.HS + ((size_t)dir * T + (size_t)b * S) * 512 + h * 128 + dvq * 32;
    __syncthreads();
    for (int i = tid; i < 3 * 34 * RS / 4; i += NTHREADS) ((u32*)(smem + OFF_VT))[i] = 0u;
    for (int cc = 0; cc < 4; ++cc) { const int c = wid * 4 + cc, tau0 = c * 128 + 2 * lane; const int tok0 = dir ? S - 1 - tau0 : tau0, tok1 = dir ? tok0 - 1 : tok0 + 1;
      const float li0 = gts[(size_t)tok0 * 16 + dir * 4 + h], gf0 = gts[(size_t)tok0 * 16 + 8 + dir * 4 + h], li1 = gts[(size_t)tok1 * 16 + dir * 4 + h], gf1 = gts[(size_t)tok1 * 16 + 8 + dir * 4 + h];
      const float lf0 = fminf(gf0, 0.f) - log1pf(__expf(-fabsf(gf0))), lf1 = fminf(gf1, 0.f) - log1pf(__expf(-fabsf(gf1)));
      const float pr = lf0 + lf1; float incl = pr;
#pragma unroll
      for (int o = 1; o < 64; o <<= 1) { const float v = __shfl_up(incl, o); if (lane >= o) incl += v; }
      const float b0 = incl - pr + lf0, b1 = b0 + lf1, a0 = li0 - b0, a1 = li1 - b1;
      float im = fmaxf(a0, a1);
#pragma unroll
      for (int o = 1; o < 64; o <<= 1) { const float v = __shfl_up(im, o); if (lane >= o) im = fmaxf(im, v); }
      float ex = __shfl_up(im, 1); if (lane == 0) ex = -INFINITY;
      const float pa0 = fmaxf(ex, a0), pa1 = fmaxf(pa0, a1);
      LA[tau0] = a0; LA[tau0 + 1] = a1; LPA[tau0] = pa0; LPA[tau0 + 1] = pa1; if (lane == 63) LM[64 + c] = b1; }
    __syncthreads();
    if (tid == 0) { float m = 0.f; for (int c = 0; c < 32; ++c) { LM[c] = m; m = LM[64 + c] + fmaxf(m, LPA[c * 128 + 127]); } LM[32] = m; }
    __syncthreads();
    u32x4 qreg[4], kreg[4], vreg;
#define ML_TOK(tau) (dir ? S - 1 - (tau) : (tau))
#define ML_LOAD(c) do { _Pragma("unroll") for (int i_ = 0; i_ < 4; ++i_) { const int tk_ = ML_TOK((c) * 128 + (tid >> 4) + 32 * i_); \
        qreg[i_] = *(const u32x4*)(QKb + (size_t)tk_ * 1024 + (tid & 15) * 8); kreg[i_] = *(const u32x4*)(QKb + (size_t)tk_ * 1024 + 512 + (tid & 15) * 8); } \
      { const int tk_ = ML_TOK((c) * 128 + (tid >> 2)); vreg = *(const u32x4*)(ZVb + (size_t)tk_ * 512 + (tid & 3) * 8); } } while (0)
#define ML_LI(c) gts[(size_t)ML_TOK((c) * 128 + (tid & 127)) * 16 + dir * 4 + h]
#define ML_TABLES(c, li_) do { if (tid < 128) { const int tau_ = (c) * 128 + tid; const float a_ = LA[tau_], mc_ = LM[(c)]; \
        const float Mj_ = fmaxf(mc_, LPA[tau_]), Me_ = fmaxf(mc_, LPA[(c) * 128 + 127]); float* tb_ = LTAB + ((c) & 1) * 512; \
        tb_[tid] = __expf(fminf(Me_ - Mj_, 60.f)); tb_[128 + tid] = __expf(mc_ - Mj_); tb_[256 + tid] = __expf(-((li_ - a_) + Mj_)); tb_[384 + tid] = __expf(a_ - Me_); } } while (0)
#define ML_STORE(c) do { _Pragma("unroll") for (int i_ = 0; i_ < 4; ++i_) { const int row_ = (tid >> 4) + 32 * i_; \
        *(u32x4*)(smem + OFF_Q + row_ * RS + (tid & 15) * 16) = qreg[i_]; *(u32x4*)(smem + OFF_K + row_ * RS + (tid & 15) * 16) = kreg[i_]; } \
      { const int s_ = tid >> 2, ps_ = spos(s_) * 2; const float we_ = LTAB[((c) & 1) * 512 + 384 + s_]; const u32 vw_[4] = {vreg.x, vreg.y, vreg.z, vreg.w}; \
        _Pragma("unroll") for (int i_ = 0; i_ < 4; ++i_) { const int r0_ = ((tid & 3) * 8 + 2 * i_) * RS + ps_; \
          *(bf16_t*)(smem + OFF_VT + r0_) = (bf16_t)(vw_[i_] & 0xFFFFu); *(bf16_t*)(smem + OFF_VT + r0_ + RS) = (bf16_t)(vw_[i_] >> 16); \
          *(bf16_t*)(smem + OFF_VW + r0_) = f2bf(bflo(vw_[i_]) * we_); *(bf16_t*)(smem + OFF_VW + r0_ + RS) = f2bf(bfhi(vw_[i_]) * we_); } } \
      if (tid < 128) { const int ps_ = spos(tid) * 2; *(bf16_t*)(smem + OFF_VT + 32 * RS + ps_) = (bf16_t)0x3F80u; *(bf16_t*)(smem + OFF_VW + 32 * RS + ps_) = f2bf(LTAB[((c) & 1) * 512 + 384 + tid]); } } while (0)
    float li_pf = ML_LI(0);
    ML_LOAD(0); ML_TABLES(0, li_pf);
    li_pf = ML_LI(1);
    __syncthreads();
    ML_STORE(0);
    __syncthreads();
    f32x16 Cacc;
#pragma unroll
    for (int r = 0; r < 16; ++r) Cacc[r] = 0.f;
    for (int c = 0; c < 32; ++c) {
      int tidc_ = threadIdx.x; asm volatile("" : "+v"(tidc_));
      const int tid = tidc_, wid = tid >> 6, lane = tid & 63, l31 = lane & 31, hh = lane >> 5;
      const int t2 = wid >> 1, nt = wid & 1, brow = min(nt * 32 + l31, 33);
      if (c + 1 < 32) { ML_LOAD(c + 1); ML_TABLES(c + 1, li_pf); }
      if (c + 2 < 32) li_pf = ML_LI(c + 2);
      const float* tab = LTAB + (c & 1) * 512;
      f32x16 acc;
#pragma unroll
      for (int r = 0; r < 16; ++r) acc[r] = 0.f;
      const char* qa = smem + OFF_Q + (t2 * 32 + l31) * RS + hh * 16;
      if (nt == 0) { const char* cb = smem + OFF_CT + l31 * RS + hh * 16;
#pragma unroll
        for (int ks = 0; ks < 8; ++ks) acc = ML_MFMA(*(const bf16x8*)(qa + ks * 32), *(const bf16x8*)(cb + ks * 32), acc);
#pragma unroll
        for (int r = 0; r < 16; ++r) acc[r] *= tab[128 + t2 * 32 + crow(r, hh)];
      } else { const char* cb = smem + OFF_CT + (l31 == 0 ? 32 : 33) * RS + hh * 16; f32x16 aq;
#pragma unroll
        for (int r = 0; r < 16; ++r) aq[r] = 0.f;
#pragma unroll
        for (int ks = 0; ks < 8; ++ks) aq = ML_MFMA(*(const bf16x8*)(qa + ks * 32), *(const bf16x8*)(cb + ks * 32), aq);
        if (l31 == 0) {
#pragma unroll
          for (int r = 0; r < 16; ++r) { const int j = t2 * 32 + crow(r, hh); LDEN[256 + j] = aq[r] * tab[128 + j]; } } }
      const float fj = tab[t2 * 32 + l31];
      float psum = 0.f;
      for (int si = nt; si <= t2; si += 2) {
        f32x16 X;
#pragma unroll
        for (int r = 0; r < 16; ++r) X[r] = 0.f;
        const char* ka = smem + OFF_K + (si * 32 + l31) * RS + hh * 16;
#pragma unroll
        for (int ks = 0; ks < 8; ++ks) X = ML_MFMA(*(const bf16x8*)(ka + ks * 32), *(const bf16x8*)(qa + ks * 32), X);
        const float* We = tab + 384 + si * 32;
#pragma unroll
        for (int r = 0; r < 16; ++r) { const int sl = crow(r, hh); float w = We[sl] * fj; if (si == t2 && sl > l31) w = 0.f; X[r] *= w; psum += X[r]; }
        const bf16x8 f0 = pack8(X[0], X[1], X[2], X[3], X[4], X[5], X[6], X[7]), f1 = pack8(X[8], X[9], X[10], X[11], X[12], X[13], X[14], X[15]);
        const char* vb = smem + OFF_VT + l31 * RS + si * 64 + hh * 16;
        acc = ML_MFMA(f0, *(const bf16x8*)(vb), acc); acc = ML_MFMA(f1, *(const bf16x8*)(vb + 32), acc);
      }
      psum += __shfl_xor(psum, 32);
      if (hh == 0) LDEN[nt * 128 + t2 * 32 + l31] = psum;
      if (nt == 1) { float* ex = (float*)(smem + OFF_EX) + t2 * 1024 + lane;
#pragma unroll
        for (int r = 0; r < 16; ++r) ex[r * 64] = acc[r]; }
      { const float mc = LM[c], decay = __expf(mc - fmaxf(mc, LPA[c * 128 + 127]));
#pragma unroll
        for (int r = 0; r < 16; ++r) Cacc[r] *= decay;
        const unsigned ta = lds0 + OFF_K + ((lane & 15) >> 2) * RS + (t2 * 32 + 16 * ((lane >> 4) & 1) + 4 * (lane & 3)) * 2 + 4 * hh * RS;
        const char* wb = smem + OFF_VW + brow * RS + hh * 16;
#pragma unroll
        for (int kq = 0; kq < 2; ++kq) { s16x4 r0, r1, r2, r3, r4, r5, r6, r7; tr_read8(ta + 64 * kq * RS, r0, r1, r2, r3, r4, r5, r6, r7); __builtin_amdgcn_sched_barrier(0);
          Cacc = ML_MFMA(((bf16x8){r0[0], r0[1], r0[2], r0[3], r1[0], r1[1], r1[2], r1[3]}), *(const bf16x8*)(wb + (4 * kq + 0) * 32), Cacc);
          Cacc = ML_MFMA(((bf16x8){r2[0], r2[1], r2[2], r2[3], r3[0], r3[1], r3[2], r3[3]}), *(const bf16x8*)(wb + (4 * kq + 1) * 32), Cacc);
          Cacc = ML_MFMA(((bf16x8){r4[0], r4[1], r4[2], r4[3], r5[0], r5[1], r5[2], r5[3]}), *(const bf16x8*)(wb + (4 * kq + 2) * 32), Cacc);
          Cacc = ML_MFMA(((bf16x8){r6[0], r6[1], r6[2], r6[3], r7[0], r7[1], r7[2], r7[3]}), *(const bf16x8*)(wb + (4 * kq + 3) * 32), Cacc); } }
      __syncthreads();
      if (nt == 0) { const float* ex = (const float*)(smem + OFF_EX) + t2 * 1024 + lane;
#pragma unroll
        for (int r = 0; r < 16; ++r) { const int j = t2 * 32 + crow(r, hh); const float dn = LDEN[j] + LDEN[128 + j] + LDEN[256 + j], nr = tab[256 + j]; const int tk = ML_TOK(c * 128 + j);
          HSb[(size_t)tk * 512 + l31] = f2bf((acc[r] + ex[r * 64]) / fmaxf(fabsf(dn), nr)); } }
      if (nt * 32 + l31 <= 32) { char* cw = smem + OFF_CT + (nt * 32 + l31) * RS + (t2 * 32 + 4 * hh) * 2;
#pragma unroll
        for (int g = 0; g < 4; ++g) { u32x2 w; w.x = pack2(Cacc[4 * g], Cacc[4 * g + 1]); w.y = pack2(Cacc[4 * g + 2], Cacc[4 * g + 3]); *(u32x2*)(cw + 16 * g) = w; } }
      if (c + 1 < 32) ML_STORE(c + 1);
      __syncthreads();
    }
#undef ML_TOK
#undef ML_LOAD
#undef ML_TABLES
#undef ML_LI
#undef ML_STORE
  }
}
}

__device__ void phase_peer_select_naive(const Params& p, int layer, char* smem) {
  float* kl = (float*)smem;
  float* qsh = kl + 2 * 128 * 129;
  const int tid = threadIdx.x, wid = tid >> 6, lane = tid & 63; float* qs = qsh + wid * 128;
  __syncthreads();
  for (int i = tid; i < 2 * 128 * 128; i += NTHREADS) kl[(i >> 7) * 129 + (i & 127)] = p.peer_keys[(size_t)layer * 32768 + i];
  __syncthreads();
  for (int job = blockIdx.x; job < T; job += gridDim.x) {
    const int t = job, h = wid;
    float ts[2][16]; int ti[2][16];
#pragma unroll
    for (int pp = 0; pp < 2; ++pp) {
      const bf16_t* q = p.QP + (size_t)t * 2048 + h * 256 + pp * 128; const float q0 = bf2f(q[lane]), q1 = bf2f(q[lane + 64]);
      const float r = rsqrtf(wave_sum(q0 * q0 + q1 * q1) * (1.f / 128.f) + EPS); qs[lane] = q0 * r; qs[lane + 64] = q1 * r;
      float s0 = 0.f, s1 = 0.f; const float* k0 = kl + (pp * 128 + lane) * 129; const float* k1 = k0 + 64 * 129;
      for (int c = 0; c < 128; ++c) { const float qc = qs[c]; s0 += qc * k0[c]; s1 += qc * k1[c]; }
#pragma unroll
      for (int k = 0; k < 16; ++k) { const float mx = wave_max(fmaxf(s0, s1)); int cand = (s0 == mx) ? lane : ((s1 == mx) ? lane + 64 : 9999);
        for (int o = 32; o >= 1; o >>= 1) cand = min(cand, __shfl_xor(cand, o));
        ts[pp][k] = mx; ti[pp][k] = cand; if (cand == lane) s0 = -INFINITY; if (cand == lane + 64) s1 = -INFINITY; }
    }
    float cs[4];
#pragma unroll
    for (int r = 0; r < 4; ++r) { const int c = lane * 4 + r; float va = 0.f, vb = 0.f;
#pragma unroll
      for (int k = 0; k < 16; ++k) { if (k == (c >> 4)) va = ts[0][k]; if (k == (c & 15)) vb = ts[1][k]; }
      cs[r] = va + vb; }
    float top[16]; int tix[16];
#pragma unroll
    for (int k = 0; k < 16; ++k) { const float mx = wave_max(fmaxf(fmaxf(cs[0], cs[1]), fmaxf(cs[2], cs[3]))); int cand = 9999;
#pragma unroll
      for (int r = 3; r >= 0; --r) if (cs[r] == mx) cand = lane * 4 + r;
      for (int o = 32; o >= 1; o >>= 1) cand = min(cand, __shfl_xor(cand, o));
      top[k] = mx; tix[k] = cand;
#pragma unroll
      for (int r = 0; r < 4; ++r) if (cand == lane * 4 + r) cs[r] = -INFINITY; }
    float sum = 0.f;
#pragma unroll
    for (int k = 0; k < 16; ++k) sum += __expf(top[k] - top[0]);
    if (lane < 16) { float tv = 0.f; int tc = 0;
#pragma unroll
      for (int k = 0; k < 16; ++k) if (k == lane) { tv = top[k]; tc = tix[k]; }
      int ia = 0, ib = 0;
#pragma unroll
      for (int k = 0; k < 16; ++k) { if (k == (tc >> 4)) ia = ti[0][k]; if (k == (tc & 15)) ib = ti[1][k]; }
      p.pidx[((size_t)t * 8 + h) * 16 + lane] = (bf16_t)(ia * 128 + ib); p.pgate[((size_t)t * 8 + h) * 16 + lane] = __expf(tv - top[0]) / sum; }
  }
}

namespace sel {
typedef short bf16x8 __attribute__((ext_vector_type(8)));
typedef float f32x16 __attribute__((ext_vector_type(16)));
constexpr int RS = 272, OFF_W = 2 * 128 * RS, WB = 3 * 16 * 32 * 4;
static_assert(OFF_W + 8 * WB <= SMEM_BYTES, "select LDS layout");
constexpr float NEG = -3.0e38f;
__device__ __forceinline__ float max3(float a, float b, float c) { return fmaxf(fmaxf(a, b), c); }
__device__ __forceinline__ float xhalf(float v) { return __shfl_xor(v, 32); }

#define CE(a, b) do { const float hi_ = fmaxf(a, b), lo_ = fminf(a, b); a = hi_; b = lo_; } while (0)
#define SORT16(V) do { CE(V[0], V[1]); CE(V[2], V[3]); CE(V[0], V[2]); CE(V[1], V[3]); CE(V[1], V[2]); CE(V[4], V[5]); CE(V[6], V[7]); CE(V[4], V[6]); CE(V[5], V[7]); CE(V[5], V[6]); CE(V[0], V[4]); CE(V[2], V[6]); CE(V[2], V[4]); CE(V[1], V[5]); CE(V[3], V[7]); CE(V[3], V[5]); CE(V[1], V[2]); CE(V[3], V[4]); CE(V[5], V[6]); CE(V[8], V[9]); CE(V[10], V[11]); CE(V[8], V[10]); CE(V[9], V[11]); CE(V[9], V[10]); CE(V[12], V[13]); CE(V[14], V[15]); CE(V[12], V[14]); CE(V[13], V[15]); CE(V[13], V[14]); CE(V[8], V[12]); CE(V[10], V[14]); CE(V[10], V[12]); CE(V[9], V[13]); CE(V[11], V[15]); CE(V[11], V[13]); CE(V[9], V[10]); CE(V[11], V[12]); CE(V[13], V[14]); CE(V[0], V[8]); CE(V[4], V[12]); CE(V[4], V[8]); CE(V[2], V[10]); CE(V[6], V[14]); CE(V[6], V[10]); CE(V[2], V[4]); CE(V[6], V[8]); CE(V[10], V[12]); CE(V[1], V[9]); CE(V[5], V[13]); CE(V[5], V[9]); CE(V[3], V[11]); CE(V[7], V[15]); CE(V[7], V[11]); CE(V[3], V[5]); CE(V[7], V[9]); CE(V[11], V[13]); CE(V[1], V[2]); CE(V[3], V[4]); CE(V[5], V[6]); CE(V[7], V[8]); CE(V[9], V[10]); CE(V[11], V[12]); CE(V[13], V[14]); } while (0)
#define BMERGE16(V) do { CE(V[0], V[8]); CE(V[1], V[9]); CE(V[2], V[10]); CE(V[3], V[11]); CE(V[4], V[12]); CE(V[5], V[13]); CE(V[6], V[14]); CE(V[7], V[15]); CE(V[0], V[4]); CE(V[1], V[5]); CE(V[2], V[6]); CE(V[3], V[7]); CE(V[8], V[12]); CE(V[9], V[13]); CE(V[10], V[14]); CE(V[11], V[15]); CE(V[0], V[2]); CE(V[1], V[3]); CE(V[4], V[6]); CE(V[5], V[7]); CE(V[8], V[10]); CE(V[9], V[11]); CE(V[12], V[14]); CE(V[13], V[15]); CE(V[0], V[1]); CE(V[2], V[3]); CE(V[4], V[5]); CE(V[6], V[7]); CE(V[8], V[9]); CE(V[10], V[11]); CE(V[12], V[13]); CE(V[14], V[15]); } while (0)

__device__ void phase_peer_select(const Params& p, int layer, char* smem) {
  const int tid0 = threadIdx.x;
  __syncthreads();
  { const bf16_t* kb = p.keysb + (size_t)layer * 32768;
    for (int i = tid0; i < 2 * 128 * 16; i += NTHREADS) { const int row = i >> 4, ch = i & 15; *(u32x4*)(smem + row * RS + ch * 16) = *(const u32x4*)(kb + (size_t)row * 128 + ch * 8); } }
  __syncthreads();
  for (int job = blockIdx.x; job < T / 32; job += gridDim.x) {
    int tid_ = threadIdx.x; asm volatile("" : "+v"(tid_));
    const int tid = tid_, wid = tid >> 6, lane = tid & 63, l31 = lane & 31, hh = lane >> 5, h = wid;
    const int t = job * 32 + l31;
    float* const wl = (float*)(smem + OFF_W + wid * WB);
    float rs[2], s1[16], s2[16];
#pragma unroll
    for (int pp = 0; pp < 2; ++pp) {
      const bf16_t* qrow = p.QP + (size_t)t * 2048 + h * 256 + pp * 128 + hh * 8;
      bf16x8 bq[8]; float ssq = 0.f;
#pragma unroll
      for (int ks = 0; ks < 8; ++ks) { const u32x4 w = *(const u32x4*)(qrow + ks * 16); bq[ks] = __builtin_bit_cast(bf16x8, w);
        const u32 w0 = w.x, w1 = w.y, w2 = w.z, w3 = w.w; ssq = dot2bf(w0, w0, ssq); ssq = dot2bf(w1, w1, ssq); ssq = dot2bf(w2, w2, ssq); ssq = dot2bf(w3, w3, ssq); }
      ssq += xhalf(ssq); rs[pp] = rsqrtf(ssq * (1.f / 128.f) + EPS);
      f32x16 X[4];
#pragma unroll
      for (int nt = 0; nt < 4; ++nt) {
#pragma unroll
        for (int r = 0; r < 16; ++r) X[nt][r] = 0.f;
        const char* ka = smem + (pp * 128 + nt * 32 + l31) * RS + hh * 16;
#pragma unroll
        for (int ks = 0; ks < 8; ++ks) X[nt] = __builtin_amdgcn_mfma_f32_32x32x16_bf16(*(const bf16x8*)(ka + ks * 32), bq[ks], X[nt], 0, 0, 0); }
#pragma unroll
      for (int nt = 0; nt < 4; ++nt)
#pragma unroll
        for (int r = 0; r < 16; ++r) X[nt][r] = __uint_as_float((__float_as_uint(X[nt][r]) & ~0x7Fu) | (u32)(nt * 32 + (r & 3) + 8 * (r >> 2)) | ((u32)hh << 2));
      SORT16(X[0]); SORT16(X[1]); SORT16(X[2]); SORT16(X[3]);
#pragma unroll
      for (int i = 0; i < 16; ++i) { X[0][i] = fmaxf(X[0][i], X[1][15 - i]); X[2][i] = fmaxf(X[2][i], X[3][15 - i]); }
      BMERGE16(X[0]); BMERGE16(X[2]);
#pragma unroll
      for (int i = 0; i < 16; ++i) X[0][i] = fmaxf(X[0][i], X[2][15 - i]);
      BMERGE16(X[0]);
      f32x16 lo_, hi_;
#pragma unroll
      for (int i = 0; i < 16; ++i) { const u32 b_ = __float_as_uint(X[0][i]); auto r_ = __builtin_amdgcn_permlane32_swap(b_, b_, false, false); lo_[i] = __uint_as_float(r_[0]); hi_[i] = __uint_as_float(r_[1]); }
#pragma unroll
      for (int i = 0; i < 16; ++i) X[0][i] = fmaxf(lo_[i], hi_[15 - i]);
      BMERGE16(X[0]);
#pragma unroll
      for (int k = 0; k < 16; ++k) { wl[(pp * 16 + k) * 32 + l31] = X[0][k]; if (pp == 0) s1[k] = X[0][k] * rs[0]; else s2[k] = X[0][k] * rs[1]; }
    }
    constexpr int A0[25] = {0, 0, 0, 0, 0, 0, 0, 0, 0, 0, 0, 0, 0, 0, 0, 0, 2, 2, 2, 2, 2, 3, 3, 3, 3}, B0[25] = {0, 1, 2, 3, 4, 5, 6, 7, 8, 9, 10, 11, 12, 13, 14, 15, 0, 1, 2, 3, 4, 0, 1, 2, 3};
    constexpr int A1[25] = {1, 1, 1, 1, 1, 1, 1, 1, 4, 4, 4, 5, 5, 6, 6, 7, 7, 8, 9, 10, 11, 12, 13, 14, 15}, B1[25] = {0, 1, 2, 3, 4, 5, 6, 7, 0, 1, 2, 0, 1, 0, 1, 0, 1, 0, 0, 0, 0, 0, 0, 0, 0};
    float cd[25];
#pragma unroll
    for (int i = 0; i < 25; ++i) { const float v0 = s1[A0[i]] + s2[B0[i]], v1 = s1[A1[i]] + s2[B1[i]]; const float v = hh ? v1 : v0; const u32 cid = hh ? (u32)(A1[i] * 16 + B1[i]) : (u32)(A0[i] * 16 + B0[i]);
      cd[i] = __uint_as_float((__float_as_uint(v) & ~0xFFu) | cid); }
#pragma unroll 1
    for (int k = 0; k < 16; ++k) {
      float m = cd[24];
#pragma unroll
      for (int i = 0; i < 24; i += 2) m = max3(m, cd[i], cd[i + 1]);
      const float M = fmaxf(m, xhalf(m));
      wl[(32 + k) * 32 + l31] = M;
#pragma unroll
      for (int i = 0; i < 25; ++i) cd[i] = (cd[i] == M) ? NEG : cd[i];
    }
    float tv[16];
#pragma unroll
    for (int k = 0; k < 16; ++k) tv[k] = wl[(32 + k) * 32 + l31];
    float sum = 0.f;
#pragma unroll
    for (int k = 0; k < 16; ++k) sum += __expf(tv[k] - tv[0]);
    const float inv = 1.f / sum;
    u32 ev[8]; float go[8];
#pragma unroll
    for (int q = 0; q < 8; ++q) { const float v = wl[(32 + hh * 8 + q) * 32 + l31]; const u32 cid = __float_as_uint(v) & 0xFFu;
      const u32 i1 = __float_as_uint(wl[(cid >> 4) * 32 + l31]) & 0x7Fu, i2 = __float_as_uint(wl[(16 + (cid & 15)) * 32 + l31]) & 0x7Fu; ev[q] = i1 * 128 + i2;
      go[q] = __expf(v - tv[0]) * inv; }
    const u32 io0 = ev[0] | (ev[1] << 16), io1 = ev[2] | (ev[3] << 16), io2 = ev[4] | (ev[5] << 16), io3 = ev[6] | (ev[7] << 16);
    const size_t ob = ((size_t)t * 8 + h) * 16 + hh * 8;
    *(u32x4*)(p.pidx + ob) = (u32x4){io0, io1, io2, io3};
    *(f32x4*)(p.pgate + ob) = (f32x4){go[0], go[1], go[2], go[3]}; *(f32x4*)(p.pgate + ob + 4) = (f32x4){go[4], go[5], go[6], go[7]};
  }
}
}

typedef float f32x2 __attribute__((ext_vector_type(2)));
constexpr float U8_SCALE = 32.f, V8_SCALE = 2.f;
constexpr int GT = 4;
constexpr int GW_WAVE_BYTES = GT * (2048 + 128 * 2 + 128 * 4);
static_assert(8 * GW_WAVE_BYTES <= SMEM_BYTES - 16, "gather LDS layout");
__device__ __forceinline__ float gelu_erf(float z) { return 0.5f * z * (1.f + erff(z * 0.70710678118654752f)); }
__device__ __forceinline__ float reduce8(float d0, float d1, float d2, float d3, float d4, float d5, float d6, float d7, int lane) {
  float e[4];
  { auto r0 = __builtin_amdgcn_permlane32_swap(__float_as_uint(d0), __float_as_uint(d4), false, false); e[0] = __uint_as_float(r0[0]) + __uint_as_float(r0[1]);
    auto r1 = __builtin_amdgcn_permlane32_swap(__float_as_uint(d1), __float_as_uint(d5), false, false); e[1] = __uint_as_float(r1[0]) + __uint_as_float(r1[1]);
    auto r2 = __builtin_amdgcn_permlane32_swap(__float_as_uint(d2), __float_as_uint(d6), false, false); e[2] = __uint_as_float(r2[0]) + __uint_as_float(r2[1]);
    auto r3 = __builtin_amdgcn_permlane32_swap(__float_as_uint(d3), __float_as_uint(d7), false, false); e[3] = __uint_as_float(r3[0]) + __uint_as_float(r3[1]); }
  float f0, f1;
  { auto r0 = __builtin_amdgcn_permlane16_swap(__float_as_uint(e[0]), __float_as_uint(e[2]), false, false); f0 = __uint_as_float(r0[0]) + __uint_as_float(r0[1]);
    auto r1 = __builtin_amdgcn_permlane16_swap(__float_as_uint(e[1]), __float_as_uint(e[3]), false, false); f1 = __uint_as_float(r1[0]) + __uint_as_float(r1[1]); }
  const bool up = (lane & 8) != 0; const float keep = up ? f1 : f0, send = up ? f0 : f1;
  float g = keep + __shfl_xor(send, 8);
  g += __shfl_xor(g, 4); g += __shfl_xor(g, 2); g += __shfl_xor(g, 1);
  return g;
}
template <int NEXT>
__device__ void phase_peer_gather(const Params& p, int layer, char* smem) {
  const __amdgpu_buffer_rsrc_t rsU = __builtin_amdgcn_make_buffer_rsrc((void*)(p.U8 + (size_t)layer * 16384 * 1024), 0, 16384 * 1024, 0x00020000);
  const __amdgpu_buffer_rsrc_t rsV = __builtin_amdgcn_make_buffer_rsrc((void*)(p.V8 + (size_t)layer * 16384 * 1024), 0, 16384 * 1024, 0x00020000);
  for (int job = blockIdx.x; job < T / (8 * GT); job += gridDim.x) {
    int tid_ = threadIdx.x; asm volatile("" : "+v"(tid_));
    const int tid = tid_, wid = tid >> 6, lane = tid & 63;
    const int tb = (job * 8 + wid) * GT;
    const int vidx = 4 * (lane >> 5) + 2 * ((lane >> 4) & 1) + ((lane >> 3) & 1); const unsigned lane16 = (unsigned)lane * 16u;
    char* wl = smem + wid * GW_WAVE_BYTES; bf16_t* sx = (bf16_t*)wl; bf16_t* sidx = (bf16_t*)(wl + GT * 2048); float* sgate = (float*)(wl + GT * 2048 + GT * 256);
#pragma unroll 1
    for (int g = 0; g < GT; ++g) { const size_t t = (size_t)(tb + g);
      *(u32x4*)(sx + g * 1024 + lane * 16) = *(const u32x4*)(p.H + t * D + lane * 16); *(u32x4*)(sx + g * 1024 + lane * 16 + 8) = *(const u32x4*)(p.H + t * D + lane * 16 + 8);
      const int ia = p.pidx[t * 128 + lane], ib = p.pidx[t * 128 + 64 + lane]; const float ga = p.pgate[t * 128 + lane], gb = p.pgate[t * 128 + 64 + lane];
      const int wa = ia >> 10, wb = ib >> 10; int off = 0, pa = 0, pb = 0;
#pragma unroll
      for (int w = 0; w < 16; ++w) { const unsigned long long m0 = __ballot(wa == w), m1 = __ballot(wb == w); const int c0 = __popcll(m0), c1 = __popcll(m1);
        const int r0 = __builtin_amdgcn_mbcnt_hi((unsigned)(m0 >> 32), __builtin_amdgcn_mbcnt_lo((unsigned)m0, 0)), r1 = __builtin_amdgcn_mbcnt_hi((unsigned)(m1 >> 32), __builtin_amdgcn_mbcnt_lo((unsigned)m1, 0));
        if (wa == w) pa = off + r0; if (wb == w) pb = off + c0 + r1; off += c0 + c1; }
      sidx[g * 128 + pa] = (bf16_t)ia; sgate[g * 128 + pa] = ga; sidx[g * 128 + pb] = (bf16_t)ib; sgate[g * 128 + pb] = gb; }
    f32x2 acc[GT][8];
#pragma unroll
    for (int g = 0; g < GT; ++g)
#pragma unroll
      for (int i = 0; i < 8; ++i) acc[g][i] = (f32x2){0.f, 0.f};
#pragma unroll 1
    for (int hb = 0; hb < 16; ++hb) {
#pragma unroll
      for (int g = 0; g < GT; ++g) {
        const int myidx = (int)sidx[g * 128 + hb * 8 + (lane & 7)]; const float mygate = sgate[g * 128 + hb * 8 + vidx];
        const u32x4 h0 = *(const u32x4*)(sx + g * 1024 + lane * 16), h1 = *(const u32x4*)(sx + g * 1024 + lane * 16 + 8);
        const u32 hx[8] = {h0.x, h0.y, h0.z, h0.w, h1.x, h1.y, h1.z, h1.w};
        u32x4 ur[8], vr[8];
#pragma unroll
        for (int k = 0; k < 8; ++k) { const unsigned e = (unsigned)__builtin_amdgcn_readlane(myidx, k); ur[k] = __builtin_amdgcn_raw_buffer_load_b128(rsU, lane16, e * 1024u, 0); if (k < 4) vr[k] = __builtin_amdgcn_raw_buffer_load_b128(rsV, lane16, e * 1024u, 0); }
        float d[8];
#pragma unroll
        for (int k = 0; k < 8; ++k) { const u32 w[4] = {ur[k].x, ur[k].y, ur[k].z, ur[k].w}; float a = 0.f;
#pragma unroll
          for (int j = 0; j < 4; ++j) { const u32 lo = __builtin_bit_cast(u32, __builtin_amdgcn_cvt_scalef32_pk_bf16_fp8(w[j], 1.0f, false)), hi = __builtin_bit_cast(u32, __builtin_amdgcn_cvt_scalef32_pk_bf16_fp8(w[j], 1.0f, true));
            a = dot2bf(lo, hx[2 * j], a); a = dot2bf(hi, hx[2 * j + 1], a); }
          asm volatile("" : "+v"(a));
          d[k] = a; }
        asm volatile("" ::: "memory");
#pragma unroll
        for (int k = 4; k < 8; ++k) { const unsigned e = (unsigned)__builtin_amdgcn_readlane(myidx, k); vr[k] = __builtin_amdgcn_raw_buffer_load_b128(rsV, lane16, e * 1024u, 0); }
        const float z = reduce8(d[0], d[1], d[2], d[3], d[4], d[5], d[6], d[7], lane) * (1.f / U8_SCALE);
        const float cf = mygate * gelu_erf(z) * (1.f / V8_SCALE);
#pragma unroll
        for (int k = 0; k < 8; ++k) { const float ck = __uint_as_float(__builtin_amdgcn_readlane(__float_as_uint(cf), 32 * (k >> 2) + 16 * ((k >> 1) & 1) + 8 * (k & 1)));
          const u32 w[4] = {vr[k].x, vr[k].y, vr[k].z, vr[k].w}; const f32x2 c2 = (f32x2){ck, ck};
#pragma unroll
          for (int j = 0; j < 4; ++j) { const f32x2 lo = __builtin_amdgcn_cvt_pk_f32_fp8((int)w[j], false), hi = __builtin_amdgcn_cvt_pk_f32_fp8((int)w[j], true);
            acc[g][2 * j] = lo * c2 + acc[g][2 * j]; acc[g][2 * j + 1] = hi * c2 + acc[g][2 * j + 1]; } }
        asm volatile("" ::: "memory");
      }
      if ((hb & 3) == 3) __syncthreads();
    }
#pragma unroll
    for (int g = 0; g < GT; ++g) { const int t = tb + g, b = t / S;
      const float* g2 = p.mod + (size_t)(layer * 8 + b) * 6144 + 5120 + lane * 16; float* xp = p.X + (size_t)t * D + lane * 16;
      float xv[16]; float ss = 0.f;
#pragma unroll
      for (int q = 0; q < 4; ++q) { const f32x4 x0 = *(const f32x4*)(xp + 4 * q), g0 = *(const f32x4*)(g2 + 4 * q);
        xv[4 * q + 0] = x0.x + g0.x * acc[g][2 * q].x; xv[4 * q + 1] = x0.y + g0.y * acc[g][2 * q].y; xv[4 * q + 2] = x0.z + g0.z * acc[g][2 * q + 1].x; xv[4 * q + 3] = x0.w + g0.w * acc[g][2 * q + 1].y; }
#pragma unroll
      for (int i = 0; i < 16; ++i) ss += xv[i] * xv[i];
      ss = wave_sum(ss); const float r = rsqrtf(ss * (1.f / D) + EPS);
      if (NEXT == 0) {
        const float* ml = p.mod + (size_t)((layer + 1) * 8 + b) * 6144 + lane * 16; const float* gn = p.nmg + (layer + 1) * D + lane * 16; float y[16];
#pragma unroll
        for (int i = 0; i < 16; ++i) y[i] = xv[i] * r * gn[i] * (1.f + ml[1024 + i]) + ml[i];
#pragma unroll
        for (int q = 0; q < 4; ++q) *(f32x4*)(xp + 4 * q) = (f32x4){xv[4 * q], xv[4 * q + 1], xv[4 * q + 2], xv[4 * q + 3]};
        u32x4 w0, w1; w0.x = pack2(y[0], y[1]); w0.y = pack2(y[2], y[3]); w0.z = pack2(y[4], y[5]); w0.w = pack2(y[6], y[7]); w1.x = pack2(y[8], y[9]); w1.y = pack2(y[10], y[11]); w1.z = pack2(y[12], y[13]); w1.w = pack2(y[14], y[15]);
        *(u32x4*)(p.H + (size_t)t * D + lane * 16) = w0; *(u32x4*)(p.H + (size_t)t * D + lane * 16 + 8) = w1;
      } else {
        const float* fg = p.final_g + lane * 16;
#pragma unroll
        for (int q = 0; q < 4; ++q) *(f32x4*)(xp + 4 * q) = (f32x4){xv[4 * q] * r * fg[4 * q], xv[4 * q + 1] * r * fg[4 * q + 1], xv[4 * q + 2] * r * fg[4 * q + 2], xv[4 * q + 3] * r * fg[4 * q + 3]};
      }
      asm volatile("" ::: "memory");
    }
    __syncthreads();
  }
}

template <bool WITH_GATES>
__device__ void phase_norm(const Params& p, const float* __restrict__ xin, const float* __restrict__ g, const float* __restrict__ modl, int sh_off, int sc_off, char* smem) {
  float* wg = (float*)smem;
  if (WITH_GATES) { __syncthreads(); for (int i = threadIdx.x; i < 16 * 1024; i += NTHREADS) wg[i] = p.Wg[i]; __syncthreads(); }
  for (int job = blockIdx.x; job < T / 32; job += gridDim.x) {
    int tid_ = threadIdx.x; asm volatile("" : "+v"(tid_));
    const int tid = tid_, wid = tid >> 6, lane = tid & 63; const int tb = job * 32 + wid * 4, b = tb / S;
    f32x4 v[4][4];
#pragma unroll
    for (int q = 0; q < 4; ++q)
#pragma unroll
      for (int i = 0; i < 4; ++i) v[q][i] = *(const f32x4*)(xin + (size_t)(tb + q) * D + i * 256 + lane * 4);
    const float* shp = modl + (size_t)b * 6144 + sh_off; const float* scp = modl + (size_t)b * 6144 + sc_off;
    f32x4 ga[4], gc[4];
#pragma unroll
    for (int i = 0; i < 4; ++i) { const int d = i * 256 + lane * 4; const f32x4 gg = *(const f32x4*)(g + d), s1 = *(const f32x4*)(scp + d); ga[i] = gg * (1.f + s1); gc[i] = *(const f32x4*)(shp + d); }
#pragma unroll
    for (int q = 0; q < 4; ++q) { float ss = 0.f;
#pragma unroll
      for (int i = 0; i < 4; ++i) ss += v[q][i].x * v[q][i].x + v[q][i].y * v[q][i].y + v[q][i].z * v[q][i].z + v[q][i].w * v[q][i].w;
      ss = wave_sum(ss); const float r = rsqrtf(ss * (1.f / D) + EPS);
#pragma unroll
      for (int i = 0; i < 4; ++i) { v[q][i] = v[q][i] * r * ga[i] + gc[i]; u32x2 w; w.x = pack2(v[q][i].x, v[q][i].y); w.y = pack2(v[q][i].z, v[q][i].w); *(u32x2*)(p.H + (size_t)(tb + q) * D + i * 256 + lane * 4) = w; }
      if (WITH_GATES) { float myg = 0.f;
#pragma unroll 2
        for (int gi = 0; gi < 16; ++gi) { float a = 0.f;
#pragma unroll
          for (int i = 0; i < 4; ++i) { const f32x4 w4 = *(const f32x4*)(wg + gi * 1024 + i * 256 + lane * 4); a += v[q][i].x * w4.x + v[q][i].y * w4.y + v[q][i].z * w4.z + v[q][i].w * w4.w; }
          a = wave_sum(a); if (lane == gi) myg = a; }
        if (lane < 16) p.gates[(size_t)(tb + q) * 16 + lane] = myg + p.ev_b_in[2560 + lane]; }
    }
  }
}
__device__ void phase_cat(const Params& p) {
  for (int job = blockIdx.x; job < T / 32; job += gridDim.x) {
    int tid_ = threadIdx.x; asm volatile("" : "+v"(tid_));
    const int tid = tid_, wid = tid >> 6, lane = tid & 63; const int tb = job * 32 + wid * 4;
    u32x4 a[4], bq[4], so[4];
#pragma unroll
    for (int q = 0; q < 4; ++q) { const size_t o = (size_t)(tb + q) * 512 + lane * 8; a[q] = *(const u32x4*)(p.HS + o); bq[q] = *(const u32x4*)(p.HS + (size_t)T * 512 + o); so[q] = *(const u32x4*)(p.ZO + o); }
    const f32x4 g0 = *(const f32x4*)(p.mnorm_g + lane * 8), g1 = *(const f32x4*)(p.mnorm_g + lane * 8 + 4);
#pragma unroll
    for (int q = 0; q < 4; ++q) { float x[8]; const u32 aw[4] = {a[q].x, a[q].y, a[q].z, a[q].w}, bw[4] = {bq[q].x, bq[q].y, bq[q].z, bq[q].w}, sw[4] = {so[q].x, so[q].y, so[q].z, so[q].w};
      float ss = 0.f;
#pragma unroll
      for (int j = 0; j < 4; ++j) { x[2 * j] = bflo(aw[j]) + bflo(bw[j]); x[2 * j + 1] = bfhi(aw[j]) + bfhi(bw[j]); ss += x[2 * j] * x[2 * j] + x[2 * j + 1] * x[2 * j + 1]; }
      ss += __shfl_xor(ss, 1); ss += __shfl_xor(ss, 2); ss += __shfl_xor(ss, 4); ss += __shfl_xor(ss, 8);
      const float r = rsqrtf(ss * (1.f / 128.f) + EPS);
      u32x4 w; w.x = pack2(x[0] * r * g0.x * bflo(sw[0]), x[1] * r * g0.y * bfhi(sw[0])); w.y = pack2(x[2] * r * g0.z * bflo(sw[1]), x[3] * r * g0.w * bfhi(sw[1]));
      w.z = pack2(x[4] * r * g1.x * bflo(sw[2]), x[5] * r * g1.y * bfhi(sw[2])); w.w = pack2(x[6] * r * g1.z * bflo(sw[3]), x[7] * r * g1.w * bfhi(sw[3]));
      *(u32x4*)(p.CAT + (size_t)(tb + q) * 1024 + lane * 8) = w; }
  }
}
__device__ void phase_qkrope(const Params& p, char* smem) {
  float* tab = (float*)smem;
  __syncthreads();
  for (int i = threadIdx.x; i < 64 * 32; i += NTHREADS) { const int pos = i >> 5, fi = i & 31; const float fr = exp2f(-(float)(2 * fi) * (13.287712379549449f / 64.f)); float sn, cs; sincosf((float)pos * fr, &sn, &cs); tab[2 * i] = cs; tab[2 * i + 1] = sn; }
  __syncthreads();
  for (int job = blockIdx.x; job < T / 16; job += gridDim.x) {
    int tid_ = threadIdx.x; asm volatile("" : "+v"(tid_));
    const int tid = tid_, wid = tid >> 6, lane = tid & 63; const int tb = job * 16 + wid * 2;
    u32x4 raw[2][3];
#pragma unroll
    for (int q = 0; q < 2; ++q)
#pragma unroll
      for (int i = 0; i < 3; ++i) raw[q][i] = *(const u32x4*)(p.QKV + (size_t)(tb + q) * 1536 + (lane + 64 * i) * 8);
#pragma unroll
    for (int q = 0; q < 2; ++q) { const int t = tb + q, b = t / S, s = t & (S - 1);
#pragma unroll
      for (int i = 0; i < 3; ++i) { const int c = lane + 64 * i, hh = c >> 4, cc = c & 15; float x[8]; const u32 rw[4] = {raw[q][i].x, raw[q][i].y, raw[q][i].z, raw[q][i].w};
#pragma unroll
        for (int j = 0; j < 4; ++j) { x[2 * j] = bflo(rw[j]); x[2 * j + 1] = bfhi(rw[j]); }
        u32x4 w;
        if (hh < 10) { float ss = 0.f;
#pragma unroll
          for (int j = 0; j < 8; ++j) ss += x[j] * x[j];
          ss += __shfl_xor(ss, 1); ss += __shfl_xor(ss, 2); ss += __shfl_xor(ss, 4); ss += __shfl_xor(ss, 8);
          const float r = rsqrtf(ss * (1.f / 128.f) + EPS); const float* gp = (hh < 8 ? p.qn_g : p.kn_g) + cc * 8;
          const int pos = cc < 8 ? (s >> 6) : (s & 63); const float* tp = tab + (pos * 32 + (cc & 7) * 4) * 2; float y[8];
#pragma unroll
          for (int j = 0; j < 4; ++j) { const float x0 = x[2 * j] * r * gp[2 * j], x1 = x[2 * j + 1] * r * gp[2 * j + 1], cs = tp[2 * j], sn = tp[2 * j + 1]; y[2 * j] = x0 * cs - x1 * sn; y[2 * j + 1] = x0 * sn + x1 * cs; }
          w.x = pack2(y[0], y[1]); w.y = pack2(y[2], y[3]); w.z = pack2(y[4], y[5]); w.w = pack2(y[6], y[7]);
        } else w = raw[q][i];
        bf16_t* dst = hh < 8 ? p.Qh + (((size_t)b * 8 + hh) * S + s) * 128 : (hh < 10 ? p.Kh + (((size_t)b * 2 + hh - 8) * S + s) * 128 : p.Vh + (((size_t)b * 2 + hh - 10) * S + s) * 128);
        *(u32x4*)(dst + cc * 8) = w; }
    }
  }
}

__device__ void phase_attn_naive(const Params& p) {
  const int tid = threadIdx.x, wid = tid >> 6, lane = tid & 63;
  for (int job = blockIdx.x; job < T * 2 / 8; job += gridDim.x) {
    const int w = job * 8 + wid, kv = w & 1, t = w >> 1, b = t / S, s = t & (S - 1);
    float q0[4], q1[4], m[4], l[4], o0[4], o1[4];
#pragma unroll
    for (int g = 0; g < 4; ++g) { const u32 qq = *(const u32*)(p.Qh + (((size_t)b * 8 + kv * 4 + g) * S + s) * 128 + lane * 2); q0[g] = bflo(qq); q1[g] = bfhi(qq); m[g] = -1e30f; l[g] = 0.f; o0[g] = 0.f; o1[g] = 0.f; }
    const bf16_t* Kb = p.Kh + ((size_t)b * 2 + kv) * S * 128; const bf16_t* Vb = p.Vh + ((size_t)b * 2 + kv) * S * 128;
    for (int k = 0; k < S; ++k) { const u32 kk = *(const u32*)(Kb + (size_t)k * 128 + lane * 2), vv = *(const u32*)(Vb + (size_t)k * 128 + lane * 2);
      const float k0 = bflo(kk), k1 = bfhi(kk), v0 = bflo(vv), v1 = bfhi(vv);
#pragma unroll
      for (int g = 0; g < 4; ++g) { const float sc = wave_sum(q0[g] * k0 + q1[g] * k1) * KSCALE; const float mn = fmaxf(m[g], sc), al = __expf(m[g] - mn), pw = __expf(sc - mn);
        l[g] = l[g] * al + pw; o0[g] = o0[g] * al + pw * v0; o1[g] = o1[g] * al + pw * v1; m[g] = mn; } }
#pragma unroll
    for (int g = 0; g < 4; ++g) *(u32*)(p.CAT + (size_t)t * 1024 + (kv * 4 + g) * 128 + lane * 2) = pack2(o0[g] / l[g], o1[g] / l[g]);
  }
}

namespace att {
using bf16 = unsigned short;
constexpr int   D = 128, NW = 8, QBLK = 32, KVBLK = 64;
constexpr float SCALE = 0.088388347648318440f;
constexpr float THR = 8.f;
constexpr int SDEPTH = 2;
constexpr int LDQ = 128, LDK = 128, LDO = 1024;
constexpr size_t SHM_V = KVBLK * D * 2, SHM_K = KVBLK * D * 2, SHM_ATTN = 2 * SHM_V + 2 * SHM_K + NW * 64 * 4;
using bf16x8 = __attribute__((ext_vector_type(8))) short;
using s16x4  = __attribute__((ext_vector_type(4))) short;
using f32x16 = __attribute__((ext_vector_type(16))) float;
using f32x8  = __attribute__((ext_vector_type(8))) float;
using u32x4  = __attribute__((ext_vector_type(4))) unsigned;
#define KSWZ(row, colB) ((row) * 256 + ((colB) ^ (((row) & 7) << 4)))
#define SBAR() __builtin_amdgcn_sched_barrier(0)
__device__ __forceinline__ int crow(int r, int hi) { return (r & 3) + 8 * (r >> 2) + 4 * hi; }
__device__ __forceinline__ unsigned cvtpk(float lo, float hi) {
  unsigned r; asm volatile("v_cvt_pk_bf16_f32 %0, %1, %2" : "=v"(r) : "v"(lo), "v"(hi)); return r;
}
template <typename TIn> struct Stage;
template <> struct Stage<bf16>  { using T = bf16x8;
  __device__ static __forceinline__ T ld8(const bf16* p) { return *reinterpret_cast<const bf16x8*>(p); }
  __device__ static __forceinline__ bf16x8 tobf(T x) { return x; } };
template <> struct Stage<float> { using T = f32x8;
  __device__ static __forceinline__ T ld8(const float* p) { return *reinterpret_cast<const f32x8*>(p); }
  __device__ static __forceinline__ bf16x8 tobf(T x) {
    u32x4 w = {cvtpk(x[0], x[1]), cvtpk(x[2], x[3]), cvtpk(x[4], x[5]), cvtpk(x[6], x[7])}; return *reinterpret_cast<bf16x8*>(&w); } };

__device__ __forceinline__ void partialSM(f32x16& p0, f32x16& p1, float& m_reg, float& mn, float& alpha) {
  constexpr float C = SCALE * 1.4426950408889634f;
  float pmax = p0[0]; for (int r = 1; r < 16; ++r) pmax = fmaxf(pmax, p0[r]); for (int r = 0; r < 16; ++r) pmax = fmaxf(pmax, p1[r]);
  { auto rr = __builtin_amdgcn_permlane32_swap(__float_as_uint(pmax), __float_as_uint(pmax), false, false);
    pmax = fmaxf(__uint_as_float(rr[0]), __uint_as_float(rr[1])); }
  if (__builtin_expect(__all(pmax - m_reg <= THR / SCALE), 1)) { mn = m_reg; alpha = 1.f; }
  else { mn = fmaxf(m_reg, pmax); alpha = __builtin_amdgcn_exp2f((m_reg - mn) * C); m_reg = mn; }
  float mnC = -mn * C;
  for (int r = 0; r < 16; ++r) p0[r] = fmaf(p0[r], C, mnC); for (int r = 0; r < 16; ++r) p1[r] = fmaf(p1[r], C, mnC);
  for (int r = 0; r < 16; ++r) p0[r] = __builtin_amdgcn_exp2f(p0[r]);
}
__device__ __forceinline__ void finishSM(f32x16& p0, f32x16& p1, float alpha, float& l_reg, bf16x8& pa0, bf16x8& pa1, bf16x8& pa2, bf16x8& pa3) {
  for (int r = 0; r < 16; ++r) p1[r] = __builtin_amdgcn_exp2f(p1[r]);
  float ps = 0; for (int r = 0; r < 16; ++r) ps += p0[r]; for (int r = 0; r < 16; ++r) ps += p1[r];
  { auto rr = __builtin_amdgcn_permlane32_swap(__float_as_uint(ps), __float_as_uint(ps), false, false);
    ps = __uint_as_float(rr[0]) + __uint_as_float(rr[1]); }
  l_reg = l_reg * alpha + ps;
#define PK4(P, BASE, OUT) do { unsigned a0 = cvtpk(P[BASE + 0], P[BASE + 1]), a1 = cvtpk(P[BASE + 2], P[BASE + 3]);   \
    unsigned b0 = cvtpk(P[BASE + 4], P[BASE + 5]), b1 = cvtpk(P[BASE + 6], P[BASE + 7]);                              \
    auto r0 = __builtin_amdgcn_permlane32_swap(a0, b0, false, false); auto r1 = __builtin_amdgcn_permlane32_swap(a1, b1, false, false); \
    u32x4 w = {r0[0], r1[0], r0[1], r1[1]}; OUT = *reinterpret_cast<bf16x8*>(&w); } while (0)
  PK4(p0, 0, pa0); PK4(p0, 8, pa1); PK4(p1, 0, pa2); PK4(p1, 8, pa3);
#undef PK4
}
__device__ __forceinline__ void qkt(f32x16& p0, f32x16& p1, const bf16* Ks, const bf16x8* qr, int r32, int hi) {
  p0 = f32x16{}; p1 = f32x16{};
  for (int d0 = 0; d0 < 8; ++d0) { int cb = (d0 * 16 + hi * 8) * 2;
    bf16x8 b0 = *reinterpret_cast<const bf16x8*>((const char*)Ks + KSWZ(r32, cb));
    bf16x8 b1 = *reinterpret_cast<const bf16x8*>((const char*)Ks + KSWZ(32 + r32, cb));
    p0 = __builtin_amdgcn_mfma_f32_32x32x16_bf16(b0, qr[d0], p0, 0, 0, 0);
    p1 = __builtin_amdgcn_mfma_f32_32x32x16_bf16(b1, qr[d0], p1, 0, 0, 0); }
}
__device__ __forceinline__ int v_st(int k, int c) { const int kk = (k & ~0xC) | ((k & 4) << 1) | ((k & 8) >> 1); return ((kk >> 3) * 4 + (c >> 5)) * 512 + ((kk & 7) * 32 + (c & 31)) * 2; }
__device__ __forceinline__ int v_rd_base(int lane) { return ((lane & 3) << 3) | (((lane >> 2) & 3) << 6) | (((lane >> 4) & 1) << 5) | (((lane >> 5) & 1) << 8); }
constexpr int v_rd_off(int d0, int ks, int half) { return d0 * 512 + ks * 4096 + half * 2048; }
template <int OFF> __device__ __forceinline__ s16x4 tr_read(int vb) {
  s16x4 r; asm volatile("ds_read_b64_tr_b16 %0, %1 offset:%2" : "=&v"(r) : "v"(vb), "i"(OFF) : "memory"); return r;
}
template <int D0> __device__ __forceinline__ void pv_one(f32x16& od, int vb, bf16x8 pa0, bf16x8 pa1, bf16x8 pa2, bf16x8 pa3) {
  const s16x4 l0 = tr_read<v_rd_off(D0, 0, 0)>(vb), h0 = tr_read<v_rd_off(D0, 0, 1)>(vb), l1 = tr_read<v_rd_off(D0, 1, 0)>(vb), h1 = tr_read<v_rd_off(D0, 1, 1)>(vb);
  const s16x4 l2 = tr_read<v_rd_off(D0, 2, 0)>(vb), h2 = tr_read<v_rd_off(D0, 2, 1)>(vb), l3 = tr_read<v_rd_off(D0, 3, 0)>(vb), h3 = tr_read<v_rd_off(D0, 3, 1)>(vb);
  asm volatile("s_waitcnt lgkmcnt(0)" ::: "memory"); SBAR();
#define PK(L, H) (bf16x8){L[0], L[1], L[2], L[3], H[0], H[1], H[2], H[3]}
  od = __builtin_amdgcn_mfma_f32_32x32x16_bf16(pa0, PK(l0, h0), od, 0, 0, 0);
  od = __builtin_amdgcn_mfma_f32_32x32x16_bf16(pa1, PK(l1, h1), od, 0, 0, 0);
  od = __builtin_amdgcn_mfma_f32_32x32x16_bf16(pa2, PK(l2, h2), od, 0, 0, 0);
  od = __builtin_amdgcn_mfma_f32_32x32x16_bf16(pa3, PK(l3, h3), od, 0, 0, 0);
#undef PK
}
__device__ __forceinline__ void pv_d0(f32x16* o, int vb, bf16x8 pa0, bf16x8 pa1, bf16x8 pa2, bf16x8 pa3) {
  pv_one<0>(o[0], vb, pa0, pa1, pa2, pa3); pv_one<1>(o[1], vb, pa0, pa1, pa2, pa3); pv_one<2>(o[2], vb, pa0, pa1, pa2, pa3); pv_one<3>(o[3], vb, pa0, pa1, pa2, pa3);
}

template <typename TQ>
__device__ __forceinline__ void attn_dense_body(const TQ* __restrict__ Qb, const bf16* __restrict__ Kh, const bf16* __restrict__ Vh,
                                                bf16* __restrict__ Ob, int seq, char* lds) {
  using St = Stage<bf16>; using SQ = Stage<TQ>;
  int tid_ = threadIdx.x; asm volatile("" : "+v"(tid_)); const int tid = tid_, wid = tid >> 6, lane = tid & 63, r32 = lane & 31, hi = lane >> 5;
  bf16* V_lds = (bf16*)lds; bf16* K_lds = (bf16*)(lds + 2 * SHM_V);
  float* ws = (float*)(lds + 2 * SHM_V + 2 * SHM_K) + wid * 64; float* li_l = ws; float* al_l = ws + 32;
  float m_reg = -1e30f, l_reg = 0; f32x16 o[4] = {}; bf16x8 qr[8];
  const TQ* Qw = Qb + (long)(wid * QBLK + r32) * LDQ + hi * 8;
#pragma unroll
  for (int d0 = 0; d0 < 8; ++d0) qr[d0] = SQ::tobf(SQ::ld8(Qw + d0 * 16));
  const int sr = tid >> 4, sc = (tid & 15) * 8, vst0 = v_st(sr, sc), vst1 = v_st(32 + sr, sc);
  const int vb0 = (int)(uintptr_t)V_lds + v_rd_base(lane);
  struct { typename St::T vs0, vs1, ks0, ks1; } sr_[SDEPTH];
#define SLOAD(i, k0) do { sr_[i].vs0 = St::ld8(&Vh[(long)((k0) + sr) * LDK + sc]); sr_[i].vs1 = St::ld8(&Vh[(long)((k0) + 32 + sr) * LDK + sc]); \
    sr_[i].ks0 = St::ld8(&Kh[(long)((k0) + sr) * LDK + sc]); sr_[i].ks1 = St::ld8(&Kh[(long)((k0) + 32 + sr) * LDK + sc]); } while (0)
#define SWRITE(b, i) do { *(bf16x8*)((char*)V_lds + (b) * SHM_V + vst0) = St::tobf(sr_[i].vs0);          \
    *(bf16x8*)((char*)V_lds + (b) * SHM_V + vst1) = St::tobf(sr_[i].vs1); int kc = sc * 2;               \
    *(bf16x8*)((char*)K_lds + (b) * SHM_K + KSWZ(sr, kc)) = St::tobf(sr_[i].ks0);                       \
    *(bf16x8*)((char*)K_lds + (b) * SHM_K + KSWZ(32 + sr, kc)) = St::tobf(sr_[i].ks1); } while (0)
#define SWAIT() do { if constexpr (SDEPTH == 2) asm volatile("s_waitcnt vmcnt(4)" ::: "memory"); else asm volatile("s_waitcnt vmcnt(0)" ::: "memory"); } while (0)
#define RESC(a) do { if (__any((a) < 1.f)) { if (hi == 0) al_l[r32] = (a); asm volatile("s_waitcnt lgkmcnt(0)" ::: "memory"); \
    for (int d = 0; d < 4; ++d) for (int r = 0; r < 16; ++r) o[d][r] *= al_l[crow(r, hi)]; } } while (0)
  f32x16 pA0, pA1, pB0, pB1; float mnA, mnB, alA, alB; bf16x8 pa0, pa1, pa2, pa3; const int NT = seq / KVBLK;
  constexpr int SE = 0, SO = SDEPTH - 1;
  SLOAD(SE, 0); asm volatile("s_waitcnt vmcnt(0)" ::: "memory"); SWRITE(0, SE); __syncthreads();
  qkt(pA0, pA1, K_lds, qr, r32, hi); partialSM(pA0, pA1, m_reg, mnA, alA);
  SLOAD(SO, KVBLK); if constexpr (SDEPTH == 2) { if (2 < NT) SLOAD(SE, 2 * KVBLK); }
  SWAIT(); SWRITE(1, SO); __syncthreads();
  for (int j = 1; j + 1 < NT; j += 2) {
    SBAR(); qkt(pB0, pB1, (bf16*)((char*)K_lds + SHM_K), qr, r32, hi);
    finishSM(pA0, pA1, alA, l_reg, pa0, pa1, pa2, pa3); SBAR();
    SLOAD(SO, (j + SDEPTH) * KVBLK); SBAR();
    pv_d0(o, vb0, pa0, pa1, pa2, pa3); partialSM(pB0, pB1, m_reg, mnB, alB);
    __syncthreads(); SWAIT(); SWRITE(0, SE);
    RESC(alB); __syncthreads();
    SBAR(); qkt(pA0, pA1, K_lds, qr, r32, hi);
    finishSM(pB0, pB1, alB, l_reg, pa0, pa1, pa2, pa3); SBAR();
    if (SDEPTH == 1 || j + 3 < NT) SLOAD(SE, (j + 1 + SDEPTH) * KVBLK); SBAR();
    pv_d0(o, vb0 + (int)SHM_V, pa0, pa1, pa2, pa3); partialSM(pA0, pA1, m_reg, mnA, alA);
    __syncthreads(); SWAIT(); SWRITE(1, SO);
    RESC(alA); __syncthreads();
  }
  SBAR(); qkt(pB0, pB1, (bf16*)((char*)K_lds + SHM_K), qr, r32, hi);
  finishSM(pA0, pA1, alA, l_reg, pa0, pa1, pa2, pa3); SBAR();
  pv_d0(o, vb0, pa0, pa1, pa2, pa3); partialSM(pB0, pB1, m_reg, mnB, alB);
  __syncthreads(); RESC(alB);
  finishSM(pB0, pB1, alB, l_reg, pa0, pa1, pa2, pa3); SBAR();
  pv_d0(o, vb0 + (int)SHM_V, pa0, pa1, pa2, pa3);
  if (hi == 0) li_l[r32] = l_reg; asm volatile("s_waitcnt lgkmcnt(0)" ::: "memory");
  float rli[16];
#pragma unroll
  for (int r = 0; r < 16; ++r) rli[r] = __builtin_amdgcn_rcpf(li_l[crow(r, hi)]);
  __syncthreads();
  bf16* Ol = (bf16*)lds + wid * (QBLK * D);
#pragma unroll
  for (int r = 0; r < 16; ++r) { const int orow = crow(r, hi);
#pragma unroll
    for (int d0 = 0; d0 < 4; ++d0) { const float v = o[d0][r] * rli[r]; unsigned u = __float_as_uint(v); u += 0x7FFFu + ((u >> 16) & 1u); Ol[orow * D + d0 * 32 + r32] = (bf16)(u >> 16); } }
  asm volatile("s_waitcnt lgkmcnt(0)" ::: "memory");
#pragma unroll
  for (int i = 0; i < 8; ++i) { const int row = i * 4 + (lane >> 4), ch = (lane & 15) * 8;
    const u32x4 v = *reinterpret_cast<const u32x4*>(Ol + row * D + ch);
    *reinterpret_cast<u32x4*>(Ob + (long)(wid * QBLK + row) * LDO + ch) = v; }
  __syncthreads();
#undef SLOAD
#undef SWRITE
#undef SWAIT
#undef RESC
}

}

__device__ void phase_attn(const Params& p, char* smem) {
  const int G = (int)gridDim.x, c = (int)blockIdx.x;
  for (int i = 0; i * G + c < 1024; ++i) {
    int pair, j;
    if (G == 256) { pair = 2 * (c & 7) + (i >> 1); j = (i & 1) * 32 + (c >> 3); } else { const int L = i * G + c; pair = L >> 6; j = L & 63; }
    const int b = pair >> 1, kv = pair & 1, qb = j >> 2, g = j & 3, h = kv * 4 + g;
    const bf16_t* Qb = p.Qh + (((size_t)b * 8 + h) * S + qb * 256) * 128; const bf16_t* Kp = p.Kh + ((size_t)b * 2 + kv) * S * 128; const bf16_t* Vp = p.Vh + ((size_t)b * 2 + kv) * S * 128;
    bf16_t* Ob = p.CAT + ((size_t)b * S + qb * 256) * 1024 + h * 128;
    att::attn_dense_body<att::bf16>(Qb, Kp, Vp, Ob, S, smem);
  }
}

#define XB_TMO      128
#define XB_XCNT(j)  (256  + 64 * (j))
#define XB_XSUB(j)  (1280 + 64 * (j))
#define XB_XGEN(j)  (2304 + 64 * (j))
#define XB_TOP      3328
#define XB_TOPGEN   3392
#define XCD_BAR_WORDS 3456
#define XB_SPIN_CAP (1u << 18)
#define LAS __attribute__((address_space(3)))

__device__ __forceinline__ unsigned xb_ld(unsigned* p)              { return __hip_atomic_load(p, __ATOMIC_RELAXED, __HIP_MEMORY_SCOPE_AGENT); }
__device__ __forceinline__ unsigned xb_add(unsigned* p, unsigned v) { return __hip_atomic_fetch_add(p, v, __ATOMIC_RELAXED, __HIP_MEMORY_SCOPE_AGENT); }
__device__ __forceinline__ unsigned xb_xcc_id() { return (unsigned)__builtin_amdgcn_s_getreg((3 << 11) | 20) & 0xFu; }
#define XB_SPIN(cond, bar) do { unsigned _sp = 0; while (cond) { __builtin_amdgcn_s_sleep(1); \
    if ((++_sp & 255u) == 0u) { if (xb_ld(&(bar)[XB_TMO])) break; if (_sp > XB_SPIN_CAP) { atomicAdd(&(bar)[XB_TMO], 1u); break; } } } } while (0)

struct XcdBarrier {
    unsigned* bar; unsigned x;
    volatile LAS unsigned* st;
};

__device__ __forceinline__ XcdBarrier xcd_barrier_post(unsigned* bar, volatile LAS unsigned* st) {
    XcdBarrier b; b.bar = bar; b.x = xb_xcc_id(); b.st = st;
    if (threadIdx.x == 0) (void)xb_add(&bar[XB_XCNT(b.x)], 1u);
    return b;
}
__device__ __forceinline__ void xcd_barrier_complete(unsigned* bar, unsigned x, unsigned& nloc, unsigned& nx) {
    const unsigned G = gridDim.x * gridDim.y * gridDim.z;
    unsigned sum, cnt, mine, sp = 0u;
    for (;;) {
        sum = 0u; cnt = 0u; mine = 0u;
#pragma unroll
        for (unsigned j = 0; j < 16; ++j) { const unsigned c = xb_ld(&bar[XB_XCNT(j)]); sum += c; cnt += (c > 0u) ? 1u : 0u; mine = (j == x) ? c : mine; }
        if (sum == G) break;
        __builtin_amdgcn_s_sleep(1);
        if ((++sp & 255u) == 0u) { if (xb_ld(&bar[XB_TMO])) break; if (sp > XB_SPIN_CAP) { atomicAdd(&bar[XB_TMO], 1u); break; } }
    }
    nloc = mine > 0u ? mine : 1u; nx = cnt > 0u ? cnt : 1u;
}

__device__ __forceinline__ void xcd_barrier(const XcdBarrier& b) {
    asm volatile("s_waitcnt vmcnt(0)" ::: "memory");
    __syncthreads();
    if (threadIdx.x == 0) {
        unsigned* bar = b.bar;
        __builtin_amdgcn_s_waitcnt(0);
        unsigned nloc = b.st[0], nx = b.st[1];
        if (nloc == 0u) { xcd_barrier_complete(bar, b.x, nloc, nx); b.st[0] = nloc; b.st[1] = nx; }
        const unsigned old = xb_add(&bar[XB_XSUB(b.x)], 1u);
        const unsigned gen = old / nloc;
        if (old + 1u == (gen + 1u) * nloc) {
            __builtin_amdgcn_fence(__ATOMIC_RELEASE, "agent");
            asm volatile("s_waitcnt vmcnt(0)" ::: "memory");
            const unsigned og = xb_add(&bar[XB_TOP], 1u);
            const unsigned tg = og / nx;
            if (og + 1u == (tg + 1u) * nx) xb_add(&bar[XB_TOPGEN], 1u);
            else XB_SPIN(xb_ld(&bar[XB_TOPGEN]) == tg, bar);
            __builtin_amdgcn_fence(__ATOMIC_ACQUIRE, "agent");
            xb_add(&bar[XB_XGEN(b.x)], 1u);
            asm volatile("s_waitcnt vmcnt(0)" ::: "memory");
        } else {
            XB_SPIN(xb_ld(&bar[XB_XGEN(b.x)]) == gen, bar);
            __builtin_amdgcn_fence(__ATOMIC_ACQUIRE, "agent");
            asm volatile("s_waitcnt vmcnt(0)" ::: "memory");
        }
    }
    __syncthreads();
}


constexpr int NPH = 19;
__global__ __launch_bounds__(NTHREADS, 2) void mega(Params p, int ph0, int ph1) {
  extern __shared__ __attribute__((aligned(16))) char smem[];
  cg::grid_group grid = cg::this_grid();
  volatile LAS unsigned* xst = (volatile LAS unsigned*)(LAS char*)(smem + SMEM_BYTES - 16);
  if (threadIdx.x == 0) { xst[0] = 0u; xst[1] = 0u; }
  __syncthreads();
  const XcdBarrier xb = xcd_barrier_post(p.bar, xst);
#ifndef REP_MASK
#define REP_MASK 0
#endif
#define GSYNC(k) do { if ((k) == 1) grid.sync(); else xcd_barrier(xb); } while (0)
#define PHASE(k, call) if (ph0 <= (k) && (k) < ph1) { if ((k) > ph0) GSYNC(k); if ((REP_MASK >> (k)) & 1) { { call; } xcd_barrier(xb); } call; }
#if !defined(ONLY_PHASE) || ONLY_PHASE == 0
  PHASE(0, phase_prep(p, smem))
#endif
#if !defined(ONLY_PHASE) || ONLY_PHASE == 1
  PHASE(1, phase_norm<true>(p, p.x, p.nmg, p.mod, 0, 1024, smem))
#endif
#if !defined(ONLY_PHASE) || ONLY_PHASE == 2
  PHASE(2, phase_gemm_fast(p.H, p.Wt_evin, T, 2560, 1024, (EpiEvin{p.ZQK, p.ZV, p.ZO, p.ZP, p.ev_b_in}), smem))
#endif
#if !defined(ONLY_PHASE) || ONLY_PHASE == 3
  PHASE(3, cp::phase_convpool(p, smem))
#endif
#if !defined(ONLY_PHASE) || ONLY_PHASE == 4
  PHASE(4, ml::phase_mlstm(p, smem))
#endif
#if !defined(ONLY_PHASE) || ONLY_PHASE == 5
  PHASE(5, phase_cat(p))
#endif
#if !defined(ONLY_PHASE) || ONLY_PHASE == 6
  PHASE(6, phase_gemm_fast(p.CAT, p.Wt_evout, T, 1024, 1024, (EpiRes{p.x, p.X, p.mod + 2048}), smem))
#endif
#if !defined(ONLY_PHASE) || ONLY_PHASE == 7
  PHASE(7, phase_norm<false>(p, p.X, p.nfg, p.mod, 3072, 4096, smem))
#endif
#if !defined(ONLY_PHASE) || ONLY_PHASE == 8
  PHASE(8, phase_gemm_fast(p.H, p.Wt_q, T, 2048, 1024, (EpiPlain{p.QP, 2048}), smem))
#endif
#if !defined(ONLY_PHASE) || ONLY_PHASE == 9
  PHASE(9, sel::phase_peer_select(p, 0, smem))
#endif
#if !defined(ONLY_PHASE) || ONLY_PHASE == 10
  PHASE(10, phase_peer_gather<0>(p, 0, smem))
#endif
#if !defined(ONLY_PHASE) || ONLY_PHASE == 11
  PHASE(11, phase_gemm_fast(p.H, p.Wt_odin, T, 1536, 1024, (EpiPlain{p.QKV, 1536}), smem))
#endif
#if !defined(ONLY_PHASE) || ONLY_PHASE == 12
  PHASE(12, phase_qkrope(p, smem))
#endif
#if !defined(ONLY_PHASE) || ONLY_PHASE == 13
  PHASE(13, phase_attn(p, smem))
#endif
#if !defined(ONLY_PHASE) || ONLY_PHASE == 14
  PHASE(14, phase_gemm_fast(p.CAT, p.Wt_odout, T, 1024, 1024, (EpiRes{p.X, p.X, p.mod + (size_t)8 * 6144 + 2048}), smem))
#endif
#if !defined(ONLY_PHASE) || ONLY_PHASE == 15
  PHASE(15, phase_norm<false>(p, p.X, p.nfg + D, p.mod + (size_t)8 * 6144, 3072, 4096, smem))
#endif
#if !defined(ONLY_PHASE) || ONLY_PHASE == 16
  PHASE(16, phase_gemm_fast(p.H, p.Wt_q + (size_t)2048 * 1024, T, 2048, 1024, (EpiPlain{p.QP, 2048}), smem))
#endif
#if !defined(ONLY_PHASE) || ONLY_PHASE == 17
  PHASE(17, sel::phase_peer_select(p, 1, smem))
#endif
#if !defined(ONLY_PHASE) || ONLY_PHASE == 18
  PHASE(18, phase_peer_gather<1>(p, 1, smem))
#endif
#undef PHASE
}
}

extern "C" void kernel_launch(void* const* d_in, const int* in_sizes, int n_in, void* d_out, int out_size, void* d_ws, size_t ws_size, hipStream_t stream) {
  (void)in_sizes; (void)n_in; (void)out_size;
  Params p{};
  const float** fin = (const float**)&p;
  for (int i = 0; i < 23; ++i) fin[i] = (const float*)d_in[i];
  p.X = (float*)d_out;
  char* ws = (char*)d_ws; size_t off = 0;
  auto alloc = [&](size_t bytes) { char* q = ws + off; off += (bytes + 255) / 256 * 256; return q; };
  p.U8 = (unsigned char*)alloc((size_t)2 * 16384 * 1024); p.V8 = (unsigned char*)alloc((size_t)2 * 16384 * 1024);
  p.Wt_evin = (bf16_t*)alloc((size_t)2560 * 1024 * 2); p.Wt_evout = (bf16_t*)alloc((size_t)1024 * 1024 * 2); p.Wt_odin = (bf16_t*)alloc((size_t)1536 * 1024 * 2);
  p.Wt_odout = (bf16_t*)alloc((size_t)1024 * 1024 * 2); p.Wt_q = (bf16_t*)alloc((size_t)2 * 2048 * 1024 * 2); p.keysb = (bf16_t*)alloc((size_t)2 * 2 * 128 * 128 * 2); p.poolWt = (bf16_t*)alloc((size_t)4 * 128 * 128 * 2);
  p.Wg = (float*)alloc(16 * 1024 * 4); p.mod = (float*)alloc(2 * 8 * 6144 * 4); p.gates = (float*)alloc((size_t)T * 16 * 4);
  p.pgate = (float*)alloc((size_t)T * 128 * 4); p.pidx = (bf16_t*)alloc((size_t)T * 128 * 2);
  p.H = (bf16_t*)alloc((size_t)T * 1024 * 2); p.CAT = p.H;
  char* big = alloc((size_t)T * 2048 * 2);
  p.ZQK = (bf16_t*)big; p.ZV = (bf16_t*)(big + (size_t)T * 1024 * 2); p.ZO = (bf16_t*)(big + (size_t)T * 1536 * 2); p.HS = (bf16_t*)big; p.QP = (bf16_t*)big; p.QKV = (bf16_t*)big;
  char* big2 = alloc((size_t)T * 1536 * 2);
  p.QK = (bf16_t*)big2; p.ZP = (bf16_t*)(big2 + (size_t)T * 1024 * 2); p.Qh = (bf16_t*)big2; p.Kh = (bf16_t*)(big2 + (size_t)T * 1024 * 2); p.Vh = (bf16_t*)(big2 + (size_t)T * 1280 * 2);
  p.bar = (unsigned*)alloc(XCD_BAR_WORDS * 4);
  if (off > ws_size) { fprintf(stderr, "kernel_launch: workspace too small: need %zu have %zu\n", off, ws_size); return; }

  static int grid_blocks = 0;
  if (!grid_blocks) {
    int dev = 0, cus = 0, per_cu = 0; hipGetDevice(&dev); hipDeviceGetAttribute(&cus, hipDeviceAttributeMultiprocessorCount, dev);
    hipFuncSetAttribute((const void*)mega, hipFuncAttributeMaxDynamicSharedMemorySize, SMEM_BYTES);
    hipOccupancyMaxActiveBlocksPerMultiprocessor(&per_cu, mega, NTHREADS, SMEM_BYTES);
    if (per_cu > 1) per_cu = 1;
    grid_blocks = cus * per_cu;
    if (grid_blocks <= 0) { fprintf(stderr, "kernel_launch: occupancy query returned 0\n"); grid_blocks = 0; return; }
  }
  hipMemsetAsync(p.bar, 0, XCD_BAR_WORDS * 4, stream);
#if MULTI_LAUNCH
  for (int ph = 0; ph < NPH; ++ph) hipLaunchKernelGGL(mega, dim3(grid_blocks), dim3(NTHREADS), SMEM_BYTES, stream, p, ph, ph + 1);
#else
  int ph0 = 0, ph1 = NPH; void* args[] = {&p, &ph0, &ph1};
  hipError_t e = hipLaunchCooperativeKernel((const void*)mega, dim3(grid_blocks), dim3(NTHREADS), args, SMEM_BYTES, stream);
  if (e != hipSuccess) fprintf(stderr, "cooperative launch failed: %s (grid %d)\n", hipGetErrorString(e), grid_blocks);
#endif
}
```

```cpp
#include <hip/hip_runtime.h>
#include <hip/hip_cooperative_groups.h>
#include <math.h>
#include <stdint.h>
#include <stdio.h>
namespace cg = cooperative_groups;

#ifndef MULTI_LAUNCH
#define MULTI_LAUNCH 0
#endif

namespace {
typedef unsigned short bf16_t;
typedef unsigned int u32;
typedef float f32x4 __attribute__((ext_vector_type(4)));
typedef u32 u32x4 __attribute__((ext_vector_type(4)));
typedef u32 u32x2 __attribute__((ext_vector_type(2)));
typedef __bf16 bf16x2_t __attribute__((ext_vector_type(2)));

constexpr int D = 1024, NB = 8, S = 4096, T = NB * S;
constexpr int EVEN_IN = 2576;
constexpr float EPS = 1e-6f;
constexpr int NTHREADS = 512;
constexpr int SMEM_BYTES = 160 * 1024;
constexpr float KSCALE = 0.08838834764831845f;

struct Params {
  const float *x, *c, *ada_w, *ada_b, *nmg, *nfg, *ev_w_in, *ev_b_in, *conv_w, *conv_b, *mnorm_g, *pool_w, *pool_sc, *ev_w_out, *od_w_in, *qn_g, *kn_g, *od_w_out,
      *peer_wq, *peer_keys, *peer_u, *peer_v, *final_g;
  float* X;
  bf16_t *Wt_evin, *Wt_evout, *Wt_odin, *Wt_odout, *Wt_q, *keysb, *poolWt; unsigned char *U8, *V8;
  float *Wg, *mod, *gates, *pgate;
  bf16_t *H, *ZQK, *ZV, *ZO, *ZP, *QK, *HS, *CAT, *QP, *QKV, *Qh, *Kh, *Vh;
  bf16_t* pidx;
  unsigned* bar;
};

__device__ __forceinline__ float siluf(float x) { return x / (1.f + __expf(-x)); }
__device__ __forceinline__ float sigmf(float x) { return 1.f / (1.f + __expf(-x)); }
__device__ __forceinline__ float wave_sum(float v) { for (int o = 32; o >= 1; o >>= 1) v += __shfl_xor(v, o); return v; }
__device__ __forceinline__ float wave_max(float v) { for (int o = 32; o >= 1; o >>= 1) v = fmaxf(v, __shfl_xor(v, o)); return v; }
__device__ __forceinline__ bf16_t f2bf(float f) { u32 r; asm("v_cvt_pk_bf16_f32 %0, %1, %1" : "=v"(r) : "v"(f)); return (bf16_t)r; }
__device__ __forceinline__ float bf2f(bf16_t b) { return __uint_as_float(((u32)b) << 16); }
__device__ __forceinline__ u32 pack2(float lo, float hi) { u32 r; asm("v_cvt_pk_bf16_f32 %0, %1, %2" : "=v"(r) : "v"(lo), "v"(hi)); return r; }
__device__ __forceinline__ float bflo(u32 w) { return __uint_as_float(w << 16); }
__device__ __forceinline__ float bfhi(u32 w) { return __uint_as_float(w & 0xFFFF0000u); }
__device__ __forceinline__ float dot2bf(u32 a, u32 b, float c) { return __builtin_amdgcn_fdot2_f32_bf16(__builtin_bit_cast(bf16x2_t, a), __builtin_bit_cast(bf16x2_t, b), c, false); }

constexpr int PJ_MOD = 192, PJ_TR = 2576, PJ_WG = 1, PJ_KEYS = 16, PJ_UV = 8192;
constexpr int PJ_TOTAL = PJ_MOD + PJ_TR + PJ_WG + PJ_KEYS + PJ_UV;

__device__ void prep_transpose_tile(const float* __restrict__ src, int ld, int k0, int n0, bf16_t* __restrict__ dst, int dstK, char* smem) {
  float* tile = (float*)smem;
  const int tid = threadIdx.x;
  __syncthreads();
  for (int pass = 0; pass < 8; ++pass) { int kk = pass * 8 + (tid >> 6), n = tid & 63; tile[kk * 65 + n] = src[(size_t)(k0 + kk) * ld + n0 + n]; }
  __syncthreads();
  int n = tid >> 3, kc = (tid & 7) * 8; u32x4 w;
  w.x = pack2(tile[(kc + 0) * 65 + n], tile[(kc + 1) * 65 + n]); w.y = pack2(tile[(kc + 2) * 65 + n], tile[(kc + 3) * 65 + n]);
  w.z = pack2(tile[(kc + 4) * 65 + n], tile[(kc + 5) * 65 + n]); w.w = pack2(tile[(kc + 6) * 65 + n], tile[(kc + 7) * 65 + n]);
  *(u32x4*)(dst + (size_t)(n0 + n) * dstK + k0 + kc) = w;
}

__device__ void phase_prep(const Params& p, char* smem) {
  const int tid = threadIdx.x;
  for (int job = blockIdx.x; job < PJ_TOTAL; job += gridDim.x) {
    if (job < PJ_MOD) {
      float* cs = (float*)smem; float* red = cs + 8192;
      __syncthreads();
      for (int i = tid; i < 8192; i += NTHREADS) cs[i] = siluf(p.c[i]);
      __syncthreads();
      const int l = job / 96, e0 = (job % 96) * 64, col = tid & 63, dg = tid >> 6;
      float acc[8];
#pragma unroll
      for (int b = 0; b < 8; ++b) acc[b] = 0.f;
      const float* w = p.ada_w + (size_t)l * D * 6144 + e0 + col;
      for (int d = dg * 128; d < dg * 128 + 128; ++d) { float wv = w[(size_t)d * 6144];
#pragma unroll
        for (int b = 0; b < 8; ++b) acc[b] += cs[b * 1024 + d] * wv; }
#pragma unroll
      for (int b = 0; b < 8; ++b) red[(dg * 8 + b) * 64 + col] = acc[b];
      __syncthreads();
      { const int b = tid >> 6; float s = 0.f;
#pragma unroll
        for (int g = 0; g < 8; ++g) s += red[(g * 8 + b) * 64 + col];
        p.mod[(size_t)(l * 8 + b) * 6144 + e0 + col] = s + p.ada_b[l * 6144 + e0 + col]; }
    } else if (job < PJ_MOD + PJ_TR) {
      int tt = job - PJ_MOD;
      if (tt < 640) prep_transpose_tile(p.ev_w_in, EVEN_IN, (tt / 40) * 64, (tt % 40) * 64, p.Wt_evin, 1024, smem);
      else if (tt < 896) { tt -= 640; prep_transpose_tile(p.ev_w_out, 1024, (tt / 16) * 64, (tt % 16) * 64, p.Wt_evout, 1024, smem); }
      else if (tt < 1280) { tt -= 896; prep_transpose_tile(p.od_w_in, 1536, (tt / 24) * 64, (tt % 24) * 64, p.Wt_odin, 1024, smem); }
      else if (tt < 1536) { tt -= 1280; prep_transpose_tile(p.od_w_out, 1024, (tt / 16) * 64, (tt % 16) * 64, p.Wt_odout, 1024, smem); }
      else if (tt < 2560) { tt -= 1536; int l = tt / 512; tt %= 512; prep_transpose_tile(p.peer_wq + (size_t)l * D * 2048, 2048, (tt / 32) * 64, (tt % 32) * 64, p.Wt_q + (size_t)l * 2048 * 1024, 1024, smem); }
      else { tt -= 2560; const int g = tt >> 2; prep_transpose_tile(p.pool_w + (size_t)g * 16384, 128, ((tt >> 1) & 1) * 64, (tt & 1) * 64, p.poolWt + (size_t)g * 16384, 128, smem); }
    } else if (job < PJ_MOD + PJ_TR + PJ_WG) {
      for (int i = tid; i < 16 * 1024; i += NTHREADS) { int g = i >> 10, d = i & 1023; p.Wg[i] = p.ev_w_in[(size_t)d * EVEN_IN + 2560 + g]; }
    } else if (job < PJ_MOD + PJ_TR + PJ_WG + PJ_KEYS) {
      int j = job - (PJ_MOD + PJ_TR + PJ_WG);
      for (int i = tid; i < 4096; i += NTHREADS) p.keysb[j * 4096 + i] = f2bf(p.peer_keys[j * 4096 + i]);
    } else {
      int j = job - (PJ_MOD + PJ_TR + PJ_WG + PJ_KEYS); const bool isu = j < 4096; const float* src = isu ? p.peer_u : p.peer_v; unsigned char* dst = isu ? p.U8 : p.V8; j &= 4095; const float sc = isu ? 32.f : 2.f;
      const size_t o = (size_t)j * 8192 + tid * 16; u32x4 w; u32 ww[4];
#pragma unroll
      for (int q = 0; q < 4; ++q) { const f32x4 a = *(const f32x4*)(src + o + 4 * q); int pk = __builtin_amdgcn_cvt_pk_fp8_f32(a.x * sc, a.y * sc, 0, false); pk = __builtin_amdgcn_cvt_pk_fp8_f32(a.z * sc, a.w * sc, pk, true); ww[q] = (u32)pk; }
      w.x = ww[0]; w.y = ww[1]; w.z = ww[2]; w.w = ww[3]; *(u32x4*)(dst + o) = w;
    }
  }
}

enum { EPI_EVIN = 0, EPI_EVOUT = 1, EPI_PEERQ = 2, EPI_ODIN = 3, EPI_ODOUT = 4 };
template <int EPI> __device__ __forceinline__ void epi_store(const Params& p, int layer, int m, int n, float acc) {
  if (EPI == EPI_EVIN) { float v = acc + p.ev_b_in[n];
    if (n < 1024) p.ZQK[(size_t)m * 1024 + n] = f2bf(v); else if (n < 1536) p.ZV[(size_t)m * 512 + n - 1024] = f2bf(v);
    else if (n < 2048) p.ZO[(size_t)m * 512 + n - 1536] = f2bf(sigmf(v)); else p.ZP[(size_t)m * 512 + n - 2048] = f2bf(v); }
  else if (EPI == EPI_EVOUT) { int b = m / S; p.X[(size_t)m * D + n] = p.x[(size_t)m * D + n] + p.mod[(size_t)(0 * 8 + b) * 6144 + 2048 + n] * acc; }
  else if (EPI == EPI_PEERQ) p.QP[(size_t)m * 2048 + n] = f2bf(acc);
  else if (EPI == EPI_ODIN) p.QKV[(size_t)m * 1536 + n] = f2bf(acc);
  else if (EPI == EPI_ODOUT) { int b = m / S; p.X[(size_t)m * D + n] += p.mod[(size_t)(1 * 8 + b) * 6144 + 2048 + n] * acc; }
}
template <int EPI> __device__ void phase_gemm_naive(const Params& p, int layer, const bf16_t* __restrict__ A, const bf16_t* __restrict__ Bt, int M, int N, int K, char* smem) {
  float* As = (float*)smem; float* Bs = As + 32 * 132;
  const int tid = threadIdx.x, tx = tid & 15, ty = tid >> 4; const int nN = N / 64, njobs = (M / 128) * nN;
  for (int job = blockIdx.x; job < njobs; job += gridDim.x) {
    const int m0 = (job / nN) * 128, n0 = (job % nN) * 64; float acc[4][4];
#pragma unroll
    for (int i = 0; i < 4; ++i)
#pragma unroll
      for (int j = 0; j < 4; ++j) acc[i][j] = 0.f;
    for (int k0 = 0; k0 < K; k0 += 32) {
      __syncthreads();
      { int row = tid >> 2, kc = (tid & 3) * 8; u32x4 w = *(const u32x4*)(A + (size_t)(m0 + row) * K + k0 + kc);
        As[(kc + 0) * 132 + row] = bflo(w.x); As[(kc + 1) * 132 + row] = bfhi(w.x); As[(kc + 2) * 132 + row] = bflo(w.y); As[(kc + 3) * 132 + row] = bfhi(w.y);
        As[(kc + 4) * 132 + row] = bflo(w.z); As[(kc + 5) * 132 + row] = bfhi(w.z); As[(kc + 6) * 132 + row] = bflo(w.w); As[(kc + 7) * 132 + row] = bfhi(w.w); }
      if (tid < 256) { int row = tid >> 2, kc = (tid & 3) * 8; u32x4 w = *(const u32x4*)(Bt + (size_t)(n0 + row) * K + k0 + kc);
        Bs[(kc + 0) * 68 + row] = bflo(w.x); Bs[(kc + 1) * 68 + row] = bfhi(w.x); Bs[(kc + 2) * 68 + row] = bflo(w.y); Bs[(kc + 3) * 68 + row] = bfhi(w.y);
        Bs[(kc + 4) * 68 + row] = bflo(w.z); Bs[(kc + 5) * 68 + row] = bfhi(w.z); Bs[(kc + 6) * 68 + row] = bflo(w.w); Bs[(kc + 7) * 68 + row] = bfhi(w.w); }
      __syncthreads();
#pragma unroll 8
      for (int kk = 0; kk < 32; ++kk) { f32x4 a = *(const f32x4*)(As + kk * 132 + ty * 4), b = *(const f32x4*)(Bs + kk * 68 + tx * 4);
        acc[0][0] += a.x * b.x; acc[0][1] += a.x * b.y; acc[0][2] += a.x * b.z; acc[0][3] += a.x * b.w;
        acc[1][0] += a.y * b.x; acc[1][1] += a.y * b.y; acc[1][2] += a.y * b.z; acc[1][3] += a.y * b.w;
        acc[2][0] += a.z * b.x; acc[2][1] += a.z * b.y; acc[2][2] += a.z * b.z; acc[2][3] += a.z * b.w;
        acc[3][0] += a.w * b.x; acc[3][1] += a.w * b.y; acc[3][2] += a.w * b.z; acc[3][3] += a.w * b.w; }
    }
#pragma unroll
    for (int i = 0; i < 4; ++i)
#pragma unroll
      for (int j = 0; j < 4; ++j) epi_store<EPI>(p, layer, m0 + ty * 4 + i, n0 + tx * 4 + j, acc[i][j]);
  }
}

namespace pg8 {
#define PG8_LAS __attribute__((address_space(3)))
typedef unsigned short bf16_t;
typedef short bf16x8 __attribute__((ext_vector_type(8)));
typedef float f32x4 __attribute__((ext_vector_type(4)));
typedef unsigned u32x4 __attribute__((ext_vector_type(4)));
constexpr int BM = 256, BK = 64, HALF = 128, HTB = HALF * BK * 2  , STAGE_BYTES = 8 * HTB, NXCD = 8, WGM = 8;

__host__ __device__ __forceinline__ int lds_byte(int r, int c) { const int st = (r >> 4) * 2 + (c >> 5), rr = r & 15, cc = c & 31, ob = rr * 64 + cc * 2; return st * 1024 + (ob ^ (((ob >> 9) & 1) << 5)); }
__host__ __device__ __forceinline__ void stage_rc(int b, int& R, int& C) { const int st = b / 1024, sb = b % 1024, swz = sb ^ (((sb >> 9) & 1) << 5); R = (st >> 1) * 16 + swz / 64; C = (st & 1) * 32 + (swz % 64) / 2; }
__host__ __device__ __forceinline__ int perm32(int rho) { const int n = rho >> 4, i = rho & 15; return 8 * (i >> 2) + 4 * n + (i & 3); }

struct Unit { int pm, pn; };
struct Gemm { const bf16_t* A; const bf16_t* Bt; int M, N, K; };

struct StaticOrder {
    int nM, nN, nwg, G, c;
    __host__ __device__ void init(int M, int N, int G_, int c_) { nM = M / BM; nN = N / BM; nwg = nM * nN; G = G_; c = c_; }
    __host__ __device__ bool next(int i, Unit& u) const {
        const long L = (long)i * G + c; if (L >= nwg) return false;
        int wgid = (int)L; { const int q = nwg / NXCD, r = nwg % NXCD, xcd = wgid % NXCD, off = wgid / NXCD; wgid = (xcd < r ? xcd * (q + 1) : r * (q + 1) + (xcd - r) * q) + off; }
        const int nig = WGM * nN, gid = wgid / nig, fm = gid * WGM, gsz = (nM - fm) < WGM ? (nM - fm) : WGM;
        u.pm = fm + ((wgid % nig) % gsz); u.pn = (wgid % nig) / gsz; return true;
    }
    __device__ __forceinline__ void a_ready(const Unit&) const {}
    __device__ __forceinline__ void done(const Unit&) const {}
};
__device__ __forceinline__ unsigned cvt_pk_bf16(float lo, float hi) { unsigned r; asm volatile("v_cvt_pk_bf16_f32 %0, %1, %2" : "=v"(r) : "v"(lo), "v"(hi)); return r; }
template <class Epi, class Sched, bool STAMP = false>
__device__ __forceinline__ void gemm_phase(PG8_LAS unsigned char* lds, const Gemm g, const Sched& S, const Epi& E, unsigned long long* stamps) {
    const int tid = threadIdx.x, wid = __builtin_amdgcn_readfirstlane(tid >> 6), lane = tid & 63, wr = wid >> 2, wc = wid & 3, fr = lane & 15, fq = lane >> 4;
    const int K = g.K, nt = K / BK;
    int ts_lo = 0, ts_hi = 0, nts = 0; const unsigned long long rt_entry = STAMP ? (unsigned long long)wall_clock64() : 0ull;
#define PG8_STAMP() do { if (STAMP && wid == 0 && nts < 64) { const unsigned long long _c = (unsigned long long)clock64(); \
        ts_lo = (lane == nts) ? (int)(unsigned)_c : ts_lo; ts_hi = (lane == nts) ? (int)(unsigned)(_c >> 32) : ts_hi; ++nts; } } while (0)
    PG8_STAMP();
    unsigned voffA[2], voffB[2];
#pragma unroll
    for (int i = 0; i < 2; ++i) { int R, C; stage_rc(tid * 16 + i * 8192, R, C); const int Rb = Epi::PERM ? ((R & ~31) + perm32(R & 31)) : R;
        voffA[i] = (unsigned)(R * K + C) * 2u; voffB[i] = (unsigned)(Rb * K + C) * 2u; }
    const size_t kstep = (size_t)(BK * 2);
    const size_t hstep = (size_t)HALF * K * 2;
    const size_t tstep = 2 * hstep;
    const unsigned ldsw = (unsigned)wid * 1024u;
    const int aoff = lds_byte(wr * 64 + fr, fq * 8), boff = lds_byte(wc * 32 + fr, fq * 8);
#define PG8_SA(b, h) (((b) * 2 + (h)) * HTB)
#define PG8_SB(b, h) ((4 + (b) * 2 + (h)) * HTB)
#define PG8_STAGE(bufoff, gbase, voff) do { _Pragma("unroll") for (int _i = 0; _i < 2; ++_i) \
        __builtin_amdgcn_global_load_lds((const unsigned*)((const char*)(gbase) + (voff)[_i]), (PG8_LAS unsigned*)(lds + (bufoff) + ldsw + _i * 8192), 16, 0, 0); } while (0)
#define PG8_LDA(dst, b, h) do { _Pragma("unroll") for (int m = 0; m < 4; ++m) _Pragma("unroll") for (int k = 0; k < 2; ++k) dst[m][k] = *(const PG8_LAS bf16x8*)(lds + PG8_SA(b, h) + aoff + m * 2048 + k * 1024); } while (0)
#define PG8_LDB(dst, b, h) do { _Pragma("unroll") for (int n = 0; n < 2; ++n) _Pragma("unroll") for (int k = 0; k < 2; ++k) dst[n][k] = *(const PG8_LAS bf16x8*)(lds + PG8_SB(b, h) + boff + n * 2048 + k * 1024); } while (0)
#define PG8_MMA(ai, bj, At, Bt) do { __builtin_amdgcn_s_setprio(1); _Pragma("unroll") for (int m = 0; m < 4; ++m) _Pragma("unroll") for (int n = 0; n < 2; ++n) _Pragma("unroll") for (int k = 0; k < 2; ++k) \
        acc[ai][bj][m][n] = __builtin_amdgcn_mfma_f32_16x16x32_bf16(Bt[n][k], At[m][k], acc[ai][bj][m][n], 0, 0, 0); __builtin_amdgcn_s_setprio(0); } while (0)
#define PG8_WAIT_V(n) asm volatile("s_waitcnt vmcnt(" #n ")" ::: "memory")
#define PG8_WAIT_L(n) asm volatile("s_waitcnt lgkmcnt(" #n ")" ::: "memory")
#define PG8_BAR __builtin_amdgcn_s_barrier()
#define PG8_SCHED __builtin_amdgcn_sched_barrier(0)
    Unit cur, nxt; int ui = 0;
    if (!S.next(0, cur)) return;
    f32x4 acc[2][2][4][2];
#pragma unroll
    for (int a = 0; a < 2; ++a)
#pragma unroll
        for (int b = 0; b < 2; ++b)
#pragma unroll
            for (int m = 0; m < 4; ++m)
#pragma unroll
                for (int n = 0; n < 2; ++n) acc[a][b][m][n] = (f32x4){0.f, 0.f, 0.f, 0.f};
    bf16x8 At[4][2], B0[2][2], B1[2][2];
    const char* cA = (const char*)g.A + (size_t)cur.pm * tstep; const char* cB = (const char*)g.Bt + (size_t)cur.pn * tstep;
    S.a_ready(cur);
    PG8_STAGE(PG8_SB(0, 0), cB, voffB); PG8_STAGE(PG8_SA(0, 0), cA, voffA); PG8_STAGE(PG8_SB(0, 1), cB + hstep, voffB); PG8_STAGE(PG8_SA(0, 1), cA + hstep, voffA);
    if (wr == 1) PG8_BAR;
    PG8_WAIT_V(4); PG8_BAR;
    PG8_STAGE(PG8_SB(1, 0), cB + kstep, voffB); PG8_STAGE(PG8_SA(1, 0), cA + kstep, voffA); PG8_STAGE(PG8_SB(1, 1), cB + hstep + kstep, voffB);
    PG8_WAIT_V(6); PG8_BAR;
    PG8_STAMP();
    for (;;) {
        const bool has_next = S.next(ui + 1, nxt);
        const char* nA = has_next ? (const char*)g.A + (size_t)nxt.pm * tstep : cA; const char* nB = has_next ? (const char*)g.Bt + (size_t)nxt.pn * tstep : cB;
        for (int t = 0; t < nt; t += 2) {
            const bool last = (t == nt - 2);
            const char* a1 = cA + (size_t)(t + 1) * kstep;
            const char* a2 = last ? nA : cA + (size_t)(t + 2) * kstep; const char* b2 = last ? nB : cB + (size_t)(t + 2) * kstep;
            const char* a3 = a2 + kstep; const char* b3 = b2 + kstep;
            if (last && has_next) S.a_ready(nxt);
            PG8_LDB(B0, 0, 0); PG8_SCHED; PG8_LDA(At, 0, 0); PG8_STAGE(PG8_SA(1, 1), a1 + hstep, voffA);
            PG8_WAIT_L(8); PG8_BAR; PG8_WAIT_L(0); PG8_MMA(0, 0, At, B0); PG8_BAR; PG8_SCHED;
            PG8_LDB(B1, 0, 1); PG8_STAGE(PG8_SB(0, 0), b2, voffB);
            PG8_BAR; PG8_WAIT_L(0); PG8_MMA(0, 1, At, B1); PG8_BAR;
            PG8_LDA(At, 0, 1); PG8_STAGE(PG8_SA(0, 0), a2, voffA);
            PG8_BAR; PG8_WAIT_L(0); PG8_MMA(1, 0, At, B0); PG8_BAR; PG8_SCHED;
            PG8_STAGE(PG8_SB(0, 1), b2 + hstep, voffB);
            PG8_WAIT_V(6); PG8_BAR; PG8_MMA(1, 1, At, B1); PG8_BAR;
            PG8_LDB(B0, 1, 0); PG8_SCHED; PG8_LDA(At, 1, 0); PG8_STAGE(PG8_SA(0, 1), a2 + hstep, voffA);
            PG8_WAIT_L(8); PG8_BAR; PG8_WAIT_L(0); PG8_MMA(0, 0, At, B0); PG8_BAR; PG8_SCHED;
            PG8_LDB(B1, 1, 1); PG8_STAGE(PG8_SB(1, 0), b3, voffB);
            PG8_BAR; PG8_WAIT_L(0); PG8_MMA(0, 1, At, B1); PG8_BAR;
            PG8_LDA(At, 1, 1); PG8_STAGE(PG8_SA(1, 0), a3, voffA);
            PG8_BAR; PG8_WAIT_L(0); PG8_MMA(1, 0, At, B0); PG8_BAR; PG8_SCHED;
            PG8_STAGE(PG8_SB(1, 1), b3 + hstep, voffB);
            PG8_WAIT_V(6); PG8_BAR; PG8_MMA(1, 1, At, B1); PG8_BAR;
        }
        PG8_STAMP();
        if constexpr (!Epi::AFTER_DRAIN) { E(acc, cur, wr, wc, fr, fq); S.done(cur); }
        PG8_STAMP();
        if (!has_next) break;
#pragma unroll
        for (int a = 0; a < 2; ++a)
#pragma unroll
            for (int b = 0; b < 2; ++b)
#pragma unroll
                for (int m = 0; m < 4; ++m)
#pragma unroll
                    for (int n = 0; n < 2; ++n) acc[a][b][m][n] = (f32x4){0.f, 0.f, 0.f, 0.f};
        cur = nxt; cA = nA; cB = nB; ++ui;
    }
    PG8_WAIT_V(0);
    if (wr == 0) PG8_BAR;
    PG8_BAR;
    if constexpr (Epi::AFTER_DRAIN) { E.fused(acc, cur, wr, wc, fr, fq, lds, wid, lane); S.done(cur); }
    PG8_STAMP();
    if (STAMP && wid == 0) { stamps[lane] = lane < nts ? (((unsigned long long)(unsigned)ts_hi << 32) | (unsigned)ts_lo) : 0ull;
        if (lane == 62) stamps[62] = rt_entry; if (lane == 63) stamps[63] = (unsigned long long)wall_clock64(); }
#undef PG8_STAMP
#undef PG8_SA
#undef PG8_SB
#undef PG8_STAGE
#undef PG8_LDA
#undef PG8_LDB
#undef PG8_MMA
#undef PG8_WAIT_V
#undef PG8_WAIT_L
#undef PG8_BAR
#undef PG8_SCHED
}
}

struct EpiEvin {
  static constexpr bool PERM = true, AFTER_DRAIN = false;
  bf16_t *ZQK, *ZV, *ZO, *ZP; const float* bias;
  __device__ __forceinline__ void operator()(const pg8::f32x4 (&acc)[2][2][4][2], const pg8::Unit& u, int wr, int wc, int fr, int fq) const {
    const int row0 = u.pm * 256 + wr * 64 + fr, ct = u.pn * 256;
    bf16_t* base; int ldc, cl; bool sig = false;
    if (ct < 1024) { base = ZQK; ldc = 1024; cl = ct; } else if (ct < 1536) { base = ZV; ldc = 512; cl = ct - 1024; } else if (ct < 2048) { base = ZO; ldc = 512; cl = ct - 1536; sig = true; } else { base = ZP; ldc = 512; cl = ct - 2048; }
    const int cofs = wc * 32 + 8 * fq;
    pg8::f32x4 bv[2][2];
#pragma unroll
    for (int bj = 0; bj < 2; ++bj)
#pragma unroll
      for (int n = 0; n < 2; ++n) bv[bj][n] = *(const pg8::f32x4*)(bias + ct + cofs + bj * 128 + 4 * n);
#pragma unroll
    for (int ai = 0; ai < 2; ++ai)
#pragma unroll
      for (int m = 0; m < 4; ++m) { bf16_t* rowp = base + (size_t)(row0 + ai * 128 + m * 16) * ldc + cl + cofs;
#pragma unroll
        for (int bj = 0; bj < 2; ++bj) { pg8::f32x4 v0 = acc[ai][bj][m][0] + bv[bj][0], v1 = acc[ai][bj][m][1] + bv[bj][1];
          if (sig) {
#pragma unroll
            for (int j = 0; j < 4; ++j) { v0[j] = sigmf(v0[j]); v1[j] = sigmf(v1[j]); } }
          pg8::u32x4 w; w.x = pg8::cvt_pk_bf16(v0[0], v0[1]); w.y = pg8::cvt_pk_bf16(v0[2], v0[3]); w.z = pg8::cvt_pk_bf16(v1[0], v1[1]); w.w = pg8::cvt_pk_bf16(v1[2], v1[3]);
          *(pg8::u32x4*)(rowp + bj * 128) = w; } }
  }
};
struct EpiPlain {
  static constexpr bool PERM = true, AFTER_DRAIN = false;
  bf16_t* out; int ldc;
  __device__ __forceinline__ void operator()(const pg8::f32x4 (&acc)[2][2][4][2], const pg8::Unit& u, int wr, int wc, int fr, int fq) const {
    const int row0 = u.pm * 256 + wr * 64 + fr, col0 = u.pn * 256 + wc * 32 + 8 * fq;
#pragma unroll
    for (int ai = 0; ai < 2; ++ai)
#pragma unroll
      for (int m = 0; m < 4; ++m) { bf16_t* rowp = out + (size_t)(row0 + ai * 128 + m * 16) * ldc + col0;
#pragma unroll
        for (int bj = 0; bj < 2; ++bj) { const pg8::f32x4 v0 = acc[ai][bj][m][0], v1 = acc[ai][bj][m][1];
          pg8::u32x4 w; w.x = pg8::cvt_pk_bf16(v0[0], v0[1]); w.y = pg8::cvt_pk_bf16(v0[2], v0[3]); w.z = pg8::cvt_pk_bf16(v1[0], v1[1]); w.w = pg8::cvt_pk_bf16(v1[2], v1[3]);
          *(pg8::u32x4*)(rowp + bj * 128) = w; } }
  }
};
struct EpiRes {
  static constexpr bool PERM = false, AFTER_DRAIN = false;
  const float* xin; float* X; const float* gate;
  __device__ __forceinline__ void operator()(const pg8::f32x4 (&acc)[2][2][4][2], const pg8::Unit& u, int wr, int wc, int fr, int fq) const {
    const int row0 = u.pm * 256 + wr * 64 + fr, col0 = u.pn * 256 + wc * 32 + 4 * fq; const float* gb = gate + (size_t)((u.pm * 256) / S) * 6144;
    pg8::f32x4 gv[2][2];
#pragma unroll
    for (int bj = 0; bj < 2; ++bj)
#pragma unroll
      for (int n = 0; n < 2; ++n) gv[bj][n] = *(const pg8::f32x4*)(gb + col0 + bj * 128 + n * 16);
#pragma unroll
    for (int ai = 0; ai < 2; ++ai)
#pragma unroll
      for (int m = 0; m < 4; ++m) { const size_t off = (size_t)(row0 + ai * 128 + m * 16) * 1024 + col0;
#pragma unroll
        for (int bj = 0; bj < 2; ++bj)
#pragma unroll
          for (int n = 0; n < 2; ++n) { const pg8::f32x4 xi = *(const pg8::f32x4*)(xin + off + bj * 128 + n * 16); *(pg8::f32x4*)(X + off + bj * 128 + n * 16) = xi + gv[bj][n] * acc[ai][bj][m][n]; }
        asm volatile("" ::: "memory"); }
  }
};
template <class Epi> __device__ __forceinline__ void phase_gemm_fast(const bf16_t* A, const bf16_t* Bt, int M, int N, int K, const Epi& E, char* smem) {
  pg8::Gemm g; g.A = A; g.Bt = Bt; g.M = M; g.N = N; g.K = K;
  pg8::StaticOrder So; So.init(M, N, (int)gridDim.x, (int)blockIdx.x);
  pg8::gemm_phase<Epi, pg8::StaticOrder, false>((PG8_LAS unsigned char*)smem, g, So, E, nullptr);
}

namespace cp {
typedef short bf16x8 __attribute__((ext_vector_type(8)));
typedef float f32x16 __attribute__((ext_vector_type(16)));
constexpr int RS = 272;
__device__ __forceinline__ void unpack8(const u32x4 w, float* f) { f[0] = bflo(w.x); f[1] = bfhi(w.x); f[2] = bflo(w.y); f[3] = bfhi(w.y); f[4] = bflo(w.z); f[5] = bfhi(w.z); f[6] = bflo(w.w); f[7] = bfhi(w.w); }
__device__ void phase_convpool(const Params& p, char* smem) {
  for (int job = blockIdx.x; job < T / 64; job += gridDim.x) {
    int tid_ = threadIdx.x; asm volatile("" : "+v"(tid_));
    const int tid = tid_, c0 = (tid & 127) * 8, t0 = job * 64 + (tid >> 7) * 16, s0 = t0 & (S - 1);
    float cw[5][8], cb[8];
#pragma unroll
    for (int j = 0; j < 5; ++j) { const f32x4 a = *(const f32x4*)(p.conv_w + j * 1024 + c0), b = *(const f32x4*)(p.conv_w + j * 1024 + c0 + 4); cw[j][0] = a.x; cw[j][1] = a.y; cw[j][2] = a.z; cw[j][3] = a.w; cw[j][4] = b.x; cw[j][5] = b.y; cw[j][6] = b.z; cw[j][7] = b.w; }
    { const f32x4 a = *(const f32x4*)(p.conv_b + c0), b = *(const f32x4*)(p.conv_b + c0 + 4); cb[0] = a.x; cb[1] = a.y; cb[2] = a.z; cb[3] = a.w; cb[4] = b.x; cb[5] = b.y; cb[6] = b.z; cb[7] = b.w; }
    const float sc = c0 >= 512 ? KSCALE : 1.f;
    float win[5][8];
#pragma unroll
    for (int j = 0; j < 4; ++j) { const int ss = s0 + j - 2; u32x4 w = (u32x4){0u, 0u, 0u, 0u}; if (ss >= 0 && ss < S) w = *(const u32x4*)(p.ZQK + (size_t)(t0 + j - 2) * 1024 + c0); unpack8(w, win[j + 1]); }
#pragma unroll
    for (int i = 0; i < 16; ++i) {
#pragma unroll
      for (int j = 0; j < 4; ++j)
#pragma unroll
        for (int q = 0; q < 8; ++q) win[j][q] = win[j + 1][q];
      { const int ss = s0 + i + 2; u32x4 w = (u32x4){0u, 0u, 0u, 0u}; if (ss < S) w = *(const u32x4*)(p.ZQK + (size_t)(t0 + i + 2) * 1024 + c0); unpack8(w, win[4]); }
      float a[8];
#pragma unroll
      for (int q = 0; q < 8; ++q) { float v = cb[q];
#pragma unroll
        for (int j = 0; j < 5; ++j) v += cw[j][q] * win[j][q];
        a[q] = siluf(v) * sc; }
      u32x4 o; o.x = pack2(a[0], a[1]); o.y = pack2(a[2], a[3]); o.z = pack2(a[4], a[5]); o.w = pack2(a[6], a[7]); *(u32x4*)(p.QK + (size_t)(t0 + i) * 1024 + c0) = o;
    }
  }
  for (int job = blockIdx.x; job < (T / 128) * 4; job += gridDim.x) {
    int tid_ = threadIdx.x; asm volatile("" : "+v"(tid_));
    const int tid = tid_, wid = tid >> 6, lane = tid & 63, l31 = lane & 31, hh = lane >> 5;
    const int g = (job + (job >> 8)) & 3, t0 = (job >> 2) * 128, win = 2 << g, hw = win >> 1;
    __syncthreads();
#pragma unroll
    for (int i = 0; i < 4; ++i) { const int idx = tid + i * NTHREADS, row = idx >> 4, ch = idx & 15; *(u32x4*)(smem + 128 * RS + row * RS + ch * 16) = *(const u32x4*)(p.poolWt + (size_t)g * 16384 + row * 128 + ch * 8); }
#pragma unroll 1
    for (int i = 0; i < 4; ++i) { const int idx = tid + i * NTHREADS, row = idx >> 4, ch = idx & 15, t = t0 + row, s = t & (S - 1); const int lo = max(s - hw, 0), hi = min(s + hw, S);
      float sum[8], own[8];
#pragma unroll
      for (int q = 0; q < 8; ++q) sum[q] = 0.f;
      const bf16_t* base = p.ZP + (size_t)(t - s) * 512 + g * 128 + ch * 8;
      u32x4 rw[16];
#pragma unroll
      for (int r = 0; r < 16; ++r) { rw[r] = (u32x4){0u, 0u, 0u, 0u}; if (r < win) { const int rr = s - hw + r; if (rr >= 0 && rr < S) rw[r] = *(const u32x4*)(base + (size_t)rr * 512); } }
#pragma unroll
      for (int r = 0; r < 16; ++r) if (r < win) { float f[8]; unpack8(rw[r], f);
#pragma unroll
        for (int q = 0; q < 8; ++q) sum[q] += f[q]; }
      unpack8(*(const u32x4*)(base + (size_t)s * 512), own); const float inv = 1.f / (float)(hi - lo);
      u32x4 o; o.x = pack2(sum[0] * inv - own[0], sum[1] * inv - own[1]); o.y = pack2(sum[2] * inv - own[2], sum[3] * inv - own[3]); o.z = pack2(sum[4] * inv - own[4], sum[5] * inv - own[5]); o.w = pack2(sum[6] * inv - own[6], sum[7] * inv - own[7]);
      *(u32x4*)(smem + row * RS + ch * 16) = o; }
    __syncthreads();
    const int mt = wid >> 1;
#pragma unroll
    for (int q = 0; q < 2; ++q) { const int nt = (wid & 1) * 2 + q;
      f32x16 acc;
#pragma unroll
      for (int r = 0; r < 16; ++r) acc[r] = 0.f;
      const char* ya = smem + (mt * 32 + l31) * RS + hh * 16; const char* wb = smem + 128 * RS + (nt * 32 + l31) * RS + hh * 16;
#pragma unroll
      for (int ks = 0; ks < 8; ++ks) acc = __builtin_amdgcn_mfma_f32_32x32x16_bf16(*(const bf16x8*)(ya + ks * 32), *(const bf16x8*)(wb + ks * 32), acc, 0, 0, 0);
      const int e = nt * 32 + l31; const float psc = p.pool_sc[g * 128 + e];
#pragma unroll
      for (int r = 0; r < 16; ++r) { const int row = mt * 32 + (r & 3) + 8 * (r >> 2) + 4 * hh; p.CAT[(size_t)(t0 + row) * 1024 + 512 + g * 128 + e] = f2bf(acc[r] * psc); } }
  }
}
}

__device__ void phase_mlstm_naive(const Params& p, char* smem) {
  float* qs = (float*)smem; float* ks = qs + 128; float* nump = ks + 128; float* red = nump + 512;
  const int tid = threadIdx.x, j = tid & 127, qd = tid >> 7;
  for (int job = blockIdx.x; job < 64; job += gridDim.x) {
    const int dir = job >> 5, b = (job >> 2) & 7, h = job & 3;
    float C[32];
#pragma unroll
    for (int d = 0; d < 32; ++d) C[d] = 0.f;
    float n = 0.f, m = 0.f;
    for (int step = 0; step < S; ++step) { const int s = dir ? S - 1 - step : step; const size_t t = (size_t)b * S + s;
      const float li = p.gates[t * 16 + dir * 4 + h], gf = p.gates[t * 16 + 8 + dir * 4 + h];
      const float lf = fminf(gf, 0.f) - log1pf(__expf(-fabsf(gf)));
      __syncthreads();
      if (qd == 0) { qs[j] = bf2f(p.QK[t * 1024 + h * 128 + j]); ks[j] = bf2f(p.QK[t * 1024 + 512 + h * 128 + j]); }
      const float v = bf2f(p.ZV[t * 512 + h * 128 + j]);
      __syncthreads();
      const float mn = fmaxf(lf + m, li), ip = __expf(li - mn), fp = __expf(lf + m - mn); m = mn;
      float num = 0.f;
#pragma unroll
      for (int d = 0; d < 32; ++d) { C[d] = fp * C[d] + ip * ks[qd * 32 + d] * v; num += qs[qd * 32 + d] * C[d]; }
      float dp = 0.f; if (qd == 0) { n = fp * n + ip * ks[j]; dp = qs[j] * n; }
      nump[qd * 128 + j] = num;
      dp = wave_sum(dp); if ((tid & 63) == 0) red[tid >> 6] = dp;
      __syncthreads();
      if (qd == 0) { const float den = red[0] + red[1]; num = nump[j] + nump[128 + j] + nump[256 + j] + nump[384 + j];
        p.HS[((size_t)dir * T + t) * 512 + h * 128 + j] = f2bf(num / fmaxf(fabsf(den), __expf(-mn))); }
    }
    __syncthreads();
  }
}

namespace ml {
typedef short bf16x8 __attribute__((ext_vector_type(8)));
typedef short s16x4 __attribute__((ext_vector_type(4)));
typedef float f32x16 __attribute__((ext_vector_type(16)));
constexpr int RS = 272;
constexpr int OFF_Q = 0, OFF_K = 128 * RS, OFF_VT = 2 * 128 * RS, OFF_VW = OFF_VT + 34 * RS, OFF_CT = OFF_VW + 34 * RS, OFF_A = OFF_CT + 34 * RS;
constexpr int OFF_PA = OFF_A + 16384, OFF_MCH = OFF_PA + 16384, OFF_TAB = OFF_MCH + 512, OFF_DEN = OFF_TAB + 4096  , OFF_EX = OFF_DEN + 1536  , OFF_END = OFF_EX + 16384;
static_assert(OFF_A % 16 == 0 && OFF_END <= SMEM_BYTES, "mlstm LDS layout");
__device__ __forceinline__ int crow(int r, int h) { return (r & 3) + 8 * (r >> 2) + 4 * h; }
__device__ __forceinline__ int spos(int s) { return (s & ~12) | ((s & 4) << 1) | ((s & 8) >> 1); }
#define ML_MFMA(a, b, c) __builtin_amdgcn_mfma_f32_32x32x16_bf16((a), (b), (c), 0, 0, 0)
__device__ __forceinline__ bf16x8 pack8(float x0, float x1, float x2, float x3, float x4, float x5, float x6, float x7) {
  u32x4 w;
  asm volatile("v_cvt_pk_bf16_f32 %0, %4, %5\n\tv_cvt_pk_bf16_f32 %1, %6, %7\n\tv_cvt_pk_bf16_f32 %2, %8, %9\n\tv_cvt_pk_bf16_f32 %3, %10, %11\n\ts_nop 1"
               : "=&v"(w.x), "=&v"(w.y), "=&v"(w.z), "=&v"(w.w) : "v"(x0), "v"(x1), "v"(x2), "v"(x3), "v"(x4), "v"(x5), "v"(x6), "v"(x7));
  return __builtin_bit_cast(bf16x8, w);
}
__device__ __forceinline__ void tr_read8(unsigned a, s16x4& r0, s16x4& r1, s16x4& r2, s16x4& r3, s16x4& r4, s16x4& r5, s16x4& r6, s16x4& r7) {
  asm volatile("ds_read_b64_tr_b16 %0, %8\n\tds_read_b64_tr_b16 %1, %8 offset:2176\n\tds_read_b64_tr_b16 %2, %8 offset:4352\n\tds_read_b64_tr_b16 %3, %8 offset:6528\n\t"
               "ds_read_b64_tr_b16 %4, %8 offset:8704\n\tds_read_b64_tr_b16 %5, %8 offset:10880\n\tds_read_b64_tr_b16 %6, %8 offset:13056\n\tds_read_b64_tr_b16 %7, %8 offset:15232\n\ts_waitcnt lgkmcnt(0)"
               : "=&v"(r0), "=&v"(r1), "=&v"(r2), "=&v"(r3), "=&v"(r4), "=&v"(r5), "=&v"(r6), "=&v"(r7) : "v"(a) : "memory");
}
static_assert(8 * RS == 2176, "tr_read8 offsets assume 272-byte rows");

__device__ void phase_mlstm(const Params& p, char* smem) {
  int tid_ = threadIdx.x; asm volatile("" : "+v"(tid_));
  const int tid = tid_, wid = tid >> 6, lane = tid & 63, l31 = lane & 31, hh = lane >> 5;
  float* const LA = (float*)(smem + OFF_A); float* const LPA = (float*)(smem + OFF_PA); float* const LM = (float*)(smem + OFF_MCH);
  float* const LTAB = (float*)(smem + OFF_TAB); float* const LDEN = (float*)(smem + OFF_DEN);
  const unsigned lds0 = (unsigned)(uintptr_t)smem;
  for (int job = blockIdx.x; job < 256; job += gridDim.x) {
    const int dvq = job & 3, h = (job >> 2) & 3, b = (job >> 4) & 7, dir = job >> 7;
    const float* gts = p.gates + (size_t)b * S * 16;
    const bf16_t* QKb = p.QK + (size_t)b * S * 1024 + h * 128; const bf16_t* ZVb = p.ZV + (size_t)b * S * 512 + h * 128 + dvq * 32;
    bf16_t* HSb = p.HS + ((size_t)dir * T + (size_t)b * S) * 512 + h * 128 + dvq * 32;
    __syncthreads();
    for (int i = tid; i < 3 * 34 * RS / 4; i += NTHREADS) ((u32*)(smem + OFF_VT))[i] = 0u;
    for (int cc = 0; cc < 4; ++cc) { const int c = wid * 4 + cc, tau0 = c * 128 + 2 * lane; const int tok0 = dir ? S - 1 - tau0 : tau0, tok1 = dir ? tok0 - 1 : tok0 + 1;
      const float li0 = gts[(size_t)tok0 * 16 + dir * 4 + h], gf0 = gts[(size_t)tok0 * 16 + 8 + dir * 4 + h], li1 = gts[(size_t)tok1 * 16 + dir * 4 + h], gf1 = gts[(size_t)tok1 * 16 + 8 + dir * 4 + h];
      const float lf0 = fminf(gf0, 0.f) - log1pf(__expf(-fabsf(gf0))), lf1 = fminf(gf1, 0.f) - log1pf(__expf(-fabsf(gf1)));
      const float pr = lf0 + lf1; float incl = pr;
#pragma unroll
      for (int o = 1; o < 64; o <<= 1) { const float v = __shfl_up(incl, o); if (lane >= o) incl += v; }
      const float b0 = incl - pr + lf0, b1 = b0 + lf1, a0 = li0 - b0, a1 = li1 - b1;
      float im = fmaxf(a0, a1);
#pragma unroll
      for (int o = 1; o < 64; o <<= 1) { const float v = __shfl_up(im, o); if (lane >= o) im = fmaxf(im, v); }
      float ex = __shfl_up(im, 1); if (lane == 0) ex = -INFINITY;
      const float pa0 = fmaxf(ex, a0), pa1 = fmaxf(pa0, a1);
      LA[tau0] = a0; LA[tau0 + 1] = a1; LPA[tau0] = pa0; LPA[tau0 + 1] = pa1; if (lane == 63) LM[64 + c] = b1; }
    __syncthreads();
    if (tid == 0) { float m = 0.f; for (int c = 0; c < 32; ++c) { LM[c] = m; m = LM[64 + c] + fmaxf(m, LPA[c * 128 + 127]); } LM[32] = m; }
    __syncthreads();
    u32x4 qreg[4], kreg[4], vreg;
#define ML_TOK(tau) (dir ? S - 1 - (tau) : (tau))
#define ML_LOAD(c) do { _Pragma("unroll") for (int i_ = 0; i_ < 4; ++i_) { const int tk_ = ML_TOK((c) * 128 + (tid >> 4) + 32 * i_); \
        qreg[i_] = *(const u32x4*)(QKb + (size_t)tk_ * 1024 + (tid & 15) * 8); kreg[i_] = *(const u32x4*)(QKb + (size_t)tk_ * 1024 + 512 + (tid & 15) * 8); } \
      { const int tk_ = ML_TOK((c) * 128 + (tid >> 2)); vreg = *(const u32x4*)(ZVb + (size_t)tk_ * 512 + (tid & 3) * 8); } } while (0)
#define ML_LI(c) gts[(size_t)ML_TOK((c) * 128 + (tid & 127)) * 16 + dir * 4 + h]
#define ML_TABLES(c, li_) do { if (tid < 128) { const int tau_ = (c) * 128 + tid; const float a_ = LA[tau_], mc_ = LM[(c)]; \
        const float Mj_ = fmaxf(mc_, LPA[tau_]), Me_ = fmaxf(mc_, LPA[(c) * 128 + 127]); float* tb_ = LTAB + ((c) & 1) * 512; \
        tb_[tid] = __expf(fminf(Me_ - Mj_, 60.f)); tb_[128 + tid] = __expf(mc_ - Mj_); tb_[256 + tid] = __expf(-((li_ - a_) + Mj_)); tb_[384 + tid] = __expf(a_ - Me_); } } while (0)
#define ML_STORE(c) do { _Pragma("unroll") for (int i_ = 0; i_ < 4; ++i_) { const int row_ = (tid >> 4) + 32 * i_; \
        *(u32x4*)(smem + OFF_Q + row_ * RS + (tid & 15) * 16) = qreg[i_]; *(u32x4*)(smem + OFF_K + row_ * RS + (tid & 15) * 16) = kreg[i_]; } \
      { const int s_ = tid >> 2, ps_ = spos(s_) * 2; const float we_ = LTAB[((c) & 1) * 512 + 384 + s_]; const u32 vw_[4] = {vreg.x, vreg.y, vreg.z, vreg.w}; \
        _Pragma("unroll") for (int i_ = 0; i_ < 4; ++i_) { const int r0_ = ((tid & 3) * 8 + 2 * i_) * RS + ps_; \
          *(bf16_t*)(smem + OFF_VT + r0_) = (bf16_t)(vw_[i_] & 0xFFFFu); *(bf16_t*)(smem + OFF_VT + r0_ + RS) = (bf16_t)(vw_[i_] >> 16); \
          *(bf16_t*)(smem + OFF_VW + r0_) = f2bf(bflo(vw_[i_]) * we_); *(bf16_t*)(smem + OFF_VW + r0_ + RS) = f2bf(bfhi(vw_[i_]) * we_); } } \
      if (tid < 128) { const int ps_ = spos(tid) * 2; *(bf16_t*)(smem + OFF_VT + 32 * RS + ps_) = (bf16_t)0x3F80u; *(bf16_t*)(smem + OFF_VW + 32 * RS + ps_) = f2bf(LTAB[((c) & 1) * 512 + 384 + tid]); } } while (0)
    float li_pf = ML_LI(0);
    ML_LOAD(0); ML_TABLES(0, li_pf);
    li_pf = ML_LI(1);
    __syncthreads();
    ML_STORE(0);
    __syncthreads();
    f32x16 Cacc;
#pragma unroll
    for (int r = 0; r < 16; ++r) Cacc[r] = 0.f;
    for (int c = 0; c < 32; ++c) {
      int tidc_ = threadIdx.x; asm volatile("" : "+v"(tidc_));
      const int tid = tidc_, wid = tid >> 6, lane = tid & 63, l31 = lane & 31, hh = lane >> 5;
      const int t2 = wid >> 1, nt = wid & 1, brow = min(nt * 32 + l31, 33);
      if (c + 1 < 32) { ML_LOAD(c + 1); ML_TABLES(c + 1, li_pf); }
      if (c + 2 < 32) li_pf = ML_LI(c + 2);
      const float* tab = LTAB + (c & 1) * 512;
      f32x16 acc;
#pragma unroll
      for (int r = 0; r < 16; ++r) acc[r] = 0.f;
      const char* qa = smem + OFF_Q + (t2 * 32 + l31) * RS + hh * 16;
      if (nt == 0) { const char* cb = smem + OFF_CT + l31 * RS + hh * 16;
#pragma unroll
        for (int ks = 0; ks < 8; ++ks) acc = ML_MFMA(*(const bf16x8*)(qa + ks * 32), *(const bf16x8*)(cb + ks * 32), acc);
#pragma unroll
        for (int r = 0; r < 16; ++r) acc[r] *= tab[128 + t2 * 32 + crow(r, hh)];
      } else { const char* cb = smem + OFF_CT + (l31 == 0 ? 32 : 33) * RS + hh * 16; f32x16 aq;
#pragma unroll
        for (int r = 0; r < 16; ++r) aq[r] = 0.f;
#pragma unroll
        for (int ks = 0; ks < 8; ++ks) aq = ML_MFMA(*(const bf16x8*)(qa + ks * 32), *(const bf16x8*)(cb + ks * 32), aq);
        if (l31 == 0) {
#pragma unroll
          for (int r = 0; r < 16; ++r) { const int j = t2 * 32 + crow(r, hh); LDEN[256 + j] = aq[r] * tab[128 + j]; } } }
      const float fj = tab[t2 * 32 + l31];
      float psum = 0.f;
      for (int si = nt; si <= t2; si += 2) {
        f32x16 X;
#pragma unroll
        for (int r = 0; r < 16; ++r) X[r] = 0.f;
        const char* ka = smem + OFF_K + (si * 32 + l31) * RS + hh * 16;
#pragma unroll
        for (int ks = 0; ks < 8; ++ks) X = ML_MFMA(*(const bf16x8*)(ka + ks * 32), *(const bf16x8*)(qa + ks * 32), X);
        const float* We = tab + 384 + si * 32;
#pragma unroll
        for (int r = 0; r < 16; ++r) { const int sl = crow(r, hh); float w = We[sl] * fj; if (si == t2 && sl > l31) w = 0.f; X[r] *= w; psum += X[r]; }
        const bf16x8 f0 = pack8(X[0], X[1], X[2], X[3], X[4], X[5], X[6], X[7]), f1 = pack8(X[8], X[9], X[10], X[11], X[12], X[13], X[14], X[15]);
        const char* vb = smem + OFF_VT + l31 * RS + si * 64 + hh * 16;
        acc = ML_MFMA(f0, *(const bf16x8*)(vb), acc); acc = ML_MFMA(f1, *(const bf16x8*)(vb + 32), acc);
      }
      psum += __shfl_xor(psum, 32);
      if (hh == 0) LDEN[nt * 128 + t2 * 32 + l31] = psum;
      if (nt == 1) { float* ex = (float*)(smem + OFF_EX) + t2 * 1024 + lane;
#pragma unroll
        for (int r = 0; r < 16; ++r) ex[r * 64] = acc[r]; }
      { const float mc = LM[c], decay = __expf(mc - fmaxf(mc, LPA[c * 128 + 127]));
#pragma unroll
        for (int r = 0; r < 16; ++r) Cacc[r] *= decay;
        const unsigned ta = lds0 + OFF_K + ((lane & 15) >> 2) * RS + (t2 * 32 + 16 * ((lane >> 4) & 1) + 4 * (lane & 3)) * 2 + 4 * hh * RS;
        const char* wb = smem + OFF_VW + brow * RS + hh * 16;
#pragma unroll
        for (int kq = 0; kq < 2; ++kq) { s16x4 r0, r1, r2, r3, r4, r5, r6, r7; tr_read8(ta + 64 * kq * RS, r0, r1, r2, r3, r4, r5, r6, r7); __builtin_amdgcn_sched_barrier(0);
          Cacc = ML_MFMA(((bf16x8){r0[0], r0[1], r0[2], r0[3], r1[0], r1[1], r1[2], r1[3]}), *(const bf16x8*)(wb + (4 * kq + 0) * 32), Cacc);
          Cacc = ML_MFMA(((bf16x8){r2[0], r2[1], r2[2], r2[3], r3[0], r3[1], r3[2], r3[3]}), *(const bf16x8*)(wb + (4 * kq + 1) * 32), Cacc);
          Cacc = ML_MFMA(((bf16x8){r4[0], r4[1], r4[2], r4[3], r5[0], r5[1], r5[2], r5[3]}), *(const bf16x8*)(wb + (4 * kq + 2) * 32), Cacc);
          Cacc = ML_MFMA(((bf16x8){r6[0], r6[1], r6[2], r6[3], r7[0], r7[1], r7[2], r7[3]}), *(const bf16x8*)(wb + (4 * kq + 3) * 32), Cacc); } }
      __syncthreads();
      if (nt == 0) { const float* ex = (const float*)(smem + OFF_EX) + t2 * 1024 + lane;
#pragma unroll
        for (int r = 0; r < 16; ++r) { const int j = t2 * 32 + crow(r, hh); const float dn = LDEN[j] + LDEN[128 + j] + LDEN[256 + j], nr = tab[256 + j]; const int tk = ML_TOK(c * 128 + j);
          HSb[(size_t)tk * 512 + l31] = f2bf((acc[r] + ex[r * 64]) * __builtin_amdgcn_rcpf(fmaxf(fabsf(dn), nr))); } }
      if (nt * 32 + l31 <= 32) { char* cw = smem + OFF_CT + (nt * 32 + l31) * RS + (t2 * 32 + 4 * hh) * 2;
#pragma unroll
        for (int g = 0; g < 4; ++g) { u32x2 w; w.x = pack2(Cacc[4 * g], Cacc[4 * g + 1]); w.y = pack2(Cacc[4 * g + 2], Cacc[4 * g + 3]); *(u32x2*)(cw + 16 * g) = w; } }
      if (c + 1 < 32) ML_STORE(c + 1);
      __syncthreads();
    }
#undef ML_TOK
#undef ML_LOAD
#undef ML_TABLES
#undef ML_LI
#undef ML_STORE
  }
}
}

__device__ void phase_peer_select_naive(const Params& p, int layer, char* smem) {
  float* kl = (float*)smem;
  float* qsh = kl + 2 * 128 * 129;
  const int tid = threadIdx.x, wid = tid >> 6, lane = tid & 63; float* qs = qsh + wid * 128;
  __syncthreads();
  for (int i = tid; i < 2 * 128 * 128; i += NTHREADS) kl[(i >> 7) * 129 + (i & 127)] = p.peer_keys[(size_t)layer * 32768 + i];
  __syncthreads();
  for (int job = blockIdx.x; job < T; job += gridDim.x) {
    const int t = job, h = wid;
    float ts[2][16]; int ti[2][16];
#pragma unroll
    for (int pp = 0; pp < 2; ++pp) {
      const bf16_t* q = p.QP + (size_t)t * 2048 + h * 256 + pp * 128; const float q0 = bf2f(q[lane]), q1 = bf2f(q[lane + 64]);
      const float r = rsqrtf(wave_sum(q0 * q0 + q1 * q1) * (1.f / 128.f) + EPS); qs[lane] = q0 * r; qs[lane + 64] = q1 * r;
      float s0 = 0.f, s1 = 0.f; const float* k0 = kl + (pp * 128 + lane) * 129; const float* k1 = k0 + 64 * 129;
      for (int c = 0; c < 128; ++c) { const float qc = qs[c]; s0 += qc * k0[c]; s1 += qc * k1[c]; }
#pragma unroll
      for (int k = 0; k < 16; ++k) { const float mx = wave_max(fmaxf(s0, s1)); int cand = (s0 == mx) ? lane : ((s1 == mx) ? lane + 64 : 9999);
        for (int o = 32; o >= 1; o >>= 1) cand = min(cand, __shfl_xor(cand, o));
        ts[pp][k] = mx; ti[pp][k] = cand; if (cand == lane) s0 = -INFINITY; if (cand == lane + 64) s1 = -INFINITY; }
    }
    float cs[4];
#pragma unroll
    for (int r = 0; r < 4; ++r) { const int c = lane * 4 + r; float va = 0.f, vb = 0.f;
#pragma unroll
      for (int k = 0; k < 16; ++k) { if (k == (c >> 4)) va = ts[0][k]; if (k == (c & 15)) vb = ts[1][k]; }
      cs[r] = va + vb; }
    float top[16]; int tix[16];
#pragma unroll
    for (int k = 0; k < 16; ++k) { const float mx = wave_max(fmaxf(fmaxf(cs[0], cs[1]), fmaxf(cs[2], cs[3]))); int cand = 9999;
#pragma unroll
      for (int r = 3; r >= 0; --r) if (cs[r] == mx) cand = lane * 4 + r;
      for (int o = 32; o >= 1; o >>= 1) cand = min(cand, __shfl_xor(cand, o));
      top[k] = mx; tix[k] = cand;
#pragma unroll
      for (int r = 0; r < 4; ++r) if (cand == lane * 4 + r) cs[r] = -INFINITY; }
    float sum = 0.f;
#pragma unroll
    for (int k = 0; k < 16; ++k) sum += __expf(top[k] - top[0]);
    if (lane < 16) { float tv = 0.f; int tc = 0;
#pragma unroll
      for (int k = 0; k < 16; ++k) if (k == lane) { tv = top[k]; tc = tix[k]; }
      int ia = 0, ib = 0;
#pragma unroll
      for (int k = 0; k < 16; ++k) { if (k == (tc >> 4)) ia = ti[0][k]; if (k == (tc & 15)) ib = ti[1][k]; }
      p.pidx[((size_t)t * 8 + h) * 16 + lane] = (bf16_t)(ia * 128 + ib); p.pgate[((size_t)t * 8 + h) * 16 + lane] = __expf(tv - top[0]) / sum; }
  }
}

namespace sel {
typedef short bf16x8 __attribute__((ext_vector_type(8)));
typedef float f32x16 __attribute__((ext_vector_type(16)));
constexpr int RS = 272, OFF_W = 2 * 128 * RS, WB = 3 * 16 * 32 * 4;
static_assert(OFF_W + 8 * WB <= SMEM_BYTES, "select LDS layout");
constexpr float NEG = -3.0e38f;
__device__ __forceinline__ float max3(float a, float b, float c) { return fmaxf(fmaxf(a, b), c); }
__device__ __forceinline__ float xhalf(float v) { return __shfl_xor(v, 32); }

#define CE(a, b) do { const float hi_ = fmaxf(a, b), lo_ = fminf(a, b); a = hi_; b = lo_; } while (0)
#define SORT16(V) do { CE(V[0], V[1]); CE(V[2], V[3]); CE(V[0], V[2]); CE(V[1], V[3]); CE(V[1], V[2]); CE(V[4], V[5]); CE(V[6], V[7]); CE(V[4], V[6]); CE(V[5], V[7]); CE(V[5], V[6]); CE(V[0], V[4]); CE(V[2], V[6]); CE(V[2], V[4]); CE(V[1], V[5]); CE(V[3], V[7]); CE(V[3], V[5]); CE(V[1], V[2]); CE(V[3], V[4]); CE(V[5], V[6]); CE(V[8], V[9]); CE(V[10], V[11]); CE(V[8], V[10]); CE(V[9], V[11]); CE(V[9], V[10]); CE(V[12], V[13]); CE(V[14], V[15]); CE(V[12], V[14]); CE(V[13], V[15]); CE(V[13], V[14]); CE(V[8], V[12]); CE(V[10], V[14]); CE(V[10], V[12]); CE(V[9], V[13]); CE(V[11], V[15]); CE(V[11], V[13]); CE(V[9], V[10]); CE(V[11], V[12]); CE(V[13], V[14]); CE(V[0], V[8]); CE(V[4], V[12]); CE(V[4], V[8]); CE(V[2], V[10]); CE(V[6], V[14]); CE(V[6], V[10]); CE(V[2], V[4]); CE(V[6], V[8]); CE(V[10], V[12]); CE(V[1], V[9]); CE(V[5], V[13]); CE(V[5], V[9]); CE(V[3], V[11]); CE(V[7], V[15]); CE(V[7], V[11]); CE(V[3], V[5]); CE(V[7], V[9]); CE(V[11], V[13]); CE(V[1], V[2]); CE(V[3], V[4]); CE(V[5], V[6]); CE(V[7], V[8]); CE(V[9], V[10]); CE(V[11], V[12]); CE(V[13], V[14]); } while (0)
#define BMERGE16(V) do { CE(V[0], V[8]); CE(V[1], V[9]); CE(V[2], V[10]); CE(V[3], V[11]); CE(V[4], V[12]); CE(V[5], V[13]); CE(V[6], V[14]); CE(V[7], V[15]); CE(V[0], V[4]); CE(V[1], V[5]); CE(V[2], V[6]); CE(V[3], V[7]); CE(V[8], V[12]); CE(V[9], V[13]); CE(V[10], V[14]); CE(V[11], V[15]); CE(V[0], V[2]); CE(V[1], V[3]); CE(V[4], V[6]); CE(V[5], V[7]); CE(V[8], V[10]); CE(V[9], V[11]); CE(V[12], V[14]); CE(V[13], V[15]); CE(V[0], V[1]); CE(V[2], V[3]); CE(V[4], V[5]); CE(V[6], V[7]); CE(V[8], V[9]); CE(V[10], V[11]); CE(V[12], V[13]); CE(V[14], V[15]); } while (0)

__device__ void phase_peer_select(const Params& p, int layer, char* smem) {
  const int tid0 = threadIdx.x;
  __syncthreads();
  { const bf16_t* kb = p.keysb + (size_t)layer * 32768;
    for (int i = tid0; i < 2 * 128 * 16; i += NTHREADS) { const int row = i >> 4, ch = i & 15; *(u32x4*)(smem + row * RS + ch * 16) = *(const u32x4*)(kb + (size_t)row * 128 + ch * 8); } }
  __syncthreads();
  for (int job = blockIdx.x; job < T / 32; job += gridDim.x) {
    int tid_ = threadIdx.x; asm volatile("" : "+v"(tid_));
    const int tid = tid_, wid = tid >> 6, lane = tid & 63, l31 = lane & 31, hh = lane >> 5, h = wid;
    const int t = job * 32 + l31;
    float* const wl = (float*)(smem + OFF_W + wid * WB);
    float rs[2], s1[16], s2[16];
#pragma unroll
    for (int pp = 0; pp < 2; ++pp) {
      const bf16_t* qrow = p.QP + (size_t)t * 2048 + h * 256 + pp * 128 + hh * 8;
      bf16x8 bq[8]; float ssq = 0.f;
#pragma unroll
      for (int ks = 0; ks < 8; ++ks) { const u32x4 w = *(const u32x4*)(qrow + ks * 16); bq[ks] = __builtin_bit_cast(bf16x8, w);
        const u32 w0 = w.x, w1 = w.y, w2 = w.z, w3 = w.w; ssq = dot2bf(w0, w0, ssq); ssq = dot2bf(w1, w1, ssq); ssq = dot2bf(w2, w2, ssq); ssq = dot2bf(w3, w3, ssq); }
      ssq += xhalf(ssq); rs[pp] = rsqrtf(ssq * (1.f / 128.f) + EPS);
      f32x16 X[4];
#pragma unroll
      for (int nt = 0; nt < 4; ++nt) {
#pragma unroll
        for (int r = 0; r < 16; ++r) X[nt][r] = 0.f;
        const char* ka = smem + (pp * 128 + nt * 32 + l31) * RS + hh * 16;
#pragma unroll
        for (int ks = 0; ks < 8; ++ks) X[nt] = __builtin_amdgcn_mfma_f32_32x32x16_bf16(*(const bf16x8*)(ka + ks * 32), bq[ks], X[nt], 0, 0, 0); }
#pragma unroll
      for (int nt = 0; nt < 4; ++nt)
#pragma unroll
        for (int r = 0; r < 16; ++r) X[nt][r] = __uint_as_float((__float_as_uint(X[nt][r]) & ~0x7Fu) | (u32)(nt * 32 + (r & 3) + 8 * (r >> 2)) | ((u32)hh << 2));
      SORT16(X[0]); SORT16(X[1]); SORT16(X[2]); SORT16(X[3]);
#pragma unroll
      for (int i = 0; i < 16; ++i) { X[0][i] = fmaxf(X[0][i], X[1][15 - i]); X[2][i] = fmaxf(X[2][i], X[3][15 - i]); }
      BMERGE16(X[0]); BMERGE16(X[2]);
#pragma unroll
      for (int i = 0; i < 16; ++i) X[0][i] = fmaxf(X[0][i], X[2][15 - i]);
      BMERGE16(X[0]);
      f32x16 lo_, hi_;
#pragma unroll
      for (int i = 0; i < 16; ++i) { const u32 b_ = __float_as_uint(X[0][i]); auto r_ = __builtin_amdgcn_permlane32_swap(b_, b_, false, false); lo_[i] = __uint_as_float(r_[0]); hi_[i] = __uint_as_float(r_[1]); }
#pragma unroll
      for (int i = 0; i < 16; ++i) X[0][i] = fmaxf(lo_[i], hi_[15 - i]);
      BMERGE16(X[0]);
#pragma unroll
      for (int k = 0; k < 16; ++k) { wl[(pp * 16 + k) * 32 + l31] = X[0][k]; if (pp == 0) s1[k] = X[0][k] * rs[0]; else s2[k] = X[0][k] * rs[1]; }
    }
    constexpr int A0[25] = {0, 0, 0, 0, 0, 0, 0, 0, 0, 0, 0, 0, 0, 0, 0, 0, 2, 2, 2, 2, 2, 3, 3, 3, 3}, B0[25] = {0, 1, 2, 3, 4, 5, 6, 7, 8, 9, 10, 11, 12, 13, 14, 15, 0, 1, 2, 3, 4, 0, 1, 2, 3};
    constexpr int A1[25] = {1, 1, 1, 1, 1, 1, 1, 1, 4, 4, 4, 5, 5, 6, 6, 7, 7, 8, 9, 10, 11, 12, 13, 14, 15}, B1[25] = {0, 1, 2, 3, 4, 5, 6, 7, 0, 1, 2, 0, 1, 0, 1, 0, 1, 0, 0, 0, 0, 0, 0, 0, 0};
    float cd[25];
#pragma unroll
    for (int i = 0; i < 25; ++i) { const float v0 = s1[A0[i]] + s2[B0[i]], v1 = s1[A1[i]] + s2[B1[i]]; const float v = hh ? v1 : v0; const u32 cid = hh ? (u32)(A1[i] * 16 + B1[i]) : (u32)(A0[i] * 16 + B0[i]);
      cd[i] = __uint_as_float((__float_as_uint(v) & ~0xFFu) | cid); }
#pragma unroll 1
    for (int k = 0; k < 16; ++k) {
      float m = cd[24];
#pragma unroll
      for (int i = 0; i < 24; i += 2) m = max3(m, cd[i], cd[i + 1]);
      const float M = fmaxf(m, xhalf(m));
      wl[(32 + k) * 32 + l31] = M;
#pragma unroll
      for (int i = 0; i < 25; ++i) cd[i] = (cd[i] == M) ? NEG : cd[i];
    }
    float tv[16];
#pragma unroll
    for (int k = 0; k < 16; ++k) tv[k] = wl[(32 + k) * 32 + l31];
    float sum = 0.f;
#pragma unroll
    for (int k = 0; k < 16; ++k) sum += __expf(tv[k] - tv[0]);
    const float inv = 1.f / sum;
    u32 ev[8]; float go[8];
#pragma unroll
    for (int q = 0; q < 8; ++q) { const float v = wl[(32 + hh * 8 + q) * 32 + l31]; const u32 cid = __float_as_uint(v) & 0xFFu;
      const u32 i1 = __float_as_uint(wl[(cid >> 4) * 32 + l31]) & 0x7Fu, i2 = __float_as_uint(wl[(16 + (cid & 15)) * 32 + l31]) & 0x7Fu; ev[q] = i1 * 128 + i2;
      go[q] = __expf(v - tv[0]) * inv; }
    const u32 io0 = ev[0] | (ev[1] << 16), io1 = ev[2] | (ev[3] << 16), io2 = ev[4] | (ev[5] << 16), io3 = ev[6] | (ev[7] << 16);
    const size_t ob = ((size_t)t * 8 + h) * 16 + hh * 8;
    *(u32x4*)(p.pidx + ob) = (u32x4){io0, io1, io2, io3};
    *(f32x4*)(p.pgate + ob) = (f32x4){go[0], go[1], go[2], go[3]}; *(f32x4*)(p.pgate + ob + 4) = (f32x4){go[4], go[5], go[6], go[7]};
  }
}
}

typedef float f32x2 __attribute__((ext_vector_type(2)));
constexpr float U8_SCALE = 32.f, V8_SCALE = 2.f;
constexpr int GT = 4;
constexpr int GW_WAVE_BYTES = GT * (2048 + 128 * 2 + 128 * 4);
static_assert(8 * GW_WAVE_BYTES <= SMEM_BYTES - 16, "gather LDS layout");
__device__ __forceinline__ float gelu_erf(float z) { return 0.5f * z * (1.f + erff(z * 0.70710678118654752f)); }
__device__ __forceinline__ float reduce8(float d0, float d1, float d2, float d3, float d4, float d5, float d6, float d7, int lane) {
  float e[4];
  { auto r0 = __builtin_amdgcn_permlane32_swap(__float_as_uint(d0), __float_as_uint(d4), false, false); e[0] = __uint_as_float(r0[0]) + __uint_as_float(r0[1]);
    auto r1 = __builtin_amdgcn_permlane32_swap(__float_as_uint(d1), __float_as_uint(d5), false, false); e[1] = __uint_as_float(r1[0]) + __uint_as_float(r1[1]);
    auto r2 = __builtin_amdgcn_permlane32_swap(__float_as_uint(d2), __float_as_uint(d6), false, false); e[2] = __uint_as_float(r2[0]) + __uint_as_float(r2[1]);
    auto r3 = __builtin_amdgcn_permlane32_swap(__float_as_uint(d3), __float_as_uint(d7), false, false); e[3] = __uint_as_float(r3[0]) + __uint_as_float(r3[1]); }
  float f0, f1;
  { auto r0 = __builtin_amdgcn_permlane16_swap(__float_as_uint(e[0]), __float_as_uint(e[2]), false, false); f0 = __uint_as_float(r0[0]) + __uint_as_float(r0[1]);
    auto r1 = __builtin_amdgcn_permlane16_swap(__float_as_uint(e[1]), __float_as_uint(e[3]), false, false); f1 = __uint_as_float(r1[0]) + __uint_as_float(r1[1]); }
  const bool up = (lane & 8) != 0; const float keep = up ? f1 : f0, send = up ? f0 : f1;
  float g = keep + __shfl_xor(send, 8);
  g += __shfl_xor(g, 4); g += __shfl_xor(g, 2); g += __shfl_xor(g, 1);
  return g;
}
template <int NEXT>
__device__ void phase_peer_gather(const Params& p, int layer, char* smem) {
  const __amdgpu_buffer_rsrc_t rsU = __builtin_amdgcn_make_buffer_rsrc((void*)(p.U8 + (size_t)layer * 16384 * 1024), 0, 16384 * 1024, 0x00020000);
  const __amdgpu_buffer_rsrc_t rsV = __builtin_amdgcn_make_buffer_rsrc((void*)(p.V8 + (size_t)layer * 16384 * 1024), 0, 16384 * 1024, 0x00020000);
  for (int job = blockIdx.x; job < T / (8 * GT); job += gridDim.x) {
    int tid_ = threadIdx.x; asm volatile("" : "+v"(tid_));
    const int tid = tid_, wid = tid >> 6, lane = tid & 63;
    const int tb = (job * 8 + wid) * GT;
    const int vidx = 4 * (lane >> 5) + 2 * ((lane >> 4) & 1) + ((lane >> 3) & 1); const unsigned lane16 = (unsigned)lane * 16u;
    char* wl = smem + wid * GW_WAVE_BYTES; bf16_t* sx = (bf16_t*)wl; bf16_t* sidx = (bf16_t*)(wl + GT * 2048); float* sgate = (float*)(wl + GT * 2048 + GT * 256);
#pragma unroll 1
    for (int g = 0; g < GT; ++g) { const size_t t = (size_t)(tb + g);
      *(u32x4*)(sx + g * 1024 + lane * 16) = *(const u32x4*)(p.H + t * D + lane * 16); *(u32x4*)(sx + g * 1024 + lane * 16 + 8) = *(const u32x4*)(p.H + t * D + lane * 16 + 8);
      const int ia = p.pidx[t * 128 + lane], ib = p.pidx[t * 128 + 64 + lane]; const float ga = p.pgate[t * 128 + lane], gb = p.pgate[t * 128 + 64 + lane];
      const int wa = ia >> 10, wb = ib >> 10; int off = 0, pa = 0, pb = 0;
#pragma unroll
      for (int w = 0; w < 16; ++w) { const unsigned long long m0 = __ballot(wa == w), m1 = __ballot(wb == w); const int c0 = __popcll(m0), c1 = __popcll(m1);
        const int r0 = __builtin_amdgcn_mbcnt_hi((unsigned)(m0 >> 32), __builtin_amdgcn_mbcnt_lo((unsigned)m0, 0)), r1 = __builtin_amdgcn_mbcnt_hi((unsigned)(m1 >> 32), __builtin_amdgcn_mbcnt_lo((unsigned)m1, 0));
        if (wa == w) pa = off + r0; if (wb == w) pb = off + c0 + r1; off += c0 + c1; }
      sidx[g * 128 + pa] = (bf16_t)ia; sgate[g * 128 + pa] = ga; sidx[g * 128 + pb] = (bf16_t)ib; sgate[g * 128 + pb] = gb; }
    f32x2 acc[GT][8];
#pragma unroll
    for (int g = 0; g < GT; ++g)
#pragma unroll
      for (int i = 0; i < 8; ++i) acc[g][i] = (f32x2){0.f, 0.f};
#pragma unroll 1
    for (int hb = 0; hb < 16; ++hb) {
#pragma unroll
      for (int g = 0; g < GT; ++g) {
        const int myidx = (int)sidx[g * 128 + hb * 8 + (lane & 7)]; const float mygate = sgate[g * 128 + hb * 8 + vidx];
        const u32x4 h0 = *(const u32x4*)(sx + g * 1024 + lane * 16), h1 = *(const u32x4*)(sx + g * 1024 + lane * 16 + 8);
        const u32 hx[8] = {h0.x, h0.y, h0.z, h0.w, h1.x, h1.y, h1.z, h1.w};
        u32x4 ur[8], vr[8];
#pragma unroll
        for (int k = 0; k < 8; ++k) { const unsigned e = (unsigned)__builtin_amdgcn_readlane(myidx, k); ur[k] = __builtin_amdgcn_raw_buffer_load_b128(rsU, lane16, e * 1024u, 0); if (k < 4) vr[k] = __builtin_amdgcn_raw_buffer_load_b128(rsV, lane16, e * 1024u, 0); }
        float d[8];
#pragma unroll
        for (int k = 0; k < 8; ++k) { const u32 w[4] = {ur[k].x, ur[k].y, ur[k].z, ur[k].w}; float a = 0.f;
#pragma unroll
          for (int j = 0; j < 4; ++j) { const u32 lo = __builtin_bit_cast(u32, __builtin_amdgcn_cvt_scalef32_pk_bf16_fp8(w[j], 1.0f, false)), hi = __builtin_bit_cast(u32, __builtin_amdgcn_cvt_scalef32_pk_bf16_fp8(w[j], 1.0f, true));
            a = dot2bf(lo, hx[2 * j], a); a = dot2bf(hi, hx[2 * j + 1], a); }
          asm volatile("" : "+v"(a));
          d[k] = a; }
        asm volatile("" ::: "memory");
#pragma unroll
        for (int k = 4; k < 8; ++k) { const unsigned e = (unsigned)__builtin_amdgcn_readlane(myidx, k); vr[k] = __builtin_amdgcn_raw_buffer_load_b128(rsV, lane16, e * 1024u, 0); }
        const float z = reduce8(d[0], d[1], d[2], d[3], d[4], d[5], d[6], d[7], lane) * (1.f / U8_SCALE);
        const float cf = mygate * gelu_erf(z) * (1.f / V8_SCALE);
#pragma unroll
        for (int k = 0; k < 8; ++k) { const float ck = __uint_as_float(__builtin_amdgcn_readlane(__float_as_uint(cf), 32 * (k >> 2) + 16 * ((k >> 1) & 1) + 8 * (k & 1)));
          const u32 w[4] = {vr[k].x, vr[k].y, vr[k].z, vr[k].w}; const f32x2 c2 = (f32x2){ck, ck};
#pragma unroll
          for (int j = 0; j < 4; ++j) { const f32x2 lo = __builtin_amdgcn_cvt_pk_f32_fp8((int)w[j], false), hi = __builtin_amdgcn_cvt_pk_f32_fp8((int)w[j], true);
            acc[g][2 * j] = lo * c2 + acc[g][2 * j]; acc[g][2 * j + 1] = hi * c2 + acc[g][2 * j + 1]; } }
        asm volatile("" ::: "memory");
      }
      if ((hb & 3) == 3) __syncthreads();
    }
#pragma unroll
    for (int g = 0; g < GT; ++g) { const int t = tb + g, b = t / S;
      const float* g2 = p.mod + (size_t)(layer * 8 + b) * 6144 + 5120 + lane * 16; float* xp = p.X + (size_t)t * D + lane * 16;
      float xv[16]; float ss = 0.f;
#pragma unroll
      for (int q = 0; q < 4; ++q) { const f32x4 x0 = *(const f32x4*)(xp + 4 * q), g0 = *(const f32x4*)(g2 + 4 * q);
        xv[4 * q + 0] = x0.x + g0.x * acc[g][2 * q].x; xv[4 * q + 1] = x0.y + g0.y * acc[g][2 * q].y; xv[4 * q + 2] = x0.z + g0.z * acc[g][2 * q + 1].x; xv[4 * q + 3] = x0.w + g0.w * acc[g][2 * q + 1].y; }
#pragma unroll
      for (int i = 0; i < 16; ++i) ss += xv[i] * xv[i];
      ss = wave_sum(ss); const float r = rsqrtf(ss * (1.f / D) + EPS);
      if (NEXT == 0) {
        const float* ml = p.mod + (size_t)((layer + 1) * 8 + b) * 6144 + lane * 16; const float* gn = p.nmg + (layer + 1) * D + lane * 16; float y[16];
#pragma unroll
        for (int i = 0; i < 16; ++i) y[i] = xv[i] * r * gn[i] * (1.f + ml[1024 + i]) + ml[i];
#pragma unroll
        for (int q = 0; q < 4; ++q) *(f32x4*)(xp + 4 * q) = (f32x4){xv[4 * q], xv[4 * q + 1], xv[4 * q + 2], xv[4 * q + 3]};
        u32x4 w0, w1; w0.x = pack2(y[0], y[1]); w0.y = pack2(y[2], y[3]); w0.z = pack2(y[4], y[5]); w0.w = pack2(y[6], y[7]); w1.x = pack2(y[8], y[9]); w1.y = pack2(y[10], y[11]); w1.z = pack2(y[12], y[13]); w1.w = pack2(y[14], y[15]);
        *(u32x4*)(p.H + (size_t)t * D + lane * 16) = w0; *(u32x4*)(p.H + (size_t)t * D + lane * 16 + 8) = w1;
      } else {
        const float* fg = p.final_g + lane * 16;
#pragma unroll
        for (int q = 0; q < 4; ++q) *(f32x4*)(xp + 4 * q) = (f32x4){xv[4 * q] * r * fg[4 * q], xv[4 * q + 1] * r * fg[4 * q + 1], xv[4 * q + 2] * r * fg[4 * q + 2], xv[4 * q + 3] * r * fg[4 * q + 3]};
      }
      asm volatile("" ::: "memory");
    }
    __syncthreads();
  }
}

constexpr int PF_LIDX = 2 * 128 * 272, PF_LGATE = PF_LIDX + 32 * 128 * 2, PF_X = PF_LGATE + 32 * 128 * 4;
static_assert(PF_X + 8 * 8192 <= SMEM_BYTES - 16 && GT == 4, "fused PEER LDS layout");
template <int NEXT>
__device__ void phase_peer_fused(const Params& p, int layer, char* smem) {
  using namespace sel;
  bf16_t* const Lidx = (bf16_t*)(smem + PF_LIDX); float* const Lgate = (float*)(smem + PF_LGATE);
  const int tid0 = threadIdx.x;
  __syncthreads();
  { const bf16_t* kb = p.keysb + (size_t)layer * 32768;
    for (int i = tid0; i < 2 * 128 * 16; i += NTHREADS) { const int row = i >> 4, ch = i & 15; *(u32x4*)(smem + row * RS + ch * 16) = *(const u32x4*)(kb + (size_t)row * 128 + ch * 8); } }
  __syncthreads();
  const __amdgpu_buffer_rsrc_t rsU = __builtin_amdgcn_make_buffer_rsrc((void*)(p.U8 + (size_t)layer * 16384 * 1024), 0, 16384 * 1024, 0x00020000);
  const __amdgpu_buffer_rsrc_t rsV = __builtin_amdgcn_make_buffer_rsrc((void*)(p.V8 + (size_t)layer * 16384 * 1024), 0, 16384 * 1024, 0x00020000);
  for (int job = blockIdx.x; job < T / 32; job += gridDim.x) {
   {
    int tid_ = threadIdx.x; asm volatile("" : "+v"(tid_));
    const int tid = tid_, wid = tid >> 6, lane = tid & 63, l31 = lane & 31, hh = lane >> 5, h = wid;
    const int t = job * 32 + l31;
    float* const wl = (float*)(smem + PF_X + wid * 8192);
    float rs[2], s1[16], s2[16];
#pragma unroll
    for (int pp = 0; pp < 2; ++pp) {
      const bf16_t* qrow = p.QP + (size_t)t * 2048 + h * 256 + pp * 128 + hh * 8;
      bf16x8 bq[8]; float ssq = 0.f;
#pragma unroll
      for (int ks = 0; ks < 8; ++ks) { const u32x4 w = *(const u32x4*)(qrow + ks * 16); bq[ks] = __builtin_bit_cast(bf16x8, w);
        const u32 w0 = w.x, w1 = w.y, w2 = w.z, w3 = w.w; ssq = dot2bf(w0, w0, ssq); ssq = dot2bf(w1, w1, ssq); ssq = dot2bf(w2, w2, ssq); ssq = dot2bf(w3, w3, ssq); }
      ssq += xhalf(ssq); rs[pp] = rsqrtf(ssq * (1.f / 128.f) + EPS);
      f32x16 X[4];
#pragma unroll
      for (int nt = 0; nt < 4; ++nt) {
#pragma unroll
        for (int r = 0; r < 16; ++r) X[nt][r] = 0.f;
        const char* ka = smem + (pp * 128 + nt * 32 + l31) * RS + hh * 16;
#pragma unroll
        for (int ks = 0; ks < 8; ++ks) X[nt] = __builtin_amdgcn_mfma_f32_32x32x16_bf16(*(const bf16x8*)(ka + ks * 32), bq[ks], X[nt], 0, 0, 0); }
#pragma unroll
      for (int nt = 0; nt < 4; ++nt)
#pragma unroll
        for (int r = 0; r < 16; ++r) X[nt][r] = __uint_as_float((__float_as_uint(X[nt][r]) & ~0x7Fu) | (u32)(nt * 32 + (r & 3) + 8 * (r >> 2)) | ((u32)hh << 2));
      SORT16(X[0]); SORT16(X[1]); SORT16(X[2]); SORT16(X[3]);
#pragma unroll
      for (int i = 0; i < 16; ++i) { X[0][i] = fmaxf(X[0][i], X[1][15 - i]); X[2][i] = fmaxf(X[2][i], X[3][15 - i]); }
      BMERGE16(X[0]); BMERGE16(X[2]);
#pragma unroll
      for (int i = 0; i < 16; ++i) X[0][i] = fmaxf(X[0][i], X[2][15 - i]);
      BMERGE16(X[0]);
      f32x16 lo_, hi_;
#pragma unroll
      for (int i = 0; i < 16; ++i) { const u32 b_ = __float_as_uint(X[0][i]); auto r_ = __builtin_amdgcn_permlane32_swap(b_, b_, false, false); lo_[i] = __uint_as_float(r_[0]); hi_[i] = __uint_as_float(r_[1]); }
#pragma unroll
      for (int i = 0; i < 16; ++i) X[0][i] = fmaxf(lo_[i], hi_[15 - i]);
      BMERGE16(X[0]);
#pragma unroll
      for (int k = 0; k < 16; ++k) { wl[(pp * 16 + k) * 32 + l31] = X[0][k]; if (pp == 0) s1[k] = X[0][k] * rs[0]; else s2[k] = X[0][k] * rs[1]; }
    }
    constexpr int A0[25] = {0, 0, 0, 0, 0, 0, 0, 0, 0, 0, 0, 0, 0, 0, 0, 0, 2, 2, 2, 2, 2, 3, 3, 3, 3}, B0[25] = {0, 1, 2, 3, 4, 5, 6, 7, 8, 9, 10, 11, 12, 13, 14, 15, 0, 1, 2, 3, 4, 0, 1, 2, 3};
    constexpr int A1[25] = {1, 1, 1, 1, 1, 1, 1, 1, 4, 4, 4, 5, 5, 6, 6, 7, 7, 8, 9, 10, 11, 12, 13, 14, 15}, B1[25] = {0, 1, 2, 3, 4, 5, 6, 7, 0, 1, 2, 0, 1, 0, 1, 0, 1, 0, 0, 0, 0, 0, 0, 0, 0};
    float cd[25];
#pragma unroll
    for (int i = 0; i < 25; ++i) { const float v0 = s1[A0[i]] + s2[B0[i]], v1 = s1[A1[i]] + s2[B1[i]]; const float v = hh ? v1 : v0; const u32 cid = hh ? (u32)(A1[i] * 16 + B1[i]) : (u32)(A0[i] * 16 + B0[i]);
      cd[i] = __uint_as_float((__float_as_uint(v) & ~0xFFu) | cid); }
#pragma unroll 1
    for (int k = 0; k < 16; ++k) {
      float m = cd[24];
#pragma unroll
      for (int i = 0; i < 24; i += 2) m = max3(m, cd[i], cd[i + 1]);
      const float M = fmaxf(m, xhalf(m));
      wl[(32 + k) * 32 + l31] = M;
#pragma unroll
      for (int i = 0; i < 25; ++i) cd[i] = (cd[i] == M) ? NEG : cd[i];
    }
    float tv[16];
#pragma unroll
    for (int k = 0; k < 16; ++k) tv[k] = wl[(32 + k) * 32 + l31];
    float sum = 0.f;
#pragma unroll
    for (int k = 0; k < 16; ++k) sum += __expf(tv[k] - tv[0]);
    const float inv = 1.f / sum;
    u32 ev[8]; float go[8];
#pragma unroll
    for (int q = 0; q < 8; ++q) { const float v = wl[(32 + hh * 8 + q) * 32 + l31]; const u32 cid = __float_as_uint(v) & 0xFFu;
      const u32 i1 = __float_as_uint(wl[(cid >> 4) * 32 + l31]) & 0x7Fu, i2 = __float_as_uint(wl[(16 + (cid & 15)) * 32 + l31]) & 0x7Fu; ev[q] = i1 * 128 + i2;
      go[q] = __expf(v - tv[0]) * inv; }
    const u32 io0 = ev[0] | (ev[1] << 16), io1 = ev[2] | (ev[3] << 16), io2 = ev[4] | (ev[5] << 16), io3 = ev[6] | (ev[7] << 16);
    { const int ob = l31 * 128 + h * 16 + hh * 8;
      *(u32x4*)(Lidx + ob) = (u32x4){io0, io1, io2, io3};
      *(f32x4*)(Lgate + ob) = (f32x4){go[0], go[1], go[2], go[3]}; *(f32x4*)(Lgate + ob + 4) = (f32x4){go[4], go[5], go[6], go[7]}; }
   }
   __syncthreads();
   {
    int tid_ = threadIdx.x; asm volatile("" : "+v"(tid_));
    const int tid = tid_, wid = tid >> 6, lane = tid & 63;
    const int tb = (job * 8 + wid) * GT;
    const int vidx = 4 * (lane >> 5) + 2 * ((lane >> 4) & 1) + ((lane >> 3) & 1); const unsigned lane16 = (unsigned)lane * 16u;
    bf16_t* sx = (bf16_t*)(smem + PF_X + wid * 8192); bf16_t* sidx = Lidx + wid * GT * 128; float* sgate = Lgate + wid * GT * 128;
#pragma unroll 1
    for (int g = 0; g < GT; ++g) { const size_t t = (size_t)(tb + g);
      *(u32x4*)(sx + g * 1024 + lane * 16) = *(const u32x4*)(p.H + t * D + lane * 16); *(u32x4*)(sx + g * 1024 + lane * 16 + 8) = *(const u32x4*)(p.H + t * D + lane * 16 + 8);
      const int ia = sidx[g * 128 + lane], ib = sidx[g * 128 + 64 + lane]; const float ga = sgate[g * 128 + lane], gb = sgate[g * 128 + 64 + lane];
      const int wa = ia >> 10, wb = ib >> 10; int off = 0, pa = 0, pb = 0;
#pragma unroll
      for (int w = 0; w < 16; ++w) { const unsigned long long m0 = __ballot(wa == w), m1 = __ballot(wb == w); const int c0 = __popcll(m0), c1 = __popcll(m1);
        const int r0 = __builtin_amdgcn_mbcnt_hi((unsigned)(m0 >> 32), __builtin_amdgcn_mbcnt_lo((unsigned)m0, 0)), r1 = __builtin_amdgcn_mbcnt_hi((unsigned)(m1 >> 32), __builtin_amdgcn_mbcnt_lo((unsigned)m1, 0));
        if (wa == w) pa = off + r0; if (wb == w) pb = off + c0 + r1; off += c0 + c1; }
      sidx[g * 128 + pa] = (bf16_t)ia; sgate[g * 128 + pa] = ga; sidx[g * 128 + pb] = (bf16_t)ib; sgate[g * 128 + pb] = gb; }
    f32x2 acc[GT][8];
#pragma unroll
    for (int g = 0; g < GT; ++g)
#pragma unroll
      for (int i = 0; i < 8; ++i) acc[g][i] = (f32x2){0.f, 0.f};
#pragma unroll 1
    for (int hb = 0; hb < 16; ++hb) {
#pragma unroll
      for (int g = 0; g < GT; ++g) {
        const int myidx = (int)sidx[g * 128 + hb * 8 + (lane & 7)]; const float mygate = sgate[g * 128 + hb * 8 + vidx];
        const u32x4 h0 = *(const u32x4*)(sx + g * 1024 + lane * 16), h1 = *(const u32x4*)(sx + g * 1024 + lane * 16 + 8);
        const u32 hx[8] = {h0.x, h0.y, h0.z, h0.w, h1.x, h1.y, h1.z, h1.w};
        u32x4 ur[8], vr[8];
#pragma unroll
        for (int k = 0; k < 8; ++k) { const unsigned e = (unsigned)__builtin_amdgcn_readlane(myidx, k); ur[k] = __builtin_amdgcn_raw_buffer_load_b128(rsU, lane16, e * 1024u, 0); if (k < 4) vr[k] = __builtin_amdgcn_raw_buffer_load_b128(rsV, lane16, e * 1024u, 0); }
        float d[8];
#pragma unroll
        for (int k = 0; k < 8; ++k) { const u32 w[4] = {ur[k].x, ur[k].y, ur[k].z, ur[k].w}; float a = 0.f;
#pragma unroll
          for (int j = 0; j < 4; ++j) { const u32 lo = __builtin_bit_cast(u32, __builtin_amdgcn_cvt_scalef32_pk_bf16_fp8(w[j], 1.0f, false)), hi = __builtin_bit_cast(u32, __builtin_amdgcn_cvt_scalef32_pk_bf16_fp8(w[j], 1.0f, true));
            a = dot2bf(lo, hx[2 * j], a); a = dot2bf(hi, hx[2 * j + 1], a); }
          asm volatile("" : "+v"(a));
          d[k] = a; }
        asm volatile("" ::: "memory");
#pragma unroll
        for (int k = 4; k < 8; ++k) { const unsigned e = (unsigned)__builtin_amdgcn_readlane(myidx, k); vr[k] = __builtin_amdgcn_raw_buffer_load_b128(rsV, lane16, e * 1024u, 0); }
        const float z = reduce8(d[0], d[1], d[2], d[3], d[4], d[5], d[6], d[7], lane) * (1.f / U8_SCALE);
        const float cf = mygate * gelu_erf(z) * (1.f / V8_SCALE);
#pragma unroll
        for (int k = 0; k < 8; ++k) { const float ck = __uint_as_float(__builtin_amdgcn_readlane(__float_as_uint(cf), 32 * (k >> 2) + 16 * ((k >> 1) & 1) + 8 * (k & 1)));
          const u32 w[4] = {vr[k].x, vr[k].y, vr[k].z, vr[k].w}; const f32x2 c2 = (f32x2){ck, ck};
#pragma unroll
          for (int j = 0; j < 4; ++j) { const f32x2 lo = __builtin_amdgcn_cvt_pk_f32_fp8((int)w[j], false), hi = __builtin_amdgcn_cvt_pk_f32_fp8((int)w[j], true);
            acc[g][2 * j] = lo * c2 + acc[g][2 * j]; acc[g][2 * j + 1] = hi * c2 + acc[g][2 * j + 1]; } }
        asm volatile("" ::: "memory");
      }
      if ((hb & 3) == 3) __syncthreads();
    }
#pragma unroll
    for (int g = 0; g < GT; ++g) { const int t = tb + g, b = t / S;
      const float* g2 = p.mod + (size_t)(layer * 8 + b) * 6144 + 5120 + lane * 16; float* xp = p.X + (size_t)t * D + lane * 16;
      float xv[16]; float ss = 0.f;
#pragma unroll
      for (int q = 0; q < 4; ++q) { const f32x4 x0 = *(const f32x4*)(xp + 4 * q), g0 = *(const f32x4*)(g2 + 4 * q);
        xv[4 * q + 0] = x0.x + g0.x * acc[g][2 * q].x; xv[4 * q + 1] = x0.y + g0.y * acc[g][2 * q].y; xv[4 * q + 2] = x0.z + g0.z * acc[g][2 * q + 1].x; xv[4 * q + 3] = x0.w + g0.w * acc[g][2 * q + 1].y; }
#pragma unroll
      for (int i = 0; i < 16; ++i) ss += xv[i] * xv[i];
      ss = wave_sum(ss); const float r = rsqrtf(ss * (1.f / D) + EPS);
      if (NEXT == 0) {
        const float* ml = p.mod + (size_t)((layer + 1) * 8 + b) * 6144 + lane * 16; const float* gn = p.nmg + (layer + 1) * D + lane * 16; float y[16];
#pragma unroll
        for (int i = 0; i < 16; ++i) y[i] = xv[i] * r * gn[i] * (1.f + ml[1024 + i]) + ml[i];
#pragma unroll
        for (int q = 0; q < 4; ++q) *(f32x4*)(xp + 4 * q) = (f32x4){xv[4 * q], xv[4 * q + 1], xv[4 * q + 2], xv[4 * q + 3]};
        u32x4 w0, w1; w0.x = pack2(y[0], y[1]); w0.y = pack2(y[2], y[3]); w0.z = pack2(y[4], y[5]); w0.w = pack2(y[6], y[7]); w1.x = pack2(y[8], y[9]); w1.y = pack2(y[10], y[11]); w1.z = pack2(y[12], y[13]); w1.w = pack2(y[14], y[15]);
        *(u32x4*)(p.H + (size_t)t * D + lane * 16) = w0; *(u32x4*)(p.H + (size_t)t * D + lane * 16 + 8) = w1;
      } else {
        const float* fg = p.final_g + lane * 16;
#pragma unroll
        for (int q = 0; q < 4; ++q) *(f32x4*)(xp + 4 * q) = (f32x4){xv[4 * q] * r * fg[4 * q], xv[4 * q + 1] * r * fg[4 * q + 1], xv[4 * q + 2] * r * fg[4 * q + 2], xv[4 * q + 3] * r * fg[4 * q + 3]};
      }
      asm volatile("" ::: "memory");
    }
    __syncthreads();
   }
  }
}

template <bool WITH_GATES>
__device__ void phase_norm(const Params& p, const float* __restrict__ xin, const float* __restrict__ g, const float* __restrict__ modl, int sh_off, int sc_off, char* smem) {
  float* wg = (float*)smem;
  if (WITH_GATES) { __syncthreads(); for (int i = threadIdx.x; i < 16 * 1024; i += NTHREADS) wg[i] = p.Wg[i]; __syncthreads(); }
  for (int job = blockIdx.x; job < T / 32; job += gridDim.x) {
    int tid_ = threadIdx.x; asm volatile("" : "+v"(tid_));
    const int tid = tid_, wid = tid >> 6, lane = tid & 63; const int tb = job * 32 + wid * 4, b = tb / S;
    f32x4 v[4][4];
#pragma unroll
    for (int q = 0; q < 4; ++q)
#pragma unroll
      for (int i = 0; i < 4; ++i) v[q][i] = *(const f32x4*)(xin + (size_t)(tb + q) * D + i * 256 + lane * 4);
    const float* shp = modl + (size_t)b * 6144 + sh_off; const float* scp = modl + (size_t)b * 6144 + sc_off;
    f32x4 ga[4], gc[4];
#pragma unroll
    for (int i = 0; i < 4; ++i) { const int d = i * 256 + lane * 4; const f32x4 gg = *(const f32x4*)(g + d), s1 = *(const f32x4*)(scp + d); ga[i] = gg * (1.f + s1); gc[i] = *(const f32x4*)(shp + d); }
#pragma unroll
    for (int q = 0; q < 4; ++q) { float ss = 0.f;
#pragma unroll
      for (int i = 0; i < 4; ++i) ss += v[q][i].x * v[q][i].x + v[q][i].y * v[q][i].y + v[q][i].z * v[q][i].z + v[q][i].w * v[q][i].w;
      ss = wave_sum(ss); const float r = rsqrtf(ss * (1.f / D) + EPS);
#pragma unroll
      for (int i = 0; i < 4; ++i) { v[q][i] = v[q][i] * r * ga[i] + gc[i]; u32x2 w; w.x = pack2(v[q][i].x, v[q][i].y); w.y = pack2(v[q][i].z, v[q][i].w); *(u32x2*)(p.H + (size_t)(tb + q) * D + i * 256 + lane * 4) = w; }
      if (WITH_GATES) { float myg = 0.f;
#pragma unroll 2
        for (int gi = 0; gi < 16; ++gi) { float a = 0.f;
#pragma unroll
          for (int i = 0; i < 4; ++i) { const f32x4 w4 = *(const f32x4*)(wg + gi * 1024 + i * 256 + lane * 4); a += v[q][i].x * w4.x + v[q][i].y * w4.y + v[q][i].z * w4.z + v[q][i].w * w4.w; }
          a = wave_sum(a); if (lane == gi) myg = a; }
        if (lane < 16) p.gates[(size_t)(tb + q) * 16 + lane] = myg + p.ev_b_in[2560 + lane]; }
    }
  }
}
__device__ void phase_cat(const Params& p) {
  for (int job = blockIdx.x; job < T / 32; job += gridDim.x) {
    int tid_ = threadIdx.x; asm volatile("" : "+v"(tid_));
    const int tid = tid_, wid = tid >> 6, lane = tid & 63; const int tb = job * 32 + wid * 4;
    u32x4 a[4], bq[4], so[4];
#pragma unroll
    for (int q = 0; q < 4; ++q) { const size_t o = (size_t)(tb + q) * 512 + lane * 8; a[q] = *(const u32x4*)(p.HS + o); bq[q] = *(const u32x4*)(p.HS + (size_t)T * 512 + o); so[q] = *(const u32x4*)(p.ZO + o); }
    const f32x4 g0 = *(const f32x4*)(p.mnorm_g + lane * 8), g1 = *(const f32x4*)(p.mnorm_g + lane * 8 + 4);
#pragma unroll
    for (int q = 0; q < 4; ++q) { float x[8]; const u32 aw[4] = {a[q].x, a[q].y, a[q].z, a[q].w}, bw[4] = {bq[q].x, bq[q].y, bq[q].z, bq[q].w}, sw[4] = {so[q].x, so[q].y, so[q].z, so[q].w};
      float ss = 0.f;
#pragma unroll
      for (int j = 0; j < 4; ++j) { x[2 * j] = bflo(aw[j]) + bflo(bw[j]); x[2 * j + 1] = bfhi(aw[j]) + bfhi(bw[j]); ss += x[2 * j] * x[2 * j] + x[2 * j + 1] * x[2 * j + 1]; }
      ss += __shfl_xor(ss, 1); ss += __shfl_xor(ss, 2); ss += __shfl_xor(ss, 4); ss += __shfl_xor(ss, 8);
      const float r = rsqrtf(ss * (1.f / 128.f) + EPS);
      u32x4 w; w.x = pack2(x[0] * r * g0.x * bflo(sw[0]), x[1] * r * g0.y * bfhi(sw[0])); w.y = pack2(x[2] * r * g0.z * bflo(sw[1]), x[3] * r * g0.w * bfhi(sw[1]));
      w.z = pack2(x[4] * r * g1.x * bflo(sw[2]), x[5] * r * g1.y * bfhi(sw[2])); w.w = pack2(x[6] * r * g1.z * bflo(sw[3]), x[7] * r * g1.w * bfhi(sw[3]));
      *(u32x4*)(p.CAT + (size_t)(tb + q) * 1024 + lane * 8) = w; }
  }
}
__device__ void phase_qkrope(const Params& p, char* smem) {
  float* tab = (float*)smem;
  __syncthreads();
  for (int i = threadIdx.x; i < 64 * 32; i += NTHREADS) { const int pos = i >> 5, fi = i & 31; const float fr = exp2f(-(float)(2 * fi) * (13.287712379549449f / 64.f)); float sn, cs; sincosf((float)pos * fr, &sn, &cs); tab[2 * i] = cs; tab[2 * i + 1] = sn; }
  __syncthreads();
  for (int job = blockIdx.x; job < T / 16; job += gridDim.x) {
    int tid_ = threadIdx.x; asm volatile("" : "+v"(tid_));
    const int tid = tid_, wid = tid >> 6, lane = tid & 63; const int tb = job * 16 + wid * 2;
    u32x4 raw[2][3];
#pragma unroll
    for (int q = 0; q < 2; ++q)
#pragma unroll
      for (int i = 0; i < 3; ++i) raw[q][i] = *(const u32x4*)(p.QKV + (size_t)(tb + q) * 1536 + (lane + 64 * i) * 8);
#pragma unroll
    for (int q = 0; q < 2; ++q) { const int t = tb + q, b = t / S, s = t & (S - 1);
#pragma unroll
      for (int i = 0; i < 3; ++i) { const int c = lane + 64 * i, hh = c >> 4, cc = c & 15; float x[8]; const u32 rw[4] = {raw[q][i].x, raw[q][i].y, raw[q][i].z, raw[q][i].w};
#pragma unroll
        for (int j = 0; j < 4; ++j) { x[2 * j] = bflo(rw[j]); x[2 * j + 1] = bfhi(rw[j]); }
        u32x4 w;
        if (hh < 10) { float ss = 0.f;
#pragma unroll
          for (int j = 0; j < 8; ++j) ss += x[j] * x[j];
          ss += __shfl_xor(ss, 1); ss += __shfl_xor(ss, 2); ss += __shfl_xor(ss, 4); ss += __shfl_xor(ss, 8);
          const float r = rsqrtf(ss * (1.f / 128.f) + EPS); const float* gp = (hh < 8 ? p.qn_g : p.kn_g) + cc * 8;
          const int pos = cc < 8 ? (s >> 6) : (s & 63); const float* tp = tab + (pos * 32 + (cc & 7) * 4) * 2; float y[8];
#pragma unroll
          for (int j = 0; j < 4; ++j) { const float x0 = x[2 * j] * r * gp[2 * j], x1 = x[2 * j + 1] * r * gp[2 * j + 1], cs = tp[2 * j], sn = tp[2 * j + 1]; y[2 * j] = x0 * cs - x1 * sn; y[2 * j + 1] = x0 * sn + x1 * cs; }
          w.x = pack2(y[0], y[1]); w.y = pack2(y[2], y[3]); w.z = pack2(y[4], y[5]); w.w = pack2(y[6], y[7]);
        } else w = raw[q][i];
        bf16_t* dst = hh < 8 ? p.Qh + (((size_t)b * 8 + hh) * S + s) * 128 : (hh < 10 ? p.Kh + (((size_t)b * 2 + hh - 8) * S + s) * 128 : p.Vh + (((size_t)b * 2 + hh - 10) * S + s) * 128);
        *(u32x4*)(dst + cc * 8) = w; }
    }
  }
}

__device__ void phase_attn_naive(const Params& p) {
  const int tid = threadIdx.x, wid = tid >> 6, lane = tid & 63;
  for (int job = blockIdx.x; job < T * 2 / 8; job += gridDim.x) {
    const int w = job * 8 + wid, kv = w & 1, t = w >> 1, b = t / S, s = t & (S - 1);
    float q0[4], q1[4], m[4], l[4], o0[4], o1[4];
#pragma unroll
    for (int g = 0; g < 4; ++g) { const u32 qq = *(const u32*)(p.Qh + (((size_t)b * 8 + kv * 4 + g) * S + s) * 128 + lane * 2); q0[g] = bflo(qq); q1[g] = bfhi(qq); m[g] = -1e30f; l[g] = 0.f; o0[g] = 0.f; o1[g] = 0.f; }
    const bf16_t* Kb = p.Kh + ((size_t)b * 2 + kv) * S * 128; const bf16_t* Vb = p.Vh + ((size_t)b * 2 + kv) * S * 128;
    for (int k = 0; k < S; ++k) { const u32 kk = *(const u32*)(Kb + (size_t)k * 128 + lane * 2), vv = *(const u32*)(Vb + (size_t)k * 128 + lane * 2);
      const float k0 = bflo(kk), k1 = bfhi(kk), v0 = bflo(vv), v1 = bfhi(vv);
#pragma unroll
      for (int g = 0; g < 4; ++g) { const float sc = wave_sum(q0[g] * k0 + q1[g] * k1) * KSCALE; const float mn = fmaxf(m[g], sc), al = __expf(m[g] - mn), pw = __expf(sc - mn);
        l[g] = l[g] * al + pw; o0[g] = o0[g] * al + pw * v0; o1[g] = o1[g] * al + pw * v1; m[g] = mn; } }
#pragma unroll
    for (int g = 0; g < 4; ++g) *(u32*)(p.CAT + (size_t)t * 1024 + (kv * 4 + g) * 128 + lane * 2) = pack2(o0[g] / l[g], o1[g] / l[g]);
  }
}

namespace att {
using bf16 = unsigned short;
constexpr int   D = 128, NW = 8, QBLK = 32, KVBLK = 64;
constexpr float SCALE = 0.088388347648318440f;
constexpr float THR = 8.f;
constexpr int SDEPTH = 2;
constexpr int LDQ = 128, LDK = 128, LDO = 1024;
constexpr size_t SHM_V = KVBLK * D * 2, SHM_K = KVBLK * D * 2, SHM_ATTN = 2 * SHM_V + 2 * SHM_K + NW * 64 * 4;
using bf16x8 = __attribute__((ext_vector_type(8))) short;
using s16x4  = __attribute__((ext_vector_type(4))) short;
using f32x16 = __attribute__((ext_vector_type(16))) float;
using f32x8  = __attribute__((ext_vector_type(8))) float;
using u32x4  = __attribute__((ext_vector_type(4))) unsigned;
#define KSWZ(row, colB) ((row) * 256 + ((colB) ^ (((row) & 7) << 4)))
#define SBAR() __builtin_amdgcn_sched_barrier(0)
__device__ __forceinline__ int crow(int r, int hi) { return (r & 3) + 8 * (r >> 2) + 4 * hi; }
__device__ __forceinline__ unsigned cvtpk(float lo, float hi) {
  unsigned r; asm volatile("v_cvt_pk_bf16_f32 %0, %1, %2" : "=v"(r) : "v"(lo), "v"(hi)); return r;
}
template <typename TIn> struct Stage;
template <> struct Stage<bf16>  { using T = bf16x8;
  __device__ static __forceinline__ T ld8(const bf16* p) { return *reinterpret_cast<const bf16x8*>(p); }
  __device__ static __forceinline__ bf16x8 tobf(T x) { return x; } };
template <> struct Stage<float> { using T = f32x8;
  __device__ static __forceinline__ T ld8(const float* p) { return *reinterpret_cast<const f32x8*>(p); }
  __device__ static __forceinline__ bf16x8 tobf(T x) {
    u32x4 w = {cvtpk(x[0], x[1]), cvtpk(x[2], x[3]), cvtpk(x[4], x[5]), cvtpk(x[6], x[7])}; return *reinterpret_cast<bf16x8*>(&w); } };

__device__ __forceinline__ void partialSM(f32x16& p0, f32x16& p1, float& m_reg, float& mn, float& alpha) {
  constexpr float C = SCALE * 1.4426950408889634f;
  float pmax = p0[0]; for (int r = 1; r < 16; ++r) pmax = fmaxf(pmax, p0[r]); for (int r = 0; r < 16; ++r) pmax = fmaxf(pmax, p1[r]);
  { auto rr = __builtin_amdgcn_permlane32_swap(__float_as_uint(pmax), __float_as_uint(pmax), false, false);
    pmax = fmaxf(__uint_as_float(rr[0]), __uint_as_float(rr[1])); }
  if (__builtin_expect(__all(pmax - m_reg <= THR / SCALE), 1)) { mn = m_reg; alpha = 1.f; }
  else { mn = fmaxf(m_reg, pmax); alpha = __builtin_amdgcn_exp2f((m_reg - mn) * C); m_reg = mn; }
  float mnC = -mn * C;
  for (int r = 0; r < 16; ++r) p0[r] = fmaf(p0[r], C, mnC); for (int r = 0; r < 16; ++r) p1[r] = fmaf(p1[r], C, mnC);
  for (int r = 0; r < 16; ++r) p0[r] = __builtin_amdgcn_exp2f(p0[r]);
}
__device__ __forceinline__ void finishSM(f32x16& p0, f32x16& p1, float alpha, float& l_reg, bf16x8& pa0, bf16x8& pa1, bf16x8& pa2, bf16x8& pa3) {
  for (int r = 0; r < 16; ++r) p1[r] = __builtin_amdgcn_exp2f(p1[r]);
  float ps = 0; for (int r = 0; r < 16; ++r) ps += p0[r]; for (int r = 0; r < 16; ++r) ps += p1[r];
  { auto rr = __builtin_amdgcn_permlane32_swap(__float_as_uint(ps), __float_as_uint(ps), false, false);
    ps = __uint_as_float(rr[0]) + __uint_as_float(rr[1]); }
  l_reg = l_reg * alpha + ps;
#define PK4(P, BASE, OUT) do { unsigned a0 = cvtpk(P[BASE + 0], P[BASE + 1]), a1 = cvtpk(P[BASE + 2], P[BASE + 3]);   \
    unsigned b0 = cvtpk(P[BASE + 4], P[BASE + 5]), b1 = cvtpk(P[BASE + 6], P[BASE + 7]);                              \
    auto r0 = __builtin_amdgcn_permlane32_swap(a0, b0, false, false); auto r1 = __builtin_amdgcn_permlane32_swap(a1, b1, false, false); \
    u32x4 w = {r0[0], r1[0], r0[1], r1[1]}; OUT = *reinterpret_cast<bf16x8*>(&w); } while (0)
  PK4(p0, 0, pa0); PK4(p0, 8, pa1); PK4(p1, 0, pa2); PK4(p1, 8, pa3);
#undef PK4
}
__device__ __forceinline__ void qkt(f32x16& p0, f32x16& p1, const bf16* Ks, const bf16x8* qr, int r32, int hi) {
  p0 = f32x16{}; p1 = f32x16{};
  for (int d0 = 0; d0 < 8; ++d0) { int cb = (d0 * 16 + hi * 8) * 2;
    bf16x8 b0 = *reinterpret_cast<const bf16x8*>((const char*)Ks + KSWZ(r32, cb));
    bf16x8 b1 = *reinterpret_cast<const bf16x8*>((const char*)Ks + KSWZ(32 + r32, cb));
    p0 = __builtin_amdgcn_mfma_f32_32x32x16_bf16(b0, qr[d0], p0, 0, 0, 0);
    p1 = __builtin_amdgcn_mfma_f32_32x32x16_bf16(b1, qr[d0], p1, 0, 0, 0); }
}
__device__ __forceinline__ int v_st(int k, int c) { const int kk = (k & ~0xC) | ((k & 4) << 1) | ((k & 8) >> 1); return ((kk >> 3) * 4 + (c >> 5)) * 512 + ((kk & 7) * 32 + (c & 31)) * 2; }
__device__ __forceinline__ int v_rd_base(int lane) { return ((lane & 3) << 3) | (((lane >> 2) & 3) << 6) | (((lane >> 4) & 1) << 5) | (((lane >> 5) & 1) << 8); }
constexpr int v_rd_off(int d0, int ks, int half) { return d0 * 512 + ks * 4096 + half * 2048; }
template <int OFF> __device__ __forceinline__ s16x4 tr_read(int vb) {
  s16x4 r; asm volatile("ds_read_b64_tr_b16 %0, %1 offset:%2" : "=&v"(r) : "v"(vb), "i"(OFF) : "memory"); return r;
}
template <int D0> __device__ __forceinline__ void pv_one(f32x16& od, int vb, bf16x8 pa0, bf16x8 pa1, bf16x8 pa2, bf16x8 pa3) {
  const s16x4 l0 = tr_read<v_rd_off(D0, 0, 0)>(vb), h0 = tr_read<v_rd_off(D0, 0, 1)>(vb), l1 = tr_read<v_rd_off(D0, 1, 0)>(vb), h1 = tr_read<v_rd_off(D0, 1, 1)>(vb);
  const s16x4 l2 = tr_read<v_rd_off(D0, 2, 0)>(vb), h2 = tr_read<v_rd_off(D0, 2, 1)>(vb), l3 = tr_read<v_rd_off(D0, 3, 0)>(vb), h3 = tr_read<v_rd_off(D0, 3, 1)>(vb);
  asm volatile("s_waitcnt lgkmcnt(0)" ::: "memory"); SBAR();
#define PK(L, H) (bf16x8){L[0], L[1], L[2], L[3], H[0], H[1], H[2], H[3]}
  od = __builtin_amdgcn_mfma_f32_32x32x16_bf16(pa0, PK(l0, h0), od, 0, 0, 0);
  od = __builtin_amdgcn_mfma_f32_32x32x16_bf16(pa1, PK(l1, h1), od, 0, 0, 0);
  od = __builtin_amdgcn_mfma_f32_32x32x16_bf16(pa2, PK(l2, h2), od, 0, 0, 0);
  od = __builtin_amdgcn_mfma_f32_32x32x16_bf16(pa3, PK(l3, h3), od, 0, 0, 0);
#undef PK
}
__device__ __forceinline__ void pv_d0(f32x16* o, int vb, bf16x8 pa0, bf16x8 pa1, bf16x8 pa2, bf16x8 pa3) {
  pv_one<0>(o[0], vb, pa0, pa1, pa2, pa3); pv_one<1>(o[1], vb, pa0, pa1, pa2, pa3); pv_one<2>(o[2], vb, pa0, pa1, pa2, pa3); pv_one<3>(o[3], vb, pa0, pa1, pa2, pa3);
}

template <typename TQ>
__device__ __forceinline__ void attn_dense_body(const TQ* __restrict__ Qb, const bf16* __restrict__ Kh, const bf16* __restrict__ Vh,
                                                bf16* __restrict__ Ob, int seq, char* lds) {
  using St = Stage<bf16>; using SQ = Stage<TQ>;
  int tid_ = threadIdx.x; asm volatile("" : "+v"(tid_)); const int tid = tid_, wid = tid >> 6, lane = tid & 63, r32 = lane & 31, hi = lane >> 5;
  bf16* V_lds = (bf16*)lds; bf16* K_lds = (bf16*)(lds + 2 * SHM_V);
  float* ws = (float*)(lds + 2 * SHM_V + 2 * SHM_K) + wid * 64; float* li_l = ws; float* al_l = ws + 32;
  float m_reg = -1e30f, l_reg = 0; f32x16 o[4] = {}; bf16x8 qr[8];
  const TQ* Qw = Qb + (long)(wid * QBLK + r32) * LDQ + hi * 8;
#pragma unroll
  for (int d0 = 0; d0 < 8; ++d0) qr[d0] = SQ::tobf(SQ::ld8(Qw + d0 * 16));
  const int sr = tid >> 4, sc = (tid & 15) * 8, vst0 = v_st(sr, sc), vst1 = v_st(32 + sr, sc);
  const int vb0 = (int)(uintptr_t)V_lds + v_rd_base(lane);
  struct { typename St::T vs0, vs1, ks0, ks1; } sr_[SDEPTH];
#define SLOAD(i, k0) do { sr_[i].vs0 = St::ld8(&Vh[(long)((k0) + sr) * LDK + sc]); sr_[i].vs1 = St::ld8(&Vh[(long)((k0) + 32 + sr) * LDK + sc]); \
    sr_[i].ks0 = St::ld8(&Kh[(long)((k0) + sr) * LDK + sc]); sr_[i].ks1 = St::ld8(&Kh[(long)((k0) + 32 + sr) * LDK + sc]); } while (0)
#define SWRITE(b, i) do { *(bf16x8*)((char*)V_lds + (b) * SHM_V + vst0) = St::tobf(sr_[i].vs0);          \
    *(bf16x8*)((char*)V_lds + (b) * SHM_V + vst1) = St::tobf(sr_[i].vs1); int kc = sc * 2;               \
    *(bf16x8*)((char*)K_lds + (b) * SHM_K + KSWZ(sr, kc)) = St::tobf(sr_[i].ks0);                       \
    *(bf16x8*)((char*)K_lds + (b) * SHM_K + KSWZ(32 + sr, kc)) = St::tobf(sr_[i].ks1); } while (0)
#define SWAIT() do { if constexpr (SDEPTH == 2) asm volatile("s_waitcnt vmcnt(4)" ::: "memory"); else asm volatile("s_waitcnt vmcnt(0)" ::: "memory"); } while (0)
#define RESC(a) do { if (__any((a) < 1.f)) { if (hi == 0) al_l[r32] = (a); asm volatile("s_waitcnt lgkmcnt(0)" ::: "memory"); \
    for (int d = 0; d < 4; ++d) for (int r = 0; r < 16; ++r) o[d][r] *= al_l[crow(r, hi)]; } } while (0)
  f32x16 pA0, pA1, pB0, pB1; float mnA, mnB, alA, alB; bf16x8 pa0, pa1, pa2, pa3; const int NT = seq / KVBLK;
  constexpr int SE = 0, SO = SDEPTH - 1;
  SLOAD(SE, 0); asm volatile("s_waitcnt vmcnt(0)" ::: "memory"); SWRITE(0, SE); __syncthreads();
  qkt(pA0, pA1, K_lds, qr, r32, hi); partialSM(pA0, pA1, m_reg, mnA, alA);
  SLOAD(SO, KVBLK); if constexpr (SDEPTH == 2) { if (2 < NT) SLOAD(SE, 2 * KVBLK); }
  SWAIT(); SWRITE(1, SO); __syncthreads();
  for (int j = 1; j + 1 < NT; j += 2) {
    SBAR(); qkt(pB0, pB1, (bf16*)((char*)K_lds + SHM_K), qr, r32, hi);
    finishSM(pA0, pA1, alA, l_reg, pa0, pa1, pa2, pa3); SBAR();
    SLOAD(SO, (j + SDEPTH) * KVBLK); SBAR();
    pv_d0(o, vb0, pa0, pa1, pa2, pa3); partialSM(pB0, pB1, m_reg, mnB, alB);
    __syncthreads(); SWAIT(); SWRITE(0, SE);
    RESC(alB); __syncthreads();
    SBAR(); qkt(pA0, pA1, K_lds, qr, r32, hi);
    finishSM(pB0, pB1, alB, l_reg, pa0, pa1, pa2, pa3); SBAR();
    if (SDEPTH == 1 || j + 3 < NT) SLOAD(SE, (j + 1 + SDEPTH) * KVBLK); SBAR();
    pv_d0(o, vb0 + (int)SHM_V, pa0, pa1, pa2, pa3); partialSM(pA0, pA1, m_reg, mnA, alA);
    __syncthreads(); SWAIT(); SWRITE(1, SO);
    RESC(alA); __syncthreads();
  }
  SBAR(); qkt(pB0, pB1, (bf16*)((char*)K_lds + SHM_K), qr, r32, hi);
  finishSM(pA0, pA1, alA, l_reg, pa0, pa1, pa2, pa3); SBAR();
  pv_d0(o, vb0, pa0, pa1, pa2, pa3); partialSM(pB0, pB1, m_reg, mnB, alB);
  __syncthreads(); RESC(alB);
  finishSM(pB0, pB1, alB, l_reg, pa0, pa1, pa2, pa3); SBAR();
  pv_d0(o, vb0 + (int)SHM_V, pa0, pa1, pa2, pa3);
  if (hi == 0) li_l[r32] = l_reg; asm volatile("s_waitcnt lgkmcnt(0)" ::: "memory");
  float rli[16];
#pragma unroll
  for (int r = 0; r < 16; ++r) rli[r] = __builtin_amdgcn_rcpf(li_l[crow(r, hi)]);
  __syncthreads();
  bf16* Ol = (bf16*)lds + wid * (QBLK * D);
#pragma unroll
  for (int r = 0; r < 16; ++r) { const int orow = crow(r, hi);
#pragma unroll
    for (int d0 = 0; d0 < 4; ++d0) { const float v = o[d0][r] * rli[r]; unsigned u = __float_as_uint(v); u += 0x7FFFu + ((u >> 16) & 1u); Ol[orow * D + d0 * 32 + r32] = (bf16)(u >> 16); } }
  asm volatile("s_waitcnt lgkmcnt(0)" ::: "memory");
#pragma unroll
  for (int i = 0; i < 8; ++i) { const int row = i * 4 + (lane >> 4), ch = (lane & 15) * 8;
    const u32x4 v = *reinterpret_cast<const u32x4*>(Ol + row * D + ch);
    *reinterpret_cast<u32x4*>(Ob + (long)(wid * QBLK + row) * LDO + ch) = v; }
  __syncthreads();
#undef SLOAD
#undef SWRITE
#undef SWAIT
#undef RESC
}

}

__device__ void phase_attn(const Params& p, char* smem) {
  const int G = (int)gridDim.x, c = (int)blockIdx.x;
  for (int i = 0; i * G + c < 1024; ++i) {
    int pair, j;
    if (G == 256) { pair = 2 * (c & 7) + (i >> 1); j = (i & 1) * 32 + (c >> 3); } else { const int L = i * G + c; pair = L >> 6; j = L & 63; }
    const int b = pair >> 1, kv = pair & 1, qb = j >> 2, g = j & 3, h = kv * 4 + g;
    const bf16_t* Qb = p.Qh + (((size_t)b * 8 + h) * S + qb * 256) * 128; const bf16_t* Kp = p.Kh + ((size_t)b * 2 + kv) * S * 128; const bf16_t* Vp = p.Vh + ((size_t)b * 2 + kv) * S * 128;
    bf16_t* Ob = p.CAT + ((size_t)b * S + qb * 256) * 1024 + h * 128;
    att::attn_dense_body<att::bf16>(Qb, Kp, Vp, Ob, S, smem);
  }
}

#define XB_TMO      128
#define XB_XCNT(j)  (256  + 64 * (j))
#define XB_XSUB(j)  (1280 + 64 * (j))
#define XB_XGEN(j)  (2304 + 64 * (j))
#define XB_TOP      3328
#define XB_TOPGEN   3392
#define XCD_BAR_WORDS 3456
#define XB_SPIN_CAP (1u << 18)
#define LAS __attribute__((address_space(3)))

__device__ __forceinline__ unsigned xb_ld(unsigned* p)              { return __hip_atomic_load(p, __ATOMIC_RELAXED, __HIP_MEMORY_SCOPE_AGENT); }
__device__ __forceinline__ unsigned xb_add(unsigned* p, unsigned v) { return __hip_atomic_fetch_add(p, v, __ATOMIC_RELAXED, __HIP_MEMORY_SCOPE_AGENT); }
__device__ __forceinline__ unsigned xb_xcc_id() { return (unsigned)__builtin_amdgcn_s_getreg((3 << 11) | 20) & 0xFu; }
#define XB_SPIN(cond, bar) do { unsigned _sp = 0; while (cond) { __builtin_amdgcn_s_sleep(1); \
    if ((++_sp & 255u) == 0u) { if (xb_ld(&(bar)[XB_TMO])) break; if (_sp > XB_SPIN_CAP) { atomicAdd(&(bar)[XB_TMO], 1u); break; } } } } while (0)

struct XcdBarrier {
    unsigned* bar; unsigned x;
    volatile LAS unsigned* st;
};

__device__ __forceinline__ XcdBarrier xcd_barrier_post(unsigned* bar, volatile LAS unsigned* st) {
    XcdBarrier b; b.bar = bar; b.x = xb_xcc_id(); b.st = st;
    if (threadIdx.x == 0) (void)xb_add(&bar[XB_XCNT(b.x)], 1u);
    return b;
}
__device__ __forceinline__ void xcd_barrier_complete(unsigned* bar, unsigned x, unsigned& nloc, unsigned& nx) {
    const unsigned G = gridDim.x * gridDim.y * gridDim.z;
    unsigned sum, cnt, mine, sp = 0u;
    for (;;) {
        sum = 0u; cnt = 0u; mine = 0u;
#pragma unroll
        for (unsigned j = 0; j < 16; ++j) { const unsigned c = xb_ld(&bar[XB_XCNT(j)]); sum += c; cnt += (c > 0u) ? 1u : 0u; mine = (j == x) ? c : mine; }
        if (sum == G) break;
        __builtin_amdgcn_s_sleep(1);
        if ((++sp & 255u) == 0u) { if (xb_ld(&bar[XB_TMO])) break; if (sp > XB_SPIN_CAP) { atomicAdd(&bar[XB_TMO], 1u); break; } }
    }
    nloc = mine > 0u ? mine : 1u; nx = cnt > 0u ? cnt : 1u;
}

__device__ __forceinline__ void xcd_barrier(const XcdBarrier& b) {
    asm volatile("s_waitcnt vmcnt(0)" ::: "memory");
    __syncthreads();
    if (threadIdx.x == 0) {
        unsigned* bar = b.bar;
        __builtin_amdgcn_s_waitcnt(0);
        unsigned nloc = b.st[0], nx = b.st[1];
        if (nloc == 0u) { xcd_barrier_complete(bar, b.x, nloc, nx); b.st[0] = nloc; b.st[1] = nx; }
        const unsigned old = xb_add(&bar[XB_XSUB(b.x)], 1u);
        const unsigned gen = old / nloc;
        if (old + 1u == (gen + 1u) * nloc) {
            __builtin_amdgcn_fence(__ATOMIC_RELEASE, "agent");
            asm volatile("s_waitcnt vmcnt(0)" ::: "memory");
            const unsigned og = xb_add(&bar[XB_TOP], 1u);
            const unsigned tg = og / nx;
            if (og + 1u == (tg + 1u) * nx) xb_add(&bar[XB_TOPGEN], 1u);
            else XB_SPIN(xb_ld(&bar[XB_TOPGEN]) == tg, bar);
            __builtin_amdgcn_fence(__ATOMIC_ACQUIRE, "agent");
            xb_add(&bar[XB_XGEN(b.x)], 1u);
            asm volatile("s_waitcnt vmcnt(0)" ::: "memory");
        } else {
            XB_SPIN(xb_ld(&bar[XB_XGEN(b.x)]) == gen, bar);
            __builtin_amdgcn_fence(__ATOMIC_ACQUIRE, "agent");
            asm volatile("s_waitcnt vmcnt(0)" ::: "memory");
        }
    }
    __syncthreads();
}


constexpr int NPH = 19;
__global__ __launch_bounds__(NTHREADS, 2) void mega(Params p, int ph0, int ph1) {
  extern __shared__ __attribute__((aligned(16))) char smem[];
  cg::grid_group grid = cg::this_grid();
  volatile LAS unsigned* xst = (volatile LAS unsigned*)(LAS char*)(smem + SMEM_BYTES - 16);
  if (threadIdx.x == 0) { xst[0] = 0u; xst[1] = 0u; }
  __syncthreads();
  const XcdBarrier xb = xcd_barrier_post(p.bar, xst);
#ifndef REP_MASK
#define REP_MASK 0
#endif
#define GSYNC(k) do { if ((k) == 1) grid.sync(); else xcd_barrier(xb); } while (0)
#define PHASE(k, call) if (ph0 <= (k) && (k) < ph1) { if ((k) > ph0) GSYNC(k); if ((REP_MASK >> (k)) & 1) { { call; } xcd_barrier(xb); } call; }
#if !defined(ONLY_PHASE) || ONLY_PHASE == 0
  PHASE(0, phase_prep(p, smem))
#endif
#if !defined(ONLY_PHASE) || ONLY_PHASE == 1
  PHASE(1, phase_norm<true>(p, p.x, p.nmg, p.mod, 0, 1024, smem))
#endif
#if !defined(ONLY_PHASE) || ONLY_PHASE == 2
  PHASE(2, phase_gemm_fast(p.H, p.Wt_evin, T, 2560, 1024, (EpiEvin{p.ZQK, p.ZV, p.ZO, p.ZP, p.ev_b_in}), smem))
#endif
#if !defined(ONLY_PHASE) || ONLY_PHASE == 3
  PHASE(3, cp::phase_convpool(p, smem))
#endif
#if !defined(ONLY_PHASE) || ONLY_PHASE == 4
  PHASE(4, ml::phase_mlstm(p, smem))
#endif
#if !defined(ONLY_PHASE) || ONLY_PHASE == 5
  PHASE(5, phase_cat(p))
#endif
#if !defined(ONLY_PHASE) || ONLY_PHASE == 6
  PHASE(6, phase_gemm_fast(p.CAT, p.Wt_evout, T, 1024, 1024, (EpiRes{p.x, p.X, p.mod + 2048}), smem))
#endif
#if !defined(ONLY_PHASE) || ONLY_PHASE == 7
  PHASE(7, phase_norm<false>(p, p.X, p.nfg, p.mod, 3072, 4096, smem))
#endif
#if !defined(ONLY_PHASE) || ONLY_PHASE == 8
  PHASE(8, phase_gemm_fast(p.H, p.Wt_q, T, 2048, 1024, (EpiPlain{p.QP, 2048}), smem))
#endif
#if !defined(ONLY_PHASE) || ONLY_PHASE == 9
#endif
#if !defined(ONLY_PHASE) || ONLY_PHASE == 10
  PHASE(10, phase_peer_fused<0>(p, 0, smem))
#endif
#if !defined(ONLY_PHASE) || ONLY_PHASE == 11
  PHASE(11, phase_gemm_fast(p.H, p.Wt_odin, T, 1536, 1024, (EpiPlain{p.QKV, 1536}), smem))
#endif
#if !defined(ONLY_PHASE) || ONLY_PHASE == 12
  PHASE(12, phase_qkrope(p, smem))
#endif
#if !defined(ONLY_PHASE) || ONLY_PHASE == 13
  PHASE(13, phase_attn(p, smem))
#endif
#if !defined(ONLY_PHASE) || ONLY_PHASE == 14
  PHASE(14, phase_gemm_fast(p.CAT, p.Wt_odout, T, 1024, 1024, (EpiRes{p.X, p.X, p.mod + (size_t)8 * 6144 + 2048}), smem))
#endif
#if !defined(ONLY_PHASE) || ONLY_PHASE == 15
  PHASE(15, phase_norm<false>(p, p.X, p.nfg + D, p.mod + (size_t)8 * 6144, 3072, 4096, smem))
#endif
#if !defined(ONLY_PHASE) || ONLY_PHASE == 16
  PHASE(16, phase_gemm_fast(p.H, p.Wt_q + (size_t)2048 * 1024, T, 2048, 1024, (EpiPlain{p.QP, 2048}), smem))
#endif
#if !defined(ONLY_PHASE) || ONLY_PHASE == 17
#endif
#if !defined(ONLY_PHASE) || ONLY_PHASE == 18
  PHASE(18, phase_peer_fused<1>(p, 1, smem))
#endif
#undef PHASE
}
}

extern "C" void kernel_launch(void* const* d_in, const int* in_sizes, int n_in, void* d_out, int out_size, void* d_ws, size_t ws_size, hipStream_t stream) {
  (void)in_sizes; (void)n_in; (void)out_size;
  Params p{};
  const float** fin = (const float**)&p;
  for (int i = 0; i < 23; ++i) fin[i] = (const float*)d_in[i];
  p.X = (float*)d_out;
  char* ws = (char*)d_ws; size_t off = 0;
  auto alloc = [&](size_t bytes) { char* q = ws + off; off += (bytes + 255) / 256 * 256; return q; };
  p.U8 = (unsigned char*)alloc((size_t)2 * 16384 * 1024); p.V8 = (unsigned char*)alloc((size_t)2 * 16384 * 1024);
  p.Wt_evin = (bf16_t*)alloc((size_t)2560 * 1024 * 2); p.Wt_evout = (bf16_t*)alloc((size_t)1024 * 1024 * 2); p.Wt_odin = (bf16_t*)alloc((size_t)1536 * 1024 * 2);
  p.Wt_odout = (bf16_t*)alloc((size_t)1024 * 1024 * 2); p.Wt_q = (bf16_t*)alloc((size_t)2 * 2048 * 1024 * 2); p.keysb = (bf16_t*)alloc((size_t)2 * 2 * 128 * 128 * 2); p.poolWt = (bf16_t*)alloc((size_t)4 * 128 * 128 * 2);
  p.Wg = (float*)alloc(16 * 1024 * 4); p.mod = (float*)alloc(2 * 8 * 6144 * 4); p.gates = (float*)alloc((size_t)T * 16 * 4);
  p.pgate = (float*)alloc((size_t)T * 128 * 4); p.pidx = (bf16_t*)alloc((size_t)T * 128 * 2);
  p.H = (bf16_t*)alloc((size_t)T * 1024 * 2); p.CAT = p.H;
  char* big = alloc((size_t)T * 2048 * 2);
  p.ZQK = (bf16_t*)big; p.ZV = (bf16_t*)(big + (size_t)T * 1024 * 2); p.ZO = (bf16_t*)(big + (size_t)T * 1536 * 2); p.HS = (bf16_t*)big; p.QP = (bf16_t*)big; p.QKV = (bf16_t*)big;
  char* big2 = alloc((size_t)T * 1536 * 2);
  p.QK = (bf16_t*)big2; p.ZP = (bf16_t*)(big2 + (size_t)T * 1024 * 2); p.Qh = (bf16_t*)big2; p.Kh = (bf16_t*)(big2 + (size_t)T * 1024 * 2); p.Vh = (bf16_t*)(big2 + (size_t)T * 1280 * 2);
  p.bar = (unsigned*)alloc(XCD_BAR_WORDS * 4);
  if (off > ws_size) { fprintf(stderr, "kernel_launch: workspace too small: need %zu have %zu\n", off, ws_size); return; }

  static int grid_blocks = 0;
  if (!grid_blocks) {
    int dev = 0, cus = 0, per_cu = 0; hipGetDevice(&dev); hipDeviceGetAttribute(&cus, hipDeviceAttributeMultiprocessorCount, dev);
    hipFuncSetAttribute((const void*)mega, hipFuncAttributeMaxDynamicSharedMemorySize, SMEM_BYTES);
    hipOccupancyMaxActiveBlocksPerMultiprocessor(&per_cu, mega, NTHREADS, SMEM_BYTES);
    if (per_cu > 1) per_cu = 1;
    grid_blocks = cus * per_cu;
    if (grid_blocks <= 0) { fprintf(stderr, "kernel_launch: occupancy query returned 0\n"); grid_blocks = 0; return; }
  }
  hipMemsetAsync(p.bar, 0, XCD_BAR_WORDS * 4, stream);
#if MULTI_LAUNCH
  for (int ph = 0; ph < NPH; ++ph) hipLaunchKernelGGL(mega, dim3(grid_blocks), dim3(NTHREADS), SMEM_BYTES, stream, p, ph, ph + 1);
#else
  int ph0 = 0, ph1 = NPH; void* args[] = {&p, &ph0, &ph1};
  hipError_t e = hipLaunchCooperativeKernel((const void*)mega, dim3(grid_blocks), dim3(NTHREADS), args, SMEM_BYTES, stream);
  if (e != hipSuccess) fprintf(stderr, "cooperative launch failed: %s (grid %d)\n", hipGetErrorString(e), grid_blocks);
#endif
}
```

```cpp
#include <hip/hip_runtime.h>
#include <hip/hip_cooperative_groups.h>
#include <math.h>
#include <stdint.h>
#include <stdio.h>
namespace cg = cooperative_groups;

#ifndef MULTI_LAUNCH
#define MULTI_LAUNCH 0
#endif

namespace {
typedef unsigned short bf16_t;
typedef unsigned int u32;
typedef float f32x4 __attribute__((ext_vector_type(4)));
typedef u32 u32x4 __attribute__((ext_vector_type(4)));
typedef u32 u32x2 __attribute__((ext_vector_type(2)));
typedef __bf16 bf16x2_t __attribute__((ext_vector_type(2)));

constexpr int D = 1024, NB = 8, S = 4096, T = NB * S;
constexpr int EVEN_IN = 2576;
constexpr float EPS = 1e-6f;
constexpr int NTHREADS = 512;
constexpr int SMEM_BYTES = 160 * 1024;
constexpr float KSCALE = 0.08838834764831845f;

struct Params {
  const float *x, *c, *ada_w, *ada_b, *nmg, *nfg, *ev_w_in, *ev_b_in, *conv_w, *conv_b, *mnorm_g, *pool_w, *pool_sc, *ev_w_out, *od_w_in, *qn_g, *kn_g, *od_w_out,
      *peer_wq, *peer_keys, *peer_u, *peer_v, *final_g;
  float* X;
  bf16_t *Wt_evin, *Wt_evout, *Wt_odin, *Wt_odout, *Wt_q, *keysb, *poolWt; unsigned char *U8, *V8;
  float *Wg, *mod, *gates, *pgate;
  bf16_t *H, *ZQK, *ZV, *ZO, *ZP, *QK, *HS, *CAT, *QP, *QKV, *Qh, *Kh, *Vh;
  bf16_t* pidx;
  unsigned* bar;
};

__device__ __forceinline__ float siluf(float x) { return x / (1.f + __expf(-x)); }
__device__ __forceinline__ float sigmf(float x) { return 1.f / (1.f + __expf(-x)); }
__device__ __forceinline__ float wave_sum(float v) { for (int o = 32; o >= 1; o >>= 1) v += __shfl_xor(v, o); return v; }
__device__ __forceinline__ float wave_max(float v) { for (int o = 32; o >= 1; o >>= 1) v = fmaxf(v, __shfl_xor(v, o)); return v; }
__device__ __forceinline__ bf16_t f2bf(float f) { u32 r; asm("v_cvt_pk_bf16_f32 %0, %1, %1" : "=v"(r) : "v"(f)); return (bf16_t)r; }
__device__ __forceinline__ float bf2f(bf16_t b) { return __uint_as_float(((u32)b) << 16); }
__device__ __forceinline__ u32 pack2(float lo, float hi) { u32 r; asm("v_cvt_pk_bf16_f32 %0, %1, %2" : "=v"(r) : "v"(lo), "v"(hi)); return r; }
__device__ __forceinline__ float bflo(u32 w) { return __uint_as_float(w << 16); }
__device__ __forceinline__ float bfhi(u32 w) { return __uint_as_float(w & 0xFFFF0000u); }
__device__ __forceinline__ float dot2bf(u32 a, u32 b, float c) { return __builtin_amdgcn_fdot2_f32_bf16(__builtin_bit_cast(bf16x2_t, a), __builtin_bit_cast(bf16x2_t, b), c, false); }

constexpr int PJ_MOD = 192, PJ_TR = 2576, PJ_WG = 1, PJ_KEYS = 16, PJ_UV = 8192;
constexpr int PJ_TOTAL = PJ_MOD + PJ_TR + PJ_WG + PJ_KEYS + PJ_UV;

__device__ void prep_transpose_tile(const float* __restrict__ src, int ld, int k0, int n0, bf16_t* __restrict__ dst, int dstK, char* smem) {
  float* tile = (float*)smem;
  const int tid = threadIdx.x;
  __syncthreads();
  for (int pass = 0; pass < 8; ++pass) { int kk = pass * 8 + (tid >> 6), n = tid & 63; tile[kk * 65 + n] = src[(size_t)(k0 + kk) * ld + n0 + n]; }
  __syncthreads();
  int n = tid >> 3, kc = (tid & 7) * 8; u32x4 w;
  w.x = pack2(tile[(kc + 0) * 65 + n], tile[(kc + 1) * 65 + n]); w.y = pack2(tile[(kc + 2) * 65 + n], tile[(kc + 3) * 65 + n]);
  w.z = pack2(tile[(kc + 4) * 65 + n], tile[(kc + 5) * 65 + n]); w.w = pack2(tile[(kc + 6) * 65 + n], tile[(kc + 7) * 65 + n]);
  *(u32x4*)(dst + (size_t)(n0 + n) * dstK + k0 + kc) = w;
}

__device__ void phase_prep(const Params& p, char* smem) {
  const int tid = threadIdx.x;
  for (int job = blockIdx.x; job < PJ_TOTAL; job += gridDim.x) {
    if (job < PJ_MOD) {
      float* cs = (float*)smem; float* red = cs + 8192;
      __syncthreads();
      for (int i = tid; i < 8192; i += NTHREADS) cs[i] = siluf(p.c[i]);
      __syncthreads();
      const int l = job / 96, e0 = (job % 96) * 64, col = tid & 63, dg = tid >> 6;
      float acc[8];
#pragma unroll
      for (int b = 0; b < 8; ++b) acc[b] = 0.f;
      const float* w = p.ada_w + (size_t)l * D * 6144 + e0 + col;
      for (int d = dg * 128; d < dg * 128 + 128; ++d) { float wv = w[(size_t)d * 6144];
#pragma unroll
        for (int b = 0; b < 8; ++b) acc[b] += cs[b * 1024 + d] * wv; }
#pragma unroll
      for (int b = 0; b < 8; ++b) red[(dg * 8 + b) * 64 + col] = acc[b];
      __syncthreads();
      { const int b = tid >> 6; float s = 0.f;
#pragma unroll
        for (int g = 0; g < 8; ++g) s += red[(g * 8 + b) * 64 + col];
        p.mod[(size_t)(l * 8 + b) * 6144 + e0 + col] = s + p.ada_b[l * 6144 + e0 + col]; }
    } else if (job < PJ_MOD + PJ_TR) {
      int tt = job - PJ_MOD;
      if (tt < 640) prep_transpose_tile(p.ev_w_in, EVEN_IN, (tt / 40) * 64, (tt % 40) * 64, p.Wt_evin, 1024, smem);
      else if (tt < 896) { tt -= 640; prep_transpose_tile(p.ev_w_out, 1024, (tt / 16) * 64, (tt % 16) * 64, p.Wt_evout, 1024, smem); }
      else if (tt < 1280) { tt -= 896; prep_transpose_tile(p.od_w_in, 1536, (tt / 24) * 64, (tt % 24) * 64, p.Wt_odin, 1024, smem); }
      else if (tt < 1536) { tt -= 1280; prep_transpose_tile(p.od_w_out, 1024, (tt / 16) * 64, (tt % 16) * 64, p.Wt_odout, 1024, smem); }
      else if (tt < 2560) { tt -= 1536; int l = tt / 512; tt %= 512; prep_transpose_tile(p.peer_wq + (size_t)l * D * 2048, 2048, (tt / 32) * 64, (tt % 32) * 64, p.Wt_q + (size_t)l * 2048 * 1024, 1024, smem); }
      else { tt -= 2560; const int g = tt >> 2; prep_transpose_tile(p.pool_w + (size_t)g * 16384, 128, ((tt >> 1) & 1) * 64, (tt & 1) * 64, p.poolWt + (size_t)g * 16384, 128, smem); }
    } else if (job < PJ_MOD + PJ_TR + PJ_WG) {
      for (int i = tid; i < 16 * 1024; i += NTHREADS) { int g = i >> 10, d = i & 1023; p.Wg[i] = p.ev_w_in[(size_t)d * EVEN_IN + 2560 + g]; }
    } else if (job < PJ_MOD + PJ_TR + PJ_WG + PJ_KEYS) {
      int j = job - (PJ_MOD + PJ_TR + PJ_WG);
      for (int i = tid; i < 4096; i += NTHREADS) p.keysb[j * 4096 + i] = f2bf(p.peer_keys[j * 4096 + i]);
    } else {
      int j = job - (PJ_MOD + PJ_TR + PJ_WG + PJ_KEYS); const bool isu = j < 4096; const float* src = isu ? p.peer_u : p.peer_v; unsigned char* dst = isu ? p.U8 : p.V8; j &= 4095; const float sc = isu ? 32.f : 2.f;
      const size_t o = (size_t)j * 8192 + tid * 16; u32x4 w; u32 ww[4];
#pragma unroll
      for (int q = 0; q < 4; ++q) { const f32x4 a = *(const f32x4*)(src + o + 4 * q); int pk = __builtin_amdgcn_cvt_pk_fp8_f32(a.x * sc, a.y * sc, 0, false); pk = __builtin_amdgcn_cvt_pk_fp8_f32(a.z * sc, a.w * sc, pk, true); ww[q] = (u32)pk; }
      w.x = ww[0]; w.y = ww[1]; w.z = ww[2]; w.w = ww[3]; *(u32x4*)(dst + o) = w;
    }
  }
}

enum { EPI_EVIN = 0, EPI_EVOUT = 1, EPI_PEERQ = 2, EPI_ODIN = 3, EPI_ODOUT = 4 };
template <int EPI> __device__ __forceinline__ void epi_store(const Params& p, int layer, int m, int n, float acc) {
  if (EPI == EPI_EVIN) { float v = acc + p.ev_b_in[n];
    if (n < 1024) p.ZQK[(size_t)m * 1024 + n] = f2bf(v); else if (n < 1536) p.ZV[(size_t)m * 512 + n - 1024] = f2bf(v);
    else if (n < 2048) p.ZO[(size_t)m * 512 + n - 1536] = f2bf(sigmf(v)); else p.ZP[(size_t)m * 512 + n - 2048] = f2bf(v); }
  else if (EPI == EPI_EVOUT) { int b = m / S; p.X[(size_t)m * D + n] = p.x[(size_t)m * D + n] + p.mod[(size_t)(0 * 8 + b) * 6144 + 2048 + n] * acc; }
  else if (EPI == EPI_PEERQ) p.QP[(size_t)m * 2048 + n] = f2bf(acc);
  else if (EPI == EPI_ODIN) p.QKV[(size_t)m * 1536 + n] = f2bf(acc);
  else if (EPI == EPI_ODOUT) { int b = m / S; p.X[(size_t)m * D + n] += p.mod[(size_t)(1 * 8 + b) * 6144 + 2048 + n] * acc; }
}
template <int EPI> __device__ void phase_gemm_naive(const Params& p, int layer, const bf16_t* __restrict__ A, const bf16_t* __restrict__ Bt, int M, int N, int K, char* smem) {
  float* As = (float*)smem; float* Bs = As + 32 * 132;
  const int tid = threadIdx.x, tx = tid & 15, ty = tid >> 4; const int nN = N / 64, njobs = (M / 128) * nN;
  for (int job = blockIdx.x; job < njobs; job += gridDim.x) {
    const int m0 = (job / nN) * 128, n0 = (job % nN) * 64; float acc[4][4];
#pragma unroll
    for (int i = 0; i < 4; ++i)
#pragma unroll
      for (int j = 0; j < 4; ++j) acc[i][j] = 0.f;
    for (int k0 = 0; k0 < K; k0 += 32) {
      __syncthreads();
      { int row = tid >> 2, kc = (tid & 3) * 8; u32x4 w = *(const u32x4*)(A + (size_t)(m0 + row) * K + k0 + kc);
        As[(kc + 0) * 132 + row] = bflo(w.x); As[(kc + 1) * 132 + row] = bfhi(w.x); As[(kc + 2) * 132 + row] = bflo(w.y); As[(kc + 3) * 132 + row] = bfhi(w.y);
        As[(kc + 4) * 132 + row] = bflo(w.z); As[(kc + 5) * 132 + row] = bfhi(w.z); As[(kc + 6) * 132 + row] = bflo(w.w); As[(kc + 7) * 132 + row] = bfhi(w.w); }
      if (tid < 256) { int row = tid >> 2, kc = (tid & 3) * 8; u32x4 w = *(const u32x4*)(Bt + (size_t)(n0 + row) * K + k0 + kc);
        Bs[(kc + 0) * 68 + row] = bflo(w.x); Bs[(kc + 1) * 68 + row] = bfhi(w.x); Bs[(kc + 2) * 68 + row] = bflo(w.y); Bs[(kc + 3) * 68 + row] = bfhi(w.y);
        Bs[(kc + 4) * 68 + row] = bflo(w.z); Bs[(kc + 5) * 68 + row] = bfhi(w.z); Bs[(kc + 6) * 68 + row] = bflo(w.w); Bs[(kc + 7) * 68 + row] = bfhi(w.w); }
      __syncthreads();
#pragma unroll 8
      for (int kk = 0; kk < 32; ++kk) { f32x4 a = *(const f32x4*)(As + kk * 132 + ty * 4), b = *(const f32x4*)(Bs + kk * 68 + tx * 4);
        acc[0][0] += a.x * b.x; acc[0][1] += a.x * b.y; acc[0][2] += a.x * b.z; acc[0][3] += a.x * b.w;
        acc[1][0] += a.y * b.x; acc[1][1] += a.y * b.y; acc[1][2] += a.y * b.z; acc[1][3] += a.y * b.w;
        acc[2][0] += a.z * b.x; acc[2][1] += a.z * b.y; acc[2][2] += a.z * b.z; acc[2][3] += a.z * b.w;
        acc[3][0] += a.w * b.x; acc[3][1] += a.w * b.y; acc[3][2] += a.w * b.z; acc[3][3] += a.w * b.w; }
    }
#pragma unroll
    for (int i = 0; i < 4; ++i)
#pragma unroll
      for (int j = 0; j < 4; ++j) epi_store<EPI>(p, layer, m0 + ty * 4 + i, n0 + tx * 4 + j, acc[i][j]);
  }
}

namespace pg8 {
#define PG8_LAS __attribute__((address_space(3)))
typedef unsigned short bf16_t;
typedef short bf16x8 __attribute__((ext_vector_type(8)));
typedef float f32x4 __attribute__((ext_vector_type(4)));
typedef unsigned u32x4 __attribute__((ext_vector_type(4)));
constexpr int BM = 256, BK = 64, HALF = 128, HTB = HALF * BK * 2  , STAGE_BYTES = 8 * HTB, NXCD = 8, WGM = 8;

__host__ __device__ __forceinline__ int lds_byte(int r, int c) { const int st = (r >> 4) * 2 + (c >> 5), rr = r & 15, cc = c & 31, ob = rr * 64 + cc * 2; return st * 1024 + (ob ^ (((ob >> 9) & 1) << 5)); }
__host__ __device__ __forceinline__ void stage_rc(int b, int& R, int& C) { const int st = b / 1024, sb = b % 1024, swz = sb ^ (((sb >> 9) & 1) << 5); R = (st >> 1) * 16 + swz / 64; C = (st & 1) * 32 + (swz % 64) / 2; }
__host__ __device__ __forceinline__ int perm32(int rho) { const int n = rho >> 4, i = rho & 15; return 8 * (i >> 2) + 4 * n + (i & 3); }

struct Unit { int pm, pn; };
struct Gemm { const bf16_t* A; const bf16_t* Bt; int M, N, K; };

struct StaticOrder {
    int nM, nN, nwg, G, c;
    __host__ __device__ void init(int M, int N, int G_, int c_) { nM = M / BM; nN = N / BM; nwg = nM * nN; G = G_; c = c_; }
    __host__ __device__ bool next(int i, Unit& u) const {
        const long L = (long)i * G + c; if (L >= nwg) return false;
        int wgid = (int)L; { const int q = nwg / NXCD, r = nwg % NXCD, xcd = wgid % NXCD, off = wgid / NXCD; wgid = (xcd < r ? xcd * (q + 1) : r * (q + 1) + (xcd - r) * q) + off; }
        const int nig = WGM * nN, gid = wgid / nig, fm = gid * WGM, gsz = (nM - fm) < WGM ? (nM - fm) : WGM;
        u.pm = fm + ((wgid % nig) % gsz); u.pn = (wgid % nig) / gsz; return true;
    }
    __device__ __forceinline__ void a_ready(const Unit&) const {}
    __device__ __forceinline__ void done(const Unit&) const {}
};
__device__ __forceinline__ unsigned cvt_pk_bf16(float lo, float hi) { unsigned r; asm volatile("v_cvt_pk_bf16_f32 %0, %1, %2" : "=v"(r) : "v"(lo), "v"(hi)); return r; }
template <class Epi, class Sched, bool STAMP = false>
__device__ __forceinline__ void gemm_phase(PG8_LAS unsigned char* lds, const Gemm g, const Sched& S, const Epi& E, unsigned long long* stamps) {
    const int tid = threadIdx.x, wid = __builtin_amdgcn_readfirstlane(tid >> 6), lane = tid & 63, wr = wid >> 2, wc = wid & 3, fr = lane & 15, fq = lane >> 4;
    const int K = g.K, nt = K / BK;
    int ts_lo = 0, ts_hi = 0, nts = 0; const unsigned long long rt_entry = STAMP ? (unsigned long long)wall_clock64() : 0ull;
#define PG8_STAMP() do { if (STAMP && wid == 0 && nts < 64) { const unsigned long long _c = (unsigned long long)clock64(); \
        ts_lo = (lane == nts) ? (int)(unsigned)_c : ts_lo; ts_hi = (lane == nts) ? (int)(unsigned)(_c >> 32) : ts_hi; ++nts; } } while (0)
    PG8_STAMP();
    unsigned voffA[2], voffB[2];
#pragma unroll
    for (int i = 0; i < 2; ++i) { int R, C; stage_rc(tid * 16 + i * 8192, R, C); const int Rb = Epi::PERM ? ((R & ~31) + perm32(R & 31)) : R;
        voffA[i] = (unsigned)(R * K + C) * 2u; voffB[i] = (unsigned)(Rb * K + C) * 2u; }
    const size_t kstep = (size_t)(BK * 2);
    const size_t hstep = (size_t)HALF * K * 2;
    const size_t tstep = 2 * hstep;
    const unsigned ldsw = (unsigned)wid * 1024u;
    const int aoff = lds_byte(wr * 64 + fr, fq * 8), boff = lds_byte(wc * 32 + fr, fq * 8);
#define PG8_SA(b, h) (((b) * 2 + (h)) * HTB)
#define PG8_SB(b, h) ((4 + (b) * 2 + (h)) * HTB)
#define PG8_STAGE(bufoff, gbase, voff) do { _Pragma("unroll") for (int _i = 0; _i < 2; ++_i) \
        __builtin_amdgcn_global_load_lds((const unsigned*)((const char*)(gbase) + (voff)[_i]), (PG8_LAS unsigned*)(lds + (bufoff) + ldsw + _i * 8192), 16, 0, 0); } while (0)
#define PG8_LDA(dst, b, h) do { _Pragma("unroll") for (int m = 0; m < 4; ++m) _Pragma("unroll") for (int k = 0; k < 2; ++k) dst[m][k] = *(const PG8_LAS bf16x8*)(lds + PG8_SA(b, h) + aoff + m * 2048 + k * 1024); } while (0)
#define PG8_LDB(dst, b, h) do { _Pragma("unroll") for (int n = 0; n < 2; ++n) _Pragma("unroll") for (int k = 0; k < 2; ++k) dst[n][k] = *(const PG8_LAS bf16x8*)(lds + PG8_SB(b, h) + boff + n * 2048 + k * 1024); } while (0)
#define PG8_MMA(ai, bj, At, Bt) do { __builtin_amdgcn_s_setprio(1); _Pragma("unroll") for (int m = 0; m < 4; ++m) _Pragma("unroll") for (int n = 0; n < 2; ++n) _Pragma("unroll") for (int k = 0; k < 2; ++k) \
        acc[ai][bj][m][n] = __builtin_amdgcn_mfma_f32_16x16x32_bf16(Bt[n][k], At[m][k], acc[ai][bj][m][n], 0, 0, 0); __builtin_amdgcn_s_setprio(0); } while (0)
#define PG8_WAIT_V(n) asm volatile("s_waitcnt vmcnt(" #n ")" ::: "memory")
#define PG8_WAIT_L(n) asm volatile("s_waitcnt lgkmcnt(" #n ")" ::: "memory")
#define PG8_BAR __builtin_amdgcn_s_barrier()
#define PG8_SCHED __builtin_amdgcn_sched_barrier(0)
    Unit cur, nxt; int ui = 0;
    if (!S.next(0, cur)) return;
    f32x4 acc[2][2][4][2];
#pragma unroll
    for (int a = 0; a < 2; ++a)
#pragma unroll
        for (int b = 0; b < 2; ++b)
#pragma unroll
            for (int m = 0; m < 4; ++m)
#pragma unroll
                for (int n = 0; n < 2; ++n) acc[a][b][m][n] = (f32x4){0.f, 0.f, 0.f, 0.f};
    bf16x8 At[4][2], B0[2][2], B1[2][2];
    const char* cA = (const char*)g.A + (size_t)cur.pm * tstep; const char* cB = (const char*)g.Bt + (size_t)cur.pn * tstep;
    S.a_ready(cur);
    PG8_STAGE(PG8_SB(0, 0), cB, voffB); PG8_STAGE(PG8_SA(0, 0), cA, voffA); PG8_STAGE(PG8_SB(0, 1), cB + hstep, voffB); PG8_STAGE(PG8_SA(0, 1), cA + hstep, voffA);
    if (wr == 1) PG8_BAR;
    PG8_WAIT_V(4); PG8_BAR;
    PG8_STAGE(PG8_SB(1, 0), cB + kstep, voffB); PG8_STAGE(PG8_SA(1, 0), cA + kstep, voffA); PG8_STAGE(PG8_SB(1, 1), cB + hstep + kstep, voffB);
    PG8_WAIT_V(6); PG8_BAR;
    PG8_STAMP();
    for (;;) {
        const bool has_next = S.next(ui + 1, nxt);
        const char* nA = has_next ? (const char*)g.A + (size_t)nxt.pm * tstep : cA; const char* nB = has_next ? (const char*)g.Bt + (size_t)nxt.pn * tstep : cB;
        for (int t = 0; t < nt; t += 2) {
            const bool last = (t == nt - 2);
            const char* a1 = cA + (size_t)(t + 1) * kstep;
            const char* a2 = last ? nA : cA + (size_t)(t + 2) * kstep; const char* b2 = last ? nB : cB + (size_t)(t + 2) * kstep;
            const char* a3 = a2 + kstep; const char* b3 = b2 + kstep;
            if (last && has_next) S.a_ready(nxt);
            PG8_LDB(B0, 0, 0); PG8_SCHED; PG8_LDA(At, 0, 0); PG8_STAGE(PG8_SA(1, 1), a1 + hstep, voffA);
            PG8_WAIT_L(8); PG8_BAR; PG8_WAIT_L(0); PG8_MMA(0, 0, At, B0); PG8_BAR; PG8_SCHED;
            PG8_LDB(B1, 0, 1); PG8_STAGE(PG8_SB(0, 0), b2, voffB);
            PG8_BAR; PG8_WAIT_L(0); PG8_MMA(0, 1, At, B1); PG8_BAR;
            PG8_LDA(At, 0, 1); PG8_STAGE(PG8_SA(0, 0), a2, voffA);
            PG8_BAR; PG8_WAIT_L(0); PG8_MMA(1, 0, At, B0); PG8_BAR; PG8_SCHED;
            PG8_STAGE(PG8_SB(0, 1), b2 + hstep, voffB);
            PG8_WAIT_V(6); PG8_BAR; PG8_MMA(1, 1, At, B1); PG8_BAR;
            PG8_LDB(B0, 1, 0); PG8_SCHED; PG8_LDA(At, 1, 0); PG8_STAGE(PG8_SA(0, 1), a2 + hstep, voffA);
            PG8_WAIT_L(8); PG8_BAR; PG8_WAIT_L(0); PG8_MMA(0, 0, At, B0); PG8_BAR; PG8_SCHED;
            PG8_LDB(B1, 1, 1); PG8_STAGE(PG8_SB(1, 0), b3, voffB);
            PG8_BAR; PG8_WAIT_L(0); PG8_MMA(0, 1, At, B1); PG8_BAR;
            PG8_LDA(At, 1, 1); PG8_STAGE(PG8_SA(1, 0), a3, voffA);
            PG8_BAR; PG8_WAIT_L(0); PG8_MMA(1, 0, At, B0); PG8_BAR; PG8_SCHED;
            PG8_STAGE(PG8_SB(1, 1), b3 + hstep, voffB);
            PG8_WAIT_V(6); PG8_BAR; PG8_MMA(1, 1, At, B1); PG8_BAR;
        }
        PG8_STAMP();
        if constexpr (!Epi::AFTER_DRAIN) { E(acc, cur, wr, wc, fr, fq); S.done(cur); }
        PG8_STAMP();
        if (!has_next) break;
#pragma unroll
        for (int a = 0; a < 2; ++a)
#pragma unroll
            for (int b = 0; b < 2; ++b)
#pragma unroll
                for (int m = 0; m < 4; ++m)
#pragma unroll
                    for (int n = 0; n < 2; ++n) acc[a][b][m][n] = (f32x4){0.f, 0.f, 0.f, 0.f};
        cur = nxt; cA = nA; cB = nB; ++ui;
    }
    PG8_WAIT_V(0);
    if (wr == 0) PG8_BAR;
    PG8_BAR;
    if constexpr (Epi::AFTER_DRAIN) { E.fused(acc, cur, wr, wc, fr, fq, lds, wid, lane); S.done(cur); }
    PG8_STAMP();
    if (STAMP && wid == 0) { stamps[lane] = lane < nts ? (((unsigned long long)(unsigned)ts_hi << 32) | (unsigned)ts_lo) : 0ull;
        if (lane == 62) stamps[62] = rt_entry; if (lane == 63) stamps[63] = (unsigned long long)wall_clock64(); }
#undef PG8_STAMP
#undef PG8_SA
#undef PG8_SB
#undef PG8_STAGE
#undef PG8_LDA
#undef PG8_LDB
#undef PG8_MMA
#undef PG8_WAIT_V
#undef PG8_WAIT_L
#undef PG8_BAR
#undef PG8_SCHED
}
}

struct EpiEvin {
  static constexpr bool PERM = true, AFTER_DRAIN = false;
  bf16_t *ZQK, *ZV, *ZO, *ZP; const float* bias;
  __device__ __forceinline__ void operator()(const pg8::f32x4 (&acc)[2][2][4][2], const pg8::Unit& u, int wr, int wc, int fr, int fq) const {
    const int row0 = u.pm * 256 + wr * 64 + fr, ct = u.pn * 256;
    bf16_t* base; int ldc, cl; bool sig = false;
    if (ct < 1024) { base = ZQK; ldc = 1024; cl = ct; } else if (ct < 1536) { base = ZV; ldc = 512; cl = ct - 1024; } else if (ct < 2048) { base = ZO; ldc = 512; cl = ct - 1536; sig = true; } else { base = ZP; ldc = 512; cl = ct - 2048; }
    const int cofs = wc * 32 + 8 * fq;
    pg8::f32x4 bv[2][2];
#pragma unroll
    for (int bj = 0; bj < 2; ++bj)
#pragma unroll
      for (int n = 0; n < 2; ++n) bv[bj][n] = *(const pg8::f32x4*)(bias + ct + cofs + bj * 128 + 4 * n);
#pragma unroll
    for (int ai = 0; ai < 2; ++ai)
#pragma unroll
      for (int m = 0; m < 4; ++m) { bf16_t* rowp = base + (size_t)(row0 + ai * 128 + m * 16) * ldc + cl + cofs;
#pragma unroll
        for (int bj = 0; bj < 2; ++bj) { pg8::f32x4 v0 = acc[ai][bj][m][0] + bv[bj][0], v1 = acc[ai][bj][m][1] + bv[bj][1];
          if (sig) {
#pragma unroll
            for (int j = 0; j < 4; ++j) { v0[j] = sigmf(v0[j]); v1[j] = sigmf(v1[j]); } }
          pg8::u32x4 w; w.x = pg8::cvt_pk_bf16(v0[0], v0[1]); w.y = pg8::cvt_pk_bf16(v0[2], v0[3]); w.z = pg8::cvt_pk_bf16(v1[0], v1[1]); w.w = pg8::cvt_pk_bf16(v1[2], v1[3]);
          *(pg8::u32x4*)(rowp + bj * 128) = w; } }
  }
};
struct EpiPlain {
  static constexpr bool PERM = true, AFTER_DRAIN = false;
  bf16_t* out; int ldc;
  __device__ __forceinline__ void operator()(const pg8::f32x4 (&acc)[2][2][4][2], const pg8::Unit& u, int wr, int wc, int fr, int fq) const {
    const int row0 = u.pm * 256 + wr * 64 + fr, col0 = u.pn * 256 + wc * 32 + 8 * fq;
#pragma unroll
    for (int ai = 0; ai < 2; ++ai)
#pragma unroll
      for (int m = 0; m < 4; ++m) { bf16_t* rowp = out + (size_t)(row0 + ai * 128 + m * 16) * ldc + col0;
#pragma unroll
        for (int bj = 0; bj < 2; ++bj) { const pg8::f32x4 v0 = acc[ai][bj][m][0], v1 = acc[ai][bj][m][1];
          pg8::u32x4 w; w.x = pg8::cvt_pk_bf16(v0[0], v0[1]); w.y = pg8::cvt_pk_bf16(v0[2], v0[3]); w.z = pg8::cvt_pk_bf16(v1[0], v1[1]); w.w = pg8::cvt_pk_bf16(v1[2], v1[3]);
          *(pg8::u32x4*)(rowp + bj * 128) = w; } }
  }
};
struct EpiRes {
  static constexpr bool PERM = false, AFTER_DRAIN = false;
  const float* xin; float* X; const float* gate;
  __device__ __forceinline__ void operator()(const pg8::f32x4 (&acc)[2][2][4][2], const pg8::Unit& u, int wr, int wc, int fr, int fq) const {
    const int row0 = u.pm * 256 + wr * 64 + fr, col0 = u.pn * 256 + wc * 32 + 4 * fq; const float* gb = gate + (size_t)((u.pm * 256) / S) * 6144;
    pg8::f32x4 gv[2][2];
#pragma unroll
    for (int bj = 0; bj < 2; ++bj)
#pragma unroll
      for (int n = 0; n < 2; ++n) gv[bj][n] = *(const pg8::f32x4*)(gb + col0 + bj * 128 + n * 16);
#pragma unroll
    for (int ai = 0; ai < 2; ++ai)
#pragma unroll
      for (int m = 0; m < 4; ++m) { const size_t off = (size_t)(row0 + ai * 128 + m * 16) * 1024 + col0;
#pragma unroll
        for (int bj = 0; bj < 2; ++bj)
#pragma unroll
          for (int n = 0; n < 2; ++n) { const pg8::f32x4 xi = *(const pg8::f32x4*)(xin + off + bj * 128 + n * 16); *(pg8::f32x4*)(X + off + bj * 128 + n * 16) = xi + gv[bj][n] * acc[ai][bj][m][n]; }
        asm volatile("" ::: "memory"); }
  }
};
template <class Epi> __device__ __forceinline__ void phase_gemm_fast(const bf16_t* A, const bf16_t* Bt, int M, int N, int K, const Epi& E, char* smem) {
  pg8::Gemm g; g.A = A; g.Bt = Bt; g.M = M; g.N = N; g.K = K;
  pg8::StaticOrder So; So.init(M, N, (int)gridDim.x, (int)blockIdx.x);
  pg8::gemm_phase<Epi, pg8::StaticOrder, false>((PG8_LAS unsigned char*)smem, g, So, E, nullptr);
}

namespace cp {
typedef short bf16x8 __attribute__((ext_vector_type(8)));
typedef float f32x16 __attribute__((ext_vector_type(16)));
constexpr int RS = 272;
__device__ __forceinline__ void unpack8(const u32x4 w, float* f) { f[0] = bflo(w.x); f[1] = bfhi(w.x); f[2] = bflo(w.y); f[3] = bfhi(w.y); f[4] = bflo(w.z); f[5] = bfhi(w.z); f[6] = bflo(w.w); f[7] = bfhi(w.w); }
__device__ void phase_convpool(const Params& p, char* smem) {
  for (int job = blockIdx.x; job < T / 64; job += gridDim.x) {
    int tid_ = threadIdx.x; asm volatile("" : "+v"(tid_));
    const int tid = tid_, c0 = (tid & 127) * 8, t0 = job * 64 + (tid >> 7) * 16, s0 = t0 & (S - 1);
    float cw[5][8], cb[8];
#pragma unroll
    for (int j = 0; j < 5; ++j) { const f32x4 a = *(const f32x4*)(p.conv_w + j * 1024 + c0), b = *(const f32x4*)(p.conv_w + j * 1024 + c0 + 4); cw[j][0] = a.x; cw[j][1] = a.y; cw[j][2] = a.z; cw[j][3] = a.w; cw[j][4] = b.x; cw[j][5] = b.y; cw[j][6] = b.z; cw[j][7] = b.w; }
    { const f32x4 a = *(const f32x4*)(p.conv_b + c0), b = *(const f32x4*)(p.conv_b + c0 + 4); cb[0] = a.x; cb[1] = a.y; cb[2] = a.z; cb[3] = a.w; cb[4] = b.x; cb[5] = b.y; cb[6] = b.z; cb[7] = b.w; }
    const float sc = c0 >= 512 ? KSCALE : 1.f;
    float win[5][8];
#pragma unroll
    for (int j = 0; j < 4; ++j) { const int ss = s0 + j - 2; u32x4 w = (u32x4){0u, 0u, 0u, 0u}; if (ss >= 0 && ss < S) w = *(const u32x4*)(p.ZQK + (size_t)(t0 + j - 2) * 1024 + c0); unpack8(w, win[j + 1]); }
#pragma unroll
    for (int i = 0; i < 16; ++i) {
#pragma unroll
      for (int j = 0; j < 4; ++j)
#pragma unroll
        for (int q = 0; q < 8; ++q) win[j][q] = win[j + 1][q];
      { const int ss = s0 + i + 2; u32x4 w = (u32x4){0u, 0u, 0u, 0u}; if (ss < S) w = *(const u32x4*)(p.ZQK + (size_t)(t0 + i + 2) * 1024 + c0); unpack8(w, win[4]); }
      float a[8];
#pragma unroll
      for (int q = 0; q < 8; ++q) { float v = cb[q];
#pragma unroll
        for (int j = 0; j < 5; ++j) v += cw[j][q] * win[j][q];
        a[q] = siluf(v) * sc; }
      u32x4 o; o.x = pack2(a[0], a[1]); o.y = pack2(a[2], a[3]); o.z = pack2(a[4], a[5]); o.w = pack2(a[6], a[7]); *(u32x4*)(p.QK + (size_t)(t0 + i) * 1024 + c0) = o;
    }
  }
  for (int job = blockIdx.x; job < (T / 128) * 4; job += gridDim.x) {
    int tid_ = threadIdx.x; asm volatile("" : "+v"(tid_));
    const int tid = tid_, wid = tid >> 6, lane = tid & 63, l31 = lane & 31, hh = lane >> 5;
    const int g = (job + (job >> 8)) & 3, t0 = (job >> 2) * 128, win = 2 << g, hw = win >> 1;
    __syncthreads();
#pragma unroll
    for (int i = 0; i < 4; ++i) { const int idx = tid + i * NTHREADS, row = idx >> 4, ch = idx & 15; *(u32x4*)(smem + 128 * RS + row * RS + ch * 16) = *(const u32x4*)(p.poolWt + (size_t)g * 16384 + row * 128 + ch * 8); }
#pragma unroll 1
    for (int i = 0; i < 4; ++i) { const int idx = tid + i * NTHREADS, row = idx >> 4, ch = idx & 15, t = t0 + row, s = t & (S - 1); const int lo = max(s - hw, 0), hi = min(s + hw, S);
      float sum[8], own[8];
#pragma unroll
      for (int q = 0; q < 8; ++q) sum[q] = 0.f;
      const bf16_t* base = p.ZP + (size_t)(t - s) * 512 + g * 128 + ch * 8;
      u32x4 rw[16];
#pragma unroll
      for (int r = 0; r < 16; ++r) { rw[r] = (u32x4){0u, 0u, 0u, 0u}; if (r < win) { const int rr = s - hw + r; if (rr >= 0 && rr < S) rw[r] = *(const u32x4*)(base + (size_t)rr * 512); } }
#pragma unroll
      for (int r = 0; r < 16; ++r) if (r < win) { float f[8]; unpack8(rw[r], f);
#pragma unroll
        for (int q = 0; q < 8; ++q) sum[q] += f[q]; }
      unpack8(*(const u32x4*)(base + (size_t)s * 512), own); const float inv = 1.f / (float)(hi - lo);
      u32x4 o; o.x = pack2(sum[0] * inv - own[0], sum[1] * inv - own[1]); o.y = pack2(sum[2] * inv - own[2], sum[3] * inv - own[3]); o.z = pack2(sum[4] * inv - own[4], sum[5] * inv - own[5]); o.w = pack2(sum[6] * inv - own[6], sum[7] * inv - own[7]);
      *(u32x4*)(smem + row * RS + ch * 16) = o; }
    __syncthreads();
    const int mt = wid >> 1;
#pragma unroll
    for (int q = 0; q < 2; ++q) { const int nt = (wid & 1) * 2 + q;
      f32x16 acc;
#pragma unroll
      for (int r = 0; r < 16; ++r) acc[r] = 0.f;
      const char* ya = smem + (mt * 32 + l31) * RS + hh * 16; const char* wb = smem + 128 * RS + (nt * 32 + l31) * RS + hh * 16;
#pragma unroll
      for (int ks = 0; ks < 8; ++ks) acc = __builtin_amdgcn_mfma_f32_32x32x16_bf16(*(const bf16x8*)(ya + ks * 32), *(const bf16x8*)(wb + ks * 32), acc, 0, 0, 0);
      const int e = nt * 32 + l31; const float psc = p.pool_sc[g * 128 + e];
#pragma unroll
      for (int r = 0; r < 16; ++r) { const int row = mt * 32 + (r & 3) + 8 * (r >> 2) + 4 * hh; p.CAT[(size_t)(t0 + row) * 1024 + 512 + g * 128 + e] = f2bf(acc[r] * psc); } }
  }
}
}

__device__ void phase_mlstm_naive(const Params& p, char* smem) {
  float* qs = (float*)smem; float* ks = qs + 128; float* nump = ks + 128; float* red = nump + 512;
  const int tid = threadIdx.x, j = tid & 127, qd = tid >> 7;
  for (int job = blockIdx.x; job < 64; job += gridDim.x) {
    const int dir = job >> 5, b = (job >> 2) & 7, h = job & 3;
    float C[32];
#pragma unroll
    for (int d = 0; d < 32; ++d) C[d] = 0.f;
    float n = 0.f, m = 0.f;
    for (int step = 0; step < S; ++step) { const int s = dir ? S - 1 - step : step; const size_t t = (size_t)b * S + s;
      const float li = p.gates[t * 16 + dir * 4 + h], gf = p.gates[t * 16 + 8 + dir * 4 + h];
      const float lf = fminf(gf, 0.f) - log1pf(__expf(-fabsf(gf)));
      __syncthreads();
      if (qd == 0) { qs[j] = bf2f(p.QK[t * 1024 + h * 128 + j]); ks[j] = bf2f(p.QK[t * 1024 + 512 + h * 128 + j]); }
      const float v = bf2f(p.ZV[t * 512 + h * 128 + j]);
      __syncthreads();
      const float mn = fmaxf(lf + m, li), ip = __expf(li - mn), fp = __expf(lf + m - mn); m = mn;
      float num = 0.f;
#pragma unroll
      for (int d = 0; d < 32; ++d) { C[d] = fp * C[d] + ip * ks[qd * 32 + d] * v; num += qs[qd * 32 + d] * C[d]; }
      float dp = 0.f; if (qd == 0) { n = fp * n + ip * ks[j]; dp = qs[j] * n; }
      nump[qd * 128 + j] = num;
      dp = wave_sum(dp); if ((tid & 63) == 0) red[tid >> 6] = dp;
      __syncthreads();
      if (qd == 0) { const float den = red[0] + red[1]; num = nump[j] + nump[128 + j] + nump[256 + j] + nump[384 + j];
        p.HS[((size_t)dir * T + t) * 512 + h * 128 + j] = f2bf(num / fmaxf(fabsf(den), __expf(-mn))); }
    }
    __syncthreads();
  }
}

namespace ml {
typedef short bf16x8 __attribute__((ext_vector_type(8)));
typedef short s16x4 __attribute__((ext_vector_type(4)));
typedef float f32x16 __attribute__((ext_vector_type(16)));
constexpr int RS = 272;
constexpr int OFF_Q = 0, OFF_K = 128 * RS, OFF_VT = 2 * 128 * RS, OFF_VW = OFF_VT + 34 * RS, OFF_CT = OFF_VW + 34 * RS, OFF_A = OFF_CT + 34 * RS;
constexpr int OFF_PA = OFF_A + 16384, OFF_MCH = OFF_PA + 16384, OFF_TAB = OFF_MCH + 512, OFF_DEN = OFF_TAB + 4096  , OFF_EX = OFF_DEN + 1536  , OFF_OUT = OFF_EX + 16384  , OFF_END = OFF_OUT + 128 * 80;
static_assert(OFF_A % 16 == 0 && OFF_END <= SMEM_BYTES, "mlstm LDS layout");
__device__ __forceinline__ int crow(int r, int h) { return (r & 3) + 8 * (r >> 2) + 4 * h; }
__device__ __forceinline__ int spos(int s) { return (s & ~12) | ((s & 4) << 1) | ((s & 8) >> 1); }
#define ML_MFMA(a, b, c) __builtin_amdgcn_mfma_f32_32x32x16_bf16((a), (b), (c), 0, 0, 0)
__device__ __forceinline__ bf16x8 pack8(float x0, float x1, float x2, float x3, float x4, float x5, float x6, float x7) {
  u32x4 w;
  asm volatile("v_cvt_pk_bf16_f32 %0, %4, %5\n\tv_cvt_pk_bf16_f32 %1, %6, %7\n\tv_cvt_pk_bf16_f32 %2, %8, %9\n\tv_cvt_pk_bf16_f32 %3, %10, %11\n\ts_nop 1"
               : "=&v"(w.x), "=&v"(w.y), "=&v"(w.z), "=&v"(w.w) : "v"(x0), "v"(x1), "v"(x2), "v"(x3), "v"(x4), "v"(x5), "v"(x6), "v"(x7));
  return __builtin_bit_cast(bf16x8, w);
}
__device__ __forceinline__ void tr_read8(unsigned a, s16x4& r0, s16x4& r1, s16x4& r2, s16x4& r3, s16x4& r4, s16x4& r5, s16x4& r6, s16x4& r7) {
  asm volatile("ds_read_b64_tr_b16 %0, %8\n\tds_read_b64_tr_b16 %1, %8 offset:2176\n\tds_read_b64_tr_b16 %2, %8 offset:4352\n\tds_read_b64_tr_b16 %3, %8 offset:6528\n\t"
               "ds_read_b64_tr_b16 %4, %8 offset:8704\n\tds_read_b64_tr_b16 %5, %8 offset:10880\n\tds_read_b64_tr_b16 %6, %8 offset:13056\n\tds_read_b64_tr_b16 %7, %8 offset:15232\n\ts_waitcnt lgkmcnt(0)"
               : "=&v"(r0), "=&v"(r1), "=&v"(r2), "=&v"(r3), "=&v"(r4), "=&v"(r5), "=&v"(r6), "=&v"(r7) : "v"(a) : "memory");
}
static_assert(8 * RS == 2176, "tr_read8 offsets assume 272-byte rows");

__device__ void phase_mlstm(const Params& p, char* smem) {
  int tid_ = threadIdx.x; asm volatile("" : "+v"(tid_));
  const int tid = tid_, wid = tid >> 6, lane = tid & 63, l31 = lane & 31, hh = lane >> 5;
  float* const LA = (float*)(smem + OFF_A); float* const LPA = (float*)(smem + OFF_PA); float* const LM = (float*)(smem + OFF_MCH);
  float* const LTAB = (float*)(smem + OFF_TAB); float* const LDEN = (float*)(smem + OFF_DEN);
  const unsigned lds0 = (unsigned)(uintptr_t)smem;
  for (int job = blockIdx.x; job < 256; job += gridDim.x) {
    const int dvq = job & 3, h = (job >> 2) & 3, b = (job >> 4) & 7, dir = job >> 7;
    const float* gts = p.gates + (size_t)b * S * 16;
    const bf16_t* QKb = p.QK + (size_t)b * S * 1024 + h * 128; const bf16_t* ZVb = p.ZV + (size_t)b * S * 512 + h * 128 + dvq * 32;
    bf16_t* HSb = p.HS + ((size_t)dir * T + (size_t)b * S) * 512 + h * 128 + dvq * 32;
    __syncthreads();
    for (int i = tid; i < 3 * 34 * RS / 4; i += NTHREADS) ((u32*)(smem + OFF_VT))[i] = 0u;
    for (int cc = 0; cc < 4; ++cc) { const int c = wid * 4 + cc, tau0 = c * 128 + 2 * lane; const int tok0 = dir ? S - 1 - tau0 : tau0, tok1 = dir ? tok0 - 1 : tok0 + 1;
      const float li0 = gts[(size_t)tok0 * 16 + dir * 4 + h], gf0 = gts[(size_t)tok0 * 16 + 8 + dir * 4 + h], li1 = gts[(size_t)tok1 * 16 + dir * 4 + h], gf1 = gts[(size_t)tok1 * 16 + 8 + dir * 4 + h];
      const float lf0 = fminf(gf0, 0.f) - log1pf(__expf(-fabsf(gf0))), lf1 = fminf(gf1, 0.f) - log1pf(__expf(-fabsf(gf1)));
      const float pr = lf0 + lf1; float incl = pr;
#pragma unroll
      for (int o = 1; o < 64; o <<= 1) { const float v = __shfl_up(incl, o); if (lane >= o) incl += v; }
      const float b0 = incl - pr + lf0, b1 = b0 + lf1, a0 = li0 - b0, a1 = li1 - b1;
      float im = fmaxf(a0, a1);
#pragma unroll
      for (int o = 1; o < 64; o <<= 1) { const float v = __shfl_up(im, o); if (lane >= o) im = fmaxf(im, v); }
      float ex = __shfl_up(im, 1); if (lane == 0) ex = -INFINITY;
      const float pa0 = fmaxf(ex, a0), pa1 = fmaxf(pa0, a1);
      LA[tau0] = a0; LA[tau0 + 1] = a1; LPA[tau0] = pa0; LPA[tau0 + 1] = pa1; if (lane == 63) LM[64 + c] = b1; }
    __syncthreads();
    if (tid == 0) { float m = 0.f; for (int c = 0; c < 32; ++c) { LM[c] = m; m = LM[64 + c] + fmaxf(m, LPA[c * 128 + 127]); } LM[32] = m; }
    __syncthreads();
    u32x4 qreg[4], kreg[4], vreg;
#define ML_TOK(tau) (dir ? S - 1 - (tau) : (tau))
#define ML_LOAD(c) do { _Pragma("unroll") for (int i_ = 0; i_ < 4; ++i_) { const int tk_ = ML_TOK((c) * 128 + (tid >> 4) + 32 * i_); \
        qreg[i_] = *(const u32x4*)(QKb + (size_t)tk_ * 1024 + (tid & 15) * 8); kreg[i_] = *(const u32x4*)(QKb + (size_t)tk_ * 1024 + 512 + (tid & 15) * 8); } \
      { const int tk_ = ML_TOK((c) * 128 + (tid & 127)); vreg = *(const u32x4*)(ZVb + (size_t)tk_ * 512 + (tid >> 7) * 8); } } while (0)
#define ML_LI(c) gts[(size_t)ML_TOK((c) * 128 + (tid & 127)) * 16 + dir * 4 + h]
#define ML_TABLES(c, li_) do { if (tid < 128) { const int tau_ = (c) * 128 + tid; const float a_ = LA[tau_], mc_ = LM[(c)]; \
        const float Mj_ = fmaxf(mc_, LPA[tau_]), Me_ = fmaxf(mc_, LPA[(c) * 128 + 127]); float* tb_ = LTAB + ((c) & 1) * 512; \
        tb_[tid] = __expf(fminf(Me_ - Mj_, 60.f)); tb_[128 + tid] = __expf(mc_ - Mj_); tb_[256 + tid] = __expf(-((li_ - a_) + Mj_)); tb_[384 + tid] = __expf(a_ - Me_); } } while (0)
#define ML_STORE(c) do { _Pragma("unroll") for (int i_ = 0; i_ < 4; ++i_) { const int row_ = (tid >> 4) + 32 * i_; \
        *(u32x4*)(smem + OFF_Q + row_ * RS + (tid & 15) * 16) = qreg[i_]; *(u32x4*)(smem + OFF_K + row_ * RS + (tid & 15) * 16) = kreg[i_]; } \
      { const int s_ = tid & 127, ps_ = spos(s_) * 2; const float we_ = LTAB[((c) & 1) * 512 + 384 + s_]; const u32 vw_[4] = {vreg.x, vreg.y, vreg.z, vreg.w}; \
        _Pragma("unroll") for (int i_ = 0; i_ < 4; ++i_) { const int r0_ = ((tid >> 7) * 8 + 2 * i_) * RS + ps_; \
          *(bf16_t*)(smem + OFF_VT + r0_) = (bf16_t)(vw_[i_] & 0xFFFFu); *(bf16_t*)(smem + OFF_VT + r0_ + RS) = (bf16_t)(vw_[i_] >> 16); \
          *(bf16_t*)(smem + OFF_VW + r0_) = f2bf(bflo(vw_[i_]) * we_); *(bf16_t*)(smem + OFF_VW + r0_ + RS) = f2bf(bfhi(vw_[i_]) * we_); } } \
      if (tid < 128) { const int ps_ = spos(tid) * 2; *(bf16_t*)(smem + OFF_VT + 32 * RS + ps_) = (bf16_t)0x3F80u; *(bf16_t*)(smem + OFF_VW + 32 * RS + ps_) = f2bf(LTAB[((c) & 1) * 512 + 384 + tid]); } } while (0)
    float li_pf = ML_LI(0);
    ML_LOAD(0); ML_TABLES(0, li_pf);
    li_pf = ML_LI(1);
    __syncthreads();
    ML_STORE(0);
    __syncthreads();
    f32x16 Cacc;
#pragma unroll
    for (int r = 0; r < 16; ++r) Cacc[r] = 0.f;
    for (int c = 0; c < 32; ++c) {
      int tidc_ = threadIdx.x; asm volatile("" : "+v"(tidc_));
      const int tid = tidc_, wid = tid >> 6, lane = tid & 63, l31 = lane & 31, hh = lane >> 5;
      const int t2 = wid >> 1, nt = wid & 1, brow = min(nt * 32 + l31, 33);
      if (c + 1 < 32) { ML_LOAD(c + 1); ML_TABLES(c + 1, li_pf); }
      if (c + 2 < 32) li_pf = ML_LI(c + 2);
      const float* tab = LTAB + (c & 1) * 512;
      f32x16 acc;
#pragma unroll
      for (int r = 0; r < 16; ++r) acc[r] = 0.f;
      const char* qa = smem + OFF_Q + (t2 * 32 + l31) * RS + hh * 16;
      if (nt == 0) { const char* cb = smem + OFF_CT + l31 * RS + hh * 16;
#pragma unroll
        for (int ks = 0; ks < 8; ++ks) acc = ML_MFMA(*(const bf16x8*)(qa + ks * 32), *(const bf16x8*)(cb + ks * 32), acc);
#pragma unroll
        for (int r = 0; r < 16; ++r) acc[r] *= tab[128 + t2 * 32 + crow(r, hh)];
      } else { const char* cb = smem + OFF_CT + (l31 == 0 ? 32 : 33) * RS + hh * 16; f32x16 aq;
#pragma unroll
        for (int r = 0; r < 16; ++r) aq[r] = 0.f;
#pragma unroll
        for (int ks = 0; ks < 8; ++ks) aq = ML_MFMA(*(const bf16x8*)(qa + ks * 32), *(const bf16x8*)(cb + ks * 32), aq);
        if (l31 == 0) {
#pragma unroll
          for (int r = 0; r < 16; ++r) { const int j = t2 * 32 + crow(r, hh); LDEN[256 + j] = aq[r] * tab[128 + j]; } } }
      const float fj = tab[t2 * 32 + l31];
      float psum = 0.f;
      for (int si = nt; si <= t2; si += 2) {
        f32x16 X;
#pragma unroll
        for (int r = 0; r < 16; ++r) X[r] = 0.f;
        const char* ka = smem + OFF_K + (si * 32 + l31) * RS + hh * 16;
#pragma unroll
        for (int ks = 0; ks < 8; ++ks) X = ML_MFMA(*(const bf16x8*)(ka + ks * 32), *(const bf16x8*)(qa + ks * 32), X);
        const float* We = tab + 384 + si * 32;
#pragma unroll
        for (int r = 0; r < 16; ++r) { const int sl = crow(r, hh); float w = We[sl] * fj; if (si == t2 && sl > l31) w = 0.f; X[r] *= w; psum += X[r]; }
        const bf16x8 f0 = pack8(X[0], X[1], X[2], X[3], X[4], X[5], X[6], X[7]), f1 = pack8(X[8], X[9], X[10], X[11], X[12], X[13], X[14], X[15]);
        const char* vb = smem + OFF_VT + l31 * RS + si * 64 + hh * 16;
        acc = ML_MFMA(f0, *(const bf16x8*)(vb), acc); acc = ML_MFMA(f1, *(const bf16x8*)(vb + 32), acc);
      }
      psum += __shfl_xor(psum, 32);
      if (hh == 0) LDEN[nt * 128 + t2 * 32 + l31] = psum;
      if (nt == 1) { float* ex = (float*)(smem + OFF_EX) + t2 * 1024 + lane;
#pragma unroll
        for (int r = 0; r < 16; ++r) ex[r * 64] = acc[r]; }
      { const float mc = LM[c], decay = __expf(mc - fmaxf(mc, LPA[c * 128 + 127]));
#pragma unroll
        for (int r = 0; r < 16; ++r) Cacc[r] *= decay;
        const unsigned ta = lds0 + OFF_K + ((lane & 15) >> 2) * RS + (t2 * 32 + 16 * ((lane >> 4) & 1) + 4 * (lane & 3)) * 2 + 4 * hh * RS;
        const char* wb = smem + OFF_VW + brow * RS + hh * 16;
#pragma unroll
        for (int kq = 0; kq < 2; ++kq) { s16x4 r0, r1, r2, r3, r4, r5, r6, r7; tr_read8(ta + 64 * kq * RS, r0, r1, r2, r3, r4, r5, r6, r7); __builtin_amdgcn_sched_barrier(0);
          Cacc = ML_MFMA(((bf16x8){r0[0], r0[1], r0[2], r0[3], r1[0], r1[1], r1[2], r1[3]}), *(const bf16x8*)(wb + (4 * kq + 0) * 32), Cacc);
          Cacc = ML_MFMA(((bf16x8){r2[0], r2[1], r2[2], r2[3], r3[0], r3[1], r3[2], r3[3]}), *(const bf16x8*)(wb + (4 * kq + 1) * 32), Cacc);
          Cacc = ML_MFMA(((bf16x8){r4[0], r4[1], r4[2], r4[3], r5[0], r5[1], r5[2], r5[3]}), *(const bf16x8*)(wb + (4 * kq + 2) * 32), Cacc);
          Cacc = ML_MFMA(((bf16x8){r6[0], r6[1], r6[2], r6[3], r7[0], r7[1], r7[2], r7[3]}), *(const bf16x8*)(wb + (4 * kq + 3) * 32), Cacc); } }
      __syncthreads();
      if (nt == 0) { const float* ex = (const float*)(smem + OFF_EX) + t2 * 1024 + lane;
#pragma unroll
        for (int r = 0; r < 16; ++r) { const int j = t2 * 32 + crow(r, hh); const float dn = LDEN[j] + LDEN[128 + j] + LDEN[256 + j], nr = tab[256 + j];
          *(bf16_t*)(smem + OFF_OUT + j * 80 + l31 * 2) = f2bf((acc[r] + ex[r * 64]) * __builtin_amdgcn_rcpf(fmaxf(fabsf(dn), nr))); } }
      if (nt * 32 + l31 <= 32) { char* cw = smem + OFF_CT + (nt * 32 + l31) * RS + (t2 * 32 + 4 * hh) * 2;
#pragma unroll
        for (int g = 0; g < 4; ++g) { u32x2 w; w.x = pack2(Cacc[4 * g], Cacc[4 * g + 1]); w.y = pack2(Cacc[4 * g + 2], Cacc[4 * g + 3]); *(u32x2*)(cw + 16 * g) = w; } }
      if (c + 1 < 32) ML_STORE(c + 1);
      __syncthreads();
      { const int j = tid >> 2, ch = tid & 3; const u32x4 o = *(const u32x4*)(smem + OFF_OUT + j * 80 + ch * 16);
        *(u32x4*)(HSb + (size_t)ML_TOK(c * 128 + j) * 512 + ch * 8) = o; }
    }
#undef ML_TOK
#undef ML_LOAD
#undef ML_TABLES
#undef ML_LI
#undef ML_STORE
  }
}
}

__device__ void phase_peer_select_naive(const Params& p, int layer, char* smem) {
  float* kl = (float*)smem;
  float* qsh = kl + 2 * 128 * 129;
  const int tid = threadIdx.x, wid = tid >> 6, lane = tid & 63; float* qs = qsh + wid * 128;
  __syncthreads();
  for (int i = tid; i < 2 * 128 * 128; i += NTHREADS) kl[(i >> 7) * 129 + (i & 127)] = p.peer_keys[(size_t)layer * 32768 + i];
  __syncthreads();
  for (int job = blockIdx.x; job < T; job += gridDim.x) {
    const int t = job, h = wid;
    float ts[2][16]; int ti[2][16];
#pragma unroll
    for (int pp = 0; pp < 2; ++pp) {
      const bf16_t* q = p.QP + (size_t)t * 2048 + h * 256 + pp * 128; const float q0 = bf2f(q[lane]), q1 = bf2f(q[lane + 64]);
      const float r = rsqrtf(wave_sum(q0 * q0 + q1 * q1) * (1.f / 128.f) + EPS); qs[lane] = q0 * r; qs[lane + 64] = q1 * r;
      float s0 = 0.f, s1 = 0.f; const float* k0 = kl + (pp * 128 + lane) * 129; const float* k1 = k0 + 64 * 129;
      for (int c = 0; c < 128; ++c) { const float qc = qs[c]; s0 += qc * k0[c]; s1 += qc * k1[c]; }
#pragma unroll
      for (int k = 0; k < 16; ++k) { const float mx = wave_max(fmaxf(s0, s1)); int cand = (s0 == mx) ? lane : ((s1 == mx) ? lane + 64 : 9999);
        for (int o = 32; o >= 1; o >>= 1) cand = min(cand, __shfl_xor(cand, o));
        ts[pp][k] = mx; ti[pp][k] = cand; if (cand == lane) s0 = -INFINITY; if (cand == lane + 64) s1 = -INFINITY; }
    }
    float cs[4];
#pragma unroll
    for (int r = 0; r < 4; ++r) { const int c = lane * 4 + r; float va = 0.f, vb = 0.f;
#pragma unroll
      for (int k = 0; k < 16; ++k) { if (k == (c >> 4)) va = ts[0][k]; if (k == (c & 15)) vb = ts[1][k]; }
      cs[r] = va + vb; }
    float top[16]; int tix[16];
#pragma unroll
    for (int k = 0; k < 16; ++k) { const float mx = wave_max(fmaxf(fmaxf(cs[0], cs[1]), fmaxf(cs[2], cs[3]))); int cand = 9999;
#pragma unroll
      for (int r = 3; r >= 0; --r) if (cs[r] == mx) cand = lane * 4 + r;
      for (int o = 32; o >= 1; o >>= 1) cand = min(cand, __shfl_xor(cand, o));
      top[k] = mx; tix[k] = cand;
#pragma unroll
      for (int r = 0; r < 4; ++r) if (cand == lane * 4 + r) cs[r] = -INFINITY; }
    float sum = 0.f;
#pragma unroll
    for (int k = 0; k < 16; ++k) sum += __expf(top[k] - top[0]);
    if (lane < 16) { float tv = 0.f; int tc = 0;
#pragma unroll
      for (int k = 0; k < 16; ++k) if (k == lane) { tv = top[k]; tc = tix[k]; }
      int ia = 0, ib = 0;
#pragma unroll
      for (int k = 0; k < 16; ++k) { if (k == (tc >> 4)) ia = ti[0][k]; if (k == (tc & 15)) ib = ti[1][k]; }
      p.pidx[((size_t)t * 8 + h) * 16 + lane] = (bf16_t)(ia * 128 + ib); p.pgate[((size_t)t * 8 + h) * 16 + lane] = __expf(tv - top[0]) / sum; }
  }
}

namespace sel {
typedef short bf16x8 __attribute__((ext_vector_type(8)));
typedef float f32x16 __attribute__((ext_vector_type(16)));
constexpr int RS = 272, OFF_W = 2 * 128 * RS, WB = 3 * 16 * 32 * 4;
static_assert(OFF_W + 8 * WB <= SMEM_BYTES, "select LDS layout");
constexpr float NEG = -3.0e38f;
__device__ __forceinline__ float max3(float a, float b, float c) { return fmaxf(fmaxf(a, b), c); }
__device__ __forceinline__ float xhalf(float v) { return __shfl_xor(v, 32); }

#define CE(a, b) do { const float hi_ = fmaxf(a, b), lo_ = fminf(a, b); a = hi_; b = lo_; } while (0)
#define SORT16(V) do { CE(V[0], V[1]); CE(V[2], V[3]); CE(V[0], V[2]); CE(V[1], V[3]); CE(V[1], V[2]); CE(V[4], V[5]); CE(V[6], V[7]); CE(V[4], V[6]); CE(V[5], V[7]); CE(V[5], V[6]); CE(V[0], V[4]); CE(V[2], V[6]); CE(V[2], V[4]); CE(V[1], V[5]); CE(V[3], V[7]); CE(V[3], V[5]); CE(V[1], V[2]); CE(V[3], V[4]); CE(V[5], V[6]); CE(V[8], V[9]); CE(V[10], V[11]); CE(V[8], V[10]); CE(V[9], V[11]); CE(V[9], V[10]); CE(V[12], V[13]); CE(V[14], V[15]); CE(V[12], V[14]); CE(V[13], V[15]); CE(V[13], V[14]); CE(V[8], V[12]); CE(V[10], V[14]); CE(V[10], V[12]); CE(V[9], V[13]); CE(V[11], V[15]); CE(V[11], V[13]); CE(V[9], V[10]); CE(V[11], V[12]); CE(V[13], V[14]); CE(V[0], V[8]); CE(V[4], V[12]); CE(V[4], V[8]); CE(V[2], V[10]); CE(V[6], V[14]); CE(V[6], V[10]); CE(V[2], V[4]); CE(V[6], V[8]); CE(V[10], V[12]); CE(V[1], V[9]); CE(V[5], V[13]); CE(V[5], V[9]); CE(V[3], V[11]); CE(V[7], V[15]); CE(V[7], V[11]); CE(V[3], V[5]); CE(V[7], V[9]); CE(V[11], V[13]); CE(V[1], V[2]); CE(V[3], V[4]); CE(V[5], V[6]); CE(V[7], V[8]); CE(V[9], V[10]); CE(V[11], V[12]); CE(V[13], V[14]); } while (0)
#define BMERGE16(V) do { CE(V[0], V[8]); CE(V[1], V[9]); CE(V[2], V[10]); CE(V[3], V[11]); CE(V[4], V[12]); CE(V[5], V[13]); CE(V[6], V[14]); CE(V[7], V[15]); CE(V[0], V[4]); CE(V[1], V[5]); CE(V[2], V[6]); CE(V[3], V[7]); CE(V[8], V[12]); CE(V[9], V[13]); CE(V[10], V[14]); CE(V[11], V[15]); CE(V[0], V[2]); CE(V[1], V[3]); CE(V[4], V[6]); CE(V[5], V[7]); CE(V[8], V[10]); CE(V[9], V[11]); CE(V[12], V[14]); CE(V[13], V[15]); CE(V[0], V[1]); CE(V[2], V[3]); CE(V[4], V[5]); CE(V[6], V[7]); CE(V[8], V[9]); CE(V[10], V[11]); CE(V[12], V[13]); CE(V[14], V[15]); } while (0)

__device__ void phase_peer_select(const Params& p, int layer, char* smem) {
  const int tid0 = threadIdx.x;
  __syncthreads();
  { const bf16_t* kb = p.keysb + (size_t)layer * 32768;
    for (int i = tid0; i < 2 * 128 * 16; i += NTHREADS) { const int row = i >> 4, ch = i & 15; *(u32x4*)(smem + row * RS + ch * 16) = *(const u32x4*)(kb + (size_t)row * 128 + ch * 8); } }
  __syncthreads();
  for (int job = blockIdx.x; job < T / 32; job += gridDim.x) {
    int tid_ = threadIdx.x; asm volatile("" : "+v"(tid_));
    const int tid = tid_, wid = tid >> 6, lane = tid & 63, l31 = lane & 31, hh = lane >> 5, h = wid;
    const int t = job * 32 + l31;
    float* const wl = (float*)(smem + OFF_W + wid * WB);
    float rs[2], s1[16], s2[16];
#pragma unroll
    for (int pp = 0; pp < 2; ++pp) {
      const bf16_t* qrow = p.QP + (size_t)t * 2048 + h * 256 + pp * 128 + hh * 8;
      bf16x8 bq[8]; float ssq = 0.f;
#pragma unroll
      for (int ks = 0; ks < 8; ++ks) { const u32x4 w = *(const u32x4*)(qrow + ks * 16); bq[ks] = __builtin_bit_cast(bf16x8, w);
        const u32 w0 = w.x, w1 = w.y, w2 = w.z, w3 = w.w; ssq = dot2bf(w0, w0, ssq); ssq = dot2bf(w1, w1, ssq); ssq = dot2bf(w2, w2, ssq); ssq = dot2bf(w3, w3, ssq); }
      ssq += xhalf(ssq); rs[pp] = rsqrtf(ssq * (1.f / 128.f) + EPS);
      f32x16 X[4];
#pragma unroll
      for (int nt = 0; nt < 4; ++nt) {
#pragma unroll
        for (int r = 0; r < 16; ++r) X[nt][r] = 0.f;
        const char* ka = smem + (pp * 128 + nt * 32 + l31) * RS + hh * 16;
#pragma unroll
        for (int ks = 0; ks < 8; ++ks) X[nt] = __builtin_amdgcn_mfma_f32_32x32x16_bf16(*(const bf16x8*)(ka + ks * 32), bq[ks], X[nt], 0, 0, 0); }
#pragma unroll
      for (int nt = 0; nt < 4; ++nt)
#pragma unroll
        for (int r = 0; r < 16; ++r) X[nt][r] = __uint_as_float((__float_as_uint(X[nt][r]) & ~0x7Fu) | (u32)(nt * 32 + (r & 3) + 8 * (r >> 2)) | ((u32)hh << 2));
      SORT16(X[0]); SORT16(X[1]); SORT16(X[2]); SORT16(X[3]);
#pragma unroll
      for (int i = 0; i < 16; ++i) { X[0][i] = fmaxf(X[0][i], X[1][15 - i]); X[2][i] = fmaxf(X[2][i], X[3][15 - i]); }
      BMERGE16(X[0]); BMERGE16(X[2]);
#pragma unroll
      for (int i = 0; i < 16; ++i) X[0][i] = fmaxf(X[0][i], X[2][15 - i]);
      BMERGE16(X[0]);
      f32x16 lo_, hi_;
#pragma unroll
      for (int i = 0; i < 16; ++i) { const u32 b_ = __float_as_uint(X[0][i]); auto r_ = __builtin_amdgcn_permlane32_swap(b_, b_, false, false); lo_[i] = __uint_as_float(r_[0]); hi_[i] = __uint_as_float(r_[1]); }
#pragma unroll
      for (int i = 0; i < 16; ++i) X[0][i] = fmaxf(lo_[i], hi_[15 - i]);
      BMERGE16(X[0]);
#pragma unroll
      for (int k = 0; k < 16; ++k) { wl[(pp * 16 + k) * 32 + l31] = X[0][k]; if (pp == 0) s1[k] = X[0][k] * rs[0]; else s2[k] = X[0][k] * rs[1]; }
    }
    constexpr int A0[25] = {0, 0, 0, 0, 0, 0, 0, 0, 0, 0, 0, 0, 0, 0, 0, 0, 2, 2, 2, 2, 2, 3, 3, 3, 3}, B0[25] = {0, 1, 2, 3, 4, 5, 6, 7, 8, 9, 10, 11, 12, 13, 14, 15, 0, 1, 2, 3, 4, 0, 1, 2, 3};
    constexpr int A1[25] = {1, 1, 1, 1, 1, 1, 1, 1, 4, 4, 4, 5, 5, 6, 6, 7, 7, 8, 9, 10, 11, 12, 13, 14, 15}, B1[25] = {0, 1, 2, 3, 4, 5, 6, 7, 0, 1, 2, 0, 1, 0, 1, 0, 1, 0, 0, 0, 0, 0, 0, 0, 0};
    float cd[25];
#pragma unroll
    for (int i = 0; i < 25; ++i) { const float v0 = s1[A0[i]] + s2[B0[i]], v1 = s1[A1[i]] + s2[B1[i]]; const float v = hh ? v1 : v0; const u32 cid = hh ? (u32)(A1[i] * 16 + B1[i]) : (u32)(A0[i] * 16 + B0[i]);
      cd[i] = __uint_as_float((__float_as_uint(v) & ~0xFFu) | cid); }
#pragma unroll 1
    for (int k = 0; k < 16; ++k) {
      float m = cd[24];
#pragma unroll
      for (int i = 0; i < 24; i += 2) m = max3(m, cd[i], cd[i + 1]);
      const float M = fmaxf(m, xhalf(m));
      wl[(32 + k) * 32 + l31] = M;
#pragma unroll
      for (int i = 0; i < 25; ++i) cd[i] = (cd[i] == M) ? NEG : cd[i];
    }
    float tv[16];
#pragma unroll
    for (int k = 0; k < 16; ++k) tv[k] = wl[(32 + k) * 32 + l31];
    float sum = 0.f;
#pragma unroll
    for (int k = 0; k < 16; ++k) sum += __expf(tv[k] - tv[0]);
    const float inv = 1.f / sum;
    u32 ev[8]; float go[8];
#pragma unroll
    for (int q = 0; q < 8; ++q) { const float v = wl[(32 + hh * 8 + q) * 32 + l31]; const u32 cid = __float_as_uint(v) & 0xFFu;
      const u32 i1 = __float_as_uint(wl[(cid >> 4) * 32 + l31]) & 0x7Fu, i2 = __float_as_uint(wl[(16 + (cid & 15)) * 32 + l31]) & 0x7Fu; ev[q] = i1 * 128 + i2;
      go[q] = __expf(v - tv[0]) * inv; }
    const u32 io0 = ev[0] | (ev[1] << 16), io1 = ev[2] | (ev[3] << 16), io2 = ev[4] | (ev[5] << 16), io3 = ev[6] | (ev[7] << 16);
    const size_t ob = ((size_t)t * 8 + h) * 16 + hh * 8;
    *(u32x4*)(p.pidx + ob) = (u32x4){io0, io1, io2, io3};
    *(f32x4*)(p.pgate + ob) = (f32x4){go[0], go[1], go[2], go[3]}; *(f32x4*)(p.pgate + ob + 4) = (f32x4){go[4], go[5], go[6], go[7]};
  }
}
}

typedef float f32x2 __attribute__((ext_vector_type(2)));
constexpr float U8_SCALE = 32.f, V8_SCALE = 2.f;
constexpr int GT = 4;
constexpr int GW_WAVE_BYTES = GT * (2048 + 128 * 2 + 128 * 4);
static_assert(8 * GW_WAVE_BYTES <= SMEM_BYTES - 16, "gather LDS layout");
__device__ __forceinline__ float gelu_erf(float z) { return 0.5f * z * (1.f + erff(z * 0.70710678118654752f)); }
__device__ __forceinline__ float reduce8(float d0, float d1, float d2, float d3, float d4, float d5, float d6, float d7, int lane) {
  float e[4];
  { auto r0 = __builtin_amdgcn_permlane32_swap(__float_as_uint(d0), __float_as_uint(d4), false, false); e[0] = __uint_as_float(r0[0]) + __uint_as_float(r0[1]);
    auto r1 = __builtin_amdgcn_permlane32_swap(__float_as_uint(d1), __float_as_uint(d5), false, false); e[1] = __uint_as_float(r1[0]) + __uint_as_float(r1[1]);
    auto r2 = __builtin_amdgcn_permlane32_swap(__float_as_uint(d2), __float_as_uint(d6), false, false); e[2] = __uint_as_float(r2[0]) + __uint_as_float(r2[1]);
    auto r3 = __builtin_amdgcn_permlane32_swap(__float_as_uint(d3), __float_as_uint(d7), false, false); e[3] = __uint_as_float(r3[0]) + __uint_as_float(r3[1]); }
  float f0, f1;
  { auto r0 = __builtin_amdgcn_permlane16_swap(__float_as_uint(e[0]), __float_as_uint(e[2]), false, false); f0 = __uint_as_float(r0[0]) + __uint_as_float(r0[1]);
    auto r1 = __builtin_amdgcn_permlane16_swap(__float_as_uint(e[1]), __float_as_uint(e[3]), false, false); f1 = __uint_as_float(r1[0]) + __uint_as_float(r1[1]); }
  const bool up = (lane & 8) != 0; const float keep = up ? f1 : f0, send = up ? f0 : f1;
  float g = keep + __shfl_xor(send, 8);
  g += __shfl_xor(g, 4); g += __shfl_xor(g, 2); g += __shfl_xor(g, 1);
  return g;
}
template <int NEXT>
__device__ void phase_peer_gather(const Params& p, int layer, char* smem) {
  const __amdgpu_buffer_rsrc_t rsU = __builtin_amdgcn_make_buffer_rsrc((void*)(p.U8 + (size_t)layer * 16384 * 1024), 0, 16384 * 1024, 0x00020000);
  const __amdgpu_buffer_rsrc_t rsV = __builtin_amdgcn_make_buffer_rsrc((void*)(p.V8 + (size_t)layer * 16384 * 1024), 0, 16384 * 1024, 0x00020000);
  for (int job = blockIdx.x; job < T / (8 * GT); job += gridDim.x) {
    int tid_ = threadIdx.x; asm volatile("" : "+v"(tid_));
    const int tid = tid_, wid = tid >> 6, lane = tid & 63;
    const int tb = (job * 8 + wid) * GT;
    const int vidx = 4 * (lane >> 5) + 2 * ((lane >> 4) & 1) + ((lane >> 3) & 1); const unsigned lane16 = (unsigned)lane * 16u;
    char* wl = smem + wid * GW_WAVE_BYTES; bf16_t* sx = (bf16_t*)wl; bf16_t* sidx = (bf16_t*)(wl + GT * 2048); float* sgate = (float*)(wl + GT * 2048 + GT * 256);
#pragma unroll 1
    for (int g = 0; g < GT; ++g) { const size_t t = (size_t)(tb + g);
      *(u32x4*)(sx + g * 1024 + lane * 16) = *(const u32x4*)(p.H + t * D + lane * 16); *(u32x4*)(sx + g * 1024 + lane * 16 + 8) = *(const u32x4*)(p.H + t * D + lane * 16 + 8);
      const int ia = p.pidx[t * 128 + lane], ib = p.pidx[t * 128 + 64 + lane]; const float ga = p.pgate[t * 128 + lane], gb = p.pgate[t * 128 + 64 + lane];
      const int wa = ia >> 10, wb = ib >> 10; int off = 0, pa = 0, pb = 0;
#pragma unroll
      for (int w = 0; w < 16; ++w) { const unsigned long long m0 = __ballot(wa == w), m1 = __ballot(wb == w); const int c0 = __popcll(m0), c1 = __popcll(m1);
        const int r0 = __builtin_amdgcn_mbcnt_hi((unsigned)(m0 >> 32), __builtin_amdgcn_mbcnt_lo((unsigned)m0, 0)), r1 = __builtin_amdgcn_mbcnt_hi((unsigned)(m1 >> 32), __builtin_amdgcn_mbcnt_lo((unsigned)m1, 0));
        if (wa == w) pa = off + r0; if (wb == w) pb = off + c0 + r1; off += c0 + c1; }
      sidx[g * 128 + pa] = (bf16_t)ia; sgate[g * 128 + pa] = ga; sidx[g * 128 + pb] = (bf16_t)ib; sgate[g * 128 + pb] = gb; }
    f32x2 acc[GT][8];
#pragma unroll
    for (int g = 0; g < GT; ++g)
#pragma unroll
      for (int i = 0; i < 8; ++i) acc[g][i] = (f32x2){0.f, 0.f};
#pragma unroll 1
    for (int hb = 0; hb < 16; ++hb) {
#pragma unroll
      for (int g = 0; g < GT; ++g) {
        const int myidx = (int)sidx[g * 128 + hb * 8 + (lane & 7)]; const float mygate = sgate[g * 128 + hb * 8 + vidx];
        const u32x4 h0 = *(const u32x4*)(sx + g * 1024 + lane * 16), h1 = *(const u32x4*)(sx + g * 1024 + lane * 16 + 8);
        const u32 hx[8] = {h0.x, h0.y, h0.z, h0.w, h1.x, h1.y, h1.z, h1.w};
        u32x4 ur[8], vr[8];
#pragma unroll
        for (int k = 0; k < 8; ++k) { const unsigned e = (unsigned)__builtin_amdgcn_readlane(myidx, k); ur[k] = __builtin_amdgcn_raw_buffer_load_b128(rsU, lane16, e * 1024u, 0); if (k < 4) vr[k] = __builtin_amdgcn_raw_buffer_load_b128(rsV, lane16, e * 1024u, 0); }
        float d[8];
#pragma unroll
        for (int k = 0; k < 8; ++k) { const u32 w[4] = {ur[k].x, ur[k].y, ur[k].z, ur[k].w}; float a = 0.f;
#pragma unroll
          for (int j = 0; j < 4; ++j) { const u32 lo = __builtin_bit_cast(u32, __builtin_amdgcn_cvt_scalef32_pk_bf16_fp8(w[j], 1.0f, false)), hi = __builtin_bit_cast(u32, __builtin_amdgcn_cvt_scalef32_pk_bf16_fp8(w[j], 1.0f, true));
            a = dot2bf(lo, hx[2 * j], a); a = dot2bf(hi, hx[2 * j + 1], a); }
          asm volatile("" : "+v"(a));
          d[k] = a; }
        asm volatile("" ::: "memory");
#pragma unroll
        for (int k = 4; k < 8; ++k) { const unsigned e = (unsigned)__builtin_amdgcn_readlane(myidx, k); vr[k] = __builtin_amdgcn_raw_buffer_load_b128(rsV, lane16, e * 1024u, 0); }
        const float z = reduce8(d[0], d[1], d[2], d[3], d[4], d[5], d[6], d[7], lane) * (1.f / U8_SCALE);
        const float cf = mygate * gelu_erf(z) * (1.f / V8_SCALE);
#pragma unroll
        for (int k = 0; k < 8; ++k) { const float ck = __uint_as_float(__builtin_amdgcn_readlane(__float_as_uint(cf), 32 * (k >> 2) + 16 * ((k >> 1) & 1) + 8 * (k & 1)));
          const u32 w[4] = {vr[k].x, vr[k].y, vr[k].z, vr[k].w}; const f32x2 c2 = (f32x2){ck, ck};
#pragma unroll
          for (int j = 0; j < 4; ++j) { const f32x2 lo = __builtin_amdgcn_cvt_pk_f32_fp8((int)w[j], false), hi = __builtin_amdgcn_cvt_pk_f32_fp8((int)w[j], true);
            acc[g][2 * j] = lo * c2 + acc[g][2 * j]; acc[g][2 * j + 1] = hi * c2 + acc[g][2 * j + 1]; } }
        asm volatile("" ::: "memory");
      }
      if ((hb & 3) == 3) __syncthreads();
    }
#pragma unroll
    for (int g = 0; g < GT; ++g) { const int t = tb + g, b = t / S;
      const float* g2 = p.mod + (size_t)(layer * 8 + b) * 6144 + 5120 + lane * 16; float* xp = p.X + (size_t)t * D + lane * 16;
      float xv[16]; float ss = 0.f;
#pragma unroll
      for (int q = 0; q < 4; ++q) { const f32x4 x0 = *(const f32x4*)(xp + 4 * q), g0 = *(const f32x4*)(g2 + 4 * q);
        xv[4 * q + 0] = x0.x + g0.x * acc[g][2 * q].x; xv[4 * q + 1] = x0.y + g0.y * acc[g][2 * q].y; xv[4 * q + 2] = x0.z + g0.z * acc[g][2 * q + 1].x; xv[4 * q + 3] = x0.w + g0.w * acc[g][2 * q + 1].y; }
#pragma unroll
      for (int i = 0; i < 16; ++i) ss += xv[i] * xv[i];
      ss = wave_sum(ss); const float r = rsqrtf(ss * (1.f / D) + EPS);
      if (NEXT == 0) {
        const float* ml = p.mod + (size_t)((layer + 1) * 8 + b) * 6144 + lane * 16; const float* gn = p.nmg + (layer + 1) * D + lane * 16; float y[16];
#pragma unroll
        for (int i = 0; i < 16; ++i) y[i] = xv[i] * r * gn[i] * (1.f + ml[1024 + i]) + ml[i];
#pragma unroll
        for (int q = 0; q < 4; ++q) *(f32x4*)(xp + 4 * q) = (f32x4){xv[4 * q], xv[4 * q + 1], xv[4 * q + 2], xv[4 * q + 3]};
        u32x4 w0, w1; w0.x = pack2(y[0], y[1]); w0.y = pack2(y[2], y[3]); w0.z = pack2(y[4], y[5]); w0.w = pack2(y[6], y[7]); w1.x = pack2(y[8], y[9]); w1.y = pack2(y[10], y[11]); w1.z = pack2(y[12], y[13]); w1.w = pack2(y[14], y[15]);
        *(u32x4*)(p.H + (size_t)t * D + lane * 16) = w0; *(u32x4*)(p.H + (size_t)t * D + lane * 16 + 8) = w1;
      } else {
        const float* fg = p.final_g + lane * 16;
#pragma unroll
        for (int q = 0; q < 4; ++q) *(f32x4*)(xp + 4 * q) = (f32x4){xv[4 * q] * r * fg[4 * q], xv[4 * q + 1] * r * fg[4 * q + 1], xv[4 * q + 2] * r * fg[4 * q + 2], xv[4 * q + 3] * r * fg[4 * q + 3]};
      }
      asm volatile("" ::: "memory");
    }
    __syncthreads();
  }
}

constexpr int PF_LIDX = 2 * 128 * 272, PF_LGATE = PF_LIDX + 32 * 128 * 2, PF_X = PF_LGATE + 32 * 128 * 4;
static_assert(PF_X + 8 * 8192 <= SMEM_BYTES - 16 && GT == 4, "fused PEER LDS layout");
template <int NEXT>
__device__ void phase_peer_fused(const Params& p, int layer, char* smem) {
  using namespace sel;
  bf16_t* const Lidx = (bf16_t*)(smem + PF_LIDX); float* const Lgate = (float*)(smem + PF_LGATE);
  const int tid0 = threadIdx.x;
  __syncthreads();
  { const bf16_t* kb = p.keysb + (size_t)layer * 32768;
    for (int i = tid0; i < 2 * 128 * 16; i += NTHREADS) { const int row = i >> 4, ch = i & 15; *(u32x4*)(smem + row * RS + ch * 16) = *(const u32x4*)(kb + (size_t)row * 128 + ch * 8); } }
  __syncthreads();
  const __amdgpu_buffer_rsrc_t rsU = __builtin_amdgcn_make_buffer_rsrc((void*)(p.U8 + (size_t)layer * 16384 * 1024), 0, 16384 * 1024, 0x00020000);
  const __amdgpu_buffer_rsrc_t rsV = __builtin_amdgcn_make_buffer_rsrc((void*)(p.V8 + (size_t)layer * 16384 * 1024), 0, 16384 * 1024, 0x00020000);
  for (int job = blockIdx.x; job < T / 32; job += gridDim.x) {
   {
    int tid_ = threadIdx.x; asm volatile("" : "+v"(tid_));
    const int tid = tid_, wid = tid >> 6, lane = tid & 63, l31 = lane & 31, hh = lane >> 5, h = wid;
    const int t = job * 32 + l31;
    float* const wl = (float*)(smem + PF_X + wid * 8192);
    float rs[2], s1[16], s2[16];
#pragma unroll
    for (int pp = 0; pp < 2; ++pp) {
      const bf16_t* qrow = p.QP + (size_t)t * 2048 + h * 256 + pp * 128 + hh * 8;
      bf16x8 bq[8]; float ssq = 0.f;
#pragma unroll
      for (int ks = 0; ks < 8; ++ks) { const u32x4 w = *(const u32x4*)(qrow + ks * 16); bq[ks] = __builtin_bit_cast(bf16x8, w);
        const u32 w0 = w.x, w1 = w.y, w2 = w.z, w3 = w.w; ssq = dot2bf(w0, w0, ssq); ssq = dot2bf(w1, w1, ssq); ssq = dot2bf(w2, w2, ssq); ssq = dot2bf(w3, w3, ssq); }
      ssq += xhalf(ssq); rs[pp] = rsqrtf(ssq * (1.f / 128.f) + EPS);
      f32x16 X[4];
#pragma unroll
      for (int nt = 0; nt < 4; ++nt) {
#pragma unroll
        for (int r = 0; r < 16; ++r) X[nt][r] = 0.f;
        const char* ka = smem + (pp * 128 + nt * 32 + l31) * RS + hh * 16;
#pragma unroll
        for (int ks = 0; ks < 8; ++ks) X[nt] = __builtin_amdgcn_mfma_f32_32x32x16_bf16(*(const bf16x8*)(ka + ks * 32), bq[ks], X[nt], 0, 0, 0); }
#pragma unroll
      for (int nt = 0; nt < 4; ++nt)
#pragma unroll
        for (int r = 0; r < 16; ++r) X[nt][r] = __uint_as_float((__float_as_uint(X[nt][r]) & ~0x7Fu) | (u32)(nt * 32 + (r & 3) + 8 * (r >> 2)) | ((u32)hh << 2));
      SORT16(X[0]); SORT16(X[1]); SORT16(X[2]); SORT16(X[3]);
#pragma unroll
      for (int i = 0; i < 16; ++i) { X[0][i] = fmaxf(X[0][i], X[1][15 - i]); X[2][i] = fmaxf(X[2][i], X[3][15 - i]); }
      BMERGE16(X[0]); BMERGE16(X[2]);
#pragma unroll
      for (int i = 0; i < 16; ++i) X[0][i] = fmaxf(X[0][i], X[2][15 - i]);
      BMERGE16(X[0]);
      f32x16 lo_, hi_;
#pragma unroll
      for (int i = 0; i < 16; ++i) { const u32 b_ = __float_as_uint(X[0][i]); auto r_ = __builtin_amdgcn_permlane32_swap(b_, b_, false, false); lo_[i] = __uint_as_float(r_[0]); hi_[i] = __uint_as_float(r_[1]); }
#pragma unroll
      for (int i = 0; i < 16; ++i) X[0][i] = fmaxf(lo_[i], hi_[15 - i]);
      BMERGE16(X[0]);
#pragma unroll
      for (int k = 0; k < 16; ++k) { wl[(pp * 16 + k) * 32 + l31] = X[0][k]; if (pp == 0) s1[k] = X[0][k] * rs[0]; else s2[k] = X[0][k] * rs[1]; }
    }
    constexpr int A0[25] = {0, 0, 0, 0, 0, 0, 0, 0, 0, 0, 0, 0, 0, 0, 0, 0, 2, 2, 2, 2, 2, 3, 3, 3, 3}, B0[25] = {0, 1, 2, 3, 4, 5, 6, 7, 8, 9, 10, 11, 12, 13, 14, 15, 0, 1, 2, 3, 4, 0, 1, 2, 3};
    constexpr int A1[25] = {1, 1, 1, 1, 1, 1, 1, 1, 4, 4, 4, 5, 5, 6, 6, 7, 7, 8, 9, 10, 11, 12, 13, 14, 15}, B1[25] = {0, 1, 2, 3, 4, 5, 6, 7, 0, 1, 2, 0, 1, 0, 1, 0, 1, 0, 0, 0, 0, 0, 0, 0, 0};
    float cd[25];
#pragma unroll
    for (int i = 0; i < 25; ++i) { const float v0 = s1[A0[i]] + s2[B0[i]], v1 = s1[A1[i]] + s2[B1[i]]; const float v = hh ? v1 : v0; const u32 cid = hh ? (u32)(A1[i] * 16 + B1[i]) : (u32)(A0[i] * 16 + B0[i]);
      cd[i] = __uint_as_float((__float_as_uint(v) & ~0xFFu) | cid); }
#pragma unroll 1
    for (int k = 0; k < 16; ++k) {
      float m = cd[24];
#pragma unroll
      for (int i = 0; i < 24; i += 2) m = max3(m, cd[i], cd[i + 1]);
      const float M = fmaxf(m, xhalf(m));
      wl[(32 + k) * 32 + l31] = M;
#pragma unroll
      for (int i = 0; i < 25; ++i) cd[i] = (cd[i] == M) ? NEG : cd[i];
    }
    float tv[16];
#pragma unroll
    for (int k = 0; k < 16; ++k) tv[k] = wl[(32 + k) * 32 + l31];
    float sum = 0.f;
#pragma unroll
    for (int k = 0; k < 16; ++k) sum += __expf(tv[k] - tv[0]);
    const float inv = 1.f / sum;
    u32 ev[8]; float go[8];
#pragma unroll
    for (int q = 0; q < 8; ++q) { const float v = wl[(32 + hh * 8 + q) * 32 + l31]; const u32 cid = __float_as_uint(v) & 0xFFu;
      const u32 i1 = __float_as_uint(wl[(cid >> 4) * 32 + l31]) & 0x7Fu, i2 = __float_as_uint(wl[(16 + (cid & 15)) * 32 + l31]) & 0x7Fu; ev[q] = i1 * 128 + i2;
      go[q] = __expf(v - tv[0]) * inv; }
    const u32 io0 = ev[0] | (ev[1] << 16), io1 = ev[2] | (ev[3] << 16), io2 = ev[4] | (ev[5] << 16), io3 = ev[6] | (ev[7] << 16);
    { const int ob = l31 * 128 + h * 16 + hh * 8;
      *(u32x4*)(Lidx + ob) = (u32x4){io0, io1, io2, io3};
      *(f32x4*)(Lgate + ob) = (f32x4){go[0], go[1], go[2], go[3]}; *(f32x4*)(Lgate + ob + 4) = (f32x4){go[4], go[5], go[6], go[7]}; }
   }
   __syncthreads();
   {
    int tid_ = threadIdx.x; asm volatile("" : "+v"(tid_));
    const int tid = tid_, wid = tid >> 6, lane = tid & 63;
    const int tb = (job * 8 + wid) * GT;
    const int vidx = 4 * (lane >> 5) + 2 * ((lane >> 4) & 1) + ((lane >> 3) & 1); const unsigned lane16 = (unsigned)lane * 16u;
    bf16_t* sx = (bf16_t*)(smem + PF_X + wid * 8192); bf16_t* sidx = Lidx + wid * GT * 128; float* sgate = Lgate + wid * GT * 128;
#pragma unroll 1
    for (int g = 0; g < GT; ++g) { const size_t t = (size_t)(tb + g);
      *(u32x4*)(sx + g * 1024 + lane * 16) = *(const u32x4*)(p.H + t * D + lane * 16); *(u32x4*)(sx + g * 1024 + lane * 16 + 8) = *(const u32x4*)(p.H + t * D + lane * 16 + 8);
      const int ia = sidx[g * 128 + lane], ib = sidx[g * 128 + 64 + lane]; const float ga = sgate[g * 128 + lane], gb = sgate[g * 128 + 64 + lane];
      const int wa = ia >> 10, wb = ib >> 10; int off = 0, pa = 0, pb = 0;
#pragma unroll
      for (int w = 0; w < 16; ++w) { const unsigned long long m0 = __ballot(wa == w), m1 = __ballot(wb == w); const int c0 = __popcll(m0), c1 = __popcll(m1);
        const int r0 = __builtin_amdgcn_mbcnt_hi((unsigned)(m0 >> 32), __builtin_amdgcn_mbcnt_lo((unsigned)m0, 0)), r1 = __builtin_amdgcn_mbcnt_hi((unsigned)(m1 >> 32), __builtin_amdgcn_mbcnt_lo((unsigned)m1, 0));
        if (wa == w) pa = off + r0; if (wb == w) pb = off + c0 + r1; off += c0 + c1; }
      sidx[g * 128 + pa] = (bf16_t)ia; sgate[g * 128 + pa] = ga; sidx[g * 128 + pb] = (bf16_t)ib; sgate[g * 128 + pb] = gb; }
    f32x2 acc[GT][8];
#pragma unroll
    for (int g = 0; g < GT; ++g)
#pragma unroll
      for (int i = 0; i < 8; ++i) acc[g][i] = (f32x2){0.f, 0.f};
#pragma unroll 1
    for (int hb = 0; hb < 16; ++hb) {
#pragma unroll
      for (int g = 0; g < GT; ++g) {
        const int myidx = (int)sidx[g * 128 + hb * 8 + (lane & 7)]; const float mygate = sgate[g * 128 + hb * 8 + vidx];
        const u32x4 h0 = *(const u32x4*)(sx + g * 1024 + lane * 16), h1 = *(const u32x4*)(sx + g * 1024 + lane * 16 + 8);
        const u32 hx[8] = {h0.x, h0.y, h0.z, h0.w, h1.x, h1.y, h1.z, h1.w};
        u32x4 ur[8], vr[8];
#pragma unroll
        for (int k = 0; k < 8; ++k) { const unsigned e = (unsigned)__builtin_amdgcn_readlane(myidx, k); ur[k] = __builtin_amdgcn_raw_buffer_load_b128(rsU, lane16, e * 1024u, 0); if (k < 4) vr[k] = __builtin_amdgcn_raw_buffer_load_b128(rsV, lane16, e * 1024u, 0); }
        float d[8];
#pragma unroll
        for (int k = 0; k < 8; ++k) { const u32 w[4] = {ur[k].x, ur[k].y, ur[k].z, ur[k].w}; float a = 0.f;
#pragma unroll
          for (int j = 0; j < 4; ++j) { const u32 lo = __builtin_bit_cast(u32, __builtin_amdgcn_cvt_scalef32_pk_bf16_fp8(w[j], 1.0f, false)), hi = __builtin_bit_cast(u32, __builtin_amdgcn_cvt_scalef32_pk_bf16_fp8(w[j], 1.0f, true));
            a = dot2bf(lo, hx[2 * j], a); a = dot2bf(hi, hx[2 * j + 1], a); }
          asm volatile("" : "+v"(a));
          d[k] = a; }
        asm volatile("" ::: "memory");
#pragma unroll
        for (int k = 4; k < 8; ++k) { const unsigned e = (unsigned)__builtin_amdgcn_readlane(myidx, k); vr[k] = __builtin_amdgcn_raw_buffer_load_b128(rsV, lane16, e * 1024u, 0); }
        const float z = reduce8(d[0], d[1], d[2], d[3], d[4], d[5], d[6], d[7], lane) * (1.f / U8_SCALE);
        const float cf = mygate * gelu_erf(z) * (1.f / V8_SCALE);
#pragma unroll
        for (int k = 0; k < 8; ++k) { const float ck = __uint_as_float(__builtin_amdgcn_readlane(__float_as_uint(cf), 32 * (k >> 2) + 16 * ((k >> 1) & 1) + 8 * (k & 1)));
          const u32 w[4] = {vr[k].x, vr[k].y, vr[k].z, vr[k].w}; const f32x2 c2 = (f32x2){ck, ck};
#pragma unroll
          for (int j = 0; j < 4; ++j) { const f32x2 lo = __builtin_amdgcn_cvt_pk_f32_fp8((int)w[j], false), hi = __builtin_amdgcn_cvt_pk_f32_fp8((int)w[j], true);
            acc[g][2 * j] = lo * c2 + acc[g][2 * j]; acc[g][2 * j + 1] = hi * c2 + acc[g][2 * j + 1]; } }
        asm volatile("" ::: "memory");
      }
      if ((hb & 3) == 3) __syncthreads();
    }
#pragma unroll
    for (int g = 0; g < GT; ++g) { const int t = tb + g, b = t / S;
      const float* g2 = p.mod + (size_t)(layer * 8 + b) * 6144 + 5120 + lane * 16; float* xp = p.X + (size_t)t * D + lane * 16;
      float xv[16]; float ss = 0.f;
#pragma unroll
      for (int q = 0; q < 4; ++q) { const f32x4 x0 = *(const f32x4*)(xp + 4 * q), g0 = *(const f32x4*)(g2 + 4 * q);
        xv[4 * q + 0] = x0.x + g0.x * acc[g][2 * q].x; xv[4 * q + 1] = x0.y + g0.y * acc[g][2 * q].y; xv[4 * q + 2] = x0.z + g0.z * acc[g][2 * q + 1].x; xv[4 * q + 3] = x0.w + g0.w * acc[g][2 * q + 1].y; }
#pragma unroll
      for (int i = 0; i < 16; ++i) ss += xv[i] * xv[i];
      ss = wave_sum(ss); const float r = rsqrtf(ss * (1.f / D) + EPS);
      if (NEXT == 0) {
        const float* ml = p.mod + (size_t)((layer + 1) * 8 + b) * 6144 + lane * 16; const float* gn = p.nmg + (layer + 1) * D + lane * 16; float y[16];
#pragma unroll
        for (int i = 0; i < 16; ++i) y[i] = xv[i] * r * gn[i] * (1.f + ml[1024 + i]) + ml[i];
#pragma unroll
        for (int q = 0; q < 4; ++q) *(f32x4*)(xp + 4 * q) = (f32x4){xv[4 * q], xv[4 * q + 1], xv[4 * q + 2], xv[4 * q + 3]};
        u32x4 w0, w1; w0.x = pack2(y[0], y[1]); w0.y = pack2(y[2], y[3]); w0.z = pack2(y[4], y[5]); w0.w = pack2(y[6], y[7]); w1.x = pack2(y[8], y[9]); w1.y = pack2(y[10], y[11]); w1.z = pack2(y[12], y[13]); w1.w = pack2(y[14], y[15]);
        *(u32x4*)(p.H + (size_t)t * D + lane * 16) = w0; *(u32x4*)(p.H + (size_t)t * D + lane * 16 + 8) = w1;
      } else {
        const float* fg = p.final_g + lane * 16;
#pragma unroll
        for (int q = 0; q < 4; ++q) *(f32x4*)(xp + 4 * q) = (f32x4){xv[4 * q] * r * fg[4 * q], xv[4 * q + 1] * r * fg[4 * q + 1], xv[4 * q + 2] * r * fg[4 * q + 2], xv[4 * q + 3] * r * fg[4 * q + 3]};
      }
      asm volatile("" ::: "memory");
    }
    __syncthreads();
   }
  }
}

template <bool WITH_GATES>
__device__ void phase_norm(const Params& p, const float* __restrict__ xin, const float* __restrict__ g, const float* __restrict__ modl, int sh_off, int sc_off, char* smem) {
  float* wg = (float*)smem;
  if (WITH_GATES) { __syncthreads(); for (int i = threadIdx.x; i < 16 * 1024; i += NTHREADS) wg[i] = p.Wg[i]; __syncthreads(); }
  for (int job = blockIdx.x; job < T / 32; job += gridDim.x) {
    int tid_ = threadIdx.x; asm volatile("" : "+v"(tid_));
    const int tid = tid_, wid = tid >> 6, lane = tid & 63; const int tb = job * 32 + wid * 4, b = tb / S;
    f32x4 v[4][4];
#pragma unroll
    for (int q = 0; q < 4; ++q)
#pragma unroll
      for (int i = 0; i < 4; ++i) v[q][i] = *(const f32x4*)(xin + (size_t)(tb + q) * D + i * 256 + lane * 4);
    const float* shp = modl + (size_t)b * 6144 + sh_off; const float* scp = modl + (size_t)b * 6144 + sc_off;
    f32x4 ga[4], gc[4];
#pragma unroll
    for (int i = 0; i < 4; ++i) { const int d = i * 256 + lane * 4; const f32x4 gg = *(const f32x4*)(g + d), s1 = *(const f32x4*)(scp + d); ga[i] = gg * (1.f + s1); gc[i] = *(const f32x4*)(shp + d); }
#pragma unroll
    for (int q = 0; q < 4; ++q) { float ss = 0.f;
#pragma unroll
      for (int i = 0; i < 4; ++i) ss += v[q][i].x * v[q][i].x + v[q][i].y * v[q][i].y + v[q][i].z * v[q][i].z + v[q][i].w * v[q][i].w;
      ss = wave_sum(ss); const float r = rsqrtf(ss * (1.f / D) + EPS);
#pragma unroll
      for (int i = 0; i < 4; ++i) { v[q][i] = v[q][i] * r * ga[i] + gc[i]; u32x2 w; w.x = pack2(v[q][i].x, v[q][i].y); w.y = pack2(v[q][i].z, v[q][i].w); *(u32x2*)(p.H + (size_t)(tb + q) * D + i * 256 + lane * 4) = w; }
      if (WITH_GATES) { float myg = 0.f;
#pragma unroll 2
        for (int gi = 0; gi < 16; ++gi) { float a = 0.f;
#pragma unroll
          for (int i = 0; i < 4; ++i) { const f32x4 w4 = *(const f32x4*)(wg + gi * 1024 + i * 256 + lane * 4); a += v[q][i].x * w4.x + v[q][i].y * w4.y + v[q][i].z * w4.z + v[q][i].w * w4.w; }
          a = wave_sum(a); if (lane == gi) myg = a; }
        if (lane < 16) p.gates[(size_t)(tb + q) * 16 + lane] = myg + p.ev_b_in[2560 + lane]; }
    }
  }
}
__device__ void phase_cat(const Params& p) {
  for (int job = blockIdx.x; job < T / 32; job += gridDim.x) {
    int tid_ = threadIdx.x; asm volatile("" : "+v"(tid_));
    const int tid = tid_, wid = tid >> 6, lane = tid & 63; const int tb = job * 32 + wid * 4;
    u32x4 a[4], bq[4], so[4];
#pragma unroll
    for (int q = 0; q < 4; ++q) { const size_t o = (size_t)(tb + q) * 512 + lane * 8; a[q] = *(const u32x4*)(p.HS + o); bq[q] = *(const u32x4*)(p.HS + (size_t)T * 512 + o); so[q] = *(const u32x4*)(p.ZO + o); }
    const f32x4 g0 = *(const f32x4*)(p.mnorm_g + lane * 8), g1 = *(const f32x4*)(p.mnorm_g + lane * 8 + 4);
#pragma unroll
    for (int q = 0; q < 4; ++q) { float x[8]; const u32 aw[4] = {a[q].x, a[q].y, a[q].z, a[q].w}, bw[4] = {bq[q].x, bq[q].y, bq[q].z, bq[q].w}, sw[4] = {so[q].x, so[q].y, so[q].z, so[q].w};
      float ss = 0.f;
#pragma unroll
      for (int j = 0; j < 4; ++j) { x[2 * j] = bflo(aw[j]) + bflo(bw[j]); x[2 * j + 1] = bfhi(aw[j]) + bfhi(bw[j]); ss += x[2 * j] * x[2 * j] + x[2 * j + 1] * x[2 * j + 1]; }
      ss += __shfl_xor(ss, 1); ss += __shfl_xor(ss, 2); ss += __shfl_xor(ss, 4); ss += __shfl_xor(ss, 8);
      const float r = rsqrtf(ss * (1.f / 128.f) + EPS);
      u32x4 w; w.x = pack2(x[0] * r * g0.x * bflo(sw[0]), x[1] * r * g0.y * bfhi(sw[0])); w.y = pack2(x[2] * r * g0.z * bflo(sw[1]), x[3] * r * g0.w * bfhi(sw[1]));
      w.z = pack2(x[4] * r * g1.x * bflo(sw[2]), x[5] * r * g1.y * bfhi(sw[2])); w.w = pack2(x[6] * r * g1.z * bflo(sw[3]), x[7] * r * g1.w * bfhi(sw[3]));
      *(u32x4*)(p.CAT + (size_t)(tb + q) * 1024 + lane * 8) = w; }
  }
}
__device__ void phase_qkrope(const Params& p, char* smem) {
  float* tab = (float*)smem;
  __syncthreads();
  for (int i = threadIdx.x; i < 64 * 32; i += NTHREADS) { const int pos = i >> 5, fi = i & 31; const float fr = exp2f(-(float)(2 * fi) * (13.287712379549449f / 64.f)); float sn, cs; sincosf((float)pos * fr, &sn, &cs); tab[2 * i] = cs; tab[2 * i + 1] = sn; }
  __syncthreads();
  for (int job = blockIdx.x; job < T / 16; job += gridDim.x) {
    int tid_ = threadIdx.x; asm volatile("" : "+v"(tid_));
    const int tid = tid_, wid = tid >> 6, lane = tid & 63; const int tb = job * 16 + wid * 2;
    u32x4 raw[2][3];
#pragma unroll
    for (int q = 0; q < 2; ++q)
#pragma unroll
      for (int i = 0; i < 3; ++i) raw[q][i] = *(const u32x4*)(p.QKV + (size_t)(tb + q) * 1536 + (lane + 64 * i) * 8);
#pragma unroll
    for (int q = 0; q < 2; ++q) { const int t = tb + q, b = t / S, s = t & (S - 1);
#pragma unroll
      for (int i = 0; i < 3; ++i) { const int c = lane + 64 * i, hh = c >> 4, cc = c & 15; float x[8]; const u32 rw[4] = {raw[q][i].x, raw[q][i].y, raw[q][i].z, raw[q][i].w};
#pragma unroll
        for (int j = 0; j < 4; ++j) { x[2 * j] = bflo(rw[j]); x[2 * j + 1] = bfhi(rw[j]); }
        u32x4 w;
        if (hh < 10) { float ss = 0.f;
#pragma unroll
          for (int j = 0; j < 8; ++j) ss += x[j] * x[j];
          ss += __shfl_xor(ss, 1); ss += __shfl_xor(ss, 2); ss += __shfl_xor(ss, 4); ss += __shfl_xor(ss, 8);
          const float r = rsqrtf(ss * (1.f / 128.f) + EPS); const float* gp = (hh < 8 ? p.qn_g : p.kn_g) + cc * 8;
          const int pos = cc < 8 ? (s >> 6) : (s & 63); const float* tp = tab + (pos * 32 + (cc & 7) * 4) * 2; float y[8];
#pragma unroll
          for (int j = 0; j < 4; ++j) { const float x0 = x[2 * j] * r * gp[2 * j], x1 = x[2 * j + 1] * r * gp[2 * j + 1], cs = tp[2 * j], sn = tp[2 * j + 1]; y[2 * j] = x0 * cs - x1 * sn; y[2 * j + 1] = x0 * sn + x1 * cs; }
          w.x = pack2(y[0], y[1]); w.y = pack2(y[2], y[3]); w.z = pack2(y[4], y[5]); w.w = pack2(y[6], y[7]);
        } else w = raw[q][i];
        bf16_t* dst = hh < 8 ? p.Qh + (((size_t)b * 8 + hh) * S + s) * 128 : (hh < 10 ? p.Kh + (((size_t)b * 2 + hh - 8) * S + s) * 128 : p.Vh + (((size_t)b * 2 + hh - 10) * S + s) * 128);
        *(u32x4*)(dst + cc * 8) = w; }
    }
  }
}

__device__ void phase_attn_naive(const Params& p) {
  const int tid = threadIdx.x, wid = tid >> 6, lane = tid & 63;
  for (int job = blockIdx.x; job < T * 2 / 8; job += gridDim.x) {
    const int w = job * 8 + wid, kv = w & 1, t = w >> 1, b = t / S, s = t & (S - 1);
    float q0[4], q1[4], m[4], l[4], o0[4], o1[4];
#pragma unroll
    for (int g = 0; g < 4; ++g) { const u32 qq = *(const u32*)(p.Qh + (((size_t)b * 8 + kv * 4 + g) * S + s) * 128 + lane * 2); q0[g] = bflo(qq); q1[g] = bfhi(qq); m[g] = -1e30f; l[g] = 0.f; o0[g] = 0.f; o1[g] = 0.f; }
    const bf16_t* Kb = p.Kh + ((size_t)b * 2 + kv) * S * 128; const bf16_t* Vb = p.Vh + ((size_t)b * 2 + kv) * S * 128;
    for (int k = 0; k < S; ++k) { const u32 kk = *(const u32*)(Kb + (size_t)k * 128 + lane * 2), vv = *(const u32*)(Vb + (size_t)k * 128 + lane * 2);
      const float k0 = bflo(kk), k1 = bfhi(kk), v0 = bflo(vv), v1 = bfhi(vv);
#pragma unroll
      for (int g = 0; g < 4; ++g) { const float sc = wave_sum(q0[g] * k0 + q1[g] * k1) * KSCALE; const float mn = fmaxf(m[g], sc), al = __expf(m[g] - mn), pw = __expf(sc - mn);
        l[g] = l[g] * al + pw; o0[g] = o0[g] * al + pw * v0; o1[g] = o1[g] * al + pw * v1; m[g] = mn; } }
#pragma unroll
    for (int g = 0; g < 4; ++g) *(u32*)(p.CAT + (size_t)t * 1024 + (kv * 4 + g) * 128 + lane * 2) = pack2(o0[g] / l[g], o1[g] / l[g]);
  }
}

namespace att {
using bf16 = unsigned short;
constexpr int   D = 128, NW = 8, QBLK = 32, KVBLK = 64;
constexpr float SCALE = 0.088388347648318440f;
constexpr float THR = 8.f;
constexpr int SDEPTH = 2;
constexpr int LDQ = 128, LDK = 128, LDO = 1024;
constexpr size_t SHM_V = KVBLK * D * 2, SHM_K = KVBLK * D * 2, SHM_ATTN = 2 * SHM_V + 2 * SHM_K + NW * 64 * 4;
using bf16x8 = __attribute__((ext_vector_type(8))) short;
using s16x4  = __attribute__((ext_vector_type(4))) short;
using f32x16 = __attribute__((ext_vector_type(16))) float;
using f32x8  = __attribute__((ext_vector_type(8))) float;
using u32x4  = __attribute__((ext_vector_type(4))) unsigned;
#define KSWZ(row, colB) ((row) * 256 + ((colB) ^ (((row) & 7) << 4)))
#define SBAR() __builtin_amdgcn_sched_barrier(0)
__device__ __forceinline__ int crow(int r, int hi) { return (r & 3) + 8 * (r >> 2) + 4 * hi; }
__device__ __forceinline__ unsigned cvtpk(float lo, float hi) {
  unsigned r; asm volatile("v_cvt_pk_bf16_f32 %0, %1, %2" : "=v"(r) : "v"(lo), "v"(hi)); return r;
}
template <typename TIn> struct Stage;
template <> struct Stage<bf16>  { using T = bf16x8;
  __device__ static __forceinline__ T ld8(const bf16* p) { return *reinterpret_cast<const bf16x8*>(p); }
  __device__ static __forceinline__ bf16x8 tobf(T x) { return x; } };
template <> struct Stage<float> { using T = f32x8;
  __device__ static __forceinline__ T ld8(const float* p) { return *reinterpret_cast<const f32x8*>(p); }
  __device__ static __forceinline__ bf16x8 tobf(T x) {
    u32x4 w = {cvtpk(x[0], x[1]), cvtpk(x[2], x[3]), cvtpk(x[4], x[5]), cvtpk(x[6], x[7])}; return *reinterpret_cast<bf16x8*>(&w); } };

__device__ __forceinline__ void partialSM(f32x16& p0, f32x16& p1, float& m_reg, float& mn, float& alpha) {
  constexpr float C = SCALE * 1.4426950408889634f;
  float pmax = p0[0]; for (int r = 1; r < 16; ++r) pmax = fmaxf(pmax, p0[r]); for (int r = 0; r < 16; ++r) pmax = fmaxf(pmax, p1[r]);
  { auto rr = __builtin_amdgcn_permlane32_swap(__float_as_uint(pmax), __float_as_uint(pmax), false, false);
    pmax = fmaxf(__uint_as_float(rr[0]), __uint_as_float(rr[1])); }
  if (__builtin_expect(__all(pmax - m_reg <= THR / SCALE), 1)) { mn = m_reg; alpha = 1.f; }
  else { mn = fmaxf(m_reg, pmax); alpha = __builtin_amdgcn_exp2f((m_reg - mn) * C); m_reg = mn; }
  float mnC = -mn * C;
  for (int r = 0; r < 16; ++r) p0[r] = fmaf(p0[r], C, mnC); for (int r = 0; r < 16; ++r) p1[r] = fmaf(p1[r], C, mnC);
  for (int r = 0; r < 16; ++r) p0[r] = __builtin_amdgcn_exp2f(p0[r]);
}
__device__ __forceinline__ void finishSM(f32x16& p0, f32x16& p1, float alpha, float& l_reg, bf16x8& pa0, bf16x8& pa1, bf16x8& pa2, bf16x8& pa3) {
  for (int r = 0; r < 16; ++r) p1[r] = __builtin_amdgcn_exp2f(p1[r]);
  float ps = 0; for (int r = 0; r < 16; ++r) ps += p0[r]; for (int r = 0; r < 16; ++r) ps += p1[r];
  { auto rr = __builtin_amdgcn_permlane32_swap(__float_as_uint(ps), __float_as_uint(ps), false, false);
    ps = __uint_as_float(rr[0]) + __uint_as_float(rr[1]); }
  l_reg = l_reg * alpha + ps;
#define PK4(P, BASE, OUT) do { unsigned a0 = cvtpk(P[BASE + 0], P[BASE + 1]), a1 = cvtpk(P[BASE + 2], P[BASE + 3]);   \
    unsigned b0 = cvtpk(P[BASE + 4], P[BASE + 5]), b1 = cvtpk(P[BASE + 6], P[BASE + 7]);                              \
    auto r0 = __builtin_amdgcn_permlane32_swap(a0, b0, false, false); auto r1 = __builtin_amdgcn_permlane32_swap(a1, b1, false, false); \
    u32x4 w = {r0[0], r1[0], r0[1], r1[1]}; OUT = *reinterpret_cast<bf16x8*>(&w); } while (0)
  PK4(p0, 0, pa0); PK4(p0, 8, pa1); PK4(p1, 0, pa2); PK4(p1, 8, pa3);
#undef PK4
}
__device__ __forceinline__ void qkt(f32x16& p0, f32x16& p1, const bf16* Ks, const bf16x8* qr, int r32, int hi) {
  p0 = f32x16{}; p1 = f32x16{};
  for (int d0 = 0; d0 < 8; ++d0) { int cb = (d0 * 16 + hi * 8) * 2;
    bf16x8 b0 = *reinterpret_cast<const bf16x8*>((const char*)Ks + KSWZ(r32, cb));
    bf16x8 b1 = *reinterpret_cast<const bf16x8*>((const char*)Ks + KSWZ(32 + r32, cb));
    p0 = __builtin_amdgcn_mfma_f32_32x32x16_bf16(b0, qr[d0], p0, 0, 0, 0);
    p1 = __builtin_amdgcn_mfma_f32_32x32x16_bf16(b1, qr[d0], p1, 0, 0, 0); }
}
__device__ __forceinline__ int v_st(int k, int c) { const int kk = (k & ~0xC) | ((k & 4) << 1) | ((k & 8) >> 1); return ((kk >> 3) * 4 + (c >> 5)) * 512 + ((kk & 7) * 32 + (c & 31)) * 2; }
__device__ __forceinline__ int v_rd_base(int lane) { return ((lane & 3) << 3) | (((lane >> 2) & 3) << 6) | (((lane >> 4) & 1) << 5) | (((lane >> 5) & 1) << 8); }
constexpr int v_rd_off(int d0, int ks, int half) { return d0 * 512 + ks * 4096 + half * 2048; }
template <int OFF> __device__ __forceinline__ s16x4 tr_read(int vb) {
  s16x4 r; asm volatile("ds_read_b64_tr_b16 %0, %1 offset:%2" : "=&v"(r) : "v"(vb), "i"(OFF) : "memory"); return r;
}
template <int D0> __device__ __forceinline__ void pv_one(f32x16& od, int vb, bf16x8 pa0, bf16x8 pa1, bf16x8 pa2, bf16x8 pa3) {
  const s16x4 l0 = tr_read<v_rd_off(D0, 0, 0)>(vb), h0 = tr_read<v_rd_off(D0, 0, 1)>(vb), l1 = tr_read<v_rd_off(D0, 1, 0)>(vb), h1 = tr_read<v_rd_off(D0, 1, 1)>(vb);
  const s16x4 l2 = tr_read<v_rd_off(D0, 2, 0)>(vb), h2 = tr_read<v_rd_off(D0, 2, 1)>(vb), l3 = tr_read<v_rd_off(D0, 3, 0)>(vb), h3 = tr_read<v_rd_off(D0, 3, 1)>(vb);
  asm volatile("s_waitcnt lgkmcnt(0)" ::: "memory"); SBAR();
#define PK(L, H) (bf16x8){L[0], L[1], L[2], L[3], H[0], H[1], H[2], H[3]}
  od = __builtin_amdgcn_mfma_f32_32x32x16_bf16(pa0, PK(l0, h0), od, 0, 0, 0);
  od = __builtin_amdgcn_mfma_f32_32x32x16_bf16(pa1, PK(l1, h1), od, 0, 0, 0);
  od = __builtin_amdgcn_mfma_f32_32x32x16_bf16(pa2, PK(l2, h2), od, 0, 0, 0);
  od = __builtin_amdgcn_mfma_f32_32x32x16_bf16(pa3, PK(l3, h3), od, 0, 0, 0);
#undef PK
}
__device__ __forceinline__ void pv_d0(f32x16* o, int vb, bf16x8 pa0, bf16x8 pa1, bf16x8 pa2, bf16x8 pa3) {
  pv_one<0>(o[0], vb, pa0, pa1, pa2, pa3); pv_one<1>(o[1], vb, pa0, pa1, pa2, pa3); pv_one<2>(o[2], vb, pa0, pa1, pa2, pa3); pv_one<3>(o[3], vb, pa0, pa1, pa2, pa3);
}

template <typename TQ>
__device__ __forceinline__ void attn_dense_body(const TQ* __restrict__ Qb, const bf16* __restrict__ Kh, const bf16* __restrict__ Vh,
                                                bf16* __restrict__ Ob, int seq, char* lds) {
  using St = Stage<bf16>; using SQ = Stage<TQ>;
  int tid_ = threadIdx.x; asm volatile("" : "+v"(tid_)); const int tid = tid_, wid = tid >> 6, lane = tid & 63, r32 = lane & 31, hi = lane >> 5;
  bf16* V_lds = (bf16*)lds; bf16* K_lds = (bf16*)(lds + 2 * SHM_V);
  float* ws = (float*)(lds + 2 * SHM_V + 2 * SHM_K) + wid * 64; float* li_l = ws; float* al_l = ws + 32;
  float m_reg = -1e30f, l_reg = 0; f32x16 o[4] = {}; bf16x8 qr[8];
  const TQ* Qw = Qb + (long)(wid * QBLK + r32) * LDQ + hi * 8;
#pragma unroll
  for (int d0 = 0; d0 < 8; ++d0) qr[d0] = SQ::tobf(SQ::ld8(Qw + d0 * 16));
  const int sr = tid >> 4, sc = (tid & 15) * 8, vst0 = v_st(sr, sc), vst1 = v_st(32 + sr, sc);
  const int vb0 = (int)(uintptr_t)V_lds + v_rd_base(lane);
  struct { typename St::T vs0, vs1, ks0, ks1; } sr_[SDEPTH];
#define SLOAD(i, k0) do { sr_[i].vs0 = St::ld8(&Vh[(long)((k0) + sr) * LDK + sc]); sr_[i].vs1 = St::ld8(&Vh[(long)((k0) + 32 + sr) * LDK + sc]); \
    sr_[i].ks0 = St::ld8(&Kh[(long)((k0) + sr) * LDK + sc]); sr_[i].ks1 = St::ld8(&Kh[(long)((k0) + 32 + sr) * LDK + sc]); } while (0)
#define SWRITE(b, i) do { *(bf16x8*)((char*)V_lds + (b) * SHM_V + vst0) = St::tobf(sr_[i].vs0);          \
    *(bf16x8*)((char*)V_lds + (b) * SHM_V + vst1) = St::tobf(sr_[i].vs1); int kc = sc * 2;               \
    *(bf16x8*)((char*)K_lds + (b) * SHM_K + KSWZ(sr, kc)) = St::tobf(sr_[i].ks0);                       \
    *(bf16x8*)((char*)K_lds + (b) * SHM_K + KSWZ(32 + sr, kc)) = St::tobf(sr_[i].ks1); } while (0)
#define SWAIT() do { if constexpr (SDEPTH == 2) asm volatile("s_waitcnt vmcnt(4)" ::: "memory"); else asm volatile("s_waitcnt vmcnt(0)" ::: "memory"); } while (0)
#define RESC(a) do { if (__any((a) < 1.f)) { if (hi == 0) al_l[r32] = (a); asm volatile("s_waitcnt lgkmcnt(0)" ::: "memory"); \
    for (int d = 0; d < 4; ++d) for (int r = 0; r < 16; ++r) o[d][r] *= al_l[crow(r, hi)]; } } while (0)
  f32x16 pA0, pA1, pB0, pB1; float mnA, mnB, alA, alB; bf16x8 pa0, pa1, pa2, pa3; const int NT = seq / KVBLK;
  constexpr int SE = 0, SO = SDEPTH - 1;
  SLOAD(SE, 0); asm volatile("s_waitcnt vmcnt(0)" ::: "memory"); SWRITE(0, SE); __syncthreads();
  qkt(pA0, pA1, K_lds, qr, r32, hi); partialSM(pA0, pA1, m_reg, mnA, alA);
  SLOAD(SO, KVBLK); if constexpr (SDEPTH == 2) { if (2 < NT) SLOAD(SE, 2 * KVBLK); }
  SWAIT(); SWRITE(1, SO); __syncthreads();
  for (int j = 1; j + 1 < NT; j += 2) {
    SBAR(); qkt(pB0, pB1, (bf16*)((char*)K_lds + SHM_K), qr, r32, hi);
    finishSM(pA0, pA1, alA, l_reg, pa0, pa1, pa2, pa3); SBAR();
    SLOAD(SO, (j + SDEPTH) * KVBLK); SBAR();
    pv_d0(o, vb0, pa0, pa1, pa2, pa3); partialSM(pB0, pB1, m_reg, mnB, alB);
    __syncthreads(); SWAIT(); SWRITE(0, SE);
    RESC(alB); __syncthreads();
    SBAR(); qkt(pA0, pA1, K_lds, qr, r32, hi);
    finishSM(pB0, pB1, alB, l_reg, pa0, pa1, pa2, pa3); SBAR();
    if (SDEPTH == 1 || j + 3 < NT) SLOAD(SE, (j + 1 + SDEPTH) * KVBLK); SBAR();
    pv_d0(o, vb0 + (int)SHM_V, pa0, pa1, pa2, pa3); partialSM(pA0, pA1, m_reg, mnA, alA);
    __syncthreads(); SWAIT(); SWRITE(1, SO);
    RESC(alA); __syncthreads();
  }
  SBAR(); qkt(pB0, pB1, (bf16*)((char*)K_lds + SHM_K), qr, r32, hi);
  finishSM(pA0, pA1, alA, l_reg, pa0, pa1, pa2, pa3); SBAR();
  pv_d0(o, vb0, pa0, pa1, pa2, pa3); partialSM(pB0, pB1, m_reg, mnB, alB);
  __syncthreads(); RESC(alB);
  finishSM(pB0, pB1, alB, l_reg, pa0, pa1, pa2, pa3); SBAR();
  pv_d0(o, vb0 + (int)SHM_V, pa0, pa1, pa2, pa3);
  if (hi == 0) li_l[r32] = l_reg; asm volatile("s_waitcnt lgkmcnt(0)" ::: "memory");
  float rli[16];
#pragma unroll
  for (int r = 0; r < 16; ++r) rli[r] = __builtin_amdgcn_rcpf(li_l[crow(r, hi)]);
  __syncthreads();
  bf16* Ol = (bf16*)lds + wid * (QBLK * D);
#pragma unroll
  for (int r = 0; r < 16; ++r) { const int orow = crow(r, hi);
#pragma unroll
    for (int d0 = 0; d0 < 4; ++d0) { const float v = o[d0][r] * rli[r]; unsigned u = __float_as_uint(v); u += 0x7FFFu + ((u >> 16) & 1u); Ol[orow * D + d0 * 32 + r32] = (bf16)(u >> 16); } }
  asm volatile("s_waitcnt lgkmcnt(0)" ::: "memory");
#pragma unroll
  for (int i = 0; i < 8; ++i) { const int row = i * 4 + (lane >> 4), ch = (lane & 15) * 8;
    const u32x4 v = *reinterpret_cast<const u32x4*>(Ol + row * D + ch);
    *reinterpret_cast<u32x4*>(Ob + (long)(wid * QBLK + row) * LDO + ch) = v; }
  __syncthreads();
#undef SLOAD
#undef SWRITE
#undef SWAIT
#undef RESC
}

}

__device__ void phase_attn(const Params& p, char* smem) {
  const int G = (int)gridDim.x, c = (int)blockIdx.x;
  for (int i = 0; i * G + c < 1024; ++i) {
    int pair, j;
    if (G == 256) { pair = 2 * (c & 7) + (i >> 1); j = (i & 1) * 32 + (c >> 3); } else { const int L = i * G + c; pair = L >> 6; j = L & 63; }
    const int b = pair >> 1, kv = pair & 1, qb = j >> 2, g = j & 3, h = kv * 4 + g;
    const bf16_t* Qb = p.Qh + (((size_t)b * 8 + h) * S + qb * 256) * 128; const bf16_t* Kp = p.Kh + ((size_t)b * 2 + kv) * S * 128; const bf16_t* Vp = p.Vh + ((size_t)b * 2 + kv) * S * 128;
    bf16_t* Ob = p.CAT + ((size_t)b * S + qb * 256) * 1024 + h * 128;
    att::attn_dense_body<att::bf16>(Qb, Kp, Vp, Ob, S, smem);
  }
}

#define XB_TMO      128
#define XB_XCNT(j)  (256  + 64 * (j))
#define XB_XSUB(j)  (1280 + 64 * (j))
#define XB_XGEN(j)  (2304 + 64 * (j))
#define XB_TOP      3328
#define XB_TOPGEN   3392
#define XCD_BAR_WORDS 3456
#define XB_SPIN_CAP (1u << 18)
#define LAS __attribute__((address_space(3)))

__device__ __forceinline__ unsigned xb_ld(unsigned* p)              { return __hip_atomic_load(p, __ATOMIC_RELAXED, __HIP_MEMORY_SCOPE_AGENT); }
__device__ __forceinline__ unsigned xb_add(unsigned* p, unsigned v) { return __hip_atomic_fetch_add(p, v, __ATOMIC_RELAXED, __HIP_MEMORY_SCOPE_AGENT); }
__device__ __forceinline__ unsigned xb_xcc_id() { return (unsigned)__builtin_amdgcn_s_getreg((3 << 11) | 20) & 0xFu; }
#define XB_SPIN(cond, bar) do { unsigned _sp = 0; while (cond) { __builtin_amdgcn_s_sleep(1); \
    if ((++_sp & 255u) == 0u) { if (xb_ld(&(bar)[XB_TMO])) break; if (_sp > XB_SPIN_CAP) { atomicAdd(&(bar)[XB_TMO], 1u); break; } } } } while (0)

struct XcdBarrier {
    unsigned* bar; unsigned x;
    volatile LAS unsigned* st;
};

__device__ __forceinline__ XcdBarrier xcd_barrier_post(unsigned* bar, volatile LAS unsigned* st) {
    XcdBarrier b; b.bar = bar; b.x = xb_xcc_id(); b.st = st;
    if (threadIdx.x == 0) (void)xb_add(&bar[XB_XCNT(b.x)], 1u);
    return b;
}
__device__ __forceinline__ void xcd_barrier_complete(unsigned* bar, unsigned x, unsigned& nloc, unsigned& nx) {
    const unsigned G = gridDim.x * gridDim.y * gridDim.z;
    unsigned sum, cnt, mine, sp = 0u;
    for (;;) {
        sum = 0u; cnt = 0u; mine = 0u;
#pragma unroll
        for (unsigned j = 0; j < 16; ++j) { const unsigned c = xb_ld(&bar[XB_XCNT(j)]); sum += c; cnt += (c > 0u) ? 1u : 0u; mine = (j == x) ? c : mine; }
        if (sum == G) break;
        __builtin_amdgcn_s_sleep(1);
        if ((++sp & 255u) == 0u) { if (xb_ld(&bar[XB_TMO])) break; if (sp > XB_SPIN_CAP) { atomicAdd(&bar[XB_TMO], 1u); break; } }
    }
    nloc = mine > 0u ? mine : 1u; nx = cnt > 0u ? cnt : 1u;
}

__device__ __forceinline__ void xcd_barrier(const XcdBarrier& b) {
    asm volatile("s_waitcnt vmcnt(0)" ::: "memory");
    __syncthreads();
    if (threadIdx.x == 0) {
        unsigned* bar = b.bar;
        __builtin_amdgcn_s_waitcnt(0);
        unsigned nloc = b.st[0], nx = b.st[1];
        if (nloc == 0u) { xcd_barrier_complete(bar, b.x, nloc, nx); b.st[0] = nloc; b.st[1] = nx; }
        const unsigned old = xb_add(&bar[XB_XSUB(b.x)], 1u);
        const unsigned gen = old / nloc;
        if (old + 1u == (gen + 1u) * nloc) {
            __builtin_amdgcn_fence(__ATOMIC_RELEASE, "agent");
            asm volatile("s_waitcnt vmcnt(0)" ::: "memory");
            const unsigned og = xb_add(&bar[XB_TOP], 1u);
            const unsigned tg = og / nx;
            if (og + 1u == (tg + 1u) * nx) xb_add(&bar[XB_TOPGEN], 1u);
            else XB_SPIN(xb_ld(&bar[XB_TOPGEN]) == tg, bar);
            __builtin_amdgcn_fence(__ATOMIC_ACQUIRE, "agent");
            xb_add(&bar[XB_XGEN(b.x)], 1u);
            asm volatile("s_waitcnt vmcnt(0)" ::: "memory");
        } else {
            XB_SPIN(xb_ld(&bar[XB_XGEN(b.x)]) == gen, bar);
            __builtin_amdgcn_fence(__ATOMIC_ACQUIRE, "agent");
            asm volatile("s_waitcnt vmcnt(0)" ::: "memory");
        }
    }
    __syncthreads();
}


constexpr int NPH = 19;
__global__ __launch_bounds__(NTHREADS, 2) void mega(Params p, int ph0, int ph1) {
  extern __shared__ __attribute__((aligned(16))) char smem[];
  cg::grid_group grid = cg::this_grid();
  volatile LAS unsigned* xst = (volatile LAS unsigned*)(LAS char*)(smem + SMEM_BYTES - 16);
  if (threadIdx.x == 0) { xst[0] = 0u; xst[1] = 0u; }
  __syncthreads();
  const XcdBarrier xb = xcd_barrier_post(p.bar, xst);
#ifndef REP_MASK
#define REP_MASK 0
#endif
#define GSYNC(k) do { if ((k) == 1) grid.sync(); else xcd_barrier(xb); } while (0)
#define PHASE(k, call) if (ph0 <= (k) && (k) < ph1) { if ((k) > ph0) GSYNC(k); if ((REP_MASK >> (k)) & 1) { { call; } xcd_barrier(xb); } call; }
#if !defined(ONLY_PHASE) || ONLY_PHASE == 0
  PHASE(0, phase_prep(p, smem))
#endif
#if !defined(ONLY_PHASE) || ONLY_PHASE == 1
  PHASE(1, phase_norm<true>(p, p.x, p.nmg, p.mod, 0, 1024, smem))
#endif
#if !defined(ONLY_PHASE) || ONLY_PHASE == 2
  PHASE(2, phase_gemm_fast(p.H, p.Wt_evin, T, 2560, 1024, (EpiEvin{p.ZQK, p.ZV, p.ZO, p.ZP, p.ev_b_in}), smem))
#endif
#if !defined(ONLY_PHASE) || ONLY_PHASE == 3
  PHASE(3, cp::phase_convpool(p, smem))
#endif
#if !defined(ONLY_PHASE) || ONLY_PHASE == 4
  PHASE(4, ml::phase_mlstm(p, smem))
#endif
#if !defined(ONLY_PHASE) || ONLY_PHASE == 5
  PHASE(5, phase_cat(p))
#endif
#if !defined(ONLY_PHASE) || ONLY_PHASE == 6
  PHASE(6, phase_gemm_fast(p.CAT, p.Wt_evout, T, 1024, 1024, (EpiRes{p.x, p.X, p.mod + 2048}), smem))
#endif
#if !defined(ONLY_PHASE) || ONLY_PHASE == 7
  PHASE(7, phase_norm<false>(p, p.X, p.nfg, p.mod, 3072, 4096, smem))
#endif
#if !defined(ONLY_PHASE) || ONLY_PHASE == 8
  PHASE(8, phase_gemm_fast(p.H, p.Wt_q, T, 2048, 1024, (EpiPlain{p.QP, 2048}), smem))
#endif
#if !defined(ONLY_PHASE) || ONLY_PHASE == 9
#endif
#if !defined(ONLY_PHASE) || ONLY_PHASE == 10
  PHASE(10, phase_peer_fused<0>(p, 0, smem))
#endif
#if !defined(ONLY_PHASE) || ONLY_PHASE == 11
  PHASE(11, phase_gemm_fast(p.H, p.Wt_odin, T, 1536, 1024, (EpiPlain{p.QKV, 1536}), smem))
#endif
#if !defined(ONLY_PHASE) || ONLY_PHASE == 12
  PHASE(12, phase_qkrope(p, smem))
#endif
#if !defined(ONLY_PHASE) || ONLY_PHASE == 13
  PHASE(13, phase_attn(p, smem))
#endif
#if !defined(ONLY_PHASE) || ONLY_PHASE == 14
  PHASE(14, phase_gemm_fast(p.CAT, p.Wt_odout, T, 1024, 1024, (EpiRes{p.X, p.X, p.mod + (size_t)8 * 6144 + 2048}), smem))
#endif
#if !defined(ONLY_PHASE) || ONLY_PHASE == 15
  PHASE(15, phase_norm<false>(p, p.X, p.nfg + D, p.mod + (size_t)8 * 6144, 3072, 4096, smem))
#endif
#if !defined(ONLY_PHASE) || ONLY_PHASE == 16
  PHASE(16, phase_gemm_fast(p.H, p.Wt_q + (size_t)2048 * 1024, T, 2048, 1024, (EpiPlain{p.QP, 2048}), smem))
#endif
#if !defined(ONLY_PHASE) || ONLY_PHASE == 17
#endif
#if !defined(ONLY_PHASE) || ONLY_PHASE == 18
  PHASE(18, phase_peer_fused<1>(p, 1, smem))
#endif
#undef PHASE
}
}

extern "C" void kernel_launch(void* const* d_in, const int* in_sizes, int n_in, void* d_out, int out_size, void* d_ws, size_t ws_size, hipStream_t stream) {
  (void)in_sizes; (void)n_in; (void)out_size;
  Params p{};
  const float** fin = (const float**)&p;
  for (int i = 0; i < 23; ++i) fin[i] = (const float*)d_in[i];
  p.X = (float*)d_out;
  char* ws = (char*)d_ws; size_t off = 0;
  auto alloc = [&](size_t bytes) { char* q = ws + off; off += (bytes + 255) / 256 * 256; return q; };
  p.U8 = (unsigned char*)alloc((size_t)2 * 16384 * 1024); p.V8 = (unsigned char*)alloc((size_t)2 * 16384 * 1024);
  p.Wt_evin = (bf16_t*)alloc((size_t)2560 * 1024 * 2); p.Wt_evout = (bf16_t*)alloc((size_t)1024 * 1024 * 2); p.Wt_odin = (bf16_t*)alloc((size_t)1536 * 1024 * 2);
  p.Wt_odout = (bf16_t*)alloc((size_t)1024 * 1024 * 2); p.Wt_q = (bf16_t*)alloc((size_t)2 * 2048 * 1024 * 2); p.keysb = (bf16_t*)alloc((size_t)2 * 2 * 128 * 128 * 2); p.poolWt = (bf16_t*)alloc((size_t)4 * 128 * 128 * 2);
  p.Wg = (float*)alloc(16 * 1024 * 4); p.mod = (float*)alloc(2 * 8 * 6144 * 4); p.gates = (float*)alloc((size_t)T * 16 * 4);
  p.pgate = (float*)alloc((size_t)T * 128 * 4); p.pidx = (bf16_t*)alloc((size_t)T * 128 * 2);
  p.H = (bf16_t*)alloc((size_t)T * 1024 * 2); p.CAT = p.H;
  char* big = alloc((size_t)T * 2048 * 2);
  p.ZQK = (bf16_t*)big; p.ZV = (bf16_t*)(big + (size_t)T * 1024 * 2); p.ZO = (bf16_t*)(big + (size_t)T * 1536 * 2); p.HS = (bf16_t*)big; p.QP = (bf16_t*)big; p.QKV = (bf16_t*)big;
  char* big2 = alloc((size_t)T * 1536 * 2);
  p.QK = (bf16_t*)big2; p.ZP = (bf16_t*)(big2 + (size_t)T * 1024 * 2); p.Qh = (bf16_t*)big2; p.Kh = (bf16_t*)(big2 + (size_t)T * 1024 * 2); p.Vh = (bf16_t*)(big2 + (size_t)T * 1280 * 2);
  p.bar = (unsigned*)alloc(XCD_BAR_WORDS * 4);
  if (off > ws_size) { fprintf(stderr, "kernel_launch: workspace too small: need %zu have %zu\n", off, ws_size); return; }

  static int grid_blocks = 0;
  if (!grid_blocks) {
    int dev = 0, cus = 0, per_cu = 0; hipGetDevice(&dev); hipDeviceGetAttribute(&cus, hipDeviceAttributeMultiprocessorCount, dev);
    hipFuncSetAttribute((const void*)mega, hipFuncAttributeMaxDynamicSharedMemorySize, SMEM_BYTES);
    hipOccupancyMaxActiveBlocksPerMultiprocessor(&per_cu, mega, NTHREADS, SMEM_BYTES);
    if (per_cu > 1) per_cu = 1;
    grid_blocks = cus * per_cu;
    if (grid_blocks <= 0) { fprintf(stderr, "kernel_launch: occupancy query returned 0\n"); grid_blocks = 0; return; }
  }
  hipMemsetAsync(p.bar, 0, XCD_BAR_WORDS * 4, stream);
#if MULTI_LAUNCH
  for (int ph = 0; ph < NPH; ++ph) hipLaunchKernelGGL(mega, dim3(grid_blocks), dim3(NTHREADS), SMEM_BYTES, stream, p, ph, ph + 1);
#else
  int ph0 = 0, ph1 = NPH; void* args[] = {&p, &ph0, &ph1};
  hipError_t e = hipLaunchCooperativeKernel((const void*)mega, dim3(grid_blocks), dim3(NTHREADS), args, SMEM_BYTES, stream);
  if (e != hipSuccess) fprintf(stderr, "cooperative launch failed: %s (grid %d)\n", hipGetErrorString(e), grid_blocks);
#endif
}
```

```cpp
#include <hip/hip_runtime.h>
#include <hip/hip_cooperative_groups.h>
#include <math.h>
#include <stdint.h>
#include <stdio.h>
namespace cg = cooperative_groups;

#ifndef MULTI_LAUNCH
#define MULTI_LAUNCH 0
#endif

namespace {
typedef unsigned short bf16_t;
typedef unsigned int u32;
typedef float f32x4 __attribute__((ext_vector_type(4)));
typedef u32 u32x4 __attribute__((ext_vector_type(4)));
typedef u32 u32x2 __attribute__((ext_vector_type(2)));
typedef __bf16 bf16x2_t __attribute__((ext_vector_type(2)));

constexpr int D = 1024, NB = 8, S = 4096, T = NB * S;
constexpr int EVEN_IN = 2576;
constexpr float EPS = 1e-6f;
constexpr int NTHREADS = 512;
constexpr int SMEM_BYTES = 160 * 1024;
constexpr float KSCALE = 0.08838834764831845f;

struct Params {
  const float *x, *c, *ada_w, *ada_b, *nmg, *nfg, *ev_w_in, *ev_b_in, *conv_w, *conv_b, *mnorm_g, *pool_w, *pool_sc, *ev_w_out, *od_w_in, *qn_g, *kn_g, *od_w_out,
      *peer_wq, *peer_keys, *peer_u, *peer_v, *final_g;
  float* X;
  bf16_t *Wt_evin, *Wt_evout, *Wt_odin, *Wt_odout, *Wt_q, *keysb, *poolWt; unsigned char *U8, *V8;
  float *Wg, *mod, *gates, *pgate;
  bf16_t *H, *ZQK, *ZV, *ZO, *ZP, *QK, *HS, *CAT, *QP, *QKV, *Qh, *Kh, *Vh, *Yb;
  bf16_t* pidx;
  unsigned* bar;
};

__device__ __forceinline__ float siluf(float x) { return x * __builtin_amdgcn_rcpf(1.f + __expf(-x)); }
__device__ __forceinline__ u32 e2m3(float x) { const float a = fminf(fabsf(x), 7.5f);
  const int c = a < 2.f ? __float2int_rn(a * 8.f) : a < 4.f ? __float2int_rn(a * 4.f) + 8 : __float2int_rn(a * 2.f) + 16;
  return (u32)c | (x < 0.f ? 32u : 0u); }
__device__ __forceinline__ float sigmf(float x) { return __builtin_amdgcn_rcpf(1.f + __expf(-x)); }
constexpr int DPP_X1 = 0xB1, DPP_X2 = 0x4E, DPP_HMIR = 0x141, DPP_MIR = 0x140;
template <int CTRL> __device__ __forceinline__ int dppi(int v) { return __builtin_amdgcn_update_dpp(0, v, CTRL, 0xF, 0xF, true); }
template <int CTRL> __device__ __forceinline__ float dppf(float v) { return __int_as_float(__builtin_amdgcn_update_dpp(0, __float_as_int(v), CTRL, 0xF, 0xF, true)); }
__device__ __forceinline__ float sum16x(float v) { const unsigned b = __float_as_uint(v); auto r = __builtin_amdgcn_permlane16_swap(b, b, false, false); return __uint_as_float(r[0]) + __uint_as_float(r[1]); }
__device__ __forceinline__ float sum32x(float v) { const unsigned b = __float_as_uint(v); auto r = __builtin_amdgcn_permlane32_swap(b, b, false, false); return __uint_as_float(r[0]) + __uint_as_float(r[1]); }
__device__ __forceinline__ float max16x(float v) { const unsigned b = __float_as_uint(v); auto r = __builtin_amdgcn_permlane16_swap(b, b, false, false); return fmaxf(__uint_as_float(r[0]), __uint_as_float(r[1])); }
__device__ __forceinline__ float max32x(float v) { const unsigned b = __float_as_uint(v); auto r = __builtin_amdgcn_permlane32_swap(b, b, false, false); return fmaxf(__uint_as_float(r[0]), __uint_as_float(r[1])); }
__device__ __forceinline__ float row_sum(float v) { v += dppf<DPP_X1>(v); v += dppf<DPP_X2>(v); v += dppf<DPP_HMIR>(v); v += dppf<DPP_MIR>(v); return v; }
__device__ __forceinline__ float wave_sum(float v) { v = row_sum(v); v = sum16x(v); return sum32x(v); }
__device__ __forceinline__ float wave_max(float v) { v = fmaxf(v, dppf<DPP_X1>(v)); v = fmaxf(v, dppf<DPP_X2>(v)); v = fmaxf(v, dppf<DPP_HMIR>(v)); v = fmaxf(v, dppf<DPP_MIR>(v)); v = max16x(v); return max32x(v); }
__device__ __forceinline__ bf16_t f2bf(float f) { u32 r; asm("v_cvt_pk_bf16_f32 %0, %1, %1" : "=v"(r) : "v"(f)); return (bf16_t)r; }
__device__ __forceinline__ float bf2f(bf16_t b) { return __uint_as_float(((u32)b) << 16); }
__device__ __forceinline__ u32 pack2(float lo, float hi) { u32 r; asm("v_cvt_pk_bf16_f32 %0, %1, %2" : "=v"(r) : "v"(lo), "v"(hi)); return r; }
__device__ __forceinline__ float bflo(u32 w) { return __uint_as_float(w << 16); }
__device__ __forceinline__ float bfhi(u32 w) { return __uint_as_float(w & 0xFFFF0000u); }
__device__ __forceinline__ float dot2bf(u32 a, u32 b, float c) { return __builtin_amdgcn_fdot2_f32_bf16(__builtin_bit_cast(bf16x2_t, a), __builtin_bit_cast(bf16x2_t, b), c, false); }

constexpr float U6_SCALE = 48.f, V6_SCALE = 3.f;
constexpr int PJ_MOD = 192, PJ_TR = 2576, PJ_WG = 1, PJ_KEYS = 16, PJ_UV = 8192;
constexpr int PJ_TOTAL = PJ_MOD + PJ_TR + PJ_WG + PJ_KEYS + PJ_UV;

__device__ void prep_transpose_tile(const float* __restrict__ src, int ld, int k0, int n0, bf16_t* __restrict__ dst, int dstK, char* smem) {
  float* tile = (float*)smem;
  const int tid = threadIdx.x;
  __syncthreads();
  for (int pass = 0; pass < 8; ++pass) { int kk = pass * 8 + (tid >> 6), n = tid & 63; tile[kk * 65 + n] = src[(size_t)(k0 + kk) * ld + n0 + n]; }
  __syncthreads();
  int n = tid >> 3, kc = (tid & 7) * 8; u32x4 w;
  w.x = pack2(tile[(kc + 0) * 65 + n], tile[(kc + 1) * 65 + n]); w.y = pack2(tile[(kc + 2) * 65 + n], tile[(kc + 3) * 65 + n]);
  w.z = pack2(tile[(kc + 4) * 65 + n], tile[(kc + 5) * 65 + n]); w.w = pack2(tile[(kc + 6) * 65 + n], tile[(kc + 7) * 65 + n]);
  *(u32x4*)(dst + (size_t)(n0 + n) * dstK + k0 + kc) = w;
}

__device__ void phase_prep(const Params& p, char* smem) {
  const int tid = threadIdx.x;
  for (int job = blockIdx.x; job < PJ_TOTAL; job += gridDim.x) {
    if (job < PJ_MOD) {
      float* cs = (float*)smem; float* red = cs + 8192;
      __syncthreads();
      for (int i = tid; i < 8192; i += NTHREADS) cs[i] = siluf(p.c[i]);
      __syncthreads();
      const int l = job / 96, e0 = (job % 96) * 64, col = tid & 63, dg = tid >> 6;
      float acc[8];
#pragma unroll
      for (int b = 0; b < 8; ++b) acc[b] = 0.f;
      const float* w = p.ada_w + (size_t)l * D * 6144 + e0 + col;
      for (int d = dg * 128; d < dg * 128 + 128; ++d) { float wv = w[(size_t)d * 6144];
#pragma unroll
        for (int b = 0; b < 8; ++b) acc[b] += cs[b * 1024 + d] * wv; }
#pragma unroll
      for (int b = 0; b < 8; ++b) red[(dg * 8 + b) * 64 + col] = acc[b];
      __syncthreads();
      { const int b = tid >> 6; float s = 0.f;
#pragma unroll
        for (int g = 0; g < 8; ++g) s += red[(g * 8 + b) * 64 + col];
        p.mod[(size_t)(l * 8 + b) * 6144 + e0 + col] = s + p.ada_b[l * 6144 + e0 + col]; }
    } else if (job < PJ_MOD + PJ_TR) {
      int tt = job - PJ_MOD;
      if (tt < 640) prep_transpose_tile(p.ev_w_in, EVEN_IN, (tt / 40) * 64, (tt % 40) * 64, p.Wt_evin, 1024, smem);
      else if (tt < 896) { tt -= 640; prep_transpose_tile(p.ev_w_out, 1024, (tt / 16) * 64, (tt % 16) * 64, p.Wt_evout, 1024, smem); }
      else if (tt < 1280) { tt -= 896; prep_transpose_tile(p.od_w_in, 1536, (tt / 24) * 64, (tt % 24) * 64, p.Wt_odin, 1024, smem); }
      else if (tt < 1536) { tt -= 1280; prep_transpose_tile(p.od_w_out, 1024, (tt / 16) * 64, (tt % 16) * 64, p.Wt_odout, 1024, smem); }
      else if (tt < 2560) { tt -= 1536; int l = tt / 512; tt %= 512; prep_transpose_tile(p.peer_wq + (size_t)l * D * 2048, 2048, (tt / 32) * 64, (tt % 32) * 64, p.Wt_q + (size_t)l * 2048 * 1024, 1024, smem); }
      else { tt -= 2560; const int g = tt >> 2; prep_transpose_tile(p.pool_w + (size_t)g * 16384, 128, ((tt >> 1) & 1) * 64, (tt & 1) * 64, p.poolWt + (size_t)g * 16384, 128, smem); }
    } else if (job < PJ_MOD + PJ_TR + PJ_WG) {
      for (int i = tid; i < 16 * 1024; i += NTHREADS) { int g = i >> 10, d = i & 1023; p.Wg[i] = p.ev_w_in[(size_t)d * EVEN_IN + 2560 + g]; }
    } else if (job < PJ_MOD + PJ_TR + PJ_WG + PJ_KEYS) {
      int j = job - (PJ_MOD + PJ_TR + PJ_WG);
      for (int i = tid; i < 4096; i += NTHREADS) p.keysb[j * 4096 + i] = f2bf(p.peer_keys[j * 4096 + i]);
    } else {
      int j = job - (PJ_MOD + PJ_TR + PJ_WG + PJ_KEYS); const bool isu = j < 4096; const float* src = isu ? p.peer_u : p.peer_v; unsigned char* dst = isu ? p.U8 : p.V8; j &= 4095;
      const size_t o = (size_t)j * 8192 + tid * 16; u32 ww[4]; const float sc = isu ? U6_SCALE : V6_SCALE;
#pragma unroll
      for (int q = 0; q < 4; ++q) { const f32x4 a = *(const f32x4*)(src + o + 4 * q);
        ww[q] = e2m3(a.x * sc) | (e2m3(a.y * sc) << 6) | (e2m3(a.z * sc) << 12) | (e2m3(a.w * sc) << 18); }
      { u32* d3 = (u32*)(dst + ((size_t)j * 512 + tid) * 12);
        d3[0] = ww[0] | (ww[1] << 24); d3[1] = (ww[1] >> 8) | (ww[2] << 16); d3[2] = (ww[2] >> 16) | (ww[3] << 8); }
    }
  }
}

namespace pg8 {
#define PG8_LAS __attribute__((address_space(3)))
typedef unsigned short bf16_t;
typedef short bf16x8 __attribute__((ext_vector_type(8)));
typedef float f32x4 __attribute__((ext_vector_type(4)));
typedef unsigned u32x4 __attribute__((ext_vector_type(4)));
constexpr int BM = 256, BK = 64, HALF = 128, HTB = HALF * BK * 2  , STAGE_BYTES = 8 * HTB, NXCD = 8, WGM = 8;

__host__ __device__ __forceinline__ int lds_byte(int r, int c) { const int st = (r >> 4) * 2 + (c >> 5), rr = r & 15, cc = c & 31, ob = rr * 64 + cc * 2; return st * 1024 + (ob ^ (((ob >> 9) & 1) << 5)); }
__host__ __device__ __forceinline__ void stage_rc(int b, int& R, int& C) { const int st = b / 1024, sb = b % 1024, swz = sb ^ (((sb >> 9) & 1) << 5); R = (st >> 1) * 16 + swz / 64; C = (st & 1) * 32 + (swz % 64) / 2; }
__host__ __device__ __forceinline__ int perm32(int rho) { const int n = rho >> 4, i = rho & 15; return 8 * (i >> 2) + 4 * n + (i & 3); }

struct Unit { int pm, pn; };
struct Gemm { const bf16_t* A; const bf16_t* Bt; int M, N, K; };

struct StaticOrder {
    int nM, nN, nwg, G, c;
    __host__ __device__ void init(int M, int N, int G_, int c_) { nM = M / BM; nN = N / BM; nwg = nM * nN; G = G_; c = c_; }
    __host__ __device__ bool next(int i, Unit& u) const {
        const long L = (long)i * G + c; if (L >= nwg) return false;
        int wgid = (int)L; { const int q = nwg / NXCD, r = nwg % NXCD, xcd = wgid % NXCD, off = wgid / NXCD; wgid = (xcd < r ? xcd * (q + 1) : r * (q + 1) + (xcd - r) * q) + off; }
        const int nig = WGM * nN, gid = wgid / nig, fm = gid * WGM, gsz = (nM - fm) < WGM ? (nM - fm) : WGM;
        u.pm = fm + ((wgid % nig) % gsz); u.pn = (wgid % nig) / gsz; return true;
    }
    __device__ __forceinline__ void a_ready(const Unit&) const {}
    __device__ __forceinline__ void done(const Unit&) const {}
};
__device__ __forceinline__ unsigned cvt_pk_bf16(float lo, float hi) { unsigned r; asm volatile("v_cvt_pk_bf16_f32 %0, %1, %2" : "=v"(r) : "v"(lo), "v"(hi)); return r; }
template <class Epi, class Sched, bool STAMP = false>
__device__ __forceinline__ void gemm_phase(PG8_LAS unsigned char* lds, const Gemm g, const Sched& S, const Epi& E, unsigned long long* stamps) {
    const int tid = threadIdx.x, wid = __builtin_amdgcn_readfirstlane(tid >> 6), lane = tid & 63, wr = wid >> 2, wc = wid & 3, fr = lane & 15, fq = lane >> 4;
    const int K = g.K, nt = K / BK;
    int ts_lo = 0, ts_hi = 0, nts = 0; const unsigned long long rt_entry = STAMP ? (unsigned long long)wall_clock64() : 0ull;
#define PG8_STAMP() do { if (STAMP && wid == 0 && nts < 64) { const unsigned long long _c = (unsigned long long)clock64(); \
        ts_lo = (lane == nts) ? (int)(unsigned)_c : ts_lo; ts_hi = (lane == nts) ? (int)(unsigned)(_c >> 32) : ts_hi; ++nts; } } while (0)
    PG8_STAMP();
    unsigned voffA[2], voffB[2];
#pragma unroll
    for (int i = 0; i < 2; ++i) { int R, C; stage_rc(tid * 16 + i * 8192, R, C); const int Rb = Epi::PERM ? ((R & ~31) + perm32(R & 31)) : R;
        voffA[i] = (unsigned)(R * K + C) * 2u; voffB[i] = (unsigned)(Rb * K + C) * 2u; }
    const size_t kstep = (size_t)(BK * 2);
    const size_t hstep = (size_t)HALF * K * 2;
    const size_t tstep = 2 * hstep;
    const unsigned ldsw = (unsigned)wid * 1024u;
    const int aoff = lds_byte(wr * 64 + fr, fq * 8), boff = lds_byte(wc * 32 + fr, fq * 8);
#define PG8_SA(b, h) (((b) * 2 + (h)) * HTB)
#define PG8_SB(b, h) ((4 + (b) * 2 + (h)) * HTB)
#define PG8_STAGE(bufoff, gbase, voff) do { _Pragma("unroll") for (int _i = 0; _i < 2; ++_i) \
        __builtin_amdgcn_global_load_lds((const unsigned*)((const char*)(gbase) + (voff)[_i]), (PG8_LAS unsigned*)(lds + (bufoff) + ldsw + _i * 8192), 16, 0, 0); } while (0)
#define PG8_LDA(dst, b, h) do { _Pragma("unroll") for (int m = 0; m < 4; ++m) _Pragma("unroll") for (int k = 0; k < 2; ++k) dst[m][k] = *(const PG8_LAS bf16x8*)(lds + PG8_SA(b, h) + aoff + m * 2048 + k * 1024); } while (0)
#define PG8_LDB(dst, b, h) do { _Pragma("unroll") for (int n = 0; n < 2; ++n) _Pragma("unroll") for (int k = 0; k < 2; ++k) dst[n][k] = *(const PG8_LAS bf16x8*)(lds + PG8_SB(b, h) + boff + n * 2048 + k * 1024); } while (0)
#define PG8_MMA(ai, bj, At, Bt) do { __builtin_amdgcn_s_setprio(1); _Pragma("unroll") for (int m = 0; m < 4; ++m) _Pragma("unroll") for (int n = 0; n < 2; ++n) _Pragma("unroll") for (int k = 0; k < 2; ++k) \
        acc[ai][bj][m][n] = __builtin_amdgcn_mfma_f32_16x16x32_bf16(Bt[n][k], At[m][k], acc[ai][bj][m][n], 0, 0, 0); __builtin_amdgcn_s_setprio(0); } while (0)
#define PG8_WAIT_V(n) asm volatile("s_waitcnt vmcnt(" #n ")" ::: "memory")
#define PG8_WAIT_L(n) asm volatile("s_waitcnt lgkmcnt(" #n ")" ::: "memory")
#define PG8_BAR __builtin_amdgcn_s_barrier()
#define PG8_SCHED __builtin_amdgcn_sched_barrier(0)
    Unit cur, nxt; int ui = 0;
    if (!S.next(0, cur)) return;
    f32x4 acc[2][2][4][2];
#pragma unroll
    for (int a = 0; a < 2; ++a)
#pragma unroll
        for (int b = 0; b < 2; ++b)
#pragma unroll
            for (int m = 0; m < 4; ++m)
#pragma unroll
                for (int n = 0; n < 2; ++n) acc[a][b][m][n] = (f32x4){0.f, 0.f, 0.f, 0.f};
    bf16x8 At[4][2], B0[2][2], B1[2][2];
    const char* cA = (const char*)g.A + (size_t)cur.pm * tstep; const char* cB = (const char*)g.Bt + (size_t)cur.pn * tstep;
    S.a_ready(cur);
    PG8_STAGE(PG8_SB(0, 0), cB, voffB); PG8_STAGE(PG8_SA(0, 0), cA, voffA); PG8_STAGE(PG8_SB(0, 1), cB + hstep, voffB); PG8_STAGE(PG8_SA(0, 1), cA + hstep, voffA);
    if (wr == 1) PG8_BAR;
    PG8_WAIT_V(4); PG8_BAR;
    PG8_STAGE(PG8_SB(1, 0), cB + kstep, voffB); PG8_STAGE(PG8_SA(1, 0), cA + kstep, voffA); PG8_STAGE(PG8_SB(1, 1), cB + hstep + kstep, voffB);
    PG8_WAIT_V(6); PG8_BAR;
    PG8_STAMP();
    for (;;) {
        const bool has_next = S.next(ui + 1, nxt);
        const char* nA = has_next ? (const char*)g.A + (size_t)nxt.pm * tstep : cA; const char* nB = has_next ? (const char*)g.Bt + (size_t)nxt.pn * tstep : cB;
        for (int t = 0; t < nt; t += 2) {
            const bool last = (t == nt - 2);
            const char* a1 = cA + (size_t)(t + 1) * kstep;
            const char* a2 = last ? nA : cA + (size_t)(t + 2) * kstep; const char* b2 = last ? nB : cB + (size_t)(t + 2) * kstep;
            const char* a3 = a2 + kstep; const char* b3 = b2 + kstep;
            if (last && has_next) S.a_ready(nxt);
            PG8_LDB(B0, 0, 0); PG8_SCHED; PG8_LDA(At, 0, 0); PG8_STAGE(PG8_SA(1, 1), a1 + hstep, voffA);
            PG8_WAIT_L(8); PG8_BAR; PG8_WAIT_L(0); PG8_MMA(0, 0, At, B0); PG8_BAR; PG8_SCHED;
            PG8_LDB(B1, 0, 1); PG8_STAGE(PG8_SB(0, 0), b2, voffB);
            PG8_BAR; PG8_WAIT_L(0); PG8_MMA(0, 1, At, B1); PG8_BAR;
            PG8_LDA(At, 0, 1); PG8_STAGE(PG8_SA(0, 0), a2, voffA);
            PG8_BAR; PG8_WAIT_L(0); PG8_MMA(1, 0, At, B0); PG8_BAR; PG8_SCHED;
            PG8_STAGE(PG8_SB(0, 1), b2 + hstep, voffB);
            PG8_WAIT_V(6); PG8_BAR; PG8_MMA(1, 1, At, B1); PG8_BAR;
            PG8_LDB(B0, 1, 0); PG8_SCHED; PG8_LDA(At, 1, 0); PG8_STAGE(PG8_SA(0, 1), a2 + hstep, voffA);
            PG8_WAIT_L(8); PG8_BAR; PG8_WAIT_L(0); PG8_MMA(0, 0, At, B0); PG8_BAR; PG8_SCHED;
            PG8_LDB(B1, 1, 1); PG8_STAGE(PG8_SB(1, 0), b3, voffB);
            PG8_BAR; PG8_WAIT_L(0); PG8_MMA(0, 1, At, B1); PG8_BAR;
            PG8_LDA(At, 1, 1); PG8_STAGE(PG8_SA(1, 0), a3, voffA);
            PG8_BAR; PG8_WAIT_L(0); PG8_MMA(1, 0, At, B0); PG8_BAR; PG8_SCHED;
            PG8_STAGE(PG8_SB(1, 1), b3 + hstep, voffB);
            PG8_WAIT_V(6); PG8_BAR; PG8_MMA(1, 1, At, B1); PG8_BAR;
        }
        PG8_STAMP();
        if constexpr (!Epi::AFTER_DRAIN) { E(acc, cur, wr, wc, fr, fq); S.done(cur); }
        PG8_STAMP();
        if (!has_next) break;
#pragma unroll
        for (int a = 0; a < 2; ++a)
#pragma unroll
            for (int b = 0; b < 2; ++b)
#pragma unroll
                for (int m = 0; m < 4; ++m)
#pragma unroll
                    for (int n = 0; n < 2; ++n) acc[a][b][m][n] = (f32x4){0.f, 0.f, 0.f, 0.f};
        cur = nxt; cA = nA; cB = nB; ++ui;
    }
    PG8_WAIT_V(0);
    if (wr == 0) PG8_BAR;
    PG8_BAR;
    if constexpr (Epi::AFTER_DRAIN) { E.fused(acc, cur, wr, wc, fr, fq, lds, wid, lane); S.done(cur); }
    PG8_STAMP();
    if (STAMP && wid == 0) { stamps[lane] = lane < nts ? (((unsigned long long)(unsigned)ts_hi << 32) | (unsigned)ts_lo) : 0ull;
        if (lane == 62) stamps[62] = rt_entry; if (lane == 63) stamps[63] = (unsigned long long)wall_clock64(); }
#undef PG8_STAMP
#undef PG8_SA
#undef PG8_SB
#undef PG8_STAGE
#undef PG8_LDA
#undef PG8_LDB
#undef PG8_MMA
#undef PG8_WAIT_V
#undef PG8_WAIT_L
#undef PG8_BAR
#undef PG8_SCHED
}
}

struct EpiEvin {
  static constexpr bool PERM = true, AFTER_DRAIN = false;
  bf16_t *ZQK, *ZV, *ZO, *ZP; const float* bias;
  __device__ __forceinline__ void operator()(const pg8::f32x4 (&acc)[2][2][4][2], const pg8::Unit& u, int wr, int wc, int fr, int fq) const {
    const int row0 = u.pm * 256 + wr * 64 + fr, ct = u.pn * 256;
    bf16_t* base; int ldc, cl; bool sig = false;
    if (ct < 1024) { base = ZQK; ldc = 1024; cl = ct; } else if (ct < 1536) { base = ZV; ldc = 512; cl = ct - 1024; } else if (ct < 2048) { base = ZO; ldc = 512; cl = ct - 1536; sig = true; } else { base = ZP; ldc = 512; cl = ct - 2048; }
    const int cofs = wc * 32 + 8 * fq;
    pg8::f32x4 bv[2][2];
#pragma unroll
    for (int bj = 0; bj < 2; ++bj)
#pragma unroll
      for (int n = 0; n < 2; ++n) bv[bj][n] = *(const pg8::f32x4*)(bias + ct + cofs + bj * 128 + 4 * n);
#pragma unroll
    for (int ai = 0; ai < 2; ++ai)
#pragma unroll
      for (int m = 0; m < 4; ++m) { bf16_t* rowp = base + (size_t)(row0 + ai * 128 + m * 16) * ldc + cl + cofs;
#pragma unroll
        for (int bj = 0; bj < 2; ++bj) { pg8::f32x4 v0 = acc[ai][bj][m][0] + bv[bj][0], v1 = acc[ai][bj][m][1] + bv[bj][1];
          if (sig) {
#pragma unroll
            for (int j = 0; j < 4; ++j) { v0[j] = sigmf(v0[j]); v1[j] = sigmf(v1[j]); } }
          pg8::u32x4 w; w.x = pg8::cvt_pk_bf16(v0[0], v0[1]); w.y = pg8::cvt_pk_bf16(v0[2], v0[3]); w.z = pg8::cvt_pk_bf16(v1[0], v1[1]); w.w = pg8::cvt_pk_bf16(v1[2], v1[3]);
          *(pg8::u32x4*)(rowp + bj * 128) = w; } }
  }
};
struct EpiPlain {
  static constexpr bool PERM = true, AFTER_DRAIN = false;
  bf16_t* out; int ldc;
  __device__ __forceinline__ void operator()(const pg8::f32x4 (&acc)[2][2][4][2], const pg8::Unit& u, int wr, int wc, int fr, int fq) const {
    const int row0 = u.pm * 256 + wr * 64 + fr, col0 = u.pn * 256 + wc * 32 + 8 * fq;
#pragma unroll
    for (int ai = 0; ai < 2; ++ai)
#pragma unroll
      for (int m = 0; m < 4; ++m) { bf16_t* rowp = out + (size_t)(row0 + ai * 128 + m * 16) * ldc + col0;
#pragma unroll
        for (int bj = 0; bj < 2; ++bj) { const pg8::f32x4 v0 = acc[ai][bj][m][0], v1 = acc[ai][bj][m][1];
          pg8::u32x4 w; w.x = pg8::cvt_pk_bf16(v0[0], v0[1]); w.y = pg8::cvt_pk_bf16(v0[2], v0[3]); w.z = pg8::cvt_pk_bf16(v1[0], v1[1]); w.w = pg8::cvt_pk_bf16(v1[2], v1[3]);
          *(pg8::u32x4*)(rowp + bj * 128) = w; } }
  }
};
struct EpiQP {
  static constexpr bool PERM = true, AFTER_DRAIN = false;
  bf16_t* out;
  __device__ __forceinline__ void operator()(const pg8::f32x4 (&acc)[2][2][4][2], const pg8::Unit& u, int wr, int wc, int fr, int fq) const {
    const int row0 = u.pm * 256 + wr * 64 + fr, head = u.pn;
    const int ks = 2 * wc + (fq >> 1), hh = fq & 1;
#pragma unroll
    for (int ai = 0; ai < 2; ++ai)
#pragma unroll
      for (int m = 0; m < 4; ++m) { const int r = row0 + ai * 128 + m * 16;
#pragma unroll
        for (int bj = 0; bj < 2; ++bj) { const pg8::f32x4 v0 = acc[ai][bj][m][0], v1 = acc[ai][bj][m][1];
          pg8::u32x4 w; w.x = pg8::cvt_pk_bf16(v0[0], v0[1]); w.y = pg8::cvt_pk_bf16(v0[2], v0[3]); w.z = pg8::cvt_pk_bf16(v1[0], v1[1]); w.w = pg8::cvt_pk_bf16(v1[2], v1[3]);
          *(pg8::u32x4*)(out + ((((((size_t)(r >> 5) * 8 + head) * 2 + bj) * 8 + ks) * 2 + hh) * 32 + (r & 31)) * 8) = w; } }
  }
};
struct EpiRes {
  static constexpr bool PERM = false, AFTER_DRAIN = false;
  const float* xin; float* X; const float* gate;
  __device__ __forceinline__ void operator()(const pg8::f32x4 (&acc)[2][2][4][2], const pg8::Unit& u, int wr, int wc, int fr, int fq) const {
    const int row0 = u.pm * 256 + wr * 64 + fr, col0 = u.pn * 256 + wc * 32 + 4 * fq; const float* gb = gate + (size_t)((u.pm * 256) / S) * 6144;
    pg8::f32x4 gv[2][2];
#pragma unroll
    for (int bj = 0; bj < 2; ++bj)
#pragma unroll
      for (int n = 0; n < 2; ++n) gv[bj][n] = *(const pg8::f32x4*)(gb + col0 + bj * 128 + n * 16);
#pragma unroll
    for (int ai = 0; ai < 2; ++ai)
#pragma unroll
      for (int m = 0; m < 4; ++m) { const size_t off = (size_t)(row0 + ai * 128 + m * 16) * 1024 + col0;
#pragma unroll
        for (int bj = 0; bj < 2; ++bj)
#pragma unroll
          for (int n = 0; n < 2; ++n) { const pg8::f32x4 xi = *(const pg8::f32x4*)(xin + off + bj * 128 + n * 16); *(pg8::f32x4*)(X + off + bj * 128 + n * 16) = xi + gv[bj][n] * acc[ai][bj][m][n]; }
        asm volatile("" ::: "memory"); }
  }
};
template <class Epi> __device__ __forceinline__ void phase_gemm_fast(const bf16_t* A, const bf16_t* Bt, int M, int N, int K, const Epi& E, char* smem) {
  pg8::Gemm g; g.A = A; g.Bt = Bt; g.M = M; g.N = N; g.K = K;
  pg8::StaticOrder So; So.init(M, N, (int)gridDim.x, (int)blockIdx.x);
  pg8::gemm_phase<Epi, pg8::StaticOrder, false>((PG8_LAS unsigned char*)smem, g, So, E, nullptr);
}

namespace cp {
typedef short bf16x8 __attribute__((ext_vector_type(8)));
typedef float f32x16 __attribute__((ext_vector_type(16)));
constexpr int RS = 272;
__device__ __forceinline__ void unpack8(const u32x4 w, float* f) { f[0] = bflo(w.x); f[1] = bfhi(w.x); f[2] = bflo(w.y); f[3] = bfhi(w.y); f[4] = bflo(w.z); f[5] = bfhi(w.z); f[6] = bflo(w.w); f[7] = bfhi(w.w); }
__device__ void phase_convpool(const Params& p, char* smem) {
  for (int job = blockIdx.x; job < T / 64; job += gridDim.x) {
    int tid_ = threadIdx.x; asm volatile("" : "+v"(tid_));
    const int tid = tid_, c0 = (tid & 127) * 8, t0 = job * 64 + (tid >> 7) * 16, s0 = t0 & (S - 1);
    float cw[5][8], cb[8];
#pragma unroll
    for (int j = 0; j < 5; ++j) { const f32x4 a = *(const f32x4*)(p.conv_w + j * 1024 + c0), b = *(const f32x4*)(p.conv_w + j * 1024 + c0 + 4); cw[j][0] = a.x; cw[j][1] = a.y; cw[j][2] = a.z; cw[j][3] = a.w; cw[j][4] = b.x; cw[j][5] = b.y; cw[j][6] = b.z; cw[j][7] = b.w; }
    { const f32x4 a = *(const f32x4*)(p.conv_b + c0), b = *(const f32x4*)(p.conv_b + c0 + 4); cb[0] = a.x; cb[1] = a.y; cb[2] = a.z; cb[3] = a.w; cb[4] = b.x; cb[5] = b.y; cb[6] = b.z; cb[7] = b.w; }
    const float sc = c0 >= 512 ? KSCALE : 1.f;
    float win[5][8];
#pragma unroll
    for (int j = 0; j < 4; ++j) { const int ss = s0 + j - 2; u32x4 w = (u32x4){0u, 0u, 0u, 0u}; if (ss >= 0 && ss < S) w = *(const u32x4*)(p.ZQK + (size_t)(t0 + j - 2) * 1024 + c0); unpack8(w, win[j + 1]); }
#pragma unroll
    for (int i = 0; i < 16; ++i) {
#pragma unroll
      for (int j = 0; j < 4; ++j)
#pragma unroll
        for (int q = 0; q < 8; ++q) win[j][q] = win[j + 1][q];
      { const int ss = s0 + i + 2; u32x4 w = (u32x4){0u, 0u, 0u, 0u}; if (ss < S) w = *(const u32x4*)(p.ZQK + (size_t)(t0 + i + 2) * 1024 + c0); unpack8(w, win[4]); }
      float a[8];
#pragma unroll
      for (int q = 0; q < 8; ++q) { float v = cb[q];
#pragma unroll
        for (int j = 0; j < 5; ++j) v += cw[j][q] * win[j][q];
        a[q] = siluf(v) * sc; }
      u32x4 o; o.x = pack2(a[0], a[1]); o.y = pack2(a[2], a[3]); o.z = pack2(a[4], a[5]); o.w = pack2(a[6], a[7]); *(u32x4*)(p.QK + (size_t)(t0 + i) * 1024 + c0) = o;
    }
  }
  for (int job = blockIdx.x; job < (T / 128) * 4; job += gridDim.x) {
    int tid_ = threadIdx.x; asm volatile("" : "+v"(tid_));
    const int tid = tid_, wid = tid >> 6, lane = tid & 63, l31 = lane & 31, hh = lane >> 5;
    const int g = (job + (job >> 8)) & 3, t0 = (job >> 2) * 128, win = 2 << g, hw = win >> 1;
    __syncthreads();
#pragma unroll
    for (int i = 0; i < 4; ++i) { const int idx = tid + i * NTHREADS, row = idx >> 4, ch = idx & 15; *(u32x4*)(smem + 128 * RS + row * RS + ch * 16) = *(const u32x4*)(p.poolWt + (size_t)g * 16384 + row * 128 + ch * 8); }
#pragma unroll 1
    for (int i = 0; i < 4; ++i) { const int idx = tid + i * NTHREADS, row = idx >> 4, ch = idx & 15, t = t0 + row, s = t & (S - 1); const int lo = max(s - hw, 0), hi = min(s + hw, S);
      float sum[8], own[8];
#pragma unroll
      for (int q = 0; q < 8; ++q) sum[q] = 0.f;
      const bf16_t* base = p.ZP + (size_t)(t - s) * 512 + g * 128 + ch * 8;
      u32x4 rw[16];
#pragma unroll
      for (int r = 0; r < 16; ++r) { rw[r] = (u32x4){0u, 0u, 0u, 0u}; if (r < win) { const int rr = s - hw + r; if (rr >= 0 && rr < S) rw[r] = *(const u32x4*)(base + (size_t)rr * 512); } }
#pragma unroll
      for (int r = 0; r < 16; ++r) if (r < win) { float f[8]; unpack8(rw[r], f);
#pragma unroll
        for (int q = 0; q < 8; ++q) sum[q] += f[q]; }
      unpack8(*(const u32x4*)(base + (size_t)s * 512), own); const float inv = 1.f / (float)(hi - lo);
      u32x4 o; o.x = pack2(sum[0] * inv - own[0], sum[1] * inv - own[1]); o.y = pack2(sum[2] * inv - own[2], sum[3] * inv - own[3]); o.z = pack2(sum[4] * inv - own[4], sum[5] * inv - own[5]); o.w = pack2(sum[6] * inv - own[6], sum[7] * inv - own[7]);
      *(u32x4*)(smem + row * RS + ch * 16) = o; }
    __syncthreads();
    const int mt = wid >> 1;
#pragma unroll
    for (int q = 0; q < 2; ++q) { const int nt = (wid & 1) * 2 + q;
      f32x16 acc;
#pragma unroll
      for (int r = 0; r < 16; ++r) acc[r] = 0.f;
      const char* ya = smem + (mt * 32 + l31) * RS + hh * 16; const char* wb = smem + 128 * RS + (nt * 32 + l31) * RS + hh * 16;
#pragma unroll
      for (int ks = 0; ks < 8; ++ks) acc = __builtin_amdgcn_mfma_f32_32x32x16_bf16(*(const bf16x8*)(ya + ks * 32), *(const bf16x8*)(wb + ks * 32), acc, 0, 0, 0);
      const int e = nt * 32 + l31; const float psc = p.pool_sc[g * 128 + e];
#pragma unroll
      for (int r = 0; r < 16; ++r) { const int row = mt * 32 + (r & 3) + 8 * (r >> 2) + 4 * hh; p.CAT[(size_t)(t0 + row) * 1024 + 512 + g * 128 + e] = f2bf(acc[r] * psc); } }
  }
}
}

namespace ml {
typedef short bf16x8 __attribute__((ext_vector_type(8)));
typedef short s16x4 __attribute__((ext_vector_type(4)));
typedef float f32x16 __attribute__((ext_vector_type(16)));
constexpr int RS = 272;
constexpr int OFF_Q = 0, OFF_K = 128 * RS, OFF_VT = 2 * 128 * RS, OFF_VW = OFF_VT + 34 * RS, OFF_CT = OFF_VW + 34 * RS, OFF_A = OFF_CT + 34 * RS;
constexpr int OFF_PA = OFF_A + 16384, OFF_MCH = OFF_PA + 16384, OFF_TAB = OFF_MCH + 512, OFF_DEN = OFF_TAB + 4096  , OFF_EX = OFF_DEN + 1536  , OFF_OUT = OFF_EX + 16384  , OFF_END = OFF_OUT + 128 * 80;
static_assert(OFF_A % 16 == 0 && OFF_END <= SMEM_BYTES, "mlstm LDS layout");
__device__ __forceinline__ int crow(int r, int h) { return (r & 3) + 8 * (r >> 2) + 4 * h; }
__device__ __forceinline__ int spos(int s) { return (s & ~12) | ((s & 4) << 1) | ((s & 8) >> 1); }
#define ML_MFMA(a, b, c) __builtin_amdgcn_mfma_f32_32x32x16_bf16((a), (b), (c), 0, 0, 0)
__device__ __forceinline__ bf16x8 pack8(float x0, float x1, float x2, float x3, float x4, float x5, float x6, float x7) {
  u32x4 w;
  asm volatile("v_cvt_pk_bf16_f32 %0, %4, %5\n\tv_cvt_pk_bf16_f32 %1, %6, %7\n\tv_cvt_pk_bf16_f32 %2, %8, %9\n\tv_cvt_pk_bf16_f32 %3, %10, %11\n\ts_nop 1"
               : "=&v"(w.x), "=&v"(w.y), "=&v"(w.z), "=&v"(w.w) : "v"(x0), "v"(x1), "v"(x2), "v"(x3), "v"(x4), "v"(x5), "v"(x6), "v"(x7));
  return __builtin_bit_cast(bf16x8, w);
}
__device__ __forceinline__ void tr_read8(unsigned a, s16x4& r0, s16x4& r1, s16x4& r2, s16x4& r3, s16x4& r4, s16x4& r5, s16x4& r6, s16x4& r7) {
  asm volatile("ds_read_b64_tr_b16 %0, %8\n\tds_read_b64_tr_b16 %1, %8 offset:2176\n\tds_read_b64_tr_b16 %2, %8 offset:4352\n\tds_read_b64_tr_b16 %3, %8 offset:6528\n\t"
               "ds_read_b64_tr_b16 %4, %8 offset:8704\n\tds_read_b64_tr_b16 %5, %8 offset:10880\n\tds_read_b64_tr_b16 %6, %8 offset:13056\n\tds_read_b64_tr_b16 %7, %8 offset:15232\n\ts_waitcnt lgkmcnt(0)"
               : "=&v"(r0), "=&v"(r1), "=&v"(r2), "=&v"(r3), "=&v"(r4), "=&v"(r5), "=&v"(r6), "=&v"(r7) : "v"(a) : "memory");
}
static_assert(8 * RS == 2176, "tr_read8 offsets assume 272-byte rows");

__device__ void phase_mlstm(const Params& p, char* smem) {
  int tid_ = threadIdx.x; asm volatile("" : "+v"(tid_));
  const int tid = tid_, wid = tid >> 6, lane = tid & 63, l31 = lane & 31, hh = lane >> 5;
  float* const LA = (float*)(smem + OFF_A); float* const LPA = (float*)(smem + OFF_PA); float* const LM = (float*)(smem + OFF_MCH);
  float* const LTAB = (float*)(smem + OFF_TAB); float* const LDEN = (float*)(smem + OFF_DEN);
  const unsigned lds0 = (unsigned)(uintptr_t)smem;
  for (int job = blockIdx.x; job < 256; job += gridDim.x) {
    const int dvq = job & 3, h = (job >> 2) & 3, b = (job >> 4) & 7, dir = job >> 7;
    const float* gts = p.gates + (size_t)b * S * 16;
    const bf16_t* QKb = p.QK + (size_t)b * S * 1024 + h * 128; const bf16_t* ZVb = p.ZV + (size_t)b * S * 512 + h * 128 + dvq * 32;
    bf16_t* HSb = p.HS + ((size_t)dir * T + (size_t)b * S) * 512 + h * 128 + dvq * 32;
    __syncthreads();
    for (int i = tid; i < 3 * 34 * RS / 4; i += NTHREADS) ((u32*)(smem + OFF_VT))[i] = 0u;
    for (int cc = 0; cc < 4; ++cc) { const int c = wid * 4 + cc, tau0 = c * 128 + 2 * lane; const int tok0 = dir ? S - 1 - tau0 : tau0, tok1 = dir ? tok0 - 1 : tok0 + 1;
      const float li0 = gts[(size_t)tok0 * 16 + dir * 4 + h], gf0 = gts[(size_t)tok0 * 16 + 8 + dir * 4 + h], li1 = gts[(size_t)tok1 * 16 + dir * 4 + h], gf1 = gts[(size_t)tok1 * 16 + 8 + dir * 4 + h];
      const float lf0 = fminf(gf0, 0.f) - log1pf(__expf(-fabsf(gf0))), lf1 = fminf(gf1, 0.f) - log1pf(__expf(-fabsf(gf1)));
      const float pr = lf0 + lf1; float incl = pr;
#pragma unroll
      for (int o = 1; o < 64; o <<= 1) { const float v = __shfl_up(incl, o); if (lane >= o) incl += v; }
      const float b0 = incl - pr + lf0, b1 = b0 + lf1, a0 = li0 - b0, a1 = li1 - b1;
      float im = fmaxf(a0, a1);
#pragma unroll
      for (int o = 1; o < 64; o <<= 1) { const float v = __shfl_up(im, o); if (lane >= o) im = fmaxf(im, v); }
      float ex = __shfl_up(im, 1); if (lane == 0) ex = -INFINITY;
      const float pa0 = fmaxf(ex, a0), pa1 = fmaxf(pa0, a1);
      LA[tau0] = a0; LA[tau0 + 1] = a1; LPA[tau0] = pa0; LPA[tau0 + 1] = pa1; if (lane == 63) LM[64 + c] = b1; }
    __syncthreads();
    if (tid == 0) { float m = 0.f; for (int c = 0; c < 32; ++c) { LM[c] = m; m = LM[64 + c] + fmaxf(m, LPA[c * 128 + 127]); } LM[32] = m; }
    __syncthreads();
    u32x4 qreg[4], kreg[4], vreg;
#define ML_TOK(tau) (dir ? S - 1 - (tau) : (tau))
#define ML_LOAD(c) do { _Pragma("unroll") for (int i_ = 0; i_ < 4; ++i_) { const int tk_ = ML_TOK((c) * 128 + (tid >> 4) + 32 * i_); \
        qreg[i_] = *(const u32x4*)(QKb + (size_t)tk_ * 1024 + (tid & 15) * 8); kreg[i_] = *(const u32x4*)(QKb + (size_t)tk_ * 1024 + 512 + (tid & 15) * 8); } \
      { const int tk_ = ML_TOK((c) * 128 + (tid & 127)); vreg = *(const u32x4*)(ZVb + (size_t)tk_ * 512 + (tid >> 7) * 8); } } while (0)
#define ML_LI(c) gts[(size_t)ML_TOK((c) * 128 + (tid & 127)) * 16 + dir * 4 + h]
#define ML_TABLES(c, li_) do { if (tid < 128) { const int tau_ = (c) * 128 + tid; const float a_ = LA[tau_], mc_ = LM[(c)]; \
        const float Mj_ = fmaxf(mc_, LPA[tau_]), Me_ = fmaxf(mc_, LPA[(c) * 128 + 127]); float* tb_ = LTAB + ((c) & 1) * 512; \
        tb_[tid] = __expf(fminf(Me_ - Mj_, 60.f)); tb_[128 + tid] = __expf(mc_ - Mj_); tb_[256 + tid] = __expf(-((li_ - a_) + Mj_)); tb_[384 + tid] = __expf(a_ - Me_); } } while (0)
#define ML_STORE(c) do { _Pragma("unroll") for (int i_ = 0; i_ < 4; ++i_) { const int row_ = (tid >> 4) + 32 * i_; \
        *(u32x4*)(smem + OFF_Q + row_ * RS + (tid & 15) * 16) = qreg[i_]; *(u32x4*)(smem + OFF_K + row_ * RS + (tid & 15) * 16) = kreg[i_]; } \
      { const int s_ = tid & 127, ps_ = spos(s_) * 2; const float we_ = LTAB[((c) & 1) * 512 + 384 + s_]; const u32 vw_[4] = {vreg.x, vreg.y, vreg.z, vreg.w}; \
        _Pragma("unroll") for (int i_ = 0; i_ < 4; ++i_) { const int r0_ = ((tid >> 7) * 8 + 2 * i_) * RS + ps_; \
          *(bf16_t*)(smem + OFF_VT + r0_) = (bf16_t)(vw_[i_] & 0xFFFFu); *(bf16_t*)(smem + OFF_VT + r0_ + RS) = (bf16_t)(vw_[i_] >> 16); \
          *(bf16_t*)(smem + OFF_VW + r0_) = f2bf(bflo(vw_[i_]) * we_); *(bf16_t*)(smem + OFF_VW + r0_ + RS) = f2bf(bfhi(vw_[i_]) * we_); } } \
      if (tid < 128) { const int ps_ = spos(tid) * 2; *(bf16_t*)(smem + OFF_VT + 32 * RS + ps_) = (bf16_t)0x3F80u; *(bf16_t*)(smem + OFF_VW + 32 * RS + ps_) = f2bf(LTAB[((c) & 1) * 512 + 384 + tid]); } } while (0)
    float li_pf = ML_LI(0);
    ML_LOAD(0); ML_TABLES(0, li_pf);
    li_pf = ML_LI(1);
    __syncthreads();
    ML_STORE(0);
    __syncthreads();
    f32x16 Cacc;
#pragma unroll
    for (int r = 0; r < 16; ++r) Cacc[r] = 0.f;
    for (int c = 0; c < 32; ++c) {
      int tidc_ = threadIdx.x; asm volatile("" : "+v"(tidc_));
      const int tid = tidc_, wid = tid >> 6, lane = tid & 63, l31 = lane & 31, hh = lane >> 5;
      const int t2 = wid >> 1, nt = wid & 1, brow = min(nt * 32 + l31, 33);
      if (c + 1 < 32) { ML_LOAD(c + 1); ML_TABLES(c + 1, li_pf); }
      if (c + 2 < 32) li_pf = ML_LI(c + 2);
      const float* tab = LTAB + (c & 1) * 512;
      f32x16 acc;
#pragma unroll
      for (int r = 0; r < 16; ++r) acc[r] = 0.f;
      const char* qa = smem + OFF_Q + (t2 * 32 + l31) * RS + hh * 16;
      if (nt == 0) { const char* cb = smem + OFF_CT + l31 * RS + hh * 16;
#pragma unroll
        for (int ks = 0; ks < 8; ++ks) acc = ML_MFMA(*(const bf16x8*)(qa + ks * 32), *(const bf16x8*)(cb + ks * 32), acc);
#pragma unroll
        for (int r = 0; r < 16; ++r) acc[r] *= tab[128 + t2 * 32 + crow(r, hh)];
      } else { const char* cb = smem + OFF_CT + (l31 == 0 ? 32 : 33) * RS + hh * 16; f32x16 aq;
#pragma unroll
        for (int r = 0; r < 16; ++r) aq[r] = 0.f;
#pragma unroll
        for (int ks = 0; ks < 8; ++ks) aq = ML_MFMA(*(const bf16x8*)(qa + ks * 32), *(const bf16x8*)(cb + ks * 32), aq);
        if (l31 == 0) {
#pragma unroll
          for (int r = 0; r < 16; ++r) { const int j = t2 * 32 + crow(r, hh); LDEN[256 + j] = aq[r] * tab[128 + j]; } } }
      const float fj = tab[t2 * 32 + l31];
      float psum = 0.f;
      for (int si = nt; si <= t2; si += 2) {
        f32x16 X;
#pragma unroll
        for (int r = 0; r < 16; ++r) X[r] = 0.f;
        const char* ka = smem + OFF_K + (si * 32 + l31) * RS + hh * 16;
#pragma unroll
        for (int ks = 0; ks < 8; ++ks) X = ML_MFMA(*(const bf16x8*)(ka + ks * 32), *(const bf16x8*)(qa + ks * 32), X);
        const float* We = tab + 384 + si * 32;
#pragma unroll
        for (int r = 0; r < 16; ++r) { const int sl = crow(r, hh); float w = We[sl] * fj; if (si == t2 && sl > l31) w = 0.f; X[r] *= w; psum += X[r]; }
        const bf16x8 f0 = pack8(X[0], X[1], X[2], X[3], X[4], X[5], X[6], X[7]), f1 = pack8(X[8], X[9], X[10], X[11], X[12], X[13], X[14], X[15]);
        const char* vb = smem + OFF_VT + l31 * RS + si * 64 + hh * 16;
        acc = ML_MFMA(f0, *(const bf16x8*)(vb), acc); acc = ML_MFMA(f1, *(const bf16x8*)(vb + 32), acc);
      }
      psum = sum32x(psum);
      if (hh == 0) LDEN[nt * 128 + t2 * 32 + l31] = psum;
      if (nt == 1) { float* ex = (float*)(smem + OFF_EX) + t2 * 1024 + lane;
#pragma unroll
        for (int r = 0; r < 16; ++r) ex[r * 64] = acc[r]; }
      { const float mc = LM[c], decay = __expf(mc - fmaxf(mc, LPA[c * 128 + 127]));
#pragma unroll
        for (int r = 0; r < 16; ++r) Cacc[r] *= decay;
        const unsigned ta = lds0 + OFF_K + ((lane & 15) >> 2) * RS + (t2 * 32 + 16 * ((lane >> 4) & 1) + 4 * (lane & 3)) * 2 + 4 * hh * RS;
        const char* wb = smem + OFF_VW + brow * RS + hh * 16;
#pragma unroll
        for (int kq = 0; kq < 2; ++kq) { s16x4 r0, r1, r2, r3, r4, r5, r6, r7; tr_read8(ta + 64 * kq * RS, r0, r1, r2, r3, r4, r5, r6, r7); __builtin_amdgcn_sched_barrier(0);
          Cacc = ML_MFMA(((bf16x8){r0[0], r0[1], r0[2], r0[3], r1[0], r1[1], r1[2], r1[3]}), *(const bf16x8*)(wb + (4 * kq + 0) * 32), Cacc);
          Cacc = ML_MFMA(((bf16x8){r2[0], r2[1], r2[2], r2[3], r3[0], r3[1], r3[2], r3[3]}), *(const bf16x8*)(wb + (4 * kq + 1) * 32), Cacc);
          Cacc = ML_MFMA(((bf16x8){r4[0], r4[1], r4[2], r4[3], r5[0], r5[1], r5[2], r5[3]}), *(const bf16x8*)(wb + (4 * kq + 2) * 32), Cacc);
          Cacc = ML_MFMA(((bf16x8){r6[0], r6[1], r6[2], r6[3], r7[0], r7[1], r7[2], r7[3]}), *(const bf16x8*)(wb + (4 * kq + 3) * 32), Cacc); } }
      __syncthreads();
      if (nt == 0) { const float* ex = (const float*)(smem + OFF_EX) + t2 * 1024 + lane;
#pragma unroll
        for (int r = 0; r < 16; ++r) { const int j = t2 * 32 + crow(r, hh); const float dn = LDEN[j] + LDEN[128 + j] + LDEN[256 + j], nr = tab[256 + j];
          *(bf16_t*)(smem + OFF_OUT + j * 80 + l31 * 2) = f2bf((acc[r] + ex[r * 64]) * __builtin_amdgcn_rcpf(fmaxf(fabsf(dn), nr))); } }
      if (nt * 32 + l31 <= 32) { char* cw = smem + OFF_CT + (nt * 32 + l31) * RS + (t2 * 32 + 4 * hh) * 2;
#pragma unroll
        for (int g = 0; g < 4; ++g) { u32x2 w; w.x = pack2(Cacc[4 * g], Cacc[4 * g + 1]); w.y = pack2(Cacc[4 * g + 2], Cacc[4 * g + 3]); *(u32x2*)(cw + 16 * g) = w; } }
      if (c + 1 < 32) ML_STORE(c + 1);
      __syncthreads();
      { const int j = tid >> 2, ch = tid & 3; const u32x4 o = *(const u32x4*)(smem + OFF_OUT + j * 80 + ch * 16);
        *(u32x4*)(HSb + (size_t)ML_TOK(c * 128 + j) * 512 + ch * 8) = o; }
    }
#undef ML_TOK
#undef ML_LOAD
#undef ML_TABLES
#undef ML_LI
#undef ML_STORE
  }
}
}

namespace sel {
typedef short bf16x8 __attribute__((ext_vector_type(8)));
typedef float f32x16 __attribute__((ext_vector_type(16)));
constexpr int RS = 272, OFF_W = 2 * 128 * RS, WB = 3 * 16 * 32 * 4;
static_assert(OFF_W + 8 * WB <= SMEM_BYTES, "select LDS layout");
constexpr float NEG = -3.0e38f;
__device__ __forceinline__ float max3(float a, float b, float c) { return fmaxf(fmaxf(a, b), c); }
__device__ __forceinline__ float xhalf(float v) { return __shfl_xor(v, 32); }

#define CE(a, b) do { const float hi_ = fmaxf(a, b), lo_ = fminf(a, b); a = hi_; b = lo_; } while (0)
#define SORT16(V) do { CE(V[0], V[1]); CE(V[2], V[3]); CE(V[0], V[2]); CE(V[1], V[3]); CE(V[1], V[2]); CE(V[4], V[5]); CE(V[6], V[7]); CE(V[4], V[6]); CE(V[5], V[7]); CE(V[5], V[6]); CE(V[0], V[4]); CE(V[2], V[6]); CE(V[2], V[4]); CE(V[1], V[5]); CE(V[3], V[7]); CE(V[3], V[5]); CE(V[1], V[2]); CE(V[3], V[4]); CE(V[5], V[6]); CE(V[8], V[9]); CE(V[10], V[11]); CE(V[8], V[10]); CE(V[9], V[11]); CE(V[9], V[10]); CE(V[12], V[13]); CE(V[14], V[15]); CE(V[12], V[14]); CE(V[13], V[15]); CE(V[13], V[14]); CE(V[8], V[12]); CE(V[10], V[14]); CE(V[10], V[12]); CE(V[9], V[13]); CE(V[11], V[15]); CE(V[11], V[13]); CE(V[9], V[10]); CE(V[11], V[12]); CE(V[13], V[14]); CE(V[0], V[8]); CE(V[4], V[12]); CE(V[4], V[8]); CE(V[2], V[10]); CE(V[6], V[14]); CE(V[6], V[10]); CE(V[2], V[4]); CE(V[6], V[8]); CE(V[10], V[12]); CE(V[1], V[9]); CE(V[5], V[13]); CE(V[5], V[9]); CE(V[3], V[11]); CE(V[7], V[15]); CE(V[7], V[11]); CE(V[3], V[5]); CE(V[7], V[9]); CE(V[11], V[13]); CE(V[1], V[2]); CE(V[3], V[4]); CE(V[5], V[6]); CE(V[7], V[8]); CE(V[9], V[10]); CE(V[11], V[12]); CE(V[13], V[14]); } while (0)
#define BMERGE16(V) do { CE(V[0], V[8]); CE(V[1], V[9]); CE(V[2], V[10]); CE(V[3], V[11]); CE(V[4], V[12]); CE(V[5], V[13]); CE(V[6], V[14]); CE(V[7], V[15]); CE(V[0], V[4]); CE(V[1], V[5]); CE(V[2], V[6]); CE(V[3], V[7]); CE(V[8], V[12]); CE(V[9], V[13]); CE(V[10], V[14]); CE(V[11], V[15]); CE(V[0], V[2]); CE(V[1], V[3]); CE(V[4], V[6]); CE(V[5], V[7]); CE(V[8], V[10]); CE(V[9], V[11]); CE(V[12], V[14]); CE(V[13], V[15]); CE(V[0], V[1]); CE(V[2], V[3]); CE(V[4], V[5]); CE(V[6], V[7]); CE(V[8], V[9]); CE(V[10], V[11]); CE(V[12], V[13]); CE(V[14], V[15]); } while (0)

}

typedef float f32x2 __attribute__((ext_vector_type(2)));
typedef unsigned u32x3 __attribute__((ext_vector_type(3)));
typedef unsigned u32x6 __attribute__((ext_vector_type(6)));
typedef unsigned u32x16 __attribute__((ext_vector_type(16)));
typedef float f32x32 __attribute__((ext_vector_type(32)));
constexpr int GT = 4;
constexpr int GW_WAVE_BYTES = GT * (2048 + 128 * 2 + 128 * 4);
static_assert(8 * GW_WAVE_BYTES <= SMEM_BYTES - 16, "gather LDS layout");
__device__ __forceinline__ float gelu_erf(float z) { const float ax = fabsf(z) * 0.70710678118654752f;
  const float t = __builtin_amdgcn_rcpf(fmaf(0.3275911f, ax, 1.f));
  float pl = fmaf(1.061405429f, t, -1.453152027f); pl = fmaf(pl, t, 1.421413741f); pl = fmaf(pl, t, -0.284496736f); pl = fmaf(pl, t, 0.254829592f); pl *= t;
  const float er = 1.f - pl * __expf(-ax * ax);
  return 0.5f * z + 0.5f * fabsf(z) * er; }
__device__ __forceinline__ float reduce8(float d0, float d1, float d2, float d3, float d4, float d5, float d6, float d7, int lane) {
  float e[4];
  { auto r0 = __builtin_amdgcn_permlane32_swap(__float_as_uint(d0), __float_as_uint(d4), false, false); e[0] = __uint_as_float(r0[0]) + __uint_as_float(r0[1]);
    auto r1 = __builtin_amdgcn_permlane32_swap(__float_as_uint(d1), __float_as_uint(d5), false, false); e[1] = __uint_as_float(r1[0]) + __uint_as_float(r1[1]);
    auto r2 = __builtin_amdgcn_permlane32_swap(__float_as_uint(d2), __float_as_uint(d6), false, false); e[2] = __uint_as_float(r2[0]) + __uint_as_float(r2[1]);
    auto r3 = __builtin_amdgcn_permlane32_swap(__float_as_uint(d3), __float_as_uint(d7), false, false); e[3] = __uint_as_float(r3[0]) + __uint_as_float(r3[1]); }
  float f0, f1;
  { auto r0 = __builtin_amdgcn_permlane16_swap(__float_as_uint(e[0]), __float_as_uint(e[2]), false, false); f0 = __uint_as_float(r0[0]) + __uint_as_float(r0[1]);
    auto r1 = __builtin_amdgcn_permlane16_swap(__float_as_uint(e[1]), __float_as_uint(e[3]), false, false); f1 = __uint_as_float(r1[0]) + __uint_as_float(r1[1]); }
  const bool up = (lane & 8) != 0; const float keep = up ? f1 : f0, send = up ? f0 : f1;
  float g = keep + dppf<DPP_MIR>(send);
  g += dppf<DPP_X1>(g); g += dppf<DPP_X2>(g); g += dppf<DPP_HMIR>(g);
  return g;
}
__device__ __forceinline__ int reduce8i(int d0, int d1, int d2, int d3, int d4, int d5, int d6, int d7, int lane) {
  int e[4];
  { auto r0 = __builtin_amdgcn_permlane32_swap((unsigned)d0, (unsigned)d4, false, false); e[0] = (int)(r0[0] + r0[1]);
    auto r1 = __builtin_amdgcn_permlane32_swap((unsigned)d1, (unsigned)d5, false, false); e[1] = (int)(r1[0] + r1[1]);
    auto r2 = __builtin_amdgcn_permlane32_swap((unsigned)d2, (unsigned)d6, false, false); e[2] = (int)(r2[0] + r2[1]);
    auto r3 = __builtin_amdgcn_permlane32_swap((unsigned)d3, (unsigned)d7, false, false); e[3] = (int)(r3[0] + r3[1]); }
  int f0, f1;
  { auto r0 = __builtin_amdgcn_permlane16_swap((unsigned)e[0], (unsigned)e[2], false, false); f0 = (int)(r0[0] + r0[1]);
    auto r1 = __builtin_amdgcn_permlane16_swap((unsigned)e[1], (unsigned)e[3], false, false); f1 = (int)(r1[0] + r1[1]); }
  const bool up = (lane & 8) != 0; const int keep = up ? f1 : f0, send = up ? f0 : f1;
  int g = keep + dppi<DPP_MIR>(send);
  g += dppi<DPP_X1>(g); g += dppi<DPP_X2>(g); g += dppi<DPP_HMIR>(g);
  return g;
}
constexpr int PF_LIDX = 2 * 128 * 272, PF_LGATE = PF_LIDX + 32 * 128 * 2, PF_X = PF_LGATE + 32 * 128 * 4;
static_assert(PF_X + 8 * 8192 <= SMEM_BYTES - 16 && GT == 4, "fused PEER LDS layout");
template <int NEXT>
__device__ void phase_peer_fused(const Params& p, int layer, char* smem) {
  using namespace sel;
  bf16_t* const Lidx = (bf16_t*)(smem + PF_LIDX); float* const Lgate = (float*)(smem + PF_LGATE);
  const int tid0 = threadIdx.x;
  __syncthreads();
  { const bf16_t* kb = p.keysb + (size_t)layer * 32768;
    for (int i = tid0; i < 2 * 128 * 16; i += NTHREADS) { const int row = i >> 4, ch = i & 15; *(u32x4*)(smem + row * RS + ch * 16) = *(const u32x4*)(kb + (size_t)row * 128 + ch * 8); } }
  __syncthreads();
  const __amdgpu_buffer_rsrc_t rsU = __builtin_amdgcn_make_buffer_rsrc((void*)(p.U8 + (size_t)layer * 16384 * 768), 0, 16384 * 768, 0x00020000);
  const __amdgpu_buffer_rsrc_t rsV = __builtin_amdgcn_make_buffer_rsrc((void*)(p.V8 + (size_t)layer * 16384 * 768), 0, 16384 * 768, 0x00020000);
  for (int job = blockIdx.x; job < T / 32; job += gridDim.x) {
   {
    int tid_ = threadIdx.x; asm volatile("" : "+v"(tid_));
    const int tid = tid_, wid = tid >> 6, lane = tid & 63, l31 = lane & 31, hh = lane >> 5, h = wid;
    const int t = job * 32 + l31;
    float* const wl = (float*)(smem + PF_X + wid * 8192);
    float rs[2], s1[16], s2[16];
#pragma unroll
    for (int pp = 0; pp < 2; ++pp) {
      const bf16_t* qrow = p.QP + ((((((size_t)(t >> 5) * 8 + h) * 2 + pp) * 8) * 2 + hh) * 32 + (t & 31)) * 8;
      bf16x8 bq[8]; float ssq = 0.f;
#pragma unroll
      for (int ks = 0; ks < 8; ++ks) { const u32x4 w = *(const u32x4*)(qrow + ks * 512); bq[ks] = __builtin_bit_cast(bf16x8, w);
        const u32 w0 = w.x, w1 = w.y, w2 = w.z, w3 = w.w; ssq = dot2bf(w0, w0, ssq); ssq = dot2bf(w1, w1, ssq); ssq = dot2bf(w2, w2, ssq); ssq = dot2bf(w3, w3, ssq); }
      ssq = sum32x(ssq); rs[pp] = rsqrtf(ssq * (1.f / 128.f) + EPS);
      f32x16 X[4];
#pragma unroll
      for (int nt = 0; nt < 4; ++nt) {
#pragma unroll
        for (int r = 0; r < 16; ++r) X[nt][r] = 0.f;
        const char* ka = smem + (pp * 128 + nt * 32 + l31) * RS + hh * 16;
#pragma unroll
        for (int ks = 0; ks < 8; ++ks) X[nt] = __builtin_amdgcn_mfma_f32_32x32x16_bf16(*(const bf16x8*)(ka + ks * 32), bq[ks], X[nt], 0, 0, 0); }
#pragma unroll
      for (int nt = 0; nt < 4; ++nt)
#pragma unroll
        for (int r = 0; r < 16; ++r) X[nt][r] = __uint_as_float((__float_as_uint(X[nt][r]) & ~0x7Fu) | (u32)(nt * 32 + (r & 3) + 8 * (r >> 2)) | ((u32)hh << 2));
      SORT16(X[0]); SORT16(X[1]); SORT16(X[2]); SORT16(X[3]);
#pragma unroll
      for (int i = 0; i < 16; ++i) { X[0][i] = fmaxf(X[0][i], X[1][15 - i]); X[2][i] = fmaxf(X[2][i], X[3][15 - i]); }
      BMERGE16(X[0]); BMERGE16(X[2]);
#pragma unroll
      for (int i = 0; i < 16; ++i) X[0][i] = fmaxf(X[0][i], X[2][15 - i]);
      BMERGE16(X[0]);
      f32x16 lo_, hi_;
#pragma unroll
      for (int i = 0; i < 16; ++i) { const u32 b_ = __float_as_uint(X[0][i]); auto r_ = __builtin_amdgcn_permlane32_swap(b_, b_, false, false); lo_[i] = __uint_as_float(r_[0]); hi_[i] = __uint_as_float(r_[1]); }
#pragma unroll
      for (int i = 0; i < 16; ++i) X[0][i] = fmaxf(lo_[i], hi_[15 - i]);
      BMERGE16(X[0]);
#pragma unroll
      for (int k = 0; k < 16; ++k) { wl[(pp * 16 + k) * 32 + l31] = X[0][k]; if (pp == 0) s1[k] = X[0][k] * rs[0]; else s2[k] = X[0][k] * rs[1]; }
    }
    constexpr int A0[25] = {0, 0, 0, 0, 0, 0, 0, 0, 0, 0, 0, 0, 0, 0, 0, 0, 2, 2, 2, 2, 2, 3, 3, 3, 3}, B0[25] = {0, 1, 2, 3, 4, 5, 6, 7, 8, 9, 10, 11, 12, 13, 14, 15, 0, 1, 2, 3, 4, 0, 1, 2, 3};
    constexpr int A1[25] = {1, 1, 1, 1, 1, 1, 1, 1, 4, 4, 4, 5, 5, 6, 6, 7, 7, 8, 9, 10, 11, 12, 13, 14, 15}, B1[25] = {0, 1, 2, 3, 4, 5, 6, 7, 0, 1, 2, 0, 1, 0, 1, 0, 1, 0, 0, 0, 0, 0, 0, 0, 0};
    float cd[25]; u32 hmask = 0u - (u32)hh; asm volatile("" : "+v"(hmask));
#pragma unroll
    for (int i = 0; i < 25; ++i) { const float v0 = s1[A0[i]] + s2[B0[i]], v1 = s1[A1[i]] + s2[B1[i]]; const float v = hh ? v1 : v0; const u32 cid = (u32)(A0[i] * 16 + B0[i]) ^ (hmask & (u32)((A1[i] * 16 + B1[i]) ^ (A0[i] * 16 + B0[i])));
      cd[i] = __uint_as_float((__float_as_uint(v) & ~0xFFu) | cid); }
#pragma unroll 1
    for (int k = 0; k < 16; ++k) {
      float m = cd[24];
#pragma unroll
      for (int i = 0; i < 24; i += 2) m = max3(m, cd[i], cd[i + 1]);
      const float M = max32x(m);
      wl[(32 + k) * 32 + l31] = M;
#pragma unroll
      for (int i = 0; i < 25; ++i) cd[i] = (cd[i] == M) ? NEG : cd[i];
    }
    float tv[16];
#pragma unroll
    for (int k = 0; k < 16; ++k) tv[k] = wl[(32 + k) * 32 + l31];
    float sum = 0.f;
#pragma unroll
    for (int k = 0; k < 16; ++k) sum += __expf(tv[k] - tv[0]);
    const float inv = 1.f / sum;
    u32 ev[8]; float go[8];
#pragma unroll
    for (int q = 0; q < 8; ++q) { const float v = wl[(32 + hh * 8 + q) * 32 + l31]; const u32 cid = __float_as_uint(v) & 0xFFu;
      const u32 i1 = __float_as_uint(wl[(cid >> 4) * 32 + l31]) & 0x7Fu, i2 = __float_as_uint(wl[(16 + (cid & 15)) * 32 + l31]) & 0x7Fu; ev[q] = i1 * 128 + i2;
      go[q] = __expf(v - tv[0]) * inv; }
    const u32 io0 = ev[0] | (ev[1] << 16), io1 = ev[2] | (ev[3] << 16), io2 = ev[4] | (ev[5] << 16), io3 = ev[6] | (ev[7] << 16);
    { const int ob = l31 * 128 + h * 16 + hh * 8;
      *(u32x4*)(Lidx + ob) = (u32x4){io0, io1, io2, io3};
      *(f32x4*)(Lgate + ob) = (f32x4){go[0], go[1], go[2], go[3]}; *(f32x4*)(Lgate + ob + 4) = (f32x4){go[4], go[5], go[6], go[7]}; }
   }
   __syncthreads();
   {
    int tid_ = threadIdx.x; asm volatile("" : "+v"(tid_));
    const int tid = tid_, wid = tid >> 6, lane = tid & 63;
    const int tb = (job * 8 + wid) * GT;
    const int vidx = 4 * (lane >> 5) + 2 * ((lane >> 4) & 1) + ((lane >> 3) & 1); const unsigned lane16 = (unsigned)lane * 16u, lane12 = (unsigned)lane * 12u;
    bf16_t* sx = (bf16_t*)(smem + PF_X + wid * 8192); bf16_t* sidx = Lidx + wid * GT * 128; float* sgate = Lgate + wid * GT * 128;
#pragma unroll 1
    for (int g = 0; g < GT; ++g) { const size_t t = (size_t)(tb + g);
      { const u32x4 h0 = *(const u32x4*)(p.H + t * D + lane * 16), h1 = *(const u32x4*)(p.H + t * D + lane * 16 + 8);
        *(u32x4*)((char*)sx + g * 2048 + lane * 16) = h0; *(u32x4*)((char*)sx + g * 2048 + 1024 + lane * 16) = h1; }
      const int ia = sidx[g * 128 + lane], ib = sidx[g * 128 + 64 + lane]; const float ga = sgate[g * 128 + lane], gb = sgate[g * 128 + 64 + lane];
      const int wa = ia >> 10, wb = ib >> 10; int off = 0, pa = 0, pb = 0;
#pragma unroll
      for (int w = 0; w < 16; ++w) { const unsigned long long m0 = __ballot(wa == w), m1 = __ballot(wb == w); const int c0 = __popcll(m0), c1 = __popcll(m1);
        const int r0 = __builtin_amdgcn_mbcnt_hi((unsigned)(m0 >> 32), __builtin_amdgcn_mbcnt_lo((unsigned)m0, 0)), r1 = __builtin_amdgcn_mbcnt_hi((unsigned)(m1 >> 32), __builtin_amdgcn_mbcnt_lo((unsigned)m1, 0));
        if (wa == w) pa = off + r0; if (wb == w) pb = off + c0 + r1; off += c0 + c1; }
      sidx[g * 128 + pa] = (bf16_t)ia; sgate[g * 128 + pa] = ga; sidx[g * 128 + pb] = (bf16_t)ib; sgate[g * 128 + pb] = gb; }
    f32x2 acc[GT][8];
#pragma unroll
    for (int g = 0; g < GT; ++g)
#pragma unroll
      for (int i = 0; i < 8; ++i) acc[g][i] = (f32x2){0.f, 0.f};
    if (wid >= 4) __builtin_amdgcn_s_sleep(35);
#pragma unroll 1
    for (int hb = 0; hb < 16; ++hb) {
#pragma unroll
      for (int g = 0; g < GT; ++g) {
        const int myidx = (int)sidx[g * 128 + hb * 8 + (lane & 7)]; const float mygate = sgate[g * 128 + hb * 8 + vidx];
        const u32x4 h0 = *(const u32x4*)((const char*)sx + g * 2048 + lane * 16), h1 = *(const u32x4*)((const char*)sx + g * 2048 + 1024 + lane * 16);
        const u32 hx[8] = {h0.x, h0.y, h0.z, h0.w, h1.x, h1.y, h1.z, h1.w};
        u32x3 ur[8], vr[8];
#pragma unroll
        for (int k = 0; k < 8; ++k) { const unsigned e = (unsigned)__builtin_amdgcn_readlane(myidx, k); ur[k] = __builtin_amdgcn_raw_buffer_load_b96(rsU, lane12, e * 768u, 0); if (k < 4) vr[k] = __builtin_amdgcn_raw_buffer_load_b96(rsV, lane12, e * 768u, 0); }
        float d[8];
#pragma unroll
        for (int kk = 0; kk < 4; ++kk) { const int k0 = 2 * kk, k1 = 2 * kk + 1;
          const u32x6 pk = {ur[k0].x, ur[k0].y, ur[k0].z, ur[k1].x, ur[k1].y, ur[k1].z};
          const u32x16 ub = __builtin_bit_cast(u32x16, __builtin_amdgcn_cvt_scalef32_pk32_bf16_fp6(pk, 1.0f));
          float a0 = 0.f, a1 = 0.f;
#pragma unroll
          for (int j = 0; j < 8; ++j) { const u32 w0 = ub[j], w1 = ub[8 + j]; a0 = dot2bf(w0, hx[j], a0); a1 = dot2bf(w1, hx[j], a1); }
          d[k0] = a0; d[k1] = a1; }
        asm volatile("" ::: "memory");
#pragma unroll
        for (int k = 4; k < 8; ++k) { const unsigned e = (unsigned)__builtin_amdgcn_readlane(myidx, k); vr[k] = __builtin_amdgcn_raw_buffer_load_b96(rsV, lane12, e * 768u, 0); }
        const float z = reduce8(d[0], d[1], d[2], d[3], d[4], d[5], d[6], d[7], lane) * (1.f / U6_SCALE);
        __builtin_amdgcn_sched_barrier(0);
        const float cf = mygate * gelu_erf(z) * (1.f / V6_SCALE);
        __builtin_amdgcn_sched_barrier(0);
#pragma unroll
        for (int kk = 0; kk < 4; ++kk) { const int k0 = 2 * kk, k1 = 2 * kk + 1;
          const float c0 = __uint_as_float(__builtin_amdgcn_readlane(__float_as_uint(cf), 32 * (k0 >> 2) + 16 * ((k0 >> 1) & 1) + 8 * (k0 & 1)));
          const float c1 = __uint_as_float(__builtin_amdgcn_readlane(__float_as_uint(cf), 32 * (k1 >> 2) + 16 * ((k1 >> 1) & 1) + 8 * (k1 & 1)));
          const u32x6 pk = {vr[k0].x, vr[k0].y, vr[k0].z, vr[k1].x, vr[k1].y, vr[k1].z};
          const f32x32 f = __builtin_amdgcn_cvt_scalef32_pk32_f32_fp6(pk, 1.0f);
          const f32x2 ca = (f32x2){c0, c0}, cb = (f32x2){c1, c1};
#pragma unroll
          for (int j = 0; j < 8; ++j) acc[g][j] = (f32x2){f[2 * j], f[2 * j + 1]} * ca + acc[g][j];
#pragma unroll
          for (int j = 0; j < 8; ++j) acc[g][j] = (f32x2){f[16 + 2 * j], f[17 + 2 * j]} * cb + acc[g][j]; }
        asm volatile("" ::: "memory");
      }
      if (hb == 7) { __syncthreads(); if (wid >= 4) __builtin_amdgcn_s_sleep(35); }
    }
    f32x4 xr[GT][4];
#pragma unroll
    for (int g = 0; g < GT; ++g)
#pragma unroll
      for (int q = 0; q < 4; ++q) xr[g][q] = *(const f32x4*)(p.X + (size_t)(tb + g) * D + lane * 16 + 4 * q);
#pragma unroll
    for (int g = 0; g < GT; ++g) { const int t = tb + g, b = t / S;
      const float* g2 = p.mod + (size_t)(layer * 8 + b) * 6144 + 5120 + lane * 16; float* xp = p.X + (size_t)t * D + lane * 16;
      float xv[16]; float ss = 0.f;
#pragma unroll
      for (int q = 0; q < 4; ++q) { const f32x4 x0 = xr[g][q], g0 = *(const f32x4*)(g2 + 4 * q);
        xv[4 * q + 0] = x0.x + g0.x * acc[g][2 * q].x; xv[4 * q + 1] = x0.y + g0.y * acc[g][2 * q].y; xv[4 * q + 2] = x0.z + g0.z * acc[g][2 * q + 1].x; xv[4 * q + 3] = x0.w + g0.w * acc[g][2 * q + 1].y; }
#pragma unroll
      for (int i = 0; i < 16; ++i) ss += xv[i] * xv[i];
      ss = wave_sum(ss); const float r = rsqrtf(ss * (1.f / D) + EPS);
      if (NEXT == 0) {
        const float* ml = p.mod + (size_t)((layer + 1) * 8 + b) * 6144 + lane * 16; const float* gn = p.nmg + (layer + 1) * D + lane * 16; float y[16];
#pragma unroll
        for (int i = 0; i < 16; ++i) y[i] = xv[i] * r * gn[i] * (1.f + ml[1024 + i]) + ml[i];
#pragma unroll
        for (int q = 0; q < 4; ++q) *(f32x4*)(xp + 4 * q) = (f32x4){xv[4 * q], xv[4 * q + 1], xv[4 * q + 2], xv[4 * q + 3]};
        u32x4 w0, w1; w0.x = pack2(y[0], y[1]); w0.y = pack2(y[2], y[3]); w0.z = pack2(y[4], y[5]); w0.w = pack2(y[6], y[7]); w1.x = pack2(y[8], y[9]); w1.y = pack2(y[10], y[11]); w1.z = pack2(y[12], y[13]); w1.w = pack2(y[14], y[15]);
        *(u32x4*)(p.H + (size_t)t * D + lane * 16) = w0; *(u32x4*)(p.H + (size_t)t * D + lane * 16 + 8) = w1;
      } else {
        const float* fg = p.final_g + lane * 16;
#pragma unroll
        for (int q = 0; q < 4; ++q) *(f32x4*)(xp + 4 * q) = (f32x4){xv[4 * q] * r * fg[4 * q], xv[4 * q + 1] * r * fg[4 * q + 1], xv[4 * q + 2] * r * fg[4 * q + 2], xv[4 * q + 3] * r * fg[4 * q + 3]};
      }
      asm volatile("" ::: "memory");
    }
    __syncthreads();
   }
  }
}

template <bool WITH_GATES, bool WITH_RES = false>
__device__ void phase_norm(const Params& p, const float* xin, const float* __restrict__ g, const float* __restrict__ modl, int sh_off, int sc_off, char* smem, const bf16_t* __restrict__ Y = nullptr, int gate_off = 0) {
  constexpr int GRS = 2064;
  char* const wgb = smem; char* const htile = smem + 16 * GRS;
  if (WITH_GATES) { __syncthreads();
    for (int i = threadIdx.x; i < 16 * 128; i += NTHREADS) { const int row = i >> 7, ch = i & 127; const f32x4 a = *(const f32x4*)(p.Wg + row * 1024 + ch * 8), b = *(const f32x4*)(p.Wg + row * 1024 + ch * 8 + 4);
      u32x4 w; w.x = pack2(a.x, a.y); w.y = pack2(a.z, a.w); w.z = pack2(b.x, b.y); w.w = pack2(b.z, b.w); *(u32x4*)(wgb + row * GRS + ch * 16) = w; }
    __syncthreads(); }
  for (int job = blockIdx.x; job < T / 32; job += gridDim.x) {
    int tid_ = threadIdx.x; asm volatile("" : "+v"(tid_));
    const int tid = tid_, wid = tid >> 6, lane = tid & 63; const int tb = job * 32 + wid * 4, b = tb / S;
    f32x4 v[4][4];
#pragma unroll
    for (int q = 0; q < 4; ++q)
#pragma unroll
      for (int i = 0; i < 4; ++i) v[q][i] = *(const f32x4*)(xin + (size_t)(tb + q) * D + i * 256 + lane * 4);
    if (WITH_RES) { const float* gtp = modl + (size_t)b * 6144 + gate_off;
#pragma unroll
      for (int i = 0; i < 4; ++i) { const f32x4 gt = *(const f32x4*)(gtp + i * 256 + lane * 4);
#pragma unroll
        for (int q = 0; q < 4; ++q) { const u32x2 yw = *(const u32x2*)(Y + (size_t)(tb + q) * D + i * 256 + lane * 4);
          v[q][i].x += gt.x * bflo(yw.x); v[q][i].y += gt.y * bfhi(yw.x); v[q][i].z += gt.z * bflo(yw.y); v[q][i].w += gt.w * bfhi(yw.y);
          *(f32x4*)(p.X + (size_t)(tb + q) * D + i * 256 + lane * 4) = v[q][i]; } } }
    const float* shp = modl + (size_t)b * 6144 + sh_off; const float* scp = modl + (size_t)b * 6144 + sc_off;
    f32x4 ga[4], gc[4];
#pragma unroll
    for (int i = 0; i < 4; ++i) { const int d = i * 256 + lane * 4; const f32x4 gg = *(const f32x4*)(g + d), s1 = *(const f32x4*)(scp + d); ga[i] = gg * (1.f + s1); gc[i] = *(const f32x4*)(shp + d); }
#pragma unroll
    for (int q = 0; q < 4; ++q) { float ss = 0.f;
#pragma unroll
      for (int i = 0; i < 4; ++i) ss += v[q][i].x * v[q][i].x + v[q][i].y * v[q][i].y + v[q][i].z * v[q][i].z + v[q][i].w * v[q][i].w;
      ss = wave_sum(ss); const float r = rsqrtf(ss * (1.f / D) + EPS);
#pragma unroll
      for (int i = 0; i < 4; ++i) { v[q][i] = v[q][i] * r * ga[i] + gc[i]; u32x2 w; w.x = pack2(v[q][i].x, v[q][i].y); w.y = pack2(v[q][i].z, v[q][i].w); *(u32x2*)(p.H + (size_t)(tb + q) * D + i * 256 + lane * 4) = w;
        if (WITH_GATES) *(u32x2*)(htile + (wid * 4 + q) * GRS + (i * 256 + lane * 4) * 2) = w; }
    }
    if (WITH_GATES) {
      typedef short bf16x8_ __attribute__((ext_vector_type(8)));
      __syncthreads();
      if (wid < 2) { f32x4 acc = (f32x4){0.f, 0.f, 0.f, 0.f};
        const char* ap = htile + (wid * 16 + (lane & 15)) * GRS + (lane >> 4) * 16; const char* bp = wgb + (lane & 15) * GRS + (lane >> 4) * 16;
#pragma unroll 8
        for (int ks = 0; ks < 32; ++ks) acc = __builtin_amdgcn_mfma_f32_16x16x32_bf16(*(const bf16x8_*)(ap + ks * 64), *(const bf16x8_*)(bp + ks * 64), acc, 0, 0, 0);
        const int gate = lane & 15; const float bias = p.ev_b_in[2560 + gate]; float* gp = p.gates + (size_t)(job * 32 + wid * 16 + 4 * (lane >> 4)) * 16 + gate;
        gp[0] = acc[0] + bias; gp[16] = acc[1] + bias; gp[32] = acc[2] + bias; gp[48] = acc[3] + bias; }
      __syncthreads();
    }
  }
}
__device__ void phase_cat(const Params& p) {
  for (int job = blockIdx.x; job < T / 32; job += gridDim.x) {
    int tid_ = threadIdx.x; asm volatile("" : "+v"(tid_));
    const int tid = tid_, wid = tid >> 6, lane = tid & 63; const int tb = job * 32 + wid * 4;
    u32x4 a[4], bq[4], so[4];
#pragma unroll
    for (int q = 0; q < 4; ++q) { const size_t o = (size_t)(tb + q) * 512 + lane * 8; a[q] = *(const u32x4*)(p.HS + o); bq[q] = *(const u32x4*)(p.HS + (size_t)T * 512 + o); so[q] = *(const u32x4*)(p.ZO + o); }
    const f32x4 g0 = *(const f32x4*)(p.mnorm_g + lane * 8), g1 = *(const f32x4*)(p.mnorm_g + lane * 8 + 4);
#pragma unroll
    for (int q = 0; q < 4; ++q) { float x[8]; const u32 aw[4] = {a[q].x, a[q].y, a[q].z, a[q].w}, bw[4] = {bq[q].x, bq[q].y, bq[q].z, bq[q].w}, sw[4] = {so[q].x, so[q].y, so[q].z, so[q].w};
      float ss = 0.f;
#pragma unroll
      for (int j = 0; j < 4; ++j) { x[2 * j] = bflo(aw[j]) + bflo(bw[j]); x[2 * j + 1] = bfhi(aw[j]) + bfhi(bw[j]); ss += x[2 * j] * x[2 * j] + x[2 * j + 1] * x[2 * j + 1]; }
      ss = row_sum(ss);
      const float r = rsqrtf(ss * (1.f / 128.f) + EPS);
      u32x4 w; w.x = pack2(x[0] * r * g0.x * bflo(sw[0]), x[1] * r * g0.y * bfhi(sw[0])); w.y = pack2(x[2] * r * g0.z * bflo(sw[1]), x[3] * r * g0.w * bfhi(sw[1]));
      w.z = pack2(x[4] * r * g1.x * bflo(sw[2]), x[5] * r * g1.y * bfhi(sw[2])); w.w = pack2(x[6] * r * g1.z * bflo(sw[3]), x[7] * r * g1.w * bfhi(sw[3]));
      *(u32x4*)(p.CAT + (size_t)(tb + q) * 1024 + lane * 8) = w; }
  }
}
__device__ void phase_qkrope(const Params& p, char* smem) {
  float* tab = (float*)smem;
  __syncthreads();
  for (int i = threadIdx.x; i < 64 * 32; i += NTHREADS) { const int pos = i >> 5, fi = i & 31; const float fr = exp2f(-(float)(2 * fi) * (13.287712379549449f / 64.f)); float sn, cs; sincosf((float)pos * fr, &sn, &cs); tab[2 * i] = cs; tab[2 * i + 1] = sn; }
  __syncthreads();
  for (int job = blockIdx.x; job < T / 16; job += gridDim.x) {
    int tid_ = threadIdx.x; asm volatile("" : "+v"(tid_));
    const int tid = tid_, wid = tid >> 6, lane = tid & 63; const int t = job * 16 + wid * 2 + (lane >> 5), kvh = (lane >> 4) & 1, cc = lane & 15, b = t / S, s = t & (S - 1);
    const u32x4 raw = *(const u32x4*)(p.QKV + (size_t)t * 1536 + 1024 + kvh * 128 + cc * 8); const u32 rw[4] = {raw.x, raw.y, raw.z, raw.w}; float x[8];
#pragma unroll
    for (int j = 0; j < 4; ++j) { x[2 * j] = bflo(rw[j]); x[2 * j + 1] = bfhi(rw[j]); }
    float ss = 0.f;
#pragma unroll
    for (int j = 0; j < 8; ++j) ss += x[j] * x[j];
    ss = row_sum(ss);
    const float r = rsqrtf(ss * (1.f / 128.f) + EPS); const float* gp = p.kn_g + cc * 8;
    const int pos = cc < 8 ? (s >> 6) : (s & 63); const float* tp = tab + (pos * 32 + (cc & 7) * 4) * 2; float y[8];
#pragma unroll
    for (int j = 0; j < 4; ++j) { const float x0 = x[2 * j] * r * gp[2 * j], x1 = x[2 * j + 1] * r * gp[2 * j + 1], cs = tp[2 * j], sn = tp[2 * j + 1]; y[2 * j] = x0 * cs - x1 * sn; y[2 * j + 1] = x0 * sn + x1 * cs; }
    u32x4 w; w.x = pack2(y[0], y[1]); w.y = pack2(y[2], y[3]); w.z = pack2(y[4], y[5]); w.w = pack2(y[6], y[7]);
    *(u32x4*)(p.Kh + (((size_t)b * 2 + kvh) * S + s) * 128 + cc * 8) = w;
  }
}

namespace att {
using bf16 = unsigned short;
constexpr int   D = 128, NW = 8, QBLK = 32, KVBLK = 64;
constexpr float SCALE = 0.088388347648318440f;
constexpr float THR = 8.f;
constexpr int SDEPTH = 2;
constexpr int LDQ = 1536, LDK = 128, LDV = 1536, LDO = 1024;
constexpr size_t SHM_V = KVBLK * D * 2, SHM_K = KVBLK * D * 2, SHM_ATTN = 2 * SHM_V + 2 * SHM_K + NW * 64 * 4;
using bf16x8 = __attribute__((ext_vector_type(8))) short;
using s16x4  = __attribute__((ext_vector_type(4))) short;
using f32x16 = __attribute__((ext_vector_type(16))) float;
using f32x8  = __attribute__((ext_vector_type(8))) float;
using u32x4  = __attribute__((ext_vector_type(4))) unsigned;
#define KSWZ(row, colB) ((row) * 256 + ((colB) ^ (((row) & 7) << 4)))
#define SBAR() __builtin_amdgcn_sched_barrier(0)
__device__ __forceinline__ int crow(int r, int hi) { return (r & 3) + 8 * (r >> 2) + 4 * hi; }
__device__ __forceinline__ unsigned cvtpk(float lo, float hi) {
  unsigned r; asm volatile("v_cvt_pk_bf16_f32 %0, %1, %2" : "=v"(r) : "v"(lo), "v"(hi)); return r;
}
template <typename TIn> struct Stage;
template <> struct Stage<bf16>  { using T = bf16x8;
  __device__ static __forceinline__ T ld8(const bf16* p) { return *reinterpret_cast<const bf16x8*>(p); }
  __device__ static __forceinline__ bf16x8 tobf(T x) { return x; } };
template <> struct Stage<float> { using T = f32x8;
  __device__ static __forceinline__ T ld8(const float* p) { return *reinterpret_cast<const f32x8*>(p); }
  __device__ static __forceinline__ bf16x8 tobf(T x) {
    u32x4 w = {cvtpk(x[0], x[1]), cvtpk(x[2], x[3]), cvtpk(x[4], x[5]), cvtpk(x[6], x[7])}; return *reinterpret_cast<bf16x8*>(&w); } };

__device__ __forceinline__ void partialSM(f32x16& p0, f32x16& p1, float& m_reg, float& mn, float& alpha) {
  constexpr float C = SCALE * 1.4426950408889634f;
  float pmax = p0[0]; for (int r = 1; r < 16; ++r) pmax = fmaxf(pmax, p0[r]); for (int r = 0; r < 16; ++r) pmax = fmaxf(pmax, p1[r]);
  { auto rr = __builtin_amdgcn_permlane32_swap(__float_as_uint(pmax), __float_as_uint(pmax), false, false);
    pmax = fmaxf(__uint_as_float(rr[0]), __uint_as_float(rr[1])); }
  if (__builtin_expect(__all(pmax - m_reg <= THR / SCALE), 1)) { mn = m_reg; alpha = 1.f; }
  else { mn = fmaxf(m_reg, pmax); alpha = __builtin_amdgcn_exp2f((m_reg - mn) * C); m_reg = mn; }
  float mnC = -mn * C;
  for (int r = 0; r < 16; ++r) p0[r] = fmaf(p0[r], C, mnC); for (int r = 0; r < 16; ++r) p1[r] = fmaf(p1[r], C, mnC);
  for (int r = 0; r < 16; ++r) p0[r] = __builtin_amdgcn_exp2f(p0[r]);
}
__device__ __forceinline__ void finishSM(f32x16& p0, f32x16& p1, float alpha, float& l_reg, bf16x8& pa0, bf16x8& pa1, bf16x8& pa2, bf16x8& pa3) {
  for (int r = 0; r < 16; ++r) p1[r] = __builtin_amdgcn_exp2f(p1[r]);
  float ps = 0; for (int r = 0; r < 16; ++r) ps += p0[r]; for (int r = 0; r < 16; ++r) ps += p1[r];
  { auto rr = __builtin_amdgcn_permlane32_swap(__float_as_uint(ps), __float_as_uint(ps), false, false);
    ps = __uint_as_float(rr[0]) + __uint_as_float(rr[1]); }
  l_reg = l_reg * alpha + ps;
#define PK4(P, BASE, OUT) do { unsigned a0 = cvtpk(P[BASE + 0], P[BASE + 1]), a1 = cvtpk(P[BASE + 2], P[BASE + 3]);   \
    unsigned b0 = cvtpk(P[BASE + 4], P[BASE + 5]), b1 = cvtpk(P[BASE + 6], P[BASE + 7]);                              \
    auto r0 = __builtin_amdgcn_permlane32_swap(a0, b0, false, false); auto r1 = __builtin_amdgcn_permlane32_swap(a1, b1, false, false); \
    u32x4 w = {r0[0], r1[0], r0[1], r1[1]}; OUT = *reinterpret_cast<bf16x8*>(&w); } while (0)
  PK4(p0, 0, pa0); PK4(p0, 8, pa1); PK4(p1, 0, pa2); PK4(p1, 8, pa3);
#undef PK4
}
__device__ __forceinline__ void qkt(f32x16& p0, f32x16& p1, const bf16* Ks, const bf16x8* qr, int r32, int hi) {
  p0 = f32x16{}; p1 = f32x16{};
  for (int d0 = 0; d0 < 8; ++d0) { int cb = (d0 * 16 + hi * 8) * 2;
    bf16x8 b0 = *reinterpret_cast<const bf16x8*>((const char*)Ks + KSWZ(r32, cb));
    bf16x8 b1 = *reinterpret_cast<const bf16x8*>((const char*)Ks + KSWZ(32 + r32, cb));
    p0 = __builtin_amdgcn_mfma_f32_32x32x16_bf16(b0, qr[d0], p0, 0, 0, 0);
    p1 = __builtin_amdgcn_mfma_f32_32x32x16_bf16(b1, qr[d0], p1, 0, 0, 0); }
}
__device__ __forceinline__ int v_st(int k, int c) { const int kk = (k & ~0xC) | ((k & 4) << 1) | ((k & 8) >> 1); return ((kk >> 3) * 4 + (c >> 5)) * 512 + ((kk & 7) * 32 + (c & 31)) * 2; }
__device__ __forceinline__ int v_rd_base(int lane) { return ((lane & 3) << 3) | (((lane >> 2) & 3) << 6) | (((lane >> 4) & 1) << 5) | (((lane >> 5) & 1) << 8); }
constexpr int v_rd_off(int d0, int ks, int half) { return d0 * 512 + ks * 4096 + half * 2048; }
template <int OFF> __device__ __forceinline__ s16x4 tr_read(int vb) {
  s16x4 r; asm volatile("ds_read_b64_tr_b16 %0, %1 offset:%2" : "=&v"(r) : "v"(vb), "i"(OFF) : "memory"); return r;
}
template <int D0> __device__ __forceinline__ void pv_one(f32x16& od, int vb, bf16x8 pa0, bf16x8 pa1, bf16x8 pa2, bf16x8 pa3) {
  const s16x4 l0 = tr_read<v_rd_off(D0, 0, 0)>(vb), h0 = tr_read<v_rd_off(D0, 0, 1)>(vb), l1 = tr_read<v_rd_off(D0, 1, 0)>(vb), h1 = tr_read<v_rd_off(D0, 1, 1)>(vb);
  const s16x4 l2 = tr_read<v_rd_off(D0, 2, 0)>(vb), h2 = tr_read<v_rd_off(D0, 2, 1)>(vb), l3 = tr_read<v_rd_off(D0, 3, 0)>(vb), h3 = tr_read<v_rd_off(D0, 3, 1)>(vb);
  asm volatile("s_waitcnt lgkmcnt(0)" ::: "memory"); SBAR();
#define PK(L, H) (bf16x8){L[0], L[1], L[2], L[3], H[0], H[1], H[2], H[3]}
  od = __builtin_amdgcn_mfma_f32_32x32x16_bf16(pa0, PK(l0, h0), od, 0, 0, 0);
  od = __builtin_amdgcn_mfma_f32_32x32x16_bf16(pa1, PK(l1, h1), od, 0, 0, 0);
  od = __builtin_amdgcn_mfma_f32_32x32x16_bf16(pa2, PK(l2, h2), od, 0, 0, 0);
  od = __builtin_amdgcn_mfma_f32_32x32x16_bf16(pa3, PK(l3, h3), od, 0, 0, 0);
#undef PK
}
__device__ __forceinline__ void pv_d0(f32x16* o, int vb, bf16x8 pa0, bf16x8 pa1, bf16x8 pa2, bf16x8 pa3) {
  pv_one<0>(o[0], vb, pa0, pa1, pa2, pa3); pv_one<1>(o[1], vb, pa0, pa1, pa2, pa3); pv_one<2>(o[2], vb, pa0, pa1, pa2, pa3); pv_one<3>(o[3], vb, pa0, pa1, pa2, pa3);
}

template <typename TQ>
__device__ __forceinline__ void attn_dense_body(const TQ* __restrict__ Qb, const bf16* __restrict__ Kh, const bf16* __restrict__ Vh,
                                                bf16* __restrict__ Ob, int seq, char* lds, const float* __restrict__ qg, const float* rtab, int s0) {
  using St = Stage<bf16>; using SQ = Stage<TQ>;
  int tid_ = threadIdx.x; asm volatile("" : "+v"(tid_)); const int tid = tid_, wid = tid >> 6, lane = tid & 63, r32 = lane & 31, hi = lane >> 5;
  bf16* V_lds = (bf16*)lds; bf16* K_lds = (bf16*)(lds + 2 * SHM_V);
  float* ws = (float*)(lds + 2 * SHM_V + 2 * SHM_K) + wid * 64; float* li_l = ws; float* al_l = ws + 32;
  float m_reg = -1e30f, l_reg = 0; f32x16 o[4] = {}; bf16x8 qr[8];
  const TQ* Qw = Qb + (long)(wid * QBLK + r32) * LDQ + hi * 8;
  {
    bf16x8 raw[8]; float ss = 0.f;
#pragma unroll
    for (int d0 = 0; d0 < 8; ++d0) { raw[d0] = SQ::tobf(SQ::ld8(Qw + d0 * 16));
#pragma unroll
      for (int e = 0; e < 8; ++e) { const float v = __uint_as_float(((unsigned)(unsigned short)raw[d0][e]) << 16); ss += v * v; } }
    ss = sum32x(ss); const float rn = rsqrtf(ss * (1.f / 128.f) + 1e-6f); const int sq = s0 + wid * QBLK + r32;
#pragma unroll
    for (int d0 = 0; d0 < 8; ++d0) { const float* gp = qg + d0 * 16 + hi * 8; const int pos = d0 < 4 ? (sq >> 6) : (sq & 63); const float* tp = rtab + (pos * 32 + (d0 & 3) * 8 + hi * 4) * 2; unsigned w[4];
#pragma unroll
      for (int j = 0; j < 4; ++j) { const float x0 = __uint_as_float(((unsigned)(unsigned short)raw[d0][2 * j]) << 16) * rn * gp[2 * j], x1 = __uint_as_float(((unsigned)(unsigned short)raw[d0][2 * j + 1]) << 16) * rn * gp[2 * j + 1];
        const float cs = tp[2 * j], sn = tp[2 * j + 1]; w[j] = cvtpk(x0 * cs - x1 * sn, x0 * sn + x1 * cs); }
      u32x4 ww = {w[0], w[1], w[2], w[3]}; qr[d0] = *reinterpret_cast<bf16x8*>(&ww); }
  }
  const int sr = tid >> 4, sc = (tid & 15) * 8, vst0 = v_st(sr, sc), vst1 = v_st(32 + sr, sc);
  const int vb0 = (int)(uintptr_t)V_lds + v_rd_base(lane);
  struct { typename St::T vs0, vs1, ks0, ks1; } sr_[SDEPTH];
#define SLOAD(i, k0) do { sr_[i].vs0 = St::ld8(&Vh[(long)((k0) + sr) * LDV + sc]); sr_[i].vs1 = St::ld8(&Vh[(long)((k0) + 32 + sr) * LDV + sc]); \
    sr_[i].ks0 = St::ld8(&Kh[(long)((k0) + sr) * LDK + sc]); sr_[i].ks1 = St::ld8(&Kh[(long)((k0) + 32 + sr) * LDK + sc]); } while (0)
#define SWRITE(b, i) do { *(bf16x8*)((char*)V_lds + (b) * SHM_V + vst0) = St::tobf(sr_[i].vs0);          \
    *(bf16x8*)((char*)V_lds + (b) * SHM_V + vst1) = St::tobf(sr_[i].vs1); int kc = sc * 2;               \
    *(bf16x8*)((char*)K_lds + (b) * SHM_K + KSWZ(sr, kc)) = St::tobf(sr_[i].ks0);                       \
    *(bf16x8*)((char*)K_lds + (b) * SHM_K + KSWZ(32 + sr, kc)) = St::tobf(sr_[i].ks1); } while (0)
#define SWAIT() do { if constexpr (SDEPTH == 2) asm volatile("s_waitcnt vmcnt(4)" ::: "memory"); else asm volatile("s_waitcnt vmcnt(0)" ::: "memory"); } while (0)
#define RESC(a) do { if (__any((a) < 1.f)) { if (hi == 0) al_l[r32] = (a); asm volatile("s_waitcnt lgkmcnt(0)" ::: "memory"); \
    for (int d = 0; d < 4; ++d) for (int r = 0; r < 16; ++r) o[d][r] *= al_l[crow(r, hi)]; } } while (0)
  f32x16 pA0, pA1, pB0, pB1; float mnA, mnB, alA, alB; bf16x8 pa0, pa1, pa2, pa3; const int NT = seq / KVBLK;
  constexpr int SE = 0, SO = SDEPTH - 1;
  SLOAD(SE, 0); asm volatile("s_waitcnt vmcnt(0)" ::: "memory"); SWRITE(0, SE); __syncthreads();
  qkt(pA0, pA1, K_lds, qr, r32, hi); partialSM(pA0, pA1, m_reg, mnA, alA);
  SLOAD(SO, KVBLK); if constexpr (SDEPTH == 2) { if (2 < NT) SLOAD(SE, 2 * KVBLK); }
  SWAIT(); SWRITE(1, SO); __syncthreads();
  for (int j = 1; j + 1 < NT; j += 2) {
    SBAR(); qkt(pB0, pB1, (bf16*)((char*)K_lds + SHM_K), qr, r32, hi);
    finishSM(pA0, pA1, alA, l_reg, pa0, pa1, pa2, pa3); SBAR();
    SLOAD(SO, (j + SDEPTH) * KVBLK); SBAR();
    pv_d0(o, vb0, pa0, pa1, pa2, pa3); partialSM(pB0, pB1, m_reg, mnB, alB);
    __syncthreads(); SWAIT(); SWRITE(0, SE);
    RESC(alB); __syncthreads();
    SBAR(); qkt(pA0, pA1, K_lds, qr, r32, hi);
    finishSM(pB0, pB1, alB, l_reg, pa0, pa1, pa2, pa3); SBAR();
    if (SDEPTH == 1 || j + 3 < NT) SLOAD(SE, (j + 1 + SDEPTH) * KVBLK); SBAR();
    pv_d0(o, vb0 + (int)SHM_V, pa0, pa1, pa2, pa3); partialSM(pA0, pA1, m_reg, mnA, alA);
    __syncthreads(); SWAIT(); SWRITE(1, SO);
    RESC(alA); __syncthreads();
  }
  SBAR(); qkt(pB0, pB1, (bf16*)((char*)K_lds + SHM_K), qr, r32, hi);
  finishSM(pA0, pA1, alA, l_reg, pa0, pa1, pa2, pa3); SBAR();
  pv_d0(o, vb0, pa0, pa1, pa2, pa3); partialSM(pB0, pB1, m_reg, mnB, alB);
  __syncthreads(); RESC(alB);
  finishSM(pB0, pB1, alB, l_reg, pa0, pa1, pa2, pa3); SBAR();
  pv_d0(o, vb0 + (int)SHM_V, pa0, pa1, pa2, pa3);
  if (hi == 0) li_l[r32] = l_reg; asm volatile("s_waitcnt lgkmcnt(0)" ::: "memory");
  float rli[16];
#pragma unroll
  for (int r = 0; r < 16; ++r) rli[r] = __builtin_amdgcn_rcpf(li_l[crow(r, hi)]);
  __syncthreads();
  bf16* Ol = (bf16*)lds + wid * (QBLK * D);
#pragma unroll
  for (int r = 0; r < 16; ++r) { const int orow = crow(r, hi);
#pragma unroll
    for (int d0 = 0; d0 < 4; ++d0) { const float v = o[d0][r] * rli[r]; unsigned u = __float_as_uint(v); u += 0x7FFFu + ((u >> 16) & 1u); Ol[orow * D + d0 * 32 + r32] = (bf16)(u >> 16); } }
  asm volatile("s_waitcnt lgkmcnt(0)" ::: "memory");
#pragma unroll
  for (int i = 0; i < 8; ++i) { const int row = i * 4 + (lane >> 4), ch = (lane & 15) * 8;
    const u32x4 v = *reinterpret_cast<const u32x4*>(Ol + row * D + ch);
    *reinterpret_cast<u32x4*>(Ob + (long)(wid * QBLK + row) * LDO + ch) = v; }
  __syncthreads();
#undef SLOAD
#undef SWRITE
#undef SWAIT
#undef RESC
}

}

__device__ void phase_attn(const Params& p, char* smem) {
  const int G = (int)gridDim.x, c = (int)blockIdx.x;
  float* rtab = (float*)(smem + 68 * 1024);
  __syncthreads();
  for (int i = threadIdx.x; i < 64 * 32; i += NTHREADS) { const int pos = i >> 5, fi = i & 31; const float fr = exp2f(-(float)(2 * fi) * (13.287712379549449f / 64.f)); float sn, cs; sincosf((float)pos * fr, &sn, &cs); rtab[2 * i] = cs; rtab[2 * i + 1] = sn; }
  __syncthreads();
  for (int i = 0; i * G + c < 1024; ++i) {
    int pair, j;
    if (G == 256) { pair = 2 * (c & 7) + (i >> 1); j = (i & 1) * 32 + (c >> 3); } else { const int L = i * G + c; pair = L >> 6; j = L & 63; }
    const int b = pair >> 1, kv = pair & 1, qb = j >> 2, g = j & 3, h = kv * 4 + g;
    const bf16_t* Qb = p.QKV + ((size_t)b * S + qb * 256) * 1536 + h * 128; const bf16_t* Kp = p.Kh + ((size_t)b * 2 + kv) * S * 128; const bf16_t* Vp = p.QKV + (size_t)b * S * 1536 + 1280 + kv * 128;
    bf16_t* Ob = p.CAT + ((size_t)b * S + qb * 256) * 1024 + h * 128;
    att::attn_dense_body<att::bf16>(Qb, Kp, Vp, Ob, S, smem, p.qn_g, rtab, qb * 256);
  }
}

#define XB_TMO      128
#define XB_XCNT(j)  (256  + 64 * (j))
#define XB_XSUB(j)  (1280 + 64 * (j))
#define XB_XGEN(j)  (2304 + 64 * (j))
#define XB_TOP      3328
#define XB_TOPGEN   3392
#define XCD_BAR_WORDS 3456
#define XB_SPIN_CAP (1u << 18)
#define LAS __attribute__((address_space(3)))

__device__ __forceinline__ unsigned xb_ld(unsigned* p)              { return __hip_atomic_load(p, __ATOMIC_RELAXED, __HIP_MEMORY_SCOPE_AGENT); }
__device__ __forceinline__ unsigned xb_add(unsigned* p, unsigned v) { return __hip_atomic_fetch_add(p, v, __ATOMIC_RELAXED, __HIP_MEMORY_SCOPE_AGENT); }
__device__ __forceinline__ unsigned xb_xcc_id() { return (unsigned)__builtin_amdgcn_s_getreg((3 << 11) | 20) & 0xFu; }
#define XB_SPIN(cond, bar) do { unsigned _sp = 0; while (cond) { __builtin_amdgcn_s_sleep(1); \
    if ((++_sp & 255u) == 0u) { if (xb_ld(&(bar)[XB_TMO])) break; if (_sp > XB_SPIN_CAP) { atomicAdd(&(bar)[XB_TMO], 1u); break; } } } } while (0)

struct XcdBarrier {
    unsigned* bar; unsigned x;
    volatile LAS unsigned* st;
};

__device__ __forceinline__ XcdBarrier xcd_barrier_post(unsigned* bar, volatile LAS unsigned* st) {
    XcdBarrier b; b.bar = bar; b.x = xb_xcc_id(); b.st = st;
    if (threadIdx.x == 0) (void)xb_add(&bar[XB_XCNT(b.x)], 1u);
    return b;
}
__device__ __forceinline__ void xcd_barrier_complete(unsigned* bar, unsigned x, unsigned& nloc, unsigned& nx) {
    const unsigned G = gridDim.x * gridDim.y * gridDim.z;
    unsigned sum, cnt, mine, sp = 0u;
    for (;;) {
        sum = 0u; cnt = 0u; mine = 0u;
#pragma unroll
        for (unsigned j = 0; j < 16; ++j) { const unsigned c = xb_ld(&bar[XB_XCNT(j)]); sum += c; cnt += (c > 0u) ? 1u : 0u; mine = (j == x) ? c : mine; }
        if (sum == G) break;
        __builtin_amdgcn_s_sleep(1);
        if ((++sp & 255u) == 0u) { if (xb_ld(&bar[XB_TMO])) break; if (sp > XB_SPIN_CAP) { atomicAdd(&bar[XB_TMO], 1u); break; } }
    }
    nloc = mine > 0u ? mine : 1u; nx = cnt > 0u ? cnt : 1u;
}

__device__ __forceinline__ void xcd_barrier(const XcdBarrier& b) {
    asm volatile("s_waitcnt vmcnt(0)" ::: "memory");
    __syncthreads();
    if (threadIdx.x == 0) {
        unsigned* bar = b.bar;
        __builtin_amdgcn_s_waitcnt(0);
        unsigned nloc = b.st[0], nx = b.st[1];
        if (nloc == 0u) { xcd_barrier_complete(bar, b.x, nloc, nx); b.st[0] = nloc; b.st[1] = nx; }
        const unsigned old = xb_add(&bar[XB_XSUB(b.x)], 1u);
        const unsigned gen = old / nloc;
        if (old + 1u == (gen + 1u) * nloc) {
            __builtin_amdgcn_fence(__ATOMIC_RELEASE, "agent");
            asm volatile("s_waitcnt vmcnt(0)" ::: "memory");
            const unsigned og = xb_add(&bar[XB_TOP], 1u);
            const unsigned tg = og / nx;
            if (og + 1u == (tg + 1u) * nx) xb_add(&bar[XB_TOPGEN], 1u);
            else XB_SPIN(xb_ld(&bar[XB_TOPGEN]) == tg, bar);
            __builtin_amdgcn_fence(__ATOMIC_ACQUIRE, "agent");
            xb_add(&bar[XB_XGEN(b.x)], 1u);
            asm volatile("s_waitcnt vmcnt(0)" ::: "memory");
        } else {
            XB_SPIN(xb_ld(&bar[XB_XGEN(b.x)]) == gen, bar);
            __builtin_amdgcn_fence(__ATOMIC_ACQUIRE, "agent");
            asm volatile("s_waitcnt vmcnt(0)" ::: "memory");
        }
    }
    __syncthreads();
}


constexpr int NPH = 19;
__global__ __launch_bounds__(NTHREADS, 2) void mega(Params p, int ph0, int ph1) {
  extern __shared__ __attribute__((aligned(16))) char smem[];
  cg::grid_group grid = cg::this_grid();
  volatile LAS unsigned* xst = (volatile LAS unsigned*)(LAS char*)(smem + SMEM_BYTES - 16);
  if (threadIdx.x == 0) { xst[0] = 0u; xst[1] = 0u; }
  __syncthreads();
  const XcdBarrier xb = xcd_barrier_post(p.bar, xst);
#define GSYNC(k) do { if ((k) == 1) grid.sync(); else xcd_barrier(xb); } while (0)
#define PHASE(k, call) if (ph0 <= (k) && (k) < ph1) { if ((k) > ph0) GSYNC(k); call; }
#if !defined(ONLY_PHASE) || ONLY_PHASE == 0
  PHASE(0, phase_prep(p, smem))
#endif
#if !defined(ONLY_PHASE) || ONLY_PHASE == 1
  PHASE(1, phase_norm<true>(p, p.x, p.nmg, p.mod, 0, 1024, smem))
#endif
#if !defined(ONLY_PHASE) || ONLY_PHASE == 2
  PHASE(2, phase_gemm_fast(p.H, p.Wt_evin, T, 2560, 1024, (EpiEvin{p.ZQK, p.ZV, p.ZO, p.ZP, p.ev_b_in}), smem))
#endif
#if !defined(ONLY_PHASE) || ONLY_PHASE == 3
  PHASE(3, cp::phase_convpool(p, smem))
#endif
#if !defined(ONLY_PHASE) || ONLY_PHASE == 4
  PHASE(4, ml::phase_mlstm(p, smem))
#endif
#if !defined(ONLY_PHASE) || ONLY_PHASE == 5
  PHASE(5, phase_cat(p))
#endif
#if !defined(ONLY_PHASE) || ONLY_PHASE == 6
  PHASE(6, phase_gemm_fast(p.CAT, p.Wt_evout, T, 1024, 1024, (EpiPlain{p.Yb, 1024}), smem))
#endif
#if !defined(ONLY_PHASE) || ONLY_PHASE == 7
  PHASE(7, (phase_norm<false, true>(p, p.x, p.nfg, p.mod, 3072, 4096, smem, p.Yb, 2048)))
#endif
#if !defined(ONLY_PHASE) || ONLY_PHASE == 8
  PHASE(8, phase_gemm_fast(p.H, p.Wt_q, T, 2048, 1024, (EpiQP{p.QP}), smem))
#endif
#if !defined(ONLY_PHASE) || ONLY_PHASE == 9
#endif
#if !defined(ONLY_PHASE) || ONLY_PHASE == 10
  PHASE(10, phase_peer_fused<0>(p, 0, smem))
#endif
#if !defined(ONLY_PHASE) || ONLY_PHASE == 11
  PHASE(11, phase_gemm_fast(p.H, p.Wt_odin, T, 1536, 1024, (EpiPlain{p.QKV, 1536}), smem))
#endif
#if !defined(ONLY_PHASE) || ONLY_PHASE == 12
  PHASE(12, phase_qkrope(p, smem))
#endif
#if !defined(ONLY_PHASE) || ONLY_PHASE == 13
  PHASE(13, phase_attn(p, smem))
#endif
#if !defined(ONLY_PHASE) || ONLY_PHASE == 14
  PHASE(14, phase_gemm_fast(p.CAT, p.Wt_odout, T, 1024, 1024, (EpiPlain{p.Yb, 1024}), smem))
#endif
#if !defined(ONLY_PHASE) || ONLY_PHASE == 15
  PHASE(15, (phase_norm<false, true>(p, p.X, p.nfg + D, p.mod + (size_t)8 * 6144, 3072, 4096, smem, p.Yb, 2048)))
#endif
#if !defined(ONLY_PHASE) || ONLY_PHASE == 16
  PHASE(16, phase_gemm_fast(p.H, p.Wt_q + (size_t)2048 * 1024, T, 2048, 1024, (EpiQP{p.QP}), smem))
#endif
#if !defined(ONLY_PHASE) || ONLY_PHASE == 17
#endif
#if !defined(ONLY_PHASE) || ONLY_PHASE == 18
  PHASE(18, phase_peer_fused<1>(p, 1, smem))
#endif
#undef PHASE
}
}

extern "C" void kernel_launch(void* const* d_in, const int* in_sizes, int n_in, void* d_out, int out_size, void* d_ws, size_t ws_size, hipStream_t stream) {
  (void)in_sizes; (void)n_in; (void)out_size;
  Params p{};
  const float** fin = (const float**)&p;
  for (int i = 0; i < 23; ++i) fin[i] = (const float*)d_in[i];
  p.X = (float*)d_out;
  char* ws = (char*)d_ws; size_t off = 0;
  auto alloc = [&](size_t bytes) { char* q = ws + off; off += (bytes + 255) / 256 * 256; return q; };
  p.U8 = (unsigned char*)alloc((size_t)2 * 16384 * 1024); p.V8 = (unsigned char*)alloc((size_t)2 * 16384 * 1024);
  p.Wt_evin = (bf16_t*)alloc((size_t)2560 * 1024 * 2); p.Wt_evout = (bf16_t*)alloc((size_t)1024 * 1024 * 2); p.Wt_odin = (bf16_t*)alloc((size_t)1536 * 1024 * 2);
  p.Wt_odout = (bf16_t*)alloc((size_t)1024 * 1024 * 2); p.Wt_q = (bf16_t*)alloc((size_t)2 * 2048 * 1024 * 2); p.keysb = (bf16_t*)alloc((size_t)2 * 2 * 128 * 128 * 2); p.poolWt = (bf16_t*)alloc((size_t)4 * 128 * 128 * 2);
  p.Wg = (float*)alloc(16 * 1024 * 4); p.mod = (float*)alloc(2 * 8 * 6144 * 4); p.gates = (float*)alloc((size_t)T * 16 * 4);
  p.H = (bf16_t*)alloc((size_t)T * 1024 * 2); p.CAT = p.H;
  char* big = alloc((size_t)T * 2048 * 2);
  p.ZQK = (bf16_t*)big; p.ZV = (bf16_t*)(big + (size_t)T * 1024 * 2); p.ZO = (bf16_t*)(big + (size_t)T * 1536 * 2); p.HS = (bf16_t*)big; p.QP = (bf16_t*)big; p.QKV = (bf16_t*)big; p.Yb = (bf16_t*)big;
  char* big2 = alloc((size_t)T * 1536 * 2);
  p.QK = (bf16_t*)big2; p.ZP = (bf16_t*)(big2 + (size_t)T * 1024 * 2); p.Qh = (bf16_t*)big2; p.Kh = (bf16_t*)(big2 + (size_t)T * 1024 * 2); p.Vh = (bf16_t*)(big2 + (size_t)T * 1280 * 2);
  p.bar = (unsigned*)alloc(XCD_BAR_WORDS * 4);
  if (off > ws_size) { fprintf(stderr, "kernel_launch: workspace too small: need %zu have %zu\n", off, ws_size); return; }

  static int grid_blocks = 0;
  if (!grid_blocks) {
    int dev = 0, cus = 0, per_cu = 0; hipGetDevice(&dev); hipDeviceGetAttribute(&cus, hipDeviceAttributeMultiprocessorCount, dev);
    hipFuncSetAttribute((const void*)mega, hipFuncAttributeMaxDynamicSharedMemorySize, SMEM_BYTES);
    hipOccupancyMaxActiveBlocksPerMultiprocessor(&per_cu, mega, NTHREADS, SMEM_BYTES);
    if (per_cu > 1) per_cu = 1;
    grid_blocks = cus * per_cu;
    if (grid_blocks <= 0) { fprintf(stderr, "kernel_launch: occupancy query returned 0\n"); grid_blocks = 0; return; }
  }
  hipMemsetAsync(p.bar, 0, XCD_BAR_WORDS * 4, stream);
#if MULTI_LAUNCH
  for (int ph = 0; ph < NPH; ++ph) hipLaunchKernelGGL(mega, dim3(grid_blocks), dim3(NTHREADS), SMEM_BYTES, stream, p, ph, ph + 1);
#else
  int ph0 = 0, ph1 = NPH; void* args[] = {&p, &ph0, &ph1};
  hipError_t e = hipLaunchCooperativeKernel((const void*)mega, dim3(grid_blocks), dim3(NTHREADS), args, SMEM_BYTES, stream);
  if (e != hipSuccess) fprintf(stderr, "cooperative launch failed: %s (grid %d)\n", hipGetErrorString(e), grid_blocks);
#endif
}
```

```cpp
#include <hip/hip_runtime.h>
#include <hip/hip_cooperative_groups.h>
#include <math.h>
#include <stdint.h>
#include <stdio.h>
namespace cg = cooperative_groups;

#ifndef MULTI_LAUNCH
#define MULTI_LAUNCH 0
#endif

namespace {
typedef unsigned short bf16_t;
typedef unsigned int u32;
typedef float f32x4 __attribute__((ext_vector_type(4)));
typedef u32 u32x4 __attribute__((ext_vector_type(4)));
typedef u32 u32x2 __attribute__((ext_vector_type(2)));
typedef __bf16 bf16x2_t __attribute__((ext_vector_type(2)));

constexpr int D = 1024, NB = 8, S = 4096, T = NB * S;
constexpr int EVEN_IN = 2576;
constexpr float EPS = 1e-6f;
constexpr int NTHREADS = 512;
constexpr int SMEM_BYTES = 160 * 1024;
constexpr float KSCALE = 0.08838834764831845f;

struct Params {
  const float *x, *c, *ada_w, *ada_b, *nmg, *nfg, *ev_w_in, *ev_b_in, *conv_w, *conv_b, *mnorm_g, *pool_w, *pool_sc, *ev_w_out, *od_w_in, *qn_g, *kn_g, *od_w_out,
      *peer_wq, *peer_keys, *peer_u, *peer_v, *final_g;
  float* X;
  bf16_t *Wt_evin, *Wt_evout, *Wt_odin, *Wt_odout, *Wt_q, *keysb, *poolWt; unsigned char *U8, *V8;
  float *Wg, *mod, *gates, *pgate;
  bf16_t *H, *ZQK, *ZV, *ZO, *ZP, *QK, *HS, *CAT, *QP, *QKV, *Qh, *Kh, *Vh, *Yb;
  bf16_t* pidx;
  unsigned* bar;
};

__device__ __forceinline__ float siluf(float x) { return x * __builtin_amdgcn_rcpf(1.f + __expf(-x)); }
__device__ __forceinline__ u32 e2m3(float x) { const float a = fminf(fabsf(x), 7.5f);
  const int c = a < 2.f ? __float2int_rn(a * 8.f) : a < 4.f ? __float2int_rn(a * 4.f) + 8 : __float2int_rn(a * 2.f) + 16;
  return (u32)c | (x < 0.f ? 32u : 0u); }
__device__ __forceinline__ float sigmf(float x) { return __builtin_amdgcn_rcpf(1.f + __expf(-x)); }
constexpr int DPP_X1 = 0xB1, DPP_X2 = 0x4E, DPP_HMIR = 0x141, DPP_MIR = 0x140;
template <int CTRL> __device__ __forceinline__ int dppi(int v) { return __builtin_amdgcn_update_dpp(0, v, CTRL, 0xF, 0xF, true); }
template <int CTRL> __device__ __forceinline__ float dppf(float v) { return __int_as_float(__builtin_amdgcn_update_dpp(0, __float_as_int(v), CTRL, 0xF, 0xF, true)); }
__device__ __forceinline__ float sum16x(float v) { const unsigned b = __float_as_uint(v); auto r = __builtin_amdgcn_permlane16_swap(b, b, false, false); return __uint_as_float(r[0]) + __uint_as_float(r[1]); }
__device__ __forceinline__ float sum32x(float v) { const unsigned b = __float_as_uint(v); auto r = __builtin_amdgcn_permlane32_swap(b, b, false, false); return __uint_as_float(r[0]) + __uint_as_float(r[1]); }
__device__ __forceinline__ float max16x(float v) { const unsigned b = __float_as_uint(v); auto r = __builtin_amdgcn_permlane16_swap(b, b, false, false); return fmaxf(__uint_as_float(r[0]), __uint_as_float(r[1])); }
__device__ __forceinline__ float max32x(float v) { const unsigned b = __float_as_uint(v); auto r = __builtin_amdgcn_permlane32_swap(b, b, false, false); return fmaxf(__uint_as_float(r[0]), __uint_as_float(r[1])); }
__device__ __forceinline__ float row_sum(float v) { v += dppf<DPP_X1>(v); v += dppf<DPP_X2>(v); v += dppf<DPP_HMIR>(v); v += dppf<DPP_MIR>(v); return v; }
__device__ __forceinline__ float wave_sum(float v) { v = row_sum(v); v = sum16x(v); return sum32x(v); }
__device__ __forceinline__ float wave_max(float v) { v = fmaxf(v, dppf<DPP_X1>(v)); v = fmaxf(v, dppf<DPP_X2>(v)); v = fmaxf(v, dppf<DPP_HMIR>(v)); v = fmaxf(v, dppf<DPP_MIR>(v)); v = max16x(v); return max32x(v); }
__device__ __forceinline__ bf16_t f2bf(float f) { u32 r; asm("v_cvt_pk_bf16_f32 %0, %1, %1" : "=v"(r) : "v"(f)); return (bf16_t)r; }
__device__ __forceinline__ float bf2f(bf16_t b) { return __uint_as_float(((u32)b) << 16); }
__device__ __forceinline__ u32 pack2(float lo, float hi) { u32 r; asm("v_cvt_pk_bf16_f32 %0, %1, %2" : "=v"(r) : "v"(lo), "v"(hi)); return r; }
__device__ __forceinline__ float bflo(u32 w) { return __uint_as_float(w << 16); }
__device__ __forceinline__ float bfhi(u32 w) { return __uint_as_float(w & 0xFFFF0000u); }
__device__ __forceinline__ float dot2bf(u32 a, u32 b, float c) { return __builtin_amdgcn_fdot2_f32_bf16(__builtin_bit_cast(bf16x2_t, a), __builtin_bit_cast(bf16x2_t, b), c, false); }

constexpr float U6_SCALE = 48.f, V6_SCALE = 3.f;
constexpr int PJ_MOD = 192, PJ_TR = 2576, PJ_WG = 1, PJ_KEYS = 16, PJ_UV = 8192;
constexpr int PJ_TOTAL = PJ_MOD + PJ_TR + PJ_WG + PJ_KEYS + PJ_UV;

__device__ void prep_transpose_tile(const float* __restrict__ src, int ld, int k0, int n0, bf16_t* __restrict__ dst, int dstK, char* smem) {
  float* tile = (float*)smem;
  const int tid = threadIdx.x;
  __syncthreads();
  for (int pass = 0; pass < 8; ++pass) { int kk = pass * 8 + (tid >> 6), n = tid & 63; tile[kk * 65 + n] = src[(size_t)(k0 + kk) * ld + n0 + n]; }
  __syncthreads();
  int n = tid >> 3, kc = (tid & 7) * 8; u32x4 w;
  w.x = pack2(tile[(kc + 0) * 65 + n], tile[(kc + 1) * 65 + n]); w.y = pack2(tile[(kc + 2) * 65 + n], tile[(kc + 3) * 65 + n]);
  w.z = pack2(tile[(kc + 4) * 65 + n], tile[(kc + 5) * 65 + n]); w.w = pack2(tile[(kc + 6) * 65 + n], tile[(kc + 7) * 65 + n]);
  *(u32x4*)(dst + (size_t)(n0 + n) * dstK + k0 + kc) = w;
}

__device__ void phase_prep(const Params& p, char* smem) {
  const int tid = threadIdx.x;
  for (int job = blockIdx.x; job < PJ_TOTAL; job += gridDim.x) {
    if (job < PJ_MOD) {
      float* cs = (float*)smem; float* red = cs + 8192;
      __syncthreads();
      for (int i = tid; i < 8192; i += NTHREADS) cs[i] = siluf(p.c[i]);
      __syncthreads();
      const int l = job / 96, e0 = (job % 96) * 64, col = tid & 63, dg = tid >> 6;
      float acc[8];
#pragma unroll
      for (int b = 0; b < 8; ++b) acc[b] = 0.f;
      const float* w = p.ada_w + (size_t)l * D * 6144 + e0 + col;
      for (int d = dg * 128; d < dg * 128 + 128; ++d) { float wv = w[(size_t)d * 6144];
#pragma unroll
        for (int b = 0; b < 8; ++b) acc[b] += cs[b * 1024 + d] * wv; }
#pragma unroll
      for (int b = 0; b < 8; ++b) red[(dg * 8 + b) * 64 + col] = acc[b];
      __syncthreads();
      { const int b = tid >> 6; float s = 0.f;
#pragma unroll
        for (int g = 0; g < 8; ++g) s += red[(g * 8 + b) * 64 + col];
        p.mod[(size_t)(l * 8 + b) * 6144 + e0 + col] = s + p.ada_b[l * 6144 + e0 + col]; }
    } else if (job < PJ_MOD + PJ_TR) {
      int tt = job - PJ_MOD;
      if (tt < 640) prep_transpose_tile(p.ev_w_in, EVEN_IN, (tt / 40) * 64, (tt % 40) * 64, p.Wt_evin, 1024, smem);
      else if (tt < 896) { tt -= 640; prep_transpose_tile(p.ev_w_out, 1024, (tt / 16) * 64, (tt % 16) * 64, p.Wt_evout, 1024, smem); }
      else if (tt < 1280) { tt -= 896; prep_transpose_tile(p.od_w_in, 1536, (tt / 24) * 64, (tt % 24) * 64, p.Wt_odin, 1024, smem); }
      else if (tt < 1536) { tt -= 1280; prep_transpose_tile(p.od_w_out, 1024, (tt / 16) * 64, (tt % 16) * 64, p.Wt_odout, 1024, smem); }
      else if (tt < 2560) { tt -= 1536; int l = tt / 512; tt %= 512; prep_transpose_tile(p.peer_wq + (size_t)l * D * 2048, 2048, (tt / 32) * 64, (tt % 32) * 64, p.Wt_q + (size_t)l * 2048 * 1024, 1024, smem); }
      else { tt -= 2560; const int g = tt >> 2; prep_transpose_tile(p.pool_w + (size_t)g * 16384, 128, ((tt >> 1) & 1) * 64, (tt & 1) * 64, p.poolWt + (size_t)g * 16384, 128, smem); }
    } else if (job < PJ_MOD + PJ_TR + PJ_WG) {
      for (int i = tid; i < 16 * 1024; i += NTHREADS) { int g = i >> 10, d = i & 1023; p.Wg[i] = p.ev_w_in[(size_t)d * EVEN_IN + 2560 + g]; }
    } else if (job < PJ_MOD + PJ_TR + PJ_WG + PJ_KEYS) {
      int j = job - (PJ_MOD + PJ_TR + PJ_WG);
      for (int i = tid; i < 4096; i += NTHREADS) p.keysb[j * 4096 + i] = f2bf(p.peer_keys[j * 4096 + i]);
    } else {
      int j = job - (PJ_MOD + PJ_TR + PJ_WG + PJ_KEYS); const bool isu = j < 4096; const float* src = isu ? p.peer_u : p.peer_v; unsigned char* dst = isu ? p.U8 : p.V8; j &= 4095;
      const size_t o = (size_t)j * 8192 + tid * 16; u32 ww[4]; const float sc = isu ? U6_SCALE : V6_SCALE;
#pragma unroll
      for (int q = 0; q < 4; ++q) { const f32x4 a = *(const f32x4*)(src + o + 4 * q);
        ww[q] = e2m3(a.x * sc) | (e2m3(a.y * sc) << 6) | (e2m3(a.z * sc) << 12) | (e2m3(a.w * sc) << 18); }
      { u32* d3 = (u32*)(dst + ((size_t)j * 512 + tid) * 12);
        d3[0] = ww[0] | (ww[1] << 24); d3[1] = (ww[1] >> 8) | (ww[2] << 16); d3[2] = (ww[2] >> 16) | (ww[3] << 8); }
    }
  }
}

namespace pg8 {
#define PG8_LAS __attribute__((address_space(3)))
typedef unsigned short bf16_t;
typedef short bf16x8 __attribute__((ext_vector_type(8)));
typedef float f32x4 __attribute__((ext_vector_type(4)));
typedef unsigned u32x4 __attribute__((ext_vector_type(4)));
constexpr int BM = 256, BK = 64, HALF = 128, HTB = HALF * BK * 2  , STAGE_BYTES = 8 * HTB, NXCD = 8, WGM = 8;

__host__ __device__ __forceinline__ int lds_byte(int r, int c) { const int st = (r >> 4) * 2 + (c >> 5), rr = r & 15, cc = c & 31, ob = rr * 64 + cc * 2; return st * 1024 + (ob ^ (((ob >> 9) & 1) << 5)); }
__host__ __device__ __forceinline__ void stage_rc(int b, int& R, int& C) { const int st = b / 1024, sb = b % 1024, swz = sb ^ (((sb >> 9) & 1) << 5); R = (st >> 1) * 16 + swz / 64; C = (st & 1) * 32 + (swz % 64) / 2; }
__host__ __device__ __forceinline__ int perm32(int rho) { const int n = rho >> 4, i = rho & 15; return 8 * (i >> 2) + 4 * n + (i & 3); }

struct Unit { int pm, pn; };
struct Gemm { const bf16_t* A; const bf16_t* Bt; int M, N, K; };

struct StaticOrder {
    int nM, nN, nwg, G, c;
    __host__ __device__ void init(int M, int N, int G_, int c_) { nM = M / BM; nN = N / BM; nwg = nM * nN; G = G_; c = c_; }
    __host__ __device__ bool next(int i, Unit& u) const {
        const long L = (long)i * G + c; if (L >= nwg) return false;
        int wgid = (int)L; { const int q = nwg / NXCD, r = nwg % NXCD, xcd = wgid % NXCD, off = wgid / NXCD; wgid = (xcd < r ? xcd * (q + 1) : r * (q + 1) + (xcd - r) * q) + off; }
        const int nig = WGM * nN, gid = wgid / nig, fm = gid * WGM, gsz = (nM - fm) < WGM ? (nM - fm) : WGM;
        u.pm = fm + ((wgid % nig) % gsz); u.pn = (wgid % nig) / gsz; return true;
    }
    __device__ __forceinline__ void a_ready(const Unit&) const {}
    __device__ __forceinline__ void done(const Unit&) const {}
};
__device__ __forceinline__ unsigned cvt_pk_bf16(float lo, float hi) { unsigned r; asm volatile("v_cvt_pk_bf16_f32 %0, %1, %2" : "=v"(r) : "v"(lo), "v"(hi)); return r; }
template <class Epi, class Sched, bool STAMP = false>
__device__ __forceinline__ void gemm_phase(PG8_LAS unsigned char* lds, const Gemm g, const Sched& S, const Epi& E, unsigned long long* stamps) {
    const int tid = threadIdx.x, wid = __builtin_amdgcn_readfirstlane(tid >> 6), lane = tid & 63, wr = wid >> 2, wc = wid & 3, fr = lane & 15, fq = lane >> 4;
    const int K = g.K, nt = K / BK;
    int ts_lo = 0, ts_hi = 0, nts = 0; const unsigned long long rt_entry = STAMP ? (unsigned long long)wall_clock64() : 0ull;
#define PG8_STAMP() do { if (STAMP && wid == 0 && nts < 64) { const unsigned long long _c = (unsigned long long)clock64(); \
        ts_lo = (lane == nts) ? (int)(unsigned)_c : ts_lo; ts_hi = (lane == nts) ? (int)(unsigned)(_c >> 32) : ts_hi; ++nts; } } while (0)
    PG8_STAMP();
    unsigned voffA[2], voffB[2];
#pragma unroll
    for (int i = 0; i < 2; ++i) { int R, C; stage_rc(tid * 16 + i * 8192, R, C); const int Rb = Epi::PERM ? ((R & ~31) + perm32(R & 31)) : R;
        voffA[i] = (unsigned)(R * K + C) * 2u; voffB[i] = (unsigned)(Rb * K + C) * 2u; }
    const size_t kstep = (size_t)(BK * 2);
    const size_t hstep = (size_t)HALF * K * 2;
    const size_t tstep = 2 * hstep;
    const unsigned ldsw = (unsigned)wid * 1024u;
    const int aoff = lds_byte(wr * 64 + fr, fq * 8), boff = lds_byte(wc * 32 + fr, fq * 8);
#define PG8_SA(b, h) (((b) * 2 + (h)) * HTB)
#define PG8_SB(b, h) ((4 + (b) * 2 + (h)) * HTB)
#define PG8_STAGE(bufoff, gbase, voff) do { _Pragma("unroll") for (int _i = 0; _i < 2; ++_i) \
        __builtin_amdgcn_global_load_lds((const unsigned*)((const char*)(gbase) + (voff)[_i]), (PG8_LAS unsigned*)(lds + (bufoff) + ldsw + _i * 8192), 16, 0, 0); } while (0)
#define PG8_LDA(dst, b, h) do { _Pragma("unroll") for (int m = 0; m < 4; ++m) _Pragma("unroll") for (int k = 0; k < 2; ++k) dst[m][k] = *(const PG8_LAS bf16x8*)(lds + PG8_SA(b, h) + aoff + m * 2048 + k * 1024); } while (0)
#define PG8_LDB(dst, b, h) do { _Pragma("unroll") for (int n = 0; n < 2; ++n) _Pragma("unroll") for (int k = 0; k < 2; ++k) dst[n][k] = *(const PG8_LAS bf16x8*)(lds + PG8_SB(b, h) + boff + n * 2048 + k * 1024); } while (0)
#define PG8_MMA(ai, bj, At, Bt) do { __builtin_amdgcn_s_setprio(1); _Pragma("unroll") for (int m = 0; m < 4; ++m) _Pragma("unroll") for (int n = 0; n < 2; ++n) _Pragma("unroll") for (int k = 0; k < 2; ++k) \
        acc[ai][bj][m][n] = __builtin_amdgcn_mfma_f32_16x16x32_bf16(Bt[n][k], At[m][k], acc[ai][bj][m][n], 0, 0, 0); __builtin_amdgcn_s_setprio(0); } while (0)
#define PG8_WAIT_V(n) asm volatile("s_waitcnt vmcnt(" #n ")" ::: "memory")
#define PG8_WAIT_L(n) asm volatile("s_waitcnt lgkmcnt(" #n ")" ::: "memory")
#define PG8_BAR __builtin_amdgcn_s_barrier()
#define PG8_SCHED __builtin_amdgcn_sched_barrier(0)
    Unit cur, nxt; int ui = 0;
    if (!S.next(0, cur)) return;
    f32x4 acc[2][2][4][2];
#pragma unroll
    for (int a = 0; a < 2; ++a)
#pragma unroll
        for (int b = 0; b < 2; ++b)
#pragma unroll
            for (int m = 0; m < 4; ++m)
#pragma unroll
                for (int n = 0; n < 2; ++n) acc[a][b][m][n] = (f32x4){0.f, 0.f, 0.f, 0.f};
    bf16x8 At[4][2], B0[2][2], B1[2][2];
    const char* cA = (const char*)g.A + (size_t)cur.pm * tstep; const char* cB = (const char*)g.Bt + (size_t)cur.pn * tstep;
    S.a_ready(cur);
    PG8_STAGE(PG8_SB(0, 0), cB, voffB); PG8_STAGE(PG8_SA(0, 0), cA, voffA); PG8_STAGE(PG8_SB(0, 1), cB + hstep, voffB); PG8_STAGE(PG8_SA(0, 1), cA + hstep, voffA);
    if (wr == 1) PG8_BAR;
    PG8_WAIT_V(4); PG8_BAR;
    PG8_STAGE(PG8_SB(1, 0), cB + kstep, voffB); PG8_STAGE(PG8_SA(1, 0), cA + kstep, voffA); PG8_STAGE(PG8_SB(1, 1), cB + hstep + kstep, voffB);
    PG8_WAIT_V(6); PG8_BAR;
    PG8_STAMP();
    for (;;) {
        const bool has_next = S.next(ui + 1, nxt);
        const char* nA = has_next ? (const char*)g.A + (size_t)nxt.pm * tstep : cA; const char* nB = has_next ? (const char*)g.Bt + (size_t)nxt.pn * tstep : cB;
        for (int t = 0; t < nt; t += 2) {
            const bool last = (t == nt - 2);
            const char* a1 = cA + (size_t)(t + 1) * kstep;
            const char* a2 = last ? nA : cA + (size_t)(t + 2) * kstep; const char* b2 = last ? nB : cB + (size_t)(t + 2) * kstep;
            const char* a3 = a2 + kstep; const char* b3 = b2 + kstep;
            if (last && has_next) S.a_ready(nxt);
            PG8_LDB(B0, 0, 0); PG8_SCHED; PG8_LDA(At, 0, 0); PG8_STAGE(PG8_SA(1, 1), a1 + hstep, voffA);
            PG8_WAIT_L(8); PG8_BAR; PG8_WAIT_L(0); PG8_MMA(0, 0, At, B0); PG8_BAR; PG8_SCHED;
            PG8_LDB(B1, 0, 1); PG8_STAGE(PG8_SB(0, 0), b2, voffB);
            PG8_BAR; PG8_WAIT_L(0); PG8_MMA(0, 1, At, B1); PG8_BAR;
            PG8_LDA(At, 0, 1); PG8_STAGE(PG8_SA(0, 0), a2, voffA);
            PG8_BAR; PG8_WAIT_L(0); PG8_MMA(1, 0, At, B0); PG8_BAR; PG8_SCHED;
            PG8_STAGE(PG8_SB(0, 1), b2 + hstep, voffB);
            PG8_WAIT_V(6); PG8_BAR; PG8_MMA(1, 1, At, B1); PG8_BAR;
            PG8_LDB(B0, 1, 0); PG8_SCHED; PG8_LDA(At, 1, 0); PG8_STAGE(PG8_SA(0, 1), a2 + hstep, voffA);
            PG8_WAIT_L(8); PG8_BAR; PG8_WAIT_L(0); PG8_MMA(0, 0, At, B0); PG8_BAR; PG8_SCHED;
            PG8_LDB(B1, 1, 1); PG8_STAGE(PG8_SB(1, 0), b3, voffB);
            PG8_BAR; PG8_WAIT_L(0); PG8_MMA(0, 1, At, B1); PG8_BAR;
            PG8_LDA(At, 1, 1); PG8_STAGE(PG8_SA(1, 0), a3, voffA);
            PG8_BAR; PG8_WAIT_L(0); PG8_MMA(1, 0, At, B0); PG8_BAR; PG8_SCHED;
            PG8_STAGE(PG8_SB(1, 1), b3 + hstep, voffB);
            PG8_WAIT_V(6); PG8_BAR; PG8_MMA(1, 1, At, B1); PG8_BAR;
        }
        PG8_STAMP();
        if constexpr (!Epi::AFTER_DRAIN) { E(acc, cur, wr, wc, fr, fq); S.done(cur); }
        PG8_STAMP();
        if (!has_next) break;
#pragma unroll
        for (int a = 0; a < 2; ++a)
#pragma unroll
            for (int b = 0; b < 2; ++b)
#pragma unroll
                for (int m = 0; m < 4; ++m)
#pragma unroll
                    for (int n = 0; n < 2; ++n) acc[a][b][m][n] = (f32x4){0.f, 0.f, 0.f, 0.f};
        cur = nxt; cA = nA; cB = nB; ++ui;
    }
    PG8_WAIT_V(0);
    if (wr == 0) PG8_BAR;
    PG8_BAR;
    if constexpr (Epi::AFTER_DRAIN) { E.fused(acc, cur, wr, wc, fr, fq, lds, wid, lane); S.done(cur); }
    PG8_STAMP();
    if (STAMP && wid == 0) { stamps[lane] = lane < nts ? (((unsigned long long)(unsigned)ts_hi << 32) | (unsigned)ts_lo) : 0ull;
        if (lane == 62) stamps[62] = rt_entry; if (lane == 63) stamps[63] = (unsigned long long)wall_clock64(); }
#undef PG8_STAMP
#undef PG8_SA
#undef PG8_SB
#undef PG8_STAGE
#undef PG8_LDA
#undef PG8_LDB
#undef PG8_MMA
#undef PG8_WAIT_V
#undef PG8_WAIT_L
#undef PG8_BAR
#undef PG8_SCHED
}
}

struct EpiEvin {
  static constexpr bool PERM = true, AFTER_DRAIN = false;
  bf16_t *ZQK, *ZV, *ZO, *ZP; const float* bias;
  __device__ __forceinline__ void operator()(const pg8::f32x4 (&acc)[2][2][4][2], const pg8::Unit& u, int wr, int wc, int fr, int fq) const {
    const int row0 = u.pm * 256 + wr * 64 + fr, ct = u.pn * 256;
    bf16_t* base; int ldc, cl; bool sig = false;
    if (ct < 1024) { base = ZQK; ldc = 1024; cl = ct; } else if (ct < 1536) { base = ZV; ldc = 512; cl = ct - 1024; } else if (ct < 2048) { base = ZO; ldc = 512; cl = ct - 1536; sig = true; } else { base = ZP; ldc = 512; cl = ct - 2048; }
    const int cofs = wc * 32 + 8 * fq;
    pg8::f32x4 bv[2][2];
#pragma unroll
    for (int bj = 0; bj < 2; ++bj)
#pragma unroll
      for (int n = 0; n < 2; ++n) bv[bj][n] = *(const pg8::f32x4*)(bias + ct + cofs + bj * 128 + 4 * n);
#pragma unroll
    for (int ai = 0; ai < 2; ++ai)
#pragma unroll
      for (int m = 0; m < 4; ++m) { bf16_t* rowp = base + (size_t)(row0 + ai * 128 + m * 16) * ldc + cl + cofs;
#pragma unroll
        for (int bj = 0; bj < 2; ++bj) { pg8::f32x4 v0 = acc[ai][bj][m][0] + bv[bj][0], v1 = acc[ai][bj][m][1] + bv[bj][1];
          if (sig) {
#pragma unroll
            for (int j = 0; j < 4; ++j) { v0[j] = sigmf(v0[j]); v1[j] = sigmf(v1[j]); } }
          pg8::u32x4 w; w.x = pg8::cvt_pk_bf16(v0[0], v0[1]); w.y = pg8::cvt_pk_bf16(v0[2], v0[3]); w.z = pg8::cvt_pk_bf16(v1[0], v1[1]); w.w = pg8::cvt_pk_bf16(v1[2], v1[3]);
          *(pg8::u32x4*)(rowp + bj * 128) = w; } }
  }
};
struct EpiPlain {
  static constexpr bool PERM = true, AFTER_DRAIN = false;
  bf16_t* out; int ldc;
  __device__ __forceinline__ void operator()(const pg8::f32x4 (&acc)[2][2][4][2], const pg8::Unit& u, int wr, int wc, int fr, int fq) const {
    const int row0 = u.pm * 256 + wr * 64 + fr, col0 = u.pn * 256 + wc * 32 + 8 * fq;
#pragma unroll
    for (int ai = 0; ai < 2; ++ai)
#pragma unroll
      for (int m = 0; m < 4; ++m) { bf16_t* rowp = out + (size_t)(row0 + ai * 128 + m * 16) * ldc + col0;
#pragma unroll
        for (int bj = 0; bj < 2; ++bj) { const pg8::f32x4 v0 = acc[ai][bj][m][0], v1 = acc[ai][bj][m][1];
          pg8::u32x4 w; w.x = pg8::cvt_pk_bf16(v0[0], v0[1]); w.y = pg8::cvt_pk_bf16(v0[2], v0[3]); w.z = pg8::cvt_pk_bf16(v1[0], v1[1]); w.w = pg8::cvt_pk_bf16(v1[2], v1[3]);
          *(pg8::u32x4*)(rowp + bj * 128) = w; } }
  }
};
struct EpiQP {
  static constexpr bool PERM = true, AFTER_DRAIN = false;
  bf16_t* out;
  __device__ __forceinline__ void operator()(const pg8::f32x4 (&acc)[2][2][4][2], const pg8::Unit& u, int wr, int wc, int fr, int fq) const {
    const int row0 = u.pm * 256 + wr * 64 + fr, head = u.pn;
    const int ks = 2 * wc + (fq >> 1), hh = fq & 1;
#pragma unroll
    for (int ai = 0; ai < 2; ++ai)
#pragma unroll
      for (int m = 0; m < 4; ++m) { const int r = row0 + ai * 128 + m * 16;
#pragma unroll
        for (int bj = 0; bj < 2; ++bj) { const pg8::f32x4 v0 = acc[ai][bj][m][0], v1 = acc[ai][bj][m][1];
          pg8::u32x4 w; w.x = pg8::cvt_pk_bf16(v0[0], v0[1]); w.y = pg8::cvt_pk_bf16(v0[2], v0[3]); w.z = pg8::cvt_pk_bf16(v1[0], v1[1]); w.w = pg8::cvt_pk_bf16(v1[2], v1[3]);
          *(pg8::u32x4*)(out + ((((((size_t)(r >> 5) * 8 + head) * 2 + bj) * 8 + ks) * 2 + hh) * 32 + (r & 31)) * 8) = w; } }
  }
};
struct EpiRes {
  static constexpr bool PERM = false, AFTER_DRAIN = false;
  const float* xin; float* X; const float* gate;
  __device__ __forceinline__ void operator()(const pg8::f32x4 (&acc)[2][2][4][2], const pg8::Unit& u, int wr, int wc, int fr, int fq) const {
    const int row0 = u.pm * 256 + wr * 64 + fr, col0 = u.pn * 256 + wc * 32 + 4 * fq; const float* gb = gate + (size_t)((u.pm * 256) / S) * 6144;
    pg8::f32x4 gv[2][2];
#pragma unroll
    for (int bj = 0; bj < 2; ++bj)
#pragma unroll
      for (int n = 0; n < 2; ++n) gv[bj][n] = *(const pg8::f32x4*)(gb + col0 + bj * 128 + n * 16);
#pragma unroll
    for (int ai = 0; ai < 2; ++ai)
#pragma unroll
      for (int m = 0; m < 4; ++m) { const size_t off = (size_t)(row0 + ai * 128 + m * 16) * 1024 + col0;
#pragma unroll
        for (int bj = 0; bj < 2; ++bj)
#pragma unroll
          for (int n = 0; n < 2; ++n) { const pg8::f32x4 xi = *(const pg8::f32x4*)(xin + off + bj * 128 + n * 16); *(pg8::f32x4*)(X + off + bj * 128 + n * 16) = xi + gv[bj][n] * acc[ai][bj][m][n]; }
        asm volatile("" ::: "memory"); }
  }
};
template <class Epi> __device__ __forceinline__ void phase_gemm_fast(const bf16_t* A, const bf16_t* Bt, int M, int N, int K, const Epi& E, char* smem) {
  pg8::Gemm g; g.A = A; g.Bt = Bt; g.M = M; g.N = N; g.K = K;
  pg8::StaticOrder So; So.init(M, N, (int)gridDim.x, (int)blockIdx.x);
  pg8::gemm_phase<Epi, pg8::StaticOrder, false>((PG8_LAS unsigned char*)smem, g, So, E, nullptr);
}

namespace cp {
typedef short bf16x8 __attribute__((ext_vector_type(8)));
typedef float f32x16 __attribute__((ext_vector_type(16)));
constexpr int RS = 272;
__device__ __forceinline__ void unpack8(const u32x4 w, float* f) { f[0] = bflo(w.x); f[1] = bfhi(w.x); f[2] = bflo(w.y); f[3] = bfhi(w.y); f[4] = bflo(w.z); f[5] = bfhi(w.z); f[6] = bflo(w.w); f[7] = bfhi(w.w); }
__device__ void phase_convpool(const Params& p, char* smem) {
  for (int job = blockIdx.x; job < T / 64; job += gridDim.x) {
    int tid_ = threadIdx.x; asm volatile("" : "+v"(tid_));
    const int tid = tid_, c0 = (tid & 127) * 8, t0 = job * 64 + (tid >> 7) * 16, s0 = t0 & (S - 1);
    float cw[5][8], cb[8];
#pragma unroll
    for (int j = 0; j < 5; ++j) { const f32x4 a = *(const f32x4*)(p.conv_w + j * 1024 + c0), b = *(const f32x4*)(p.conv_w + j * 1024 + c0 + 4); cw[j][0] = a.x; cw[j][1] = a.y; cw[j][2] = a.z; cw[j][3] = a.w; cw[j][4] = b.x; cw[j][5] = b.y; cw[j][6] = b.z; cw[j][7] = b.w; }
    { const f32x4 a = *(const f32x4*)(p.conv_b + c0), b = *(const f32x4*)(p.conv_b + c0 + 4); cb[0] = a.x; cb[1] = a.y; cb[2] = a.z; cb[3] = a.w; cb[4] = b.x; cb[5] = b.y; cb[6] = b.z; cb[7] = b.w; }
    const float sc = c0 >= 512 ? KSCALE : 1.f;
    float win[5][8];
#pragma unroll
    for (int j = 0; j < 4; ++j) { const int ss = s0 + j - 2; u32x4 w = (u32x4){0u, 0u, 0u, 0u}; if (ss >= 0 && ss < S) w = *(const u32x4*)(p.ZQK + (size_t)(t0 + j - 2) * 1024 + c0); unpack8(w, win[j + 1]); }
#pragma unroll
    for (int i = 0; i < 16; ++i) {
#pragma unroll
      for (int j = 0; j < 4; ++j)
#pragma unroll
        for (int q = 0; q < 8; ++q) win[j][q] = win[j + 1][q];
      { const int ss = s0 + i + 2; u32x4 w = (u32x4){0u, 0u, 0u, 0u}; if (ss < S) w = *(const u32x4*)(p.ZQK + (size_t)(t0 + i + 2) * 1024 + c0); unpack8(w, win[4]); }
      float a[8];
#pragma unroll
      for (int q = 0; q < 8; ++q) { float v = cb[q];
#pragma unroll
        for (int j = 0; j < 5; ++j) v += cw[j][q] * win[j][q];
        a[q] = siluf(v) * sc; }
      u32x4 o; o.x = pack2(a[0], a[1]); o.y = pack2(a[2], a[3]); o.z = pack2(a[4], a[5]); o.w = pack2(a[6], a[7]); *(u32x4*)(p.QK + (size_t)(t0 + i) * 1024 + c0) = o;
    }
  }
  for (int job = blockIdx.x; job < (T / 128) * 4; job += gridDim.x) {
    int tid_ = threadIdx.x; asm volatile("" : "+v"(tid_));
    const int tid = tid_, wid = tid >> 6, lane = tid & 63, l31 = lane & 31, hh = lane >> 5;
    const int g = (job + (job >> 8)) & 3, t0 = (job >> 2) * 128, win = 2 << g, hw = win >> 1;
    __syncthreads();
#pragma unroll
    for (int i = 0; i < 4; ++i) { const int idx = tid + i * NTHREADS, row = idx >> 4, ch = idx & 15; *(u32x4*)(smem + 128 * RS + row * RS + ch * 16) = *(const u32x4*)(p.poolWt + (size_t)g * 16384 + row * 128 + ch * 8); }
#pragma unroll 1
    for (int i = 0; i < 4; ++i) { const int idx = tid + i * NTHREADS, row = idx >> 4, ch = idx & 15, t = t0 + row, s = t & (S - 1); const int lo = max(s - hw, 0), hi = min(s + hw, S);
      float sum[8], own[8];
#pragma unroll
      for (int q = 0; q < 8; ++q) sum[q] = 0.f;
      const bf16_t* base = p.ZP + (size_t)(t - s) * 512 + g * 128 + ch * 8;
      u32x4 rw[16];
#pragma unroll
      for (int r = 0; r < 16; ++r) { rw[r] = (u32x4){0u, 0u, 0u, 0u}; if (r < win) { const int rr = s - hw + r; if (rr >= 0 && rr < S) rw[r] = *(const u32x4*)(base + (size_t)rr * 512); } }
#pragma unroll
      for (int r = 0; r < 16; ++r) if (r < win) { float f[8]; unpack8(rw[r], f);
#pragma unroll
        for (int q = 0; q < 8; ++q) sum[q] += f[q]; }
      unpack8(*(const u32x4*)(base + (size_t)s * 512), own); const float inv = 1.f / (float)(hi - lo);
      u32x4 o; o.x = pack2(sum[0] * inv - own[0], sum[1] * inv - own[1]); o.y = pack2(sum[2] * inv - own[2], sum[3] * inv - own[3]); o.z = pack2(sum[4] * inv - own[4], sum[5] * inv - own[5]); o.w = pack2(sum[6] * inv - own[6], sum[7] * inv - own[7]);
      *(u32x4*)(smem + row * RS + ch * 16) = o; }
    __syncthreads();
    const int mt = wid >> 1;
#pragma unroll
    for (int q = 0; q < 2; ++q) { const int nt = (wid & 1) * 2 + q;
      f32x16 acc;
#pragma unroll
      for (int r = 0; r < 16; ++r) acc[r] = 0.f;
      const char* ya = smem + (mt * 32 + l31) * RS + hh * 16; const char* wb = smem + 128 * RS + (nt * 32 + l31) * RS + hh * 16;
#pragma unroll
      for (int ks = 0; ks < 8; ++ks) acc = __builtin_amdgcn_mfma_f32_32x32x16_bf16(*(const bf16x8*)(ya + ks * 32), *(const bf16x8*)(wb + ks * 32), acc, 0, 0, 0);
      const int e = nt * 32 + l31; const float psc = p.pool_sc[g * 128 + e];
#pragma unroll
      for (int r = 0; r < 16; ++r) { const int row = mt * 32 + (r & 3) + 8 * (r >> 2) + 4 * hh; p.CAT[(size_t)(t0 + row) * 1024 + 512 + g * 128 + e] = f2bf(acc[r] * psc); } }
  }
}
}

namespace ml {
typedef short bf16x8 __attribute__((ext_vector_type(8)));
typedef short s16x4 __attribute__((ext_vector_type(4)));
typedef float f32x16 __attribute__((ext_vector_type(16)));
constexpr int RS = 272;
constexpr int OFF_Q = 0, OFF_K = 128 * RS, OFF_VT = 2 * 128 * RS, OFF_VW = OFF_VT + 34 * RS, OFF_CT = OFF_VW + 34 * RS, OFF_A = OFF_CT + 34 * RS;
constexpr int OFF_PA = OFF_A + 16384, OFF_MCH = OFF_PA + 16384, OFF_TAB = OFF_MCH + 512, OFF_DEN = OFF_TAB + 4096  , OFF_EX = OFF_DEN + 1536  , OFF_OUT = OFF_EX + 16384  , OFF_END = OFF_OUT + 128 * 80;
static_assert(OFF_A % 16 == 0 && OFF_END <= SMEM_BYTES, "mlstm LDS layout");
__device__ __forceinline__ int crow(int r, int h) { return (r & 3) + 8 * (r >> 2) + 4 * h; }
__device__ __forceinline__ int spos(int s) { return (s & ~12) | ((s & 4) << 1) | ((s & 8) >> 1); }
#define ML_MFMA(a, b, c) __builtin_amdgcn_mfma_f32_32x32x16_bf16((a), (b), (c), 0, 0, 0)
__device__ __forceinline__ bf16x8 pack8(float x0, float x1, float x2, float x3, float x4, float x5, float x6, float x7) {
  u32x4 w;
  asm volatile("v_cvt_pk_bf16_f32 %0, %4, %5\n\tv_cvt_pk_bf16_f32 %1, %6, %7\n\tv_cvt_pk_bf16_f32 %2, %8, %9\n\tv_cvt_pk_bf16_f32 %3, %10, %11\n\ts_nop 1"
               : "=&v"(w.x), "=&v"(w.y), "=&v"(w.z), "=&v"(w.w) : "v"(x0), "v"(x1), "v"(x2), "v"(x3), "v"(x4), "v"(x5), "v"(x6), "v"(x7));
  return __builtin_bit_cast(bf16x8, w);
}
__device__ __forceinline__ void tr_read8(unsigned a, s16x4& r0, s16x4& r1, s16x4& r2, s16x4& r3, s16x4& r4, s16x4& r5, s16x4& r6, s16x4& r7) {
  asm volatile("ds_read_b64_tr_b16 %0, %8\n\tds_read_b64_tr_b16 %1, %8 offset:2176\n\tds_read_b64_tr_b16 %2, %8 offset:4352\n\tds_read_b64_tr_b16 %3, %8 offset:6528\n\t"
               "ds_read_b64_tr_b16 %4, %8 offset:8704\n\tds_read_b64_tr_b16 %5, %8 offset:10880\n\tds_read_b64_tr_b16 %6, %8 offset:13056\n\tds_read_b64_tr_b16 %7, %8 offset:15232\n\ts_waitcnt lgkmcnt(0)"
               : "=&v"(r0), "=&v"(r1), "=&v"(r2), "=&v"(r3), "=&v"(r4), "=&v"(r5), "=&v"(r6), "=&v"(r7) : "v"(a) : "memory");
}
static_assert(8 * RS == 2176, "tr_read8 offsets assume 272-byte rows");

__device__ void phase_mlstm(const Params& p, char* smem) {
  int tid_ = threadIdx.x; asm volatile("" : "+v"(tid_));
  const int tid = tid_, wid = tid >> 6, lane = tid & 63, l31 = lane & 31, hh = lane >> 5;
  float* const LA = (float*)(smem + OFF_A); float* const LPA = (float*)(smem + OFF_PA); float* const LM = (float*)(smem + OFF_MCH);
  float* const LTAB = (float*)(smem + OFF_TAB); float* const LDEN = (float*)(smem + OFF_DEN);
  const unsigned lds0 = (unsigned)(uintptr_t)smem;
  for (int job = blockIdx.x; job < 256; job += gridDim.x) {
    const int dvq = job & 3, h = (job >> 2) & 3, b = (job >> 4) & 7, dir = job >> 7;
    const float* gts = p.gates + (size_t)b * S * 16;
    const bf16_t* QKb = p.QK + (size_t)b * S * 1024 + h * 128; const bf16_t* ZVb = p.ZV + (size_t)b * S * 512 + h * 128 + dvq * 32;
    bf16_t* HSb = p.HS + ((size_t)dir * T + (size_t)b * S) * 512 + h * 128 + dvq * 32;
    __syncthreads();
    for (int i = tid; i < 3 * 34 * RS / 4; i += NTHREADS) ((u32*)(smem + OFF_VT))[i] = 0u;
    for (int cc = 0; cc < 4; ++cc) { const int c = wid * 4 + cc, tau0 = c * 128 + 2 * lane; const int tok0 = dir ? S - 1 - tau0 : tau0, tok1 = dir ? tok0 - 1 : tok0 + 1;
      const float li0 = gts[(size_t)tok0 * 16 + dir * 4 + h], gf0 = gts[(size_t)tok0 * 16 + 8 + dir * 4 + h], li1 = gts[(size_t)tok1 * 16 + dir * 4 + h], gf1 = gts[(size_t)tok1 * 16 + 8 + dir * 4 + h];
      const float lf0 = fminf(gf0, 0.f) - log1pf(__expf(-fabsf(gf0))), lf1 = fminf(gf1, 0.f) - log1pf(__expf(-fabsf(gf1)));
      const float pr = lf0 + lf1; float incl = pr;
#pragma unroll
      for (int o = 1; o < 64; o <<= 1) { const float v = __shfl_up(incl, o); if (lane >= o) incl += v; }
      const float b0 = incl - pr + lf0, b1 = b0 + lf1, a0 = li0 - b0, a1 = li1 - b1;
      float im = fmaxf(a0, a1);
#pragma unroll
      for (int o = 1; o < 64; o <<= 1) { const float v = __shfl_up(im, o); if (lane >= o) im = fmaxf(im, v); }
      float ex = __shfl_up(im, 1); if (lane == 0) ex = -INFINITY;
      const float pa0 = fmaxf(ex, a0), pa1 = fmaxf(pa0, a1);
      LA[tau0] = a0; LA[tau0 + 1] = a1; LPA[tau0] = pa0; LPA[tau0 + 1] = pa1; if (lane == 63) LM[64 + c] = b1; }
    __syncthreads();
    if (tid == 0) { float m = 0.f; for (int c = 0; c < 32; ++c) { LM[c] = m; m = LM[64 + c] + fmaxf(m, LPA[c * 128 + 127]); } LM[32] = m; }
    __syncthreads();
    u32x4 qreg[4], kreg[4], vreg;
#define ML_TOK(tau) (dir ? S - 1 - (tau) : (tau))
#define ML_LOAD(c) do { _Pragma("unroll") for (int i_ = 0; i_ < 4; ++i_) { const int tk_ = ML_TOK((c) * 128 + (tid >> 4) + 32 * i_); \
        qreg[i_] = *(const u32x4*)(QKb + (size_t)tk_ * 1024 + (tid & 15) * 8); kreg[i_] = *(const u32x4*)(QKb + (size_t)tk_ * 1024 + 512 + (tid & 15) * 8); } \
      { const int tk_ = ML_TOK((c) * 128 + (tid & 127)); vreg = *(const u32x4*)(ZVb + (size_t)tk_ * 512 + (tid >> 7) * 8); } } while (0)
#define ML_LI(c) gts[(size_t)ML_TOK((c) * 128 + (tid & 127)) * 16 + dir * 4 + h]
#define ML_TABLES(c, li_) do { if (tid < 128) { const int tau_ = (c) * 128 + tid; const float a_ = LA[tau_], mc_ = LM[(c)]; \
        const float Mj_ = fmaxf(mc_, LPA[tau_]), Me_ = fmaxf(mc_, LPA[(c) * 128 + 127]); float* tb_ = LTAB + ((c) & 1) * 512; \
        tb_[tid] = __expf(fminf(Me_ - Mj_, 60.f)); tb_[128 + tid] = __expf(mc_ - Mj_); tb_[256 + tid] = __expf(-((li_ - a_) + Mj_)); tb_[384 + tid] = __expf(a_ - Me_); } } while (0)
#define ML_STORE(c) do { _Pragma("unroll") for (int i_ = 0; i_ < 4; ++i_) { const int row_ = (tid >> 4) + 32 * i_; \
        *(u32x4*)(smem + OFF_Q + row_ * RS + (tid & 15) * 16) = qreg[i_]; *(u32x4*)(smem + OFF_K + row_ * RS + (tid & 15) * 16) = kreg[i_]; } \
      { const int s_ = tid & 127, ps_ = spos(s_) * 2; const float we_ = LTAB[((c) & 1) * 512 + 384 + s_]; const u32 vw_[4] = {vreg.x, vreg.y, vreg.z, vreg.w}; \
        _Pragma("unroll") for (int i_ = 0; i_ < 4; ++i_) { const int r0_ = ((tid >> 7) * 8 + 2 * i_) * RS + ps_; \
          *(bf16_t*)(smem + OFF_VT + r0_) = (bf16_t)(vw_[i_] & 0xFFFFu); *(bf16_t*)(smem + OFF_VT + r0_ + RS) = (bf16_t)(vw_[i_] >> 16); \
          *(bf16_t*)(smem + OFF_VW + r0_) = f2bf(bflo(vw_[i_]) * we_); *(bf16_t*)(smem + OFF_VW + r0_ + RS) = f2bf(bfhi(vw_[i_]) * we_); } } \
      if (tid < 128) { const int ps_ = spos(tid) * 2; *(bf16_t*)(smem + OFF_VT + 32 * RS + ps_) = (bf16_t)0x3F80u; *(bf16_t*)(smem + OFF_VW + 32 * RS + ps_) = f2bf(LTAB[((c) & 1) * 512 + 384 + tid]); } } while (0)
    float li_pf = ML_LI(0);
    ML_LOAD(0); ML_TABLES(0, li_pf);
    li_pf = ML_LI(1);
    __syncthreads();
    ML_STORE(0);
    __syncthreads();
    f32x16 Cacc;
#pragma unroll
    for (int r = 0; r < 16; ++r) Cacc[r] = 0.f;
    for (int c = 0; c < 32; ++c) {
      int tidc_ = threadIdx.x; asm volatile("" : "+v"(tidc_));
      const int tid = tidc_, wid = tid >> 6, lane = tid & 63, l31 = lane & 31, hh = lane >> 5;
      const int t2 = wid >> 1, nt = wid & 1, brow = min(nt * 32 + l31, 33);
      if (c + 1 < 32) { ML_LOAD(c + 1); ML_TABLES(c + 1, li_pf); }
      if (c + 2 < 32) li_pf = ML_LI(c + 2);
      const float* tab = LTAB + (c & 1) * 512;
      f32x16 acc;
#pragma unroll
      for (int r = 0; r < 16; ++r) acc[r] = 0.f;
      const char* qa = smem + OFF_Q + (t2 * 32 + l31) * RS + hh * 16;
      if (nt == 0) { const char* cb = smem + OFF_CT + l31 * RS + hh * 16;
#pragma unroll
        for (int ks = 0; ks < 8; ++ks) acc = ML_MFMA(*(const bf16x8*)(qa + ks * 32), *(const bf16x8*)(cb + ks * 32), acc);
#pragma unroll
        for (int r = 0; r < 16; ++r) acc[r] *= tab[128 + t2 * 32 + crow(r, hh)];
      } else { const char* cb = smem + OFF_CT + (l31 == 0 ? 32 : 33) * RS + hh * 16; f32x16 aq;
#pragma unroll
        for (int r = 0; r < 16; ++r) aq[r] = 0.f;
#pragma unroll
        for (int ks = 0; ks < 8; ++ks) aq = ML_MFMA(*(const bf16x8*)(qa + ks * 32), *(const bf16x8*)(cb + ks * 32), aq);
        if (l31 == 0) {
#pragma unroll
          for (int r = 0; r < 16; ++r) { const int j = t2 * 32 + crow(r, hh); LDEN[256 + j] = aq[r] * tab[128 + j]; } } }
      const float fj = tab[t2 * 32 + l31];
      float psum = 0.f;
      for (int si = nt; si <= t2; si += 2) {
        f32x16 X;
#pragma unroll
        for (int r = 0; r < 16; ++r) X[r] = 0.f;
        const char* ka = smem + OFF_K + (si * 32 + l31) * RS + hh * 16;
#pragma unroll
        for (int ks = 0; ks < 8; ++ks) X = ML_MFMA(*(const bf16x8*)(ka + ks * 32), *(const bf16x8*)(qa + ks * 32), X);
        const float* We = tab + 384 + si * 32;
#pragma unroll
        for (int r = 0; r < 16; ++r) { const int sl = crow(r, hh); float w = We[sl] * fj; if (si == t2 && sl > l31) w = 0.f; X[r] *= w; psum += X[r]; }
        const bf16x8 f0 = pack8(X[0], X[1], X[2], X[3], X[4], X[5], X[6], X[7]), f1 = pack8(X[8], X[9], X[10], X[11], X[12], X[13], X[14], X[15]);
        const char* vb = smem + OFF_VT + l31 * RS + si * 64 + hh * 16;
        acc = ML_MFMA(f0, *(const bf16x8*)(vb), acc); acc = ML_MFMA(f1, *(const bf16x8*)(vb + 32), acc);
      }
      psum = sum32x(psum);
      if (hh == 0) LDEN[nt * 128 + t2 * 32 + l31] = psum;
      if (nt == 1) { float* ex = (float*)(smem + OFF_EX) + t2 * 1024 + lane;
#pragma unroll
        for (int r = 0; r < 16; ++r) ex[r * 64] = acc[r]; }
      { const float mc = LM[c], decay = __expf(mc - fmaxf(mc, LPA[c * 128 + 127]));
#pragma unroll
        for (int r = 0; r < 16; ++r) Cacc[r] *= decay;
        const unsigned ta = lds0 + OFF_K + ((lane & 15) >> 2) * RS + (t2 * 32 + 16 * ((lane >> 4) & 1) + 4 * (lane & 3)) * 2 + 4 * hh * RS;
        const char* wb = smem + OFF_VW + brow * RS + hh * 16;
#pragma unroll
        for (int kq = 0; kq < 2; ++kq) { s16x4 r0, r1, r2, r3, r4, r5, r6, r7; tr_read8(ta + 64 * kq * RS, r0, r1, r2, r3, r4, r5, r6, r7); __builtin_amdgcn_sched_barrier(0);
          Cacc = ML_MFMA(((bf16x8){r0[0], r0[1], r0[2], r0[3], r1[0], r1[1], r1[2], r1[3]}), *(const bf16x8*)(wb + (4 * kq + 0) * 32), Cacc);
          Cacc = ML_MFMA(((bf16x8){r2[0], r2[1], r2[2], r2[3], r3[0], r3[1], r3[2], r3[3]}), *(const bf16x8*)(wb + (4 * kq + 1) * 32), Cacc);
          Cacc = ML_MFMA(((bf16x8){r4[0], r4[1], r4[2], r4[3], r5[0], r5[1], r5[2], r5[3]}), *(const bf16x8*)(wb + (4 * kq + 2) * 32), Cacc);
          Cacc = ML_MFMA(((bf16x8){r6[0], r6[1], r6[2], r6[3], r7[0], r7[1], r7[2], r7[3]}), *(const bf16x8*)(wb + (4 * kq + 3) * 32), Cacc); } }
      __syncthreads();
      if (nt == 0) { const float* ex = (const float*)(smem + OFF_EX) + t2 * 1024 + lane;
#pragma unroll
        for (int r = 0; r < 16; ++r) { const int j = t2 * 32 + crow(r, hh); const float dn = LDEN[j] + LDEN[128 + j] + LDEN[256 + j], nr = tab[256 + j];
          *(bf16_t*)(smem + OFF_OUT + j * 80 + l31 * 2) = f2bf((acc[r] + ex[r * 64]) * __builtin_amdgcn_rcpf(fmaxf(fabsf(dn), nr))); } }
      if (nt * 32 + l31 <= 32) { char* cw = smem + OFF_CT + (nt * 32 + l31) * RS + (t2 * 32 + 4 * hh) * 2;
#pragma unroll
        for (int g = 0; g < 4; ++g) { u32x2 w; w.x = pack2(Cacc[4 * g], Cacc[4 * g + 1]); w.y = pack2(Cacc[4 * g + 2], Cacc[4 * g + 3]); *(u32x2*)(cw + 16 * g) = w; } }
      if (c + 1 < 32) ML_STORE(c + 1);
      __syncthreads();
      { const int j = tid >> 2, ch = tid & 3; const u32x4 o = *(const u32x4*)(smem + OFF_OUT + j * 80 + ch * 16);
        *(u32x4*)(HSb + (size_t)ML_TOK(c * 128 + j) * 512 + ch * 8) = o; }
    }
#undef ML_TOK
#undef ML_LOAD
#undef ML_TABLES
#undef ML_LI
#undef ML_STORE
  }
}
}

namespace sel {
typedef short bf16x8 __attribute__((ext_vector_type(8)));
typedef float f32x16 __attribute__((ext_vector_type(16)));
constexpr int RS = 272, OFF_W = 2 * 128 * RS, WB = 3 * 16 * 32 * 4;
static_assert(OFF_W + 8 * WB <= SMEM_BYTES, "select LDS layout");
constexpr float NEG = -3.0e38f;
__device__ __forceinline__ float max3(float a, float b, float c) { return fmaxf(fmaxf(a, b), c); }
__device__ __forceinline__ float xhalf(float v) { return __shfl_xor(v, 32); }

#define CE(a, b) do { const float hi_ = fmaxf(a, b), lo_ = fminf(a, b); a = hi_; b = lo_; } while (0)
#define SORT16(V) do { CE(V[0], V[1]); CE(V[2], V[3]); CE(V[0], V[2]); CE(V[1], V[3]); CE(V[1], V[2]); CE(V[4], V[5]); CE(V[6], V[7]); CE(V[4], V[6]); CE(V[5], V[7]); CE(V[5], V[6]); CE(V[0], V[4]); CE(V[2], V[6]); CE(V[2], V[4]); CE(V[1], V[5]); CE(V[3], V[7]); CE(V[3], V[5]); CE(V[1], V[2]); CE(V[3], V[4]); CE(V[5], V[6]); CE(V[8], V[9]); CE(V[10], V[11]); CE(V[8], V[10]); CE(V[9], V[11]); CE(V[9], V[10]); CE(V[12], V[13]); CE(V[14], V[15]); CE(V[12], V[14]); CE(V[13], V[15]); CE(V[13], V[14]); CE(V[8], V[12]); CE(V[10], V[14]); CE(V[10], V[12]); CE(V[9], V[13]); CE(V[11], V[15]); CE(V[11], V[13]); CE(V[9], V[10]); CE(V[11], V[12]); CE(V[13], V[14]); CE(V[0], V[8]); CE(V[4], V[12]); CE(V[4], V[8]); CE(V[2], V[10]); CE(V[6], V[14]); CE(V[6], V[10]); CE(V[2], V[4]); CE(V[6], V[8]); CE(V[10], V[12]); CE(V[1], V[9]); CE(V[5], V[13]); CE(V[5], V[9]); CE(V[3], V[11]); CE(V[7], V[15]); CE(V[7], V[11]); CE(V[3], V[5]); CE(V[7], V[9]); CE(V[11], V[13]); CE(V[1], V[2]); CE(V[3], V[4]); CE(V[5], V[6]); CE(V[7], V[8]); CE(V[9], V[10]); CE(V[11], V[12]); CE(V[13], V[14]); } while (0)
#define BMERGE16(V) do { CE(V[0], V[8]); CE(V[1], V[9]); CE(V[2], V[10]); CE(V[3], V[11]); CE(V[4], V[12]); CE(V[5], V[13]); CE(V[6], V[14]); CE(V[7], V[15]); CE(V[0], V[4]); CE(V[1], V[5]); CE(V[2], V[6]); CE(V[3], V[7]); CE(V[8], V[12]); CE(V[9], V[13]); CE(V[10], V[14]); CE(V[11], V[15]); CE(V[0], V[2]); CE(V[1], V[3]); CE(V[4], V[6]); CE(V[5], V[7]); CE(V[8], V[10]); CE(V[9], V[11]); CE(V[12], V[14]); CE(V[13], V[15]); CE(V[0], V[1]); CE(V[2], V[3]); CE(V[4], V[5]); CE(V[6], V[7]); CE(V[8], V[9]); CE(V[10], V[11]); CE(V[12], V[13]); CE(V[14], V[15]); } while (0)

}

typedef float f32x2 __attribute__((ext_vector_type(2)));
typedef unsigned u32x3 __attribute__((ext_vector_type(3)));
typedef unsigned u32x2g __attribute__((ext_vector_type(2)));
typedef unsigned u32x6 __attribute__((ext_vector_type(6)));
typedef unsigned u32x16 __attribute__((ext_vector_type(16)));
typedef float f32x32 __attribute__((ext_vector_type(32)));
constexpr int GT = 4;
constexpr int GW_WAVE_BYTES = GT * (2048 + 128 * 2 + 128 * 4);
static_assert(8 * GW_WAVE_BYTES <= SMEM_BYTES - 16, "gather LDS layout");
__device__ __forceinline__ float gelu_erf(float z) { const float ax = fabsf(z) * 0.70710678118654752f;
  const float t = __builtin_amdgcn_rcpf(fmaf(0.3275911f, ax, 1.f));
  float pl = fmaf(1.061405429f, t, -1.453152027f); pl = fmaf(pl, t, 1.421413741f); pl = fmaf(pl, t, -0.284496736f); pl = fmaf(pl, t, 0.254829592f); pl *= t;
  const float er = 1.f - pl * __expf(-ax * ax);
  return 0.5f * z + 0.5f * fabsf(z) * er; }
__device__ __forceinline__ float reduce8(float d0, float d1, float d2, float d3, float d4, float d5, float d6, float d7, int lane) {
  float e[4];
  { auto r0 = __builtin_amdgcn_permlane32_swap(__float_as_uint(d0), __float_as_uint(d4), false, false); e[0] = __uint_as_float(r0[0]) + __uint_as_float(r0[1]);
    auto r1 = __builtin_amdgcn_permlane32_swap(__float_as_uint(d1), __float_as_uint(d5), false, false); e[1] = __uint_as_float(r1[0]) + __uint_as_float(r1[1]);
    auto r2 = __builtin_amdgcn_permlane32_swap(__float_as_uint(d2), __float_as_uint(d6), false, false); e[2] = __uint_as_float(r2[0]) + __uint_as_float(r2[1]);
    auto r3 = __builtin_amdgcn_permlane32_swap(__float_as_uint(d3), __float_as_uint(d7), false, false); e[3] = __uint_as_float(r3[0]) + __uint_as_float(r3[1]); }
  float f0, f1;
  { auto r0 = __builtin_amdgcn_permlane16_swap(__float_as_uint(e[0]), __float_as_uint(e[2]), false, false); f0 = __uint_as_float(r0[0]) + __uint_as_float(r0[1]);
    auto r1 = __builtin_amdgcn_permlane16_swap(__float_as_uint(e[1]), __float_as_uint(e[3]), false, false); f1 = __uint_as_float(r1[0]) + __uint_as_float(r1[1]); }
  const bool up = (lane & 8) != 0; const float keep = up ? f1 : f0, send = up ? f0 : f1;
  float g = keep + dppf<DPP_MIR>(send);
  g += dppf<DPP_X1>(g); g += dppf<DPP_X2>(g); g += dppf<DPP_HMIR>(g);
  return g;
}
__device__ __forceinline__ int reduce8i(int d0, int d1, int d2, int d3, int d4, int d5, int d6, int d7, int lane) {
  int e[4];
  { auto r0 = __builtin_amdgcn_permlane32_swap((unsigned)d0, (unsigned)d4, false, false); e[0] = (int)(r0[0] + r0[1]);
    auto r1 = __builtin_amdgcn_permlane32_swap((unsigned)d1, (unsigned)d5, false, false); e[1] = (int)(r1[0] + r1[1]);
    auto r2 = __builtin_amdgcn_permlane32_swap((unsigned)d2, (unsigned)d6, false, false); e[2] = (int)(r2[0] + r2[1]);
    auto r3 = __builtin_amdgcn_permlane32_swap((unsigned)d3, (unsigned)d7, false, false); e[3] = (int)(r3[0] + r3[1]); }
  int f0, f1;
  { auto r0 = __builtin_amdgcn_permlane16_swap((unsigned)e[0], (unsigned)e[2], false, false); f0 = (int)(r0[0] + r0[1]);
    auto r1 = __builtin_amdgcn_permlane16_swap((unsigned)e[1], (unsigned)e[3], false, false); f1 = (int)(r1[0] + r1[1]); }
  const bool up = (lane & 8) != 0; const int keep = up ? f1 : f0, send = up ? f0 : f1;
  int g = keep + dppi<DPP_MIR>(send);
  g += dppi<DPP_X1>(g); g += dppi<DPP_X2>(g); g += dppi<DPP_HMIR>(g);
  return g;
}
constexpr int PF_LIDX = 2 * 128 * 272, PF_LGATE = PF_LIDX + 32 * 128 * 2, PF_X = PF_LGATE + 32 * 128 * 4;
static_assert(PF_X + 8 * 8192 <= SMEM_BYTES - 16 && GT == 4, "fused PEER LDS layout");
template <int NEXT>
__device__ void phase_peer_fused(const Params& p, int layer, char* smem) {
  using namespace sel;
  bf16_t* const Lidx = (bf16_t*)(smem + PF_LIDX); float* const Lgate = (float*)(smem + PF_LGATE);
  const int tid0 = threadIdx.x;
  __syncthreads();
  { const bf16_t* kb = p.keysb + (size_t)layer * 32768;
    for (int i = tid0; i < 2 * 128 * 16; i += NTHREADS) { const int row = i >> 4, ch = i & 15; *(u32x4*)(smem + row * RS + ch * 16) = *(const u32x4*)(kb + (size_t)row * 128 + ch * 8); } }
  __syncthreads();
  const __amdgpu_buffer_rsrc_t rsU = __builtin_amdgcn_make_buffer_rsrc((void*)(p.U8 + (size_t)layer * 16384 * 768), 0, 16384 * 768, 0x00020000);
  const __amdgpu_buffer_rsrc_t rsV = __builtin_amdgcn_make_buffer_rsrc((void*)(p.V8 + (size_t)layer * 16384 * 768), 0, 16384 * 768, 0x00020000);
  for (int job = blockIdx.x; job < T / 32; job += gridDim.x) {
   {
    int tid_ = threadIdx.x; asm volatile("" : "+v"(tid_));
    const int tid = tid_, wid = tid >> 6, lane = tid & 63, l31 = lane & 31, hh = lane >> 5, h = wid;
    const int t = job * 32 + l31;
    float* const wl = (float*)(smem + PF_X + wid * 8192);
    float rs[2], s1[16], s2[16];
#pragma unroll
    for (int pp = 0; pp < 2; ++pp) {
      const bf16_t* qrow = p.QP + ((((((size_t)(t >> 5) * 8 + h) * 2 + pp) * 8) * 2 + hh) * 32 + (t & 31)) * 8;
      bf16x8 bq[8]; float ssq = 0.f;
#pragma unroll
      for (int ks = 0; ks < 8; ++ks) { const u32x4 w = *(const u32x4*)(qrow + ks * 512); bq[ks] = __builtin_bit_cast(bf16x8, w);
        const u32 w0 = w.x, w1 = w.y, w2 = w.z, w3 = w.w; ssq = dot2bf(w0, w0, ssq); ssq = dot2bf(w1, w1, ssq); ssq = dot2bf(w2, w2, ssq); ssq = dot2bf(w3, w3, ssq); }
      ssq = sum32x(ssq); rs[pp] = rsqrtf(ssq * (1.f / 128.f) + EPS);
      f32x16 X[4];
#pragma unroll
      for (int nt = 0; nt < 4; ++nt) {
#pragma unroll
        for (int r = 0; r < 16; ++r) X[nt][r] = 0.f;
        const char* ka = smem + (pp * 128 + nt * 32 + l31) * RS + hh * 16;
#pragma unroll
        for (int ks = 0; ks < 8; ++ks) X[nt] = __builtin_amdgcn_mfma_f32_32x32x16_bf16(*(const bf16x8*)(ka + ks * 32), bq[ks], X[nt], 0, 0, 0); }
#pragma unroll
      for (int nt = 0; nt < 4; ++nt)
#pragma unroll
        for (int r = 0; r < 16; ++r) X[nt][r] = __uint_as_float((__float_as_uint(X[nt][r]) & ~0x7Fu) | (u32)(nt * 32 + (r & 3) + 8 * (r >> 2)) | ((u32)hh << 2));
      SORT16(X[0]); SORT16(X[1]); SORT16(X[2]); SORT16(X[3]);
#pragma unroll
      for (int i = 0; i < 16; ++i) { X[0][i] = fmaxf(X[0][i], X[1][15 - i]); X[2][i] = fmaxf(X[2][i], X[3][15 - i]); }
      BMERGE16(X[0]); BMERGE16(X[2]);
#pragma unroll
      for (int i = 0; i < 16; ++i) X[0][i] = fmaxf(X[0][i], X[2][15 - i]);
      BMERGE16(X[0]);
      f32x16 lo_, hi_;
#pragma unroll
      for (int i = 0; i < 16; ++i) { const u32 b_ = __float_as_uint(X[0][i]); auto r_ = __builtin_amdgcn_permlane32_swap(b_, b_, false, false); lo_[i] = __uint_as_float(r_[0]); hi_[i] = __uint_as_float(r_[1]); }
#pragma unroll
      for (int i = 0; i < 16; ++i) X[0][i] = fmaxf(lo_[i], hi_[15 - i]);
      BMERGE16(X[0]);
#pragma unroll
      for (int k = 0; k < 16; ++k) { wl[(pp * 16 + k) * 32 + l31] = X[0][k]; if (pp == 0) s1[k] = X[0][k] * rs[0]; else s2[k] = X[0][k] * rs[1]; }
    }
    constexpr int A0[25] = {0, 0, 0, 0, 0, 0, 0, 0, 0, 0, 0, 0, 0, 0, 0, 0, 2, 2, 2, 2, 2, 3, 3, 3, 3}, B0[25] = {0, 1, 2, 3, 4, 5, 6, 7, 8, 9, 10, 11, 12, 13, 14, 15, 0, 1, 2, 3, 4, 0, 1, 2, 3};
    constexpr int A1[25] = {1, 1, 1, 1, 1, 1, 1, 1, 4, 4, 4, 5, 5, 6, 6, 7, 7, 8, 9, 10, 11, 12, 13, 14, 15}, B1[25] = {0, 1, 2, 3, 4, 5, 6, 7, 0, 1, 2, 0, 1, 0, 1, 0, 1, 0, 0, 0, 0, 0, 0, 0, 0};
    float cd[25]; u32 hmask = 0u - (u32)hh; asm volatile("" : "+v"(hmask));
#pragma unroll
    for (int i = 0; i < 25; ++i) { const float v0 = s1[A0[i]] + s2[B0[i]], v1 = s1[A1[i]] + s2[B1[i]]; const float v = hh ? v1 : v0; const u32 cid = (u32)(A0[i] * 16 + B0[i]) ^ (hmask & (u32)((A1[i] * 16 + B1[i]) ^ (A0[i] * 16 + B0[i])));
      cd[i] = __uint_as_float((__float_as_uint(v) & ~0xFFu) | cid); }
#pragma unroll 1
    for (int k = 0; k < 16; ++k) {
      float m = cd[24];
#pragma unroll
      for (int i = 0; i < 24; i += 2) m = max3(m, cd[i], cd[i + 1]);
      const float M = max32x(m);
      wl[(32 + k) * 32 + l31] = M;
#pragma unroll
      for (int i = 0; i < 25; ++i) cd[i] = (cd[i] == M) ? NEG : cd[i];
    }
    float tv[16];
#pragma unroll
    for (int k = 0; k < 16; ++k) tv[k] = wl[(32 + k) * 32 + l31];
    float sum = 0.f;
#pragma unroll
    for (int k = 0; k < 16; ++k) sum += __expf(tv[k] - tv[0]);
    const float inv = 1.f / sum;
    u32 ev[8]; float go[8];
#pragma unroll
    for (int q = 0; q < 8; ++q) { const float v = wl[(32 + hh * 8 + q) * 32 + l31]; const u32 cid = __float_as_uint(v) & 0xFFu;
      const u32 i1 = __float_as_uint(wl[(cid >> 4) * 32 + l31]) & 0x7Fu, i2 = __float_as_uint(wl[(16 + (cid & 15)) * 32 + l31]) & 0x7Fu; ev[q] = i1 * 128 + i2;
      go[q] = __expf(v - tv[0]) * inv; }
    const u32 io0 = ev[0] | (ev[1] << 16), io1 = ev[2] | (ev[3] << 16), io2 = ev[4] | (ev[5] << 16), io3 = ev[6] | (ev[7] << 16);
    { const int ob = l31 * 128 + h * 16 + hh * 8;
      *(u32x4*)(Lidx + ob) = (u32x4){io0, io1, io2, io3};
      *(f32x4*)(Lgate + ob) = (f32x4){go[0], go[1], go[2], go[3]}; *(f32x4*)(Lgate + ob + 4) = (f32x4){go[4], go[5], go[6], go[7]}; }
   }
   __syncthreads();
   {
    int tid_ = threadIdx.x; asm volatile("" : "+v"(tid_));
    const int tid = tid_, wid = tid >> 6, lane = tid & 63;
    const int tb = (job * 8 + wid) * GT;
    const int vidx = 4 * (lane >> 5) + 2 * ((lane >> 4) & 1) + ((lane >> 3) & 1); const unsigned lane16 = (unsigned)lane * 16u, lane12 = (unsigned)lane * 12u;
    bf16_t* sx = (bf16_t*)(smem + PF_X + wid * 8192); bf16_t* sidx = Lidx + wid * GT * 128; float* sgate = Lgate + wid * GT * 128;
#pragma unroll 1
    for (int g = 0; g < GT; ++g) { const size_t t = (size_t)(tb + g);
      { const u32x4 h0 = *(const u32x4*)(p.H + t * D + lane * 16), h1 = *(const u32x4*)(p.H + t * D + lane * 16 + 8);
        char* xo = (char*)sx + g * 2048 + (2 * (lane & 1)) * 512 + (lane >> 1) * 16;
        *(u32x4*)xo = h0; *(u32x4*)(xo + 512) = h1; }
      const int ia = sidx[g * 128 + lane], ib = sidx[g * 128 + 64 + lane]; const float ga = sgate[g * 128 + lane], gb = sgate[g * 128 + 64 + lane];
      const int wa = ia >> 10, wb = ib >> 10; int off = 0, pa = 0, pb = 0;
#pragma unroll
      for (int w = 0; w < 16; ++w) { const unsigned long long m0 = __ballot(wa == w), m1 = __ballot(wb == w); const int c0 = __popcll(m0), c1 = __popcll(m1);
        const int r0 = __builtin_amdgcn_mbcnt_hi((unsigned)(m0 >> 32), __builtin_amdgcn_mbcnt_lo((unsigned)m0, 0)), r1 = __builtin_amdgcn_mbcnt_hi((unsigned)(m1 >> 32), __builtin_amdgcn_mbcnt_lo((unsigned)m1, 0));
        if (wa == w) pa = off + r0; if (wb == w) pb = off + c0 + r1; off += c0 + c1; }
      sidx[g * 128 + pa] = (bf16_t)ia; sgate[g * 128 + pa] = ga; sidx[g * 128 + pb] = (bf16_t)ib; sgate[g * 128 + pb] = gb; }
    const int hh2 = lane >> 5, l5 = lane & 31; const unsigned l24 = (unsigned)l5 * 24u;
    const int kidx = 4 * ((lane >> 4) & 1) + 2 * ((lane >> 3) & 1) + ((lane >> 2) & 1);
    f32x2 acc[2][16];
#pragma unroll
    for (int q = 0; q < 2; ++q)
#pragma unroll
      for (int i = 0; i < 16; ++i) acc[q][i] = (f32x2){0.f, 0.f};
#pragma unroll 1
    for (int hb = 0; hb < 16; ++hb) {
#pragma unroll
      for (int q = 0; q < 2; ++q) {
        const int tokb = (2 * q + hh2) * 128 + hb * 8;
        const u32x4 iw = *(const u32x4*)(sidx + tokb); const u32 iwv[4] = {iw.x, iw.y, iw.z, iw.w};
        unsigned voff[8];
#pragma unroll
        for (int k = 0; k < 8; ++k) voff[k] = ((k & 1) ? (iwv[k >> 1] >> 16) : (iwv[k >> 1] & 0xFFFFu)) * 768u + l24;
        u32 hx[16];
#pragma unroll
        for (int c = 0; c < 4; ++c) { const u32x4 hq = *(const u32x4*)((const char*)sx + (2 * q + hh2) * 2048 + c * 512 + l5 * 16); hx[4 * c] = hq.x; hx[4 * c + 1] = hq.y; hx[4 * c + 2] = hq.z; hx[4 * c + 3] = hq.w; }
        u32x4 ra[8]; u32x2 rb[8];
#pragma unroll
        for (int k = 0; k < 8; ++k) { ra[k] = __builtin_amdgcn_raw_buffer_load_b128(rsU, voff[k], 0, 0); rb[k] = __builtin_amdgcn_raw_buffer_load_b64(rsU, voff[k] + 16u, 0, 0); }
        float d[8];
#pragma unroll
        for (int k = 0; k < 8; ++k) { const u32x6 pk = {ra[k].x, ra[k].y, ra[k].z, ra[k].w, rb[k].x, rb[k].y};
          const u32x16 ub = __builtin_bit_cast(u32x16, __builtin_amdgcn_cvt_scalef32_pk32_bf16_fp6(pk, 1.0f));
          float a0 = 0.f, a1 = 0.f;
#pragma unroll
          for (int j = 0; j < 8; ++j) { const u32 w0 = ub[2 * j], w1 = ub[2 * j + 1]; a0 = dot2bf(w0, hx[2 * j], a0); a1 = dot2bf(w1, hx[2 * j + 1], a1); }
          d[k] = a0 + a1; }
        asm volatile("" ::: "memory");
#pragma unroll
        for (int k = 0; k < 8; ++k) { ra[k] = __builtin_amdgcn_raw_buffer_load_b128(rsV, voff[k], 0, 0); rb[k] = __builtin_amdgcn_raw_buffer_load_b64(rsV, voff[k] + 16u, 0, 0); }
        float e4[4];
#pragma unroll
        for (int i = 0; i < 4; ++i) { auto r = __builtin_amdgcn_permlane16_swap(__float_as_uint(d[i]), __float_as_uint(d[i + 4]), false, false); e4[i] = __uint_as_float(r[0]) + __uint_as_float(r[1]); }
        const bool up8 = (lane & 8) != 0, up4 = (lane & 4) != 0;
        const float f0 = (up8 ? e4[2] : e4[0]) + dppf<DPP_MIR>(up8 ? e4[0] : e4[2]);
        const float f1 = (up8 ? e4[3] : e4[1]) + dppf<DPP_MIR>(up8 ? e4[1] : e4[3]);
        float zz = (up4 ? f1 : f0) + dppf<DPP_HMIR>(up4 ? f0 : f1);
        zz += dppf<DPP_X1>(zz); zz += dppf<DPP_X2>(zz);
        const float z = zz * (1.f / U6_SCALE);
        __builtin_amdgcn_sched_barrier(0);
        const float cf = sgate[tokb + kidx] * gelu_erf(z) * (1.f / V6_SCALE);
        __builtin_amdgcn_sched_barrier(0);
#pragma unroll
        for (int k = 0; k < 8; ++k) { const int src = 16 * (k >> 2) + 8 * ((k >> 1) & 1) + 4 * (k & 1);
          const float clo = __uint_as_float(__builtin_amdgcn_readlane(__float_as_uint(cf), src)), chi = __uint_as_float(__builtin_amdgcn_readlane(__float_as_uint(cf), 32 + src));
          const float ck = hh2 ? chi : clo; const f32x2 c2 = (f32x2){ck, ck};
          const u32x6 pk = {ra[k].x, ra[k].y, ra[k].z, ra[k].w, rb[k].x, rb[k].y};
          const f32x32 f = __builtin_amdgcn_cvt_scalef32_pk32_f32_fp6(pk, 1.0f);
#pragma unroll
          for (int j = 0; j < 16; ++j) acc[q][j] = (f32x2){f[2 * j], f[2 * j + 1]} * c2 + acc[q][j]; }
        asm volatile("" ::: "memory");
      }
      if (hb == 7) __syncthreads();
    }
    f32x4 xr[GT][4];
#pragma unroll
    for (int g = 0; g < GT; ++g)
#pragma unroll
      for (int q = 0; q < 4; ++q) xr[g][q] = *(const f32x4*)(p.X + (size_t)(tb + g) * D + lane * 16 + 4 * q);
#pragma unroll
    for (int g = 0; g < GT; ++g) { const int t = tb + g, b = t / S;
      if ((g & 1) == 0) {
        float* tr = (float*)sx;
#pragma unroll
        for (int j = 0; j < 8; ++j) *(f32x4*)(tr + hh2 * 1024 + l5 * 32 + 4 * j) = (f32x4){acc[g >> 1][2 * j].x, acc[g >> 1][2 * j].y, acc[g >> 1][2 * j + 1].x, acc[g >> 1][2 * j + 1].y};
        asm volatile("s_waitcnt lgkmcnt(0)" ::: "memory"); }
      f32x2 ag[8];
      { const float* tr = (const float*)sx + (g & 1) * 1024 + lane * 16;
#pragma unroll
        for (int j = 0; j < 4; ++j) { const f32x4 v4 = *(const f32x4*)(tr + 4 * j); ag[2 * j] = (f32x2){v4.x, v4.y}; ag[2 * j + 1] = (f32x2){v4.z, v4.w}; }
        if (g & 1) asm volatile("s_waitcnt lgkmcnt(0)" ::: "memory"); }
      const float* g2 = p.mod + (size_t)(layer * 8 + b) * 6144 + 5120 + lane * 16; float* xp = p.X + (size_t)t * D + lane * 16;
      float xv[16]; float ss = 0.f;
#pragma unroll
      for (int q = 0; q < 4; ++q) { const f32x4 x0 = xr[g][q], g0 = *(const f32x4*)(g2 + 4 * q);
        xv[4 * q + 0] = x0.x + g0.x * ag[2 * q].x; xv[4 * q + 1] = x0.y + g0.y * ag[2 * q].y; xv[4 * q + 2] = x0.z + g0.z * ag[2 * q + 1].x; xv[4 * q + 3] = x0.w + g0.w * ag[2 * q + 1].y; }
#pragma unroll
      for (int i = 0; i < 16; ++i) ss += xv[i] * xv[i];
      ss = wave_sum(ss); const float r = rsqrtf(ss * (1.f / D) + EPS);
      if (NEXT == 0) {
        const float* ml = p.mod + (size_t)((layer + 1) * 8 + b) * 6144 + lane * 16; const float* gn = p.nmg + (layer + 1) * D + lane * 16; float y[16];
#pragma unroll
        for (int i = 0; i < 16; ++i) y[i] = xv[i] * r * gn[i] * (1.f + ml[1024 + i]) + ml[i];
#pragma unroll
        for (int q = 0; q < 4; ++q) *(f32x4*)(xp + 4 * q) = (f32x4){xv[4 * q], xv[4 * q + 1], xv[4 * q + 2], xv[4 * q + 3]};
        u32x4 w0, w1; w0.x = pack2(y[0], y[1]); w0.y = pack2(y[2], y[3]); w0.z = pack2(y[4], y[5]); w0.w = pack2(y[6], y[7]); w1.x = pack2(y[8], y[9]); w1.y = pack2(y[10], y[11]); w1.z = pack2(y[12], y[13]); w1.w = pack2(y[14], y[15]);
        *(u32x4*)(p.H + (size_t)t * D + lane * 16) = w0; *(u32x4*)(p.H + (size_t)t * D + lane * 16 + 8) = w1;
      } else {
        const float* fg = p.final_g + lane * 16;
#pragma unroll
        for (int q = 0; q < 4; ++q) *(f32x4*)(xp + 4 * q) = (f32x4){xv[4 * q] * r * fg[4 * q], xv[4 * q + 1] * r * fg[4 * q + 1], xv[4 * q + 2] * r * fg[4 * q + 2], xv[4 * q + 3] * r * fg[4 * q + 3]};
      }
      asm volatile("" ::: "memory");
    }
    __syncthreads();
   }
  }
}

template <bool WITH_GATES, bool WITH_RES = false>
__device__ void phase_norm(const Params& p, const float* xin, const float* __restrict__ g, const float* __restrict__ modl, int sh_off, int sc_off, char* smem, const bf16_t* __restrict__ Y = nullptr, int gate_off = 0) {
  constexpr int GRS = 2064;
  char* const wgb = smem; char* const htile = smem + 16 * GRS;
  if (WITH_GATES) { __syncthreads();
    for (int i = threadIdx.x; i < 16 * 128; i += NTHREADS) { const int row = i >> 7, ch = i & 127; const f32x4 a = *(const f32x4*)(p.Wg + row * 1024 + ch * 8), b = *(const f32x4*)(p.Wg + row * 1024 + ch * 8 + 4);
      u32x4 w; w.x = pack2(a.x, a.y); w.y = pack2(a.z, a.w); w.z = pack2(b.x, b.y); w.w = pack2(b.z, b.w); *(u32x4*)(wgb + row * GRS + ch * 16) = w; }
    __syncthreads(); }
  for (int job = blockIdx.x; job < T / 32; job += gridDim.x) {
    int tid_ = threadIdx.x; asm volatile("" : "+v"(tid_));
    const int tid = tid_, wid = tid >> 6, lane = tid & 63; const int tb = job * 32 + wid * 4, b = tb / S;
    f32x4 v[4][4];
#pragma unroll
    for (int q = 0; q < 4; ++q)
#pragma unroll
      for (int i = 0; i < 4; ++i) v[q][i] = *(const f32x4*)(xin + (size_t)(tb + q) * D + i * 256 + lane * 4);
    if (WITH_RES) { const float* gtp = modl + (size_t)b * 6144 + gate_off;
#pragma unroll
      for (int i = 0; i < 4; ++i) { const f32x4 gt = *(const f32x4*)(gtp + i * 256 + lane * 4);
#pragma unroll
        for (int q = 0; q < 4; ++q) { const u32x2 yw = *(const u32x2*)(Y + (size_t)(tb + q) * D + i * 256 + lane * 4);
          v[q][i].x += gt.x * bflo(yw.x); v[q][i].y += gt.y * bfhi(yw.x); v[q][i].z += gt.z * bflo(yw.y); v[q][i].w += gt.w * bfhi(yw.y);
          *(f32x4*)(p.X + (size_t)(tb + q) * D + i * 256 + lane * 4) = v[q][i]; } } }
    const float* shp = modl + (size_t)b * 6144 + sh_off; const float* scp = modl + (size_t)b * 6144 + sc_off;
    f32x4 ga[4], gc[4];
#pragma unroll
    for (int i = 0; i < 4; ++i) { const int d = i * 256 + lane * 4; const f32x4 gg = *(const f32x4*)(g + d), s1 = *(const f32x4*)(scp + d); ga[i] = gg * (1.f + s1); gc[i] = *(const f32x4*)(shp + d); }
#pragma unroll
    for (int q = 0; q < 4; ++q) { float ss = 0.f;
#pragma unroll
      for (int i = 0; i < 4; ++i) ss += v[q][i].x * v[q][i].x + v[q][i].y * v[q][i].y + v[q][i].z * v[q][i].z + v[q][i].w * v[q][i].w;
      ss = wave_sum(ss); const float r = rsqrtf(ss * (1.f / D) + EPS);
#pragma unroll
      for (int i = 0; i < 4; ++i) { v[q][i] = v[q][i] * r * ga[i] + gc[i]; u32x2 w; w.x = pack2(v[q][i].x, v[q][i].y); w.y = pack2(v[q][i].z, v[q][i].w); *(u32x2*)(p.H + (size_t)(tb + q) * D + i * 256 + lane * 4) = w;
        if (WITH_GATES) *(u32x2*)(htile + (wid * 4 + q) * GRS + (i * 256 + lane * 4) * 2) = w; }
    }
    if (WITH_GATES) {
      typedef short bf16x8_ __attribute__((ext_vector_type(8)));
      __syncthreads();
      if (wid < 2) { f32x4 acc = (f32x4){0.f, 0.f, 0.f, 0.f};
        const char* ap = htile + (wid * 16 + (lane & 15)) * GRS + (lane >> 4) * 16; const char* bp = wgb + (lane & 15) * GRS + (lane >> 4) * 16;
#pragma unroll 8
        for (int ks = 0; ks < 32; ++ks) acc = __builtin_amdgcn_mfma_f32_16x16x32_bf16(*(const bf16x8_*)(ap + ks * 64), *(const bf16x8_*)(bp + ks * 64), acc, 0, 0, 0);
        const int gate = lane & 15; const float bias = p.ev_b_in[2560 + gate]; float* gp = p.gates + (size_t)(job * 32 + wid * 16 + 4 * (lane >> 4)) * 16 + gate;
        gp[0] = acc[0] + bias; gp[16] = acc[1] + bias; gp[32] = acc[2] + bias; gp[48] = acc[3] + bias; }
      __syncthreads();
    }
  }
}
__device__ void phase_cat(const Params& p) {
  for (int job = blockIdx.x; job < T / 32; job += gridDim.x) {
    int tid_ = threadIdx.x; asm volatile("" : "+v"(tid_));
    const int tid = tid_, wid = tid >> 6, lane = tid & 63; const int tb = job * 32 + wid * 4;
    u32x4 a[4], bq[4], so[4];
#pragma unroll
    for (int q = 0; q < 4; ++q) { const size_t o = (size_t)(tb + q) * 512 + lane * 8; a[q] = *(const u32x4*)(p.HS + o); bq[q] = *(const u32x4*)(p.HS + (size_t)T * 512 + o); so[q] = *(const u32x4*)(p.ZO + o); }
    const f32x4 g0 = *(const f32x4*)(p.mnorm_g + lane * 8), g1 = *(const f32x4*)(p.mnorm_g + lane * 8 + 4);
#pragma unroll
    for (int q = 0; q < 4; ++q) { float x[8]; const u32 aw[4] = {a[q].x, a[q].y, a[q].z, a[q].w}, bw[4] = {bq[q].x, bq[q].y, bq[q].z, bq[q].w}, sw[4] = {so[q].x, so[q].y, so[q].z, so[q].w};
      float ss = 0.f;
#pragma unroll
      for (int j = 0; j < 4; ++j) { x[2 * j] = bflo(aw[j]) + bflo(bw[j]); x[2 * j + 1] = bfhi(aw[j]) + bfhi(bw[j]); ss += x[2 * j] * x[2 * j] + x[2 * j + 1] * x[2 * j + 1]; }
      ss = row_sum(ss);
      const float r = rsqrtf(ss * (1.f / 128.f) + EPS);
      u32x4 w; w.x = pack2(x[0] * r * g0.x * bflo(sw[0]), x[1] * r * g0.y * bfhi(sw[0])); w.y = pack2(x[2] * r * g0.z * bflo(sw[1]), x[3] * r * g0.w * bfhi(sw[1]));
      w.z = pack2(x[4] * r * g1.x * bflo(sw[2]), x[5] * r * g1.y * bfhi(sw[2])); w.w = pack2(x[6] * r * g1.z * bflo(sw[3]), x[7] * r * g1.w * bfhi(sw[3]));
      *(u32x4*)(p.CAT + (size_t)(tb + q) * 1024 + lane * 8) = w; }
  }
}
__device__ void phase_qkrope(const Params& p, char* smem) {
  float* tab = (float*)smem;
  __syncthreads();
  for (int i = threadIdx.x; i < 64 * 32; i += NTHREADS) { const int pos = i >> 5, fi = i & 31; const float fr = exp2f(-(float)(2 * fi) * (13.287712379549449f / 64.f)); float sn, cs; sincosf((float)pos * fr, &sn, &cs); tab[2 * i] = cs; tab[2 * i + 1] = sn; }
  __syncthreads();
  for (int job = blockIdx.x; job < T / 16; job += gridDim.x) {
    int tid_ = threadIdx.x; asm volatile("" : "+v"(tid_));
    const int tid = tid_, wid = tid >> 6, lane = tid & 63; const int t = job * 16 + wid * 2 + (lane >> 5), kvh = (lane >> 4) & 1, cc = lane & 15, b = t / S, s = t & (S - 1);
    const u32x4 raw = *(const u32x4*)(p.QKV + (size_t)t * 1536 + 1024 + kvh * 128 + cc * 8); const u32 rw[4] = {raw.x, raw.y, raw.z, raw.w}; float x[8];
#pragma unroll
    for (int j = 0; j < 4; ++j) { x[2 * j] = bflo(rw[j]); x[2 * j + 1] = bfhi(rw[j]); }
    float ss = 0.f;
#pragma unroll
    for (int j = 0; j < 8; ++j) ss += x[j] * x[j];
    ss = row_sum(ss);
    const float r = rsqrtf(ss * (1.f / 128.f) + EPS); const float* gp = p.kn_g + cc * 8;
    const int pos = cc < 8 ? (s >> 6) : (s & 63); const float* tp = tab + (pos * 32 + (cc & 7) * 4) * 2; float y[8];
#pragma unroll
    for (int j = 0; j < 4; ++j) { const float x0 = x[2 * j] * r * gp[2 * j], x1 = x[2 * j + 1] * r * gp[2 * j + 1], cs = tp[2 * j], sn = tp[2 * j + 1]; y[2 * j] = x0 * cs - x1 * sn; y[2 * j + 1] = x0 * sn + x1 * cs; }
    u32x4 w; w.x = pack2(y[0], y[1]); w.y = pack2(y[2], y[3]); w.z = pack2(y[4], y[5]); w.w = pack2(y[6], y[7]);
    *(u32x4*)(p.Kh + (((size_t)b * 2 + kvh) * S + s) * 128 + cc * 8) = w;
  }
}

namespace att {
using bf16 = unsigned short;
constexpr int   D = 128, NW = 8, QBLK = 32, KVBLK = 64;
constexpr float SCALE = 0.088388347648318440f;
constexpr float THR = 8.f;
constexpr int SDEPTH = 2;
constexpr int LDQ = 1536, LDK = 128, LDV = 1536, LDO = 1024;
constexpr size_t SHM_V = KVBLK * D * 2, SHM_K = KVBLK * D * 2, SHM_ATTN = 2 * SHM_V + 2 * SHM_K + NW * 64 * 4;
using bf16x8 = __attribute__((ext_vector_type(8))) short;
using s16x4  = __attribute__((ext_vector_type(4))) short;
using f32x16 = __attribute__((ext_vector_type(16))) float;
using f32x8  = __attribute__((ext_vector_type(8))) float;
using u32x4  = __attribute__((ext_vector_type(4))) unsigned;
#define KSWZ(row, colB) ((row) * 256 + ((colB) ^ (((row) & 7) << 4)))
#define SBAR() __builtin_amdgcn_sched_barrier(0)
__device__ __forceinline__ int crow(int r, int hi) { return (r & 3) + 8 * (r >> 2) + 4 * hi; }
__device__ __forceinline__ unsigned cvtpk(float lo, float hi) {
  unsigned r; asm volatile("v_cvt_pk_bf16_f32 %0, %1, %2" : "=v"(r) : "v"(lo), "v"(hi)); return r;
}
template <typename TIn> struct Stage;
template <> struct Stage<bf16>  { using T = bf16x8;
  __device__ static __forceinline__ T ld8(const bf16* p) { return *reinterpret_cast<const bf16x8*>(p); }
  __device__ static __forceinline__ bf16x8 tobf(T x) { return x; } };
template <> struct Stage<float> { using T = f32x8;
  __device__ static __forceinline__ T ld8(const float* p) { return *reinterpret_cast<const f32x8*>(p); }
  __device__ static __forceinline__ bf16x8 tobf(T x) {
    u32x4 w = {cvtpk(x[0], x[1]), cvtpk(x[2], x[3]), cvtpk(x[4], x[5]), cvtpk(x[6], x[7])}; return *reinterpret_cast<bf16x8*>(&w); } };

__device__ __forceinline__ void partialSM(f32x16& p0, f32x16& p1, float& m_reg, float& mn, float& alpha) {
  constexpr float C = SCALE * 1.4426950408889634f;
  float pmax = p0[0]; for (int r = 1; r < 16; ++r) pmax = fmaxf(pmax, p0[r]); for (int r = 0; r < 16; ++r) pmax = fmaxf(pmax, p1[r]);
  { auto rr = __builtin_amdgcn_permlane32_swap(__float_as_uint(pmax), __float_as_uint(pmax), false, false);
    pmax = fmaxf(__uint_as_float(rr[0]), __uint_as_float(rr[1])); }
  if (__builtin_expect(__all(pmax - m_reg <= THR / SCALE), 1)) { mn = m_reg; alpha = 1.f; }
  else { mn = fmaxf(m_reg, pmax); alpha = __builtin_amdgcn_exp2f((m_reg - mn) * C); m_reg = mn; }
  float mnC = -mn * C;
  for (int r = 0; r < 16; ++r) p0[r] = fmaf(p0[r], C, mnC); for (int r = 0; r < 16; ++r) p1[r] = fmaf(p1[r], C, mnC);
  for (int r = 0; r < 16; ++r) p0[r] = __builtin_amdgcn_exp2f(p0[r]);
}
__device__ __forceinline__ void finishSM(f32x16& p0, f32x16& p1, float alpha, float& l_reg, bf16x8& pa0, bf16x8& pa1, bf16x8& pa2, bf16x8& pa3) {
  for (int r = 0; r < 16; ++r) p1[r] = __builtin_amdgcn_exp2f(p1[r]);
  float ps = 0; for (int r = 0; r < 16; ++r) ps += p0[r]; for (int r = 0; r < 16; ++r) ps += p1[r];
  { auto rr = __builtin_amdgcn_permlane32_swap(__float_as_uint(ps), __float_as_uint(ps), false, false);
    ps = __uint_as_float(rr[0]) + __uint_as_float(rr[1]); }
  l_reg = l_reg * alpha + ps;
#define PK4(P, BASE, OUT) do { unsigned a0 = cvtpk(P[BASE + 0], P[BASE + 1]), a1 = cvtpk(P[BASE + 2], P[BASE + 3]);   \
    unsigned b0 = cvtpk(P[BASE + 4], P[BASE + 5]), b1 = cvtpk(P[BASE + 6], P[BASE + 7]);                              \
    auto r0 = __builtin_amdgcn_permlane32_swap(a0, b0, false, false); auto r1 = __builtin_amdgcn_permlane32_swap(a1, b1, false, false); \
    u32x4 w = {r0[0], r1[0], r0[1], r1[1]}; OUT = *reinterpret_cast<bf16x8*>(&w); } while (0)
  PK4(p0, 0, pa0); PK4(p0, 8, pa1); PK4(p1, 0, pa2); PK4(p1, 8, pa3);
#undef PK4
}
__device__ __forceinline__ void qkt(f32x16& p0, f32x16& p1, const bf16* Ks, const bf16x8* qr, int r32, int hi) {
  p0 = f32x16{}; p1 = f32x16{};
  for (int d0 = 0; d0 < 8; ++d0) { int cb = (d0 * 16 + hi * 8) * 2;
    bf16x8 b0 = *reinterpret_cast<const bf16x8*>((const char*)Ks + KSWZ(r32, cb));
    bf16x8 b1 = *reinterpret_cast<const bf16x8*>((const char*)Ks + KSWZ(32 + r32, cb));
    p0 = __builtin_amdgcn_mfma_f32_32x32x16_bf16(b0, qr[d0], p0, 0, 0, 0);
    p1 = __builtin_amdgcn_mfma_f32_32x32x16_bf16(b1, qr[d0], p1, 0, 0, 0); }
}
__device__ __forceinline__ int v_st(int k, int c) { const int kk = (k & ~0xC) | ((k & 4) << 1) | ((k & 8) >> 1); return ((kk >> 3) * 4 + (c >> 5)) * 512 + ((kk & 7) * 32 + (c & 31)) * 2; }
__device__ __forceinline__ int v_rd_base(int lane) { return ((lane & 3) << 3) | (((lane >> 2) & 3) << 6) | (((lane >> 4) & 1) << 5) | (((lane >> 5) & 1) << 8); }
constexpr int v_rd_off(int d0, int ks, int half) { return d0 * 512 + ks * 4096 + half * 2048; }
template <int OFF> __device__ __forceinline__ s16x4 tr_read(int vb) {
  s16x4 r; asm volatile("ds_read_b64_tr_b16 %0, %1 offset:%2" : "=&v"(r) : "v"(vb), "i"(OFF) : "memory"); return r;
}
template <int D0> __device__ __forceinline__ void pv_one(f32x16& od, int vb, bf16x8 pa0, bf16x8 pa1, bf16x8 pa2, bf16x8 pa3) {
  const s16x4 l0 = tr_read<v_rd_off(D0, 0, 0)>(vb), h0 = tr_read<v_rd_off(D0, 0, 1)>(vb), l1 = tr_read<v_rd_off(D0, 1, 0)>(vb), h1 = tr_read<v_rd_off(D0, 1, 1)>(vb);
  const s16x4 l2 = tr_read<v_rd_off(D0, 2, 0)>(vb), h2 = tr_read<v_rd_off(D0, 2, 1)>(vb), l3 = tr_read<v_rd_off(D0, 3, 0)>(vb), h3 = tr_read<v_rd_off(D0, 3, 1)>(vb);
  asm volatile("s_waitcnt lgkmcnt(0)" ::: "memory"); SBAR();
#define PK(L, H) (bf16x8){L[0], L[1], L[2], L[3], H[0], H[1], H[2], H[3]}
  od = __builtin_amdgcn_mfma_f32_32x32x16_bf16(pa0, PK(l0, h0), od, 0, 0, 0);
  od = __builtin_amdgcn_mfma_f32_32x32x16_bf16(pa1, PK(l1, h1), od, 0, 0, 0);
  od = __builtin_amdgcn_mfma_f32_32x32x16_bf16(pa2, PK(l2, h2), od, 0, 0, 0);
  od = __builtin_amdgcn_mfma_f32_32x32x16_bf16(pa3, PK(l3, h3), od, 0, 0, 0);
#undef PK
}
__device__ __forceinline__ void pv_d0(f32x16* o, int vb, bf16x8 pa0, bf16x8 pa1, bf16x8 pa2, bf16x8 pa3) {
  pv_one<0>(o[0], vb, pa0, pa1, pa2, pa3); pv_one<1>(o[1], vb, pa0, pa1, pa2, pa3); pv_one<2>(o[2], vb, pa0, pa1, pa2, pa3); pv_one<3>(o[3], vb, pa0, pa1, pa2, pa3);
}

template <typename TQ>
__device__ __forceinline__ void attn_dense_body(const TQ* __restrict__ Qb, const bf16* __restrict__ Kh, const bf16* __restrict__ Vh,
                                                bf16* __restrict__ Ob, int seq, char* lds, const float* __restrict__ qg, const float* rtab, int s0) {
  using St = Stage<bf16>; using SQ = Stage<TQ>;
  int tid_ = threadIdx.x; asm volatile("" : "+v"(tid_)); const int tid = tid_, wid = tid >> 6, lane = tid & 63, r32 = lane & 31, hi = lane >> 5;
  bf16* V_lds = (bf16*)lds; bf16* K_lds = (bf16*)(lds + 2 * SHM_V);
  float* ws = (float*)(lds + 2 * SHM_V + 2 * SHM_K) + wid * 64; float* li_l = ws; float* al_l = ws + 32;
  float m_reg = -1e30f, l_reg = 0; f32x16 o[4] = {}; bf16x8 qr[8];
  const TQ* Qw = Qb + (long)(wid * QBLK + r32) * LDQ + hi * 8;
  {
    bf16x8 raw[8]; float ss = 0.f;
#pragma unroll
    for (int d0 = 0; d0 < 8; ++d0) { raw[d0] = SQ::tobf(SQ::ld8(Qw + d0 * 16));
#pragma unroll
      for (int e = 0; e < 8; ++e) { const float v = __uint_as_float(((unsigned)(unsigned short)raw[d0][e]) << 16); ss += v * v; } }
    ss = sum32x(ss); const float rn = rsqrtf(ss * (1.f / 128.f) + 1e-6f); const int sq = s0 + wid * QBLK + r32;
#pragma unroll
    for (int d0 = 0; d0 < 8; ++d0) { const float* gp = qg + d0 * 16 + hi * 8; const int pos = d0 < 4 ? (sq >> 6) : (sq & 63); const float* tp = rtab + (pos * 32 + (d0 & 3) * 8 + hi * 4) * 2; unsigned w[4];
#pragma unroll
      for (int j = 0; j < 4; ++j) { const float x0 = __uint_as_float(((unsigned)(unsigned short)raw[d0][2 * j]) << 16) * rn * gp[2 * j], x1 = __uint_as_float(((unsigned)(unsigned short)raw[d0][2 * j + 1]) << 16) * rn * gp[2 * j + 1];
        const float cs = tp[2 * j], sn = tp[2 * j + 1]; w[j] = cvtpk(x0 * cs - x1 * sn, x0 * sn + x1 * cs); }
      u32x4 ww = {w[0], w[1], w[2], w[3]}; qr[d0] = *reinterpret_cast<bf16x8*>(&ww); }
  }
  const int sr = tid >> 4, sc = (tid & 15) * 8, vst0 = v_st(sr, sc), vst1 = v_st(32 + sr, sc);
  const int vb0 = (int)(uintptr_t)V_lds + v_rd_base(lane);
  struct { typename St::T vs0, vs1, ks0, ks1; } sr_[SDEPTH];
#define SLOAD(i, k0) do { sr_[i].vs0 = St::ld8(&Vh[(long)((k0) + sr) * LDV + sc]); sr_[i].vs1 = St::ld8(&Vh[(long)((k0) + 32 + sr) * LDV + sc]); \
    sr_[i].ks0 = St::ld8(&Kh[(long)((k0) + sr) * LDK + sc]); sr_[i].ks1 = St::ld8(&Kh[(long)((k0) + 32 + sr) * LDK + sc]); } while (0)
#define SWRITE(b, i) do { *(bf16x8*)((char*)V_lds + (b) * SHM_V + vst0) = St::tobf(sr_[i].vs0);          \
    *(bf16x8*)((char*)V_lds + (b) * SHM_V + vst1) = St::tobf(sr_[i].vs1); int kc = sc * 2;               \
    *(bf16x8*)((char*)K_lds + (b) * SHM_K + KSWZ(sr, kc)) = St::tobf(sr_[i].ks0);                       \
    *(bf16x8*)((char*)K_lds + (b) * SHM_K + KSWZ(32 + sr, kc)) = St::tobf(sr_[i].ks1); } while (0)
#define SWAIT() do { if constexpr (SDEPTH == 2) asm volatile("s_waitcnt vmcnt(4)" ::: "memory"); else asm volatile("s_waitcnt vmcnt(0)" ::: "memory"); } while (0)
#define RESC(a) do { if (__any((a) < 1.f)) { if (hi == 0) al_l[r32] = (a); asm volatile("s_waitcnt lgkmcnt(0)" ::: "memory"); \
    for (int d = 0; d < 4; ++d) for (int r = 0; r < 16; ++r) o[d][r] *= al_l[crow(r, hi)]; } } while (0)
  f32x16 pA0, pA1, pB0, pB1; float mnA, mnB, alA, alB; bf16x8 pa0, pa1, pa2, pa3; const int NT = seq / KVBLK;
  constexpr int SE = 0, SO = SDEPTH - 1;
  SLOAD(SE, 0); asm volatile("s_waitcnt vmcnt(0)" ::: "memory"); SWRITE(0, SE); __syncthreads();
  qkt(pA0, pA1, K_lds, qr, r32, hi); partialSM(pA0, pA1, m_reg, mnA, alA);
  SLOAD(SO, KVBLK); if constexpr (SDEPTH == 2) { if (2 < NT) SLOAD(SE, 2 * KVBLK); }
  SWAIT(); SWRITE(1, SO); __syncthreads();
  for (int j = 1; j + 1 < NT; j += 2) {
    SBAR(); qkt(pB0, pB1, (bf16*)((char*)K_lds + SHM_K), qr, r32, hi);
    finishSM(pA0, pA1, alA, l_reg, pa0, pa1, pa2, pa3); SBAR();
    SLOAD(SO, (j + SDEPTH) * KVBLK); SBAR();
    pv_d0(o, vb0, pa0, pa1, pa2, pa3); partialSM(pB0, pB1, m_reg, mnB, alB);
    __syncthreads(); SWAIT(); SWRITE(0, SE);
    RESC(alB); __syncthreads();
    SBAR(); qkt(pA0, pA1, K_lds, qr, r32, hi);
    finishSM(pB0, pB1, alB, l_reg, pa0, pa1, pa2, pa3); SBAR();
    if (SDEPTH == 1 || j + 3 < NT) SLOAD(SE, (j + 1 + SDEPTH) * KVBLK); SBAR();
    pv_d0(o, vb0 + (int)SHM_V, pa0, pa1, pa2, pa3); partialSM(pA0, pA1, m_reg, mnA, alA);
    __syncthreads(); SWAIT(); SWRITE(1, SO);
    RESC(alA); __syncthreads();
  }
  SBAR(); qkt(pB0, pB1, (bf16*)((char*)K_lds + SHM_K), qr, r32, hi);
  finishSM(pA0, pA1, alA, l_reg, pa0, pa1, pa2, pa3); SBAR();
  pv_d0(o, vb0, pa0, pa1, pa2, pa3); partialSM(pB0, pB1, m_reg, mnB, alB);
  __syncthreads(); RESC(alB);
  finishSM(pB0, pB1, alB, l_reg, pa0, pa1, pa2, pa3); SBAR();
  pv_d0(o, vb0 + (int)SHM_V, pa0, pa1, pa2, pa3);
  if (hi == 0) li_l[r32] = l_reg; asm volatile("s_waitcnt lgkmcnt(0)" ::: "memory");
  float rli[16];
#pragma unroll
  for (int r = 0; r < 16; ++r) rli[r] = __builtin_amdgcn_rcpf(li_l[crow(r, hi)]);
  __syncthreads();
  bf16* Ol = (bf16*)lds + wid * (QBLK * D);
#pragma unroll
  for (int r = 0; r < 16; ++r) { const int orow = crow(r, hi);
#pragma unroll
    for (int d0 = 0; d0 < 4; ++d0) { const float v = o[d0][r] * rli[r]; unsigned u = __float_as_uint(v); u += 0x7FFFu + ((u >> 16) & 1u); Ol[orow * D + d0 * 32 + r32] = (bf16)(u >> 16); } }
  asm volatile("s_waitcnt lgkmcnt(0)" ::: "memory");
#pragma unroll
  for (int i = 0; i < 8; ++i) { const int row = i * 4 + (lane >> 4), ch = (lane & 15) * 8;
    const u32x4 v = *reinterpret_cast<const u32x4*>(Ol + row * D + ch);
    *reinterpret_cast<u32x4*>(Ob + (long)(wid * QBLK + row) * LDO + ch) = v; }
  __syncthreads();
#undef SLOAD
#undef SWRITE
#undef SWAIT
#undef RESC
}

}

__device__ void phase_attn(const Params& p, char* smem) {
  const int G = (int)gridDim.x, c = (int)blockIdx.x;
  float* rtab = (float*)(smem + 68 * 1024);
  __syncthreads();
  for (int i = threadIdx.x; i < 64 * 32; i += NTHREADS) { const int pos = i >> 5, fi = i & 31; const float fr = exp2f(-(float)(2 * fi) * (13.287712379549449f / 64.f)); float sn, cs; sincosf((float)pos * fr, &sn, &cs); rtab[2 * i] = cs; rtab[2 * i + 1] = sn; }
  __syncthreads();
  for (int i = 0; i * G + c < 1024; ++i) {
    int pair, j;
    if (G == 256) { pair = 2 * (c & 7) + (i >> 1); j = (i & 1) * 32 + (c >> 3); } else { const int L = i * G + c; pair = L >> 6; j = L & 63; }
    const int b = pair >> 1, kv = pair & 1, qb = j >> 2, g = j & 3, h = kv * 4 + g;
    const bf16_t* Qb = p.QKV + ((size_t)b * S + qb * 256) * 1536 + h * 128; const bf16_t* Kp = p.Kh + ((size_t)b * 2 + kv) * S * 128; const bf16_t* Vp = p.QKV + (size_t)b * S * 1536 + 1280 + kv * 128;
    bf16_t* Ob = p.CAT + ((size_t)b * S + qb * 256) * 1024 + h * 128;
    att::attn_dense_body<att::bf16>(Qb, Kp, Vp, Ob, S, smem, p.qn_g, rtab, qb * 256);
  }
}

#define XB_TMO      128
#define XB_XCNT(j)  (256  + 64 * (j))
#define XB_XSUB(j)  (1280 + 64 * (j))
#define XB_XGEN(j)  (2304 + 64 * (j))
#define XB_TOP      3328
#define XB_TOPGEN   3392
#define XCD_BAR_WORDS 3456
#define XB_SPIN_CAP (1u << 18)
#define LAS __attribute__((address_space(3)))

__device__ __forceinline__ unsigned xb_ld(unsigned* p)              { return __hip_atomic_load(p, __ATOMIC_RELAXED, __HIP_MEMORY_SCOPE_AGENT); }
__device__ __forceinline__ unsigned xb_add(unsigned* p, unsigned v) { return __hip_atomic_fetch_add(p, v, __ATOMIC_RELAXED, __HIP_MEMORY_SCOPE_AGENT); }
__device__ __forceinline__ unsigned xb_xcc_id() { return (unsigned)__builtin_amdgcn_s_getreg((3 << 11) | 20) & 0xFu; }
#define XB_SPIN(cond, bar) do { unsigned _sp = 0; while (cond) { __builtin_amdgcn_s_sleep(1); \
    if ((++_sp & 255u) == 0u) { if (xb_ld(&(bar)[XB_TMO])) break; if (_sp > XB_SPIN_CAP) { atomicAdd(&(bar)[XB_TMO], 1u); break; } } } } while (0)

struct XcdBarrier {
    unsigned* bar; unsigned x;
    volatile LAS unsigned* st;
};

__device__ __forceinline__ XcdBarrier xcd_barrier_post(unsigned* bar, volatile LAS unsigned* st) {
    XcdBarrier b; b.bar = bar; b.x = xb_xcc_id(); b.st = st;
    if (threadIdx.x == 0) (void)xb_add(&bar[XB_XCNT(b.x)], 1u);
    return b;
}
__device__ __forceinline__ void xcd_barrier_complete(unsigned* bar, unsigned x, unsigned& nloc, unsigned& nx) {
    const unsigned G = gridDim.x * gridDim.y * gridDim.z;
    unsigned sum, cnt, mine, sp = 0u;
    for (;;) {
        sum = 0u; cnt = 0u; mine = 0u;
#pragma unroll
        for (unsigned j = 0; j < 16; ++j) { const unsigned c = xb_ld(&bar[XB_XCNT(j)]); sum += c; cnt += (c > 0u) ? 1u : 0u; mine = (j == x) ? c : mine; }
        if (sum == G) break;
        __builtin_amdgcn_s_sleep(1);
        if ((++sp & 255u) == 0u) { if (xb_ld(&bar[XB_TMO])) break; if (sp > XB_SPIN_CAP) { atomicAdd(&bar[XB_TMO], 1u); break; } }
    }
    nloc = mine > 0u ? mine : 1u; nx = cnt > 0u ? cnt : 1u;
}

__device__ __forceinline__ void xcd_barrier(const XcdBarrier& b) {
    asm volatile("s_waitcnt vmcnt(0)" ::: "memory");
    __syncthreads();
    if (threadIdx.x == 0) {
        unsigned* bar = b.bar;
        __builtin_amdgcn_s_waitcnt(0);
        unsigned nloc = b.st[0], nx = b.st[1];
        if (nloc == 0u) { xcd_barrier_complete(bar, b.x, nloc, nx); b.st[0] = nloc; b.st[1] = nx; }
        const unsigned old = xb_add(&bar[XB_XSUB(b.x)], 1u);
        const unsigned gen = old / nloc;
        if (old + 1u == (gen + 1u) * nloc) {
            __builtin_amdgcn_fence(__ATOMIC_RELEASE, "agent");
            asm volatile("s_waitcnt vmcnt(0)" ::: "memory");
            const unsigned og = xb_add(&bar[XB_TOP], 1u);
            const unsigned tg = og / nx;
            if (og + 1u == (tg + 1u) * nx) xb_add(&bar[XB_TOPGEN], 1u);
            else XB_SPIN(xb_ld(&bar[XB_TOPGEN]) == tg, bar);
            __builtin_amdgcn_fence(__ATOMIC_ACQUIRE, "agent");
            xb_add(&bar[XB_XGEN(b.x)], 1u);
            asm volatile("s_waitcnt vmcnt(0)" ::: "memory");
        } else {
            XB_SPIN(xb_ld(&bar[XB_XGEN(b.x)]) == gen, bar);
            __builtin_amdgcn_fence(__ATOMIC_ACQUIRE, "agent");
            asm volatile("s_waitcnt vmcnt(0)" ::: "memory");
        }
    }
    __syncthreads();
}


constexpr int NPH = 19;
__global__ __launch_bounds__(NTHREADS, 2) void mega(Params p, int ph0, int ph1) {
  extern __shared__ __attribute__((aligned(16))) char smem[];
  cg::grid_group grid = cg::this_grid();
  volatile LAS unsigned* xst = (volatile LAS unsigned*)(LAS char*)(smem + SMEM_BYTES - 16);
  if (threadIdx.x == 0) { xst[0] = 0u; xst[1] = 0u; }
  __syncthreads();
  const XcdBarrier xb = xcd_barrier_post(p.bar, xst);
#define GSYNC(k) do { if ((k) == 1) grid.sync(); else xcd_barrier(xb); } while (0)
#define PHASE(k, call) if (ph0 <= (k) && (k) < ph1) { if ((k) > ph0) GSYNC(k); call; }
#if !defined(ONLY_PHASE) || ONLY_PHASE == 0
  PHASE(0, phase_prep(p, smem))
#endif
#if !defined(ONLY_PHASE) || ONLY_PHASE == 1
  PHASE(1, phase_norm<true>(p, p.x, p.nmg, p.mod, 0, 1024, smem))
#endif
#if !defined(ONLY_PHASE) || ONLY_PHASE == 2
  PHASE(2, phase_gemm_fast(p.H, p.Wt_evin, T, 2560, 1024, (EpiEvin{p.ZQK, p.ZV, p.ZO, p.ZP, p.ev_b_in}), smem))
#endif
#if !defined(ONLY_PHASE) || ONLY_PHASE == 3
  PHASE(3, cp::phase_convpool(p, smem))
#endif
#if !defined(ONLY_PHASE) || ONLY_PHASE == 4
  PHASE(4, ml::phase_mlstm(p, smem))
#endif
#if !defined(ONLY_PHASE) || ONLY_PHASE == 5
  PHASE(5, phase_cat(p))
#endif
#if !defined(ONLY_PHASE) || ONLY_PHASE == 6
  PHASE(6, phase_gemm_fast(p.CAT, p.Wt_evout, T, 1024, 1024, (EpiPlain{p.Yb, 1024}), smem))
#endif
#if !defined(ONLY_PHASE) || ONLY_PHASE == 7
  PHASE(7, (phase_norm<false, true>(p, p.x, p.nfg, p.mod, 3072, 4096, smem, p.Yb, 2048)))
#endif
#if !defined(ONLY_PHASE) || ONLY_PHASE == 8
  PHASE(8, phase_gemm_fast(p.H, p.Wt_q, T, 2048, 1024, (EpiQP{p.QP}), smem))
#endif
#if !defined(ONLY_PHASE) || ONLY_PHASE == 9
#endif
#if !defined(ONLY_PHASE) || ONLY_PHASE == 10
  PHASE(10, phase_peer_fused<0>(p, 0, smem))
#endif
#if !defined(ONLY_PHASE) || ONLY_PHASE == 11
  PHASE(11, phase_gemm_fast(p.H, p.Wt_odin, T, 1536, 1024, (EpiPlain{p.QKV, 1536}), smem))
#endif
#if !defined(ONLY_PHASE) || ONLY_PHASE == 12
  PHASE(12, phase_qkrope(p, smem))
#endif
#if !defined(ONLY_PHASE) || ONLY_PHASE == 13
  PHASE(13, phase_attn(p, smem))
#endif
#if !defined(ONLY_PHASE) || ONLY_PHASE == 14
  PHASE(14, phase_gemm_fast(p.CAT, p.Wt_odout, T, 1024, 1024, (EpiPlain{p.Yb, 1024}), smem))
#endif
#if !defined(ONLY_PHASE) || ONLY_PHASE == 15
  PHASE(15, (phase_norm<false, true>(p, p.X, p.nfg + D, p.mod + (size_t)8 * 6144, 3072, 4096, smem, p.Yb, 2048)))
#endif
#if !defined(ONLY_PHASE) || ONLY_PHASE == 16
  PHASE(16, phase_gemm_fast(p.H, p.Wt_q + (size_t)2048 * 1024, T, 2048, 1024, (EpiQP{p.QP}), smem))
#endif
#if !defined(ONLY_PHASE) || ONLY_PHASE == 17
#endif
#if !defined(ONLY_PHASE) || ONLY_PHASE == 18
  PHASE(18, phase_peer_fused<1>(p, 1, smem))
#endif
#undef PHASE
}
}

extern "C" void kernel_launch(void* const* d_in, const int* in_sizes, int n_in, void* d_out, int out_size, void* d_ws, size_t ws_size, hipStream_t stream) {
  (void)in_sizes; (void)n_in; (void)out_size;
  Params p{};
  const float** fin = (const float**)&p;
  for (int i = 0; i < 23; ++i) fin[i] = (const float*)d_in[i];
  p.X = (float*)d_out;
  char* ws = (char*)d_ws; size_t off = 0;
  auto alloc = [&](size_t bytes) { char* q = ws + off; off += (bytes + 255) / 256 * 256; return q; };
  p.U8 = (unsigned char*)alloc((size_t)2 * 16384 * 1024); p.V8 = (unsigned char*)alloc((size_t)2 * 16384 * 1024);
  p.Wt_evin = (bf16_t*)alloc((size_t)2560 * 1024 * 2); p.Wt_evout = (bf16_t*)alloc((size_t)1024 * 1024 * 2); p.Wt_odin = (bf16_t*)alloc((size_t)1536 * 1024 * 2);
  p.Wt_odout = (bf16_t*)alloc((size_t)1024 * 1024 * 2); p.Wt_q = (bf16_t*)alloc((size_t)2 * 2048 * 1024 * 2); p.keysb = (bf16_t*)alloc((size_t)2 * 2 * 128 * 128 * 2); p.poolWt = (bf16_t*)alloc((size_t)4 * 128 * 128 * 2);
  p.Wg = (float*)alloc(16 * 1024 * 4); p.mod = (float*)alloc(2 * 8 * 6144 * 4); p.gates = (float*)alloc((size_t)T * 16 * 4);
  p.H = (bf16_t*)alloc((size_t)T * 1024 * 2); p.CAT = p.H;
  char* big = alloc((size_t)T * 2048 * 2);
  p.ZQK = (bf16_t*)big; p.ZV = (bf16_t*)(big + (size_t)T * 1024 * 2); p.ZO = (bf16_t*)(big + (size_t)T * 1536 * 2); p.HS = (bf16_t*)big; p.QP = (bf16_t*)big; p.QKV = (bf16_t*)big; p.Yb = (bf16_t*)big;
  char* big2 = alloc((size_t)T * 1536 * 2);
  p.QK = (bf16_t*)big2; p.ZP = (bf16_t*)(big2 + (size_t)T * 1024 * 2); p.Qh = (bf16_t*)big2; p.Kh = (bf16_t*)(big2 + (size_t)T * 1024 * 2); p.Vh = (bf16_t*)(big2 + (size_t)T * 1280 * 2);
  p.bar = (unsigned*)alloc(XCD_BAR_WORDS * 4);
  if (off > ws_size) { fprintf(stderr, "kernel_launch: workspace too small: need %zu have %zu\n", off, ws_size); return; }

  static int grid_blocks = 0;
  if (!grid_blocks) {
    int dev = 0, cus = 0, per_cu = 0; hipGetDevice(&dev); hipDeviceGetAttribute(&cus, hipDeviceAttributeMultiprocessorCount, dev);
    hipFuncSetAttribute((const void*)mega, hipFuncAttributeMaxDynamicSharedMemorySize, SMEM_BYTES);
    hipOccupancyMaxActiveBlocksPerMultiprocessor(&per_cu, mega, NTHREADS, SMEM_BYTES);
    if (per_cu > 1) per_cu = 1;
    grid_blocks = cus * per_cu;
    if (grid_blocks <= 0) { fprintf(stderr, "kernel_launch: occupancy query returned 0\n"); grid_blocks = 0; return; }
  }
  hipMemsetAsync(p.bar, 0, XCD_BAR_WORDS * 4, stream);
#if MULTI_LAUNCH
  for (int ph = 0; ph < NPH; ++ph) hipLaunchKernelGGL(mega, dim3(grid_blocks), dim3(NTHREADS), SMEM_BYTES, stream, p, ph, ph + 1);
#else
  int ph0 = 0, ph1 = NPH; void* args[] = {&p, &ph0, &ph1};
  hipError_t e = hipLaunchCooperativeKernel((const void*)mega, dim3(grid_blocks), dim3(NTHREADS), args, SMEM_BYTES, stream);
  if (e != hipSuccess) fprintf(stderr, "cooperative launch failed: %s (grid %d)\n", hipGetErrorString(e), grid_blocks);
#endif
}
```
